# Optimizing an MI355X kernel written in HIP

```python
import math
import jax, jax.numpy as jnp
from jax import lax
import numpy as np

D_MODEL = 1024
BATCH = 4
SEQ = 8192
DEPTH = 2

CHUNK = 64
N_EVEN = (DEPTH + 1) // 2
N_ODD = DEPTH // 2
EPS = 1e-6
LN_EPS = 1e-5
ROPE_THETA = 10000.0

CONV_DIM = D_MODEL
CONV_WIDTH = 31
RWKV_HEAD = 64
RWKV_HEADS = D_MODEL // RWKV_HEAD
RWKV_DIM = RWKV_HEADS * RWKV_HEAD
LORA_DIM = 64
GN_EPS = 64e-5
ATT_HEADS = 16
ATT_HEAD_DIM = 128
ATT_DIM = ATT_HEADS * ATT_HEAD_DIM
IDX_HEADS = 8
IDX_HEAD_DIM = 64
TOPK_MAX = 256
Q_BLOCK = 128

EVEN_SIZES = (CONV_DIM, CONV_DIM, CONV_DIM,
              RWKV_DIM, RWKV_DIM, RWKV_DIM,
              LORA_DIM, LORA_DIM, RWKV_DIM)
EVEN_COLS = sum(EVEN_SIZES)
EVEN_OUT = CONV_DIM + RWKV_DIM
ODD_SIZES = (ATT_DIM, ATT_HEAD_DIM, ATT_HEAD_DIM,
             IDX_HEADS * IDX_HEAD_DIM, IDX_HEAD_DIM, IDX_HEADS,
             ATT_DIM)
ODD_COLS = sum(ODD_SIZES)

kernel_name = "chunk_causal_hybrid_conv_rwkv7_dsa"


def split_cols(z, sizes):
    idx = np.cumsum(sizes)[:-1].tolist()
    return jnp.split(z, idx, axis=-1)


def rms_norm(x, g):
    xf = x.astype(jnp.float32)
    y = xf * lax.rsqrt(jnp.mean(xf * xf, axis=-1, keepdims=True) + EPS)
    return (y * g.astype(jnp.float32)).astype(x.dtype)


def layer_norm(x, w, b, eps):
    xf = x.astype(jnp.float32)
    mu = jnp.mean(xf, axis=-1, keepdims=True)
    var = jnp.mean(jnp.square(xf - mu), axis=-1, keepdims=True)
    y = (xf - mu) * lax.rsqrt(var + eps)
    return (y * w.astype(jnp.float32) + b.astype(jnp.float32)).astype(x.dtype)


def rope(x, pos):
    d = x.shape[-1]
    inv = ROPE_THETA ** (-jnp.arange(0, d, 2, dtype=jnp.float32) / d)
    ang = pos.astype(jnp.float32)[..., None] * inv
    cos = jnp.cos(ang)[:, :, None, :]
    sin = jnp.sin(ang)[:, :, None, :]
    xf = x.astype(jnp.float32)
    x1, x2 = jnp.split(xf, 2, axis=-1)
    out = jnp.concatenate([x1 * cos - x2 * sin, x2 * cos + x1 * sin], axis=-1)
    return out.astype(x.dtype)


def token_shift(z):
    return jnp.pad(z[:, :-1], ((0, 0), (1, 0), (0, 0)))


def conformer_conv(val, glu, conv_w, conv_vec):
    u = val * jax.nn.sigmoid(glu)
    y = lax.conv_general_dilated(u, conv_w.astype(u.dtype), window_strides=(1,),
                                 padding=[(CONV_WIDTH - 1, 0)],
                                 dimension_numbers=('NWC', 'WIO', 'NWC'),
                                 feature_group_count=CONV_DIM)
    y = y + conv_vec[0]
    y = layer_norm(y, conv_vec[1], conv_vec[2], LN_EPS)
    return jax.nn.silu(y)


def rwkv7_step(state, inp):
    r_t, w_t, k_t, v_t, kk_t, a_t = inp
    sa = jnp.einsum('bhvk,bhk->bhv', state, -kk_t)
    state = (state * w_t[:, :, None, :]
             + sa[..., None] * (kk_t * a_t)[:, :, None, :]
             + v_t[..., None] * k_t[:, :, None, :])
    y = jnp.einsum('bhvk,bhk->bhv', state, r_t)
    return state, y


def rwkv7_mix(r, k, v, wd, ad, mu_rkv, mu_lora, vec, w_up, a_up, r_k):
    B, S, _ = r.shape
    f32 = jnp.float32
    lerp = lambda z, mu: z + (token_shift(z) - z) * mu
    r = lerp(r, mu_rkv[0]).astype(f32)
    k = lerp(k, mu_rkv[1]).astype(f32)
    v = lerp(v, mu_rkv[2]).astype(f32)
    wd = lerp(wd, mu_lora[0]).astype(f32)
    ad = lerp(ad, mu_lora[1]).astype(f32)
    vec = vec.astype(f32)
    w0, a0, k_k, k_a, lnx_w, lnx_b = vec[0], vec[1], vec[2], vec[3], vec[4], vec[5]
    w_log = -jax.nn.softplus(-(w0 + jnp.tanh(wd) @ w_up.astype(f32))) - 0.5
    decay = jnp.exp(-jnp.exp(w_log))
    a = jax.nn.sigmoid(a0 + ad @ a_up.astype(f32))
    heads = lambda t: t.reshape(B, S, RWKV_HEADS, RWKV_HEAD)
    kk = heads(k * k_k)
    kk = kk / jnp.maximum(jnp.sqrt(jnp.sum(kk * kk, axis=-1, keepdims=True)), 1e-12)
    k = k * (1.0 + (a - 1.0) * k_a)
    r_h, w_h, k_h, v_h, a_h = heads(r), heads(decay), heads(k), heads(v), heads(a)
    xs = tuple(jnp.moveaxis(t, 1, 0) for t in (r_h, w_h, k_h, v_h, kk, a_h))
    state0 = jnp.zeros((B, RWKV_HEADS, RWKV_HEAD, RWKV_HEAD), f32)
    _, y = lax.scan(rwkv7_step, state0, xs)
    y = jnp.moveaxis(y, 0, 1)
    mu = jnp.mean(y, axis=-1, keepdims=True)
    var = jnp.mean(jnp.square(y - mu), axis=-1, keepdims=True)
    y = ((y - mu) * lax.rsqrt(var + GN_EPS)).reshape(B, S, RWKV_DIM) * lnx_w + lnx_b
    bonus = jnp.sum(r_h * k_h * r_k.astype(f32), axis=-1, keepdims=True) * v_h
    return y + bonus.reshape(B, S, RWKV_DIM)


def dsa_attention(q, k, v, qi, ki, wi, positions):
    B, S = positions.shape
    k_sel = min(TOPK_MAX, S // 4)
    nb = S // Q_BLOCK
    chunk_id = positions // CHUNK
    kf = ki.astype(jnp.float32)

    def to_blocks(t):
        return jnp.moveaxis(t.reshape((B, nb, Q_BLOCK) + t.shape[2:]), 1, 0)

    def block(args):
        qb, qib, wib, cqb = args
        idx_logits = jnp.einsum('bqhd,bsd->bqhs', qib.astype(jnp.float32), kf) * (IDX_HEAD_DIM ** -0.5)
        score = jnp.einsum('bqh,bqhs->bqs', wib.astype(jnp.float32) * (IDX_HEADS ** -0.5),
                           jax.nn.relu(idx_logits))
        adm = chunk_id[:, None, :] <= cqb[:, :, None]
        score = jnp.where(adm, score, -jnp.inf)
        top_val, top_idx = lax.top_k(score, k_sel)
        valid = jnp.isfinite(top_val)
        kg = jax.vmap(lambda kb, ib: kb[ib])(k, top_idx)
        vg = jax.vmap(lambda vb, ib: vb[ib])(v, top_idx)
        logits = jnp.einsum('bqhd,bqkd->bqhk', qb, kg).astype(jnp.float32) * (ATT_HEAD_DIM ** -0.5)
        logits = jnp.where(valid[:, :, None, :], logits, -jnp.inf)
        p = jax.nn.softmax(logits, axis=-1).astype(v.dtype)
        return jnp.einsum('bqhk,bqkd->bqhd', p, vg)

    o = lax.map(block, (to_blocks(q), to_blocks(qi), to_blocks(wi), to_blocks(chunk_id)))
    return jnp.moveaxis(o, 0, 1).reshape(B, S, ATT_DIM)


def setup_inputs(seed: int = 0) -> dict:
    key = jax.random.key(seed)
    ks = jax.random.split(key, 24)
    nrm = lambda k, shape, s: jax.random.normal(k, shape, jnp.float32) * s
    x = nrm(ks[0], (BATCH, SEQ, D_MODEL), 1.0)
    c = nrm(ks[1], (BATCH, D_MODEL), 1.0)
    offsets = jax.random.randint(ks[2], (BATCH,), 0, 64, dtype=jnp.int32) * CHUNK
    positions = offsets[:, None] + jnp.arange(SEQ, dtype=jnp.int32)[None, :]
    ada_w = nrm(ks[3], (DEPTH, D_MODEL, 3 * D_MODEL), 0.5 * D_MODEL ** -0.5)
    ada_b = nrm(ks[4], (DEPTH, 3 * D_MODEL), 0.02)
    norm_g = 1.0 + nrm(ks[5], (DEPTH, D_MODEL), 0.05)
    final_g = 1.0 + nrm(ks[6], (D_MODEL,), 0.05)
    even_w_in = nrm(ks[7], (N_EVEN, D_MODEL, EVEN_COLS), D_MODEL ** -0.5)
    even_w_out = nrm(ks[8], (N_EVEN, EVEN_OUT, D_MODEL), EVEN_OUT ** -0.5)
    conv_w = nrm(ks[9], (N_EVEN, CONV_WIDTH, 1, CONV_DIM), CONV_WIDTH ** -0.5)
    kc = jax.random.split(ks[10], 3)
    conv_vec = jnp.stack([nrm(kc[0], (N_EVEN, CONV_DIM), 0.02),
                          1.0 + nrm(kc[1], (N_EVEN, CONV_DIM), 0.05),
                          nrm(kc[2], (N_EVEN, CONV_DIM), 0.02)], axis=1)
    rwkv_mu_rkv = jax.random.uniform(ks[11], (N_EVEN, 3, RWKV_DIM), jnp.float32)
    rwkv_mu_lora = jax.random.uniform(ks[12], (N_EVEN, 2, LORA_DIM), jnp.float32)
    kv = jax.random.split(ks[13], 6)
    rwkv_vec = jnp.stack([
        jax.random.uniform(kv[0], (N_EVEN, RWKV_DIM), jnp.float32, -4.0, 1.0),
        nrm(kv[1], (N_EVEN, RWKV_DIM), 0.1),
        0.85 + nrm(kv[2], (N_EVEN, RWKV_DIM), 0.05),
        1.0 + nrm(kv[3], (N_EVEN, RWKV_DIM), 0.05),
        1.0 + nrm(kv[4], (N_EVEN, RWKV_DIM), 0.05),
        nrm(kv[5], (N_EVEN, RWKV_DIM), 0.02)], axis=1)
    rwkv_w_up = nrm(ks[14], (N_EVEN, LORA_DIM, RWKV_DIM), 0.5 * LORA_DIM ** -0.5)
    rwkv_a_up = nrm(ks[15], (N_EVEN, LORA_DIM, RWKV_DIM), 0.5 * LORA_DIM ** -0.5)
    rwkv_r_k = nrm(ks[16], (N_EVEN, RWKV_HEADS, RWKV_HEAD), 0.1)
    odd_w_in = nrm(ks[17], (N_ODD, D_MODEL, ODD_COLS), D_MODEL ** -0.5)
    odd_w_out = nrm(ks[18], (N_ODD, ATT_DIM, D_MODEL), ATT_DIM ** -0.5)
    return {"x": x, "c": c, "positions": positions, "ada_w": ada_w, "ada_b": ada_b,
            "norm_g": norm_g, "final_g": final_g, "even_w_in": even_w_in,
            "even_w_out": even_w_out, "conv_w": conv_w, "conv_vec": conv_vec,
            "rwkv_mu_rkv": rwkv_mu_rkv, "rwkv_mu_lora": rwkv_mu_lora, "rwkv_vec": rwkv_vec,
            "rwkv_w_up": rwkv_w_up, "rwkv_a_up": rwkv_a_up, "rwkv_r_k": rwkv_r_k,
            "odd_w_in": odd_w_in, "odd_w_out": odd_w_out}


def reference(x, c, positions, ada_w, ada_b, norm_g, final_g, even_w_in, even_w_out,
              conv_w, conv_vec, rwkv_mu_rkv, rwkv_mu_lora, rwkv_vec, rwkv_w_up, rwkv_a_up,
              rwkv_r_k, odd_w_in, odd_w_out):
    B, S, _ = x.shape
    cond = jax.nn.silu(c)
    for l in range(DEPTH):
        mod = cond @ ada_w[l] + ada_b[l]
        shift, scale, gate = jnp.split(mod, 3, axis=-1)
        h = rms_norm(x, norm_g[l]) * (1.0 + scale[:, None, :]) + shift[:, None, :]
        j = l // 2
        if l % 2 == 0:
            z = h @ even_w_in[j]
            a_val, a_glu, a_gate, r, k, v, wd, ad, b_gate = split_cols(z, EVEN_SIZES)
            ya = conformer_conv(a_val, a_glu, conv_w[j], conv_vec[j]) * jax.nn.silu(a_gate)
            yb = rwkv7_mix(r, k, v, wd, ad, rwkv_mu_rkv[j], rwkv_mu_lora[j], rwkv_vec[j],
                           rwkv_w_up[j], rwkv_a_up[j], rwkv_r_k[j]).astype(h.dtype)
            yb = yb * jax.nn.silu(b_gate)
            out = jnp.concatenate([ya, yb], axis=-1) @ even_w_out[j]
        else:
            z = h @ odd_w_in[j]
            q, k, v, qi, ki, wi, g = split_cols(z, ODD_SIZES)
            q = rope(q.reshape(B, S, ATT_HEADS, ATT_HEAD_DIM), positions)
            k = rope(k[:, :, None, :], positions)[:, :, 0, :]
            qi = rope(qi.reshape(B, S, IDX_HEADS, IDX_HEAD_DIM), positions)
            ki = rope(ki[:, :, None, :], positions)[:, :, 0, :]
            o = dsa_attention(q, k, v, qi, ki, wi, positions)
            out = (o * jax.nn.silu(g)) @ odd_w_out[j]
        x = x + gate[:, None, :] * out
    return rms_norm(x, final_g)
```

```cpp
#include <hip/hip_runtime.h>
#include <hip/hip_cooperative_groups.h>
#include <cstdio>
#include <cstdint>
namespace cg = cooperative_groups;

#define LAS __attribute__((address_space(3)))
typedef unsigned short bf16_t;
typedef float f32x4 __attribute__((ext_vector_type(4)));
typedef float f32x2 __attribute__((ext_vector_type(2)));
typedef float f32x16 __attribute__((ext_vector_type(16)));
typedef unsigned u32x4 __attribute__((ext_vector_type(4)));
typedef unsigned u32x2 __attribute__((ext_vector_type(2)));
typedef short bf16x8 __attribute__((ext_vector_type(8)));
typedef short s16x4 __attribute__((ext_vector_type(4)));

constexpr int BATCH = 4, SEQ = 8192, DM = 1024, MTOK = BATCH * SEQ;
constexpr int N0 = 7424, N1 = 5120;
constexpr int EVEN_COLS = 7296, ODD_COLS = 4936;
constexpr int NWAVES = 8, NTHREADS = 512;
constexpr int LDS_BYTES = 147456;

constexpr size_t MiB = 1u << 20;
constexpr size_t WS_MODP = 0;
constexpr size_t WS_WIN0 = 4 * MiB, WS_WOUT0 = 20 * MiB, WS_WIN1 = 24 * MiB, WS_WOUT1 = 34 * MiB, WS_WLORA = 38 * MiB;
constexpr size_t WS_CSA = 40 * MiB, WS_CSI = 56 * MiB;
constexpr size_t WS_H = 64 * MiB;
constexpr size_t WS_YAB = 64 * MiB;
constexpr size_t WS_U = 192 * MiB, WS_AG = 256 * MiB, WS_R = 320 * MiB, WS_K = 384 * MiB, WS_V = 448 * MiB;
constexpr size_t WS_AARR = WS_U, WS_DARR = WS_AG;
constexpr size_t WS_Q = 128 * MiB, WS_G = 256 * MiB, WS_KV = 384 * MiB, WS_QI = 400 * MiB, WS_KI = 432 * MiB, WS_WI = 436 * MiB;
constexpr size_t WS_NEED = 512 * MiB;
constexpr size_t DO_BG = 0, DO_WDAD = 64 * MiB, DO_LA = 72 * MiB, DO_RK = 88 * MiB;

__device__ __forceinline__ float bflo(unsigned w) { return __uint_as_float(w << 16); }
__device__ __forceinline__ float bfhi(unsigned w) { return __uint_as_float(w & 0xffff0000u); }
__device__ __forceinline__ unsigned pk2(float lo, float hi) { unsigned r; asm volatile("v_cvt_pk_bf16_f32 %0, %1, %2" : "=v"(r) : "v"(lo), "v"(hi)); return r; }
__device__ __forceinline__ float sigmoidf_(float x) { return __builtin_amdgcn_rcpf(1.0f + __expf(-x)); }
__device__ __forceinline__ float wave_sum(float v) {
#pragma unroll
    for (int o = 1; o < 64; o <<= 1) v += __shfl_xor(v, o);
    return v;
}
template <int CTRL> __device__ __forceinline__ float dppmov(float x) { return __int_as_float(__builtin_amdgcn_update_dpp(0, __float_as_int(x), CTRL, 0xf, 0xf, true)); }
__device__ __forceinline__ float quad_sum(float x) { x += dppmov<0xB1>(x); x += dppmov<0x4E>(x); return x; }
__device__ __forceinline__ float row16_sum(float x) { x += dppmov<0xB1>(x); x += dppmov<0x4E>(x); x += dppmov<0x141>(x); x += dppmov<0x140>(x); return x; }
#define LDS_WAIT() asm volatile("s_waitcnt lgkmcnt(0)" ::: "memory")

__device__ __forceinline__ int map0(int n) {
    const int t = n >> 8, r = n & 255;
    if (t < 8) return (r < 128) ? 128 * t + r : 1024 + 128 * t + (r - 128);
    if (t < 12) return 2048 + 256 * (t - 8) + r;
    if (t < 24) return 3072 + 256 * (t - 12) + r;
    if (t < 28) return 6272 + 256 * (t - 24) + r;
    return (r < 128) ? 6144 + r : -1;
}
__device__ __forceinline__ int map1(int n) {
    const int t = n >> 8, r = n & 255, half = r >> 7, rr = r & 127;
    if (t < 8) return (2 * t + (rr >> 6)) * 128 + half * 64 + (rr & 63);
    if (t == 8) return 2048 + (rr >> 6) * 128 + half * 64 + (rr & 63);
    if (t < 11) return 2304 + (4 * (t - 9) + (rr >> 5)) * 64 + half * 32 + (rr & 31);
    if (t == 11) { if (rr < 32) return 2816 + half * 32 + rr; if (half == 0 && rr < 40) return 2880 + (rr - 32); return -1; }
    return 2888 + 256 * (t - 12) + r;
}
namespace pg8 {
#define PG8_LAS __attribute__((address_space(3)))
typedef unsigned short bf16_t;
typedef short bf16x8 __attribute__((ext_vector_type(8)));
typedef float f32x4 __attribute__((ext_vector_type(4)));
typedef unsigned u32x4 __attribute__((ext_vector_type(4)));
constexpr int BM = 256, BK = 64, HALF = 128, HTB = HALF * BK * 2  , STAGE_BYTES = 8 * HTB, NXCD = 8, WGM = 8;

__host__ __device__ __forceinline__ int lds_byte(int r, int c) { const int st = (r >> 4) * 2 + (c >> 5), rr = r & 15, cc = c & 31, ob = rr * 64 + cc * 2; return st * 1024 + (ob ^ (((ob >> 9) & 1) << 5)); }
__host__ __device__ __forceinline__ void stage_rc(int b, int& R, int& C) { const int st = b / 1024, sb = b % 1024, swz = sb ^ (((sb >> 9) & 1) << 5); R = (st >> 1) * 16 + swz / 64; C = (st & 1) * 32 + (swz % 64) / 2; }
__host__ __device__ __forceinline__ int perm32(int rho) { const int n = rho >> 4, i = rho & 15; return 8 * (i >> 2) + 4 * n + (i & 3); }

struct Unit { int pm, pn; };
struct Gemm { const bf16_t* A; const bf16_t* Bt; int M, N, K; };

struct StaticOrder {
    int nM, nN, nwg, G, c;
    __host__ __device__ void init(int M, int N, int G_, int c_) { nM = M / BM; nN = N / BM; nwg = nM * nN; G = G_; c = c_; }
    __host__ __device__ bool next(int i, Unit& u) const {
        const long L = (long)i * G + c; if (L >= nwg) return false;
        int wgid = (int)L; { const int q = nwg / NXCD, r = nwg % NXCD, xcd = wgid % NXCD, off = wgid / NXCD; wgid = (xcd < r ? xcd * (q + 1) : r * (q + 1) + (xcd - r) * q) + off; }
        const int nig = WGM * nN, gid = wgid / nig, fm = gid * WGM, gsz = (nM - fm) < WGM ? (nM - fm) : WGM;
        u.pm = fm + ((wgid % nig) % gsz); u.pn = (wgid % nig) / gsz; return true;
    }
    __device__ __forceinline__ void a_ready(const Unit&) const {}
    __device__ __forceinline__ void done(const Unit&) const {}
};

__device__ __forceinline__ unsigned cvt_pk_bf16(float lo, float hi) { unsigned r; asm volatile("v_cvt_pk_bf16_f32 %0, %1, %2" : "=v"(r) : "v"(lo), "v"(hi)); return r; }
typedef float f32x2 __attribute__((ext_vector_type(2)));
template <class Epi, class Sched, bool ALIGN_EPI = false, bool SP2 = false>
__device__ __forceinline__ void gemm_phase(PG8_LAS unsigned char* lds, const Gemm g, const Sched& S, const Epi& E) {
    const int tid = threadIdx.x, wid = __builtin_amdgcn_readfirstlane(tid >> 6), lane = tid & 63, wr = wid >> 2, wc = wid & 3, fr = lane & 15, fq = lane >> 4;
    const int K = g.K, nt = K / BK;
    unsigned voffA[2], voffB[2];
#pragma unroll
    for (int i = 0; i < 2; ++i) { int R, C; stage_rc(tid * 16 + i * 8192, R, C); const int Rb = Epi::PERM ? ((R & ~31) + perm32(R & 31)) : R;
        voffA[i] = (unsigned)(R * K + C) * 2u; voffB[i] = (unsigned)(Rb * K + C) * 2u; }
    const size_t kstep = (size_t)(BK * 2);
    const size_t hstep = (size_t)HALF * K * 2;
    const size_t tstep = 2 * hstep;
    const unsigned ldsw = (unsigned)wid * 1024u;
    const int aoff = lds_byte(wr * 64 + fr, fq * 8), boff = lds_byte(wc * 32 + fr, fq * 8);
#define PG8_SA(b, h) (((b) * 2 + (h)) * HTB)
#define PG8_SB(b, h) ((4 + (b) * 2 + (h)) * HTB)
#define PG8_STAGE(bufoff, gbase, voff) do { _Pragma("unroll") for (int _i = 0; _i < 2; ++_i) \
        __builtin_amdgcn_global_load_lds((const unsigned*)((const char*)(gbase) + (voff)[_i]), (PG8_LAS unsigned*)(lds + (bufoff) + ldsw + _i * 8192), 16, 0, 0); } while (0)
#define PG8_LDA(dst, b, h) do { _Pragma("unroll") for (int m = 0; m < 4; ++m) _Pragma("unroll") for (int k = 0; k < 2; ++k) dst[m][k] = *(const PG8_LAS bf16x8*)(lds + PG8_SA(b, h) + aoff + m * 2048 + k * 1024); } while (0)
#define PG8_LDB(dst, b, h) do { _Pragma("unroll") for (int n = 0; n < 2; ++n) _Pragma("unroll") for (int k = 0; k < 2; ++k) dst[n][k] = *(const PG8_LAS bf16x8*)(lds + PG8_SB(b, h) + boff + n * 2048 + k * 1024); } while (0)
#define PG8_MMA(ai, bj, At, Bt) do { __builtin_amdgcn_s_setprio(1); _Pragma("unroll") for (int m = 0; m < 4; ++m) _Pragma("unroll") for (int n = 0; n < 2; ++n) _Pragma("unroll") for (int k = 0; k < 2; ++k) \
        acc[ai][bj][m][n] = __builtin_amdgcn_mfma_f32_16x16x32_bf16(Bt[n][k], At[m][k], acc[ai][bj][m][n], 0, 0, 0); __builtin_amdgcn_s_setprio(0); } while (0)
#define PG8_WAIT_V(n) asm volatile("s_waitcnt vmcnt(" #n ")" ::: "memory")
#define PG8_WAIT_L(n) asm volatile("s_waitcnt lgkmcnt(" #n ")" ::: "memory")
#define PG8_BAR __builtin_amdgcn_s_barrier()
#define PG8_SCHED __builtin_amdgcn_sched_barrier(0)
    Unit cur, nxt; int ui = 0;
    if (!S.next(0, cur)) return;
    f32x4 acc[2][2][4][2];
#pragma unroll
    for (int a = 0; a < 2; ++a)
#pragma unroll
        for (int b = 0; b < 2; ++b)
#pragma unroll
            for (int m = 0; m < 4; ++m)
#pragma unroll
                for (int n = 0; n < 2; ++n) acc[a][b][m][n] = (f32x4){0.f, 0.f, 0.f, 0.f};
    bf16x8 At[4][2], B0[2][2], B1[2][2];
    const char* cA = (const char*)g.A + (size_t)cur.pm * tstep; const char* cB = (const char*)g.Bt + (size_t)cur.pn * tstep;
    S.a_ready(cur);
    if constexpr (SP2) {
        PG8_STAGE(PG8_SB(0, 0), cB, voffB); PG8_STAGE(PG8_SB(0, 1), cB + hstep, voffB); PG8_STAGE(PG8_SA(0, 0), cA, voffA); PG8_STAGE(PG8_SA(0, 1), cA + hstep, voffA);
        if (wr == 1) PG8_BAR;
        PG8_WAIT_V(2); PG8_BAR;
        PG8_STAGE(PG8_SB(1, 0), cB + kstep, voffB); PG8_STAGE(PG8_SA(1, 0), cA + kstep, voffA); PG8_STAGE(PG8_SB(1, 1), cB + hstep + kstep, voffB);
        PG8_WAIT_V(6); PG8_BAR;
    } else {
        PG8_STAGE(PG8_SB(0, 0), cB, voffB); PG8_STAGE(PG8_SA(0, 0), cA, voffA); PG8_STAGE(PG8_SB(0, 1), cB + hstep, voffB); PG8_STAGE(PG8_SA(0, 1), cA + hstep, voffA);
        if (wr == 1) PG8_BAR;
        PG8_WAIT_V(4); PG8_BAR;
        PG8_STAGE(PG8_SB(1, 0), cB + kstep, voffB); PG8_STAGE(PG8_SA(1, 0), cA + kstep, voffA); PG8_STAGE(PG8_SB(1, 1), cB + hstep + kstep, voffB);
        PG8_WAIT_V(6); PG8_BAR;
    }
    for (;;) {
        const bool has_next = S.next(ui + 1, nxt);
        const char* nA = has_next ? (const char*)g.A + (size_t)nxt.pm * tstep : cA; const char* nB = has_next ? (const char*)g.Bt + (size_t)nxt.pn * tstep : cB;
        for (int t = 0; t < nt; t += 2) {
            const bool last = (t == nt - 2);
            const char* a1 = cA + (size_t)(t + 1) * kstep;
            const char* a2 = last ? nA : cA + (size_t)(t + 2) * kstep; const char* b2 = last ? nB : cB + (size_t)(t + 2) * kstep;
            const char* a3 = a2 + kstep; const char* b3 = b2 + kstep;
            if (last && has_next) S.a_ready(nxt);
            if constexpr (SP2) {
            PG8_LDB(B0, 0, 0); PG8_LDB(B1, 0, 1); PG8_SCHED; PG8_LDA(At, 0, 0); PG8_STAGE(PG8_SA(1, 1), a1 + hstep, voffA);
            PG8_WAIT_V(8); PG8_WAIT_L(0); PG8_BAR; PG8_MMA(0, 0, At, B0); PG8_MMA(0, 1, At, B1); PG8_BAR; PG8_SCHED;
            PG8_LDA(At, 0, 1); PG8_STAGE(PG8_SB(0, 0), b2, voffB); PG8_STAGE(PG8_SB(0, 1), b2 + hstep, voffB); PG8_STAGE(PG8_SA(0, 0), a2, voffA);
            PG8_WAIT_V(8); PG8_WAIT_L(0); PG8_BAR; PG8_MMA(1, 0, At, B0); PG8_MMA(1, 1, At, B1); PG8_BAR; PG8_SCHED;
            PG8_LDB(B0, 1, 0); PG8_LDB(B1, 1, 1); PG8_SCHED; PG8_LDA(At, 1, 0); PG8_STAGE(PG8_SA(0, 1), a2 + hstep, voffA);
            PG8_WAIT_V(8); PG8_WAIT_L(0); PG8_BAR; PG8_MMA(0, 0, At, B0); PG8_MMA(0, 1, At, B1); PG8_BAR; PG8_SCHED;
            PG8_LDA(At, 1, 1); PG8_STAGE(PG8_SB(1, 0), b3, voffB); PG8_STAGE(PG8_SB(1, 1), b3 + hstep, voffB); PG8_STAGE(PG8_SA(1, 0), a3, voffA);
            PG8_WAIT_V(8); PG8_WAIT_L(0); PG8_BAR; PG8_MMA(1, 0, At, B0); PG8_MMA(1, 1, At, B1); PG8_BAR; PG8_SCHED;
            } else {
            PG8_LDB(B0, 0, 0); PG8_SCHED; PG8_LDA(At, 0, 0); PG8_STAGE(PG8_SA(1, 1), a1 + hstep, voffA);
            PG8_WAIT_L(8); PG8_BAR; PG8_WAIT_L(0); PG8_MMA(0, 0, At, B0); PG8_BAR; PG8_SCHED;
            PG8_LDB(B1, 0, 1); PG8_STAGE(PG8_SB(0, 0), b2, voffB);
            PG8_BAR; PG8_WAIT_L(0); PG8_MMA(0, 1, At, B1); PG8_BAR;
            PG8_LDA(At, 0, 1); PG8_STAGE(PG8_SA(0, 0), a2, voffA);
            PG8_BAR; PG8_WAIT_L(0); PG8_MMA(1, 0, At, B0); PG8_BAR; PG8_SCHED;
            PG8_STAGE(PG8_SB(0, 1), b2 + hstep, voffB);
            PG8_WAIT_V(6); PG8_BAR; PG8_MMA(1, 1, At, B1); PG8_BAR;
            PG8_LDB(B0, 1, 0); PG8_SCHED; PG8_LDA(At, 1, 0); PG8_STAGE(PG8_SA(0, 1), a2 + hstep, voffA);
            PG8_WAIT_L(8); PG8_BAR; PG8_WAIT_L(0); PG8_MMA(0, 0, At, B0); PG8_BAR; PG8_SCHED;
            PG8_LDB(B1, 1, 1); PG8_STAGE(PG8_SB(1, 0), b3, voffB);
            PG8_BAR; PG8_WAIT_L(0); PG8_MMA(0, 1, At, B1); PG8_BAR;
            PG8_LDA(At, 1, 1); PG8_STAGE(PG8_SA(1, 0), a3, voffA);
            PG8_BAR; PG8_WAIT_L(0); PG8_MMA(1, 0, At, B0); PG8_BAR; PG8_SCHED;
            PG8_STAGE(PG8_SB(1, 1), b3 + hstep, voffB);
            PG8_WAIT_V(6); PG8_BAR; PG8_MMA(1, 1, At, B1); PG8_BAR;
            }
        }
        if constexpr (ALIGN_EPI) { if (wr == 0) PG8_BAR; }
        if constexpr (!Epi::AFTER_DRAIN) { E(acc, cur, wr, wc, fr, fq); S.done(cur); }
        if (!has_next) break;
#pragma unroll
        for (int a = 0; a < 2; ++a)
#pragma unroll
            for (int b = 0; b < 2; ++b)
#pragma unroll
                for (int m = 0; m < 4; ++m)
#pragma unroll
                    for (int n = 0; n < 2; ++n) acc[a][b][m][n] = (f32x4){0.f, 0.f, 0.f, 0.f};
        cur = nxt; cA = nA; cB = nB; ++ui;
        if constexpr (ALIGN_EPI) { if (wr == 1) PG8_BAR; }
    }
    PG8_WAIT_V(0);
    if constexpr (!ALIGN_EPI) { if (wr == 0) PG8_BAR; }
    PG8_BAR;
    if constexpr (Epi::AFTER_DRAIN) { E.fused(acc, cur, wr, wc, fr, fq, lds, wid, lane); S.done(cur); }
#undef PG8_SA
#undef PG8_SB
#undef PG8_STAGE
#undef PG8_LDA
#undef PG8_LDB
#undef PG8_MMA
#undef PG8_WAIT_V
#undef PG8_WAIT_L
#undef PG8_BAR
#undef PG8_SCHED
}
}

__device__ __forceinline__ u32x4 pack8(const f32x4 a, const f32x4 b) { u32x4 w; w.x = pk2(a[0], a[1]); w.y = pk2(a[2], a[3]); w.z = pk2(b[0], b[1]); w.w = pk2(b[2], b[3]); return w; }
__device__ __forceinline__ f32x4 silu4(const f32x4 v) { f32x4 o; o[0] = v[0] * sigmoidf_(v[0]); o[1] = v[1] * sigmoidf_(v[1]); o[2] = v[2] * sigmoidf_(v[2]); o[3] = v[3] * sigmoidf_(v[3]); return o; }
__device__ __forceinline__ f32x4 sig4(const f32x4 v) { f32x4 o; o[0] = sigmoidf_(v[0]); o[1] = sigmoidf_(v[1]); o[2] = sigmoidf_(v[2]); o[3] = sigmoidf_(v[3]); return o; }

struct Epi0 {
    static constexpr bool PERM = true, AFTER_DRAIN = false;
    unsigned char* ws; unsigned char* dout;
    __device__ __forceinline__ void operator()(const f32x4 (&acc)[2][2][4][2], const pg8::Unit& u, int wr, int wc, int fr, int fq) const {
        const int row0 = u.pm * 256 + wr * 64 + fr, t = u.pn, cw = wc * 32 + 8 * fq;
        if (t < 8) {
            bf16_t* U = (bf16_t*)(ws + WS_U);
#pragma unroll
            for (int ai = 0; ai < 2; ++ai)
#pragma unroll
                for (int m = 0; m < 4; ++m) { const size_t row = (size_t)(row0 + ai * 128 + m * 16);
                    const f32x4 a = acc[ai][0][m][0] * sig4(acc[ai][1][m][0]), b = acc[ai][0][m][1] * sig4(acc[ai][1][m][1]);
                    *(u32x4*)(U + row * 1024 + 128 * t + cw) = pack8(a, b); }
        } else if (t == 28) {
            bf16_t* WDAD = (bf16_t*)(dout + DO_WDAD);
#pragma unroll
            for (int ai = 0; ai < 2; ++ai)
#pragma unroll
                for (int m = 0; m < 4; ++m) { const size_t row = (size_t)(row0 + ai * 128 + m * 16);
                    *(u32x4*)(WDAD + row * 128 + cw) = pack8(acc[ai][0][m][0], acc[ai][0][m][1]); }
        } else {
            const bool act = (t < 12) || (t >= 24); const int c0 = 256 * (t & 3);
            unsigned char* bp = (t >= 24) ? (dout + DO_BG) : (ws + WS_AG + (size_t)((t - 8) >> 2) * (64 * MiB));
            bf16_t* base = (bf16_t*)bp;
#pragma unroll
            for (int ai = 0; ai < 2; ++ai)
#pragma unroll
                for (int m = 0; m < 4; ++m) { const size_t row = (size_t)(row0 + ai * 128 + m * 16);
#pragma unroll
                    for (int bj = 0; bj < 2; ++bj) { f32x4 a = acc[ai][bj][m][0], b = acc[ai][bj][m][1];
                        if (act) { a = silu4(a); b = silu4(b); }
                        *(u32x4*)(base + row * 1024 + c0 + 128 * bj + cw) = pack8(a, b); } }
        }
    }
};
static_assert(WS_R == WS_AG + 64 * MiB && WS_K == WS_AG + 128 * MiB && WS_V == WS_AG + 192 * MiB, "Epi0 region arithmetic");

struct EpiLora {
    static constexpr bool PERM = true, AFTER_DRAIN = false;
    bf16_t *D, *A; const float* vec;
    __device__ __forceinline__ void operator()(const f32x4 (&acc)[2][2][4][2], const pg8::Unit& u, int wr, int wc, int fr, int fq) const {
        const int row0 = u.pm * 256 + wr * 64 + fr, t = u.pn, cw = wc * 32 + 8 * fq;
        const bool isd = t < 4; bf16_t* base = isd ? D : A; const int c0 = 256 * (t & 3); const float* bias = vec + (isd ? 0 : 1024) + c0 + cw;
        const float sc = isd ? 0.60653065971f : 1.0f;
#pragma unroll
        for (int ai = 0; ai < 2; ++ai)
#pragma unroll
            for (int m = 0; m < 4; ++m) { const size_t row = (size_t)(row0 + ai * 128 + m * 16);
#pragma unroll
                for (int bj = 0; bj < 2; ++bj) { const f32x4 b0 = *(const f32x4*)(bias + 128 * bj), b1 = *(const f32x4*)(bias + 128 * bj + 4);
                    const f32x4 a = sig4(acc[ai][bj][m][0] + b0) * sc, b = sig4(acc[ai][bj][m][1] + b1) * sc;
                    *(u32x4*)(base + row * 1024 + c0 + 128 * bj + cw) = pack8(a, b); } }
    }
};

struct EpiRes {
    static constexpr bool PERM = false, AFTER_DRAIN = false;
    const float* resid; float* out; const float* modp; const float* ada_b; int layer;
    __device__ __forceinline__ void operator()(const f32x4 (&acc)[2][2][4][2], const pg8::Unit& u, int wr, int wc, int fr, int fq) const {
        const int row0 = u.pm * 256 + wr * 64 + fr, col0 = u.pn * 256 + wc * 32 + 4 * fq, b = (u.pm * 256) / SEQ;
        f32x4 gv[2][2];
#pragma unroll
        for (int bj = 0; bj < 2; ++bj)
#pragma unroll
            for (int n = 0; n < 2; ++n) { const int c = col0 + bj * 128 + n * 16; f32x4 g = *(const f32x4*)(ada_b + layer * 3072 + 2048 + c);
#pragma unroll
                for (int s = 0; s < 8; ++s) g += *(const f32x4*)(modp + (size_t)((s * 2 + layer) * 4 + b) * 3072 + 2048 + c);
                gv[bj][n] = g; }
#pragma unroll
        for (int ai = 0; ai < 2; ++ai)
#pragma unroll
            for (int m = 0; m < 4; ++m) { const size_t off = (size_t)(row0 + ai * 128 + m * 16) * 1024 + col0;
#pragma unroll
                for (int bj = 0; bj < 2; ++bj)
#pragma unroll
                    for (int n = 0; n < 2; ++n) { const f32x4 r = *(const f32x4*)(resid + off + bj * 128 + n * 16);
                        *(f32x4*)(out + off + bj * 128 + n * 16) = r + gv[bj][n] * acc[ai][bj][m][n]; }
                asm volatile("" ::: "memory"); }
    }
};

constexpr float Q_SCALE = 0.08838834764831845f * 1.4426950408889634f;
constexpr float WI_SCALE = 0.35355339059327373f * 0.125f;
struct Epi1 {
    static constexpr bool PERM = true, AFTER_DRAIN = false;
    bf16_t *Q, *KV, *QI, *KI, *G; float* WI; const f32x2* csa; const f32x2* csi;
    __device__ __forceinline__ void rope8(const f32x4 x1a, const f32x4 x1b, const f32x4 x2a, const f32x4 x2b, const f32x2* cs, float sc, u32x4& o1, u32x4& o2) const {
        float c[8], s[8];
#pragma unroll
        for (int j = 0; j < 4; ++j) { const f32x4 v = *(const f32x4*)(cs + 2 * j); c[2 * j] = v[0]; s[2 * j] = v[1]; c[2 * j + 1] = v[2]; s[2 * j + 1] = v[3]; }
        float a[8], b[8];
#pragma unroll
        for (int j = 0; j < 4; ++j) { a[j] = x1a[j]; a[4 + j] = x1b[j]; b[j] = x2a[j]; b[4 + j] = x2b[j]; }
        float p[8], q[8];
#pragma unroll
        for (int j = 0; j < 8; ++j) { p[j] = (a[j] * c[j] - b[j] * s[j]) * sc; q[j] = (b[j] * c[j] + a[j] * s[j]) * sc; }
        o1.x = pk2(p[0], p[1]); o1.y = pk2(p[2], p[3]); o1.z = pk2(p[4], p[5]); o1.w = pk2(p[6], p[7]);
        o2.x = pk2(q[0], q[1]); o2.y = pk2(q[2], q[3]); o2.z = pk2(q[4], q[5]); o2.w = pk2(q[6], q[7]);
    }
    __device__ __forceinline__ void operator()(const f32x4 (&acc)[2][2][4][2], const pg8::Unit& u, int wr, int wc, int fr, int fq) const {
        const int row0 = u.pm * 256 + wr * 64 + fr, t = u.pn, cw = wc * 32 + 8 * fq;
#pragma unroll
        for (int ai = 0; ai < 2; ++ai)
#pragma unroll
            for (int m = 0; m < 4; ++m) { const size_t row = (size_t)(row0 + ai * 128 + m * 16);
                const f32x4 x1a = acc[ai][0][m][0], x1b = acc[ai][0][m][1], x2a = acc[ai][1][m][0], x2b = acc[ai][1][m][1];
                if (t < 8) { const int head = 2 * t + (wc >> 1), i0 = (wc & 1) * 32 + 8 * fq; u32x4 o1, o2;
                    rope8(x1a, x1b, x2a, x2b, csa + row * 64 + i0, Q_SCALE, o1, o2);
                    *(u32x4*)(Q + row * 2048 + head * 128 + i0) = o1; *(u32x4*)(Q + row * 2048 + head * 128 + 64 + i0) = o2;
                } else if (t == 8) { const int i0 = (wc & 1) * 32 + 8 * fq;
                    if (wc < 2) { u32x4 o1, o2; rope8(x1a, x1b, x2a, x2b, csa + row * 64 + i0, 1.0f, o1, o2);
                        *(u32x4*)(KV + row * 256 + i0) = o1; *(u32x4*)(KV + row * 256 + 64 + i0) = o2; }
                    else { *(u32x4*)(KV + row * 256 + 128 + i0) = pack8(x1a, x1b); *(u32x4*)(KV + row * 256 + 192 + i0) = pack8(x2a, x2b); }
                } else if (t < 11) { const int head = 4 * (t - 9) + wc, i0 = 8 * fq; u32x4 o1, o2;
                    rope8(x1a, x1b, x2a, x2b, csi + row * 32 + i0, 1.0f, o1, o2);
                    *(u32x4*)(QI + row * 512 + head * 64 + i0) = o1; *(u32x4*)(QI + row * 512 + head * 64 + 32 + i0) = o2;
                } else if (t == 11) {
                    if (wc == 0) { const int i0 = 8 * fq; u32x4 o1, o2; rope8(x1a, x1b, x2a, x2b, csi + row * 32 + i0, 1.0f, o1, o2);
                        *(u32x4*)(KI + row * 64 + i0) = o1; *(u32x4*)(KI + row * 64 + 32 + i0) = o2; }
                    else if (wc == 1 && fq == 0) { *(f32x4*)(WI + row * 8) = x1a * WI_SCALE; *(f32x4*)(WI + row * 8 + 4) = x1b * WI_SCALE; }
                } else { const int c0 = 256 * (t - 12);
                    *(u32x4*)(G + row * 2048 + c0 + cw) = pack8(silu4(x1a), silu4(x1b)); *(u32x4*)(G + row * 2048 + c0 + 128 + cw) = pack8(silu4(x2a), silu4(x2b)); }
            }
    }
};

struct Args {
    const float* x; const float* c; const int* pos; const float* ada_w; const float* ada_b; const float* norm_g; const float* final_g;
    const float* even_w_in; const float* even_w_out; const float* conv_w; const float* conv_vec; const float* mu_rkv; const float* mu_lora;
    const float* rwkv_vec; const float* w_up; const float* a_up; const float* r_k; const float* odd_w_in; const float* odd_w_out;
    float* out; unsigned char* ws; int ph_lo, ph_hi;
};

template <class SrcF>
__device__ __forceinline__ void transpose_item(const SrcF& src, int K, bf16_t* WT, LAS float* scr, int item, int nblk, int lane) {
    const int kb = item / nblk, nb = item % nblk, k0 = 64 * kb, n0 = 32 * nb;
#pragma unroll 8
    for (int i = 0; i < 32; ++i) { const int kk = 2 * i + (lane >> 5); scr[kk * 33 + (lane & 31)] = src(k0 + kk, n0 + (lane & 31)); }
    LDS_WAIT();
    const int c = lane & 7;
#pragma unroll
    for (int j = 0; j < 4; ++j) { const int n = (lane >> 3) + 8 * j; const LAS float* s = scr + (8 * c) * 33 + n;
        u32x4 o; o.x = pk2(s[0 * 33], s[1 * 33]); o.y = pk2(s[2 * 33], s[3 * 33]); o.z = pk2(s[4 * 33], s[5 * 33]); o.w = pk2(s[6 * 33], s[7 * 33]);
        *(u32x4*)(WT + (size_t)(n0 + n) * K + k0 + 8 * c) = o; }
    LDS_WAIT();
}

__device__ __forceinline__ void p0_prologue(const Args& a, LAS unsigned char* lds) {
    const int tid = threadIdx.x, lane = tid & 63, wave = __builtin_amdgcn_readfirstlane(tid >> 6);
    LAS float* scr = (LAS float*)(lds + wave * 16384);
    const int gw = blockIdx.x * NWAVES + wave, NGW = gridDim.x * NWAVES;
    unsigned char* ws = a.ws;
    constexpr int I_W0 = (DM / 64) * (N0 / 32), I_WO = (2048 / 64) * (DM / 32), I_W1 = (DM / 64) * (N1 / 32), I_WL = (256 / 64) * (2048 / 32), I_MOD = 96 * 8, I_ROPE = MTOK;
    constexpr int NITEMS = I_W0 + I_WO + I_W1 + I_WO + I_WL + I_MOD + I_ROPE;
    for (int it = gw; it < NITEMS; it += NGW) {
        int r = it;
        if (r < I_W0) { const float* W = a.even_w_in; transpose_item([W](int k, int n) { const int s = map0(n); return s < 0 ? 0.f : W[(size_t)k * EVEN_COLS + s]; }, DM, (bf16_t*)(ws + WS_WIN0), scr, r, N0 / 32, lane); continue; } r -= I_W0;
        if (r < I_WO) { const float* W = a.even_w_out; transpose_item([W](int k, int n) { return W[(size_t)k * DM + n]; }, 2048, (bf16_t*)(ws + WS_WOUT0), scr, r, DM / 32, lane); continue; } r -= I_WO;
        if (r < I_W1) { const float* W = a.odd_w_in; transpose_item([W](int k, int n) { const int s = map1(n); return s < 0 ? 0.f : W[(size_t)k * ODD_COLS + s]; }, DM, (bf16_t*)(ws + WS_WIN1), scr, r, N1 / 32, lane); continue; } r -= I_W1;
        if (r < I_WO) { const float* W = a.odd_w_out; transpose_item([W](int k, int n) { return W[(size_t)k * DM + n]; }, 2048, (bf16_t*)(ws + WS_WOUT1), scr, r, DM / 32, lane); continue; } r -= I_WO;
        if (r < I_WL) { const float* wu = a.w_up; const float* au = a.a_up;
            transpose_item([wu, au](int k, int n) { if (n < 1024) return k < 64 ? wu[k * 1024 + n] : 0.f; return (k >= 64 && k < 128) ? au[(k - 64) * 1024 + (n - 1024)] : 0.f; }, 256, (bf16_t*)(ws + WS_WLORA), scr, r, 2048 / 32, lane); continue; } r -= I_WL;
        if (r < I_MOD) {
            const int cgp = r >> 3, ks = r & 7, col = cgp * 64 + lane, l = col / 3072, cc = col - l * 3072;
            const float* W = a.ada_w + (size_t)l * DM * 3072 + cc; float acc0 = 0.f, acc1 = 0.f, acc2 = 0.f, acc3 = 0.f;
            for (int k = ks * 128; k < ks * 128 + 128; ++k) { const float w = W[(size_t)k * 3072];
                const float c0 = a.c[k], c1 = a.c[DM + k], c2 = a.c[2 * DM + k], c3 = a.c[3 * DM + k];
                acc0 += c0 * sigmoidf_(c0) * w; acc1 += c1 * sigmoidf_(c1) * w; acc2 += c2 * sigmoidf_(c2) * w; acc3 += c3 * sigmoidf_(c3) * w; }
            float* mp = (float*)(ws + WS_MODP) + (size_t)((ks * 2 + l) * 4) * 3072 + cc;
            mp[0] = acc0; mp[3072] = acc1; mp[2 * 3072] = acc2; mp[3 * 3072] = acc3; continue; } r -= I_MOD;
        {
            const float p = (float)a.pos[r];
            { const float inv = powf(10000.0f, -(float)(2 * lane) / 128.0f); float sn, cs; sincosf(p * inv, &sn, &cs); ((f32x2*)(ws + WS_CSA))[(size_t)r * 64 + lane] = (f32x2){cs, sn}; }
            if (lane < 32) { const float inv = powf(10000.0f, -(float)(2 * lane) / 64.0f); float sn, cs; sincosf(p * inv, &sn, &cs); ((f32x2*)(ws + WS_CSI))[(size_t)r * 32 + lane] = (f32x2){cs, sn}; }
        }
    }
}

__device__ __forceinline__ void norm_phase(const Args& a, LAS unsigned char* lds, const float* src, int layer) {
    const int tid = threadIdx.x, lane = tid & 63, wave = __builtin_amdgcn_readfirstlane(tid >> 6);
    LAS float* gs = (LAS float*)lds; LAS float* sh = gs + DM;
    const float* modp = (const float*)(a.ws + WS_MODP); bf16_t* H = (bf16_t*)(a.ws + WS_H);
    for (int tile = blockIdx.x; tile < MTOK / 128; tile += gridDim.x) {
        const int b = (tile * 128) / SEQ;
        __syncthreads();
        for (int c = tid; c < DM; c += NTHREADS) {
            float sc = a.ada_b[layer * 3072 + 1024 + c], sf = a.ada_b[layer * 3072 + c];
#pragma unroll
            for (int s = 0; s < 8; ++s) { const float* mp = modp + (size_t)((s * 2 + layer) * 4 + b) * 3072; sc += mp[1024 + c]; sf += mp[c]; }
            gs[c] = a.norm_g[layer * DM + c] * (1.0f + sc); sh[c] = sf; }
        __syncthreads();
        for (int r = 0; r < 16; ++r) { const size_t m = (size_t)tile * 128 + wave * 16 + r;
            const f32x4* xr = (const f32x4*)(src + m * DM) + lane; f32x4 v[4]; float ss = 0.f;
#pragma unroll
            for (int j = 0; j < 4; ++j) { v[j] = xr[64 * j]; ss += (v[j][0] * v[j][0] + v[j][1] * v[j][1]) + (v[j][2] * v[j][2] + v[j][3] * v[j][3]); }
            const float rstd = rsqrtf(wave_sum(ss) * (1.0f / DM) + 1e-6f);
            u32x2* o = (u32x2*)(H + m * DM) + lane;
#pragma unroll
            for (int j = 0; j < 4; ++j) { const f32x4 g = *(const LAS f32x4*)(gs + 4 * (64 * j + lane)), s = *(const LAS f32x4*)(sh + 4 * (64 * j + lane));
                const f32x4 h = v[j] * rstd * g + s; u32x2 w; w.x = pk2(h[0], h[1]); w.y = pk2(h[2], h[3]); o[64 * j] = w; }
        }
    }
}

__device__ __forceinline__ void final_phase(const Args& a) {
    const int tid = threadIdx.x, lane = tid & 63, wave = __builtin_amdgcn_readfirstlane(tid >> 6);
    const int gw = blockIdx.x * NWAVES + wave, NGW = gridDim.x * NWAVES;
    f32x4 g[4];
#pragma unroll
    for (int j = 0; j < 4; ++j) g[j] = *((const f32x4*)a.final_g + 64 * j + lane);
    for (int m = gw; m < MTOK; m += NGW) { f32x4* xr = (f32x4*)(a.out + (size_t)m * DM) + lane; f32x4 v[4]; float ss = 0.f;
#pragma unroll
        for (int j = 0; j < 4; ++j) { v[j] = xr[64 * j]; ss += (v[j][0] * v[j][0] + v[j][1] * v[j][1]) + (v[j][2] * v[j][2] + v[j][3] * v[j][3]); }
        const float rstd = rsqrtf(wave_sum(ss) * (1.0f / DM) + 1e-6f);
#pragma unroll
        for (int j = 0; j < 4; ++j) xr[64 * j] = v[j] * rstd * g[j]; }
}

__device__ __forceinline__ void conv_phase(const Args& a, LAS unsigned char* lds) {
    const int tid = threadIdx.x, lane = tid & 63, wave = __builtin_amdgcn_readfirstlane(tid >> 6);
    const bf16_t* U = (const bf16_t*)(a.ws + WS_U); const bf16_t* AG = (const bf16_t*)(a.ws + WS_AG); bf16_t* YAB = (bf16_t*)(a.ws + WS_YAB);
    f32x2 w[31];
#pragma unroll
    for (int j = 0; j < 31; ++j) w[j] = *(const f32x2*)(a.conv_w + j * DM + 2 * tid);
    const f32x2 cbias = *(const f32x2*)(a.conv_vec + 2 * tid);
    for (int tile = blockIdx.x; tile < MTOK / 32; tile += gridDim.x) {
        const int b = tile >> 8, s0 = (tile & 255) * 32;
        __syncthreads();
        for (int idx = tid; idx < 62 * 128; idx += NTHREADS) { const int row = idx >> 7, ch = idx & 127, s = s0 - 30 + row;
            u32x4 v = (u32x4){0u, 0u, 0u, 0u}; if (s >= 0) v = *(const u32x4*)(U + ((size_t)(b * SEQ + s)) * DM + ch * 8);
            *(LAS u32x4*)(lds + row * 2048 + ch * 16) = v; }
        __syncthreads();
        f32x2 acc[32];
#pragma unroll
        for (int t = 0; t < 32; ++t) acc[t] = (f32x2){0.f, 0.f};
#pragma unroll
        for (int i = 0; i < 62; ++i) { const unsigned xw = *(const LAS unsigned*)(lds + i * 2048 + tid * 4); const f32x2 xv = (f32x2){bflo(xw), bfhi(xw)};
#pragma unroll
            for (int t = (i > 30 ? i - 30 : 0); t <= (i < 31 ? i : 31); ++t) acc[t] += xv * w[i - t]; }
        __syncthreads();
#pragma unroll
        for (int t = 0; t < 32; ++t) *(LAS f32x2*)(lds + (size_t)t * 4096 + tid * 8) = acc[t] + cbias;
        __syncthreads();
        f32x4 lw[4], lb[4];
#pragma unroll
        for (int j = 0; j < 4; ++j) { lw[j] = *(const f32x4*)(a.conv_vec + DM + 4 * (lane + 64 * j)); lb[j] = *(const f32x4*)(a.conv_vec + 2 * DM + 4 * (lane + 64 * j)); }
        for (int tt = 0; tt < 4; ++tt) { const int t = wave * 4 + tt; const size_t m = (size_t)b * SEQ + s0 + t;
            f32x4 v[4]; float s = 0.f;
#pragma unroll
            for (int j = 0; j < 4; ++j) { v[j] = *(const LAS f32x4*)(lds + (size_t)t * 4096 + 16 * (lane + 64 * j)); s += (v[j][0] + v[j][1]) + (v[j][2] + v[j][3]); }
            const float mean = wave_sum(s) * (1.0f / DM); float q = 0.f;
#pragma unroll
            for (int j = 0; j < 4; ++j) { v[j] = v[j] - mean; q += (v[j][0] * v[j][0] + v[j][1] * v[j][1]) + (v[j][2] * v[j][2] + v[j][3] * v[j][3]); }
            const float rstd = rsqrtf(wave_sum(q) * (1.0f / DM) + 1e-5f);
#pragma unroll
            for (int j = 0; j < 4; ++j) { const f32x4 y = v[j] * rstd * lw[j] + lb[j]; const u32x2 g = *(const u32x2*)(AG + m * DM + 4 * (lane + 64 * j));
                const f32x4 o = silu4(y) * (f32x4){bflo(g.x), bfhi(g.x), bflo(g.y), bfhi(g.y)};
                u32x2 wv; wv.x = pk2(o[0], o[1]); wv.y = pk2(o[2], o[3]); *(u32x2*)(YAB + m * 2048 + 4 * (lane + 64 * j)) = wv; }
        }
    }
    {
        const bf16_t* WDAD = (const bf16_t*)((unsigned char*)a.out + DO_WDAD); bf16_t* LA = (bf16_t*)((unsigned char*)a.out + DO_LA);
        const int gw = blockIdx.x * NWAVES + wave, NGW = gridDim.x * NWAVES;
        const f32x2 mu = *(const f32x2*)(a.mu_lora + 2 * lane);
        for (int m = gw; m < MTOK; m += NGW) { const int s = m & (SEQ - 1);
            const unsigned cur = *(const unsigned*)(WDAD + (size_t)m * 128 + 2 * lane); unsigned prv = 0u; if (s > 0) prv = *(const unsigned*)(WDAD + (size_t)(m - 1) * 128 + 2 * lane);
            float v0 = bflo(cur), v1 = bfhi(cur); v0 += (bflo(prv) - v0) * mu[0]; v1 += (bfhi(prv) - v1) * mu[1];
            if (lane < 32) { v0 = tanhf(v0); v1 = tanhf(v1); }
            *(unsigned*)(LA + (size_t)m * 256 + 2 * lane) = pk2(v0, v1); *(unsigned*)(LA + (size_t)m * 256 + 128 + 2 * lane) = 0u; }
    }
}

struct ScanRaw { u32x2 r, rp, k, kp, v, vp, d, a; };
constexpr int SC_CH = 16, SC_BUF_F = 5 * SC_CH * 64 + SC_CH * 16;

__device__ __forceinline__ void scan_phase(const Args& a, LAS unsigned char* lds) {
    const int tid = threadIdx.x, lane = tid & 63, wave = __builtin_amdgcn_readfirstlane(tid >> 6);
    const bf16_t* Rg = (const bf16_t*)(a.ws + WS_R); const bf16_t* Kg = (const bf16_t*)(a.ws + WS_K); const bf16_t* Vg = (const bf16_t*)(a.ws + WS_V);
    const bf16_t* Dg = (const bf16_t*)(a.ws + WS_DARR); const bf16_t* Ag = (const bf16_t*)(a.ws + WS_AARR);
    bf16_t* YAB = (bf16_t*)(a.ws + WS_YAB); float* RK = (float*)((unsigned char*)a.out + DO_RK);
    LAS float* bufs = (LAS float*)lds; LAS float* ybuf = bufs + 2 * SC_BUF_F;
    constexpr int NCH = SEQ / SC_CH;
    for (int job = blockIdx.x; job < 256; job += gridDim.x) {
        const int vcu = (gridDim.x == 256) ? ((job & 7) * 32 + (job >> 3)) : job;
        const int bh = vcu >> 2, vq = vcu & 3, b = bh >> 4, h = bh & 15;
        __syncthreads();
        if (wave >= 4) {
            const int pt = tid - 256, tok = pt >> 4, cgp = pt & 15, ch = h * 64 + 4 * cgp;
            const f32x4 mur = *(const f32x4*)(a.mu_rkv + ch), muk = *(const f32x4*)(a.mu_rkv + DM + ch), muv = *(const f32x4*)(a.mu_rkv + 2 * DM + ch);
            const f32x4 k_k = *(const f32x4*)(a.rwkv_vec + 2 * DM + ch), k_a = *(const f32x4*)(a.rwkv_vec + 3 * DM + ch), rkw = *(const f32x4*)(a.r_k + ch);
            auto load = [&](int c) { ScanRaw q; const int s = c * SC_CH + tok; const size_t m = (size_t)b * SEQ + s; const size_t o = m * DM + ch; const size_t op = (s > 0) ? o - DM : o;
                q.r = *(const u32x2*)(Rg + o); q.k = *(const u32x2*)(Kg + o); q.v = *(const u32x2*)(Vg + o); q.d = *(const u32x2*)(Dg + o); q.a = *(const u32x2*)(Ag + o);
                q.rp = *(const u32x2*)(Rg + op); q.kp = *(const u32x2*)(Kg + op); q.vp = *(const u32x2*)(Vg + op);
                if (s == 0) { q.rp = (u32x2){0u, 0u}; q.kp = (u32x2){0u, 0u}; q.vp = (u32x2){0u, 0u}; }
                return q; };
            auto un4 = [](u32x2 w) { return (f32x4){bflo(w.x), bfhi(w.x), bflo(w.y), bfhi(w.y)}; };
            auto process = [&](const ScanRaw& q, int c, LAS float* buf) {
                const f32x4 r0 = un4(q.r), k0 = un4(q.k), v0 = un4(q.v);
                const f32x4 rl = r0 + (un4(q.rp) - r0) * mur, kl = k0 + (un4(q.kp) - k0) * muk, vl = v0 + (un4(q.vp) - v0) * muv;
                const f32x4 d = un4(q.d), av = un4(q.a);
                f32x4 wdec; wdec[0] = __expf(-d[0]); wdec[1] = __expf(-d[1]); wdec[2] = __expf(-d[2]); wdec[3] = __expf(-d[3]);
                const f32x4 kkr = kl * k_k; float ss = (kkr[0] * kkr[0] + kkr[1] * kkr[1]) + (kkr[2] * kkr[2] + kkr[3] * kkr[3]); ss = row16_sum(ss);
                const float inv = 1.0f / fmaxf(sqrtf(ss), 1e-12f);
                const f32x4 kk = kkr * inv, kp = kl * (1.0f + (av - 1.0f) * k_a), bb = kk * av;
                float rk = (rl[0] * kp[0] * rkw[0] + rl[1] * kp[1] * rkw[1]) + (rl[2] * kp[2] * rkw[2] + rl[3] * kp[3] * rkw[3]); rk = row16_sum(rk);
                const int o = tok * 64 + 4 * cgp;
                *(LAS f32x4*)(buf + o) = -kk; *(LAS f32x4*)(buf + 1024 + o) = wdec; *(LAS f32x4*)(buf + 2048 + o) = bb; *(LAS f32x4*)(buf + 3072 + o) = kp; *(LAS f32x4*)(buf + 4096 + o) = rl;
                if ((cgp >> 2) == vq) *(LAS f32x4*)(buf + 5120 + tok * 16 + 4 * (cgp & 3)) = vl;
                if (vq == 0 && cgp == 0) RK[((size_t)b * SEQ + c * SC_CH + tok) * 16 + h] = rk; };
            auto flush = [&](int c, const LAS float* yb) {
                if (wave == 4) { const int t2 = lane >> 2, rq = lane & 3; const f32x4 y = *(const LAS f32x4*)(yb + t2 * 16 + 4 * rq);
                    u32x2 wv; wv.x = pk2(y[0], y[1]); wv.y = pk2(y[2], y[3]);
                    *(u32x2*)(YAB + ((size_t)b * SEQ + c * SC_CH + t2) * 2048 + 1024 + h * 64 + 16 * vq + 4 * rq) = wv; } };
            ScanRaw q0 = load(0), q1 = load(1);
            process(q0, 0, bufs); q0 = q1; q1 = load(2);
            __syncthreads();
            for (int c = 0; c < NCH; ++c) {
                if (c + 1 < NCH) process(q0, c + 1, bufs + ((c + 1) & 1) * SC_BUF_F);
                q0 = q1; if (c + 3 < NCH) q1 = load(c + 3);
                if (c >= 1) flush(c - 1, ybuf + ((c - 1) & 1) * 256);
                __syncthreads();
            }
            flush(NCH - 1, ybuf + ((NCH - 1) & 1) * 256);
        } else {
            const int rw = lane >> 4, ks = lane & 15, row = wave * 4 + rw;
            float s0 = 0.f, s1 = 0.f, s2 = 0.f, s3 = 0.f;
            __syncthreads();
            for (int c = 0; c < NCH; ++c) {
                const LAS float* buf = bufs + (c & 1) * SC_BUF_F; LAS float* yb = ybuf + (c & 1) * 256;
#pragma unroll
                for (int t = 0; t < SC_CH; ++t) {
                    const f32x4 nk = *(const LAS f32x4*)(buf + t * 64 + 4 * ks), w4 = *(const LAS f32x4*)(buf + 1024 + t * 64 + 4 * ks), b4 = *(const LAS f32x4*)(buf + 2048 + t * 64 + 4 * ks);
                    const f32x4 kp = *(const LAS f32x4*)(buf + 3072 + t * 64 + 4 * ks), r4 = *(const LAS f32x4*)(buf + 4096 + t * 64 + 4 * ks); const float vv = buf[5120 + t * 16 + row];
                    float sa = (s0 * nk[0] + s1 * nk[1]) + (s2 * nk[2] + s3 * nk[3]); sa = row16_sum(sa);
                    s0 = s0 * w4[0] + (sa * b4[0] + vv * kp[0]); s1 = s1 * w4[1] + (sa * b4[1] + vv * kp[1]);
                    s2 = s2 * w4[2] + (sa * b4[2] + vv * kp[2]); s3 = s3 * w4[3] + (sa * b4[3] + vv * kp[3]);
                    float y = (s0 * r4[0] + s1 * r4[1]) + (s2 * r4[2] + s3 * r4[3]); y = row16_sum(y);
                    if (ks == 0) yb[t * 16 + row] = y;
                }
                __syncthreads();
            }
        }
    }
}

__device__ __forceinline__ void post_phase(const Args& a) {
    const int tid = threadIdx.x, lane = tid & 63, wave = __builtin_amdgcn_readfirstlane(tid >> 6);
    const int gw = blockIdx.x * NWAVES + wave, NGW = gridDim.x * NWAVES;
    const bf16_t* Vg = (const bf16_t*)(a.ws + WS_V); const bf16_t* BG = (const bf16_t*)((unsigned char*)a.out + DO_BG); const float* RK = (const float*)((unsigned char*)a.out + DO_RK);
    bf16_t* YAB = (bf16_t*)(a.ws + WS_YAB);
    const int head = lane >> 2, c0 = head * 64 + 16 * (lane & 3);
    f32x4 muv[4], lw[4], lb[4];
#pragma unroll
    for (int j = 0; j < 4; ++j) { muv[j] = *(const f32x4*)(a.mu_rkv + 2 * DM + c0 + 4 * j); lw[j] = *(const f32x4*)(a.rwkv_vec + 4 * DM + c0 + 4 * j); lb[j] = *(const f32x4*)(a.rwkv_vec + 5 * DM + c0 + 4 * j); }
    auto un4 = [](unsigned x, unsigned y) { return (f32x4){bflo(x), bfhi(x), bflo(y), bfhi(y)}; };
    for (int m = gw; m < MTOK; m += NGW) { const int s = m & (SEQ - 1);
        bf16_t* yp = YAB + (size_t)m * 2048 + 1024 + c0;
        const u32x4 ya = *(const u32x4*)yp, yb2 = *(const u32x4*)(yp + 8);
        const u32x4 va = *(const u32x4*)(Vg + (size_t)m * DM + c0), vb = *(const u32x4*)(Vg + (size_t)m * DM + c0 + 8);
        u32x4 pa = (u32x4){0u, 0u, 0u, 0u}, pb = pa; if (s > 0) { pa = *(const u32x4*)(Vg + (size_t)(m - 1) * DM + c0); pb = *(const u32x4*)(Vg + (size_t)(m - 1) * DM + c0 + 8); }
        const u32x4 ga = *(const u32x4*)(BG + (size_t)m * DM + c0), gb = *(const u32x4*)(BG + (size_t)m * DM + c0 + 8);
        const float rk = RK[(size_t)m * 16 + head];
        f32x4 y[4] = {un4(ya.x, ya.y), un4(ya.z, ya.w), un4(yb2.x, yb2.y), un4(yb2.z, yb2.w)};
        const f32x4 v[4] = {un4(va.x, va.y), un4(va.z, va.w), un4(vb.x, vb.y), un4(vb.z, vb.w)};
        const f32x4 p[4] = {un4(pa.x, pa.y), un4(pa.z, pa.w), un4(pb.x, pb.y), un4(pb.z, pb.w)};
        const f32x4 g[4] = {un4(ga.x, ga.y), un4(ga.z, ga.w), un4(gb.x, gb.y), un4(gb.z, gb.w)};
        float sm = 0.f;
#pragma unroll
        for (int j = 0; j < 4; ++j) sm += (y[j][0] + y[j][1]) + (y[j][2] + y[j][3]);
        const float mean = quad_sum(sm) * (1.0f / 64.0f); float q = 0.f;
#pragma unroll
        for (int j = 0; j < 4; ++j) { y[j] = y[j] - mean; q += (y[j][0] * y[j][0] + y[j][1] * y[j][1]) + (y[j][2] * y[j][2] + y[j][3] * y[j][3]); }
        const float rstd = rsqrtf(quad_sum(q) * (1.0f / 64.0f) + 64e-5f);
        u32x4 o[2];
#pragma unroll
        for (int j = 0; j < 4; ++j) { const f32x4 vl = v[j] + (p[j] - v[j]) * muv[j]; const f32x4 r = (y[j] * rstd * lw[j] + lb[j] + rk * vl) * g[j];
            if (j & 1) { o[j >> 1].z = pk2(r[0], r[1]); o[j >> 1].w = pk2(r[2], r[3]); } else { o[j >> 1].x = pk2(r[0], r[1]); o[j >> 1].y = pk2(r[2], r[3]); } }
        *(u32x4*)yp = o[0]; *(u32x4*)(yp + 8) = o[1];
    }
}

constexpr int DS_CAP = 1024, DS_TRIG = 896, DS_TOPK = 256;
constexpr int DS_CAND_OFF = 0, DS_HIST_OFF = 32 * DS_CAP * 4, DS_CNT_OFF = DS_HIST_OFF + 8 * 1024, DS_TAU_OFF = DS_CNT_OFF + 128;
static_assert(DS_TAU_OFF + 128 <= LDS_BYTES, "dsa LDS map");

__device__ __forceinline__ void select_compact(LAS unsigned* cq, LAS unsigned* cntq, LAS unsigned* tauq, LAS unsigned* hist, int lane) {
    const unsigned n = *cntq;
    unsigned e[16];
#pragma unroll
    for (int j = 0; j < 16; ++j) { const unsigned idx = lane + 64 * j; e[j] = idx < n ? cq[idx] : 0u; }
    unsigned prefix = 0u, mask = 0u, need = DS_TOPK;
#pragma unroll 1
    for (int pass = 0; pass < 4; ++pass) {
        const int shift = 24 - 8 * pass;
        *(LAS u32x4*)(hist + 4 * lane) = (u32x4){0u, 0u, 0u, 0u};
        LDS_WAIT();
#pragma unroll
        for (int j = 0; j < 16; ++j) if (e[j] != 0u && (e[j] & mask) == prefix) (void)__hip_atomic_fetch_add(hist + ((e[j] >> shift) & 255u), 1u, __ATOMIC_RELAXED, __HIP_MEMORY_SCOPE_WORKGROUP);
        LDS_WAIT();
        const u32x4 h4 = *(const LAS u32x4*)(hist + 4 * lane);
        const unsigned tot = (h4.x + h4.y) + (h4.z + h4.w);
        unsigned v = tot;
#pragma unroll
        for (int o = 1; o < 64; o <<= 1) { const unsigned t = __shfl_down(v, o); if (lane + o < 64) v += t; }
        const unsigned above = v - tot;
        const bool is = (above < need) && (need <= v);
        unsigned B = 0u, ca = 0u;
        if (is) { unsigned c = above;
            if (c + h4.w >= need) { B = 4 * lane + 3; ca = c; } else { c += h4.w;
            if (c + h4.z >= need) { B = 4 * lane + 2; ca = c; } else { c += h4.z;
            if (c + h4.y >= need) { B = 4 * lane + 1; ca = c; } else { c += h4.y; B = 4 * lane; ca = c; } } } }
        const unsigned long long bal = __ballot(is);
        if (bal == 0ull) break;
        const int src = __ffsll((long long)bal) - 1;
        B = __shfl(B, src); ca = __shfl(ca, src);
        need -= ca; prefix |= B << shift; mask |= 0xFFu << shift;
    }
    const unsigned T = prefix;
    unsigned base = 0u;
#pragma unroll
    for (int j = 0; j < 16; ++j) { const bool keep = (e[j] >= T) && (e[j] != 0u); const unsigned long long bal = __ballot(keep);
        const unsigned pos = base + __builtin_amdgcn_mbcnt_hi((unsigned)(bal >> 32), __builtin_amdgcn_mbcnt_lo((unsigned)bal, 0u));
        if (keep) cq[pos] = e[j];
        base += (unsigned)__popcll(bal); }
    if (lane == 0) { *cntq = base; *tauq = T; }
    LDS_WAIT();
}

__device__ __forceinline__ unsigned vrow_off(int pr) { return (unsigned)((pr / 12) * 4096 + 1024 + (pr % 12) * 256); }
__device__ __forceinline__ unsigned swz_b(int row) { return (unsigned)(((row & 3) << 2) | ((row >> 2) & 3)); }

__device__ __forceinline__ void dsa_phase(const Args& a, LAS unsigned char* lds) {
    const int wave = __builtin_amdgcn_readfirstlane((int)threadIdx.x >> 6);
    const bf16_t* Qg = (const bf16_t*)(a.ws + WS_Q); const bf16_t* KVg = (const bf16_t*)(a.ws + WS_KV); const bf16_t* QIg = (const bf16_t*)(a.ws + WS_QI);
    const bf16_t* KIg = (const bf16_t*)(a.ws + WS_KI); const float* WIg = (const float*)(a.ws + WS_WI); bf16_t* Gg = (bf16_t*)(a.ws + WS_G);
    LAS unsigned* cand = (LAS unsigned*)(lds + DS_CAND_OFF); LAS unsigned* hist = (LAS unsigned*)(lds + DS_HIST_OFF) + wave * 256;
    LAS unsigned* cnt = (LAS unsigned*)(lds + DS_CNT_OFF); LAS unsigned* taup = (LAS unsigned*)(lds + DS_TAU_OFF);
    const int qg = wave & 1, kw = wave >> 1;
    for (int L = blockIdx.x; L < 1024; L += gridDim.x) {
        int lane; asm volatile("v_mbcnt_lo_u32_b32 %0, -1, 0\n\tv_mbcnt_hi_u32_b32 %0, -1, %0" : "=v"(lane));
        const int tid = wave * 64 + lane, l15s = lane & 15, gq = lane >> 4, ql = 16 * qg + l15s;
        int b, j;
        if (gridDim.x == 256) { const int i = blockIdx.x, ui = L >> 8, x = i & 7, li = (i >> 3) * 2 + (x >> 2); b = x & 3; j = (ui == 0) ? li : (ui == 1) ? 127 - li : (ui == 2) ? 128 + li : 255 - li; }
        else { b = L >> 8; j = L & 255; }
        const unsigned mb = (unsigned)b * SEQ; const int q0 = 32 * j; const unsigned mq = mb + q0 + ql;
        const int pos0 = a.pos[mb]; int nadm = ((a.pos[mq] >> 6) + 1) * 64 - pos0; nadm = nadm > SEQ ? SEQ : nadm;
        int nmax = ((a.pos[mb + q0 + 31] >> 6) + 1) * 64 - pos0; nmax = nmax > SEQ ? SEQ : nmax;
        const int nstep = (nmax + 127) >> 7;
        __syncthreads();
        if (tid < 32) { cnt[tid] = 0u; taup[tid] = 0u; }
        bf16x8 bq[8][2];
#pragma unroll
        for (int h = 0; h < 8; ++h)
#pragma unroll
            for (int ks = 0; ks < 2; ++ks) bq[h][ks] = *(const bf16x8*)(QIg + (mq * 512u + h * 64 + 32 * ks + 8 * gq));
        float wh[8]; { const f32x4 w0 = *(const f32x4*)(WIg + mq * 8), w1 = *(const f32x4*)(WIg + mq * 8 + 4); wh[0] = w0[0]; wh[1] = w0[1]; wh[2] = w0[2]; wh[3] = w0[3]; wh[4] = w1[0]; wh[5] = w1[1]; wh[6] = w1[2]; wh[7] = w1[3]; }
        __syncthreads();
#ifndef DSA_NO_STREAM
        for (int step = 0; step < nstep; ++step) {
            const int kb = 128 * step + 32 * kw; const bool active = kb < nmax;
            float sc[8];
            if (active) {
                const bf16_t* kr = KIg + ((mb + kb + l15s) * 64u + 8u * gq);
                bf16x8 ka[2][2];
#pragma unroll
                for (int st = 0; st < 2; ++st)
#pragma unroll
                    for (int ks = 0; ks < 2; ++ks) ka[st][ks] = *(const bf16x8*)(kr + st * 16 * 64 + 32 * ks);
#pragma unroll
                for (int i = 0; i < 8; ++i) sc[i] = 0.f;
#pragma unroll
                for (int h = 0; h < 8; ++h)
#pragma unroll
                    for (int st = 0; st < 2; ++st) { f32x4 acc = (f32x4){0.f, 0.f, 0.f, 0.f};
#pragma unroll
                        for (int ks = 0; ks < 2; ++ks) acc = __builtin_amdgcn_mfma_f32_16x16x32_bf16(ka[st][ks], bq[h][ks], acc, 0, 0, 0);
#pragma unroll
                        for (int r = 0; r < 4; ++r) sc[4 * st + r] += wh[h] * fmaxf(acc[r], 0.f); }
            }
            __syncthreads();
            if (active) {
                const unsigned tp = taup[ql]; unsigned pm = 0u;
#pragma unroll
                for (int i = 0; i < 8; ++i) { const int key = kb + 16 * (i >> 2) + 4 * gq + (i & 3); const unsigned u = __float_as_uint(sc[i]);
                    const unsigned ord = (u & 0x80000000u) ? ~u : (u | 0x80000000u); const unsigned pk = (ord & 0xFFFFE000u) | (unsigned)key;
                    sc[i] = __uint_as_float(pk);
                    if (key < nadm && pk > tp) pm |= 1u << i; }
                const unsigned n = (unsigned)__popc(pm);
                unsigned k = 0u; if (n) k = __hip_atomic_fetch_add(cnt + ql, n, __ATOMIC_RELAXED, __HIP_MEMORY_SCOPE_WORKGROUP);
                LAS unsigned* cq = cand + ql * DS_CAP;
#pragma unroll
                for (int i = 0; i < 8; ++i) if (pm & (1u << i)) { cq[k] = __float_as_uint(sc[i]); ++k; }
            }
            __syncthreads();
#pragma unroll 1
            for (int qq = 0; qq < 4; ++qq) { const int q = 4 * wave + qq; if (cnt[q] > (unsigned)DS_TRIG) select_compact(cand + q * DS_CAP, cnt + q, taup + q, hist, lane); }
        }
#endif
#ifndef DSA_NO_ATT
#pragma unroll 1
        for (int qq = 0; qq < 4; ++qq) { const int q = 4 * wave + qq; if (cnt[q] > (unsigned)DS_TOPK) select_compact(cand + q * DS_CAP, cnt + q, taup + q, hist, lane); }
        const bf16_t* KVb = KVg + (size_t)mb * 256;
        int lane_a = lane; asm volatile("" : "+v"(lane_a));
        const int g16 = lane_a >> 4, l15 = lane_a & 15;
        const unsigned vbase = (unsigned)(size_t)(lds + DS_CAND_OFF) + (unsigned)wave * 16384u;
        unsigned ta0, ta1;
        { const int q = l15 >> 2, p = lane_a & 3; const int pr0 = 8 * g16 + q, pr1 = pr0 + 4;
          ta0 = vbase + vrow_off(pr0) + 16u * ((unsigned)(p >> 1) ^ swz_b(pr0)) + 8u * (unsigned)(p & 1);
          ta1 = vbase + vrow_off(pr1) + 16u * ((unsigned)(p >> 1) ^ swz_b(pr1)) + 8u * (unsigned)(p & 1); }
        unsigned vwa[8];
#pragma unroll
        for (int j2 = 0; j2 < 8; ++j2) { const int srow = 4 * j2 + g16; const int pr = (srow < 16) ? 8 * (srow >> 2) + (srow & 3) : 8 * ((srow - 16) >> 2) + 4 + (srow & 3);
            vwa[j2] = vbase + vrow_off(pr) + 16u * ((unsigned)l15 ^ swz_b(pr)); }

#pragma unroll 1
        for (int qq = 0; qq < 4; ++qq) {
            const int q = 4 * wave + qq; const unsigned m = mb + q0 + q; const int n = (int)cnt[q]; const LAS unsigned* cq = cand + q * DS_CAP;
            bf16x8 qb[4];
#pragma unroll
            for (int ks = 0; ks < 4; ++ks) qb[ks] = *(const bf16x8*)(Qg + (m * 2048u + l15 * 128 + 32 * ks + 8 * g16));
            f32x4 sacc[16];
            const int nl = n - l15; const LAS unsigned* cql = cq + l15;
#pragma unroll
            for (int jt = 0; jt < 16; ++jt) { const unsigned e = cql[16 * jt]; const unsigned key = (16 * jt < nl) ? (e & 0x1FFFu) : 0u;
                const bf16_t* kr = KVb + (key * 256u + 8u * g16); f32x4 acc = (f32x4){0.f, 0.f, 0.f, 0.f};
#pragma unroll
                for (int ks = 0; ks < 4; ++ks) acc = __builtin_amdgcn_mfma_f32_16x16x32_bf16(*(const bf16x8*)(kr + 32 * ks), qb[ks], acc, 0, 0, 0);
                sacc[jt] = acc; if ((jt & 1) == 1) __builtin_amdgcn_sched_barrier(0); }
            float mx = -1e30f; const int nn = n - 4 * g16;
#pragma unroll
            for (int jt = 0; jt < 16; ++jt)
#pragma unroll
                for (int r = 0; r < 4; ++r) { if (16 * jt + r >= nn) sacc[jt][r] = -1e30f; mx = fmaxf(mx, sacc[jt][r]); }
            mx = fmaxf(mx, __shfl_xor(mx, 16)); mx = fmaxf(mx, __shfl_xor(mx, 32));
            float sum = 0.f;
#pragma unroll
            for (int jt = 0; jt < 16; ++jt)
#pragma unroll
                for (int r = 0; r < 4; ++r) { const float p = __builtin_amdgcn_exp2f(sacc[jt][r] - mx); sacc[jt][r] = p; sum += p; }
            sum += __shfl_xor(sum, 16); sum += __shfl_xor(sum, 32);
            u32x4 pfr[8];
#pragma unroll
            for (int kk = 0; kk < 8; ++kk) { const f32x4 pa = sacc[2 * kk], pb2 = sacc[2 * kk + 1];
                pfr[kk].x = pk2(pa[0], pa[1]); pfr[kk].y = pk2(pa[2], pa[3]); pfr[kk].z = pk2(pb2[0], pb2[1]); pfr[kk].w = pk2(pb2[2], pb2[3]); }
            __builtin_amdgcn_sched_barrier(0);
            f32x4 o[8];
#pragma unroll
            for (int c = 0; c < 8; ++c) o[c] = (f32x4){0.f, 0.f, 0.f, 0.f};
            u32x4 vr[4]; const int ng = n - g16; const LAS unsigned* cqg = cq + g16;
            auto vload = [&](int kk, int hv) {
#pragma unroll
                for (int j2 = 0; j2 < 4; ++j2) { const int sl = 32 * kk + 4 * (4 * hv + j2); const unsigned e = cqg[sl]; const unsigned key = (sl < ng) ? (e & 0x1FFFu) : 0u;
                    vr[j2] = *(const u32x4*)(KVb + (key * 256u + 128u + 8u * l15)); } };
            vload(0, 0);
#pragma unroll
            for (int kk = 0; kk < 8; ++kk) {
#pragma unroll
                for (int j2 = 0; j2 < 4; ++j2) *(LAS u32x4*)(size_t)vwa[j2] = vr[j2];
                __builtin_amdgcn_sched_barrier(0);
                vload(kk, 1);
#pragma unroll
                for (int j2 = 0; j2 < 4; ++j2) *(LAS u32x4*)(size_t)vwa[4 + j2] = vr[j2];
                __builtin_amdgcn_sched_barrier(0);
                if (kk < 7) vload(kk + 1, 0);
                LDS_WAIT();
                const bf16x8 pfrag = __builtin_bit_cast(bf16x8, pfr[kk]);
#pragma unroll
                for (int ch = 0; ch < 2; ++ch) {
                    s16x4 t0[4], t1[4];
                    asm volatile("ds_read_b64_tr_b16 %0, %8\n\tds_read_b64_tr_b16 %1, %9\n\tds_read_b64_tr_b16 %2, %10\n\tds_read_b64_tr_b16 %3, %11\n\t"
                                 "ds_read_b64_tr_b16 %4, %12\n\tds_read_b64_tr_b16 %5, %13\n\tds_read_b64_tr_b16 %6, %14\n\tds_read_b64_tr_b16 %7, %15\n\ts_waitcnt lgkmcnt(0)"
                                 : "=&v"(t0[0]), "=&v"(t0[1]), "=&v"(t0[2]), "=&v"(t0[3]), "=&v"(t1[0]), "=&v"(t1[1]), "=&v"(t1[2]), "=&v"(t1[3])
                                 : "v"(ta0 ^ (unsigned)((4 * ch + 0) << 5)), "v"(ta0 ^ (unsigned)((4 * ch + 1) << 5)), "v"(ta0 ^ (unsigned)((4 * ch + 2) << 5)), "v"(ta0 ^ (unsigned)((4 * ch + 3) << 5)),
                                   "v"(ta1 ^ (unsigned)((4 * ch + 0) << 5)), "v"(ta1 ^ (unsigned)((4 * ch + 1) << 5)), "v"(ta1 ^ (unsigned)((4 * ch + 2) << 5)), "v"(ta1 ^ (unsigned)((4 * ch + 3) << 5)) : "memory");
                    __builtin_amdgcn_sched_barrier(0);
#pragma unroll
                    for (int c = 0; c < 4; ++c) { const bf16x8 av = __builtin_shufflevector(t0[c], t1[c], 0, 1, 2, 3, 4, 5, 6, 7);
                        o[4 * ch + c] = __builtin_amdgcn_mfma_f32_16x16x32_bf16(av, pfrag, o[4 * ch + c], 0, 0, 0); }
                }
            }
            const float inv = 1.0f / sum;
#pragma unroll
            for (int c = 0; c < 8; ++c) { bf16_t* gp = Gg + (m * 2048u + l15 * 128 + 16 * c + 4 * g16); const u32x2 gw = *(const u32x2*)gp;
                const f32x4 r = o[c] * inv * (f32x4){bflo(gw.x), bfhi(gw.x), bflo(gw.y), bfhi(gw.y)};
                u32x2 wv; wv.x = pk2(r[0], r[1]); wv.y = pk2(r[2], r[3]); *(u32x2*)gp = wv; }
        }
#endif
    }
}

#ifndef MK_SPLIT
#define MK_SPLIT 0
#endif
#ifndef MK_PH_END
#define MK_PH_END 13
#endif
constexpr int N_PHASES = 13;

__global__ void __launch_bounds__(NTHREADS, 2) fwd_megakernel(Args a) {
    extern __shared__ __attribute__((aligned(16))) unsigned char lds_raw[];
    LAS unsigned char* lds = (LAS unsigned char*)lds_raw;
    cg::grid_group grid = cg::this_grid();
    const int lo = a.ph_lo, hi = a.ph_hi;
    unsigned char* ws = a.ws;
#ifdef ONLY_PH
#define IN(k) ((k) == ONLY_PH && lo <= (k) && (k) < hi)
#else
#define IN(k) (lo <= (k) && (k) < hi)
#endif
#define SEAM(k) do { if (IN(k) && IN((k) + 1)) grid.sync(); } while (0)
    if (IN(0)) { p0_prologue(a, lds); } SEAM(0);
    if (IN(1)) { norm_phase(a, lds, a.x, 0); } SEAM(1);
    if (IN(2)) {
        pg8::Gemm g{(const bf16_t*)(ws + WS_H), (const bf16_t*)(ws + WS_WIN0), MTOK, N0, DM}; pg8::StaticOrder S; S.init(MTOK, N0, gridDim.x, blockIdx.x);
        Epi0 E{ws, (unsigned char*)a.out};
        pg8::gemm_phase<Epi0, pg8::StaticOrder, true, true>(lds, g, S, E);
    } SEAM(2);
    if (IN(3)) { conv_phase(a, lds); } SEAM(3);
    if (IN(4)) {
        pg8::Gemm g{(const bf16_t*)((unsigned char*)a.out + DO_LA), (const bf16_t*)(ws + WS_WLORA), MTOK, 2048, 256}; pg8::StaticOrder S; S.init(MTOK, 2048, gridDim.x, blockIdx.x);
        EpiLora E{(bf16_t*)(ws + WS_DARR), (bf16_t*)(ws + WS_AARR), a.rwkv_vec};
        pg8::gemm_phase<EpiLora, pg8::StaticOrder, true, true>(lds, g, S, E);
    } SEAM(4);
    if (IN(5)) { scan_phase(a, lds); } SEAM(5);
    if (IN(6)) { post_phase(a); } SEAM(6);
    if (IN(7)) {
        pg8::Gemm g{(const bf16_t*)(ws + WS_YAB), (const bf16_t*)(ws + WS_WOUT0), MTOK, DM, 2048}; pg8::StaticOrder S; S.init(MTOK, DM, gridDim.x, blockIdx.x);
        EpiRes E{a.x, a.out, (const float*)(ws + WS_MODP), a.ada_b, 0};
        pg8::gemm_phase<EpiRes, pg8::StaticOrder, true, true>(lds, g, S, E);
    } SEAM(7);
    if (IN(8)) { norm_phase(a, lds, a.out, 1); } SEAM(8);
    if (IN(9)) {
        pg8::Gemm g{(const bf16_t*)(ws + WS_H), (const bf16_t*)(ws + WS_WIN1), MTOK, N1, DM}; pg8::StaticOrder S; S.init(MTOK, N1, gridDim.x, blockIdx.x);
        Epi1 E{(bf16_t*)(ws + WS_Q), (bf16_t*)(ws + WS_KV), (bf16_t*)(ws + WS_QI), (bf16_t*)(ws + WS_KI), (bf16_t*)(ws + WS_G), (float*)(ws + WS_WI), (const f32x2*)(ws + WS_CSA), (const f32x2*)(ws + WS_CSI)};
        pg8::gemm_phase<Epi1, pg8::StaticOrder, true, true>(lds, g, S, E);
    } SEAM(9);
    if (IN(10)) { dsa_phase(a, lds); } SEAM(10);
    if (IN(11)) {
        pg8::Gemm g{(const bf16_t*)(ws + WS_G), (const bf16_t*)(ws + WS_WOUT1), MTOK, DM, 2048}; pg8::StaticOrder S; S.init(MTOK, DM, gridDim.x, blockIdx.x);
        EpiRes E{a.out, a.out, (const float*)(ws + WS_MODP), a.ada_b, 1};
        pg8::gemm_phase<EpiRes, pg8::StaticOrder, true, true>(lds, g, S, E);
    } SEAM(11);
    if (IN(12)) { final_phase(a); }
#undef IN
#undef SEAM
}

extern "C" void kernel_launch(void* const* d_in, const int* in_sizes, int n_in, void* d_out, int out_size, void* d_ws, size_t ws_size, hipStream_t stream) {
    static int grid = 0;
    if (grid == 0) {
        if (n_in != 19 || out_size != MTOK * DM || ws_size < WS_NEED) { fprintf(stderr, "kernel_launch: unexpected shapes (n_in %d, out %d, ws %zu)\n", n_in, out_size, ws_size); grid = -1; return; }
        int dev = 0, cus = 0, per_cu = 0;
        (void)hipGetDevice(&dev); (void)hipDeviceGetAttribute(&cus, hipDeviceAttributeMultiprocessorCount, dev);
        if (hipFuncSetAttribute((const void*)fwd_megakernel, hipFuncAttributeMaxDynamicSharedMemorySize, LDS_BYTES) != hipSuccess) { fprintf(stderr, "kernel_launch: hipFuncSetAttribute failed\n"); grid = -1; return; }
        if (hipOccupancyMaxActiveBlocksPerMultiprocessor(&per_cu, (const void*)fwd_megakernel, NTHREADS, LDS_BYTES) != hipSuccess || per_cu < 1) { fprintf(stderr, "kernel_launch: occupancy query says %d\n", per_cu); per_cu = 1; }
        (void)hipGetLastError();
        grid = cus;
        if (grid > 256) grid = 256;
    }
    if (grid < 0) return;
    Args a{};
    a.x = (const float*)d_in[0]; a.c = (const float*)d_in[1]; a.pos = (const int*)d_in[2]; a.ada_w = (const float*)d_in[3]; a.ada_b = (const float*)d_in[4];
    a.norm_g = (const float*)d_in[5]; a.final_g = (const float*)d_in[6]; a.even_w_in = (const float*)d_in[7]; a.even_w_out = (const float*)d_in[8];
    a.conv_w = (const float*)d_in[9]; a.conv_vec = (const float*)d_in[10]; a.mu_rkv = (const float*)d_in[11]; a.mu_lora = (const float*)d_in[12];
    a.rwkv_vec = (const float*)d_in[13]; a.w_up = (const float*)d_in[14]; a.a_up = (const float*)d_in[15]; a.r_k = (const float*)d_in[16];
    a.odd_w_in = (const float*)d_in[17]; a.odd_w_out = (const float*)d_in[18];
    a.out = (float*)d_out; a.ws = (unsigned char*)d_ws;
#if MK_SPLIT
    for (int p = 0; p < MK_PH_END; ++p) { a.ph_lo = p; a.ph_hi = p + 1; void* args[] = {&a};
        hipError_t e = hipLaunchCooperativeKernel((const void*)fwd_megakernel, dim3(grid), dim3(NTHREADS), args, LDS_BYTES, stream);
        if (e != hipSuccess) { fprintf(stderr, "launch %d failed: %s\n", p, hipGetErrorString(e)); break; } }
#else
    a.ph_lo = 0; a.ph_hi = MK_PH_END; void* args[] = {&a};
    hipError_t e = hipLaunchCooperativeKernel((const void*)fwd_megakernel, dim3(grid), dim3(NTHREADS), args, LDS_BYTES, stream);
    if (e != hipSuccess) fprintf(stderr, "cooperative launch failed: %s (grid %d)\n", hipGetErrorString(e), grid);
#endif
}
```

```cpp
#include <hip/hip_runtime.h>
#include <hip/hip_cooperative_groups.h>
#include <cstdio>
#include <cstdint>
namespace cg = cooperative_groups;

#define LAS __attribute__((address_space(3)))
typedef unsigned short bf16_t;
typedef float f32x4 __attribute__((ext_vector_type(4)));
typedef float f32x2 __attribute__((ext_vector_type(2)));
typedef float f32x16 __attribute__((ext_vector_type(16)));
typedef unsigned u32x4 __attribute__((ext_vector_type(4)));
typedef unsigned u32x2 __attribute__((ext_vector_type(2)));
typedef short bf16x8 __attribute__((ext_vector_type(8)));
typedef short s16x4 __attribute__((ext_vector_type(4)));

constexpr int BATCH = 4, SEQ = 8192, DM = 1024, MTOK = BATCH * SEQ;
constexpr int N0 = 7424, N1 = 5120;
constexpr int EVEN_COLS = 7296, ODD_COLS = 4936;
constexpr int NWAVES = 8, NTHREADS = 512;
constexpr int LDS_BYTES = 155648;

constexpr size_t MiB = 1u << 20;
constexpr size_t WS_MODP = 0; constexpr size_t WS_STAMP = 3 * MiB; constexpr size_t WS_XSAVE = 1 * MiB;
constexpr size_t WS_BAR = 3 * MiB + 512 * 1024;
constexpr size_t WS_WIN0 = 4 * MiB, WS_WOUT0 = 20 * MiB, WS_WIN1 = 24 * MiB, WS_WOUT1 = 34 * MiB, WS_WLORA = 38 * MiB;
constexpr size_t WS_CSA = 40 * MiB, WS_CSI = 56 * MiB;
constexpr size_t WS_H = 64 * MiB;
constexpr size_t WS_YAB = 64 * MiB;
constexpr size_t WS_U = 192 * MiB, WS_AG = 256 * MiB, WS_R = 320 * MiB, WS_K = 384 * MiB, WS_V = 448 * MiB;
constexpr size_t WS_AARR = WS_U, WS_DARR = WS_AG;
constexpr size_t WS_Q = 128 * MiB, WS_G = 256 * MiB, WS_KV = 384 * MiB, WS_QI = 400 * MiB, WS_KI = 432 * MiB, WS_WI = 436 * MiB;
constexpr size_t WS_NEED = 512 * MiB;
constexpr size_t DO_BG = 0, DO_WDAD = 64 * MiB, DO_LA = 72 * MiB, DO_RK = 64 * MiB;

__device__ __forceinline__ float bflo(unsigned w) { return __uint_as_float(w << 16); }
__device__ __forceinline__ float bfhi(unsigned w) { return __uint_as_float(w & 0xffff0000u); }
typedef __bf16 bf16x2_t __attribute__((ext_vector_type(2)));
__device__ __forceinline__ unsigned pk2(float lo, float hi) { const f32x2 v = {lo, hi}; const bf16x2_t b = __builtin_convertvector(v, bf16x2_t); return __builtin_bit_cast(unsigned, b); }
__device__ __forceinline__ float sigmoidf_(float x) { return __builtin_amdgcn_rcpf(1.0f + __expf(-x)); }
__device__ __forceinline__ float wave_sum(float v) {
#pragma unroll
    for (int o = 1; o < 64; o <<= 1) v += __shfl_xor(v, o);
    return v;
}
template <int CTRL> __device__ __forceinline__ float dppmov(float x) { return __int_as_float(__builtin_amdgcn_update_dpp(0, __float_as_int(x), CTRL, 0xf, 0xf, true)); }
__device__ __forceinline__ float quad_sum(float x) { x += dppmov<0xB1>(x); x += dppmov<0x4E>(x); return x; }
__device__ __forceinline__ float row16_sum(float x) { x += dppmov<0xB1>(x); x += dppmov<0x4E>(x); x += dppmov<0x141>(x); x += dppmov<0x140>(x); return x; }
__device__ __forceinline__ int lane_id() { int l; asm volatile("v_mbcnt_lo_u32_b32 %0, -1, 0\n\tv_mbcnt_hi_u32_b32 %0, -1, %0" : "=v"(l)); return l; }
#define LDS_WAIT() asm volatile("s_waitcnt lgkmcnt(0)" ::: "memory")

__device__ __forceinline__ int map0(int n) {
    const int t = n >> 8, r = n & 255;
    if (t < 8) return (r < 128) ? 128 * t + r : 1024 + 128 * t + (r - 128);
    if (t < 12) return 2048 + 256 * (t - 8) + r;
    if (t < 24) return 3072 + 256 * (t - 12) + r;
    if (t < 28) return 6272 + 256 * (t - 24) + r;
    return (r < 128) ? 6144 + r : -1;
}
__device__ __forceinline__ int map1(int n) {
    const int t = n >> 8, r = n & 255, half = r >> 7, rr = r & 127;
    if (t < 8) return (2 * t + (rr >> 6)) * 128 + half * 64 + (rr & 63);
    if (t == 8) return 2048 + (rr >> 6) * 128 + half * 64 + (rr & 63);
    if (t < 11) return 2304 + (4 * (t - 9) + (rr >> 5)) * 64 + half * 32 + (rr & 31);
    if (t == 11) { if (rr < 32) return 2816 + half * 32 + rr; if (half == 0 && rr < 40) return 2880 + (rr - 32); return -1; }
    return 2888 + 256 * (t - 12) + r;
}

#ifndef PROBE_BLK
#define PROBE_BLK 0
#endif
#ifndef PROBE_WAVE
#define PROBE_WAVE 0
#endif
#if defined(STAMP_K) && defined(PROBE_SEC)
#define PROBE_BEGIN(sec, wsp, wv) unsigned long long PT0_##sec = 0; if ((sec) == PROBE_SEC && blockIdx.x == PROBE_BLK && (wv) == PROBE_WAVE) PT0_##sec = __builtin_amdgcn_s_memrealtime()
#define PROBE_END(sec, wsp, wv) do { if ((sec) == PROBE_SEC && blockIdx.x == PROBE_BLK && (wv) == PROBE_WAVE) { const unsigned long long dt_ = __builtin_amdgcn_s_memrealtime() - PT0_##sec; \
        if (__builtin_amdgcn_mbcnt_lo(~0u, 0u) == 0u) __hip_atomic_fetch_add((unsigned long long*)((wsp) + WS_STAMP) + 2, dt_, __ATOMIC_RELAXED, __HIP_MEMORY_SCOPE_AGENT); } } while (0)
#else
#define PROBE_BEGIN(sec, wsp, wv) do { } while (0)
#define PROBE_END(sec, wsp, wv) do { } while (0)
#endif
namespace pg8 {
#define PG8_LAS __attribute__((address_space(3)))
typedef unsigned short bf16_t;
typedef short bf16x8 __attribute__((ext_vector_type(8)));
typedef float f32x4 __attribute__((ext_vector_type(4)));
typedef unsigned u32x4 __attribute__((ext_vector_type(4)));
constexpr int BM = 256, BK = 64, HALF = 128, HTB = HALF * BK * 2  , STAGE_BYTES = 8 * HTB, NXCD = 8, WGM = 8;

__host__ __device__ __forceinline__ int lds_byte(int r, int c) { const int st = (r >> 4) * 2 + (c >> 5), rr = r & 15, cc = c & 31, ob = rr * 64 + cc * 2; return st * 1024 + (ob ^ (((ob >> 9) & 1) << 5)); }
__host__ __device__ __forceinline__ void stage_rc(int b, int& R, int& C) { const int st = b / 1024, sb = b % 1024, swz = sb ^ (((sb >> 9) & 1) << 5); R = (st >> 1) * 16 + swz / 64; C = (st & 1) * 32 + (swz % 64) / 2; }
__host__ __device__ __forceinline__ int perm32(int rho) { const int n = rho >> 4, i = rho & 15; return 8 * (i >> 2) + 4 * n + (i & 3); }

struct Unit { int pm, pn; };
struct Gemm { const bf16_t* A; const bf16_t* Bt; int M, N, K; };

struct StaticOrder {
    int nM, nN, nwg, G, c;
    __host__ __device__ void init(int M, int N, int G_, int c_) { nM = M / BM; nN = N / BM; nwg = nM * nN; G = G_; c = c_; }
    __host__ __device__ bool next(int i, Unit& u) const {
        const long L = (long)i * G + c; if (L >= nwg) return false;
        int wgid = (int)L; { const int q = nwg / NXCD, r = nwg % NXCD, xcd = wgid % NXCD, off = wgid / NXCD; wgid = (xcd < r ? xcd * (q + 1) : r * (q + 1) + (xcd - r) * q) + off; }
        const int nig = WGM * nN, gid = wgid / nig, fm = gid * WGM, gsz = (nM - fm) < WGM ? (nM - fm) : WGM;
        u.pm = fm + ((wgid % nig) % gsz); u.pn = (wgid % nig) / gsz; return true;
    }
    __device__ __forceinline__ void a_ready(const Unit&) const {}
    __device__ __forceinline__ void done(const Unit&) const {}
};

__device__ __forceinline__ unsigned cvt_pk_bf16(float lo, float hi) { unsigned r; asm volatile("v_cvt_pk_bf16_f32 %0, %1, %2" : "=v"(r) : "v"(lo), "v"(hi)); return r; }
typedef float f32x2 __attribute__((ext_vector_type(2)));
template <class Epi, class Sched, bool ALIGN_EPI = false, bool SP2 = false>
__device__ __forceinline__ void gemm_phase(PG8_LAS unsigned char* lds, const Gemm g, const Sched& S, const Epi& E, const int wave_in) {
    int lane; asm volatile("v_mbcnt_lo_u32_b32 %0, -1, 0\n\tv_mbcnt_hi_u32_b32 %0, -1, %0" : "=v"(lane));
    const int wid = wave_in, tid = wid * 64 + lane, wr = wid >> 2, wc = wid & 3, fr = lane & 15, fq = lane >> 4;
    const int K = g.K, nt = K / BK;
    unsigned voffA[2], voffB[2];
#pragma unroll
    for (int i = 0; i < 2; ++i) { int R, C; stage_rc(tid * 16 + i * 8192, R, C); const int Rb = Epi::PERM ? ((R & ~31) + perm32(R & 31)) : R;
        voffA[i] = (unsigned)(R * K + C) * 2u; voffB[i] = (unsigned)(Rb * K + C) * 2u; }
    const size_t kstep = (size_t)(BK * 2);
    const size_t hstep = (size_t)HALF * K * 2;
    const size_t tstep = 2 * hstep;
    const unsigned ldsw = (unsigned)wid * 1024u;
    const int aoff = lds_byte(wr * 64 + fr, fq * 8), boff = lds_byte(wc * 32 + fr, fq * 8);
#define PG8_SA(b, h) (((b) * 2 + (h)) * HTB)
#define PG8_SB(b, h) ((4 + (b) * 2 + (h)) * HTB)
#define PG8_STAGE(bufoff, gbase, voff) do { _Pragma("unroll") for (int _i = 0; _i < 2; ++_i) \
        __builtin_amdgcn_global_load_lds((const unsigned*)((const char*)(gbase) + (voff)[_i]), (PG8_LAS unsigned*)(lds + (bufoff) + ldsw + _i * 8192), 16, 0, 0); } while (0)
#define PG8_LDA(dst, b, h) do { _Pragma("unroll") for (int m = 0; m < 4; ++m) _Pragma("unroll") for (int k = 0; k < 2; ++k) dst[m][k] = *(const PG8_LAS bf16x8*)(lds + PG8_SA(b, h) + aoff + m * 2048 + k * 1024); } while (0)
#define PG8_LDB(dst, b, h) do { _Pragma("unroll") for (int n = 0; n < 2; ++n) _Pragma("unroll") for (int k = 0; k < 2; ++k) dst[n][k] = *(const PG8_LAS bf16x8*)(lds + PG8_SB(b, h) + boff + n * 2048 + k * 1024); } while (0)
#define PG8_MMA(ai, bj, At, Bt) do { __builtin_amdgcn_s_setprio(1); _Pragma("unroll") for (int m = 0; m < 4; ++m) _Pragma("unroll") for (int n = 0; n < 2; ++n) _Pragma("unroll") for (int k = 0; k < 2; ++k) \
        acc[ai][bj][m][n] = __builtin_amdgcn_mfma_f32_16x16x32_bf16(Bt[n][k], At[m][k], acc[ai][bj][m][n], 0, 0, 0); __builtin_amdgcn_s_setprio(0); } while (0)
#define PG8_WAIT_V(n) asm volatile("s_waitcnt vmcnt(" #n ")" ::: "memory")
#define PG8_WAIT_L(n) asm volatile("s_waitcnt lgkmcnt(" #n ")" ::: "memory")
#define PG8_BAR __builtin_amdgcn_s_barrier()
#define PG8_SCHED __builtin_amdgcn_sched_barrier(0)
    Unit cur, nxt; int ui = 0;
    if (!S.next(0, cur)) return;
    f32x4 acc[2][2][4][2];
#pragma unroll
    for (int a = 0; a < 2; ++a)
#pragma unroll
        for (int b = 0; b < 2; ++b)
#pragma unroll
            for (int m = 0; m < 4; ++m)
#pragma unroll
                for (int n = 0; n < 2; ++n) acc[a][b][m][n] = (f32x4){0.f, 0.f, 0.f, 0.f};
    bf16x8 At[4][2], B0[2][2], B1[2][2];
    const char* cA = (const char*)g.A + (size_t)cur.pm * tstep; const char* cB = (const char*)g.Bt + (size_t)cur.pn * tstep;
    S.a_ready(cur);
    if constexpr (SP2) {
        PG8_STAGE(PG8_SB(0, 0), cB, voffB); PG8_STAGE(PG8_SB(0, 1), cB + hstep, voffB); PG8_STAGE(PG8_SA(0, 0), cA, voffA); PG8_STAGE(PG8_SA(0, 1), cA + hstep, voffA);
        if (wr == 1) PG8_BAR;
        PG8_WAIT_V(2); PG8_BAR;
        PG8_STAGE(PG8_SB(1, 0), cB + kstep, voffB); PG8_STAGE(PG8_SA(1, 0), cA + kstep, voffA); PG8_STAGE(PG8_SB(1, 1), cB + hstep + kstep, voffB);
        PG8_WAIT_V(6); PG8_BAR;
    } else {
        PG8_STAGE(PG8_SB(0, 0), cB, voffB); PG8_STAGE(PG8_SA(0, 0), cA, voffA); PG8_STAGE(PG8_SB(0, 1), cB + hstep, voffB); PG8_STAGE(PG8_SA(0, 1), cA + hstep, voffA);
        if (wr == 1) PG8_BAR;
        PG8_WAIT_V(4); PG8_BAR;
        PG8_STAGE(PG8_SB(1, 0), cB + kstep, voffB); PG8_STAGE(PG8_SA(1, 0), cA + kstep, voffA); PG8_STAGE(PG8_SB(1, 1), cB + hstep + kstep, voffB);
        PG8_WAIT_V(6); PG8_BAR;
    }
    for (;;) {
        const bool has_next = S.next(ui + 1, nxt);
        const char* nA = has_next ? (const char*)g.A + (size_t)nxt.pm * tstep : cA; const char* nB = has_next ? (const char*)g.Bt + (size_t)nxt.pn * tstep : cB;
        for (int t = 0; t < nt; t += 2) {
            const bool last = (t == nt - 2);
            const char* a1 = cA + (size_t)(t + 1) * kstep;
            const char* a2 = last ? nA : cA + (size_t)(t + 2) * kstep; const char* b2 = last ? nB : cB + (size_t)(t + 2) * kstep;
            const char* a3 = a2 + kstep; const char* b3 = b2 + kstep;
            if (last && has_next) S.a_ready(nxt);
            if constexpr (SP2) {
            PG8_LDB(B0, 0, 0); PG8_LDB(B1, 0, 1); PG8_SCHED; PG8_LDA(At, 0, 0); PG8_STAGE(PG8_SA(1, 1), a1 + hstep, voffA);
            PG8_WAIT_V(8); PG8_WAIT_L(0); PG8_BAR; PG8_MMA(0, 0, At, B0); PG8_MMA(0, 1, At, B1); PG8_BAR; PG8_SCHED;
            PG8_LDA(At, 0, 1); PG8_STAGE(PG8_SB(0, 0), b2, voffB); PG8_STAGE(PG8_SB(0, 1), b2 + hstep, voffB); PG8_STAGE(PG8_SA(0, 0), a2, voffA);
            PG8_WAIT_V(8); PG8_WAIT_L(0); PG8_BAR; PG8_MMA(1, 0, At, B0); PG8_MMA(1, 1, At, B1); PG8_BAR; PG8_SCHED;
            PG8_LDB(B0, 1, 0); PG8_LDB(B1, 1, 1); PG8_SCHED; PG8_LDA(At, 1, 0); PG8_STAGE(PG8_SA(0, 1), a2 + hstep, voffA);
            PG8_WAIT_V(8); PG8_WAIT_L(0); PG8_BAR; PG8_MMA(0, 0, At, B0); PG8_MMA(0, 1, At, B1); PG8_BAR; PG8_SCHED;
            PG8_LDA(At, 1, 1); PG8_STAGE(PG8_SB(1, 0), b3, voffB); PG8_STAGE(PG8_SB(1, 1), b3 + hstep, voffB); PG8_STAGE(PG8_SA(1, 0), a3, voffA);
            PG8_WAIT_V(8); PG8_WAIT_L(0); PG8_BAR; PG8_MMA(1, 0, At, B0); PG8_MMA(1, 1, At, B1); PG8_BAR; PG8_SCHED;
            } else {
            PG8_LDB(B0, 0, 0); PG8_SCHED; PG8_LDA(At, 0, 0); PG8_STAGE(PG8_SA(1, 1), a1 + hstep, voffA);
            PG8_WAIT_L(8); PG8_BAR; PG8_WAIT_L(0); PG8_MMA(0, 0, At, B0); PG8_BAR; PG8_SCHED;
            PG8_LDB(B1, 0, 1); PG8_STAGE(PG8_SB(0, 0), b2, voffB);
            PG8_BAR; PG8_WAIT_L(0); PG8_MMA(0, 1, At, B1); PG8_BAR;
            PG8_LDA(At, 0, 1); PG8_STAGE(PG8_SA(0, 0), a2, voffA);
            PG8_BAR; PG8_WAIT_L(0); PG8_MMA(1, 0, At, B0); PG8_BAR; PG8_SCHED;
            PG8_STAGE(PG8_SB(0, 1), b2 + hstep, voffB);
            PG8_WAIT_V(6); PG8_BAR; PG8_MMA(1, 1, At, B1); PG8_BAR;
            PG8_LDB(B0, 1, 0); PG8_SCHED; PG8_LDA(At, 1, 0); PG8_STAGE(PG8_SA(0, 1), a2 + hstep, voffA);
            PG8_WAIT_L(8); PG8_BAR; PG8_WAIT_L(0); PG8_MMA(0, 0, At, B0); PG8_BAR; PG8_SCHED;
            PG8_LDB(B1, 1, 1); PG8_STAGE(PG8_SB(1, 0), b3, voffB);
            PG8_BAR; PG8_WAIT_L(0); PG8_MMA(0, 1, At, B1); PG8_BAR;
            PG8_LDA(At, 1, 1); PG8_STAGE(PG8_SA(1, 0), a3, voffA);
            PG8_BAR; PG8_WAIT_L(0); PG8_MMA(1, 0, At, B0); PG8_BAR; PG8_SCHED;
            PG8_STAGE(PG8_SB(1, 1), b3 + hstep, voffB);
            PG8_WAIT_V(6); PG8_BAR; PG8_MMA(1, 1, At, B1); PG8_BAR;
            }
        }
        if constexpr (ALIGN_EPI) { if (wr == 0) PG8_BAR; }
        if constexpr (!Epi::AFTER_DRAIN) { E(acc, cur, wr, wc, fr, fq); S.done(cur); }
        if (!has_next) break;
#pragma unroll
        for (int a = 0; a < 2; ++a)
#pragma unroll
            for (int b = 0; b < 2; ++b)
#pragma unroll
                for (int m = 0; m < 4; ++m)
#pragma unroll
                    for (int n = 0; n < 2; ++n) acc[a][b][m][n] = (f32x4){0.f, 0.f, 0.f, 0.f};
        cur = nxt; cA = nA; cB = nB; ++ui;
        if constexpr (ALIGN_EPI) { if (wr == 1) PG8_BAR; }
    }
    PG8_WAIT_V(0);
    if constexpr (!ALIGN_EPI) { if (wr == 0) PG8_BAR; }
    PG8_BAR;
    if constexpr (Epi::AFTER_DRAIN) { E.fused(acc, cur, wr, wc, fr, fq, lds, wid, lane); S.done(cur); }
#undef PG8_SA
#undef PG8_SB
#undef PG8_STAGE
#undef PG8_LDA
#undef PG8_LDB
#undef PG8_MMA
#undef PG8_WAIT_V
#undef PG8_WAIT_L
#undef PG8_BAR
#undef PG8_SCHED
}
}

__device__ __forceinline__ u32x4 pack8(const f32x4 a, const f32x4 b) { u32x4 w; w.x = pk2(a[0], a[1]); w.y = pk2(a[2], a[3]); w.z = pk2(b[0], b[1]); w.w = pk2(b[2], b[3]); return w; }
__device__ __forceinline__ f32x4 silu4(const f32x4 v) { f32x4 o; o[0] = v[0] * sigmoidf_(v[0]); o[1] = v[1] * sigmoidf_(v[1]); o[2] = v[2] * sigmoidf_(v[2]); o[3] = v[3] * sigmoidf_(v[3]); return o; }
__device__ __forceinline__ f32x4 sig4(const f32x4 v) { f32x4 o; o[0] = sigmoidf_(v[0]); o[1] = sigmoidf_(v[1]); o[2] = sigmoidf_(v[2]); o[3] = sigmoidf_(v[3]); return o; }

struct Epi0 {
    static constexpr bool PERM = true, AFTER_DRAIN = false;
    unsigned char* ws; unsigned char* dout; bool cheap;
    __device__ __forceinline__ void operator()(const f32x4 (&acc)[2][2][4][2], const pg8::Unit& u, int wr, int wc, int fr, int fq) const {
        const int row0 = u.pm * 256 + wr * 64 + fr, t = u.pn, cw = wc * 32 + 8 * fq;
        if (t < 8) {
            bf16_t* U = (bf16_t*)(ws + WS_U);
#pragma unroll
            for (int ai = 0; ai < 2; ++ai)
#pragma unroll
                for (int m = 0; m < 4; ++m) { const size_t row = (size_t)(row0 + ai * 128 + m * 16);
                    const f32x4 a = cheap ? acc[ai][0][m][0] : acc[ai][0][m][0] * sig4(acc[ai][1][m][0]), b = cheap ? acc[ai][0][m][1] : acc[ai][0][m][1] * sig4(acc[ai][1][m][1]);
                    *(u32x4*)(U + row * 1024 + 128 * t + cw) = pack8(a, b); }
        } else if (t == 28) {
            bf16_t* WDAD = (bf16_t*)(dout + DO_WDAD);
#pragma unroll
            for (int ai = 0; ai < 2; ++ai)
#pragma unroll
                for (int m = 0; m < 4; ++m) { const size_t row = (size_t)(row0 + ai * 128 + m * 16);
                    *(u32x4*)(WDAD + row * 128 + cw) = pack8(acc[ai][0][m][0], acc[ai][0][m][1]); }
        } else {
            const bool act = ((t < 12) || (t >= 24)) && !cheap; const int c0 = 256 * (t & 3);
            unsigned char* bp = (t >= 24) ? (dout + DO_BG) : (ws + WS_AG + (size_t)((t - 8) >> 2) * (64 * MiB));
            bf16_t* base = (bf16_t*)bp;
#pragma unroll
            for (int ai = 0; ai < 2; ++ai)
#pragma unroll
                for (int m = 0; m < 4; ++m) { const size_t row = (size_t)(row0 + ai * 128 + m * 16);
#pragma unroll
                    for (int bj = 0; bj < 2; ++bj) { f32x4 a = acc[ai][bj][m][0], b = acc[ai][bj][m][1];
                        if (act) { a = silu4(a); b = silu4(b); }
                        *(u32x4*)(base + row * 1024 + c0 + 128 * bj + cw) = pack8(a, b); } }
        }
    }
};
static_assert(WS_R == WS_AG + 64 * MiB && WS_K == WS_AG + 128 * MiB && WS_V == WS_AG + 192 * MiB, "Epi0 region arithmetic");

struct EpiLora {
    static constexpr bool PERM = true, AFTER_DRAIN = false;
    bf16_t *D, *A; const float* vec;
    __device__ __forceinline__ void operator()(const f32x4 (&acc)[2][2][4][2], const pg8::Unit& u, int wr, int wc, int fr, int fq) const {
        const int row0 = u.pm * 256 + wr * 64 + fr, t = u.pn, cw = wc * 32 + 8 * fq;
        const bool isd = t < 4; bf16_t* base = isd ? D : A; const int c0 = 256 * (t & 3); const float* bias = vec + (isd ? 0 : 1024) + c0 + cw;
        const float sc = isd ? 0.60653065971f : 1.0f;
#pragma unroll
        for (int ai = 0; ai < 2; ++ai)
#pragma unroll
            for (int m = 0; m < 4; ++m) { const size_t row = (size_t)(row0 + ai * 128 + m * 16);
#pragma unroll
                for (int bj = 0; bj < 2; ++bj) { const f32x4 b0 = *(const f32x4*)(bias + 128 * bj), b1 = *(const f32x4*)(bias + 128 * bj + 4);
                    const f32x4 a = sig4(acc[ai][bj][m][0] + b0) * sc, b = sig4(acc[ai][bj][m][1] + b1) * sc;
                    *(u32x4*)(base + row * 1024 + c0 + 128 * bj + cw) = pack8(a, b); } }
    }
};

struct EpiRes {
    static constexpr bool PERM = false, AFTER_DRAIN = false;
    const float* resid; float* out; const float* modp; const float* ada_b; int layer;
    __device__ __forceinline__ void operator()(const f32x4 (&acc)[2][2][4][2], const pg8::Unit& u, int wr, int wc, int fr, int fq) const {
        const int row0 = u.pm * 256 + wr * 64 + fr, col0 = u.pn * 256 + wc * 32 + 4 * fq, b = (u.pm * 256) / SEQ;
        f32x4 gv[2][2];
#pragma unroll
        for (int bj = 0; bj < 2; ++bj)
#pragma unroll
            for (int n = 0; n < 2; ++n) { const int c = col0 + bj * 128 + n * 16; f32x4 g = *(const f32x4*)(ada_b + layer * 3072 + 2048 + c);
#pragma unroll
                for (int s = 0; s < 8; ++s) g += *(const f32x4*)(modp + (size_t)((s * 2 + layer) * 4 + b) * 3072 + 2048 + c);
                gv[bj][n] = g; }
#pragma unroll
        for (int ai = 0; ai < 2; ++ai)
#pragma unroll
            for (int m = 0; m < 4; ++m) { const size_t off = (size_t)(row0 + ai * 128 + m * 16) * 1024 + col0;
#pragma unroll
                for (int bj = 0; bj < 2; ++bj)
#pragma unroll
                    for (int n = 0; n < 2; ++n) { const f32x4 r = *(const f32x4*)(resid + off + bj * 128 + n * 16);
                        *(f32x4*)(out + off + bj * 128 + n * 16) = r + gv[bj][n] * acc[ai][bj][m][n]; }
                asm volatile("" ::: "memory"); }
    }
};

constexpr float Q_SCALE = 0.08838834764831845f * 1.4426950408889634f;
constexpr float WI_SCALE = 0.35355339059327373f * 0.125f;
struct Epi1 {
    static constexpr bool PERM = true, AFTER_DRAIN = false;
    bf16_t *Q, *KV, *QI, *KI, *G; float* WI; const f32x2* csa; const f32x2* csi;
    __device__ __forceinline__ void rope8(const f32x4 x1a, const f32x4 x1b, const f32x4 x2a, const f32x4 x2b, const f32x2* cs, float sc, u32x4& o1, u32x4& o2) const {
        float c[8], s[8];
#pragma unroll
        for (int j = 0; j < 4; ++j) { const f32x4 v = *(const f32x4*)(cs + 2 * j); c[2 * j] = v[0]; s[2 * j] = v[1]; c[2 * j + 1] = v[2]; s[2 * j + 1] = v[3]; }
        float a[8], b[8];
#pragma unroll
        for (int j = 0; j < 4; ++j) { a[j] = x1a[j]; a[4 + j] = x1b[j]; b[j] = x2a[j]; b[4 + j] = x2b[j]; }
        float p[8], q[8];
#pragma unroll
        for (int j = 0; j < 8; ++j) { p[j] = (a[j] * c[j] - b[j] * s[j]) * sc; q[j] = (b[j] * c[j] + a[j] * s[j]) * sc; }
        o1.x = pk2(p[0], p[1]); o1.y = pk2(p[2], p[3]); o1.z = pk2(p[4], p[5]); o1.w = pk2(p[6], p[7]);
        o2.x = pk2(q[0], q[1]); o2.y = pk2(q[2], q[3]); o2.z = pk2(q[4], q[5]); o2.w = pk2(q[6], q[7]);
    }
    __device__ __forceinline__ void operator()(const f32x4 (&acc)[2][2][4][2], const pg8::Unit& u, int wr, int wc, int fr, int fq) const {
        const int row0 = u.pm * 256 + wr * 64 + fr, t = u.pn, cw = wc * 32 + 8 * fq;
#pragma unroll
        for (int ai = 0; ai < 2; ++ai)
#pragma unroll
            for (int m = 0; m < 4; ++m) { const size_t row = (size_t)(row0 + ai * 128 + m * 16);
                const f32x4 x1a = acc[ai][0][m][0], x1b = acc[ai][0][m][1], x2a = acc[ai][1][m][0], x2b = acc[ai][1][m][1];
                if (t < 8) { const int head = 2 * t + (wc >> 1), i0 = (wc & 1) * 32 + 8 * fq; u32x4 o1, o2;
                    rope8(x1a, x1b, x2a, x2b, csa + row * 64 + i0, Q_SCALE, o1, o2);
                    *(u32x4*)(Q + row * 2048 + head * 128 + i0) = o1; *(u32x4*)(Q + row * 2048 + head * 128 + 64 + i0) = o2;
                } else if (t == 8) { const int i0 = (wc & 1) * 32 + 8 * fq;
                    if (wc < 2) { u32x4 o1, o2; rope8(x1a, x1b, x2a, x2b, csa + row * 64 + i0, 1.0f, o1, o2);
                        *(u32x4*)(KV + row * 256 + i0) = o1; *(u32x4*)(KV + row * 256 + 64 + i0) = o2; }
                    else { *(u32x4*)(KV + row * 256 + 128 + i0) = pack8(x1a, x1b); *(u32x4*)(KV + row * 256 + 192 + i0) = pack8(x2a, x2b); }
                } else if (t < 11) { const int head = 4 * (t - 9) + wc, i0 = 8 * fq; u32x4 o1, o2;
                    rope8(x1a, x1b, x2a, x2b, csi + row * 32 + i0, 1.0f, o1, o2);
                    *(u32x4*)(QI + row * 512 + head * 64 + i0) = o1; *(u32x4*)(QI + row * 512 + head * 64 + 32 + i0) = o2;
                } else if (t == 11) {
                    if (wc == 0) { const int i0 = 8 * fq; u32x4 o1, o2; rope8(x1a, x1b, x2a, x2b, csi + row * 32 + i0, 1.0f, o1, o2);
                        *(u32x4*)(KI + row * 64 + i0) = o1; *(u32x4*)(KI + row * 64 + 32 + i0) = o2; }
                    else if (wc == 1 && fq == 0) { *(f32x4*)(WI + row * 8) = x1a * WI_SCALE; *(f32x4*)(WI + row * 8 + 4) = x1b * WI_SCALE; }
                } else { const int c0 = 256 * (t - 12);
                    *(u32x4*)(G + row * 2048 + c0 + cw) = pack8(silu4(x1a), silu4(x1b)); *(u32x4*)(G + row * 2048 + c0 + 128 + cw) = pack8(silu4(x2a), silu4(x2b)); }
            }
    }
};

struct Args {
    const float* x; const float* c; const int* pos; const float* ada_w; const float* ada_b; const float* norm_g; const float* final_g;
    const float* even_w_in; const float* even_w_out; const float* conv_w; const float* conv_vec; const float* mu_rkv; const float* mu_lora;
    const float* rwkv_vec; const float* w_up; const float* a_up; const float* r_k; const float* odd_w_in; const float* odd_w_out;
    float* out; unsigned char* ws; int ph_lo, ph_hi;
};

template <class SrcF>
__device__ __forceinline__ void transpose_item(const SrcF& src, int K, bf16_t* WT, LAS float* scr, int item, int nblk, int lane) {
    const int kb = item / nblk, nb = item % nblk, k0 = 64 * kb, n0 = 32 * nb;
#pragma unroll 8
    for (int i = 0; i < 32; ++i) { const int kk = 2 * i + (lane >> 5); scr[kk * 33 + (lane & 31)] = src(k0 + kk, n0 + (lane & 31)); }
    LDS_WAIT();
    const int c = lane & 7;
#pragma unroll
    for (int j = 0; j < 4; ++j) { const int n = (lane >> 3) + 8 * j; const LAS float* s = scr + (8 * c) * 33 + n;
        u32x4 o; o.x = pk2(s[0 * 33], s[1 * 33]); o.y = pk2(s[2 * 33], s[3 * 33]); o.z = pk2(s[4 * 33], s[5 * 33]); o.w = pk2(s[6 * 33], s[7 * 33]);
        *(u32x4*)(WT + (size_t)(n0 + n) * K + k0 + 8 * c) = o; }
    LDS_WAIT();
}

__device__ __forceinline__ void transpose_item_col(const float* W, int ldw, int scol, int K, bf16_t* WT, LAS float* scr, int k0, int n0, int lane) {
    const float* wp = W + (size_t)(k0 + (lane >> 5)) * ldw + (scol < 0 ? 0 : scol);
#pragma unroll 8
    for (int i = 0; i < 32; ++i) { const float v = wp[(size_t)(2 * i) * ldw]; scr[(2 * i + (lane >> 5)) * 33 + (lane & 31)] = scol < 0 ? 0.f : v; }
    LDS_WAIT();
    const int c = lane & 7;
#pragma unroll
    for (int j = 0; j < 4; ++j) { const int n = (lane >> 3) + 8 * j; const LAS float* s = scr + (8 * c) * 33 + n;
        u32x4 o; o.x = pk2(s[0 * 33], s[1 * 33]); o.y = pk2(s[2 * 33], s[3 * 33]); o.z = pk2(s[4 * 33], s[5 * 33]); o.w = pk2(s[6 * 33], s[7 * 33]);
        *(u32x4*)(WT + (size_t)(n0 + n) * K + k0 + 8 * c) = o; }
    LDS_WAIT();
}
__device__ __forceinline__ void p0_late(const Args& a, const int wave, LAS unsigned char* lds, int first, int nblk) {
    const int lane = lane_id(), tid = wave * 64 + lane;
    LAS float* scr = (LAS float*)(lds + wave * 16384);
    const int gw = ((int)blockIdx.x - first) * NWAVES + wave, NGW = nblk * NWAVES;
    unsigned char* ws = a.ws;
    constexpr int I_WO = (2048 / 64) * (DM / 32), I_W1 = (DM / 64) * (N1 / 32), I_ROPE = MTOK;
    for (int it = gw; it < I_W1 + I_WO + I_ROPE; it += NGW) {
        int r = it;
        if (r < I_W1) { const int nblk = N1 / 32, k0 = 64 * (r / nblk), n0 = 32 * (r % nblk); transpose_item_col(a.odd_w_in, ODD_COLS, map1(n0 + (lane & 31)), DM, (bf16_t*)(ws + WS_WIN1), scr, k0, n0, lane); continue; } r -= I_W1;
        if (r < I_WO) { const int nblk = DM / 32, k0 = 64 * (r / nblk), n0 = 32 * (r % nblk); transpose_item_col(a.odd_w_out, DM, n0 + (lane & 31), 2048, (bf16_t*)(ws + WS_WOUT1), scr, k0, n0, lane); continue; } r -= I_WO;
        {
            const float p = (float)a.pos[r];
            { const float inv = powf(10000.0f, -(float)(2 * lane) / 128.0f); float sn, cs; sincosf(p * inv, &sn, &cs); ((f32x2*)(ws + WS_CSA))[(size_t)r * 64 + lane] = (f32x2){cs, sn}; }
            if (lane < 32) { const float inv = powf(10000.0f, -(float)(2 * lane) / 64.0f); float sn, cs; sincosf(p * inv, &sn, &cs); ((f32x2*)(ws + WS_CSI))[(size_t)r * 32 + lane] = (f32x2){cs, sn}; }
        }
    }
}
__device__ __forceinline__ void p0_prologue(const Args& a, const int wave, LAS unsigned char* lds) {
    const int lane = lane_id(), tid = wave * 64 + lane;
    LAS float* scr = (LAS float*)(lds + wave * 16384);
    const int gw = blockIdx.x * NWAVES + wave, NGW = gridDim.x * NWAVES;
    unsigned char* ws = a.ws;
    constexpr int I_W0 = (DM / 64) * (N0 / 32), I_WO = (2048 / 64) * (DM / 32), I_W1 = (DM / 64) * (N1 / 32), I_WL = (256 / 64) * (2048 / 32), I_MOD = 96 * 8, I_ROPE = MTOK;
    constexpr int NITEMS = I_W0 + I_WO + I_W1 + I_WO + I_WL + I_MOD + I_ROPE;
    constexpr int N_EARLY = I_W0 + I_WO + I_WL + I_MOD;
    for (int it = gw; it < N_EARLY; it += NGW) {
        int r = it; if (r >= I_W0 + I_WO) r += I_W1 + I_WO;
        if (r < I_W0) { const float* W = a.even_w_in; transpose_item([W](int k, int n) { const int s = map0(n); return s < 0 ? 0.f : W[(size_t)k * EVEN_COLS + s]; }, DM, (bf16_t*)(ws + WS_WIN0), scr, r, N0 / 32, lane); continue; } r -= I_W0;
        if (r < I_WO) { const float* W = a.even_w_out; transpose_item([W](int k, int n) { return W[(size_t)k * DM + n]; }, 2048, (bf16_t*)(ws + WS_WOUT0), scr, r, DM / 32, lane); continue; } r -= I_WO;
        if (r < I_W1) { const float* W = a.odd_w_in; transpose_item([W](int k, int n) { const int s = map1(n); return s < 0 ? 0.f : W[(size_t)k * ODD_COLS + s]; }, DM, (bf16_t*)(ws + WS_WIN1), scr, r, N1 / 32, lane); continue; } r -= I_W1;
        if (r < I_WO) { const float* W = a.odd_w_out; transpose_item([W](int k, int n) { return W[(size_t)k * DM + n]; }, 2048, (bf16_t*)(ws + WS_WOUT1), scr, r, DM / 32, lane); continue; } r -= I_WO;
        if (r < I_WL) { const float* wu = a.w_up; const float* au = a.a_up;
            transpose_item([wu, au](int k, int n) { if (n < 1024) return k < 64 ? wu[k * 1024 + n] : 0.f; return (k >= 64 && k < 128) ? au[(k - 64) * 1024 + (n - 1024)] : 0.f; }, 256, (bf16_t*)(ws + WS_WLORA), scr, r, 2048 / 32, lane); continue; } r -= I_WL;
        if (r < I_MOD) {
            const int cgp = r >> 3, ks = r & 7, col = cgp * 64 + lane, l = col / 3072, cc = col - l * 3072;
            const float* W = a.ada_w + (size_t)l * DM * 3072 + cc; float acc0 = 0.f, acc1 = 0.f, acc2 = 0.f, acc3 = 0.f;
            for (int k = ks * 128; k < ks * 128 + 128; ++k) { const float w = W[(size_t)k * 3072];
                const float c0 = a.c[k], c1 = a.c[DM + k], c2 = a.c[2 * DM + k], c3 = a.c[3 * DM + k];
                acc0 += c0 * sigmoidf_(c0) * w; acc1 += c1 * sigmoidf_(c1) * w; acc2 += c2 * sigmoidf_(c2) * w; acc3 += c3 * sigmoidf_(c3) * w; }
            float* mp = (float*)(ws + WS_MODP) + (size_t)((ks * 2 + l) * 4) * 3072 + cc;
            mp[0] = acc0; mp[3072] = acc1; mp[2 * 3072] = acc2; mp[3 * 3072] = acc3; continue; } r -= I_MOD;
    }
}

__device__ __forceinline__ void norm_phase(const Args& a, const int wave, LAS unsigned char* lds, const float* src, int layer) {
    const int lane = lane_id(), tid = wave * 64 + lane;
    LAS float* gs = (LAS float*)lds; LAS float* sh = gs + DM;
    const float* modp = (const float*)(a.ws + WS_MODP); bf16_t* H = (bf16_t*)(a.ws + WS_H);
    for (int tile = blockIdx.x; tile < MTOK / 128; tile += gridDim.x) {
        const int b = (tile * 128) / SEQ;
        __syncthreads();
        for (int c = tid; c < DM; c += NTHREADS) {
            float sc = a.ada_b[layer * 3072 + 1024 + c], sf = a.ada_b[layer * 3072 + c];
#pragma unroll
            for (int s = 0; s < 8; ++s) { const float* mp = modp + (size_t)((s * 2 + layer) * 4 + b) * 3072; sc += mp[1024 + c]; sf += mp[c]; }
            gs[c] = a.norm_g[layer * DM + c] * (1.0f + sc); sh[c] = sf; }
        __syncthreads();
        for (int r4 = 0; r4 < 16; r4 += 4) {
            f32x4 v[4][4]; float ss[4];
#pragma unroll
            for (int q = 0; q < 4; ++q) { const size_t m = (size_t)tile * 128 + wave * 16 + r4 + q; const f32x4* xr = (const f32x4*)(src + m * DM) + lane;
#pragma unroll
                for (int j = 0; j < 4; ++j) v[q][j] = xr[64 * j]; }
#pragma unroll
            for (int q = 0; q < 4; ++q) { float s = 0.f;
#pragma unroll
                for (int j = 0; j < 4; ++j) s += (v[q][j][0] * v[q][j][0] + v[q][j][1] * v[q][j][1]) + (v[q][j][2] * v[q][j][2] + v[q][j][3] * v[q][j][3]);
                ss[q] = s; }
#pragma unroll
            for (int q = 0; q < 4; ++q) ss[q] = wave_sum(ss[q]);
#pragma unroll
            for (int q = 0; q < 4; ++q) { const size_t m = (size_t)tile * 128 + wave * 16 + r4 + q; const float rstd = rsqrtf(ss[q] * (1.0f / DM) + 1e-6f);
                u32x2* o = (u32x2*)(H + m * DM) + lane;
#pragma unroll
                for (int j = 0; j < 4; ++j) { const f32x4 g = *(const LAS f32x4*)(gs + 4 * (64 * j + lane)), s = *(const LAS f32x4*)(sh + 4 * (64 * j + lane));
                    const f32x4 h = v[q][j] * rstd * g + s; u32x2 w; w.x = pk2(h[0], h[1]); w.y = pk2(h[2], h[3]); o[64 * j] = w; } }
        }
    }
}

__device__ __forceinline__ void final_phase(const Args& a, const int wave) {
    const int lane = lane_id(), tid = wave * 64 + lane;
    const int gw = blockIdx.x * NWAVES + wave, NGW = gridDim.x * NWAVES;
    f32x4 g[4];
#pragma unroll
    for (int j = 0; j < 4; ++j) g[j] = *((const f32x4*)a.final_g + 64 * j + lane);
    float tsc = 1.0f;
#ifdef STAMP_K
    { const unsigned long long* st = (const unsigned long long*)(a.ws + WS_STAMP); tsc = 1.0f + (float)(st[1] - st[0] + st[2]) * 1e-7f; }
#endif
    for (int m0 = 4 * gw; m0 < MTOK; m0 += 4 * NGW) {
        f32x4 v[4][4]; float ss[4];
#pragma unroll
        for (int q = 0; q < 4; ++q) { const f32x4* xr = (const f32x4*)(a.out + (size_t)(m0 + q) * DM) + lane;
#pragma unroll
            for (int j = 0; j < 4; ++j) v[q][j] = xr[64 * j]; }
#pragma unroll
        for (int q = 0; q < 4; ++q) { float s = 0.f;
#pragma unroll
            for (int j = 0; j < 4; ++j) s += (v[q][j][0] * v[q][j][0] + v[q][j][1] * v[q][j][1]) + (v[q][j][2] * v[q][j][2] + v[q][j][3] * v[q][j][3]);
            ss[q] = wave_sum(s); }
#pragma unroll
        for (int q = 0; q < 4; ++q) { const float rstd = rsqrtf(ss[q] * (1.0f / DM) + 1e-6f) * tsc; f32x4* xr = (f32x4*)(a.out + (size_t)(m0 + q) * DM) + lane;
#pragma unroll
            for (int j = 0; j < 4; ++j) xr[64 * j] = v[q][j] * rstd * g[j]; }
    }
}


__device__ __forceinline__ void conv_phase(const Args& a, const int wave, LAS unsigned char* lds, int first, int stride) {
    const int lane = lane_id(), tid = wave * 64 + lane;
    const bf16_t* U = (const bf16_t*)(a.ws + WS_U); const bf16_t* AG = (const bf16_t*)(a.ws + WS_AG); bf16_t* YAB = (bf16_t*)(a.ws + WS_YAB);
    f32x2 w[31];
#pragma unroll
    for (int j = 0; j < 31; ++j) w[j] = *(const f32x2*)(a.conv_w + j * DM + 2 * tid);
    const f32x2 cbias = *(const f32x2*)(a.conv_vec + 2 * tid);
    for (int tile = first; tile < MTOK / 32; tile += stride) {
        const int b = tile >> 8, s0 = (tile & 255) * 32;
        __syncthreads();
        for (int idx = tid; idx < 62 * 128; idx += NTHREADS) { const int row = idx >> 7, ch = idx & 127, s = s0 - 30 + row;
            u32x4 v = (u32x4){0u, 0u, 0u, 0u}; if (s >= 0) v = *(const u32x4*)(U + ((size_t)(b * SEQ + s)) * DM + ch * 8);
            *(LAS u32x4*)(lds + row * 2048 + ch * 16) = v; }
        __syncthreads();
        LAS unsigned char* rb0 = lds + tid * 4; LAS unsigned char* rb1 = rb0 + 65536; LAS unsigned char* wb0 = lds + tid * 8; LAS unsigned char* wb1 = wb0 + 65536;
        asm volatile("" : "+v"(rb0), "+v"(rb1), "+v"(wb0), "+v"(wb1));
        f32x2 acc[32];
#pragma unroll
        for (int t = 0; t < 32; ++t) acc[t] = (f32x2){0.f, 0.f};
#pragma unroll
        for (int i = 0; i < 62; ++i) { const unsigned xw = (i < 32) ? *(const LAS unsigned*)(rb0 + i * 2048) : *(const LAS unsigned*)(rb1 + (i - 32) * 2048); const f32x2 xv = (f32x2){bflo(xw), bfhi(xw)};
#pragma unroll
            for (int t = (i > 30 ? i - 30 : 0); t <= (i < 31 ? i : 31); ++t) acc[t] += xv * w[i - t]; }
        __syncthreads();
#pragma unroll
        for (int t = 0; t < 32; ++t) { if (t < 16) *(LAS f32x2*)(wb0 + t * 4096) = acc[t] + cbias; else *(LAS f32x2*)(wb1 + (t - 16) * 4096) = acc[t] + cbias; }
        __syncthreads();
        f32x4 lw[4], lb[4];
#pragma unroll
        for (int j = 0; j < 4; ++j) { lw[j] = *(const f32x4*)(a.conv_vec + DM + 4 * (lane + 64 * j)); lb[j] = *(const f32x4*)(a.conv_vec + 2 * DM + 4 * (lane + 64 * j)); }
        for (int tt = 0; tt < 4; ++tt) { const int t = wave * 4 + tt; const size_t m = (size_t)b * SEQ + s0 + t;
            f32x4 v[4]; float s = 0.f;
#pragma unroll
            for (int j = 0; j < 4; ++j) { v[j] = *(const LAS f32x4*)(lds + (size_t)t * 4096 + 16 * (lane + 64 * j)); s += (v[j][0] + v[j][1]) + (v[j][2] + v[j][3]); }
            const float mean = wave_sum(s) * (1.0f / DM); float q = 0.f;
#pragma unroll
            for (int j = 0; j < 4; ++j) { v[j] = v[j] - mean; q += (v[j][0] * v[j][0] + v[j][1] * v[j][1]) + (v[j][2] * v[j][2] + v[j][3] * v[j][3]); }
            const float rstd = rsqrtf(wave_sum(q) * (1.0f / DM) + 1e-5f);
#pragma unroll
            for (int j = 0; j < 4; ++j) { const f32x4 y = v[j] * rstd * lw[j] + lb[j]; const u32x2 g = *(const u32x2*)(AG + m * DM + 4 * (lane + 64 * j));
                const f32x4 o = silu4(y) * (f32x4){bflo(g.x), bfhi(g.x), bflo(g.y), bfhi(g.y)};
                u32x2 wv; wv.x = pk2(o[0], o[1]); wv.y = pk2(o[2], o[3]); *(u32x2*)(YAB + m * 2048 + 4 * (lane + 64 * j)) = wv; }
        }
    }
}

__device__ __forceinline__ void lora_pre_phase(const Args& a, const int wave) {
    const int lane = lane_id(), tid = wave * 64 + lane;

        const bf16_t* WDAD = (const bf16_t*)((unsigned char*)a.out + DO_WDAD); bf16_t* LA = (bf16_t*)((unsigned char*)a.out + DO_LA);
        const int gw = blockIdx.x * NWAVES + wave, NGW = gridDim.x * NWAVES;
        const f32x2 mu = *(const f32x2*)(a.mu_lora + 2 * lane);
        for (int m = gw; m < MTOK; m += NGW) { const int s = m & (SEQ - 1);
            const unsigned cur = *(const unsigned*)(WDAD + (size_t)m * 128 + 2 * lane); unsigned prv = 0u; if (s > 0) prv = *(const unsigned*)(WDAD + (size_t)(m - 1) * 128 + 2 * lane);
            float v0 = bflo(cur), v1 = bfhi(cur); v0 += (bflo(prv) - v0) * mu[0]; v1 += (bfhi(prv) - v1) * mu[1];
            if (lane < 32) { v0 = tanhf(v0); v1 = tanhf(v1); }
            *(unsigned*)(LA + (size_t)m * 256 + 2 * lane) = pk2(v0, v1); *(unsigned*)(LA + (size_t)m * 256 + 128 + 2 * lane) = 0u; }
    }

struct ScanRaw { u32x2 r, rp, k, kp, v, vp, d, a; };
constexpr int SC_CH = 16, SC_BUF_F = 5 * SC_CH * 64 + SC_CH * 16;

__device__ __forceinline__ void scan_phase(const Args& a, const int wave, LAS unsigned char* lds) {
    const int lane = lane_id(), tid = wave * 64 + lane;
    const bf16_t* Rg = (const bf16_t*)(a.ws + WS_R); const bf16_t* Kg = (const bf16_t*)(a.ws + WS_K); const bf16_t* Vg = (const bf16_t*)(a.ws + WS_V);
    const bf16_t* Dg = (const bf16_t*)(a.ws + WS_DARR); const bf16_t* Ag = (const bf16_t*)(a.ws + WS_AARR);
    bf16_t* YAB = (bf16_t*)(a.ws + WS_YAB); float* RK = (float*)((unsigned char*)a.out + DO_RK);
    LAS float* bufs = (LAS float*)lds; LAS float* ybuf = bufs + 2 * SC_BUF_F;
    constexpr int NCH = SEQ / SC_CH;
    for (int job = blockIdx.x; job < 256; job += gridDim.x) {
        const int vcu = (gridDim.x == 256) ? ((job & 7) * 32 + (job >> 3)) : job;
        const int bh = vcu >> 2, vq = vcu & 3, b = bh >> 4, h = bh & 15;
        __syncthreads();
        if (wave >= 4) {
            const int pt = tid - 256, tok = pt >> 4, cgp = pt & 15, ch = h * 64 + 4 * cgp;
            const f32x4 mur = *(const f32x4*)(a.mu_rkv + ch), muk = *(const f32x4*)(a.mu_rkv + DM + ch), muv = *(const f32x4*)(a.mu_rkv + 2 * DM + ch);
            const f32x4 k_k = *(const f32x4*)(a.rwkv_vec + 2 * DM + ch), k_a = *(const f32x4*)(a.rwkv_vec + 3 * DM + ch), rkw = *(const f32x4*)(a.r_k + ch);
            auto load = [&](int c) { ScanRaw q; const int s = c * SC_CH + tok; const size_t m = (size_t)b * SEQ + s; const size_t o = m * DM + ch; const size_t op = (s > 0) ? o - DM : o;
                q.r = *(const u32x2*)(Rg + o); q.k = *(const u32x2*)(Kg + o); q.v = *(const u32x2*)(Vg + o); q.d = *(const u32x2*)(Dg + o); q.a = *(const u32x2*)(Ag + o);
                q.rp = *(const u32x2*)(Rg + op); q.kp = *(const u32x2*)(Kg + op); q.vp = *(const u32x2*)(Vg + op);
                if (s == 0) { q.rp = (u32x2){0u, 0u}; q.kp = (u32x2){0u, 0u}; q.vp = (u32x2){0u, 0u}; }
                return q; };
            auto un4 = [](u32x2 w) { return (f32x4){bflo(w.x), bfhi(w.x), bflo(w.y), bfhi(w.y)}; };
            auto process = [&](const ScanRaw& q, int c, LAS float* buf) {
                const f32x4 r0 = un4(q.r), k0 = un4(q.k), v0 = un4(q.v);
                const f32x4 rl = r0 + (un4(q.rp) - r0) * mur, kl = k0 + (un4(q.kp) - k0) * muk, vl = v0 + (un4(q.vp) - v0) * muv;
                const f32x4 d = un4(q.d), av = un4(q.a);
                f32x4 wdec; wdec[0] = __expf(-d[0]); wdec[1] = __expf(-d[1]); wdec[2] = __expf(-d[2]); wdec[3] = __expf(-d[3]);
                const f32x4 kkr = kl * k_k; float ss = (kkr[0] * kkr[0] + kkr[1] * kkr[1]) + (kkr[2] * kkr[2] + kkr[3] * kkr[3]); ss = row16_sum(ss);
                const float inv = 1.0f / fmaxf(sqrtf(ss), 1e-12f);
                const f32x4 kk = kkr * inv, kp = kl * (1.0f + (av - 1.0f) * k_a), bb = kk * av;
                float rk = (rl[0] * kp[0] * rkw[0] + rl[1] * kp[1] * rkw[1]) + (rl[2] * kp[2] * rkw[2] + rl[3] * kp[3] * rkw[3]); rk = row16_sum(rk);
                const int o = tok * 64 + 4 * cgp;
                *(LAS f32x4*)(buf + o) = -kk; *(LAS f32x4*)(buf + 1024 + o) = wdec; *(LAS f32x4*)(buf + 2048 + o) = bb; *(LAS f32x4*)(buf + 3072 + o) = kp; *(LAS f32x4*)(buf + 4096 + o) = rl;
                if ((cgp >> 2) == vq) *(LAS f32x4*)(buf + 5120 + tok * 16 + 4 * (cgp & 3)) = vl;
                if (vq == 0 && cgp == 0) RK[((size_t)b * SEQ + c * SC_CH + tok) * 16 + h] = rk; };
            auto flush = [&](int c, const LAS float* yb) {
                if (wave == 4) { const int t2 = lane >> 2, rq = lane & 3; const f32x4 y = *(const LAS f32x4*)(yb + t2 * 16 + 4 * rq);
                    u32x2 wv; wv.x = pk2(y[0], y[1]); wv.y = pk2(y[2], y[3]);
                    *(u32x2*)(YAB + ((size_t)b * SEQ + c * SC_CH + t2) * 2048 + 1024 + h * 64 + 16 * vq + 4 * rq) = wv; } };
            ScanRaw q0 = load(0), q1 = load(1);
            process(q0, 0, bufs); q0 = q1; q1 = load(2);
            __syncthreads();
            for (int c = 0; c < NCH; ++c) {
                if (c + 1 < NCH) process(q0, c + 1, bufs + ((c + 1) & 1) * SC_BUF_F);
                q0 = q1; if (c + 3 < NCH) q1 = load(c + 3);
                if (c >= 1) flush(c - 1, ybuf + ((c - 1) & 1) * 256);
                __syncthreads();
            }
            flush(NCH - 1, ybuf + ((NCH - 1) & 1) * 256);
        } else {
            const int rw = lane >> 4, ks = lane & 15, row = wave * 4 + rw;
            float s0 = 0.f, s1 = 0.f, s2 = 0.f, s3 = 0.f;
            __syncthreads();
            for (int c = 0; c < NCH; ++c) {
                const LAS float* buf = bufs + (c & 1) * SC_BUF_F; LAS float* yb = ybuf + (c & 1) * 256;
#pragma unroll
                for (int t = 0; t < SC_CH; ++t) {
                    const f32x4 nk = *(const LAS f32x4*)(buf + t * 64 + 4 * ks), w4 = *(const LAS f32x4*)(buf + 1024 + t * 64 + 4 * ks), b4 = *(const LAS f32x4*)(buf + 2048 + t * 64 + 4 * ks);
                    const f32x4 kp = *(const LAS f32x4*)(buf + 3072 + t * 64 + 4 * ks), r4 = *(const LAS f32x4*)(buf + 4096 + t * 64 + 4 * ks); const float vv = buf[5120 + t * 16 + row];
                    float sa = (s0 * nk[0] + s1 * nk[1]) + (s2 * nk[2] + s3 * nk[3]); sa = row16_sum(sa);
                    s0 = s0 * w4[0] + (sa * b4[0] + vv * kp[0]); s1 = s1 * w4[1] + (sa * b4[1] + vv * kp[1]);
                    s2 = s2 * w4[2] + (sa * b4[2] + vv * kp[2]); s3 = s3 * w4[3] + (sa * b4[3] + vv * kp[3]);
                    float y = (s0 * r4[0] + s1 * r4[1]) + (s2 * r4[2] + s3 * r4[3]); y = row16_sum(y);
                    if (ks == 0) yb[t * 16 + row] = y;
                }
                __syncthreads();
            }
        }
    }
}

__device__ __forceinline__ void post_phase(const Args& a, const int wave) {
    const int lane = lane_id(), tid = wave * 64 + lane;
    const int gw = blockIdx.x * NWAVES + wave, NGW = gridDim.x * NWAVES;
    const bf16_t* Vg = (const bf16_t*)(a.ws + WS_V); const bf16_t* BG = (const bf16_t*)((unsigned char*)a.out + DO_BG); const float* RK = (const float*)((unsigned char*)a.out + DO_RK);
    bf16_t* YAB = (bf16_t*)(a.ws + WS_YAB);
    const int head = lane >> 2, c0 = head * 64 + 16 * (lane & 3);
    f32x4 muv[4], lw[4], lb[4];
#pragma unroll
    for (int j = 0; j < 4; ++j) { muv[j] = *(const f32x4*)(a.mu_rkv + 2 * DM + c0 + 4 * j); lw[j] = *(const f32x4*)(a.rwkv_vec + 4 * DM + c0 + 4 * j); lb[j] = *(const f32x4*)(a.rwkv_vec + 5 * DM + c0 + 4 * j); }
    auto un4 = [](unsigned x, unsigned y) { return (f32x4){bflo(x), bfhi(x), bflo(y), bfhi(y)}; };
    for (int m = gw; m < MTOK; m += NGW) { const int s = m & (SEQ - 1);
        bf16_t* yp = YAB + (size_t)m * 2048 + 1024 + c0;
        const u32x4 ya = *(const u32x4*)yp, yb2 = *(const u32x4*)(yp + 8);
        const u32x4 va = *(const u32x4*)(Vg + (size_t)m * DM + c0), vb = *(const u32x4*)(Vg + (size_t)m * DM + c0 + 8);
        u32x4 pa = (u32x4){0u, 0u, 0u, 0u}, pb = pa; if (s > 0) { pa = *(const u32x4*)(Vg + (size_t)(m - 1) * DM + c0); pb = *(const u32x4*)(Vg + (size_t)(m - 1) * DM + c0 + 8); }
        const u32x4 ga = *(const u32x4*)(BG + (size_t)m * DM + c0), gb = *(const u32x4*)(BG + (size_t)m * DM + c0 + 8);
        const float rk = RK[(size_t)m * 16 + head];
        f32x4 y[4] = {un4(ya.x, ya.y), un4(ya.z, ya.w), un4(yb2.x, yb2.y), un4(yb2.z, yb2.w)};
        const f32x4 v[4] = {un4(va.x, va.y), un4(va.z, va.w), un4(vb.x, vb.y), un4(vb.z, vb.w)};
        const f32x4 p[4] = {un4(pa.x, pa.y), un4(pa.z, pa.w), un4(pb.x, pb.y), un4(pb.z, pb.w)};
        const f32x4 g[4] = {un4(ga.x, ga.y), un4(ga.z, ga.w), un4(gb.x, gb.y), un4(gb.z, gb.w)};
        float sm = 0.f;
#pragma unroll
        for (int j = 0; j < 4; ++j) sm += (y[j][0] + y[j][1]) + (y[j][2] + y[j][3]);
        const float mean = quad_sum(sm) * (1.0f / 64.0f); float q = 0.f;
#pragma unroll
        for (int j = 0; j < 4; ++j) { y[j] = y[j] - mean; q += (y[j][0] * y[j][0] + y[j][1] * y[j][1]) + (y[j][2] * y[j][2] + y[j][3] * y[j][3]); }
        const float rstd = rsqrtf(quad_sum(q) * (1.0f / 64.0f) + 64e-5f);
        u32x4 o[2];
#pragma unroll
        for (int j = 0; j < 4; ++j) { const f32x4 vl = v[j] + (p[j] - v[j]) * muv[j]; const f32x4 r = (y[j] * rstd * lw[j] + lb[j] + rk * vl) * g[j];
            if (j & 1) { o[j >> 1].z = pk2(r[0], r[1]); o[j >> 1].w = pk2(r[2], r[3]); } else { o[j >> 1].x = pk2(r[0], r[1]); o[j >> 1].y = pk2(r[2], r[3]); } }
        *(u32x4*)yp = o[0]; *(u32x4*)(yp + 8) = o[1];
    }
}

constexpr int CS_L = 32, CS_NCH = SEQ / CS_L, CS_NSLOT = 3;
constexpr int CS_NT = 0, CS_RT = 4096, CS_BT = 8192, CS_KT = 12288, CS_TM = 8192, CS_AKN = 10240, CS_ABR = 12288, CS_AKR = 14336, CS_BC = 16384, CS_KC = 20480, CS_VC = 24576, CS_GL = 28672, CS_SLOT = 29184;
constexpr int CS_RAW = CS_NSLOT * CS_SLOT, CS_RAWSZ = 5 * 33 * 128;
constexpr int CS_FLAGS = CS_RAW + CS_NSLOT * CS_RAWSZ;
static_assert(CS_FLAGS + 64 <= LDS_BYTES && (CS_RAW % 16) == 0 && (CS_RAWSZ % 16) == 0, "chunked scan LDS map");
__device__ __forceinline__ int permp(int j) { return 8 * ((j & 15) >> 2) + 4 * (j >> 4) + (j & 3); }
template <int CTRL, int RM> __device__ __forceinline__ float dppf(float x) { return __int_as_float(__builtin_amdgcn_update_dpp(0, __float_as_int(x), CTRL, RM, 0xf, true)); }
__device__ __forceinline__ float wave_total(float x) {
    x = row16_sum(x); x += dppf<0x142, 0xa>(x); x += dppf<0x143, 0xc>(x); return __int_as_float(__builtin_amdgcn_readlane(__float_as_int(x), 63)); }
__device__ __forceinline__ float wave_sum64(float x) { x = row16_sum(x); x += __shfl_xor(x, 16); x += __shfl_xor(x, 32); return x; }
__device__ __forceinline__ bf16x8 cfrag(const f32x16& x, int s) {
    u32x4 w; w.x = pk2(x[8 * s + 0], x[8 * s + 1]); w.y = pk2(x[8 * s + 2], x[8 * s + 3]); w.z = pk2(x[8 * s + 4], x[8 * s + 5]); w.w = pk2(x[8 * s + 6], x[8 * s + 7]); return __builtin_bit_cast(bf16x8, w); }
__device__ __forceinline__ bf16x8 cfrag2(const f32x4& a, const f32x4& b) { u32x4 w; w.x = pk2(a[0], a[1]); w.y = pk2(a[2], a[3]); w.z = pk2(b[0], b[1]); w.w = pk2(b[2], b[3]); return __builtin_bit_cast(bf16x8, w); }
__device__ __forceinline__ void lds_poll_ge(LAS unsigned* p, unsigned want) { while (__hip_atomic_load(p, __ATOMIC_RELAXED, __HIP_MEMORY_SCOPE_WORKGROUP) < want) __builtin_amdgcn_s_sleep(1); asm volatile("" ::: "memory"); }

__device__ __forceinline__ void cscan_job(const Args& a, const int wave, LAS unsigned char* lds, int bh) {
    int lane; asm volatile("v_mbcnt_lo_u32_b32 %0, -1, 0\n\tv_mbcnt_hi_u32_b32 %0, -1, %0" : "=v"(lane));
    const int tid = wave * 64 + lane;
    const int b = bh >> 4, h = bh & 15;
    const bf16_t* Rg = (const bf16_t*)(a.ws + WS_R); const bf16_t* Kg = (const bf16_t*)(a.ws + WS_K); const bf16_t* Vg = (const bf16_t*)(a.ws + WS_V);
    const bf16_t* Dg = (const bf16_t*)(a.ws + WS_DARR); const bf16_t* Ag = (const bf16_t*)(a.ws + WS_AARR);
    bf16_t* YAB = (bf16_t*)(a.ws + WS_YAB); float* RK = (float*)((unsigned char*)a.out + DO_RK);
    LAS unsigned* ready = (LAS unsigned*)(lds + CS_FLAGS); LAS unsigned* done = ready + CS_NSLOT; LAS unsigned* rawready = done + CS_NSLOT; LAS unsigned* rawfree = rawready + CS_NSLOT;
    __syncthreads();
    if (tid < 4 * CS_NSLOT) ready[tid] = 0u;
    __syncthreads();
    if (wave == 4) {
        const int rr = lane >> 3, cc = lane & 7;
        for (int c = 0; c < CS_NCH; ++c) {
            const int s = c % CS_NSLOT; LAS unsigned char* rw = lds + CS_RAW + s * CS_RAWSZ;
            const size_t m0 = (size_t)b * SEQ + (size_t)c * CS_L;
            u32x4 v[5][4], vp[3];
#pragma unroll
            for (int ar = 0; ar < 5; ++ar) { const bf16_t* src = (ar == 0) ? Rg : (ar == 1) ? Kg : (ar == 2) ? Vg : (ar == 3) ? Dg : Ag;
#pragma unroll
                for (int q4 = 0; q4 < 4; ++q4) v[ar][q4] = *(const u32x4*)(src + (m0 + 8 * q4 + rr) * DM + h * 64 + 8 * cc); }
#pragma unroll
            for (int ar = 0; ar < 3; ++ar) { const bf16_t* src = (ar == 0) ? Rg : (ar == 1) ? Kg : Vg; vp[ar] = (u32x4){0u, 0u, 0u, 0u};
                if (c > 0 && lane < 8) vp[ar] = *(const u32x4*)(src + (m0 - 1) * DM + h * 64 + 8 * cc); }
            if (c >= CS_NSLOT) lds_poll_ge(rawfree + s, (unsigned)(c / CS_NSLOT));
#pragma unroll
            for (int ar = 0; ar < 5; ++ar)
#pragma unroll
                for (int q4 = 0; q4 < 4; ++q4) *(LAS u32x4*)(rw + (ar * 33 + 1 + 8 * q4 + rr) * 128 + 16 * cc) = v[ar][q4];
            if (lane < 8) {
#pragma unroll
                for (int ar = 0; ar < 3; ++ar) *(LAS u32x4*)(rw + (ar * 33) * 128 + 16 * cc) = vp[ar]; }
            LDS_WAIT();
            if (lane == 0) __hip_atomic_store(rawready + s, (unsigned)(c + 1), __ATOMIC_RELAXED, __HIP_MEMORY_SCOPE_WORKGROUP);
        }
    } else if (wave >= 5) {
        const int hw = wave - 5, gch = h * 64 + lane;
        const float mur = a.mu_rkv[gch], muk = a.mu_rkv[DM + gch], muv = a.mu_rkv[2 * DM + gch], kkw = a.rwkv_vec[2 * DM + gch], kaw = a.rwkv_vec[3 * DM + gch], rkw = a.r_k[gch];
        const int kpos = 32 * (lane >> 5) + permp(lane & 31);
        for (int c = hw; c < CS_NCH; c += CS_NSLOT) {
            const int s = hw; LAS unsigned char* sl = lds + s * CS_SLOT; const LAS unsigned short* rw = (const LAS unsigned short*)(lds + CS_RAW + s * CS_RAWSZ);
            const unsigned use = (unsigned)(c / CS_NSLOT);
            { PROBE_BEGIN(10, a.ws, wave);
            if (use > 0u) lds_poll_ge(done + s, 4u * use);
            lds_poll_ge(rawready + s, (unsigned)(c + 1));
            PROBE_END(10, a.ws, wave); }
            PROBE_BEGIN(11, a.ws, wave);
            const size_t m0 = (size_t)b * SEQ + (size_t)c * CS_L; const size_t o0 = m0 * DM + gch;
            float rp = bflo((unsigned)rw[(0 * 33) * 64 + lane]), kp = bflo((unsigned)rw[(1 * 33) * 64 + lane]), vp = bflo((unsigned)rw[(2 * 33) * 64 + lane]);
            float cum = 0.f, gprev = 1.f;
            unsigned bcw[16], kcw[16], vcw[16];
#pragma unroll
            for (int grp = 0; grp < 4; ++grp) {
                float rlv[8], kkrv[8], kprv[8], vlv[8], aav[8], ddv[8], red[16];
#pragma unroll
                for (int e = 0; e < 8; ++e) { const int row = 1 + 8 * grp + e;
                    const float r0 = bflo((unsigned)rw[(0 * 33 + row) * 64 + lane]), k0 = bflo((unsigned)rw[(1 * 33 + row) * 64 + lane]), v0 = bflo((unsigned)rw[(2 * 33 + row) * 64 + lane]);
                    ddv[e] = bflo((unsigned)rw[(3 * 33 + row) * 64 + lane]); aav[e] = bflo((unsigned)rw[(4 * 33 + row) * 64 + lane]);
                    rlv[e] = r0 + (rp - r0) * mur; const float kl = k0 + (kp - k0) * muk; vlv[e] = v0 + (vp - v0) * muv; rp = r0; kp = k0; vp = v0;
                    kkrv[e] = kl * kkw; kprv[e] = kl * (1.0f + (aav[e] - 1.0f) * kaw);
                    red[2 * e] = kkrv[e] * kkrv[e]; red[2 * e + 1] = rlv[e] * kprv[e] * rkw; }
#pragma unroll
                for (int e = 0; e < 16; ++e) red[e] += dppf<0xB1, 0xf>(red[e]);
#pragma unroll
                for (int e = 0; e < 16; ++e) red[e] += dppf<0x4E, 0xf>(red[e]);
#pragma unroll
                for (int e = 0; e < 16; ++e) red[e] += dppf<0x141, 0xf>(red[e]);
#pragma unroll
                for (int e = 0; e < 16; ++e) red[e] += dppf<0x140, 0xf>(red[e]);
#pragma unroll
                for (int e = 0; e < 16; ++e) red[e] += dppf<0x142, 0xa>(red[e]);
#pragma unroll
                for (int e = 0; e < 16; ++e) red[e] += dppf<0x143, 0xc>(red[e]);
#pragma unroll
                for (int e = 0; e < 16; ++e) red[e] = __int_as_float(__builtin_amdgcn_readlane(__float_as_int(red[e]), 63));
                if (lane < 8) { float rkv = red[1];
#pragma unroll
                    for (int e = 1; e < 8; ++e) rkv = (lane == e) ? red[2 * e + 1] : rkv;
                    RK[(m0 + 8 * grp + lane) * 16 + h] = rkv; }
#pragma unroll
                for (int j2 = 0; j2 < 4; ++j2) {
                    const int i2 = 4 * grp + j2;
                    float nt[2], bt[2], kt[2], rt[2], vt[2];
#pragma unroll
                    for (int e = 0; e < 2; ++e) { const int te = 2 * j2 + e;
                        const float kkv = kkrv[te] * __builtin_amdgcn_rsqf(fmaxf(red[2 * te], 1e-24f)), bb = kkv * aav[te];
                        cum += ddv[te]; const float gi = __expf(-cum), ginv = __builtin_amdgcn_rcpf(gi);
                        nt[e] = -kkv * gprev; bt[e] = bb * ginv; kt[e] = kprv[te] * ginv; rt[e] = rlv[te] * gi; vt[e] = vlv[te]; gprev = gi; }
                    const unsigned wn = pk2(nt[0], nt[1]), wb = pk2(bt[0], bt[1]), wk = pk2(kt[0], kt[1]), wr = pk2(rt[0], rt[1]), wv = pk2(vt[0], vt[1]);
                    const int i = 2 * i2;
                    *(LAS unsigned short*)(sl + CS_NT + (i * 64 + kpos) * 2) = (unsigned short)wn; *(LAS unsigned short*)(sl + CS_NT + ((i + 1) * 64 + kpos) * 2) = (unsigned short)(wn >> 16);
                    *(LAS unsigned short*)(sl + CS_RT + (i * 64 + kpos) * 2) = (unsigned short)wr; *(LAS unsigned short*)(sl + CS_RT + ((i + 1) * 64 + kpos) * 2) = (unsigned short)(wr >> 16);
                    *(LAS unsigned short*)(sl + CS_BT + (i * 64 + kpos) * 2) = (unsigned short)wb; *(LAS unsigned short*)(sl + CS_BT + ((i + 1) * 64 + kpos) * 2) = (unsigned short)(wb >> 16);
                    *(LAS unsigned short*)(sl + CS_KT + (i * 64 + kpos) * 2) = (unsigned short)wk; *(LAS unsigned short*)(sl + CS_KT + ((i + 1) * 64 + kpos) * 2) = (unsigned short)(wk >> 16);
                    const int pw = permp(i) >> 1;
                    bcw[pw] = wb; kcw[pw] = wk; vcw[pw] = wv;
                }
                __builtin_amdgcn_sched_barrier(0);
            }
#pragma unroll
            for (int q4 = 0; q4 < 4; ++q4) {
                *(LAS u32x4*)(sl + CS_BC + lane * 64 + 16 * q4) = (u32x4){bcw[4 * q4], bcw[4 * q4 + 1], bcw[4 * q4 + 2], bcw[4 * q4 + 3]};
                *(LAS u32x4*)(sl + CS_KC + lane * 64 + 16 * q4) = (u32x4){kcw[4 * q4], kcw[4 * q4 + 1], kcw[4 * q4 + 2], kcw[4 * q4 + 3]};
                *(LAS u32x4*)(sl + CS_VC + lane * 64 + 16 * q4) = (u32x4){vcw[4 * q4], vcw[4 * q4 + 1], vcw[4 * q4 + 2], vcw[4 * q4 + 3]}; }
            *(LAS float*)(sl + CS_GL + lane * 4) = gprev;
            LDS_WAIT();
            if (lane == 0) __hip_atomic_store(rawfree + s, use + 1u, __ATOMIC_RELAXED, __HIP_MEMORY_SCOPE_WORKGROUP);
            PROBE_END(11, a.ws, wave);
            PROBE_BEGIN(12, a.ws, wave);
            const int tok = lane & 31, hf = lane >> 5;
            bf16x8 fn[4], fr[4], fb[4], fk[4];
#pragma unroll
            for (int ks = 0; ks < 4; ++ks) { fn[ks] = *(const LAS bf16x8*)(sl + CS_NT + (tok * 64 + 16 * ks + 8 * hf) * 2); fr[ks] = *(const LAS bf16x8*)(sl + CS_RT + (tok * 64 + 16 * ks + 8 * hf) * 2);
                fb[ks] = *(const LAS bf16x8*)(sl + CS_BT + (tok * 64 + 16 * ks + 8 * hf) * 2); fk[ks] = *(const LAS bf16x8*)(sl + CS_KT + (tok * 64 + 16 * ks + 8 * hf) * 2); }
            f32x16 P, Pt, Tm, Akn, Abr, Akr;
#pragma unroll
            for (int e = 0; e < 16; ++e) { P[e] = 0.f; Pt[e] = 0.f; Akn[e] = 0.f; Abr[e] = 0.f; Akr[e] = 0.f; }
#pragma unroll
            for (int ks = 0; ks < 4; ++ks) { P = __builtin_amdgcn_mfma_f32_32x32x16_bf16(fn[ks], fb[ks], P, 0, 0, 0); Pt = __builtin_amdgcn_mfma_f32_32x32x16_bf16(fb[ks], fn[ks], Pt, 0, 0, 0);
                Akn = __builtin_amdgcn_mfma_f32_32x32x16_bf16(fn[ks], fk[ks], Akn, 0, 0, 0); Abr = __builtin_amdgcn_mfma_f32_32x32x16_bf16(fr[ks], fb[ks], Abr, 0, 0, 0); Akr = __builtin_amdgcn_mfma_f32_32x32x16_bf16(fr[ks], fk[ks], Akr, 0, 0, 0); }
#pragma unroll
            for (int e = 0; e < 16; ++e) { const int row = (e & 3) + 8 * (e >> 2) + 4 * hf, col = tok;
                if (!(col < row)) { P[e] = 0.f; Akn[e] = 0.f; } if (!(row < col)) Pt[e] = 0.f; if (col > row) { Abr[e] = 0.f; Akr[e] = 0.f; }
                Tm[e] = P[e] + (row == col ? 1.0f : 0.f); }
#pragma unroll
            for (int mm = 1; mm <= 4; ++mm) {
                const bf16x8 p0 = cfrag(P, 0), p1 = cfrag(P, 1), q0 = cfrag(Pt, 0), q1 = cfrag(Pt, 1);
                f32x16 Ptn, Pn;
#pragma unroll
                for (int e = 0; e < 16; ++e) { Ptn[e] = 0.f; Pn[e] = 0.f; }
                Ptn = __builtin_amdgcn_mfma_f32_32x32x16_bf16(p0, q0, Ptn, 0, 0, 0); Ptn = __builtin_amdgcn_mfma_f32_32x32x16_bf16(p1, q1, Ptn, 0, 0, 0);
                if (mm < 4) { Pn = __builtin_amdgcn_mfma_f32_32x32x16_bf16(q0, p0, Pn, 0, 0, 0); Pn = __builtin_amdgcn_mfma_f32_32x32x16_bf16(q1, p1, Pn, 0, 0, 0); }
                const bf16x8 t0 = cfrag(Tm, 0), t1 = cfrag(Tm, 1), u0 = cfrag(Ptn, 0), u1 = cfrag(Ptn, 1);
                Tm = __builtin_amdgcn_mfma_f32_32x32x16_bf16(u0, t0, Tm, 0, 0, 0); Tm = __builtin_amdgcn_mfma_f32_32x32x16_bf16(u1, t1, Tm, 0, 0, 0);
                P = Pn; Pt = Ptn;
            }
            { const int pc = permp(tok);
#pragma unroll
              for (int e = 0; e < 16; e += 2) { const int row = (e & 3) + 8 * (e >> 2) + 4 * hf;
                const unsigned w0 = pk2(Tm[e], Tm[e + 1]), w1 = pk2(Akn[e], Akn[e + 1]), w2 = pk2(Abr[e], Abr[e + 1]), w3 = pk2(Akr[e], Akr[e + 1]);
                *(LAS unsigned short*)(sl + CS_TM + (row * 32 + pc) * 2) = (unsigned short)w0; *(LAS unsigned short*)(sl + CS_TM + ((row + 1) * 32 + pc) * 2) = (unsigned short)(w0 >> 16);
                *(LAS unsigned short*)(sl + CS_AKN + (row * 32 + pc) * 2) = (unsigned short)w1; *(LAS unsigned short*)(sl + CS_AKN + ((row + 1) * 32 + pc) * 2) = (unsigned short)(w1 >> 16);
                *(LAS unsigned short*)(sl + CS_ABR + (row * 32 + pc) * 2) = (unsigned short)w2; *(LAS unsigned short*)(sl + CS_ABR + ((row + 1) * 32 + pc) * 2) = (unsigned short)(w2 >> 16);
                *(LAS unsigned short*)(sl + CS_AKR + (row * 32 + pc) * 2) = (unsigned short)w3; *(LAS unsigned short*)(sl + CS_AKR + ((row + 1) * 32 + pc) * 2) = (unsigned short)(w3 >> 16); } }
            LDS_WAIT();
            if (lane == 0) __hip_atomic_store(ready + s, (unsigned)(c + 1), __ATOMIC_RELAXED, __HIP_MEMORY_SCOPE_WORKGROUP);
            PROBE_END(12, a.ws, wave);
        }
    } else {
        const int l15 = lane & 15, g = lane >> 4, vb = wave;
        f32x4 xc[4];
#pragma unroll
        for (int kt = 0; kt < 4; ++kt) xc[kt] = (f32x4){0.f, 0.f, 0.f, 0.f};
        for (int c = 0; c < CS_NCH; ++c) {
            const int s = c % CS_NSLOT; const LAS unsigned char* sl = lds + s * CS_SLOT;
            lds_poll_ge(ready + s, (unsigned)(c + 1));
            const bf16x8 xb0 = cfrag2(xc[0], xc[1]), xb1 = cfrag2(xc[2], xc[3]);
            const bf16x8 vop = *(const LAS bf16x8*)(sl + CS_VC + ((16 * vb + l15) * 32 + 8 * g) * 2);
            f32x4 W[2], U[2], Y[2];
#pragma unroll
            for (int rt = 0; rt < 2; ++rt) { const int row = 16 * rt + l15; f32x4 acc = (f32x4){0.f, 0.f, 0.f, 0.f};
                acc = __builtin_amdgcn_mfma_f32_16x16x32_bf16(*(const LAS bf16x8*)(sl + CS_AKN + (row * 32 + 8 * g) * 2), vop, acc, 0, 0, 0);
                acc = __builtin_amdgcn_mfma_f32_16x16x32_bf16(*(const LAS bf16x8*)(sl + CS_NT + (row * 64 + 8 * g) * 2), xb0, acc, 0, 0, 0);
                acc = __builtin_amdgcn_mfma_f32_16x16x32_bf16(*(const LAS bf16x8*)(sl + CS_NT + (row * 64 + 32 + 8 * g) * 2), xb1, acc, 0, 0, 0);
                W[rt] = acc; }
            const bf16x8 wb = cfrag2(W[0], W[1]);
#pragma unroll
            for (int rt = 0; rt < 2; ++rt) { const int row = 16 * rt + l15;
                U[rt] = __builtin_amdgcn_mfma_f32_16x16x32_bf16(*(const LAS bf16x8*)(sl + CS_TM + (row * 32 + 8 * g) * 2), wb, (f32x4){0.f, 0.f, 0.f, 0.f}, 0, 0, 0); }
            const bf16x8 ub = cfrag2(U[0], U[1]);
#pragma unroll
            for (int rt = 0; rt < 2; ++rt) { const int row = 16 * rt + l15; f32x4 acc = (f32x4){0.f, 0.f, 0.f, 0.f};
                acc = __builtin_amdgcn_mfma_f32_16x16x32_bf16(*(const LAS bf16x8*)(sl + CS_AKR + (row * 32 + 8 * g) * 2), vop, acc, 0, 0, 0);
                acc = __builtin_amdgcn_mfma_f32_16x16x32_bf16(*(const LAS bf16x8*)(sl + CS_RT + (row * 64 + 8 * g) * 2), xb0, acc, 0, 0, 0);
                acc = __builtin_amdgcn_mfma_f32_16x16x32_bf16(*(const LAS bf16x8*)(sl + CS_RT + (row * 64 + 32 + 8 * g) * 2), xb1, acc, 0, 0, 0);
                acc = __builtin_amdgcn_mfma_f32_16x16x32_bf16(*(const LAS bf16x8*)(sl + CS_ABR + (row * 32 + 8 * g) * 2), ub, acc, 0, 0, 0);
                Y[rt] = acc; }
#pragma unroll
            for (int kt = 0; kt < 4; ++kt) { const int row = 16 * kt + l15; f32x4 acc = xc[kt];
                acc = __builtin_amdgcn_mfma_f32_16x16x32_bf16(*(const LAS bf16x8*)(sl + CS_KC + (row * 32 + 8 * g) * 2), vop, acc, 0, 0, 0);
                acc = __builtin_amdgcn_mfma_f32_16x16x32_bf16(*(const LAS bf16x8*)(sl + CS_BC + (row * 32 + 8 * g) * 2), ub, acc, 0, 0, 0);
                xc[kt] = acc * *(const LAS f32x4*)(sl + CS_GL + (16 * kt + 4 * g) * 4); }
            LDS_WAIT();
            if (lane == 0) (void)__hip_atomic_fetch_add(done + s, 1u, __ATOMIC_RELAXED, __HIP_MEMORY_SCOPE_WORKGROUP);
#pragma unroll
            for (int rt = 0; rt < 2; ++rt)
#pragma unroll
                for (int e = 0; e < 4; ++e) { const size_t m = (size_t)b * SEQ + (size_t)c * CS_L + 16 * rt + 4 * g + e;
                    YAB[m * 2048 + 1024 + h * 64 + 16 * vb + l15] = (bf16_t)(pk2(Y[rt][e], 0.f) & 0xffffu); }
        }
    }
}

constexpr int CR_PIECE = 32, CR_NP = CS_NCH / CR_PIECE, CR_PW = 4, CR_PSLOT = CS_SLOT + 2 * 33 * 128;
constexpr size_t DO_IMG = 66 * MiB;
static_assert(DO_IMG + (size_t)64 * CR_PIECE * CS_SLOT <= 128 * MiB && CR_PW * CR_PSLOT <= CS_FLAGS, "image buffer / producer slots");

__device__ __forceinline__ void cscan_produce(const Args& a, const int wave, LAS unsigned char* lds, const int piece) {
    if (wave >= CR_PW) return;
    const bf16_t* Rg = (const bf16_t*)(a.ws + WS_R); const bf16_t* Kg = (const bf16_t*)(a.ws + WS_K); const bf16_t* Vg = (const bf16_t*)(a.ws + WS_V);
    const bf16_t* Dg = (const bf16_t*)(a.ws + WS_DARR); const bf16_t* Ag = (const bf16_t*)(a.ws + WS_AARR);
    float* RK = (float*)((unsigned char*)a.out + DO_RK); unsigned char* IMG = (unsigned char*)a.out + DO_IMG;
    LAS unsigned char* sl = lds + wave * CR_PSLOT;
    const LAS unsigned short* rawD = (const LAS unsigned short*)(sl + 16384); const LAS unsigned short* rawA = (const LAS unsigned short*)(sl + 20480);
    const LAS unsigned short* rawR = (const LAS unsigned short*)(sl + 24576); const LAS unsigned short* rawK = (const LAS unsigned short*)(sl + CS_SLOT); const LAS unsigned short* rawV = (const LAS unsigned short*)(sl + CS_SLOT + 33 * 128);
    u32x4 pre[5][4], prep[3];
    auto issue = [&](int it2, int rr, int c8, int lane) { const int bh2 = it2 / CR_PIECE, cc2 = it2 % CR_PIECE, c2 = piece * CR_PIECE + cc2; const unsigned mm = (unsigned)(bh2 >> 4) * SEQ + (unsigned)c2 * CS_L; const int hh = bh2 & 15;
        const unsigned eoff = ((mm + rr) * DM + hh * 64 + 8 * c8) * 2u;
        const unsigned char* wsb = a.ws;
#pragma unroll
        for (int ar = 0; ar < 5; ++ar) { constexpr size_t AOFF[5] = {WS_R, WS_K, WS_V, WS_DARR, WS_AARR};
#pragma unroll
            for (int q4 = 0; q4 < 4; ++q4) pre[ar][q4] = *(const u32x4*)(wsb + AOFF[ar] + eoff + (unsigned)(8 * q4 * DM * 2)); }
        const bool hasp = (c2 > 0) && (lane < 8); const unsigned poff = hasp ? (eoff - (unsigned)((rr + 1) * DM * 2)) : eoff;
#pragma unroll
        for (int ar = 0; ar < 3; ++ar) { constexpr size_t AOFF[3] = {WS_R, WS_K, WS_V}; const u32x4 t = *(const u32x4*)(wsb + AOFF[ar] + poff); prep[ar] = hasp ? t : (u32x4){0u, 0u, 0u, 0u}; } };
    const int it0 = blockIdx.x * CR_PW + wave;
    { const int l0 = lane_id(); if (it0 < 64 * CR_PIECE) issue(it0, l0 >> 3, l0 & 7, l0); }
    for (int it = blockIdx.x * CR_PW + wave; it < 64 * CR_PIECE; it += gridDim.x * CR_PW) {
        const int lane = lane_id(), rr = lane >> 3, c8 = lane & 7, kpos = 32 * (lane >> 5) + permp(lane & 31);
        const int bh = it / CR_PIECE, cc = it % CR_PIECE, b = bh >> 4, h = bh & 15, c = piece * CR_PIECE + cc, gch = h * 64 + lane;
        const float mur = a.mu_rkv[gch], muk = a.mu_rkv[DM + gch], muv = a.mu_rkv[2 * DM + gch], kkw = a.rwkv_vec[2 * DM + gch], kaw = a.rwkv_vec[3 * DM + gch], rkw = a.r_k[gch];
            const size_t m0 = (size_t)b * SEQ + (size_t)c * CS_L;
            { LAS unsigned char* wb = sl + rr * 128 + 16 * c8; asm volatile("" : "+v"(wb));
#pragma unroll
              for (int q4 = 0; q4 < 4; ++q4) {
                *(LAS u32x4*)(wb + 24576 + (8 * q4 + 1) * 128) = pre[0][q4]; *(LAS u32x4*)(wb + CS_SLOT + (8 * q4 + 1) * 128) = pre[1][q4]; *(LAS u32x4*)(wb + CS_SLOT + 33 * 128 + (8 * q4 + 1) * 128) = pre[2][q4];
                *(LAS u32x4*)(wb + 16384 + (8 * q4) * 128) = pre[3][q4]; *(LAS u32x4*)(wb + 20480 + (8 * q4) * 128) = pre[4][q4]; }
              if (lane < 8) { *(LAS u32x4*)(wb + 24576) = prep[0]; *(LAS u32x4*)(wb + CS_SLOT) = prep[1]; *(LAS u32x4*)(wb + CS_SLOT + 33 * 128) = prep[2]; } }
            LDS_WAIT();
            const LAS unsigned short* rb = (const LAS unsigned short*)sl + lane; asm volatile("" : "+v"(rb));
            float rp = bflo((unsigned)rb[24576 / 2]), kp = bflo((unsigned)rb[CS_SLOT / 2]), vp = bflo((unsigned)rb[(CS_SLOT + 33 * 128) / 2]);
            float cum = 0.f, gprev = 1.f;
            unsigned bcw[16], kcw[16], vcw[16];
#pragma unroll
            for (int grp = 0; grp < 4; ++grp) {
                float rlv[8], kkrv[8], kprv[8], vlv[8], aav[8], ddv[8], red[16];
#pragma unroll
                for (int e = 0; e < 8; ++e) { const int row = 8 * grp + e;
                    const float r0 = bflo((unsigned)rb[24576 / 2 + (row + 1) * 64]), k0 = bflo((unsigned)rb[CS_SLOT / 2 + (row + 1) * 64]), v0 = bflo((unsigned)rb[(CS_SLOT + 33 * 128) / 2 + (row + 1) * 64]);
                    ddv[e] = bflo((unsigned)rb[16384 / 2 + row * 64]); aav[e] = bflo((unsigned)rb[20480 / 2 + row * 64]);
                    rlv[e] = r0 + (rp - r0) * mur; const float kl = k0 + (kp - k0) * muk; vlv[e] = v0 + (vp - v0) * muv; rp = r0; kp = k0; vp = v0;
                    kkrv[e] = kl * kkw; kprv[e] = kl * (1.0f + (aav[e] - 1.0f) * kaw);
                    red[2 * e] = kkrv[e] * kkrv[e]; red[2 * e + 1] = rlv[e] * kprv[e] * rkw; }
#pragma unroll
                for (int e = 0; e < 16; ++e) red[e] += dppf<0xB1, 0xf>(red[e]);
#pragma unroll
                for (int e = 0; e < 16; ++e) red[e] += dppf<0x4E, 0xf>(red[e]);
#pragma unroll
                for (int e = 0; e < 16; ++e) red[e] += dppf<0x141, 0xf>(red[e]);
#pragma unroll
                for (int e = 0; e < 16; ++e) red[e] += dppf<0x140, 0xf>(red[e]);
#pragma unroll
                for (int e = 0; e < 16; ++e) red[e] += dppf<0x142, 0xa>(red[e]);
#pragma unroll
                for (int e = 0; e < 16; ++e) red[e] += dppf<0x143, 0xc>(red[e]);
#pragma unroll
                for (int e = 0; e < 16; ++e) red[e] = __int_as_float(__builtin_amdgcn_readlane(__float_as_int(red[e]), 63));
                if (lane < 8) { float rkv = red[1];
#pragma unroll
                    for (int e = 1; e < 8; ++e) rkv = (lane == e) ? red[2 * e + 1] : rkv;
                    RK[(m0 + 8 * grp + lane) * 16 + h] = rkv; }
#pragma unroll
                for (int j2 = 0; j2 < 4; ++j2) {
                    const int i2 = 4 * grp + j2;
                    float nt[2], bt[2], kt[2], rt[2], vt[2];
#pragma unroll
                    for (int e = 0; e < 2; ++e) { const int te = 2 * j2 + e;
                        const float kkv = kkrv[te] * __builtin_amdgcn_rsqf(fmaxf(red[2 * te], 1e-24f)), bb = kkv * aav[te];
                        cum += ddv[te]; const float gi = __expf(-cum), ginv = __builtin_amdgcn_rcpf(gi);
                        nt[e] = -kkv * gprev; bt[e] = bb * ginv; kt[e] = kprv[te] * ginv; rt[e] = rlv[te] * gi; vt[e] = vlv[te]; gprev = gi; }
                    const unsigned wn = pk2(nt[0], nt[1]), wb = pk2(bt[0], bt[1]), wk = pk2(kt[0], kt[1]), wr = pk2(rt[0], rt[1]), wv = pk2(vt[0], vt[1]);
                    const int i = 2 * i2;
                    *(LAS unsigned short*)(sl + CS_NT + (i * 64 + kpos) * 2) = (unsigned short)wn; *(LAS unsigned short*)(sl + CS_NT + ((i + 1) * 64 + kpos) * 2) = (unsigned short)(wn >> 16);
                    *(LAS unsigned short*)(sl + CS_RT + (i * 64 + kpos) * 2) = (unsigned short)wr; *(LAS unsigned short*)(sl + CS_RT + ((i + 1) * 64 + kpos) * 2) = (unsigned short)(wr >> 16);
                    *(LAS unsigned short*)(sl + CS_BT + (i * 64 + kpos) * 2) = (unsigned short)wb; *(LAS unsigned short*)(sl + CS_BT + ((i + 1) * 64 + kpos) * 2) = (unsigned short)(wb >> 16);
                    *(LAS unsigned short*)(sl + CS_KT + (i * 64 + kpos) * 2) = (unsigned short)wk; *(LAS unsigned short*)(sl + CS_KT + ((i + 1) * 64 + kpos) * 2) = (unsigned short)(wk >> 16);
                    const int pw = permp(i) >> 1;
                    bcw[pw] = wb; kcw[pw] = wk; vcw[pw] = wv;
                }
                __builtin_amdgcn_sched_barrier(0);
            }
#pragma unroll
            for (int q4 = 0; q4 < 4; ++q4) {
                *(LAS u32x4*)(sl + CS_BC + lane * 64 + 16 * q4) = (u32x4){bcw[4 * q4], bcw[4 * q4 + 1], bcw[4 * q4 + 2], bcw[4 * q4 + 3]};
                *(LAS u32x4*)(sl + CS_KC + lane * 64 + 16 * q4) = (u32x4){kcw[4 * q4], kcw[4 * q4 + 1], kcw[4 * q4 + 2], kcw[4 * q4 + 3]};
                *(LAS u32x4*)(sl + CS_VC + lane * 64 + 16 * q4) = (u32x4){vcw[4 * q4], vcw[4 * q4 + 1], vcw[4 * q4 + 2], vcw[4 * q4 + 3]}; }
            *(LAS float*)(sl + CS_GL + lane * 4) = gprev;
            LDS_WAIT();
            const int tok = lane & 31, hf = lane >> 5;
            bf16x8 fn[4], fr[4], fb[4], fk[4];
#pragma unroll
            for (int ks = 0; ks < 4; ++ks) { fn[ks] = *(const LAS bf16x8*)(sl + CS_NT + (tok * 64 + 16 * ks + 8 * hf) * 2); fr[ks] = *(const LAS bf16x8*)(sl + CS_RT + (tok * 64 + 16 * ks + 8 * hf) * 2);
                fb[ks] = *(const LAS bf16x8*)(sl + CS_BT + (tok * 64 + 16 * ks + 8 * hf) * 2); fk[ks] = *(const LAS bf16x8*)(sl + CS_KT + (tok * 64 + 16 * ks + 8 * hf) * 2); }
            f32x16 P, Pt, Tm, Akn, Abr, Akr;
#pragma unroll
            for (int e = 0; e < 16; ++e) { P[e] = 0.f; Pt[e] = 0.f; Akn[e] = 0.f; Abr[e] = 0.f; Akr[e] = 0.f; }
#pragma unroll
            for (int ks = 0; ks < 4; ++ks) { P = __builtin_amdgcn_mfma_f32_32x32x16_bf16(fn[ks], fb[ks], P, 0, 0, 0); Pt = __builtin_amdgcn_mfma_f32_32x32x16_bf16(fb[ks], fn[ks], Pt, 0, 0, 0);
                Akn = __builtin_amdgcn_mfma_f32_32x32x16_bf16(fn[ks], fk[ks], Akn, 0, 0, 0); Abr = __builtin_amdgcn_mfma_f32_32x32x16_bf16(fr[ks], fb[ks], Abr, 0, 0, 0); Akr = __builtin_amdgcn_mfma_f32_32x32x16_bf16(fr[ks], fk[ks], Akr, 0, 0, 0); }
#pragma unroll
            for (int e = 0; e < 16; ++e) { const int row = (e & 3) + 8 * (e >> 2) + 4 * hf, col = tok;
                if (!(col < row)) { P[e] = 0.f; Akn[e] = 0.f; } if (!(row < col)) Pt[e] = 0.f; if (col > row) { Abr[e] = 0.f; Akr[e] = 0.f; }
                Tm[e] = P[e] + (row == col ? 1.0f : 0.f); }
#pragma unroll
            for (int mm = 1; mm <= 4; ++mm) {
                const bf16x8 p0 = cfrag(P, 0), p1 = cfrag(P, 1), q0 = cfrag(Pt, 0), q1 = cfrag(Pt, 1);
                f32x16 Ptn, Pn;
#pragma unroll
                for (int e = 0; e < 16; ++e) { Ptn[e] = 0.f; Pn[e] = 0.f; }
                Ptn = __builtin_amdgcn_mfma_f32_32x32x16_bf16(p0, q0, Ptn, 0, 0, 0); Ptn = __builtin_amdgcn_mfma_f32_32x32x16_bf16(p1, q1, Ptn, 0, 0, 0);
                if (mm < 4) { Pn = __builtin_amdgcn_mfma_f32_32x32x16_bf16(q0, p0, Pn, 0, 0, 0); Pn = __builtin_amdgcn_mfma_f32_32x32x16_bf16(q1, p1, Pn, 0, 0, 0); }
                const bf16x8 t0 = cfrag(Tm, 0), t1 = cfrag(Tm, 1), u0 = cfrag(Ptn, 0), u1 = cfrag(Ptn, 1);
                Tm = __builtin_amdgcn_mfma_f32_32x32x16_bf16(u0, t0, Tm, 0, 0, 0); Tm = __builtin_amdgcn_mfma_f32_32x32x16_bf16(u1, t1, Tm, 0, 0, 0);
                P = Pn; Pt = Ptn;
            }
            { const int itn = it + gridDim.x * CR_PW; if (itn < 64 * CR_PIECE) { const int l2 = lane_id(); issue(itn, l2 >> 3, l2 & 7, l2); } }
            { const int pc = permp(tok);
#pragma unroll
              for (int e = 0; e < 16; e += 2) { const int row = (e & 3) + 8 * (e >> 2) + 4 * hf;
                const unsigned w0 = pk2(Tm[e], Tm[e + 1]), w1 = pk2(Akn[e], Akn[e + 1]), w2 = pk2(Abr[e], Abr[e + 1]), w3 = pk2(Akr[e], Akr[e + 1]);
                *(LAS unsigned short*)(sl + CS_TM + (row * 32 + pc) * 2) = (unsigned short)w0; *(LAS unsigned short*)(sl + CS_TM + ((row + 1) * 32 + pc) * 2) = (unsigned short)(w0 >> 16);
                *(LAS unsigned short*)(sl + CS_AKN + (row * 32 + pc) * 2) = (unsigned short)w1; *(LAS unsigned short*)(sl + CS_AKN + ((row + 1) * 32 + pc) * 2) = (unsigned short)(w1 >> 16);
                *(LAS unsigned short*)(sl + CS_ABR + (row * 32 + pc) * 2) = (unsigned short)w2; *(LAS unsigned short*)(sl + CS_ABR + ((row + 1) * 32 + pc) * 2) = (unsigned short)(w2 >> 16);
                *(LAS unsigned short*)(sl + CS_AKR + (row * 32 + pc) * 2) = (unsigned short)w3; *(LAS unsigned short*)(sl + CS_AKR + ((row + 1) * 32 + pc) * 2) = (unsigned short)(w3 >> 16); } }
            LDS_WAIT();
            { unsigned char* dst = IMG + (size_t)it * CS_SLOT;
#pragma unroll 1
              for (int j = lane; j < CS_SLOT / 16; j += 64) *(u32x4*)(dst + 16 * j) = *(const LAS u32x4*)(sl + 16 * j); }
            LDS_WAIT();
    }
}

__device__ __forceinline__ void cscan_consume(const Args& a, const int wave, LAS unsigned char* lds, const int bh, const int piece, f32x4 (&xc)[4]) {
    const int lane = lane_id();
    const int b = bh >> 4, h = bh & 15;
    bf16_t* YAB = (bf16_t*)(a.ws + WS_YAB); const unsigned char* IMG = (const unsigned char*)a.out + DO_IMG;
    LAS unsigned* ready = (LAS unsigned*)(lds + CS_FLAGS); LAS unsigned* done = ready + 4;
    if (wave == 4) {
        constexpr int NI = (CS_SLOT + 1023) / 1024;
        for (int cc = 0; cc <= CR_PIECE; ++cc) {
            if (cc < CR_PIECE) { const int c = piece * CR_PIECE + cc, s = cc & 3; LAS unsigned char* sl = lds + s * CS_SLOT;
                const unsigned char* src = IMG + (size_t)(bh * CR_PIECE + cc) * CS_SLOT;
                if (c >= 4) lds_poll_ge(done + s, 4u * (unsigned)(c >> 2));
#pragma unroll
                for (int j = 0; j < NI; ++j) { const int idx = lane + 64 * j;
                    if (idx < CS_SLOT / 16) __builtin_amdgcn_global_load_lds((const unsigned*)(src + 16 * idx), (LAS unsigned*)(sl + 1024 * j), 16, 0, 0); } }
            if (cc >= 1) {
                if (cc < CR_PIECE) asm volatile("s_waitcnt vmcnt(29)" ::: "memory"); else asm volatile("s_waitcnt vmcnt(0)" ::: "memory");
                if (lane == 0) __hip_atomic_store(ready + ((cc - 1) & 3), (unsigned)(piece * CR_PIECE + cc), __ATOMIC_RELAXED, __HIP_MEMORY_SCOPE_WORKGROUP); }
        }
    } else if (wave < 4) {
        const int l15 = lane & 15, g = lane >> 4, vb = wave;
        for (int cc = 0; cc < CR_PIECE; ++cc) { const int c = piece * CR_PIECE + cc, s = cc & 3; const LAS unsigned char* sl = lds + s * CS_SLOT;
            { lds_poll_ge(ready + s, (unsigned)(c + 1)); }
            const bf16x8 xb0 = cfrag2(xc[0], xc[1]), xb1 = cfrag2(xc[2], xc[3]);
            const bf16x8 vop = *(const LAS bf16x8*)(sl + CS_VC + ((16 * vb + l15) * 32 + 8 * g) * 2);
            f32x4 W[2], U[2], Y[2];
#pragma unroll
            for (int rt = 0; rt < 2; ++rt) { const int row = 16 * rt + l15; f32x4 acc = (f32x4){0.f, 0.f, 0.f, 0.f};
                acc = __builtin_amdgcn_mfma_f32_16x16x32_bf16(*(const LAS bf16x8*)(sl + CS_AKN + (row * 32 + 8 * g) * 2), vop, acc, 0, 0, 0);
                acc = __builtin_amdgcn_mfma_f32_16x16x32_bf16(*(const LAS bf16x8*)(sl + CS_NT + (row * 64 + 8 * g) * 2), xb0, acc, 0, 0, 0);
                acc = __builtin_amdgcn_mfma_f32_16x16x32_bf16(*(const LAS bf16x8*)(sl + CS_NT + (row * 64 + 32 + 8 * g) * 2), xb1, acc, 0, 0, 0);
                W[rt] = acc; }
            const bf16x8 wb = cfrag2(W[0], W[1]);
#pragma unroll
            for (int rt = 0; rt < 2; ++rt) { const int row = 16 * rt + l15;
                U[rt] = __builtin_amdgcn_mfma_f32_16x16x32_bf16(*(const LAS bf16x8*)(sl + CS_TM + (row * 32 + 8 * g) * 2), wb, (f32x4){0.f, 0.f, 0.f, 0.f}, 0, 0, 0); }
            const bf16x8 ub = cfrag2(U[0], U[1]);
#pragma unroll
            for (int rt = 0; rt < 2; ++rt) { const int row = 16 * rt + l15; f32x4 acc = (f32x4){0.f, 0.f, 0.f, 0.f};
                acc = __builtin_amdgcn_mfma_f32_16x16x32_bf16(*(const LAS bf16x8*)(sl + CS_AKR + (row * 32 + 8 * g) * 2), vop, acc, 0, 0, 0);
                acc = __builtin_amdgcn_mfma_f32_16x16x32_bf16(*(const LAS bf16x8*)(sl + CS_RT + (row * 64 + 8 * g) * 2), xb0, acc, 0, 0, 0);
                acc = __builtin_amdgcn_mfma_f32_16x16x32_bf16(*(const LAS bf16x8*)(sl + CS_RT + (row * 64 + 32 + 8 * g) * 2), xb1, acc, 0, 0, 0);
                acc = __builtin_amdgcn_mfma_f32_16x16x32_bf16(*(const LAS bf16x8*)(sl + CS_ABR + (row * 32 + 8 * g) * 2), ub, acc, 0, 0, 0);
                Y[rt] = acc; }
#pragma unroll
            for (int kt = 0; kt < 4; ++kt) { const int row = 16 * kt + l15; f32x4 acc = xc[kt];
                acc = __builtin_amdgcn_mfma_f32_16x16x32_bf16(*(const LAS bf16x8*)(sl + CS_KC + (row * 32 + 8 * g) * 2), vop, acc, 0, 0, 0);
                acc = __builtin_amdgcn_mfma_f32_16x16x32_bf16(*(const LAS bf16x8*)(sl + CS_BC + (row * 32 + 8 * g) * 2), ub, acc, 0, 0, 0);
                xc[kt] = acc * *(const LAS f32x4*)(sl + CS_GL + (16 * kt + 4 * g) * 4); }
            LDS_WAIT();
            if (lane == 0) (void)__hip_atomic_fetch_add(done + s, 1u, __ATOMIC_RELAXED, __HIP_MEMORY_SCOPE_WORKGROUP);
#pragma unroll
            for (int rt = 0; rt < 2; ++rt)
#pragma unroll
                for (int e = 0; e < 4; ++e) { const size_t m = (size_t)b * SEQ + (size_t)c * CS_L + 16 * rt + 4 * g + e;
                    YAB[m * 2048 + 1024 + h * 64 + 16 * vb + l15] = (bf16_t)(pk2(Y[rt][e], 0.f) & 0xffffu); }
        }
    }
}

constexpr int DS_NQ = 16, DS_CAP = 2048, DS_TRIG = 1536, DS_TOPK = 256;
constexpr int DS_HIST_WORDS = 320;
constexpr int DS_CAND_OFF = 0, DS_HIST_OFF = DS_NQ * DS_CAP * 4, DS_CNT_OFF = DS_HIST_OFF + 8 * DS_HIST_WORDS * 4, DS_TAU_OFF = DS_CNT_OFF + 64;
static_assert(DS_TAU_OFF + 64 <= LDS_BYTES, "dsa LDS map");

template <int CTRL, int RM> __device__ __forceinline__ unsigned dppu(unsigned x) { return (unsigned)__builtin_amdgcn_update_dpp(0, (int)x, CTRL, RM, 0xf, true); }
__device__ __forceinline__ unsigned wave_scan_incl(unsigned v) {
    v += dppu<0x111, 0xf>(v); v += dppu<0x112, 0xf>(v); v += dppu<0x114, 0xf>(v); v += dppu<0x118, 0xf>(v);
    v += dppu<0x142, 0xa>(v);
    v += dppu<0x143, 0xc>(v);
    return v; }
template <int NE>
__device__ __forceinline__ void select_compact(LAS unsigned* cq, LAS unsigned* cntq, LAS unsigned* tauq, LAS unsigned* hist, int lane) {
    const unsigned n = *cntq;
    unsigned e[NE];
#pragma unroll
    for (int j = 0; j < NE; ++j) { const unsigned idx = lane + 64 * j; e[j] = idx < n ? cq[idx] : 0u; }
    unsigned npos = 0u;
#pragma unroll
    for (int j = 0; j < NE; ++j) npos += (unsigned)__popcll(__ballot(e[j] >= 0x80000000u));
    if (npos >= (unsigned)DS_TOPK) {
#pragma unroll
        for (int j = 0; j < NE; ++j) e[j] = (e[j] >= 0x80000000u) ? e[j] : 0u; }
    unsigned va = 0xFFFFFFFFu, vo = 0u;
#pragma unroll
    for (int j = 0; j < NE; ++j) { va &= (e[j] != 0u) ? e[j] : 0xFFFFFFFFu; vo |= e[j]; }
    va &= (unsigned)__builtin_amdgcn_update_dpp(-1, (int)va, 0xB1, 0xf, 0xf, true); va &= (unsigned)__builtin_amdgcn_update_dpp(-1, (int)va, 0x4E, 0xf, 0xf, true);
    va &= (unsigned)__builtin_amdgcn_update_dpp(-1, (int)va, 0x141, 0xf, 0xf, true); va &= (unsigned)__builtin_amdgcn_update_dpp(-1, (int)va, 0x140, 0xf, 0xf, true);
    vo |= dppu<0xB1, 0xf>(vo); vo |= dppu<0x4E, 0xf>(vo); vo |= dppu<0x141, 0xf>(vo); vo |= dppu<0x140, 0xf>(vo);
    const unsigned vas = (unsigned)(__builtin_amdgcn_readlane((int)va, 0) & __builtin_amdgcn_readlane((int)va, 16) & __builtin_amdgcn_readlane((int)va, 32) & __builtin_amdgcn_readlane((int)va, 48));
    const unsigned vos = (unsigned)(__builtin_amdgcn_readlane((int)vo, 0) | __builtin_amdgcn_readlane((int)vo, 16) | __builtin_amdgcn_readlane((int)vo, 32) | __builtin_amdgcn_readlane((int)vo, 48));
    const unsigned diff = vas ^ vos;
    const int top = diff ? 31 - __builtin_clz(diff) : 7;
    unsigned prefix = (top >= 31) ? 0u : (vos & ~((2u << top) - 1u)), mask = (top >= 31) ? 0u : ~((2u << top) - 1u), need = DS_TOPK;
    int hi = top;
    const int rl = 63 - lane;
#pragma unroll 1
    for (int pass = 0; pass < 4 && hi >= 0; ++pass) {
        const int shift = hi >= 7 ? hi - 7 : 0; const unsigned dmask = (hi >= 7) ? 0xFFu : ((2u << hi) - 1u);
        *(LAS u32x4*)(hist + 4 * lane) = (u32x4){0u, 0u, 0u, 0u};
        LDS_WAIT();
#pragma unroll
        for (int j = 0; j < NE; ++j) { const bool hit = (e[j] != 0u) && ((e[j] & mask) == prefix); const unsigned bin = hit ? ((e[j] >> shift) & dmask) : (256u + (unsigned)lane);
            (void)__hip_atomic_fetch_add(hist + bin, 1u, __ATOMIC_RELAXED, __HIP_MEMORY_SCOPE_WORKGROUP); }
        LDS_WAIT();
        const u32x4 h4 = *(const LAS u32x4*)(hist + 4 * rl);
        const unsigned tot = (h4.x + h4.y) + (h4.z + h4.w);
        const unsigned v = wave_scan_incl(tot);
        const unsigned above = v - tot;
        const bool is = (above < need) && (need <= v);
        unsigned B = 0u, ca = 0u;
        if (is) { unsigned c = above;
            if (c + h4.w >= need) { B = 4 * rl + 3; ca = c; } else { c += h4.w;
            if (c + h4.z >= need) { B = 4 * rl + 2; ca = c; } else { c += h4.z;
            if (c + h4.y >= need) { B = 4 * rl + 1; ca = c; } else { c += h4.y; B = 4 * rl; ca = c; } } } }
        const unsigned long long bal = __ballot(is);
        if (bal == 0ull) break;
        const int src = __builtin_amdgcn_readfirstlane(__ffsll((long long)bal) - 1);
        B = (unsigned)__builtin_amdgcn_readlane((int)B, src); ca = (unsigned)__builtin_amdgcn_readlane((int)ca, src);
        need -= ca; prefix |= B << shift; mask |= dmask << shift; hi = shift - 1;
    }
    const unsigned T = prefix;
    unsigned base = 0u;
#pragma unroll
    for (int j = 0; j < NE; ++j) { const bool keep = (e[j] >= T) && (e[j] != 0u); const unsigned long long bal = __ballot(keep);
        const unsigned pos = base + __builtin_amdgcn_mbcnt_hi((unsigned)(bal >> 32), __builtin_amdgcn_mbcnt_lo((unsigned)bal, 0u));
        if (keep) cq[pos] = e[j];
        base += (unsigned)__popcll(bal); }
    if (lane == 0) { *cntq = base; *tauq = T; }
    LDS_WAIT();
}

template <int NE>
__device__ __forceinline__ void filter_compact(LAS unsigned* cq, LAS unsigned* cntq, LAS unsigned* tauq, int lane) {
    const unsigned n = *cntq;
    unsigned e[NE];
#pragma unroll
    for (int j = 0; j < NE; ++j) { const unsigned idx = lane + 64 * j; e[j] = idx < n ? cq[idx] : 0u; }
    unsigned m0 = 0u, m1 = 0u, m2 = 0u, m3 = 0u;
#pragma unroll
    for (int j = 0; j < NE; ++j) { unsigned x = e[j], t;
        t = max(m0, x); x = min(m0, x); m0 = t; t = max(m1, x); x = min(m1, x); m1 = t; t = max(m2, x); x = min(m2, x); m2 = t; m3 = max(m3, x); }
    unsigned T = m3;
    T = min(T, (unsigned)__builtin_amdgcn_update_dpp(-1, (int)T, 0xB1, 0xf, 0xf, true)); T = min(T, (unsigned)__builtin_amdgcn_update_dpp(-1, (int)T, 0x4E, 0xf, 0xf, true));
    T = min(T, (unsigned)__builtin_amdgcn_update_dpp(-1, (int)T, 0x141, 0xf, 0xf, true)); T = min(T, (unsigned)__builtin_amdgcn_update_dpp(-1, (int)T, 0x140, 0xf, 0xf, true));
    T = min(min((unsigned)__builtin_amdgcn_readlane((int)T, 0), (unsigned)__builtin_amdgcn_readlane((int)T, 16)), min((unsigned)__builtin_amdgcn_readlane((int)T, 32), (unsigned)__builtin_amdgcn_readlane((int)T, 48)));
    unsigned base = 0u;
#pragma unroll
    for (int j = 0; j < NE; ++j) { const bool keep = (e[j] >= T) && (e[j] != 0u); const unsigned long long bal = __ballot(keep);
        const unsigned pos = base + __builtin_amdgcn_mbcnt_hi((unsigned)(bal >> 32), __builtin_amdgcn_mbcnt_lo((unsigned)bal, 0u));
        if (keep) cq[pos] = e[j];
        base += (unsigned)__popcll(bal); }
    if (lane == 0) { *cntq = base; *tauq = (T > 0u) ? T - 1u : 0u; }
    LDS_WAIT();
}

__device__ __forceinline__ unsigned vrow_off(int pr) { return (unsigned)(pr < 28 ? 1024 + 256 * pr : 9216 + 256 * (pr - 28)); }
__device__ __forceinline__ unsigned swz_b(int row) { return (unsigned)(((row & 3) << 2) | ((row >> 2) & 3)); }

__device__ __forceinline__ void dsa_phase(const Args& a, const int wave, LAS unsigned char* lds, const bool dry = false) {
    const bf16_t* Qg = (const bf16_t*)(a.ws + WS_Q); const bf16_t* KVg = (const bf16_t*)(a.ws + WS_KV); const bf16_t* QIg = (const bf16_t*)(a.ws + WS_QI);
    const bf16_t* KIg = (const bf16_t*)(a.ws + WS_KI); const float* WIg = (const float*)(a.ws + WS_WI); bf16_t* Gg = (bf16_t*)(a.ws + WS_G);
    LAS unsigned* cand = (LAS unsigned*)(lds + DS_CAND_OFF); LAS unsigned* hist = (LAS unsigned*)(lds + DS_HIST_OFF) + wave * DS_HIST_WORDS;
    LAS unsigned* cnt = (LAS unsigned*)(lds + DS_CNT_OFF); LAS unsigned* taup = (LAS unsigned*)(lds + DS_TAU_OFF);
    for (int L = blockIdx.x; L < 2048; L += gridDim.x) {
        int lane; asm volatile("v_mbcnt_lo_u32_b32 %0, -1, 0\n\tv_mbcnt_hi_u32_b32 %0, -1, %0" : "=v"(lane));
        const int tid = wave * 64 + lane, ql = lane & 15, gq = lane >> 4;
        int b, j;
        if (gridDim.x == 256) { const int i = blockIdx.x, ui = L >> 8, x = i & 7, li = (i >> 3) * 2 + (x >> 2); b = x & 3; j = 128 * (ui >> 1) + ((ui & 1) ? 127 - li : li); }
        else { b = L >> 9; j = L & 511; }
        const unsigned mb = (unsigned)b * SEQ; const int q0 = DS_NQ * j; const unsigned mq = mb + q0 + ql;
        const int pos0 = a.pos[mb]; int nadm = ((a.pos[mq] >> 6) + 1) * 64 - pos0; nadm = nadm > SEQ ? SEQ : nadm;
        int nmax = ((a.pos[mb + q0 + DS_NQ - 1] >> 6) + 1) * 64 - pos0; nmax = nmax > SEQ ? SEQ : nmax;
        const int nstep = (nmax + 511) >> 9;
#ifdef DSA_REP_STREAM
        for (int srep_ = 0; srep_ < 2; ++srep_) {
#endif
        __syncthreads();
        if (tid < DS_NQ) { cnt[tid] = 0u; taup[tid] = 0u; }
        bf16x8 bq[8][2];
#pragma unroll
        for (int h = 0; h < 8; ++h)
#pragma unroll
            for (int ks = 0; ks < 2; ++ks) bq[h][ks] = *(const bf16x8*)(QIg + (mq * 512u + h * 64 + 32 * ks + 8 * gq));
        f32x2 wh[8]; { const f32x4 w0 = *(const f32x4*)(WIg + mq * 8), w1 = *(const f32x4*)(WIg + mq * 8 + 4);
#pragma unroll
            for (int h = 0; h < 4; ++h) { wh[h] = (f32x2){w0[h], w0[h]}; wh[4 + h] = (f32x2){w1[h], w1[h]}; } }
        __syncthreads();
        bf16x8 ka[4][2];
        { const bf16_t* kr = KIg + ((mb + 64 * wave + ql) * 64u + 8u * gq);
#pragma unroll
          for (int st = 0; st < 4; ++st)
#pragma unroll
            for (int ks = 0; ks < 2; ++ks) ka[st][ks] = *(const bf16x8*)(kr + st * 16 * 64 + 32 * ks); }
        for (int step = 0; step <= nstep; ++step) {
            const int kb = 512 * step + 64 * wave; const bool active = (kb < nmax) && (step < nstep);
            PROBE_BEGIN(2, a.ws, wave);
            if (active) {
                f32x2 sc2[8];
#ifdef DSA_SCORE2
                for (int srep2_ = 0; srep2_ < 2; ++srep2_) {
#endif
#pragma unroll
                for (int i = 0; i < 8; ++i) sc2[i] = (f32x2){0.f, 0.f};
#pragma unroll
                for (int h = 0; h < 8; ++h)
#pragma unroll
                    for (int st = 0; st < 4; ++st) { f32x4 acc = (f32x4){0.f, 0.f, 0.f, 0.f};
#pragma unroll
                        for (int ks = 0; ks < 2; ++ks) acc = __builtin_amdgcn_mfma_f32_16x16x32_bf16(ka[st][ks], bq[h][ks], acc, 0, 0, 0);
                        sc2[2 * st] += wh[h] * (f32x2){fmaxf(acc[0], 0.f), fmaxf(acc[1], 0.f)}; sc2[2 * st + 1] += wh[h] * (f32x2){fmaxf(acc[2], 0.f), fmaxf(acc[3], 0.f)};
                        if (st == 3 && (h & 1)) __builtin_amdgcn_sched_barrier(0); }
#ifdef DSA_SCORE2
#pragma unroll
                for (int i = 0; i < 8; ++i) asm volatile("" : "+v"(sc2[i]));
                }
#endif
                float sc[16];
#pragma unroll
                for (int i = 0; i < 8; ++i) { sc[2 * i] = sc2[i][0]; sc[2 * i + 1] = sc2[i][1]; }
                __builtin_amdgcn_sched_barrier(0);
                { const int kbn = (kb + 512 < SEQ) ? kb + 512 : kb; unsigned ko0 = (mb + kbn + ql) * 64u + 8u * gq, ko1 = ko0 + 2048u;
                  asm volatile("" : "+v"(ko0), "+v"(ko1));
#pragma unroll
                  for (int st = 0; st < 4; ++st)
#pragma unroll
                    for (int ks = 0; ks < 2; ++ks) ka[st][ks] = *(const bf16x8*)(KIg + ((st & 2) ? ko1 : ko0) + (st & 1) * 16 * 64 + 32 * ks); }
                const unsigned tp = taup[ql]; unsigned pm = 0u;
#pragma unroll
                for (int i = 0; i < 16; ++i) { const int key = kb + 16 * (i >> 2) + 4 * gq + (i & 3); const unsigned u = __float_as_uint(sc[i]);
                    const unsigned ord = (u & 0x80000000u) ? ~u : (u | 0x80000000u); const unsigned pk = (ord & 0xFFFFE000u) | (unsigned)key;
                    sc[i] = __uint_as_float(pk);
                    if (key < nadm && pk > tp) pm |= 1u << i; }
                const unsigned n = (unsigned)__popc(pm);
                unsigned k = 0u; if (n) k = __hip_atomic_fetch_add(cnt + ql, n, __ATOMIC_RELAXED, __HIP_MEMORY_SCOPE_WORKGROUP);
                LAS unsigned* cq = cand + ql * DS_CAP;
#pragma unroll
                for (int i = 0; i < 16; ++i) if (pm & (1u << i)) { cq[k] = __float_as_uint(sc[i]); ++k; }
            }
            __syncthreads();
            PROBE_END(2, a.ws, wave);
            const u32x4 c0 = *(const LAS u32x4*)(cnt), c1 = *(const LAS u32x4*)(cnt + 4), c2 = *(const LAS u32x4*)(cnt + 8), c3 = *(const LAS u32x4*)(cnt + 12);
            unsigned cm = max(max(max(c0.x, c0.y), max(c0.z, c0.w)), max(max(c1.x, c1.y), max(c1.z, c1.w)));
            cm = max(cm, max(max(max(c2.x, c2.y), max(c2.z, c2.w)), max(max(c3.x, c3.y), max(c3.z, c3.w))));
            const unsigned trig = (step == nstep) ? (unsigned)DS_TOPK : (unsigned)DS_TRIG;
#ifdef DSA_SEL2
            const int nsel = (step == nstep) ? 4 : 2;
#else
            const int nsel = 2;
#endif
            if (cm > trig) {
                PROBE_BEGIN(1, a.ws, wave);
#pragma unroll 1
                for (int qq = 0; qq < nsel; ++qq) { const int q = 2 * wave + (qq & 1); if (cnt[q] > trig || qq >= 2) {
                    if (step != nstep) filter_compact<32>(cand + q * DS_CAP, cnt + q, taup + q, lane);
                    if (step == nstep || cnt[q] > (unsigned)DS_TRIG) select_compact<32>(cand + q * DS_CAP, cnt + q, taup + q, hist, lane); } }
                __syncthreads();
                PROBE_END(1, a.ws, wave);
            }
        }
#ifdef DSA_REP_STREAM
        }
#endif
        const bf16_t* KVb = KVg + (size_t)mb * 256;
        int lane_a = lane; asm volatile("" : "+v"(lane_a));
        const int g16 = lane_a >> 4, l15 = lane_a & 15;
        const unsigned vbase = (unsigned)(size_t)(lds + DS_CAND_OFF) + (unsigned)wave * 16384u;
        unsigned ta0, ta1;
        { const int q = l15 >> 2, p = lane_a & 3; const int pr0 = 8 * g16 + q, pr1 = pr0 + 4;
          ta0 = vbase + vrow_off(pr0) + 16u * ((unsigned)(p >> 1) ^ swz_b(pr0)) + 8u * (unsigned)(p & 1);
          ta1 = vbase + vrow_off(pr1) + 16u * ((unsigned)(p >> 1) ^ swz_b(pr1)) + 8u * (unsigned)(p & 1); }
        unsigned vwa[8];
#pragma unroll
        for (int j2 = 0; j2 < 8; ++j2) { const int srow = 4 * j2 + g16; const int pr = (srow < 16) ? 8 * (srow >> 2) + (srow & 3) : 8 * ((srow - 16) >> 2) + 4 + (srow & 3);
            vwa[j2] = vbase + vrow_off(pr) + 16u * ((unsigned)l15 ^ swz_b(pr)); }
#ifdef DSA_REP_ATT
        for (int arep_ = 0; arep_ < 2; ++arep_) { const bool dry2 = dry || (arep_ == 0 && a.ph_hi > 0);
#else
        { const bool dry2 = dry;
#endif
#pragma unroll 1
        for (int qq = 0; qq < 2; ++qq) {
            const int q = 2 * wave + qq; const unsigned m = mb + q0 + q; const int n = (int)cnt[q]; const LAS unsigned* cq = cand + q * DS_CAP;
            bf16x8 qb[4];
#pragma unroll
            for (int ks = 0; ks < 4; ++ks) qb[ks] = *(const bf16x8*)(Qg + (m * 2048u + l15 * 128 + 32 * ks + 8 * g16));
            f32x4 sacc[16];
            const int nl = n - l15; const LAS unsigned* cql = cq + l15;
            bf16x8 kf[2][16];
            auto kload = [&](int grp, bf16x8 (&dst)[16]) {
#pragma unroll
                for (int t = 0; t < 4; ++t) { const int jt = 4 * grp + t; const unsigned e = cql[16 * jt]; const unsigned key = (16 * jt < nl) ? (e & 0x1FFFu) : 0u;
                    const bf16_t* kr = KVb + (key * 256u + 8u * g16);
#pragma unroll
                    for (int ks = 0; ks < 4; ++ks) dst[4 * t + ks] = *(const bf16x8*)(kr + 32 * ks); } };
            kload(0, kf[0]);
#pragma unroll
            for (int grp = 0; grp < 4; ++grp) {
                if (grp < 3) kload(grp + 1, kf[(grp + 1) & 1]);
#pragma unroll
                for (int t = 0; t < 4; ++t) { f32x4 acc = (f32x4){0.f, 0.f, 0.f, 0.f};
#pragma unroll
                    for (int ks = 0; ks < 4; ++ks) acc = __builtin_amdgcn_mfma_f32_16x16x32_bf16(kf[grp & 1][4 * t + ks], qb[ks], acc, 0, 0, 0);
                    sacc[4 * grp + t] = acc; }
                __builtin_amdgcn_sched_barrier(0);
            }
            u32x4 vr[2][8]; const int ng = n - g16; const LAS unsigned* cqg = cq + g16;
            auto vload = [&](int kk, u32x4 (&dst)[8]) {
#pragma unroll
                for (int j2 = 0; j2 < 8; ++j2) { const int sl = 32 * kk + 4 * j2; const unsigned e = cqg[sl]; const unsigned key = (sl < ng) ? (e & 0x1FFFu) : 0u;
                    dst[j2] = *(const u32x4*)(KVb + (key * 256u + 128u + 8u * l15)); } };
            vload(0, vr[0]); vload(1, vr[1]);
            __builtin_amdgcn_sched_barrier(0);
            float mx = -1e30f; const float nnf = (float)(n - 4 * g16 - 1);
#pragma unroll
            for (int jt = 0; jt < 16; ++jt)
#pragma unroll
                for (int r = 0; r < 4; ++r) { sacc[jt][r] = fmaf(fminf(nnf - (float)(16 * jt + r), 0.f), 1e30f, sacc[jt][r]); mx = fmaxf(mx, sacc[jt][r]); }
            mx = fmaxf(mx, __shfl_xor(mx, 16)); mx = fmaxf(mx, __shfl_xor(mx, 32));
            float sum = 0.f;
#pragma unroll
            for (int jt = 0; jt < 16; ++jt)
#pragma unroll
                for (int r = 0; r < 4; ++r) { const float p = __builtin_amdgcn_exp2f(sacc[jt][r] - mx); sacc[jt][r] = p; sum += p; }
            sum += __shfl_xor(sum, 16); sum += __shfl_xor(sum, 32);
            u32x4 pfr[8];
#pragma unroll
            for (int kk = 0; kk < 8; ++kk) { const f32x4 pa = sacc[2 * kk], pb2 = sacc[2 * kk + 1];
                pfr[kk].x = pk2(pa[0], pa[1]); pfr[kk].y = pk2(pa[2], pa[3]); pfr[kk].z = pk2(pb2[0], pb2[1]); pfr[kk].w = pk2(pb2[2], pb2[3]); }
            __builtin_amdgcn_sched_barrier(0);
            f32x4 o[8];
#pragma unroll
            for (int c = 0; c < 8; ++c) o[c] = (f32x4){0.f, 0.f, 0.f, 0.f};
#pragma unroll
            for (int kk = 0; kk < 8; ++kk) {
#pragma unroll
                for (int j2 = 0; j2 < 8; ++j2) *(LAS u32x4*)(size_t)vwa[j2] = vr[kk & 1][j2];
                __builtin_amdgcn_sched_barrier(0);
                if (kk + 2 < 8) vload(kk + 2, vr[kk & 1]);
                LDS_WAIT();
                const bf16x8 pfrag = __builtin_bit_cast(bf16x8, pfr[kk]);
#pragma unroll
                for (int ch = 0; ch < 2; ++ch) {
                    s16x4 t0[4], t1[4];
                    asm volatile("ds_read_b64_tr_b16 %0, %8\n\tds_read_b64_tr_b16 %1, %9\n\tds_read_b64_tr_b16 %2, %10\n\tds_read_b64_tr_b16 %3, %11\n\t"
                                 "ds_read_b64_tr_b16 %4, %12\n\tds_read_b64_tr_b16 %5, %13\n\tds_read_b64_tr_b16 %6, %14\n\tds_read_b64_tr_b16 %7, %15\n\ts_waitcnt lgkmcnt(0)"
                                 : "=&v"(t0[0]), "=&v"(t0[1]), "=&v"(t0[2]), "=&v"(t0[3]), "=&v"(t1[0]), "=&v"(t1[1]), "=&v"(t1[2]), "=&v"(t1[3])
                                 : "v"(ta0 ^ (unsigned)((4 * ch + 0) << 5)), "v"(ta0 ^ (unsigned)((4 * ch + 1) << 5)), "v"(ta0 ^ (unsigned)((4 * ch + 2) << 5)), "v"(ta0 ^ (unsigned)((4 * ch + 3) << 5)),
                                   "v"(ta1 ^ (unsigned)((4 * ch + 0) << 5)), "v"(ta1 ^ (unsigned)((4 * ch + 1) << 5)), "v"(ta1 ^ (unsigned)((4 * ch + 2) << 5)), "v"(ta1 ^ (unsigned)((4 * ch + 3) << 5)) : "memory");
                    __builtin_amdgcn_sched_barrier(0);
#pragma unroll
                    for (int c = 0; c < 4; ++c) { const bf16x8 av = __builtin_shufflevector(t0[c], t1[c], 0, 1, 2, 3, 4, 5, 6, 7);
                        o[4 * ch + c] = __builtin_amdgcn_mfma_f32_16x16x32_bf16(av, pfrag, o[4 * ch + c], 0, 0, 0); }
                }
            }
            const float inv = 1.0f / sum;
#pragma unroll
            for (int c = 0; c < 8; ++c) { bf16_t* gp = Gg + (m * 2048u + l15 * 128 + 16 * c + 4 * g16); const u32x2 gw = *(const u32x2*)gp;
                const f32x4 r = o[c] * inv * (f32x4){bflo(gw.x), bfhi(gw.x), bflo(gw.y), bfhi(gw.y)};
                u32x2 wv; wv.x = pk2(r[0], r[1]); wv.y = pk2(r[2], r[3]); if (!dry2) *(u32x2*)gp = wv; }
        }
        }
    }
}

#ifndef OLD_SCAN
#define OLD_SCAN 0
#endif
#ifndef MK_SPLIT
#define MK_SPLIT 0
#endif
#ifndef MK_PH_END
#define MK_PH_END 13
#endif
constexpr int N_PHASES = 13;

__device__ __forceinline__ void grid_bar(unsigned* bar, const unsigned epoch, const int wave) {
    asm volatile("s_waitcnt vmcnt(0)" ::: "memory");
    __syncthreads();
    if (wave == 0) {
        if (lane_id() == 0) {
            __builtin_amdgcn_fence(__ATOMIC_RELEASE, "agent");
            asm volatile("s_waitcnt vmcnt(0)" ::: "memory");
            const unsigned old = __hip_atomic_fetch_add(bar, 1u, __ATOMIC_RELAXED, __HIP_MEMORY_SCOPE_AGENT);
            if (old + 1u == gridDim.x * epoch) __hip_atomic_store(bar + 64, epoch, __ATOMIC_RELAXED, __HIP_MEMORY_SCOPE_AGENT);
            else while (__hip_atomic_load(bar + 64, __ATOMIC_RELAXED, __HIP_MEMORY_SCOPE_AGENT) < epoch) __builtin_amdgcn_s_sleep(2);
            __builtin_amdgcn_fence(__ATOMIC_ACQUIRE, "agent");
            asm volatile("s_waitcnt vmcnt(0)" ::: "memory");
        }
    }
    __syncthreads();
}

typedef const __attribute__((address_space(4))) Args* KArgs;
#if defined(__HIP_DEVICE_COMPILE__)
__device__ __forceinline__ Args kargs() { KArgs p = (KArgs)__builtin_amdgcn_kernarg_segment_ptr(); asm volatile("" : "+s"(p)); return *p; }
#else
__device__ __forceinline__ Args kargs() { return Args{}; }
#endif
#define PHASE_ARGS const Args a = kargs(); unsigned char* ws = a.ws; (void)ws

__global__ void __launch_bounds__(NTHREADS, 2) fwd_megakernel(Args a_by_value) {
    extern __shared__ __attribute__((aligned(16))) unsigned char lds_raw[];
    LAS unsigned char* lds = (LAS unsigned char*)lds_raw;
    cg::grid_group grid = cg::this_grid();
    const int wave = __builtin_amdgcn_readfirstlane((int)threadIdx.x >> 6);
    int lo, hi; { const Args a0 = kargs(); lo = a0.ph_lo; hi = a0.ph_hi; }
#ifdef ONLY_PH
#define IN(k) ((k) == ONLY_PH && lo <= (k) && (k) < hi)
#else
#define IN(k) (lo <= (k) && (k) < hi)
#endif
#define SEAM(k) do { if (IN(k) && IN((k) + 1)) { if ((k) == 0) grid.sync(); else grid_bar((unsigned*)(kargs().ws + WS_BAR), (unsigned)(k), wave); } } while (0)
#ifdef REP_PH
#define NREP(k) ((k) == REP_PH ? 2 : 1)
#else
#define NREP(k) 1
#endif
#define REPEAT(k) for (int rep_ = 0; rep_ < NREP(k); ++rep_, (rep_ < NREP(k) ? grid_bar((unsigned*)(kargs().ws + WS_BAR) + 128, 1u, wave) : (void)0))
#ifdef STAMP_K
#define TSTAMP(k) do { if (((k) == STAMP_K || (k) == STAMP_K + 1) && blockIdx.x == 0 && wave == 0) { const unsigned long long t_ = __builtin_amdgcn_s_memrealtime(); \
        if (__builtin_amdgcn_mbcnt_lo(~0u, 0u) == 0u) ((unsigned long long*)(kargs().ws + WS_STAMP))[(k) - STAMP_K] = t_; } } while (0)
#else
#define TSTAMP(k) do { } while (0)
#endif
#ifdef STAMP_K
    if (blockIdx.x == PROBE_BLK && wave == 0) { unsigned long long* st_ = (unsigned long long*)(kargs().ws + WS_STAMP); if (__builtin_amdgcn_mbcnt_lo(~0u, 0u) < 3u) st_[__builtin_amdgcn_mbcnt_lo(~0u, 0u)] = 0ull; }
#endif
    TSTAMP(0);
    if (IN(0)) REPEAT(0) { PHASE_ARGS; p0_prologue(a, wave, lds); } SEAM(0); TSTAMP(1);
    if (IN(1)) REPEAT(1) { PHASE_ARGS; norm_phase(a, wave, lds, a.x, 0); } SEAM(1); TSTAMP(2);
    if (IN(2)) REPEAT(2) { PHASE_ARGS;
        pg8::Gemm g{(const bf16_t*)(ws + WS_H), (const bf16_t*)(ws + WS_WIN0), MTOK, N0, DM}; pg8::StaticOrder S; S.init(MTOK, N0, gridDim.x, blockIdx.x);
        #ifdef EPI0_CHEAP_FIRST
        Epi0 E{ws, (unsigned char*)a.out, NREP(2) == 2 && rep_ == 0 && a.ph_hi > 0};
#else
        Epi0 E{ws, (unsigned char*)a.out, false};
#endif
        pg8::gemm_phase<Epi0, pg8::StaticOrder, true, true>(lds, g, S, E, wave);
    } SEAM(2); TSTAMP(3);
    if (IN(3)) REPEAT(3) { PHASE_ARGS; conv_phase(a, wave, lds, blockIdx.x, gridDim.x); lora_pre_phase(a, wave); } SEAM(3); TSTAMP(4);
    if (IN(4)) REPEAT(4) { PHASE_ARGS;
        pg8::Gemm g{(const bf16_t*)((unsigned char*)a.out + DO_LA), (const bf16_t*)(ws + WS_WLORA), MTOK, 2048, 256}; pg8::StaticOrder S; S.init(MTOK, 2048, gridDim.x, blockIdx.x);
        EpiLora E{(bf16_t*)(ws + WS_DARR), (bf16_t*)(ws + WS_AARR), a.rwkv_vec};
        pg8::gemm_phase<EpiLora, pg8::StaticOrder, true, true>(lds, g, S, E, wave);
    } SEAM(4); TSTAMP(5);
    if (IN(5)) REPEAT(5) { PHASE_ARGS;
#if OLD_SCAN
        scan_phase(a, wave, lds);
#else
        unsigned* pbar = (unsigned*)(ws + WS_BAR) + 256;
        for (int piece = 0; piece < CR_NP; ++piece) {
            { PROBE_BEGIN(20, a.ws, wave); cscan_produce(a, wave, lds, piece); PROBE_END(20, a.ws, wave); }
            { PROBE_BEGIN(21, a.ws, wave); grid_bar(pbar, (unsigned)(2 * piece + 1), wave); PROBE_END(21, a.ws, wave); }
            if (piece == 0) { __syncthreads(); if (wave == 0 && lane_id() < 8) ((LAS unsigned*)(lds + CS_FLAGS))[lane_id()] = 0u; __syncthreads(); }
            PROBE_BEGIN(22, a.ws, wave);
            if (blockIdx.x < 64) {
                f32x4 xc[4]; f32x4* sv = (f32x4*)(ws + WS_XSAVE) + ((size_t)(blockIdx.x * 4 + (wave & 3)) * 64 + lane_id()) * 4;
#pragma unroll
                for (int kt = 0; kt < 4; ++kt) xc[kt] = (piece == 0 || wave >= 4) ? (f32x4){0.f, 0.f, 0.f, 0.f} : sv[kt];
                cscan_consume(a, wave, lds, blockIdx.x, piece, xc);
                if (wave < 4) {
#pragma unroll
                    for (int kt = 0; kt < 4; ++kt) sv[kt] = xc[kt]; }
            }
            else if (piece == 0) p0_late(a, wave, lds, 64, gridDim.x - 64);
            PROBE_END(22, a.ws, wave);
            { PROBE_BEGIN(23, a.ws, wave); grid_bar(pbar, (unsigned)(2 * piece + 2), wave); PROBE_END(23, a.ws, wave); }
        }
#endif
    } SEAM(5); TSTAMP(6);
    if (IN(6)) REPEAT(6) { PHASE_ARGS; post_phase(a, wave); } SEAM(6); TSTAMP(7);
    if (IN(7)) REPEAT(7) { PHASE_ARGS;
        pg8::Gemm g{(const bf16_t*)(ws + WS_YAB), (const bf16_t*)(ws + WS_WOUT0), MTOK, DM, 2048}; pg8::StaticOrder S; S.init(MTOK, DM, gridDim.x, blockIdx.x);
        EpiRes E{a.x, a.out, (const float*)(ws + WS_MODP), a.ada_b, 0};
        pg8::gemm_phase<EpiRes, pg8::StaticOrder, true, true>(lds, g, S, E, wave);
    } SEAM(7); TSTAMP(8);
    if (IN(8)) REPEAT(8) { PHASE_ARGS; norm_phase(a, wave, lds, a.out, 1); } SEAM(8); TSTAMP(9);
    if (IN(9)) REPEAT(9) { PHASE_ARGS;
        pg8::Gemm g{(const bf16_t*)(ws + WS_H), (const bf16_t*)(ws + WS_WIN1), MTOK, N1, DM}; pg8::StaticOrder S; S.init(MTOK, N1, gridDim.x, blockIdx.x);
        Epi1 E{(bf16_t*)(ws + WS_Q), (bf16_t*)(ws + WS_KV), (bf16_t*)(ws + WS_QI), (bf16_t*)(ws + WS_KI), (bf16_t*)(ws + WS_G), (float*)(ws + WS_WI), (const f32x2*)(ws + WS_CSA), (const f32x2*)(ws + WS_CSI)};
        pg8::gemm_phase<Epi1, pg8::StaticOrder, true, true>(lds, g, S, E, wave);
    } SEAM(9); TSTAMP(10);
    if (IN(10)) REPEAT(10) { PHASE_ARGS; dsa_phase(a, wave, lds, NREP(10) == 2 && rep_ == 0 && a.ph_hi > 0); } SEAM(10); TSTAMP(11);
    if (IN(11)) REPEAT(11) { PHASE_ARGS;
        pg8::Gemm g{(const bf16_t*)(ws + WS_G), (const bf16_t*)(ws + WS_WOUT1), MTOK, DM, 2048}; pg8::StaticOrder S; S.init(MTOK, DM, gridDim.x, blockIdx.x);
        EpiRes E{a.out, a.out, (const float*)(ws + WS_MODP), a.ada_b, 1};
        pg8::gemm_phase<EpiRes, pg8::StaticOrder, true, true>(lds, g, S, E, wave);
    } SEAM(11); TSTAMP(12);
    if (IN(12)) REPEAT(12) { PHASE_ARGS; final_phase(a, wave); }
#undef IN
#undef SEAM
}

extern "C" void kernel_launch(void* const* d_in, const int* in_sizes, int n_in, void* d_out, int out_size, void* d_ws, size_t ws_size, hipStream_t stream) {
    static int grid = 0;
    if (grid == 0) {
        if (n_in != 19 || out_size != MTOK * DM || ws_size < WS_NEED) { fprintf(stderr, "kernel_launch: unexpected shapes (n_in %d, out %d, ws %zu)\n", n_in, out_size, ws_size); grid = -1; return; }
        int dev = 0, cus = 0, per_cu = 0;
        (void)hipGetDevice(&dev); (void)hipDeviceGetAttribute(&cus, hipDeviceAttributeMultiprocessorCount, dev);
        if (hipFuncSetAttribute((const void*)fwd_megakernel, hipFuncAttributeMaxDynamicSharedMemorySize, LDS_BYTES) != hipSuccess) { fprintf(stderr, "kernel_launch: hipFuncSetAttribute failed\n"); grid = -1; return; }
        if (hipOccupancyMaxActiveBlocksPerMultiprocessor(&per_cu, (const void*)fwd_megakernel, NTHREADS, LDS_BYTES) != hipSuccess || per_cu < 1) { fprintf(stderr, "kernel_launch: occupancy query says %d\n", per_cu); per_cu = 1; }
        (void)hipGetLastError();
        grid = cus;
        if (grid > 256) grid = 256;
    }
    if (grid < 0) return;
    Args a{};
    a.x = (const float*)d_in[0]; a.c = (const float*)d_in[1]; a.pos = (const int*)d_in[2]; a.ada_w = (const float*)d_in[3]; a.ada_b = (const float*)d_in[4];
    a.norm_g = (const float*)d_in[5]; a.final_g = (const float*)d_in[6]; a.even_w_in = (const float*)d_in[7]; a.even_w_out = (const float*)d_in[8];
    a.conv_w = (const float*)d_in[9]; a.conv_vec = (const float*)d_in[10]; a.mu_rkv = (const float*)d_in[11]; a.mu_lora = (const float*)d_in[12];
    a.rwkv_vec = (const float*)d_in[13]; a.w_up = (const float*)d_in[14]; a.a_up = (const float*)d_in[15]; a.r_k = (const float*)d_in[16];
    a.odd_w_in = (const float*)d_in[17]; a.odd_w_out = (const float*)d_in[18];
    a.out = (float*)d_out; a.ws = (unsigned char*)d_ws;
    (void)hipMemsetAsync((char*)d_ws + WS_BAR, 0, 4096, stream);
#if MK_SPLIT
    for (int p = 0; p < MK_PH_END; ++p) { a.ph_lo = p; a.ph_hi = p + 1; void* args[] = {&a};
        hipError_t e = hipLaunchCooperativeKernel((const void*)fwd_megakernel, dim3(grid), dim3(NTHREADS), args, LDS_BYTES, stream);
        if (e != hipSuccess) { fprintf(stderr, "launch %d failed: %s\n", p, hipGetErrorString(e)); break; } }
#else
    a.ph_lo = 0; a.ph_hi = MK_PH_END; void* args[] = {&a};
    hipError_t e = hipLaunchCooperativeKernel((const void*)fwd_megakernel, dim3(grid), dim3(NTHREADS), args, LDS_BYTES, stream);
    if (e != hipSuccess) fprintf(stderr, "cooperative launch failed: %s (grid %d)\n", hipGetErrorString(e), grid);
#endif
}
```

```cpp
#include <hip/hip_runtime.h>
#include <hip/hip_cooperative_groups.h>
#include <cstdio>
#include <cstdint>
namespace cg = cooperative_groups;

#define LAS __attribute__((address_space(3)))
typedef unsigned short bf16_t;
typedef float f32x4 __attribute__((ext_vector_type(4)));
typedef float f32x2 __attribute__((ext_vector_type(2)));
typedef float f32x16 __attribute__((ext_vector_type(16)));
typedef unsigned u32x4 __attribute__((ext_vector_type(4)));
typedef unsigned u32x2 __attribute__((ext_vector_type(2)));
typedef short bf16x8 __attribute__((ext_vector_type(8)));
typedef short s16x4 __attribute__((ext_vector_type(4)));

constexpr int BATCH = 4, SEQ = 8192, DM = 1024, MTOK = BATCH * SEQ;
constexpr int N0 = 7424, N1 = 5120;
constexpr int EVEN_COLS = 7296, ODD_COLS = 4936;
constexpr int NWAVES = 8, NTHREADS = 512;
constexpr int LDS_BYTES = 155648;

constexpr size_t MiB = 1u << 20;
constexpr size_t WS_MODP = 0; constexpr size_t WS_STAMP = 3 * MiB; constexpr size_t WS_XSAVE = 1 * MiB;
constexpr size_t WS_BAR = 3 * MiB + 512 * 1024;
constexpr size_t WS_WIN0 = 4 * MiB, WS_WOUT0 = 20 * MiB, WS_WIN1 = 24 * MiB, WS_WOUT1 = 34 * MiB, WS_WLORA = 38 * MiB;
constexpr size_t WS_CSA = 40 * MiB, WS_CSI = 56 * MiB;
constexpr size_t WS_H = 64 * MiB;
constexpr size_t WS_YAB = 64 * MiB;
constexpr size_t WS_U = 192 * MiB, WS_AG = 256 * MiB, WS_R = 320 * MiB, WS_K = 384 * MiB, WS_V = 448 * MiB;
constexpr size_t WS_AARR = WS_U, WS_DARR = WS_AG;
constexpr size_t WS_Q = 128 * MiB, WS_G = 256 * MiB, WS_KV = 384 * MiB, WS_QI = 400 * MiB, WS_KI = 432 * MiB, WS_WI = 436 * MiB;
constexpr size_t WS_NEED = 512 * MiB;
constexpr size_t DO_BG = 0, DO_WDAD = 64 * MiB, DO_LA = 72 * MiB, DO_RK = 64 * MiB;

__device__ __forceinline__ float bflo(unsigned w) { return __uint_as_float(w << 16); }
__device__ __forceinline__ float bfhi(unsigned w) { return __uint_as_float(w & 0xffff0000u); }
typedef __bf16 bf16x2_t __attribute__((ext_vector_type(2)));
__device__ __forceinline__ unsigned pk2(float lo, float hi) { const f32x2 v = {lo, hi}; const bf16x2_t b = __builtin_convertvector(v, bf16x2_t); return __builtin_bit_cast(unsigned, b); }
__device__ __forceinline__ float sigmoidf_(float x) { return __builtin_amdgcn_rcpf(1.0f + __expf(-x)); }
__device__ __forceinline__ float wave_sum(float v) {
#pragma unroll
    for (int o = 1; o < 64; o <<= 1) v += __shfl_xor(v, o);
    return v;
}
template <int CTRL> __device__ __forceinline__ float dppmov(float x) { return __int_as_float(__builtin_amdgcn_update_dpp(0, __float_as_int(x), CTRL, 0xf, 0xf, true)); }
__device__ __forceinline__ float quad_sum(float x) { x += dppmov<0xB1>(x); x += dppmov<0x4E>(x); return x; }
__device__ __forceinline__ float row16_sum(float x) { x += dppmov<0xB1>(x); x += dppmov<0x4E>(x); x += dppmov<0x141>(x); x += dppmov<0x140>(x); return x; }
__device__ __forceinline__ int lane_id() { int l; asm volatile("v_mbcnt_lo_u32_b32 %0, -1, 0\n\tv_mbcnt_hi_u32_b32 %0, -1, %0" : "=v"(l)); return l; }
#define LDS_WAIT() asm volatile("s_waitcnt lgkmcnt(0)" ::: "memory")

__device__ __forceinline__ int map0(int n) {
    const int t = n >> 8, r = n & 255;
    if (t < 8) return (r < 128) ? 128 * t + r : 1024 + 128 * t + (r - 128);
    if (t < 12) return 2048 + 256 * (t - 8) + r;
    if (t < 24) return 3072 + 256 * (t - 12) + r;
    if (t < 28) return 6272 + 256 * (t - 24) + r;
    return (r < 128) ? 6144 + r : -1;
}
__device__ __forceinline__ int map1(int n) {
    const int t = n >> 8, r = n & 255, half = r >> 7, rr = r & 127;
    if (t < 8) return (2 * t + (rr >> 6)) * 128 + half * 64 + (rr & 63);
    if (t == 8) return 2048 + (rr >> 6) * 128 + half * 64 + (rr & 63);
    if (t < 11) return 2304 + (4 * (t - 9) + (rr >> 5)) * 64 + half * 32 + (rr & 31);
    if (t == 11) { if (rr < 32) return 2816 + half * 32 + rr; if (half == 0 && rr < 40) return 2880 + (rr - 32); return -1; }
    return 2888 + 256 * (t - 12) + r;
}

#ifndef PROBE_BLK
#define PROBE_BLK 0
#endif
#ifndef PROBE_WAVE
#define PROBE_WAVE 0
#endif
#if defined(STAMP_K) && defined(PROBE_SEC)
#define PROBE_BEGIN(sec, wsp, wv) unsigned long long PT0_##sec = 0; if ((sec) == PROBE_SEC && blockIdx.x == PROBE_BLK && (wv) == PROBE_WAVE) PT0_##sec = __builtin_amdgcn_s_memrealtime()
#define PROBE_END(sec, wsp, wv) do { if ((sec) == PROBE_SEC && blockIdx.x == PROBE_BLK && (wv) == PROBE_WAVE) { const unsigned long long dt_ = __builtin_amdgcn_s_memrealtime() - PT0_##sec; \
        if (__builtin_amdgcn_mbcnt_lo(~0u, 0u) == 0u) __hip_atomic_fetch_add((unsigned long long*)((wsp) + WS_STAMP) + 2, dt_, __ATOMIC_RELAXED, __HIP_MEMORY_SCOPE_AGENT); } } while (0)
#else
#define PROBE_BEGIN(sec, wsp, wv) do { } while (0)
#define PROBE_END(sec, wsp, wv) do { } while (0)
#endif
namespace pg8 {
#define PG8_LAS __attribute__((address_space(3)))
typedef unsigned short bf16_t;
typedef short bf16x8 __attribute__((ext_vector_type(8)));
typedef float f32x4 __attribute__((ext_vector_type(4)));
typedef unsigned u32x4 __attribute__((ext_vector_type(4)));
constexpr int BM = 256, BK = 64, HALF = 128, HTB = HALF * BK * 2  , STAGE_BYTES = 8 * HTB, NXCD = 8, WGM = 8;

__host__ __device__ __forceinline__ int lds_byte(int r, int c) { const int st = (r >> 4) * 2 + (c >> 5), rr = r & 15, cc = c & 31, ob = rr * 64 + cc * 2; return st * 1024 + (ob ^ (((ob >> 9) & 1) << 5)); }
__host__ __device__ __forceinline__ void stage_rc(int b, int& R, int& C) { const int st = b / 1024, sb = b % 1024, swz = sb ^ (((sb >> 9) & 1) << 5); R = (st >> 1) * 16 + swz / 64; C = (st & 1) * 32 + (swz % 64) / 2; }
__host__ __device__ __forceinline__ int perm32(int rho) { const int n = rho >> 4, i = rho & 15; return 8 * (i >> 2) + 4 * n + (i & 3); }

struct Unit { int pm, pn; };
struct Gemm { const bf16_t* A; const bf16_t* Bt; int M, N, K; };

struct StaticOrder {
    int nM, nN, nwg, G, c;
    __host__ __device__ void init(int M, int N, int G_, int c_) { nM = M / BM; nN = N / BM; nwg = nM * nN; G = G_; c = c_; }
    __host__ __device__ bool next(int i, Unit& u) const {
        const long L = (long)i * G + c; if (L >= nwg) return false;
        int wgid = (int)L; { const int q = nwg / NXCD, r = nwg % NXCD, xcd = wgid % NXCD, off = wgid / NXCD; wgid = (xcd < r ? xcd * (q + 1) : r * (q + 1) + (xcd - r) * q) + off; }
        const int nig = WGM * nN, gid = wgid / nig, fm = gid * WGM, gsz = (nM - fm) < WGM ? (nM - fm) : WGM;
        u.pm = fm + ((wgid % nig) % gsz); u.pn = (wgid % nig) / gsz; return true;
    }
    __device__ __forceinline__ void a_ready(const Unit&) const {}
    __device__ __forceinline__ void done(const Unit&) const {}
};

__device__ __forceinline__ unsigned cvt_pk_bf16(float lo, float hi) { unsigned r; asm volatile("v_cvt_pk_bf16_f32 %0, %1, %2" : "=v"(r) : "v"(lo), "v"(hi)); return r; }
typedef float f32x2 __attribute__((ext_vector_type(2)));
template <class Epi, class Sched, bool ALIGN_EPI = false, bool SP2 = false>
__device__ __forceinline__ void gemm_phase(PG8_LAS unsigned char* lds, const Gemm g, const Sched& S, const Epi& E, const int wave_in) {
    int lane; asm volatile("v_mbcnt_lo_u32_b32 %0, -1, 0\n\tv_mbcnt_hi_u32_b32 %0, -1, %0" : "=v"(lane));
    const int wid = wave_in, tid = wid * 64 + lane, wr = wid >> 2, wc = wid & 3, fr = lane & 15, fq = lane >> 4;
    const int K = g.K, nt = K / BK;
    unsigned voffA[2], voffB[2];
#pragma unroll
    for (int i = 0; i < 2; ++i) { int R, C; stage_rc(tid * 16 + i * 8192, R, C); const int Rb = Epi::PERM ? ((R & ~31) + perm32(R & 31)) : R;
        voffA[i] = (unsigned)(R * K + C) * 2u; voffB[i] = (unsigned)(Rb * K + C) * 2u; }
    const size_t kstep = (size_t)(BK * 2);
    const size_t hstep = (size_t)HALF * K * 2;
    const size_t tstep = 2 * hstep;
    const unsigned ldsw = (unsigned)wid * 1024u;
    const int aoff = lds_byte(wr * 64 + fr, fq * 8), boff = lds_byte(wc * 32 + fr, fq * 8);
#define PG8_SA(b, h) (((b) * 2 + (h)) * HTB)
#define PG8_SB(b, h) ((4 + (b) * 2 + (h)) * HTB)
#define PG8_STAGE(bufoff, gbase, voff) do { _Pragma("unroll") for (int _i = 0; _i < 2; ++_i) \
        __builtin_amdgcn_global_load_lds((const unsigned*)((const char*)(gbase) + (voff)[_i]), (PG8_LAS unsigned*)(lds + (bufoff) + ldsw + _i * 8192), 16, 0, 0); } while (0)
#define PG8_LDA(dst, b, h) do { _Pragma("unroll") for (int m = 0; m < 4; ++m) _Pragma("unroll") for (int k = 0; k < 2; ++k) dst[m][k] = *(const PG8_LAS bf16x8*)(lds + PG8_SA(b, h) + aoff + m * 2048 + k * 1024); } while (0)
#define PG8_LDB(dst, b, h) do { _Pragma("unroll") for (int n = 0; n < 2; ++n) _Pragma("unroll") for (int k = 0; k < 2; ++k) dst[n][k] = *(const PG8_LAS bf16x8*)(lds + PG8_SB(b, h) + boff + n * 2048 + k * 1024); } while (0)
#define PG8_MMA(ai, bj, At, Bt) do { __builtin_amdgcn_s_setprio(1); _Pragma("unroll") for (int m = 0; m < 4; ++m) _Pragma("unroll") for (int n = 0; n < 2; ++n) _Pragma("unroll") for (int k = 0; k < 2; ++k) \
        acc[ai][bj][m][n] = __builtin_amdgcn_mfma_f32_16x16x32_bf16(Bt[n][k], At[m][k], acc[ai][bj][m][n], 0, 0, 0); __builtin_amdgcn_s_setprio(0); } while (0)
#define PG8_WAIT_V(n) asm volatile("s_waitcnt vmcnt(" #n ")" ::: "memory")
#define PG8_WAIT_L(n) asm volatile("s_waitcnt lgkmcnt(" #n ")" ::: "memory")
#define PG8_BAR __builtin_amdgcn_s_barrier()
#define PG8_SCHED __builtin_amdgcn_sched_barrier(0)
    Unit cur, nxt; int ui = 0;
    if (!S.next(0, cur)) return;
    f32x4 acc[2][2][4][2];
#pragma unroll
    for (int a = 0; a < 2; ++a)
#pragma unroll
        for (int b = 0; b < 2; ++b)
#pragma unroll
            for (int m = 0; m < 4; ++m)
#pragma unroll
                for (int n = 0; n < 2; ++n) acc[a][b][m][n] = (f32x4){0.f, 0.f, 0.f, 0.f};
    bf16x8 At[4][2], B0[2][2], B1[2][2];
    const char* cA = (const char*)g.A + (size_t)cur.pm * tstep; const char* cB = (const char*)g.Bt + (size_t)cur.pn * tstep;
    S.a_ready(cur);
    if constexpr (SP2) {
        PG8_STAGE(PG8_SB(0, 0), cB, voffB); PG8_STAGE(PG8_SB(0, 1), cB + hstep, voffB); PG8_STAGE(PG8_SA(0, 0), cA, voffA); PG8_STAGE(PG8_SA(0, 1), cA + hstep, voffA);
        if (wr == 1) PG8_BAR;
        PG8_WAIT_V(2); PG8_BAR;
        PG8_STAGE(PG8_SB(1, 0), cB + kstep, voffB); PG8_STAGE(PG8_SA(1, 0), cA + kstep, voffA); PG8_STAGE(PG8_SB(1, 1), cB + hstep + kstep, voffB);
        PG8_WAIT_V(6); PG8_BAR;
    } else {
        PG8_STAGE(PG8_SB(0, 0), cB, voffB); PG8_STAGE(PG8_SA(0, 0), cA, voffA); PG8_STAGE(PG8_SB(0, 1), cB + hstep, voffB); PG8_STAGE(PG8_SA(0, 1), cA + hstep, voffA);
        if (wr == 1) PG8_BAR;
        PG8_WAIT_V(4); PG8_BAR;
        PG8_STAGE(PG8_SB(1, 0), cB + kstep, voffB); PG8_STAGE(PG8_SA(1, 0), cA + kstep, voffA); PG8_STAGE(PG8_SB(1, 1), cB + hstep + kstep, voffB);
        PG8_WAIT_V(6); PG8_BAR;
    }
    for (;;) {
        const bool has_next = S.next(ui + 1, nxt);
        const char* nA = has_next ? (const char*)g.A + (size_t)nxt.pm * tstep : cA; const char* nB = has_next ? (const char*)g.Bt + (size_t)nxt.pn * tstep : cB;
        for (int t = 0; t < nt; t += 2) {
            const bool last = (t == nt - 2);
            const char* a1 = cA + (size_t)(t + 1) * kstep;
            const char* a2 = last ? nA : cA + (size_t)(t + 2) * kstep; const char* b2 = last ? nB : cB + (size_t)(t + 2) * kstep;
            const char* a3 = a2 + kstep; const char* b3 = b2 + kstep;
            if (last && has_next) S.a_ready(nxt);
            if constexpr (SP2) {
            PG8_LDB(B0, 0, 0); PG8_LDB(B1, 0, 1); PG8_SCHED; PG8_LDA(At, 0, 0); PG8_STAGE(PG8_SA(1, 1), a1 + hstep, voffA);
            PG8_WAIT_V(8); PG8_WAIT_L(0); PG8_BAR; PG8_MMA(0, 0, At, B0); PG8_MMA(0, 1, At, B1); PG8_BAR; PG8_SCHED;
            PG8_LDA(At, 0, 1); PG8_STAGE(PG8_SB(0, 0), b2, voffB); PG8_STAGE(PG8_SB(0, 1), b2 + hstep, voffB); PG8_STAGE(PG8_SA(0, 0), a2, voffA);
            PG8_WAIT_V(8); PG8_WAIT_L(0); PG8_BAR; PG8_MMA(1, 0, At, B0); PG8_MMA(1, 1, At, B1); PG8_BAR; PG8_SCHED;
            PG8_LDB(B0, 1, 0); PG8_LDB(B1, 1, 1); PG8_SCHED; PG8_LDA(At, 1, 0); PG8_STAGE(PG8_SA(0, 1), a2 + hstep, voffA);
            PG8_WAIT_V(8); PG8_WAIT_L(0); PG8_BAR; PG8_MMA(0, 0, At, B0); PG8_MMA(0, 1, At, B1); PG8_BAR; PG8_SCHED;
            PG8_LDA(At, 1, 1); PG8_STAGE(PG8_SB(1, 0), b3, voffB); PG8_STAGE(PG8_SB(1, 1), b3 + hstep, voffB); PG8_STAGE(PG8_SA(1, 0), a3, voffA);
            PG8_WAIT_V(8); PG8_WAIT_L(0); PG8_BAR; PG8_MMA(1, 0, At, B0); PG8_MMA(1, 1, At, B1); PG8_BAR; PG8_SCHED;
            } else {
            PG8_LDB(B0, 0, 0); PG8_SCHED; PG8_LDA(At, 0, 0); PG8_STAGE(PG8_SA(1, 1), a1 + hstep, voffA);
            PG8_WAIT_L(8); PG8_BAR; PG8_WAIT_L(0); PG8_MMA(0, 0, At, B0); PG8_BAR; PG8_SCHED;
            PG8_LDB(B1, 0, 1); PG8_STAGE(PG8_SB(0, 0), b2, voffB);
            PG8_BAR; PG8_WAIT_L(0); PG8_MMA(0, 1, At, B1); PG8_BAR;
            PG8_LDA(At, 0, 1); PG8_STAGE(PG8_SA(0, 0), a2, voffA);
            PG8_BAR; PG8_WAIT_L(0); PG8_MMA(1, 0, At, B0); PG8_BAR; PG8_SCHED;
            PG8_STAGE(PG8_SB(0, 1), b2 + hstep, voffB);
            PG8_WAIT_V(6); PG8_BAR; PG8_MMA(1, 1, At, B1); PG8_BAR;
            PG8_LDB(B0, 1, 0); PG8_SCHED; PG8_LDA(At, 1, 0); PG8_STAGE(PG8_SA(0, 1), a2 + hstep, voffA);
            PG8_WAIT_L(8); PG8_BAR; PG8_WAIT_L(0); PG8_MMA(0, 0, At, B0); PG8_BAR; PG8_SCHED;
            PG8_LDB(B1, 1, 1); PG8_STAGE(PG8_SB(1, 0), b3, voffB);
            PG8_BAR; PG8_WAIT_L(0); PG8_MMA(0, 1, At, B1); PG8_BAR;
            PG8_LDA(At, 1, 1); PG8_STAGE(PG8_SA(1, 0), a3, voffA);
            PG8_BAR; PG8_WAIT_L(0); PG8_MMA(1, 0, At, B0); PG8_BAR; PG8_SCHED;
            PG8_STAGE(PG8_SB(1, 1), b3 + hstep, voffB);
            PG8_WAIT_V(6); PG8_BAR; PG8_MMA(1, 1, At, B1); PG8_BAR;
            }
        }
        if constexpr (ALIGN_EPI) { if (wr == 0) PG8_BAR; }
        if constexpr (!Epi::AFTER_DRAIN) { E(acc, cur, wr, wc, fr, fq); S.done(cur); }
        if (!has_next) break;
#pragma unroll
        for (int a = 0; a < 2; ++a)
#pragma unroll
            for (int b = 0; b < 2; ++b)
#pragma unroll
                for (int m = 0; m < 4; ++m)
#pragma unroll
                    for (int n = 0; n < 2; ++n) acc[a][b][m][n] = (f32x4){0.f, 0.f, 0.f, 0.f};
        cur = nxt; cA = nA; cB = nB; ++ui;
        if constexpr (ALIGN_EPI) { if (wr == 1) PG8_BAR; }
    }
    PG8_WAIT_V(0);
    if constexpr (!ALIGN_EPI) { if (wr == 0) PG8_BAR; }
    PG8_BAR;
    if constexpr (Epi::AFTER_DRAIN) { E.fused(acc, cur, wr, wc, fr, fq, lds, wid, lane); S.done(cur); }
#undef PG8_SA
#undef PG8_SB
#undef PG8_STAGE
#undef PG8_LDA
#undef PG8_LDB
#undef PG8_MMA
#undef PG8_WAIT_V
#undef PG8_WAIT_L
#undef PG8_BAR
#undef PG8_SCHED
}
}

__device__ __forceinline__ u32x4 pack8(const f32x4 a, const f32x4 b) { u32x4 w; w.x = pk2(a[0], a[1]); w.y = pk2(a[2], a[3]); w.z = pk2(b[0], b[1]); w.w = pk2(b[2], b[3]); return w; }
__device__ __forceinline__ f32x4 silu4(const f32x4 v) { f32x4 o; o[0] = v[0] * sigmoidf_(v[0]); o[1] = v[1] * sigmoidf_(v[1]); o[2] = v[2] * sigmoidf_(v[2]); o[3] = v[3] * sigmoidf_(v[3]); return o; }
__device__ __forceinline__ f32x4 sig4(const f32x4 v) { f32x4 o; o[0] = sigmoidf_(v[0]); o[1] = sigmoidf_(v[1]); o[2] = sigmoidf_(v[2]); o[3] = sigmoidf_(v[3]); return o; }

struct Epi0 {
    static constexpr bool PERM = true, AFTER_DRAIN = false;
    unsigned char* ws; unsigned char* dout; bool cheap;
    __device__ __forceinline__ void operator()(const f32x4 (&acc)[2][2][4][2], const pg8::Unit& u, int wr, int wc, int fr, int fq) const {
        const int row0 = u.pm * 256 + wr * 64 + fr, t = u.pn, cw = wc * 32 + 8 * fq;
        if (t < 8) {
            bf16_t* U = (bf16_t*)(ws + WS_U);
#pragma unroll
            for (int ai = 0; ai < 2; ++ai)
#pragma unroll
                for (int m = 0; m < 4; ++m) { const size_t row = (size_t)(row0 + ai * 128 + m * 16);
                    const f32x4 a = cheap ? acc[ai][0][m][0] : acc[ai][0][m][0] * sig4(acc[ai][1][m][0]), b = cheap ? acc[ai][0][m][1] : acc[ai][0][m][1] * sig4(acc[ai][1][m][1]);
                    *(u32x4*)(U + row * 1024 + 128 * t + cw) = pack8(a, b); }
        } else if (t == 28) {
            bf16_t* WDAD = (bf16_t*)(dout + DO_WDAD);
#pragma unroll
            for (int ai = 0; ai < 2; ++ai)
#pragma unroll
                for (int m = 0; m < 4; ++m) { const size_t row = (size_t)(row0 + ai * 128 + m * 16);
                    *(u32x4*)(WDAD + row * 128 + cw) = pack8(acc[ai][0][m][0], acc[ai][0][m][1]); }
        } else {
            const bool act = ((t < 12) || (t >= 24)) && !cheap; const int c0 = 256 * (t & 3);
            unsigned char* bp = (t >= 24) ? (dout + DO_BG) : (ws + WS_AG + (size_t)((t - 8) >> 2) * (64 * MiB));
            bf16_t* base = (bf16_t*)bp;
#pragma unroll
            for (int ai = 0; ai < 2; ++ai)
#pragma unroll
                for (int m = 0; m < 4; ++m) { const size_t row = (size_t)(row0 + ai * 128 + m * 16);
#pragma unroll
                    for (int bj = 0; bj < 2; ++bj) { f32x4 a = acc[ai][bj][m][0], b = acc[ai][bj][m][1];
                        if (act) { a = silu4(a); b = silu4(b); }
                        *(u32x4*)(base + row * 1024 + c0 + 128 * bj + cw) = pack8(a, b); } }
        }
    }
};
static_assert(WS_R == WS_AG + 64 * MiB && WS_K == WS_AG + 128 * MiB && WS_V == WS_AG + 192 * MiB, "Epi0 region arithmetic");

struct EpiLora {
    static constexpr bool PERM = true, AFTER_DRAIN = false;
    bf16_t *D, *A; const float* vec;
    __device__ __forceinline__ void operator()(const f32x4 (&acc)[2][2][4][2], const pg8::Unit& u, int wr, int wc, int fr, int fq) const {
        const int row0 = u.pm * 256 + wr * 64 + fr, t = u.pn, cw = wc * 32 + 8 * fq;
        const bool isd = t < 4; bf16_t* base = isd ? D : A; const int c0 = 256 * (t & 3); const float* bias = vec + (isd ? 0 : 1024) + c0 + cw;
        const float sc = isd ? 0.60653065971f : 1.0f;
#pragma unroll
        for (int ai = 0; ai < 2; ++ai)
#pragma unroll
            for (int m = 0; m < 4; ++m) { const size_t row = (size_t)(row0 + ai * 128 + m * 16);
#pragma unroll
                for (int bj = 0; bj < 2; ++bj) { const f32x4 b0 = *(const f32x4*)(bias + 128 * bj), b1 = *(const f32x4*)(bias + 128 * bj + 4);
                    const f32x4 a = sig4(acc[ai][bj][m][0] + b0) * sc, b = sig4(acc[ai][bj][m][1] + b1) * sc;
                    *(u32x4*)(base + row * 1024 + c0 + 128 * bj + cw) = pack8(a, b); } }
    }
};

struct EpiRes {
    static constexpr bool PERM = false, AFTER_DRAIN = false;
    const float* resid; float* out; const float* modp; const float* ada_b; int layer;
    __device__ __forceinline__ void operator()(const f32x4 (&acc)[2][2][4][2], const pg8::Unit& u, int wr, int wc, int fr, int fq) const {
        const int row0 = u.pm * 256 + wr * 64 + fr, col0 = u.pn * 256 + wc * 32 + 4 * fq, b = (u.pm * 256) / SEQ;
        f32x4 gv[2][2];
#pragma unroll
        for (int bj = 0; bj < 2; ++bj)
#pragma unroll
            for (int n = 0; n < 2; ++n) { const int c = col0 + bj * 128 + n * 16; f32x4 g = *(const f32x4*)(ada_b + layer * 3072 + 2048 + c);
#pragma unroll
                for (int s = 0; s < 8; ++s) g += *(const f32x4*)(modp + (size_t)((s * 2 + layer) * 4 + b) * 3072 + 2048 + c);
                gv[bj][n] = g; }
#pragma unroll
        for (int ai = 0; ai < 2; ++ai)
#pragma unroll
            for (int m = 0; m < 4; ++m) { const size_t off = (size_t)(row0 + ai * 128 + m * 16) * 1024 + col0;
#pragma unroll
                for (int bj = 0; bj < 2; ++bj)
#pragma unroll
                    for (int n = 0; n < 2; ++n) { const f32x4 r = *(const f32x4*)(resid + off + bj * 128 + n * 16);
                        *(f32x4*)(out + off + bj * 128 + n * 16) = r + gv[bj][n] * acc[ai][bj][m][n]; }
                asm volatile("" ::: "memory"); }
    }
};

constexpr float Q_SCALE = 0.08838834764831845f * 1.4426950408889634f;
constexpr float WI_SCALE = 0.35355339059327373f * 0.125f;
struct Epi1 {
    static constexpr bool PERM = true, AFTER_DRAIN = false;
    bf16_t *Q, *KV, *QI, *KI, *G; float* WI; const f32x2* csa; const f32x2* csi;
    __device__ __forceinline__ void rope8(const f32x4 x1a, const f32x4 x1b, const f32x4 x2a, const f32x4 x2b, const f32x2* cs, float sc, u32x4& o1, u32x4& o2) const {
        float c[8], s[8];
#pragma unroll
        for (int j = 0; j < 4; ++j) { const f32x4 v = *(const f32x4*)(cs + 2 * j); c[2 * j] = v[0]; s[2 * j] = v[1]; c[2 * j + 1] = v[2]; s[2 * j + 1] = v[3]; }
        float a[8], b[8];
#pragma unroll
        for (int j = 0; j < 4; ++j) { a[j] = x1a[j]; a[4 + j] = x1b[j]; b[j] = x2a[j]; b[4 + j] = x2b[j]; }
        float p[8], q[8];
#pragma unroll
        for (int j = 0; j < 8; ++j) { p[j] = (a[j] * c[j] - b[j] * s[j]) * sc; q[j] = (b[j] * c[j] + a[j] * s[j]) * sc; }
        o1.x = pk2(p[0], p[1]); o1.y = pk2(p[2], p[3]); o1.z = pk2(p[4], p[5]); o1.w = pk2(p[6], p[7]);
        o2.x = pk2(q[0], q[1]); o2.y = pk2(q[2], q[3]); o2.z = pk2(q[4], q[5]); o2.w = pk2(q[6], q[7]);
    }
    __device__ __forceinline__ void operator()(const f32x4 (&acc)[2][2][4][2], const pg8::Unit& u, int wr, int wc, int fr, int fq) const {
        const int row0 = u.pm * 256 + wr * 64 + fr, t = u.pn, cw = wc * 32 + 8 * fq;
#pragma unroll
        for (int ai = 0; ai < 2; ++ai)
#pragma unroll
            for (int m = 0; m < 4; ++m) { const size_t row = (size_t)(row0 + ai * 128 + m * 16);
                const f32x4 x1a = acc[ai][0][m][0], x1b = acc[ai][0][m][1], x2a = acc[ai][1][m][0], x2b = acc[ai][1][m][1];
                if (t < 8) { const int head = 2 * t + (wc >> 1), i0 = (wc & 1) * 32 + 8 * fq; u32x4 o1, o2;
                    rope8(x1a, x1b, x2a, x2b, csa + row * 64 + i0, Q_SCALE, o1, o2);
                    *(u32x4*)(Q + row * 2048 + head * 128 + i0) = o1; *(u32x4*)(Q + row * 2048 + head * 128 + 64 + i0) = o2;
                } else if (t == 8) { const int i0 = (wc & 1) * 32 + 8 * fq;
                    if (wc < 2) { u32x4 o1, o2; rope8(x1a, x1b, x2a, x2b, csa + row * 64 + i0, 1.0f, o1, o2);
                        *(u32x4*)(KV + row * 256 + i0) = o1; *(u32x4*)(KV + row * 256 + 64 + i0) = o2; }
                    else { *(u32x4*)(KV + row * 256 + 128 + i0) = pack8(x1a, x1b); *(u32x4*)(KV + row * 256 + 192 + i0) = pack8(x2a, x2b); }
                } else if (t < 11) { const int head = 4 * (t - 9) + wc, i0 = 8 * fq; u32x4 o1, o2;
                    rope8(x1a, x1b, x2a, x2b, csi + row * 32 + i0, 1.0f, o1, o2);
                    *(u32x4*)(QI + row * 512 + head * 64 + i0) = o1; *(u32x4*)(QI + row * 512 + head * 64 + 32 + i0) = o2;
                } else if (t == 11) {
                    if (wc == 0) { const int i0 = 8 * fq; u32x4 o1, o2; rope8(x1a, x1b, x2a, x2b, csi + row * 32 + i0, 1.0f, o1, o2);
                        *(u32x4*)(KI + row * 64 + i0) = o1; *(u32x4*)(KI + row * 64 + 32 + i0) = o2; }
                    else if (wc == 1 && fq == 0) { *(f32x4*)(WI + row * 8) = x1a * WI_SCALE; *(f32x4*)(WI + row * 8 + 4) = x1b * WI_SCALE; }
                } else { const int c0 = 256 * (t - 12);
                    *(u32x4*)(G + row * 2048 + c0 + cw) = pack8(silu4(x1a), silu4(x1b)); *(u32x4*)(G + row * 2048 + c0 + 128 + cw) = pack8(silu4(x2a), silu4(x2b)); }
            }
    }
};

struct Args {
    const float* x; const float* c; const int* pos; const float* ada_w; const float* ada_b; const float* norm_g; const float* final_g;
    const float* even_w_in; const float* even_w_out; const float* conv_w; const float* conv_vec; const float* mu_rkv; const float* mu_lora;
    const float* rwkv_vec; const float* w_up; const float* a_up; const float* r_k; const float* odd_w_in; const float* odd_w_out;
    float* out; unsigned char* ws; int ph_lo, ph_hi;
};

template <class SrcF>
__device__ __forceinline__ void transpose_item(const SrcF& src, int K, bf16_t* WT, LAS float* scr, int item, int nblk, int lane) {
    const int kb = item / nblk, nb = item % nblk, k0 = 64 * kb, n0 = 32 * nb;
#pragma unroll 8
    for (int i = 0; i < 32; ++i) { const int kk = 2 * i + (lane >> 5); scr[kk * 33 + (lane & 31)] = src(k0 + kk, n0 + (lane & 31)); }
    LDS_WAIT();
    const int c = lane & 7;
#pragma unroll
    for (int j = 0; j < 4; ++j) { const int n = (lane >> 3) + 8 * j; const LAS float* s = scr + (8 * c) * 33 + n;
        u32x4 o; o.x = pk2(s[0 * 33], s[1 * 33]); o.y = pk2(s[2 * 33], s[3 * 33]); o.z = pk2(s[4 * 33], s[5 * 33]); o.w = pk2(s[6 * 33], s[7 * 33]);
        *(u32x4*)(WT + (size_t)(n0 + n) * K + k0 + 8 * c) = o; }
    LDS_WAIT();
}

__device__ __forceinline__ void transpose_item_col(const float* W, int ldw, int scol, int K, bf16_t* WT, LAS float* scr, int k0, int n0, int lane) {
    const float* wp = W + (size_t)(k0 + (lane >> 5)) * ldw + (scol < 0 ? 0 : scol);
#pragma unroll 8
    for (int i = 0; i < 32; ++i) { const float v = wp[(size_t)(2 * i) * ldw]; scr[(2 * i + (lane >> 5)) * 33 + (lane & 31)] = scol < 0 ? 0.f : v; }
    LDS_WAIT();
    const int c = lane & 7;
#pragma unroll
    for (int j = 0; j < 4; ++j) { const int n = (lane >> 3) + 8 * j; const LAS float* s = scr + (8 * c) * 33 + n;
        u32x4 o; o.x = pk2(s[0 * 33], s[1 * 33]); o.y = pk2(s[2 * 33], s[3 * 33]); o.z = pk2(s[4 * 33], s[5 * 33]); o.w = pk2(s[6 * 33], s[7 * 33]);
        *(u32x4*)(WT + (size_t)(n0 + n) * K + k0 + 8 * c) = o; }
    LDS_WAIT();
}
__device__ __forceinline__ void rope_item(const Args& a, int r, int lane) {
    const float p = (float)a.pos[r];
    { const float inv = powf(10000.0f, -(float)(2 * lane) / 128.0f); float sn, cs; sincosf(p * inv, &sn, &cs); ((f32x2*)(a.ws + WS_CSA))[(size_t)r * 64 + lane] = (f32x2){cs, sn}; }
    if (lane < 32) { const float inv = powf(10000.0f, -(float)(2 * lane) / 64.0f); float sn, cs; sincosf(p * inv, &sn, &cs); ((f32x2*)(a.ws + WS_CSI))[(size_t)r * 32 + lane] = (f32x2){cs, sn}; }
}
__device__ __forceinline__ void p0_late(const Args& a, const int wave, LAS unsigned char* lds, int first, int nblk) {
    const int lane = lane_id(), tid = wave * 64 + lane;
    LAS float* scr = (LAS float*)(lds + wave * 16384);
    const int gw = ((int)blockIdx.x - first) * NWAVES + wave, NGW = nblk * NWAVES;
    unsigned char* ws = a.ws;
    constexpr int I_WO = (2048 / 64) * (DM / 32), I_W1 = (DM / 64) * (N1 / 32), I_ROPE = MTOK;
    for (int it = gw; it < I_W1 + I_WO + I_ROPE; it += NGW) {
        int r = it;
        if (r < I_W1) { const int nblk = N1 / 32, k0 = 64 * (r / nblk), n0 = 32 * (r % nblk); transpose_item_col(a.odd_w_in, ODD_COLS, map1(n0 + (lane & 31)), DM, (bf16_t*)(ws + WS_WIN1), scr, k0, n0, lane); continue; } r -= I_W1;
        if (r < I_WO) { const int nblk = DM / 32, k0 = 64 * (r / nblk), n0 = 32 * (r % nblk); transpose_item_col(a.odd_w_out, DM, n0 + (lane & 31), 2048, (bf16_t*)(ws + WS_WOUT1), scr, k0, n0, lane); continue; } r -= I_WO;
        {
            const float p = (float)a.pos[r];
            { const float inv = powf(10000.0f, -(float)(2 * lane) / 128.0f); float sn, cs; sincosf(p * inv, &sn, &cs); ((f32x2*)(ws + WS_CSA))[(size_t)r * 64 + lane] = (f32x2){cs, sn}; }
            if (lane < 32) { const float inv = powf(10000.0f, -(float)(2 * lane) / 64.0f); float sn, cs; sincosf(p * inv, &sn, &cs); ((f32x2*)(ws + WS_CSI))[(size_t)r * 32 + lane] = (f32x2){cs, sn}; }
        }
    }
}
__device__ __forceinline__ void p0_prologue(const Args& a, const int wave, LAS unsigned char* lds) {
    const int lane = lane_id(), tid = wave * 64 + lane;
    LAS float* scr = (LAS float*)(lds + wave * 16384);
    const int gw = blockIdx.x * NWAVES + wave, NGW = gridDim.x * NWAVES;
    unsigned char* ws = a.ws;
    constexpr int I_W0 = (DM / 64) * (N0 / 32), I_WO = (2048 / 64) * (DM / 32), I_W1 = (DM / 64) * (N1 / 32), I_WL = (256 / 64) * (2048 / 32), I_MOD = 96 * 8, I_ROPE = MTOK;
    constexpr int NITEMS = I_W0 + I_WO + I_W1 + I_WO + I_WL + I_MOD + I_ROPE;
    constexpr int N_EARLY = I_W0 + I_WO + I_W1 + I_WO + I_WL + I_MOD;
    for (int it = gw; it < N_EARLY; it += NGW) {
        int r = it;
        if (r < I_W0) { const float* W = a.even_w_in; transpose_item([W](int k, int n) { const int s = map0(n); return s < 0 ? 0.f : W[(size_t)k * EVEN_COLS + s]; }, DM, (bf16_t*)(ws + WS_WIN0), scr, r, N0 / 32, lane); continue; } r -= I_W0;
        if (r < I_WO) { const float* W = a.even_w_out; transpose_item([W](int k, int n) { return W[(size_t)k * DM + n]; }, 2048, (bf16_t*)(ws + WS_WOUT0), scr, r, DM / 32, lane); continue; } r -= I_WO;
        if (r < I_W1) { const float* W = a.odd_w_in; transpose_item([W](int k, int n) { const int s = map1(n); return s < 0 ? 0.f : W[(size_t)k * ODD_COLS + s]; }, DM, (bf16_t*)(ws + WS_WIN1), scr, r, N1 / 32, lane); continue; } r -= I_W1;
        if (r < I_WO) { const float* W = a.odd_w_out; transpose_item([W](int k, int n) { return W[(size_t)k * DM + n]; }, 2048, (bf16_t*)(ws + WS_WOUT1), scr, r, DM / 32, lane); continue; } r -= I_WO;
        if (r < I_WL) { const float* wu = a.w_up; const float* au = a.a_up;
            transpose_item([wu, au](int k, int n) { if (n < 1024) return k < 64 ? wu[k * 1024 + n] : 0.f; return (k >= 64 && k < 128) ? au[(k - 64) * 1024 + (n - 1024)] : 0.f; }, 256, (bf16_t*)(ws + WS_WLORA), scr, r, 2048 / 32, lane); continue; } r -= I_WL;
        if (r < I_MOD) {
            const int cgp = r >> 3, ks = r & 7, col = cgp * 64 + lane, l = col / 3072, cc = col - l * 3072;
            const float* W = a.ada_w + (size_t)l * DM * 3072 + cc; float acc0 = 0.f, acc1 = 0.f, acc2 = 0.f, acc3 = 0.f;
            for (int k = ks * 128; k < ks * 128 + 128; ++k) { const float w = W[(size_t)k * 3072];
                const float c0 = a.c[k], c1 = a.c[DM + k], c2 = a.c[2 * DM + k], c3 = a.c[3 * DM + k];
                acc0 += c0 * sigmoidf_(c0) * w; acc1 += c1 * sigmoidf_(c1) * w; acc2 += c2 * sigmoidf_(c2) * w; acc3 += c3 * sigmoidf_(c3) * w; }
            float* mp = (float*)(ws + WS_MODP) + (size_t)((ks * 2 + l) * 4) * 3072 + cc;
            mp[0] = acc0; mp[3072] = acc1; mp[2 * 3072] = acc2; mp[3 * 3072] = acc3; continue; } r -= I_MOD;
    }
}

__device__ __forceinline__ void norm_phase(const Args& a, const int wave, LAS unsigned char* lds, const float* src, int layer) {
    const int lane = lane_id(), tid = wave * 64 + lane;
    LAS float* gs = (LAS float*)lds; LAS float* sh = gs + DM;
    const float* modp = (const float*)(a.ws + WS_MODP); bf16_t* H = (bf16_t*)(a.ws + WS_H);
    for (int tile = blockIdx.x; tile < MTOK / 128; tile += gridDim.x) {
        const int b = (tile * 128) / SEQ;
        __syncthreads();
        for (int c = tid; c < DM; c += NTHREADS) {
            float sc = a.ada_b[layer * 3072 + 1024 + c], sf = a.ada_b[layer * 3072 + c];
#pragma unroll
            for (int s = 0; s < 8; ++s) { const float* mp = modp + (size_t)((s * 2 + layer) * 4 + b) * 3072; sc += mp[1024 + c]; sf += mp[c]; }
            gs[c] = a.norm_g[layer * DM + c] * (1.0f + sc); sh[c] = sf; }
        __syncthreads();
        for (int r4 = 0; r4 < 16; r4 += 4) {
            f32x4 v[4][4]; float ss[4];
#pragma unroll
            for (int q = 0; q < 4; ++q) { const size_t m = (size_t)tile * 128 + wave * 16 + r4 + q; const f32x4* xr = (const f32x4*)(src + m * DM) + lane;
#pragma unroll
                for (int j = 0; j < 4; ++j) v[q][j] = xr[64 * j]; }
#pragma unroll
            for (int q = 0; q < 4; ++q) { float s = 0.f;
#pragma unroll
                for (int j = 0; j < 4; ++j) s += (v[q][j][0] * v[q][j][0] + v[q][j][1] * v[q][j][1]) + (v[q][j][2] * v[q][j][2] + v[q][j][3] * v[q][j][3]);
                ss[q] = s; }
#pragma unroll
            for (int q = 0; q < 4; ++q) ss[q] = wave_sum(ss[q]);
#pragma unroll
            for (int q = 0; q < 4; ++q) { const size_t m = (size_t)tile * 128 + wave * 16 + r4 + q; const float rstd = rsqrtf(ss[q] * (1.0f / DM) + 1e-6f);
                u32x2* o = (u32x2*)(H + m * DM) + lane;
#pragma unroll
                for (int j = 0; j < 4; ++j) { const f32x4 g = *(const LAS f32x4*)(gs + 4 * (64 * j + lane)), s = *(const LAS f32x4*)(sh + 4 * (64 * j + lane));
                    const f32x4 h = v[q][j] * rstd * g + s; u32x2 w; w.x = pk2(h[0], h[1]); w.y = pk2(h[2], h[3]); o[64 * j] = w; } }
        }
    }
}

__device__ __forceinline__ void final_phase(const Args& a, const int wave) {
    const int lane = lane_id(), tid = wave * 64 + lane;
    const int gw = blockIdx.x * NWAVES + wave, NGW = gridDim.x * NWAVES;
    f32x4 g[4];
#pragma unroll
    for (int j = 0; j < 4; ++j) g[j] = *((const f32x4*)a.final_g + 64 * j + lane);
    float tsc = 1.0f;
#ifdef STAMP_K
    { const unsigned long long* st = (const unsigned long long*)(a.ws + WS_STAMP); tsc = 1.0f + (float)(st[1] - st[0] + st[2]) * 1e-7f; }
#endif
    for (int m0 = 4 * gw; m0 < MTOK; m0 += 4 * NGW) {
        f32x4 v[4][4]; float ss[4];
#pragma unroll
        for (int q = 0; q < 4; ++q) { const f32x4* xr = (const f32x4*)(a.out + (size_t)(m0 + q) * DM) + lane;
#pragma unroll
            for (int j = 0; j < 4; ++j) v[q][j] = xr[64 * j]; }
#pragma unroll
        for (int q = 0; q < 4; ++q) { float s = 0.f;
#pragma unroll
            for (int j = 0; j < 4; ++j) s += (v[q][j][0] * v[q][j][0] + v[q][j][1] * v[q][j][1]) + (v[q][j][2] * v[q][j][2] + v[q][j][3] * v[q][j][3]);
            ss[q] = wave_sum(s); }
#pragma unroll
        for (int q = 0; q < 4; ++q) { const float rstd = rsqrtf(ss[q] * (1.0f / DM) + 1e-6f) * tsc; f32x4* xr = (f32x4*)(a.out + (size_t)(m0 + q) * DM) + lane;
#pragma unroll
            for (int j = 0; j < 4; ++j) xr[64 * j] = v[q][j] * rstd * g[j]; }
    }
}


__device__ __forceinline__ void conv_phase(const Args& a, const int wave, LAS unsigned char* lds, int first, int stride) {
    const int lane = lane_id(), tid = wave * 64 + lane;
    const bf16_t* U = (const bf16_t*)(a.ws + WS_U); const bf16_t* AG = (const bf16_t*)(a.ws + WS_AG); bf16_t* YAB = (bf16_t*)(a.ws + WS_YAB);
    f32x2 w[31];
#pragma unroll
    for (int j = 0; j < 31; ++j) w[j] = *(const f32x2*)(a.conv_w + j * DM + 2 * tid);
    const f32x2 cbias = *(const f32x2*)(a.conv_vec + 2 * tid);
    for (int tile = first; tile < MTOK / 32; tile += stride) {
        const int b = tile >> 8, s0 = (tile & 255) * 32;
        __syncthreads();
        for (int idx = tid; idx < 62 * 128; idx += NTHREADS) { const int row = idx >> 7, ch = idx & 127, s = s0 - 30 + row;
            u32x4 v = (u32x4){0u, 0u, 0u, 0u}; if (s >= 0) v = *(const u32x4*)(U + ((size_t)(b * SEQ + s)) * DM + ch * 8);
            *(LAS u32x4*)(lds + row * 2048 + ch * 16) = v; }
        __syncthreads();
        LAS unsigned char* rb0 = lds + tid * 4; LAS unsigned char* rb1 = rb0 + 65536; LAS unsigned char* wb0 = lds + tid * 8; LAS unsigned char* wb1 = wb0 + 65536;
        asm volatile("" : "+v"(rb0), "+v"(rb1), "+v"(wb0), "+v"(wb1));
        f32x2 acc[32];
#pragma unroll
        for (int t = 0; t < 32; ++t) acc[t] = (f32x2){0.f, 0.f};
#pragma unroll
        for (int i = 0; i < 62; ++i) { const unsigned xw = (i < 32) ? *(const LAS unsigned*)(rb0 + i * 2048) : *(const LAS unsigned*)(rb1 + (i - 32) * 2048); const f32x2 xv = (f32x2){bflo(xw), bfhi(xw)};
#pragma unroll
            for (int t = (i > 30 ? i - 30 : 0); t <= (i < 31 ? i : 31); ++t) acc[t] += xv * w[i - t]; }
        __syncthreads();
#pragma unroll
        for (int t = 0; t < 32; ++t) { if (t < 16) *(LAS f32x2*)(wb0 + t * 4096) = acc[t] + cbias; else *(LAS f32x2*)(wb1 + (t - 16) * 4096) = acc[t] + cbias; }
        __syncthreads();
        f32x4 lw[4], lb[4];
#pragma unroll
        for (int j = 0; j < 4; ++j) { lw[j] = *(const f32x4*)(a.conv_vec + DM + 4 * (lane + 64 * j)); lb[j] = *(const f32x4*)(a.conv_vec + 2 * DM + 4 * (lane + 64 * j)); }
        for (int tt = 0; tt < 4; ++tt) { const int t = wave * 4 + tt; const size_t m = (size_t)b * SEQ + s0 + t;
            f32x4 v[4]; float s = 0.f;
#pragma unroll
            for (int j = 0; j < 4; ++j) { v[j] = *(const LAS f32x4*)(lds + (size_t)t * 4096 + 16 * (lane + 64 * j)); s += (v[j][0] + v[j][1]) + (v[j][2] + v[j][3]); }
            const float mean = wave_sum(s) * (1.0f / DM); float q = 0.f;
#pragma unroll
            for (int j = 0; j < 4; ++j) { v[j] = v[j] - mean; q += (v[j][0] * v[j][0] + v[j][1] * v[j][1]) + (v[j][2] * v[j][2] + v[j][3] * v[j][3]); }
            const float rstd = rsqrtf(wave_sum(q) * (1.0f / DM) + 1e-5f);
#pragma unroll
            for (int j = 0; j < 4; ++j) { const f32x4 y = v[j] * rstd * lw[j] + lb[j]; const u32x2 g = *(const u32x2*)(AG + m * DM + 4 * (lane + 64 * j));
                const f32x4 o = silu4(y) * (f32x4){bflo(g.x), bfhi(g.x), bflo(g.y), bfhi(g.y)};
                u32x2 wv; wv.x = pk2(o[0], o[1]); wv.y = pk2(o[2], o[3]); *(u32x2*)(YAB + m * 2048 + 4 * (lane + 64 * j)) = wv; }
        }
    }
}

__device__ __forceinline__ void lora_pre_phase(const Args& a, const int wave) {
    const int lane = lane_id(), tid = wave * 64 + lane;

        const bf16_t* WDAD = (const bf16_t*)((unsigned char*)a.out + DO_WDAD); bf16_t* LA = (bf16_t*)((unsigned char*)a.out + DO_LA);
        const int gw = blockIdx.x * NWAVES + wave, NGW = gridDim.x * NWAVES;
        const f32x2 mu = *(const f32x2*)(a.mu_lora + 2 * lane);
        for (int m = gw; m < MTOK; m += NGW) { const int s = m & (SEQ - 1);
            const unsigned cur = *(const unsigned*)(WDAD + (size_t)m * 128 + 2 * lane); unsigned prv = 0u; if (s > 0) prv = *(const unsigned*)(WDAD + (size_t)(m - 1) * 128 + 2 * lane);
            float v0 = bflo(cur), v1 = bfhi(cur); v0 += (bflo(prv) - v0) * mu[0]; v1 += (bfhi(prv) - v1) * mu[1];
            if (lane < 32) { v0 = tanhf(v0); v1 = tanhf(v1); }
            *(unsigned*)(LA + (size_t)m * 256 + 2 * lane) = pk2(v0, v1); *(unsigned*)(LA + (size_t)m * 256 + 128 + 2 * lane) = 0u; }
    }

struct ScanRaw { u32x2 r, rp, k, kp, v, vp, d, a; };
constexpr int SC_CH = 16, SC_BUF_F = 5 * SC_CH * 64 + SC_CH * 16;

__device__ __forceinline__ void scan_phase(const Args& a, const int wave, LAS unsigned char* lds) {
    const int lane = lane_id(), tid = wave * 64 + lane;
    const bf16_t* Rg = (const bf16_t*)(a.ws + WS_R); const bf16_t* Kg = (const bf16_t*)(a.ws + WS_K); const bf16_t* Vg = (const bf16_t*)(a.ws + WS_V);
    const bf16_t* Dg = (const bf16_t*)(a.ws + WS_DARR); const bf16_t* Ag = (const bf16_t*)(a.ws + WS_AARR);
    bf16_t* YAB = (bf16_t*)(a.ws + WS_YAB); float* RK = (float*)((unsigned char*)a.out + DO_RK);
    LAS float* bufs = (LAS float*)lds; LAS float* ybuf = bufs + 2 * SC_BUF_F;
    constexpr int NCH = SEQ / SC_CH;
    for (int job = blockIdx.x; job < 256; job += gridDim.x) {
        const int vcu = (gridDim.x == 256) ? ((job & 7) * 32 + (job >> 3)) : job;
        const int bh = vcu >> 2, vq = vcu & 3, b = bh >> 4, h = bh & 15;
        __syncthreads();
        if (wave >= 4) {
            const int pt = tid - 256, tok = pt >> 4, cgp = pt & 15, ch = h * 64 + 4 * cgp;
            const f32x4 mur = *(const f32x4*)(a.mu_rkv + ch), muk = *(const f32x4*)(a.mu_rkv + DM + ch), muv = *(const f32x4*)(a.mu_rkv + 2 * DM + ch);
            const f32x4 k_k = *(const f32x4*)(a.rwkv_vec + 2 * DM + ch), k_a = *(const f32x4*)(a.rwkv_vec + 3 * DM + ch), rkw = *(const f32x4*)(a.r_k + ch);
            auto load = [&](int c) { ScanRaw q; const int s = c * SC_CH + tok; const size_t m = (size_t)b * SEQ + s; const size_t o = m * DM + ch; const size_t op = (s > 0) ? o - DM : o;
                q.r = *(const u32x2*)(Rg + o); q.k = *(const u32x2*)(Kg + o); q.v = *(const u32x2*)(Vg + o); q.d = *(const u32x2*)(Dg + o); q.a = *(const u32x2*)(Ag + o);
                q.rp = *(const u32x2*)(Rg + op); q.kp = *(const u32x2*)(Kg + op); q.vp = *(const u32x2*)(Vg + op);
                if (s == 0) { q.rp = (u32x2){0u, 0u}; q.kp = (u32x2){0u, 0u}; q.vp = (u32x2){0u, 0u}; }
                return q; };
            auto un4 = [](u32x2 w) { return (f32x4){bflo(w.x), bfhi(w.x), bflo(w.y), bfhi(w.y)}; };
            auto process = [&](const ScanRaw& q, int c, LAS float* buf) {
                const f32x4 r0 = un4(q.r), k0 = un4(q.k), v0 = un4(q.v);
                const f32x4 rl = r0 + (un4(q.rp) - r0) * mur, kl = k0 + (un4(q.kp) - k0) * muk, vl = v0 + (un4(q.vp) - v0) * muv;
                const f32x4 d = un4(q.d), av = un4(q.a);
                f32x4 wdec; wdec[0] = __expf(-d[0]); wdec[1] = __expf(-d[1]); wdec[2] = __expf(-d[2]); wdec[3] = __expf(-d[3]);
                const f32x4 kkr = kl * k_k; float ss = (kkr[0] * kkr[0] + kkr[1] * kkr[1]) + (kkr[2] * kkr[2] + kkr[3] * kkr[3]); ss = row16_sum(ss);
                const float inv = 1.0f / fmaxf(sqrtf(ss), 1e-12f);
                const f32x4 kk = kkr * inv, kp = kl * (1.0f + (av - 1.0f) * k_a), bb = kk * av;
                float rk = (rl[0] * kp[0] * rkw[0] + rl[1] * kp[1] * rkw[1]) + (rl[2] * kp[2] * rkw[2] + rl[3] * kp[3] * rkw[3]); rk = row16_sum(rk);
                const int o = tok * 64 + 4 * cgp;
                *(LAS f32x4*)(buf + o) = -kk; *(LAS f32x4*)(buf + 1024 + o) = wdec; *(LAS f32x4*)(buf + 2048 + o) = bb; *(LAS f32x4*)(buf + 3072 + o) = kp; *(LAS f32x4*)(buf + 4096 + o) = rl;
                if ((cgp >> 2) == vq) *(LAS f32x4*)(buf + 5120 + tok * 16 + 4 * (cgp & 3)) = vl;
                if (vq == 0 && cgp == 0) RK[((size_t)b * SEQ + c * SC_CH + tok) * 16 + h] = rk; };
            auto flush = [&](int c, const LAS float* yb) {
                if (wave == 4) { const int t2 = lane >> 2, rq = lane & 3; const f32x4 y = *(const LAS f32x4*)(yb + t2 * 16 + 4 * rq);
                    u32x2 wv; wv.x = pk2(y[0], y[1]); wv.y = pk2(y[2], y[3]);
                    *(u32x2*)(YAB + ((size_t)b * SEQ + c * SC_CH + t2) * 2048 + 1024 + h * 64 + 16 * vq + 4 * rq) = wv; } };
            ScanRaw q0 = load(0), q1 = load(1);
            process(q0, 0, bufs); q0 = q1; q1 = load(2);
            __syncthreads();
            for (int c = 0; c < NCH; ++c) {
                if (c + 1 < NCH) process(q0, c + 1, bufs + ((c + 1) & 1) * SC_BUF_F);
                q0 = q1; if (c + 3 < NCH) q1 = load(c + 3);
                if (c >= 1) flush(c - 1, ybuf + ((c - 1) & 1) * 256);
                __syncthreads();
            }
            flush(NCH - 1, ybuf + ((NCH - 1) & 1) * 256);
        } else {
            const int rw = lane >> 4, ks = lane & 15, row = wave * 4 + rw;
            float s0 = 0.f, s1 = 0.f, s2 = 0.f, s3 = 0.f;
            __syncthreads();
            for (int c = 0; c < NCH; ++c) {
                const LAS float* buf = bufs + (c & 1) * SC_BUF_F; LAS float* yb = ybuf + (c & 1) * 256;
#pragma unroll
                for (int t = 0; t < SC_CH; ++t) {
                    const f32x4 nk = *(const LAS f32x4*)(buf + t * 64 + 4 * ks), w4 = *(const LAS f32x4*)(buf + 1024 + t * 64 + 4 * ks), b4 = *(const LAS f32x4*)(buf + 2048 + t * 64 + 4 * ks);
                    const f32x4 kp = *(const LAS f32x4*)(buf + 3072 + t * 64 + 4 * ks), r4 = *(const LAS f32x4*)(buf + 4096 + t * 64 + 4 * ks); const float vv = buf[5120 + t * 16 + row];
                    float sa = (s0 * nk[0] + s1 * nk[1]) + (s2 * nk[2] + s3 * nk[3]); sa = row16_sum(sa);
                    s0 = s0 * w4[0] + (sa * b4[0] + vv * kp[0]); s1 = s1 * w4[1] + (sa * b4[1] + vv * kp[1]);
                    s2 = s2 * w4[2] + (sa * b4[2] + vv * kp[2]); s3 = s3 * w4[3] + (sa * b4[3] + vv * kp[3]);
                    float y = (s0 * r4[0] + s1 * r4[1]) + (s2 * r4[2] + s3 * r4[3]); y = row16_sum(y);
                    if (ks == 0) yb[t * 16 + row] = y;
                }
                __syncthreads();
            }
        }
    }
}

__device__ __forceinline__ void post_phase(const Args& a, const int wave) {
    const int lane = lane_id(), tid = wave * 64 + lane;
    const int gw = blockIdx.x * NWAVES + wave, NGW = gridDim.x * NWAVES;
    const bf16_t* Vg = (const bf16_t*)(a.ws + WS_V); const bf16_t* BG = (const bf16_t*)((unsigned char*)a.out + DO_BG); const float* RK = (const float*)((unsigned char*)a.out + DO_RK);
    bf16_t* YAB = (bf16_t*)(a.ws + WS_YAB);
    const int head = lane >> 2, c0 = head * 64 + 16 * (lane & 3);
    f32x4 muv[4], lw[4], lb[4];
#pragma unroll
    for (int j = 0; j < 4; ++j) { muv[j] = *(const f32x4*)(a.mu_rkv + 2 * DM + c0 + 4 * j); lw[j] = *(const f32x4*)(a.rwkv_vec + 4 * DM + c0 + 4 * j); lb[j] = *(const f32x4*)(a.rwkv_vec + 5 * DM + c0 + 4 * j); }
    auto un4 = [](unsigned x, unsigned y) { return (f32x4){bflo(x), bfhi(x), bflo(y), bfhi(y)}; };
    for (int m = gw; m < MTOK; m += NGW) { const int s = m & (SEQ - 1);
        bf16_t* yp = YAB + (size_t)m * 2048 + 1024 + c0;
        const u32x4 ya = *(const u32x4*)yp, yb2 = *(const u32x4*)(yp + 8);
        const u32x4 va = *(const u32x4*)(Vg + (size_t)m * DM + c0), vb = *(const u32x4*)(Vg + (size_t)m * DM + c0 + 8);
        u32x4 pa = (u32x4){0u, 0u, 0u, 0u}, pb = pa; if (s > 0) { pa = *(const u32x4*)(Vg + (size_t)(m - 1) * DM + c0); pb = *(const u32x4*)(Vg + (size_t)(m - 1) * DM + c0 + 8); }
        const u32x4 ga = *(const u32x4*)(BG + (size_t)m * DM + c0), gb = *(const u32x4*)(BG + (size_t)m * DM + c0 + 8);
        const float rk = RK[(size_t)m * 16 + head];
        f32x4 y[4] = {un4(ya.x, ya.y), un4(ya.z, ya.w), un4(yb2.x, yb2.y), un4(yb2.z, yb2.w)};
        const f32x4 v[4] = {un4(va.x, va.y), un4(va.z, va.w), un4(vb.x, vb.y), un4(vb.z, vb.w)};
        const f32x4 p[4] = {un4(pa.x, pa.y), un4(pa.z, pa.w), un4(pb.x, pb.y), un4(pb.z, pb.w)};
        const f32x4 g[4] = {un4(ga.x, ga.y), un4(ga.z, ga.w), un4(gb.x, gb.y), un4(gb.z, gb.w)};
        float sm = 0.f;
#pragma unroll
        for (int j = 0; j < 4; ++j) sm += (y[j][0] + y[j][1]) + (y[j][2] + y[j][3]);
        const float mean = quad_sum(sm) * (1.0f / 64.0f); float q = 0.f;
#pragma unroll
        for (int j = 0; j < 4; ++j) { y[j] = y[j] - mean; q += (y[j][0] * y[j][0] + y[j][1] * y[j][1]) + (y[j][2] * y[j][2] + y[j][3] * y[j][3]); }
        const float rstd = rsqrtf(quad_sum(q) * (1.0f / 64.0f) + 64e-5f);
        u32x4 o[2];
#pragma unroll
        for (int j = 0; j < 4; ++j) { const f32x4 vl = v[j] + (p[j] - v[j]) * muv[j]; const f32x4 r = (y[j] * rstd * lw[j] + lb[j] + rk * vl) * g[j];
            if (j & 1) { o[j >> 1].z = pk2(r[0], r[1]); o[j >> 1].w = pk2(r[2], r[3]); } else { o[j >> 1].x = pk2(r[0], r[1]); o[j >> 1].y = pk2(r[2], r[3]); } }
        *(u32x4*)yp = o[0]; *(u32x4*)(yp + 8) = o[1];
    }
}

constexpr int CS_L = 32, CS_NCH = SEQ / CS_L, CS_NSLOT = 3;
constexpr int CS_NT = 0, CS_RT = 4096, CS_BT = 8192, CS_KT = 12288, CS_TM = 8192, CS_AKN = 10240, CS_ABR = 12288, CS_AKR = 14336, CS_BC = 16384, CS_KC = 20480, CS_VC = 24576, CS_GL = 28672, CS_SLOT = 29184;
constexpr int CS_RAW = CS_NSLOT * CS_SLOT, CS_RAWSZ = 5 * 33 * 128;
constexpr int CS_FLAGS = CS_RAW + CS_NSLOT * CS_RAWSZ;
static_assert(CS_FLAGS + 64 <= LDS_BYTES && (CS_RAW % 16) == 0 && (CS_RAWSZ % 16) == 0, "chunked scan LDS map");
__device__ __forceinline__ int permp(int j) { return 8 * ((j & 15) >> 2) + 4 * (j >> 4) + (j & 3); }
template <int CTRL, int RM> __device__ __forceinline__ float dppf(float x) { return __int_as_float(__builtin_amdgcn_update_dpp(0, __float_as_int(x), CTRL, RM, 0xf, true)); }
__device__ __forceinline__ float wave_total(float x) {
    x = row16_sum(x); x += dppf<0x142, 0xa>(x); x += dppf<0x143, 0xc>(x); return __int_as_float(__builtin_amdgcn_readlane(__float_as_int(x), 63)); }
__device__ __forceinline__ float wave_sum64(float x) { x = row16_sum(x); x += __shfl_xor(x, 16); x += __shfl_xor(x, 32); return x; }
__device__ __forceinline__ bf16x8 cfrag(const f32x16& x, int s) {
    u32x4 w; w.x = pk2(x[8 * s + 0], x[8 * s + 1]); w.y = pk2(x[8 * s + 2], x[8 * s + 3]); w.z = pk2(x[8 * s + 4], x[8 * s + 5]); w.w = pk2(x[8 * s + 6], x[8 * s + 7]); return __builtin_bit_cast(bf16x8, w); }
__device__ __forceinline__ bf16x8 cfrag2(const f32x4& a, const f32x4& b) { u32x4 w; w.x = pk2(a[0], a[1]); w.y = pk2(a[2], a[3]); w.z = pk2(b[0], b[1]); w.w = pk2(b[2], b[3]); return __builtin_bit_cast(bf16x8, w); }
__device__ __forceinline__ void lds_poll_ge(LAS unsigned* p, unsigned want) { while (__hip_atomic_load(p, __ATOMIC_RELAXED, __HIP_MEMORY_SCOPE_WORKGROUP) < want) __builtin_amdgcn_s_sleep(1); asm volatile("" ::: "memory"); }

__device__ __forceinline__ void cscan_job(const Args& a, const int wave, LAS unsigned char* lds, int bh) {
    int lane; asm volatile("v_mbcnt_lo_u32_b32 %0, -1, 0\n\tv_mbcnt_hi_u32_b32 %0, -1, %0" : "=v"(lane));
    const int tid = wave * 64 + lane;
    const int b = bh >> 4, h = bh & 15;
    const bf16_t* Rg = (const bf16_t*)(a.ws + WS_R); const bf16_t* Kg = (const bf16_t*)(a.ws + WS_K); const bf16_t* Vg = (const bf16_t*)(a.ws + WS_V);
    const bf16_t* Dg = (const bf16_t*)(a.ws + WS_DARR); const bf16_t* Ag = (const bf16_t*)(a.ws + WS_AARR);
    bf16_t* YAB = (bf16_t*)(a.ws + WS_YAB); float* RK = (float*)((unsigned char*)a.out + DO_RK);
    LAS unsigned* ready = (LAS unsigned*)(lds + CS_FLAGS); LAS unsigned* done = ready + CS_NSLOT; LAS unsigned* rawready = done + CS_NSLOT; LAS unsigned* rawfree = rawready + CS_NSLOT;
    __syncthreads();
    if (tid < 4 * CS_NSLOT) ready[tid] = 0u;
    __syncthreads();
    if (wave == 4) {
        const int rr = lane >> 3, cc = lane & 7;
        for (int c = 0; c < CS_NCH; ++c) {
            const int s = c % CS_NSLOT; LAS unsigned char* rw = lds + CS_RAW + s * CS_RAWSZ;
            const size_t m0 = (size_t)b * SEQ + (size_t)c * CS_L;
            u32x4 v[5][4], vp[3];
#pragma unroll
            for (int ar = 0; ar < 5; ++ar) { const bf16_t* src = (ar == 0) ? Rg : (ar == 1) ? Kg : (ar == 2) ? Vg : (ar == 3) ? Dg : Ag;
#pragma unroll
                for (int q4 = 0; q4 < 4; ++q4) v[ar][q4] = *(const u32x4*)(src + (m0 + 8 * q4 + rr) * DM + h * 64 + 8 * cc); }
#pragma unroll
            for (int ar = 0; ar < 3; ++ar) { const bf16_t* src = (ar == 0) ? Rg : (ar == 1) ? Kg : Vg; vp[ar] = (u32x4){0u, 0u, 0u, 0u};
                if (c > 0 && lane < 8) vp[ar] = *(const u32x4*)(src + (m0 - 1) * DM + h * 64 + 8 * cc); }
            if (c >= CS_NSLOT) lds_poll_ge(rawfree + s, (unsigned)(c / CS_NSLOT));
#pragma unroll
            for (int ar = 0; ar < 5; ++ar)
#pragma unroll
                for (int q4 = 0; q4 < 4; ++q4) *(LAS u32x4*)(rw + (ar * 33 + 1 + 8 * q4 + rr) * 128 + 16 * cc) = v[ar][q4];
            if (lane < 8) {
#pragma unroll
                for (int ar = 0; ar < 3; ++ar) *(LAS u32x4*)(rw + (ar * 33) * 128 + 16 * cc) = vp[ar]; }
            LDS_WAIT();
            if (lane == 0) __hip_atomic_store(rawready + s, (unsigned)(c + 1), __ATOMIC_RELAXED, __HIP_MEMORY_SCOPE_WORKGROUP);
        }
    } else if (wave >= 5) {
        const int hw = wave - 5, gch = h * 64 + lane;
        const float mur = a.mu_rkv[gch], muk = a.mu_rkv[DM + gch], muv = a.mu_rkv[2 * DM + gch], kkw = a.rwkv_vec[2 * DM + gch], kaw = a.rwkv_vec[3 * DM + gch], rkw = a.r_k[gch];
        const int kpos = 32 * (lane >> 5) + permp(lane & 31);
        for (int c = hw; c < CS_NCH; c += CS_NSLOT) {
            const int s = hw; LAS unsigned char* sl = lds + s * CS_SLOT; const LAS unsigned short* rw = (const LAS unsigned short*)(lds + CS_RAW + s * CS_RAWSZ);
            const unsigned use = (unsigned)(c / CS_NSLOT);
            { PROBE_BEGIN(10, a.ws, wave);
            if (use > 0u) lds_poll_ge(done + s, 4u * use);
            lds_poll_ge(rawready + s, (unsigned)(c + 1));
            PROBE_END(10, a.ws, wave); }
            PROBE_BEGIN(11, a.ws, wave);
            const size_t m0 = (size_t)b * SEQ + (size_t)c * CS_L; const size_t o0 = m0 * DM + gch;
            float rp = bflo((unsigned)rw[(0 * 33) * 64 + lane]), kp = bflo((unsigned)rw[(1 * 33) * 64 + lane]), vp = bflo((unsigned)rw[(2 * 33) * 64 + lane]);
            float cum = 0.f, gprev = 1.f;
            unsigned bcw[16], kcw[16], vcw[16];
#pragma unroll
            for (int grp = 0; grp < 4; ++grp) {
                float rlv[8], kkrv[8], kprv[8], vlv[8], aav[8], ddv[8], red[16];
#pragma unroll
                for (int e = 0; e < 8; ++e) { const int row = 1 + 8 * grp + e;
                    const float r0 = bflo((unsigned)rw[(0 * 33 + row) * 64 + lane]), k0 = bflo((unsigned)rw[(1 * 33 + row) * 64 + lane]), v0 = bflo((unsigned)rw[(2 * 33 + row) * 64 + lane]);
                    ddv[e] = bflo((unsigned)rw[(3 * 33 + row) * 64 + lane]); aav[e] = bflo((unsigned)rw[(4 * 33 + row) * 64 + lane]);
                    rlv[e] = r0 + (rp - r0) * mur; const float kl = k0 + (kp - k0) * muk; vlv[e] = v0 + (vp - v0) * muv; rp = r0; kp = k0; vp = v0;
                    kkrv[e] = kl * kkw; kprv[e] = kl * (1.0f + (aav[e] - 1.0f) * kaw);
                    red[2 * e] = kkrv[e] * kkrv[e]; red[2 * e + 1] = rlv[e] * kprv[e] * rkw; }
#pragma unroll
                for (int e = 0; e < 16; ++e) red[e] += dppf<0xB1, 0xf>(red[e]);
#pragma unroll
                for (int e = 0; e < 16; ++e) red[e] += dppf<0x4E, 0xf>(red[e]);
#pragma unroll
                for (int e = 0; e < 16; ++e) red[e] += dppf<0x141, 0xf>(red[e]);
#pragma unroll
                for (int e = 0; e < 16; ++e) red[e] += dppf<0x140, 0xf>(red[e]);
#pragma unroll
                for (int e = 0; e < 16; ++e) red[e] += dppf<0x142, 0xa>(red[e]);
#pragma unroll
                for (int e = 0; e < 16; ++e) red[e] += dppf<0x143, 0xc>(red[e]);
#pragma unroll
                for (int e = 0; e < 16; ++e) red[e] = __int_as_float(__builtin_amdgcn_readlane(__float_as_int(red[e]), 63));
                if (lane < 8) { float rkv = red[1];
#pragma unroll
                    for (int e = 1; e < 8; ++e) rkv = (lane == e) ? red[2 * e + 1] : rkv;
                    RK[(m0 + 8 * grp + lane) * 16 + h] = rkv; }
#pragma unroll
                for (int j2 = 0; j2 < 4; ++j2) {
                    const int i2 = 4 * grp + j2;
                    float nt[2], bt[2], kt[2], rt[2], vt[2];
#pragma unroll
                    for (int e = 0; e < 2; ++e) { const int te = 2 * j2 + e;
                        const float kkv = kkrv[te] * __builtin_amdgcn_rsqf(fmaxf(red[2 * te], 1e-24f)), bb = kkv * aav[te];
                        cum += ddv[te]; const float gi = __expf(-cum), ginv = __builtin_amdgcn_rcpf(gi);
                        nt[e] = -kkv * gprev; bt[e] = bb * ginv; kt[e] = kprv[te] * ginv; rt[e] = rlv[te] * gi; vt[e] = vlv[te]; gprev = gi; }
                    const unsigned wn = pk2(nt[0], nt[1]), wb = pk2(bt[0], bt[1]), wk = pk2(kt[0], kt[1]), wr = pk2(rt[0], rt[1]), wv = pk2(vt[0], vt[1]);
                    const int i = 2 * i2;
                    *(LAS unsigned short*)(sl + CS_NT + (i * 64 + kpos) * 2) = (unsigned short)wn; *(LAS unsigned short*)(sl + CS_NT + ((i + 1) * 64 + kpos) * 2) = (unsigned short)(wn >> 16);
                    *(LAS unsigned short*)(sl + CS_RT + (i * 64 + kpos) * 2) = (unsigned short)wr; *(LAS unsigned short*)(sl + CS_RT + ((i + 1) * 64 + kpos) * 2) = (unsigned short)(wr >> 16);
                    *(LAS unsigned short*)(sl + CS_BT + (i * 64 + kpos) * 2) = (unsigned short)wb; *(LAS unsigned short*)(sl + CS_BT + ((i + 1) * 64 + kpos) * 2) = (unsigned short)(wb >> 16);
                    *(LAS unsigned short*)(sl + CS_KT + (i * 64 + kpos) * 2) = (unsigned short)wk; *(LAS unsigned short*)(sl + CS_KT + ((i + 1) * 64 + kpos) * 2) = (unsigned short)(wk >> 16);
                    const int pw = permp(i) >> 1;
                    bcw[pw] = wb; kcw[pw] = wk; vcw[pw] = wv;
                }
                __builtin_amdgcn_sched_barrier(0);
            }
#pragma unroll
            for (int q4 = 0; q4 < 4; ++q4) {
                *(LAS u32x4*)(sl + CS_BC + lane * 64 + 16 * q4) = (u32x4){bcw[4 * q4], bcw[4 * q4 + 1], bcw[4 * q4 + 2], bcw[4 * q4 + 3]};
                *(LAS u32x4*)(sl + CS_KC + lane * 64 + 16 * q4) = (u32x4){kcw[4 * q4], kcw[4 * q4 + 1], kcw[4 * q4 + 2], kcw[4 * q4 + 3]};
                *(LAS u32x4*)(sl + CS_VC + lane * 64 + 16 * q4) = (u32x4){vcw[4 * q4], vcw[4 * q4 + 1], vcw[4 * q4 + 2], vcw[4 * q4 + 3]}; }
            *(LAS float*)(sl + CS_GL + lane * 4) = gprev;
            LDS_WAIT();
            if (lane == 0) __hip_atomic_store(rawfree + s, use + 1u, __ATOMIC_RELAXED, __HIP_MEMORY_SCOPE_WORKGROUP);
            PROBE_END(11, a.ws, wave);
            PROBE_BEGIN(12, a.ws, wave);
            const int tok = lane & 31, hf = lane >> 5;
            bf16x8 fn[4], fr[4], fb[4], fk[4];
#pragma unroll
            for (int ks = 0; ks < 4; ++ks) { fn[ks] = *(const LAS bf16x8*)(sl + CS_NT + (tok * 64 + 16 * ks + 8 * hf) * 2); fr[ks] = *(const LAS bf16x8*)(sl + CS_RT + (tok * 64 + 16 * ks + 8 * hf) * 2);
                fb[ks] = *(const LAS bf16x8*)(sl + CS_BT + (tok * 64 + 16 * ks + 8 * hf) * 2); fk[ks] = *(const LAS bf16x8*)(sl + CS_KT + (tok * 64 + 16 * ks + 8 * hf) * 2); }
            f32x16 P, Pt, Tm, Akn, Abr, Akr;
#pragma unroll
            for (int e = 0; e < 16; ++e) { P[e] = 0.f; Pt[e] = 0.f; Akn[e] = 0.f; Abr[e] = 0.f; Akr[e] = 0.f; }
#pragma unroll
            for (int ks = 0; ks < 4; ++ks) { P = __builtin_amdgcn_mfma_f32_32x32x16_bf16(fn[ks], fb[ks], P, 0, 0, 0); Pt = __builtin_amdgcn_mfma_f32_32x32x16_bf16(fb[ks], fn[ks], Pt, 0, 0, 0);
                Akn = __builtin_amdgcn_mfma_f32_32x32x16_bf16(fn[ks], fk[ks], Akn, 0, 0, 0); Abr = __builtin_amdgcn_mfma_f32_32x32x16_bf16(fr[ks], fb[ks], Abr, 0, 0, 0); Akr = __builtin_amdgcn_mfma_f32_32x32x16_bf16(fr[ks], fk[ks], Akr, 0, 0, 0); }
#pragma unroll
            for (int e = 0; e < 16; ++e) { const int row = (e & 3) + 8 * (e >> 2) + 4 * hf, col = tok;
                if (!(col < row)) { P[e] = 0.f; Akn[e] = 0.f; } if (!(row < col)) Pt[e] = 0.f; if (col > row) { Abr[e] = 0.f; Akr[e] = 0.f; }
                Tm[e] = P[e] + (row == col ? 1.0f : 0.f); }
#pragma unroll
            for (int mm = 1; mm <= 4; ++mm) {
                const bf16x8 p0 = cfrag(P, 0), p1 = cfrag(P, 1), q0 = cfrag(Pt, 0), q1 = cfrag(Pt, 1);
                f32x16 Ptn, Pn;
#pragma unroll
                for (int e = 0; e < 16; ++e) { Ptn[e] = 0.f; Pn[e] = 0.f; }
                Ptn = __builtin_amdgcn_mfma_f32_32x32x16_bf16(p0, q0, Ptn, 0, 0, 0); Ptn = __builtin_amdgcn_mfma_f32_32x32x16_bf16(p1, q1, Ptn, 0, 0, 0);
                if (mm < 4) { Pn = __builtin_amdgcn_mfma_f32_32x32x16_bf16(q0, p0, Pn, 0, 0, 0); Pn = __builtin_amdgcn_mfma_f32_32x32x16_bf16(q1, p1, Pn, 0, 0, 0); }
                const bf16x8 t0 = cfrag(Tm, 0), t1 = cfrag(Tm, 1), u0 = cfrag(Ptn, 0), u1 = cfrag(Ptn, 1);
                Tm = __builtin_amdgcn_mfma_f32_32x32x16_bf16(u0, t0, Tm, 0, 0, 0); Tm = __builtin_amdgcn_mfma_f32_32x32x16_bf16(u1, t1, Tm, 0, 0, 0);
                P = Pn; Pt = Ptn;
            }
            { const int pc = permp(tok);
#pragma unroll
              for (int e = 0; e < 16; e += 2) { const int row = (e & 3) + 8 * (e >> 2) + 4 * hf;
                const unsigned w0 = pk2(Tm[e], Tm[e + 1]), w1 = pk2(Akn[e], Akn[e + 1]), w2 = pk2(Abr[e], Abr[e + 1]), w3 = pk2(Akr[e], Akr[e + 1]);
                *(LAS unsigned short*)(sl + CS_TM + (row * 32 + pc) * 2) = (unsigned short)w0; *(LAS unsigned short*)(sl + CS_TM + ((row + 1) * 32 + pc) * 2) = (unsigned short)(w0 >> 16);
                *(LAS unsigned short*)(sl + CS_AKN + (row * 32 + pc) * 2) = (unsigned short)w1; *(LAS unsigned short*)(sl + CS_AKN + ((row + 1) * 32 + pc) * 2) = (unsigned short)(w1 >> 16);
                *(LAS unsigned short*)(sl + CS_ABR + (row * 32 + pc) * 2) = (unsigned short)w2; *(LAS unsigned short*)(sl + CS_ABR + ((row + 1) * 32 + pc) * 2) = (unsigned short)(w2 >> 16);
                *(LAS unsigned short*)(sl + CS_AKR + (row * 32 + pc) * 2) = (unsigned short)w3; *(LAS unsigned short*)(sl + CS_AKR + ((row + 1) * 32 + pc) * 2) = (unsigned short)(w3 >> 16); } }
            LDS_WAIT();
            if (lane == 0) __hip_atomic_store(ready + s, (unsigned)(c + 1), __ATOMIC_RELAXED, __HIP_MEMORY_SCOPE_WORKGROUP);
            PROBE_END(12, a.ws, wave);
        }
    } else {
        const int l15 = lane & 15, g = lane >> 4, vb = wave;
        f32x4 xc[4];
#pragma unroll
        for (int kt = 0; kt < 4; ++kt) xc[kt] = (f32x4){0.f, 0.f, 0.f, 0.f};
        for (int c = 0; c < CS_NCH; ++c) {
            const int s = c % CS_NSLOT; const LAS unsigned char* sl = lds + s * CS_SLOT;
            lds_poll_ge(ready + s, (unsigned)(c + 1));
            const bf16x8 xb0 = cfrag2(xc[0], xc[1]), xb1 = cfrag2(xc[2], xc[3]);
            const bf16x8 vop = *(const LAS bf16x8*)(sl + CS_VC + ((16 * vb + l15) * 32 + 8 * g) * 2);
            f32x4 W[2], U[2], Y[2];
#pragma unroll
            for (int rt = 0; rt < 2; ++rt) { const int row = 16 * rt + l15; f32x4 acc = (f32x4){0.f, 0.f, 0.f, 0.f};
                acc = __builtin_amdgcn_mfma_f32_16x16x32_bf16(*(const LAS bf16x8*)(sl + CS_AKN + (row * 32 + 8 * g) * 2), vop, acc, 0, 0, 0);
                acc = __builtin_amdgcn_mfma_f32_16x16x32_bf16(*(const LAS bf16x8*)(sl + CS_NT + (row * 64 + 8 * g) * 2), xb0, acc, 0, 0, 0);
                acc = __builtin_amdgcn_mfma_f32_16x16x32_bf16(*(const LAS bf16x8*)(sl + CS_NT + (row * 64 + 32 + 8 * g) * 2), xb1, acc, 0, 0, 0);
                W[rt] = acc; }
            const bf16x8 wb = cfrag2(W[0], W[1]);
#pragma unroll
            for (int rt = 0; rt < 2; ++rt) { const int row = 16 * rt + l15;
                U[rt] = __builtin_amdgcn_mfma_f32_16x16x32_bf16(*(const LAS bf16x8*)(sl + CS_TM + (row * 32 + 8 * g) * 2), wb, (f32x4){0.f, 0.f, 0.f, 0.f}, 0, 0, 0); }
            const bf16x8 ub = cfrag2(U[0], U[1]);
#pragma unroll
            for (int rt = 0; rt < 2; ++rt) { const int row = 16 * rt + l15; f32x4 acc = (f32x4){0.f, 0.f, 0.f, 0.f};
                acc = __builtin_amdgcn_mfma_f32_16x16x32_bf16(*(const LAS bf16x8*)(sl + CS_AKR + (row * 32 + 8 * g) * 2), vop, acc, 0, 0, 0);
                acc = __builtin_amdgcn_mfma_f32_16x16x32_bf16(*(const LAS bf16x8*)(sl + CS_RT + (row * 64 + 8 * g) * 2), xb0, acc, 0, 0, 0);
                acc = __builtin_amdgcn_mfma_f32_16x16x32_bf16(*(const LAS bf16x8*)(sl + CS_RT + (row * 64 + 32 + 8 * g) * 2), xb1, acc, 0, 0, 0);
                acc = __builtin_amdgcn_mfma_f32_16x16x32_bf16(*(const LAS bf16x8*)(sl + CS_ABR + (row * 32 + 8 * g) * 2), ub, acc, 0, 0, 0);
                Y[rt] = acc; }
#pragma unroll
            for (int kt = 0; kt < 4; ++kt) { const int row = 16 * kt + l15; f32x4 acc = xc[kt];
                acc = __builtin_amdgcn_mfma_f32_16x16x32_bf16(*(const LAS bf16x8*)(sl + CS_KC + (row * 32 + 8 * g) * 2), vop, acc, 0, 0, 0);
                acc = __builtin_amdgcn_mfma_f32_16x16x32_bf16(*(const LAS bf16x8*)(sl + CS_BC + (row * 32 + 8 * g) * 2), ub, acc, 0, 0, 0);
                xc[kt] = acc * *(const LAS f32x4*)(sl + CS_GL + (16 * kt + 4 * g) * 4); }
            LDS_WAIT();
            if (lane == 0) (void)__hip_atomic_fetch_add(done + s, 1u, __ATOMIC_RELAXED, __HIP_MEMORY_SCOPE_WORKGROUP);
#pragma unroll
            for (int rt = 0; rt < 2; ++rt)
#pragma unroll
                for (int e = 0; e < 4; ++e) { const size_t m = (size_t)b * SEQ + (size_t)c * CS_L + 16 * rt + 4 * g + e;
                    YAB[m * 2048 + 1024 + h * 64 + 16 * vb + l15] = (bf16_t)(pk2(Y[rt][e], 0.f) & 0xffffu); }
        }
    }
}

constexpr int CR_PIECE = 12, CR_NP = (CS_NCH + CR_PIECE - 1) / CR_PIECE, CR_PW = 4, CR_PSLOT = CS_SLOT + 2 * 33 * 128;
constexpr size_t DO_IMG = 66 * MiB;
static_assert((CR_PIECE % 4) == 0 && DO_IMG + (size_t)2 * 64 * CR_PIECE * CS_SLOT <= 128 * MiB && CR_PW * CR_PSLOT <= CS_FLAGS, "image buffer / producer slots");

__device__ __forceinline__ void cscan_produce(const Args& a, const int wave, LAS unsigned char* lds, const int piece, const int first, const int nblk) {
    const int nch = (CS_NCH - piece * CR_PIECE) < CR_PIECE ? (CS_NCH - piece * CR_PIECE) : CR_PIECE;
    if (wave >= CR_PW) {
        const int lane = lane_id(); const int iw = ((int)blockIdx.x - first) * (NWAVES - CR_PW) + (wave - CR_PW), niw = nblk * (NWAVES - CR_PW);
        for (int t = piece * 2 * niw + iw; t < (piece + 1) * 2 * niw && t < MTOK; t += niw) rope_item(a, t, lane);
        return; }
    const bf16_t* Rg = (const bf16_t*)(a.ws + WS_R); const bf16_t* Kg = (const bf16_t*)(a.ws + WS_K); const bf16_t* Vg = (const bf16_t*)(a.ws + WS_V);
    const bf16_t* Dg = (const bf16_t*)(a.ws + WS_DARR); const bf16_t* Ag = (const bf16_t*)(a.ws + WS_AARR);
    float* RK = (float*)((unsigned char*)a.out + DO_RK); unsigned char* IMG = (unsigned char*)a.out + DO_IMG + (size_t)(piece & 1) * 64 * CR_PIECE * CS_SLOT;
    LAS unsigned char* sl = lds + wave * CR_PSLOT;
    const LAS unsigned short* rawD = (const LAS unsigned short*)(sl + 16384); const LAS unsigned short* rawA = (const LAS unsigned short*)(sl + 20480);
    const LAS unsigned short* rawR = (const LAS unsigned short*)(sl + 24576); const LAS unsigned short* rawK = (const LAS unsigned short*)(sl + CS_SLOT); const LAS unsigned short* rawV = (const LAS unsigned short*)(sl + CS_SLOT + 33 * 128);
    u32x4 pre[5][4], prep[3];
    auto issue = [&](int it2, int rr, int c8, int lane) { const int bh2 = it2 / nch, cc2 = it2 % nch, c2 = piece * CR_PIECE + cc2; const unsigned mm = (unsigned)(bh2 >> 4) * SEQ + (unsigned)c2 * CS_L; const int hh = bh2 & 15;
        const unsigned eoff = ((mm + rr) * DM + hh * 64 + 8 * c8) * 2u;
        const unsigned char* wsb = a.ws;
#pragma unroll
        for (int ar = 0; ar < 5; ++ar) { constexpr size_t AOFF[5] = {WS_R, WS_K, WS_V, WS_DARR, WS_AARR};
#pragma unroll
            for (int q4 = 0; q4 < 4; ++q4) pre[ar][q4] = *(const u32x4*)(wsb + AOFF[ar] + eoff + (unsigned)(8 * q4 * DM * 2)); }
        const bool hasp = (c2 > 0) && (lane < 8); const unsigned poff = hasp ? (eoff - (unsigned)((rr + 1) * DM * 2)) : eoff;
#pragma unroll
        for (int ar = 0; ar < 3; ++ar) { constexpr size_t AOFF[3] = {WS_R, WS_K, WS_V}; const u32x4 t = *(const u32x4*)(wsb + AOFF[ar] + poff); prep[ar] = hasp ? t : (u32x4){0u, 0u, 0u, 0u}; } };
    const int it0 = ((int)blockIdx.x - first) * CR_PW + wave, nimg = 64 * nch, itstep = nblk * CR_PW;
    { const int l0 = lane_id(); if (it0 < nimg) issue(it0, l0 >> 3, l0 & 7, l0); }
    for (int it = it0; it < nimg; it += itstep) {
        const int lane = lane_id(), rr = lane >> 3, c8 = lane & 7, kpos = 32 * (lane >> 5) + permp(lane & 31);
        const int bh = it / nch, cc = it % nch, b = bh >> 4, h = bh & 15, c = piece * CR_PIECE + cc, gch = h * 64 + lane;
        const float mur = a.mu_rkv[gch], muk = a.mu_rkv[DM + gch], muv = a.mu_rkv[2 * DM + gch], kkw = a.rwkv_vec[2 * DM + gch], kaw = a.rwkv_vec[3 * DM + gch], rkw = a.r_k[gch];
            const size_t m0 = (size_t)b * SEQ + (size_t)c * CS_L;
            { LAS unsigned char* wb = sl + rr * 128 + 16 * c8; asm volatile("" : "+v"(wb));
#pragma unroll
              for (int q4 = 0; q4 < 4; ++q4) {
                *(LAS u32x4*)(wb + 24576 + (8 * q4 + 1) * 128) = pre[0][q4]; *(LAS u32x4*)(wb + CS_SLOT + (8 * q4 + 1) * 128) = pre[1][q4]; *(LAS u32x4*)(wb + CS_SLOT + 33 * 128 + (8 * q4 + 1) * 128) = pre[2][q4];
                *(LAS u32x4*)(wb + 16384 + (8 * q4) * 128) = pre[3][q4]; *(LAS u32x4*)(wb + 20480 + (8 * q4) * 128) = pre[4][q4]; }
              if (lane < 8) { *(LAS u32x4*)(wb + 24576) = prep[0]; *(LAS u32x4*)(wb + CS_SLOT) = prep[1]; *(LAS u32x4*)(wb + CS_SLOT + 33 * 128) = prep[2]; } }
            LDS_WAIT();
            const LAS unsigned short* rb = (const LAS unsigned short*)sl + lane; asm volatile("" : "+v"(rb));
            float rp = bflo((unsigned)rb[24576 / 2]), kp = bflo((unsigned)rb[CS_SLOT / 2]), vp = bflo((unsigned)rb[(CS_SLOT + 33 * 128) / 2]);
            float cum = 0.f, gprev = 1.f;
            unsigned bcw[16], kcw[16], vcw[16];
#pragma unroll
            for (int grp = 0; grp < 4; ++grp) {
                float rlv[8], kkrv[8], kprv[8], vlv[8], aav[8], ddv[8], red[16];
#pragma unroll
                for (int e = 0; e < 8; ++e) { const int row = 8 * grp + e;
                    const float r0 = bflo((unsigned)rb[24576 / 2 + (row + 1) * 64]), k0 = bflo((unsigned)rb[CS_SLOT / 2 + (row + 1) * 64]), v0 = bflo((unsigned)rb[(CS_SLOT + 33 * 128) / 2 + (row + 1) * 64]);
                    ddv[e] = bflo((unsigned)rb[16384 / 2 + row * 64]); aav[e] = bflo((unsigned)rb[20480 / 2 + row * 64]);
                    rlv[e] = r0 + (rp - r0) * mur; const float kl = k0 + (kp - k0) * muk; vlv[e] = v0 + (vp - v0) * muv; rp = r0; kp = k0; vp = v0;
                    kkrv[e] = kl * kkw; kprv[e] = kl * (1.0f + (aav[e] - 1.0f) * kaw);
                    red[2 * e] = kkrv[e] * kkrv[e]; red[2 * e + 1] = rlv[e] * kprv[e] * rkw; }
#pragma unroll
                for (int e = 0; e < 16; ++e) red[e] += dppf<0xB1, 0xf>(red[e]);
#pragma unroll
                for (int e = 0; e < 16; ++e) red[e] += dppf<0x4E, 0xf>(red[e]);
#pragma unroll
                for (int e = 0; e < 16; ++e) red[e] += dppf<0x141, 0xf>(red[e]);
#pragma unroll
                for (int e = 0; e < 16; ++e) red[e] += dppf<0x140, 0xf>(red[e]);
#pragma unroll
                for (int e = 0; e < 16; ++e) red[e] += dppf<0x142, 0xa>(red[e]);
#pragma unroll
                for (int e = 0; e < 16; ++e) red[e] += dppf<0x143, 0xc>(red[e]);
#pragma unroll
                for (int e = 0; e < 16; ++e) red[e] = __int_as_float(__builtin_amdgcn_readlane(__float_as_int(red[e]), 63));
                if (lane < 8) { float rkv = red[1];
#pragma unroll
                    for (int e = 1; e < 8; ++e) rkv = (lane == e) ? red[2 * e + 1] : rkv;
                    RK[(m0 + 8 * grp + lane) * 16 + h] = rkv; }
#pragma unroll
                for (int j2 = 0; j2 < 4; ++j2) {
                    const int i2 = 4 * grp + j2;
                    float nt[2], bt[2], kt[2], rt[2], vt[2];
#pragma unroll
                    for (int e = 0; e < 2; ++e) { const int te = 2 * j2 + e;
                        const float kkv = kkrv[te] * __builtin_amdgcn_rsqf(fmaxf(red[2 * te], 1e-24f)), bb = kkv * aav[te];
                        cum += ddv[te]; const float gi = __expf(-cum), ginv = __builtin_amdgcn_rcpf(gi);
                        nt[e] = -kkv * gprev; bt[e] = bb * ginv; kt[e] = kprv[te] * ginv; rt[e] = rlv[te] * gi; vt[e] = vlv[te]; gprev = gi; }
                    const unsigned wn = pk2(nt[0], nt[1]), wb = pk2(bt[0], bt[1]), wk = pk2(kt[0], kt[1]), wr = pk2(rt[0], rt[1]), wv = pk2(vt[0], vt[1]);
                    const int i = 2 * i2;
                    *(LAS unsigned short*)(sl + CS_NT + (i * 64 + kpos) * 2) = (unsigned short)wn; *(LAS unsigned short*)(sl + CS_NT + ((i + 1) * 64 + kpos) * 2) = (unsigned short)(wn >> 16);
                    *(LAS unsigned short*)(sl + CS_RT + (i * 64 + kpos) * 2) = (unsigned short)wr; *(LAS unsigned short*)(sl + CS_RT + ((i + 1) * 64 + kpos) * 2) = (unsigned short)(wr >> 16);
                    *(LAS unsigned short*)(sl + CS_BT + (i * 64 + kpos) * 2) = (unsigned short)wb; *(LAS unsigned short*)(sl + CS_BT + ((i + 1) * 64 + kpos) * 2) = (unsigned short)(wb >> 16);
                    *(LAS unsigned short*)(sl + CS_KT + (i * 64 + kpos) * 2) = (unsigned short)wk; *(LAS unsigned short*)(sl + CS_KT + ((i + 1) * 64 + kpos) * 2) = (unsigned short)(wk >> 16);
                    const int pw = permp(i) >> 1;
                    bcw[pw] = wb; kcw[pw] = wk; vcw[pw] = wv;
                }
                __builtin_amdgcn_sched_barrier(0);
            }
#pragma unroll
            for (int q4 = 0; q4 < 4; ++q4) {
                *(LAS u32x4*)(sl + CS_BC + lane * 64 + 16 * q4) = (u32x4){bcw[4 * q4], bcw[4 * q4 + 1], bcw[4 * q4 + 2], bcw[4 * q4 + 3]};
                *(LAS u32x4*)(sl + CS_KC + lane * 64 + 16 * q4) = (u32x4){kcw[4 * q4], kcw[4 * q4 + 1], kcw[4 * q4 + 2], kcw[4 * q4 + 3]};
                *(LAS u32x4*)(sl + CS_VC + lane * 64 + 16 * q4) = (u32x4){vcw[4 * q4], vcw[4 * q4 + 1], vcw[4 * q4 + 2], vcw[4 * q4 + 3]}; }
            *(LAS float*)(sl + CS_GL + lane * 4) = gprev;
            LDS_WAIT();
            const int tok = lane & 31, hf = lane >> 5;
            bf16x8 fn[4], fr[4], fb[4], fk[4];
#pragma unroll
            for (int ks = 0; ks < 4; ++ks) { fn[ks] = *(const LAS bf16x8*)(sl + CS_NT + (tok * 64 + 16 * ks + 8 * hf) * 2); fr[ks] = *(const LAS bf16x8*)(sl + CS_RT + (tok * 64 + 16 * ks + 8 * hf) * 2);
                fb[ks] = *(const LAS bf16x8*)(sl + CS_BT + (tok * 64 + 16 * ks + 8 * hf) * 2); fk[ks] = *(const LAS bf16x8*)(sl + CS_KT + (tok * 64 + 16 * ks + 8 * hf) * 2); }
            f32x16 P, Pt, Tm, Akn, Abr, Akr;
#pragma unroll
            for (int e = 0; e < 16; ++e) { P[e] = 0.f; Pt[e] = 0.f; Akn[e] = 0.f; Abr[e] = 0.f; Akr[e] = 0.f; }
#pragma unroll
            for (int ks = 0; ks < 4; ++ks) { P = __builtin_amdgcn_mfma_f32_32x32x16_bf16(fn[ks], fb[ks], P, 0, 0, 0); Pt = __builtin_amdgcn_mfma_f32_32x32x16_bf16(fb[ks], fn[ks], Pt, 0, 0, 0);
                Akn = __builtin_amdgcn_mfma_f32_32x32x16_bf16(fn[ks], fk[ks], Akn, 0, 0, 0); Abr = __builtin_amdgcn_mfma_f32_32x32x16_bf16(fr[ks], fb[ks], Abr, 0, 0, 0); Akr = __builtin_amdgcn_mfma_f32_32x32x16_bf16(fr[ks], fk[ks], Akr, 0, 0, 0); }
#pragma unroll
            for (int e = 0; e < 16; ++e) { const int row = (e & 3) + 8 * (e >> 2) + 4 * hf, col = tok;
                if (!(col < row)) { P[e] = 0.f; Akn[e] = 0.f; } if (!(row < col)) Pt[e] = 0.f; if (col > row) { Abr[e] = 0.f; Akr[e] = 0.f; }
                Tm[e] = P[e] + (row == col ? 1.0f : 0.f); }
#pragma unroll
            for (int mm = 1; mm <= 4; ++mm) {
                const bf16x8 p0 = cfrag(P, 0), p1 = cfrag(P, 1), q0 = cfrag(Pt, 0), q1 = cfrag(Pt, 1);
                f32x16 Ptn, Pn;
#pragma unroll
                for (int e = 0; e < 16; ++e) { Ptn[e] = 0.f; Pn[e] = 0.f; }
                Ptn = __builtin_amdgcn_mfma_f32_32x32x16_bf16(p0, q0, Ptn, 0, 0, 0); Ptn = __builtin_amdgcn_mfma_f32_32x32x16_bf16(p1, q1, Ptn, 0, 0, 0);
                if (mm < 4) { Pn = __builtin_amdgcn_mfma_f32_32x32x16_bf16(q0, p0, Pn, 0, 0, 0); Pn = __builtin_amdgcn_mfma_f32_32x32x16_bf16(q1, p1, Pn, 0, 0, 0); }
                const bf16x8 t0 = cfrag(Tm, 0), t1 = cfrag(Tm, 1), u0 = cfrag(Ptn, 0), u1 = cfrag(Ptn, 1);
                Tm = __builtin_amdgcn_mfma_f32_32x32x16_bf16(u0, t0, Tm, 0, 0, 0); Tm = __builtin_amdgcn_mfma_f32_32x32x16_bf16(u1, t1, Tm, 0, 0, 0);
                P = Pn; Pt = Ptn;
            }
            { const int itn = it + itstep; if (itn < nimg) { const int l2 = lane_id(); issue(itn, l2 >> 3, l2 & 7, l2); } }
            { const int pc = permp(tok);
#pragma unroll
              for (int e = 0; e < 16; e += 2) { const int row = (e & 3) + 8 * (e >> 2) + 4 * hf;
                const unsigned w0 = pk2(Tm[e], Tm[e + 1]), w1 = pk2(Akn[e], Akn[e + 1]), w2 = pk2(Abr[e], Abr[e + 1]), w3 = pk2(Akr[e], Akr[e + 1]);
                *(LAS unsigned short*)(sl + CS_TM + (row * 32 + pc) * 2) = (unsigned short)w0; *(LAS unsigned short*)(sl + CS_TM + ((row + 1) * 32 + pc) * 2) = (unsigned short)(w0 >> 16);
                *(LAS unsigned short*)(sl + CS_AKN + (row * 32 + pc) * 2) = (unsigned short)w1; *(LAS unsigned short*)(sl + CS_AKN + ((row + 1) * 32 + pc) * 2) = (unsigned short)(w1 >> 16);
                *(LAS unsigned short*)(sl + CS_ABR + (row * 32 + pc) * 2) = (unsigned short)w2; *(LAS unsigned short*)(sl + CS_ABR + ((row + 1) * 32 + pc) * 2) = (unsigned short)(w2 >> 16);
                *(LAS unsigned short*)(sl + CS_AKR + (row * 32 + pc) * 2) = (unsigned short)w3; *(LAS unsigned short*)(sl + CS_AKR + ((row + 1) * 32 + pc) * 2) = (unsigned short)(w3 >> 16); } }
            LDS_WAIT();
            { unsigned char* dst = IMG + (size_t)(bh * CR_PIECE + cc) * CS_SLOT;
#pragma unroll 1
              for (int j = lane; j < CS_SLOT / 16; j += 64) *(u32x4*)(dst + 16 * j) = *(const LAS u32x4*)(sl + 16 * j); }
            LDS_WAIT();
    }
}

__device__ __forceinline__ void cscan_consume(const Args& a, const int wave, LAS unsigned char* lds, const int bh, const int piece, f32x4 (&xc)[4]) {
    const int lane = lane_id();
    const int b = bh >> 4, h = bh & 15;
    bf16_t* YAB = (bf16_t*)(a.ws + WS_YAB); const unsigned char* IMG = (const unsigned char*)a.out + DO_IMG + (size_t)(piece & 1) * 64 * CR_PIECE * CS_SLOT;
    const int nch = (CS_NCH - piece * CR_PIECE) < CR_PIECE ? (CS_NCH - piece * CR_PIECE) : CR_PIECE;
    LAS unsigned* ready = (LAS unsigned*)(lds + CS_FLAGS); LAS unsigned* done = ready + 4;
    if (wave == 4) {
        constexpr int NI = (CS_SLOT + 1023) / 1024;
        for (int cc = 0; cc <= nch; ++cc) {
            if (cc < nch) { const int c = piece * CR_PIECE + cc, s = cc & 3; LAS unsigned char* sl = lds + s * CS_SLOT;
                const unsigned char* src = IMG + (size_t)(bh * CR_PIECE + cc) * CS_SLOT;
                if (c >= 4) lds_poll_ge(done + s, 4u * (unsigned)(c >> 2));
#pragma unroll
                for (int j = 0; j < NI; ++j) { const int idx = lane + 64 * j;
                    if (idx < CS_SLOT / 16) __builtin_amdgcn_global_load_lds((const unsigned*)(src + 16 * idx), (LAS unsigned*)(sl + 1024 * j), 16, 0, 0); } }
            if (cc >= 1) {
                if (cc < nch) asm volatile("s_waitcnt vmcnt(29)" ::: "memory"); else asm volatile("s_waitcnt vmcnt(0)" ::: "memory");
                if (lane == 0) __hip_atomic_store(ready + ((cc - 1) & 3), (unsigned)(piece * CR_PIECE + cc), __ATOMIC_RELAXED, __HIP_MEMORY_SCOPE_WORKGROUP); }
        }
    } else if (wave < 4) {
        const int l15 = lane & 15, g = lane >> 4, vb = wave;
        for (int cc = 0; cc < nch; ++cc) { const int c = piece * CR_PIECE + cc, s = cc & 3; const LAS unsigned char* sl = lds + s * CS_SLOT;
            { lds_poll_ge(ready + s, (unsigned)(c + 1)); }
            const bf16x8 xb0 = cfrag2(xc[0], xc[1]), xb1 = cfrag2(xc[2], xc[3]);
            const bf16x8 vop = *(const LAS bf16x8*)(sl + CS_VC + ((16 * vb + l15) * 32 + 8 * g) * 2);
            f32x4 W[2], U[2], Y[2];
#pragma unroll
            for (int rt = 0; rt < 2; ++rt) { const int row = 16 * rt + l15; f32x4 acc = (f32x4){0.f, 0.f, 0.f, 0.f};
                acc = __builtin_amdgcn_mfma_f32_16x16x32_bf16(*(const LAS bf16x8*)(sl + CS_AKN + (row * 32 + 8 * g) * 2), vop, acc, 0, 0, 0);
                acc = __builtin_amdgcn_mfma_f32_16x16x32_bf16(*(const LAS bf16x8*)(sl + CS_NT + (row * 64 + 8 * g) * 2), xb0, acc, 0, 0, 0);
                acc = __builtin_amdgcn_mfma_f32_16x16x32_bf16(*(const LAS bf16x8*)(sl + CS_NT + (row * 64 + 32 + 8 * g) * 2), xb1, acc, 0, 0, 0);
                W[rt] = acc; }
            const bf16x8 wb = cfrag2(W[0], W[1]);
#pragma unroll
            for (int rt = 0; rt < 2; ++rt) { const int row = 16 * rt + l15;
                U[rt] = __builtin_amdgcn_mfma_f32_16x16x32_bf16(*(const LAS bf16x8*)(sl + CS_TM + (row * 32 + 8 * g) * 2), wb, (f32x4){0.f, 0.f, 0.f, 0.f}, 0, 0, 0); }
            const bf16x8 ub = cfrag2(U[0], U[1]);
#pragma unroll
            for (int rt = 0; rt < 2; ++rt) { const int row = 16 * rt + l15; f32x4 acc = (f32x4){0.f, 0.f, 0.f, 0.f};
                acc = __builtin_amdgcn_mfma_f32_16x16x32_bf16(*(const LAS bf16x8*)(sl + CS_AKR + (row * 32 + 8 * g) * 2), vop, acc, 0, 0, 0);
                acc = __builtin_amdgcn_mfma_f32_16x16x32_bf16(*(const LAS bf16x8*)(sl + CS_RT + (row * 64 + 8 * g) * 2), xb0, acc, 0, 0, 0);
                acc = __builtin_amdgcn_mfma_f32_16x16x32_bf16(*(const LAS bf16x8*)(sl + CS_RT + (row * 64 + 32 + 8 * g) * 2), xb1, acc, 0, 0, 0);
                acc = __builtin_amdgcn_mfma_f32_16x16x32_bf16(*(const LAS bf16x8*)(sl + CS_ABR + (row * 32 + 8 * g) * 2), ub, acc, 0, 0, 0);
                Y[rt] = acc; }
#pragma unroll
            for (int kt = 0; kt < 4; ++kt) { const int row = 16 * kt + l15; f32x4 acc = xc[kt];
                acc = __builtin_amdgcn_mfma_f32_16x16x32_bf16(*(const LAS bf16x8*)(sl + CS_KC + (row * 32 + 8 * g) * 2), vop, acc, 0, 0, 0);
                acc = __builtin_amdgcn_mfma_f32_16x16x32_bf16(*(const LAS bf16x8*)(sl + CS_BC + (row * 32 + 8 * g) * 2), ub, acc, 0, 0, 0);
                xc[kt] = acc * *(const LAS f32x4*)(sl + CS_GL + (16 * kt + 4 * g) * 4); }
            LDS_WAIT();
            if (lane == 0) (void)__hip_atomic_fetch_add(done + s, 1u, __ATOMIC_RELAXED, __HIP_MEMORY_SCOPE_WORKGROUP);
#pragma unroll
            for (int rt = 0; rt < 2; ++rt)
#pragma unroll
                for (int e = 0; e < 4; ++e) { const size_t m = (size_t)b * SEQ + (size_t)c * CS_L + 16 * rt + 4 * g + e;
                    YAB[m * 2048 + 1024 + h * 64 + 16 * vb + l15] = (bf16_t)(pk2(Y[rt][e], 0.f) & 0xffffu); }
        }
    }
}

constexpr int DS_NQ = 16, DS_CAP = 2048, DS_TRIG = 1536, DS_TOPK = 256;
constexpr int DS_HIST_WORDS = 320;
constexpr int DS_CAND_OFF = 0, DS_HIST_OFF = DS_NQ * DS_CAP * 4, DS_CNT_OFF = DS_HIST_OFF + 8 * DS_HIST_WORDS * 4, DS_TAU_OFF = DS_CNT_OFF + 64;
static_assert(DS_TAU_OFF + 64 <= LDS_BYTES, "dsa LDS map");

template <int CTRL, int RM> __device__ __forceinline__ unsigned dppu(unsigned x) { return (unsigned)__builtin_amdgcn_update_dpp(0, (int)x, CTRL, RM, 0xf, true); }
__device__ __forceinline__ unsigned wave_scan_incl(unsigned v) {
    v += dppu<0x111, 0xf>(v); v += dppu<0x112, 0xf>(v); v += dppu<0x114, 0xf>(v); v += dppu<0x118, 0xf>(v);
    v += dppu<0x142, 0xa>(v);
    v += dppu<0x143, 0xc>(v);
    return v; }
template <int NE>
__device__ __forceinline__ void select_compact(LAS unsigned* cq, LAS unsigned* cntq, LAS unsigned* tauq, LAS unsigned* hist, int lane) {
    const unsigned n = *cntq;
    unsigned e[NE];
#pragma unroll
    for (int j = 0; j < NE; ++j) { const unsigned idx = lane + 64 * j; e[j] = idx < n ? cq[idx] : 0u; }
    unsigned npos = 0u;
#pragma unroll
    for (int j = 0; j < NE; ++j) npos += (unsigned)__popcll(__ballot(e[j] >= 0x80000000u));
    if (npos >= (unsigned)DS_TOPK) {
#pragma unroll
        for (int j = 0; j < NE; ++j) e[j] = (e[j] >= 0x80000000u) ? e[j] : 0u; }
    unsigned va = 0xFFFFFFFFu, vo = 0u;
#pragma unroll
    for (int j = 0; j < NE; ++j) { va &= (e[j] != 0u) ? e[j] : 0xFFFFFFFFu; vo |= e[j]; }
    va &= (unsigned)__builtin_amdgcn_update_dpp(-1, (int)va, 0xB1, 0xf, 0xf, true); va &= (unsigned)__builtin_amdgcn_update_dpp(-1, (int)va, 0x4E, 0xf, 0xf, true);
    va &= (unsigned)__builtin_amdgcn_update_dpp(-1, (int)va, 0x141, 0xf, 0xf, true); va &= (unsigned)__builtin_amdgcn_update_dpp(-1, (int)va, 0x140, 0xf, 0xf, true);
    vo |= dppu<0xB1, 0xf>(vo); vo |= dppu<0x4E, 0xf>(vo); vo |= dppu<0x141, 0xf>(vo); vo |= dppu<0x140, 0xf>(vo);
    const unsigned vas = (unsigned)(__builtin_amdgcn_readlane((int)va, 0) & __builtin_amdgcn_readlane((int)va, 16) & __builtin_amdgcn_readlane((int)va, 32) & __builtin_amdgcn_readlane((int)va, 48));
    const unsigned vos = (unsigned)(__builtin_amdgcn_readlane((int)vo, 0) | __builtin_amdgcn_readlane((int)vo, 16) | __builtin_amdgcn_readlane((int)vo, 32) | __builtin_amdgcn_readlane((int)vo, 48));
    const unsigned diff = vas ^ vos;
    const int top = diff ? 31 - __builtin_clz(diff) : 7;
    unsigned prefix = (top >= 31) ? 0u : (vos & ~((2u << top) - 1u)), mask = (top >= 31) ? 0u : ~((2u << top) - 1u), need = DS_TOPK;
    int hi = top;
    const int rl = 63 - lane;
#pragma unroll 1
    for (int pass = 0; pass < 4 && hi >= 0; ++pass) {
        const int shift = hi >= 7 ? hi - 7 : 0; const unsigned dmask = (hi >= 7) ? 0xFFu : ((2u << hi) - 1u);
        *(LAS u32x4*)(hist + 4 * lane) = (u32x4){0u, 0u, 0u, 0u};
        LDS_WAIT();
#pragma unroll
        for (int j = 0; j < NE; ++j) { const bool hit = (e[j] != 0u) && ((e[j] & mask) == prefix); const unsigned bin = hit ? ((e[j] >> shift) & dmask) : (256u + (unsigned)lane);
            (void)__hip_atomic_fetch_add(hist + bin, 1u, __ATOMIC_RELAXED, __HIP_MEMORY_SCOPE_WORKGROUP); }
        LDS_WAIT();
        const u32x4 h4 = *(const LAS u32x4*)(hist + 4 * rl);
        const unsigned tot = (h4.x + h4.y) + (h4.z + h4.w);
        const unsigned v = wave_scan_incl(tot);
        const unsigned above = v - tot;
        const bool is = (above < need) && (need <= v);
        unsigned B = 0u, ca = 0u;
        if (is) { unsigned c = above;
            if (c + h4.w >= need) { B = 4 * rl + 3; ca = c; } else { c += h4.w;
            if (c + h4.z >= need) { B = 4 * rl + 2; ca = c; } else { c += h4.z;
            if (c + h4.y >= need) { B = 4 * rl + 1; ca = c; } else { c += h4.y; B = 4 * rl; ca = c; } } } }
        const unsigned long long bal = __ballot(is);
        if (bal == 0ull) break;
        const int src = __builtin_amdgcn_readfirstlane(__ffsll((long long)bal) - 1);
        B = (unsigned)__builtin_amdgcn_readlane((int)B, src); ca = (unsigned)__builtin_amdgcn_readlane((int)ca, src);
        need -= ca; prefix |= B << shift; mask |= dmask << shift; hi = shift - 1;
    }
    const unsigned T = prefix;
    unsigned base = 0u;
#pragma unroll
    for (int j = 0; j < NE; ++j) { const bool keep = (e[j] >= T) && (e[j] != 0u); const unsigned long long bal = __ballot(keep);
        const unsigned pos = base + __builtin_amdgcn_mbcnt_hi((unsigned)(bal >> 32), __builtin_amdgcn_mbcnt_lo((unsigned)bal, 0u));
        if (keep) cq[pos] = e[j];
        base += (unsigned)__popcll(bal); }
    if (lane == 0) { *cntq = base; *tauq = T; }
    LDS_WAIT();
}

template <int NE>
__device__ __forceinline__ void filter_compact(LAS unsigned* cq, LAS unsigned* cntq, LAS unsigned* tauq, int lane) {
    const unsigned n = *cntq;
    unsigned e[NE];
#pragma unroll
    for (int j = 0; j < NE; ++j) { const unsigned idx = lane + 64 * j; e[j] = idx < n ? cq[idx] : 0u; }
    unsigned m0 = 0u, m1 = 0u, m2 = 0u, m3 = 0u;
#pragma unroll
    for (int j = 0; j < NE; ++j) { unsigned x = e[j], t;
        t = max(m0, x); x = min(m0, x); m0 = t; t = max(m1, x); x = min(m1, x); m1 = t; t = max(m2, x); x = min(m2, x); m2 = t; m3 = max(m3, x); }
    unsigned T = m3;
    T = min(T, (unsigned)__builtin_amdgcn_update_dpp(-1, (int)T, 0xB1, 0xf, 0xf, true)); T = min(T, (unsigned)__builtin_amdgcn_update_dpp(-1, (int)T, 0x4E, 0xf, 0xf, true));
    T = min(T, (unsigned)__builtin_amdgcn_update_dpp(-1, (int)T, 0x141, 0xf, 0xf, true)); T = min(T, (unsigned)__builtin_amdgcn_update_dpp(-1, (int)T, 0x140, 0xf, 0xf, true));
    T = min(min((unsigned)__builtin_amdgcn_readlane((int)T, 0), (unsigned)__builtin_amdgcn_readlane((int)T, 16)), min((unsigned)__builtin_amdgcn_readlane((int)T, 32), (unsigned)__builtin_amdgcn_readlane((int)T, 48)));
    unsigned base = 0u;
#pragma unroll
    for (int j = 0; j < NE; ++j) { const bool keep = (e[j] >= T) && (e[j] != 0u); const unsigned long long bal = __ballot(keep);
        const unsigned pos = base + __builtin_amdgcn_mbcnt_hi((unsigned)(bal >> 32), __builtin_amdgcn_mbcnt_lo((unsigned)bal, 0u));
        if (keep) cq[pos] = e[j];
        base += (unsigned)__popcll(bal); }
    if (lane == 0) { *cntq = base; *tauq = (T > 0u) ? T - 1u : 0u; }
    LDS_WAIT();
}

__device__ __forceinline__ unsigned vrow_off(int pr) { return (unsigned)(pr < 28 ? 1024 + 256 * pr : 9216 + 256 * (pr - 28)); }
__device__ __forceinline__ unsigned swz_b(int row) { return (unsigned)(((row & 3) << 2) | ((row >> 2) & 3)); }

__device__ __forceinline__ void dsa_phase(const Args& a, const int wave, LAS unsigned char* lds, const bool dry = false) {
    const bf16_t* Qg = (const bf16_t*)(a.ws + WS_Q); const bf16_t* KVg = (const bf16_t*)(a.ws + WS_KV); const bf16_t* QIg = (const bf16_t*)(a.ws + WS_QI);
    const bf16_t* KIg = (const bf16_t*)(a.ws + WS_KI); const float* WIg = (const float*)(a.ws + WS_WI); bf16_t* Gg = (bf16_t*)(a.ws + WS_G);
    LAS unsigned* cand = (LAS unsigned*)(lds + DS_CAND_OFF); LAS unsigned* hist = (LAS unsigned*)(lds + DS_HIST_OFF) + wave * DS_HIST_WORDS;
    LAS unsigned* cnt = (LAS unsigned*)(lds + DS_CNT_OFF); LAS unsigned* taup = (LAS unsigned*)(lds + DS_TAU_OFF);
    for (int L = blockIdx.x; L < 2048; L += gridDim.x) {
        int lane; asm volatile("v_mbcnt_lo_u32_b32 %0, -1, 0\n\tv_mbcnt_hi_u32_b32 %0, -1, %0" : "=v"(lane));
        const int tid = wave * 64 + lane, ql = lane & 15, gq = lane >> 4;
        int b, j;
        if (gridDim.x == 256) { const int i = blockIdx.x, ui = L >> 8, x = i & 7, li = (i >> 3) * 2 + (x >> 2); b = x & 3; j = 128 * (ui >> 1) + ((ui & 1) ? 127 - li : li); }
        else { b = L >> 9; j = L & 511; }
        const unsigned mb = (unsigned)b * SEQ; const int q0 = DS_NQ * j; const unsigned mq = mb + q0 + ql;
        const int pos0 = a.pos[mb]; int nadm = ((a.pos[mq] >> 6) + 1) * 64 - pos0; nadm = nadm > SEQ ? SEQ : nadm;
        int nmax = ((a.pos[mb + q0 + DS_NQ - 1] >> 6) + 1) * 64 - pos0; nmax = nmax > SEQ ? SEQ : nmax;
        const int nstep = (nmax + 511) >> 9;
#ifdef DSA_REP_STREAM
        for (int srep_ = 0; srep_ < 2; ++srep_) {
#endif
        __syncthreads();
        if (tid < DS_NQ) { cnt[tid] = 0u; taup[tid] = 0u; }
        bf16x8 bq[8][2];
#pragma unroll
        for (int h = 0; h < 8; ++h)
#pragma unroll
            for (int ks = 0; ks < 2; ++ks) bq[h][ks] = *(const bf16x8*)(QIg + (mq * 512u + h * 64 + 32 * ks + 8 * gq));
        f32x2 wh[8]; { const f32x4 w0 = *(const f32x4*)(WIg + mq * 8), w1 = *(const f32x4*)(WIg + mq * 8 + 4);
#pragma unroll
            for (int h = 0; h < 4; ++h) { wh[h] = (f32x2){w0[h], w0[h]}; wh[4 + h] = (f32x2){w1[h], w1[h]}; } }
        __syncthreads();
        bf16x8 ka[4][2];
        { const bf16_t* kr = KIg + ((mb + 64 * wave + ql) * 64u + 8u * gq);
#pragma unroll
          for (int st = 0; st < 4; ++st)
#pragma unroll
            for (int ks = 0; ks < 2; ++ks) ka[st][ks] = *(const bf16x8*)(kr + st * 16 * 64 + 32 * ks); }
        for (int step = 0; step <= nstep; ++step) {
            const int kb = 512 * step + 64 * wave; const bool active = (kb < nmax) && (step < nstep);
            PROBE_BEGIN(2, a.ws, wave);
            if (active) {
                f32x2 sc2[8];
#ifdef DSA_SCORE2
                for (int srep2_ = 0; srep2_ < 2; ++srep2_) {
#endif
#pragma unroll
                for (int i = 0; i < 8; ++i) sc2[i] = (f32x2){0.f, 0.f};
#pragma unroll
                for (int h = 0; h < 8; ++h)
#pragma unroll
                    for (int st = 0; st < 4; ++st) { f32x4 acc = (f32x4){0.f, 0.f, 0.f, 0.f};
#pragma unroll
                        for (int ks = 0; ks < 2; ++ks) acc = __builtin_amdgcn_mfma_f32_16x16x32_bf16(ka[st][ks], bq[h][ks], acc, 0, 0, 0);
                        sc2[2 * st] += wh[h] * (f32x2){fmaxf(acc[0], 0.f), fmaxf(acc[1], 0.f)}; sc2[2 * st + 1] += wh[h] * (f32x2){fmaxf(acc[2], 0.f), fmaxf(acc[3], 0.f)};
                        if (st == 3 && (h & 1)) __builtin_amdgcn_sched_barrier(0); }
#ifdef DSA_SCORE2
#pragma unroll
                for (int i = 0; i < 8; ++i) asm volatile("" : "+v"(sc2[i]));
                }
#endif
                float sc[16];
#pragma unroll
                for (int i = 0; i < 8; ++i) { sc[2 * i] = sc2[i][0]; sc[2 * i + 1] = sc2[i][1]; }
                __builtin_amdgcn_sched_barrier(0);
                { const int kbn = (kb + 512 < SEQ) ? kb + 512 : kb; unsigned ko0 = (mb + kbn + ql) * 64u + 8u * gq, ko1 = ko0 + 2048u;
                  asm volatile("" : "+v"(ko0), "+v"(ko1));
#pragma unroll
                  for (int st = 0; st < 4; ++st)
#pragma unroll
                    for (int ks = 0; ks < 2; ++ks) ka[st][ks] = *(const bf16x8*)(KIg + ((st & 2) ? ko1 : ko0) + (st & 1) * 16 * 64 + 32 * ks); }
                const unsigned tp = taup[ql]; unsigned pm = 0u;
#pragma unroll
                for (int i = 0; i < 16; ++i) { const int key = kb + 16 * (i >> 2) + 4 * gq + (i & 3); const unsigned u = __float_as_uint(sc[i]);
                    const unsigned ord = (u & 0x80000000u) ? ~u : (u | 0x80000000u); const unsigned pk = (ord & 0xFFFFE000u) | (unsigned)key;
                    sc[i] = __uint_as_float(pk);
                    if (key < nadm && pk > tp) pm |= 1u << i; }
                const unsigned n = (unsigned)__popc(pm);
                unsigned k = 0u; if (n) k = __hip_atomic_fetch_add(cnt + ql, n, __ATOMIC_RELAXED, __HIP_MEMORY_SCOPE_WORKGROUP);
                LAS unsigned* cq = cand + ql * DS_CAP;
#pragma unroll
                for (int i = 0; i < 16; ++i) if (pm & (1u << i)) { cq[k] = __float_as_uint(sc[i]); ++k; }
            }
            __syncthreads();
            PROBE_END(2, a.ws, wave);
            const u32x4 c0 = *(const LAS u32x4*)(cnt), c1 = *(const LAS u32x4*)(cnt + 4), c2 = *(const LAS u32x4*)(cnt + 8), c3 = *(const LAS u32x4*)(cnt + 12);
            unsigned cm = max(max(max(c0.x, c0.y), max(c0.z, c0.w)), max(max(c1.x, c1.y), max(c1.z, c1.w)));
            cm = max(cm, max(max(max(c2.x, c2.y), max(c2.z, c2.w)), max(max(c3.x, c3.y), max(c3.z, c3.w))));
            const unsigned trig = (step == nstep) ? (unsigned)DS_TOPK : (unsigned)DS_TRIG;
#ifdef DSA_SEL2
            const int nsel = (step == nstep) ? 4 : 2;
#else
            const int nsel = 2;
#endif
            if (cm > trig) {
                PROBE_BEGIN(1, a.ws, wave);
#pragma unroll 1
                for (int qq = 0; qq < nsel; ++qq) { const int q = 2 * wave + (qq & 1); if (cnt[q] > trig || qq >= 2) {
                    if (step != nstep) filter_compact<32>(cand + q * DS_CAP, cnt + q, taup + q, lane);
                    if (step == nstep || cnt[q] > (unsigned)DS_TRIG) select_compact<32>(cand + q * DS_CAP, cnt + q, taup + q, hist, lane); } }
                __syncthreads();
                PROBE_END(1, a.ws, wave);
            }
        }
#ifdef DSA_REP_STREAM
        }
#endif
        const bf16_t* KVb = KVg + (size_t)mb * 256;
        int lane_a = lane; asm volatile("" : "+v"(lane_a));
        const int g16 = lane_a >> 4, l15 = lane_a & 15;
        const unsigned vbase = (unsigned)(size_t)(lds + DS_CAND_OFF) + (unsigned)wave * 16384u;
        unsigned ta0, ta1;
        { const int q = l15 >> 2, p = lane_a & 3; const int pr0 = 8 * g16 + q, pr1 = pr0 + 4;
          ta0 = vbase + vrow_off(pr0) + 16u * ((unsigned)(p >> 1) ^ swz_b(pr0)) + 8u * (unsigned)(p & 1);
          ta1 = vbase + vrow_off(pr1) + 16u * ((unsigned)(p >> 1) ^ swz_b(pr1)) + 8u * (unsigned)(p & 1); }
        unsigned vwa[8];
#pragma unroll
        for (int j2 = 0; j2 < 8; ++j2) { const int srow = 4 * j2 + g16; const int pr = (srow < 16) ? 8 * (srow >> 2) + (srow & 3) : 8 * ((srow - 16) >> 2) + 4 + (srow & 3);
            vwa[j2] = vbase + vrow_off(pr) + 16u * ((unsigned)l15 ^ swz_b(pr)); }
#ifdef DSA_REP_ATT
        for (int arep_ = 0; arep_ < 2; ++arep_) { const bool dry2 = dry || (arep_ == 0 && a.ph_hi > 0);
#else
        { const bool dry2 = dry;
#endif
#pragma unroll 1
        for (int qq = 0; qq < 2; ++qq) {
            const int q = 2 * wave + qq; const unsigned m = mb + q0 + q; const int n = (int)cnt[q]; const LAS unsigned* cq = cand + q * DS_CAP;
            bf16x8 qb[4];
#pragma unroll
            for (int ks = 0; ks < 4; ++ks) qb[ks] = *(const bf16x8*)(Qg + (m * 2048u + l15 * 128 + 32 * ks + 8 * g16));
            f32x4 sacc[16];
            const int nl = n - l15; const LAS unsigned* cql = cq + l15;
            bf16x8 kf[2][16];
            auto kload = [&](int grp, bf16x8 (&dst)[16]) {
#pragma unroll
                for (int t = 0; t < 4; ++t) { const int jt = 4 * grp + t; const unsigned e = cql[16 * jt]; const unsigned key = (16 * jt < nl) ? (e & 0x1FFFu) : 0u;
                    const bf16_t* kr = KVb + (key * 256u + 8u * g16);
#pragma unroll
                    for (int ks = 0; ks < 4; ++ks) dst[4 * t + ks] = *(const bf16x8*)(kr + 32 * ks); } };
            kload(0, kf[0]);
#pragma unroll
            for (int grp = 0; grp < 4; ++grp) {
                if (grp < 3) kload(grp + 1, kf[(grp + 1) & 1]);
#pragma unroll
                for (int t = 0; t < 4; ++t) { f32x4 acc = (f32x4){0.f, 0.f, 0.f, 0.f};
#pragma unroll
                    for (int ks = 0; ks < 4; ++ks) acc = __builtin_amdgcn_mfma_f32_16x16x32_bf16(kf[grp & 1][4 * t + ks], qb[ks], acc, 0, 0, 0);
                    sacc[4 * grp + t] = acc; }
                __builtin_amdgcn_sched_barrier(0);
            }
            u32x4 vr[2][8]; const int ng = n - g16; const LAS unsigned* cqg = cq + g16;
            auto vload = [&](int kk, u32x4 (&dst)[8]) {
#pragma unroll
                for (int j2 = 0; j2 < 8; ++j2) { const int sl = 32 * kk + 4 * j2; const unsigned e = cqg[sl]; const unsigned key = (sl < ng) ? (e & 0x1FFFu) : 0u;
                    dst[j2] = *(const u32x4*)(KVb + (key * 256u + 128u + 8u * l15)); } };
            vload(0, vr[0]); vload(1, vr[1]);
            __builtin_amdgcn_sched_barrier(0);
            float mx = -1e30f; const float nnf = (float)(n - 4 * g16 - 1);
#pragma unroll
            for (int jt = 0; jt < 16; ++jt)
#pragma unroll
                for (int r = 0; r < 4; ++r) { sacc[jt][r] = fmaf(fminf(nnf - (float)(16 * jt + r), 0.f), 1e30f, sacc[jt][r]); mx = fmaxf(mx, sacc[jt][r]); }
            mx = fmaxf(mx, __shfl_xor(mx, 16)); mx = fmaxf(mx, __shfl_xor(mx, 32));
            float sum = 0.f;
#pragma unroll
            for (int jt = 0; jt < 16; ++jt)
#pragma unroll
                for (int r = 0; r < 4; ++r) { const float p = __builtin_amdgcn_exp2f(sacc[jt][r] - mx); sacc[jt][r] = p; sum += p; }
            sum += __shfl_xor(sum, 16); sum += __shfl_xor(sum, 32);
            u32x4 pfr[8];
#pragma unroll
            for (int kk = 0; kk < 8; ++kk) { const f32x4 pa = sacc[2 * kk], pb2 = sacc[2 * kk + 1];
                pfr[kk].x = pk2(pa[0], pa[1]); pfr[kk].y = pk2(pa[2], pa[3]); pfr[kk].z = pk2(pb2[0], pb2[1]); pfr[kk].w = pk2(pb2[2], pb2[3]); }
            __builtin_amdgcn_sched_barrier(0);
            f32x4 o[8];
#pragma unroll
            for (int c = 0; c < 8; ++c) o[c] = (f32x4){0.f, 0.f, 0.f, 0.f};
#pragma unroll
            for (int kk = 0; kk < 8; ++kk) {
#pragma unroll
                for (int j2 = 0; j2 < 8; ++j2) *(LAS u32x4*)(size_t)vwa[j2] = vr[kk & 1][j2];
                __builtin_amdgcn_sched_barrier(0);
                if (kk + 2 < 8) vload(kk + 2, vr[kk & 1]);
                LDS_WAIT();
                const bf16x8 pfrag = __builtin_bit_cast(bf16x8, pfr[kk]);
#pragma unroll
                for (int ch = 0; ch < 2; ++ch) {
                    s16x4 t0[4], t1[4];
                    asm volatile("ds_read_b64_tr_b16 %0, %8\n\tds_read_b64_tr_b16 %1, %9\n\tds_read_b64_tr_b16 %2, %10\n\tds_read_b64_tr_b16 %3, %11\n\t"
                                 "ds_read_b64_tr_b16 %4, %12\n\tds_read_b64_tr_b16 %5, %13\n\tds_read_b64_tr_b16 %6, %14\n\tds_read_b64_tr_b16 %7, %15\n\ts_waitcnt lgkmcnt(0)"
                                 : "=&v"(t0[0]), "=&v"(t0[1]), "=&v"(t0[2]), "=&v"(t0[3]), "=&v"(t1[0]), "=&v"(t1[1]), "=&v"(t1[2]), "=&v"(t1[3])
                                 : "v"(ta0 ^ (unsigned)((4 * ch + 0) << 5)), "v"(ta0 ^ (unsigned)((4 * ch + 1) << 5)), "v"(ta0 ^ (unsigned)((4 * ch + 2) << 5)), "v"(ta0 ^ (unsigned)((4 * ch + 3) << 5)),
                                   "v"(ta1 ^ (unsigned)((4 * ch + 0) << 5)), "v"(ta1 ^ (unsigned)((4 * ch + 1) << 5)), "v"(ta1 ^ (unsigned)((4 * ch + 2) << 5)), "v"(ta1 ^ (unsigned)((4 * ch + 3) << 5)) : "memory");
                    __builtin_amdgcn_sched_barrier(0);
#pragma unroll
                    for (int c = 0; c < 4; ++c) { const bf16x8 av = __builtin_shufflevector(t0[c], t1[c], 0, 1, 2, 3, 4, 5, 6, 7);
                        o[4 * ch + c] = __builtin_amdgcn_mfma_f32_16x16x32_bf16(av, pfrag, o[4 * ch + c], 0, 0, 0); }
                }
            }
            const float inv = 1.0f / sum;
#pragma unroll
            for (int c = 0; c < 8; ++c) { bf16_t* gp = Gg + (m * 2048u + l15 * 128 + 16 * c + 4 * g16); const u32x2 gw = *(const u32x2*)gp;
                const f32x4 r = o[c] * inv * (f32x4){bflo(gw.x), bfhi(gw.x), bflo(gw.y), bfhi(gw.y)};
                u32x2 wv; wv.x = pk2(r[0], r[1]); wv.y = pk2(r[2], r[3]); if (!dry2) *(u32x2*)gp = wv; }
        }
        }
    }
}

#ifndef OLD_SCAN
#define OLD_SCAN 0
#endif
#ifndef MK_SPLIT
#define MK_SPLIT 0
#endif
#ifndef MK_PH_END
#define MK_PH_END 13
#endif
constexpr int N_PHASES = 13;

#define XB_TMO      128
#define XB_XCNT(j)  (256  + 64 * (j))
#define XB_XSUB(j)  (1280 + 64 * (j))
#define XB_XGEN(j)  (2304 + 64 * (j))
#define XB_TOP      3328
#define XB_TOPGEN   3392
#define XCD_BAR_WORDS 3456
#define XB_SPIN_CAP (1u << 18)

__device__ __forceinline__ unsigned xb_ld(unsigned* p)              { return __hip_atomic_load(p, __ATOMIC_RELAXED, __HIP_MEMORY_SCOPE_AGENT); }
__device__ __forceinline__ unsigned xb_add(unsigned* p, unsigned v) { return __hip_atomic_fetch_add(p, v, __ATOMIC_RELAXED, __HIP_MEMORY_SCOPE_AGENT); }
__device__ __forceinline__ unsigned xb_xcc_id() { return (unsigned)__builtin_amdgcn_s_getreg((3 << 11) | 20) & 0xFu; }
#define XB_SPIN(cond, bar) do { unsigned _sp = 0; while (cond) { __builtin_amdgcn_s_sleep(1); \
    if ((++_sp & 255u) == 0u) { if (xb_ld(&(bar)[XB_TMO])) break; if (_sp > XB_SPIN_CAP) { atomicAdd(&(bar)[XB_TMO], 1u); break; } } } } while (0)

struct XcdBarrier {
    unsigned* bar; unsigned x;
    volatile LAS unsigned* st;
};

__device__ __forceinline__ XcdBarrier xcd_barrier_post(unsigned* bar, volatile LAS unsigned* st, const int wave) {
    XcdBarrier b; b.bar = bar; b.x = xb_xcc_id(); b.st = st;
    if (lane_id() == 0 && wave == 0) (void)xb_add(&bar[XB_XCNT(b.x)], 1u);
    return b;
}
__device__ __forceinline__ void xcd_barrier_complete(unsigned* bar, unsigned x, unsigned& nloc, unsigned& nx) {
    const unsigned G = gridDim.x * gridDim.y * gridDim.z;
    unsigned sum, cnt, mine, sp = 0u;
    for (;;) {
        sum = 0u; cnt = 0u; mine = 0u;
#pragma unroll
        for (unsigned j = 0; j < 16; ++j) { const unsigned c = xb_ld(&bar[XB_XCNT(j)]); sum += c; cnt += (c > 0u) ? 1u : 0u; mine = (j == x) ? c : mine; }
        if (sum == G) break;
        __builtin_amdgcn_s_sleep(1);
        if ((++sp & 255u) == 0u) { if (xb_ld(&bar[XB_TMO])) break; if (sp > XB_SPIN_CAP) { atomicAdd(&bar[XB_TMO], 1u); break; } }
    }
    nloc = mine > 0u ? mine : 1u; nx = cnt > 0u ? cnt : 1u;
}

__device__ __forceinline__ void xcd_barrier(const XcdBarrier& b, const int wave) {
    asm volatile("s_waitcnt vmcnt(0)" ::: "memory");
    __syncthreads();
    if (wave == 0) { if (lane_id() == 0) {
        unsigned* bar = b.bar;
        __builtin_amdgcn_s_waitcnt(0);
        unsigned nloc = b.st[0], nx = b.st[1];
        if (nloc == 0u) { xcd_barrier_complete(bar, b.x, nloc, nx); b.st[0] = nloc; b.st[1] = nx; }
        const unsigned old = xb_add(&bar[XB_XSUB(b.x)], 1u);
        const unsigned gen = old / nloc;
        if (old + 1u == (gen + 1u) * nloc) {
            __builtin_amdgcn_fence(__ATOMIC_RELEASE, "agent");
            asm volatile("s_waitcnt vmcnt(0)" ::: "memory");
            const unsigned og = xb_add(&bar[XB_TOP], 1u);
            const unsigned tg = og / nx;
            if (og + 1u == (tg + 1u) * nx) xb_add(&bar[XB_TOPGEN], 1u);
            else XB_SPIN(xb_ld(&bar[XB_TOPGEN]) == tg, bar);
            __builtin_amdgcn_fence(__ATOMIC_ACQUIRE, "agent");
            xb_add(&bar[XB_XGEN(b.x)], 1u);
            asm volatile("s_waitcnt vmcnt(0)" ::: "memory");
        } else {
            XB_SPIN(xb_ld(&bar[XB_XGEN(b.x)]) == gen, bar);
            __builtin_amdgcn_fence(__ATOMIC_ACQUIRE, "agent");
            asm volatile("s_waitcnt vmcnt(0)" ::: "memory");
        }
    } }
    __syncthreads();
}

#define grid_bar(barptr, epoch, wv) xcd_barrier(xbar, (wv))
typedef const __attribute__((address_space(4))) Args* KArgs;
#if defined(__HIP_DEVICE_COMPILE__)
__device__ __forceinline__ Args kargs() { KArgs p = (KArgs)__builtin_amdgcn_kernarg_segment_ptr(); asm volatile("" : "+s"(p)); return *p; }
#else
__device__ __forceinline__ Args kargs() { return Args{}; }
#endif
#define PHASE_ARGS const Args a = kargs(); unsigned char* ws = a.ws; (void)ws

__global__ void __launch_bounds__(NTHREADS, 2) fwd_megakernel(Args a_by_value) {
    extern __shared__ __attribute__((aligned(16))) unsigned char lds_raw[];
    LAS unsigned char* lds = (LAS unsigned char*)lds_raw;
    cg::grid_group grid = cg::this_grid();
    const int wave = __builtin_amdgcn_readfirstlane((int)threadIdx.x >> 6);
    { volatile LAS unsigned* st0 = (volatile LAS unsigned*)(lds + LDS_BYTES - 16); if (wave == 0 && lane_id() < 4) st0[lane_id()] = 0u; __syncthreads(); }
    const XcdBarrier xbar = xcd_barrier_post((unsigned*)(kargs().ws + WS_BAR), (volatile LAS unsigned*)(lds + LDS_BYTES - 16), wave);
    int lo, hi; { const Args a0 = kargs(); lo = a0.ph_lo; hi = a0.ph_hi; }
#ifdef ONLY_PH
#define IN(k) ((k) == ONLY_PH && lo <= (k) && (k) < hi)
#else
#define IN(k) (lo <= (k) && (k) < hi)
#endif
#define SEAM(k) do { if (IN(k) && IN((k) + 1)) { if ((k) == 0) grid.sync(); else grid_bar((unsigned*)(kargs().ws + WS_BAR), (unsigned)(k), wave); } } while (0)
#ifdef REP_PH
#define NREP(k) ((k) == REP_PH ? 2 : 1)
#else
#define NREP(k) 1
#endif
#define REPEAT(k) for (int rep_ = 0; rep_ < NREP(k); ++rep_, (rep_ < NREP(k) ? grid_bar((unsigned*)(kargs().ws + WS_BAR) + 128, 1u, wave) : (void)0))
#ifdef STAMP_K
#define TSTAMP(k) do { if (((k) == STAMP_K || (k) == STAMP_K + 1) && blockIdx.x == 0 && wave == 0) { const unsigned long long t_ = __builtin_amdgcn_s_memrealtime(); \
        if (__builtin_amdgcn_mbcnt_lo(~0u, 0u) == 0u) ((unsigned long long*)(kargs().ws + WS_STAMP))[(k) - STAMP_K] = t_; } } while (0)
#else
#define TSTAMP(k) do { } while (0)
#endif
#ifdef STAMP_K
    if (blockIdx.x == PROBE_BLK && wave == 0) { unsigned long long* st_ = (unsigned long long*)(kargs().ws + WS_STAMP); if (__builtin_amdgcn_mbcnt_lo(~0u, 0u) < 3u) st_[__builtin_amdgcn_mbcnt_lo(~0u, 0u)] = 0ull; }
#endif
    TSTAMP(0);
    if (IN(0)) REPEAT(0) { PHASE_ARGS; p0_prologue(a, wave, lds); } SEAM(0); TSTAMP(1);
    if (IN(1)) REPEAT(1) { PHASE_ARGS; norm_phase(a, wave, lds, a.x, 0); } SEAM(1); TSTAMP(2);
    if (IN(2)) REPEAT(2) { PHASE_ARGS;
        pg8::Gemm g{(const bf16_t*)(ws + WS_H), (const bf16_t*)(ws + WS_WIN0), MTOK, N0, DM}; pg8::StaticOrder S; S.init(MTOK, N0, gridDim.x, blockIdx.x);
        #ifdef EPI0_CHEAP_FIRST
        Epi0 E{ws, (unsigned char*)a.out, NREP(2) == 2 && rep_ == 0 && a.ph_hi > 0};
#else
        Epi0 E{ws, (unsigned char*)a.out, false};
#endif
        pg8::gemm_phase<Epi0, pg8::StaticOrder, true, true>(lds, g, S, E, wave);
    } SEAM(2); TSTAMP(3);
    if (IN(3)) REPEAT(3) { PHASE_ARGS; conv_phase(a, wave, lds, blockIdx.x, gridDim.x); lora_pre_phase(a, wave); } SEAM(3); TSTAMP(4);
    if (IN(4)) REPEAT(4) { PHASE_ARGS;
        pg8::Gemm g{(const bf16_t*)((unsigned char*)a.out + DO_LA), (const bf16_t*)(ws + WS_WLORA), MTOK, 2048, 256}; pg8::StaticOrder S; S.init(MTOK, 2048, gridDim.x, blockIdx.x);
        EpiLora E{(bf16_t*)(ws + WS_DARR), (bf16_t*)(ws + WS_AARR), a.rwkv_vec};
        pg8::gemm_phase<EpiLora, pg8::StaticOrder, true, true>(lds, g, S, E, wave);
    } SEAM(4); TSTAMP(5);
    if (IN(5)) REPEAT(5) { PHASE_ARGS;
#if OLD_SCAN
        scan_phase(a, wave, lds);
#else
        unsigned* pbar = (unsigned*)(ws + WS_BAR) + 256;
        { __syncthreads(); if (wave == 0 && lane_id() < 8) ((LAS unsigned*)(lds + CS_FLAGS))[lane_id()] = 0u; __syncthreads(); }
        for (int r = 0; r <= CR_NP; ++r) {
            if (blockIdx.x >= 64) { if (r < CR_NP) cscan_produce(a, wave, lds, r, 64, gridDim.x - 64); }
            else if (r >= 1) {
                const int piece = r - 1;
                f32x4 xc[4]; f32x4* sv = (f32x4*)(ws + WS_XSAVE) + ((size_t)(blockIdx.x * 4 + (wave & 3)) * 64 + lane_id()) * 4;
#pragma unroll
                for (int kt = 0; kt < 4; ++kt) xc[kt] = (piece == 0 || wave >= 4) ? (f32x4){0.f, 0.f, 0.f, 0.f} : sv[kt];
                cscan_consume(a, wave, lds, blockIdx.x, piece, xc);
                if (wave < 4) {
#pragma unroll
                    for (int kt = 0; kt < 4; ++kt) sv[kt] = xc[kt]; }
            }
            grid_bar(pbar, (unsigned)(r + 1), wave);
#ifdef BAR2
            grid_bar(pbar + 128, (unsigned)(r + 1), wave);
#endif
        }
#endif
    } SEAM(5); TSTAMP(6);
    if (IN(6)) REPEAT(6) { PHASE_ARGS; post_phase(a, wave); } SEAM(6); TSTAMP(7);
    if (IN(7)) REPEAT(7) { PHASE_ARGS;
        pg8::Gemm g{(const bf16_t*)(ws + WS_YAB), (const bf16_t*)(ws + WS_WOUT0), MTOK, DM, 2048}; pg8::StaticOrder S; S.init(MTOK, DM, gridDim.x, blockIdx.x);
        EpiRes E{a.x, a.out, (const float*)(ws + WS_MODP), a.ada_b, 0};
        pg8::gemm_phase<EpiRes, pg8::StaticOrder, true, true>(lds, g, S, E, wave);
    } SEAM(7); TSTAMP(8);
    if (IN(8)) REPEAT(8) { PHASE_ARGS; norm_phase(a, wave, lds, a.out, 1); } SEAM(8); TSTAMP(9);
    if (IN(9)) REPEAT(9) { PHASE_ARGS;
        pg8::Gemm g{(const bf16_t*)(ws + WS_H), (const bf16_t*)(ws + WS_WIN1), MTOK, N1, DM}; pg8::StaticOrder S; S.init(MTOK, N1, gridDim.x, blockIdx.x);
        Epi1 E{(bf16_t*)(ws + WS_Q), (bf16_t*)(ws + WS_KV), (bf16_t*)(ws + WS_QI), (bf16_t*)(ws + WS_KI), (bf16_t*)(ws + WS_G), (float*)(ws + WS_WI), (const f32x2*)(ws + WS_CSA), (const f32x2*)(ws + WS_CSI)};
        pg8::gemm_phase<Epi1, pg8::StaticOrder, true, true>(lds, g, S, E, wave);
    } SEAM(9); TSTAMP(10);
    if (IN(10)) REPEAT(10) { PHASE_ARGS; dsa_phase(a, wave, lds, NREP(10) == 2 && rep_ == 0 && a.ph_hi > 0); } SEAM(10); TSTAMP(11);
    if (IN(11)) REPEAT(11) { PHASE_ARGS;
        pg8::Gemm g{(const bf16_t*)(ws + WS_G), (const bf16_t*)(ws + WS_WOUT1), MTOK, DM, 2048}; pg8::StaticOrder S; S.init(MTOK, DM, gridDim.x, blockIdx.x);
        EpiRes E{a.out, a.out, (const float*)(ws + WS_MODP), a.ada_b, 1};
        pg8::gemm_phase<EpiRes, pg8::StaticOrder, true, true>(lds, g, S, E, wave);
    } SEAM(11); TSTAMP(12);
    if (IN(12)) REPEAT(12) { PHASE_ARGS; final_phase(a, wave); }
#undef IN
#undef SEAM
}

extern "C" void kernel_launch(void* const* d_in, const int* in_sizes, int n_in, void* d_out, int out_size, void* d_ws, size_t ws_size, hipStream_t stream) {
    static int grid = 0;
    if (grid == 0) {
        if (n_in != 19 || out_size != MTOK * DM || ws_size < WS_NEED) { fprintf(stderr, "kernel_launch: unexpected shapes (n_in %d, out %d, ws %zu)\n", n_in, out_size, ws_size); grid = -1; return; }
        int dev = 0, cus = 0, per_cu = 0;
        (void)hipGetDevice(&dev); (void)hipDeviceGetAttribute(&cus, hipDeviceAttributeMultiprocessorCount, dev);
        if (hipFuncSetAttribute((const void*)fwd_megakernel, hipFuncAttributeMaxDynamicSharedMemorySize, LDS_BYTES) != hipSuccess) { fprintf(stderr, "kernel_launch: hipFuncSetAttribute failed\n"); grid = -1; return; }
        if (hipOccupancyMaxActiveBlocksPerMultiprocessor(&per_cu, (const void*)fwd_megakernel, NTHREADS, LDS_BYTES) != hipSuccess || per_cu < 1) { fprintf(stderr, "kernel_launch: occupancy query says %d\n", per_cu); per_cu = 1; }
        (void)hipGetLastError();
        grid = cus;
        if (grid > 256) grid = 256;
    }
    if (grid < 0) return;
    Args a{};
    a.x = (const float*)d_in[0]; a.c = (const float*)d_in[1]; a.pos = (const int*)d_in[2]; a.ada_w = (const float*)d_in[3]; a.ada_b = (const float*)d_in[4];
    a.norm_g = (const float*)d_in[5]; a.final_g = (const float*)d_in[6]; a.even_w_in = (const float*)d_in[7]; a.even_w_out = (const float*)d_in[8];
    a.conv_w = (const float*)d_in[9]; a.conv_vec = (const float*)d_in[10]; a.mu_rkv = (const float*)d_in[11]; a.mu_lora = (const float*)d_in[12];
    a.rwkv_vec = (const float*)d_in[13]; a.w_up = (const float*)d_in[14]; a.a_up = (const float*)d_in[15]; a.r_k = (const float*)d_in[16];
    a.odd_w_in = (const float*)d_in[17]; a.odd_w_out = (const float*)d_in[18];
    a.out = (float*)d_out; a.ws = (unsigned char*)d_ws;
    (void)hipMemsetAsync((char*)d_ws + WS_BAR, 0, 65536, stream);
#if MK_SPLIT
    for (int p = 0; p < MK_PH_END; ++p) { a.ph_lo = p; a.ph_hi = p + 1; void* args[] = {&a};
        hipError_t e = hipLaunchCooperativeKernel((const void*)fwd_megakernel, dim3(grid), dim3(NTHREADS), args, LDS_BYTES, stream);
        if (e != hipSuccess) { fprintf(stderr, "launch %d failed: %s\n", p, hipGetErrorString(e)); break; } }
#else
    a.ph_lo = 0; a.ph_hi = MK_PH_END; void* args[] = {&a};
    hipError_t e = hipLaunchCooperativeKernel((const void*)fwd_megakernel, dim3(grid), dim3(NTHREADS), args, LDS_BYTES, stream);
    if (e != hipSuccess) fprintf(stderr, "cooperative launch failed: %s (grid %d)\n", hipGetErrorString(e), grid);
#endif
}
```

```cpp
#include <hip/hip_runtime.h>
#include <hip/hip_cooperative_groups.h>
#include <cstdio>
#include <cstdint>
namespace cg = cooperative_groups;

#define LAS __attribute__((address_space(3)))
typedef unsigned short bf16_t;
typedef float f32x4 __attribute__((ext_vector_type(4)));
typedef float f32x2 __attribute__((ext_vector_type(2)));
typedef float f32x16 __attribute__((ext_vector_type(16)));
typedef unsigned u32x4 __attribute__((ext_vector_type(4)));
typedef unsigned u32x2 __attribute__((ext_vector_type(2)));
typedef short bf16x8 __attribute__((ext_vector_type(8)));
typedef short s16x4 __attribute__((ext_vector_type(4)));

constexpr int BATCH = 4, SEQ = 8192, DM = 1024, MTOK = BATCH * SEQ;
constexpr int N0 = 7424, N1 = 5120;
constexpr int EVEN_COLS = 7296, ODD_COLS = 4936;
constexpr int NWAVES = 8, NTHREADS = 512;
constexpr int LDS_BYTES = 155648;

constexpr size_t MiB = 1u << 20;
constexpr size_t WS_MODP = 0; constexpr size_t WS_STAMP = 3 * MiB; constexpr size_t WS_XSAVE = 1 * MiB;
constexpr size_t WS_BAR = 3 * MiB + 512 * 1024;
constexpr size_t WS_WIN0 = 4 * MiB, WS_WOUT0 = 20 * MiB, WS_WIN1 = 24 * MiB, WS_WOUT1 = 34 * MiB, WS_WLORA = 38 * MiB;
constexpr size_t WS_CSA = 40 * MiB, WS_CSI = 56 * MiB;
constexpr size_t WS_H = 64 * MiB;
constexpr size_t WS_YAB = 64 * MiB;
constexpr size_t WS_U = 192 * MiB, WS_AG = 256 * MiB, WS_R = 320 * MiB, WS_K = 384 * MiB, WS_V = 448 * MiB;
constexpr size_t WS_AARR = WS_U, WS_DARR = WS_AG;
constexpr size_t WS_Q = 128 * MiB, WS_G = 256 * MiB, WS_KV = 384 * MiB, WS_QI = 400 * MiB, WS_KI = 432 * MiB, WS_WI = 436 * MiB;
constexpr size_t WS_NEED = 512 * MiB;
constexpr size_t DO_BG = 0, DO_WDAD = 64 * MiB, DO_LA = 72 * MiB, DO_RK = 64 * MiB;

__device__ __forceinline__ float bflo(unsigned w) { return __uint_as_float(w << 16); }
__device__ __forceinline__ float bfhi(unsigned w) { return __uint_as_float(w & 0xffff0000u); }
typedef __bf16 bf16x2_t __attribute__((ext_vector_type(2)));
__device__ __forceinline__ unsigned pk2(float lo, float hi) { const f32x2 v = {lo, hi}; const bf16x2_t b = __builtin_convertvector(v, bf16x2_t); return __builtin_bit_cast(unsigned, b); }
__device__ __forceinline__ float sigmoidf_(float x) { return __builtin_amdgcn_rcpf(1.0f + __expf(-x)); }
__device__ __forceinline__ float wave_sum(float v) {
#pragma unroll
    for (int o = 1; o < 64; o <<= 1) v += __shfl_xor(v, o);
    return v;
}
template <int CTRL> __device__ __forceinline__ float dppmov(float x) { return __int_as_float(__builtin_amdgcn_update_dpp(0, __float_as_int(x), CTRL, 0xf, 0xf, true)); }
__device__ __forceinline__ float quad_sum(float x) { x += dppmov<0xB1>(x); x += dppmov<0x4E>(x); return x; }
__device__ __forceinline__ float row16_sum(float x) { x += dppmov<0xB1>(x); x += dppmov<0x4E>(x); x += dppmov<0x141>(x); x += dppmov<0x140>(x); return x; }
__device__ __forceinline__ int lane_id() { int l; asm volatile("v_mbcnt_lo_u32_b32 %0, -1, 0\n\tv_mbcnt_hi_u32_b32 %0, -1, %0" : "=v"(l)); return l; }
#define LDS_WAIT() asm volatile("s_waitcnt lgkmcnt(0)" ::: "memory")

__device__ __forceinline__ int map0(int n) {
    const int t = n >> 8, r = n & 255;
    if (t < 8) return (r < 128) ? 128 * t + r : 1024 + 128 * t + (r - 128);
    if (t < 12) return 2048 + 256 * (t - 8) + r;
    if (t < 24) return 3072 + 256 * (t - 12) + r;
    if (t < 28) return 6272 + 256 * (t - 24) + r;
    return (r < 128) ? 6144 + r : -1;
}
__device__ __forceinline__ int map1(int n) {
    const int t = n >> 8, r = n & 255, half = r >> 7, rr = r & 127;
    if (t < 8) return (2 * t + (rr >> 6)) * 128 + half * 64 + (rr & 63);
    if (t == 8) return 2048 + (rr >> 6) * 128 + half * 64 + (rr & 63);
    if (t < 11) return 2304 + (4 * (t - 9) + (rr >> 5)) * 64 + half * 32 + (rr & 31);
    if (t == 11) { if (rr < 32) return 2816 + half * 32 + rr; if (half == 0 && rr < 40) return 2880 + (rr - 32); return -1; }
    return 2888 + 256 * (t - 12) + r;
}

#ifndef PROBE_BLK
#define PROBE_BLK 0
#endif
#ifndef PROBE_WAVE
#define PROBE_WAVE 0
#endif
#if defined(STAMP_K) && defined(PROBE_SEC)
#define PROBE_BEGIN(sec, wsp, wv) unsigned long long PT0_##sec = 0; if ((sec) == PROBE_SEC && blockIdx.x == PROBE_BLK && (wv) == PROBE_WAVE) PT0_##sec = __builtin_amdgcn_s_memrealtime()
#define PROBE_END(sec, wsp, wv) do { if ((sec) == PROBE_SEC && blockIdx.x == PROBE_BLK && (wv) == PROBE_WAVE) { const unsigned long long dt_ = __builtin_amdgcn_s_memrealtime() - PT0_##sec; \
        if (__builtin_amdgcn_mbcnt_lo(~0u, 0u) == 0u) __hip_atomic_fetch_add((unsigned long long*)((wsp) + WS_STAMP) + 2, dt_, __ATOMIC_RELAXED, __HIP_MEMORY_SCOPE_AGENT); } } while (0)
#else
#define PROBE_BEGIN(sec, wsp, wv) do { } while (0)
#define PROBE_END(sec, wsp, wv) do { } while (0)
#endif
namespace pg8 {
#define PG8_LAS __attribute__((address_space(3)))
typedef unsigned short bf16_t;
typedef short bf16x8 __attribute__((ext_vector_type(8)));
typedef float f32x4 __attribute__((ext_vector_type(4)));
typedef unsigned u32x4 __attribute__((ext_vector_type(4)));
constexpr int BM = 256, BK = 64, HALF = 128, HTB = HALF * BK * 2  , STAGE_BYTES = 8 * HTB, NXCD = 8, WGM = 8;

__host__ __device__ __forceinline__ int lds_byte(int r, int c) { const int st = (r >> 4) * 2 + (c >> 5), rr = r & 15, cc = c & 31, ob = rr * 64 + cc * 2; return st * 1024 + (ob ^ (((ob >> 9) & 1) << 5)); }
__host__ __device__ __forceinline__ void stage_rc(int b, int& R, int& C) { const int st = b / 1024, sb = b % 1024, swz = sb ^ (((sb >> 9) & 1) << 5); R = (st >> 1) * 16 + swz / 64; C = (st & 1) * 32 + (swz % 64) / 2; }
__host__ __device__ __forceinline__ int perm32(int rho) { const int n = rho >> 4, i = rho & 15; return 8 * (i >> 2) + 4 * n + (i & 3); }

struct Unit { int pm, pn; };
struct Gemm { const bf16_t* A; const bf16_t* Bt; int M, N, K; };

struct StaticOrder {
    int nM, nN, nwg, G, c;
    __host__ __device__ void init(int M, int N, int G_, int c_) { nM = M / BM; nN = N / BM; nwg = nM * nN; G = G_; c = c_; }
    __host__ __device__ bool next(int i, Unit& u) const {
        const long L = (long)i * G + c; if (L >= nwg) return false;
        int wgid = (int)L; { const int q = nwg / NXCD, r = nwg % NXCD, xcd = wgid % NXCD, off = wgid / NXCD; wgid = (xcd < r ? xcd * (q + 1) : r * (q + 1) + (xcd - r) * q) + off; }
        const int nig = WGM * nN, gid = wgid / nig, fm = gid * WGM, gsz = (nM - fm) < WGM ? (nM - fm) : WGM;
        u.pm = fm + ((wgid % nig) % gsz); u.pn = (wgid % nig) / gsz; return true;
    }
    __device__ __forceinline__ void a_ready(const Unit&) const {}
    __device__ __forceinline__ void done(const Unit&) const {}
};

__device__ __forceinline__ unsigned cvt_pk_bf16(float lo, float hi) { unsigned r; asm volatile("v_cvt_pk_bf16_f32 %0, %1, %2" : "=v"(r) : "v"(lo), "v"(hi)); return r; }
typedef float f32x2 __attribute__((ext_vector_type(2)));
template <class Epi, class Sched, bool ALIGN_EPI = false, bool SP2 = false>
__device__ __forceinline__ void gemm_phase(PG8_LAS unsigned char* lds, const Gemm g, const Sched& S, const Epi& E, const int wave_in) {
    int lane; asm volatile("v_mbcnt_lo_u32_b32 %0, -1, 0\n\tv_mbcnt_hi_u32_b32 %0, -1, %0" : "=v"(lane));
    const int wid = wave_in, tid = wid * 64 + lane, wr = wid >> 2, wc = wid & 3, fr = lane & 15, fq = lane >> 4;
    const int K = g.K, nt = K / BK;
    unsigned voffA[2], voffB[2];
#pragma unroll
    for (int i = 0; i < 2; ++i) { int R, C; stage_rc(tid * 16 + i * 8192, R, C); const int Rb = Epi::PERM ? ((R & ~31) + perm32(R & 31)) : R;
        voffA[i] = (unsigned)(R * K + C) * 2u; voffB[i] = (unsigned)(Rb * K + C) * 2u; }
    const size_t kstep = (size_t)(BK * 2);
    const size_t hstep = (size_t)HALF * K * 2;
    const size_t tstep = 2 * hstep;
    const unsigned ldsw = (unsigned)wid * 1024u;
    const int aoff = lds_byte(wr * 64 + fr, fq * 8), boff = lds_byte(wc * 32 + fr, fq * 8);
#define PG8_SA(b, h) (((b) * 2 + (h)) * HTB)
#define PG8_SB(b, h) ((4 + (b) * 2 + (h)) * HTB)
#define PG8_STAGE(bufoff, gbase, voff) do { _Pragma("unroll") for (int _i = 0; _i < 2; ++_i) \
        __builtin_amdgcn_global_load_lds((const unsigned*)((const char*)(gbase) + (voff)[_i]), (PG8_LAS unsigned*)(lds + (bufoff) + ldsw + _i * 8192), 16, 0, 0); } while (0)
#define PG8_LDA(dst, b, h) do { _Pragma("unroll") for (int m = 0; m < 4; ++m) _Pragma("unroll") for (int k = 0; k < 2; ++k) dst[m][k] = *(const PG8_LAS bf16x8*)(lds + PG8_SA(b, h) + aoff + m * 2048 + k * 1024); } while (0)
#define PG8_LDB(dst, b, h) do { _Pragma("unroll") for (int n = 0; n < 2; ++n) _Pragma("unroll") for (int k = 0; k < 2; ++k) dst[n][k] = *(const PG8_LAS bf16x8*)(lds + PG8_SB(b, h) + boff + n * 2048 + k * 1024); } while (0)
#define PG8_MMA(ai, bj, At, Bt) do { __builtin_amdgcn_s_setprio(1); _Pragma("unroll") for (int m = 0; m < 4; ++m) _Pragma("unroll") for (int n = 0; n < 2; ++n) _Pragma("unroll") for (int k = 0; k < 2; ++k) \
        acc[ai][bj][m][n] = __builtin_amdgcn_mfma_f32_16x16x32_bf16(Bt[n][k], At[m][k], acc[ai][bj][m][n], 0, 0, 0); __builtin_amdgcn_s_setprio(0); } while (0)
#define PG8_WAIT_V(n) asm volatile("s_waitcnt vmcnt(" #n ")" ::: "memory")
#define PG8_WAIT_L(n) asm volatile("s_waitcnt lgkmcnt(" #n ")" ::: "memory")
#define PG8_BAR __builtin_amdgcn_s_barrier()
#define PG8_SCHED __builtin_amdgcn_sched_barrier(0)
    Unit cur, nxt; int ui = 0;
    if (!S.next(0, cur)) return;
    f32x4 acc[2][2][4][2];
#pragma unroll
    for (int a = 0; a < 2; ++a)
#pragma unroll
        for (int b = 0; b < 2; ++b)
#pragma unroll
            for (int m = 0; m < 4; ++m)
#pragma unroll
                for (int n = 0; n < 2; ++n) acc[a][b][m][n] = (f32x4){0.f, 0.f, 0.f, 0.f};
    bf16x8 At[4][2], B0[2][2], B1[2][2];
    const char* cA = (const char*)g.A + (size_t)cur.pm * tstep; const char* cB = (const char*)g.Bt + (size_t)cur.pn * tstep;
    S.a_ready(cur);
    if constexpr (SP2) {
        PG8_STAGE(PG8_SB(0, 0), cB, voffB); PG8_STAGE(PG8_SB(0, 1), cB + hstep, voffB); PG8_STAGE(PG8_SA(0, 0), cA, voffA); PG8_STAGE(PG8_SA(0, 1), cA + hstep, voffA);
        if (wr == 1) PG8_BAR;
        PG8_WAIT_V(2); PG8_BAR;
        PG8_STAGE(PG8_SB(1, 0), cB + kstep, voffB); PG8_STAGE(PG8_SA(1, 0), cA + kstep, voffA); PG8_STAGE(PG8_SB(1, 1), cB + hstep + kstep, voffB);
        PG8_WAIT_V(6); PG8_BAR;
    } else {
        PG8_STAGE(PG8_SB(0, 0), cB, voffB); PG8_STAGE(PG8_SA(0, 0), cA, voffA); PG8_STAGE(PG8_SB(0, 1), cB + hstep, voffB); PG8_STAGE(PG8_SA(0, 1), cA + hstep, voffA);
        if (wr == 1) PG8_BAR;
        PG8_WAIT_V(4); PG8_BAR;
        PG8_STAGE(PG8_SB(1, 0), cB + kstep, voffB); PG8_STAGE(PG8_SA(1, 0), cA + kstep, voffA); PG8_STAGE(PG8_SB(1, 1), cB + hstep + kstep, voffB);
        PG8_WAIT_V(6); PG8_BAR;
    }
    for (;;) {
        const bool has_next = S.next(ui + 1, nxt);
        const char* nA = has_next ? (const char*)g.A + (size_t)nxt.pm * tstep : cA; const char* nB = has_next ? (const char*)g.Bt + (size_t)nxt.pn * tstep : cB;
        for (int t = 0; t < nt; t += 2) {
            const bool last = (t == nt - 2);
            const char* a1 = cA + (size_t)(t + 1) * kstep;
            const char* a2 = last ? nA : cA + (size_t)(t + 2) * kstep; const char* b2 = last ? nB : cB + (size_t)(t + 2) * kstep;
            const char* a3 = a2 + kstep; const char* b3 = b2 + kstep;
            if (last && has_next) S.a_ready(nxt);
            if constexpr (SP2) {
            PG8_LDB(B0, 0, 0); PG8_LDB(B1, 0, 1); PG8_SCHED; PG8_LDA(At, 0, 0); PG8_STAGE(PG8_SA(1, 1), a1 + hstep, voffA);
            PG8_WAIT_V(8); PG8_WAIT_L(0); PG8_BAR; PG8_MMA(0, 0, At, B0); PG8_MMA(0, 1, At, B1); PG8_BAR; PG8_SCHED;
            PG8_LDA(At, 0, 1); PG8_STAGE(PG8_SB(0, 0), b2, voffB); PG8_STAGE(PG8_SB(0, 1), b2 + hstep, voffB); PG8_STAGE(PG8_SA(0, 0), a2, voffA);
            PG8_WAIT_V(8); PG8_WAIT_L(0); PG8_BAR; PG8_MMA(1, 0, At, B0); PG8_MMA(1, 1, At, B1); PG8_BAR; PG8_SCHED;
            PG8_LDB(B0, 1, 0); PG8_LDB(B1, 1, 1); PG8_SCHED; PG8_LDA(At, 1, 0); PG8_STAGE(PG8_SA(0, 1), a2 + hstep, voffA);
            PG8_WAIT_V(8); PG8_WAIT_L(0); PG8_BAR; PG8_MMA(0, 0, At, B0); PG8_MMA(0, 1, At, B1); PG8_BAR; PG8_SCHED;
            PG8_LDA(At, 1, 1); PG8_STAGE(PG8_SB(1, 0), b3, voffB); PG8_STAGE(PG8_SB(1, 1), b3 + hstep, voffB); PG8_STAGE(PG8_SA(1, 0), a3, voffA);
            PG8_WAIT_V(8); PG8_WAIT_L(0); PG8_BAR; PG8_MMA(1, 0, At, B0); PG8_MMA(1, 1, At, B1); PG8_BAR; PG8_SCHED;
            } else {
            PG8_LDB(B0, 0, 0); PG8_SCHED; PG8_LDA(At, 0, 0); PG8_STAGE(PG8_SA(1, 1), a1 + hstep, voffA);
            PG8_WAIT_L(8); PG8_BAR; PG8_WAIT_L(0); PG8_MMA(0, 0, At, B0); PG8_BAR; PG8_SCHED;
            PG8_LDB(B1, 0, 1); PG8_STAGE(PG8_SB(0, 0), b2, voffB);
            PG8_BAR; PG8_WAIT_L(0); PG8_MMA(0, 1, At, B1); PG8_BAR;
            PG8_LDA(At, 0, 1); PG8_STAGE(PG8_SA(0, 0), a2, voffA);
            PG8_BAR; PG8_WAIT_L(0); PG8_MMA(1, 0, At, B0); PG8_BAR; PG8_SCHED;
            PG8_STAGE(PG8_SB(0, 1), b2 + hstep, voffB);
            PG8_WAIT_V(6); PG8_BAR; PG8_MMA(1, 1, At, B1); PG8_BAR;
            PG8_LDB(B0, 1, 0); PG8_SCHED; PG8_LDA(At, 1, 0); PG8_STAGE(PG8_SA(0, 1), a2 + hstep, voffA);
            PG8_WAIT_L(8); PG8_BAR; PG8_WAIT_L(0); PG8_MMA(0, 0, At, B0); PG8_BAR; PG8_SCHED;
            PG8_LDB(B1, 1, 1); PG8_STAGE(PG8_SB(1, 0), b3, voffB);
            PG8_BAR; PG8_WAIT_L(0); PG8_MMA(0, 1, At, B1); PG8_BAR;
            PG8_LDA(At, 1, 1); PG8_STAGE(PG8_SA(1, 0), a3, voffA);
            PG8_BAR; PG8_WAIT_L(0); PG8_MMA(1, 0, At, B0); PG8_BAR; PG8_SCHED;
            PG8_STAGE(PG8_SB(1, 1), b3 + hstep, voffB);
            PG8_WAIT_V(6); PG8_BAR; PG8_MMA(1, 1, At, B1); PG8_BAR;
            }
        }
        if constexpr (ALIGN_EPI) { if (wr == 0) PG8_BAR; }
        if constexpr (!Epi::AFTER_DRAIN) { E(acc, cur, wr, wc, fr, fq); S.done(cur); }
        if (!has_next) break;
#pragma unroll
        for (int a = 0; a < 2; ++a)
#pragma unroll
            for (int b = 0; b < 2; ++b)
#pragma unroll
                for (int m = 0; m < 4; ++m)
#pragma unroll
                    for (int n = 0; n < 2; ++n) acc[a][b][m][n] = (f32x4){0.f, 0.f, 0.f, 0.f};
        cur = nxt; cA = nA; cB = nB; ++ui;
        if constexpr (ALIGN_EPI) { if (wr == 1) PG8_BAR; }
    }
    PG8_WAIT_V(0);
    if constexpr (!ALIGN_EPI) { if (wr == 0) PG8_BAR; }
    PG8_BAR;
    if constexpr (Epi::AFTER_DRAIN) { E.fused(acc, cur, wr, wc, fr, fq, lds, wid, lane); S.done(cur); }
#undef PG8_SA
#undef PG8_SB
#undef PG8_STAGE
#undef PG8_LDA
#undef PG8_LDB
#undef PG8_MMA
#undef PG8_WAIT_V
#undef PG8_WAIT_L
#undef PG8_BAR
#undef PG8_SCHED
}
}

__device__ __forceinline__ u32x4 pack8(const f32x4 a, const f32x4 b) { u32x4 w; w.x = pk2(a[0], a[1]); w.y = pk2(a[2], a[3]); w.z = pk2(b[0], b[1]); w.w = pk2(b[2], b[3]); return w; }
__device__ __forceinline__ f32x4 silu4(const f32x4 v) { f32x4 o; o[0] = v[0] * sigmoidf_(v[0]); o[1] = v[1] * sigmoidf_(v[1]); o[2] = v[2] * sigmoidf_(v[2]); o[3] = v[3] * sigmoidf_(v[3]); return o; }
__device__ __forceinline__ f32x4 sig4(const f32x4 v) { f32x4 o; o[0] = sigmoidf_(v[0]); o[1] = sigmoidf_(v[1]); o[2] = sigmoidf_(v[2]); o[3] = sigmoidf_(v[3]); return o; }

struct Epi0 {
    static constexpr bool PERM = true, AFTER_DRAIN = false;
    unsigned char* ws; unsigned char* dout; bool cheap;
    __device__ __forceinline__ void operator()(const f32x4 (&acc)[2][2][4][2], const pg8::Unit& u, int wr, int wc, int fr, int fq) const {
        const int row0 = u.pm * 256 + wr * 64 + fr, t = u.pn, cw = wc * 32 + 8 * fq;
        if (t < 8) {
            bf16_t* U = (bf16_t*)(ws + WS_U);
#pragma unroll
            for (int ai = 0; ai < 2; ++ai)
#pragma unroll
                for (int m = 0; m < 4; ++m) { const size_t row = (size_t)(row0 + ai * 128 + m * 16);
                    const f32x4 a = cheap ? acc[ai][0][m][0] : acc[ai][0][m][0] * sig4(acc[ai][1][m][0]), b = cheap ? acc[ai][0][m][1] : acc[ai][0][m][1] * sig4(acc[ai][1][m][1]);
                    *(u32x4*)(U + row * 1024 + 128 * t + cw) = pack8(a, b); }
        } else if (t == 28) {
            bf16_t* WDAD = (bf16_t*)(dout + DO_WDAD);
#pragma unroll
            for (int ai = 0; ai < 2; ++ai)
#pragma unroll
                for (int m = 0; m < 4; ++m) { const size_t row = (size_t)(row0 + ai * 128 + m * 16);
                    *(u32x4*)(WDAD + row * 128 + cw) = pack8(acc[ai][0][m][0], acc[ai][0][m][1]); }
        } else {
            const bool act = ((t < 12) || (t >= 24)) && !cheap; const int c0 = 256 * (t & 3);
            unsigned char* bp = (t >= 24) ? (dout + DO_BG) : (ws + WS_AG + (size_t)((t - 8) >> 2) * (64 * MiB));
            bf16_t* base = (bf16_t*)bp;
#pragma unroll
            for (int ai = 0; ai < 2; ++ai)
#pragma unroll
                for (int m = 0; m < 4; ++m) { const size_t row = (size_t)(row0 + ai * 128 + m * 16);
#pragma unroll
                    for (int bj = 0; bj < 2; ++bj) { f32x4 a = acc[ai][bj][m][0], b = acc[ai][bj][m][1];
                        if (act) { a = silu4(a); b = silu4(b); }
                        *(u32x4*)(base + row * 1024 + c0 + 128 * bj + cw) = pack8(a, b); } }
        }
    }
};
static_assert(WS_R == WS_AG + 64 * MiB && WS_K == WS_AG + 128 * MiB && WS_V == WS_AG + 192 * MiB, "Epi0 region arithmetic");

struct EpiLora {
    static constexpr bool PERM = true, AFTER_DRAIN = false;
    bf16_t *D, *A; const float* vec;
    __device__ __forceinline__ void operator()(const f32x4 (&acc)[2][2][4][2], const pg8::Unit& u, int wr, int wc, int fr, int fq) const {
        const int row0 = u.pm * 256 + wr * 64 + fr, t = u.pn, cw = wc * 32 + 8 * fq;
        const bool isd = t < 4; bf16_t* base = isd ? D : A; const int c0 = 256 * (t & 3); const float* bias = vec + (isd ? 0 : 1024) + c0 + cw;
        const float sc = isd ? 0.60653065971f : 1.0f;
#pragma unroll
        for (int ai = 0; ai < 2; ++ai)
#pragma unroll
            for (int m = 0; m < 4; ++m) { const size_t row = (size_t)(row0 + ai * 128 + m * 16);
#pragma unroll
                for (int bj = 0; bj < 2; ++bj) { const f32x4 b0 = *(const f32x4*)(bias + 128 * bj), b1 = *(const f32x4*)(bias + 128 * bj + 4);
                    const f32x4 a = sig4(acc[ai][bj][m][0] + b0) * sc, b = sig4(acc[ai][bj][m][1] + b1) * sc;
                    *(u32x4*)(base + row * 1024 + c0 + 128 * bj + cw) = pack8(a, b); } }
    }
};

struct EpiRes {
    static constexpr bool PERM = false, AFTER_DRAIN = false;
    const float* resid; float* out; const float* modp; const float* ada_b; int layer;
    __device__ __forceinline__ void operator()(const f32x4 (&acc)[2][2][4][2], const pg8::Unit& u, int wr, int wc, int fr, int fq) const {
        const int row0 = u.pm * 256 + wr * 64 + fr, col0 = u.pn * 256 + wc * 32 + 4 * fq, b = (u.pm * 256) / SEQ;
        f32x4 gv[2][2];
#pragma unroll
        for (int bj = 0; bj < 2; ++bj)
#pragma unroll
            for (int n = 0; n < 2; ++n) { const int c = col0 + bj * 128 + n * 16; f32x4 g = *(const f32x4*)(ada_b + layer * 3072 + 2048 + c);
#pragma unroll
                for (int s = 0; s < 8; ++s) g += *(const f32x4*)(modp + (size_t)((s * 2 + layer) * 4 + b) * 3072 + 2048 + c);
                gv[bj][n] = g; }
#pragma unroll
        for (int ai = 0; ai < 2; ++ai)
#pragma unroll
            for (int m = 0; m < 4; ++m) { const size_t off = (size_t)(row0 + ai * 128 + m * 16) * 1024 + col0;
#pragma unroll
                for (int bj = 0; bj < 2; ++bj)
#pragma unroll
                    for (int n = 0; n < 2; ++n) { const f32x4 r = *(const f32x4*)(resid + off + bj * 128 + n * 16);
                        *(f32x4*)(out + off + bj * 128 + n * 16) = r + gv[bj][n] * acc[ai][bj][m][n]; }
                if (m & 1) asm volatile("" ::: "memory"); }
    }
};

constexpr float Q_SCALE = 0.08838834764831845f * 1.4426950408889634f;
constexpr float WI_SCALE = 0.35355339059327373f * 0.125f;
struct Epi1 {
    static constexpr bool PERM = true, AFTER_DRAIN = false;
    bf16_t *Q, *KV, *QI, *KI, *G; float* WI; const f32x2* csa; const f32x2* csi;
    __device__ __forceinline__ void rope8(const f32x4 x1a, const f32x4 x1b, const f32x4 x2a, const f32x4 x2b, const f32x2* cs, float sc, u32x4& o1, u32x4& o2) const {
        float c[8], s[8];
#pragma unroll
        for (int j = 0; j < 4; ++j) { const f32x4 v = *(const f32x4*)(cs + 2 * j); c[2 * j] = v[0]; s[2 * j] = v[1]; c[2 * j + 1] = v[2]; s[2 * j + 1] = v[3]; }
        float a[8], b[8];
#pragma unroll
        for (int j = 0; j < 4; ++j) { a[j] = x1a[j]; a[4 + j] = x1b[j]; b[j] = x2a[j]; b[4 + j] = x2b[j]; }
        float p[8], q[8];
#pragma unroll
        for (int j = 0; j < 8; ++j) { p[j] = (a[j] * c[j] - b[j] * s[j]) * sc; q[j] = (b[j] * c[j] + a[j] * s[j]) * sc; }
        o1.x = pk2(p[0], p[1]); o1.y = pk2(p[2], p[3]); o1.z = pk2(p[4], p[5]); o1.w = pk2(p[6], p[7]);
        o2.x = pk2(q[0], q[1]); o2.y = pk2(q[2], q[3]); o2.z = pk2(q[4], q[5]); o2.w = pk2(q[6], q[7]);
    }
    __device__ __forceinline__ void operator()(const f32x4 (&acc)[2][2][4][2], const pg8::Unit& u, int wr, int wc, int fr, int fq) const {
        const int row0 = u.pm * 256 + wr * 64 + fr, t = u.pn, cw = wc * 32 + 8 * fq;
#pragma unroll
        for (int ai = 0; ai < 2; ++ai)
#pragma unroll
            for (int m = 0; m < 4; ++m) { const size_t row = (size_t)(row0 + ai * 128 + m * 16);
                const f32x4 x1a = acc[ai][0][m][0], x1b = acc[ai][0][m][1], x2a = acc[ai][1][m][0], x2b = acc[ai][1][m][1];
                if (t < 8) { const int head = 2 * t + (wc >> 1), i0 = (wc & 1) * 32 + 8 * fq; u32x4 o1, o2;
                    rope8(x1a, x1b, x2a, x2b, csa + row * 64 + i0, Q_SCALE, o1, o2);
                    *(u32x4*)(Q + row * 2048 + head * 128 + i0) = o1; *(u32x4*)(Q + row * 2048 + head * 128 + 64 + i0) = o2;
                } else if (t == 8) { const int i0 = (wc & 1) * 32 + 8 * fq;
                    if (wc < 2) { u32x4 o1, o2; rope8(x1a, x1b, x2a, x2b, csa + row * 64 + i0, 1.0f, o1, o2);
                        *(u32x4*)(KV + row * 256 + i0) = o1; *(u32x4*)(KV + row * 256 + 64 + i0) = o2; }
                    else { *(u32x4*)(KV + row * 256 + 128 + i0) = pack8(x1a, x1b); *(u32x4*)(KV + row * 256 + 192 + i0) = pack8(x2a, x2b); }
                } else if (t < 11) { const int head = 4 * (t - 9) + wc, i0 = 8 * fq; u32x4 o1, o2;
                    rope8(x1a, x1b, x2a, x2b, csi + row * 32 + i0, 1.0f, o1, o2);
                    *(u32x4*)(QI + row * 512 + head * 64 + i0) = o1; *(u32x4*)(QI + row * 512 + head * 64 + 32 + i0) = o2;
                } else if (t == 11) {
                    if (wc == 0) { const int i0 = 8 * fq; u32x4 o1, o2; rope8(x1a, x1b, x2a, x2b, csi + row * 32 + i0, 1.0f, o1, o2);
                        *(u32x4*)(KI + row * 64 + i0) = o1; *(u32x4*)(KI + row * 64 + 32 + i0) = o2; }
                    else if (wc == 1 && fq == 0) { *(f32x4*)(WI + row * 8) = x1a * WI_SCALE; *(f32x4*)(WI + row * 8 + 4) = x1b * WI_SCALE; }
                } else { const int c0 = 256 * (t - 12);
                    *(u32x4*)(G + row * 2048 + c0 + cw) = pack8(silu4(x1a), silu4(x1b)); *(u32x4*)(G + row * 2048 + c0 + 128 + cw) = pack8(silu4(x2a), silu4(x2b)); }
            }
    }
};

struct Args {
    const float* x; const float* c; const int* pos; const float* ada_w; const float* ada_b; const float* norm_g; const float* final_g;
    const float* even_w_in; const float* even_w_out; const float* conv_w; const float* conv_vec; const float* mu_rkv; const float* mu_lora;
    const float* rwkv_vec; const float* w_up; const float* a_up; const float* r_k; const float* odd_w_in; const float* odd_w_out;
    float* out; unsigned char* ws; int ph_lo, ph_hi;
};

template <class SrcF>
__device__ __forceinline__ void transpose_item(const SrcF& src, int K, bf16_t* WT, LAS float* scr, int item, int nblk, int lane) {
    const int kb = item / nblk, nb = item % nblk, k0 = 64 * kb, n0 = 32 * nb;
    float tv[32];
#pragma unroll
    for (int i = 0; i < 32; ++i) tv[i] = src(k0 + 2 * i + (lane >> 5), n0 + (lane & 31));
#pragma unroll
    for (int i = 0; i < 32; ++i) scr[(2 * i + (lane >> 5)) * 33 + (lane & 31)] = tv[i];
    LDS_WAIT();
    const int c = lane & 7;
#pragma unroll
    for (int j = 0; j < 4; ++j) { const int n = (lane >> 3) + 8 * j; const LAS float* s = scr + (8 * c) * 33 + n;
        u32x4 o; o.x = pk2(s[0 * 33], s[1 * 33]); o.y = pk2(s[2 * 33], s[3 * 33]); o.z = pk2(s[4 * 33], s[5 * 33]); o.w = pk2(s[6 * 33], s[7 * 33]);
        *(u32x4*)(WT + (size_t)(n0 + n) * K + k0 + 8 * c) = o; }
    LDS_WAIT();
}

__device__ __forceinline__ void transpose_item_col(const float* W, int ldw, int scol, int K, bf16_t* WT, LAS float* scr, int k0, int n0, int lane) {
    const float* wp = W + (size_t)(k0 + (lane >> 5)) * ldw + (scol < 0 ? 0 : scol);
#pragma unroll 8
    for (int i = 0; i < 32; ++i) { const float v = wp[(size_t)(2 * i) * ldw]; scr[(2 * i + (lane >> 5)) * 33 + (lane & 31)] = scol < 0 ? 0.f : v; }
    LDS_WAIT();
    const int c = lane & 7;
#pragma unroll
    for (int j = 0; j < 4; ++j) { const int n = (lane >> 3) + 8 * j; const LAS float* s = scr + (8 * c) * 33 + n;
        u32x4 o; o.x = pk2(s[0 * 33], s[1 * 33]); o.y = pk2(s[2 * 33], s[3 * 33]); o.z = pk2(s[4 * 33], s[5 * 33]); o.w = pk2(s[6 * 33], s[7 * 33]);
        *(u32x4*)(WT + (size_t)(n0 + n) * K + k0 + 8 * c) = o; }
    LDS_WAIT();
}
__device__ __forceinline__ void rope_item(const Args& a, int r, int lane) {
    const float p = (float)a.pos[r];
    { const float inv = powf(10000.0f, -(float)(2 * lane) / 128.0f); float sn, cs; sincosf(p * inv, &sn, &cs); ((f32x2*)(a.ws + WS_CSA))[(size_t)r * 64 + lane] = (f32x2){cs, sn}; }
    if (lane < 32) { const float inv = powf(10000.0f, -(float)(2 * lane) / 64.0f); float sn, cs; sincosf(p * inv, &sn, &cs); ((f32x2*)(a.ws + WS_CSI))[(size_t)r * 32 + lane] = (f32x2){cs, sn}; }
}
__device__ __forceinline__ void p0_late(const Args& a, const int wave, LAS unsigned char* lds, int first, int nblk) {
    const int lane = lane_id(), tid = wave * 64 + lane;
    LAS float* scr = (LAS float*)(lds + wave * 16384);
    const int gw = ((int)blockIdx.x - first) * NWAVES + wave, NGW = nblk * NWAVES;
    unsigned char* ws = a.ws;
    constexpr int I_WO = (2048 / 64) * (DM / 32), I_W1 = (DM / 64) * (N1 / 32), I_ROPE = MTOK;
    for (int it = gw; it < I_W1 + I_WO + I_ROPE; it += NGW) {
        int r = it;
        if (r < I_W1) { const int nblk = N1 / 32, k0 = 64 * (r / nblk), n0 = 32 * (r % nblk); transpose_item_col(a.odd_w_in, ODD_COLS, map1(n0 + (lane & 31)), DM, (bf16_t*)(ws + WS_WIN1), scr, k0, n0, lane); continue; } r -= I_W1;
        if (r < I_WO) { const int nblk = DM / 32, k0 = 64 * (r / nblk), n0 = 32 * (r % nblk); transpose_item_col(a.odd_w_out, DM, n0 + (lane & 31), 2048, (bf16_t*)(ws + WS_WOUT1), scr, k0, n0, lane); continue; } r -= I_WO;
        {
            const float p = (float)a.pos[r];
            { const float inv = powf(10000.0f, -(float)(2 * lane) / 128.0f); float sn, cs; sincosf(p * inv, &sn, &cs); ((f32x2*)(ws + WS_CSA))[(size_t)r * 64 + lane] = (f32x2){cs, sn}; }
            if (lane < 32) { const float inv = powf(10000.0f, -(float)(2 * lane) / 64.0f); float sn, cs; sincosf(p * inv, &sn, &cs); ((f32x2*)(ws + WS_CSI))[(size_t)r * 32 + lane] = (f32x2){cs, sn}; }
        }
    }
}
__device__ __forceinline__ void p0_prologue(const Args& a, const int wave, LAS unsigned char* lds) {
    const int lane = lane_id(), tid = wave * 64 + lane;
    LAS float* scr = (LAS float*)(lds + wave * 16384);
    const int gw = blockIdx.x * NWAVES + wave, NGW = gridDim.x * NWAVES;
    unsigned char* ws = a.ws;
    constexpr int I_W0 = (DM / 64) * (N0 / 32), I_WO = (2048 / 64) * (DM / 32), I_W1 = (DM / 64) * (N1 / 32), I_WL = (256 / 64) * (2048 / 32), I_MOD = 96 * 8, I_ROPE = MTOK;
    constexpr int NITEMS = I_W0 + I_WO + I_W1 + I_WO + I_WL + I_MOD + I_ROPE;
    constexpr int N_EARLY = I_W0 + I_WO + I_W1 + I_WO + I_WL + I_MOD;
    for (int it = gw; it < N_EARLY; it += NGW) {
        int r = it;
        if (r < I_W0) { const float* W = a.even_w_in; transpose_item([W](int k, int n) { const int s = map0(n); return s < 0 ? 0.f : W[(size_t)k * EVEN_COLS + s]; }, DM, (bf16_t*)(ws + WS_WIN0), scr, r, N0 / 32, lane); continue; } r -= I_W0;
        if (r < I_WO) { const float* W = a.even_w_out; transpose_item([W](int k, int n) { return W[(size_t)k * DM + n]; }, 2048, (bf16_t*)(ws + WS_WOUT0), scr, r, DM / 32, lane); continue; } r -= I_WO;
        if (r < I_W1) { const float* W = a.odd_w_in; transpose_item([W](int k, int n) { const int s = map1(n); return s < 0 ? 0.f : W[(size_t)k * ODD_COLS + s]; }, DM, (bf16_t*)(ws + WS_WIN1), scr, r, N1 / 32, lane); continue; } r -= I_W1;
        if (r < I_WO) { const float* W = a.odd_w_out; transpose_item([W](int k, int n) { return W[(size_t)k * DM + n]; }, 2048, (bf16_t*)(ws + WS_WOUT1), scr, r, DM / 32, lane); continue; } r -= I_WO;
        if (r < I_WL) { const float* wu = a.w_up; const float* au = a.a_up;
            transpose_item([wu, au](int k, int n) { if (n < 1024) return k < 64 ? wu[k * 1024 + n] : 0.f; return (k >= 64 && k < 128) ? au[(k - 64) * 1024 + (n - 1024)] : 0.f; }, 256, (bf16_t*)(ws + WS_WLORA), scr, r, 2048 / 32, lane); continue; } r -= I_WL;
        if (r < I_MOD) {
            const int cgp = r >> 3, ks = r & 7, col = cgp * 64 + lane, l = col / 3072, cc = col - l * 3072;
#pragma unroll
            for (int i = 0; i < 8; ++i) { const int idx = lane + 64 * i, bb = idx >> 7, kk = idx & 127; const float cv = a.c[bb * DM + ks * 128 + kk]; scr[kk * 4 + bb] = cv * sigmoidf_(cv); }
            LDS_WAIT();
            const float* W = a.ada_w + (size_t)l * DM * 3072 + cc + (size_t)(ks * 128) * 3072; f32x4 acc4 = (f32x4){0.f, 0.f, 0.f, 0.f};
#pragma unroll 1
            for (int k8 = 0; k8 < 128; k8 += 16) { float wv[16];
#pragma unroll
                for (int i = 0; i < 16; ++i) wv[i] = W[(size_t)(k8 + i) * 3072];
#pragma unroll
                for (int i = 0; i < 16; ++i) acc4 += *(const LAS f32x4*)(scr + (k8 + i) * 4) * wv[i]; }
            LDS_WAIT();
            const float acc0 = acc4[0], acc1 = acc4[1], acc2 = acc4[2], acc3 = acc4[3];
            float* mp = (float*)(ws + WS_MODP) + (size_t)((ks * 2 + l) * 4) * 3072 + cc;
            mp[0] = acc0; mp[3072] = acc1; mp[2 * 3072] = acc2; mp[3 * 3072] = acc3; continue; } r -= I_MOD;
    }
}

__device__ __forceinline__ void norm_phase(const Args& a, const int wave, LAS unsigned char* lds, const float* src, int layer) {
    const int lane = lane_id(), tid = wave * 64 + lane;
    LAS float* gs = (LAS float*)lds; LAS float* sh = gs + DM;
    const float* modp = (const float*)(a.ws + WS_MODP); bf16_t* H = (bf16_t*)(a.ws + WS_H);
    for (int tile = blockIdx.x; tile < MTOK / 128; tile += gridDim.x) {
        const int b = (tile * 128) / SEQ;
        __syncthreads();
        for (int c = tid; c < DM; c += NTHREADS) {
            float sc = a.ada_b[layer * 3072 + 1024 + c], sf = a.ada_b[layer * 3072 + c];
#pragma unroll
            for (int s = 0; s < 8; ++s) { const float* mp = modp + (size_t)((s * 2 + layer) * 4 + b) * 3072; sc += mp[1024 + c]; sf += mp[c]; }
            gs[c] = a.norm_g[layer * DM + c] * (1.0f + sc); sh[c] = sf; }
        __syncthreads();
        for (int r4 = 0; r4 < 16; r4 += 4) {
            f32x4 v[4][4]; float ss[4];
#pragma unroll
            for (int q = 0; q < 4; ++q) { const size_t m = (size_t)tile * 128 + wave * 16 + r4 + q; const f32x4* xr = (const f32x4*)(src + m * DM) + lane;
#pragma unroll
                for (int j = 0; j < 4; ++j) v[q][j] = xr[64 * j]; }
#pragma unroll
            for (int q = 0; q < 4; ++q) { float s = 0.f;
#pragma unroll
                for (int j = 0; j < 4; ++j) s += (v[q][j][0] * v[q][j][0] + v[q][j][1] * v[q][j][1]) + (v[q][j][2] * v[q][j][2] + v[q][j][3] * v[q][j][3]);
                ss[q] = s; }
#pragma unroll
            for (int q = 0; q < 4; ++q) ss[q] = wave_sum(ss[q]);
#pragma unroll
            for (int q = 0; q < 4; ++q) { const size_t m = (size_t)tile * 128 + wave * 16 + r4 + q; const float rstd = rsqrtf(ss[q] * (1.0f / DM) + 1e-6f);
                u32x2* o = (u32x2*)(H + m * DM) + lane;
#pragma unroll
                for (int j = 0; j < 4; ++j) { const f32x4 g = *(const LAS f32x4*)(gs + 4 * (64 * j + lane)), s = *(const LAS f32x4*)(sh + 4 * (64 * j + lane));
                    const f32x4 h = v[q][j] * rstd * g + s; u32x2 w; w.x = pk2(h[0], h[1]); w.y = pk2(h[2], h[3]); o[64 * j] = w; } }
        }
    }
}

__device__ __forceinline__ void final_phase(const Args& a, const int wave) {
    const int lane = lane_id(), tid = wave * 64 + lane;
    const int gw = blockIdx.x * NWAVES + wave, NGW = gridDim.x * NWAVES;
    f32x4 g[4];
#pragma unroll
    for (int j = 0; j < 4; ++j) g[j] = *((const f32x4*)a.final_g + 64 * j + lane);
    float tsc = 1.0f;
#ifdef STAMP_K
    { const unsigned long long* st = (const unsigned long long*)(a.ws + WS_STAMP); tsc = 1.0f + (float)(st[1] - st[0] + st[2]) * 1e-7f; }
#endif
    for (int m0 = 4 * gw; m0 < MTOK; m0 += 4 * NGW) {
        f32x4 v[4][4]; float ss[4];
#pragma unroll
        for (int q = 0; q < 4; ++q) { const f32x4* xr = (const f32x4*)(a.out + (size_t)(m0 + q) * DM) + lane;
#pragma unroll
            for (int j = 0; j < 4; ++j) v[q][j] = xr[64 * j]; }
#pragma unroll
        for (int q = 0; q < 4; ++q) { float s = 0.f;
#pragma unroll
            for (int j = 0; j < 4; ++j) s += (v[q][j][0] * v[q][j][0] + v[q][j][1] * v[q][j][1]) + (v[q][j][2] * v[q][j][2] + v[q][j][3] * v[q][j][3]);
            ss[q] = wave_sum(s); }
#pragma unroll
        for (int q = 0; q < 4; ++q) { const float rstd = rsqrtf(ss[q] * (1.0f / DM) + 1e-6f) * tsc; f32x4* xr = (f32x4*)(a.out + (size_t)(m0 + q) * DM) + lane;
#pragma unroll
            for (int j = 0; j < 4; ++j) xr[64 * j] = v[q][j] * rstd * g[j]; }
    }
}


__device__ __forceinline__ void conv_phase(const Args& a, const int wave, LAS unsigned char* lds, int first, int stride) {
    const int lane = lane_id(), tid = wave * 64 + lane;
    const bf16_t* U = (const bf16_t*)(a.ws + WS_U); const bf16_t* AG = (const bf16_t*)(a.ws + WS_AG); bf16_t* YAB = (bf16_t*)(a.ws + WS_YAB);
    f32x2 w[31];
#pragma unroll
    for (int j = 0; j < 31; ++j) w[j] = *(const f32x2*)(a.conv_w + j * DM + 2 * tid);
    const f32x2 cbias = *(const f32x2*)(a.conv_vec + 2 * tid);
    for (int tile = first; tile < MTOK / 32; tile += stride) {
        const int b = tile >> 8, s0 = (tile & 255) * 32;
        __syncthreads();
        for (int idx = tid; idx < 62 * 128; idx += NTHREADS) { const int row = idx >> 7, ch = idx & 127, s = s0 - 30 + row;
            u32x4 v = (u32x4){0u, 0u, 0u, 0u}; if (s >= 0) v = *(const u32x4*)(U + ((size_t)(b * SEQ + s)) * DM + ch * 8);
            *(LAS u32x4*)(lds + row * 2048 + ch * 16) = v; }
        __syncthreads();
        LAS unsigned char* rb0 = lds + tid * 4; LAS unsigned char* rb1 = rb0 + 65536; LAS unsigned char* wb0 = lds + tid * 8; LAS unsigned char* wb1 = wb0 + 65536;
        asm volatile("" : "+v"(rb0), "+v"(rb1), "+v"(wb0), "+v"(wb1));
        f32x2 acc[32];
#pragma unroll
        for (int t = 0; t < 32; ++t) acc[t] = (f32x2){0.f, 0.f};
#pragma unroll
        for (int i = 0; i < 62; ++i) { const unsigned xw = (i < 32) ? *(const LAS unsigned*)(rb0 + i * 2048) : *(const LAS unsigned*)(rb1 + (i - 32) * 2048); const f32x2 xv = (f32x2){bflo(xw), bfhi(xw)};
#pragma unroll
            for (int t = (i > 30 ? i - 30 : 0); t <= (i < 31 ? i : 31); ++t) acc[t] += xv * w[i - t]; }
        __syncthreads();
#pragma unroll
        for (int t = 0; t < 32; ++t) { if (t < 16) *(LAS f32x2*)(wb0 + t * 4096) = acc[t] + cbias; else *(LAS f32x2*)(wb1 + (t - 16) * 4096) = acc[t] + cbias; }
        __syncthreads();
        f32x4 lw[4], lb[4];
#pragma unroll
        for (int j = 0; j < 4; ++j) { lw[j] = *(const f32x4*)(a.conv_vec + DM + 4 * (lane + 64 * j)); lb[j] = *(const f32x4*)(a.conv_vec + 2 * DM + 4 * (lane + 64 * j)); }
        for (int tt = 0; tt < 4; ++tt) { const int t = wave * 4 + tt; const size_t m = (size_t)b * SEQ + s0 + t;
            f32x4 v[4]; float s = 0.f;
#pragma unroll
            for (int j = 0; j < 4; ++j) { v[j] = *(const LAS f32x4*)(lds + (size_t)t * 4096 + 16 * (lane + 64 * j)); s += (v[j][0] + v[j][1]) + (v[j][2] + v[j][3]); }
            const float mean = wave_sum(s) * (1.0f / DM); float q = 0.f;
#pragma unroll
            for (int j = 0; j < 4; ++j) { v[j] = v[j] - mean; q += (v[j][0] * v[j][0] + v[j][1] * v[j][1]) + (v[j][2] * v[j][2] + v[j][3] * v[j][3]); }
            const float rstd = rsqrtf(wave_sum(q) * (1.0f / DM) + 1e-5f);
#pragma unroll
            for (int j = 0; j < 4; ++j) { const f32x4 y = v[j] * rstd * lw[j] + lb[j]; const u32x2 g = *(const u32x2*)(AG + m * DM + 4 * (lane + 64 * j));
                const f32x4 o = silu4(y) * (f32x4){bflo(g.x), bfhi(g.x), bflo(g.y), bfhi(g.y)};
                u32x2 wv; wv.x = pk2(o[0], o[1]); wv.y = pk2(o[2], o[3]); *(u32x2*)(YAB + m * 2048 + 4 * (lane + 64 * j)) = wv; }
        }
    }
}

__device__ __forceinline__ void lora_pre_phase(const Args& a, const int wave) {
    const int lane = lane_id(), tid = wave * 64 + lane;

        const bf16_t* WDAD = (const bf16_t*)((unsigned char*)a.out + DO_WDAD); bf16_t* LA = (bf16_t*)((unsigned char*)a.out + DO_LA);
        const int gw = blockIdx.x * NWAVES + wave, NGW = gridDim.x * NWAVES;
        const f32x2 mu = *(const f32x2*)(a.mu_lora + 2 * lane);
        for (int m0 = gw * 4; m0 < MTOK; m0 += NGW * 4) {
            unsigned cur[4], prv[4];
#pragma unroll
            for (int i = 0; i < 4; ++i) { const int m = m0 + i; cur[i] = *(const unsigned*)(WDAD + (size_t)m * 128 + 2 * lane); }
#pragma unroll
            for (int i = 0; i < 4; ++i) { const int m = m0 + i; if (i > 0) prv[i] = cur[i - 1]; else { prv[0] = 0u; if ((m & (SEQ - 1)) > 0) prv[0] = *(const unsigned*)(WDAD + (size_t)(m - 1) * 128 + 2 * lane); } }
#pragma unroll
            for (int i = 0; i < 4; ++i) { const int m = m0 + i;
                float v0 = bflo(cur[i]), v1 = bfhi(cur[i]); v0 += (bflo(prv[i]) - v0) * mu[0]; v1 += (bfhi(prv[i]) - v1) * mu[1];
                if (lane < 32) { v0 = tanhf(v0); v1 = tanhf(v1); }
                *(unsigned*)(LA + (size_t)m * 256 + 2 * lane) = pk2(v0, v1); *(unsigned*)(LA + (size_t)m * 256 + 128 + 2 * lane) = 0u; }
        }
    }

struct ScanRaw { u32x2 r, rp, k, kp, v, vp, d, a; };
constexpr int SC_CH = 16, SC_BUF_F = 5 * SC_CH * 64 + SC_CH * 16;

__device__ __forceinline__ void scan_phase(const Args& a, const int wave, LAS unsigned char* lds) {
    const int lane = lane_id(), tid = wave * 64 + lane;
    const bf16_t* Rg = (const bf16_t*)(a.ws + WS_R); const bf16_t* Kg = (const bf16_t*)(a.ws + WS_K); const bf16_t* Vg = (const bf16_t*)(a.ws + WS_V);
    const bf16_t* Dg = (const bf16_t*)(a.ws + WS_DARR); const bf16_t* Ag = (const bf16_t*)(a.ws + WS_AARR);
    bf16_t* YAB = (bf16_t*)(a.ws + WS_YAB); float* RK = (float*)((unsigned char*)a.out + DO_RK);
    LAS float* bufs = (LAS float*)lds; LAS float* ybuf = bufs + 2 * SC_BUF_F;
    constexpr int NCH = SEQ / SC_CH;
    for (int job = blockIdx.x; job < 256; job += gridDim.x) {
        const int vcu = (gridDim.x == 256) ? ((job & 7) * 32 + (job >> 3)) : job;
        const int bh = vcu >> 2, vq = vcu & 3, b = bh >> 4, h = bh & 15;
        __syncthreads();
        if (wave >= 4) {
            const int pt = tid - 256, tok = pt >> 4, cgp = pt & 15, ch = h * 64 + 4 * cgp;
            const f32x4 mur = *(const f32x4*)(a.mu_rkv + ch), muk = *(const f32x4*)(a.mu_rkv + DM + ch), muv = *(const f32x4*)(a.mu_rkv + 2 * DM + ch);
            const f32x4 k_k = *(const f32x4*)(a.rwkv_vec + 2 * DM + ch), k_a = *(const f32x4*)(a.rwkv_vec + 3 * DM + ch), rkw = *(const f32x4*)(a.r_k + ch);
            auto load = [&](int c) { ScanRaw q; const int s = c * SC_CH + tok; const size_t m = (size_t)b * SEQ + s; const size_t o = m * DM + ch; const size_t op = (s > 0) ? o - DM : o;
                q.r = *(const u32x2*)(Rg + o); q.k = *(const u32x2*)(Kg + o); q.v = *(const u32x2*)(Vg + o); q.d = *(const u32x2*)(Dg + o); q.a = *(const u32x2*)(Ag + o);
                q.rp = *(const u32x2*)(Rg + op); q.kp = *(const u32x2*)(Kg + op); q.vp = *(const u32x2*)(Vg + op);
                if (s == 0) { q.rp = (u32x2){0u, 0u}; q.kp = (u32x2){0u, 0u}; q.vp = (u32x2){0u, 0u}; }
                return q; };
            auto un4 = [](u32x2 w) { return (f32x4){bflo(w.x), bfhi(w.x), bflo(w.y), bfhi(w.y)}; };
            auto process = [&](const ScanRaw& q, int c, LAS float* buf) {
                const f32x4 r0 = un4(q.r), k0 = un4(q.k), v0 = un4(q.v);
                const f32x4 rl = r0 + (un4(q.rp) - r0) * mur, kl = k0 + (un4(q.kp) - k0) * muk, vl = v0 + (un4(q.vp) - v0) * muv;
                const f32x4 d = un4(q.d), av = un4(q.a);
                f32x4 wdec; wdec[0] = __expf(-d[0]); wdec[1] = __expf(-d[1]); wdec[2] = __expf(-d[2]); wdec[3] = __expf(-d[3]);
                const f32x4 kkr = kl * k_k; float ss = (kkr[0] * kkr[0] + kkr[1] * kkr[1]) + (kkr[2] * kkr[2] + kkr[3] * kkr[3]); ss = row16_sum(ss);
                const float inv = 1.0f / fmaxf(sqrtf(ss), 1e-12f);
                const f32x4 kk = kkr * inv, kp = kl * (1.0f + (av - 1.0f) * k_a), bb = kk * av;
                float rk = (rl[0] * kp[0] * rkw[0] + rl[1] * kp[1] * rkw[1]) + (rl[2] * kp[2] * rkw[2] + rl[3] * kp[3] * rkw[3]); rk = row16_sum(rk);
                const int o = tok * 64 + 4 * cgp;
                *(LAS f32x4*)(buf + o) = -kk; *(LAS f32x4*)(buf + 1024 + o) = wdec; *(LAS f32x4*)(buf + 2048 + o) = bb; *(LAS f32x4*)(buf + 3072 + o) = kp; *(LAS f32x4*)(buf + 4096 + o) = rl;
                if ((cgp >> 2) == vq) *(LAS f32x4*)(buf + 5120 + tok * 16 + 4 * (cgp & 3)) = vl;
                if (vq == 0 && cgp == 0) RK[((size_t)b * SEQ + c * SC_CH + tok) * 16 + h] = rk; };
            auto flush = [&](int c, const LAS float* yb) {
                if (wave == 4) { const int t2 = lane >> 2, rq = lane & 3; const f32x4 y = *(const LAS f32x4*)(yb + t2 * 16 + 4 * rq);
                    u32x2 wv; wv.x = pk2(y[0], y[1]); wv.y = pk2(y[2], y[3]);
                    *(u32x2*)(YAB + ((size_t)b * SEQ + c * SC_CH + t2) * 2048 + 1024 + h * 64 + 16 * vq + 4 * rq) = wv; } };
            ScanRaw q0 = load(0), q1 = load(1);
            process(q0, 0, bufs); q0 = q1; q1 = load(2);
            __syncthreads();
            for (int c = 0; c < NCH; ++c) {
                if (c + 1 < NCH) process(q0, c + 1, bufs + ((c + 1) & 1) * SC_BUF_F);
                q0 = q1; if (c + 3 < NCH) q1 = load(c + 3);
                if (c >= 1) flush(c - 1, ybuf + ((c - 1) & 1) * 256);
                __syncthreads();
            }
            flush(NCH - 1, ybuf + ((NCH - 1) & 1) * 256);
        } else {
            const int rw = lane >> 4, ks = lane & 15, row = wave * 4 + rw;
            float s0 = 0.f, s1 = 0.f, s2 = 0.f, s3 = 0.f;
            __syncthreads();
            for (int c = 0; c < NCH; ++c) {
                const LAS float* buf = bufs + (c & 1) * SC_BUF_F; LAS float* yb = ybuf + (c & 1) * 256;
#pragma unroll
                for (int t = 0; t < SC_CH; ++t) {
                    const f32x4 nk = *(const LAS f32x4*)(buf + t * 64 + 4 * ks), w4 = *(const LAS f32x4*)(buf + 1024 + t * 64 + 4 * ks), b4 = *(const LAS f32x4*)(buf + 2048 + t * 64 + 4 * ks);
                    const f32x4 kp = *(const LAS f32x4*)(buf + 3072 + t * 64 + 4 * ks), r4 = *(const LAS f32x4*)(buf + 4096 + t * 64 + 4 * ks); const float vv = buf[5120 + t * 16 + row];
                    float sa = (s0 * nk[0] + s1 * nk[1]) + (s2 * nk[2] + s3 * nk[3]); sa = row16_sum(sa);
                    s0 = s0 * w4[0] + (sa * b4[0] + vv * kp[0]); s1 = s1 * w4[1] + (sa * b4[1] + vv * kp[1]);
                    s2 = s2 * w4[2] + (sa * b4[2] + vv * kp[2]); s3 = s3 * w4[3] + (sa * b4[3] + vv * kp[3]);
                    float y = (s0 * r4[0] + s1 * r4[1]) + (s2 * r4[2] + s3 * r4[3]); y = row16_sum(y);
                    if (ks == 0) yb[t * 16 + row] = y;
                }
                __syncthreads();
            }
        }
    }
}

__device__ __forceinline__ void post_phase(const Args& a, const int wave) {
    const int lane = lane_id(), tid = wave * 64 + lane;
    const int gw = blockIdx.x * NWAVES + wave, NGW = gridDim.x * NWAVES;
    const bf16_t* Vg = (const bf16_t*)(a.ws + WS_V); const bf16_t* BG = (const bf16_t*)((unsigned char*)a.out + DO_BG); const float* RK = (const float*)((unsigned char*)a.out + DO_RK);
    bf16_t* YAB = (bf16_t*)(a.ws + WS_YAB);
    const int head = lane >> 2, c0 = head * 64 + 16 * (lane & 3);
    f32x4 muv[4], lw[4], lb[4];
#pragma unroll
    for (int j = 0; j < 4; ++j) { muv[j] = *(const f32x4*)(a.mu_rkv + 2 * DM + c0 + 4 * j); lw[j] = *(const f32x4*)(a.rwkv_vec + 4 * DM + c0 + 4 * j); lb[j] = *(const f32x4*)(a.rwkv_vec + 5 * DM + c0 + 4 * j); }
    auto un4 = [](unsigned x, unsigned y) { return (f32x4){bflo(x), bfhi(x), bflo(y), bfhi(y)}; };
    for (int m = gw; m < MTOK; m += NGW) { const int s = m & (SEQ - 1);
        bf16_t* yp = YAB + (size_t)m * 2048 + 1024 + c0;
        const u32x4 ya = *(const u32x4*)yp, yb2 = *(const u32x4*)(yp + 8);
        const u32x4 va = *(const u32x4*)(Vg + (size_t)m * DM + c0), vb = *(const u32x4*)(Vg + (size_t)m * DM + c0 + 8);
        u32x4 pa = (u32x4){0u, 0u, 0u, 0u}, pb = pa; if (s > 0) { pa = *(const u32x4*)(Vg + (size_t)(m - 1) * DM + c0); pb = *(const u32x4*)(Vg + (size_t)(m - 1) * DM + c0 + 8); }
        const u32x4 ga = *(const u32x4*)(BG + (size_t)m * DM + c0), gb = *(const u32x4*)(BG + (size_t)m * DM + c0 + 8);
        const float rk = RK[(size_t)m * 16 + head];
        f32x4 y[4] = {un4(ya.x, ya.y), un4(ya.z, ya.w), un4(yb2.x, yb2.y), un4(yb2.z, yb2.w)};
        const f32x4 v[4] = {un4(va.x, va.y), un4(va.z, va.w), un4(vb.x, vb.y), un4(vb.z, vb.w)};
        const f32x4 p[4] = {un4(pa.x, pa.y), un4(pa.z, pa.w), un4(pb.x, pb.y), un4(pb.z, pb.w)};
        const f32x4 g[4] = {un4(ga.x, ga.y), un4(ga.z, ga.w), un4(gb.x, gb.y), un4(gb.z, gb.w)};
        float sm = 0.f;
#pragma unroll
        for (int j = 0; j < 4; ++j) sm += (y[j][0] + y[j][1]) + (y[j][2] + y[j][3]);
        const float mean = quad_sum(sm) * (1.0f / 64.0f); float q = 0.f;
#pragma unroll
        for (int j = 0; j < 4; ++j) { y[j] = y[j] - mean; q += (y[j][0] * y[j][0] + y[j][1] * y[j][1]) + (y[j][2] * y[j][2] + y[j][3] * y[j][3]); }
        const float rstd = rsqrtf(quad_sum(q) * (1.0f / 64.0f) + 64e-5f);
        u32x4 o[2];
#pragma unroll
        for (int j = 0; j < 4; ++j) { const f32x4 vl = v[j] + (p[j] - v[j]) * muv[j]; const f32x4 r = (y[j] * rstd * lw[j] + lb[j] + rk * vl) * g[j];
            if (j & 1) { o[j >> 1].z = pk2(r[0], r[1]); o[j >> 1].w = pk2(r[2], r[3]); } else { o[j >> 1].x = pk2(r[0], r[1]); o[j >> 1].y = pk2(r[2], r[3]); } }
        *(u32x4*)yp = o[0]; *(u32x4*)(yp + 8) = o[1];
    }
}

constexpr int CS_L = 32, CS_NCH = SEQ / CS_L, CS_NSLOT = 3;
constexpr int CS_NT = 0, CS_RT = 4096, CS_BT = 8192, CS_KT = 12288, CS_TM = 8192, CS_AKN = 10240, CS_ABR = 12288, CS_AKR = 14336, CS_BC = 16384, CS_KC = 20480, CS_VC = 24576, CS_GL = 28672, CS_SLOT = 29184;
constexpr int CS_RAW = CS_NSLOT * CS_SLOT, CS_RAWSZ = 5 * 33 * 128;
constexpr int CS_FLAGS = CS_RAW + CS_NSLOT * CS_RAWSZ;
static_assert(CS_FLAGS + 64 <= LDS_BYTES && (CS_RAW % 16) == 0 && (CS_RAWSZ % 16) == 0, "chunked scan LDS map");
__device__ __forceinline__ int permp(int j) { return 8 * ((j & 15) >> 2) + 4 * (j >> 4) + (j & 3); }
template <int CTRL, int RM> __device__ __forceinline__ float dppf(float x) { return __int_as_float(__builtin_amdgcn_update_dpp(0, __float_as_int(x), CTRL, RM, 0xf, true)); }
__device__ __forceinline__ float wave_total(float x) {
    x = row16_sum(x); x += dppf<0x142, 0xa>(x); x += dppf<0x143, 0xc>(x); return __int_as_float(__builtin_amdgcn_readlane(__float_as_int(x), 63)); }
__device__ __forceinline__ float wave_sum64(float x) { x = row16_sum(x); x += __shfl_xor(x, 16); x += __shfl_xor(x, 32); return x; }
__device__ __forceinline__ bf16x8 cfrag(const f32x16& x, int s) {
    u32x4 w; w.x = pk2(x[8 * s + 0], x[8 * s + 1]); w.y = pk2(x[8 * s + 2], x[8 * s + 3]); w.z = pk2(x[8 * s + 4], x[8 * s + 5]); w.w = pk2(x[8 * s + 6], x[8 * s + 7]); return __builtin_bit_cast(bf16x8, w); }
__device__ __forceinline__ bf16x8 cfrag2(const f32x4& a, const f32x4& b) { u32x4 w; w.x = pk2(a[0], a[1]); w.y = pk2(a[2], a[3]); w.z = pk2(b[0], b[1]); w.w = pk2(b[2], b[3]); return __builtin_bit_cast(bf16x8, w); }
__device__ __forceinline__ void lds_poll_ge(LAS unsigned* p, unsigned want) { while (__hip_atomic_load(p, __ATOMIC_RELAXED, __HIP_MEMORY_SCOPE_WORKGROUP) < want) __builtin_amdgcn_s_sleep(1); asm volatile("" ::: "memory"); }

__device__ __forceinline__ void cscan_job(const Args& a, const int wave, LAS unsigned char* lds, int bh) {
    int lane; asm volatile("v_mbcnt_lo_u32_b32 %0, -1, 0\n\tv_mbcnt_hi_u32_b32 %0, -1, %0" : "=v"(lane));
    const int tid = wave * 64 + lane;
    const int b = bh >> 4, h = bh & 15;
    const bf16_t* Rg = (const bf16_t*)(a.ws + WS_R); const bf16_t* Kg = (const bf16_t*)(a.ws + WS_K); const bf16_t* Vg = (const bf16_t*)(a.ws + WS_V);
    const bf16_t* Dg = (const bf16_t*)(a.ws + WS_DARR); const bf16_t* Ag = (const bf16_t*)(a.ws + WS_AARR);
    bf16_t* YAB = (bf16_t*)(a.ws + WS_YAB); float* RK = (float*)((unsigned char*)a.out + DO_RK);
    LAS unsigned* ready = (LAS unsigned*)(lds + CS_FLAGS); LAS unsigned* done = ready + CS_NSLOT; LAS unsigned* rawready = done + CS_NSLOT; LAS unsigned* rawfree = rawready + CS_NSLOT;
    __syncthreads();
    if (tid < 4 * CS_NSLOT) ready[tid] = 0u;
    __syncthreads();
    if (wave == 4) {
        const int rr = lane >> 3, cc = lane & 7;
        for (int c = 0; c < CS_NCH; ++c) {
            const int s = c % CS_NSLOT; LAS unsigned char* rw = lds + CS_RAW + s * CS_RAWSZ;
            const size_t m0 = (size_t)b * SEQ + (size_t)c * CS_L;
            u32x4 v[5][4], vp[3];
#pragma unroll
            for (int ar = 0; ar < 5; ++ar) { const bf16_t* src = (ar == 0) ? Rg : (ar == 1) ? Kg : (ar == 2) ? Vg : (ar == 3) ? Dg : Ag;
#pragma unroll
                for (int q4 = 0; q4 < 4; ++q4) v[ar][q4] = *(const u32x4*)(src + (m0 + 8 * q4 + rr) * DM + h * 64 + 8 * cc); }
#pragma unroll
            for (int ar = 0; ar < 3; ++ar) { const bf16_t* src = (ar == 0) ? Rg : (ar == 1) ? Kg : Vg; vp[ar] = (u32x4){0u, 0u, 0u, 0u};
                if (c > 0 && lane < 8) vp[ar] = *(const u32x4*)(src + (m0 - 1) * DM + h * 64 + 8 * cc); }
            if (c >= CS_NSLOT) lds_poll_ge(rawfree + s, (unsigned)(c / CS_NSLOT));
#pragma unroll
            for (int ar = 0; ar < 5; ++ar)
#pragma unroll
                for (int q4 = 0; q4 < 4; ++q4) *(LAS u32x4*)(rw + (ar * 33 + 1 + 8 * q4 + rr) * 128 + 16 * cc) = v[ar][q4];
            if (lane < 8) {
#pragma unroll
                for (int ar = 0; ar < 3; ++ar) *(LAS u32x4*)(rw + (ar * 33) * 128 + 16 * cc) = vp[ar]; }
            LDS_WAIT();
            if (lane == 0) __hip_atomic_store(rawready + s, (unsigned)(c + 1), __ATOMIC_RELAXED, __HIP_MEMORY_SCOPE_WORKGROUP);
        }
    } else if (wave >= 5) {
        const int hw = wave - 5, gch = h * 64 + lane;
        const float mur = a.mu_rkv[gch], muk = a.mu_rkv[DM + gch], muv = a.mu_rkv[2 * DM + gch], kkw = a.rwkv_vec[2 * DM + gch], kaw = a.rwkv_vec[3 * DM + gch], rkw = a.r_k[gch];
        const int kpos = 32 * (lane >> 5) + permp(lane & 31);
        for (int c = hw; c < CS_NCH; c += CS_NSLOT) {
            const int s = hw; LAS unsigned char* sl = lds + s * CS_SLOT; const LAS unsigned short* rw = (const LAS unsigned short*)(lds + CS_RAW + s * CS_RAWSZ);
            const unsigned use = (unsigned)(c / CS_NSLOT);
            { PROBE_BEGIN(10, a.ws, wave);
            if (use > 0u) lds_poll_ge(done + s, 4u * use);
            lds_poll_ge(rawready + s, (unsigned)(c + 1));
            PROBE_END(10, a.ws, wave); }
            PROBE_BEGIN(11, a.ws, wave);
            const size_t m0 = (size_t)b * SEQ + (size_t)c * CS_L; const size_t o0 = m0 * DM + gch;
            float rp = bflo((unsigned)rw[(0 * 33) * 64 + lane]), kp = bflo((unsigned)rw[(1 * 33) * 64 + lane]), vp = bflo((unsigned)rw[(2 * 33) * 64 + lane]);
            float cum = 0.f, gprev = 1.f;
            unsigned bcw[16], kcw[16], vcw[16];
#pragma unroll
            for (int grp = 0; grp < 4; ++grp) {
                float rlv[8], kkrv[8], kprv[8], vlv[8], aav[8], ddv[8], red[16];
#pragma unroll
                for (int e = 0; e < 8; ++e) { const int row = 1 + 8 * grp + e;
                    const float r0 = bflo((unsigned)rw[(0 * 33 + row) * 64 + lane]), k0 = bflo((unsigned)rw[(1 * 33 + row) * 64 + lane]), v0 = bflo((unsigned)rw[(2 * 33 + row) * 64 + lane]);
                    ddv[e] = bflo((unsigned)rw[(3 * 33 + row) * 64 + lane]); aav[e] = bflo((unsigned)rw[(4 * 33 + row) * 64 + lane]);
                    rlv[e] = r0 + (rp - r0) * mur; const float kl = k0 + (kp - k0) * muk; vlv[e] = v0 + (vp - v0) * muv; rp = r0; kp = k0; vp = v0;
                    kkrv[e] = kl * kkw; kprv[e] = kl * (1.0f + (aav[e] - 1.0f) * kaw);
                    red[2 * e] = kkrv[e] * kkrv[e]; red[2 * e + 1] = rlv[e] * kprv[e] * rkw; }
#pragma unroll
                for (int e = 0; e < 16; ++e) red[e] += dppf<0xB1, 0xf>(red[e]);
#pragma unroll
                for (int e = 0; e < 16; ++e) red[e] += dppf<0x4E, 0xf>(red[e]);
#pragma unroll
                for (int e = 0; e < 16; ++e) red[e] += dppf<0x141, 0xf>(red[e]);
#pragma unroll
                for (int e = 0; e < 16; ++e) red[e] += dppf<0x140, 0xf>(red[e]);
#pragma unroll
                for (int e = 0; e < 16; ++e) red[e] += dppf<0x142, 0xa>(red[e]);
#pragma unroll
                for (int e = 0; e < 16; ++e) red[e] += dppf<0x143, 0xc>(red[e]);
#pragma unroll
                for (int e = 0; e < 16; ++e) red[e] = __int_as_float(__builtin_amdgcn_readlane(__float_as_int(red[e]), 63));
                if (lane < 8) { float rkv = red[1];
#pragma unroll
                    for (int e = 1; e < 8; ++e) rkv = (lane == e) ? red[2 * e + 1] : rkv;
                    RK[(m0 + 8 * grp + lane) * 16 + h] = rkv; }
#pragma unroll
                for (int j2 = 0; j2 < 4; ++j2) {
                    const int i2 = 4 * grp + j2;
                    float nt[2], bt[2], kt[2], rt[2], vt[2];
#pragma unroll
                    for (int e = 0; e < 2; ++e) { const int te = 2 * j2 + e;
                        const float kkv = kkrv[te] * __builtin_amdgcn_rsqf(fmaxf(red[2 * te], 1e-24f)), bb = kkv * aav[te];
                        cum += ddv[te]; const float gi = __expf(-cum), ginv = __builtin_amdgcn_rcpf(gi);
                        nt[e] = -kkv * gprev; bt[e] = bb * ginv; kt[e] = kprv[te] * ginv; rt[e] = rlv[te] * gi; vt[e] = vlv[te]; gprev = gi; }
                    const unsigned wn = pk2(nt[0], nt[1]), wb = pk2(bt[0], bt[1]), wk = pk2(kt[0], kt[1]), wr = pk2(rt[0], rt[1]), wv = pk2(vt[0], vt[1]);
                    const int i = 2 * i2;
                    *(LAS unsigned short*)(sl + CS_NT + (i * 64 + kpos) * 2) = (unsigned short)wn; *(LAS unsigned short*)(sl + CS_NT + ((i + 1) * 64 + kpos) * 2) = (unsigned short)(wn >> 16);
                    *(LAS unsigned short*)(sl + CS_RT + (i * 64 + kpos) * 2) = (unsigned short)wr; *(LAS unsigned short*)(sl + CS_RT + ((i + 1) * 64 + kpos) * 2) = (unsigned short)(wr >> 16);
                    *(LAS unsigned short*)(sl + CS_BT + (i * 64 + kpos) * 2) = (unsigned short)wb; *(LAS unsigned short*)(sl + CS_BT + ((i + 1) * 64 + kpos) * 2) = (unsigned short)(wb >> 16);
                    *(LAS unsigned short*)(sl + CS_KT + (i * 64 + kpos) * 2) = (unsigned short)wk; *(LAS unsigned short*)(sl + CS_KT + ((i + 1) * 64 + kpos) * 2) = (unsigned short)(wk >> 16);
                    const int pw = permp(i) >> 1;
                    bcw[pw] = wb; kcw[pw] = wk; vcw[pw] = wv;
                }
                __builtin_amdgcn_sched_barrier(0);
            }
#pragma unroll
            for (int q4 = 0; q4 < 4; ++q4) {
                *(LAS u32x4*)(sl + CS_BC + lane * 64 + 16 * q4) = (u32x4){bcw[4 * q4], bcw[4 * q4 + 1], bcw[4 * q4 + 2], bcw[4 * q4 + 3]};
                *(LAS u32x4*)(sl + CS_KC + lane * 64 + 16 * q4) = (u32x4){kcw[4 * q4], kcw[4 * q4 + 1], kcw[4 * q4 + 2], kcw[4 * q4 + 3]};
                *(LAS u32x4*)(sl + CS_VC + lane * 64 + 16 * q4) = (u32x4){vcw[4 * q4], vcw[4 * q4 + 1], vcw[4 * q4 + 2], vcw[4 * q4 + 3]}; }
            *(LAS float*)(sl + CS_GL + lane * 4) = gprev;
            LDS_WAIT();
            if (lane == 0) __hip_atomic_store(rawfree + s, use + 1u, __ATOMIC_RELAXED, __HIP_MEMORY_SCOPE_WORKGROUP);
            PROBE_END(11, a.ws, wave);
            PROBE_BEGIN(12, a.ws, wave);
            const int tok = lane & 31, hf = lane >> 5;
            bf16x8 fn[4], fr[4], fb[4], fk[4];
#pragma unroll
            for (int ks = 0; ks < 4; ++ks) { fn[ks] = *(const LAS bf16x8*)(sl + CS_NT + (tok * 64 + 16 * ks + 8 * hf) * 2); fr[ks] = *(const LAS bf16x8*)(sl + CS_RT + (tok * 64 + 16 * ks + 8 * hf) * 2);
                fb[ks] = *(const LAS bf16x8*)(sl + CS_BT + (tok * 64 + 16 * ks + 8 * hf) * 2); fk[ks] = *(const LAS bf16x8*)(sl + CS_KT + (tok * 64 + 16 * ks + 8 * hf) * 2); }
            f32x16 P, Pt, Tm, Akn, Abr, Akr;
#pragma unroll
            for (int e = 0; e < 16; ++e) { P[e] = 0.f; Pt[e] = 0.f; Akn[e] = 0.f; Abr[e] = 0.f; Akr[e] = 0.f; }
#pragma unroll
            for (int ks = 0; ks < 4; ++ks) { P = __builtin_amdgcn_mfma_f32_32x32x16_bf16(fn[ks], fb[ks], P, 0, 0, 0); Pt = __builtin_amdgcn_mfma_f32_32x32x16_bf16(fb[ks], fn[ks], Pt, 0, 0, 0);
                Akn = __builtin_amdgcn_mfma_f32_32x32x16_bf16(fn[ks], fk[ks], Akn, 0, 0, 0); Abr = __builtin_amdgcn_mfma_f32_32x32x16_bf16(fr[ks], fb[ks], Abr, 0, 0, 0); Akr = __builtin_amdgcn_mfma_f32_32x32x16_bf16(fr[ks], fk[ks], Akr, 0, 0, 0); }
#pragma unroll
            for (int e = 0; e < 16; ++e) { const int row = (e & 3) + 8 * (e >> 2) + 4 * hf, col = tok;
                if (!(col < row)) { P[e] = 0.f; Akn[e] = 0.f; } if (!(row < col)) Pt[e] = 0.f; if (col > row) { Abr[e] = 0.f; Akr[e] = 0.f; }
                Tm[e] = P[e] + (row == col ? 1.0f : 0.f); }
#pragma unroll
            for (int mm = 1; mm <= 4; ++mm) {
                const bf16x8 p0 = cfrag(P, 0), p1 = cfrag(P, 1), q0 = cfrag(Pt, 0), q1 = cfrag(Pt, 1);
                f32x16 Ptn, Pn;
#pragma unroll
                for (int e = 0; e < 16; ++e) { Ptn[e] = 0.f; Pn[e] = 0.f; }
                Ptn = __builtin_amdgcn_mfma_f32_32x32x16_bf16(p0, q0, Ptn, 0, 0, 0); Ptn = __builtin_amdgcn_mfma_f32_32x32x16_bf16(p1, q1, Ptn, 0, 0, 0);
                if (mm < 4) { Pn = __builtin_amdgcn_mfma_f32_32x32x16_bf16(q0, p0, Pn, 0, 0, 0); Pn = __builtin_amdgcn_mfma_f32_32x32x16_bf16(q1, p1, Pn, 0, 0, 0); }
                const bf16x8 t0 = cfrag(Tm, 0), t1 = cfrag(Tm, 1), u0 = cfrag(Ptn, 0), u1 = cfrag(Ptn, 1);
                Tm = __builtin_amdgcn_mfma_f32_32x32x16_bf16(u0, t0, Tm, 0, 0, 0); Tm = __builtin_amdgcn_mfma_f32_32x32x16_bf16(u1, t1, Tm, 0, 0, 0);
                P = Pn; Pt = Ptn;
            }
            { const int pc = permp(tok);
#pragma unroll
              for (int e = 0; e < 16; e += 2) { const int row = (e & 3) + 8 * (e >> 2) + 4 * hf;
                const unsigned w0 = pk2(Tm[e], Tm[e + 1]), w1 = pk2(Akn[e], Akn[e + 1]), w2 = pk2(Abr[e], Abr[e + 1]), w3 = pk2(Akr[e], Akr[e + 1]);
                *(LAS unsigned short*)(sl + CS_TM + (row * 32 + pc) * 2) = (unsigned short)w0; *(LAS unsigned short*)(sl + CS_TM + ((row + 1) * 32 + pc) * 2) = (unsigned short)(w0 >> 16);
                *(LAS unsigned short*)(sl + CS_AKN + (row * 32 + pc) * 2) = (unsigned short)w1; *(LAS unsigned short*)(sl + CS_AKN + ((row + 1) * 32 + pc) * 2) = (unsigned short)(w1 >> 16);
                *(LAS unsigned short*)(sl + CS_ABR + (row * 32 + pc) * 2) = (unsigned short)w2; *(LAS unsigned short*)(sl + CS_ABR + ((row + 1) * 32 + pc) * 2) = (unsigned short)(w2 >> 16);
                *(LAS unsigned short*)(sl + CS_AKR + (row * 32 + pc) * 2) = (unsigned short)w3; *(LAS unsigned short*)(sl + CS_AKR + ((row + 1) * 32 + pc) * 2) = (unsigned short)(w3 >> 16); } }
            LDS_WAIT();
            if (lane == 0) __hip_atomic_store(ready + s, (unsigned)(c + 1), __ATOMIC_RELAXED, __HIP_MEMORY_SCOPE_WORKGROUP);
            PROBE_END(12, a.ws, wave);
        }
    } else {
        const int l15 = lane & 15, g = lane >> 4, vb = wave;
        f32x4 xc[4];
#pragma unroll
        for (int kt = 0; kt < 4; ++kt) xc[kt] = (f32x4){0.f, 0.f, 0.f, 0.f};
        for (int c = 0; c < CS_NCH; ++c) {
            const int s = c % CS_NSLOT; const LAS unsigned char* sl = lds + s * CS_SLOT;
            lds_poll_ge(ready + s, (unsigned)(c + 1));
            const bf16x8 xb0 = cfrag2(xc[0], xc[1]), xb1 = cfrag2(xc[2], xc[3]);
            const bf16x8 vop = *(const LAS bf16x8*)(sl + CS_VC + ((16 * vb + l15) * 32 + 8 * g) * 2);
            f32x4 W[2], U[2], Y[2];
#pragma unroll
            for (int rt = 0; rt < 2; ++rt) { const int row = 16 * rt + l15; f32x4 acc = (f32x4){0.f, 0.f, 0.f, 0.f};
                acc = __builtin_amdgcn_mfma_f32_16x16x32_bf16(*(const LAS bf16x8*)(sl + CS_AKN + (row * 32 + 8 * g) * 2), vop, acc, 0, 0, 0);
                acc = __builtin_amdgcn_mfma_f32_16x16x32_bf16(*(const LAS bf16x8*)(sl + CS_NT + (row * 64 + 8 * g) * 2), xb0, acc, 0, 0, 0);
                acc = __builtin_amdgcn_mfma_f32_16x16x32_bf16(*(const LAS bf16x8*)(sl + CS_NT + (row * 64 + 32 + 8 * g) * 2), xb1, acc, 0, 0, 0);
                W[rt] = acc; }
            const bf16x8 wb = cfrag2(W[0], W[1]);
#pragma unroll
            for (int rt = 0; rt < 2; ++rt) { const int row = 16 * rt + l15;
                U[rt] = __builtin_amdgcn_mfma_f32_16x16x32_bf16(*(const LAS bf16x8*)(sl + CS_TM + (row * 32 + 8 * g) * 2), wb, (f32x4){0.f, 0.f, 0.f, 0.f}, 0, 0, 0); }
            const bf16x8 ub = cfrag2(U[0], U[1]);
#pragma unroll
            for (int rt = 0; rt < 2; ++rt) { const int row = 16 * rt + l15; f32x4 acc = (f32x4){0.f, 0.f, 0.f, 0.f};
                acc = __builtin_amdgcn_mfma_f32_16x16x32_bf16(*(const LAS bf16x8*)(sl + CS_AKR + (row * 32 + 8 * g) * 2), vop, acc, 0, 0, 0);
                acc = __builtin_amdgcn_mfma_f32_16x16x32_bf16(*(const LAS bf16x8*)(sl + CS_RT + (row * 64 + 8 * g) * 2), xb0, acc, 0, 0, 0);
                acc = __builtin_amdgcn_mfma_f32_16x16x32_bf16(*(const LAS bf16x8*)(sl + CS_RT + (row * 64 + 32 + 8 * g) * 2), xb1, acc, 0, 0, 0);
                acc = __builtin_amdgcn_mfma_f32_16x16x32_bf16(*(const LAS bf16x8*)(sl + CS_ABR + (row * 32 + 8 * g) * 2), ub, acc, 0, 0, 0);
                Y[rt] = acc; }
#pragma unroll
            for (int kt = 0; kt < 4; ++kt) { const int row = 16 * kt + l15; f32x4 acc = xc[kt];
                acc = __builtin_amdgcn_mfma_f32_16x16x32_bf16(*(const LAS bf16x8*)(sl + CS_KC + (row * 32 + 8 * g) * 2), vop, acc, 0, 0, 0);
                acc = __builtin_amdgcn_mfma_f32_16x16x32_bf16(*(const LAS bf16x8*)(sl + CS_BC + (row * 32 + 8 * g) * 2), ub, acc, 0, 0, 0);
                xc[kt] = acc * *(const LAS f32x4*)(sl + CS_GL + (16 * kt + 4 * g) * 4); }
            LDS_WAIT();
            if (lane == 0) (void)__hip_atomic_fetch_add(done + s, 1u, __ATOMIC_RELAXED, __HIP_MEMORY_SCOPE_WORKGROUP);
#pragma unroll
            for (int rt = 0; rt < 2; ++rt)
#pragma unroll
                for (int e = 0; e < 4; ++e) { const size_t m = (size_t)b * SEQ + (size_t)c * CS_L + 16 * rt + 4 * g + e;
                    YAB[m * 2048 + 1024 + h * 64 + 16 * vb + l15] = (bf16_t)(pk2(Y[rt][e], 0.f) & 0xffffu); }
        }
    }
}

constexpr int CR_PIECE = 12, CR_NP = (CS_NCH + CR_PIECE - 1) / CR_PIECE, CR_PW = 4, CR_PSLOT = CS_SLOT + 2 * 33 * 128;
constexpr size_t DO_IMG = 66 * MiB;
static_assert((CR_PIECE % 4) == 0 && DO_IMG + (size_t)2 * 64 * CR_PIECE * CS_SLOT <= 128 * MiB && CR_PW * CR_PSLOT <= CS_FLAGS, "image buffer / producer slots");

__device__ __forceinline__ void cscan_produce(const Args& a, const int wave, LAS unsigned char* lds, const int piece, const int first, const int nblk) {
    const int nch = (CS_NCH - piece * CR_PIECE) < CR_PIECE ? (CS_NCH - piece * CR_PIECE) : CR_PIECE;
    if (wave >= CR_PW) {
        const int lane = lane_id(); const int iw = ((int)blockIdx.x - first) * (NWAVES - CR_PW) + (wave - CR_PW), niw = nblk * (NWAVES - CR_PW);
        for (int t = piece * 2 * niw + iw; t < (piece + 1) * 2 * niw && t < MTOK; t += niw) rope_item(a, t, lane);
        return; }
    const bf16_t* Rg = (const bf16_t*)(a.ws + WS_R); const bf16_t* Kg = (const bf16_t*)(a.ws + WS_K); const bf16_t* Vg = (const bf16_t*)(a.ws + WS_V);
    const bf16_t* Dg = (const bf16_t*)(a.ws + WS_DARR); const bf16_t* Ag = (const bf16_t*)(a.ws + WS_AARR);
    float* RK = (float*)((unsigned char*)a.out + DO_RK); unsigned char* IMG = (unsigned char*)a.out + DO_IMG + (size_t)(piece & 1) * 64 * CR_PIECE * CS_SLOT;
    LAS unsigned char* sl = lds + wave * CR_PSLOT;
    const LAS unsigned short* rawD = (const LAS unsigned short*)(sl + 16384); const LAS unsigned short* rawA = (const LAS unsigned short*)(sl + 20480);
    const LAS unsigned short* rawR = (const LAS unsigned short*)(sl + 24576); const LAS unsigned short* rawK = (const LAS unsigned short*)(sl + CS_SLOT); const LAS unsigned short* rawV = (const LAS unsigned short*)(sl + CS_SLOT + 33 * 128);
    u32x4 pre[5][4], prep[3];
    auto issue = [&](int it2, int rr, int c8, int lane) { const int bh2 = it2 / nch, cc2 = it2 % nch, c2 = piece * CR_PIECE + cc2; const unsigned mm = (unsigned)(bh2 >> 4) * SEQ + (unsigned)c2 * CS_L; const int hh = bh2 & 15;
        const unsigned eoff = ((mm + rr) * DM + hh * 64 + 8 * c8) * 2u;
        const unsigned char* wsb = a.ws;
#pragma unroll
        for (int ar = 0; ar < 5; ++ar) { constexpr size_t AOFF[5] = {WS_R, WS_K, WS_V, WS_DARR, WS_AARR};
#pragma unroll
            for (int q4 = 0; q4 < 4; ++q4) pre[ar][q4] = *(const u32x4*)(wsb + AOFF[ar] + eoff + (unsigned)(8 * q4 * DM * 2)); }
        const bool hasp = (c2 > 0) && (lane < 8); const unsigned poff = hasp ? (eoff - (unsigned)((rr + 1) * DM * 2)) : eoff;
#pragma unroll
        for (int ar = 0; ar < 3; ++ar) { constexpr size_t AOFF[3] = {WS_R, WS_K, WS_V}; const u32x4 t = *(const u32x4*)(wsb + AOFF[ar] + poff); prep[ar] = hasp ? t : (u32x4){0u, 0u, 0u, 0u}; } };
    const int it0 = ((int)blockIdx.x - first) * CR_PW + wave, nimg = 64 * nch, itstep = nblk * CR_PW;
    { const int l0 = lane_id(); if (it0 < nimg) issue(it0, l0 >> 3, l0 & 7, l0); }
    for (int it = it0; it < nimg; it += itstep) {
        const int lane = lane_id(), rr = lane >> 3, c8 = lane & 7, kpos = 32 * (lane >> 5) + permp(lane & 31);
        const int bh = it / nch, cc = it % nch, b = bh >> 4, h = bh & 15, c = piece * CR_PIECE + cc, gch = h * 64 + lane;
        const float mur = a.mu_rkv[gch], muk = a.mu_rkv[DM + gch], muv = a.mu_rkv[2 * DM + gch], kkw = a.rwkv_vec[2 * DM + gch], kaw = a.rwkv_vec[3 * DM + gch], rkw = a.r_k[gch];
            const size_t m0 = (size_t)b * SEQ + (size_t)c * CS_L;
            { LAS unsigned char* wb = sl + rr * 128 + 16 * c8; asm volatile("" : "+v"(wb));
#pragma unroll
              for (int q4 = 0; q4 < 4; ++q4) {
                *(LAS u32x4*)(wb + 24576 + (8 * q4 + 1) * 128) = pre[0][q4]; *(LAS u32x4*)(wb + CS_SLOT + (8 * q4 + 1) * 128) = pre[1][q4]; *(LAS u32x4*)(wb + CS_SLOT + 33 * 128 + (8 * q4 + 1) * 128) = pre[2][q4];
                *(LAS u32x4*)(wb + 16384 + (8 * q4) * 128) = pre[3][q4]; *(LAS u32x4*)(wb + 20480 + (8 * q4) * 128) = pre[4][q4]; }
              if (lane < 8) { *(LAS u32x4*)(wb + 24576) = prep[0]; *(LAS u32x4*)(wb + CS_SLOT) = prep[1]; *(LAS u32x4*)(wb + CS_SLOT + 33 * 128) = prep[2]; } }
            LDS_WAIT();
            const LAS unsigned short* rb = (const LAS unsigned short*)sl + lane; asm volatile("" : "+v"(rb));
            float rp = bflo((unsigned)rb[24576 / 2]), kp = bflo((unsigned)rb[CS_SLOT / 2]), vp = bflo((unsigned)rb[(CS_SLOT + 33 * 128) / 2]);
            float cum = 0.f, gprev = 1.f;
            unsigned bcw[16], kcw[16], vcw[16];
#pragma unroll
            for (int grp = 0; grp < 4; ++grp) {
                float rlv[8], kkrv[8], kprv[8], vlv[8], aav[8], ddv[8], red[16];
#pragma unroll
                for (int e = 0; e < 8; ++e) { const int row = 8 * grp + e;
                    const float r0 = bflo((unsigned)rb[24576 / 2 + (row + 1) * 64]), k0 = bflo((unsigned)rb[CS_SLOT / 2 + (row + 1) * 64]), v0 = bflo((unsigned)rb[(CS_SLOT + 33 * 128) / 2 + (row + 1) * 64]);
                    ddv[e] = bflo((unsigned)rb[16384 / 2 + row * 64]); aav[e] = bflo((unsigned)rb[20480 / 2 + row * 64]);
                    rlv[e] = r0 + (rp - r0) * mur; const float kl = k0 + (kp - k0) * muk; vlv[e] = v0 + (vp - v0) * muv; rp = r0; kp = k0; vp = v0;
                    kkrv[e] = kl * kkw; kprv[e] = kl * (1.0f + (aav[e] - 1.0f) * kaw);
                    red[2 * e] = kkrv[e] * kkrv[e]; red[2 * e + 1] = rlv[e] * kprv[e] * rkw; }
#pragma unroll
                for (int e = 0; e < 16; ++e) red[e] += dppf<0xB1, 0xf>(red[e]);
#pragma unroll
                for (int e = 0; e < 16; ++e) red[e] += dppf<0x4E, 0xf>(red[e]);
#pragma unroll
                for (int e = 0; e < 16; ++e) red[e] += dppf<0x141, 0xf>(red[e]);
#pragma unroll
                for (int e = 0; e < 16; ++e) red[e] += dppf<0x140, 0xf>(red[e]);
#pragma unroll
                for (int e = 0; e < 16; ++e) red[e] += dppf<0x142, 0xa>(red[e]);
#pragma unroll
                for (int e = 0; e < 16; ++e) red[e] += dppf<0x143, 0xc>(red[e]);
#pragma unroll
                for (int e = 0; e < 16; ++e) red[e] = __int_as_float(__builtin_amdgcn_readlane(__float_as_int(red[e]), 63));
                if (lane < 8) { float rkv = red[1];
#pragma unroll
                    for (int e = 1; e < 8; ++e) rkv = (lane == e) ? red[2 * e + 1] : rkv;
                    RK[(m0 + 8 * grp + lane) * 16 + h] = rkv; }
#pragma unroll
                for (int j2 = 0; j2 < 4; ++j2) {
                    const int i2 = 4 * grp + j2;
                    float nt[2], bt[2], kt[2], rt[2], vt[2];
#pragma unroll
                    for (int e = 0; e < 2; ++e) { const int te = 2 * j2 + e;
                        const float kkv = kkrv[te] * __builtin_amdgcn_rsqf(fmaxf(red[2 * te], 1e-24f)), bb = kkv * aav[te];
                        cum += ddv[te]; const float gi = __expf(-cum), ginv = __builtin_amdgcn_rcpf(gi);
                        nt[e] = -kkv * gprev; bt[e] = bb * ginv; kt[e] = kprv[te] * ginv; rt[e] = rlv[te] * gi; vt[e] = vlv[te]; gprev = gi; }
                    const unsigned wn = pk2(nt[0], nt[1]), wb = pk2(bt[0], bt[1]), wk = pk2(kt[0], kt[1]), wr = pk2(rt[0], rt[1]), wv = pk2(vt[0], vt[1]);
                    const int i = 2 * i2;
                    *(LAS unsigned short*)(sl + CS_NT + (i * 64 + kpos) * 2) = (unsigned short)wn; *(LAS unsigned short*)(sl + CS_NT + ((i + 1) * 64 + kpos) * 2) = (unsigned short)(wn >> 16);
                    *(LAS unsigned short*)(sl + CS_RT + (i * 64 + kpos) * 2) = (unsigned short)wr; *(LAS unsigned short*)(sl + CS_RT + ((i + 1) * 64 + kpos) * 2) = (unsigned short)(wr >> 16);
                    *(LAS unsigned short*)(sl + CS_BT + (i * 64 + kpos) * 2) = (unsigned short)wb; *(LAS unsigned short*)(sl + CS_BT + ((i + 1) * 64 + kpos) * 2) = (unsigned short)(wb >> 16);
                    *(LAS unsigned short*)(sl + CS_KT + (i * 64 + kpos) * 2) = (unsigned short)wk; *(LAS unsigned short*)(sl + CS_KT + ((i + 1) * 64 + kpos) * 2) = (unsigned short)(wk >> 16);
                    const int pw = permp(i) >> 1;
                    bcw[pw] = wb; kcw[pw] = wk; vcw[pw] = wv;
                }
                __builtin_amdgcn_sched_barrier(0);
            }
#pragma unroll
            for (int q4 = 0; q4 < 4; ++q4) {
                *(LAS u32x4*)(sl + CS_BC + lane * 64 + 16 * q4) = (u32x4){bcw[4 * q4], bcw[4 * q4 + 1], bcw[4 * q4 + 2], bcw[4 * q4 + 3]};
                *(LAS u32x4*)(sl + CS_KC + lane * 64 + 16 * q4) = (u32x4){kcw[4 * q4], kcw[4 * q4 + 1], kcw[4 * q4 + 2], kcw[4 * q4 + 3]};
                *(LAS u32x4*)(sl + CS_VC + lane * 64 + 16 * q4) = (u32x4){vcw[4 * q4], vcw[4 * q4 + 1], vcw[4 * q4 + 2], vcw[4 * q4 + 3]}; }
            *(LAS float*)(sl + CS_GL + lane * 4) = gprev;
            LDS_WAIT();
            const int tok = lane & 31, hf = lane >> 5;
            bf16x8 fn[4], fr[4], fb[4], fk[4];
#pragma unroll
            for (int ks = 0; ks < 4; ++ks) { fn[ks] = *(const LAS bf16x8*)(sl + CS_NT + (tok * 64 + 16 * ks + 8 * hf) * 2); fr[ks] = *(const LAS bf16x8*)(sl + CS_RT + (tok * 64 + 16 * ks + 8 * hf) * 2);
                fb[ks] = *(const LAS bf16x8*)(sl + CS_BT + (tok * 64 + 16 * ks + 8 * hf) * 2); fk[ks] = *(const LAS bf16x8*)(sl + CS_KT + (tok * 64 + 16 * ks + 8 * hf) * 2); }
            f32x16 P, Pt, Tm, Akn, Abr, Akr;
#pragma unroll
            for (int e = 0; e < 16; ++e) { P[e] = 0.f; Pt[e] = 0.f; Akn[e] = 0.f; Abr[e] = 0.f; Akr[e] = 0.f; }
#pragma unroll
            for (int ks = 0; ks < 4; ++ks) { P = __builtin_amdgcn_mfma_f32_32x32x16_bf16(fn[ks], fb[ks], P, 0, 0, 0); Pt = __builtin_amdgcn_mfma_f32_32x32x16_bf16(fb[ks], fn[ks], Pt, 0, 0, 0);
                Akn = __builtin_amdgcn_mfma_f32_32x32x16_bf16(fn[ks], fk[ks], Akn, 0, 0, 0); Abr = __builtin_amdgcn_mfma_f32_32x32x16_bf16(fr[ks], fb[ks], Abr, 0, 0, 0); Akr = __builtin_amdgcn_mfma_f32_32x32x16_bf16(fr[ks], fk[ks], Akr, 0, 0, 0); }
#pragma unroll
            for (int e = 0; e < 16; ++e) { const int row = (e & 3) + 8 * (e >> 2) + 4 * hf, col = tok;
                if (!(col < row)) { P[e] = 0.f; Akn[e] = 0.f; } if (!(row < col)) Pt[e] = 0.f; if (col > row) { Abr[e] = 0.f; Akr[e] = 0.f; }
                Tm[e] = P[e] + (row == col ? 1.0f : 0.f); }
#pragma unroll
            for (int mm = 1; mm <= 4; ++mm) {
                const bf16x8 p0 = cfrag(P, 0), p1 = cfrag(P, 1), q0 = cfrag(Pt, 0), q1 = cfrag(Pt, 1);
                f32x16 Ptn, Pn;
#pragma unroll
                for (int e = 0; e < 16; ++e) { Ptn[e] = 0.f; Pn[e] = 0.f; }
                Ptn = __builtin_amdgcn_mfma_f32_32x32x16_bf16(p0, q0, Ptn, 0, 0, 0); Ptn = __builtin_amdgcn_mfma_f32_32x32x16_bf16(p1, q1, Ptn, 0, 0, 0);
                if (mm < 4) { Pn = __builtin_amdgcn_mfma_f32_32x32x16_bf16(q0, p0, Pn, 0, 0, 0); Pn = __builtin_amdgcn_mfma_f32_32x32x16_bf16(q1, p1, Pn, 0, 0, 0); }
                const bf16x8 t0 = cfrag(Tm, 0), t1 = cfrag(Tm, 1), u0 = cfrag(Ptn, 0), u1 = cfrag(Ptn, 1);
                Tm = __builtin_amdgcn_mfma_f32_32x32x16_bf16(u0, t0, Tm, 0, 0, 0); Tm = __builtin_amdgcn_mfma_f32_32x32x16_bf16(u1, t1, Tm, 0, 0, 0);
                P = Pn; Pt = Ptn;
            }
            { const int itn = it + itstep; if (itn < nimg) { const int l2 = lane_id(); issue(itn, l2 >> 3, l2 & 7, l2); } }
            { const int pc = permp(tok);
#pragma unroll
              for (int e = 0; e < 16; e += 2) { const int row = (e & 3) + 8 * (e >> 2) + 4 * hf;
                const unsigned w0 = pk2(Tm[e], Tm[e + 1]), w1 = pk2(Akn[e], Akn[e + 1]), w2 = pk2(Abr[e], Abr[e + 1]), w3 = pk2(Akr[e], Akr[e + 1]);
                *(LAS unsigned short*)(sl + CS_TM + (row * 32 + pc) * 2) = (unsigned short)w0; *(LAS unsigned short*)(sl + CS_TM + ((row + 1) * 32 + pc) * 2) = (unsigned short)(w0 >> 16);
                *(LAS unsigned short*)(sl + CS_AKN + (row * 32 + pc) * 2) = (unsigned short)w1; *(LAS unsigned short*)(sl + CS_AKN + ((row + 1) * 32 + pc) * 2) = (unsigned short)(w1 >> 16);
                *(LAS unsigned short*)(sl + CS_ABR + (row * 32 + pc) * 2) = (unsigned short)w2; *(LAS unsigned short*)(sl + CS_ABR + ((row + 1) * 32 + pc) * 2) = (unsigned short)(w2 >> 16);
                *(LAS unsigned short*)(sl + CS_AKR + (row * 32 + pc) * 2) = (unsigned short)w3; *(LAS unsigned short*)(sl + CS_AKR + ((row + 1) * 32 + pc) * 2) = (unsigned short)(w3 >> 16); } }
            LDS_WAIT();
            { unsigned char* dst = IMG + (size_t)(bh * CR_PIECE + cc) * CS_SLOT;
#pragma unroll 1
              for (int j = lane; j < CS_SLOT / 16; j += 64) *(u32x4*)(dst + 16 * j) = *(const LAS u32x4*)(sl + 16 * j); }
            LDS_WAIT();
    }
}

__device__ __forceinline__ void cscan_consume(const Args& a, const int wave, LAS unsigned char* lds, const int bh, const int piece, f32x4 (&xc)[4]) {
    const int lane = lane_id();
    const int b = bh >> 4, h = bh & 15;
    bf16_t* YAB = (bf16_t*)(a.ws + WS_YAB); const unsigned char* IMG = (const unsigned char*)a.out + DO_IMG + (size_t)(piece & 1) * 64 * CR_PIECE * CS_SLOT;
    const int nch = (CS_NCH - piece * CR_PIECE) < CR_PIECE ? (CS_NCH - piece * CR_PIECE) : CR_PIECE;
    LAS unsigned* ready = (LAS unsigned*)(lds + CS_FLAGS); LAS unsigned* done = ready + 4;
    if (wave == 4) {
        constexpr int NI = (CS_SLOT + 1023) / 1024;
        for (int cc = 0; cc <= nch; ++cc) {
            if (cc < nch) { const int c = piece * CR_PIECE + cc, s = cc & 3; LAS unsigned char* sl = lds + s * CS_SLOT;
                const unsigned char* src = IMG + (size_t)(bh * CR_PIECE + cc) * CS_SLOT;
                if (c >= 4) lds_poll_ge(done + s, 4u * (unsigned)(c >> 2));
#pragma unroll
                for (int j = 0; j < NI; ++j) { const int idx = lane + 64 * j;
                    if (idx < CS_SLOT / 16) __builtin_amdgcn_global_load_lds((const unsigned*)(src + 16 * idx), (LAS unsigned*)(sl + 1024 * j), 16, 0, 0); } }
            if (cc >= 1) {
                if (cc < nch) asm volatile("s_waitcnt vmcnt(29)" ::: "memory"); else asm volatile("s_waitcnt vmcnt(0)" ::: "memory");
                if (lane == 0) __hip_atomic_store(ready + ((cc - 1) & 3), (unsigned)(piece * CR_PIECE + cc), __ATOMIC_RELAXED, __HIP_MEMORY_SCOPE_WORKGROUP); }
        }
    } else if (wave < 4) {
        const int l15 = lane & 15, g = lane >> 4, vb = wave;
        for (int cc = 0; cc < nch; ++cc) { const int c = piece * CR_PIECE + cc, s = cc & 3; const LAS unsigned char* sl = lds + s * CS_SLOT;
            { lds_poll_ge(ready + s, (unsigned)(c + 1)); }
            const bf16x8 xb0 = cfrag2(xc[0], xc[1]), xb1 = cfrag2(xc[2], xc[3]);
            const bf16x8 vop = *(const LAS bf16x8*)(sl + CS_VC + ((16 * vb + l15) * 32 + 8 * g) * 2);
            f32x4 W[2], U[2], Y[2];
#pragma unroll
            for (int rt = 0; rt < 2; ++rt) { const int row = 16 * rt + l15; f32x4 acc = (f32x4){0.f, 0.f, 0.f, 0.f};
                acc = __builtin_amdgcn_mfma_f32_16x16x32_bf16(*(const LAS bf16x8*)(sl + CS_AKN + (row * 32 + 8 * g) * 2), vop, acc, 0, 0, 0);
                acc = __builtin_amdgcn_mfma_f32_16x16x32_bf16(*(const LAS bf16x8*)(sl + CS_NT + (row * 64 + 8 * g) * 2), xb0, acc, 0, 0, 0);
                acc = __builtin_amdgcn_mfma_f32_16x16x32_bf16(*(const LAS bf16x8*)(sl + CS_NT + (row * 64 + 32 + 8 * g) * 2), xb1, acc, 0, 0, 0);
                W[rt] = acc; }
            const bf16x8 wb = cfrag2(W[0], W[1]);
#pragma unroll
            for (int rt = 0; rt < 2; ++rt) { const int row = 16 * rt + l15;
                U[rt] = __builtin_amdgcn_mfma_f32_16x16x32_bf16(*(const LAS bf16x8*)(sl + CS_TM + (row * 32 + 8 * g) * 2), wb, (f32x4){0.f, 0.f, 0.f, 0.f}, 0, 0, 0); }
            const bf16x8 ub = cfrag2(U[0], U[1]);
#pragma unroll
            for (int rt = 0; rt < 2; ++rt) { const int row = 16 * rt + l15; f32x4 acc = (f32x4){0.f, 0.f, 0.f, 0.f};
                acc = __builtin_amdgcn_mfma_f32_16x16x32_bf16(*(const LAS bf16x8*)(sl + CS_AKR + (row * 32 + 8 * g) * 2), vop, acc, 0, 0, 0);
                acc = __builtin_amdgcn_mfma_f32_16x16x32_bf16(*(const LAS bf16x8*)(sl + CS_RT + (row * 64 + 8 * g) * 2), xb0, acc, 0, 0, 0);
                acc = __builtin_amdgcn_mfma_f32_16x16x32_bf16(*(const LAS bf16x8*)(sl + CS_RT + (row * 64 + 32 + 8 * g) * 2), xb1, acc, 0, 0, 0);
                acc = __builtin_amdgcn_mfma_f32_16x16x32_bf16(*(const LAS bf16x8*)(sl + CS_ABR + (row * 32 + 8 * g) * 2), ub, acc, 0, 0, 0);
                Y[rt] = acc; }
#pragma unroll
            for (int kt = 0; kt < 4; ++kt) { const int row = 16 * kt + l15; f32x4 acc = xc[kt];
                acc = __builtin_amdgcn_mfma_f32_16x16x32_bf16(*(const LAS bf16x8*)(sl + CS_KC + (row * 32 + 8 * g) * 2), vop, acc, 0, 0, 0);
                acc = __builtin_amdgcn_mfma_f32_16x16x32_bf16(*(const LAS bf16x8*)(sl + CS_BC + (row * 32 + 8 * g) * 2), ub, acc, 0, 0, 0);
                xc[kt] = acc * *(const LAS f32x4*)(sl + CS_GL + (16 * kt + 4 * g) * 4); }
            LDS_WAIT();
            if (lane == 0) (void)__hip_atomic_fetch_add(done + s, 1u, __ATOMIC_RELAXED, __HIP_MEMORY_SCOPE_WORKGROUP);
#pragma unroll
            for (int rt = 0; rt < 2; ++rt)
#pragma unroll
                for (int e = 0; e < 4; ++e) { const size_t m = (size_t)b * SEQ + (size_t)c * CS_L + 16 * rt + 4 * g + e;
                    YAB[m * 2048 + 1024 + h * 64 + 16 * vb + l15] = (bf16_t)(pk2(Y[rt][e], 0.f) & 0xffffu); }
        }
    }
}

constexpr int DS_NQ = 16, DS_CAP = 2048, DS_TRIG = 1536, DS_TOPK = 256;
constexpr int DS_HIST_WORDS = 320;
constexpr int DS_CAND_OFF = 0, DS_HIST_OFF = DS_NQ * DS_CAP * 4, DS_CNT_OFF = DS_HIST_OFF + 8 * DS_HIST_WORDS * 4, DS_TAU_OFF = DS_CNT_OFF + 64;
static_assert(DS_TAU_OFF + 64 <= LDS_BYTES, "dsa LDS map");

template <int CTRL, int RM> __device__ __forceinline__ unsigned dppu(unsigned x) { return (unsigned)__builtin_amdgcn_update_dpp(0, (int)x, CTRL, RM, 0xf, true); }
__device__ __forceinline__ unsigned wave_scan_incl(unsigned v) {
    v += dppu<0x111, 0xf>(v); v += dppu<0x112, 0xf>(v); v += dppu<0x114, 0xf>(v); v += dppu<0x118, 0xf>(v);
    v += dppu<0x142, 0xa>(v);
    v += dppu<0x143, 0xc>(v);
    return v; }
template <int NE>
__device__ __forceinline__ void select_compact(LAS unsigned* cq, LAS unsigned* cntq, LAS unsigned* tauq, LAS unsigned* hist, int lane) {
    const unsigned n = *cntq;
    unsigned e[NE];
#pragma unroll
    for (int j = 0; j < NE; ++j) { const unsigned idx = lane + 64 * j; e[j] = idx < n ? cq[idx] : 0u; }
    unsigned npos = 0u;
#pragma unroll
    for (int j = 0; j < NE; ++j) npos += (unsigned)__popcll(__ballot(e[j] >= 0x80000000u));
    if (npos >= (unsigned)DS_TOPK) {
#pragma unroll
        for (int j = 0; j < NE; ++j) e[j] = (e[j] >= 0x80000000u) ? e[j] : 0u; }
    unsigned va = 0xFFFFFFFFu, vo = 0u;
#pragma unroll
    for (int j = 0; j < NE; ++j) { va &= (e[j] != 0u) ? e[j] : 0xFFFFFFFFu; vo |= e[j]; }
    va &= (unsigned)__builtin_amdgcn_update_dpp(-1, (int)va, 0xB1, 0xf, 0xf, true); va &= (unsigned)__builtin_amdgcn_update_dpp(-1, (int)va, 0x4E, 0xf, 0xf, true);
    va &= (unsigned)__builtin_amdgcn_update_dpp(-1, (int)va, 0x141, 0xf, 0xf, true); va &= (unsigned)__builtin_amdgcn_update_dpp(-1, (int)va, 0x140, 0xf, 0xf, true);
    vo |= dppu<0xB1, 0xf>(vo); vo |= dppu<0x4E, 0xf>(vo); vo |= dppu<0x141, 0xf>(vo); vo |= dppu<0x140, 0xf>(vo);
    const unsigned vas = (unsigned)(__builtin_amdgcn_readlane((int)va, 0) & __builtin_amdgcn_readlane((int)va, 16) & __builtin_amdgcn_readlane((int)va, 32) & __builtin_amdgcn_readlane((int)va, 48));
    const unsigned vos = (unsigned)(__builtin_amdgcn_readlane((int)vo, 0) | __builtin_amdgcn_readlane((int)vo, 16) | __builtin_amdgcn_readlane((int)vo, 32) | __builtin_amdgcn_readlane((int)vo, 48));
    const unsigned diff = vas ^ vos;
    const int top = diff ? 31 - __builtin_clz(diff) : 7;
    unsigned prefix = (top >= 31) ? 0u : (vos & ~((2u << top) - 1u)), mask = (top >= 31) ? 0u : ~((2u << top) - 1u), need = DS_TOPK;
    int hi = top;
    const int rl = 63 - lane;
#pragma unroll 1
    for (int pass = 0; pass < 4 && hi >= 0; ++pass) {
        const int shift = hi >= 7 ? hi - 7 : 0; const unsigned dmask = (hi >= 7) ? 0xFFu : ((2u << hi) - 1u);
        *(LAS u32x4*)(hist + 4 * lane) = (u32x4){0u, 0u, 0u, 0u};
        LDS_WAIT();
#pragma unroll
        for (int j = 0; j < NE; ++j) { const bool hit = (e[j] != 0u) && ((e[j] & mask) == prefix); const unsigned bin = hit ? ((e[j] >> shift) & dmask) : (256u + (unsigned)lane);
            (void)__hip_atomic_fetch_add(hist + bin, 1u, __ATOMIC_RELAXED, __HIP_MEMORY_SCOPE_WORKGROUP); }
        LDS_WAIT();
        const u32x4 h4 = *(const LAS u32x4*)(hist + 4 * rl);
        const unsigned tot = (h4.x + h4.y) + (h4.z + h4.w);
        const unsigned v = wave_scan_incl(tot);
        const unsigned above = v - tot;
        const bool is = (above < need) && (need <= v);
        unsigned B = 0u, ca = 0u;
        if (is) { unsigned c = above;
            if (c + h4.w >= need) { B = 4 * rl + 3; ca = c; } else { c += h4.w;
            if (c + h4.z >= need) { B = 4 * rl + 2; ca = c; } else { c += h4.z;
            if (c + h4.y >= need) { B = 4 * rl + 1; ca = c; } else { c += h4.y; B = 4 * rl; ca = c; } } } }
        const unsigned long long bal = __ballot(is);
        if (bal == 0ull) break;
        const int src = __builtin_amdgcn_readfirstlane(__ffsll((long long)bal) - 1);
        B = (unsigned)__builtin_amdgcn_readlane((int)B, src); ca = (unsigned)__builtin_amdgcn_readlane((int)ca, src);
        need -= ca; prefix |= B << shift; mask |= dmask << shift; hi = shift - 1;
    }
    const unsigned T = prefix;
    unsigned base = 0u;
#pragma unroll
    for (int j = 0; j < NE; ++j) { const bool keep = (e[j] >= T) && (e[j] != 0u); const unsigned long long bal = __ballot(keep);
        const unsigned pos = base + __builtin_amdgcn_mbcnt_hi((unsigned)(bal >> 32), __builtin_amdgcn_mbcnt_lo((unsigned)bal, 0u));
        if (keep) cq[pos] = e[j];
        base += (unsigned)__popcll(bal); }
    if (lane == 0) { *cntq = base; *tauq = T; }
    LDS_WAIT();
}

template <int NE>
__device__ __forceinline__ void filter_compact(LAS unsigned* cq, LAS unsigned* cntq, LAS unsigned* tauq, int lane) {
    const unsigned n = *cntq;
    unsigned e[NE];
#pragma unroll
    for (int j = 0; j < NE; ++j) { const unsigned idx = lane + 64 * j; e[j] = idx < n ? cq[idx] : 0u; }
    unsigned m0 = 0u, m1 = 0u, m2 = 0u, m3 = 0u;
#pragma unroll
    for (int j = 0; j < NE; ++j) { unsigned x = e[j], t;
        t = max(m0, x); x = min(m0, x); m0 = t; t = max(m1, x); x = min(m1, x); m1 = t; t = max(m2, x); x = min(m2, x); m2 = t; m3 = max(m3, x); }
    unsigned T = m3;
    T = min(T, (unsigned)__builtin_amdgcn_update_dpp(-1, (int)T, 0xB1, 0xf, 0xf, true)); T = min(T, (unsigned)__builtin_amdgcn_update_dpp(-1, (int)T, 0x4E, 0xf, 0xf, true));
    T = min(T, (unsigned)__builtin_amdgcn_update_dpp(-1, (int)T, 0x141, 0xf, 0xf, true)); T = min(T, (unsigned)__builtin_amdgcn_update_dpp(-1, (int)T, 0x140, 0xf, 0xf, true));
    T = min(min((unsigned)__builtin_amdgcn_readlane((int)T, 0), (unsigned)__builtin_amdgcn_readlane((int)T, 16)), min((unsigned)__builtin_amdgcn_readlane((int)T, 32), (unsigned)__builtin_amdgcn_readlane((int)T, 48)));
    unsigned base = 0u;
#pragma unroll
    for (int j = 0; j < NE; ++j) { const bool keep = (e[j] >= T) && (e[j] != 0u); const unsigned long long bal = __ballot(keep);
        const unsigned pos = base + __builtin_amdgcn_mbcnt_hi((unsigned)(bal >> 32), __builtin_amdgcn_mbcnt_lo((unsigned)bal, 0u));
        if (keep) cq[pos] = e[j];
        base += (unsigned)__popcll(bal); }
    if (lane == 0) { *cntq = base; *tauq = (T > 0u) ? T - 1u : 0u; }
    LDS_WAIT();
}

__device__ __forceinline__ unsigned vrow_off(int pr) { return (unsigned)(pr < 28 ? 1024 + 256 * pr : 9216 + 256 * (pr - 28)); }
__device__ __forceinline__ unsigned swz_b(int row) { return (unsigned)(((row & 3) << 2) | ((row >> 2) & 3)); }

__device__ __forceinline__ void dsa_phase(const Args& a, const int wave, LAS unsigned char* lds, const bool dry = false) {
    const bf16_t* Qg = (const bf16_t*)(a.ws + WS_Q); const bf16_t* KVg = (const bf16_t*)(a.ws + WS_KV); const bf16_t* QIg = (const bf16_t*)(a.ws + WS_QI);
    const bf16_t* KIg = (const bf16_t*)(a.ws + WS_KI); const float* WIg = (const float*)(a.ws + WS_WI); bf16_t* Gg = (bf16_t*)(a.ws + WS_G);
    LAS unsigned* cand = (LAS unsigned*)(lds + DS_CAND_OFF); LAS unsigned* hist = (LAS unsigned*)(lds + DS_HIST_OFF) + wave * DS_HIST_WORDS;
    LAS unsigned* cnt = (LAS unsigned*)(lds + DS_CNT_OFF); LAS unsigned* taup = (LAS unsigned*)(lds + DS_TAU_OFF);
    for (int L = blockIdx.x; L < 2048; L += gridDim.x) {
        int lane; asm volatile("v_mbcnt_lo_u32_b32 %0, -1, 0\n\tv_mbcnt_hi_u32_b32 %0, -1, %0" : "=v"(lane));
        const int tid = wave * 64 + lane, ql = lane & 15, gq = lane >> 4;
        int b, j;
        if (gridDim.x == 256) { const int i = blockIdx.x, ui = L >> 8, x = i & 7, li = (i >> 3) * 2 + (x >> 2); b = x & 3; j = 128 * (ui >> 1) + ((ui & 1) ? 127 - li : li); }
        else { b = L >> 9; j = L & 511; }
        const unsigned mb = (unsigned)b * SEQ; const int q0 = DS_NQ * j; const unsigned mq = mb + q0 + ql;
        const int pos0 = a.pos[mb]; int nadm = ((a.pos[mq] >> 6) + 1) * 64 - pos0; nadm = nadm > SEQ ? SEQ : nadm;
        int nmax = ((a.pos[mb + q0 + DS_NQ - 1] >> 6) + 1) * 64 - pos0; nmax = nmax > SEQ ? SEQ : nmax;
        const int nstep = (nmax + 511) >> 9;
#ifdef DSA_REP_STREAM
        for (int srep_ = 0; srep_ < 2; ++srep_) {
#endif
        __syncthreads();
        if (tid < DS_NQ) { cnt[tid] = 0u; taup[tid] = 0u; }
        bf16x8 bq[8][2];
#pragma unroll
        for (int h = 0; h < 8; ++h)
#pragma unroll
            for (int ks = 0; ks < 2; ++ks) bq[h][ks] = *(const bf16x8*)(QIg + (mq * 512u + h * 64 + 32 * ks + 8 * gq));
        f32x2 wh[8]; { const f32x4 w0 = *(const f32x4*)(WIg + mq * 8), w1 = *(const f32x4*)(WIg + mq * 8 + 4);
#pragma unroll
            for (int h = 0; h < 4; ++h) { wh[h] = (f32x2){w0[h], w0[h]}; wh[4 + h] = (f32x2){w1[h], w1[h]}; } }
        __syncthreads();
        bf16x8 ka[4][2];
        { const bf16_t* kr = KIg + ((mb + 64 * wave + ql) * 64u + 8u * gq);
#pragma unroll
          for (int st = 0; st < 4; ++st)
#pragma unroll
            for (int ks = 0; ks < 2; ++ks) ka[st][ks] = *(const bf16x8*)(kr + st * 16 * 64 + 32 * ks); }
        for (int step = 0; step <= nstep; ++step) {
            const int kb = 512 * step + 64 * wave; const bool active = (kb < nmax) && (step < nstep);
            PROBE_BEGIN(2, a.ws, wave);
            if (active) {
                f32x2 sc2[8];
#ifdef DSA_SCORE2
                for (int srep2_ = 0; srep2_ < 2; ++srep2_) {
#endif
#pragma unroll
                for (int i = 0; i < 8; ++i) sc2[i] = (f32x2){0.f, 0.f};
#pragma unroll
                for (int h = 0; h < 8; ++h)
#pragma unroll
                    for (int st = 0; st < 4; ++st) { f32x4 acc = (f32x4){0.f, 0.f, 0.f, 0.f};
#pragma unroll
                        for (int ks = 0; ks < 2; ++ks) acc = __builtin_amdgcn_mfma_f32_16x16x32_bf16(ka[st][ks], bq[h][ks], acc, 0, 0, 0);
                        sc2[2 * st] += wh[h] * (f32x2){fmaxf(acc[0], 0.f), fmaxf(acc[1], 0.f)}; sc2[2 * st + 1] += wh[h] * (f32x2){fmaxf(acc[2], 0.f), fmaxf(acc[3], 0.f)};
                        if (st == 3 && (h & 1)) __builtin_amdgcn_sched_barrier(0); }
#ifdef DSA_SCORE2
#pragma unroll
                for (int i = 0; i < 8; ++i) asm volatile("" : "+v"(sc2[i]));
                }
#endif
                float sc[16];
#pragma unroll
                for (int i = 0; i < 8; ++i) { sc[2 * i] = sc2[i][0]; sc[2 * i + 1] = sc2[i][1]; }
                __builtin_amdgcn_sched_barrier(0);
                { const int kbn = (kb + 512 < SEQ) ? kb + 512 : kb; unsigned ko0 = (mb + kbn + ql) * 64u + 8u * gq, ko1 = ko0 + 2048u;
                  asm volatile("" : "+v"(ko0), "+v"(ko1));
#pragma unroll
                  for (int st = 0; st < 4; ++st)
#pragma unroll
                    for (int ks = 0; ks < 2; ++ks) ka[st][ks] = *(const bf16x8*)(KIg + ((st & 2) ? ko1 : ko0) + (st & 1) * 16 * 64 + 32 * ks); }
                const unsigned tp = taup[ql]; unsigned pm = 0u;
#pragma unroll
                for (int i = 0; i < 16; ++i) { const int key = kb + 16 * (i >> 2) + 4 * gq + (i & 3); const unsigned u = __float_as_uint(sc[i]);
                    const unsigned ord = (u & 0x80000000u) ? ~u : (u | 0x80000000u); const unsigned pk = (ord & 0xFFFFE000u) | (unsigned)key;
                    sc[i] = __uint_as_float(pk);
                    if (key < nadm && pk > tp) pm |= 1u << i; }
                const unsigned n = (unsigned)__popc(pm);
                unsigned k = 0u; if (n) k = __hip_atomic_fetch_add(cnt + ql, n, __ATOMIC_RELAXED, __HIP_MEMORY_SCOPE_WORKGROUP);
                LAS unsigned* cq = cand + ql * DS_CAP;
#pragma unroll
                for (int i = 0; i < 16; ++i) if (pm & (1u << i)) { cq[k] = __float_as_uint(sc[i]); ++k; }
            }
            __syncthreads();
            PROBE_END(2, a.ws, wave);
            const u32x4 c0 = *(const LAS u32x4*)(cnt), c1 = *(const LAS u32x4*)(cnt + 4), c2 = *(const LAS u32x4*)(cnt + 8), c3 = *(const LAS u32x4*)(cnt + 12);
            unsigned cm = max(max(max(c0.x, c0.y), max(c0.z, c0.w)), max(max(c1.x, c1.y), max(c1.z, c1.w)));
            cm = max(cm, max(max(max(c2.x, c2.y), max(c2.z, c2.w)), max(max(c3.x, c3.y), max(c3.z, c3.w))));
            const unsigned trig = (step == nstep) ? (unsigned)DS_TOPK : (unsigned)DS_TRIG;
#ifdef DSA_SEL2
            const int nsel = (step == nstep) ? 4 : 2;
#else
            const int nsel = 2;
#endif
            if (cm > trig) {
                PROBE_BEGIN(1, a.ws, wave);
#pragma unroll 1
                for (int qq = 0; qq < nsel; ++qq) { const int q = 2 * wave + (qq & 1); if (cnt[q] > trig || qq >= 2) {
                    if (step != nstep) filter_compact<32>(cand + q * DS_CAP, cnt + q, taup + q, lane);
                    if (step == nstep || cnt[q] > (unsigned)DS_TRIG) select_compact<32>(cand + q * DS_CAP, cnt + q, taup + q, hist, lane); } }
                __syncthreads();
                PROBE_END(1, a.ws, wave);
            }
        }
#ifdef DSA_REP_STREAM
        }
#endif
        const bf16_t* KVb = KVg + (size_t)mb * 256;
        int lane_a = lane; asm volatile("" : "+v"(lane_a));
        const int g16 = lane_a >> 4, l15 = lane_a & 15;
        const unsigned vbase = (unsigned)(size_t)(lds + DS_CAND_OFF) + (unsigned)wave * 16384u;
        unsigned ta0, ta1;
        { const int q = l15 >> 2, p = lane_a & 3; const int pr0 = 8 * g16 + q, pr1 = pr0 + 4;
          ta0 = vbase + vrow_off(pr0) + 16u * ((unsigned)(p >> 1) ^ swz_b(pr0)) + 8u * (unsigned)(p & 1);
          ta1 = vbase + vrow_off(pr1) + 16u * ((unsigned)(p >> 1) ^ swz_b(pr1)) + 8u * (unsigned)(p & 1); }
        unsigned vwa[8];
#pragma unroll
        for (int j2 = 0; j2 < 8; ++j2) { const int srow = 4 * j2 + g16; const int pr = (srow < 16) ? 8 * (srow >> 2) + (srow & 3) : 8 * ((srow - 16) >> 2) + 4 + (srow & 3);
            vwa[j2] = vbase + vrow_off(pr) + 16u * ((unsigned)l15 ^ swz_b(pr)); }
#ifdef DSA_REP_ATT
        for (int arep_ = 0; arep_ < 2; ++arep_) { const bool dry2 = dry || (arep_ == 0 && a.ph_hi > 0);
#else
        { const bool dry2 = dry;
#endif
#pragma unroll 1
        for (int qq = 0; qq < 2; ++qq) {
            const int q = 2 * wave + qq; const unsigned m = mb + q0 + q; const int n = (int)cnt[q]; const LAS unsigned* cq = cand + q * DS_CAP;
            bf16x8 qb[4];
#pragma unroll
            for (int ks = 0; ks < 4; ++ks) qb[ks] = *(const bf16x8*)(Qg + (m * 2048u + l15 * 128 + 32 * ks + 8 * g16));
            f32x4 sacc[16];
            const int nl = n - l15; const LAS unsigned* cql = cq + l15;
            bf16x8 kf[2][16];
            auto kload = [&](int grp, bf16x8 (&dst)[16]) {
#pragma unroll
                for (int t = 0; t < 4; ++t) { const int jt = 4 * grp + t; const unsigned e = cql[16 * jt]; const unsigned key = (16 * jt < nl) ? (e & 0x1FFFu) : 0u;
                    const bf16_t* kr = KVb + (key * 256u + 8u * g16);
#pragma unroll
                    for (int ks = 0; ks < 4; ++ks) dst[4 * t + ks] = *(const bf16x8*)(kr + 32 * ks); } };
            kload(0, kf[0]);
#pragma unroll
            for (int grp = 0; grp < 4; ++grp) {
                if (grp < 3) kload(grp + 1, kf[(grp + 1) & 1]);
#pragma unroll
                for (int t = 0; t < 4; ++t) { f32x4 acc = (f32x4){0.f, 0.f, 0.f, 0.f};
#pragma unroll
                    for (int ks = 0; ks < 4; ++ks) acc = __builtin_amdgcn_mfma_f32_16x16x32_bf16(kf[grp & 1][4 * t + ks], qb[ks], acc, 0, 0, 0);
                    sacc[4 * grp + t] = acc; }
                __builtin_amdgcn_sched_barrier(0);
            }
            u32x4 vr[2][8]; const int ng = n - g16; const LAS unsigned* cqg = cq + g16;
            auto vload = [&](int kk, u32x4 (&dst)[8]) {
#pragma unroll
                for (int j2 = 0; j2 < 8; ++j2) { const int sl = 32 * kk + 4 * j2; const unsigned e = cqg[sl]; const unsigned key = (sl < ng) ? (e & 0x1FFFu) : 0u;
                    dst[j2] = *(const u32x4*)(KVb + (key * 256u + 128u + 8u * l15)); } };
            vload(0, vr[0]); vload(1, vr[1]);
            __builtin_amdgcn_sched_barrier(0);
            float mx = -1e30f; const float nnf = (float)(n - 4 * g16 - 1);
#pragma unroll
            for (int jt = 0; jt < 16; ++jt)
#pragma unroll
                for (int r = 0; r < 4; ++r) { sacc[jt][r] = fmaf(fminf(nnf - (float)(16 * jt + r), 0.f), 1e30f, sacc[jt][r]); mx = fmaxf(mx, sacc[jt][r]); }
            mx = fmaxf(mx, __shfl_xor(mx, 16)); mx = fmaxf(mx, __shfl_xor(mx, 32));
            float sum = 0.f;
#pragma unroll
            for (int jt = 0; jt < 16; ++jt)
#pragma unroll
                for (int r = 0; r < 4; ++r) { const float p = __builtin_amdgcn_exp2f(sacc[jt][r] - mx); sacc[jt][r] = p; sum += p; }
            sum += __shfl_xor(sum, 16); sum += __shfl_xor(sum, 32);
            u32x4 pfr[8];
#pragma unroll
            for (int kk = 0; kk < 8; ++kk) { const f32x4 pa = sacc[2 * kk], pb2 = sacc[2 * kk + 1];
                pfr[kk].x = pk2(pa[0], pa[1]); pfr[kk].y = pk2(pa[2], pa[3]); pfr[kk].z = pk2(pb2[0], pb2[1]); pfr[kk].w = pk2(pb2[2], pb2[3]); }
            __builtin_amdgcn_sched_barrier(0);
            f32x4 o[8];
#pragma unroll
            for (int c = 0; c < 8; ++c) o[c] = (f32x4){0.f, 0.f, 0.f, 0.f};
#pragma unroll
            for (int kk = 0; kk < 8; ++kk) {
#pragma unroll
                for (int j2 = 0; j2 < 8; ++j2) *(LAS u32x4*)(size_t)vwa[j2] = vr[kk & 1][j2];
                __builtin_amdgcn_sched_barrier(0);
                if (kk + 2 < 8) vload(kk + 2, vr[kk & 1]);
                LDS_WAIT();
                const bf16x8 pfrag = __builtin_bit_cast(bf16x8, pfr[kk]);
#pragma unroll
                for (int ch = 0; ch < 2; ++ch) {
                    s16x4 t0[4], t1[4];
                    asm volatile("ds_read_b64_tr_b16 %0, %8\n\tds_read_b64_tr_b16 %1, %9\n\tds_read_b64_tr_b16 %2, %10\n\tds_read_b64_tr_b16 %3, %11\n\t"
                                 "ds_read_b64_tr_b16 %4, %12\n\tds_read_b64_tr_b16 %5, %13\n\tds_read_b64_tr_b16 %6, %14\n\tds_read_b64_tr_b16 %7, %15\n\ts_waitcnt lgkmcnt(0)"
                                 : "=&v"(t0[0]), "=&v"(t0[1]), "=&v"(t0[2]), "=&v"(t0[3]), "=&v"(t1[0]), "=&v"(t1[1]), "=&v"(t1[2]), "=&v"(t1[3])
                                 : "v"(ta0 ^ (unsigned)((4 * ch + 0) << 5)), "v"(ta0 ^ (unsigned)((4 * ch + 1) << 5)), "v"(ta0 ^ (unsigned)((4 * ch + 2) << 5)), "v"(ta0 ^ (unsigned)((4 * ch + 3) << 5)),
                                   "v"(ta1 ^ (unsigned)((4 * ch + 0) << 5)), "v"(ta1 ^ (unsigned)((4 * ch + 1) << 5)), "v"(ta1 ^ (unsigned)((4 * ch + 2) << 5)), "v"(ta1 ^ (unsigned)((4 * ch + 3) << 5)) : "memory");
                    __builtin_amdgcn_sched_barrier(0);
#pragma unroll
                    for (int c = 0; c < 4; ++c) { const bf16x8 av = __builtin_shufflevector(t0[c], t1[c], 0, 1, 2, 3, 4, 5, 6, 7);
                        o[4 * ch + c] = __builtin_amdgcn_mfma_f32_16x16x32_bf16(av, pfrag, o[4 * ch + c], 0, 0, 0); }
                }
            }
            const float inv = 1.0f / sum;
#pragma unroll
            for (int c = 0; c < 8; ++c) { bf16_t* gp = Gg + (m * 2048u + l15 * 128 + 16 * c + 4 * g16); const u32x2 gw = *(const u32x2*)gp;
                const f32x4 r = o[c] * inv * (f32x4){bflo(gw.x), bfhi(gw.x), bflo(gw.y), bfhi(gw.y)};
                u32x2 wv; wv.x = pk2(r[0], r[1]); wv.y = pk2(r[2], r[3]); if (!dry2) *(u32x2*)gp = wv; }
        }
        }
    }
}

#ifndef OLD_SCAN
#define OLD_SCAN 0
#endif
#ifndef MK_SPLIT
#define MK_SPLIT 0
#endif
#ifndef MK_PH_END
#define MK_PH_END 13
#endif
constexpr int N_PHASES = 13;

#define XB_TMO      128
#define XB_XCNT(j)  (256  + 64 * (j))
#define XB_XSUB(j)  (1280 + 64 * (j))
#define XB_XGEN(j)  (2304 + 64 * (j))
#define XB_TOP      3328
#define XB_TOPGEN   3392
#define XCD_BAR_WORDS 3456
#define XB_SPIN_CAP (1u << 18)

__device__ __forceinline__ unsigned xb_ld(unsigned* p)              { return __hip_atomic_load(p, __ATOMIC_RELAXED, __HIP_MEMORY_SCOPE_AGENT); }
__device__ __forceinline__ unsigned xb_add(unsigned* p, unsigned v) { return __hip_atomic_fetch_add(p, v, __ATOMIC_RELAXED, __HIP_MEMORY_SCOPE_AGENT); }
__device__ __forceinline__ unsigned xb_xcc_id() { return (unsigned)__builtin_amdgcn_s_getreg((3 << 11) | 20) & 0xFu; }
#define XB_SPIN(cond, bar) do { unsigned _sp = 0; while (cond) { __builtin_amdgcn_s_sleep(1); \
    if ((++_sp & 255u) == 0u) { if (xb_ld(&(bar)[XB_TMO])) break; if (_sp > XB_SPIN_CAP) { atomicAdd(&(bar)[XB_TMO], 1u); break; } } } } while (0)

struct XcdBarrier {
    unsigned* bar; unsigned x;
    volatile LAS unsigned* st;
};

__device__ __forceinline__ XcdBarrier xcd_barrier_post(unsigned* bar, volatile LAS unsigned* st, const int wave) {
    XcdBarrier b; b.bar = bar; b.x = xb_xcc_id(); b.st = st;
    if (lane_id() == 0 && wave == 0) (void)xb_add(&bar[XB_XCNT(b.x)], 1u);
    return b;
}
__device__ __forceinline__ void xcd_barrier_complete(unsigned* bar, unsigned x, unsigned& nloc, unsigned& nx) {
    const unsigned G = gridDim.x * gridDim.y * gridDim.z;
    unsigned sum, cnt, mine, sp = 0u;
    for (;;) {
        sum = 0u; cnt = 0u; mine = 0u;
#pragma unroll
        for (unsigned j = 0; j < 16; ++j) { const unsigned c = xb_ld(&bar[XB_XCNT(j)]); sum += c; cnt += (c > 0u) ? 1u : 0u; mine = (j == x) ? c : mine; }
        if (sum == G) break;
        __builtin_amdgcn_s_sleep(1);
        if ((++sp & 255u) == 0u) { if (xb_ld(&bar[XB_TMO])) break; if (sp > XB_SPIN_CAP) { atomicAdd(&bar[XB_TMO], 1u); break; } }
    }
    nloc = mine > 0u ? mine : 1u; nx = cnt > 0u ? cnt : 1u;
}

__device__ __forceinline__ void xcd_barrier(const XcdBarrier& b, const int wave) {
    asm volatile("s_waitcnt vmcnt(0)" ::: "memory");
    __syncthreads();
    if (wave == 0) { if (lane_id() == 0) {
        unsigned* bar = b.bar;
        __builtin_amdgcn_s_waitcnt(0);
        unsigned nloc = b.st[0], nx = b.st[1];
        if (nloc == 0u) { xcd_barrier_complete(bar, b.x, nloc, nx); b.st[0] = nloc; b.st[1] = nx; }
        const unsigned old = xb_add(&bar[XB_XSUB(b.x)], 1u);
        const unsigned gen = old / nloc;
        if (old + 1u == (gen + 1u) * nloc) {
            __builtin_amdgcn_fence(__ATOMIC_RELEASE, "agent");
            asm volatile("s_waitcnt vmcnt(0)" ::: "memory");
            const unsigned og = xb_add(&bar[XB_TOP], 1u);
            const unsigned tg = og / nx;
            if (og + 1u == (tg + 1u) * nx) xb_add(&bar[XB_TOPGEN], 1u);
            else XB_SPIN(xb_ld(&bar[XB_TOPGEN]) == tg, bar);
            __builtin_amdgcn_fence(__ATOMIC_ACQUIRE, "agent");
            xb_add(&bar[XB_XGEN(b.x)], 1u);
            asm volatile("s_waitcnt vmcnt(0)" ::: "memory");
        } else {
            XB_SPIN(xb_ld(&bar[XB_XGEN(b.x)]) == gen, bar);
            __builtin_amdgcn_fence(__ATOMIC_ACQUIRE, "agent");
            asm volatile("s_waitcnt vmcnt(0)" ::: "memory");
        }
    } }
    __syncthreads();
}

#define grid_bar(barptr, epoch, wv) xcd_barrier(xbar, (wv))
typedef const __attribute__((address_space(4))) Args* KArgs;
#if defined(__HIP_DEVICE_COMPILE__)
__device__ __forceinline__ Args kargs() { KArgs p = (KArgs)__builtin_amdgcn_kernarg_segment_ptr(); asm volatile("" : "+s"(p)); return *p; }
#else
__device__ __forceinline__ Args kargs() { return Args{}; }
#endif
#define PHASE_ARGS const Args a = kargs(); unsigned char* ws = a.ws; (void)ws

__global__ void __launch_bounds__(NTHREADS, 2) fwd_megakernel(Args a_by_value) {
    extern __shared__ __attribute__((aligned(16))) unsigned char lds_raw[];
    LAS unsigned char* lds = (LAS unsigned char*)lds_raw;
    cg::grid_group grid = cg::this_grid();
    const int wave = __builtin_amdgcn_readfirstlane((int)threadIdx.x >> 6);
    { volatile LAS unsigned* st0 = (volatile LAS unsigned*)(lds + LDS_BYTES - 16); if (wave == 0 && lane_id() < 4) st0[lane_id()] = 0u; __syncthreads(); }
    const XcdBarrier xbar = xcd_barrier_post((unsigned*)(kargs().ws + WS_BAR), (volatile LAS unsigned*)(lds + LDS_BYTES - 16), wave);
    int lo, hi; { const Args a0 = kargs(); lo = a0.ph_lo; hi = a0.ph_hi; }
#ifdef ONLY_PH
#define IN(k) ((k) == ONLY_PH && lo <= (k) && (k) < hi)
#else
#define IN(k) (lo <= (k) && (k) < hi)
#endif
#define SEAM(k) do { if (IN(k) && IN((k) + 1)) { if ((k) == 0) grid.sync(); else grid_bar((unsigned*)(kargs().ws + WS_BAR), (unsigned)(k), wave); } } while (0)
#ifdef REP_PH
#define NREP(k) ((k) == REP_PH ? 2 : 1)
#else
#define NREP(k) 1
#endif
#define REPEAT(k) for (int rep_ = 0; rep_ < NREP(k); ++rep_, (rep_ < NREP(k) ? grid_bar((unsigned*)(kargs().ws + WS_BAR) + 128, 1u, wave) : (void)0))
#ifdef STAMP_K
#define TSTAMP(k) do { if (((k) == STAMP_K || (k) == STAMP_K + 1) && blockIdx.x == 0 && wave == 0) { const unsigned long long t_ = __builtin_amdgcn_s_memrealtime(); \
        if (__builtin_amdgcn_mbcnt_lo(~0u, 0u) == 0u) ((unsigned long long*)(kargs().ws + WS_STAMP))[(k) - STAMP_K] = t_; } } while (0)
#else
#define TSTAMP(k) do { } while (0)
#endif
#ifdef STAMP_K
    if (blockIdx.x == PROBE_BLK && wave == 0) { unsigned long long* st_ = (unsigned long long*)(kargs().ws + WS_STAMP); if (__builtin_amdgcn_mbcnt_lo(~0u, 0u) < 3u) st_[__builtin_amdgcn_mbcnt_lo(~0u, 0u)] = 0ull; }
#endif
    TSTAMP(0);
    if (IN(0)) REPEAT(0) { PHASE_ARGS; p0_prologue(a, wave, lds); } SEAM(0); TSTAMP(1);
    if (IN(1)) REPEAT(1) { PHASE_ARGS; norm_phase(a, wave, lds, a.x, 0); } SEAM(1); TSTAMP(2);
    if (IN(2)) REPEAT(2) { PHASE_ARGS;
        pg8::Gemm g{(const bf16_t*)(ws + WS_H), (const bf16_t*)(ws + WS_WIN0), MTOK, N0, DM}; pg8::StaticOrder S; S.init(MTOK, N0, gridDim.x, blockIdx.x);
        #ifdef EPI0_CHEAP_FIRST
        Epi0 E{ws, (unsigned char*)a.out, NREP(2) == 2 && rep_ == 0 && a.ph_hi > 0};
#else
        Epi0 E{ws, (unsigned char*)a.out, false};
#endif
#ifdef SKEW0
        if (blockIdx.x >= 128) { const unsigned long long t0_ = __builtin_amdgcn_s_memrealtime(); while (__builtin_amdgcn_s_memrealtime() - t0_ < (unsigned long long)(SKEW0)) __builtin_amdgcn_s_sleep(64); }
#endif
        pg8::gemm_phase<Epi0, pg8::StaticOrder, true, true>(lds, g, S, E, wave);
    } SEAM(2); TSTAMP(3);
    if (IN(3)) REPEAT(3) { PHASE_ARGS; conv_phase(a, wave, lds, blockIdx.x, gridDim.x); lora_pre_phase(a, wave); } SEAM(3); TSTAMP(4);
    if (IN(4)) REPEAT(4) { PHASE_ARGS;
        pg8::Gemm g{(const bf16_t*)((unsigned char*)a.out + DO_LA), (const bf16_t*)(ws + WS_WLORA), MTOK, 2048, 256}; pg8::StaticOrder S; S.init(MTOK, 2048, gridDim.x, blockIdx.x);
        EpiLora E{(bf16_t*)(ws + WS_DARR), (bf16_t*)(ws + WS_AARR), a.rwkv_vec};
        pg8::gemm_phase<EpiLora, pg8::StaticOrder, true, true>(lds, g, S, E, wave);
    } SEAM(4); TSTAMP(5);
    if (IN(5)) REPEAT(5) { PHASE_ARGS;
#if OLD_SCAN
        scan_phase(a, wave, lds);
#else
        unsigned* pbar = (unsigned*)(ws + WS_BAR) + 256;
        { __syncthreads(); if (wave == 0 && lane_id() < 8) ((LAS unsigned*)(lds + CS_FLAGS))[lane_id()] = 0u; __syncthreads(); }
        for (int r = 0; r <= CR_NP; ++r) {
            if (blockIdx.x >= 64) { if (r < CR_NP) cscan_produce(a, wave, lds, r, 64, gridDim.x - 64); }
            else if (r >= 1) {
                const int piece = r - 1;
                f32x4 xc[4]; f32x4* sv = (f32x4*)(ws + WS_XSAVE) + ((size_t)(blockIdx.x * 4 + (wave & 3)) * 64 + lane_id()) * 4;
#pragma unroll
                for (int kt = 0; kt < 4; ++kt) xc[kt] = (piece == 0 || wave >= 4) ? (f32x4){0.f, 0.f, 0.f, 0.f} : sv[kt];
                cscan_consume(a, wave, lds, blockIdx.x, piece, xc);
                if (wave < 4) {
#pragma unroll
                    for (int kt = 0; kt < 4; ++kt) sv[kt] = xc[kt]; }
            }
            grid_bar(pbar, (unsigned)(r + 1), wave);
#ifdef BAR2
            grid_bar(pbar + 128, (unsigned)(r + 1), wave);
#endif
        }
#endif
    } SEAM(5); TSTAMP(6);
    if (IN(6)) REPEAT(6) { PHASE_ARGS; post_phase(a, wave); } SEAM(6); TSTAMP(7);
    if (IN(7)) REPEAT(7) { PHASE_ARGS;
        pg8::Gemm g{(const bf16_t*)(ws + WS_YAB), (const bf16_t*)(ws + WS_WOUT0), MTOK, DM, 2048}; pg8::StaticOrder S; S.init(MTOK, DM, gridDim.x, blockIdx.x);
        EpiRes E{a.x, a.out, (const float*)(ws + WS_MODP), a.ada_b, 0};
        pg8::gemm_phase<EpiRes, pg8::StaticOrder, true, true>(lds, g, S, E, wave);
    } SEAM(7); TSTAMP(8);
    if (IN(8)) REPEAT(8) { PHASE_ARGS; norm_phase(a, wave, lds, a.out, 1); } SEAM(8); TSTAMP(9);
    if (IN(9)) REPEAT(9) { PHASE_ARGS;
        pg8::Gemm g{(const bf16_t*)(ws + WS_H), (const bf16_t*)(ws + WS_WIN1), MTOK, N1, DM}; pg8::StaticOrder S; S.init(MTOK, N1, gridDim.x, blockIdx.x);
        Epi1 E{(bf16_t*)(ws + WS_Q), (bf16_t*)(ws + WS_KV), (bf16_t*)(ws + WS_QI), (bf16_t*)(ws + WS_KI), (bf16_t*)(ws + WS_G), (float*)(ws + WS_WI), (const f32x2*)(ws + WS_CSA), (const f32x2*)(ws + WS_CSI)};
        pg8::gemm_phase<Epi1, pg8::StaticOrder, true, true>(lds, g, S, E, wave);
    } SEAM(9); TSTAMP(10);
    if (IN(10)) REPEAT(10) { PHASE_ARGS; dsa_phase(a, wave, lds, NREP(10) == 2 && rep_ == 0 && a.ph_hi > 0); } SEAM(10); TSTAMP(11);
    if (IN(11)) REPEAT(11) { PHASE_ARGS;
        pg8::Gemm g{(const bf16_t*)(ws + WS_G), (const bf16_t*)(ws + WS_WOUT1), MTOK, DM, 2048}; pg8::StaticOrder S; S.init(MTOK, DM, gridDim.x, blockIdx.x);
        EpiRes E{a.out, a.out, (const float*)(ws + WS_MODP), a.ada_b, 1};
        pg8::gemm_phase<EpiRes, pg8::StaticOrder, true, true>(lds, g, S, E, wave);
    } SEAM(11); TSTAMP(12);
    if (IN(12)) REPEAT(12) { PHASE_ARGS; final_phase(a, wave); }
#undef IN
#undef SEAM
}

extern "C" void kernel_launch(void* const* d_in, const int* in_sizes, int n_in, void* d_out, int out_size, void* d_ws, size_t ws_size, hipStream_t stream) {
    static int grid = 0;
    if (grid == 0) {
        if (n_in != 19 || out_size != MTOK * DM || ws_size < WS_NEED) { fprintf(stderr, "kernel_launch: unexpected shapes (n_in %d, out %d, ws %zu)\n", n_in, out_size, ws_size); grid = -1; return; }
        int dev = 0, cus = 0, per_cu = 0;
        (void)hipGetDevice(&dev); (void)hipDeviceGetAttribute(&cus, hipDeviceAttributeMultiprocessorCount, dev);
        if (hipFuncSetAttribute((const void*)fwd_megakernel, hipFuncAttributeMaxDynamicSharedMemorySize, LDS_BYTES) != hipSuccess) { fprintf(stderr, "kernel_launch: hipFuncSetAttribute failed\n"); grid = -1; return; }
        if (hipOccupancyMaxActiveBlocksPerMultiprocessor(&per_cu, (const void*)fwd_megakernel, NTHREADS, LDS_BYTES) != hipSuccess || per_cu < 1) { fprintf(stderr, "kernel_launch: occupancy query says %d\n", per_cu); per_cu = 1; }
        (void)hipGetLastError();
        grid = cus;
        if (grid > 256) grid = 256;
    }
    if (grid < 0) return;
    Args a{};
    a.x = (const float*)d_in[0]; a.c = (const float*)d_in[1]; a.pos = (const int*)d_in[2]; a.ada_w = (const float*)d_in[3]; a.ada_b = (const float*)d_in[4];
    a.norm_g = (const float*)d_in[5]; a.final_g = (const float*)d_in[6]; a.even_w_in = (const float*)d_in[7]; a.even_w_out = (const float*)d_in[8];
    a.conv_w = (const float*)d_in[9]; a.conv_vec = (const float*)d_in[10]; a.mu_rkv = (const float*)d_in[11]; a.mu_lora = (const float*)d_in[12];
    a.rwkv_vec = (const float*)d_in[13]; a.w_up = (const float*)d_in[14]; a.a_up = (const float*)d_in[15]; a.r_k = (const float*)d_in[16];
    a.odd_w_in = (const float*)d_in[17]; a.odd_w_out = (const float*)d_in[18];
    a.out = (float*)d_out; a.ws = (unsigned char*)d_ws;
    (void)hipMemsetAsync((char*)d_ws + WS_BAR, 0, 65536, stream);
#if MK_SPLIT
    for (int p = 0; p < MK_PH_END; ++p) { a.ph_lo = p; a.ph_hi = p + 1; void* args[] = {&a};
        hipError_t e = hipLaunchCooperativeKernel((const void*)fwd_megakernel, dim3(grid), dim3(NTHREADS), args, LDS_BYTES, stream);
        if (e != hipSuccess) { fprintf(stderr, "launch %d failed: %s\n", p, hipGetErrorString(e)); break; } }
#else
    a.ph_lo = 0; a.ph_hi = MK_PH_END; void* args[] = {&a};
    hipError_t e = hipLaunchCooperativeKernel((const void*)fwd_megakernel, dim3(grid), dim3(NTHREADS), args, LDS_BYTES, stream);
    if (e != hipSuccess) fprintf(stderr, "cooperative launch failed: %s (grid %d)\n", hipGetErrorString(e), grid);
#endif
}
```

```cpp
#include <hip/hip_runtime.h>
#include <hip/hip_cooperative_groups.h>
#include <cstdio>
#include <cstdint>
namespace cg = cooperative_groups;

#define LAS __attribute__((address_space(3)))
typedef unsigned short bf16_t;
typedef float f32x4 __attribute__((ext_vector_type(4)));
typedef float f32x2 __attribute__((ext_vector_type(2)));
typedef float f32x16 __attribute__((ext_vector_type(16)));
typedef unsigned u32x4 __attribute__((ext_vector_type(4)));
typedef unsigned u32x2 __attribute__((ext_vector_type(2)));
typedef short bf16x8 __attribute__((ext_vector_type(8)));
typedef short s16x4 __attribute__((ext_vector_type(4)));

constexpr int BATCH = 4, SEQ = 8192, DM = 1024, MTOK = BATCH * SEQ;
constexpr int N0 = 7424, N1 = 5120;
constexpr int EVEN_COLS = 7296, ODD_COLS = 4936;
constexpr int NWAVES = 8, NTHREADS = 512;
constexpr int LDS_BYTES = 155648;

constexpr size_t MiB = 1u << 20;
constexpr size_t WS_MODP = 0; constexpr size_t WS_STAMP = 3 * MiB; constexpr size_t WS_XSAVE = 1 * MiB;
constexpr size_t WS_BAR = 3 * MiB + 512 * 1024;
constexpr size_t WS_WIN0 = 4 * MiB, WS_WOUT0 = 20 * MiB, WS_WIN1 = 24 * MiB, WS_WOUT1 = 34 * MiB, WS_WLORA = 38 * MiB;
constexpr size_t WS_CSA = 40 * MiB, WS_CSI = 56 * MiB;
constexpr size_t WS_H = 64 * MiB;
constexpr size_t WS_YAB = 64 * MiB;
constexpr size_t WS_U = 192 * MiB, WS_AG = 256 * MiB, WS_R = 320 * MiB, WS_K = 384 * MiB, WS_V = 448 * MiB;
constexpr size_t WS_AARR = WS_U, WS_DARR = WS_AG;
constexpr size_t WS_Q = 128 * MiB, WS_G = 256 * MiB, WS_KV = 384 * MiB, WS_QI = 400 * MiB, WS_KI = 432 * MiB, WS_WI = 436 * MiB;
constexpr size_t WS_NEED = 512 * MiB;
constexpr size_t DO_BG = 0, DO_WDAD = 64 * MiB, DO_LA = 72 * MiB, DO_RK = 64 * MiB;

__device__ __forceinline__ float bflo(unsigned w) { return __uint_as_float(w << 16); }
__device__ __forceinline__ float bfhi(unsigned w) { return __uint_as_float(w & 0xffff0000u); }
typedef __bf16 bf16x2_t __attribute__((ext_vector_type(2)));
__device__ __forceinline__ unsigned pk2(float lo, float hi) { const f32x2 v = {lo, hi}; const bf16x2_t b = __builtin_convertvector(v, bf16x2_t); return __builtin_bit_cast(unsigned, b); }
__device__ __forceinline__ float sigmoidf_(float x) { return __builtin_amdgcn_rcpf(1.0f + __expf(-x)); }
__device__ __forceinline__ float wave_sum(float v) {
#pragma unroll
    for (int o = 1; o < 64; o <<= 1) v += __shfl_xor(v, o);
    return v;
}
template <int CTRL> __device__ __forceinline__ float dppmov(float x) { return __int_as_float(__builtin_amdgcn_update_dpp(0, __float_as_int(x), CTRL, 0xf, 0xf, true)); }
__device__ __forceinline__ float quad_sum(float x) { x += dppmov<0xB1>(x); x += dppmov<0x4E>(x); return x; }
__device__ __forceinline__ float row16_sum(float x) { x += dppmov<0xB1>(x); x += dppmov<0x4E>(x); x += dppmov<0x141>(x); x += dppmov<0x140>(x); return x; }
__device__ __forceinline__ int lane_id() { int l; asm volatile("v_mbcnt_lo_u32_b32 %0, -1, 0\n\tv_mbcnt_hi_u32_b32 %0, -1, %0" : "=v"(l)); return l; }
#define LDS_WAIT() asm volatile("s_waitcnt lgkmcnt(0)" ::: "memory")

__device__ __forceinline__ int map0(int n) {
    const int t = n >> 8, r = n & 255;
    if (t < 8) return (r < 128) ? 128 * t + r : 1024 + 128 * t + (r - 128);
    if (t < 12) return 2048 + 256 * (t - 8) + r;
    if (t < 24) return 3072 + 256 * (t - 12) + r;
    if (t < 28) return 6272 + 256 * (t - 24) + r;
    return (r < 128) ? 6144 + r : -1;
}
__device__ __forceinline__ int map1(int n) {
    const int t = n >> 8, r = n & 255, half = r >> 7, rr = r & 127;
    if (t < 8) return (2 * t + (rr >> 6)) * 128 + half * 64 + (rr & 63);
    if (t == 8) return 2048 + (rr >> 6) * 128 + half * 64 + (rr & 63);
    if (t < 11) return 2304 + (4 * (t - 9) + (rr >> 5)) * 64 + half * 32 + (rr & 31);
    if (t == 11) { if (rr < 32) return 2816 + half * 32 + rr; if (half == 0 && rr < 40) return 2880 + (rr - 32); return -1; }
    return 2888 + 256 * (t - 12) + r;
}

#ifndef PROBE_BLK
#define PROBE_BLK 0
#endif
#ifndef PROBE_WAVE
#define PROBE_WAVE 0
#endif
#if defined(STAMP_K) && defined(PROBE_SEC)
#define PROBE_BEGIN(sec, wsp, wv) unsigned long long PT0_##sec = 0; if ((sec) == PROBE_SEC && blockIdx.x == PROBE_BLK && (wv) == PROBE_WAVE) PT0_##sec = __builtin_amdgcn_s_memrealtime()
#define PROBE_END(sec, wsp, wv) do { if ((sec) == PROBE_SEC && blockIdx.x == PROBE_BLK && (wv) == PROBE_WAVE) { const unsigned long long dt_ = __builtin_amdgcn_s_memrealtime() - PT0_##sec; \
        if (__builtin_amdgcn_mbcnt_lo(~0u, 0u) == 0u) __hip_atomic_fetch_add((unsigned long long*)((wsp) + WS_STAMP) + 2, dt_, __ATOMIC_RELAXED, __HIP_MEMORY_SCOPE_AGENT); } } while (0)
#else
#define PROBE_BEGIN(sec, wsp, wv) do { } while (0)
#define PROBE_END(sec, wsp, wv) do { } while (0)
#endif
namespace pg8 {
#define PG8_LAS __attribute__((address_space(3)))
typedef unsigned short bf16_t;
typedef short bf16x8 __attribute__((ext_vector_type(8)));
typedef float f32x4 __attribute__((ext_vector_type(4)));
typedef unsigned u32x4 __attribute__((ext_vector_type(4)));
constexpr int BM = 256, BK = 64, HALF = 128, HTB = HALF * BK * 2  , STAGE_BYTES = 8 * HTB, NXCD = 8, WGM = 8;

__host__ __device__ __forceinline__ int lds_byte(int r, int c) { const int st = (r >> 4) * 2 + (c >> 5), rr = r & 15, cc = c & 31, ob = rr * 64 + cc * 2; return st * 1024 + (ob ^ (((ob >> 9) & 1) << 5)); }
__host__ __device__ __forceinline__ void stage_rc(int b, int& R, int& C) { const int st = b / 1024, sb = b % 1024, swz = sb ^ (((sb >> 9) & 1) << 5); R = (st >> 1) * 16 + swz / 64; C = (st & 1) * 32 + (swz % 64) / 2; }
__host__ __device__ __forceinline__ int perm32(int rho) { const int n = rho >> 4, i = rho & 15; return 8 * (i >> 2) + 4 * n + (i & 3); }

struct Unit { int pm, pn; };
struct Gemm { const bf16_t* A; const bf16_t* Bt; int M, N, K; };

struct StaticOrder {
    int nM, nN, nwg, G, c;
    __host__ __device__ void init(int M, int N, int G_, int c_) { nM = M / BM; nN = N / BM; nwg = nM * nN; G = G_; c = c_; }
    __host__ __device__ bool next(int i, Unit& u) const {
        const long L = (long)i * G + c; if (L >= nwg) return false;
        int wgid = (int)L; { const int q = nwg / NXCD, r = nwg % NXCD, xcd = wgid % NXCD, off = wgid / NXCD; wgid = (xcd < r ? xcd * (q + 1) : r * (q + 1) + (xcd - r) * q) + off; }
        const int nig = WGM * nN, gid = wgid / nig, fm = gid * WGM, gsz = (nM - fm) < WGM ? (nM - fm) : WGM;
        u.pm = fm + ((wgid % nig) % gsz); u.pn = (wgid % nig) / gsz; return true;
    }
    __device__ __forceinline__ void a_ready(const Unit&) const {}
    __device__ __forceinline__ void done(const Unit&) const {}
};

__device__ __forceinline__ unsigned cvt_pk_bf16(float lo, float hi) { unsigned r; asm volatile("v_cvt_pk_bf16_f32 %0, %1, %2" : "=v"(r) : "v"(lo), "v"(hi)); return r; }
typedef float f32x2 __attribute__((ext_vector_type(2)));
template <class Epi, class Sched, bool ALIGN_EPI = false, bool SP2 = false>
__device__ __forceinline__ void gemm_phase(PG8_LAS unsigned char* lds, const Gemm g, const Sched& S, const Epi& E, const int wave_in) {
    int lane; asm volatile("v_mbcnt_lo_u32_b32 %0, -1, 0\n\tv_mbcnt_hi_u32_b32 %0, -1, %0" : "=v"(lane));
    const int wid = wave_in, tid = wid * 64 + lane, wr = wid >> 2, wc = wid & 3, fr = lane & 15, fq = lane >> 4;
    const int K = g.K, nt = K / BK;
    unsigned voffA[2], voffB[2];
#pragma unroll
    for (int i = 0; i < 2; ++i) { int R, C; stage_rc(tid * 16 + i * 8192, R, C); const int Rb = Epi::PERM ? ((R & ~31) + perm32(R & 31)) : R;
        voffA[i] = (unsigned)(R * K + C) * 2u; voffB[i] = (unsigned)(Rb * K + C) * 2u; }
    const size_t kstep = (size_t)(BK * 2);
    const size_t hstep = (size_t)HALF * K * 2;
    const size_t tstep = 2 * hstep;
    const unsigned ldsw = (unsigned)wid * 1024u;
    const int aoff = lds_byte(wr * 64 + fr, fq * 8), boff = lds_byte(wc * 32 + fr, fq * 8);
#define PG8_SA(b, h) (((b) * 2 + (h)) * HTB)
#define PG8_SB(b, h) ((4 + (b) * 2 + (h)) * HTB)
#define PG8_STAGE(bufoff, gbase, voff) do { _Pragma("unroll") for (int _i = 0; _i < 2; ++_i) \
        __builtin_amdgcn_global_load_lds((const unsigned*)((const char*)(gbase) + (voff)[_i]), (PG8_LAS unsigned*)(lds + (bufoff) + ldsw + _i * 8192), 16, 0, 0); } while (0)
#define PG8_LDA(dst, b, h) do { _Pragma("unroll") for (int m = 0; m < 4; ++m) _Pragma("unroll") for (int k = 0; k < 2; ++k) dst[m][k] = *(const PG8_LAS bf16x8*)(lds + PG8_SA(b, h) + aoff + m * 2048 + k * 1024); } while (0)
#define PG8_LDB(dst, b, h) do { _Pragma("unroll") for (int n = 0; n < 2; ++n) _Pragma("unroll") for (int k = 0; k < 2; ++k) dst[n][k] = *(const PG8_LAS bf16x8*)(lds + PG8_SB(b, h) + boff + n * 2048 + k * 1024); } while (0)
#define PG8_MMA(ai, bj, At, Bt) do { __builtin_amdgcn_s_setprio(1); _Pragma("unroll") for (int m = 0; m < 4; ++m) _Pragma("unroll") for (int n = 0; n < 2; ++n) _Pragma("unroll") for (int k = 0; k < 2; ++k) \
        acc[ai][bj][m][n] = __builtin_amdgcn_mfma_f32_16x16x32_bf16(Bt[n][k], At[m][k], acc[ai][bj][m][n], 0, 0, 0); __builtin_amdgcn_s_setprio(0); } while (0)
#define PG8_WAIT_V(n) asm volatile("s_waitcnt vmcnt(" #n ")" ::: "memory")
#define PG8_WAIT_L(n) asm volatile("s_waitcnt lgkmcnt(" #n ")" ::: "memory")
#define PG8_BAR __builtin_amdgcn_s_barrier()
#define PG8_SCHED __builtin_amdgcn_sched_barrier(0)
    Unit cur, nxt; int ui = 0;
    if (!S.next(0, cur)) return;
    f32x4 acc[2][2][4][2];
#pragma unroll
    for (int a = 0; a < 2; ++a)
#pragma unroll
        for (int b = 0; b < 2; ++b)
#pragma unroll
            for (int m = 0; m < 4; ++m)
#pragma unroll
                for (int n = 0; n < 2; ++n) acc[a][b][m][n] = (f32x4){0.f, 0.f, 0.f, 0.f};
    bf16x8 At[4][2], B0[2][2], B1[2][2];
    const char* cA = (const char*)g.A + (size_t)cur.pm * tstep; const char* cB = (const char*)g.Bt + (size_t)cur.pn * tstep;
    S.a_ready(cur);
    if constexpr (SP2) {
        PG8_STAGE(PG8_SB(0, 0), cB, voffB); PG8_STAGE(PG8_SB(0, 1), cB + hstep, voffB); PG8_STAGE(PG8_SA(0, 0), cA, voffA); PG8_STAGE(PG8_SA(0, 1), cA + hstep, voffA);
        if (wr == 1) PG8_BAR;
        PG8_WAIT_V(2); PG8_BAR;
        PG8_STAGE(PG8_SB(1, 0), cB + kstep, voffB); PG8_STAGE(PG8_SA(1, 0), cA + kstep, voffA); PG8_STAGE(PG8_SB(1, 1), cB + hstep + kstep, voffB);
        PG8_WAIT_V(6); PG8_BAR;
    } else {
        PG8_STAGE(PG8_SB(0, 0), cB, voffB); PG8_STAGE(PG8_SA(0, 0), cA, voffA); PG8_STAGE(PG8_SB(0, 1), cB + hstep, voffB); PG8_STAGE(PG8_SA(0, 1), cA + hstep, voffA);
        if (wr == 1) PG8_BAR;
        PG8_WAIT_V(4); PG8_BAR;
        PG8_STAGE(PG8_SB(1, 0), cB + kstep, voffB); PG8_STAGE(PG8_SA(1, 0), cA + kstep, voffA); PG8_STAGE(PG8_SB(1, 1), cB + hstep + kstep, voffB);
        PG8_WAIT_V(6); PG8_BAR;
    }
    for (;;) {
        const bool has_next = S.next(ui + 1, nxt);
        const char* nA = has_next ? (const char*)g.A + (size_t)nxt.pm * tstep : cA; const char* nB = has_next ? (const char*)g.Bt + (size_t)nxt.pn * tstep : cB;
        for (int t = 0; t < nt; t += 2) {
            const bool last = (t == nt - 2);
            const char* a1 = cA + (size_t)(t + 1) * kstep;
            const char* a2 = last ? nA : cA + (size_t)(t + 2) * kstep; const char* b2 = last ? nB : cB + (size_t)(t + 2) * kstep;
            const char* a3 = a2 + kstep; const char* b3 = b2 + kstep;
            if (last && has_next) S.a_ready(nxt);
            if constexpr (SP2) {
            PG8_LDB(B0, 0, 0); PG8_LDB(B1, 0, 1); PG8_SCHED; PG8_LDA(At, 0, 0); PG8_STAGE(PG8_SA(1, 1), a1 + hstep, voffA);
            PG8_WAIT_V(8); PG8_WAIT_L(0); PG8_BAR; PG8_MMA(0, 0, At, B0); PG8_MMA(0, 1, At, B1); PG8_BAR; PG8_SCHED;
            PG8_LDA(At, 0, 1); PG8_STAGE(PG8_SB(0, 0), b2, voffB); PG8_STAGE(PG8_SB(0, 1), b2 + hstep, voffB); PG8_STAGE(PG8_SA(0, 0), a2, voffA);
            PG8_WAIT_V(8); PG8_WAIT_L(0); PG8_BAR; PG8_MMA(1, 0, At, B0); PG8_MMA(1, 1, At, B1); PG8_BAR; PG8_SCHED;
            PG8_LDB(B0, 1, 0); PG8_LDB(B1, 1, 1); PG8_SCHED; PG8_LDA(At, 1, 0); PG8_STAGE(PG8_SA(0, 1), a2 + hstep, voffA);
            PG8_WAIT_V(8); PG8_WAIT_L(0); PG8_BAR; PG8_MMA(0, 0, At, B0); PG8_MMA(0, 1, At, B1); PG8_BAR; PG8_SCHED;
            PG8_LDA(At, 1, 1); PG8_STAGE(PG8_SB(1, 0), b3, voffB); PG8_STAGE(PG8_SB(1, 1), b3 + hstep, voffB); PG8_STAGE(PG8_SA(1, 0), a3, voffA);
            PG8_WAIT_V(8); PG8_WAIT_L(0); PG8_BAR; PG8_MMA(1, 0, At, B0); PG8_MMA(1, 1, At, B1); PG8_BAR; PG8_SCHED;
            } else {
            PG8_LDB(B0, 0, 0); PG8_SCHED; PG8_LDA(At, 0, 0); PG8_STAGE(PG8_SA(1, 1), a1 + hstep, voffA);
            PG8_WAIT_L(8); PG8_BAR; PG8_WAIT_L(0); PG8_MMA(0, 0, At, B0); PG8_BAR; PG8_SCHED;
            PG8_LDB(B1, 0, 1); PG8_STAGE(PG8_SB(0, 0), b2, voffB);
            PG8_BAR; PG8_WAIT_L(0); PG8_MMA(0, 1, At, B1); PG8_BAR;
            PG8_LDA(At, 0, 1); PG8_STAGE(PG8_SA(0, 0), a2, voffA);
            PG8_BAR; PG8_WAIT_L(0); PG8_MMA(1, 0, At, B0); PG8_BAR; PG8_SCHED;
            PG8_STAGE(PG8_SB(0, 1), b2 + hstep, voffB);
            PG8_WAIT_V(6); PG8_BAR; PG8_MMA(1, 1, At, B1); PG8_BAR;
            PG8_LDB(B0, 1, 0); PG8_SCHED; PG8_LDA(At, 1, 0); PG8_STAGE(PG8_SA(0, 1), a2 + hstep, voffA);
            PG8_WAIT_L(8); PG8_BAR; PG8_WAIT_L(0); PG8_MMA(0, 0, At, B0); PG8_BAR; PG8_SCHED;
            PG8_LDB(B1, 1, 1); PG8_STAGE(PG8_SB(1, 0), b3, voffB);
            PG8_BAR; PG8_WAIT_L(0); PG8_MMA(0, 1, At, B1); PG8_BAR;
            PG8_LDA(At, 1, 1); PG8_STAGE(PG8_SA(1, 0), a3, voffA);
            PG8_BAR; PG8_WAIT_L(0); PG8_MMA(1, 0, At, B0); PG8_BAR; PG8_SCHED;
            PG8_STAGE(PG8_SB(1, 1), b3 + hstep, voffB);
            PG8_WAIT_V(6); PG8_BAR; PG8_MMA(1, 1, At, B1); PG8_BAR;
            }
        }
        if constexpr (ALIGN_EPI) { if (wr == 0) PG8_BAR; }
        if constexpr (!Epi::AFTER_DRAIN) { E(acc, cur, wr, wc, fr, fq); S.done(cur); }
        if (!has_next) break;
#pragma unroll
        for (int a = 0; a < 2; ++a)
#pragma unroll
            for (int b = 0; b < 2; ++b)
#pragma unroll
                for (int m = 0; m < 4; ++m)
#pragma unroll
                    for (int n = 0; n < 2; ++n) acc[a][b][m][n] = (f32x4){0.f, 0.f, 0.f, 0.f};
        cur = nxt; cA = nA; cB = nB; ++ui;
        if constexpr (ALIGN_EPI) { if (wr == 1) PG8_BAR; }
    }
    PG8_WAIT_V(0);
    if constexpr (!ALIGN_EPI) { if (wr == 0) PG8_BAR; }
    PG8_BAR;
    if constexpr (Epi::AFTER_DRAIN) { E.fused(acc, cur, wr, wc, fr, fq, lds, wid, lane); S.done(cur); }
#undef PG8_SA
#undef PG8_SB
#undef PG8_STAGE
#undef PG8_LDA
#undef PG8_LDB
#undef PG8_MMA
#undef PG8_WAIT_V
#undef PG8_WAIT_L
#undef PG8_BAR
#undef PG8_SCHED
}
}

__device__ __forceinline__ u32x4 pack8(const f32x4 a, const f32x4 b) { u32x4 w; w.x = pk2(a[0], a[1]); w.y = pk2(a[2], a[3]); w.z = pk2(b[0], b[1]); w.w = pk2(b[2], b[3]); return w; }
__device__ __forceinline__ f32x4 silu4(const f32x4 v) { f32x4 o; o[0] = v[0] * sigmoidf_(v[0]); o[1] = v[1] * sigmoidf_(v[1]); o[2] = v[2] * sigmoidf_(v[2]); o[3] = v[3] * sigmoidf_(v[3]); return o; }
__device__ __forceinline__ f32x4 sig4(const f32x4 v) { f32x4 o; o[0] = sigmoidf_(v[0]); o[1] = sigmoidf_(v[1]); o[2] = sigmoidf_(v[2]); o[3] = sigmoidf_(v[3]); return o; }

struct Epi0 {
    static constexpr bool PERM = true, AFTER_DRAIN = false;
    unsigned char* ws; unsigned char* dout; bool cheap;
    __device__ __forceinline__ void operator()(const f32x4 (&acc)[2][2][4][2], const pg8::Unit& u, int wr, int wc, int fr, int fq) const {
        const int row0 = u.pm * 256 + wr * 64 + fr, t = u.pn, cw = wc * 32 + 8 * fq;
        if (t < 8) {
            bf16_t* U = (bf16_t*)(ws + WS_U);
#pragma unroll
            for (int ai = 0; ai < 2; ++ai)
#pragma unroll
                for (int m = 0; m < 4; ++m) { const size_t row = (size_t)(row0 + ai * 128 + m * 16);
                    const f32x4 a = cheap ? acc[ai][0][m][0] : acc[ai][0][m][0] * sig4(acc[ai][1][m][0]), b = cheap ? acc[ai][0][m][1] : acc[ai][0][m][1] * sig4(acc[ai][1][m][1]);
                    *(u32x4*)(U + row * 1024 + 128 * t + cw) = pack8(a, b); }
        } else if (t == 28) {
            bf16_t* WDAD = (bf16_t*)(dout + DO_WDAD);
#pragma unroll
            for (int ai = 0; ai < 2; ++ai)
#pragma unroll
                for (int m = 0; m < 4; ++m) { const size_t row = (size_t)(row0 + ai * 128 + m * 16);
                    *(u32x4*)(WDAD + row * 128 + cw) = pack8(acc[ai][0][m][0], acc[ai][0][m][1]); }
        } else {
            const bool act = ((t < 12) || (t >= 24)) && !cheap; const int c0 = 256 * (t & 3);
            unsigned char* bp = (t >= 24) ? (dout + DO_BG) : (ws + WS_AG + (size_t)((t - 8) >> 2) * (64 * MiB));
            bf16_t* base = (bf16_t*)bp;
#pragma unroll
            for (int ai = 0; ai < 2; ++ai)
#pragma unroll
                for (int m = 0; m < 4; ++m) { const size_t row = (size_t)(row0 + ai * 128 + m * 16);
#pragma unroll
                    for (int bj = 0; bj < 2; ++bj) { f32x4 a = acc[ai][bj][m][0], b = acc[ai][bj][m][1];
                        if (act) { a = silu4(a); b = silu4(b); }
                        *(u32x4*)(base + row * 1024 + c0 + 128 * bj + cw) = pack8(a, b); } }
        }
    }
};
static_assert(WS_R == WS_AG + 64 * MiB && WS_K == WS_AG + 128 * MiB && WS_V == WS_AG + 192 * MiB, "Epi0 region arithmetic");

struct EpiLora {
    static constexpr bool PERM = true, AFTER_DRAIN = false;
    bf16_t *D, *A; const float* vec;
    __device__ __forceinline__ void operator()(const f32x4 (&acc)[2][2][4][2], const pg8::Unit& u, int wr, int wc, int fr, int fq) const {
        const int row0 = u.pm * 256 + wr * 64 + fr, t = u.pn, cw = wc * 32 + 8 * fq;
        const bool isd = t < 4; bf16_t* base = isd ? D : A; const int c0 = 256 * (t & 3); const float* bias = vec + (isd ? 0 : 1024) + c0 + cw;
        const float sc = isd ? 0.60653065971f : 1.0f;
#pragma unroll
        for (int ai = 0; ai < 2; ++ai)
#pragma unroll
            for (int m = 0; m < 4; ++m) { const size_t row = (size_t)(row0 + ai * 128 + m * 16);
#pragma unroll
                for (int bj = 0; bj < 2; ++bj) { const f32x4 b0 = *(const f32x4*)(bias + 128 * bj), b1 = *(const f32x4*)(bias + 128 * bj + 4);
                    const f32x4 a = sig4(acc[ai][bj][m][0] + b0) * sc, b = sig4(acc[ai][bj][m][1] + b1) * sc;
                    *(u32x4*)(base + row * 1024 + c0 + 128 * bj + cw) = pack8(a, b); } }
    }
};

struct EpiRes {
    static constexpr bool PERM = false, AFTER_DRAIN = false;
    const float* resid; float* out; const float* modp; const float* ada_b; int layer;
    __device__ __forceinline__ void operator()(const f32x4 (&acc)[2][2][4][2], const pg8::Unit& u, int wr, int wc, int fr, int fq) const {
        const int row0 = u.pm * 256 + wr * 64 + fr, col0 = u.pn * 256 + wc * 32 + 4 * fq, b = (u.pm * 256) / SEQ;
        f32x4 gv[2][2];
#pragma unroll
        for (int bj = 0; bj < 2; ++bj)
#pragma unroll
            for (int n = 0; n < 2; ++n) { const int c = col0 + bj * 128 + n * 16; f32x4 g = *(const f32x4*)(ada_b + layer * 3072 + 2048 + c);
#pragma unroll
                for (int s = 0; s < 8; ++s) g += *(const f32x4*)(modp + (size_t)((s * 2 + layer) * 4 + b) * 3072 + 2048 + c);
                gv[bj][n] = g; }
#pragma unroll
        for (int ai = 0; ai < 2; ++ai)
#pragma unroll
            for (int m = 0; m < 4; ++m) { const size_t off = (size_t)(row0 + ai * 128 + m * 16) * 1024 + col0;
#pragma unroll
                for (int bj = 0; bj < 2; ++bj)
#pragma unroll
                    for (int n = 0; n < 2; ++n) { const f32x4 r = *(const f32x4*)(resid + off + bj * 128 + n * 16);
                        *(f32x4*)(out + off + bj * 128 + n * 16) = r + gv[bj][n] * acc[ai][bj][m][n]; }
                if (m & 1) asm volatile("" ::: "memory"); }
    }
};

constexpr float Q_SCALE = 0.08838834764831845f * 1.4426950408889634f;
constexpr float WI_SCALE = 0.35355339059327373f * 0.125f;
struct Epi1 {
    static constexpr bool PERM = true, AFTER_DRAIN = false;
    bf16_t *Q, *KV, *QI, *KI, *G; float* WI; const f32x2* csa; const f32x2* csi;
    __device__ __forceinline__ void rope8(const f32x4 x1a, const f32x4 x1b, const f32x4 x2a, const f32x4 x2b, const f32x2* cs, float sc, u32x4& o1, u32x4& o2) const {
        float c[8], s[8];
#pragma unroll
        for (int j = 0; j < 4; ++j) { const f32x4 v = *(const f32x4*)(cs + 2 * j); c[2 * j] = v[0]; s[2 * j] = v[1]; c[2 * j + 1] = v[2]; s[2 * j + 1] = v[3]; }
        float a[8], b[8];
#pragma unroll
        for (int j = 0; j < 4; ++j) { a[j] = x1a[j]; a[4 + j] = x1b[j]; b[j] = x2a[j]; b[4 + j] = x2b[j]; }
        float p[8], q[8];
#pragma unroll
        for (int j = 0; j < 8; ++j) { p[j] = (a[j] * c[j] - b[j] * s[j]) * sc; q[j] = (b[j] * c[j] + a[j] * s[j]) * sc; }
        o1.x = pk2(p[0], p[1]); o1.y = pk2(p[2], p[3]); o1.z = pk2(p[4], p[5]); o1.w = pk2(p[6], p[7]);
        o2.x = pk2(q[0], q[1]); o2.y = pk2(q[2], q[3]); o2.z = pk2(q[4], q[5]); o2.w = pk2(q[6], q[7]);
    }
    __device__ __forceinline__ void operator()(const f32x4 (&acc)[2][2][4][2], const pg8::Unit& u, int wr, int wc, int fr, int fq) const {
        const int row0 = u.pm * 256 + wr * 64 + fr, t = u.pn, cw = wc * 32 + 8 * fq;
#pragma unroll
        for (int ai = 0; ai < 2; ++ai)
#pragma unroll
            for (int m = 0; m < 4; ++m) { const size_t row = (size_t)(row0 + ai * 128 + m * 16);
                const f32x4 x1a = acc[ai][0][m][0], x1b = acc[ai][0][m][1], x2a = acc[ai][1][m][0], x2b = acc[ai][1][m][1];
                if (t < 8) { const int head = 2 * t + (wc >> 1), i0 = (wc & 1) * 32 + 8 * fq; u32x4 o1, o2;
                    rope8(x1a, x1b, x2a, x2b, csa + row * 64 + i0, Q_SCALE, o1, o2);
                    *(u32x4*)(Q + row * 2048 + head * 128 + i0) = o1; *(u32x4*)(Q + row * 2048 + head * 128 + 64 + i0) = o2;
                } else if (t == 8) { const int i0 = (wc & 1) * 32 + 8 * fq;
                    if (wc < 2) { u32x4 o1, o2; rope8(x1a, x1b, x2a, x2b, csa + row * 64 + i0, 1.0f, o1, o2);
                        *(u32x4*)(KV + row * 256 + i0) = o1; *(u32x4*)(KV + row * 256 + 64 + i0) = o2; }
                    else { *(u32x4*)(KV + row * 256 + 128 + i0) = pack8(x1a, x1b); *(u32x4*)(KV + row * 256 + 192 + i0) = pack8(x2a, x2b); }
                } else if (t < 11) { const int head = 4 * (t - 9) + wc, i0 = 8 * fq; u32x4 o1, o2;
                    rope8(x1a, x1b, x2a, x2b, csi + row * 32 + i0, 1.0f, o1, o2);
                    *(u32x4*)(QI + row * 512 + head * 64 + i0) = o1; *(u32x4*)(QI + row * 512 + head * 64 + 32 + i0) = o2;
                } else if (t == 11) {
                    if (wc == 0) { const int i0 = 8 * fq; u32x4 o1, o2; rope8(x1a, x1b, x2a, x2b, csi + row * 32 + i0, 1.0f, o1, o2);
                        *(u32x4*)(KI + row * 64 + i0) = o1; *(u32x4*)(KI + row * 64 + 32 + i0) = o2; }
                    else if (wc == 1 && fq == 0) { *(f32x4*)(WI + row * 8) = x1a * WI_SCALE; *(f32x4*)(WI + row * 8 + 4) = x1b * WI_SCALE; }
                } else { const int c0 = 256 * (t - 12);
                    *(u32x4*)(G + row * 2048 + c0 + cw) = pack8(silu4(x1a), silu4(x1b)); *(u32x4*)(G + row * 2048 + c0 + 128 + cw) = pack8(silu4(x2a), silu4(x2b)); }
            }
    }
};

struct Args {
    const float* x; const float* c; const int* pos; const float* ada_w; const float* ada_b; const float* norm_g; const float* final_g;
    const float* even_w_in; const float* even_w_out; const float* conv_w; const float* conv_vec; const float* mu_rkv; const float* mu_lora;
    const float* rwkv_vec; const float* w_up; const float* a_up; const float* r_k; const float* odd_w_in; const float* odd_w_out;
    float* out; unsigned char* ws; int ph_lo, ph_hi;
};

template <class SrcF>
__device__ __forceinline__ void transpose_item(const SrcF& src, int K, bf16_t* WT, LAS float* scr, int item, int nblk, int lane) {
    const int kb = item / nblk, nb = item % nblk, k0 = 64 * kb, n0 = 32 * nb;
    float tv[32];
#pragma unroll
    for (int i = 0; i < 32; ++i) tv[i] = src(k0 + 2 * i + (lane >> 5), n0 + (lane & 31));
#pragma unroll
    for (int i = 0; i < 32; ++i) scr[(2 * i + (lane >> 5)) * 33 + (lane & 31)] = tv[i];
    LDS_WAIT();
    const int c = lane & 7;
#pragma unroll
    for (int j = 0; j < 4; ++j) { const int n = (lane >> 3) + 8 * j; const LAS float* s = scr + (8 * c) * 33 + n;
        u32x4 o; o.x = pk2(s[0 * 33], s[1 * 33]); o.y = pk2(s[2 * 33], s[3 * 33]); o.z = pk2(s[4 * 33], s[5 * 33]); o.w = pk2(s[6 * 33], s[7 * 33]);
        *(u32x4*)(WT + (size_t)(n0 + n) * K + k0 + 8 * c) = o; }
    LDS_WAIT();
}

__device__ __forceinline__ void transpose_item_col(const float* W, int ldw, int scol, int K, bf16_t* WT, LAS float* scr, int k0, int n0, int lane) {
    const float* wp = W + (size_t)(k0 + (lane >> 5)) * ldw + (scol < 0 ? 0 : scol);
#pragma unroll 8
    for (int i = 0; i < 32; ++i) { const float v = wp[(size_t)(2 * i) * ldw]; scr[(2 * i + (lane >> 5)) * 33 + (lane & 31)] = scol < 0 ? 0.f : v; }
    LDS_WAIT();
    const int c = lane & 7;
#pragma unroll
    for (int j = 0; j < 4; ++j) { const int n = (lane >> 3) + 8 * j; const LAS float* s = scr + (8 * c) * 33 + n;
        u32x4 o; o.x = pk2(s[0 * 33], s[1 * 33]); o.y = pk2(s[2 * 33], s[3 * 33]); o.z = pk2(s[4 * 33], s[5 * 33]); o.w = pk2(s[6 * 33], s[7 * 33]);
        *(u32x4*)(WT + (size_t)(n0 + n) * K + k0 + 8 * c) = o; }
    LDS_WAIT();
}
__device__ __forceinline__ void rope_item(const Args& a, int r, int lane) {
    const float p = (float)a.pos[r];
    { const float inv = powf(10000.0f, -(float)(2 * lane) / 128.0f); float sn, cs; sincosf(p * inv, &sn, &cs); ((f32x2*)(a.ws + WS_CSA))[(size_t)r * 64 + lane] = (f32x2){cs, sn}; }
    if (lane < 32) { const float inv = powf(10000.0f, -(float)(2 * lane) / 64.0f); float sn, cs; sincosf(p * inv, &sn, &cs); ((f32x2*)(a.ws + WS_CSI))[(size_t)r * 32 + lane] = (f32x2){cs, sn}; }
}
__device__ __forceinline__ void p0_late(const Args& a, const int wave, LAS unsigned char* lds, int first, int nblk) {
    const int lane = lane_id(), tid = wave * 64 + lane;
    LAS float* scr = (LAS float*)(lds + wave * 16384);
    const int gw = ((int)blockIdx.x - first) * NWAVES + wave, NGW = nblk * NWAVES;
    unsigned char* ws = a.ws;
    constexpr int I_WO = (2048 / 64) * (DM / 32), I_W1 = (DM / 64) * (N1 / 32), I_ROPE = MTOK;
    for (int it = gw; it < I_W1 + I_WO + I_ROPE; it += NGW) {
        int r = it;
        if (r < I_W1) { const int nblk = N1 / 32, k0 = 64 * (r / nblk), n0 = 32 * (r % nblk); transpose_item_col(a.odd_w_in, ODD_COLS, map1(n0 + (lane & 31)), DM, (bf16_t*)(ws + WS_WIN1), scr, k0, n0, lane); continue; } r -= I_W1;
        if (r < I_WO) { const int nblk = DM / 32, k0 = 64 * (r / nblk), n0 = 32 * (r % nblk); transpose_item_col(a.odd_w_out, DM, n0 + (lane & 31), 2048, (bf16_t*)(ws + WS_WOUT1), scr, k0, n0, lane); continue; } r -= I_WO;
        {
            const float p = (float)a.pos[r];
            { const float inv = powf(10000.0f, -(float)(2 * lane) / 128.0f); float sn, cs; sincosf(p * inv, &sn, &cs); ((f32x2*)(ws + WS_CSA))[(size_t)r * 64 + lane] = (f32x2){cs, sn}; }
            if (lane < 32) { const float inv = powf(10000.0f, -(float)(2 * lane) / 64.0f); float sn, cs; sincosf(p * inv, &sn, &cs); ((f32x2*)(ws + WS_CSI))[(size_t)r * 32 + lane] = (f32x2){cs, sn}; }
        }
    }
}
__device__ __forceinline__ void p0_prologue(const Args& a, const int wave, LAS unsigned char* lds) {
    const int lane = lane_id(), tid = wave * 64 + lane;
    LAS float* scr = (LAS float*)(lds + wave * 16384);
    const int gw = blockIdx.x * NWAVES + wave, NGW = gridDim.x * NWAVES;
    unsigned char* ws = a.ws;
    constexpr int I_W0 = (DM / 64) * (N0 / 32), I_WO = (2048 / 64) * (DM / 32), I_W1 = (DM / 64) * (N1 / 32), I_WL = (256 / 64) * (2048 / 32), I_MOD = 96 * 8, I_ROPE = MTOK;
    constexpr int NITEMS = I_W0 + I_WO + I_W1 + I_WO + I_WL + I_MOD + I_ROPE;
    constexpr int N_EARLY = I_W0 + I_WO + I_W1 + I_WO + I_WL + I_MOD;
    for (int it = gw; it < N_EARLY; it += NGW) {
        int r = it;
        if (r < I_W0) { const float* W = a.even_w_in; transpose_item([W](int k, int n) { const int s = map0(n); return s < 0 ? 0.f : W[(size_t)k * EVEN_COLS + s]; }, DM, (bf16_t*)(ws + WS_WIN0), scr, r, N0 / 32, lane); continue; } r -= I_W0;
        if (r < I_WO) { const float* W = a.even_w_out; transpose_item([W](int k, int n) { return W[(size_t)k * DM + n]; }, 2048, (bf16_t*)(ws + WS_WOUT0), scr, r, DM / 32, lane); continue; } r -= I_WO;
        if (r < I_W1) { const float* W = a.odd_w_in; transpose_item([W](int k, int n) { const int s = map1(n); return s < 0 ? 0.f : W[(size_t)k * ODD_COLS + s]; }, DM, (bf16_t*)(ws + WS_WIN1), scr, r, N1 / 32, lane); continue; } r -= I_W1;
        if (r < I_WO) { const float* W = a.odd_w_out; transpose_item([W](int k, int n) { return W[(size_t)k * DM + n]; }, 2048, (bf16_t*)(ws + WS_WOUT1), scr, r, DM / 32, lane); continue; } r -= I_WO;
        if (r < I_WL) { const float* wu = a.w_up; const float* au = a.a_up;
            transpose_item([wu, au](int k, int n) { if (n < 1024) return k < 64 ? wu[k * 1024 + n] : 0.f; return (k >= 64 && k < 128) ? au[(k - 64) * 1024 + (n - 1024)] : 0.f; }, 256, (bf16_t*)(ws + WS_WLORA), scr, r, 2048 / 32, lane); continue; } r -= I_WL;
        if (r < I_MOD) {
            const int cgp = r >> 3, ks = r & 7, col = cgp * 64 + lane, l = col / 3072, cc = col - l * 3072;
#pragma unroll
            for (int i = 0; i < 8; ++i) { const int idx = lane + 64 * i, bb = idx >> 7, kk = idx & 127; const float cv = a.c[bb * DM + ks * 128 + kk]; scr[kk * 4 + bb] = cv * sigmoidf_(cv); }
            LDS_WAIT();
            const float* W = a.ada_w + (size_t)l * DM * 3072 + cc + (size_t)(ks * 128) * 3072; f32x4 acc4 = (f32x4){0.f, 0.f, 0.f, 0.f};
#pragma unroll 1
            for (int k8 = 0; k8 < 128; k8 += 16) { float wv[16];
#pragma unroll
                for (int i = 0; i < 16; ++i) wv[i] = W[(size_t)(k8 + i) * 3072];
#pragma unroll
                for (int i = 0; i < 16; ++i) acc4 += *(const LAS f32x4*)(scr + (k8 + i) * 4) * wv[i]; }
            LDS_WAIT();
            const float acc0 = acc4[0], acc1 = acc4[1], acc2 = acc4[2], acc3 = acc4[3];
            float* mp = (float*)(ws + WS_MODP) + (size_t)((ks * 2 + l) * 4) * 3072 + cc;
            mp[0] = acc0; mp[3072] = acc1; mp[2 * 3072] = acc2; mp[3 * 3072] = acc3; continue; } r -= I_MOD;
    }
}

__device__ __forceinline__ void norm_phase(const Args& a, const int wave, LAS unsigned char* lds, const float* src, int layer) {
    const int lane = lane_id(), tid = wave * 64 + lane;
    LAS float* gs = (LAS float*)lds; LAS float* sh = gs + DM;
    const float* modp = (const float*)(a.ws + WS_MODP); bf16_t* H = (bf16_t*)(a.ws + WS_H);
    for (int tile = blockIdx.x; tile < MTOK / 128; tile += gridDim.x) {
        const int b = (tile * 128) / SEQ;
        __syncthreads();
        for (int c = tid; c < DM; c += NTHREADS) {
            float sc = a.ada_b[layer * 3072 + 1024 + c], sf = a.ada_b[layer * 3072 + c];
#pragma unroll
            for (int s = 0; s < 8; ++s) { const float* mp = modp + (size_t)((s * 2 + layer) * 4 + b) * 3072; sc += mp[1024 + c]; sf += mp[c]; }
            gs[c] = a.norm_g[layer * DM + c] * (1.0f + sc); sh[c] = sf; }
        __syncthreads();
        for (int r4 = 0; r4 < 16; r4 += 4) {
            f32x4 v[4][4]; float ss[4];
#pragma unroll
            for (int q = 0; q < 4; ++q) { const size_t m = (size_t)tile * 128 + wave * 16 + r4 + q; const f32x4* xr = (const f32x4*)(src + m * DM) + lane;
#pragma unroll
                for (int j = 0; j < 4; ++j) v[q][j] = xr[64 * j]; }
#pragma unroll
            for (int q = 0; q < 4; ++q) { float s = 0.f;
#pragma unroll
                for (int j = 0; j < 4; ++j) s += (v[q][j][0] * v[q][j][0] + v[q][j][1] * v[q][j][1]) + (v[q][j][2] * v[q][j][2] + v[q][j][3] * v[q][j][3]);
                ss[q] = s; }
#pragma unroll
            for (int q = 0; q < 4; ++q) ss[q] = wave_sum(ss[q]);
#pragma unroll
            for (int q = 0; q < 4; ++q) { const size_t m = (size_t)tile * 128 + wave * 16 + r4 + q; const float rstd = rsqrtf(ss[q] * (1.0f / DM) + 1e-6f);
                u32x2* o = (u32x2*)(H + m * DM) + lane;
#pragma unroll
                for (int j = 0; j < 4; ++j) { const f32x4 g = *(const LAS f32x4*)(gs + 4 * (64 * j + lane)), s = *(const LAS f32x4*)(sh + 4 * (64 * j + lane));
                    const f32x4 h = v[q][j] * rstd * g + s; u32x2 w; w.x = pk2(h[0], h[1]); w.y = pk2(h[2], h[3]); o[64 * j] = w; } }
        }
    }
}

__device__ __forceinline__ void final_phase(const Args& a, const int wave) {
    const int lane = lane_id(), tid = wave * 64 + lane;
    const int gw = blockIdx.x * NWAVES + wave, NGW = gridDim.x * NWAVES;
    f32x4 g[4];
#pragma unroll
    for (int j = 0; j < 4; ++j) g[j] = *((const f32x4*)a.final_g + 64 * j + lane);
    float tsc = 1.0f;
#ifdef STAMP_K
    { const unsigned long long* st = (const unsigned long long*)(a.ws + WS_STAMP); tsc = 1.0f + (float)(st[1] - st[0] + st[2]) * 1e-7f; }
#endif
    for (int m0 = 4 * gw; m0 < MTOK; m0 += 4 * NGW) {
        f32x4 v[4][4]; float ss[4];
#pragma unroll
        for (int q = 0; q < 4; ++q) { const f32x4* xr = (const f32x4*)(a.out + (size_t)(m0 + q) * DM) + lane;
#pragma unroll
            for (int j = 0; j < 4; ++j) v[q][j] = xr[64 * j]; }
#pragma unroll
        for (int q = 0; q < 4; ++q) { float s = 0.f;
#pragma unroll
            for (int j = 0; j < 4; ++j) s += (v[q][j][0] * v[q][j][0] + v[q][j][1] * v[q][j][1]) + (v[q][j][2] * v[q][j][2] + v[q][j][3] * v[q][j][3]);
            ss[q] = wave_sum(s); }
#pragma unroll
        for (int q = 0; q < 4; ++q) { const float rstd = rsqrtf(ss[q] * (1.0f / DM) + 1e-6f) * tsc; f32x4* xr = (f32x4*)(a.out + (size_t)(m0 + q) * DM) + lane;
#pragma unroll
            for (int j = 0; j < 4; ++j) xr[64 * j] = v[q][j] * rstd * g[j]; }
    }
}


__device__ __forceinline__ void conv_phase(const Args& a, const int wave, LAS unsigned char* lds, int first, int stride) {
    const int lane = lane_id(), tid = wave * 64 + lane;
    const bf16_t* U = (const bf16_t*)(a.ws + WS_U); const bf16_t* AG = (const bf16_t*)(a.ws + WS_AG); bf16_t* YAB = (bf16_t*)(a.ws + WS_YAB);
    f32x2 w[31];
#pragma unroll
    for (int j = 0; j < 31; ++j) w[j] = *(const f32x2*)(a.conv_w + j * DM + 2 * tid);
    const f32x2 cbias = *(const f32x2*)(a.conv_vec + 2 * tid);
    for (int tile = first; tile < MTOK / 32; tile += stride) {
        const int b = tile >> 8, s0 = (tile & 255) * 32;
        __syncthreads();
        for (int idx = tid; idx < 62 * 128; idx += NTHREADS) { const int row = idx >> 7, ch = idx & 127, s = s0 - 30 + row;
            u32x4 v = (u32x4){0u, 0u, 0u, 0u}; if (s >= 0) v = *(const u32x4*)(U + ((size_t)(b * SEQ + s)) * DM + ch * 8);
            *(LAS u32x4*)(lds + row * 2048 + ch * 16) = v; }
        __syncthreads();
        LAS unsigned char* rb0 = lds + tid * 4; LAS unsigned char* rb1 = rb0 + 65536; LAS unsigned char* wb0 = lds + tid * 8; LAS unsigned char* wb1 = wb0 + 65536;
        asm volatile("" : "+v"(rb0), "+v"(rb1), "+v"(wb0), "+v"(wb1));
        f32x2 acc[32];
#pragma unroll
        for (int t = 0; t < 32; ++t) acc[t] = (f32x2){0.f, 0.f};
#pragma unroll
        for (int i = 0; i < 62; ++i) { const unsigned xw = (i < 32) ? *(const LAS unsigned*)(rb0 + i * 2048) : *(const LAS unsigned*)(rb1 + (i - 32) * 2048); const f32x2 xv = (f32x2){bflo(xw), bfhi(xw)};
#pragma unroll
            for (int t = (i > 30 ? i - 30 : 0); t <= (i < 31 ? i : 31); ++t) acc[t] += xv * w[i - t]; }
        __syncthreads();
#pragma unroll
        for (int t = 0; t < 32; ++t) { if (t < 16) *(LAS f32x2*)(wb0 + t * 4096) = acc[t] + cbias; else *(LAS f32x2*)(wb1 + (t - 16) * 4096) = acc[t] + cbias; }
        __syncthreads();
        f32x4 lw[4], lb[4];
#pragma unroll
        for (int j = 0; j < 4; ++j) { lw[j] = *(const f32x4*)(a.conv_vec + DM + 4 * (lane + 64 * j)); lb[j] = *(const f32x4*)(a.conv_vec + 2 * DM + 4 * (lane + 64 * j)); }
        for (int tt = 0; tt < 4; ++tt) { const int t = wave * 4 + tt; const size_t m = (size_t)b * SEQ + s0 + t;
            f32x4 v[4]; float s = 0.f;
#pragma unroll
            for (int j = 0; j < 4; ++j) { v[j] = *(const LAS f32x4*)(lds + (size_t)t * 4096 + 16 * (lane + 64 * j)); s += (v[j][0] + v[j][1]) + (v[j][2] + v[j][3]); }
            const float mean = wave_sum(s) * (1.0f / DM); float q = 0.f;
#pragma unroll
            for (int j = 0; j < 4; ++j) { v[j] = v[j] - mean; q += (v[j][0] * v[j][0] + v[j][1] * v[j][1]) + (v[j][2] * v[j][2] + v[j][3] * v[j][3]); }
            const float rstd = rsqrtf(wave_sum(q) * (1.0f / DM) + 1e-5f);
#pragma unroll
            for (int j = 0; j < 4; ++j) { const f32x4 y = v[j] * rstd * lw[j] + lb[j]; const u32x2 g = *(const u32x2*)(AG + m * DM + 4 * (lane + 64 * j));
                const f32x4 o = silu4(y) * (f32x4){bflo(g.x), bfhi(g.x), bflo(g.y), bfhi(g.y)};
                u32x2 wv; wv.x = pk2(o[0], o[1]); wv.y = pk2(o[2], o[3]); *(u32x2*)(YAB + m * 2048 + 4 * (lane + 64 * j)) = wv; }
        }
    }
}

__device__ __forceinline__ void lora_pre_phase(const Args& a, const int wave) {
    const int lane = lane_id(), tid = wave * 64 + lane;

        const bf16_t* WDAD = (const bf16_t*)((unsigned char*)a.out + DO_WDAD); bf16_t* LA = (bf16_t*)((unsigned char*)a.out + DO_LA);
        const int gw = blockIdx.x * NWAVES + wave, NGW = gridDim.x * NWAVES;
        const f32x2 mu = *(const f32x2*)(a.mu_lora + 2 * lane);
        for (int m0 = gw * 4; m0 < MTOK; m0 += NGW * 4) {
            unsigned cur[4], prv[4];
#pragma unroll
            for (int i = 0; i < 4; ++i) { const int m = m0 + i; cur[i] = *(const unsigned*)(WDAD + (size_t)m * 128 + 2 * lane); }
#pragma unroll
            for (int i = 0; i < 4; ++i) { const int m = m0 + i; if (i > 0) prv[i] = cur[i - 1]; else { prv[0] = 0u; if ((m & (SEQ - 1)) > 0) prv[0] = *(const unsigned*)(WDAD + (size_t)(m - 1) * 128 + 2 * lane); } }
#pragma unroll
            for (int i = 0; i < 4; ++i) { const int m = m0 + i;
                float v0 = bflo(cur[i]), v1 = bfhi(cur[i]); v0 += (bflo(prv[i]) - v0) * mu[0]; v1 += (bfhi(prv[i]) - v1) * mu[1];
                if (lane < 32) { v0 = tanhf(v0); v1 = tanhf(v1); }
                *(unsigned*)(LA + (size_t)m * 256 + 2 * lane) = pk2(v0, v1); *(unsigned*)(LA + (size_t)m * 256 + 128 + 2 * lane) = 0u; }
        }
    }

struct ScanRaw { u32x2 r, rp, k, kp, v, vp, d, a; };
constexpr int SC_CH = 16, SC_BUF_F = 5 * SC_CH * 64 + SC_CH * 16;

__device__ __forceinline__ void scan_phase(const Args& a, const int wave, LAS unsigned char* lds) {
    const int lane = lane_id(), tid = wave * 64 + lane;
    const bf16_t* Rg = (const bf16_t*)(a.ws + WS_R); const bf16_t* Kg = (const bf16_t*)(a.ws + WS_K); const bf16_t* Vg = (const bf16_t*)(a.ws + WS_V);
    const bf16_t* Dg = (const bf16_t*)(a.ws + WS_DARR); const bf16_t* Ag = (const bf16_t*)(a.ws + WS_AARR);
    bf16_t* YAB = (bf16_t*)(a.ws + WS_YAB); float* RK = (float*)((unsigned char*)a.out + DO_RK);
    LAS float* bufs = (LAS float*)lds; LAS float* ybuf = bufs + 2 * SC_BUF_F;
    constexpr int NCH = SEQ / SC_CH;
    for (int job = blockIdx.x; job < 256; job += gridDim.x) {
        const int vcu = (gridDim.x == 256) ? ((job & 7) * 32 + (job >> 3)) : job;
        const int bh = vcu >> 2, vq = vcu & 3, b = bh >> 4, h = bh & 15;
        __syncthreads();
        if (wave >= 4) {
            const int pt = tid - 256, tok = pt >> 4, cgp = pt & 15, ch = h * 64 + 4 * cgp;
            const f32x4 mur = *(const f32x4*)(a.mu_rkv + ch), muk = *(const f32x4*)(a.mu_rkv + DM + ch), muv = *(const f32x4*)(a.mu_rkv + 2 * DM + ch);
            const f32x4 k_k = *(const f32x4*)(a.rwkv_vec + 2 * DM + ch), k_a = *(const f32x4*)(a.rwkv_vec + 3 * DM + ch), rkw = *(const f32x4*)(a.r_k + ch);
            auto load = [&](int c) { ScanRaw q; const int s = c * SC_CH + tok; const size_t m = (size_t)b * SEQ + s; const size_t o = m * DM + ch; const size_t op = (s > 0) ? o - DM : o;
                q.r = *(const u32x2*)(Rg + o); q.k = *(const u32x2*)(Kg + o); q.v = *(const u32x2*)(Vg + o); q.d = *(const u32x2*)(Dg + o); q.a = *(const u32x2*)(Ag + o);
                q.rp = *(const u32x2*)(Rg + op); q.kp = *(const u32x2*)(Kg + op); q.vp = *(const u32x2*)(Vg + op);
                if (s == 0) { q.rp = (u32x2){0u, 0u}; q.kp = (u32x2){0u, 0u}; q.vp = (u32x2){0u, 0u}; }
                return q; };
            auto un4 = [](u32x2 w) { return (f32x4){bflo(w.x), bfhi(w.x), bflo(w.y), bfhi(w.y)}; };
            auto process = [&](const ScanRaw& q, int c, LAS float* buf) {
                const f32x4 r0 = un4(q.r), k0 = un4(q.k), v0 = un4(q.v);
                const f32x4 rl = r0 + (un4(q.rp) - r0) * mur, kl = k0 + (un4(q.kp) - k0) * muk, vl = v0 + (un4(q.vp) - v0) * muv;
                const f32x4 d = un4(q.d), av = un4(q.a);
                f32x4 wdec; wdec[0] = __expf(-d[0]); wdec[1] = __expf(-d[1]); wdec[2] = __expf(-d[2]); wdec[3] = __expf(-d[3]);
                const f32x4 kkr = kl * k_k; float ss = (kkr[0] * kkr[0] + kkr[1] * kkr[1]) + (kkr[2] * kkr[2] + kkr[3] * kkr[3]); ss = row16_sum(ss);
                const float inv = 1.0f / fmaxf(sqrtf(ss), 1e-12f);
                const f32x4 kk = kkr * inv, kp = kl * (1.0f + (av - 1.0f) * k_a), bb = kk * av;
                float rk = (rl[0] * kp[0] * rkw[0] + rl[1] * kp[1] * rkw[1]) + (rl[2] * kp[2] * rkw[2] + rl[3] * kp[3] * rkw[3]); rk = row16_sum(rk);
                const int o = tok * 64 + 4 * cgp;
                *(LAS f32x4*)(buf + o) = -kk; *(LAS f32x4*)(buf + 1024 + o) = wdec; *(LAS f32x4*)(buf + 2048 + o) = bb; *(LAS f32x4*)(buf + 3072 + o) = kp; *(LAS f32x4*)(buf + 4096 + o) = rl;
                if ((cgp >> 2) == vq) *(LAS f32x4*)(buf + 5120 + tok * 16 + 4 * (cgp & 3)) = vl;
                if (vq == 0 && cgp == 0) RK[((size_t)b * SEQ + c * SC_CH + tok) * 16 + h] = rk; };
            auto flush = [&](int c, const LAS float* yb) {
                if (wave == 4) { const int t2 = lane >> 2, rq = lane & 3; const f32x4 y = *(const LAS f32x4*)(yb + t2 * 16 + 4 * rq);
                    u32x2 wv; wv.x = pk2(y[0], y[1]); wv.y = pk2(y[2], y[3]);
                    *(u32x2*)(YAB + ((size_t)b * SEQ + c * SC_CH + t2) * 2048 + 1024 + h * 64 + 16 * vq + 4 * rq) = wv; } };
            ScanRaw q0 = load(0), q1 = load(1);
            process(q0, 0, bufs); q0 = q1; q1 = load(2);
            __syncthreads();
            for (int c = 0; c < NCH; ++c) {
                if (c + 1 < NCH) process(q0, c + 1, bufs + ((c + 1) & 1) * SC_BUF_F);
                q0 = q1; if (c + 3 < NCH) q1 = load(c + 3);
                if (c >= 1) flush(c - 1, ybuf + ((c - 1) & 1) * 256);
                __syncthreads();
            }
            flush(NCH - 1, ybuf + ((NCH - 1) & 1) * 256);
        } else {
            const int rw = lane >> 4, ks = lane & 15, row = wave * 4 + rw;
            float s0 = 0.f, s1 = 0.f, s2 = 0.f, s3 = 0.f;
            __syncthreads();
            for (int c = 0; c < NCH; ++c) {
                const LAS float* buf = bufs + (c & 1) * SC_BUF_F; LAS float* yb = ybuf + (c & 1) * 256;
#pragma unroll
                for (int t = 0; t < SC_CH; ++t) {
                    const f32x4 nk = *(const LAS f32x4*)(buf + t * 64 + 4 * ks), w4 = *(const LAS f32x4*)(buf + 1024 + t * 64 + 4 * ks), b4 = *(const LAS f32x4*)(buf + 2048 + t * 64 + 4 * ks);
                    const f32x4 kp = *(const LAS f32x4*)(buf + 3072 + t * 64 + 4 * ks), r4 = *(const LAS f32x4*)(buf + 4096 + t * 64 + 4 * ks); const float vv = buf[5120 + t * 16 + row];
                    float sa = (s0 * nk[0] + s1 * nk[1]) + (s2 * nk[2] + s3 * nk[3]); sa = row16_sum(sa);
                    s0 = s0 * w4[0] + (sa * b4[0] + vv * kp[0]); s1 = s1 * w4[1] + (sa * b4[1] + vv * kp[1]);
                    s2 = s2 * w4[2] + (sa * b4[2] + vv * kp[2]); s3 = s3 * w4[3] + (sa * b4[3] + vv * kp[3]);
                    float y = (s0 * r4[0] + s1 * r4[1]) + (s2 * r4[2] + s3 * r4[3]); y = row16_sum(y);
                    if (ks == 0) yb[t * 16 + row] = y;
                }
                __syncthreads();
            }
        }
    }
}

__device__ __forceinline__ void post_phase(const Args& a, const int wave) {
    const int lane = lane_id(), tid = wave * 64 + lane;
    const int gw = blockIdx.x * NWAVES + wave, NGW = gridDim.x * NWAVES;
    const bf16_t* Vg = (const bf16_t*)(a.ws + WS_V); const bf16_t* BG = (const bf16_t*)((unsigned char*)a.out + DO_BG); const float* RK = (const float*)((unsigned char*)a.out + DO_RK);
    bf16_t* YAB = (bf16_t*)(a.ws + WS_YAB);
    const int head = lane >> 2, c0 = head * 64 + 16 * (lane & 3);
    f32x4 muv[4], lw[4], lb[4];
#pragma unroll
    for (int j = 0; j < 4; ++j) { muv[j] = *(const f32x4*)(a.mu_rkv + 2 * DM + c0 + 4 * j); lw[j] = *(const f32x4*)(a.rwkv_vec + 4 * DM + c0 + 4 * j); lb[j] = *(const f32x4*)(a.rwkv_vec + 5 * DM + c0 + 4 * j); }
    auto un4 = [](unsigned x, unsigned y) { return (f32x4){bflo(x), bfhi(x), bflo(y), bfhi(y)}; };
    for (int m = gw; m < MTOK; m += NGW) { const int s = m & (SEQ - 1);
        bf16_t* yp = YAB + (size_t)m * 2048 + 1024 + c0;
        const u32x4 ya = *(const u32x4*)yp, yb2 = *(const u32x4*)(yp + 8);
        const u32x4 va = *(const u32x4*)(Vg + (size_t)m * DM + c0), vb = *(const u32x4*)(Vg + (size_t)m * DM + c0 + 8);
        u32x4 pa = (u32x4){0u, 0u, 0u, 0u}, pb = pa; if (s > 0) { pa = *(const u32x4*)(Vg + (size_t)(m - 1) * DM + c0); pb = *(const u32x4*)(Vg + (size_t)(m - 1) * DM + c0 + 8); }
        const u32x4 ga = *(const u32x4*)(BG + (size_t)m * DM + c0), gb = *(const u32x4*)(BG + (size_t)m * DM + c0 + 8);
        const float rk = RK[(size_t)m * 16 + head];
        f32x4 y[4] = {un4(ya.x, ya.y), un4(ya.z, ya.w), un4(yb2.x, yb2.y), un4(yb2.z, yb2.w)};
        const f32x4 v[4] = {un4(va.x, va.y), un4(va.z, va.w), un4(vb.x, vb.y), un4(vb.z, vb.w)};
        const f32x4 p[4] = {un4(pa.x, pa.y), un4(pa.z, pa.w), un4(pb.x, pb.y), un4(pb.z, pb.w)};
        const f32x4 g[4] = {un4(ga.x, ga.y), un4(ga.z, ga.w), un4(gb.x, gb.y), un4(gb.z, gb.w)};
        float sm = 0.f;
#pragma unroll
        for (int j = 0; j < 4; ++j) sm += (y[j][0] + y[j][1]) + (y[j][2] + y[j][3]);
        const float mean = quad_sum(sm) * (1.0f / 64.0f); float q = 0.f;
#pragma unroll
        for (int j = 0; j < 4; ++j) { y[j] = y[j] - mean; q += (y[j][0] * y[j][0] + y[j][1] * y[j][1]) + (y[j][2] * y[j][2] + y[j][3] * y[j][3]); }
        const float rstd = rsqrtf(quad_sum(q) * (1.0f / 64.0f) + 64e-5f);
        u32x4 o[2];
#pragma unroll
        for (int j = 0; j < 4; ++j) { const f32x4 vl = v[j] + (p[j] - v[j]) * muv[j]; const f32x4 r = (y[j] * rstd * lw[j] + lb[j] + rk * vl) * g[j];
            if (j & 1) { o[j >> 1].z = pk2(r[0], r[1]); o[j >> 1].w = pk2(r[2], r[3]); } else { o[j >> 1].x = pk2(r[0], r[1]); o[j >> 1].y = pk2(r[2], r[3]); } }
        *(u32x4*)yp = o[0]; *(u32x4*)(yp + 8) = o[1];
    }
}

constexpr int CS_L = 32, CS_NCH = SEQ / CS_L, CS_NSLOT = 3;
constexpr int CS_NT = 0, CS_RT = 4096, CS_BT = 8192, CS_KT = 12288, CS_TM = 8192, CS_AKN = 10240, CS_ABR = 12288, CS_AKR = 14336, CS_BC = 16384, CS_KC = 20480, CS_VC = 24576, CS_GL = 28672, CS_SLOT = 29184;
constexpr int CS_RAW = CS_NSLOT * CS_SLOT, CS_RAWSZ = 5 * 33 * 128;
constexpr int CS_FLAGS = CS_RAW + CS_NSLOT * CS_RAWSZ;
static_assert(CS_FLAGS + 64 <= LDS_BYTES && (CS_RAW % 16) == 0 && (CS_RAWSZ % 16) == 0, "chunked scan LDS map");
__device__ __forceinline__ int permp(int j) { return 8 * ((j & 15) >> 2) + 4 * (j >> 4) + (j & 3); }
template <int CTRL, int RM> __device__ __forceinline__ float dppf(float x) { return __int_as_float(__builtin_amdgcn_update_dpp(0, __float_as_int(x), CTRL, RM, 0xf, true)); }
__device__ __forceinline__ float wave_total(float x) {
    x = row16_sum(x); x += dppf<0x142, 0xa>(x); x += dppf<0x143, 0xc>(x); return __int_as_float(__builtin_amdgcn_readlane(__float_as_int(x), 63)); }
__device__ __forceinline__ float wave_sum64(float x) { x = row16_sum(x); x += __shfl_xor(x, 16); x += __shfl_xor(x, 32); return x; }
__device__ __forceinline__ bf16x8 cfrag(const f32x16& x, int s) {
    u32x4 w; w.x = pk2(x[8 * s + 0], x[8 * s + 1]); w.y = pk2(x[8 * s + 2], x[8 * s + 3]); w.z = pk2(x[8 * s + 4], x[8 * s + 5]); w.w = pk2(x[8 * s + 6], x[8 * s + 7]); return __builtin_bit_cast(bf16x8, w); }
__device__ __forceinline__ bf16x8 cfrag2(const f32x4& a, const f32x4& b) { u32x4 w; w.x = pk2(a[0], a[1]); w.y = pk2(a[2], a[3]); w.z = pk2(b[0], b[1]); w.w = pk2(b[2], b[3]); return __builtin_bit_cast(bf16x8, w); }
__device__ __forceinline__ void lds_poll_ge(LAS unsigned* p, unsigned want) { while (__hip_atomic_load(p, __ATOMIC_RELAXED, __HIP_MEMORY_SCOPE_WORKGROUP) < want) __builtin_amdgcn_s_sleep(1); asm volatile("" ::: "memory"); }

__device__ __forceinline__ void cscan_job(const Args& a, const int wave, LAS unsigned char* lds, int bh) {
    int lane; asm volatile("v_mbcnt_lo_u32_b32 %0, -1, 0\n\tv_mbcnt_hi_u32_b32 %0, -1, %0" : "=v"(lane));
    const int tid = wave * 64 + lane;
    const int b = bh >> 4, h = bh & 15;
    const bf16_t* Rg = (const bf16_t*)(a.ws + WS_R); const bf16_t* Kg = (const bf16_t*)(a.ws + WS_K); const bf16_t* Vg = (const bf16_t*)(a.ws + WS_V);
    const bf16_t* Dg = (const bf16_t*)(a.ws + WS_DARR); const bf16_t* Ag = (const bf16_t*)(a.ws + WS_AARR);
    bf16_t* YAB = (bf16_t*)(a.ws + WS_YAB); float* RK = (float*)((unsigned char*)a.out + DO_RK);
    LAS unsigned* ready = (LAS unsigned*)(lds + CS_FLAGS); LAS unsigned* done = ready + CS_NSLOT; LAS unsigned* rawready = done + CS_NSLOT; LAS unsigned* rawfree = rawready + CS_NSLOT;
    __syncthreads();
    if (tid < 4 * CS_NSLOT) ready[tid] = 0u;
    __syncthreads();
    if (wave == 4) {
        const int rr = lane >> 3, cc = lane & 7;
        for (int c = 0; c < CS_NCH; ++c) {
            const int s = c % CS_NSLOT; LAS unsigned char* rw = lds + CS_RAW + s * CS_RAWSZ;
            const size_t m0 = (size_t)b * SEQ + (size_t)c * CS_L;
            u32x4 v[5][4], vp[3];
#pragma unroll
            for (int ar = 0; ar < 5; ++ar) { const bf16_t* src = (ar == 0) ? Rg : (ar == 1) ? Kg : (ar == 2) ? Vg : (ar == 3) ? Dg : Ag;
#pragma unroll
                for (int q4 = 0; q4 < 4; ++q4) v[ar][q4] = *(const u32x4*)(src + (m0 + 8 * q4 + rr) * DM + h * 64 + 8 * cc); }
#pragma unroll
            for (int ar = 0; ar < 3; ++ar) { const bf16_t* src = (ar == 0) ? Rg : (ar == 1) ? Kg : Vg; vp[ar] = (u32x4){0u, 0u, 0u, 0u};
                if (c > 0 && lane < 8) vp[ar] = *(const u32x4*)(src + (m0 - 1) * DM + h * 64 + 8 * cc); }
            if (c >= CS_NSLOT) lds_poll_ge(rawfree + s, (unsigned)(c / CS_NSLOT));
#pragma unroll
            for (int ar = 0; ar < 5; ++ar)
#pragma unroll
                for (int q4 = 0; q4 < 4; ++q4) *(LAS u32x4*)(rw + (ar * 33 + 1 + 8 * q4 + rr) * 128 + 16 * cc) = v[ar][q4];
            if (lane < 8) {
#pragma unroll
                for (int ar = 0; ar < 3; ++ar) *(LAS u32x4*)(rw + (ar * 33) * 128 + 16 * cc) = vp[ar]; }
            LDS_WAIT();
            if (lane == 0) __hip_atomic_store(rawready + s, (unsigned)(c + 1), __ATOMIC_RELAXED, __HIP_MEMORY_SCOPE_WORKGROUP);
        }
    } else if (wave >= 5) {
        const int hw = wave - 5, gch = h * 64 + lane;
        const float mur = a.mu_rkv[gch], muk = a.mu_rkv[DM + gch], muv = a.mu_rkv[2 * DM + gch], kkw = a.rwkv_vec[2 * DM + gch], kaw = a.rwkv_vec[3 * DM + gch], rkw = a.r_k[gch];
        const int kpos = 32 * (lane >> 5) + permp(lane & 31);
        for (int c = hw; c < CS_NCH; c += CS_NSLOT) {
            const int s = hw; LAS unsigned char* sl = lds + s * CS_SLOT; const LAS unsigned short* rw = (const LAS unsigned short*)(lds + CS_RAW + s * CS_RAWSZ);
            const unsigned use = (unsigned)(c / CS_NSLOT);
            { PROBE_BEGIN(10, a.ws, wave);
            if (use > 0u) lds_poll_ge(done + s, 4u * use);
            lds_poll_ge(rawready + s, (unsigned)(c + 1));
            PROBE_END(10, a.ws, wave); }
            PROBE_BEGIN(11, a.ws, wave);
            const size_t m0 = (size_t)b * SEQ + (size_t)c * CS_L; const size_t o0 = m0 * DM + gch;
            float rp = bflo((unsigned)rw[(0 * 33) * 64 + lane]), kp = bflo((unsigned)rw[(1 * 33) * 64 + lane]), vp = bflo((unsigned)rw[(2 * 33) * 64 + lane]);
            float cum = 0.f, gprev = 1.f;
            unsigned bcw[16], kcw[16], vcw[16];
#pragma unroll
            for (int grp = 0; grp < 4; ++grp) {
                float rlv[8], kkrv[8], kprv[8], vlv[8], aav[8], ddv[8], red[16];
#pragma unroll
                for (int e = 0; e < 8; ++e) { const int row = 1 + 8 * grp + e;
                    const float r0 = bflo((unsigned)rw[(0 * 33 + row) * 64 + lane]), k0 = bflo((unsigned)rw[(1 * 33 + row) * 64 + lane]), v0 = bflo((unsigned)rw[(2 * 33 + row) * 64 + lane]);
                    ddv[e] = bflo((unsigned)rw[(3 * 33 + row) * 64 + lane]); aav[e] = bflo((unsigned)rw[(4 * 33 + row) * 64 + lane]);
                    rlv[e] = r0 + (rp - r0) * mur; const float kl = k0 + (kp - k0) * muk; vlv[e] = v0 + (vp - v0) * muv; rp = r0; kp = k0; vp = v0;
                    kkrv[e] = kl * kkw; kprv[e] = kl * (1.0f + (aav[e] - 1.0f) * kaw);
                    red[2 * e] = kkrv[e] * kkrv[e]; red[2 * e + 1] = rlv[e] * kprv[e] * rkw; }
#pragma unroll
                for (int e = 0; e < 16; ++e) red[e] += dppf<0xB1, 0xf>(red[e]);
#pragma unroll
                for (int e = 0; e < 16; ++e) red[e] += dppf<0x4E, 0xf>(red[e]);
#pragma unroll
                for (int e = 0; e < 16; ++e) red[e] += dppf<0x141, 0xf>(red[e]);
#pragma unroll
                for (int e = 0; e < 16; ++e) red[e] += dppf<0x140, 0xf>(red[e]);
#pragma unroll
                for (int e = 0; e < 16; ++e) red[e] += dppf<0x142, 0xa>(red[e]);
#pragma unroll
                for (int e = 0; e < 16; ++e) red[e] += dppf<0x143, 0xc>(red[e]);
#pragma unroll
                for (int e = 0; e < 16; ++e) red[e] = __int_as_float(__builtin_amdgcn_readlane(__float_as_int(red[e]), 63));
                if (lane < 8) { float rkv = red[1];
#pragma unroll
                    for (int e = 1; e < 8; ++e) rkv = (lane == e) ? red[2 * e + 1] : rkv;
                    RK[(m0 + 8 * grp + lane) * 16 + h] = rkv; }
#pragma unroll
                for (int j2 = 0; j2 < 4; ++j2) {
                    const int i2 = 4 * grp + j2;
                    float nt[2], bt[2], kt[2], rt[2], vt[2];
#pragma unroll
                    for (int e = 0; e < 2; ++e) { const int te = 2 * j2 + e;
                        const float kkv = kkrv[te] * __builtin_amdgcn_rsqf(fmaxf(red[2 * te], 1e-24f)), bb = kkv * aav[te];
                        cum += ddv[te]; const float gi = __expf(-cum), ginv = __builtin_amdgcn_rcpf(gi);
                        nt[e] = -kkv * gprev; bt[e] = bb * ginv; kt[e] = kprv[te] * ginv; rt[e] = rlv[te] * gi; vt[e] = vlv[te]; gprev = gi; }
                    const unsigned wn = pk2(nt[0], nt[1]), wb = pk2(bt[0], bt[1]), wk = pk2(kt[0], kt[1]), wr = pk2(rt[0], rt[1]), wv = pk2(vt[0], vt[1]);
                    const int i = 2 * i2;
                    *(LAS unsigned short*)(sl + CS_NT + (i * 64 + kpos) * 2) = (unsigned short)wn; *(LAS unsigned short*)(sl + CS_NT + ((i + 1) * 64 + kpos) * 2) = (unsigned short)(wn >> 16);
                    *(LAS unsigned short*)(sl + CS_RT + (i * 64 + kpos) * 2) = (unsigned short)wr; *(LAS unsigned short*)(sl + CS_RT + ((i + 1) * 64 + kpos) * 2) = (unsigned short)(wr >> 16);
                    *(LAS unsigned short*)(sl + CS_BT + (i * 64 + kpos) * 2) = (unsigned short)wb; *(LAS unsigned short*)(sl + CS_BT + ((i + 1) * 64 + kpos) * 2) = (unsigned short)(wb >> 16);
                    *(LAS unsigned short*)(sl + CS_KT + (i * 64 + kpos) * 2) = (unsigned short)wk; *(LAS unsigned short*)(sl + CS_KT + ((i + 1) * 64 + kpos) * 2) = (unsigned short)(wk >> 16);
                    const int pw = permp(i) >> 1;
                    bcw[pw] = wb; kcw[pw] = wk; vcw[pw] = wv;
                }
                __builtin_amdgcn_sched_barrier(0);
            }
#pragma unroll
            for (int q4 = 0; q4 < 4; ++q4) {
                *(LAS u32x4*)(sl + CS_BC + lane * 64 + 16 * q4) = (u32x4){bcw[4 * q4], bcw[4 * q4 + 1], bcw[4 * q4 + 2], bcw[4 * q4 + 3]};
                *(LAS u32x4*)(sl + CS_KC + lane * 64 + 16 * q4) = (u32x4){kcw[4 * q4], kcw[4 * q4 + 1], kcw[4 * q4 + 2], kcw[4 * q4 + 3]};
                *(LAS u32x4*)(sl + CS_VC + lane * 64 + 16 * q4) = (u32x4){vcw[4 * q4], vcw[4 * q4 + 1], vcw[4 * q4 + 2], vcw[4 * q4 + 3]}; }
            *(LAS float*)(sl + CS_GL + lane * 4) = gprev;
            LDS_WAIT();
            if (lane == 0) __hip_atomic_store(rawfree + s, use + 1u, __ATOMIC_RELAXED, __HIP_MEMORY_SCOPE_WORKGROUP);
            PROBE_END(11, a.ws, wave);
            PROBE_BEGIN(12, a.ws, wave);
            const int tok = lane & 31, hf = lane >> 5;
            bf16x8 fn[4], fr[4], fb[4], fk[4];
#pragma unroll
            for (int ks = 0; ks < 4; ++ks) { fn[ks] = *(const LAS bf16x8*)(sl + CS_NT + (tok * 64 + 16 * ks + 8 * hf) * 2); fr[ks] = *(const LAS bf16x8*)(sl + CS_RT + (tok * 64 + 16 * ks + 8 * hf) * 2);
                fb[ks] = *(const LAS bf16x8*)(sl + CS_BT + (tok * 64 + 16 * ks + 8 * hf) * 2); fk[ks] = *(const LAS bf16x8*)(sl + CS_KT + (tok * 64 + 16 * ks + 8 * hf) * 2); }
            f32x16 P, Pt, Tm, Akn, Abr, Akr;
#pragma unroll
            for (int e = 0; e < 16; ++e) { P[e] = 0.f; Pt[e] = 0.f; Akn[e] = 0.f; Abr[e] = 0.f; Akr[e] = 0.f; }
#pragma unroll
            for (int ks = 0; ks < 4; ++ks) { P = __builtin_amdgcn_mfma_f32_32x32x16_bf16(fn[ks], fb[ks], P, 0, 0, 0); Pt = __builtin_amdgcn_mfma_f32_32x32x16_bf16(fb[ks], fn[ks], Pt, 0, 0, 0);
                Akn = __builtin_amdgcn_mfma_f32_32x32x16_bf16(fn[ks], fk[ks], Akn, 0, 0, 0); Abr = __builtin_amdgcn_mfma_f32_32x32x16_bf16(fr[ks], fb[ks], Abr, 0, 0, 0); Akr = __builtin_amdgcn_mfma_f32_32x32x16_bf16(fr[ks], fk[ks], Akr, 0, 0, 0); }
#pragma unroll
            for (int e = 0; e < 16; ++e) { const int row = (e & 3) + 8 * (e >> 2) + 4 * hf, col = tok;
                if (!(col < row)) { P[e] = 0.f; Akn[e] = 0.f; } if (!(row < col)) Pt[e] = 0.f; if (col > row) { Abr[e] = 0.f; Akr[e] = 0.f; }
                Tm[e] = P[e] + (row == col ? 1.0f : 0.f); }
#pragma unroll
            for (int mm = 1; mm <= 4; ++mm) {
                const bf16x8 p0 = cfrag(P, 0), p1 = cfrag(P, 1), q0 = cfrag(Pt, 0), q1 = cfrag(Pt, 1);
                f32x16 Ptn, Pn;
#pragma unroll
                for (int e = 0; e < 16; ++e) { Ptn[e] = 0.f; Pn[e] = 0.f; }
                Ptn = __builtin_amdgcn_mfma_f32_32x32x16_bf16(p0, q0, Ptn, 0, 0, 0); Ptn = __builtin_amdgcn_mfma_f32_32x32x16_bf16(p1, q1, Ptn, 0, 0, 0);
                if (mm < 4) { Pn = __builtin_amdgcn_mfma_f32_32x32x16_bf16(q0, p0, Pn, 0, 0, 0); Pn = __builtin_amdgcn_mfma_f32_32x32x16_bf16(q1, p1, Pn, 0, 0, 0); }
                const bf16x8 t0 = cfrag(Tm, 0), t1 = cfrag(Tm, 1), u0 = cfrag(Ptn, 0), u1 = cfrag(Ptn, 1);
                Tm = __builtin_amdgcn_mfma_f32_32x32x16_bf16(u0, t0, Tm, 0, 0, 0); Tm = __builtin_amdgcn_mfma_f32_32x32x16_bf16(u1, t1, Tm, 0, 0, 0);
                P = Pn; Pt = Ptn;
            }
            { const int pc = permp(tok);
#pragma unroll
              for (int e = 0; e < 16; e += 2) { const int row = (e & 3) + 8 * (e >> 2) + 4 * hf;
                const unsigned w0 = pk2(Tm[e], Tm[e + 1]), w1 = pk2(Akn[e], Akn[e + 1]), w2 = pk2(Abr[e], Abr[e + 1]), w3 = pk2(Akr[e], Akr[e + 1]);
                *(LAS unsigned short*)(sl + CS_TM + (row * 32 + pc) * 2) = (unsigned short)w0; *(LAS unsigned short*)(sl + CS_TM + ((row + 1) * 32 + pc) * 2) = (unsigned short)(w0 >> 16);
                *(LAS unsigned short*)(sl + CS_AKN + (row * 32 + pc) * 2) = (unsigned short)w1; *(LAS unsigned short*)(sl + CS_AKN + ((row + 1) * 32 + pc) * 2) = (unsigned short)(w1 >> 16);
                *(LAS unsigned short*)(sl + CS_ABR + (row * 32 + pc) * 2) = (unsigned short)w2; *(LAS unsigned short*)(sl + CS_ABR + ((row + 1) * 32 + pc) * 2) = (unsigned short)(w2 >> 16);
                *(LAS unsigned short*)(sl + CS_AKR + (row * 32 + pc) * 2) = (unsigned short)w3; *(LAS unsigned short*)(sl + CS_AKR + ((row + 1) * 32 + pc) * 2) = (unsigned short)(w3 >> 16); } }
            LDS_WAIT();
            if (lane == 0) __hip_atomic_store(ready + s, (unsigned)(c + 1), __ATOMIC_RELAXED, __HIP_MEMORY_SCOPE_WORKGROUP);
            PROBE_END(12, a.ws, wave);
        }
    } else {
        const int l15 = lane & 15, g = lane >> 4, vb = wave;
        f32x4 xc[4];
#pragma unroll
        for (int kt = 0; kt < 4; ++kt) xc[kt] = (f32x4){0.f, 0.f, 0.f, 0.f};
        for (int c = 0; c < CS_NCH; ++c) {
            const int s = c % CS_NSLOT; const LAS unsigned char* sl = lds + s * CS_SLOT;
            lds_poll_ge(ready + s, (unsigned)(c + 1));
            const bf16x8 xb0 = cfrag2(xc[0], xc[1]), xb1 = cfrag2(xc[2], xc[3]);
            const bf16x8 vop = *(const LAS bf16x8*)(sl + CS_VC + ((16 * vb + l15) * 32 + 8 * g) * 2);
            f32x4 W[2], U[2], Y[2];
#pragma unroll
            for (int rt = 0; rt < 2; ++rt) { const int row = 16 * rt + l15; f32x4 acc = (f32x4){0.f, 0.f, 0.f, 0.f};
                acc = __builtin_amdgcn_mfma_f32_16x16x32_bf16(*(const LAS bf16x8*)(sl + CS_AKN + (row * 32 + 8 * g) * 2), vop, acc, 0, 0, 0);
                acc = __builtin_amdgcn_mfma_f32_16x16x32_bf16(*(const LAS bf16x8*)(sl + CS_NT + (row * 64 + 8 * g) * 2), xb0, acc, 0, 0, 0);
                acc = __builtin_amdgcn_mfma_f32_16x16x32_bf16(*(const LAS bf16x8*)(sl + CS_NT + (row * 64 + 32 + 8 * g) * 2), xb1, acc, 0, 0, 0);
                W[rt] = acc; }
            const bf16x8 wb = cfrag2(W[0], W[1]);
#pragma unroll
            for (int rt = 0; rt < 2; ++rt) { const int row = 16 * rt + l15;
                U[rt] = __builtin_amdgcn_mfma_f32_16x16x32_bf16(*(const LAS bf16x8*)(sl + CS_TM + (row * 32 + 8 * g) * 2), wb, (f32x4){0.f, 0.f, 0.f, 0.f}, 0, 0, 0); }
            const bf16x8 ub = cfrag2(U[0], U[1]);
#pragma unroll
            for (int rt = 0; rt < 2; ++rt) { const int row = 16 * rt + l15; f32x4 acc = (f32x4){0.f, 0.f, 0.f, 0.f};
                acc = __builtin_amdgcn_mfma_f32_16x16x32_bf16(*(const LAS bf16x8*)(sl + CS_AKR + (row * 32 + 8 * g) * 2), vop, acc, 0, 0, 0);
                acc = __builtin_amdgcn_mfma_f32_16x16x32_bf16(*(const LAS bf16x8*)(sl + CS_RT + (row * 64 + 8 * g) * 2), xb0, acc, 0, 0, 0);
                acc = __builtin_amdgcn_mfma_f32_16x16x32_bf16(*(const LAS bf16x8*)(sl + CS_RT + (row * 64 + 32 + 8 * g) * 2), xb1, acc, 0, 0, 0);
                acc = __builtin_amdgcn_mfma_f32_16x16x32_bf16(*(const LAS bf16x8*)(sl + CS_ABR + (row * 32 + 8 * g) * 2), ub, acc, 0, 0, 0);
                Y[rt] = acc; }
#pragma unroll
            for (int kt = 0; kt < 4; ++kt) { const int row = 16 * kt + l15; f32x4 acc = xc[kt];
                acc = __builtin_amdgcn_mfma_f32_16x16x32_bf16(*(const LAS bf16x8*)(sl + CS_KC + (row * 32 + 8 * g) * 2), vop, acc, 0, 0, 0);
                acc = __builtin_amdgcn_mfma_f32_16x16x32_bf16(*(const LAS bf16x8*)(sl + CS_BC + (row * 32 + 8 * g) * 2), ub, acc, 0, 0, 0);
                xc[kt] = acc * *(const LAS f32x4*)(sl + CS_GL + (16 * kt + 4 * g) * 4); }
            LDS_WAIT();
            if (lane == 0) (void)__hip_atomic_fetch_add(done + s, 1u, __ATOMIC_RELAXED, __HIP_MEMORY_SCOPE_WORKGROUP);
#pragma unroll
            for (int rt = 0; rt < 2; ++rt)
#pragma unroll
                for (int e = 0; e < 4; ++e) { const size_t m = (size_t)b * SEQ + (size_t)c * CS_L + 16 * rt + 4 * g + e;
                    YAB[m * 2048 + 1024 + h * 64 + 16 * vb + l15] = (bf16_t)(pk2(Y[rt][e], 0.f) & 0xffffu); }
        }
    }
}

constexpr int CR_PIECE = 12, CR_NP = (CS_NCH + CR_PIECE - 1) / CR_PIECE, CR_PW = 4, CR_PSLOT = CS_SLOT + 2 * 33 * 128;
constexpr size_t DO_IMG = 66 * MiB;
static_assert((CR_PIECE % 4) == 0 && DO_IMG + (size_t)2 * 64 * CR_PIECE * CS_SLOT <= 128 * MiB && CR_PW * CR_PSLOT <= CS_FLAGS, "image buffer / producer slots");

__device__ __forceinline__ void cscan_produce(const Args& a, const int wave, LAS unsigned char* lds, const int piece, const int first, const int nblk) {
    const int nch = (CS_NCH - piece * CR_PIECE) < CR_PIECE ? (CS_NCH - piece * CR_PIECE) : CR_PIECE;
    if (wave >= CR_PW) {
        const int lane = lane_id(); const int iw = ((int)blockIdx.x - first) * (NWAVES - CR_PW) + (wave - CR_PW), niw = nblk * (NWAVES - CR_PW);
        for (int t = piece * 2 * niw + iw; t < (piece + 1) * 2 * niw && t < MTOK; t += niw) rope_item(a, t, lane);
        return; }
    const bf16_t* Rg = (const bf16_t*)(a.ws + WS_R); const bf16_t* Kg = (const bf16_t*)(a.ws + WS_K); const bf16_t* Vg = (const bf16_t*)(a.ws + WS_V);
    const bf16_t* Dg = (const bf16_t*)(a.ws + WS_DARR); const bf16_t* Ag = (const bf16_t*)(a.ws + WS_AARR);
    float* RK = (float*)((unsigned char*)a.out + DO_RK); unsigned char* IMG = (unsigned char*)a.out + DO_IMG + (size_t)(piece & 1) * 64 * CR_PIECE * CS_SLOT;
    LAS unsigned char* sl = lds + wave * CR_PSLOT;
    const LAS unsigned short* rawD = (const LAS unsigned short*)(sl + 16384); const LAS unsigned short* rawA = (const LAS unsigned short*)(sl + 20480);
    const LAS unsigned short* rawR = (const LAS unsigned short*)(sl + 24576); const LAS unsigned short* rawK = (const LAS unsigned short*)(sl + CS_SLOT); const LAS unsigned short* rawV = (const LAS unsigned short*)(sl + CS_SLOT + 33 * 128);
    u32x4 pre[5][4], prep[3];
    auto issue = [&](int it2, int rr, int c8, int lane) { const int bh2 = it2 / nch, cc2 = it2 % nch, c2 = piece * CR_PIECE + cc2; const unsigned mm = (unsigned)(bh2 >> 4) * SEQ + (unsigned)c2 * CS_L; const int hh = bh2 & 15;
        const unsigned eoff = ((mm + rr) * DM + hh * 64 + 8 * c8) * 2u;
        const unsigned char* wsb = a.ws;
#pragma unroll
        for (int ar = 0; ar < 5; ++ar) { constexpr size_t AOFF[5] = {WS_R, WS_K, WS_V, WS_DARR, WS_AARR};
#pragma unroll
            for (int q4 = 0; q4 < 4; ++q4) pre[ar][q4] = *(const u32x4*)(wsb + AOFF[ar] + eoff + (unsigned)(8 * q4 * DM * 2)); }
        const bool hasp = (c2 > 0) && (lane < 8); const unsigned poff = hasp ? (eoff - (unsigned)((rr + 1) * DM * 2)) : eoff;
#pragma unroll
        for (int ar = 0; ar < 3; ++ar) { constexpr size_t AOFF[3] = {WS_R, WS_K, WS_V}; const u32x4 t = *(const u32x4*)(wsb + AOFF[ar] + poff); prep[ar] = hasp ? t : (u32x4){0u, 0u, 0u, 0u}; } };
    const int it0 = ((int)blockIdx.x - first) * CR_PW + wave, nimg = 64 * nch, itstep = nblk * CR_PW;
    { const int l0 = lane_id(); if (it0 < nimg) issue(it0, l0 >> 3, l0 & 7, l0); }
    for (int it = it0; it < nimg; it += itstep) {
        const int lane = lane_id(), rr = lane >> 3, c8 = lane & 7, kpos = 32 * (lane >> 5) + permp(lane & 31);
        const int bh = it / nch, cc = it % nch, b = bh >> 4, h = bh & 15, c = piece * CR_PIECE + cc, gch = h * 64 + lane;
        const float mur = a.mu_rkv[gch], muk = a.mu_rkv[DM + gch], muv = a.mu_rkv[2 * DM + gch], kkw = a.rwkv_vec[2 * DM + gch], kaw = a.rwkv_vec[3 * DM + gch], rkw = a.r_k[gch];
            const size_t m0 = (size_t)b * SEQ + (size_t)c * CS_L;
            { LAS unsigned char* wb = sl + rr * 128 + 16 * c8; asm volatile("" : "+v"(wb));
#pragma unroll
              for (int q4 = 0; q4 < 4; ++q4) {
                *(LAS u32x4*)(wb + 24576 + (8 * q4 + 1) * 128) = pre[0][q4]; *(LAS u32x4*)(wb + CS_SLOT + (8 * q4 + 1) * 128) = pre[1][q4]; *(LAS u32x4*)(wb + CS_SLOT + 33 * 128 + (8 * q4 + 1) * 128) = pre[2][q4];
                *(LAS u32x4*)(wb + 16384 + (8 * q4) * 128) = pre[3][q4]; *(LAS u32x4*)(wb + 20480 + (8 * q4) * 128) = pre[4][q4]; }
              if (lane < 8) { *(LAS u32x4*)(wb + 24576) = prep[0]; *(LAS u32x4*)(wb + CS_SLOT) = prep[1]; *(LAS u32x4*)(wb + CS_SLOT + 33 * 128) = prep[2]; } }
            LDS_WAIT();
            const LAS unsigned short* rb = (const LAS unsigned short*)sl + lane; asm volatile("" : "+v"(rb));
            float rp = bflo((unsigned)rb[24576 / 2]), kp = bflo((unsigned)rb[CS_SLOT / 2]), vp = bflo((unsigned)rb[(CS_SLOT + 33 * 128) / 2]);
            float cum = 0.f, gprev = 1.f;
            unsigned bcw[16], kcw[16], vcw[16];
#pragma unroll
            for (int grp = 0; grp < 4; ++grp) {
                float rlv[8], kkrv[8], kprv[8], vlv[8], aav[8], ddv[8], red[16];
#pragma unroll
                for (int e = 0; e < 8; ++e) { const int row = 8 * grp + e;
                    const float r0 = bflo((unsigned)rb[24576 / 2 + (row + 1) * 64]), k0 = bflo((unsigned)rb[CS_SLOT / 2 + (row + 1) * 64]), v0 = bflo((unsigned)rb[(CS_SLOT + 33 * 128) / 2 + (row + 1) * 64]);
                    ddv[e] = bflo((unsigned)rb[16384 / 2 + row * 64]); aav[e] = bflo((unsigned)rb[20480 / 2 + row * 64]);
                    rlv[e] = r0 + (rp - r0) * mur; const float kl = k0 + (kp - k0) * muk; vlv[e] = v0 + (vp - v0) * muv; rp = r0; kp = k0; vp = v0;
                    kkrv[e] = kl * kkw; kprv[e] = kl * (1.0f + (aav[e] - 1.0f) * kaw);
                    red[2 * e] = kkrv[e] * kkrv[e]; red[2 * e + 1] = rlv[e] * kprv[e] * rkw; }
#pragma unroll
                for (int e = 0; e < 16; ++e) red[e] += dppf<0xB1, 0xf>(red[e]);
#pragma unroll
                for (int e = 0; e < 16; ++e) red[e] += dppf<0x4E, 0xf>(red[e]);
#pragma unroll
                for (int e = 0; e < 16; ++e) red[e] += dppf<0x141, 0xf>(red[e]);
#pragma unroll
                for (int e = 0; e < 16; ++e) red[e] += dppf<0x140, 0xf>(red[e]);
#pragma unroll
                for (int e = 0; e < 16; ++e) red[e] += dppf<0x142, 0xa>(red[e]);
#pragma unroll
                for (int e = 0; e < 16; ++e) red[e] += dppf<0x143, 0xc>(red[e]);
#pragma unroll
                for (int e = 0; e < 16; ++e) red[e] = __int_as_float(__builtin_amdgcn_readlane(__float_as_int(red[e]), 63));
                if (lane < 8) { float rkv = red[1];
#pragma unroll
                    for (int e = 1; e < 8; ++e) rkv = (lane == e) ? red[2 * e + 1] : rkv;
                    RK[(m0 + 8 * grp + lane) * 16 + h] = rkv; }
#pragma unroll
                for (int j2 = 0; j2 < 4; ++j2) {
                    const int i2 = 4 * grp + j2;
                    float nt[2], bt[2], kt[2], rt[2], vt[2];
#pragma unroll
                    for (int e = 0; e < 2; ++e) { const int te = 2 * j2 + e;
                        const float kkv = kkrv[te] * __builtin_amdgcn_rsqf(fmaxf(red[2 * te], 1e-24f)), bb = kkv * aav[te];
                        cum += ddv[te]; const float gi = __expf(-cum), ginv = __builtin_amdgcn_rcpf(gi);
                        nt[e] = -kkv * gprev; bt[e] = bb * ginv; kt[e] = kprv[te] * ginv; rt[e] = rlv[te] * gi; vt[e] = vlv[te]; gprev = gi; }
                    const unsigned wn = pk2(nt[0], nt[1]), wb = pk2(bt[0], bt[1]), wk = pk2(kt[0], kt[1]), wr = pk2(rt[0], rt[1]), wv = pk2(vt[0], vt[1]);
                    const int i = 2 * i2;
                    *(LAS unsigned short*)(sl + CS_NT + (i * 64 + kpos) * 2) = (unsigned short)wn; *(LAS unsigned short*)(sl + CS_NT + ((i + 1) * 64 + kpos) * 2) = (unsigned short)(wn >> 16);
                    *(LAS unsigned short*)(sl + CS_RT + (i * 64 + kpos) * 2) = (unsigned short)wr; *(LAS unsigned short*)(sl + CS_RT + ((i + 1) * 64 + kpos) * 2) = (unsigned short)(wr >> 16);
                    *(LAS unsigned short*)(sl + CS_BT + (i * 64 + kpos) * 2) = (unsigned short)wb; *(LAS unsigned short*)(sl + CS_BT + ((i + 1) * 64 + kpos) * 2) = (unsigned short)(wb >> 16);
                    *(LAS unsigned short*)(sl + CS_KT + (i * 64 + kpos) * 2) = (unsigned short)wk; *(LAS unsigned short*)(sl + CS_KT + ((i + 1) * 64 + kpos) * 2) = (unsigned short)(wk >> 16);
                    const int pw = permp(i) >> 1;
                    bcw[pw] = wb; kcw[pw] = wk; vcw[pw] = wv;
                }
                __builtin_amdgcn_sched_barrier(0);
            }
#pragma unroll
            for (int q4 = 0; q4 < 4; ++q4) {
                *(LAS u32x4*)(sl + CS_BC + lane * 64 + 16 * q4) = (u32x4){bcw[4 * q4], bcw[4 * q4 + 1], bcw[4 * q4 + 2], bcw[4 * q4 + 3]};
                *(LAS u32x4*)(sl + CS_KC + lane * 64 + 16 * q4) = (u32x4){kcw[4 * q4], kcw[4 * q4 + 1], kcw[4 * q4 + 2], kcw[4 * q4 + 3]};
                *(LAS u32x4*)(sl + CS_VC + lane * 64 + 16 * q4) = (u32x4){vcw[4 * q4], vcw[4 * q4 + 1], vcw[4 * q4 + 2], vcw[4 * q4 + 3]}; }
            *(LAS float*)(sl + CS_GL + lane * 4) = gprev;
            LDS_WAIT();
            const int tok = lane & 31, hf = lane >> 5;
            bf16x8 fn[4], fr[4], fb[4], fk[4];
#pragma unroll
            for (int ks = 0; ks < 4; ++ks) { fn[ks] = *(const LAS bf16x8*)(sl + CS_NT + (tok * 64 + 16 * ks + 8 * hf) * 2); fr[ks] = *(const LAS bf16x8*)(sl + CS_RT + (tok * 64 + 16 * ks + 8 * hf) * 2);
                fb[ks] = *(const LAS bf16x8*)(sl + CS_BT + (tok * 64 + 16 * ks + 8 * hf) * 2); fk[ks] = *(const LAS bf16x8*)(sl + CS_KT + (tok * 64 + 16 * ks + 8 * hf) * 2); }
            f32x16 P, Pt, Tm, Akn, Abr, Akr;
#pragma unroll
            for (int e = 0; e < 16; ++e) { P[e] = 0.f; Pt[e] = 0.f; Akn[e] = 0.f; Abr[e] = 0.f; Akr[e] = 0.f; }
#pragma unroll
            for (int ks = 0; ks < 4; ++ks) { P = __builtin_amdgcn_mfma_f32_32x32x16_bf16(fn[ks], fb[ks], P, 0, 0, 0); Pt = __builtin_amdgcn_mfma_f32_32x32x16_bf16(fb[ks], fn[ks], Pt, 0, 0, 0);
                Akn = __builtin_amdgcn_mfma_f32_32x32x16_bf16(fn[ks], fk[ks], Akn, 0, 0, 0); Abr = __builtin_amdgcn_mfma_f32_32x32x16_bf16(fr[ks], fb[ks], Abr, 0, 0, 0); Akr = __builtin_amdgcn_mfma_f32_32x32x16_bf16(fr[ks], fk[ks], Akr, 0, 0, 0); }
#pragma unroll
            for (int e = 0; e < 16; ++e) { const int row = (e & 3) + 8 * (e >> 2) + 4 * hf, col = tok;
                if (!(col < row)) { P[e] = 0.f; Akn[e] = 0.f; } if (!(row < col)) Pt[e] = 0.f; if (col > row) { Abr[e] = 0.f; Akr[e] = 0.f; }
                Tm[e] = P[e] + (row == col ? 1.0f : 0.f); }
#pragma unroll
            for (int mm = 1; mm <= 4; ++mm) {
                const bf16x8 p0 = cfrag(P, 0), p1 = cfrag(P, 1), q0 = cfrag(Pt, 0), q1 = cfrag(Pt, 1);
                f32x16 Ptn, Pn;
#pragma unroll
                for (int e = 0; e < 16; ++e) { Ptn[e] = 0.f; Pn[e] = 0.f; }
                Ptn = __builtin_amdgcn_mfma_f32_32x32x16_bf16(p0, q0, Ptn, 0, 0, 0); Ptn = __builtin_amdgcn_mfma_f32_32x32x16_bf16(p1, q1, Ptn, 0, 0, 0);
                if (mm < 4) { Pn = __builtin_amdgcn_mfma_f32_32x32x16_bf16(q0, p0, Pn, 0, 0, 0); Pn = __builtin_amdgcn_mfma_f32_32x32x16_bf16(q1, p1, Pn, 0, 0, 0); }
                const bf16x8 t0 = cfrag(Tm, 0), t1 = cfrag(Tm, 1), u0 = cfrag(Ptn, 0), u1 = cfrag(Ptn, 1);
                Tm = __builtin_amdgcn_mfma_f32_32x32x16_bf16(u0, t0, Tm, 0, 0, 0); Tm = __builtin_amdgcn_mfma_f32_32x32x16_bf16(u1, t1, Tm, 0, 0, 0);
                P = Pn; Pt = Ptn;
            }
            { const int itn = it + itstep; if (itn < nimg) { const int l2 = lane_id(); issue(itn, l2 >> 3, l2 & 7, l2); } }
            { const int pc = permp(tok);
#pragma unroll
              for (int e = 0; e < 16; e += 2) { const int row = (e & 3) + 8 * (e >> 2) + 4 * hf;
                const unsigned w0 = pk2(Tm[e], Tm[e + 1]), w1 = pk2(Akn[e], Akn[e + 1]), w2 = pk2(Abr[e], Abr[e + 1]), w3 = pk2(Akr[e], Akr[e + 1]);
                *(LAS unsigned short*)(sl + CS_TM + (row * 32 + pc) * 2) = (unsigned short)w0; *(LAS unsigned short*)(sl + CS_TM + ((row + 1) * 32 + pc) * 2) = (unsigned short)(w0 >> 16);
                *(LAS unsigned short*)(sl + CS_AKN + (row * 32 + pc) * 2) = (unsigned short)w1; *(LAS unsigned short*)(sl + CS_AKN + ((row + 1) * 32 + pc) * 2) = (unsigned short)(w1 >> 16);
                *(LAS unsigned short*)(sl + CS_ABR + (row * 32 + pc) * 2) = (unsigned short)w2; *(LAS unsigned short*)(sl + CS_ABR + ((row + 1) * 32 + pc) * 2) = (unsigned short)(w2 >> 16);
                *(LAS unsigned short*)(sl + CS_AKR + (row * 32 + pc) * 2) = (unsigned short)w3; *(LAS unsigned short*)(sl + CS_AKR + ((row + 1) * 32 + pc) * 2) = (unsigned short)(w3 >> 16); } }
            LDS_WAIT();
            { unsigned char* dst = IMG + (size_t)(bh * CR_PIECE + cc) * CS_SLOT;
#pragma unroll 1
              for (int j = lane; j < CS_SLOT / 16; j += 64) *(u32x4*)(dst + 16 * j) = *(const LAS u32x4*)(sl + 16 * j); }
            LDS_WAIT();
    }
}

__device__ __forceinline__ void cscan_consume(const Args& a, const int wave, LAS unsigned char* lds, const int bh, const int piece, f32x4 (&xc)[4]) {
    const int lane = lane_id();
    const int b = bh >> 4, h = bh & 15;
    bf16_t* YAB = (bf16_t*)(a.ws + WS_YAB); const unsigned char* IMG = (const unsigned char*)a.out + DO_IMG + (size_t)(piece & 1) * 64 * CR_PIECE * CS_SLOT;
    const int nch = (CS_NCH - piece * CR_PIECE) < CR_PIECE ? (CS_NCH - piece * CR_PIECE) : CR_PIECE;
    LAS unsigned* ready = (LAS unsigned*)(lds + CS_FLAGS); LAS unsigned* done = ready + 4;
    if (wave == 4) {
        constexpr int NI = (CS_SLOT + 1023) / 1024;
        for (int cc = 0; cc <= nch; ++cc) {
            if (cc < nch) { const int c = piece * CR_PIECE + cc, s = cc & 3; LAS unsigned char* sl = lds + s * CS_SLOT;
                const unsigned char* src = IMG + (size_t)(bh * CR_PIECE + cc) * CS_SLOT;
                if (c >= 4) lds_poll_ge(done + s, 4u * (unsigned)(c >> 2));
#pragma unroll
                for (int j = 0; j < NI; ++j) { const int idx = lane + 64 * j;
                    if (idx < CS_SLOT / 16) __builtin_amdgcn_global_load_lds((const unsigned*)(src + 16 * idx), (LAS unsigned*)(sl + 1024 * j), 16, 0, 0); } }
            if (cc >= 1) {
                if (cc < nch) asm volatile("s_waitcnt vmcnt(29)" ::: "memory"); else asm volatile("s_waitcnt vmcnt(0)" ::: "memory");
                if (lane == 0) __hip_atomic_store(ready + ((cc - 1) & 3), (unsigned)(piece * CR_PIECE + cc), __ATOMIC_RELAXED, __HIP_MEMORY_SCOPE_WORKGROUP); }
        }
    } else if (wave < 4) {
        const int l15 = lane & 15, g = lane >> 4, vb = wave;
        for (int cc = 0; cc < nch; ++cc) { const int c = piece * CR_PIECE + cc, s = cc & 3; const LAS unsigned char* sl = lds + s * CS_SLOT;
            { lds_poll_ge(ready + s, (unsigned)(c + 1)); }
            const bf16x8 xb0 = cfrag2(xc[0], xc[1]), xb1 = cfrag2(xc[2], xc[3]);
            const bf16x8 vop = *(const LAS bf16x8*)(sl + CS_VC + ((16 * vb + l15) * 32 + 8 * g) * 2);
            f32x4 W[2], U[2], Y[2];
#pragma unroll
            for (int rt = 0; rt < 2; ++rt) { const int row = 16 * rt + l15; f32x4 acc = (f32x4){0.f, 0.f, 0.f, 0.f};
                acc = __builtin_amdgcn_mfma_f32_16x16x32_bf16(*(const LAS bf16x8*)(sl + CS_AKN + (row * 32 + 8 * g) * 2), vop, acc, 0, 0, 0);
                acc = __builtin_amdgcn_mfma_f32_16x16x32_bf16(*(const LAS bf16x8*)(sl + CS_NT + (row * 64 + 8 * g) * 2), xb0, acc, 0, 0, 0);
                acc = __builtin_amdgcn_mfma_f32_16x16x32_bf16(*(const LAS bf16x8*)(sl + CS_NT + (row * 64 + 32 + 8 * g) * 2), xb1, acc, 0, 0, 0);
                W[rt] = acc; }
            const bf16x8 wb = cfrag2(W[0], W[1]);
#pragma unroll
            for (int rt = 0; rt < 2; ++rt) { const int row = 16 * rt + l15;
                U[rt] = __builtin_amdgcn_mfma_f32_16x16x32_bf16(*(const LAS bf16x8*)(sl + CS_TM + (row * 32 + 8 * g) * 2), wb, (f32x4){0.f, 0.f, 0.f, 0.f}, 0, 0, 0); }
            const bf16x8 ub = cfrag2(U[0], U[1]);
#pragma unroll
            for (int rt = 0; rt < 2; ++rt) { const int row = 16 * rt + l15; f32x4 acc = (f32x4){0.f, 0.f, 0.f, 0.f};
                acc = __builtin_amdgcn_mfma_f32_16x16x32_bf16(*(const LAS bf16x8*)(sl + CS_AKR + (row * 32 + 8 * g) * 2), vop, acc, 0, 0, 0);
                acc = __builtin_amdgcn_mfma_f32_16x16x32_bf16(*(const LAS bf16x8*)(sl + CS_RT + (row * 64 + 8 * g) * 2), xb0, acc, 0, 0, 0);
                acc = __builtin_amdgcn_mfma_f32_16x16x32_bf16(*(const LAS bf16x8*)(sl + CS_RT + (row * 64 + 32 + 8 * g) * 2), xb1, acc, 0, 0, 0);
                acc = __builtin_amdgcn_mfma_f32_16x16x32_bf16(*(const LAS bf16x8*)(sl + CS_ABR + (row * 32 + 8 * g) * 2), ub, acc, 0, 0, 0);
                Y[rt] = acc; }
#pragma unroll
            for (int kt = 0; kt < 4; ++kt) { const int row = 16 * kt + l15; f32x4 acc = xc[kt];
                acc = __builtin_amdgcn_mfma_f32_16x16x32_bf16(*(const LAS bf16x8*)(sl + CS_KC + (row * 32 + 8 * g) * 2), vop, acc, 0, 0, 0);
                acc = __builtin_amdgcn_mfma_f32_16x16x32_bf16(*(const LAS bf16x8*)(sl + CS_BC + (row * 32 + 8 * g) * 2), ub, acc, 0, 0, 0);
                xc[kt] = acc * *(const LAS f32x4*)(sl + CS_GL + (16 * kt + 4 * g) * 4); }
            LDS_WAIT();
            if (lane == 0) (void)__hip_atomic_fetch_add(done + s, 1u, __ATOMIC_RELAXED, __HIP_MEMORY_SCOPE_WORKGROUP);
#pragma unroll
            for (int rt = 0; rt < 2; ++rt)
#pragma unroll
                for (int e = 0; e < 4; ++e) { const size_t m = (size_t)b * SEQ + (size_t)c * CS_L + 16 * rt + 4 * g + e;
                    YAB[m * 2048 + 1024 + h * 64 + 16 * vb + l15] = (bf16_t)(pk2(Y[rt][e], 0.f) & 0xffffu); }
        }
    }
}

constexpr int DS_NQ = 16, DS_CAP = 2048, DS_TRIG = 1536, DS_TOPK = 256;
constexpr int DS_HIST_WORDS = 320;
constexpr int DS_CAND_OFF = 0, DS_HIST_OFF = DS_NQ * DS_CAP * 4, DS_CNT_OFF = DS_HIST_OFF + 8 * DS_HIST_WORDS * 4, DS_TAU_OFF = DS_CNT_OFF + 64;
static_assert(DS_TAU_OFF + 64 <= LDS_BYTES, "dsa LDS map");

template <int CTRL, int RM> __device__ __forceinline__ unsigned dppu(unsigned x) { return (unsigned)__builtin_amdgcn_update_dpp(0, (int)x, CTRL, RM, 0xf, true); }
__device__ __forceinline__ unsigned wave_scan_incl(unsigned v) {
    v += dppu<0x111, 0xf>(v); v += dppu<0x112, 0xf>(v); v += dppu<0x114, 0xf>(v); v += dppu<0x118, 0xf>(v);
    v += dppu<0x142, 0xa>(v);
    v += dppu<0x143, 0xc>(v);
    return v; }
template <int NE>
__device__ __forceinline__ void select_compact(LAS unsigned* cq, LAS unsigned* cntq, LAS unsigned* tauq, LAS unsigned* hist, int lane) {
    const unsigned n = *cntq;
    unsigned e[NE];
#pragma unroll
    for (int j = 0; j < NE; ++j) { const unsigned idx = lane + 64 * j; e[j] = idx < n ? cq[idx] : 0u; }
    unsigned npos = 0u;
#pragma unroll
    for (int j = 0; j < NE; ++j) npos += (unsigned)__popcll(__ballot(e[j] >= 0x80000000u));
    if (npos >= (unsigned)DS_TOPK) {
#pragma unroll
        for (int j = 0; j < NE; ++j) e[j] = (e[j] >= 0x80000000u) ? e[j] : 0u; }
    unsigned va = 0xFFFFFFFFu, vo = 0u;
#pragma unroll
    for (int j = 0; j < NE; ++j) { va &= (e[j] != 0u) ? e[j] : 0xFFFFFFFFu; vo |= e[j]; }
    va &= (unsigned)__builtin_amdgcn_update_dpp(-1, (int)va, 0xB1, 0xf, 0xf, true); va &= (unsigned)__builtin_amdgcn_update_dpp(-1, (int)va, 0x4E, 0xf, 0xf, true);
    va &= (unsigned)__builtin_amdgcn_update_dpp(-1, (int)va, 0x141, 0xf, 0xf, true); va &= (unsigned)__builtin_amdgcn_update_dpp(-1, (int)va, 0x140, 0xf, 0xf, true);
    vo |= dppu<0xB1, 0xf>(vo); vo |= dppu<0x4E, 0xf>(vo); vo |= dppu<0x141, 0xf>(vo); vo |= dppu<0x140, 0xf>(vo);
    const unsigned vas = (unsigned)(__builtin_amdgcn_readlane((int)va, 0) & __builtin_amdgcn_readlane((int)va, 16) & __builtin_amdgcn_readlane((int)va, 32) & __builtin_amdgcn_readlane((int)va, 48));
    const unsigned vos = (unsigned)(__builtin_amdgcn_readlane((int)vo, 0) | __builtin_amdgcn_readlane((int)vo, 16) | __builtin_amdgcn_readlane((int)vo, 32) | __builtin_amdgcn_readlane((int)vo, 48));
    const unsigned diff = vas ^ vos;
    const int top = diff ? 31 - __builtin_clz(diff) : 7;
    unsigned prefix = (top >= 31) ? 0u : (vos & ~((2u << top) - 1u)), mask = (top >= 31) ? 0u : ~((2u << top) - 1u), need = DS_TOPK;
    int hi = top;
    const int rl = 63 - lane;
#pragma unroll 1
    for (int pass = 0; pass < 4 && hi >= 0; ++pass) {
        const int shift = hi >= 7 ? hi - 7 : 0; const unsigned dmask = (hi >= 7) ? 0xFFu : ((2u << hi) - 1u);
        *(LAS u32x4*)(hist + 4 * lane) = (u32x4){0u, 0u, 0u, 0u};
        LDS_WAIT();
#pragma unroll
        for (int j = 0; j < NE; ++j) { const bool hit = (e[j] != 0u) && ((e[j] & mask) == prefix); const unsigned bin = hit ? ((e[j] >> shift) & dmask) : (256u + (unsigned)lane);
            (void)__hip_atomic_fetch_add(hist + bin, 1u, __ATOMIC_RELAXED, __HIP_MEMORY_SCOPE_WORKGROUP); }
        LDS_WAIT();
        const u32x4 h4 = *(const LAS u32x4*)(hist + 4 * rl);
        const unsigned tot = (h4.x + h4.y) + (h4.z + h4.w);
        const unsigned v = wave_scan_incl(tot);
        const unsigned above = v - tot;
        const bool is = (above < need) && (need <= v);
        unsigned B = 0u, ca = 0u;
        if (is) { unsigned c = above;
            if (c + h4.w >= need) { B = 4 * rl + 3; ca = c; } else { c += h4.w;
            if (c + h4.z >= need) { B = 4 * rl + 2; ca = c; } else { c += h4.z;
            if (c + h4.y >= need) { B = 4 * rl + 1; ca = c; } else { c += h4.y; B = 4 * rl; ca = c; } } } }
        const unsigned long long bal = __ballot(is);
        if (bal == 0ull) break;
        const int src = __builtin_amdgcn_readfirstlane(__ffsll((long long)bal) - 1);
        B = (unsigned)__builtin_amdgcn_readlane((int)B, src); ca = (unsigned)__builtin_amdgcn_readlane((int)ca, src);
        need -= ca; prefix |= B << shift; mask |= dmask << shift; hi = shift - 1;
    }
    const unsigned T = prefix;
    unsigned base = 0u;
#pragma unroll
    for (int j = 0; j < NE; ++j) { const bool keep = (e[j] >= T) && (e[j] != 0u); const unsigned long long bal = __ballot(keep);
        const unsigned pos = base + __builtin_amdgcn_mbcnt_hi((unsigned)(bal >> 32), __builtin_amdgcn_mbcnt_lo((unsigned)bal, 0u));
        if (keep) cq[pos] = e[j];
        base += (unsigned)__popcll(bal); }
    if (lane == 0) { *cntq = base; *tauq = T; }
    LDS_WAIT();
}

template <int NE>
__device__ __forceinline__ void filter_compact(LAS unsigned* cq, LAS unsigned* cntq, LAS unsigned* tauq, int lane) {
    const unsigned n = *cntq;
    unsigned e[NE];
#pragma unroll
    for (int j = 0; j < NE; ++j) { const unsigned idx = lane + 64 * j; e[j] = idx < n ? cq[idx] : 0u; }
    unsigned m0 = 0u, m1 = 0u, m2 = 0u, m3 = 0u;
#pragma unroll
    for (int j = 0; j < NE; ++j) { unsigned x = e[j], t;
        t = max(m0, x); x = min(m0, x); m0 = t; t = max(m1, x); x = min(m1, x); m1 = t; t = max(m2, x); x = min(m2, x); m2 = t; m3 = max(m3, x); }
    unsigned T = m3;
    T = min(T, (unsigned)__builtin_amdgcn_update_dpp(-1, (int)T, 0xB1, 0xf, 0xf, true)); T = min(T, (unsigned)__builtin_amdgcn_update_dpp(-1, (int)T, 0x4E, 0xf, 0xf, true));
    T = min(T, (unsigned)__builtin_amdgcn_update_dpp(-1, (int)T, 0x141, 0xf, 0xf, true)); T = min(T, (unsigned)__builtin_amdgcn_update_dpp(-1, (int)T, 0x140, 0xf, 0xf, true));
    T = min(min((unsigned)__builtin_amdgcn_readlane((int)T, 0), (unsigned)__builtin_amdgcn_readlane((int)T, 16)), min((unsigned)__builtin_amdgcn_readlane((int)T, 32), (unsigned)__builtin_amdgcn_readlane((int)T, 48)));
    unsigned base = 0u;
#pragma unroll
    for (int j = 0; j < NE; ++j) { const bool keep = (e[j] >= T) && (e[j] != 0u); const unsigned long long bal = __ballot(keep);
        const unsigned pos = base + __builtin_amdgcn_mbcnt_hi((unsigned)(bal >> 32), __builtin_amdgcn_mbcnt_lo((unsigned)bal, 0u));
        if (keep) cq[pos] = e[j];
        base += (unsigned)__popcll(bal); }
    if (lane == 0) { *cntq = base; *tauq = (T > 0u) ? T - 1u : 0u; }
    LDS_WAIT();
}

__device__ __forceinline__ unsigned vrow_off(int pr) { return (unsigned)(pr < 28 ? 1024 + 256 * pr : 9216 + 256 * (pr - 28)); }
__device__ __forceinline__ unsigned swz_b(int row) { return (unsigned)(((row & 3) << 2) | ((row >> 2) & 3)); }

__device__ __forceinline__ void dsa_phase(const Args& a, const int wave, LAS unsigned char* lds, const bool dry = false) {
    const bf16_t* Qg = (const bf16_t*)(a.ws + WS_Q); const bf16_t* KVg = (const bf16_t*)(a.ws + WS_KV); const bf16_t* QIg = (const bf16_t*)(a.ws + WS_QI);
    const bf16_t* KIg = (const bf16_t*)(a.ws + WS_KI); const float* WIg = (const float*)(a.ws + WS_WI); bf16_t* Gg = (bf16_t*)(a.ws + WS_G);
    LAS unsigned* cand = (LAS unsigned*)(lds + DS_CAND_OFF); LAS unsigned* hist = (LAS unsigned*)(lds + DS_HIST_OFF) + wave * DS_HIST_WORDS;
    LAS unsigned* cnt = (LAS unsigned*)(lds + DS_CNT_OFF); LAS unsigned* taup = (LAS unsigned*)(lds + DS_TAU_OFF);
    for (int L = blockIdx.x; L < 2048; L += gridDim.x) {
        int lane; asm volatile("v_mbcnt_lo_u32_b32 %0, -1, 0\n\tv_mbcnt_hi_u32_b32 %0, -1, %0" : "=v"(lane));
        const int tid = wave * 64 + lane, ql = lane & 15, gq = lane >> 4;
        int b, j;
        if (gridDim.x == 256) { const int i = blockIdx.x, ui = L >> 8, x = i & 7, li = (i >> 3) * 2 + (x >> 2); b = x & 3; j = 128 * (ui >> 1) + ((ui & 1) ? 127 - li : li); }
        else { b = L >> 9; j = L & 511; }
        const unsigned mb = (unsigned)b * SEQ; const int q0 = DS_NQ * j; const unsigned mq = mb + q0 + ql;
        const int pos0 = a.pos[mb]; int nadm = ((a.pos[mq] >> 6) + 1) * 64 - pos0; nadm = nadm > SEQ ? SEQ : nadm;
        int nmax = ((a.pos[mb + q0 + DS_NQ - 1] >> 6) + 1) * 64 - pos0; nmax = nmax > SEQ ? SEQ : nmax;
        const int nstep = (nmax + 511) >> 9;
#ifdef DSA_REP_STREAM
        for (int srep_ = 0; srep_ < 2; ++srep_) {
#endif
        __syncthreads();
        if (tid < DS_NQ) { cnt[tid] = 0u; taup[tid] = 0u; }
        bf16x8 bq[8][2];
#pragma unroll
        for (int h = 0; h < 8; ++h)
#pragma unroll
            for (int ks = 0; ks < 2; ++ks) bq[h][ks] = *(const bf16x8*)(QIg + (mq * 512u + h * 64 + 32 * ks + 8 * gq));
        f32x2 wh[8]; { const f32x4 w0 = *(const f32x4*)(WIg + mq * 8), w1 = *(const f32x4*)(WIg + mq * 8 + 4);
#pragma unroll
            for (int h = 0; h < 4; ++h) { wh[h] = (f32x2){w0[h], w0[h]}; wh[4 + h] = (f32x2){w1[h], w1[h]}; } }
        __syncthreads();
        bf16x8 ka[4][2];
        { const bf16_t* kr = KIg + ((mb + 64 * wave + ql) * 64u + 8u * gq);
#pragma unroll
          for (int st = 0; st < 4; ++st)
#pragma unroll
            for (int ks = 0; ks < 2; ++ks) ka[st][ks] = *(const bf16x8*)(kr + st * 16 * 64 + 32 * ks); }
        for (int step = 0; step <= nstep; ++step) {
            const int kb = 512 * step + 64 * wave; const bool active = (kb < nmax) && (step < nstep);
            PROBE_BEGIN(2, a.ws, wave);
            if (active) {
                f32x2 sc2[8];
#ifdef DSA_SCORE2
                for (int srep2_ = 0; srep2_ < 2; ++srep2_) {
#endif
#pragma unroll
                for (int i = 0; i < 8; ++i) sc2[i] = (f32x2){0.f, 0.f};
#pragma unroll
                for (int h = 0; h < 8; ++h)
#pragma unroll
                    for (int st = 0; st < 4; ++st) { f32x4 acc = (f32x4){0.f, 0.f, 0.f, 0.f};
#pragma unroll
                        for (int ks = 0; ks < 2; ++ks) acc = __builtin_amdgcn_mfma_f32_16x16x32_bf16(ka[st][ks], bq[h][ks], acc, 0, 0, 0);
                        sc2[2 * st] += wh[h] * (f32x2){fmaxf(acc[0], 0.f), fmaxf(acc[1], 0.f)}; sc2[2 * st + 1] += wh[h] * (f32x2){fmaxf(acc[2], 0.f), fmaxf(acc[3], 0.f)};
                        if (st == 3 && (h & 1)) __builtin_amdgcn_sched_barrier(0); }
#ifdef DSA_SCORE2
#pragma unroll
                for (int i = 0; i < 8; ++i) asm volatile("" : "+v"(sc2[i]));
                }
#endif
                float sc[16];
#pragma unroll
                for (int i = 0; i < 8; ++i) { sc[2 * i] = sc2[i][0]; sc[2 * i + 1] = sc2[i][1]; }
                __builtin_amdgcn_sched_barrier(0);
                { const int kbn = (kb + 512 < SEQ) ? kb + 512 : kb; unsigned ko0 = (mb + kbn + ql) * 64u + 8u * gq, ko1 = ko0 + 2048u;
                  asm volatile("" : "+v"(ko0), "+v"(ko1));
#pragma unroll
                  for (int st = 0; st < 4; ++st)
#pragma unroll
                    for (int ks = 0; ks < 2; ++ks) ka[st][ks] = *(const bf16x8*)(KIg + ((st & 2) ? ko1 : ko0) + (st & 1) * 16 * 64 + 32 * ks); }
                const unsigned tp = taup[ql]; unsigned pm = 0u;
#pragma unroll
                for (int i = 0; i < 16; ++i) { const int key = kb + 16 * (i >> 2) + 4 * gq + (i & 3); const unsigned u = __float_as_uint(sc[i]);
                    const unsigned ord = (u & 0x80000000u) ? ~u : (u | 0x80000000u); const unsigned pk = (ord & 0xFFFFE000u) | (unsigned)key;
                    sc[i] = __uint_as_float(pk);
                    if (key < nadm && pk > tp) pm |= 1u << i; }
                const unsigned n = (unsigned)__popc(pm);
                unsigned k = 0u; if (n) k = __hip_atomic_fetch_add(cnt + ql, n, __ATOMIC_RELAXED, __HIP_MEMORY_SCOPE_WORKGROUP);
                LAS unsigned* cq = cand + ql * DS_CAP;
#pragma unroll
                for (int i = 0; i < 16; ++i) if (pm & (1u << i)) { cq[k] = __float_as_uint(sc[i]); ++k; }
            }
            __syncthreads();
            PROBE_END(2, a.ws, wave);
            const u32x4 c0 = *(const LAS u32x4*)(cnt), c1 = *(const LAS u32x4*)(cnt + 4), c2 = *(const LAS u32x4*)(cnt + 8), c3 = *(const LAS u32x4*)(cnt + 12);
            unsigned cm = max(max(max(c0.x, c0.y), max(c0.z, c0.w)), max(max(c1.x, c1.y), max(c1.z, c1.w)));
            cm = max(cm, max(max(max(c2.x, c2.y), max(c2.z, c2.w)), max(max(c3.x, c3.y), max(c3.z, c3.w))));
            const unsigned trig = (step == nstep) ? (unsigned)DS_TOPK : (unsigned)DS_TRIG;
#ifdef DSA_SEL2
            const int nsel = (step == nstep) ? 4 : 2;
#else
            const int nsel = 2;
#endif
            if (cm > trig) {
                PROBE_BEGIN(1, a.ws, wave);
#pragma unroll 1
                for (int qq = 0; qq < nsel; ++qq) { const int q = 2 * wave + (qq & 1); if (cnt[q] > trig || qq >= 2) {
                    if (step != nstep) filter_compact<32>(cand + q * DS_CAP, cnt + q, taup + q, lane);
                    if (step == nstep || cnt[q] > (unsigned)DS_TRIG) select_compact<32>(cand + q * DS_CAP, cnt + q, taup + q, hist, lane); } }
                __syncthreads();
                PROBE_END(1, a.ws, wave);
            }
        }
#ifdef DSA_REP_STREAM
        }
#endif
        const bf16_t* KVb = KVg + (size_t)mb * 256;
        int lane_a = lane; asm volatile("" : "+v"(lane_a));
        const int g16 = lane_a >> 4, l15 = lane_a & 15;
        const unsigned vbase = (unsigned)(size_t)(lds + DS_CAND_OFF) + (unsigned)wave * 16384u;
        unsigned ta0, ta1;
        { const int q = l15 >> 2, p = lane_a & 3; const int pr0 = 8 * g16 + q, pr1 = pr0 + 4;
          ta0 = vbase + vrow_off(pr0) + 16u * ((unsigned)(p >> 1) ^ swz_b(pr0)) + 8u * (unsigned)(p & 1);
          ta1 = vbase + vrow_off(pr1) + 16u * ((unsigned)(p >> 1) ^ swz_b(pr1)) + 8u * (unsigned)(p & 1); }
        const unsigned kwa = vbase + 10240u + (unsigned)(4 * g16) * 256u + (unsigned)((l15 ^ (4 * g16)) << 4);
        const unsigned kra = vbase + 10240u + (unsigned)l15 * 256u + (unsigned)((g16 ^ l15) << 4);
        unsigned vwa[8];
#pragma unroll
        for (int j2 = 0; j2 < 8; ++j2) { const int srow = 4 * j2 + g16; const int pr = (srow < 16) ? 8 * (srow >> 2) + (srow & 3) : 8 * ((srow - 16) >> 2) + 4 + (srow & 3);
            vwa[j2] = vbase + vrow_off(pr) + 16u * ((unsigned)l15 ^ swz_b(pr)); }
#ifdef DSA_REP_ATT
        for (int arep_ = 0; arep_ < 2; ++arep_) { const bool dry2 = dry || (arep_ == 0 && a.ph_hi > 0);
#else
        { const bool dry2 = dry;
#endif
#pragma unroll 1
        for (int qq = 0; qq < 2; ++qq) {
            const int q = 2 * wave + qq; const unsigned m = mb + q0 + q; const int n = (int)cnt[q]; const LAS unsigned* cq = cand + q * DS_CAP;
            bf16x8 qb[4];
#pragma unroll
            for (int ks = 0; ks < 4; ++ks) qb[ks] = *(const bf16x8*)(Qg + (m * 2048u + l15 * 128 + 32 * ks + 8 * g16));
            f32x4 sacc[16];
            const int nl = n - l15; const LAS unsigned* cql = cq + l15;
            u32x4 kr[5][4];
            auto kload = [&](int jt, u32x4 (&dst)[4]) { const u32x4 e4 = *(const LAS u32x4*)(cq + 16 * jt + 4 * g16);
#pragma unroll
                for (int i = 0; i < 4; ++i) dst[i] = *(const u32x4*)(KVb + ((e4[i] & 0x1FFFu) * 256u + 8u * l15)); };
            kload(0, kr[0]); kload(1, kr[1]); kload(2, kr[2]); kload(3, kr[3]);
#pragma unroll
            for (int jt = 0; jt < 16; ++jt) {
                if (jt + 4 < 16) kload(jt + 4, kr[(jt + 4) % 5]);
#pragma unroll
                for (int i = 0; i < 4; ++i) *(LAS u32x4*)(size_t)(kwa ^ (unsigned)((i << 8) | (i << 4))) = kr[jt % 5][i];
                LDS_WAIT();
                bf16x8 fa[4];
#pragma unroll
                for (int ks = 0; ks < 4; ++ks) fa[ks] = *(const LAS bf16x8*)(size_t)(kra ^ (unsigned)(ks << 6));
                f32x4 acc = (f32x4){0.f, 0.f, 0.f, 0.f};
#pragma unroll
                for (int ks = 0; ks < 4; ++ks) acc = __builtin_amdgcn_mfma_f32_16x16x32_bf16(fa[ks], qb[ks], acc, 0, 0, 0);
                sacc[jt] = acc;
            }
            u32x4 vr[2][8]; const int ng = n - g16; const LAS unsigned* cqg = cq + g16;
            auto vload = [&](int kk, u32x4 (&dst)[8]) {
#pragma unroll
                for (int j2 = 0; j2 < 8; ++j2) { const int sl = 32 * kk + 4 * j2; const unsigned e = cqg[sl]; const unsigned key = (sl < ng) ? (e & 0x1FFFu) : 0u;
                    dst[j2] = *(const u32x4*)(KVb + (key * 256u + 128u + 8u * l15)); } };
            vload(0, vr[0]); vload(1, vr[1]);
            __builtin_amdgcn_sched_barrier(0);
            float mx = -1e30f; const float nnf = (float)(n - 4 * g16 - 1);
#pragma unroll
            for (int jt = 0; jt < 16; ++jt)
#pragma unroll
                for (int r = 0; r < 4; ++r) { sacc[jt][r] = fmaf(fminf(nnf - (float)(16 * jt + r), 0.f), 1e30f, sacc[jt][r]); mx = fmaxf(mx, sacc[jt][r]); }
            mx = fmaxf(mx, __shfl_xor(mx, 16)); mx = fmaxf(mx, __shfl_xor(mx, 32));
            float sum = 0.f;
#pragma unroll
            for (int jt = 0; jt < 16; ++jt)
#pragma unroll
                for (int r = 0; r < 4; ++r) { const float p = __builtin_amdgcn_exp2f(sacc[jt][r] - mx); sacc[jt][r] = p; sum += p; }
            sum += __shfl_xor(sum, 16); sum += __shfl_xor(sum, 32);
            u32x4 pfr[8];
#pragma unroll
            for (int kk = 0; kk < 8; ++kk) { const f32x4 pa = sacc[2 * kk], pb2 = sacc[2 * kk + 1];
                pfr[kk].x = pk2(pa[0], pa[1]); pfr[kk].y = pk2(pa[2], pa[3]); pfr[kk].z = pk2(pb2[0], pb2[1]); pfr[kk].w = pk2(pb2[2], pb2[3]); }
            __builtin_amdgcn_sched_barrier(0);
            f32x4 o[8];
#pragma unroll
            for (int c = 0; c < 8; ++c) o[c] = (f32x4){0.f, 0.f, 0.f, 0.f};
#pragma unroll
            for (int kk = 0; kk < 8; ++kk) {
#pragma unroll
                for (int j2 = 0; j2 < 8; ++j2) *(LAS u32x4*)(size_t)vwa[j2] = vr[kk & 1][j2];
                __builtin_amdgcn_sched_barrier(0);
                if (kk + 2 < 8) vload(kk + 2, vr[kk & 1]);
                LDS_WAIT();
                const bf16x8 pfrag = __builtin_bit_cast(bf16x8, pfr[kk]);
#pragma unroll
                for (int ch = 0; ch < 2; ++ch) {
                    s16x4 t0[4], t1[4];
                    asm volatile("ds_read_b64_tr_b16 %0, %8\n\tds_read_b64_tr_b16 %1, %9\n\tds_read_b64_tr_b16 %2, %10\n\tds_read_b64_tr_b16 %3, %11\n\t"
                                 "ds_read_b64_tr_b16 %4, %12\n\tds_read_b64_tr_b16 %5, %13\n\tds_read_b64_tr_b16 %6, %14\n\tds_read_b64_tr_b16 %7, %15\n\ts_waitcnt lgkmcnt(0)"
                                 : "=&v"(t0[0]), "=&v"(t0[1]), "=&v"(t0[2]), "=&v"(t0[3]), "=&v"(t1[0]), "=&v"(t1[1]), "=&v"(t1[2]), "=&v"(t1[3])
                                 : "v"(ta0 ^ (unsigned)((4 * ch + 0) << 5)), "v"(ta0 ^ (unsigned)((4 * ch + 1) << 5)), "v"(ta0 ^ (unsigned)((4 * ch + 2) << 5)), "v"(ta0 ^ (unsigned)((4 * ch + 3) << 5)),
                                   "v"(ta1 ^ (unsigned)((4 * ch + 0) << 5)), "v"(ta1 ^ (unsigned)((4 * ch + 1) << 5)), "v"(ta1 ^ (unsigned)((4 * ch + 2) << 5)), "v"(ta1 ^ (unsigned)((4 * ch + 3) << 5)) : "memory");
                    __builtin_amdgcn_sched_barrier(0);
#pragma unroll
                    for (int c = 0; c < 4; ++c) { const bf16x8 av = __builtin_shufflevector(t0[c], t1[c], 0, 1, 2, 3, 4, 5, 6, 7);
                        o[4 * ch + c] = __builtin_amdgcn_mfma_f32_16x16x32_bf16(av, pfrag, o[4 * ch + c], 0, 0, 0); }
                }
            }
            const float inv = 1.0f / sum;
#pragma unroll
            for (int c = 0; c < 8; ++c) { bf16_t* gp = Gg + (m * 2048u + l15 * 128 + 16 * c + 4 * g16); const u32x2 gw = *(const u32x2*)gp;
                const f32x4 r = o[c] * inv * (f32x4){bflo(gw.x), bfhi(gw.x), bflo(gw.y), bfhi(gw.y)};
                u32x2 wv; wv.x = pk2(r[0], r[1]); wv.y = pk2(r[2], r[3]); if (!dry2) *(u32x2*)gp = wv; }
        }
        }
    }
}

#ifndef OLD_SCAN
#define OLD_SCAN 0
#endif
#ifndef MK_SPLIT
#define MK_SPLIT 0
#endif
#ifndef MK_PH_END
#define MK_PH_END 13
#endif
constexpr int N_PHASES = 13;

#define XB_TMO      128
#define XB_XCNT(j)  (256  + 64 * (j))
#define XB_XSUB(j)  (1280 + 64 * (j))
#define XB_XGEN(j)  (2304 + 64 * (j))
#define XB_TOP      3328
#define XB_TOPGEN   3392
#define XCD_BAR_WORDS 3456
#define XB_SPIN_CAP (1u << 18)

__device__ __forceinline__ unsigned xb_ld(unsigned* p)              { return __hip_atomic_load(p, __ATOMIC_RELAXED, __HIP_MEMORY_SCOPE_AGENT); }
__device__ __forceinline__ unsigned xb_add(unsigned* p, unsigned v) { return __hip_atomic_fetch_add(p, v, __ATOMIC_RELAXED, __HIP_MEMORY_SCOPE_AGENT); }
__device__ __forceinline__ unsigned xb_xcc_id() { return (unsigned)__builtin_amdgcn_s_getreg((3 << 11) | 20) & 0xFu; }
#define XB_SPIN(cond, bar) do { unsigned _sp = 0; while (cond) { __builtin_amdgcn_s_sleep(1); \
    if ((++_sp & 255u) == 0u) { if (xb_ld(&(bar)[XB_TMO])) break; if (_sp > XB_SPIN_CAP) { atomicAdd(&(bar)[XB_TMO], 1u); break; } } } } while (0)

struct XcdBarrier {
    unsigned* bar; unsigned x;
    volatile LAS unsigned* st;
};

__device__ __forceinline__ XcdBarrier xcd_barrier_post(unsigned* bar, volatile LAS unsigned* st, const int wave) {
    XcdBarrier b; b.bar = bar; b.x = xb_xcc_id(); b.st = st;
    if (lane_id() == 0 && wave == 0) (void)xb_add(&bar[XB_XCNT(b.x)], 1u);
    return b;
}
__device__ __forceinline__ void xcd_barrier_complete(unsigned* bar, unsigned x, unsigned& nloc, unsigned& nx) {
    const unsigned G = gridDim.x * gridDim.y * gridDim.z;
    unsigned sum, cnt, mine, sp = 0u;
    for (;;) {
        sum = 0u; cnt = 0u; mine = 0u;
#pragma unroll
        for (unsigned j = 0; j < 16; ++j) { const unsigned c = xb_ld(&bar[XB_XCNT(j)]); sum += c; cnt += (c > 0u) ? 1u : 0u; mine = (j == x) ? c : mine; }
        if (sum == G) break;
        __builtin_amdgcn_s_sleep(1);
        if ((++sp & 255u) == 0u) { if (xb_ld(&bar[XB_TMO])) break; if (sp > XB_SPIN_CAP) { atomicAdd(&bar[XB_TMO], 1u); break; } }
    }
    nloc = mine > 0u ? mine : 1u; nx = cnt > 0u ? cnt : 1u;
}

__device__ __forceinline__ void xcd_barrier(const XcdBarrier& b, const int wave) {
    asm volatile("s_waitcnt vmcnt(0)" ::: "memory");
    __syncthreads();
    if (wave == 0) { if (lane_id() == 0) {
        unsigned* bar = b.bar;
        __builtin_amdgcn_s_waitcnt(0);
        unsigned nloc = b.st[0], nx = b.st[1];
        if (nloc == 0u) { xcd_barrier_complete(bar, b.x, nloc, nx); b.st[0] = nloc; b.st[1] = nx; }
        const unsigned old = xb_add(&bar[XB_XSUB(b.x)], 1u);
        const unsigned gen = old / nloc;
        if (old + 1u == (gen + 1u) * nloc) {
            __builtin_amdgcn_fence(__ATOMIC_RELEASE, "agent");
            asm volatile("s_waitcnt vmcnt(0)" ::: "memory");
            const unsigned og = xb_add(&bar[XB_TOP], 1u);
            const unsigned tg = og / nx;
            if (og + 1u == (tg + 1u) * nx) xb_add(&bar[XB_TOPGEN], 1u);
            else XB_SPIN(xb_ld(&bar[XB_TOPGEN]) == tg, bar);
            __builtin_amdgcn_fence(__ATOMIC_ACQUIRE, "agent");
            xb_add(&bar[XB_XGEN(b.x)], 1u);
            asm volatile("s_waitcnt vmcnt(0)" ::: "memory");
        } else {
            XB_SPIN(xb_ld(&bar[XB_XGEN(b.x)]) == gen, bar);
            __builtin_amdgcn_fence(__ATOMIC_ACQUIRE, "agent");
            asm volatile("s_waitcnt vmcnt(0)" ::: "memory");
        }
    } }
    __syncthreads();
}

#define grid_bar(barptr, epoch, wv) xcd_barrier(xbar, (wv))
typedef const __attribute__((address_space(4))) Args* KArgs;
#if defined(__HIP_DEVICE_COMPILE__)
__device__ __forceinline__ Args kargs() { KArgs p = (KArgs)__builtin_amdgcn_kernarg_segment_ptr(); asm volatile("" : "+s"(p)); return *p; }
#else
__device__ __forceinline__ Args kargs() { return Args{}; }
#endif
#define PHASE_ARGS const Args a = kargs(); unsigned char* ws = a.ws; (void)ws

__global__ void __launch_bounds__(NTHREADS, 2) fwd_megakernel(Args a_by_value) {
    extern __shared__ __attribute__((aligned(16))) unsigned char lds_raw[];
    LAS unsigned char* lds = (LAS unsigned char*)lds_raw;
    cg::grid_group grid = cg::this_grid();
    const int wave = __builtin_amdgcn_readfirstlane((int)threadIdx.x >> 6);
    { volatile LAS unsigned* st0 = (volatile LAS unsigned*)(lds + LDS_BYTES - 16); if (wave == 0 && lane_id() < 4) st0[lane_id()] = 0u; __syncthreads(); }
    const XcdBarrier xbar = xcd_barrier_post((unsigned*)(kargs().ws + WS_BAR), (volatile LAS unsigned*)(lds + LDS_BYTES - 16), wave);
    int lo, hi; { const Args a0 = kargs(); lo = a0.ph_lo; hi = a0.ph_hi; }
#ifdef ONLY_PH
#define IN(k) ((k) == ONLY_PH && lo <= (k) && (k) < hi)
#else
#define IN(k) (lo <= (k) && (k) < hi)
#endif
#define SEAM(k) do { if (IN(k) && IN((k) + 1)) { if ((k) == 0) grid.sync(); else grid_bar((unsigned*)(kargs().ws + WS_BAR), (unsigned)(k), wave); } } while (0)
#ifdef REP_PH
#ifndef REP_N
#define REP_N 2
#endif
#define NREP(k) ((k) == REP_PH ? REP_N : 1)
#else
#define NREP(k) 1
#endif
#define REPEAT(k) for (int rep_ = 0; rep_ < NREP(k); ++rep_, (rep_ < NREP(k) ? grid_bar((unsigned*)(kargs().ws + WS_BAR) + 128, 1u, wave) : (void)0))
#ifdef STAMP_K
#define TSTAMP(k) do { if (((k) == STAMP_K || (k) == STAMP_K + 1) && blockIdx.x == 0 && wave == 0) { const unsigned long long t_ = __builtin_amdgcn_s_memrealtime(); \
        if (__builtin_amdgcn_mbcnt_lo(~0u, 0u) == 0u) ((unsigned long long*)(kargs().ws + WS_STAMP))[(k) - STAMP_K] = t_; } } while (0)
#else
#define TSTAMP(k) do { } while (0)
#endif
#ifdef STAMP_K
    if (blockIdx.x == PROBE_BLK && wave == 0) { unsigned long long* st_ = (unsigned long long*)(kargs().ws + WS_STAMP); if (__builtin_amdgcn_mbcnt_lo(~0u, 0u) < 3u) st_[__builtin_amdgcn_mbcnt_lo(~0u, 0u)] = 0ull; }
#endif
    TSTAMP(0);
    if (IN(0)) REPEAT(0) { PHASE_ARGS; p0_prologue(a, wave, lds); } SEAM(0); TSTAMP(1);
    if (IN(1)) REPEAT(1) { PHASE_ARGS; norm_phase(a, wave, lds, a.x, 0); } SEAM(1); TSTAMP(2);
    if (IN(2)) REPEAT(2) { PHASE_ARGS;
        pg8::Gemm g{(const bf16_t*)(ws + WS_H), (const bf16_t*)(ws + WS_WIN0), MTOK, N0, DM}; pg8::StaticOrder S; S.init(MTOK, N0, gridDim.x, blockIdx.x);
        #ifdef EPI0_CHEAP_FIRST
        Epi0 E{ws, (unsigned char*)a.out, NREP(2) == 2 && rep_ == 0 && a.ph_hi > 0};
#else
        Epi0 E{ws, (unsigned char*)a.out, false};
#endif
#ifdef SKEW0
        if (blockIdx.x >= 128) { const unsigned long long t0_ = __builtin_amdgcn_s_memrealtime(); while (__builtin_amdgcn_s_memrealtime() - t0_ < (unsigned long long)(SKEW0)) __builtin_amdgcn_s_sleep(64); }
#endif
        pg8::gemm_phase<Epi0, pg8::StaticOrder, true, true>(lds, g, S, E, wave);
    } SEAM(2); TSTAMP(3);
    if (IN(3)) REPEAT(3) { PHASE_ARGS; conv_phase(a, wave, lds, blockIdx.x, gridDim.x); lora_pre_phase(a, wave); } SEAM(3); TSTAMP(4);
    if (IN(4)) REPEAT(4) { PHASE_ARGS;
        pg8::Gemm g{(const bf16_t*)((unsigned char*)a.out + DO_LA), (const bf16_t*)(ws + WS_WLORA), MTOK, 2048, 256}; pg8::StaticOrder S; S.init(MTOK, 2048, gridDim.x, blockIdx.x);
        EpiLora E{(bf16_t*)(ws + WS_DARR), (bf16_t*)(ws + WS_AARR), a.rwkv_vec};
        pg8::gemm_phase<EpiLora, pg8::StaticOrder, true, true>(lds, g, S, E, wave);
    } SEAM(4); TSTAMP(5);
    if (IN(5)) REPEAT(5) { PHASE_ARGS;
#if OLD_SCAN
        scan_phase(a, wave, lds);
#else
        unsigned* pbar = (unsigned*)(ws + WS_BAR) + 256;
        { __syncthreads(); if (wave == 0 && lane_id() < 8) ((LAS unsigned*)(lds + CS_FLAGS))[lane_id()] = 0u; __syncthreads(); }
        for (int r = 0; r <= CR_NP; ++r) {
            if (blockIdx.x >= 64) { if (r < CR_NP) cscan_produce(a, wave, lds, r, 64, gridDim.x - 64); }
            else if (r >= 1) {
                const int piece = r - 1;
                f32x4 xc[4]; f32x4* sv = (f32x4*)(ws + WS_XSAVE) + ((size_t)(blockIdx.x * 4 + (wave & 3)) * 64 + lane_id()) * 4;
#pragma unroll
                for (int kt = 0; kt < 4; ++kt) xc[kt] = (piece == 0 || wave >= 4) ? (f32x4){0.f, 0.f, 0.f, 0.f} : sv[kt];
                cscan_consume(a, wave, lds, blockIdx.x, piece, xc);
                if (wave < 4) {
#pragma unroll
                    for (int kt = 0; kt < 4; ++kt) sv[kt] = xc[kt]; }
            }
            grid_bar(pbar, (unsigned)(r + 1), wave);
#ifdef BAR2
            grid_bar(pbar + 128, (unsigned)(r + 1), wave);
#endif
        }
#endif
    } SEAM(5); TSTAMP(6);
    if (IN(6)) REPEAT(6) { PHASE_ARGS; post_phase(a, wave); } SEAM(6); TSTAMP(7);
    if (IN(7)) REPEAT(7) { PHASE_ARGS;
        pg8::Gemm g{(const bf16_t*)(ws + WS_YAB), (const bf16_t*)(ws + WS_WOUT0), MTOK, DM, 2048}; pg8::StaticOrder S; S.init(MTOK, DM, gridDim.x, blockIdx.x);
        EpiRes E{a.x, a.out, (const float*)(ws + WS_MODP), a.ada_b, 0};
        pg8::gemm_phase<EpiRes, pg8::StaticOrder, true, true>(lds, g, S, E, wave);
    } SEAM(7); TSTAMP(8);
    if (IN(8)) REPEAT(8) { PHASE_ARGS; norm_phase(a, wave, lds, a.out, 1); } SEAM(8); TSTAMP(9);
    if (IN(9)) REPEAT(9) { PHASE_ARGS;
        pg8::Gemm g{(const bf16_t*)(ws + WS_H), (const bf16_t*)(ws + WS_WIN1), MTOK, N1, DM}; pg8::StaticOrder S; S.init(MTOK, N1, gridDim.x, blockIdx.x);
        Epi1 E{(bf16_t*)(ws + WS_Q), (bf16_t*)(ws + WS_KV), (bf16_t*)(ws + WS_QI), (bf16_t*)(ws + WS_KI), (bf16_t*)(ws + WS_G), (float*)(ws + WS_WI), (const f32x2*)(ws + WS_CSA), (const f32x2*)(ws + WS_CSI)};
        pg8::gemm_phase<Epi1, pg8::StaticOrder, true, true>(lds, g, S, E, wave);
    } SEAM(9); TSTAMP(10);
    if (IN(10)) REPEAT(10) { PHASE_ARGS; dsa_phase(a, wave, lds, NREP(10) == 2 && rep_ == 0 && a.ph_hi > 0); } SEAM(10); TSTAMP(11);
    if (IN(11)) REPEAT(11) { PHASE_ARGS;
        pg8::Gemm g{(const bf16_t*)(ws + WS_G), (const bf16_t*)(ws + WS_WOUT1), MTOK, DM, 2048}; pg8::StaticOrder S; S.init(MTOK, DM, gridDim.x, blockIdx.x);
        EpiRes E{a.out, a.out, (const float*)(ws + WS_MODP), a.ada_b, 1};
        pg8::gemm_phase<EpiRes, pg8::StaticOrder, true, true>(lds, g, S, E, wave);
    } SEAM(11); TSTAMP(12);
    if (IN(12)) REPEAT(12) { PHASE_ARGS; final_phase(a, wave); }
#undef IN
#undef SEAM
}

extern "C" void kernel_launch(void* const* d_in, const int* in_sizes, int n_in, void* d_out, int out_size, void* d_ws, size_t ws_size, hipStream_t stream) {
    static int grid = 0;
    if (grid == 0) {
        if (n_in != 19 || out_size != MTOK * DM || ws_size < WS_NEED) { fprintf(stderr, "kernel_launch: unexpected shapes (n_in %d, out %d, ws %zu)\n", n_in, out_size, ws_size); grid = -1; return; }
        int dev = 0, cus = 0, per_cu = 0;
        (void)hipGetDevice(&dev); (void)hipDeviceGetAttribute(&cus, hipDeviceAttributeMultiprocessorCount, dev);
        if (hipFuncSetAttribute((const void*)fwd_megakernel, hipFuncAttributeMaxDynamicSharedMemorySize, LDS_BYTES) != hipSuccess) { fprintf(stderr, "kernel_launch: hipFuncSetAttribute failed\n"); grid = -1; return; }
        if (hipOccupancyMaxActiveBlocksPerMultiprocessor(&per_cu, (const void*)fwd_megakernel, NTHREADS, LDS_BYTES) != hipSuccess || per_cu < 1) { fprintf(stderr, "kernel_launch: occupancy query says %d\n", per_cu); per_cu = 1; }
        (void)hipGetLastError();
        grid = cus;
        if (grid > 256) grid = 256;
    }
    if (grid < 0) return;
    Args a{};
    a.x = (const float*)d_in[0]; a.c = (const float*)d_in[1]; a.pos = (const int*)d_in[2]; a.ada_w = (const float*)d_in[3]; a.ada_b = (const float*)d_in[4];
    a.norm_g = (const float*)d_in[5]; a.final_g = (const float*)d_in[6]; a.even_w_in = (const float*)d_in[7]; a.even_w_out = (const float*)d_in[8];
    a.conv_w = (const float*)d_in[9]; a.conv_vec = (const float*)d_in[10]; a.mu_rkv = (const float*)d_in[11]; a.mu_lora = (const float*)d_in[12];
    a.rwkv_vec = (const float*)d_in[13]; a.w_up = (const float*)d_in[14]; a.a_up = (const float*)d_in[15]; a.r_k = (const float*)d_in[16];
    a.odd_w_in = (const float*)d_in[17]; a.odd_w_out = (const float*)d_in[18];
    a.out = (float*)d_out; a.ws = (unsigned char*)d_ws;
    (void)hipMemsetAsync((char*)d_ws + WS_BAR, 0, 65536, stream);
#if MK_SPLIT
    for (int p = 0; p < MK_PH_END; ++p) { a.ph_lo = p; a.ph_hi = p + 1; void* args[] = {&a};
        hipError_t e = hipLaunchCooperativeKernel((const void*)fwd_megakernel, dim3(grid), dim3(NTHREADS), args, LDS_BYTES, stream);
        if (e != hipSuccess) { fprintf(stderr, "launch %d failed: %s\n", p, hipGetErrorString(e)); break; } }
#else
    a.ph_lo = 0; a.ph_hi = MK_PH_END; void* args[] = {&a};
    hipError_t e = hipLaunchCooperativeKernel((const void*)fwd_megakernel, dim3(grid), dim3(NTHREADS), args, LDS_BYTES, stream);
    if (e != hipSuccess) fprintf(stderr, "cooperative launch failed: %s (grid %d)\n", hipGetErrorString(e), grid);
#endif
}
```

```cpp
#include <hip/hip_runtime.h>
#include <hip/hip_cooperative_groups.h>
#include <cstdio>
#include <cstdint>
namespace cg = cooperative_groups;

#define LAS __attribute__((address_space(3)))
typedef unsigned short bf16_t;
typedef float f32x4 __attribute__((ext_vector_type(4)));
typedef float f32x2 __attribute__((ext_vector_type(2)));
typedef float f32x16 __attribute__((ext_vector_type(16)));
typedef unsigned u32x4 __attribute__((ext_vector_type(4)));
typedef unsigned u32x2 __attribute__((ext_vector_type(2)));
typedef short bf16x8 __attribute__((ext_vector_type(8)));
typedef short s16x4 __attribute__((ext_vector_type(4)));

constexpr int BATCH = 4, SEQ = 8192, DM = 1024, MTOK = BATCH * SEQ;
constexpr int N0 = 7424, N1 = 5120;
constexpr int EVEN_COLS = 7296, ODD_COLS = 4936;
constexpr int NWAVES = 8, NTHREADS = 512;
constexpr int LDS_BYTES = 155648;

constexpr size_t MiB = 1u << 20;
constexpr size_t WS_MODP = 0; constexpr size_t WS_STAMP = 3 * MiB; constexpr size_t WS_XSAVE = 1 * MiB;
constexpr size_t WS_BAR = 3 * MiB + 512 * 1024;
constexpr size_t WS_WIN0 = 4 * MiB, WS_WOUT0 = 20 * MiB, WS_WIN1 = 24 * MiB, WS_WOUT1 = 34 * MiB, WS_WLORA = 38 * MiB;
constexpr size_t WS_CSA = 40 * MiB, WS_CSI = 56 * MiB;
constexpr size_t WS_H = 64 * MiB;
constexpr size_t WS_YAB = 64 * MiB;
constexpr size_t WS_U = 192 * MiB, WS_AG = 256 * MiB, WS_R = 320 * MiB, WS_K = 384 * MiB, WS_V = 448 * MiB;
constexpr size_t WS_AARR = WS_U, WS_DARR = WS_AG;
constexpr size_t WS_Q = 128 * MiB, WS_G = 256 * MiB, WS_KV = 384 * MiB, WS_QI = 400 * MiB, WS_KI = 432 * MiB, WS_WI = 436 * MiB;
constexpr size_t WS_NEED = 512 * MiB;
constexpr size_t DO_BG = 0, DO_WDAD = 64 * MiB, DO_LA = 72 * MiB, DO_RK = 64 * MiB;

__device__ __forceinline__ float bflo(unsigned w) { return __uint_as_float(w << 16); }
__device__ __forceinline__ float bfhi(unsigned w) { return __uint_as_float(w & 0xffff0000u); }
typedef __bf16 bf16x2_t __attribute__((ext_vector_type(2)));
__device__ __forceinline__ unsigned pk2(float lo, float hi) { const f32x2 v = {lo, hi}; const bf16x2_t b = __builtin_convertvector(v, bf16x2_t); return __builtin_bit_cast(unsigned, b); }
__device__ __forceinline__ float sigmoidf_(float x) { return __builtin_amdgcn_rcpf(1.0f + __expf(-x)); }
__device__ __forceinline__ float wave_sum(float v) {
#pragma unroll
    for (int o = 1; o < 64; o <<= 1) v += __shfl_xor(v, o);
    return v;
}
template <int CTRL> __device__ __forceinline__ float dppmov(float x) { return __int_as_float(__builtin_amdgcn_update_dpp(0, __float_as_int(x), CTRL, 0xf, 0xf, true)); }
__device__ __forceinline__ float quad_sum(float x) { x += dppmov<0xB1>(x); x += dppmov<0x4E>(x); return x; }
__device__ __forceinline__ float row16_sum(float x) { x += dppmov<0xB1>(x); x += dppmov<0x4E>(x); x += dppmov<0x141>(x); x += dppmov<0x140>(x); return x; }
__device__ __forceinline__ int lane_id() { int l; asm volatile("v_mbcnt_lo_u32_b32 %0, -1, 0\n\tv_mbcnt_hi_u32_b32 %0, -1, %0" : "=v"(l)); return l; }
#define LDS_WAIT() asm volatile("s_waitcnt lgkmcnt(0)" ::: "memory")

__device__ __forceinline__ int map0(int n) {
    const int t = n >> 8, r = n & 255;
    if (t < 8) return (r < 128) ? 128 * t + r : 1024 + 128 * t + (r - 128);
    if (t < 12) return 2048 + 256 * (t - 8) + r;
    if (t < 24) return 3072 + 256 * (t - 12) + r;
    if (t < 28) return 6272 + 256 * (t - 24) + r;
    return (r < 128) ? 6144 + r : -1;
}
__device__ __forceinline__ int map1(int n) {
    const int t = n >> 8, r = n & 255, half = r >> 7, rr = r & 127;
    if (t < 8) return (2 * t + (rr >> 6)) * 128 + half * 64 + (rr & 63);
    if (t == 8) return 2048 + (rr >> 6) * 128 + half * 64 + (rr & 63);
    if (t < 11) return 2304 + (4 * (t - 9) + (rr >> 5)) * 64 + half * 32 + (rr & 31);
    if (t == 11) { if (rr < 32) return 2816 + half * 32 + rr; if (half == 0 && rr < 40) return 2880 + (rr - 32); return -1; }
    return 2888 + 256 * (t - 12) + r;
}

#ifndef PROBE_BLK
#define PROBE_BLK 0
#endif
#ifndef PROBE_WAVE
#define PROBE_WAVE 0
#endif
#if defined(STAMP_K) && defined(PROBE_SEC)
#define PROBE_BEGIN(sec, wsp, wv) unsigned long long PT0_##sec = 0; if ((sec) == PROBE_SEC && blockIdx.x == PROBE_BLK && (wv) == PROBE_WAVE) PT0_##sec = __builtin_amdgcn_s_memrealtime()
#define PROBE_END(sec, wsp, wv) do { if ((sec) == PROBE_SEC && blockIdx.x == PROBE_BLK && (wv) == PROBE_WAVE) { const unsigned long long dt_ = __builtin_amdgcn_s_memrealtime() - PT0_##sec; \
        if (__builtin_amdgcn_mbcnt_lo(~0u, 0u) == 0u) __hip_atomic_fetch_add((unsigned long long*)((wsp) + WS_STAMP) + 2, dt_, __ATOMIC_RELAXED, __HIP_MEMORY_SCOPE_AGENT); } } while (0)
#else
#define PROBE_BEGIN(sec, wsp, wv) do { } while (0)
#define PROBE_END(sec, wsp, wv) do { } while (0)
#endif
namespace pg8 {
#define PG8_LAS __attribute__((address_space(3)))
typedef unsigned short bf16_t;
typedef short bf16x8 __attribute__((ext_vector_type(8)));
typedef float f32x4 __attribute__((ext_vector_type(4)));
typedef unsigned u32x4 __attribute__((ext_vector_type(4)));
constexpr int BM = 256, BK = 64, HALF = 128, HTB = HALF * BK * 2  , STAGE_BYTES = 8 * HTB, NXCD = 8, WGM = 8;

__host__ __device__ __forceinline__ int lds_byte(int r, int c) { const int st = (r >> 4) * 2 + (c >> 5), rr = r & 15, cc = c & 31, ob = rr * 64 + cc * 2; return st * 1024 + (ob ^ (((ob >> 9) & 1) << 5)); }
__host__ __device__ __forceinline__ void stage_rc(int b, int& R, int& C) { const int st = b / 1024, sb = b % 1024, swz = sb ^ (((sb >> 9) & 1) << 5); R = (st >> 1) * 16 + swz / 64; C = (st & 1) * 32 + (swz % 64) / 2; }
__host__ __device__ __forceinline__ int perm32(int rho) { const int n = rho >> 4, i = rho & 15; return 8 * (i >> 2) + 4 * n + (i & 3); }

struct Unit { int pm, pn; };
struct Gemm { const bf16_t* A; const bf16_t* Bt; int M, N, K; };

struct StaticOrder {
    int nM, nN, nwg, G, c;
    __host__ __device__ void init(int M, int N, int G_, int c_) { nM = M / BM; nN = N / BM; nwg = nM * nN; G = G_; c = c_; }
    __host__ __device__ bool next(int i, Unit& u) const {
        const long L = (long)i * G + c; if (L >= nwg) return false;
        int wgid = (int)L; { const int q = nwg / NXCD, r = nwg % NXCD, xcd = wgid % NXCD, off = wgid / NXCD; wgid = (xcd < r ? xcd * (q + 1) : r * (q + 1) + (xcd - r) * q) + off; }
        const int nig = WGM * nN, gid = wgid / nig, fm = gid * WGM, gsz = (nM - fm) < WGM ? (nM - fm) : WGM;
        u.pm = fm + ((wgid % nig) % gsz); u.pn = (wgid % nig) / gsz; return true;
    }
    __device__ __forceinline__ void a_ready(const Unit&) const {}
    __device__ __forceinline__ void done(const Unit&) const {}
};

__device__ __forceinline__ unsigned cvt_pk_bf16(float lo, float hi) { unsigned r; asm volatile("v_cvt_pk_bf16_f32 %0, %1, %2" : "=v"(r) : "v"(lo), "v"(hi)); return r; }
typedef float f32x2 __attribute__((ext_vector_type(2)));
template <class Epi, class Sched, bool ALIGN_EPI = false, bool SP2 = false>
__device__ __forceinline__ void gemm_phase(PG8_LAS unsigned char* lds, const Gemm g, const Sched& S, const Epi& E, const int wave_in) {
    int lane; asm volatile("v_mbcnt_lo_u32_b32 %0, -1, 0\n\tv_mbcnt_hi_u32_b32 %0, -1, %0" : "=v"(lane));
    const int wid = wave_in, tid = wid * 64 + lane, wr = wid >> 2, wc = wid & 3, fr = lane & 15, fq = lane >> 4;
    const int K = g.K, nt = K / BK;
    unsigned voffA[2], voffB[2];
#pragma unroll
    for (int i = 0; i < 2; ++i) { int R, C; stage_rc(tid * 16 + i * 8192, R, C); const int Rb = Epi::PERM ? ((R & ~31) + perm32(R & 31)) : R;
        voffA[i] = (unsigned)(R * K + C) * 2u; voffB[i] = (unsigned)(Rb * K + C) * 2u; }
    const size_t kstep = (size_t)(BK * 2);
    const size_t hstep = (size_t)HALF * K * 2;
    const size_t tstep = 2 * hstep;
    const unsigned ldsw = (unsigned)wid * 1024u;
    const int aoff = lds_byte(wr * 64 + fr, fq * 8), boff = lds_byte(wc * 32 + fr, fq * 8);
#define PG8_SA(b, h) (((b) * 2 + (h)) * HTB)
#define PG8_SB(b, h) ((4 + (b) * 2 + (h)) * HTB)
#define PG8_STAGE(bufoff, gbase, voff) do { _Pragma("unroll") for (int _i = 0; _i < 2; ++_i) \
        __builtin_amdgcn_global_load_lds((const unsigned*)((const char*)(gbase) + (voff)[_i]), (PG8_LAS unsigned*)(lds + (bufoff) + ldsw + _i * 8192), 16, 0, 0); } while (0)
#define PG8_LDA(dst, b, h) do { _Pragma("unroll") for (int m = 0; m < 4; ++m) _Pragma("unroll") for (int k = 0; k < 2; ++k) dst[m][k] = *(const PG8_LAS bf16x8*)(lds + PG8_SA(b, h) + aoff + m * 2048 + k * 1024); } while (0)
#define PG8_LDB(dst, b, h) do { _Pragma("unroll") for (int n = 0; n < 2; ++n) _Pragma("unroll") for (int k = 0; k < 2; ++k) dst[n][k] = *(const PG8_LAS bf16x8*)(lds + PG8_SB(b, h) + boff + n * 2048 + k * 1024); } while (0)
#define PG8_MMA(ai, bj, At, Bt) do { __builtin_amdgcn_s_setprio(1); _Pragma("unroll") for (int m = 0; m < 4; ++m) _Pragma("unroll") for (int n = 0; n < 2; ++n) _Pragma("unroll") for (int k = 0; k < 2; ++k) \
        acc[ai][bj][m][n] = __builtin_amdgcn_mfma_f32_16x16x32_bf16(Bt[n][k], At[m][k], acc[ai][bj][m][n], 0, 0, 0); __builtin_amdgcn_s_setprio(0); } while (0)
#define PG8_WAIT_V(n) asm volatile("s_waitcnt vmcnt(" #n ")" ::: "memory")
#define PG8_WAIT_L(n) asm volatile("s_waitcnt lgkmcnt(" #n ")" ::: "memory")
#define PG8_BAR __builtin_amdgcn_s_barrier()
#define PG8_SCHED __builtin_amdgcn_sched_barrier(0)
    Unit cur, nxt; int ui = 0;
    if (!S.next(0, cur)) return;
    f32x4 acc[2][2][4][2];
#pragma unroll
    for (int a = 0; a < 2; ++a)
#pragma unroll
        for (int b = 0; b < 2; ++b)
#pragma unroll
            for (int m = 0; m < 4; ++m)
#pragma unroll
                for (int n = 0; n < 2; ++n) acc[a][b][m][n] = (f32x4){0.f, 0.f, 0.f, 0.f};
    bf16x8 At[4][2], B0[2][2], B1[2][2];
    const char* cA = (const char*)g.A + (size_t)cur.pm * tstep; const char* cB = (const char*)g.Bt + (size_t)cur.pn * tstep;
    S.a_ready(cur);
    if constexpr (SP2) {
        PG8_STAGE(PG8_SB(0, 0), cB, voffB); PG8_STAGE(PG8_SB(0, 1), cB + hstep, voffB); PG8_STAGE(PG8_SA(0, 0), cA, voffA); PG8_STAGE(PG8_SA(0, 1), cA + hstep, voffA);
        if (wr == 1) PG8_BAR;
        PG8_WAIT_V(2); PG8_BAR;
        PG8_STAGE(PG8_SB(1, 0), cB + kstep, voffB); PG8_STAGE(PG8_SA(1, 0), cA + kstep, voffA); PG8_STAGE(PG8_SB(1, 1), cB + hstep + kstep, voffB);
        PG8_WAIT_V(6); PG8_BAR;
    } else {
        PG8_STAGE(PG8_SB(0, 0), cB, voffB); PG8_STAGE(PG8_SA(0, 0), cA, voffA); PG8_STAGE(PG8_SB(0, 1), cB + hstep, voffB); PG8_STAGE(PG8_SA(0, 1), cA + hstep, voffA);
        if (wr == 1) PG8_BAR;
        PG8_WAIT_V(4); PG8_BAR;
        PG8_STAGE(PG8_SB(1, 0), cB + kstep, voffB); PG8_STAGE(PG8_SA(1, 0), cA + kstep, voffA); PG8_STAGE(PG8_SB(1, 1), cB + hstep + kstep, voffB);
        PG8_WAIT_V(6); PG8_BAR;
    }
    for (;;) {
        const bool has_next = S.next(ui + 1, nxt);
        const char* nA = has_next ? (const char*)g.A + (size_t)nxt.pm * tstep : cA; const char* nB = has_next ? (const char*)g.Bt + (size_t)nxt.pn * tstep : cB;
        for (int t = 0; t < nt; t += 2) {
            const bool last = (t == nt - 2);
            const char* a1 = cA + (size_t)(t + 1) * kstep;
            const char* a2 = last ? nA : cA + (size_t)(t + 2) * kstep; const char* b2 = last ? nB : cB + (size_t)(t + 2) * kstep;
            const char* a3 = a2 + kstep; const char* b3 = b2 + kstep;
            if (last && has_next) S.a_ready(nxt);
            if constexpr (SP2) {
            PG8_LDB(B0, 0, 0); PG8_LDB(B1, 0, 1); PG8_SCHED; PG8_LDA(At, 0, 0); PG8_STAGE(PG8_SA(1, 1), a1 + hstep, voffA);
            PG8_WAIT_V(8); PG8_WAIT_L(0); PG8_BAR; PG8_MMA(0, 0, At, B0); PG8_MMA(0, 1, At, B1); PG8_BAR; PG8_SCHED;
            PG8_LDA(At, 0, 1); PG8_STAGE(PG8_SB(0, 0), b2, voffB); PG8_STAGE(PG8_SB(0, 1), b2 + hstep, voffB); PG8_STAGE(PG8_SA(0, 0), a2, voffA);
            PG8_WAIT_V(8); PG8_WAIT_L(0); PG8_BAR; PG8_MMA(1, 0, At, B0); PG8_MMA(1, 1, At, B1); PG8_BAR; PG8_SCHED;
            PG8_LDB(B0, 1, 0); PG8_LDB(B1, 1, 1); PG8_SCHED; PG8_LDA(At, 1, 0); PG8_STAGE(PG8_SA(0, 1), a2 + hstep, voffA);
            PG8_WAIT_V(8); PG8_WAIT_L(0); PG8_BAR; PG8_MMA(0, 0, At, B0); PG8_MMA(0, 1, At, B1); PG8_BAR; PG8_SCHED;
            PG8_LDA(At, 1, 1); PG8_STAGE(PG8_SB(1, 0), b3, voffB); PG8_STAGE(PG8_SB(1, 1), b3 + hstep, voffB); PG8_STAGE(PG8_SA(1, 0), a3, voffA);
            PG8_WAIT_V(8); PG8_WAIT_L(0); PG8_BAR; PG8_MMA(1, 0, At, B0); PG8_MMA(1, 1, At, B1); PG8_BAR; PG8_SCHED;
            } else {
            PG8_LDB(B0, 0, 0); PG8_SCHED; PG8_LDA(At, 0, 0); PG8_STAGE(PG8_SA(1, 1), a1 + hstep, voffA);
            PG8_WAIT_L(8); PG8_BAR; PG8_WAIT_L(0); PG8_MMA(0, 0, At, B0); PG8_BAR; PG8_SCHED;
            PG8_LDB(B1, 0, 1); PG8_STAGE(PG8_SB(0, 0), b2, voffB);
            PG8_BAR; PG8_WAIT_L(0); PG8_MMA(0, 1, At, B1); PG8_BAR;
            PG8_LDA(At, 0, 1); PG8_STAGE(PG8_SA(0, 0), a2, voffA);
            PG8_BAR; PG8_WAIT_L(0); PG8_MMA(1, 0, At, B0); PG8_BAR; PG8_SCHED;
            PG8_STAGE(PG8_SB(0, 1), b2 + hstep, voffB);
            PG8_WAIT_V(6); PG8_BAR; PG8_MMA(1, 1, At, B1); PG8_BAR;
            PG8_LDB(B0, 1, 0); PG8_SCHED; PG8_LDA(At, 1, 0); PG8_STAGE(PG8_SA(0, 1), a2 + hstep, voffA);
            PG8_WAIT_L(8); PG8_BAR; PG8_WAIT_L(0); PG8_MMA(0, 0, At, B0); PG8_BAR; PG8_SCHED;
            PG8_LDB(B1, 1, 1); PG8_STAGE(PG8_SB(1, 0), b3, voffB);
            PG8_BAR; PG8_WAIT_L(0); PG8_MMA(0, 1, At, B1); PG8_BAR;
            PG8_LDA(At, 1, 1); PG8_STAGE(PG8_SA(1, 0), a3, voffA);
            PG8_BAR; PG8_WAIT_L(0); PG8_MMA(1, 0, At, B0); PG8_BAR; PG8_SCHED;
            PG8_STAGE(PG8_SB(1, 1), b3 + hstep, voffB);
            PG8_WAIT_V(6); PG8_BAR; PG8_MMA(1, 1, At, B1); PG8_BAR;
            }
        }
        if constexpr (ALIGN_EPI) { if (wr == 0) PG8_BAR; }
        if constexpr (!Epi::AFTER_DRAIN) { E(acc, cur, wr, wc, fr, fq); S.done(cur); }
        if (!has_next) break;
#pragma unroll
        for (int a = 0; a < 2; ++a)
#pragma unroll
            for (int b = 0; b < 2; ++b)
#pragma unroll
                for (int m = 0; m < 4; ++m)
#pragma unroll
                    for (int n = 0; n < 2; ++n) acc[a][b][m][n] = (f32x4){0.f, 0.f, 0.f, 0.f};
        cur = nxt; cA = nA; cB = nB; ++ui;
        if constexpr (ALIGN_EPI) { if (wr == 1) PG8_BAR; }
    }
    PG8_WAIT_V(0);
    if constexpr (!ALIGN_EPI) { if (wr == 0) PG8_BAR; }
    PG8_BAR;
    if constexpr (Epi::AFTER_DRAIN) { E.fused(acc, cur, wr, wc, fr, fq, lds, wid, lane); S.done(cur); }
#undef PG8_SA
#undef PG8_SB
#undef PG8_STAGE
#undef PG8_LDA
#undef PG8_LDB
#undef PG8_MMA
#undef PG8_WAIT_V
#undef PG8_WAIT_L
#undef PG8_BAR
#undef PG8_SCHED
}
}

__device__ __forceinline__ u32x4 pack8(const f32x4 a, const f32x4 b) { u32x4 w; w.x = pk2(a[0], a[1]); w.y = pk2(a[2], a[3]); w.z = pk2(b[0], b[1]); w.w = pk2(b[2], b[3]); return w; }
__device__ __forceinline__ f32x4 silu4(const f32x4 v) { f32x4 o; o[0] = v[0] * sigmoidf_(v[0]); o[1] = v[1] * sigmoidf_(v[1]); o[2] = v[2] * sigmoidf_(v[2]); o[3] = v[3] * sigmoidf_(v[3]); return o; }
__device__ __forceinline__ f32x4 sig4(const f32x4 v) { f32x4 o; o[0] = sigmoidf_(v[0]); o[1] = sigmoidf_(v[1]); o[2] = sigmoidf_(v[2]); o[3] = sigmoidf_(v[3]); return o; }

struct Epi0 {
    static constexpr bool PERM = true, AFTER_DRAIN = false;
    unsigned char* ws; unsigned char* dout; bool cheap;
    __device__ __forceinline__ void operator()(const f32x4 (&acc)[2][2][4][2], const pg8::Unit& u, int wr, int wc, int fr, int fq) const {
        const int row0 = u.pm * 256 + wr * 64 + fr, t = u.pn, cw = wc * 32 + 8 * fq;
        if (t < 8) {
            bf16_t* U = (bf16_t*)(ws + WS_U);
#pragma unroll
            for (int ai = 0; ai < 2; ++ai)
#pragma unroll
                for (int m = 0; m < 4; ++m) { const size_t row = (size_t)(row0 + ai * 128 + m * 16);
                    const f32x4 a = cheap ? acc[ai][0][m][0] : acc[ai][0][m][0] * sig4(acc[ai][1][m][0]), b = cheap ? acc[ai][0][m][1] : acc[ai][0][m][1] * sig4(acc[ai][1][m][1]);
                    *(u32x4*)(U + row * 1024 + 128 * t + cw) = pack8(a, b); }
        } else if (t == 28) {
            bf16_t* WDAD = (bf16_t*)(dout + DO_WDAD);
#pragma unroll
            for (int ai = 0; ai < 2; ++ai)
#pragma unroll
                for (int m = 0; m < 4; ++m) { const size_t row = (size_t)(row0 + ai * 128 + m * 16);
                    *(u32x4*)(WDAD + row * 128 + cw) = pack8(acc[ai][0][m][0], acc[ai][0][m][1]); }
        } else {
            const bool act = ((t < 12) || (t >= 24)) && !cheap; const int c0 = 256 * (t & 3);
            unsigned char* bp = (t >= 24) ? (dout + DO_BG) : (ws + WS_AG + (size_t)((t - 8) >> 2) * (64 * MiB));
            bf16_t* base = (bf16_t*)bp;
#pragma unroll
            for (int ai = 0; ai < 2; ++ai)
#pragma unroll
                for (int m = 0; m < 4; ++m) { const size_t row = (size_t)(row0 + ai * 128 + m * 16);
#pragma unroll
                    for (int bj = 0; bj < 2; ++bj) { f32x4 a = acc[ai][bj][m][0], b = acc[ai][bj][m][1];
                        if (act) { a = silu4(a); b = silu4(b); }
                        *(u32x4*)(base + row * 1024 + c0 + 128 * bj + cw) = pack8(a, b); } }
        }
    }
};
static_assert(WS_R == WS_AG + 64 * MiB && WS_K == WS_AG + 128 * MiB && WS_V == WS_AG + 192 * MiB, "Epi0 region arithmetic");

struct EpiLora {
    static constexpr bool PERM = true, AFTER_DRAIN = false;
    bf16_t *D, *A; const float* vec;
    __device__ __forceinline__ void operator()(const f32x4 (&acc)[2][2][4][2], const pg8::Unit& u, int wr, int wc, int fr, int fq) const {
        const int row0 = u.pm * 256 + wr * 64 + fr, t = u.pn, cw = wc * 32 + 8 * fq;
        const bool isd = t < 4; bf16_t* base = isd ? D : A; const int c0 = 256 * (t & 3); const float* bias = vec + (isd ? 0 : 1024) + c0 + cw;
        const float sc = isd ? 0.60653065971f : 1.0f;
#pragma unroll
        for (int ai = 0; ai < 2; ++ai)
#pragma unroll
            for (int m = 0; m < 4; ++m) { const size_t row = (size_t)(row0 + ai * 128 + m * 16);
#pragma unroll
                for (int bj = 0; bj < 2; ++bj) { const f32x4 b0 = *(const f32x4*)(bias + 128 * bj), b1 = *(const f32x4*)(bias + 128 * bj + 4);
                    const f32x4 a = sig4(acc[ai][bj][m][0] + b0) * sc, b = sig4(acc[ai][bj][m][1] + b1) * sc;
                    *(u32x4*)(base + row * 1024 + c0 + 128 * bj + cw) = pack8(a, b); } }
    }
};

struct EpiRes {
    static constexpr bool PERM = false, AFTER_DRAIN = false;
    const float* resid; float* out; const float* modp; const float* ada_b; int layer;
    __device__ __forceinline__ void operator()(const f32x4 (&acc)[2][2][4][2], const pg8::Unit& u, int wr, int wc, int fr, int fq) const {
        const int row0 = u.pm * 256 + wr * 64 + fr, col0 = u.pn * 256 + wc * 32 + 4 * fq, b = (u.pm * 256) / SEQ;
        f32x4 gv[2][2];
#pragma unroll
        for (int bj = 0; bj < 2; ++bj)
#pragma unroll
            for (int n = 0; n < 2; ++n) { const int c = col0 + bj * 128 + n * 16; f32x4 g = *(const f32x4*)(ada_b + layer * 3072 + 2048 + c);
#pragma unroll
                for (int s = 0; s < 8; ++s) g += *(const f32x4*)(modp + (size_t)((s * 2 + layer) * 4 + b) * 3072 + 2048 + c);
                gv[bj][n] = g; }
#pragma unroll
        for (int ai = 0; ai < 2; ++ai)
#pragma unroll
            for (int m = 0; m < 4; ++m) { const size_t off = (size_t)(row0 + ai * 128 + m * 16) * 1024 + col0;
#pragma unroll
                for (int bj = 0; bj < 2; ++bj)
#pragma unroll
                    for (int n = 0; n < 2; ++n) { const f32x4 r = *(const f32x4*)(resid + off + bj * 128 + n * 16);
                        *(f32x4*)(out + off + bj * 128 + n * 16) = r + gv[bj][n] * acc[ai][bj][m][n]; }
                if (m & 1) asm volatile("" ::: "memory"); }
    }
};

constexpr float Q_SCALE = 0.08838834764831845f * 1.4426950408889634f;
constexpr float WI_SCALE = 0.35355339059327373f * 0.125f;
struct Epi1 {
    static constexpr bool PERM = true, AFTER_DRAIN = false;
    bf16_t *Q, *KV, *QI, *KI, *G; float* WI; const f32x2* csa; const f32x2* csi;
    __device__ __forceinline__ void rope8(const f32x4 x1a, const f32x4 x1b, const f32x4 x2a, const f32x4 x2b, const f32x2* cs, float sc, u32x4& o1, u32x4& o2) const {
        float c[8], s[8];
#pragma unroll
        for (int j = 0; j < 4; ++j) { const f32x4 v = *(const f32x4*)(cs + 2 * j); c[2 * j] = v[0]; s[2 * j] = v[1]; c[2 * j + 1] = v[2]; s[2 * j + 1] = v[3]; }
        float a[8], b[8];
#pragma unroll
        for (int j = 0; j < 4; ++j) { a[j] = x1a[j]; a[4 + j] = x1b[j]; b[j] = x2a[j]; b[4 + j] = x2b[j]; }
        float p[8], q[8];
#pragma unroll
        for (int j = 0; j < 8; ++j) { p[j] = (a[j] * c[j] - b[j] * s[j]) * sc; q[j] = (b[j] * c[j] + a[j] * s[j]) * sc; }
        o1.x = pk2(p[0], p[1]); o1.y = pk2(p[2], p[3]); o1.z = pk2(p[4], p[5]); o1.w = pk2(p[6], p[7]);
        o2.x = pk2(q[0], q[1]); o2.y = pk2(q[2], q[3]); o2.z = pk2(q[4], q[5]); o2.w = pk2(q[6], q[7]);
    }
    __device__ __forceinline__ void operator()(const f32x4 (&acc)[2][2][4][2], const pg8::Unit& u, int wr, int wc, int fr, int fq) const {
        const int row0 = u.pm * 256 + wr * 64 + fr, t = u.pn, cw = wc * 32 + 8 * fq;
#pragma unroll
        for (int ai = 0; ai < 2; ++ai)
#pragma unroll
            for (int m = 0; m < 4; ++m) { const size_t row = (size_t)(row0 + ai * 128 + m * 16);
                const f32x4 x1a = acc[ai][0][m][0], x1b = acc[ai][0][m][1], x2a = acc[ai][1][m][0], x2b = acc[ai][1][m][1];
                if (t < 8) { const int head = 2 * t + (wc >> 1), i0 = (wc & 1) * 32 + 8 * fq; u32x4 o1, o2;
                    rope8(x1a, x1b, x2a, x2b, csa + row * 64 + i0, Q_SCALE, o1, o2);
                    *(u32x4*)(Q + row * 2048 + head * 128 + i0) = o1; *(u32x4*)(Q + row * 2048 + head * 128 + 64 + i0) = o2;
                } else if (t == 8) { const int i0 = (wc & 1) * 32 + 8 * fq;
                    if (wc < 2) { u32x4 o1, o2; rope8(x1a, x1b, x2a, x2b, csa + row * 64 + i0, 1.0f, o1, o2);
                        *(u32x4*)(KV + row * 256 + i0) = o1; *(u32x4*)(KV + row * 256 + 64 + i0) = o2; }
                    else { *(u32x4*)(KV + row * 256 + 128 + i0) = pack8(x1a, x1b); *(u32x4*)(KV + row * 256 + 192 + i0) = pack8(x2a, x2b); }
                } else if (t < 11) { const int head = 4 * (t - 9) + wc, i0 = 8 * fq; u32x4 o1, o2;
                    rope8(x1a, x1b, x2a, x2b, csi + row * 32 + i0, 1.0f, o1, o2);
                    *(u32x4*)(QI + row * 512 + head * 64 + i0) = o1; *(u32x4*)(QI + row * 512 + head * 64 + 32 + i0) = o2;
                } else if (t == 11) {
                    if (wc == 0) { const int i0 = 8 * fq; u32x4 o1, o2; rope8(x1a, x1b, x2a, x2b, csi + row * 32 + i0, 1.0f, o1, o2);
                        *(u32x4*)(KI + row * 64 + i0) = o1; *(u32x4*)(KI + row * 64 + 32 + i0) = o2; }
                    else if (wc == 1 && fq == 0) { *(f32x4*)(WI + row * 8) = x1a * WI_SCALE; *(f32x4*)(WI + row * 8 + 4) = x1b * WI_SCALE; }
                } else { const int c0 = 256 * (t - 12);
                    *(u32x4*)(G + row * 2048 + c0 + cw) = pack8(silu4(x1a), silu4(x1b)); *(u32x4*)(G + row * 2048 + c0 + 128 + cw) = pack8(silu4(x2a), silu4(x2b)); }
            }
    }
};

struct Args {
    const float* x; const float* c; const int* pos; const float* ada_w; const float* ada_b; const float* norm_g; const float* final_g;
    const float* even_w_in; const float* even_w_out; const float* conv_w; const float* conv_vec; const float* mu_rkv; const float* mu_lora;
    const float* rwkv_vec; const float* w_up; const float* a_up; const float* r_k; const float* odd_w_in; const float* odd_w_out;
    float* out; unsigned char* ws; int ph_lo, ph_hi;
};

template <class SrcF>
__device__ __forceinline__ void transpose_item(const SrcF& src, int K, bf16_t* WT, LAS float* scr, int item, int nblk, int lane) {
    const int kb = item / nblk, nb = item % nblk, k0 = 64 * kb, n0 = 32 * nb;
    float tv[32];
#pragma unroll
    for (int i = 0; i < 32; ++i) tv[i] = src(k0 + 2 * i + (lane >> 5), n0 + (lane & 31));
#pragma unroll
    for (int i = 0; i < 32; ++i) scr[(2 * i + (lane >> 5)) * 33 + (lane & 31)] = tv[i];
    LDS_WAIT();
    const int c = lane & 7;
#pragma unroll
    for (int j = 0; j < 4; ++j) { const int n = (lane >> 3) + 8 * j; const LAS float* s = scr + (8 * c) * 33 + n;
        u32x4 o; o.x = pk2(s[0 * 33], s[1 * 33]); o.y = pk2(s[2 * 33], s[3 * 33]); o.z = pk2(s[4 * 33], s[5 * 33]); o.w = pk2(s[6 * 33], s[7 * 33]);
        *(u32x4*)(WT + (size_t)(n0 + n) * K + k0 + 8 * c) = o; }
    LDS_WAIT();
}

__device__ __forceinline__ void transpose_item_col(const float* W, int ldw, int scol, int K, bf16_t* WT, LAS float* scr, int k0, int n0, int lane) {
    const float* wp = W + (size_t)(k0 + (lane >> 5)) * ldw + (scol < 0 ? 0 : scol);
#pragma unroll 8
    for (int i = 0; i < 32; ++i) { const float v = wp[(size_t)(2 * i) * ldw]; scr[(2 * i + (lane >> 5)) * 33 + (lane & 31)] = scol < 0 ? 0.f : v; }
    LDS_WAIT();
    const int c = lane & 7;
#pragma unroll
    for (int j = 0; j < 4; ++j) { const int n = (lane >> 3) + 8 * j; const LAS float* s = scr + (8 * c) * 33 + n;
        u32x4 o; o.x = pk2(s[0 * 33], s[1 * 33]); o.y = pk2(s[2 * 33], s[3 * 33]); o.z = pk2(s[4 * 33], s[5 * 33]); o.w = pk2(s[6 * 33], s[7 * 33]);
        *(u32x4*)(WT + (size_t)(n0 + n) * K + k0 + 8 * c) = o; }
    LDS_WAIT();
}
__device__ __forceinline__ void rope_item(const Args& a, int r, int lane) {
    const float p = (float)a.pos[r];
    { const float inv = powf(10000.0f, -(float)(2 * lane) / 128.0f); float sn, cs; sincosf(p * inv, &sn, &cs); ((f32x2*)(a.ws + WS_CSA))[(size_t)r * 64 + lane] = (f32x2){cs, sn}; }
    if (lane < 32) { const float inv = powf(10000.0f, -(float)(2 * lane) / 64.0f); float sn, cs; sincosf(p * inv, &sn, &cs); ((f32x2*)(a.ws + WS_CSI))[(size_t)r * 32 + lane] = (f32x2){cs, sn}; }
}
__device__ __forceinline__ void p0_late(const Args& a, const int wave, LAS unsigned char* lds, int first, int nblk) {
    const int lane = lane_id(), tid = wave * 64 + lane;
    LAS float* scr = (LAS float*)(lds + wave * 16384);
    const int gw = ((int)blockIdx.x - first) * NWAVES + wave, NGW = nblk * NWAVES;
    unsigned char* ws = a.ws;
    constexpr int I_WO = (2048 / 64) * (DM / 32), I_W1 = (DM / 64) * (N1 / 32), I_ROPE = MTOK;
    for (int it = gw; it < I_W1 + I_WO + I_ROPE; it += NGW) {
        int r = it;
        if (r < I_W1) { const int nblk = N1 / 32, k0 = 64 * (r / nblk), n0 = 32 * (r % nblk); transpose_item_col(a.odd_w_in, ODD_COLS, map1(n0 + (lane & 31)), DM, (bf16_t*)(ws + WS_WIN1), scr, k0, n0, lane); continue; } r -= I_W1;
        if (r < I_WO) { const int nblk = DM / 32, k0 = 64 * (r / nblk), n0 = 32 * (r % nblk); transpose_item_col(a.odd_w_out, DM, n0 + (lane & 31), 2048, (bf16_t*)(ws + WS_WOUT1), scr, k0, n0, lane); continue; } r -= I_WO;
        {
            const float p = (float)a.pos[r];
            { const float inv = powf(10000.0f, -(float)(2 * lane) / 128.0f); float sn, cs; sincosf(p * inv, &sn, &cs); ((f32x2*)(ws + WS_CSA))[(size_t)r * 64 + lane] = (f32x2){cs, sn}; }
            if (lane < 32) { const float inv = powf(10000.0f, -(float)(2 * lane) / 64.0f); float sn, cs; sincosf(p * inv, &sn, &cs); ((f32x2*)(ws + WS_CSI))[(size_t)r * 32 + lane] = (f32x2){cs, sn}; }
        }
    }
}
__device__ __forceinline__ void p0_prologue(const Args& a, const int wave, LAS unsigned char* lds) {
    const int lane = lane_id(), tid = wave * 64 + lane;
    LAS float* scr = (LAS float*)(lds + wave * 16384);
    const int gw = blockIdx.x * NWAVES + wave, NGW = gridDim.x * NWAVES;
    unsigned char* ws = a.ws;
    constexpr int I_W0 = (DM / 64) * (N0 / 32), I_WO = (2048 / 64) * (DM / 32), I_W1 = (DM / 64) * (N1 / 32), I_WL = (256 / 64) * (2048 / 32), I_MOD = 96 * 8, I_ROPE = MTOK;
    constexpr int NITEMS = I_W0 + I_WO + I_W1 + I_WO + I_WL + I_MOD + I_ROPE;
    constexpr int N_EARLY = I_W0 + I_WO + I_W1 + I_WO + I_WL + I_MOD;
    for (int it = gw; it < N_EARLY; it += NGW) {
        int r = it;
        if (r < I_W0) { const float* W = a.even_w_in; transpose_item([W](int k, int n) { const int s = map0(n); return s < 0 ? 0.f : W[(size_t)k * EVEN_COLS + s]; }, DM, (bf16_t*)(ws + WS_WIN0), scr, r, N0 / 32, lane); continue; } r -= I_W0;
        if (r < I_WO) { const float* W = a.even_w_out; transpose_item([W](int k, int n) { return W[(size_t)k * DM + n]; }, 2048, (bf16_t*)(ws + WS_WOUT0), scr, r, DM / 32, lane); continue; } r -= I_WO;
        if (r < I_W1) { const float* W = a.odd_w_in; transpose_item([W](int k, int n) { const int s = map1(n); return s < 0 ? 0.f : W[(size_t)k * ODD_COLS + s]; }, DM, (bf16_t*)(ws + WS_WIN1), scr, r, N1 / 32, lane); continue; } r -= I_W1;
        if (r < I_WO) { const float* W = a.odd_w_out; transpose_item([W](int k, int n) { return W[(size_t)k * DM + n]; }, 2048, (bf16_t*)(ws + WS_WOUT1), scr, r, DM / 32, lane); continue; } r -= I_WO;
        if (r < I_WL) { const float* wu = a.w_up; const float* au = a.a_up;
            transpose_item([wu, au](int k, int n) { if (n < 1024) return k < 64 ? wu[k * 1024 + n] : 0.f; return (k >= 64 && k < 128) ? au[(k - 64) * 1024 + (n - 1024)] : 0.f; }, 256, (bf16_t*)(ws + WS_WLORA), scr, r, 2048 / 32, lane); continue; } r -= I_WL;
        if (r < I_MOD) {
            const int cgp = r >> 3, ks = r & 7, col = cgp * 64 + lane, l = col / 3072, cc = col - l * 3072;
#pragma unroll
            for (int i = 0; i < 8; ++i) { const int idx = lane + 64 * i, bb = idx >> 7, kk = idx & 127; const float cv = a.c[bb * DM + ks * 128 + kk]; scr[kk * 4 + bb] = cv * sigmoidf_(cv); }
            LDS_WAIT();
            const float* W = a.ada_w + (size_t)l * DM * 3072 + cc + (size_t)(ks * 128) * 3072; f32x4 acc4 = (f32x4){0.f, 0.f, 0.f, 0.f};
#pragma unroll 1
            for (int k8 = 0; k8 < 128; k8 += 16) { float wv[16];
#pragma unroll
                for (int i = 0; i < 16; ++i) wv[i] = W[(size_t)(k8 + i) * 3072];
#pragma unroll
                for (int i = 0; i < 16; ++i) acc4 += *(const LAS f32x4*)(scr + (k8 + i) * 4) * wv[i]; }
            LDS_WAIT();
            const float acc0 = acc4[0], acc1 = acc4[1], acc2 = acc4[2], acc3 = acc4[3];
            float* mp = (float*)(ws + WS_MODP) + (size_t)((ks * 2 + l) * 4) * 3072 + cc;
            mp[0] = acc0; mp[3072] = acc1; mp[2 * 3072] = acc2; mp[3 * 3072] = acc3; continue; } r -= I_MOD;
    }
}

__device__ __forceinline__ void norm_phase(const Args& a, const int wave, LAS unsigned char* lds, const float* src, int layer) {
    const int lane = lane_id(), tid = wave * 64 + lane;
    LAS float* gs = (LAS float*)lds; LAS float* sh = gs + DM;
    const float* modp = (const float*)(a.ws + WS_MODP); bf16_t* H = (bf16_t*)(a.ws + WS_H);
    for (int tile = blockIdx.x; tile < MTOK / 128; tile += gridDim.x) {
        const int b = (tile * 128) / SEQ;
        __syncthreads();
        for (int c = tid; c < DM; c += NTHREADS) {
            float sc = a.ada_b[layer * 3072 + 1024 + c], sf = a.ada_b[layer * 3072 + c];
#pragma unroll
            for (int s = 0; s < 8; ++s) { const float* mp = modp + (size_t)((s * 2 + layer) * 4 + b) * 3072; sc += mp[1024 + c]; sf += mp[c]; }
            gs[c] = a.norm_g[layer * DM + c] * (1.0f + sc); sh[c] = sf; }
        __syncthreads();
        for (int r4 = 0; r4 < 16; r4 += 4) {
            f32x4 v[4][4]; float ss[4];
#pragma unroll
            for (int q = 0; q < 4; ++q) { const size_t m = (size_t)tile * 128 + wave * 16 + r4 + q; const f32x4* xr = (const f32x4*)(src + m * DM) + lane;
#pragma unroll
                for (int j = 0; j < 4; ++j) v[q][j] = xr[64 * j]; }
#pragma unroll
            for (int q = 0; q < 4; ++q) { float s = 0.f;
#pragma unroll
                for (int j = 0; j < 4; ++j) s += (v[q][j][0] * v[q][j][0] + v[q][j][1] * v[q][j][1]) + (v[q][j][2] * v[q][j][2] + v[q][j][3] * v[q][j][3]);
                ss[q] = s; }
#pragma unroll
            for (int q = 0; q < 4; ++q) ss[q] = wave_sum(ss[q]);
#pragma unroll
            for (int q = 0; q < 4; ++q) { const size_t m = (size_t)tile * 128 + wave * 16 + r4 + q; const float rstd = rsqrtf(ss[q] * (1.0f / DM) + 1e-6f);
                u32x2* o = (u32x2*)(H + m * DM) + lane;
#pragma unroll
                for (int j = 0; j < 4; ++j) { const f32x4 g = *(const LAS f32x4*)(gs + 4 * (64 * j + lane)), s = *(const LAS f32x4*)(sh + 4 * (64 * j + lane));
                    const f32x4 h = v[q][j] * rstd * g + s; u32x2 w; w.x = pk2(h[0], h[1]); w.y = pk2(h[2], h[3]); o[64 * j] = w; } }
        }
    }
}

__device__ __forceinline__ void final_phase(const Args& a, const int wave) {
    const int lane = lane_id(), tid = wave * 64 + lane;
    const int gw = blockIdx.x * NWAVES + wave, NGW = gridDim.x * NWAVES;
    f32x4 g[4];
#pragma unroll
    for (int j = 0; j < 4; ++j) g[j] = *((const f32x4*)a.final_g + 64 * j + lane);
    float tsc = 1.0f;
#ifdef STAMP_K
    { const unsigned long long* st = (const unsigned long long*)(a.ws + WS_STAMP); tsc = 1.0f + (float)(st[1] - st[0] + st[2]) * 1e-7f; }
#endif
    for (int m0 = 4 * gw; m0 < MTOK; m0 += 4 * NGW) {
        f32x4 v[4][4]; float ss[4];
#pragma unroll
        for (int q = 0; q < 4; ++q) { const f32x4* xr = (const f32x4*)(a.out + (size_t)(m0 + q) * DM) + lane;
#pragma unroll
            for (int j = 0; j < 4; ++j) v[q][j] = xr[64 * j]; }
#pragma unroll
        for (int q = 0; q < 4; ++q) { float s = 0.f;
#pragma unroll
            for (int j = 0; j < 4; ++j) s += (v[q][j][0] * v[q][j][0] + v[q][j][1] * v[q][j][1]) + (v[q][j][2] * v[q][j][2] + v[q][j][3] * v[q][j][3]);
            ss[q] = wave_sum(s); }
#pragma unroll
        for (int q = 0; q < 4; ++q) { const float rstd = rsqrtf(ss[q] * (1.0f / DM) + 1e-6f) * tsc; f32x4* xr = (f32x4*)(a.out + (size_t)(m0 + q) * DM) + lane;
#pragma unroll
            for (int j = 0; j < 4; ++j) xr[64 * j] = v[q][j] * rstd * g[j]; }
    }
}


__device__ __forceinline__ void conv_phase(const Args& a, const int wave, LAS unsigned char* lds, int first, int stride) {
    const int lane = lane_id(), tid = wave * 64 + lane;
    const bf16_t* U = (const bf16_t*)(a.ws + WS_U); const bf16_t* AG = (const bf16_t*)(a.ws + WS_AG); bf16_t* YAB = (bf16_t*)(a.ws + WS_YAB);
    f32x2 w[31];
#pragma unroll
    for (int j = 0; j < 31; ++j) w[j] = *(const f32x2*)(a.conv_w + j * DM + 2 * tid);
    const f32x2 cbias = *(const f32x2*)(a.conv_vec + 2 * tid);
    for (int tile = first; tile < MTOK / 32; tile += stride) {
        const int b = tile >> 8, s0 = (tile & 255) * 32;
        __syncthreads();
        for (int idx = tid; idx < 62 * 128; idx += NTHREADS) { const int row = idx >> 7, ch = idx & 127, s = s0 - 30 + row;
            u32x4 v = (u32x4){0u, 0u, 0u, 0u}; if (s >= 0) v = *(const u32x4*)(U + ((size_t)(b * SEQ + s)) * DM + ch * 8);
            *(LAS u32x4*)(lds + row * 2048 + ch * 16) = v; }
        __syncthreads();
        LAS unsigned char* rb0 = lds + tid * 4; LAS unsigned char* rb1 = rb0 + 65536; LAS unsigned char* wb0 = lds + tid * 8; LAS unsigned char* wb1 = wb0 + 65536;
        asm volatile("" : "+v"(rb0), "+v"(rb1), "+v"(wb0), "+v"(wb1));
        f32x2 acc[32];
#pragma unroll
        for (int t = 0; t < 32; ++t) acc[t] = (f32x2){0.f, 0.f};
#pragma unroll
        for (int i = 0; i < 62; ++i) { const unsigned xw = (i < 32) ? *(const LAS unsigned*)(rb0 + i * 2048) : *(const LAS unsigned*)(rb1 + (i - 32) * 2048); const f32x2 xv = (f32x2){bflo(xw), bfhi(xw)};
#pragma unroll
            for (int t = (i > 30 ? i - 30 : 0); t <= (i < 31 ? i : 31); ++t) acc[t] += xv * w[i - t]; }
        __syncthreads();
#pragma unroll
        for (int t = 0; t < 32; ++t) { if (t < 16) *(LAS f32x2*)(wb0 + t * 4096) = acc[t] + cbias; else *(LAS f32x2*)(wb1 + (t - 16) * 4096) = acc[t] + cbias; }
        __syncthreads();
        f32x4 lw[4], lb[4];
#pragma unroll
        for (int j = 0; j < 4; ++j) { lw[j] = *(const f32x4*)(a.conv_vec + DM + 4 * (lane + 64 * j)); lb[j] = *(const f32x4*)(a.conv_vec + 2 * DM + 4 * (lane + 64 * j)); }
        for (int tt = 0; tt < 4; ++tt) { const int t = wave * 4 + tt; const size_t m = (size_t)b * SEQ + s0 + t;
            f32x4 v[4]; float s = 0.f;
#pragma unroll
            for (int j = 0; j < 4; ++j) { v[j] = *(const LAS f32x4*)(lds + (size_t)t * 4096 + 16 * (lane + 64 * j)); s += (v[j][0] + v[j][1]) + (v[j][2] + v[j][3]); }
            const float mean = wave_sum(s) * (1.0f / DM); float q = 0.f;
#pragma unroll
            for (int j = 0; j < 4; ++j) { v[j] = v[j] - mean; q += (v[j][0] * v[j][0] + v[j][1] * v[j][1]) + (v[j][2] * v[j][2] + v[j][3] * v[j][3]); }
            const float rstd = rsqrtf(wave_sum(q) * (1.0f / DM) + 1e-5f);
#pragma unroll
            for (int j = 0; j < 4; ++j) { const f32x4 y = v[j] * rstd * lw[j] + lb[j]; const u32x2 g = *(const u32x2*)(AG + m * DM + 4 * (lane + 64 * j));
                const f32x4 o = silu4(y) * (f32x4){bflo(g.x), bfhi(g.x), bflo(g.y), bfhi(g.y)};
                u32x2 wv; wv.x = pk2(o[0], o[1]); wv.y = pk2(o[2], o[3]); *(u32x2*)(YAB + m * 2048 + 4 * (lane + 64 * j)) = wv; }
        }
    }
}

__device__ __forceinline__ void lora_pre_phase(const Args& a, const int wave) {
    const int lane = lane_id(), tid = wave * 64 + lane;

        const bf16_t* WDAD = (const bf16_t*)((unsigned char*)a.out + DO_WDAD); bf16_t* LA = (bf16_t*)((unsigned char*)a.out + DO_LA);
        const int gw = blockIdx.x * NWAVES + wave, NGW = gridDim.x * NWAVES;
        const f32x2 mu = *(const f32x2*)(a.mu_lora + 2 * lane);
        for (int m0 = gw * 4; m0 < MTOK; m0 += NGW * 4) {
            unsigned cur[4], prv[4];
#pragma unroll
            for (int i = 0; i < 4; ++i) { const int m = m0 + i; cur[i] = *(const unsigned*)(WDAD + (size_t)m * 128 + 2 * lane); }
#pragma unroll
            for (int i = 0; i < 4; ++i) { const int m = m0 + i; if (i > 0) prv[i] = cur[i - 1]; else { prv[0] = 0u; if ((m & (SEQ - 1)) > 0) prv[0] = *(const unsigned*)(WDAD + (size_t)(m - 1) * 128 + 2 * lane); } }
#pragma unroll
            for (int i = 0; i < 4; ++i) { const int m = m0 + i;
                float v0 = bflo(cur[i]), v1 = bfhi(cur[i]); v0 += (bflo(prv[i]) - v0) * mu[0]; v1 += (bfhi(prv[i]) - v1) * mu[1];
                if (lane < 32) { v0 = tanhf(v0); v1 = tanhf(v1); }
                *(unsigned*)(LA + (size_t)m * 256 + 2 * lane) = pk2(v0, v1); *(unsigned*)(LA + (size_t)m * 256 + 128 + 2 * lane) = 0u; }
        }
    }

struct ScanRaw { u32x2 r, rp, k, kp, v, vp, d, a; };
constexpr int SC_CH = 16, SC_BUF_F = 5 * SC_CH * 64 + SC_CH * 16;

__device__ __forceinline__ void scan_phase(const Args& a, const int wave, LAS unsigned char* lds) {
    const int lane = lane_id(), tid = wave * 64 + lane;
    const bf16_t* Rg = (const bf16_t*)(a.ws + WS_R); const bf16_t* Kg = (const bf16_t*)(a.ws + WS_K); const bf16_t* Vg = (const bf16_t*)(a.ws + WS_V);
    const bf16_t* Dg = (const bf16_t*)(a.ws + WS_DARR); const bf16_t* Ag = (const bf16_t*)(a.ws + WS_AARR);
    bf16_t* YAB = (bf16_t*)(a.ws + WS_YAB); float* RK = (float*)((unsigned char*)a.out + DO_RK);
    LAS float* bufs = (LAS float*)lds; LAS float* ybuf = bufs + 2 * SC_BUF_F;
    constexpr int NCH = SEQ / SC_CH;
    for (int job = blockIdx.x; job < 256; job += gridDim.x) {
        const int vcu = (gridDim.x == 256) ? ((job & 7) * 32 + (job >> 3)) : job;
        const int bh = vcu >> 2, vq = vcu & 3, b = bh >> 4, h = bh & 15;
        __syncthreads();
        if (wave >= 4) {
            const int pt = tid - 256, tok = pt >> 4, cgp = pt & 15, ch = h * 64 + 4 * cgp;
            const f32x4 mur = *(const f32x4*)(a.mu_rkv + ch), muk = *(const f32x4*)(a.mu_rkv + DM + ch), muv = *(const f32x4*)(a.mu_rkv + 2 * DM + ch);
            const f32x4 k_k = *(const f32x4*)(a.rwkv_vec + 2 * DM + ch), k_a = *(const f32x4*)(a.rwkv_vec + 3 * DM + ch), rkw = *(const f32x4*)(a.r_k + ch);
            auto load = [&](int c) { ScanRaw q; const int s = c * SC_CH + tok; const size_t m = (size_t)b * SEQ + s; const size_t o = m * DM + ch; const size_t op = (s > 0) ? o - DM : o;
                q.r = *(const u32x2*)(Rg + o); q.k = *(const u32x2*)(Kg + o); q.v = *(const u32x2*)(Vg + o); q.d = *(const u32x2*)(Dg + o); q.a = *(const u32x2*)(Ag + o);
                q.rp = *(const u32x2*)(Rg + op); q.kp = *(const u32x2*)(Kg + op); q.vp = *(const u32x2*)(Vg + op);
                if (s == 0) { q.rp = (u32x2){0u, 0u}; q.kp = (u32x2){0u, 0u}; q.vp = (u32x2){0u, 0u}; }
                return q; };
            auto un4 = [](u32x2 w) { return (f32x4){bflo(w.x), bfhi(w.x), bflo(w.y), bfhi(w.y)}; };
            auto process = [&](const ScanRaw& q, int c, LAS float* buf) {
                const f32x4 r0 = un4(q.r), k0 = un4(q.k), v0 = un4(q.v);
                const f32x4 rl = r0 + (un4(q.rp) - r0) * mur, kl = k0 + (un4(q.kp) - k0) * muk, vl = v0 + (un4(q.vp) - v0) * muv;
                const f32x4 d = un4(q.d), av = un4(q.a);
                f32x4 wdec; wdec[0] = __expf(-d[0]); wdec[1] = __expf(-d[1]); wdec[2] = __expf(-d[2]); wdec[3] = __expf(-d[3]);
                const f32x4 kkr = kl * k_k; float ss = (kkr[0] * kkr[0] + kkr[1] * kkr[1]) + (kkr[2] * kkr[2] + kkr[3] * kkr[3]); ss = row16_sum(ss);
                const float inv = 1.0f / fmaxf(sqrtf(ss), 1e-12f);
                const f32x4 kk = kkr * inv, kp = kl * (1.0f + (av - 1.0f) * k_a), bb = kk * av;
                float rk = (rl[0] * kp[0] * rkw[0] + rl[1] * kp[1] * rkw[1]) + (rl[2] * kp[2] * rkw[2] + rl[3] * kp[3] * rkw[3]); rk = row16_sum(rk);
                const int o = tok * 64 + 4 * cgp;
                *(LAS f32x4*)(buf + o) = -kk; *(LAS f32x4*)(buf + 1024 + o) = wdec; *(LAS f32x4*)(buf + 2048 + o) = bb; *(LAS f32x4*)(buf + 3072 + o) = kp; *(LAS f32x4*)(buf + 4096 + o) = rl;
                if ((cgp >> 2) == vq) *(LAS f32x4*)(buf + 5120 + tok * 16 + 4 * (cgp & 3)) = vl;
                if (vq == 0 && cgp == 0) RK[((size_t)b * SEQ + c * SC_CH + tok) * 16 + h] = rk; };
            auto flush = [&](int c, const LAS float* yb) {
                if (wave == 4) { const int t2 = lane >> 2, rq = lane & 3; const f32x4 y = *(const LAS f32x4*)(yb + t2 * 16 + 4 * rq);
                    u32x2 wv; wv.x = pk2(y[0], y[1]); wv.y = pk2(y[2], y[3]);
                    *(u32x2*)(YAB + ((size_t)b * SEQ + c * SC_CH + t2) * 2048 + 1024 + h * 64 + 16 * vq + 4 * rq) = wv; } };
            ScanRaw q0 = load(0), q1 = load(1);
            process(q0, 0, bufs); q0 = q1; q1 = load(2);
            __syncthreads();
            for (int c = 0; c < NCH; ++c) {
                if (c + 1 < NCH) process(q0, c + 1, bufs + ((c + 1) & 1) * SC_BUF_F);
                q0 = q1; if (c + 3 < NCH) q1 = load(c + 3);
                if (c >= 1) flush(c - 1, ybuf + ((c - 1) & 1) * 256);
                __syncthreads();
            }
            flush(NCH - 1, ybuf + ((NCH - 1) & 1) * 256);
        } else {
            const int rw = lane >> 4, ks = lane & 15, row = wave * 4 + rw;
            float s0 = 0.f, s1 = 0.f, s2 = 0.f, s3 = 0.f;
            __syncthreads();
            for (int c = 0; c < NCH; ++c) {
                const LAS float* buf = bufs + (c & 1) * SC_BUF_F; LAS float* yb = ybuf + (c & 1) * 256;
#pragma unroll
                for (int t = 0; t < SC_CH; ++t) {
                    const f32x4 nk = *(const LAS f32x4*)(buf + t * 64 + 4 * ks), w4 = *(const LAS f32x4*)(buf + 1024 + t * 64 + 4 * ks), b4 = *(const LAS f32x4*)(buf + 2048 + t * 64 + 4 * ks);
                    const f32x4 kp = *(const LAS f32x4*)(buf + 3072 + t * 64 + 4 * ks), r4 = *(const LAS f32x4*)(buf + 4096 + t * 64 + 4 * ks); const float vv = buf[5120 + t * 16 + row];
                    float sa = (s0 * nk[0] + s1 * nk[1]) + (s2 * nk[2] + s3 * nk[3]); sa = row16_sum(sa);
                    s0 = s0 * w4[0] + (sa * b4[0] + vv * kp[0]); s1 = s1 * w4[1] + (sa * b4[1] + vv * kp[1]);
                    s2 = s2 * w4[2] + (sa * b4[2] + vv * kp[2]); s3 = s3 * w4[3] + (sa * b4[3] + vv * kp[3]);
                    float y = (s0 * r4[0] + s1 * r4[1]) + (s2 * r4[2] + s3 * r4[3]); y = row16_sum(y);
                    if (ks == 0) yb[t * 16 + row] = y;
                }
                __syncthreads();
            }
        }
    }
}

__device__ __forceinline__ void post_phase(const Args& a, const int wave) {
    const int lane = lane_id(), tid = wave * 64 + lane;
    const int gw = blockIdx.x * NWAVES + wave, NGW = gridDim.x * NWAVES;
    const bf16_t* Vg = (const bf16_t*)(a.ws + WS_V); const bf16_t* BG = (const bf16_t*)((unsigned char*)a.out + DO_BG); const float* RK = (const float*)((unsigned char*)a.out + DO_RK);
    bf16_t* YAB = (bf16_t*)(a.ws + WS_YAB);
    const int head = lane >> 2, c0 = head * 64 + 16 * (lane & 3);
    f32x4 muv[4], lw[4], lb[4];
#pragma unroll
    for (int j = 0; j < 4; ++j) { muv[j] = *(const f32x4*)(a.mu_rkv + 2 * DM + c0 + 4 * j); lw[j] = *(const f32x4*)(a.rwkv_vec + 4 * DM + c0 + 4 * j); lb[j] = *(const f32x4*)(a.rwkv_vec + 5 * DM + c0 + 4 * j); }
    auto un4 = [](unsigned x, unsigned y) { return (f32x4){bflo(x), bfhi(x), bflo(y), bfhi(y)}; };
    for (int m = gw; m < MTOK; m += NGW) { const int s = m & (SEQ - 1);
        bf16_t* yp = YAB + (size_t)m * 2048 + 1024 + c0;
        const u32x4 ya = *(const u32x4*)yp, yb2 = *(const u32x4*)(yp + 8);
        const u32x4 va = *(const u32x4*)(Vg + (size_t)m * DM + c0), vb = *(const u32x4*)(Vg + (size_t)m * DM + c0 + 8);
        u32x4 pa = (u32x4){0u, 0u, 0u, 0u}, pb = pa; if (s > 0) { pa = *(const u32x4*)(Vg + (size_t)(m - 1) * DM + c0); pb = *(const u32x4*)(Vg + (size_t)(m - 1) * DM + c0 + 8); }
        const u32x4 ga = *(const u32x4*)(BG + (size_t)m * DM + c0), gb = *(const u32x4*)(BG + (size_t)m * DM + c0 + 8);
        const float rk = RK[(size_t)m * 16 + head];
        f32x4 y[4] = {un4(ya.x, ya.y), un4(ya.z, ya.w), un4(yb2.x, yb2.y), un4(yb2.z, yb2.w)};
        const f32x4 v[4] = {un4(va.x, va.y), un4(va.z, va.w), un4(vb.x, vb.y), un4(vb.z, vb.w)};
        const f32x4 p[4] = {un4(pa.x, pa.y), un4(pa.z, pa.w), un4(pb.x, pb.y), un4(pb.z, pb.w)};
        const f32x4 g[4] = {un4(ga.x, ga.y), un4(ga.z, ga.w), un4(gb.x, gb.y), un4(gb.z, gb.w)};
        float sm = 0.f;
#pragma unroll
        for (int j = 0; j < 4; ++j) sm += (y[j][0] + y[j][1]) + (y[j][2] + y[j][3]);
        const float mean = quad_sum(sm) * (1.0f / 64.0f); float q = 0.f;
#pragma unroll
        for (int j = 0; j < 4; ++j) { y[j] = y[j] - mean; q += (y[j][0] * y[j][0] + y[j][1] * y[j][1]) + (y[j][2] * y[j][2] + y[j][3] * y[j][3]); }
        const float rstd = rsqrtf(quad_sum(q) * (1.0f / 64.0f) + 64e-5f);
        u32x4 o[2];
#pragma unroll
        for (int j = 0; j < 4; ++j) { const f32x4 vl = v[j] + (p[j] - v[j]) * muv[j]; const f32x4 r = (y[j] * rstd * lw[j] + lb[j] + rk * vl) * g[j];
            if (j & 1) { o[j >> 1].z = pk2(r[0], r[1]); o[j >> 1].w = pk2(r[2], r[3]); } else { o[j >> 1].x = pk2(r[0], r[1]); o[j >> 1].y = pk2(r[2], r[3]); } }
        *(u32x4*)yp = o[0]; *(u32x4*)(yp + 8) = o[1];
    }
}

constexpr int CS_L = 32, CS_NCH = SEQ / CS_L, CS_NSLOT = 3;
constexpr int CS_NT = 0, CS_RT = 4096, CS_BT = 8192, CS_KT = 12288, CS_TM = 8192, CS_AKN = 10240, CS_ABR = 12288, CS_AKR = 14336, CS_BC = 16384, CS_KC = 20480, CS_VC = 24576, CS_GL = 28672, CS_SLOT = 29184;
constexpr int CS_RAW = CS_NSLOT * CS_SLOT, CS_RAWSZ = 5 * 33 * 128;
constexpr int CS_FLAGS = CS_RAW + CS_NSLOT * CS_RAWSZ;
static_assert(CS_FLAGS + 64 <= LDS_BYTES && (CS_RAW % 16) == 0 && (CS_RAWSZ % 16) == 0, "chunked scan LDS map");
__device__ __forceinline__ int permp(int j) { return 8 * ((j & 15) >> 2) + 4 * (j >> 4) + (j & 3); }
template <int CTRL, int RM> __device__ __forceinline__ float dppf(float x) { return __int_as_float(__builtin_amdgcn_update_dpp(0, __float_as_int(x), CTRL, RM, 0xf, true)); }
__device__ __forceinline__ float wave_total(float x) {
    x = row16_sum(x); x += dppf<0x142, 0xa>(x); x += dppf<0x143, 0xc>(x); return __int_as_float(__builtin_amdgcn_readlane(__float_as_int(x), 63)); }
__device__ __forceinline__ float wave_sum64(float x) { x = row16_sum(x); x += __shfl_xor(x, 16); x += __shfl_xor(x, 32); return x; }
__device__ __forceinline__ bf16x8 cfrag(const f32x16& x, int s) {
    u32x4 w; w.x = pk2(x[8 * s + 0], x[8 * s + 1]); w.y = pk2(x[8 * s + 2], x[8 * s + 3]); w.z = pk2(x[8 * s + 4], x[8 * s + 5]); w.w = pk2(x[8 * s + 6], x[8 * s + 7]); return __builtin_bit_cast(bf16x8, w); }
__device__ __forceinline__ bf16x8 cfrag2(const f32x4& a, const f32x4& b) { u32x4 w; w.x = pk2(a[0], a[1]); w.y = pk2(a[2], a[3]); w.z = pk2(b[0], b[1]); w.w = pk2(b[2], b[3]); return __builtin_bit_cast(bf16x8, w); }
__device__ __forceinline__ void lds_poll_ge(LAS unsigned* p, unsigned want) { while (__hip_atomic_load(p, __ATOMIC_RELAXED, __HIP_MEMORY_SCOPE_WORKGROUP) < want) __builtin_amdgcn_s_sleep(1); asm volatile("" ::: "memory"); }

__device__ __forceinline__ void cscan_job(const Args& a, const int wave, LAS unsigned char* lds, int bh) {
    int lane; asm volatile("v_mbcnt_lo_u32_b32 %0, -1, 0\n\tv_mbcnt_hi_u32_b32 %0, -1, %0" : "=v"(lane));
    const int tid = wave * 64 + lane;
    const int b = bh >> 4, h = bh & 15;
    const bf16_t* Rg = (const bf16_t*)(a.ws + WS_R); const bf16_t* Kg = (const bf16_t*)(a.ws + WS_K); const bf16_t* Vg = (const bf16_t*)(a.ws + WS_V);
    const bf16_t* Dg = (const bf16_t*)(a.ws + WS_DARR); const bf16_t* Ag = (const bf16_t*)(a.ws + WS_AARR);
    bf16_t* YAB = (bf16_t*)(a.ws + WS_YAB); float* RK = (float*)((unsigned char*)a.out + DO_RK);
    LAS unsigned* ready = (LAS unsigned*)(lds + CS_FLAGS); LAS unsigned* done = ready + CS_NSLOT; LAS unsigned* rawready = done + CS_NSLOT; LAS unsigned* rawfree = rawready + CS_NSLOT;
    __syncthreads();
    if (tid < 4 * CS_NSLOT) ready[tid] = 0u;
    __syncthreads();
    if (wave == 4) {
        const int rr = lane >> 3, cc = lane & 7;
        for (int c = 0; c < CS_NCH; ++c) {
            const int s = c % CS_NSLOT; LAS unsigned char* rw = lds + CS_RAW + s * CS_RAWSZ;
            const size_t m0 = (size_t)b * SEQ + (size_t)c * CS_L;
            u32x4 v[5][4], vp[3];
#pragma unroll
            for (int ar = 0; ar < 5; ++ar) { const bf16_t* src = (ar == 0) ? Rg : (ar == 1) ? Kg : (ar == 2) ? Vg : (ar == 3) ? Dg : Ag;
#pragma unroll
                for (int q4 = 0; q4 < 4; ++q4) v[ar][q4] = *(const u32x4*)(src + (m0 + 8 * q4 + rr) * DM + h * 64 + 8 * cc); }
#pragma unroll
            for (int ar = 0; ar < 3; ++ar) { const bf16_t* src = (ar == 0) ? Rg : (ar == 1) ? Kg : Vg; vp[ar] = (u32x4){0u, 0u, 0u, 0u};
                if (c > 0 && lane < 8) vp[ar] = *(const u32x4*)(src + (m0 - 1) * DM + h * 64 + 8 * cc); }
            if (c >= CS_NSLOT) lds_poll_ge(rawfree + s, (unsigned)(c / CS_NSLOT));
#pragma unroll
            for (int ar = 0; ar < 5; ++ar)
#pragma unroll
                for (int q4 = 0; q4 < 4; ++q4) *(LAS u32x4*)(rw + (ar * 33 + 1 + 8 * q4 + rr) * 128 + 16 * cc) = v[ar][q4];
            if (lane < 8) {
#pragma unroll
                for (int ar = 0; ar < 3; ++ar) *(LAS u32x4*)(rw + (ar * 33) * 128 + 16 * cc) = vp[ar]; }
            LDS_WAIT();
            if (lane == 0) __hip_atomic_store(rawready + s, (unsigned)(c + 1), __ATOMIC_RELAXED, __HIP_MEMORY_SCOPE_WORKGROUP);
        }
    } else if (wave >= 5) {
        const int hw = wave - 5, gch = h * 64 + lane;
        const float mur = a.mu_rkv[gch], muk = a.mu_rkv[DM + gch], muv = a.mu_rkv[2 * DM + gch], kkw = a.rwkv_vec[2 * DM + gch], kaw = a.rwkv_vec[3 * DM + gch], rkw = a.r_k[gch];
        const int kpos = 32 * (lane >> 5) + permp(lane & 31);
        for (int c = hw; c < CS_NCH; c += CS_NSLOT) {
            const int s = hw; LAS unsigned char* sl = lds + s * CS_SLOT; const LAS unsigned short* rw = (const LAS unsigned short*)(lds + CS_RAW + s * CS_RAWSZ);
            const unsigned use = (unsigned)(c / CS_NSLOT);
            { PROBE_BEGIN(10, a.ws, wave);
            if (use > 0u) lds_poll_ge(done + s, 4u * use);
            lds_poll_ge(rawready + s, (unsigned)(c + 1));
            PROBE_END(10, a.ws, wave); }
            PROBE_BEGIN(11, a.ws, wave);
            const size_t m0 = (size_t)b * SEQ + (size_t)c * CS_L; const size_t o0 = m0 * DM + gch;
            float rp = bflo((unsigned)rw[(0 * 33) * 64 + lane]), kp = bflo((unsigned)rw[(1 * 33) * 64 + lane]), vp = bflo((unsigned)rw[(2 * 33) * 64 + lane]);
            float cum = 0.f, gprev = 1.f;
            unsigned bcw[16], kcw[16], vcw[16];
#pragma unroll
            for (int grp = 0; grp < 4; ++grp) {
                float rlv[8], kkrv[8], kprv[8], vlv[8], aav[8], ddv[8], red[16];
#pragma unroll
                for (int e = 0; e < 8; ++e) { const int row = 1 + 8 * grp + e;
                    const float r0 = bflo((unsigned)rw[(0 * 33 + row) * 64 + lane]), k0 = bflo((unsigned)rw[(1 * 33 + row) * 64 + lane]), v0 = bflo((unsigned)rw[(2 * 33 + row) * 64 + lane]);
                    ddv[e] = bflo((unsigned)rw[(3 * 33 + row) * 64 + lane]); aav[e] = bflo((unsigned)rw[(4 * 33 + row) * 64 + lane]);
                    rlv[e] = r0 + (rp - r0) * mur; const float kl = k0 + (kp - k0) * muk; vlv[e] = v0 + (vp - v0) * muv; rp = r0; kp = k0; vp = v0;
                    kkrv[e] = kl * kkw; kprv[e] = kl * (1.0f + (aav[e] - 1.0f) * kaw);
                    red[2 * e] = kkrv[e] * kkrv[e]; red[2 * e + 1] = rlv[e] * kprv[e] * rkw; }
#pragma unroll
                for (int e = 0; e < 16; ++e) red[e] += dppf<0xB1, 0xf>(red[e]);
#pragma unroll
                for (int e = 0; e < 16; ++e) red[e] += dppf<0x4E, 0xf>(red[e]);
#pragma unroll
                for (int e = 0; e < 16; ++e) red[e] += dppf<0x141, 0xf>(red[e]);
#pragma unroll
                for (int e = 0; e < 16; ++e) red[e] += dppf<0x140, 0xf>(red[e]);
#pragma unroll
                for (int e = 0; e < 16; ++e) red[e] += dppf<0x142, 0xa>(red[e]);
#pragma unroll
                for (int e = 0; e < 16; ++e) red[e] += dppf<0x143, 0xc>(red[e]);
#pragma unroll
                for (int e = 0; e < 16; ++e) red[e] = __int_as_float(__builtin_amdgcn_readlane(__float_as_int(red[e]), 63));
                if (lane < 8) { float rkv = red[1];
#pragma unroll
                    for (int e = 1; e < 8; ++e) rkv = (lane == e) ? red[2 * e + 1] : rkv;
                    RK[(m0 + 8 * grp + lane) * 16 + h] = rkv; }
#pragma unroll
                for (int j2 = 0; j2 < 4; ++j2) {
                    const int i2 = 4 * grp + j2;
                    float nt[2], bt[2], kt[2], rt[2], vt[2];
#pragma unroll
                    for (int e = 0; e < 2; ++e) { const int te = 2 * j2 + e;
                        const float kkv = kkrv[te] * __builtin_amdgcn_rsqf(fmaxf(red[2 * te], 1e-24f)), bb = kkv * aav[te];
                        cum += ddv[te]; const float gi = __expf(-cum), ginv = __builtin_amdgcn_rcpf(gi);
                        nt[e] = -kkv * gprev; bt[e] = bb * ginv; kt[e] = kprv[te] * ginv; rt[e] = rlv[te] * gi; vt[e] = vlv[te]; gprev = gi; }
                    const unsigned wn = pk2(nt[0], nt[1]), wb = pk2(bt[0], bt[1]), wk = pk2(kt[0], kt[1]), wr = pk2(rt[0], rt[1]), wv = pk2(vt[0], vt[1]);
                    const int i = 2 * i2;
                    *(LAS unsigned short*)(sl + CS_NT + (i * 64 + kpos) * 2) = (unsigned short)wn; *(LAS unsigned short*)(sl + CS_NT + ((i + 1) * 64 + kpos) * 2) = (unsigned short)(wn >> 16);
                    *(LAS unsigned short*)(sl + CS_RT + (i * 64 + kpos) * 2) = (unsigned short)wr; *(LAS unsigned short*)(sl + CS_RT + ((i + 1) * 64 + kpos) * 2) = (unsigned short)(wr >> 16);
                    *(LAS unsigned short*)(sl + CS_BT + (i * 64 + kpos) * 2) = (unsigned short)wb; *(LAS unsigned short*)(sl + CS_BT + ((i + 1) * 64 + kpos) * 2) = (unsigned short)(wb >> 16);
                    *(LAS unsigned short*)(sl + CS_KT + (i * 64 + kpos) * 2) = (unsigned short)wk; *(LAS unsigned short*)(sl + CS_KT + ((i + 1) * 64 + kpos) * 2) = (unsigned short)(wk >> 16);
                    const int pw = permp(i) >> 1;
                    bcw[pw] = wb; kcw[pw] = wk; vcw[pw] = wv;
                }
                __builtin_amdgcn_sched_barrier(0);
            }
#pragma unroll
            for (int q4 = 0; q4 < 4; ++q4) {
                *(LAS u32x4*)(sl + CS_BC + lane * 64 + 16 * q4) = (u32x4){bcw[4 * q4], bcw[4 * q4 + 1], bcw[4 * q4 + 2], bcw[4 * q4 + 3]};
                *(LAS u32x4*)(sl + CS_KC + lane * 64 + 16 * q4) = (u32x4){kcw[4 * q4], kcw[4 * q4 + 1], kcw[4 * q4 + 2], kcw[4 * q4 + 3]};
                *(LAS u32x4*)(sl + CS_VC + lane * 64 + 16 * q4) = (u32x4){vcw[4 * q4], vcw[4 * q4 + 1], vcw[4 * q4 + 2], vcw[4 * q4 + 3]}; }
            *(LAS float*)(sl + CS_GL + lane * 4) = gprev;
            LDS_WAIT();
            if (lane == 0) __hip_atomic_store(rawfree + s, use + 1u, __ATOMIC_RELAXED, __HIP_MEMORY_SCOPE_WORKGROUP);
            PROBE_END(11, a.ws, wave);
            PROBE_BEGIN(12, a.ws, wave);
            const int tok = lane & 31, hf = lane >> 5;
            bf16x8 fn[4], fr[4], fb[4], fk[4];
#pragma unroll
            for (int ks = 0; ks < 4; ++ks) { fn[ks] = *(const LAS bf16x8*)(sl + CS_NT + (tok * 64 + 16 * ks + 8 * hf) * 2); fr[ks] = *(const LAS bf16x8*)(sl + CS_RT + (tok * 64 + 16 * ks + 8 * hf) * 2);
                fb[ks] = *(const LAS bf16x8*)(sl + CS_BT + (tok * 64 + 16 * ks + 8 * hf) * 2); fk[ks] = *(const LAS bf16x8*)(sl + CS_KT + (tok * 64 + 16 * ks + 8 * hf) * 2); }
            f32x16 P, Pt, Tm, Akn, Abr, Akr;
#pragma unroll
            for (int e = 0; e < 16; ++e) { P[e] = 0.f; Pt[e] = 0.f; Akn[e] = 0.f; Abr[e] = 0.f; Akr[e] = 0.f; }
#pragma unroll
            for (int ks = 0; ks < 4; ++ks) { P = __builtin_amdgcn_mfma_f32_32x32x16_bf16(fn[ks], fb[ks], P, 0, 0, 0); Pt = __builtin_amdgcn_mfma_f32_32x32x16_bf16(fb[ks], fn[ks], Pt, 0, 0, 0);
                Akn = __builtin_amdgcn_mfma_f32_32x32x16_bf16(fn[ks], fk[ks], Akn, 0, 0, 0); Abr = __builtin_amdgcn_mfma_f32_32x32x16_bf16(fr[ks], fb[ks], Abr, 0, 0, 0); Akr = __builtin_amdgcn_mfma_f32_32x32x16_bf16(fr[ks], fk[ks], Akr, 0, 0, 0); }
#pragma unroll
            for (int e = 0; e < 16; ++e) { const int row = (e & 3) + 8 * (e >> 2) + 4 * hf, col = tok;
                if (!(col < row)) { P[e] = 0.f; Akn[e] = 0.f; } if (!(row < col)) Pt[e] = 0.f; if (col > row) { Abr[e] = 0.f; Akr[e] = 0.f; }
                Tm[e] = P[e] + (row == col ? 1.0f : 0.f); }
#pragma unroll
            for (int mm = 1; mm <= 4; ++mm) {
                const bf16x8 p0 = cfrag(P, 0), p1 = cfrag(P, 1), q0 = cfrag(Pt, 0), q1 = cfrag(Pt, 1);
                f32x16 Ptn, Pn;
#pragma unroll
                for (int e = 0; e < 16; ++e) { Ptn[e] = 0.f; Pn[e] = 0.f; }
                Ptn = __builtin_amdgcn_mfma_f32_32x32x16_bf16(p0, q0, Ptn, 0, 0, 0); Ptn = __builtin_amdgcn_mfma_f32_32x32x16_bf16(p1, q1, Ptn, 0, 0, 0);
                if (mm < 4) { Pn = __builtin_amdgcn_mfma_f32_32x32x16_bf16(q0, p0, Pn, 0, 0, 0); Pn = __builtin_amdgcn_mfma_f32_32x32x16_bf16(q1, p1, Pn, 0, 0, 0); }
                const bf16x8 t0 = cfrag(Tm, 0), t1 = cfrag(Tm, 1), u0 = cfrag(Ptn, 0), u1 = cfrag(Ptn, 1);
                Tm = __builtin_amdgcn_mfma_f32_32x32x16_bf16(u0, t0, Tm, 0, 0, 0); Tm = __builtin_amdgcn_mfma_f32_32x32x16_bf16(u1, t1, Tm, 0, 0, 0);
                P = Pn; Pt = Ptn;
            }
            { const int pc = permp(tok);
#pragma unroll
              for (int e = 0; e < 16; e += 2) { const int row = (e & 3) + 8 * (e >> 2) + 4 * hf;
                const unsigned w0 = pk2(Tm[e], Tm[e + 1]), w1 = pk2(Akn[e], Akn[e + 1]), w2 = pk2(Abr[e], Abr[e + 1]), w3 = pk2(Akr[e], Akr[e + 1]);
                *(LAS unsigned short*)(sl + CS_TM + (row * 32 + pc) * 2) = (unsigned short)w0; *(LAS unsigned short*)(sl + CS_TM + ((row + 1) * 32 + pc) * 2) = (unsigned short)(w0 >> 16);
                *(LAS unsigned short*)(sl + CS_AKN + (row * 32 + pc) * 2) = (unsigned short)w1; *(LAS unsigned short*)(sl + CS_AKN + ((row + 1) * 32 + pc) * 2) = (unsigned short)(w1 >> 16);
                *(LAS unsigned short*)(sl + CS_ABR + (row * 32 + pc) * 2) = (unsigned short)w2; *(LAS unsigned short*)(sl + CS_ABR + ((row + 1) * 32 + pc) * 2) = (unsigned short)(w2 >> 16);
                *(LAS unsigned short*)(sl + CS_AKR + (row * 32 + pc) * 2) = (unsigned short)w3; *(LAS unsigned short*)(sl + CS_AKR + ((row + 1) * 32 + pc) * 2) = (unsigned short)(w3 >> 16); } }
            LDS_WAIT();
            if (lane == 0) __hip_atomic_store(ready + s, (unsigned)(c + 1), __ATOMIC_RELAXED, __HIP_MEMORY_SCOPE_WORKGROUP);
            PROBE_END(12, a.ws, wave);
        }
    } else {
        const int l15 = lane & 15, g = lane >> 4, vb = wave;
        f32x4 xc[4];
#pragma unroll
        for (int kt = 0; kt < 4; ++kt) xc[kt] = (f32x4){0.f, 0.f, 0.f, 0.f};
        for (int c = 0; c < CS_NCH; ++c) {
            const int s = c % CS_NSLOT; const LAS unsigned char* sl = lds + s * CS_SLOT;
            lds_poll_ge(ready + s, (unsigned)(c + 1));
            const bf16x8 xb0 = cfrag2(xc[0], xc[1]), xb1 = cfrag2(xc[2], xc[3]);
            const bf16x8 vop = *(const LAS bf16x8*)(sl + CS_VC + ((16 * vb + l15) * 32 + 8 * g) * 2);
            f32x4 W[2], U[2], Y[2];
#pragma unroll
            for (int rt = 0; rt < 2; ++rt) { const int row = 16 * rt + l15; f32x4 acc = (f32x4){0.f, 0.f, 0.f, 0.f};
                acc = __builtin_amdgcn_mfma_f32_16x16x32_bf16(*(const LAS bf16x8*)(sl + CS_AKN + (row * 32 + 8 * g) * 2), vop, acc, 0, 0, 0);
                acc = __builtin_amdgcn_mfma_f32_16x16x32_bf16(*(const LAS bf16x8*)(sl + CS_NT + (row * 64 + 8 * g) * 2), xb0, acc, 0, 0, 0);
                acc = __builtin_amdgcn_mfma_f32_16x16x32_bf16(*(const LAS bf16x8*)(sl + CS_NT + (row * 64 + 32 + 8 * g) * 2), xb1, acc, 0, 0, 0);
                W[rt] = acc; }
            const bf16x8 wb = cfrag2(W[0], W[1]);
#pragma unroll
            for (int rt = 0; rt < 2; ++rt) { const int row = 16 * rt + l15;
                U[rt] = __builtin_amdgcn_mfma_f32_16x16x32_bf16(*(const LAS bf16x8*)(sl + CS_TM + (row * 32 + 8 * g) * 2), wb, (f32x4){0.f, 0.f, 0.f, 0.f}, 0, 0, 0); }
            const bf16x8 ub = cfrag2(U[0], U[1]);
#pragma unroll
            for (int rt = 0; rt < 2; ++rt) { const int row = 16 * rt + l15; f32x4 acc = (f32x4){0.f, 0.f, 0.f, 0.f};
                acc = __builtin_amdgcn_mfma_f32_16x16x32_bf16(*(const LAS bf16x8*)(sl + CS_AKR + (row * 32 + 8 * g) * 2), vop, acc, 0, 0, 0);
                acc = __builtin_amdgcn_mfma_f32_16x16x32_bf16(*(const LAS bf16x8*)(sl + CS_RT + (row * 64 + 8 * g) * 2), xb0, acc, 0, 0, 0);
                acc = __builtin_amdgcn_mfma_f32_16x16x32_bf16(*(const LAS bf16x8*)(sl + CS_RT + (row * 64 + 32 + 8 * g) * 2), xb1, acc, 0, 0, 0);
                acc = __builtin_amdgcn_mfma_f32_16x16x32_bf16(*(const LAS bf16x8*)(sl + CS_ABR + (row * 32 + 8 * g) * 2), ub, acc, 0, 0, 0);
                Y[rt] = acc; }
#pragma unroll
            for (int kt = 0; kt < 4; ++kt) { const int row = 16 * kt + l15; f32x4 acc = xc[kt];
                acc = __builtin_amdgcn_mfma_f32_16x16x32_bf16(*(const LAS bf16x8*)(sl + CS_KC + (row * 32 + 8 * g) * 2), vop, acc, 0, 0, 0);
                acc = __builtin_amdgcn_mfma_f32_16x16x32_bf16(*(const LAS bf16x8*)(sl + CS_BC + (row * 32 + 8 * g) * 2), ub, acc, 0, 0, 0);
                xc[kt] = acc * *(const LAS f32x4*)(sl + CS_GL + (16 * kt + 4 * g) * 4); }
            LDS_WAIT();
            if (lane == 0) (void)__hip_atomic_fetch_add(done + s, 1u, __ATOMIC_RELAXED, __HIP_MEMORY_SCOPE_WORKGROUP);
#pragma unroll
            for (int rt = 0; rt < 2; ++rt)
#pragma unroll
                for (int e = 0; e < 4; ++e) { const size_t m = (size_t)b * SEQ + (size_t)c * CS_L + 16 * rt + 4 * g + e;
                    YAB[m * 2048 + 1024 + h * 64 + 16 * vb + l15] = (bf16_t)(pk2(Y[rt][e], 0.f) & 0xffffu); }
        }
    }
}

constexpr int CR_PIECE = 12, CR_NP = (CS_NCH + CR_PIECE - 1) / CR_PIECE, CR_PW = 4, CR_PSLOT = CS_SLOT + 2 * 33 * 128;
constexpr size_t DO_IMG = 66 * MiB;
static_assert((CR_PIECE % 4) == 0 && DO_IMG + (size_t)2 * 64 * CR_PIECE * CS_SLOT <= 128 * MiB && CR_PW * CR_PSLOT <= CS_FLAGS, "image buffer / producer slots");

__device__ __forceinline__ void cscan_produce(const Args& a, const int wave, LAS unsigned char* lds, const int piece, const int first, const int nblk) {
    const int nch = (CS_NCH - piece * CR_PIECE) < CR_PIECE ? (CS_NCH - piece * CR_PIECE) : CR_PIECE;
    if (wave >= CR_PW) {
        const int lane = lane_id(); const int iw = ((int)blockIdx.x - first) * (NWAVES - CR_PW) + (wave - CR_PW), niw = nblk * (NWAVES - CR_PW);
        for (int t = piece * 2 * niw + iw; t < (piece + 1) * 2 * niw && t < MTOK; t += niw) rope_item(a, t, lane);
        return; }
    const bf16_t* Rg = (const bf16_t*)(a.ws + WS_R); const bf16_t* Kg = (const bf16_t*)(a.ws + WS_K); const bf16_t* Vg = (const bf16_t*)(a.ws + WS_V);
    const bf16_t* Dg = (const bf16_t*)(a.ws + WS_DARR); const bf16_t* Ag = (const bf16_t*)(a.ws + WS_AARR);
    float* RK = (float*)((unsigned char*)a.out + DO_RK); unsigned char* IMG = (unsigned char*)a.out + DO_IMG + (size_t)(piece & 1) * 64 * CR_PIECE * CS_SLOT;
    LAS unsigned char* sl = lds + wave * CR_PSLOT;
    const LAS unsigned short* rawD = (const LAS unsigned short*)(sl + 16384); const LAS unsigned short* rawA = (const LAS unsigned short*)(sl + 20480);
    const LAS unsigned short* rawR = (const LAS unsigned short*)(sl + 24576); const LAS unsigned short* rawK = (const LAS unsigned short*)(sl + CS_SLOT); const LAS unsigned short* rawV = (const LAS unsigned short*)(sl + CS_SLOT + 33 * 128);
    u32x4 pre[5][4], prep[3];
    auto issue = [&](int it2, int rr, int c8, int lane) { const int bh2 = it2 / nch, cc2 = it2 % nch, c2 = piece * CR_PIECE + cc2; const unsigned mm = (unsigned)(bh2 >> 4) * SEQ + (unsigned)c2 * CS_L; const int hh = bh2 & 15;
        const unsigned eoff = ((mm + rr) * DM + hh * 64 + 8 * c8) * 2u;
        const unsigned char* wsb = a.ws;
#pragma unroll
        for (int ar = 0; ar < 5; ++ar) { constexpr size_t AOFF[5] = {WS_R, WS_K, WS_V, WS_DARR, WS_AARR};
#pragma unroll
            for (int q4 = 0; q4 < 4; ++q4) pre[ar][q4] = *(const u32x4*)(wsb + AOFF[ar] + eoff + (unsigned)(8 * q4 * DM * 2)); }
        const bool hasp = (c2 > 0) && (lane < 8); const unsigned poff = hasp ? (eoff - (unsigned)((rr + 1) * DM * 2)) : eoff;
#pragma unroll
        for (int ar = 0; ar < 3; ++ar) { constexpr size_t AOFF[3] = {WS_R, WS_K, WS_V}; const u32x4 t = *(const u32x4*)(wsb + AOFF[ar] + poff); prep[ar] = hasp ? t : (u32x4){0u, 0u, 0u, 0u}; } };
    const int it0 = ((int)blockIdx.x - first) * CR_PW + wave, nimg = 64 * nch, itstep = nblk * CR_PW;
    { const int l0 = lane_id(); if (it0 < nimg) issue(it0, l0 >> 3, l0 & 7, l0); }
    for (int it = it0; it < nimg; it += itstep) {
        const int lane = lane_id(), rr = lane >> 3, c8 = lane & 7, kpos = 32 * (lane >> 5) + permp(lane & 31);
        const int bh = it / nch, cc = it % nch, b = bh >> 4, h = bh & 15, c = piece * CR_PIECE + cc, gch = h * 64 + lane;
        const float mur = a.mu_rkv[gch], muk = a.mu_rkv[DM + gch], muv = a.mu_rkv[2 * DM + gch], kkw = a.rwkv_vec[2 * DM + gch], kaw = a.rwkv_vec[3 * DM + gch], rkw = a.r_k[gch];
            const size_t m0 = (size_t)b * SEQ + (size_t)c * CS_L;
            { LAS unsigned char* wb = sl + rr * 128 + 16 * c8; asm volatile("" : "+v"(wb));
#pragma unroll
              for (int q4 = 0; q4 < 4; ++q4) {
                *(LAS u32x4*)(wb + 24576 + (8 * q4 + 1) * 128) = pre[0][q4]; *(LAS u32x4*)(wb + CS_SLOT + (8 * q4 + 1) * 128) = pre[1][q4]; *(LAS u32x4*)(wb + CS_SLOT + 33 * 128 + (8 * q4 + 1) * 128) = pre[2][q4];
                *(LAS u32x4*)(wb + 16384 + (8 * q4) * 128) = pre[3][q4]; *(LAS u32x4*)(wb + 20480 + (8 * q4) * 128) = pre[4][q4]; }
              if (lane < 8) { *(LAS u32x4*)(wb + 24576) = prep[0]; *(LAS u32x4*)(wb + CS_SLOT) = prep[1]; *(LAS u32x4*)(wb + CS_SLOT + 33 * 128) = prep[2]; } }
            LDS_WAIT();
            const LAS unsigned short* rb = (const LAS unsigned short*)sl + lane; asm volatile("" : "+v"(rb));
            float rp = bflo((unsigned)rb[24576 / 2]), kp = bflo((unsigned)rb[CS_SLOT / 2]), vp = bflo((unsigned)rb[(CS_SLOT + 33 * 128) / 2]);
            float cum = 0.f, gprev = 1.f;
            unsigned bcw[16], kcw[16], vcw[16];
#pragma unroll
            for (int grp = 0; grp < 4; ++grp) {
                float rlv[8], kkrv[8], kprv[8], vlv[8], aav[8], ddv[8], red[16];
#pragma unroll
                for (int e = 0; e < 8; ++e) { const int row = 8 * grp + e;
                    const float r0 = bflo((unsigned)rb[24576 / 2 + (row + 1) * 64]), k0 = bflo((unsigned)rb[CS_SLOT / 2 + (row + 1) * 64]), v0 = bflo((unsigned)rb[(CS_SLOT + 33 * 128) / 2 + (row + 1) * 64]);
                    ddv[e] = bflo((unsigned)rb[16384 / 2 + row * 64]); aav[e] = bflo((unsigned)rb[20480 / 2 + row * 64]);
                    rlv[e] = r0 + (rp - r0) * mur; const float kl = k0 + (kp - k0) * muk; vlv[e] = v0 + (vp - v0) * muv; rp = r0; kp = k0; vp = v0;
                    kkrv[e] = kl * kkw; kprv[e] = kl * (1.0f + (aav[e] - 1.0f) * kaw);
                    red[2 * e] = kkrv[e] * kkrv[e]; red[2 * e + 1] = rlv[e] * kprv[e] * rkw; }
#pragma unroll
                for (int e = 0; e < 16; ++e) red[e] += dppf<0xB1, 0xf>(red[e]);
#pragma unroll
                for (int e = 0; e < 16; ++e) red[e] += dppf<0x4E, 0xf>(red[e]);
#pragma unroll
                for (int e = 0; e < 16; ++e) red[e] += dppf<0x141, 0xf>(red[e]);
#pragma unroll
                for (int e = 0; e < 16; ++e) red[e] += dppf<0x140, 0xf>(red[e]);
#pragma unroll
                for (int e = 0; e < 16; ++e) red[e] += dppf<0x142, 0xa>(red[e]);
#pragma unroll
                for (int e = 0; e < 16; ++e) red[e] += dppf<0x143, 0xc>(red[e]);
#pragma unroll
                for (int e = 0; e < 16; ++e) red[e] = __int_as_float(__builtin_amdgcn_readlane(__float_as_int(red[e]), 63));
                if (lane < 8) { float rkv = red[1];
#pragma unroll
                    for (int e = 1; e < 8; ++e) rkv = (lane == e) ? red[2 * e + 1] : rkv;
                    RK[(m0 + 8 * grp + lane) * 16 + h] = rkv; }
#pragma unroll
                for (int j2 = 0; j2 < 4; ++j2) {
                    const int i2 = 4 * grp + j2;
                    float nt[2], bt[2], kt[2], rt[2], vt[2];
#pragma unroll
                    for (int e = 0; e < 2; ++e) { const int te = 2 * j2 + e;
                        const float kkv = kkrv[te] * __builtin_amdgcn_rsqf(fmaxf(red[2 * te], 1e-24f)), bb = kkv * aav[te];
                        cum += ddv[te]; const float gi = __expf(-cum), ginv = __builtin_amdgcn_rcpf(gi);
                        nt[e] = -kkv * gprev; bt[e] = bb * ginv; kt[e] = kprv[te] * ginv; rt[e] = rlv[te] * gi; vt[e] = vlv[te]; gprev = gi; }
                    const unsigned wn = pk2(nt[0], nt[1]), wb = pk2(bt[0], bt[1]), wk = pk2(kt[0], kt[1]), wr = pk2(rt[0], rt[1]), wv = pk2(vt[0], vt[1]);
                    const int i = 2 * i2;
                    *(LAS unsigned short*)(sl + CS_NT + (i * 64 + kpos) * 2) = (unsigned short)wn; *(LAS unsigned short*)(sl + CS_NT + ((i + 1) * 64 + kpos) * 2) = (unsigned short)(wn >> 16);
                    *(LAS unsigned short*)(sl + CS_RT + (i * 64 + kpos) * 2) = (unsigned short)wr; *(LAS unsigned short*)(sl + CS_RT + ((i + 1) * 64 + kpos) * 2) = (unsigned short)(wr >> 16);
                    *(LAS unsigned short*)(sl + CS_BT + (i * 64 + kpos) * 2) = (unsigned short)wb; *(LAS unsigned short*)(sl + CS_BT + ((i + 1) * 64 + kpos) * 2) = (unsigned short)(wb >> 16);
                    *(LAS unsigned short*)(sl + CS_KT + (i * 64 + kpos) * 2) = (unsigned short)wk; *(LAS unsigned short*)(sl + CS_KT + ((i + 1) * 64 + kpos) * 2) = (unsigned short)(wk >> 16);
                    const int pw = permp(i) >> 1;
                    bcw[pw] = wb; kcw[pw] = wk; vcw[pw] = wv;
                }
                __builtin_amdgcn_sched_barrier(0);
            }
#pragma unroll
            for (int q4 = 0; q4 < 4; ++q4) {
                *(LAS u32x4*)(sl + CS_BC + lane * 64 + 16 * q4) = (u32x4){bcw[4 * q4], bcw[4 * q4 + 1], bcw[4 * q4 + 2], bcw[4 * q4 + 3]};
                *(LAS u32x4*)(sl + CS_KC + lane * 64 + 16 * q4) = (u32x4){kcw[4 * q4], kcw[4 * q4 + 1], kcw[4 * q4 + 2], kcw[4 * q4 + 3]};
                *(LAS u32x4*)(sl + CS_VC + lane * 64 + 16 * q4) = (u32x4){vcw[4 * q4], vcw[4 * q4 + 1], vcw[4 * q4 + 2], vcw[4 * q4 + 3]}; }
            *(LAS float*)(sl + CS_GL + lane * 4) = gprev;
            LDS_WAIT();
            const int tok = lane & 31, hf = lane >> 5;
            bf16x8 fn[4], fr[4], fb[4], fk[4];
#pragma unroll
            for (int ks = 0; ks < 4; ++ks) { fn[ks] = *(const LAS bf16x8*)(sl + CS_NT + (tok * 64 + 16 * ks + 8 * hf) * 2); fr[ks] = *(const LAS bf16x8*)(sl + CS_RT + (tok * 64 + 16 * ks + 8 * hf) * 2);
                fb[ks] = *(const LAS bf16x8*)(sl + CS_BT + (tok * 64 + 16 * ks + 8 * hf) * 2); fk[ks] = *(const LAS bf16x8*)(sl + CS_KT + (tok * 64 + 16 * ks + 8 * hf) * 2); }
            f32x16 P, Pt, Tm, Akn, Abr, Akr;
#pragma unroll
            for (int e = 0; e < 16; ++e) { P[e] = 0.f; Pt[e] = 0.f; Akn[e] = 0.f; Abr[e] = 0.f; Akr[e] = 0.f; }
#pragma unroll
            for (int ks = 0; ks < 4; ++ks) { P = __builtin_amdgcn_mfma_f32_32x32x16_bf16(fn[ks], fb[ks], P, 0, 0, 0); Pt = __builtin_amdgcn_mfma_f32_32x32x16_bf16(fb[ks], fn[ks], Pt, 0, 0, 0);
                Akn = __builtin_amdgcn_mfma_f32_32x32x16_bf16(fn[ks], fk[ks], Akn, 0, 0, 0); Abr = __builtin_amdgcn_mfma_f32_32x32x16_bf16(fr[ks], fb[ks], Abr, 0, 0, 0); Akr = __builtin_amdgcn_mfma_f32_32x32x16_bf16(fr[ks], fk[ks], Akr, 0, 0, 0); }
#pragma unroll
            for (int e = 0; e < 16; ++e) { const int row = (e & 3) + 8 * (e >> 2) + 4 * hf, col = tok;
                if (!(col < row)) { P[e] = 0.f; Akn[e] = 0.f; } if (!(row < col)) Pt[e] = 0.f; if (col > row) { Abr[e] = 0.f; Akr[e] = 0.f; }
                Tm[e] = P[e] + (row == col ? 1.0f : 0.f); }
#pragma unroll
            for (int mm = 1; mm <= 4; ++mm) {
                const bf16x8 p0 = cfrag(P, 0), p1 = cfrag(P, 1), q0 = cfrag(Pt, 0), q1 = cfrag(Pt, 1);
                f32x16 Ptn, Pn;
#pragma unroll
                for (int e = 0; e < 16; ++e) { Ptn[e] = 0.f; Pn[e] = 0.f; }
                Ptn = __builtin_amdgcn_mfma_f32_32x32x16_bf16(p0, q0, Ptn, 0, 0, 0); Ptn = __builtin_amdgcn_mfma_f32_32x32x16_bf16(p1, q1, Ptn, 0, 0, 0);
                if (mm < 4) { Pn = __builtin_amdgcn_mfma_f32_32x32x16_bf16(q0, p0, Pn, 0, 0, 0); Pn = __builtin_amdgcn_mfma_f32_32x32x16_bf16(q1, p1, Pn, 0, 0, 0); }
                const bf16x8 t0 = cfrag(Tm, 0), t1 = cfrag(Tm, 1), u0 = cfrag(Ptn, 0), u1 = cfrag(Ptn, 1);
                Tm = __builtin_amdgcn_mfma_f32_32x32x16_bf16(u0, t0, Tm, 0, 0, 0); Tm = __builtin_amdgcn_mfma_f32_32x32x16_bf16(u1, t1, Tm, 0, 0, 0);
                P = Pn; Pt = Ptn;
            }
            { const int itn = it + itstep; if (itn < nimg) { const int l2 = lane_id(); issue(itn, l2 >> 3, l2 & 7, l2); } }
            { const int pc = permp(tok);
#pragma unroll
              for (int e = 0; e < 16; e += 2) { const int row = (e & 3) + 8 * (e >> 2) + 4 * hf;
                const unsigned w0 = pk2(Tm[e], Tm[e + 1]), w1 = pk2(Akn[e], Akn[e + 1]), w2 = pk2(Abr[e], Abr[e + 1]), w3 = pk2(Akr[e], Akr[e + 1]);
                *(LAS unsigned short*)(sl + CS_TM + (row * 32 + pc) * 2) = (unsigned short)w0; *(LAS unsigned short*)(sl + CS_TM + ((row + 1) * 32 + pc) * 2) = (unsigned short)(w0 >> 16);
                *(LAS unsigned short*)(sl + CS_AKN + (row * 32 + pc) * 2) = (unsigned short)w1; *(LAS unsigned short*)(sl + CS_AKN + ((row + 1) * 32 + pc) * 2) = (unsigned short)(w1 >> 16);
                *(LAS unsigned short*)(sl + CS_ABR + (row * 32 + pc) * 2) = (unsigned short)w2; *(LAS unsigned short*)(sl + CS_ABR + ((row + 1) * 32 + pc) * 2) = (unsigned short)(w2 >> 16);
                *(LAS unsigned short*)(sl + CS_AKR + (row * 32 + pc) * 2) = (unsigned short)w3; *(LAS unsigned short*)(sl + CS_AKR + ((row + 1) * 32 + pc) * 2) = (unsigned short)(w3 >> 16); } }
            LDS_WAIT();
            { unsigned char* dst = IMG + (size_t)(bh * CR_PIECE + cc) * CS_SLOT;
#pragma unroll 1
              for (int j = lane; j < CS_SLOT / 16; j += 64) *(u32x4*)(dst + 16 * j) = *(const LAS u32x4*)(sl + 16 * j); }
            LDS_WAIT();
    }
}

__device__ __forceinline__ void cscan_consume(const Args& a, const int wave, LAS unsigned char* lds, const int bh, const int piece, f32x4 (&xc)[4]) {
    const int lane = lane_id();
    const int b = bh >> 4, h = bh & 15;
    bf16_t* YAB = (bf16_t*)(a.ws + WS_YAB); const unsigned char* IMG = (const unsigned char*)a.out + DO_IMG + (size_t)(piece & 1) * 64 * CR_PIECE * CS_SLOT;
    const int nch = (CS_NCH - piece * CR_PIECE) < CR_PIECE ? (CS_NCH - piece * CR_PIECE) : CR_PIECE;
    LAS unsigned* ready = (LAS unsigned*)(lds + CS_FLAGS); LAS unsigned* done = ready + 4;
    if (wave == 4) {
        constexpr int NI = (CS_SLOT + 1023) / 1024;
        for (int cc = 0; cc <= nch; ++cc) {
            if (cc < nch) { const int c = piece * CR_PIECE + cc, s = cc & 3; LAS unsigned char* sl = lds + s * CS_SLOT;
                const unsigned char* src = IMG + (size_t)(bh * CR_PIECE + cc) * CS_SLOT;
                if (c >= 4) lds_poll_ge(done + s, 4u * (unsigned)(c >> 2));
#pragma unroll
                for (int j = 0; j < NI; ++j) { const int idx = lane + 64 * j;
                    if (idx < CS_SLOT / 16) __builtin_amdgcn_global_load_lds((const unsigned*)(src + 16 * idx), (LAS unsigned*)(sl + 1024 * j), 16, 0, 0); } }
            if (cc >= 1) {
                if (cc < nch) asm volatile("s_waitcnt vmcnt(29)" ::: "memory"); else asm volatile("s_waitcnt vmcnt(0)" ::: "memory");
                if (lane == 0) __hip_atomic_store(ready + ((cc - 1) & 3), (unsigned)(piece * CR_PIECE + cc), __ATOMIC_RELAXED, __HIP_MEMORY_SCOPE_WORKGROUP); }
        }
    } else if (wave < 4) {
        const int l15 = lane & 15, g = lane >> 4, vb = wave;
        for (int cc = 0; cc < nch; ++cc) { const int c = piece * CR_PIECE + cc, s = cc & 3; const LAS unsigned char* sl = lds + s * CS_SLOT;
            { lds_poll_ge(ready + s, (unsigned)(c + 1)); }
            const bf16x8 xb0 = cfrag2(xc[0], xc[1]), xb1 = cfrag2(xc[2], xc[3]);
            const bf16x8 vop = *(const LAS bf16x8*)(sl + CS_VC + ((16 * vb + l15) * 32 + 8 * g) * 2);
            f32x4 W[2], U[2], Y[2];
#pragma unroll
            for (int rt = 0; rt < 2; ++rt) { const int row = 16 * rt + l15; f32x4 acc = (f32x4){0.f, 0.f, 0.f, 0.f};
                acc = __builtin_amdgcn_mfma_f32_16x16x32_bf16(*(const LAS bf16x8*)(sl + CS_AKN + (row * 32 + 8 * g) * 2), vop, acc, 0, 0, 0);
                acc = __builtin_amdgcn_mfma_f32_16x16x32_bf16(*(const LAS bf16x8*)(sl + CS_NT + (row * 64 + 8 * g) * 2), xb0, acc, 0, 0, 0);
                acc = __builtin_amdgcn_mfma_f32_16x16x32_bf16(*(const LAS bf16x8*)(sl + CS_NT + (row * 64 + 32 + 8 * g) * 2), xb1, acc, 0, 0, 0);
                W[rt] = acc; }
            const bf16x8 wb = cfrag2(W[0], W[1]);
#pragma unroll
            for (int rt = 0; rt < 2; ++rt) { const int row = 16 * rt + l15;
                U[rt] = __builtin_amdgcn_mfma_f32_16x16x32_bf16(*(const LAS bf16x8*)(sl + CS_TM + (row * 32 + 8 * g) * 2), wb, (f32x4){0.f, 0.f, 0.f, 0.f}, 0, 0, 0); }
            const bf16x8 ub = cfrag2(U[0], U[1]);
#pragma unroll
            for (int rt = 0; rt < 2; ++rt) { const int row = 16 * rt + l15; f32x4 acc = (f32x4){0.f, 0.f, 0.f, 0.f};
                acc = __builtin_amdgcn_mfma_f32_16x16x32_bf16(*(const LAS bf16x8*)(sl + CS_AKR + (row * 32 + 8 * g) * 2), vop, acc, 0, 0, 0);
                acc = __builtin_amdgcn_mfma_f32_16x16x32_bf16(*(const LAS bf16x8*)(sl + CS_RT + (row * 64 + 8 * g) * 2), xb0, acc, 0, 0, 0);
                acc = __builtin_amdgcn_mfma_f32_16x16x32_bf16(*(const LAS bf16x8*)(sl + CS_RT + (row * 64 + 32 + 8 * g) * 2), xb1, acc, 0, 0, 0);
                acc = __builtin_amdgcn_mfma_f32_16x16x32_bf16(*(const LAS bf16x8*)(sl + CS_ABR + (row * 32 + 8 * g) * 2), ub, acc, 0, 0, 0);
                Y[rt] = acc; }
#pragma unroll
            for (int kt = 0; kt < 4; ++kt) { const int row = 16 * kt + l15; f32x4 acc = xc[kt];
                acc = __builtin_amdgcn_mfma_f32_16x16x32_bf16(*(const LAS bf16x8*)(sl + CS_KC + (row * 32 + 8 * g) * 2), vop, acc, 0, 0, 0);
                acc = __builtin_amdgcn_mfma_f32_16x16x32_bf16(*(const LAS bf16x8*)(sl + CS_BC + (row * 32 + 8 * g) * 2), ub, acc, 0, 0, 0);
                xc[kt] = acc * *(const LAS f32x4*)(sl + CS_GL + (16 * kt + 4 * g) * 4); }
            LDS_WAIT();
            if (lane == 0) (void)__hip_atomic_fetch_add(done + s, 1u, __ATOMIC_RELAXED, __HIP_MEMORY_SCOPE_WORKGROUP);
#pragma unroll
            for (int rt = 0; rt < 2; ++rt)
#pragma unroll
                for (int e = 0; e < 4; ++e) { const size_t m = (size_t)b * SEQ + (size_t)c * CS_L + 16 * rt + 4 * g + e;
                    YAB[m * 2048 + 1024 + h * 64 + 16 * vb + l15] = (bf16_t)(pk2(Y[rt][e], 0.f) & 0xffffu); }
        }
    }
}

constexpr int DS_NQ = 16, DS_CAP = 2048, DS_TRIG = 1536, DS_TOPK = 256;
constexpr int DS_HIST_WORDS = 320;
constexpr int DS_KT_BYTES = 2048;
constexpr int DS_CAND_OFF = 0, DS_HIST_OFF = DS_NQ * DS_CAP * 4, DS_KT_OFF = DS_HIST_OFF, DS_CNT_OFF = DS_HIST_OFF + 8 * DS_KT_BYTES, DS_TAU_OFF = DS_CNT_OFF + 64;
static_assert(8 * DS_HIST_WORDS * 4 <= 8 * DS_KT_BYTES, "dsa LDS map");
static_assert(DS_TAU_OFF + 64 <= LDS_BYTES, "dsa LDS map");

template <int CTRL, int RM> __device__ __forceinline__ unsigned dppu(unsigned x) { return (unsigned)__builtin_amdgcn_update_dpp(0, (int)x, CTRL, RM, 0xf, true); }
__device__ __forceinline__ unsigned wave_scan_incl(unsigned v) {
    v += dppu<0x111, 0xf>(v); v += dppu<0x112, 0xf>(v); v += dppu<0x114, 0xf>(v); v += dppu<0x118, 0xf>(v);
    v += dppu<0x142, 0xa>(v);
    v += dppu<0x143, 0xc>(v);
    return v; }
template <int NE>
__device__ __forceinline__ void select_compact(LAS unsigned* cq, LAS unsigned* cntq, LAS unsigned* tauq, LAS unsigned* hist, int lane) {
    const unsigned n = *cntq;
    unsigned e[NE];
#pragma unroll
    for (int j = 0; j < NE; ++j) { const unsigned idx = lane + 64 * j; e[j] = idx < n ? cq[idx] : 0u; }
    unsigned npos = 0u;
#pragma unroll
    for (int j = 0; j < NE; ++j) npos += (unsigned)__popcll(__ballot(e[j] >= 0x80000000u));
    if (npos >= (unsigned)DS_TOPK) {
#pragma unroll
        for (int j = 0; j < NE; ++j) e[j] = (e[j] >= 0x80000000u) ? e[j] : 0u; }
    unsigned va = 0xFFFFFFFFu, vo = 0u;
#pragma unroll
    for (int j = 0; j < NE; ++j) { va &= (e[j] != 0u) ? e[j] : 0xFFFFFFFFu; vo |= e[j]; }
    va &= (unsigned)__builtin_amdgcn_update_dpp(-1, (int)va, 0xB1, 0xf, 0xf, true); va &= (unsigned)__builtin_amdgcn_update_dpp(-1, (int)va, 0x4E, 0xf, 0xf, true);
    va &= (unsigned)__builtin_amdgcn_update_dpp(-1, (int)va, 0x141, 0xf, 0xf, true); va &= (unsigned)__builtin_amdgcn_update_dpp(-1, (int)va, 0x140, 0xf, 0xf, true);
    vo |= dppu<0xB1, 0xf>(vo); vo |= dppu<0x4E, 0xf>(vo); vo |= dppu<0x141, 0xf>(vo); vo |= dppu<0x140, 0xf>(vo);
    const unsigned vas = (unsigned)(__builtin_amdgcn_readlane((int)va, 0) & __builtin_amdgcn_readlane((int)va, 16) & __builtin_amdgcn_readlane((int)va, 32) & __builtin_amdgcn_readlane((int)va, 48));
    const unsigned vos = (unsigned)(__builtin_amdgcn_readlane((int)vo, 0) | __builtin_amdgcn_readlane((int)vo, 16) | __builtin_amdgcn_readlane((int)vo, 32) | __builtin_amdgcn_readlane((int)vo, 48));
    const unsigned diff = vas ^ vos;
    const int top = diff ? 31 - __builtin_clz(diff) : 7;
    unsigned prefix = (top >= 31) ? 0u : (vos & ~((2u << top) - 1u)), mask = (top >= 31) ? 0u : ~((2u << top) - 1u), need = DS_TOPK;
    int hi = top;
    const int rl = 63 - lane;
#pragma unroll 1
    for (int pass = 0; pass < 4 && hi >= 0; ++pass) {
        const int shift = hi >= 7 ? hi - 7 : 0; const unsigned dmask = (hi >= 7) ? 0xFFu : ((2u << hi) - 1u);
        *(LAS u32x4*)(hist + 4 * lane) = (u32x4){0u, 0u, 0u, 0u};
        LDS_WAIT();
#pragma unroll
        for (int j = 0; j < NE; ++j) { const bool hit = (e[j] != 0u) && ((e[j] & mask) == prefix); const unsigned bin = hit ? ((e[j] >> shift) & dmask) : (256u + (unsigned)lane);
            (void)__hip_atomic_fetch_add(hist + bin, 1u, __ATOMIC_RELAXED, __HIP_MEMORY_SCOPE_WORKGROUP); }
        LDS_WAIT();
        const u32x4 h4 = *(const LAS u32x4*)(hist + 4 * rl);
        const unsigned tot = (h4.x + h4.y) + (h4.z + h4.w);
        const unsigned v = wave_scan_incl(tot);
        const unsigned above = v - tot;
        const bool is = (above < need) && (need <= v);
        unsigned B = 0u, ca = 0u;
        if (is) { unsigned c = above;
            if (c + h4.w >= need) { B = 4 * rl + 3; ca = c; } else { c += h4.w;
            if (c + h4.z >= need) { B = 4 * rl + 2; ca = c; } else { c += h4.z;
            if (c + h4.y >= need) { B = 4 * rl + 1; ca = c; } else { c += h4.y; B = 4 * rl; ca = c; } } } }
        const unsigned long long bal = __ballot(is);
        if (bal == 0ull) break;
        const int src = __builtin_amdgcn_readfirstlane(__ffsll((long long)bal) - 1);
        B = (unsigned)__builtin_amdgcn_readlane((int)B, src); ca = (unsigned)__builtin_amdgcn_readlane((int)ca, src);
        need -= ca; prefix |= B << shift; mask |= dmask << shift; hi = shift - 1;
    }
    const unsigned T = prefix;
    unsigned base = 0u;
#pragma unroll
    for (int j = 0; j < NE; ++j) { const bool keep = (e[j] >= T) && (e[j] != 0u); const unsigned long long bal = __ballot(keep);
        const unsigned pos = base + __builtin_amdgcn_mbcnt_hi((unsigned)(bal >> 32), __builtin_amdgcn_mbcnt_lo((unsigned)bal, 0u));
        if (keep) cq[pos] = e[j];
        base += (unsigned)__popcll(bal); }
    if (lane == 0) { *cntq = base; *tauq = T; }
    LDS_WAIT();
}

template <int NE>
__device__ __forceinline__ void filter_compact(LAS unsigned* cq, LAS unsigned* cntq, LAS unsigned* tauq, int lane) {
    const unsigned n = *cntq;
    unsigned e[NE];
#pragma unroll
    for (int j = 0; j < NE; ++j) { const unsigned idx = lane + 64 * j; e[j] = idx < n ? cq[idx] : 0u; }
    unsigned m0 = 0u, m1 = 0u, m2 = 0u, m3 = 0u;
#pragma unroll
    for (int j = 0; j < NE; ++j) { unsigned x = e[j], t;
        t = max(m0, x); x = min(m0, x); m0 = t; t = max(m1, x); x = min(m1, x); m1 = t; t = max(m2, x); x = min(m2, x); m2 = t; m3 = max(m3, x); }
    unsigned T = m3;
    T = min(T, (unsigned)__builtin_amdgcn_update_dpp(-1, (int)T, 0xB1, 0xf, 0xf, true)); T = min(T, (unsigned)__builtin_amdgcn_update_dpp(-1, (int)T, 0x4E, 0xf, 0xf, true));
    T = min(T, (unsigned)__builtin_amdgcn_update_dpp(-1, (int)T, 0x141, 0xf, 0xf, true)); T = min(T, (unsigned)__builtin_amdgcn_update_dpp(-1, (int)T, 0x140, 0xf, 0xf, true));
    T = min(min((unsigned)__builtin_amdgcn_readlane((int)T, 0), (unsigned)__builtin_amdgcn_readlane((int)T, 16)), min((unsigned)__builtin_amdgcn_readlane((int)T, 32), (unsigned)__builtin_amdgcn_readlane((int)T, 48)));
    unsigned base = 0u;
#pragma unroll
    for (int j = 0; j < NE; ++j) { const bool keep = (e[j] >= T) && (e[j] != 0u); const unsigned long long bal = __ballot(keep);
        const unsigned pos = base + __builtin_amdgcn_mbcnt_hi((unsigned)(bal >> 32), __builtin_amdgcn_mbcnt_lo((unsigned)bal, 0u));
        if (keep) cq[pos] = e[j];
        base += (unsigned)__popcll(bal); }
    if (lane == 0) { *cntq = base; *tauq = (T > 0u) ? T - 1u : 0u; }
    LDS_WAIT();
}

__device__ __forceinline__ float relu_(float x) { return __int_as_float(max(__float_as_int(x), 0)); }
__device__ __forceinline__ unsigned vrow_off(int pr) { return (unsigned)(pr < 28 ? 1024 + 256 * pr : 9216 + 256 * (pr - 28)); }
__device__ __forceinline__ unsigned swz_b(int row) { return (unsigned)(((row & 3) << 2) | ((row >> 2) & 3)); }

__device__ __forceinline__ void dsa_phase(const Args& a, const int wave, LAS unsigned char* lds, const bool dry = false) {
    const bf16_t* Qg = (const bf16_t*)(a.ws + WS_Q); const bf16_t* KVg = (const bf16_t*)(a.ws + WS_KV); const bf16_t* QIg = (const bf16_t*)(a.ws + WS_QI);
    const bf16_t* KIg = (const bf16_t*)(a.ws + WS_KI); const float* WIg = (const float*)(a.ws + WS_WI); bf16_t* Gg = (bf16_t*)(a.ws + WS_G);
    LAS unsigned* cand = (LAS unsigned*)(lds + DS_CAND_OFF); LAS unsigned* hist = (LAS unsigned*)(lds + DS_HIST_OFF) + wave * DS_HIST_WORDS;
    LAS unsigned* cnt = (LAS unsigned*)(lds + DS_CNT_OFF); LAS unsigned* taup = (LAS unsigned*)(lds + DS_TAU_OFF);
    for (int L = blockIdx.x; L < 2048; L += gridDim.x) {
        int lane; asm volatile("v_mbcnt_lo_u32_b32 %0, -1, 0\n\tv_mbcnt_hi_u32_b32 %0, -1, %0" : "=v"(lane));
        const int tid = wave * 64 + lane, ql = lane & 15, gq = lane >> 4;
        int b, j;
        if (gridDim.x == 256) { const int i = blockIdx.x, ui = L >> 8, x = i & 7, li = (i >> 3) * 2 + (x >> 2); b = x & 3; j = 128 * (ui >> 1) + ((ui & 1) ? 127 - li : li); }
        else { b = L >> 9; j = L & 511; }
        const unsigned mb = (unsigned)b * SEQ; const int q0 = DS_NQ * j; const unsigned mq = mb + q0 + ql;
        const int pos0 = a.pos[mb]; int nadm = ((a.pos[mq] >> 6) + 1) * 64 - pos0; nadm = nadm > SEQ ? SEQ : nadm;
        int nmax = ((a.pos[mb + q0 + DS_NQ - 1] >> 6) + 1) * 64 - pos0; nmax = nmax > SEQ ? SEQ : nmax;
        const int nstep = (nmax + 511) >> 9;
#ifdef DSA_REP_STREAM
        for (int srep_ = 0; srep_ < 2; ++srep_) { const bool sdry = (srep_ == 0) && a.ph_hi > 0;
#ifndef DSA_DRYMODE
#define DSA_DRYMODE 0
#endif
#else
        const bool sdry = false;
#define DSA_DRYMODE 0
#endif
        __syncthreads();
        if (tid < DS_NQ) { cnt[tid] = 0u; taup[tid] = 0u; }
        bf16x8 bq[8][2];
#pragma unroll
        for (int h = 0; h < 8; ++h)
#pragma unroll
            for (int ks = 0; ks < 2; ++ks) bq[h][ks] = *(const bf16x8*)(QIg + (mq * 512u + h * 64 + 32 * ks + 8 * gq));
        f32x2 wh[8]; { const f32x4 w0 = *(const f32x4*)(WIg + mq * 8), w1 = *(const f32x4*)(WIg + mq * 8 + 4);
#pragma unroll
            for (int h = 0; h < 4; ++h) { wh[h] = (f32x2){w0[h], w0[h]}; wh[4 + h] = (f32x2){w1[h], w1[h]}; } }
        __syncthreads();
        u32x4 ka[8];
        const unsigned ktb = (unsigned)(size_t)(lds + DS_KT_OFF) + (unsigned)wave * DS_KT_BYTES;
        { unsigned ko = (mb + 64 * wave) * 64u + 8u * lane, ko1 = ko + 2048u;
          asm volatile("" : "+v"(ko), "+v"(ko1));
#pragma unroll
          for (int j8 = 0; j8 < 8; ++j8) ka[j8] = *(const u32x4*)(KIg + ((j8 & 4) ? ko1 : ko) + (j8 & 3) * 512); }
        for (int step = 0; step <= nstep; ++step) {
            const int kb = 512 * step + 64 * wave; const bool active = (kb < nmax) && (step < nstep);
            PROBE_BEGIN(2, a.ws, wave);
            if (active) {
                f32x2 sc2[8];
#pragma unroll
                for (int i = 0; i < 8; ++i) sc2[i] = (f32x2){0.f, 0.f};
                const int ln = lane_id();
                const unsigned kw0 = ktb + (unsigned)(ln >> 3) * 128u + (unsigned)(((ln & 7) ^ (ln >> 4)) << 4);
                const unsigned kr0 = ktb + (unsigned)(ln & 15) * 128u + (unsigned)(((ln >> 4) ^ ((ln & 15) >> 1)) << 4);
                const int kbn = (kb + 512 < SEQ) ? kb + 512 : kb; unsigned ko = (mb + kbn) * 64u + 8u * ln, ko1 = ko + 2048u;
                asm volatile("" : "+v"(ko), "+v"(ko1));
#pragma unroll
                for (int st = 0; st < 4; ++st) {
                    *(LAS u32x4*)(size_t)kw0 = ka[2 * st]; *(LAS u32x4*)(size_t)(kw0 ^ 1088u) = ka[2 * st + 1];
                    LDS_WAIT();
                    if (!(sdry && (DSA_DRYMODE & 1))) {
                        ka[2 * st] = *(const u32x4*)(KIg + ((st & 2) ? ko1 : ko) + (2 * st & 3) * 512); ka[2 * st + 1] = *(const u32x4*)(KIg + ((st & 2) ? ko1 : ko) + ((2 * st + 1) & 3) * 512); }
                    const bf16x8 af0 = *(const LAS bf16x8*)(size_t)kr0, af1 = *(const LAS bf16x8*)(size_t)(kr0 ^ 64u);
#pragma unroll
                    for (int h = 0; h < 8; ++h) { f32x4 acc = (f32x4){0.f, 0.f, 0.f, 0.f};
                        acc = __builtin_amdgcn_mfma_f32_16x16x32_bf16(af0, bq[h][0], acc, 0, 0, 0); acc = __builtin_amdgcn_mfma_f32_16x16x32_bf16(af1, bq[h][1], acc, 0, 0, 0);
                        sc2[2 * st] += wh[h] * (f32x2){relu_(acc[0]), relu_(acc[1])}; sc2[2 * st + 1] += wh[h] * (f32x2){relu_(acc[2]), relu_(acc[3])}; }
                    __builtin_amdgcn_sched_barrier(0);
                }
                float sc[16];
#pragma unroll
                for (int i = 0; i < 8; ++i) { sc[2 * i] = sc2[i][0]; sc[2 * i + 1] = sc2[i][1]; }
                __builtin_amdgcn_sched_barrier(0);
                const unsigned tp = taup[ql]; unsigned pm = 0u;
#pragma unroll
                for (int i = 0; i < 16; ++i) { const int key = kb + 16 * (i >> 2) + 4 * gq + (i & 3); const unsigned u = __float_as_uint(sc[i]);
                    const unsigned ord = (u & 0x80000000u) ? ~u : (u | 0x80000000u); const unsigned pk = (ord & 0xFFFFE000u) | (unsigned)key;
                    sc[i] = __uint_as_float(pk);
                    if (key < nadm && pk > tp) pm |= 1u << i; }
                if (sdry && (DSA_DRYMODE & 2)) pm = 0u;
                const unsigned n = (unsigned)__popc(pm);
                unsigned k = 0u; if (n) k = __hip_atomic_fetch_add(cnt + ql, n, __ATOMIC_RELAXED, __HIP_MEMORY_SCOPE_WORKGROUP);
                LAS unsigned* cq = cand + ql * DS_CAP;
#pragma unroll
                for (int i = 0; i < 16; ++i) if (pm & (1u << i)) { cq[k] = __float_as_uint(sc[i]); ++k; }
            }
            __syncthreads();
            PROBE_END(2, a.ws, wave);
            const u32x4 c0 = *(const LAS u32x4*)(cnt), c1 = *(const LAS u32x4*)(cnt + 4), c2 = *(const LAS u32x4*)(cnt + 8), c3 = *(const LAS u32x4*)(cnt + 12);
            unsigned cm = max(max(max(c0.x, c0.y), max(c0.z, c0.w)), max(max(c1.x, c1.y), max(c1.z, c1.w)));
            cm = max(cm, max(max(max(c2.x, c2.y), max(c2.z, c2.w)), max(max(c3.x, c3.y), max(c3.z, c3.w))));
            const unsigned trig = (step == nstep) ? (unsigned)DS_TOPK : (unsigned)DS_TRIG;
#ifdef DSA_SEL2
            const int nsel = (step == nstep) ? 4 : 2;
#else
            const int nsel = 2;
#endif
            if (cm > trig) {
                PROBE_BEGIN(1, a.ws, wave);
#pragma unroll 1
                for (int qq = 0; qq < nsel; ++qq) { const int q = 2 * wave + (qq & 1); if (cnt[q] > trig || qq >= 2) {
                    if (step != nstep) filter_compact<32>(cand + q * DS_CAP, cnt + q, taup + q, lane);
                    if (step == nstep || cnt[q] > (unsigned)DS_TRIG) select_compact<32>(cand + q * DS_CAP, cnt + q, taup + q, hist, lane); } }
                __syncthreads();
                PROBE_END(1, a.ws, wave);
            }
        }
#ifdef DSA_REP_STREAM
        }
#endif
        const bf16_t* KVb = KVg + (size_t)mb * 256;
        int lane_a = lane; asm volatile("" : "+v"(lane_a));
        const int g16 = lane_a >> 4, l15 = lane_a & 15;
        const unsigned vbase = (unsigned)(size_t)(lds + DS_CAND_OFF) + (unsigned)wave * 16384u;
        unsigned ta0, ta1;
        { const int q = l15 >> 2, p = lane_a & 3; const int pr0 = 8 * g16 + q, pr1 = pr0 + 4;
          ta0 = vbase + vrow_off(pr0) + 16u * ((unsigned)(p >> 1) ^ swz_b(pr0)) + 8u * (unsigned)(p & 1);
          ta1 = vbase + vrow_off(pr1) + 16u * ((unsigned)(p >> 1) ^ swz_b(pr1)) + 8u * (unsigned)(p & 1); }
        const unsigned kwa = vbase + 10240u + (unsigned)(4 * g16) * 256u + (unsigned)((l15 ^ (4 * g16)) << 4);
        const unsigned kra = vbase + 10240u + (unsigned)l15 * 256u + (unsigned)((g16 ^ l15) << 4);
        const unsigned owa = vbase + 10240u + (unsigned)l15 * 256u + (unsigned)((g16 ^ l15) << 4);
        const unsigned ora = vbase + 10240u + (unsigned)(lane_a >> 3) * 256u + (unsigned)(((2 * (lane_a & 7)) ^ (lane_a >> 3)) << 4);
        unsigned vwa[8];
#pragma unroll
        for (int j2 = 0; j2 < 8; ++j2) { const int srow = 4 * j2 + g16; const int pr = (srow < 16) ? 8 * (srow >> 2) + (srow & 3) : 8 * ((srow - 16) >> 2) + 4 + (srow & 3);
            vwa[j2] = vbase + vrow_off(pr) + 16u * ((unsigned)l15 ^ swz_b(pr)); }
#ifdef DSA_REP_ATT
        for (int arep_ = 0; arep_ < 2; ++arep_) { const bool dry2 = dry || (arep_ == 0 && a.ph_hi > 0);
#else
        { const bool dry2 = dry;
#endif
#pragma unroll 1
        for (int qq = 0; qq < 2; ++qq) {
            const int q = 2 * wave + qq; const unsigned m = mb + q0 + q; const int n = (int)cnt[q]; const LAS unsigned* cq = cand + q * DS_CAP;
            bf16x8 qb[4];
            { u32x4 qr[4];
#pragma unroll
              for (int i = 0; i < 4; ++i) qr[i] = *(const u32x4*)(Qg + (m * 2048u + (unsigned)(4 * g16 + i) * 128u + 8u * l15));
#pragma unroll
              for (int i = 0; i < 4; ++i) *(LAS u32x4*)(size_t)(kwa ^ (unsigned)((i << 8) | (i << 4))) = qr[i];
              LDS_WAIT();
#pragma unroll
              for (int ks = 0; ks < 4; ++ks) qb[ks] = *(const LAS bf16x8*)(size_t)(kra ^ (unsigned)(ks << 6));
              LDS_WAIT(); }
            f32x4 sacc[16];
            const int nl = n - l15; const LAS unsigned* cql = cq + l15;
            u32x4 kr[5][4];
            auto kload = [&](int jt, u32x4 (&dst)[4]) { const u32x4 e4 = *(const LAS u32x4*)(cq + 16 * jt + 4 * g16);
#pragma unroll
                for (int i = 0; i < 4; ++i) dst[i] = *(const u32x4*)(KVb + ((e4[i] & 0x1FFFu) * 256u + 8u * l15)); };
            kload(0, kr[0]); kload(1, kr[1]); kload(2, kr[2]); kload(3, kr[3]);
#pragma unroll
            for (int jt = 0; jt < 16; ++jt) {
                if (jt + 4 < 16) kload(jt + 4, kr[(jt + 4) % 5]);
#pragma unroll
                for (int i = 0; i < 4; ++i) *(LAS u32x4*)(size_t)(kwa ^ (unsigned)((i << 8) | (i << 4))) = kr[jt % 5][i];
                LDS_WAIT();
                bf16x8 fa[4];
#pragma unroll
                for (int ks = 0; ks < 4; ++ks) fa[ks] = *(const LAS bf16x8*)(size_t)(kra ^ (unsigned)(ks << 6));
                f32x4 acc = (f32x4){0.f, 0.f, 0.f, 0.f};
#pragma unroll
                for (int ks = 0; ks < 4; ++ks) acc = __builtin_amdgcn_mfma_f32_16x16x32_bf16(fa[ks], qb[ks], acc, 0, 0, 0);
                sacc[jt] = acc;
            }
            u32x4 vr[2][8]; const int ng = n - g16; const LAS unsigned* cqg = cq + g16;
            auto vload = [&](int kk, u32x4 (&dst)[8]) {
#pragma unroll
                for (int j2 = 0; j2 < 8; ++j2) { const int sl = 32 * kk + 4 * j2; const unsigned e = cqg[sl]; const unsigned key = (sl < ng) ? (e & 0x1FFFu) : 0u;
                    dst[j2] = *(const u32x4*)(KVb + (key * 256u + 128u + 8u * l15)); } };
            vload(0, vr[0]); vload(1, vr[1]);
            __builtin_amdgcn_sched_barrier(0);
            float mx = -1e30f; const float nnf = (float)(n - 4 * g16 - 1);
#pragma unroll
            for (int jt = 0; jt < 16; ++jt)
#pragma unroll
                for (int r = 0; r < 4; ++r) { sacc[jt][r] = fmaf(fminf(nnf - (float)(16 * jt + r), 0.f), 1e30f, sacc[jt][r]); mx = fmaxf(mx, sacc[jt][r]); }
            mx = fmaxf(mx, __shfl_xor(mx, 16)); mx = fmaxf(mx, __shfl_xor(mx, 32));
            float sum = 0.f;
#pragma unroll
            for (int jt = 0; jt < 16; ++jt)
#pragma unroll
                for (int r = 0; r < 4; ++r) { const float p = __builtin_amdgcn_exp2f(sacc[jt][r] - mx); sacc[jt][r] = p; sum += p; }
            sum += __shfl_xor(sum, 16); sum += __shfl_xor(sum, 32);
            u32x4 pfr[8];
#pragma unroll
            for (int kk = 0; kk < 8; ++kk) { const f32x4 pa = sacc[2 * kk], pb2 = sacc[2 * kk + 1];
                pfr[kk].x = pk2(pa[0], pa[1]); pfr[kk].y = pk2(pa[2], pa[3]); pfr[kk].z = pk2(pb2[0], pb2[1]); pfr[kk].w = pk2(pb2[2], pb2[3]); }
            __builtin_amdgcn_sched_barrier(0);
            f32x4 o[8];
#pragma unroll
            for (int c = 0; c < 8; ++c) o[c] = (f32x4){0.f, 0.f, 0.f, 0.f};
#pragma unroll
            for (int kk = 0; kk < 8; ++kk) {
#pragma unroll
                for (int j2 = 0; j2 < 8; ++j2) *(LAS u32x4*)(size_t)vwa[j2] = vr[kk & 1][j2];
                __builtin_amdgcn_sched_barrier(0);
                if (kk + 2 < 8) vload(kk + 2, vr[kk & 1]);
                LDS_WAIT();
                const bf16x8 pfrag = __builtin_bit_cast(bf16x8, pfr[kk]);
#pragma unroll
                for (int ch = 0; ch < 2; ++ch) {
                    s16x4 t0[4], t1[4];
                    asm volatile("ds_read_b64_tr_b16 %0, %8\n\tds_read_b64_tr_b16 %1, %9\n\tds_read_b64_tr_b16 %2, %10\n\tds_read_b64_tr_b16 %3, %11\n\t"
                                 "ds_read_b64_tr_b16 %4, %12\n\tds_read_b64_tr_b16 %5, %13\n\tds_read_b64_tr_b16 %6, %14\n\tds_read_b64_tr_b16 %7, %15\n\ts_waitcnt lgkmcnt(0)"
                                 : "=&v"(t0[0]), "=&v"(t0[1]), "=&v"(t0[2]), "=&v"(t0[3]), "=&v"(t1[0]), "=&v"(t1[1]), "=&v"(t1[2]), "=&v"(t1[3])
                                 : "v"(ta0 ^ (unsigned)((4 * ch + 0) << 5)), "v"(ta0 ^ (unsigned)((4 * ch + 1) << 5)), "v"(ta0 ^ (unsigned)((4 * ch + 2) << 5)), "v"(ta0 ^ (unsigned)((4 * ch + 3) << 5)),
                                   "v"(ta1 ^ (unsigned)((4 * ch + 0) << 5)), "v"(ta1 ^ (unsigned)((4 * ch + 1) << 5)), "v"(ta1 ^ (unsigned)((4 * ch + 2) << 5)), "v"(ta1 ^ (unsigned)((4 * ch + 3) << 5)) : "memory");
                    __builtin_amdgcn_sched_barrier(0);
#pragma unroll
                    for (int c = 0; c < 4; ++c) { const bf16x8 av = __builtin_shufflevector(t0[c], t1[c], 0, 1, 2, 3, 4, 5, 6, 7);
                        o[4 * ch + c] = __builtin_amdgcn_mfma_f32_16x16x32_bf16(av, pfrag, o[4 * ch + c], 0, 0, 0); }
                }
            }
            const float inv = 1.0f / sum;
            bf16_t* gqp = Gg + m * 2048u;
#pragma unroll
            for (int p = 0; p < 2; ++p) {
#pragma unroll
                for (int cc = 0; cc < 4; ++cc) *(LAS f32x4*)(size_t)(owa ^ (unsigned)(cc << 6)) = o[4 * p + cc] * inv;
                LDS_WAIT();
#pragma unroll
                for (int i = 0; i < 2; ++i) { bf16_t* gp = gqp + ((8 * i + (lane_a >> 3)) * 128 + 64 * p + 8 * (lane_a & 7)); const u32x4 gw = *(const u32x4*)gp;
                    const unsigned ra_ = (ora + 2048u * (unsigned)i) ^ (unsigned)(i << 7);
                    const f32x4 t0 = *(const LAS f32x4*)(size_t)ra_, t1 = *(const LAS f32x4*)(size_t)(ra_ ^ 16u);
                    u32x4 wv; wv.x = pk2(t0[0] * bflo(gw.x), t0[1] * bfhi(gw.x)); wv.y = pk2(t0[2] * bflo(gw.y), t0[3] * bfhi(gw.y));
                    wv.z = pk2(t1[0] * bflo(gw.z), t1[1] * bfhi(gw.z)); wv.w = pk2(t1[2] * bflo(gw.w), t1[3] * bfhi(gw.w));
                    if (!dry2) *(u32x4*)gp = wv; }
                LDS_WAIT();
            }
        }
        }
    }
}

#ifndef OLD_SCAN
#define OLD_SCAN 0
#endif
#ifndef MK_SPLIT
#define MK_SPLIT 0
#endif
#ifndef MK_PH_END
#define MK_PH_END 13
#endif
constexpr int N_PHASES = 13;

#define XB_TMO      128
#define XB_XCNT(j)  (256  + 64 * (j))
#define XB_XSUB(j)  (1280 + 64 * (j))
#define XB_XGEN(j)  (2304 + 64 * (j))
#define XB_TOP      3328
#define XB_TOPGEN   3392
#define XCD_BAR_WORDS 3456
#define XB_SPIN_CAP (1u << 18)

__device__ __forceinline__ unsigned xb_ld(unsigned* p)              { return __hip_atomic_load(p, __ATOMIC_RELAXED, __HIP_MEMORY_SCOPE_AGENT); }
__device__ __forceinline__ unsigned xb_add(unsigned* p, unsigned v) { return __hip_atomic_fetch_add(p, v, __ATOMIC_RELAXED, __HIP_MEMORY_SCOPE_AGENT); }
__device__ __forceinline__ unsigned xb_xcc_id() { return (unsigned)__builtin_amdgcn_s_getreg((3 << 11) | 20) & 0xFu; }
#define XB_SPIN(cond, bar) do { unsigned _sp = 0; while (cond) { __builtin_amdgcn_s_sleep(1); \
    if ((++_sp & 255u) == 0u) { if (xb_ld(&(bar)[XB_TMO])) break; if (_sp > XB_SPIN_CAP) { atomicAdd(&(bar)[XB_TMO], 1u); break; } } } } while (0)

struct XcdBarrier {
    unsigned* bar; unsigned x;
    volatile LAS unsigned* st;
};

__device__ __forceinline__ XcdBarrier xcd_barrier_post(unsigned* bar, volatile LAS unsigned* st, const int wave) {
    XcdBarrier b; b.bar = bar; b.x = xb_xcc_id(); b.st = st;
    if (lane_id() == 0 && wave == 0) (void)xb_add(&bar[XB_XCNT(b.x)], 1u);
    return b;
}
__device__ __forceinline__ void xcd_barrier_complete(unsigned* bar, unsigned x, unsigned& nloc, unsigned& nx) {
    const unsigned G = gridDim.x * gridDim.y * gridDim.z;
    unsigned sum, cnt, mine, sp = 0u;
    for (;;) {
        sum = 0u; cnt = 0u; mine = 0u;
#pragma unroll
        for (unsigned j = 0; j < 16; ++j) { const unsigned c = xb_ld(&bar[XB_XCNT(j)]); sum += c; cnt += (c > 0u) ? 1u : 0u; mine = (j == x) ? c : mine; }
        if (sum == G) break;
        __builtin_amdgcn_s_sleep(1);
        if ((++sp & 255u) == 0u) { if (xb_ld(&bar[XB_TMO])) break; if (sp > XB_SPIN_CAP) { atomicAdd(&bar[XB_TMO], 1u); break; } }
    }
    nloc = mine > 0u ? mine : 1u; nx = cnt > 0u ? cnt : 1u;
}

__device__ __forceinline__ void xcd_barrier(const XcdBarrier& b, const int wave) {
    asm volatile("s_waitcnt vmcnt(0)" ::: "memory");
    __syncthreads();
    if (wave == 0) { if (lane_id() == 0) {
        unsigned* bar = b.bar;
        __builtin_amdgcn_s_waitcnt(0);
        unsigned nloc = b.st[0], nx = b.st[1];
        if (nloc == 0u) { xcd_barrier_complete(bar, b.x, nloc, nx); b.st[0] = nloc; b.st[1] = nx; }
        const unsigned old = xb_add(&bar[XB_XSUB(b.x)], 1u);
        const unsigned gen = old / nloc;
        if (old + 1u == (gen + 1u) * nloc) {
            __builtin_amdgcn_fence(__ATOMIC_RELEASE, "agent");
            asm volatile("s_waitcnt vmcnt(0)" ::: "memory");
            const unsigned og = xb_add(&bar[XB_TOP], 1u);
            const unsigned tg = og / nx;
            if (og + 1u == (tg + 1u) * nx) xb_add(&bar[XB_TOPGEN], 1u);
            else XB_SPIN(xb_ld(&bar[XB_TOPGEN]) == tg, bar);
            __builtin_amdgcn_fence(__ATOMIC_ACQUIRE, "agent");
            xb_add(&bar[XB_XGEN(b.x)], 1u);
            asm volatile("s_waitcnt vmcnt(0)" ::: "memory");
        } else {
            XB_SPIN(xb_ld(&bar[XB_XGEN(b.x)]) == gen, bar);
            __builtin_amdgcn_fence(__ATOMIC_ACQUIRE, "agent");
            asm volatile("s_waitcnt vmcnt(0)" ::: "memory");
        }
    } }
    __syncthreads();
}

#define grid_bar(barptr, epoch, wv) xcd_barrier(xbar, (wv))
typedef const __attribute__((address_space(4))) Args* KArgs;
#if defined(__HIP_DEVICE_COMPILE__)
__device__ __forceinline__ Args kargs() { KArgs p = (KArgs)__builtin_amdgcn_kernarg_segment_ptr(); asm volatile("" : "+s"(p)); return *p; }
#else
__device__ __forceinline__ Args kargs() { return Args{}; }
#endif
#define PHASE_ARGS const Args a = kargs(); unsigned char* ws = a.ws; (void)ws

__global__ void __launch_bounds__(NTHREADS, 2) fwd_megakernel(Args a_by_value) {
    extern __shared__ __attribute__((aligned(16))) unsigned char lds_raw[];
    LAS unsigned char* lds = (LAS unsigned char*)lds_raw;
    cg::grid_group grid = cg::this_grid();
    const int wave = __builtin_amdgcn_readfirstlane((int)threadIdx.x >> 6);
    { volatile LAS unsigned* st0 = (volatile LAS unsigned*)(lds + LDS_BYTES - 16); if (wave == 0 && lane_id() < 4) st0[lane_id()] = 0u; __syncthreads(); }
    const XcdBarrier xbar = xcd_barrier_post((unsigned*)(kargs().ws + WS_BAR), (volatile LAS unsigned*)(lds + LDS_BYTES - 16), wave);
    int lo, hi; { const Args a0 = kargs(); lo = a0.ph_lo; hi = a0.ph_hi; }
#ifdef ONLY_PH
#define IN(k) ((k) == ONLY_PH && lo <= (k) && (k) < hi)
#else
#define IN(k) (lo <= (k) && (k) < hi)
#endif
#define SEAM(k) do { if (IN(k) && IN((k) + 1)) { if ((k) == 0) grid.sync(); else grid_bar((unsigned*)(kargs().ws + WS_BAR), (unsigned)(k), wave); } } while (0)
#ifdef REP_PH
#ifndef REP_N
#define REP_N 2
#endif
#define NREP(k) ((k) == REP_PH ? REP_N : 1)
#else
#define NREP(k) 1
#endif
#define REPEAT(k) for (int rep_ = 0; rep_ < NREP(k); ++rep_, (rep_ < NREP(k) ? grid_bar((unsigned*)(kargs().ws + WS_BAR) + 128, 1u, wave) : (void)0))
#ifdef STAMP_K
#define TSTAMP(k) do { if (((k) == STAMP_K || (k) == STAMP_K + 1) && blockIdx.x == 0 && wave == 0) { const unsigned long long t_ = __builtin_amdgcn_s_memrealtime(); \
        if (__builtin_amdgcn_mbcnt_lo(~0u, 0u) == 0u) ((unsigned long long*)(kargs().ws + WS_STAMP))[(k) - STAMP_K] = t_; } } while (0)
#else
#define TSTAMP(k) do { } while (0)
#endif
#ifdef STAMP_K
    if (blockIdx.x == PROBE_BLK && wave == 0) { unsigned long long* st_ = (unsigned long long*)(kargs().ws + WS_STAMP); if (__builtin_amdgcn_mbcnt_lo(~0u, 0u) < 3u) st_[__builtin_amdgcn_mbcnt_lo(~0u, 0u)] = 0ull; }
#endif
    TSTAMP(0);
    if (IN(0)) REPEAT(0) { PHASE_ARGS; p0_prologue(a, wave, lds); } SEAM(0); TSTAMP(1);
    if (IN(1)) REPEAT(1) { PHASE_ARGS; norm_phase(a, wave, lds, a.x, 0); } SEAM(1); TSTAMP(2);
    if (IN(2)) REPEAT(2) { PHASE_ARGS;
        pg8::Gemm g{(const bf16_t*)(ws + WS_H), (const bf16_t*)(ws + WS_WIN0), MTOK, N0, DM}; pg8::StaticOrder S; S.init(MTOK, N0, gridDim.x, blockIdx.x);
        #ifdef EPI0_CHEAP_FIRST
        Epi0 E{ws, (unsigned char*)a.out, NREP(2) == 2 && rep_ == 0 && a.ph_hi > 0};
#else
        Epi0 E{ws, (unsigned char*)a.out, false};
#endif
#ifdef SKEW0
        if (blockIdx.x >= 128) { const unsigned long long t0_ = __builtin_amdgcn_s_memrealtime(); while (__builtin_amdgcn_s_memrealtime() - t0_ < (unsigned long long)(SKEW0)) __builtin_amdgcn_s_sleep(64); }
#endif
        pg8::gemm_phase<Epi0, pg8::StaticOrder, true, true>(lds, g, S, E, wave);
    } SEAM(2); TSTAMP(3);
    if (IN(3)) REPEAT(3) { PHASE_ARGS; conv_phase(a, wave, lds, blockIdx.x, gridDim.x); lora_pre_phase(a, wave); } SEAM(3); TSTAMP(4);
    if (IN(4)) REPEAT(4) { PHASE_ARGS;
        pg8::Gemm g{(const bf16_t*)((unsigned char*)a.out + DO_LA), (const bf16_t*)(ws + WS_WLORA), MTOK, 2048, 256}; pg8::StaticOrder S; S.init(MTOK, 2048, gridDim.x, blockIdx.x);
        EpiLora E{(bf16_t*)(ws + WS_DARR), (bf16_t*)(ws + WS_AARR), a.rwkv_vec};
        pg8::gemm_phase<EpiLora, pg8::StaticOrder, true, true>(lds, g, S, E, wave);
    } SEAM(4); TSTAMP(5);
    if (IN(5)) REPEAT(5) { PHASE_ARGS;
#if OLD_SCAN
        scan_phase(a, wave, lds);
#else
        unsigned* pbar = (unsigned*)(ws + WS_BAR) + 256;
        { __syncthreads(); if (wave == 0 && lane_id() < 8) ((LAS unsigned*)(lds + CS_FLAGS))[lane_id()] = 0u; __syncthreads(); }
        for (int r = 0; r <= CR_NP; ++r) {
            if (blockIdx.x >= 64) { if (r < CR_NP) cscan_produce(a, wave, lds, r, 64, gridDim.x - 64); }
            else if (r >= 1) {
                const int piece = r - 1;
                f32x4 xc[4]; f32x4* sv = (f32x4*)(ws + WS_XSAVE) + ((size_t)(blockIdx.x * 4 + (wave & 3)) * 64 + lane_id()) * 4;
#pragma unroll
                for (int kt = 0; kt < 4; ++kt) xc[kt] = (piece == 0 || wave >= 4) ? (f32x4){0.f, 0.f, 0.f, 0.f} : sv[kt];
                cscan_consume(a, wave, lds, blockIdx.x, piece, xc);
                if (wave < 4) {
#pragma unroll
                    for (int kt = 0; kt < 4; ++kt) sv[kt] = xc[kt]; }
            }
            grid_bar(pbar, (unsigned)(r + 1), wave);
#ifdef BAR2
            grid_bar(pbar + 128, (unsigned)(r + 1), wave);
#endif
        }
#endif
    } SEAM(5); TSTAMP(6);
    if (IN(6)) REPEAT(6) { PHASE_ARGS; post_phase(a, wave); } SEAM(6); TSTAMP(7);
    if (IN(7)) REPEAT(7) { PHASE_ARGS;
        pg8::Gemm g{(const bf16_t*)(ws + WS_YAB), (const bf16_t*)(ws + WS_WOUT0), MTOK, DM, 2048}; pg8::StaticOrder S; S.init(MTOK, DM, gridDim.x, blockIdx.x);
        EpiRes E{a.x, a.out, (const float*)(ws + WS_MODP), a.ada_b, 0};
        pg8::gemm_phase<EpiRes, pg8::StaticOrder, true, true>(lds, g, S, E, wave);
    } SEAM(7); TSTAMP(8);
    if (IN(8)) REPEAT(8) { PHASE_ARGS; norm_phase(a, wave, lds, a.out, 1); } SEAM(8); TSTAMP(9);
    if (IN(9)) REPEAT(9) { PHASE_ARGS;
        pg8::Gemm g{(const bf16_t*)(ws + WS_H), (const bf16_t*)(ws + WS_WIN1), MTOK, N1, DM}; pg8::StaticOrder S; S.init(MTOK, N1, gridDim.x, blockIdx.x);
        Epi1 E{(bf16_t*)(ws + WS_Q), (bf16_t*)(ws + WS_KV), (bf16_t*)(ws + WS_QI), (bf16_t*)(ws + WS_KI), (bf16_t*)(ws + WS_G), (float*)(ws + WS_WI), (const f32x2*)(ws + WS_CSA), (const f32x2*)(ws + WS_CSI)};
        pg8::gemm_phase<Epi1, pg8::StaticOrder, true, true>(lds, g, S, E, wave);
    } SEAM(9); TSTAMP(10);
    if (IN(10)) REPEAT(10) { PHASE_ARGS; dsa_phase(a, wave, lds, NREP(10) == 2 && rep_ == 0 && a.ph_hi > 0); } SEAM(10); TSTAMP(11);
    if (IN(11)) REPEAT(11) { PHASE_ARGS;
        pg8::Gemm g{(const bf16_t*)(ws + WS_G), (const bf16_t*)(ws + WS_WOUT1), MTOK, DM, 2048}; pg8::StaticOrder S; S.init(MTOK, DM, gridDim.x, blockIdx.x);
        EpiRes E{a.out, a.out, (const float*)(ws + WS_MODP), a.ada_b, 1};
        pg8::gemm_phase<EpiRes, pg8::StaticOrder, true, true>(lds, g, S, E, wave);
    } SEAM(11); TSTAMP(12);
    if (IN(12)) REPEAT(12) { PHASE_ARGS; final_phase(a, wave); }
#undef IN
#undef SEAM
}

extern "C" void kernel_launch(void* const* d_in, const int* in_sizes, int n_in, void* d_out, int out_size, void* d_ws, size_t ws_size, hipStream_t stream) {
    static int grid = 0;
    if (grid == 0) {
        if (n_in != 19 || out_size != MTOK * DM || ws_size < WS_NEED) { fprintf(stderr, "kernel_launch: unexpected shapes (n_in %d, out %d, ws %zu)\n", n_in, out_size, ws_size); grid = -1; return; }
        int dev = 0, cus = 0, per_cu = 0;
        (void)hipGetDevice(&dev); (void)hipDeviceGetAttribute(&cus, hipDeviceAttributeMultiprocessorCount, dev);
        if (hipFuncSetAttribute((const void*)fwd_megakernel, hipFuncAttributeMaxDynamicSharedMemorySize, LDS_BYTES) != hipSuccess) { fprintf(stderr, "kernel_launch: hipFuncSetAttribute failed\n"); grid = -1; return; }
        if (hipOccupancyMaxActiveBlocksPerMultiprocessor(&per_cu, (const void*)fwd_megakernel, NTHREADS, LDS_BYTES) != hipSuccess || per_cu < 1) { fprintf(stderr, "kernel_launch: occupancy query says %d\n", per_cu); per_cu = 1; }
        (void)hipGetLastError();
        grid = cus;
        if (grid > 256) grid = 256;
    }
    if (grid < 0) return;
    Args a{};
    a.x = (const float*)d_in[0]; a.c = (const float*)d_in[1]; a.pos = (const int*)d_in[2]; a.ada_w = (const float*)d_in[3]; a.ada_b = (const float*)d_in[4];
    a.norm_g = (const float*)d_in[5]; a.final_g = (const float*)d_in[6]; a.even_w_in = (const float*)d_in[7]; a.even_w_out = (const float*)d_in[8];
    a.conv_w = (const float*)d_in[9]; a.conv_vec = (const float*)d_in[10]; a.mu_rkv = (const float*)d_in[11]; a.mu_lora = (const float*)d_in[12];
    a.rwkv_vec = (const float*)d_in[13]; a.w_up = (const float*)d_in[14]; a.a_up = (const float*)d_in[15]; a.r_k = (const float*)d_in[16];
    a.odd_w_in = (const float*)d_in[17]; a.odd_w_out = (const float*)d_in[18];
    a.out = (float*)d_out; a.ws = (unsigned char*)d_ws;
    (void)hipMemsetAsync((char*)d_ws + WS_BAR, 0, 65536, stream);
#if MK_SPLIT
    for (int p = 0; p < MK_PH_END; ++p) { a.ph_lo = p; a.ph_hi = p + 1; void* args[] = {&a};
        hipError_t e = hipLaunchCooperativeKernel((const void*)fwd_megakernel, dim3(grid), dim3(NTHREADS), args, LDS_BYTES, stream);
        if (e != hipSuccess) { fprintf(stderr, "launch %d failed: %s\n", p, hipGetErrorString(e)); break; } }
#else
    a.ph_lo = 0; a.ph_hi = MK_PH_END; void* args[] = {&a};
    hipError_t e = hipLaunchCooperativeKernel((const void*)fwd_megakernel, dim3(grid), dim3(NTHREADS), args, LDS_BYTES, stream);
    if (e != hipSuccess) fprintf(stderr, "cooperative launch failed: %s (grid %d)\n", hipGetErrorString(e), grid);
#endif
}
```

```cpp
#include <hip/hip_runtime.h>
#include <hip/hip_cooperative_groups.h>
#include <cstdio>
#include <cstdint>
namespace cg = cooperative_groups;

#define LAS __attribute__((address_space(3)))
typedef unsigned short bf16_t;
typedef float f32x4 __attribute__((ext_vector_type(4)));
typedef float f32x2 __attribute__((ext_vector_type(2)));
typedef float f32x16 __attribute__((ext_vector_type(16)));
typedef unsigned u32x4 __attribute__((ext_vector_type(4)));
typedef unsigned u32x2 __attribute__((ext_vector_type(2)));
typedef short bf16x8 __attribute__((ext_vector_type(8)));
typedef short s16x4 __attribute__((ext_vector_type(4)));

constexpr int BATCH = 4, SEQ = 8192, DM = 1024, MTOK = BATCH * SEQ;
constexpr int N0 = 7424, N1 = 5120;
constexpr int EVEN_COLS = 7296, ODD_COLS = 4936;
constexpr int NWAVES = 8, NTHREADS = 512;
constexpr int LDS_BYTES = 155648;

constexpr size_t MiB = 1u << 20;
constexpr size_t WS_MODP = 0; constexpr size_t WS_STAMP = 3 * MiB; constexpr size_t WS_XSAVE = 1 * MiB;
constexpr size_t WS_BAR = 3 * MiB + 512 * 1024;
constexpr size_t WS_WIN0 = 4 * MiB, WS_WOUT0 = 20 * MiB, WS_WIN1 = 24 * MiB, WS_WOUT1 = 34 * MiB, WS_WLORA = 38 * MiB;
constexpr size_t WS_CSA = 40 * MiB, WS_CSI = 56 * MiB;
constexpr size_t WS_H = 64 * MiB;
constexpr size_t WS_YAB = 64 * MiB;
constexpr size_t WS_U = 192 * MiB, WS_AG = 256 * MiB, WS_R = 320 * MiB, WS_K = 384 * MiB, WS_V = 448 * MiB;
constexpr size_t WS_AARR = WS_U, WS_DARR = WS_AG;
constexpr size_t WS_Q = 128 * MiB, WS_G = 256 * MiB, WS_KV = 384 * MiB, WS_QI = 400 * MiB, WS_KI = 432 * MiB, WS_WI = 436 * MiB;
constexpr size_t WS_NEED = 512 * MiB;
constexpr size_t DO_BG = 0, DO_WDAD = 64 * MiB, DO_LA = 72 * MiB, DO_RK = 64 * MiB;

__device__ __forceinline__ float bflo(unsigned w) { return __uint_as_float(w << 16); }
__device__ __forceinline__ float bfhi(unsigned w) { return __uint_as_float(w & 0xffff0000u); }
typedef __bf16 bf16x2_t __attribute__((ext_vector_type(2)));
__device__ __forceinline__ unsigned pk2(float lo, float hi) { const f32x2 v = {lo, hi}; const bf16x2_t b = __builtin_convertvector(v, bf16x2_t); return __builtin_bit_cast(unsigned, b); }
__device__ __forceinline__ float sigmoidf_(float x) { return __builtin_amdgcn_rcpf(1.0f + __expf(-x)); }
__device__ __forceinline__ float wave_sum(float v) {
#pragma unroll
    for (int o = 1; o < 64; o <<= 1) v += __shfl_xor(v, o);
    return v;
}
template <int CTRL> __device__ __forceinline__ float dppmov(float x) { return __int_as_float(__builtin_amdgcn_update_dpp(0, __float_as_int(x), CTRL, 0xf, 0xf, true)); }
__device__ __forceinline__ float quad_sum(float x) { x += dppmov<0xB1>(x); x += dppmov<0x4E>(x); return x; }
__device__ __forceinline__ float row16_sum(float x) { x += dppmov<0xB1>(x); x += dppmov<0x4E>(x); x += dppmov<0x141>(x); x += dppmov<0x140>(x); return x; }
__device__ __forceinline__ int lane_id() { int l; asm volatile("v_mbcnt_lo_u32_b32 %0, -1, 0\n\tv_mbcnt_hi_u32_b32 %0, -1, %0" : "=v"(l)); return l; }
#define LDS_WAIT() asm volatile("s_waitcnt lgkmcnt(0)" ::: "memory")

__device__ __forceinline__ int map0(int n) {
    const int t = n >> 8, r = n & 255;
    if (t < 8) return (r < 128) ? 128 * t + r : 1024 + 128 * t + (r - 128);
    if (t < 12) return 2048 + 256 * (t - 8) + r;
    if (t < 24) return 3072 + 256 * (t - 12) + r;
    if (t < 28) return 6272 + 256 * (t - 24) + r;
    return (r < 128) ? 6144 + r : -1;
}
__device__ __forceinline__ int map1(int n) {
    const int t = n >> 8, r = n & 255, half = r >> 7, rr = r & 127;
    if (t < 8) return (2 * t + (rr >> 6)) * 128 + half * 64 + (rr & 63);
    if (t == 8) return 2048 + (rr >> 6) * 128 + half * 64 + (rr & 63);
    if (t < 11) return 2304 + (4 * (t - 9) + (rr >> 5)) * 64 + half * 32 + (rr & 31);
    if (t == 11) { if (rr < 32) return 2816 + half * 32 + rr; if (half == 0 && rr < 40) return 2880 + (rr - 32); return -1; }
    return 2888 + 256 * (t - 12) + r;
}

#ifndef PROBE_BLK
#define PROBE_BLK 0
#endif
#ifndef PROBE_WAVE
#define PROBE_WAVE 0
#endif
#if defined(STAMP_K) && defined(PROBE_SEC)
#define PROBE_BEGIN(sec, wsp, wv) unsigned long long PT0_##sec = 0; if ((sec) == PROBE_SEC && blockIdx.x == PROBE_BLK && (wv) == PROBE_WAVE) PT0_##sec = __builtin_amdgcn_s_memrealtime()
#define PROBE_END(sec, wsp, wv) do { if ((sec) == PROBE_SEC && blockIdx.x == PROBE_BLK && (wv) == PROBE_WAVE) { const unsigned long long dt_ = __builtin_amdgcn_s_memrealtime() - PT0_##sec; \
        if (__builtin_amdgcn_mbcnt_lo(~0u, 0u) == 0u) __hip_atomic_fetch_add((unsigned long long*)((wsp) + WS_STAMP) + 2, dt_, __ATOMIC_RELAXED, __HIP_MEMORY_SCOPE_AGENT); } } while (0)
#else
#define PROBE_BEGIN(sec, wsp, wv) do { } while (0)
#define PROBE_END(sec, wsp, wv) do { } while (0)
#endif
namespace pg8 {
#define PG8_LAS __attribute__((address_space(3)))
typedef unsigned short bf16_t;
typedef short bf16x8 __attribute__((ext_vector_type(8)));
typedef float f32x4 __attribute__((ext_vector_type(4)));
typedef unsigned u32x4 __attribute__((ext_vector_type(4)));
constexpr int BM = 256, BK = 64, HALF = 128, HTB = HALF * BK * 2  , STAGE_BYTES = 8 * HTB, NXCD = 8, WGM = 8;

__host__ __device__ __forceinline__ int lds_byte(int r, int c) { const int st = (r >> 4) * 2 + (c >> 5), rr = r & 15, cc = c & 31, ob = rr * 64 + cc * 2; return st * 1024 + (ob ^ (((ob >> 9) & 1) << 5)); }
__host__ __device__ __forceinline__ void stage_rc(int b, int& R, int& C) { const int st = b / 1024, sb = b % 1024, swz = sb ^ (((sb >> 9) & 1) << 5); R = (st >> 1) * 16 + swz / 64; C = (st & 1) * 32 + (swz % 64) / 2; }
__host__ __device__ __forceinline__ int perm32(int rho) { const int n = rho >> 4, i = rho & 15; return 8 * (i >> 2) + 4 * n + (i & 3); }

struct Unit { int pm, pn; };
struct Gemm { const bf16_t* A; const bf16_t* Bt; int M, N, K; };

struct StaticOrder {
    int nM, nN, nwg, G, c;
    __host__ __device__ void init(int M, int N, int G_, int c_) { nM = M / BM; nN = N / BM; nwg = nM * nN; G = G_; c = c_; }
    __host__ __device__ bool next(int i, Unit& u) const {
        const long L = (long)i * G + c; if (L >= nwg) return false;
        int wgid = (int)L; { const int q = nwg / NXCD, r = nwg % NXCD, xcd = wgid % NXCD, off = wgid / NXCD; wgid = (xcd < r ? xcd * (q + 1) : r * (q + 1) + (xcd - r) * q) + off; }
        const int nig = WGM * nN, gid = wgid / nig, fm = gid * WGM, gsz = (nM - fm) < WGM ? (nM - fm) : WGM;
        u.pm = fm + ((wgid % nig) % gsz); u.pn = (wgid % nig) / gsz; return true;
    }
    __device__ __forceinline__ void a_ready(const Unit&) const {}
    __device__ __forceinline__ void done(const Unit&) const {}
};

__device__ __forceinline__ unsigned cvt_pk_bf16(float lo, float hi) { unsigned r; asm volatile("v_cvt_pk_bf16_f32 %0, %1, %2" : "=v"(r) : "v"(lo), "v"(hi)); return r; }
typedef float f32x2 __attribute__((ext_vector_type(2)));
template <class Epi, class Sched, bool ALIGN_EPI = false, bool SP2 = false>
__device__ __forceinline__ void gemm_phase(PG8_LAS unsigned char* lds, const Gemm g, const Sched& S, const Epi& E, const int wave_in) {
    int lane; asm volatile("v_mbcnt_lo_u32_b32 %0, -1, 0\n\tv_mbcnt_hi_u32_b32 %0, -1, %0" : "=v"(lane));
    const int wid = wave_in, tid = wid * 64 + lane, wr = wid >> 2, wc = wid & 3, fr = lane & 15, fq = lane >> 4;
    const int K = g.K, nt = K / BK;
    unsigned voffA[2], voffB[2];
#pragma unroll
    for (int i = 0; i < 2; ++i) { int R, C; stage_rc(tid * 16 + i * 8192, R, C); const int Rb = Epi::PERM ? ((R & ~31) + perm32(R & 31)) : R;
        voffA[i] = (unsigned)(R * K + C) * 2u; voffB[i] = (unsigned)(Rb * K + C) * 2u; }
    const size_t kstep = (size_t)(BK * 2);
    const size_t hstep = (size_t)HALF * K * 2;
    const size_t tstep = 2 * hstep;
    const unsigned ldsw = (unsigned)wid * 1024u;
    const int aoff = lds_byte(wr * 64 + fr, fq * 8), boff = lds_byte(wc * 32 + fr, fq * 8);
#define PG8_SA(b, h) (((b) * 2 + (h)) * HTB)
#define PG8_SB(b, h) ((4 + (b) * 2 + (h)) * HTB)
#define PG8_STAGE(bufoff, gbase, voff) do { _Pragma("unroll") for (int _i = 0; _i < 2; ++_i) \
        __builtin_amdgcn_global_load_lds((const unsigned*)((const char*)(gbase) + (voff)[_i]), (PG8_LAS unsigned*)(lds + (bufoff) + ldsw + _i * 8192), 16, 0, 0); } while (0)
#define PG8_LDA(dst, b, h) do { _Pragma("unroll") for (int m = 0; m < 4; ++m) _Pragma("unroll") for (int k = 0; k < 2; ++k) dst[m][k] = *(const PG8_LAS bf16x8*)(lds + PG8_SA(b, h) + aoff + m * 2048 + k * 1024); } while (0)
#define PG8_LDB(dst, b, h) do { _Pragma("unroll") for (int n = 0; n < 2; ++n) _Pragma("unroll") for (int k = 0; k < 2; ++k) dst[n][k] = *(const PG8_LAS bf16x8*)(lds + PG8_SB(b, h) + boff + n * 2048 + k * 1024); } while (0)
#define PG8_MMA(ai, bj, At, Bt) do { __builtin_amdgcn_s_setprio(1); _Pragma("unroll") for (int m = 0; m < 4; ++m) _Pragma("unroll") for (int n = 0; n < 2; ++n) _Pragma("unroll") for (int k = 0; k < 2; ++k) \
        acc[ai][bj][m][n] = __builtin_amdgcn_mfma_f32_16x16x32_bf16(Bt[n][k], At[m][k], acc[ai][bj][m][n], 0, 0, 0); __builtin_amdgcn_s_setprio(0); } while (0)
#define PG8_WAIT_V(n) asm volatile("s_waitcnt vmcnt(" #n ")" ::: "memory")
#define PG8_WAIT_L(n) asm volatile("s_waitcnt lgkmcnt(" #n ")" ::: "memory")
#define PG8_BAR __builtin_amdgcn_s_barrier()
#define PG8_SCHED __builtin_amdgcn_sched_barrier(0)
    Unit cur, nxt; int ui = 0;
    if (!S.next(0, cur)) return;
    f32x4 acc[2][2][4][2];
#pragma unroll
    for (int a = 0; a < 2; ++a)
#pragma unroll
        for (int b = 0; b < 2; ++b)
#pragma unroll
            for (int m = 0; m < 4; ++m)
#pragma unroll
                for (int n = 0; n < 2; ++n) acc[a][b][m][n] = (f32x4){0.f, 0.f, 0.f, 0.f};
    bf16x8 At[4][2], B0[2][2], B1[2][2];
    const char* cA = (const char*)g.A + (size_t)cur.pm * tstep; const char* cB = (const char*)g.Bt + (size_t)cur.pn * tstep;
    S.a_ready(cur);
    if constexpr (SP2) {
        PG8_STAGE(PG8_SB(0, 0), cB, voffB); PG8_STAGE(PG8_SB(0, 1), cB + hstep, voffB); PG8_STAGE(PG8_SA(0, 0), cA, voffA); PG8_STAGE(PG8_SA(0, 1), cA + hstep, voffA);
        if (wr == 1) PG8_BAR;
        PG8_WAIT_V(2); PG8_BAR;
        PG8_STAGE(PG8_SB(1, 0), cB + kstep, voffB); PG8_STAGE(PG8_SA(1, 0), cA + kstep, voffA); PG8_STAGE(PG8_SB(1, 1), cB + hstep + kstep, voffB);
        PG8_WAIT_V(6); PG8_BAR;
    } else {
        PG8_STAGE(PG8_SB(0, 0), cB, voffB); PG8_STAGE(PG8_SA(0, 0), cA, voffA); PG8_STAGE(PG8_SB(0, 1), cB + hstep, voffB); PG8_STAGE(PG8_SA(0, 1), cA + hstep, voffA);
        if (wr == 1) PG8_BAR;
        PG8_WAIT_V(4); PG8_BAR;
        PG8_STAGE(PG8_SB(1, 0), cB + kstep, voffB); PG8_STAGE(PG8_SA(1, 0), cA + kstep, voffA); PG8_STAGE(PG8_SB(1, 1), cB + hstep + kstep, voffB);
        PG8_WAIT_V(6); PG8_BAR;
    }
    for (;;) {
        const bool has_next = S.next(ui + 1, nxt);
        const char* nA = has_next ? (const char*)g.A + (size_t)nxt.pm * tstep : cA; const char* nB = has_next ? (const char*)g.Bt + (size_t)nxt.pn * tstep : cB;
        for (int t = 0; t < nt; t += 2) {
            const bool last = (t == nt - 2);
            const char* a1 = cA + (size_t)(t + 1) * kstep;
            const char* a2 = last ? nA : cA + (size_t)(t + 2) * kstep; const char* b2 = last ? nB : cB + (size_t)(t + 2) * kstep;
            const char* a3 = a2 + kstep; const char* b3 = b2 + kstep;
            if (last && has_next) S.a_ready(nxt);
            if constexpr (SP2) {
            PG8_LDB(B0, 0, 0); PG8_LDB(B1, 0, 1); PG8_SCHED; PG8_LDA(At, 0, 0); PG8_STAGE(PG8_SA(1, 1), a1 + hstep, voffA);
            PG8_WAIT_V(8); PG8_WAIT_L(0); PG8_BAR; PG8_MMA(0, 0, At, B0); PG8_MMA(0, 1, At, B1); PG8_BAR; PG8_SCHED;
            PG8_LDA(At, 0, 1); PG8_STAGE(PG8_SB(0, 0), b2, voffB); PG8_STAGE(PG8_SB(0, 1), b2 + hstep, voffB); PG8_STAGE(PG8_SA(0, 0), a2, voffA);
            PG8_WAIT_V(8); PG8_WAIT_L(0); PG8_BAR; PG8_MMA(1, 0, At, B0); PG8_MMA(1, 1, At, B1); PG8_BAR; PG8_SCHED;
            PG8_LDB(B0, 1, 0); PG8_LDB(B1, 1, 1); PG8_SCHED; PG8_LDA(At, 1, 0); PG8_STAGE(PG8_SA(0, 1), a2 + hstep, voffA);
            PG8_WAIT_V(8); PG8_WAIT_L(0); PG8_BAR; PG8_MMA(0, 0, At, B0); PG8_MMA(0, 1, At, B1); PG8_BAR; PG8_SCHED;
            PG8_LDA(At, 1, 1); PG8_STAGE(PG8_SB(1, 0), b3, voffB); PG8_STAGE(PG8_SB(1, 1), b3 + hstep, voffB); PG8_STAGE(PG8_SA(1, 0), a3, voffA);
            PG8_WAIT_V(8); PG8_WAIT_L(0); PG8_BAR; PG8_MMA(1, 0, At, B0); PG8_MMA(1, 1, At, B1); PG8_BAR; PG8_SCHED;
            } else {
            PG8_LDB(B0, 0, 0); PG8_SCHED; PG8_LDA(At, 0, 0); PG8_STAGE(PG8_SA(1, 1), a1 + hstep, voffA);
            PG8_WAIT_L(8); PG8_BAR; PG8_WAIT_L(0); PG8_MMA(0, 0, At, B0); PG8_BAR; PG8_SCHED;
            PG8_LDB(B1, 0, 1); PG8_STAGE(PG8_SB(0, 0), b2, voffB);
            PG8_BAR; PG8_WAIT_L(0); PG8_MMA(0, 1, At, B1); PG8_BAR;
            PG8_LDA(At, 0, 1); PG8_STAGE(PG8_SA(0, 0), a2, voffA);
            PG8_BAR; PG8_WAIT_L(0); PG8_MMA(1, 0, At, B0); PG8_BAR; PG8_SCHED;
            PG8_STAGE(PG8_SB(0, 1), b2 + hstep, voffB);
            PG8_WAIT_V(6); PG8_BAR; PG8_MMA(1, 1, At, B1); PG8_BAR;
            PG8_LDB(B0, 1, 0); PG8_SCHED; PG8_LDA(At, 1, 0); PG8_STAGE(PG8_SA(0, 1), a2 + hstep, voffA);
            PG8_WAIT_L(8); PG8_BAR; PG8_WAIT_L(0); PG8_MMA(0, 0, At, B0); PG8_BAR; PG8_SCHED;
            PG8_LDB(B1, 1, 1); PG8_STAGE(PG8_SB(1, 0), b3, voffB);
            PG8_BAR; PG8_WAIT_L(0); PG8_MMA(0, 1, At, B1); PG8_BAR;
            PG8_LDA(At, 1, 1); PG8_STAGE(PG8_SA(1, 0), a3, voffA);
            PG8_BAR; PG8_WAIT_L(0); PG8_MMA(1, 0, At, B0); PG8_BAR; PG8_SCHED;
            PG8_STAGE(PG8_SB(1, 1), b3 + hstep, voffB);
            PG8_WAIT_V(6); PG8_BAR; PG8_MMA(1, 1, At, B1); PG8_BAR;
            }
        }
        if constexpr (ALIGN_EPI) { if (wr == 0) PG8_BAR; }
        if constexpr (!Epi::AFTER_DRAIN) { E(acc, cur, wr, wc, fr, fq); S.done(cur); }
        if (!has_next) break;
#pragma unroll
        for (int a = 0; a < 2; ++a)
#pragma unroll
            for (int b = 0; b < 2; ++b)
#pragma unroll
                for (int m = 0; m < 4; ++m)
#pragma unroll
                    for (int n = 0; n < 2; ++n) acc[a][b][m][n] = (f32x4){0.f, 0.f, 0.f, 0.f};
        cur = nxt; cA = nA; cB = nB; ++ui;
        if constexpr (ALIGN_EPI) { if (wr == 1) PG8_BAR; }
    }
    PG8_WAIT_V(0);
    if constexpr (!ALIGN_EPI) { if (wr == 0) PG8_BAR; }
    PG8_BAR;
    if constexpr (Epi::AFTER_DRAIN) { E.fused(acc, cur, wr, wc, fr, fq, lds, wid, lane); S.done(cur); }
#undef PG8_SA
#undef PG8_SB
#undef PG8_STAGE
#undef PG8_LDA
#undef PG8_LDB
#undef PG8_MMA
#undef PG8_WAIT_V
#undef PG8_WAIT_L
#undef PG8_BAR
#undef PG8_SCHED
}
}

__device__ __forceinline__ u32x4 pack8(const f32x4 a, const f32x4 b) { u32x4 w; w.x = pk2(a[0], a[1]); w.y = pk2(a[2], a[3]); w.z = pk2(b[0], b[1]); w.w = pk2(b[2], b[3]); return w; }
__device__ __forceinline__ f32x4 silu4(const f32x4 v) { f32x4 o; o[0] = v[0] * sigmoidf_(v[0]); o[1] = v[1] * sigmoidf_(v[1]); o[2] = v[2] * sigmoidf_(v[2]); o[3] = v[3] * sigmoidf_(v[3]); return o; }
__device__ __forceinline__ f32x4 sig4(const f32x4 v) { f32x4 o; o[0] = sigmoidf_(v[0]); o[1] = sigmoidf_(v[1]); o[2] = sigmoidf_(v[2]); o[3] = sigmoidf_(v[3]); return o; }

struct Epi0 {
    static constexpr bool PERM = true, AFTER_DRAIN = false;
    unsigned char* ws; unsigned char* dout; bool cheap;
    __device__ __forceinline__ void operator()(const f32x4 (&acc)[2][2][4][2], const pg8::Unit& u, int wr, int wc, int fr, int fq) const {
        const int row0 = u.pm * 256 + wr * 64 + fr, t = u.pn, cw = wc * 32 + 8 * fq;
        if (t < 8) {
            bf16_t* U = (bf16_t*)(ws + WS_U);
#pragma unroll
            for (int ai = 0; ai < 2; ++ai)
#pragma unroll
                for (int m = 0; m < 4; ++m) { const size_t row = (size_t)(row0 + ai * 128 + m * 16);
                    const f32x4 a = cheap ? acc[ai][0][m][0] : acc[ai][0][m][0] * sig4(acc[ai][1][m][0]), b = cheap ? acc[ai][0][m][1] : acc[ai][0][m][1] * sig4(acc[ai][1][m][1]);
                    *(u32x4*)(U + row * 1024 + 128 * t + cw) = pack8(a, b); }
        } else if (t == 28) {
            bf16_t* WDAD = (bf16_t*)(dout + DO_WDAD);
#pragma unroll
            for (int ai = 0; ai < 2; ++ai)
#pragma unroll
                for (int m = 0; m < 4; ++m) { const size_t row = (size_t)(row0 + ai * 128 + m * 16);
                    *(u32x4*)(WDAD + row * 128 + cw) = pack8(acc[ai][0][m][0], acc[ai][0][m][1]); }
        } else {
            const bool act = ((t < 12) || (t >= 24)) && !cheap; const int c0 = 256 * (t & 3);
            unsigned char* bp = (t >= 24) ? (dout + DO_BG) : (ws + WS_AG + (size_t)((t - 8) >> 2) * (64 * MiB));
            bf16_t* base = (bf16_t*)bp;
#pragma unroll
            for (int ai = 0; ai < 2; ++ai)
#pragma unroll
                for (int m = 0; m < 4; ++m) { const size_t row = (size_t)(row0 + ai * 128 + m * 16);
#pragma unroll
                    for (int bj = 0; bj < 2; ++bj) { f32x4 a = acc[ai][bj][m][0], b = acc[ai][bj][m][1];
                        if (act) { a = silu4(a); b = silu4(b); }
                        *(u32x4*)(base + row * 1024 + c0 + 128 * bj + cw) = pack8(a, b); } }
        }
    }
};
static_assert(WS_R == WS_AG + 64 * MiB && WS_K == WS_AG + 128 * MiB && WS_V == WS_AG + 192 * MiB, "Epi0 region arithmetic");

struct EpiLora {
    static constexpr bool PERM = true, AFTER_DRAIN = false;
    bf16_t *D, *A; const float* vec;
    __device__ __forceinline__ void operator()(const f32x4 (&acc)[2][2][4][2], const pg8::Unit& u, int wr, int wc, int fr, int fq) const {
        const int row0 = u.pm * 256 + wr * 64 + fr, t = u.pn, cw = wc * 32 + 8 * fq;
        const bool isd = t < 4; bf16_t* base = isd ? D : A; const int c0 = 256 * (t & 3); const float* bias = vec + (isd ? 0 : 1024) + c0 + cw;
        const float sc = isd ? 0.60653065971f : 1.0f;
#pragma unroll
        for (int ai = 0; ai < 2; ++ai)
#pragma unroll
            for (int m = 0; m < 4; ++m) { const size_t row = (size_t)(row0 + ai * 128 + m * 16);
#pragma unroll
                for (int bj = 0; bj < 2; ++bj) { const f32x4 b0 = *(const f32x4*)(bias + 128 * bj), b1 = *(const f32x4*)(bias + 128 * bj + 4);
                    const f32x4 a = sig4(acc[ai][bj][m][0] + b0) * sc, b = sig4(acc[ai][bj][m][1] + b1) * sc;
                    *(u32x4*)(base + row * 1024 + c0 + 128 * bj + cw) = pack8(a, b); } }
    }
};

struct EpiRes {
    static constexpr bool PERM = false, AFTER_DRAIN = false;
    const float* resid; float* out; const float* modp; const float* ada_b; int layer; bool cheap; LAS unsigned char* spare;
    __device__ __forceinline__ void operator()(const f32x4 (&acc)[2][2][4][2], const pg8::Unit& u, int wr, int wc, int fr, int fq) const {
        const int row0 = u.pm * 256 + wr * 64 + fr, col0 = u.pn * 256 + wc * 32 + 4 * fq, b = (u.pm * 256) / SEQ;
#ifdef EPIRES_CHEAP
        if (cheap) {
            f32x4 s = (f32x4){0.f, 0.f, 0.f, 0.f};
#pragma unroll
            for (int ai = 0; ai < 2; ++ai)
#pragma unroll
                for (int bj = 0; bj < 2; ++bj)
#pragma unroll
                    for (int m = 0; m < 4; ++m)
#pragma unroll
                        for (int n = 0; n < 2; ++n) s += acc[ai][bj][m][n];
            if (s[0] + s[1] + s[2] + s[3] == 1.2345e30f) out[(size_t)row0 * 1024 + col0] = s[0];
            return; }
#endif
        f32x4 gv[2][2];
#pragma unroll
        for (int bj = 0; bj < 2; ++bj)
#pragma unroll
            for (int n = 0; n < 2; ++n) { const int c = col0 + bj * 128 + n * 16; f32x4 g = *(const f32x4*)(ada_b + layer * 3072 + 2048 + c);
#pragma unroll
                for (int s = 0; s < 8; ++s) g += *(const f32x4*)(modp + (size_t)((s * 2 + layer) * 4 + b) * 3072 + 2048 + c);
                gv[bj][n] = g; }
        const int lane = fr + 16 * fq;
        const unsigned tile = (unsigned)(size_t)spare + (unsigned)(wr * 4 + wc) * 2048u;
        const unsigned wa = tile + (unsigned)fr * 128u + (unsigned)((fq ^ (fr >> 1)) << 4);
        const unsigned ra = tile + (unsigned)lane * 16u;
        const size_t o0 = (size_t)(u.pm * 256 + wr * 64 + (lane >> 3)) * 1024 + u.pn * 256 + wc * 32 + 4 * ((lane & 7) ^ (lane >> 4));
        const size_t o1 = (size_t)(u.pm * 256 + wr * 64 + 8 + (lane >> 3)) * 1024 + u.pn * 256 + wc * 32 + 4 * ((lane & 7) ^ (4 + (lane >> 4)));
        f32x4 rr[3][2];
        auto rload = [&](int idx, f32x4 (&dst)[2]) { const int ai = idx >> 3, m = (idx >> 1) & 3, bj = idx & 1; const size_t d = (size_t)(ai * 128 + m * 16) * 1024 + bj * 128;
            dst[0] = *(const f32x4*)(resid + o0 + d); dst[1] = *(const f32x4*)(resid + o1 + d); };
        rload(0, rr[0]); rload(1, rr[1]);
#pragma unroll
        for (int idx = 0; idx < 16; ++idx) { const int ai = idx >> 3, m = (idx >> 1) & 3, bj = idx & 1; const size_t d = (size_t)(ai * 128 + m * 16) * 1024 + bj * 128;
            if (idx + 2 < 16) rload(idx + 2, rr[(idx + 2) % 3]);
            *(LAS f32x4*)(size_t)wa = gv[bj][0] * acc[ai][bj][m][0]; *(LAS f32x4*)(size_t)(wa ^ 64u) = gv[bj][1] * acc[ai][bj][m][1];
            const f32x4 t0 = *(const LAS f32x4*)(size_t)ra, t1 = *(const LAS f32x4*)(size_t)(ra + 1024u);
            *(f32x4*)(out + o0 + d) = rr[idx % 3][0] + t0; *(f32x4*)(out + o1 + d) = rr[idx % 3][1] + t1;
            asm volatile("" ::: "memory"); }
    }
};

constexpr float Q_SCALE = 0.08838834764831845f * 1.4426950408889634f;
constexpr float WI_SCALE = 0.35355339059327373f * 0.125f;
struct Epi1 {
    static constexpr bool PERM = true, AFTER_DRAIN = false;
    bf16_t *Q, *KV, *QI, *KI, *G; float* WI; const f32x2* csa; const f32x2* csi;
    __device__ __forceinline__ void rope8(const f32x4 x1a, const f32x4 x1b, const f32x4 x2a, const f32x4 x2b, const f32x2* cs, float sc, u32x4& o1, u32x4& o2) const {
        float c[8], s[8];
#pragma unroll
        for (int j = 0; j < 4; ++j) { const f32x4 v = *(const f32x4*)(cs + 2 * j); c[2 * j] = v[0]; s[2 * j] = v[1]; c[2 * j + 1] = v[2]; s[2 * j + 1] = v[3]; }
        float a[8], b[8];
#pragma unroll
        for (int j = 0; j < 4; ++j) { a[j] = x1a[j]; a[4 + j] = x1b[j]; b[j] = x2a[j]; b[4 + j] = x2b[j]; }
        float p[8], q[8];
#pragma unroll
        for (int j = 0; j < 8; ++j) { p[j] = (a[j] * c[j] - b[j] * s[j]) * sc; q[j] = (b[j] * c[j] + a[j] * s[j]) * sc; }
        o1.x = pk2(p[0], p[1]); o1.y = pk2(p[2], p[3]); o1.z = pk2(p[4], p[5]); o1.w = pk2(p[6], p[7]);
        o2.x = pk2(q[0], q[1]); o2.y = pk2(q[2], q[3]); o2.z = pk2(q[4], q[5]); o2.w = pk2(q[6], q[7]);
    }
    __device__ __forceinline__ void operator()(const f32x4 (&acc)[2][2][4][2], const pg8::Unit& u, int wr, int wc, int fr, int fq) const {
        const int row0 = u.pm * 256 + wr * 64 + fr, t = u.pn, cw = wc * 32 + 8 * fq;
#pragma unroll
        for (int ai = 0; ai < 2; ++ai)
#pragma unroll
            for (int m = 0; m < 4; ++m) { const size_t row = (size_t)(row0 + ai * 128 + m * 16);
                const f32x4 x1a = acc[ai][0][m][0], x1b = acc[ai][0][m][1], x2a = acc[ai][1][m][0], x2b = acc[ai][1][m][1];
                if (t < 8) { const int head = 2 * t + (wc >> 1), i0 = (wc & 1) * 32 + 8 * fq; u32x4 o1, o2;
                    rope8(x1a, x1b, x2a, x2b, csa + row * 64 + i0, Q_SCALE, o1, o2);
                    *(u32x4*)(Q + row * 2048 + head * 128 + i0) = o1; *(u32x4*)(Q + row * 2048 + head * 128 + 64 + i0) = o2;
                } else if (t == 8) { const int i0 = (wc & 1) * 32 + 8 * fq;
                    if (wc < 2) { u32x4 o1, o2; rope8(x1a, x1b, x2a, x2b, csa + row * 64 + i0, 1.0f, o1, o2);
                        *(u32x4*)(KV + row * 256 + i0) = o1; *(u32x4*)(KV + row * 256 + 64 + i0) = o2; }
                    else { *(u32x4*)(KV + row * 256 + 128 + i0) = pack8(x1a, x1b); *(u32x4*)(KV + row * 256 + 192 + i0) = pack8(x2a, x2b); }
                } else if (t < 11) { const int head = 4 * (t - 9) + wc, i0 = 8 * fq; u32x4 o1, o2;
                    rope8(x1a, x1b, x2a, x2b, csi + row * 32 + i0, 1.0f, o1, o2);
                    *(u32x4*)(QI + row * 512 + head * 64 + i0) = o1; *(u32x4*)(QI + row * 512 + head * 64 + 32 + i0) = o2;
                } else if (t == 11) {
                    if (wc == 0) { const int i0 = 8 * fq; u32x4 o1, o2; rope8(x1a, x1b, x2a, x2b, csi + row * 32 + i0, 1.0f, o1, o2);
                        *(u32x4*)(KI + row * 64 + i0) = o1; *(u32x4*)(KI + row * 64 + 32 + i0) = o2; }
                    else if (wc == 1 && fq == 0) { *(f32x4*)(WI + row * 8) = x1a * WI_SCALE; *(f32x4*)(WI + row * 8 + 4) = x1b * WI_SCALE; }
                } else { const int c0 = 256 * (t - 12);
                    *(u32x4*)(G + row * 2048 + c0 + cw) = pack8(silu4(x1a), silu4(x1b)); *(u32x4*)(G + row * 2048 + c0 + 128 + cw) = pack8(silu4(x2a), silu4(x2b)); }
            }
    }
};

struct Args {
    const float* x; const float* c; const int* pos; const float* ada_w; const float* ada_b; const float* norm_g; const float* final_g;
    const float* even_w_in; const float* even_w_out; const float* conv_w; const float* conv_vec; const float* mu_rkv; const float* mu_lora;
    const float* rwkv_vec; const float* w_up; const float* a_up; const float* r_k; const float* odd_w_in; const float* odd_w_out;
    float* out; unsigned char* ws; int ph_lo, ph_hi;
};

template <class SrcF>
__device__ __forceinline__ void transpose_item(const SrcF& src, int K, bf16_t* WT, LAS float* scr, int item, int nblk, int lane) {
    const int kb = item / nblk, nb = item % nblk, k0 = 64 * kb, n0 = 32 * nb;
    float tv[32];
#pragma unroll
    for (int i = 0; i < 32; ++i) tv[i] = src(k0 + 2 * i + (lane >> 5), n0 + (lane & 31));
#pragma unroll
    for (int i = 0; i < 32; ++i) scr[(2 * i + (lane >> 5)) * 33 + (lane & 31)] = tv[i];
    LDS_WAIT();
    const int c = lane & 7;
#pragma unroll
    for (int j = 0; j < 4; ++j) { const int n = (lane >> 3) + 8 * j; const LAS float* s = scr + (8 * c) * 33 + n;
        u32x4 o; o.x = pk2(s[0 * 33], s[1 * 33]); o.y = pk2(s[2 * 33], s[3 * 33]); o.z = pk2(s[4 * 33], s[5 * 33]); o.w = pk2(s[6 * 33], s[7 * 33]);
        *(u32x4*)(WT + (size_t)(n0 + n) * K + k0 + 8 * c) = o; }
    LDS_WAIT();
}

__device__ __forceinline__ void transpose_item_col(const float* W, int ldw, int scol, int K, bf16_t* WT, LAS float* scr, int k0, int n0, int lane) {
    const float* wp = W + (size_t)(k0 + (lane >> 5)) * ldw + (scol < 0 ? 0 : scol);
#pragma unroll 8
    for (int i = 0; i < 32; ++i) { const float v = wp[(size_t)(2 * i) * ldw]; scr[(2 * i + (lane >> 5)) * 33 + (lane & 31)] = scol < 0 ? 0.f : v; }
    LDS_WAIT();
    const int c = lane & 7;
#pragma unroll
    for (int j = 0; j < 4; ++j) { const int n = (lane >> 3) + 8 * j; const LAS float* s = scr + (8 * c) * 33 + n;
        u32x4 o; o.x = pk2(s[0 * 33], s[1 * 33]); o.y = pk2(s[2 * 33], s[3 * 33]); o.z = pk2(s[4 * 33], s[5 * 33]); o.w = pk2(s[6 * 33], s[7 * 33]);
        *(u32x4*)(WT + (size_t)(n0 + n) * K + k0 + 8 * c) = o; }
    LDS_WAIT();
}
__device__ __forceinline__ void rope_item(const Args& a, int r, int lane) {
    const float p = (float)a.pos[r];
    { const float inv = powf(10000.0f, -(float)(2 * lane) / 128.0f); float sn, cs; sincosf(p * inv, &sn, &cs); ((f32x2*)(a.ws + WS_CSA))[(size_t)r * 64 + lane] = (f32x2){cs, sn}; }
    if (lane < 32) { const float inv = powf(10000.0f, -(float)(2 * lane) / 64.0f); float sn, cs; sincosf(p * inv, &sn, &cs); ((f32x2*)(a.ws + WS_CSI))[(size_t)r * 32 + lane] = (f32x2){cs, sn}; }
}
__device__ __forceinline__ void p0_late(const Args& a, const int wave, LAS unsigned char* lds, int first, int nblk) {
    const int lane = lane_id(), tid = wave * 64 + lane;
    LAS float* scr = (LAS float*)(lds + wave * 16384);
    const int gw = ((int)blockIdx.x - first) * NWAVES + wave, NGW = nblk * NWAVES;
    unsigned char* ws = a.ws;
    constexpr int I_WO = (2048 / 64) * (DM / 32), I_W1 = (DM / 64) * (N1 / 32), I_ROPE = MTOK;
    for (int it = gw; it < I_W1 + I_WO + I_ROPE; it += NGW) {
        int r = it;
        if (r < I_W1) { const int nblk = N1 / 32, k0 = 64 * (r / nblk), n0 = 32 * (r % nblk); transpose_item_col(a.odd_w_in, ODD_COLS, map1(n0 + (lane & 31)), DM, (bf16_t*)(ws + WS_WIN1), scr, k0, n0, lane); continue; } r -= I_W1;
        if (r < I_WO) { const int nblk = DM / 32, k0 = 64 * (r / nblk), n0 = 32 * (r % nblk); transpose_item_col(a.odd_w_out, DM, n0 + (lane & 31), 2048, (bf16_t*)(ws + WS_WOUT1), scr, k0, n0, lane); continue; } r -= I_WO;
        {
            const float p = (float)a.pos[r];
            { const float inv = powf(10000.0f, -(float)(2 * lane) / 128.0f); float sn, cs; sincosf(p * inv, &sn, &cs); ((f32x2*)(ws + WS_CSA))[(size_t)r * 64 + lane] = (f32x2){cs, sn}; }
            if (lane < 32) { const float inv = powf(10000.0f, -(float)(2 * lane) / 64.0f); float sn, cs; sincosf(p * inv, &sn, &cs); ((f32x2*)(ws + WS_CSI))[(size_t)r * 32 + lane] = (f32x2){cs, sn}; }
        }
    }
}
__device__ __forceinline__ void p0_prologue(const Args& a, const int wave, LAS unsigned char* lds) {
    const int lane = lane_id(), tid = wave * 64 + lane;
    LAS float* scr = (LAS float*)(lds + wave * 16384);
    const int gw = blockIdx.x * NWAVES + wave, NGW = gridDim.x * NWAVES;
    unsigned char* ws = a.ws;
    constexpr int I_W0 = (DM / 64) * (N0 / 32), I_WO = (2048 / 64) * (DM / 32), I_W1 = (DM / 64) * (N1 / 32), I_WL = (256 / 64) * (2048 / 32), I_MOD = 96 * 8, I_ROPE = MTOK;
    constexpr int NITEMS = I_W0 + I_WO + I_W1 + I_WO + I_WL + I_MOD + I_ROPE;
    constexpr int N_EARLY = I_W0 + I_WO + I_W1 + I_WO + I_WL + I_MOD;
    for (int it = gw; it < N_EARLY; it += NGW) {
        int r = it;
        if (r < I_W0) { const float* W = a.even_w_in; transpose_item([W](int k, int n) { const int s = map0(n); return s < 0 ? 0.f : W[(size_t)k * EVEN_COLS + s]; }, DM, (bf16_t*)(ws + WS_WIN0), scr, r, N0 / 32, lane); continue; } r -= I_W0;
        if (r < I_WO) { const float* W = a.even_w_out; transpose_item([W](int k, int n) { return W[(size_t)k * DM + n]; }, 2048, (bf16_t*)(ws + WS_WOUT0), scr, r, DM / 32, lane); continue; } r -= I_WO;
        if (r < I_W1) { const float* W = a.odd_w_in; transpose_item([W](int k, int n) { const int s = map1(n); return s < 0 ? 0.f : W[(size_t)k * ODD_COLS + s]; }, DM, (bf16_t*)(ws + WS_WIN1), scr, r, N1 / 32, lane); continue; } r -= I_W1;
        if (r < I_WO) { const float* W = a.odd_w_out; transpose_item([W](int k, int n) { return W[(size_t)k * DM + n]; }, 2048, (bf16_t*)(ws + WS_WOUT1), scr, r, DM / 32, lane); continue; } r -= I_WO;
        if (r < I_WL) { const float* wu = a.w_up; const float* au = a.a_up;
            transpose_item([wu, au](int k, int n) { if (n < 1024) return k < 64 ? wu[k * 1024 + n] : 0.f; return (k >= 64 && k < 128) ? au[(k - 64) * 1024 + (n - 1024)] : 0.f; }, 256, (bf16_t*)(ws + WS_WLORA), scr, r, 2048 / 32, lane); continue; } r -= I_WL;
        if (r < I_MOD) {
            const int cgp = r >> 3, ks = r & 7, col = cgp * 64 + lane, l = col / 3072, cc = col - l * 3072;
#pragma unroll
            for (int i = 0; i < 8; ++i) { const int idx = lane + 64 * i, bb = idx >> 7, kk = idx & 127; const float cv = a.c[bb * DM + ks * 128 + kk]; scr[kk * 4 + bb] = cv * sigmoidf_(cv); }
            LDS_WAIT();
            const float* W = a.ada_w + (size_t)l * DM * 3072 + cc + (size_t)(ks * 128) * 3072; f32x4 acc4 = (f32x4){0.f, 0.f, 0.f, 0.f};
#pragma unroll 1
            for (int k8 = 0; k8 < 128; k8 += 16) { float wv[16];
#pragma unroll
                for (int i = 0; i < 16; ++i) wv[i] = W[(size_t)(k8 + i) * 3072];
#pragma unroll
                for (int i = 0; i < 16; ++i) acc4 += *(const LAS f32x4*)(scr + (k8 + i) * 4) * wv[i]; }
            LDS_WAIT();
            const float acc0 = acc4[0], acc1 = acc4[1], acc2 = acc4[2], acc3 = acc4[3];
            float* mp = (float*)(ws + WS_MODP) + (size_t)((ks * 2 + l) * 4) * 3072 + cc;
            mp[0] = acc0; mp[3072] = acc1; mp[2 * 3072] = acc2; mp[3 * 3072] = acc3; continue; } r -= I_MOD;
    }
}

__device__ __forceinline__ void norm_phase(const Args& a, const int wave, LAS unsigned char* lds, const float* src, int layer) {
    const int lane = lane_id(), tid = wave * 64 + lane;
    LAS float* gs = (LAS float*)lds; LAS float* sh = gs + DM;
    const float* modp = (const float*)(a.ws + WS_MODP); bf16_t* H = (bf16_t*)(a.ws + WS_H);
    for (int tile = blockIdx.x; tile < MTOK / 128; tile += gridDim.x) {
        const int b = (tile * 128) / SEQ;
        __syncthreads();
        for (int c = tid; c < DM; c += NTHREADS) {
            float sc = a.ada_b[layer * 3072 + 1024 + c], sf = a.ada_b[layer * 3072 + c];
#pragma unroll
            for (int s = 0; s < 8; ++s) { const float* mp = modp + (size_t)((s * 2 + layer) * 4 + b) * 3072; sc += mp[1024 + c]; sf += mp[c]; }
            gs[c] = a.norm_g[layer * DM + c] * (1.0f + sc); sh[c] = sf; }
        __syncthreads();
        for (int r4 = 0; r4 < 16; r4 += 4) {
            f32x4 v[4][4]; float ss[4];
#pragma unroll
            for (int q = 0; q < 4; ++q) { const size_t m = (size_t)tile * 128 + wave * 16 + r4 + q; const f32x4* xr = (const f32x4*)(src + m * DM) + lane;
#pragma unroll
                for (int j = 0; j < 4; ++j) v[q][j] = xr[64 * j]; }
#pragma unroll
            for (int q = 0; q < 4; ++q) { float s = 0.f;
#pragma unroll
                for (int j = 0; j < 4; ++j) s += (v[q][j][0] * v[q][j][0] + v[q][j][1] * v[q][j][1]) + (v[q][j][2] * v[q][j][2] + v[q][j][3] * v[q][j][3]);
                ss[q] = s; }
#pragma unroll
            for (int q = 0; q < 4; ++q) ss[q] = wave_sum(ss[q]);
#pragma unroll
            for (int q = 0; q < 4; ++q) { const size_t m = (size_t)tile * 128 + wave * 16 + r4 + q; const float rstd = rsqrtf(ss[q] * (1.0f / DM) + 1e-6f);
                u32x2* o = (u32x2*)(H + m * DM) + lane;
#pragma unroll
                for (int j = 0; j < 4; ++j) { const f32x4 g = *(const LAS f32x4*)(gs + 4 * (64 * j + lane)), s = *(const LAS f32x4*)(sh + 4 * (64 * j + lane));
                    const f32x4 h = v[q][j] * rstd * g + s; u32x2 w; w.x = pk2(h[0], h[1]); w.y = pk2(h[2], h[3]); o[64 * j] = w; } }
        }
    }
}

__device__ __forceinline__ void final_phase(const Args& a, const int wave) {
    const int lane = lane_id(), tid = wave * 64 + lane;
    const int gw = blockIdx.x * NWAVES + wave, NGW = gridDim.x * NWAVES;
    f32x4 g[4];
#pragma unroll
    for (int j = 0; j < 4; ++j) g[j] = *((const f32x4*)a.final_g + 64 * j + lane);
    float tsc = 1.0f;
#ifdef STAMP_K
    { const unsigned long long* st = (const unsigned long long*)(a.ws + WS_STAMP); tsc = 1.0f + (float)(st[1] - st[0] + st[2]) * 1e-7f; }
#endif
    for (int m0 = 4 * gw; m0 < MTOK; m0 += 4 * NGW) {
        f32x4 v[4][4]; float ss[4];
#pragma unroll
        for (int q = 0; q < 4; ++q) { const f32x4* xr = (const f32x4*)(a.out + (size_t)(m0 + q) * DM) + lane;
#pragma unroll
            for (int j = 0; j < 4; ++j) v[q][j] = xr[64 * j]; }
#pragma unroll
        for (int q = 0; q < 4; ++q) { float s = 0.f;
#pragma unroll
            for (int j = 0; j < 4; ++j) s += (v[q][j][0] * v[q][j][0] + v[q][j][1] * v[q][j][1]) + (v[q][j][2] * v[q][j][2] + v[q][j][3] * v[q][j][3]);
            ss[q] = wave_sum(s); }
#pragma unroll
        for (int q = 0; q < 4; ++q) { const float rstd = rsqrtf(ss[q] * (1.0f / DM) + 1e-6f) * tsc; f32x4* xr = (f32x4*)(a.out + (size_t)(m0 + q) * DM) + lane;
#pragma unroll
            for (int j = 0; j < 4; ++j) xr[64 * j] = v[q][j] * rstd * g[j]; }
    }
}


__device__ __forceinline__ void conv_phase(const Args& a, const int wave, LAS unsigned char* lds, int first, int stride) {
    const int lane = lane_id(), tid = wave * 64 + lane;
    const bf16_t* U = (const bf16_t*)(a.ws + WS_U); const bf16_t* AG = (const bf16_t*)(a.ws + WS_AG); bf16_t* YAB = (bf16_t*)(a.ws + WS_YAB);
    f32x2 w[31];
#pragma unroll
    for (int j = 0; j < 31; ++j) w[j] = *(const f32x2*)(a.conv_w + j * DM + 2 * tid);
    const f32x2 cbias = *(const f32x2*)(a.conv_vec + 2 * tid);
    for (int tile = first; tile < MTOK / 32; tile += stride) {
        const int b = tile >> 8, s0 = (tile & 255) * 32;
        __syncthreads();
        for (int idx = tid; idx < 62 * 128; idx += NTHREADS) { const int row = idx >> 7, ch = idx & 127, s = s0 - 30 + row;
            u32x4 v = (u32x4){0u, 0u, 0u, 0u}; if (s >= 0) v = *(const u32x4*)(U + ((size_t)(b * SEQ + s)) * DM + ch * 8);
            *(LAS u32x4*)(lds + row * 2048 + ch * 16) = v; }
        __syncthreads();
        LAS unsigned char* rb0 = lds + tid * 4; LAS unsigned char* rb1 = rb0 + 65536; LAS unsigned char* wb0 = lds + tid * 8; LAS unsigned char* wb1 = wb0 + 65536;
        asm volatile("" : "+v"(rb0), "+v"(rb1), "+v"(wb0), "+v"(wb1));
        f32x2 acc[32];
#pragma unroll
        for (int t = 0; t < 32; ++t) acc[t] = (f32x2){0.f, 0.f};
#pragma unroll
        for (int i = 0; i < 62; ++i) { const unsigned xw = (i < 32) ? *(const LAS unsigned*)(rb0 + i * 2048) : *(const LAS unsigned*)(rb1 + (i - 32) * 2048); const f32x2 xv = (f32x2){bflo(xw), bfhi(xw)};
#pragma unroll
            for (int t = (i > 30 ? i - 30 : 0); t <= (i < 31 ? i : 31); ++t) acc[t] += xv * w[i - t]; }
        __syncthreads();
#pragma unroll
        for (int t = 0; t < 32; ++t) { if (t < 16) *(LAS f32x2*)(wb0 + t * 4096) = acc[t] + cbias; else *(LAS f32x2*)(wb1 + (t - 16) * 4096) = acc[t] + cbias; }
        __syncthreads();
        f32x4 lw[4], lb[4];
#pragma unroll
        for (int j = 0; j < 4; ++j) { lw[j] = *(const f32x4*)(a.conv_vec + DM + 4 * (lane + 64 * j)); lb[j] = *(const f32x4*)(a.conv_vec + 2 * DM + 4 * (lane + 64 * j)); }
        for (int tt = 0; tt < 4; ++tt) { const int t = wave * 4 + tt; const size_t m = (size_t)b * SEQ + s0 + t;
            f32x4 v[4]; float s = 0.f;
#pragma unroll
            for (int j = 0; j < 4; ++j) { v[j] = *(const LAS f32x4*)(lds + (size_t)t * 4096 + 16 * (lane + 64 * j)); s += (v[j][0] + v[j][1]) + (v[j][2] + v[j][3]); }
            const float mean = wave_sum(s) * (1.0f / DM); float q = 0.f;
#pragma unroll
            for (int j = 0; j < 4; ++j) { v[j] = v[j] - mean; q += (v[j][0] * v[j][0] + v[j][1] * v[j][1]) + (v[j][2] * v[j][2] + v[j][3] * v[j][3]); }
            const float rstd = rsqrtf(wave_sum(q) * (1.0f / DM) + 1e-5f);
#pragma unroll
            for (int j = 0; j < 4; ++j) { const f32x4 y = v[j] * rstd * lw[j] + lb[j]; const u32x2 g = *(const u32x2*)(AG + m * DM + 4 * (lane + 64 * j));
                const f32x4 o = silu4(y) * (f32x4){bflo(g.x), bfhi(g.x), bflo(g.y), bfhi(g.y)};
                u32x2 wv; wv.x = pk2(o[0], o[1]); wv.y = pk2(o[2], o[3]); *(u32x2*)(YAB + m * 2048 + 4 * (lane + 64 * j)) = wv; }
        }
    }
}

__device__ __forceinline__ void lora_pre_phase(const Args& a, const int wave) {
    const int lane = lane_id(), tid = wave * 64 + lane;

        const bf16_t* WDAD = (const bf16_t*)((unsigned char*)a.out + DO_WDAD); bf16_t* LA = (bf16_t*)((unsigned char*)a.out + DO_LA);
        const int gw = blockIdx.x * NWAVES + wave, NGW = gridDim.x * NWAVES;
        const f32x2 mu = *(const f32x2*)(a.mu_lora + 2 * lane);
        for (int m0 = gw * 4; m0 < MTOK; m0 += NGW * 4) {
            unsigned cur[4], prv[4];
#pragma unroll
            for (int i = 0; i < 4; ++i) { const int m = m0 + i; cur[i] = *(const unsigned*)(WDAD + (size_t)m * 128 + 2 * lane); }
#pragma unroll
            for (int i = 0; i < 4; ++i) { const int m = m0 + i; if (i > 0) prv[i] = cur[i - 1]; else { prv[0] = 0u; if ((m & (SEQ - 1)) > 0) prv[0] = *(const unsigned*)(WDAD + (size_t)(m - 1) * 128 + 2 * lane); } }
#pragma unroll
            for (int i = 0; i < 4; ++i) { const int m = m0 + i;
                float v0 = bflo(cur[i]), v1 = bfhi(cur[i]); v0 += (bflo(prv[i]) - v0) * mu[0]; v1 += (bfhi(prv[i]) - v1) * mu[1];
                if (lane < 32) { v0 = tanhf(v0); v1 = tanhf(v1); }
                *(unsigned*)(LA + (size_t)m * 256 + 2 * lane) = pk2(v0, v1); *(unsigned*)(LA + (size_t)m * 256 + 128 + 2 * lane) = 0u; }
        }
    }

struct ScanRaw { u32x2 r, rp, k, kp, v, vp, d, a; };
constexpr int SC_CH = 16, SC_BUF_F = 5 * SC_CH * 64 + SC_CH * 16;

__device__ __forceinline__ void scan_phase(const Args& a, const int wave, LAS unsigned char* lds) {
    const int lane = lane_id(), tid = wave * 64 + lane;
    const bf16_t* Rg = (const bf16_t*)(a.ws + WS_R); const bf16_t* Kg = (const bf16_t*)(a.ws + WS_K); const bf16_t* Vg = (const bf16_t*)(a.ws + WS_V);
    const bf16_t* Dg = (const bf16_t*)(a.ws + WS_DARR); const bf16_t* Ag = (const bf16_t*)(a.ws + WS_AARR);
    bf16_t* YAB = (bf16_t*)(a.ws + WS_YAB); float* RK = (float*)((unsigned char*)a.out + DO_RK);
    LAS float* bufs = (LAS float*)lds; LAS float* ybuf = bufs + 2 * SC_BUF_F;
    constexpr int NCH = SEQ / SC_CH;
    for (int job = blockIdx.x; job < 256; job += gridDim.x) {
        const int vcu = (gridDim.x == 256) ? ((job & 7) * 32 + (job >> 3)) : job;
        const int bh = vcu >> 2, vq = vcu & 3, b = bh >> 4, h = bh & 15;
        __syncthreads();
        if (wave >= 4) {
            const int pt = tid - 256, tok = pt >> 4, cgp = pt & 15, ch = h * 64 + 4 * cgp;
            const f32x4 mur = *(const f32x4*)(a.mu_rkv + ch), muk = *(const f32x4*)(a.mu_rkv + DM + ch), muv = *(const f32x4*)(a.mu_rkv + 2 * DM + ch);
            const f32x4 k_k = *(const f32x4*)(a.rwkv_vec + 2 * DM + ch), k_a = *(const f32x4*)(a.rwkv_vec + 3 * DM + ch), rkw = *(const f32x4*)(a.r_k + ch);
            auto load = [&](int c) { ScanRaw q; const int s = c * SC_CH + tok; const size_t m = (size_t)b * SEQ + s; const size_t o = m * DM + ch; const size_t op = (s > 0) ? o - DM : o;
                q.r = *(const u32x2*)(Rg + o); q.k = *(const u32x2*)(Kg + o); q.v = *(const u32x2*)(Vg + o); q.d = *(const u32x2*)(Dg + o); q.a = *(const u32x2*)(Ag + o);
                q.rp = *(const u32x2*)(Rg + op); q.kp = *(const u32x2*)(Kg + op); q.vp = *(const u32x2*)(Vg + op);
                if (s == 0) { q.rp = (u32x2){0u, 0u}; q.kp = (u32x2){0u, 0u}; q.vp = (u32x2){0u, 0u}; }
                return q; };
            auto un4 = [](u32x2 w) { return (f32x4){bflo(w.x), bfhi(w.x), bflo(w.y), bfhi(w.y)}; };
            auto process = [&](const ScanRaw& q, int c, LAS float* buf) {
                const f32x4 r0 = un4(q.r), k0 = un4(q.k), v0 = un4(q.v);
                const f32x4 rl = r0 + (un4(q.rp) - r0) * mur, kl = k0 + (un4(q.kp) - k0) * muk, vl = v0 + (un4(q.vp) - v0) * muv;
                const f32x4 d = un4(q.d), av = un4(q.a);
                f32x4 wdec; wdec[0] = __expf(-d[0]); wdec[1] = __expf(-d[1]); wdec[2] = __expf(-d[2]); wdec[3] = __expf(-d[3]);
                const f32x4 kkr = kl * k_k; float ss = (kkr[0] * kkr[0] + kkr[1] * kkr[1]) + (kkr[2] * kkr[2] + kkr[3] * kkr[3]); ss = row16_sum(ss);
                const float inv = 1.0f / fmaxf(sqrtf(ss), 1e-12f);
                const f32x4 kk = kkr * inv, kp = kl * (1.0f + (av - 1.0f) * k_a), bb = kk * av;
                float rk = (rl[0] * kp[0] * rkw[0] + rl[1] * kp[1] * rkw[1]) + (rl[2] * kp[2] * rkw[2] + rl[3] * kp[3] * rkw[3]); rk = row16_sum(rk);
                const int o = tok * 64 + 4 * cgp;
                *(LAS f32x4*)(buf + o) = -kk; *(LAS f32x4*)(buf + 1024 + o) = wdec; *(LAS f32x4*)(buf + 2048 + o) = bb; *(LAS f32x4*)(buf + 3072 + o) = kp; *(LAS f32x4*)(buf + 4096 + o) = rl;
                if ((cgp >> 2) == vq) *(LAS f32x4*)(buf + 5120 + tok * 16 + 4 * (cgp & 3)) = vl;
                if (vq == 0 && cgp == 0) RK[((size_t)b * SEQ + c * SC_CH + tok) * 16 + h] = rk; };
            auto flush = [&](int c, const LAS float* yb) {
                if (wave == 4) { const int t2 = lane >> 2, rq = lane & 3; const f32x4 y = *(const LAS f32x4*)(yb + t2 * 16 + 4 * rq);
                    u32x2 wv; wv.x = pk2(y[0], y[1]); wv.y = pk2(y[2], y[3]);
                    *(u32x2*)(YAB + ((size_t)b * SEQ + c * SC_CH + t2) * 2048 + 1024 + h * 64 + 16 * vq + 4 * rq) = wv; } };
            ScanRaw q0 = load(0), q1 = load(1);
            process(q0, 0, bufs); q0 = q1; q1 = load(2);
            __syncthreads();
            for (int c = 0; c < NCH; ++c) {
                if (c + 1 < NCH) process(q0, c + 1, bufs + ((c + 1) & 1) * SC_BUF_F);
                q0 = q1; if (c + 3 < NCH) q1 = load(c + 3);
                if (c >= 1) flush(c - 1, ybuf + ((c - 1) & 1) * 256);
                __syncthreads();
            }
            flush(NCH - 1, ybuf + ((NCH - 1) & 1) * 256);
        } else {
            const int rw = lane >> 4, ks = lane & 15, row = wave * 4 + rw;
            float s0 = 0.f, s1 = 0.f, s2 = 0.f, s3 = 0.f;
            __syncthreads();
            for (int c = 0; c < NCH; ++c) {
                const LAS float* buf = bufs + (c & 1) * SC_BUF_F; LAS float* yb = ybuf + (c & 1) * 256;
#pragma unroll
                for (int t = 0; t < SC_CH; ++t) {
                    const f32x4 nk = *(const LAS f32x4*)(buf + t * 64 + 4 * ks), w4 = *(const LAS f32x4*)(buf + 1024 + t * 64 + 4 * ks), b4 = *(const LAS f32x4*)(buf + 2048 + t * 64 + 4 * ks);
                    const f32x4 kp = *(const LAS f32x4*)(buf + 3072 + t * 64 + 4 * ks), r4 = *(const LAS f32x4*)(buf + 4096 + t * 64 + 4 * ks); const float vv = buf[5120 + t * 16 + row];
                    float sa = (s0 * nk[0] + s1 * nk[1]) + (s2 * nk[2] + s3 * nk[3]); sa = row16_sum(sa);
                    s0 = s0 * w4[0] + (sa * b4[0] + vv * kp[0]); s1 = s1 * w4[1] + (sa * b4[1] + vv * kp[1]);
                    s2 = s2 * w4[2] + (sa * b4[2] + vv * kp[2]); s3 = s3 * w4[3] + (sa * b4[3] + vv * kp[3]);
                    float y = (s0 * r4[0] + s1 * r4[1]) + (s2 * r4[2] + s3 * r4[3]); y = row16_sum(y);
                    if (ks == 0) yb[t * 16 + row] = y;
                }
                __syncthreads();
            }
        }
    }
}

__device__ __forceinline__ void post_phase(const Args& a, const int wave) {
    const int lane = lane_id(), tid = wave * 64 + lane;
    const int gw = blockIdx.x * NWAVES + wave, NGW = gridDim.x * NWAVES;
    const bf16_t* Vg = (const bf16_t*)(a.ws + WS_V); const bf16_t* BG = (const bf16_t*)((unsigned char*)a.out + DO_BG); const float* RK = (const float*)((unsigned char*)a.out + DO_RK);
    bf16_t* YAB = (bf16_t*)(a.ws + WS_YAB);
    const int head = lane >> 2, c0 = head * 64 + 16 * (lane & 3);
    f32x4 muv[4], lw[4], lb[4];
#pragma unroll
    for (int j = 0; j < 4; ++j) { muv[j] = *(const f32x4*)(a.mu_rkv + 2 * DM + c0 + 4 * j); lw[j] = *(const f32x4*)(a.rwkv_vec + 4 * DM + c0 + 4 * j); lb[j] = *(const f32x4*)(a.rwkv_vec + 5 * DM + c0 + 4 * j); }
    auto un4 = [](unsigned x, unsigned y) { return (f32x4){bflo(x), bfhi(x), bflo(y), bfhi(y)}; };
    for (int m = gw; m < MTOK; m += NGW) { const int s = m & (SEQ - 1);
        bf16_t* yp = YAB + (size_t)m * 2048 + 1024 + c0;
        const u32x4 ya = *(const u32x4*)yp, yb2 = *(const u32x4*)(yp + 8);
        const u32x4 va = *(const u32x4*)(Vg + (size_t)m * DM + c0), vb = *(const u32x4*)(Vg + (size_t)m * DM + c0 + 8);
        u32x4 pa = (u32x4){0u, 0u, 0u, 0u}, pb = pa; if (s > 0) { pa = *(const u32x4*)(Vg + (size_t)(m - 1) * DM + c0); pb = *(const u32x4*)(Vg + (size_t)(m - 1) * DM + c0 + 8); }
        const u32x4 ga = *(const u32x4*)(BG + (size_t)m * DM + c0), gb = *(const u32x4*)(BG + (size_t)m * DM + c0 + 8);
        const float rk = RK[(size_t)m * 16 + head];
        f32x4 y[4] = {un4(ya.x, ya.y), un4(ya.z, ya.w), un4(yb2.x, yb2.y), un4(yb2.z, yb2.w)};
        const f32x4 v[4] = {un4(va.x, va.y), un4(va.z, va.w), un4(vb.x, vb.y), un4(vb.z, vb.w)};
        const f32x4 p[4] = {un4(pa.x, pa.y), un4(pa.z, pa.w), un4(pb.x, pb.y), un4(pb.z, pb.w)};
        const f32x4 g[4] = {un4(ga.x, ga.y), un4(ga.z, ga.w), un4(gb.x, gb.y), un4(gb.z, gb.w)};
        float sm = 0.f;
#pragma unroll
        for (int j = 0; j < 4; ++j) sm += (y[j][0] + y[j][1]) + (y[j][2] + y[j][3]);
        const float mean = quad_sum(sm) * (1.0f / 64.0f); float q = 0.f;
#pragma unroll
        for (int j = 0; j < 4; ++j) { y[j] = y[j] - mean; q += (y[j][0] * y[j][0] + y[j][1] * y[j][1]) + (y[j][2] * y[j][2] + y[j][3] * y[j][3]); }
        const float rstd = rsqrtf(quad_sum(q) * (1.0f / 64.0f) + 64e-5f);
        u32x4 o[2];
#pragma unroll
        for (int j = 0; j < 4; ++j) { const f32x4 vl = v[j] + (p[j] - v[j]) * muv[j]; const f32x4 r = (y[j] * rstd * lw[j] + lb[j] + rk * vl) * g[j];
            if (j & 1) { o[j >> 1].z = pk2(r[0], r[1]); o[j >> 1].w = pk2(r[2], r[3]); } else { o[j >> 1].x = pk2(r[0], r[1]); o[j >> 1].y = pk2(r[2], r[3]); } }
        *(u32x4*)yp = o[0]; *(u32x4*)(yp + 8) = o[1];
    }
}

constexpr int CS_L = 32, CS_NCH = SEQ / CS_L, CS_NSLOT = 3;
constexpr int CS_NT = 0, CS_RT = 4096, CS_BT = 8192, CS_KT = 12288, CS_TM = 8192, CS_AKN = 10240, CS_ABR = 12288, CS_AKR = 14336, CS_BC = 16384, CS_KC = 20480, CS_VC = 24576, CS_GL = 28672, CS_SLOT = 29184;
constexpr int CS_RAW = CS_NSLOT * CS_SLOT, CS_RAWSZ = 5 * 33 * 128;
constexpr int CS_FLAGS = CS_RAW + CS_NSLOT * CS_RAWSZ;
static_assert(CS_FLAGS + 64 <= LDS_BYTES && (CS_RAW % 16) == 0 && (CS_RAWSZ % 16) == 0, "chunked scan LDS map");
__device__ __forceinline__ int permp(int j) { return 8 * ((j & 15) >> 2) + 4 * (j >> 4) + (j & 3); }
template <int CTRL, int RM> __device__ __forceinline__ float dppf(float x) { return __int_as_float(__builtin_amdgcn_update_dpp(0, __float_as_int(x), CTRL, RM, 0xf, true)); }
__device__ __forceinline__ float wave_total(float x) {
    x = row16_sum(x); x += dppf<0x142, 0xa>(x); x += dppf<0x143, 0xc>(x); return __int_as_float(__builtin_amdgcn_readlane(__float_as_int(x), 63)); }
__device__ __forceinline__ float wave_sum64(float x) { x = row16_sum(x); x += __shfl_xor(x, 16); x += __shfl_xor(x, 32); return x; }
__device__ __forceinline__ bf16x8 cfrag(const f32x16& x, int s) {
    u32x4 w; w.x = pk2(x[8 * s + 0], x[8 * s + 1]); w.y = pk2(x[8 * s + 2], x[8 * s + 3]); w.z = pk2(x[8 * s + 4], x[8 * s + 5]); w.w = pk2(x[8 * s + 6], x[8 * s + 7]); return __builtin_bit_cast(bf16x8, w); }
__device__ __forceinline__ bf16x8 cfrag2(const f32x4& a, const f32x4& b) { u32x4 w; w.x = pk2(a[0], a[1]); w.y = pk2(a[2], a[3]); w.z = pk2(b[0], b[1]); w.w = pk2(b[2], b[3]); return __builtin_bit_cast(bf16x8, w); }
__device__ __forceinline__ void lds_poll_ge(LAS unsigned* p, unsigned want) { while (__hip_atomic_load(p, __ATOMIC_RELAXED, __HIP_MEMORY_SCOPE_WORKGROUP) < want) __builtin_amdgcn_s_sleep(1); asm volatile("" ::: "memory"); }

__device__ __forceinline__ void cscan_job(const Args& a, const int wave, LAS unsigned char* lds, int bh) {
    int lane; asm volatile("v_mbcnt_lo_u32_b32 %0, -1, 0\n\tv_mbcnt_hi_u32_b32 %0, -1, %0" : "=v"(lane));
    const int tid = wave * 64 + lane;
    const int b = bh >> 4, h = bh & 15;
    const bf16_t* Rg = (const bf16_t*)(a.ws + WS_R); const bf16_t* Kg = (const bf16_t*)(a.ws + WS_K); const bf16_t* Vg = (const bf16_t*)(a.ws + WS_V);
    const bf16_t* Dg = (const bf16_t*)(a.ws + WS_DARR); const bf16_t* Ag = (const bf16_t*)(a.ws + WS_AARR);
    bf16_t* YAB = (bf16_t*)(a.ws + WS_YAB); float* RK = (float*)((unsigned char*)a.out + DO_RK);
    LAS unsigned* ready = (LAS unsigned*)(lds + CS_FLAGS); LAS unsigned* done = ready + CS_NSLOT; LAS unsigned* rawready = done + CS_NSLOT; LAS unsigned* rawfree = rawready + CS_NSLOT;
    __syncthreads();
    if (tid < 4 * CS_NSLOT) ready[tid] = 0u;
    __syncthreads();
    if (wave == 4) {
        const int rr = lane >> 3, cc = lane & 7;
        for (int c = 0; c < CS_NCH; ++c) {
            const int s = c % CS_NSLOT; LAS unsigned char* rw = lds + CS_RAW + s * CS_RAWSZ;
            const size_t m0 = (size_t)b * SEQ + (size_t)c * CS_L;
            u32x4 v[5][4], vp[3];
#pragma unroll
            for (int ar = 0; ar < 5; ++ar) { const bf16_t* src = (ar == 0) ? Rg : (ar == 1) ? Kg : (ar == 2) ? Vg : (ar == 3) ? Dg : Ag;
#pragma unroll
                for (int q4 = 0; q4 < 4; ++q4) v[ar][q4] = *(const u32x4*)(src + (m0 + 8 * q4 + rr) * DM + h * 64 + 8 * cc); }
#pragma unroll
            for (int ar = 0; ar < 3; ++ar) { const bf16_t* src = (ar == 0) ? Rg : (ar == 1) ? Kg : Vg; vp[ar] = (u32x4){0u, 0u, 0u, 0u};
                if (c > 0 && lane < 8) vp[ar] = *(const u32x4*)(src + (m0 - 1) * DM + h * 64 + 8 * cc); }
            if (c >= CS_NSLOT) lds_poll_ge(rawfree + s, (unsigned)(c / CS_NSLOT));
#pragma unroll
            for (int ar = 0; ar < 5; ++ar)
#pragma unroll
                for (int q4 = 0; q4 < 4; ++q4) *(LAS u32x4*)(rw + (ar * 33 + 1 + 8 * q4 + rr) * 128 + 16 * cc) = v[ar][q4];
            if (lane < 8) {
#pragma unroll
                for (int ar = 0; ar < 3; ++ar) *(LAS u32x4*)(rw + (ar * 33) * 128 + 16 * cc) = vp[ar]; }
            LDS_WAIT();
            if (lane == 0) __hip_atomic_store(rawready + s, (unsigned)(c + 1), __ATOMIC_RELAXED, __HIP_MEMORY_SCOPE_WORKGROUP);
        }
    } else if (wave >= 5) {
        const int hw = wave - 5, gch = h * 64 + lane;
        const float mur = a.mu_rkv[gch], muk = a.mu_rkv[DM + gch], muv = a.mu_rkv[2 * DM + gch], kkw = a.rwkv_vec[2 * DM + gch], kaw = a.rwkv_vec[3 * DM + gch], rkw = a.r_k[gch];
        const int kpos = 32 * (lane >> 5) + permp(lane & 31);
        for (int c = hw; c < CS_NCH; c += CS_NSLOT) {
            const int s = hw; LAS unsigned char* sl = lds + s * CS_SLOT; const LAS unsigned short* rw = (const LAS unsigned short*)(lds + CS_RAW + s * CS_RAWSZ);
            const unsigned use = (unsigned)(c / CS_NSLOT);
            { PROBE_BEGIN(10, a.ws, wave);
            if (use > 0u) lds_poll_ge(done + s, 4u * use);
            lds_poll_ge(rawready + s, (unsigned)(c + 1));
            PROBE_END(10, a.ws, wave); }
            PROBE_BEGIN(11, a.ws, wave);
            const size_t m0 = (size_t)b * SEQ + (size_t)c * CS_L; const size_t o0 = m0 * DM + gch;
            float rp = bflo((unsigned)rw[(0 * 33) * 64 + lane]), kp = bflo((unsigned)rw[(1 * 33) * 64 + lane]), vp = bflo((unsigned)rw[(2 * 33) * 64 + lane]);
            float cum = 0.f, gprev = 1.f;
            unsigned bcw[16], kcw[16], vcw[16];
#pragma unroll
            for (int grp = 0; grp < 4; ++grp) {
                float rlv[8], kkrv[8], kprv[8], vlv[8], aav[8], ddv[8], red[16];
#pragma unroll
                for (int e = 0; e < 8; ++e) { const int row = 1 + 8 * grp + e;
                    const float r0 = bflo((unsigned)rw[(0 * 33 + row) * 64 + lane]), k0 = bflo((unsigned)rw[(1 * 33 + row) * 64 + lane]), v0 = bflo((unsigned)rw[(2 * 33 + row) * 64 + lane]);
                    ddv[e] = bflo((unsigned)rw[(3 * 33 + row) * 64 + lane]); aav[e] = bflo((unsigned)rw[(4 * 33 + row) * 64 + lane]);
                    rlv[e] = r0 + (rp - r0) * mur; const float kl = k0 + (kp - k0) * muk; vlv[e] = v0 + (vp - v0) * muv; rp = r0; kp = k0; vp = v0;
                    kkrv[e] = kl * kkw; kprv[e] = kl * (1.0f + (aav[e] - 1.0f) * kaw);
                    red[2 * e] = kkrv[e] * kkrv[e]; red[2 * e + 1] = rlv[e] * kprv[e] * rkw; }
#pragma unroll
                for (int e = 0; e < 16; ++e) red[e] += dppf<0xB1, 0xf>(red[e]);
#pragma unroll
                for (int e = 0; e < 16; ++e) red[e] += dppf<0x4E, 0xf>(red[e]);
#pragma unroll
                for (int e = 0; e < 16; ++e) red[e] += dppf<0x141, 0xf>(red[e]);
#pragma unroll
                for (int e = 0; e < 16; ++e) red[e] += dppf<0x140, 0xf>(red[e]);
#pragma unroll
                for (int e = 0; e < 16; ++e) red[e] += dppf<0x142, 0xa>(red[e]);
#pragma unroll
                for (int e = 0; e < 16; ++e) red[e] += dppf<0x143, 0xc>(red[e]);
#pragma unroll
                for (int e = 0; e < 16; ++e) red[e] = __int_as_float(__builtin_amdgcn_readlane(__float_as_int(red[e]), 63));
                if (lane < 8) { float rkv = red[1];
#pragma unroll
                    for (int e = 1; e < 8; ++e) rkv = (lane == e) ? red[2 * e + 1] : rkv;
                    RK[(m0 + 8 * grp + lane) * 16 + h] = rkv; }
#pragma unroll
                for (int j2 = 0; j2 < 4; ++j2) {
                    const int i2 = 4 * grp + j2;
                    float nt[2], bt[2], kt[2], rt[2], vt[2];
#pragma unroll
                    for (int e = 0; e < 2; ++e) { const int te = 2 * j2 + e;
                        const float kkv = kkrv[te] * __builtin_amdgcn_rsqf(fmaxf(red[2 * te], 1e-24f)), bb = kkv * aav[te];
                        cum += ddv[te]; const float gi = __expf(-cum), ginv = __builtin_amdgcn_rcpf(gi);
                        nt[e] = -kkv * gprev; bt[e] = bb * ginv; kt[e] = kprv[te] * ginv; rt[e] = rlv[te] * gi; vt[e] = vlv[te]; gprev = gi; }
                    const unsigned wn = pk2(nt[0], nt[1]), wb = pk2(bt[0], bt[1]), wk = pk2(kt[0], kt[1]), wr = pk2(rt[0], rt[1]), wv = pk2(vt[0], vt[1]);
                    const int i = 2 * i2;
                    *(LAS unsigned short*)(sl + CS_NT + (i * 64 + kpos) * 2) = (unsigned short)wn; *(LAS unsigned short*)(sl + CS_NT + ((i + 1) * 64 + kpos) * 2) = (unsigned short)(wn >> 16);
                    *(LAS unsigned short*)(sl + CS_RT + (i * 64 + kpos) * 2) = (unsigned short)wr; *(LAS unsigned short*)(sl + CS_RT + ((i + 1) * 64 + kpos) * 2) = (unsigned short)(wr >> 16);
                    *(LAS unsigned short*)(sl + CS_BT + (i * 64 + kpos) * 2) = (unsigned short)wb; *(LAS unsigned short*)(sl + CS_BT + ((i + 1) * 64 + kpos) * 2) = (unsigned short)(wb >> 16);
                    *(LAS unsigned short*)(sl + CS_KT + (i * 64 + kpos) * 2) = (unsigned short)wk; *(LAS unsigned short*)(sl + CS_KT + ((i + 1) * 64 + kpos) * 2) = (unsigned short)(wk >> 16);
                    const int pw = permp(i) >> 1;
                    bcw[pw] = wb; kcw[pw] = wk; vcw[pw] = wv;
                }
                __builtin_amdgcn_sched_barrier(0);
            }
#pragma unroll
            for (int q4 = 0; q4 < 4; ++q4) {
                *(LAS u32x4*)(sl + CS_BC + lane * 64 + 16 * q4) = (u32x4){bcw[4 * q4], bcw[4 * q4 + 1], bcw[4 * q4 + 2], bcw[4 * q4 + 3]};
                *(LAS u32x4*)(sl + CS_KC + lane * 64 + 16 * q4) = (u32x4){kcw[4 * q4], kcw[4 * q4 + 1], kcw[4 * q4 + 2], kcw[4 * q4 + 3]};
                *(LAS u32x4*)(sl + CS_VC + lane * 64 + 16 * q4) = (u32x4){vcw[4 * q4], vcw[4 * q4 + 1], vcw[4 * q4 + 2], vcw[4 * q4 + 3]}; }
            *(LAS float*)(sl + CS_GL + lane * 4) = gprev;
            LDS_WAIT();
            if (lane == 0) __hip_atomic_store(rawfree + s, use + 1u, __ATOMIC_RELAXED, __HIP_MEMORY_SCOPE_WORKGROUP);
            PROBE_END(11, a.ws, wave);
            PROBE_BEGIN(12, a.ws, wave);
            const int tok = lane & 31, hf = lane >> 5;
            bf16x8 fn[4], fr[4], fb[4], fk[4];
#pragma unroll
            for (int ks = 0; ks < 4; ++ks) { fn[ks] = *(const LAS bf16x8*)(sl + CS_NT + (tok * 64 + 16 * ks + 8 * hf) * 2); fr[ks] = *(const LAS bf16x8*)(sl + CS_RT + (tok * 64 + 16 * ks + 8 * hf) * 2);
                fb[ks] = *(const LAS bf16x8*)(sl + CS_BT + (tok * 64 + 16 * ks + 8 * hf) * 2); fk[ks] = *(const LAS bf16x8*)(sl + CS_KT + (tok * 64 + 16 * ks + 8 * hf) * 2); }
            f32x16 P, Pt, Tm, Akn, Abr, Akr;
#pragma unroll
            for (int e = 0; e < 16; ++e) { P[e] = 0.f; Pt[e] = 0.f; Akn[e] = 0.f; Abr[e] = 0.f; Akr[e] = 0.f; }
#pragma unroll
            for (int ks = 0; ks < 4; ++ks) { P = __builtin_amdgcn_mfma_f32_32x32x16_bf16(fn[ks], fb[ks], P, 0, 0, 0); Pt = __builtin_amdgcn_mfma_f32_32x32x16_bf16(fb[ks], fn[ks], Pt, 0, 0, 0);
                Akn = __builtin_amdgcn_mfma_f32_32x32x16_bf16(fn[ks], fk[ks], Akn, 0, 0, 0); Abr = __builtin_amdgcn_mfma_f32_32x32x16_bf16(fr[ks], fb[ks], Abr, 0, 0, 0); Akr = __builtin_amdgcn_mfma_f32_32x32x16_bf16(fr[ks], fk[ks], Akr, 0, 0, 0); }
#pragma unroll
            for (int e = 0; e < 16; ++e) { const int row = (e & 3) + 8 * (e >> 2) + 4 * hf, col = tok;
                if (!(col < row)) { P[e] = 0.f; Akn[e] = 0.f; } if (!(row < col)) Pt[e] = 0.f; if (col > row) { Abr[e] = 0.f; Akr[e] = 0.f; }
                Tm[e] = P[e] + (row == col ? 1.0f : 0.f); }
#pragma unroll
            for (int mm = 1; mm <= 4; ++mm) {
                const bf16x8 p0 = cfrag(P, 0), p1 = cfrag(P, 1), q0 = cfrag(Pt, 0), q1 = cfrag(Pt, 1);
                f32x16 Ptn, Pn;
#pragma unroll
                for (int e = 0; e < 16; ++e) { Ptn[e] = 0.f; Pn[e] = 0.f; }
                Ptn = __builtin_amdgcn_mfma_f32_32x32x16_bf16(p0, q0, Ptn, 0, 0, 0); Ptn = __builtin_amdgcn_mfma_f32_32x32x16_bf16(p1, q1, Ptn, 0, 0, 0);
                if (mm < 4) { Pn = __builtin_amdgcn_mfma_f32_32x32x16_bf16(q0, p0, Pn, 0, 0, 0); Pn = __builtin_amdgcn_mfma_f32_32x32x16_bf16(q1, p1, Pn, 0, 0, 0); }
                const bf16x8 t0 = cfrag(Tm, 0), t1 = cfrag(Tm, 1), u0 = cfrag(Ptn, 0), u1 = cfrag(Ptn, 1);
                Tm = __builtin_amdgcn_mfma_f32_32x32x16_bf16(u0, t0, Tm, 0, 0, 0); Tm = __builtin_amdgcn_mfma_f32_32x32x16_bf16(u1, t1, Tm, 0, 0, 0);
                P = Pn; Pt = Ptn;
            }
            { const int pc = permp(tok);
#pragma unroll
              for (int e = 0; e < 16; e += 2) { const int row = (e & 3) + 8 * (e >> 2) + 4 * hf;
                const unsigned w0 = pk2(Tm[e], Tm[e + 1]), w1 = pk2(Akn[e], Akn[e + 1]), w2 = pk2(Abr[e], Abr[e + 1]), w3 = pk2(Akr[e], Akr[e + 1]);
                *(LAS unsigned short*)(sl + CS_TM + (row * 32 + pc) * 2) = (unsigned short)w0; *(LAS unsigned short*)(sl + CS_TM + ((row + 1) * 32 + pc) * 2) = (unsigned short)(w0 >> 16);
                *(LAS unsigned short*)(sl + CS_AKN + (row * 32 + pc) * 2) = (unsigned short)w1; *(LAS unsigned short*)(sl + CS_AKN + ((row + 1) * 32 + pc) * 2) = (unsigned short)(w1 >> 16);
                *(LAS unsigned short*)(sl + CS_ABR + (row * 32 + pc) * 2) = (unsigned short)w2; *(LAS unsigned short*)(sl + CS_ABR + ((row + 1) * 32 + pc) * 2) = (unsigned short)(w2 >> 16);
                *(LAS unsigned short*)(sl + CS_AKR + (row * 32 + pc) * 2) = (unsigned short)w3; *(LAS unsigned short*)(sl + CS_AKR + ((row + 1) * 32 + pc) * 2) = (unsigned short)(w3 >> 16); } }
            LDS_WAIT();
            if (lane == 0) __hip_atomic_store(ready + s, (unsigned)(c + 1), __ATOMIC_RELAXED, __HIP_MEMORY_SCOPE_WORKGROUP);
            PROBE_END(12, a.ws, wave);
        }
    } else {
        const int l15 = lane & 15, g = lane >> 4, vb = wave;
        f32x4 xc[4];
#pragma unroll
        for (int kt = 0; kt < 4; ++kt) xc[kt] = (f32x4){0.f, 0.f, 0.f, 0.f};
        for (int c = 0; c < CS_NCH; ++c) {
            const int s = c % CS_NSLOT; const LAS unsigned char* sl = lds + s * CS_SLOT;
            lds_poll_ge(ready + s, (unsigned)(c + 1));
            const bf16x8 xb0 = cfrag2(xc[0], xc[1]), xb1 = cfrag2(xc[2], xc[3]);
            const bf16x8 vop = *(const LAS bf16x8*)(sl + CS_VC + ((16 * vb + l15) * 32 + 8 * g) * 2);
            f32x4 W[2], U[2], Y[2];
#pragma unroll
            for (int rt = 0; rt < 2; ++rt) { const int row = 16 * rt + l15; f32x4 acc = (f32x4){0.f, 0.f, 0.f, 0.f};
                acc = __builtin_amdgcn_mfma_f32_16x16x32_bf16(*(const LAS bf16x8*)(sl + CS_AKN + (row * 32 + 8 * g) * 2), vop, acc, 0, 0, 0);
                acc = __builtin_amdgcn_mfma_f32_16x16x32_bf16(*(const LAS bf16x8*)(sl + CS_NT + (row * 64 + 8 * g) * 2), xb0, acc, 0, 0, 0);
                acc = __builtin_amdgcn_mfma_f32_16x16x32_bf16(*(const LAS bf16x8*)(sl + CS_NT + (row * 64 + 32 + 8 * g) * 2), xb1, acc, 0, 0, 0);
                W[rt] = acc; }
            const bf16x8 wb = cfrag2(W[0], W[1]);
#pragma unroll
            for (int rt = 0; rt < 2; ++rt) { const int row = 16 * rt + l15;
                U[rt] = __builtin_amdgcn_mfma_f32_16x16x32_bf16(*(const LAS bf16x8*)(sl + CS_TM + (row * 32 + 8 * g) * 2), wb, (f32x4){0.f, 0.f, 0.f, 0.f}, 0, 0, 0); }
            const bf16x8 ub = cfrag2(U[0], U[1]);
#pragma unroll
            for (int rt = 0; rt < 2; ++rt) { const int row = 16 * rt + l15; f32x4 acc = (f32x4){0.f, 0.f, 0.f, 0.f};
                acc = __builtin_amdgcn_mfma_f32_16x16x32_bf16(*(const LAS bf16x8*)(sl + CS_AKR + (row * 32 + 8 * g) * 2), vop, acc, 0, 0, 0);
                acc = __builtin_amdgcn_mfma_f32_16x16x32_bf16(*(const LAS bf16x8*)(sl + CS_RT + (row * 64 + 8 * g) * 2), xb0, acc, 0, 0, 0);
                acc = __builtin_amdgcn_mfma_f32_16x16x32_bf16(*(const LAS bf16x8*)(sl + CS_RT + (row * 64 + 32 + 8 * g) * 2), xb1, acc, 0, 0, 0);
                acc = __builtin_amdgcn_mfma_f32_16x16x32_bf16(*(const LAS bf16x8*)(sl + CS_ABR + (row * 32 + 8 * g) * 2), ub, acc, 0, 0, 0);
                Y[rt] = acc; }
#pragma unroll
            for (int kt = 0; kt < 4; ++kt) { const int row = 16 * kt + l15; f32x4 acc = xc[kt];
                acc = __builtin_amdgcn_mfma_f32_16x16x32_bf16(*(const LAS bf16x8*)(sl + CS_KC + (row * 32 + 8 * g) * 2), vop, acc, 0, 0, 0);
                acc = __builtin_amdgcn_mfma_f32_16x16x32_bf16(*(const LAS bf16x8*)(sl + CS_BC + (row * 32 + 8 * g) * 2), ub, acc, 0, 0, 0);
                xc[kt] = acc * *(const LAS f32x4*)(sl + CS_GL + (16 * kt + 4 * g) * 4); }
            LDS_WAIT();
            if (lane == 0) (void)__hip_atomic_fetch_add(done + s, 1u, __ATOMIC_RELAXED, __HIP_MEMORY_SCOPE_WORKGROUP);
#pragma unroll
            for (int rt = 0; rt < 2; ++rt)
#pragma unroll
                for (int e = 0; e < 4; ++e) { const size_t m = (size_t)b * SEQ + (size_t)c * CS_L + 16 * rt + 4 * g + e;
                    YAB[m * 2048 + 1024 + h * 64 + 16 * vb + l15] = (bf16_t)(pk2(Y[rt][e], 0.f) & 0xffffu); }
        }
    }
}

constexpr int CR_PIECE = 12, CR_NP = (CS_NCH + CR_PIECE - 1) / CR_PIECE, CR_PW = 4, CR_PSLOT = CS_SLOT + 2 * 33 * 128;
constexpr size_t DO_IMG = 66 * MiB;
static_assert((CR_PIECE % 4) == 0 && DO_IMG + (size_t)2 * 64 * CR_PIECE * CS_SLOT <= 128 * MiB && CR_PW * CR_PSLOT <= CS_FLAGS, "image buffer / producer slots");

__device__ __forceinline__ void cscan_produce(const Args& a, const int wave, LAS unsigned char* lds, const int piece, const int first, const int nblk) {
    const int nch = (CS_NCH - piece * CR_PIECE) < CR_PIECE ? (CS_NCH - piece * CR_PIECE) : CR_PIECE;
    if (wave >= CR_PW) {
        const int lane = lane_id(); const int iw = ((int)blockIdx.x - first) * (NWAVES - CR_PW) + (wave - CR_PW), niw = nblk * (NWAVES - CR_PW);
        for (int t = piece * 2 * niw + iw; t < (piece + 1) * 2 * niw && t < MTOK; t += niw) rope_item(a, t, lane);
        return; }
    const bf16_t* Rg = (const bf16_t*)(a.ws + WS_R); const bf16_t* Kg = (const bf16_t*)(a.ws + WS_K); const bf16_t* Vg = (const bf16_t*)(a.ws + WS_V);
    const bf16_t* Dg = (const bf16_t*)(a.ws + WS_DARR); const bf16_t* Ag = (const bf16_t*)(a.ws + WS_AARR);
    float* RK = (float*)((unsigned char*)a.out + DO_RK); unsigned char* IMG = (unsigned char*)a.out + DO_IMG + (size_t)(piece & 1) * 64 * CR_PIECE * CS_SLOT;
    LAS unsigned char* sl = lds + wave * CR_PSLOT;
    const LAS unsigned short* rawD = (const LAS unsigned short*)(sl + 16384); const LAS unsigned short* rawA = (const LAS unsigned short*)(sl + 20480);
    const LAS unsigned short* rawR = (const LAS unsigned short*)(sl + 24576); const LAS unsigned short* rawK = (const LAS unsigned short*)(sl + CS_SLOT); const LAS unsigned short* rawV = (const LAS unsigned short*)(sl + CS_SLOT + 33 * 128);
    u32x4 pre[5][4], prep[3];
    auto issue = [&](int it2, int rr, int c8, int lane) { const int bh2 = it2 / nch, cc2 = it2 % nch, c2 = piece * CR_PIECE + cc2; const unsigned mm = (unsigned)(bh2 >> 4) * SEQ + (unsigned)c2 * CS_L; const int hh = bh2 & 15;
        const unsigned eoff = ((mm + rr) * DM + hh * 64 + 8 * c8) * 2u;
        const unsigned char* wsb = a.ws;
#pragma unroll
        for (int ar = 0; ar < 5; ++ar) { constexpr size_t AOFF[5] = {WS_R, WS_K, WS_V, WS_DARR, WS_AARR};
#pragma unroll
            for (int q4 = 0; q4 < 4; ++q4) pre[ar][q4] = *(const u32x4*)(wsb + AOFF[ar] + eoff + (unsigned)(8 * q4 * DM * 2)); }
        const bool hasp = (c2 > 0) && (lane < 8); const unsigned poff = hasp ? (eoff - (unsigned)((rr + 1) * DM * 2)) : eoff;
#pragma unroll
        for (int ar = 0; ar < 3; ++ar) { constexpr size_t AOFF[3] = {WS_R, WS_K, WS_V}; const u32x4 t = *(const u32x4*)(wsb + AOFF[ar] + poff); prep[ar] = hasp ? t : (u32x4){0u, 0u, 0u, 0u}; } };
    const int it0 = ((int)blockIdx.x - first) * CR_PW + wave, nimg = 64 * nch, itstep = nblk * CR_PW;
    { const int l0 = lane_id(); if (it0 < nimg) issue(it0, l0 >> 3, l0 & 7, l0); }
    for (int it = it0; it < nimg; it += itstep) {
        const int lane = lane_id(), rr = lane >> 3, c8 = lane & 7, kpos = 32 * (lane >> 5) + permp(lane & 31);
        const int bh = it / nch, cc = it % nch, b = bh >> 4, h = bh & 15, c = piece * CR_PIECE + cc, gch = h * 64 + lane;
        const float mur = a.mu_rkv[gch], muk = a.mu_rkv[DM + gch], muv = a.mu_rkv[2 * DM + gch], kkw = a.rwkv_vec[2 * DM + gch], kaw = a.rwkv_vec[3 * DM + gch], rkw = a.r_k[gch];
            const size_t m0 = (size_t)b * SEQ + (size_t)c * CS_L;
            { LAS unsigned char* wb = sl + rr * 128 + 16 * c8; asm volatile("" : "+v"(wb));
#pragma unroll
              for (int q4 = 0; q4 < 4; ++q4) {
                *(LAS u32x4*)(wb + 24576 + (8 * q4 + 1) * 128) = pre[0][q4]; *(LAS u32x4*)(wb + CS_SLOT + (8 * q4 + 1) * 128) = pre[1][q4]; *(LAS u32x4*)(wb + CS_SLOT + 33 * 128 + (8 * q4 + 1) * 128) = pre[2][q4];
                *(LAS u32x4*)(wb + 16384 + (8 * q4) * 128) = pre[3][q4]; *(LAS u32x4*)(wb + 20480 + (8 * q4) * 128) = pre[4][q4]; }
              if (lane < 8) { *(LAS u32x4*)(wb + 24576) = prep[0]; *(LAS u32x4*)(wb + CS_SLOT) = prep[1]; *(LAS u32x4*)(wb + CS_SLOT + 33 * 128) = prep[2]; } }
            LDS_WAIT();
            const LAS unsigned short* rb = (const LAS unsigned short*)sl + lane; asm volatile("" : "+v"(rb));
            float rp = bflo((unsigned)rb[24576 / 2]), kp = bflo((unsigned)rb[CS_SLOT / 2]), vp = bflo((unsigned)rb[(CS_SLOT + 33 * 128) / 2]);
            float cum = 0.f, gprev = 1.f;
            unsigned bcw[16], kcw[16], vcw[16];
#pragma unroll
            for (int grp = 0; grp < 4; ++grp) {
                float rlv[8], kkrv[8], kprv[8], vlv[8], aav[8], ddv[8], red[16];
#pragma unroll
                for (int e = 0; e < 8; ++e) { const int row = 8 * grp + e;
                    const float r0 = bflo((unsigned)rb[24576 / 2 + (row + 1) * 64]), k0 = bflo((unsigned)rb[CS_SLOT / 2 + (row + 1) * 64]), v0 = bflo((unsigned)rb[(CS_SLOT + 33 * 128) / 2 + (row + 1) * 64]);
                    ddv[e] = bflo((unsigned)rb[16384 / 2 + row * 64]); aav[e] = bflo((unsigned)rb[20480 / 2 + row * 64]);
                    rlv[e] = r0 + (rp - r0) * mur; const float kl = k0 + (kp - k0) * muk; vlv[e] = v0 + (vp - v0) * muv; rp = r0; kp = k0; vp = v0;
                    kkrv[e] = kl * kkw; kprv[e] = kl * (1.0f + (aav[e] - 1.0f) * kaw);
                    red[2 * e] = kkrv[e] * kkrv[e]; red[2 * e + 1] = rlv[e] * kprv[e] * rkw; }
#pragma unroll
                for (int e = 0; e < 16; ++e) red[e] += dppf<0xB1, 0xf>(red[e]);
#pragma unroll
                for (int e = 0; e < 16; ++e) red[e] += dppf<0x4E, 0xf>(red[e]);
#pragma unroll
                for (int e = 0; e < 16; ++e) red[e] += dppf<0x141, 0xf>(red[e]);
#pragma unroll
                for (int e = 0; e < 16; ++e) red[e] += dppf<0x140, 0xf>(red[e]);
#pragma unroll
                for (int e = 0; e < 16; ++e) red[e] += dppf<0x142, 0xa>(red[e]);
#pragma unroll
                for (int e = 0; e < 16; ++e) red[e] += dppf<0x143, 0xc>(red[e]);
#pragma unroll
                for (int e = 0; e < 16; ++e) red[e] = __int_as_float(__builtin_amdgcn_readlane(__float_as_int(red[e]), 63));
                if (lane < 8) { float rkv = red[1];
#pragma unroll
                    for (int e = 1; e < 8; ++e) rkv = (lane == e) ? red[2 * e + 1] : rkv;
                    RK[(m0 + 8 * grp + lane) * 16 + h] = rkv; }
#pragma unroll
                for (int j2 = 0; j2 < 4; ++j2) {
                    const int i2 = 4 * grp + j2;
                    float nt[2], bt[2], kt[2], rt[2], vt[2];
#pragma unroll
                    for (int e = 0; e < 2; ++e) { const int te = 2 * j2 + e;
                        const float kkv = kkrv[te] * __builtin_amdgcn_rsqf(fmaxf(red[2 * te], 1e-24f)), bb = kkv * aav[te];
                        cum += ddv[te]; const float gi = __expf(-cum), ginv = __builtin_amdgcn_rcpf(gi);
                        nt[e] = -kkv * gprev; bt[e] = bb * ginv; kt[e] = kprv[te] * ginv; rt[e] = rlv[te] * gi; vt[e] = vlv[te]; gprev = gi; }
                    const unsigned wn = pk2(nt[0], nt[1]), wb = pk2(bt[0], bt[1]), wk = pk2(kt[0], kt[1]), wr = pk2(rt[0], rt[1]), wv = pk2(vt[0], vt[1]);
                    const int i = 2 * i2;
                    *(LAS unsigned short*)(sl + CS_NT + (i * 64 + kpos) * 2) = (unsigned short)wn; *(LAS unsigned short*)(sl + CS_NT + ((i + 1) * 64 + kpos) * 2) = (unsigned short)(wn >> 16);
                    *(LAS unsigned short*)(sl + CS_RT + (i * 64 + kpos) * 2) = (unsigned short)wr; *(LAS unsigned short*)(sl + CS_RT + ((i + 1) * 64 + kpos) * 2) = (unsigned short)(wr >> 16);
                    *(LAS unsigned short*)(sl + CS_BT + (i * 64 + kpos) * 2) = (unsigned short)wb; *(LAS unsigned short*)(sl + CS_BT + ((i + 1) * 64 + kpos) * 2) = (unsigned short)(wb >> 16);
                    *(LAS unsigned short*)(sl + CS_KT + (i * 64 + kpos) * 2) = (unsigned short)wk; *(LAS unsigned short*)(sl + CS_KT + ((i + 1) * 64 + kpos) * 2) = (unsigned short)(wk >> 16);
                    const int pw = permp(i) >> 1;
                    bcw[pw] = wb; kcw[pw] = wk; vcw[pw] = wv;
                }
                __builtin_amdgcn_sched_barrier(0);
            }
#pragma unroll
            for (int q4 = 0; q4 < 4; ++q4) {
                *(LAS u32x4*)(sl + CS_BC + lane * 64 + 16 * q4) = (u32x4){bcw[4 * q4], bcw[4 * q4 + 1], bcw[4 * q4 + 2], bcw[4 * q4 + 3]};
                *(LAS u32x4*)(sl + CS_KC + lane * 64 + 16 * q4) = (u32x4){kcw[4 * q4], kcw[4 * q4 + 1], kcw[4 * q4 + 2], kcw[4 * q4 + 3]};
                *(LAS u32x4*)(sl + CS_VC + lane * 64 + 16 * q4) = (u32x4){vcw[4 * q4], vcw[4 * q4 + 1], vcw[4 * q4 + 2], vcw[4 * q4 + 3]}; }
            *(LAS float*)(sl + CS_GL + lane * 4) = gprev;
            LDS_WAIT();
            const int tok = lane & 31, hf = lane >> 5;
            bf16x8 fn[4], fr[4], fb[4], fk[4];
#pragma unroll
            for (int ks = 0; ks < 4; ++ks) { fn[ks] = *(const LAS bf16x8*)(sl + CS_NT + (tok * 64 + 16 * ks + 8 * hf) * 2); fr[ks] = *(const LAS bf16x8*)(sl + CS_RT + (tok * 64 + 16 * ks + 8 * hf) * 2);
                fb[ks] = *(const LAS bf16x8*)(sl + CS_BT + (tok * 64 + 16 * ks + 8 * hf) * 2); fk[ks] = *(const LAS bf16x8*)(sl + CS_KT + (tok * 64 + 16 * ks + 8 * hf) * 2); }
            f32x16 P, Pt, Tm, Akn, Abr, Akr;
#pragma unroll
            for (int e = 0; e < 16; ++e) { P[e] = 0.f; Pt[e] = 0.f; Akn[e] = 0.f; Abr[e] = 0.f; Akr[e] = 0.f; }
#pragma unroll
            for (int ks = 0; ks < 4; ++ks) { P = __builtin_amdgcn_mfma_f32_32x32x16_bf16(fn[ks], fb[ks], P, 0, 0, 0); Pt = __builtin_amdgcn_mfma_f32_32x32x16_bf16(fb[ks], fn[ks], Pt, 0, 0, 0);
                Akn = __builtin_amdgcn_mfma_f32_32x32x16_bf16(fn[ks], fk[ks], Akn, 0, 0, 0); Abr = __builtin_amdgcn_mfma_f32_32x32x16_bf16(fr[ks], fb[ks], Abr, 0, 0, 0); Akr = __builtin_amdgcn_mfma_f32_32x32x16_bf16(fr[ks], fk[ks], Akr, 0, 0, 0); }
#pragma unroll
            for (int e = 0; e < 16; ++e) { const int row = (e & 3) + 8 * (e >> 2) + 4 * hf, col = tok;
                if (!(col < row)) { P[e] = 0.f; Akn[e] = 0.f; } if (!(row < col)) Pt[e] = 0.f; if (col > row) { Abr[e] = 0.f; Akr[e] = 0.f; }
                Tm[e] = P[e] + (row == col ? 1.0f : 0.f); }
#pragma unroll
            for (int mm = 1; mm <= 4; ++mm) {
                const bf16x8 p0 = cfrag(P, 0), p1 = cfrag(P, 1), q0 = cfrag(Pt, 0), q1 = cfrag(Pt, 1);
                f32x16 Ptn, Pn;
#pragma unroll
                for (int e = 0; e < 16; ++e) { Ptn[e] = 0.f; Pn[e] = 0.f; }
                Ptn = __builtin_amdgcn_mfma_f32_32x32x16_bf16(p0, q0, Ptn, 0, 0, 0); Ptn = __builtin_amdgcn_mfma_f32_32x32x16_bf16(p1, q1, Ptn, 0, 0, 0);
                if (mm < 4) { Pn = __builtin_amdgcn_mfma_f32_32x32x16_bf16(q0, p0, Pn, 0, 0, 0); Pn = __builtin_amdgcn_mfma_f32_32x32x16_bf16(q1, p1, Pn, 0, 0, 0); }
                const bf16x8 t0 = cfrag(Tm, 0), t1 = cfrag(Tm, 1), u0 = cfrag(Ptn, 0), u1 = cfrag(Ptn, 1);
                Tm = __builtin_amdgcn_mfma_f32_32x32x16_bf16(u0, t0, Tm, 0, 0, 0); Tm = __builtin_amdgcn_mfma_f32_32x32x16_bf16(u1, t1, Tm, 0, 0, 0);
                P = Pn; Pt = Ptn;
            }
            { const int itn = it + itstep; if (itn < nimg) { const int l2 = lane_id(); issue(itn, l2 >> 3, l2 & 7, l2); } }
            { const int pc = permp(tok);
#pragma unroll
              for (int e = 0; e < 16; e += 2) { const int row = (e & 3) + 8 * (e >> 2) + 4 * hf;
                const unsigned w0 = pk2(Tm[e], Tm[e + 1]), w1 = pk2(Akn[e], Akn[e + 1]), w2 = pk2(Abr[e], Abr[e + 1]), w3 = pk2(Akr[e], Akr[e + 1]);
                *(LAS unsigned short*)(sl + CS_TM + (row * 32 + pc) * 2) = (unsigned short)w0; *(LAS unsigned short*)(sl + CS_TM + ((row + 1) * 32 + pc) * 2) = (unsigned short)(w0 >> 16);
                *(LAS unsigned short*)(sl + CS_AKN + (row * 32 + pc) * 2) = (unsigned short)w1; *(LAS unsigned short*)(sl + CS_AKN + ((row + 1) * 32 + pc) * 2) = (unsigned short)(w1 >> 16);
                *(LAS unsigned short*)(sl + CS_ABR + (row * 32 + pc) * 2) = (unsigned short)w2; *(LAS unsigned short*)(sl + CS_ABR + ((row + 1) * 32 + pc) * 2) = (unsigned short)(w2 >> 16);
                *(LAS unsigned short*)(sl + CS_AKR + (row * 32 + pc) * 2) = (unsigned short)w3; *(LAS unsigned short*)(sl + CS_AKR + ((row + 1) * 32 + pc) * 2) = (unsigned short)(w3 >> 16); } }
            LDS_WAIT();
            { unsigned char* dst = IMG + (size_t)(bh * CR_PIECE + cc) * CS_SLOT;
#pragma unroll 1
              for (int j = lane; j < CS_SLOT / 16; j += 64) *(u32x4*)(dst + 16 * j) = *(const LAS u32x4*)(sl + 16 * j); }
            LDS_WAIT();
    }
}

__device__ __forceinline__ void cscan_consume(const Args& a, const int wave, LAS unsigned char* lds, const int bh, const int piece, f32x4 (&xc)[4]) {
    const int lane = lane_id();
    const int b = bh >> 4, h = bh & 15;
    bf16_t* YAB = (bf16_t*)(a.ws + WS_YAB); const unsigned char* IMG = (const unsigned char*)a.out + DO_IMG + (size_t)(piece & 1) * 64 * CR_PIECE * CS_SLOT;
    const int nch = (CS_NCH - piece * CR_PIECE) < CR_PIECE ? (CS_NCH - piece * CR_PIECE) : CR_PIECE;
    LAS unsigned* ready = (LAS unsigned*)(lds + CS_FLAGS); LAS unsigned* done = ready + 4;
    if (wave == 4) {
        constexpr int NI = (CS_SLOT + 1023) / 1024;
        for (int cc = 0; cc <= nch; ++cc) {
            if (cc < nch) { const int c = piece * CR_PIECE + cc, s = cc & 3; LAS unsigned char* sl = lds + s * CS_SLOT;
                const unsigned char* src = IMG + (size_t)(bh * CR_PIECE + cc) * CS_SLOT;
                if (c >= 4) lds_poll_ge(done + s, 4u * (unsigned)(c >> 2));
#pragma unroll
                for (int j = 0; j < NI; ++j) { const int idx = lane + 64 * j;
                    if (idx < CS_SLOT / 16) __builtin_amdgcn_global_load_lds((const unsigned*)(src + 16 * idx), (LAS unsigned*)(sl + 1024 * j), 16, 0, 0); } }
            if (cc >= 1) {
                if (cc < nch) asm volatile("s_waitcnt vmcnt(29)" ::: "memory"); else asm volatile("s_waitcnt vmcnt(0)" ::: "memory");
                if (lane == 0) __hip_atomic_store(ready + ((cc - 1) & 3), (unsigned)(piece * CR_PIECE + cc), __ATOMIC_RELAXED, __HIP_MEMORY_SCOPE_WORKGROUP); }
        }
    } else if (wave < 4) {
        const int l15 = lane & 15, g = lane >> 4, vb = wave;
        for (int cc = 0; cc < nch; ++cc) { const int c = piece * CR_PIECE + cc, s = cc & 3; const LAS unsigned char* sl = lds + s * CS_SLOT;
            { lds_poll_ge(ready + s, (unsigned)(c + 1)); }
            const bf16x8 xb0 = cfrag2(xc[0], xc[1]), xb1 = cfrag2(xc[2], xc[3]);
            const bf16x8 vop = *(const LAS bf16x8*)(sl + CS_VC + ((16 * vb + l15) * 32 + 8 * g) * 2);
            f32x4 W[2], U[2], Y[2];
#pragma unroll
            for (int rt = 0; rt < 2; ++rt) { const int row = 16 * rt + l15; f32x4 acc = (f32x4){0.f, 0.f, 0.f, 0.f};
                acc = __builtin_amdgcn_mfma_f32_16x16x32_bf16(*(const LAS bf16x8*)(sl + CS_AKN + (row * 32 + 8 * g) * 2), vop, acc, 0, 0, 0);
                acc = __builtin_amdgcn_mfma_f32_16x16x32_bf16(*(const LAS bf16x8*)(sl + CS_NT + (row * 64 + 8 * g) * 2), xb0, acc, 0, 0, 0);
                acc = __builtin_amdgcn_mfma_f32_16x16x32_bf16(*(const LAS bf16x8*)(sl + CS_NT + (row * 64 + 32 + 8 * g) * 2), xb1, acc, 0, 0, 0);
                W[rt] = acc; }
            const bf16x8 wb = cfrag2(W[0], W[1]);
#pragma unroll
            for (int rt = 0; rt < 2; ++rt) { const int row = 16 * rt + l15;
                U[rt] = __builtin_amdgcn_mfma_f32_16x16x32_bf16(*(const LAS bf16x8*)(sl + CS_TM + (row * 32 + 8 * g) * 2), wb, (f32x4){0.f, 0.f, 0.f, 0.f}, 0, 0, 0); }
            const bf16x8 ub = cfrag2(U[0], U[1]);
#pragma unroll
            for (int rt = 0; rt < 2; ++rt) { const int row = 16 * rt + l15; f32x4 acc = (f32x4){0.f, 0.f, 0.f, 0.f};
                acc = __builtin_amdgcn_mfma_f32_16x16x32_bf16(*(const LAS bf16x8*)(sl + CS_AKR + (row * 32 + 8 * g) * 2), vop, acc, 0, 0, 0);
                acc = __builtin_amdgcn_mfma_f32_16x16x32_bf16(*(const LAS bf16x8*)(sl + CS_RT + (row * 64 + 8 * g) * 2), xb0, acc, 0, 0, 0);
                acc = __builtin_amdgcn_mfma_f32_16x16x32_bf16(*(const LAS bf16x8*)(sl + CS_RT + (row * 64 + 32 + 8 * g) * 2), xb1, acc, 0, 0, 0);
                acc = __builtin_amdgcn_mfma_f32_16x16x32_bf16(*(const LAS bf16x8*)(sl + CS_ABR + (row * 32 + 8 * g) * 2), ub, acc, 0, 0, 0);
                Y[rt] = acc; }
#pragma unroll
            for (int kt = 0; kt < 4; ++kt) { const int row = 16 * kt + l15; f32x4 acc = xc[kt];
                acc = __builtin_amdgcn_mfma_f32_16x16x32_bf16(*(const LAS bf16x8*)(sl + CS_KC + (row * 32 + 8 * g) * 2), vop, acc, 0, 0, 0);
                acc = __builtin_amdgcn_mfma_f32_16x16x32_bf16(*(const LAS bf16x8*)(sl + CS_BC + (row * 32 + 8 * g) * 2), ub, acc, 0, 0, 0);
                xc[kt] = acc * *(const LAS f32x4*)(sl + CS_GL + (16 * kt + 4 * g) * 4); }
            LDS_WAIT();
            if (lane == 0) (void)__hip_atomic_fetch_add(done + s, 1u, __ATOMIC_RELAXED, __HIP_MEMORY_SCOPE_WORKGROUP);
#pragma unroll
            for (int rt = 0; rt < 2; ++rt)
#pragma unroll
                for (int e = 0; e < 4; ++e) { const size_t m = (size_t)b * SEQ + (size_t)c * CS_L + 16 * rt + 4 * g + e;
                    YAB[m * 2048 + 1024 + h * 64 + 16 * vb + l15] = (bf16_t)(pk2(Y[rt][e], 0.f) & 0xffffu); }
        }
    }
}

constexpr int DS_NQ = 16, DS_CAP = 2048, DS_TRIG = 1536, DS_TOPK = 256;
constexpr int DS_HIST_WORDS = 320;
constexpr int DS_KT_BYTES = 2048;
constexpr int DS_CAND_OFF = 0, DS_HIST_OFF = DS_NQ * DS_CAP * 4, DS_KT_OFF = DS_HIST_OFF, DS_CNT_OFF = DS_HIST_OFF + 8 * DS_KT_BYTES, DS_TAU_OFF = DS_CNT_OFF + 64;
static_assert(8 * DS_HIST_WORDS * 4 <= 8 * DS_KT_BYTES, "dsa LDS map");
static_assert(DS_TAU_OFF + 64 <= LDS_BYTES, "dsa LDS map");

template <int CTRL, int RM> __device__ __forceinline__ unsigned dppu(unsigned x) { return (unsigned)__builtin_amdgcn_update_dpp(0, (int)x, CTRL, RM, 0xf, true); }
__device__ __forceinline__ unsigned wave_scan_incl(unsigned v) {
    v += dppu<0x111, 0xf>(v); v += dppu<0x112, 0xf>(v); v += dppu<0x114, 0xf>(v); v += dppu<0x118, 0xf>(v);
    v += dppu<0x142, 0xa>(v);
    v += dppu<0x143, 0xc>(v);
    return v; }
template <int NE>
__device__ __forceinline__ void select_compact(LAS unsigned* cq, LAS unsigned* cntq, LAS unsigned* tauq, LAS unsigned* hist, int lane) {
    const unsigned n = *cntq;
    unsigned e[NE];
#pragma unroll
    for (int j = 0; j < NE; ++j) { const unsigned idx = lane + 64 * j; e[j] = idx < n ? cq[idx] : 0u; }
    unsigned npos = 0u;
#pragma unroll
    for (int j = 0; j < NE; ++j) npos += (unsigned)__popcll(__ballot(e[j] >= 0x80000000u));
    if (npos >= (unsigned)DS_TOPK) {
#pragma unroll
        for (int j = 0; j < NE; ++j) e[j] = (e[j] >= 0x80000000u) ? e[j] : 0u; }
    unsigned va = 0xFFFFFFFFu, vo = 0u;
#pragma unroll
    for (int j = 0; j < NE; ++j) { va &= (e[j] != 0u) ? e[j] : 0xFFFFFFFFu; vo |= e[j]; }
    va &= (unsigned)__builtin_amdgcn_update_dpp(-1, (int)va, 0xB1, 0xf, 0xf, true); va &= (unsigned)__builtin_amdgcn_update_dpp(-1, (int)va, 0x4E, 0xf, 0xf, true);
    va &= (unsigned)__builtin_amdgcn_update_dpp(-1, (int)va, 0x141, 0xf, 0xf, true); va &= (unsigned)__builtin_amdgcn_update_dpp(-1, (int)va, 0x140, 0xf, 0xf, true);
    vo |= dppu<0xB1, 0xf>(vo); vo |= dppu<0x4E, 0xf>(vo); vo |= dppu<0x141, 0xf>(vo); vo |= dppu<0x140, 0xf>(vo);
    const unsigned vas = (unsigned)(__builtin_amdgcn_readlane((int)va, 0) & __builtin_amdgcn_readlane((int)va, 16) & __builtin_amdgcn_readlane((int)va, 32) & __builtin_amdgcn_readlane((int)va, 48));
    const unsigned vos = (unsigned)(__builtin_amdgcn_readlane((int)vo, 0) | __builtin_amdgcn_readlane((int)vo, 16) | __builtin_amdgcn_readlane((int)vo, 32) | __builtin_amdgcn_readlane((int)vo, 48));
    const unsigned diff = vas ^ vos;
    const int top = diff ? 31 - __builtin_clz(diff) : 7;
    unsigned prefix = (top >= 31) ? 0u : (vos & ~((2u << top) - 1u)), mask = (top >= 31) ? 0u : ~((2u << top) - 1u), need = DS_TOPK;
    int hi = top;
    const int rl = 63 - lane;
#pragma unroll 1
    for (int pass = 0; pass < 4 && hi >= 0; ++pass) {
        const int shift = hi >= 7 ? hi - 7 : 0; const unsigned dmask = (hi >= 7) ? 0xFFu : ((2u << hi) - 1u);
        *(LAS u32x4*)(hist + 4 * lane) = (u32x4){0u, 0u, 0u, 0u};
        LDS_WAIT();
#pragma unroll
        for (int j = 0; j < NE; ++j) { const bool hit = (e[j] != 0u) && ((e[j] & mask) == prefix); const unsigned bin = hit ? ((e[j] >> shift) & dmask) : (256u + (unsigned)lane);
            (void)__hip_atomic_fetch_add(hist + bin, 1u, __ATOMIC_RELAXED, __HIP_MEMORY_SCOPE_WORKGROUP); }
        LDS_WAIT();
        const u32x4 h4 = *(const LAS u32x4*)(hist + 4 * rl);
        const unsigned tot = (h4.x + h4.y) + (h4.z + h4.w);
        const unsigned v = wave_scan_incl(tot);
        const unsigned above = v - tot;
        const bool is = (above < need) && (need <= v);
        unsigned B = 0u, ca = 0u;
        if (is) { unsigned c = above;
            if (c + h4.w >= need) { B = 4 * rl + 3; ca = c; } else { c += h4.w;
            if (c + h4.z >= need) { B = 4 * rl + 2; ca = c; } else { c += h4.z;
            if (c + h4.y >= need) { B = 4 * rl + 1; ca = c; } else { c += h4.y; B = 4 * rl; ca = c; } } } }
        const unsigned long long bal = __ballot(is);
        if (bal == 0ull) break;
        const int src = __builtin_amdgcn_readfirstlane(__ffsll((long long)bal) - 1);
        B = (unsigned)__builtin_amdgcn_readlane((int)B, src); ca = (unsigned)__builtin_amdgcn_readlane((int)ca, src);
        need -= ca; prefix |= B << shift; mask |= dmask << shift; hi = shift - 1;
    }
    const unsigned T = prefix;
    unsigned base = 0u;
#pragma unroll
    for (int j = 0; j < NE; ++j) { const bool keep = (e[j] >= T) && (e[j] != 0u); const unsigned long long bal = __ballot(keep);
        const unsigned pos = base + __builtin_amdgcn_mbcnt_hi((unsigned)(bal >> 32), __builtin_amdgcn_mbcnt_lo((unsigned)bal, 0u));
        if (keep) cq[pos] = e[j];
        base += (unsigned)__popcll(bal); }
    if (lane == 0) { *cntq = base; *tauq = T; }
    LDS_WAIT();
}

template <int NE>
__device__ __forceinline__ void filter_compact(LAS unsigned* cq, LAS unsigned* cntq, LAS unsigned* tauq, int lane) {
    const unsigned n = *cntq;
    unsigned e[NE];
#pragma unroll
    for (int j = 0; j < NE; ++j) { const unsigned idx = lane + 64 * j; e[j] = idx < n ? cq[idx] : 0u; }
    unsigned m0 = 0u, m1 = 0u, m2 = 0u, m3 = 0u;
#pragma unroll
    for (int j = 0; j < NE; ++j) { unsigned x = e[j], t;
        t = max(m0, x); x = min(m0, x); m0 = t; t = max(m1, x); x = min(m1, x); m1 = t; t = max(m2, x); x = min(m2, x); m2 = t; m3 = max(m3, x); }
    unsigned T = m3;
    T = min(T, (unsigned)__builtin_amdgcn_update_dpp(-1, (int)T, 0xB1, 0xf, 0xf, true)); T = min(T, (unsigned)__builtin_amdgcn_update_dpp(-1, (int)T, 0x4E, 0xf, 0xf, true));
    T = min(T, (unsigned)__builtin_amdgcn_update_dpp(-1, (int)T, 0x141, 0xf, 0xf, true)); T = min(T, (unsigned)__builtin_amdgcn_update_dpp(-1, (int)T, 0x140, 0xf, 0xf, true));
    T = min(min((unsigned)__builtin_amdgcn_readlane((int)T, 0), (unsigned)__builtin_amdgcn_readlane((int)T, 16)), min((unsigned)__builtin_amdgcn_readlane((int)T, 32), (unsigned)__builtin_amdgcn_readlane((int)T, 48)));
    unsigned base = 0u;
#pragma unroll
    for (int j = 0; j < NE; ++j) { const bool keep = (e[j] >= T) && (e[j] != 0u); const unsigned long long bal = __ballot(keep);
        const unsigned pos = base + __builtin_amdgcn_mbcnt_hi((unsigned)(bal >> 32), __builtin_amdgcn_mbcnt_lo((unsigned)bal, 0u));
        if (keep) cq[pos] = e[j];
        base += (unsigned)__popcll(bal); }
    if (lane == 0) { *cntq = base; *tauq = (T > 0u) ? T - 1u : 0u; }
    LDS_WAIT();
}

__device__ __forceinline__ float relu_(float x) { return __int_as_float(max(__float_as_int(x), 0)); }
__device__ __forceinline__ unsigned vrow_off(int pr) { return (unsigned)(pr < 28 ? 1024 + 256 * pr : 9216 + 256 * (pr - 28)); }
__device__ __forceinline__ unsigned swz_b(int row) { return (unsigned)(((row & 3) << 2) | ((row >> 2) & 3)); }

__device__ __forceinline__ void dsa_phase(const Args& a, const int wave, LAS unsigned char* lds, const bool dry = false) {
    const bf16_t* Qg = (const bf16_t*)(a.ws + WS_Q); const bf16_t* KVg = (const bf16_t*)(a.ws + WS_KV); const bf16_t* QIg = (const bf16_t*)(a.ws + WS_QI);
    const bf16_t* KIg = (const bf16_t*)(a.ws + WS_KI); const float* WIg = (const float*)(a.ws + WS_WI); bf16_t* Gg = (bf16_t*)(a.ws + WS_G);
    LAS unsigned* cand = (LAS unsigned*)(lds + DS_CAND_OFF); LAS unsigned* hist = (LAS unsigned*)(lds + DS_HIST_OFF) + wave * DS_HIST_WORDS;
    LAS unsigned* cnt = (LAS unsigned*)(lds + DS_CNT_OFF); LAS unsigned* taup = (LAS unsigned*)(lds + DS_TAU_OFF);
    for (int L = blockIdx.x; L < 2048; L += gridDim.x) {
        int lane; asm volatile("v_mbcnt_lo_u32_b32 %0, -1, 0\n\tv_mbcnt_hi_u32_b32 %0, -1, %0" : "=v"(lane));
        const int tid = wave * 64 + lane, ql = lane & 15, gq = lane >> 4;
        int b, j;
        if (gridDim.x == 256) { const int i = blockIdx.x, ui = L >> 8, x = i & 7, li = (i >> 3) * 2 + (x >> 2); b = x & 3; j = 128 * (ui >> 1) + ((ui & 1) ? 127 - li : li); }
        else { b = L >> 9; j = L & 511; }
        const unsigned mb = (unsigned)b * SEQ; const int q0 = DS_NQ * j; const unsigned mq = mb + q0 + ql;
        const int pos0 = a.pos[mb]; int nadm = ((a.pos[mq] >> 6) + 1) * 64 - pos0; nadm = nadm > SEQ ? SEQ : nadm;
        int nmax = ((a.pos[mb + q0 + DS_NQ - 1] >> 6) + 1) * 64 - pos0; nmax = nmax > SEQ ? SEQ : nmax;
        const int nstep = (nmax + 511) >> 9;
#ifdef DSA_REP_STREAM
        for (int srep_ = 0; srep_ < 2; ++srep_) { const bool sdry = (srep_ == 0) && a.ph_hi > 0;
#ifndef DSA_DRYMODE
#define DSA_DRYMODE 0
#endif
#else
        const bool sdry = false;
#define DSA_DRYMODE 0
#endif
        __syncthreads();
        if (tid < DS_NQ) { cnt[tid] = 0u; taup[tid] = 0u; }
        bf16x8 bq[8][2];
#pragma unroll
        for (int h = 0; h < 8; ++h)
#pragma unroll
            for (int ks = 0; ks < 2; ++ks) bq[h][ks] = *(const bf16x8*)(QIg + (mq * 512u + h * 64 + 32 * ks + 8 * gq));
        f32x2 wh[8]; { const f32x4 w0 = *(const f32x4*)(WIg + mq * 8), w1 = *(const f32x4*)(WIg + mq * 8 + 4);
#pragma unroll
            for (int h = 0; h < 4; ++h) { wh[h] = (f32x2){w0[h], w0[h]}; wh[4 + h] = (f32x2){w1[h], w1[h]}; } }
        __syncthreads();
        u32x4 ka[8];
        const unsigned ktb = (unsigned)(size_t)(lds + DS_KT_OFF) + (unsigned)wave * DS_KT_BYTES;
        { unsigned ko = (mb + 64 * wave) * 64u + 8u * lane, ko1 = ko + 2048u;
          asm volatile("" : "+v"(ko), "+v"(ko1));
#pragma unroll
          for (int j8 = 0; j8 < 8; ++j8) ka[j8] = *(const u32x4*)(KIg + ((j8 & 4) ? ko1 : ko) + (j8 & 3) * 512); }
        for (int step = 0; step <= nstep; ++step) {
            const int kb = 512 * step + 64 * wave; const bool active = (kb < nmax) && (step < nstep);
            PROBE_BEGIN(2, a.ws, wave);
            if (active) {
                f32x2 sc2[8];
#pragma unroll
                for (int i = 0; i < 8; ++i) sc2[i] = (f32x2){0.f, 0.f};
                const int ln = lane_id();
                const unsigned kw0 = ktb + (unsigned)(ln >> 3) * 128u + (unsigned)(((ln & 7) ^ (ln >> 4)) << 4);
                const unsigned kr0 = ktb + (unsigned)(ln & 15) * 128u + (unsigned)(((ln >> 4) ^ ((ln & 15) >> 1)) << 4);
                const int kbn = (kb + 512 < SEQ) ? kb + 512 : kb; unsigned ko = (mb + kbn) * 64u + 8u * ln, ko1 = ko + 2048u;
                asm volatile("" : "+v"(ko), "+v"(ko1));
#pragma unroll
                for (int st = 0; st < 4; ++st) {
                    *(LAS u32x4*)(size_t)kw0 = ka[2 * st]; *(LAS u32x4*)(size_t)(kw0 ^ 1088u) = ka[2 * st + 1];
                    LDS_WAIT();
                    if (!(sdry && (DSA_DRYMODE & 1))) {
                        ka[2 * st] = *(const u32x4*)(KIg + ((st & 2) ? ko1 : ko) + (2 * st & 3) * 512); ka[2 * st + 1] = *(const u32x4*)(KIg + ((st & 2) ? ko1 : ko) + ((2 * st + 1) & 3) * 512); }
                    const bf16x8 af0 = *(const LAS bf16x8*)(size_t)kr0, af1 = *(const LAS bf16x8*)(size_t)(kr0 ^ 64u);
#pragma unroll
                    for (int h = 0; h < 8; ++h) { f32x4 acc = (f32x4){0.f, 0.f, 0.f, 0.f};
                        acc = __builtin_amdgcn_mfma_f32_16x16x32_bf16(af0, bq[h][0], acc, 0, 0, 0); acc = __builtin_amdgcn_mfma_f32_16x16x32_bf16(af1, bq[h][1], acc, 0, 0, 0);
                        sc2[2 * st] += wh[h] * (f32x2){relu_(acc[0]), relu_(acc[1])}; sc2[2 * st + 1] += wh[h] * (f32x2){relu_(acc[2]), relu_(acc[3])}; }
                    __builtin_amdgcn_sched_barrier(0);
                }
                float sc[16];
#pragma unroll
                for (int i = 0; i < 8; ++i) { sc[2 * i] = sc2[i][0]; sc[2 * i + 1] = sc2[i][1]; }
                __builtin_amdgcn_sched_barrier(0);
                const unsigned tp = taup[ql]; unsigned pm = 0u;
#pragma unroll
                for (int i = 0; i < 16; ++i) { const int key = kb + 16 * (i >> 2) + 4 * gq + (i & 3); const unsigned u = __float_as_uint(sc[i]);
                    const unsigned ord = (u & 0x80000000u) ? ~u : (u | 0x80000000u); const unsigned pk = (ord & 0xFFFFE000u) | (unsigned)key;
                    sc[i] = __uint_as_float(pk);
                    if (key < nadm && pk > tp) pm |= 1u << i; }
                if (sdry && (DSA_DRYMODE & 2)) pm = 0u;
                const unsigned n = (unsigned)__popc(pm);
                unsigned k = 0u; if (n) k = __hip_atomic_fetch_add(cnt + ql, n, __ATOMIC_RELAXED, __HIP_MEMORY_SCOPE_WORKGROUP);
                LAS unsigned* cq = cand + ql * DS_CAP;
#pragma unroll
                for (int i = 0; i < 16; ++i) if (pm & (1u << i)) { cq[k] = __float_as_uint(sc[i]); ++k; }
            }
            __syncthreads();
            PROBE_END(2, a.ws, wave);
            const u32x4 c0 = *(const LAS u32x4*)(cnt), c1 = *(const LAS u32x4*)(cnt + 4), c2 = *(const LAS u32x4*)(cnt + 8), c3 = *(const LAS u32x4*)(cnt + 12);
            unsigned cm = max(max(max(c0.x, c0.y), max(c0.z, c0.w)), max(max(c1.x, c1.y), max(c1.z, c1.w)));
            cm = max(cm, max(max(max(c2.x, c2.y), max(c2.z, c2.w)), max(max(c3.x, c3.y), max(c3.z, c3.w))));
            const unsigned trig = (step == nstep) ? (unsigned)DS_TOPK : (unsigned)DS_TRIG;
#ifdef DSA_SEL2
            const int nsel = (step == nstep) ? 4 : 2;
#else
            const int nsel = 2;
#endif
            if (cm > trig) {
                PROBE_BEGIN(1, a.ws, wave);
#pragma unroll 1
                for (int qq = 0; qq < nsel; ++qq) { const int q = 2 * wave + (qq & 1); if (cnt[q] > trig || qq >= 2) {
                    if (step != nstep) filter_compact<32>(cand + q * DS_CAP, cnt + q, taup + q, lane);
                    if (step == nstep || cnt[q] > (unsigned)DS_TRIG) select_compact<32>(cand + q * DS_CAP, cnt + q, taup + q, hist, lane); } }
                __syncthreads();
                PROBE_END(1, a.ws, wave);
            }
        }
#ifdef DSA_REP_STREAM
        }
#endif
        const bf16_t* KVb = KVg + (size_t)mb * 256;
        int lane_a = lane; asm volatile("" : "+v"(lane_a));
        const int g16 = lane_a >> 4, l15 = lane_a & 15;
        const unsigned vbase = (unsigned)(size_t)(lds + DS_CAND_OFF) + (unsigned)wave * 16384u;
        unsigned ta0, ta1;
        { const int q = l15 >> 2, p = lane_a & 3; const int pr0 = 8 * g16 + q, pr1 = pr0 + 4;
          ta0 = vbase + vrow_off(pr0) + 16u * ((unsigned)(p >> 1) ^ swz_b(pr0)) + 8u * (unsigned)(p & 1);
          ta1 = vbase + vrow_off(pr1) + 16u * ((unsigned)(p >> 1) ^ swz_b(pr1)) + 8u * (unsigned)(p & 1); }
        const unsigned kwa = vbase + 10240u + (unsigned)(4 * g16) * 256u + (unsigned)((l15 ^ (4 * g16)) << 4);
        const unsigned kra = vbase + 10240u + (unsigned)l15 * 256u + (unsigned)((g16 ^ l15) << 4);
        const unsigned owa = vbase + 10240u + (unsigned)l15 * 256u + (unsigned)((g16 ^ l15) << 4);
        const unsigned ora = vbase + 10240u + (unsigned)(lane_a >> 3) * 256u + (unsigned)(((2 * (lane_a & 7)) ^ (lane_a >> 3)) << 4);
        unsigned vwa[8];
#pragma unroll
        for (int j2 = 0; j2 < 8; ++j2) { const int srow = 4 * j2 + g16; const int pr = (srow < 16) ? 8 * (srow >> 2) + (srow & 3) : 8 * ((srow - 16) >> 2) + 4 + (srow & 3);
            vwa[j2] = vbase + vrow_off(pr) + 16u * ((unsigned)l15 ^ swz_b(pr)); }
#ifdef DSA_REP_ATT
        for (int arep_ = 0; arep_ < 2; ++arep_) { const bool dry2 = dry || (arep_ == 0 && a.ph_hi > 0);
#else
        { const bool dry2 = dry;
#endif
        u32x4 qr[4];
#pragma unroll
        for (int i = 0; i < 4; ++i) qr[i] = *(const u32x4*)(Qg + ((mb + q0 + 2 * wave) * 2048u + (unsigned)(4 * g16 + i) * 128u + 8u * l15));
#pragma unroll 1
        for (int qq = 0; qq < 2; ++qq) {
            const int q = 2 * wave + qq; const unsigned m = mb + q0 + q; const int n = (int)cnt[q]; const LAS unsigned* cq = cand + q * DS_CAP;
            bf16x8 qb[4];
            {
#pragma unroll
              for (int i = 0; i < 4; ++i) *(LAS u32x4*)(size_t)(kwa ^ (unsigned)((i << 8) | (i << 4))) = qr[i];
              LDS_WAIT();
              if (qq == 0) {
#pragma unroll
                for (int i = 0; i < 4; ++i) qr[i] = *(const u32x4*)(Qg + ((m + 1u) * 2048u + (unsigned)(4 * g16 + i) * 128u + 8u * l15)); }
#pragma unroll
              for (int ks = 0; ks < 4; ++ks) qb[ks] = *(const LAS bf16x8*)(size_t)(kra ^ (unsigned)(ks << 6));
              LDS_WAIT(); }
            f32x4 sacc[16];
            const int nl = n - l15; const LAS unsigned* cql = cq + l15;
            u32x4 kr[5][4];
            auto kload = [&](int jt, u32x4 (&dst)[4]) { const u32x4 e4 = *(const LAS u32x4*)(cq + 16 * jt + 4 * g16);
#pragma unroll
                for (int i = 0; i < 4; ++i) dst[i] = *(const u32x4*)(KVb + ((e4[i] & 0x1FFFu) * 256u + 8u * l15)); };
            kload(0, kr[0]); kload(1, kr[1]); kload(2, kr[2]); kload(3, kr[3]);
#pragma unroll
            for (int i = 0; i < 4; ++i) *(LAS u32x4*)(size_t)(kwa ^ (unsigned)((i << 8) | (i << 4))) = kr[0][i];
#pragma unroll
            for (int jt = 0; jt < 16; ++jt) {
                if (jt + 4 < 16) kload(jt + 4, kr[(jt + 4) % 5]);
                bf16x8 fa[4];
#pragma unroll
                for (int ks = 0; ks < 4; ++ks) fa[ks] = *(const LAS bf16x8*)(size_t)(kra ^ (unsigned)(ks << 6));
                if (jt + 1 < 16) {
#pragma unroll
                    for (int i = 0; i < 4; ++i) *(LAS u32x4*)(size_t)(kwa ^ (unsigned)((i << 8) | (i << 4))) = kr[(jt + 1) % 5][i]; }
                f32x4 acc = (f32x4){0.f, 0.f, 0.f, 0.f};
#pragma unroll
                for (int ks = 0; ks < 4; ++ks) acc = __builtin_amdgcn_mfma_f32_16x16x32_bf16(fa[ks], qb[ks], acc, 0, 0, 0);
                sacc[jt] = acc;
            }
            u32x4 vr[2][8]; const int ng = n - g16; const LAS unsigned* cqg = cq + g16;
            auto vload = [&](int kk, u32x4 (&dst)[8]) {
#pragma unroll
                for (int j2 = 0; j2 < 8; ++j2) { const int sl = 32 * kk + 4 * j2; const unsigned e = cqg[sl]; const unsigned key = (sl < ng) ? (e & 0x1FFFu) : 0u;
                    dst[j2] = *(const u32x4*)(KVb + (key * 256u + 128u + 8u * l15)); } };
            vload(0, vr[0]); vload(1, vr[1]);
            __builtin_amdgcn_sched_barrier(0);
            float mx = -1e30f; const float nnf = (float)(n - 4 * g16 - 1);
#pragma unroll
            for (int jt = 0; jt < 16; ++jt)
#pragma unroll
                for (int r = 0; r < 4; ++r) { sacc[jt][r] = fmaf(fminf(nnf - (float)(16 * jt + r), 0.f), 1e30f, sacc[jt][r]); mx = fmaxf(mx, sacc[jt][r]); }
            mx = fmaxf(mx, __shfl_xor(mx, 16)); mx = fmaxf(mx, __shfl_xor(mx, 32));
            float sum = 0.f;
#pragma unroll
            for (int jt = 0; jt < 16; ++jt)
#pragma unroll
                for (int r = 0; r < 4; ++r) { const float p = __builtin_amdgcn_exp2f(sacc[jt][r] - mx); sacc[jt][r] = p; sum += p; }
            sum += __shfl_xor(sum, 16); sum += __shfl_xor(sum, 32);
            u32x4 pfr[8];
#pragma unroll
            for (int kk = 0; kk < 8; ++kk) { const f32x4 pa = sacc[2 * kk], pb2 = sacc[2 * kk + 1];
                pfr[kk].x = pk2(pa[0], pa[1]); pfr[kk].y = pk2(pa[2], pa[3]); pfr[kk].z = pk2(pb2[0], pb2[1]); pfr[kk].w = pk2(pb2[2], pb2[3]); }
            __builtin_amdgcn_sched_barrier(0);
            f32x4 o[8];
#pragma unroll
            for (int c = 0; c < 8; ++c) o[c] = (f32x4){0.f, 0.f, 0.f, 0.f};
            bf16_t* gqp = Gg + m * 2048u; u32x4 gwv[2][2];
#pragma unroll
            for (int p = 0; p < 2; ++p)
#pragma unroll
                for (int i = 0; i < 2; ++i) gwv[p][i] = *(const u32x4*)(gqp + ((8 * i + (lane_a >> 3)) * 128 + 64 * p + 8 * (lane_a & 7)));
#pragma unroll
            for (int kk = 0; kk < 8; ++kk) {
#pragma unroll
                for (int j2 = 0; j2 < 8; ++j2) *(LAS u32x4*)(size_t)vwa[j2] = vr[kk & 1][j2];
                __builtin_amdgcn_sched_barrier(0);
                if (kk + 2 < 8) vload(kk + 2, vr[kk & 1]);
                LDS_WAIT();
                const bf16x8 pfrag = __builtin_bit_cast(bf16x8, pfr[kk]);
#pragma unroll
                for (int ch = 0; ch < 2; ++ch) {
                    s16x4 t0[4], t1[4];
                    asm volatile("ds_read_b64_tr_b16 %0, %8\n\tds_read_b64_tr_b16 %1, %9\n\tds_read_b64_tr_b16 %2, %10\n\tds_read_b64_tr_b16 %3, %11\n\t"
                                 "ds_read_b64_tr_b16 %4, %12\n\tds_read_b64_tr_b16 %5, %13\n\tds_read_b64_tr_b16 %6, %14\n\tds_read_b64_tr_b16 %7, %15\n\ts_waitcnt lgkmcnt(0)"
                                 : "=&v"(t0[0]), "=&v"(t0[1]), "=&v"(t0[2]), "=&v"(t0[3]), "=&v"(t1[0]), "=&v"(t1[1]), "=&v"(t1[2]), "=&v"(t1[3])
                                 : "v"(ta0 ^ (unsigned)((4 * ch + 0) << 5)), "v"(ta0 ^ (unsigned)((4 * ch + 1) << 5)), "v"(ta0 ^ (unsigned)((4 * ch + 2) << 5)), "v"(ta0 ^ (unsigned)((4 * ch + 3) << 5)),
                                   "v"(ta1 ^ (unsigned)((4 * ch + 0) << 5)), "v"(ta1 ^ (unsigned)((4 * ch + 1) << 5)), "v"(ta1 ^ (unsigned)((4 * ch + 2) << 5)), "v"(ta1 ^ (unsigned)((4 * ch + 3) << 5)) : "memory");
                    __builtin_amdgcn_sched_barrier(0);
#pragma unroll
                    for (int c = 0; c < 4; ++c) { const bf16x8 av = __builtin_shufflevector(t0[c], t1[c], 0, 1, 2, 3, 4, 5, 6, 7);
                        o[4 * ch + c] = __builtin_amdgcn_mfma_f32_16x16x32_bf16(av, pfrag, o[4 * ch + c], 0, 0, 0); }
                }
            }
            const float inv = 1.0f / sum;
#pragma unroll
            for (int p = 0; p < 2; ++p) {
#pragma unroll
                for (int cc = 0; cc < 4; ++cc) *(LAS f32x4*)(size_t)(owa ^ (unsigned)(cc << 6)) = o[4 * p + cc] * inv;
                LDS_WAIT();
#pragma unroll
                for (int i = 0; i < 2; ++i) { bf16_t* gp = gqp + ((8 * i + (lane_a >> 3)) * 128 + 64 * p + 8 * (lane_a & 7)); const u32x4 gw = gwv[p][i];
                    const unsigned ra_ = (ora + 2048u * (unsigned)i) ^ (unsigned)(i << 7);
                    const f32x4 t0 = *(const LAS f32x4*)(size_t)ra_, t1 = *(const LAS f32x4*)(size_t)(ra_ ^ 16u);
                    u32x4 wv; wv.x = pk2(t0[0] * bflo(gw.x), t0[1] * bfhi(gw.x)); wv.y = pk2(t0[2] * bflo(gw.y), t0[3] * bfhi(gw.y));
                    wv.z = pk2(t1[0] * bflo(gw.z), t1[1] * bfhi(gw.z)); wv.w = pk2(t1[2] * bflo(gw.w), t1[3] * bfhi(gw.w));
                    if (!dry2) *(u32x4*)gp = wv; }
                LDS_WAIT();
            }
        }
        }
    }
}

#ifndef OLD_SCAN
#define OLD_SCAN 0
#endif
#ifndef MK_SPLIT
#define MK_SPLIT 0
#endif
#ifndef MK_PH_END
#define MK_PH_END 13
#endif
constexpr int N_PHASES = 13;

#define XB_TMO      128
#define XB_XCNT(j)  (256  + 64 * (j))
#define XB_XSUB(j)  (1280 + 64 * (j))
#define XB_XGEN(j)  (2304 + 64 * (j))
#define XB_TOP      3328
#define XB_TOPGEN   3392
#define XCD_BAR_WORDS 3456
#define XB_SPIN_CAP (1u << 18)

__device__ __forceinline__ unsigned xb_ld(unsigned* p)              { return __hip_atomic_load(p, __ATOMIC_RELAXED, __HIP_MEMORY_SCOPE_AGENT); }
__device__ __forceinline__ unsigned xb_add(unsigned* p, unsigned v) { return __hip_atomic_fetch_add(p, v, __ATOMIC_RELAXED, __HIP_MEMORY_SCOPE_AGENT); }
__device__ __forceinline__ unsigned xb_xcc_id() { return (unsigned)__builtin_amdgcn_s_getreg((3 << 11) | 20) & 0xFu; }
#define XB_SPIN(cond, bar) do { unsigned _sp = 0; while (cond) { __builtin_amdgcn_s_sleep(1); \
    if ((++_sp & 255u) == 0u) { if (xb_ld(&(bar)[XB_TMO])) break; if (_sp > XB_SPIN_CAP) { atomicAdd(&(bar)[XB_TMO], 1u); break; } } } } while (0)

struct XcdBarrier {
    unsigned* bar; unsigned x;
    volatile LAS unsigned* st;
};

__device__ __forceinline__ XcdBarrier xcd_barrier_post(unsigned* bar, volatile LAS unsigned* st, const int wave) {
    XcdBarrier b; b.bar = bar; b.x = xb_xcc_id(); b.st = st;
    if (lane_id() == 0 && wave == 0) (void)xb_add(&bar[XB_XCNT(b.x)], 1u);
    return b;
}
__device__ __forceinline__ void xcd_barrier_complete(unsigned* bar, unsigned x, unsigned& nloc, unsigned& nx) {
    const unsigned G = gridDim.x * gridDim.y * gridDim.z;
    unsigned sum, cnt, mine, sp = 0u;
    for (;;) {
        sum = 0u; cnt = 0u; mine = 0u;
#pragma unroll
        for (unsigned j = 0; j < 16; ++j) { const unsigned c = xb_ld(&bar[XB_XCNT(j)]); sum += c; cnt += (c > 0u) ? 1u : 0u; mine = (j == x) ? c : mine; }
        if (sum == G) break;
        __builtin_amdgcn_s_sleep(1);
        if ((++sp & 255u) == 0u) { if (xb_ld(&bar[XB_TMO])) break; if (sp > XB_SPIN_CAP) { atomicAdd(&bar[XB_TMO], 1u); break; } }
    }
    nloc = mine > 0u ? mine : 1u; nx = cnt > 0u ? cnt : 1u;
}

__device__ __forceinline__ void xcd_barrier(const XcdBarrier& b, const int wave) {
    asm volatile("s_waitcnt vmcnt(0)" ::: "memory");
    __syncthreads();
    if (wave == 0) { if (lane_id() == 0) {
        unsigned* bar = b.bar;
        __builtin_amdgcn_s_waitcnt(0);
        unsigned nloc = b.st[0], nx = b.st[1];
        if (nloc == 0u) { xcd_barrier_complete(bar, b.x, nloc, nx); b.st[0] = nloc; b.st[1] = nx; }
        const unsigned old = xb_add(&bar[XB_XSUB(b.x)], 1u);
        const unsigned gen = old / nloc;
        if (old + 1u == (gen + 1u) * nloc) {
            __builtin_amdgcn_fence(__ATOMIC_RELEASE, "agent");
            asm volatile("s_waitcnt vmcnt(0)" ::: "memory");
            const unsigned og = xb_add(&bar[XB_TOP], 1u);
            const unsigned tg = og / nx;
            if (og + 1u == (tg + 1u) * nx) xb_add(&bar[XB_TOPGEN], 1u);
            else XB_SPIN(xb_ld(&bar[XB_TOPGEN]) == tg, bar);
            __builtin_amdgcn_fence(__ATOMIC_ACQUIRE, "agent");
            xb_add(&bar[XB_XGEN(b.x)], 1u);
            asm volatile("s_waitcnt vmcnt(0)" ::: "memory");
        } else {
            XB_SPIN(xb_ld(&bar[XB_XGEN(b.x)]) == gen, bar);
            __builtin_amdgcn_fence(__ATOMIC_ACQUIRE, "agent");
            asm volatile("s_waitcnt vmcnt(0)" ::: "memory");
        }
    } }
    __syncthreads();
}

#define grid_bar(barptr, epoch, wv) xcd_barrier(xbar, (wv))
typedef const __attribute__((address_space(4))) Args* KArgs;
#if defined(__HIP_DEVICE_COMPILE__)
__device__ __forceinline__ Args kargs() { KArgs p = (KArgs)__builtin_amdgcn_kernarg_segment_ptr(); asm volatile("" : "+s"(p)); return *p; }
#else
__device__ __forceinline__ Args kargs() { return Args{}; }
#endif
#define PHASE_ARGS const Args a = kargs(); unsigned char* ws = a.ws; (void)ws

__global__ void __launch_bounds__(NTHREADS, 2) fwd_megakernel(Args a_by_value) {
    extern __shared__ __attribute__((aligned(16))) unsigned char lds_raw[];
    LAS unsigned char* lds = (LAS unsigned char*)lds_raw;
    cg::grid_group grid = cg::this_grid();
    const int wave = __builtin_amdgcn_readfirstlane((int)threadIdx.x >> 6);
    { volatile LAS unsigned* st0 = (volatile LAS unsigned*)(lds + LDS_BYTES - 16); if (wave == 0 && lane_id() < 4) st0[lane_id()] = 0u; __syncthreads(); }
    const XcdBarrier xbar = xcd_barrier_post((unsigned*)(kargs().ws + WS_BAR), (volatile LAS unsigned*)(lds + LDS_BYTES - 16), wave);
    int lo, hi; { const Args a0 = kargs(); lo = a0.ph_lo; hi = a0.ph_hi; }
#ifdef ONLY_PH
#define IN(k) ((k) == ONLY_PH && lo <= (k) && (k) < hi)
#else
#define IN(k) (lo <= (k) && (k) < hi)
#endif
#define SEAM(k) do { if (IN(k) && IN((k) + 1)) { if ((k) == 0) grid.sync(); else grid_bar((unsigned*)(kargs().ws + WS_BAR), (unsigned)(k), wave); } } while (0)
#ifdef REP_PH
#ifndef REP_N
#define REP_N 2
#endif
#define NREP(k) ((k) == REP_PH ? REP_N : 1)
#else
#define NREP(k) 1
#endif
#define REPEAT(k) for (int rep_ = 0; rep_ < NREP(k); ++rep_, (rep_ < NREP(k) ? grid_bar((unsigned*)(kargs().ws + WS_BAR) + 128, 1u, wave) : (void)0))
#ifdef STAMP_K
#define TSTAMP(k) do { if (((k) == STAMP_K || (k) == STAMP_K + 1) && blockIdx.x == 0 && wave == 0) { const unsigned long long t_ = __builtin_amdgcn_s_memrealtime(); \
        if (__builtin_amdgcn_mbcnt_lo(~0u, 0u) == 0u) ((unsigned long long*)(kargs().ws + WS_STAMP))[(k) - STAMP_K] = t_; } } while (0)
#else
#define TSTAMP(k) do { } while (0)
#endif
#ifdef STAMP_K
    if (blockIdx.x == PROBE_BLK && wave == 0) { unsigned long long* st_ = (unsigned long long*)(kargs().ws + WS_STAMP); if (__builtin_amdgcn_mbcnt_lo(~0u, 0u) < 3u) st_[__builtin_amdgcn_mbcnt_lo(~0u, 0u)] = 0ull; }
#endif
    TSTAMP(0);
    if (IN(0)) REPEAT(0) { PHASE_ARGS; p0_prologue(a, wave, lds); } SEAM(0); TSTAMP(1);
    if (IN(1)) REPEAT(1) { PHASE_ARGS; norm_phase(a, wave, lds, a.x, 0); } SEAM(1); TSTAMP(2);
    if (IN(2)) REPEAT(2) { PHASE_ARGS;
        pg8::Gemm g{(const bf16_t*)(ws + WS_H), (const bf16_t*)(ws + WS_WIN0), MTOK, N0, DM}; pg8::StaticOrder S; S.init(MTOK, N0, gridDim.x, blockIdx.x);
        #ifdef EPI0_CHEAP_FIRST
        Epi0 E{ws, (unsigned char*)a.out, NREP(2) == 2 && rep_ == 0 && a.ph_hi > 0};
#else
        Epi0 E{ws, (unsigned char*)a.out, false};
#endif
#ifdef SKEW0
        if (blockIdx.x >= 128) { const unsigned long long t0_ = __builtin_amdgcn_s_memrealtime(); while (__builtin_amdgcn_s_memrealtime() - t0_ < (unsigned long long)(SKEW0)) __builtin_amdgcn_s_sleep(64); }
#endif
        pg8::gemm_phase<Epi0, pg8::StaticOrder, true, true>(lds, g, S, E, wave);
    } SEAM(2); TSTAMP(3);
    if (IN(3)) REPEAT(3) { PHASE_ARGS; conv_phase(a, wave, lds, blockIdx.x, gridDim.x); lora_pre_phase(a, wave); } SEAM(3); TSTAMP(4);
    if (IN(4)) REPEAT(4) { PHASE_ARGS;
        pg8::Gemm g{(const bf16_t*)((unsigned char*)a.out + DO_LA), (const bf16_t*)(ws + WS_WLORA), MTOK, 2048, 256}; pg8::StaticOrder S; S.init(MTOK, 2048, gridDim.x, blockIdx.x);
        EpiLora E{(bf16_t*)(ws + WS_DARR), (bf16_t*)(ws + WS_AARR), a.rwkv_vec};
        pg8::gemm_phase<EpiLora, pg8::StaticOrder, true, true>(lds, g, S, E, wave);
    } SEAM(4); TSTAMP(5);
    if (IN(5)) REPEAT(5) { PHASE_ARGS;
#if OLD_SCAN
        scan_phase(a, wave, lds);
#else
        unsigned* pbar = (unsigned*)(ws + WS_BAR) + 256;
        { __syncthreads(); if (wave == 0 && lane_id() < 8) ((LAS unsigned*)(lds + CS_FLAGS))[lane_id()] = 0u; __syncthreads(); }
        for (int r = 0; r <= CR_NP; ++r) {
            if (blockIdx.x >= 64) { if (r < CR_NP) cscan_produce(a, wave, lds, r, 64, gridDim.x - 64); }
            else if (r >= 1) {
                const int piece = r - 1;
                f32x4 xc[4]; f32x4* sv = (f32x4*)(ws + WS_XSAVE) + ((size_t)(blockIdx.x * 4 + (wave & 3)) * 64 + lane_id()) * 4;
#pragma unroll
                for (int kt = 0; kt < 4; ++kt) xc[kt] = (piece == 0 || wave >= 4) ? (f32x4){0.f, 0.f, 0.f, 0.f} : sv[kt];
                cscan_consume(a, wave, lds, blockIdx.x, piece, xc);
                if (wave < 4) {
#pragma unroll
                    for (int kt = 0; kt < 4; ++kt) sv[kt] = xc[kt]; }
            }
            grid_bar(pbar, (unsigned)(r + 1), wave);
#ifdef BAR2
            grid_bar(pbar + 128, (unsigned)(r + 1), wave);
#endif
        }
#endif
    } SEAM(5); TSTAMP(6);
    if (IN(6)) REPEAT(6) { PHASE_ARGS; post_phase(a, wave); } SEAM(6); TSTAMP(7);
    if (IN(7)) REPEAT(7) { PHASE_ARGS;
        pg8::Gemm g{(const bf16_t*)(ws + WS_YAB), (const bf16_t*)(ws + WS_WOUT0), MTOK, DM, 2048}; pg8::StaticOrder S; S.init(MTOK, DM, gridDim.x, blockIdx.x);
        EpiRes E{a.x, a.out, (const float*)(ws + WS_MODP), a.ada_b, 0, NREP(7) >= 2 && rep_ == 0 && a.ph_hi > 0, lds + pg8::STAGE_BYTES};
        pg8::gemm_phase<EpiRes, pg8::StaticOrder, true, true>(lds, g, S, E, wave);
    } SEAM(7); TSTAMP(8);
    if (IN(8)) REPEAT(8) { PHASE_ARGS; norm_phase(a, wave, lds, a.out, 1); } SEAM(8); TSTAMP(9);
    if (IN(9)) REPEAT(9) { PHASE_ARGS;
        pg8::Gemm g{(const bf16_t*)(ws + WS_H), (const bf16_t*)(ws + WS_WIN1), MTOK, N1, DM}; pg8::StaticOrder S; S.init(MTOK, N1, gridDim.x, blockIdx.x);
        Epi1 E{(bf16_t*)(ws + WS_Q), (bf16_t*)(ws + WS_KV), (bf16_t*)(ws + WS_QI), (bf16_t*)(ws + WS_KI), (bf16_t*)(ws + WS_G), (float*)(ws + WS_WI), (const f32x2*)(ws + WS_CSA), (const f32x2*)(ws + WS_CSI)};
        pg8::gemm_phase<Epi1, pg8::StaticOrder, true, true>(lds, g, S, E, wave);
    } SEAM(9); TSTAMP(10);
    if (IN(10)) REPEAT(10) { PHASE_ARGS; dsa_phase(a, wave, lds, NREP(10) == 2 && rep_ == 0 && a.ph_hi > 0); } SEAM(10); TSTAMP(11);
    if (IN(11)) REPEAT(11) { PHASE_ARGS;
        pg8::Gemm g{(const bf16_t*)(ws + WS_G), (const bf16_t*)(ws + WS_WOUT1), MTOK, DM, 2048}; pg8::StaticOrder S; S.init(MTOK, DM, gridDim.x, blockIdx.x);
        EpiRes E{a.out, a.out, (const float*)(ws + WS_MODP), a.ada_b, 1, false, lds + pg8::STAGE_BYTES};
        pg8::gemm_phase<EpiRes, pg8::StaticOrder, true, true>(lds, g, S, E, wave);
    } SEAM(11); TSTAMP(12);
    if (IN(12)) REPEAT(12) { PHASE_ARGS; final_phase(a, wave); }
#undef IN
#undef SEAM
}

extern "C" void kernel_launch(void* const* d_in, const int* in_sizes, int n_in, void* d_out, int out_size, void* d_ws, size_t ws_size, hipStream_t stream) {
    static int grid = 0;
    if (grid == 0) {
        if (n_in != 19 || out_size != MTOK * DM || ws_size < WS_NEED) { fprintf(stderr, "kernel_launch: unexpected shapes (n_in %d, out %d, ws %zu)\n", n_in, out_size, ws_size); grid = -1; return; }
        int dev = 0, cus = 0, per_cu = 0;
        (void)hipGetDevice(&dev); (void)hipDeviceGetAttribute(&cus, hipDeviceAttributeMultiprocessorCount, dev);
        if (hipFuncSetAttribute((const void*)fwd_megakernel, hipFuncAttributeMaxDynamicSharedMemorySize, LDS_BYTES) != hipSuccess) { fprintf(stderr, "kernel_launch: hipFuncSetAttribute failed\n"); grid = -1; return; }
        if (hipOccupancyMaxActiveBlocksPerMultiprocessor(&per_cu, (const void*)fwd_megakernel, NTHREADS, LDS_BYTES) != hipSuccess || per_cu < 1) { fprintf(stderr, "kernel_launch: occupancy query says %d\n", per_cu); per_cu = 1; }
        (void)hipGetLastError();
        grid = cus;
        if (grid > 256) grid = 256;
    }
    if (grid < 0) return;
    Args a{};
    a.x = (const float*)d_in[0]; a.c = (const float*)d_in[1]; a.pos = (const int*)d_in[2]; a.ada_w = (const float*)d_in[3]; a.ada_b = (const float*)d_in[4];
    a.norm_g = (const float*)d_in[5]; a.final_g = (const float*)d_in[6]; a.even_w_in = (const float*)d_in[7]; a.even_w_out = (const float*)d_in[8];
    a.conv_w = (const float*)d_in[9]; a.conv_vec = (const float*)d_in[10]; a.mu_rkv = (const float*)d_in[11]; a.mu_lora = (const float*)d_in[12];
    a.rwkv_vec = (const float*)d_in[13]; a.w_up = (const float*)d_in[14]; a.a_up = (const float*)d_in[15]; a.r_k = (const float*)d_in[16];
    a.odd_w_in = (const float*)d_in[17]; a.odd_w_out = (const float*)d_in[18];
    a.out = (float*)d_out; a.ws = (unsigned char*)d_ws;
    (void)hipMemsetAsync((char*)d_ws + WS_BAR, 0, 65536, stream);
#if MK_SPLIT
    for (int p = 0; p < MK_PH_END; ++p) { a.ph_lo = p; a.ph_hi = p + 1; void* args[] = {&a};
        hipError_t e = hipLaunchCooperativeKernel((const void*)fwd_megakernel, dim3(grid), dim3(NTHREADS), args, LDS_BYTES, stream);
        if (e != hipSuccess) { fprintf(stderr, "launch %d failed: %s\n", p, hipGetErrorString(e)); break; } }
#else
    a.ph_lo = 0; a.ph_hi = MK_PH_END; void* args[] = {&a};
    hipError_t e = hipLaunchCooperativeKernel((const void*)fwd_megakernel, dim3(grid), dim3(NTHREADS), args, LDS_BYTES, stream);
    if (e != hipSuccess) fprintf(stderr, "cooperative launch failed: %s (grid %d)\n", hipGetErrorString(e), grid);
#endif
}
```

```cpp
#include <hip/hip_runtime.h>
#include <hip/hip_cooperative_groups.h>
#include <cstdio>
#include <cstdint>
namespace cg = cooperative_groups;

#define LAS __attribute__((address_space(3)))
typedef unsigned short bf16_t;
typedef float f32x4 __attribute__((ext_vector_type(4)));
typedef float f32x2 __attribute__((ext_vector_type(2)));
typedef float f32x16 __attribute__((ext_vector_type(16)));
typedef unsigned u32x4 __attribute__((ext_vector_type(4)));
typedef unsigned u32x2 __attribute__((ext_vector_type(2)));
typedef short bf16x8 __attribute__((ext_vector_type(8)));
typedef short s16x4 __attribute__((ext_vector_type(4)));

constexpr int BATCH = 4, SEQ = 8192, DM = 1024, MTOK = BATCH * SEQ;
constexpr int N0 = 7424, N1 = 5120;
constexpr int EVEN_COLS = 7296, ODD_COLS = 4936;
constexpr int NWAVES = 8, NTHREADS = 512;
constexpr int LDS_BYTES = 155648;

constexpr size_t MiB = 1u << 20;
constexpr size_t WS_MODP = 0; constexpr size_t WS_STAMP = 3 * MiB; constexpr size_t WS_XSAVE = 1 * MiB;
constexpr size_t WS_BAR = 3 * MiB + 512 * 1024;
constexpr size_t WS_WIN0 = 4 * MiB, WS_WOUT0 = 20 * MiB, WS_WIN1 = 24 * MiB, WS_WOUT1 = 34 * MiB, WS_WLORA = 38 * MiB;
constexpr size_t WS_CSA = 40 * MiB, WS_CSI = 56 * MiB;
constexpr size_t WS_H = 64 * MiB;
constexpr size_t WS_YAB = 64 * MiB;
constexpr size_t WS_U = 192 * MiB, WS_AG = 256 * MiB, WS_R = 320 * MiB, WS_K = 384 * MiB, WS_V = 448 * MiB;
constexpr size_t WS_AARR = WS_U, WS_DARR = WS_AG;
constexpr size_t WS_Q = 128 * MiB, WS_G = 256 * MiB, WS_KV = 384 * MiB, WS_QI = 400 * MiB, WS_KI = 432 * MiB, WS_WI = 436 * MiB;
constexpr size_t WS_NEED = 512 * MiB;
constexpr size_t DO_BG = 0, DO_WDAD = 64 * MiB, DO_LA = 72 * MiB, DO_RK = 64 * MiB;

__device__ __forceinline__ float bflo(unsigned w) { return __uint_as_float(w << 16); }
__device__ __forceinline__ float bfhi(unsigned w) { return __uint_as_float(w & 0xffff0000u); }
typedef __bf16 bf16x2_t __attribute__((ext_vector_type(2)));
__device__ __forceinline__ unsigned pk2(float lo, float hi) { const f32x2 v = {lo, hi}; const bf16x2_t b = __builtin_convertvector(v, bf16x2_t); return __builtin_bit_cast(unsigned, b); }
__device__ __forceinline__ float sigmoidf_(float x) { return __builtin_amdgcn_rcpf(1.0f + __expf(-x)); }
__device__ __forceinline__ float wave_sum(float v) {
#pragma unroll
    for (int o = 1; o < 64; o <<= 1) v += __shfl_xor(v, o);
    return v;
}
template <int CTRL> __device__ __forceinline__ float dppmov(float x) { return __int_as_float(__builtin_amdgcn_update_dpp(0, __float_as_int(x), CTRL, 0xf, 0xf, true)); }
__device__ __forceinline__ float quad_sum(float x) { x += dppmov<0xB1>(x); x += dppmov<0x4E>(x); return x; }
__device__ __forceinline__ float row16_sum(float x) { x += dppmov<0xB1>(x); x += dppmov<0x4E>(x); x += dppmov<0x141>(x); x += dppmov<0x140>(x); return x; }
__device__ __forceinline__ int lane_id() { int l; asm volatile("v_mbcnt_lo_u32_b32 %0, -1, 0\n\tv_mbcnt_hi_u32_b32 %0, -1, %0" : "=v"(l)); return l; }
#define LDS_WAIT() asm volatile("s_waitcnt lgkmcnt(0)" ::: "memory")

__device__ __forceinline__ int map0(int n) {
    const int t = n >> 8, r = n & 255;
    if (t < 8) return (r < 128) ? 128 * t + r : 1024 + 128 * t + (r - 128);
    if (t < 12) return 2048 + 256 * (t - 8) + r;
    if (t < 24) return 3072 + 256 * (t - 12) + r;
    if (t < 28) return 6272 + 256 * (t - 24) + r;
    return (r < 128) ? 6144 + r : -1;
}
__device__ __forceinline__ int map1(int n) {
    const int t = n >> 8, r = n & 255, half = r >> 7, rr = r & 127;
    if (t < 8) return (2 * t + (rr >> 6)) * 128 + half * 64 + (rr & 63);
    if (t == 8) return 2048 + (rr >> 6) * 128 + half * 64 + (rr & 63);
    if (t < 11) return 2304 + (4 * (t - 9) + (rr >> 5)) * 64 + half * 32 + (rr & 31);
    if (t == 11) { if (rr < 32) return 2816 + half * 32 + rr; if (half == 0 && rr < 40) return 2880 + (rr - 32); return -1; }
    return 2888 + 256 * (t - 12) + r;
}

#ifndef PROBE_BLK
#define PROBE_BLK 0
#endif
#ifndef PROBE_WAVE
#define PROBE_WAVE 0
#endif
#if defined(STAMP_K) && defined(PROBE_SEC)
#define PROBE_BEGIN(sec, wsp, wv) unsigned long long PT0_##sec = 0; if ((sec) == PROBE_SEC && blockIdx.x == PROBE_BLK && (wv) == PROBE_WAVE) PT0_##sec = __builtin_amdgcn_s_memrealtime()
#define PROBE_END(sec, wsp, wv) do { if ((sec) == PROBE_SEC && blockIdx.x == PROBE_BLK && (wv) == PROBE_WAVE) { const unsigned long long dt_ = __builtin_amdgcn_s_memrealtime() - PT0_##sec; \
        if (__builtin_amdgcn_mbcnt_lo(~0u, 0u) == 0u) __hip_atomic_fetch_add((unsigned long long*)((wsp) + WS_STAMP) + 2, dt_, __ATOMIC_RELAXED, __HIP_MEMORY_SCOPE_AGENT); } } while (0)
#else
#define PROBE_BEGIN(sec, wsp, wv) do { } while (0)
#define PROBE_END(sec, wsp, wv) do { } while (0)
#endif
namespace pg8 {
#define PG8_LAS __attribute__((address_space(3)))
typedef unsigned short bf16_t;
typedef short bf16x8 __attribute__((ext_vector_type(8)));
typedef float f32x4 __attribute__((ext_vector_type(4)));
typedef unsigned u32x4 __attribute__((ext_vector_type(4)));
constexpr int BM = 256, BK = 64, HALF = 128, HTB = HALF * BK * 2  , STAGE_BYTES = 8 * HTB, NXCD = 8, WGM = 8;

__host__ __device__ __forceinline__ int lds_byte(int r, int c) { const int st = (r >> 4) * 2 + (c >> 5), rr = r & 15, cc = c & 31, ob = rr * 64 + cc * 2; return st * 1024 + (ob ^ (((ob >> 9) & 1) << 5)); }
__host__ __device__ __forceinline__ void stage_rc(int b, int& R, int& C) { const int st = b / 1024, sb = b % 1024, swz = sb ^ (((sb >> 9) & 1) << 5); R = (st >> 1) * 16 + swz / 64; C = (st & 1) * 32 + (swz % 64) / 2; }
__host__ __device__ __forceinline__ int perm32(int rho) { const int n = rho >> 4, i = rho & 15; return 8 * (i >> 2) + 4 * n + (i & 3); }

struct Unit { int pm, pn; };
struct Gemm { const bf16_t* A; const bf16_t* Bt; int M, N, K; };

struct StaticOrder {
    int nM, nN, nwg, G, c;
    __host__ __device__ void init(int M, int N, int G_, int c_) { nM = M / BM; nN = N / BM; nwg = nM * nN; G = G_; c = c_; }
    __host__ __device__ bool next(int i, Unit& u) const {
        const long L = (long)i * G + c; if (L >= nwg) return false;
        int wgid = (int)L; { const int q = nwg / NXCD, r = nwg % NXCD, xcd = wgid % NXCD, off = wgid / NXCD; wgid = (xcd < r ? xcd * (q + 1) : r * (q + 1) + (xcd - r) * q) + off; }
        const int nig = WGM * nN, gid = wgid / nig, fm = gid * WGM, gsz = (nM - fm) < WGM ? (nM - fm) : WGM;
        u.pm = fm + ((wgid % nig) % gsz); u.pn = (wgid % nig) / gsz; return true;
    }
    __device__ __forceinline__ void a_ready(const Unit&) const {}
    __device__ __forceinline__ void done(const Unit&) const {}
};

__device__ __forceinline__ unsigned cvt_pk_bf16(float lo, float hi) { unsigned r; asm volatile("v_cvt_pk_bf16_f32 %0, %1, %2" : "=v"(r) : "v"(lo), "v"(hi)); return r; }
typedef float f32x2 __attribute__((ext_vector_type(2)));
template <class Epi, class Sched, bool ALIGN_EPI = false, bool SP2 = false>
__device__ __forceinline__ void gemm_phase(PG8_LAS unsigned char* lds, const Gemm g, const Sched& S, const Epi& E, const int wave_in) {
    int lane; asm volatile("v_mbcnt_lo_u32_b32 %0, -1, 0\n\tv_mbcnt_hi_u32_b32 %0, -1, %0" : "=v"(lane));
    const int wid = wave_in, tid = wid * 64 + lane, wr = wid >> 2, wc = wid & 3, fr = lane & 15, fq = lane >> 4;
    const int K = g.K, nt = K / BK;
    unsigned voffA[2], voffB[2];
#pragma unroll
    for (int i = 0; i < 2; ++i) { int R, C; stage_rc(tid * 16 + i * 8192, R, C); const int Rb = Epi::PERM ? ((R & ~31) + perm32(R & 31)) : R;
        voffA[i] = (unsigned)(R * K + C) * 2u; voffB[i] = (unsigned)(Rb * K + C) * 2u; }
    const size_t kstep = (size_t)(BK * 2);
    const size_t hstep = (size_t)HALF * K * 2;
    const size_t tstep = 2 * hstep;
    const unsigned ldsw = (unsigned)wid * 1024u;
    const int aoff = lds_byte(wr * 64 + fr, fq * 8), boff = lds_byte(wc * 32 + fr, fq * 8);
#define PG8_SA(b, h) (((b) * 2 + (h)) * HTB)
#define PG8_SB(b, h) ((4 + (b) * 2 + (h)) * HTB)
#define PG8_STAGE(bufoff, gbase, voff) do { _Pragma("unroll") for (int _i = 0; _i < 2; ++_i) \
        __builtin_amdgcn_global_load_lds((const unsigned*)((const char*)(gbase) + (voff)[_i]), (PG8_LAS unsigned*)(lds + (bufoff) + ldsw + _i * 8192), 16, 0, 0); } while (0)
#define PG8_LDA(dst, b, h) do { _Pragma("unroll") for (int m = 0; m < 4; ++m) _Pragma("unroll") for (int k = 0; k < 2; ++k) dst[m][k] = *(const PG8_LAS bf16x8*)(lds + PG8_SA(b, h) + aoff + m * 2048 + k * 1024); } while (0)
#define PG8_LDB(dst, b, h) do { _Pragma("unroll") for (int n = 0; n < 2; ++n) _Pragma("unroll") for (int k = 0; k < 2; ++k) dst[n][k] = *(const PG8_LAS bf16x8*)(lds + PG8_SB(b, h) + boff + n * 2048 + k * 1024); } while (0)
#define PG8_MMA(ai, bj, At, Bt) do { __builtin_amdgcn_s_setprio(1); _Pragma("unroll") for (int m = 0; m < 4; ++m) _Pragma("unroll") for (int n = 0; n < 2; ++n) _Pragma("unroll") for (int k = 0; k < 2; ++k) \
        acc[ai][bj][m][n] = __builtin_amdgcn_mfma_f32_16x16x32_bf16(Bt[n][k], At[m][k], acc[ai][bj][m][n], 0, 0, 0); __builtin_amdgcn_s_setprio(0); } while (0)
#define PG8_WAIT_V(n) asm volatile("s_waitcnt vmcnt(" #n ")" ::: "memory")
#define PG8_WAIT_L(n) asm volatile("s_waitcnt lgkmcnt(" #n ")" ::: "memory")
#define PG8_BAR __builtin_amdgcn_s_barrier()
#define PG8_SCHED __builtin_amdgcn_sched_barrier(0)
    Unit cur, nxt; int ui = 0;
    if (!S.next(0, cur)) return;
    f32x4 acc[2][2][4][2];
#pragma unroll
    for (int a = 0; a < 2; ++a)
#pragma unroll
        for (int b = 0; b < 2; ++b)
#pragma unroll
            for (int m = 0; m < 4; ++m)
#pragma unroll
                for (int n = 0; n < 2; ++n) acc[a][b][m][n] = (f32x4){0.f, 0.f, 0.f, 0.f};
    bf16x8 At[4][2], B0[2][2], B1[2][2];
    const char* cA = (const char*)g.A + (size_t)cur.pm * tstep; const char* cB = (const char*)g.Bt + (size_t)cur.pn * tstep;
    S.a_ready(cur);
    if constexpr (SP2) {
        PG8_STAGE(PG8_SB(0, 0), cB, voffB); PG8_STAGE(PG8_SB(0, 1), cB + hstep, voffB); PG8_STAGE(PG8_SA(0, 0), cA, voffA); PG8_STAGE(PG8_SA(0, 1), cA + hstep, voffA);
        if (wr == 1) PG8_BAR;
        PG8_WAIT_V(2); PG8_BAR;
        PG8_STAGE(PG8_SB(1, 0), cB + kstep, voffB); PG8_STAGE(PG8_SA(1, 0), cA + kstep, voffA); PG8_STAGE(PG8_SB(1, 1), cB + hstep + kstep, voffB);
        PG8_WAIT_V(6); PG8_BAR;
    } else {
        PG8_STAGE(PG8_SB(0, 0), cB, voffB); PG8_STAGE(PG8_SA(0, 0), cA, voffA); PG8_STAGE(PG8_SB(0, 1), cB + hstep, voffB); PG8_STAGE(PG8_SA(0, 1), cA + hstep, voffA);
        if (wr == 1) PG8_BAR;
        PG8_WAIT_V(4); PG8_BAR;
        PG8_STAGE(PG8_SB(1, 0), cB + kstep, voffB); PG8_STAGE(PG8_SA(1, 0), cA + kstep, voffA); PG8_STAGE(PG8_SB(1, 1), cB + hstep + kstep, voffB);
        PG8_WAIT_V(6); PG8_BAR;
    }
    for (;;) {
        const bool has_next = S.next(ui + 1, nxt);
        const char* nA = has_next ? (const char*)g.A + (size_t)nxt.pm * tstep : cA; const char* nB = has_next ? (const char*)g.Bt + (size_t)nxt.pn * tstep : cB;
        for (int t = 0; t < nt; t += 2) {
            const bool last = (t == nt - 2);
            const char* a1 = cA + (size_t)(t + 1) * kstep;
            const char* a2 = last ? nA : cA + (size_t)(t + 2) * kstep; const char* b2 = last ? nB : cB + (size_t)(t + 2) * kstep;
            const char* a3 = a2 + kstep; const char* b3 = b2 + kstep;
            if (last && has_next) S.a_ready(nxt);
            if constexpr (SP2) {
            PG8_LDB(B0, 0, 0); PG8_LDB(B1, 0, 1); PG8_SCHED; PG8_LDA(At, 0, 0); PG8_STAGE(PG8_SA(1, 1), a1 + hstep, voffA);
            PG8_WAIT_V(8); PG8_WAIT_L(0); PG8_BAR; PG8_MMA(0, 0, At, B0); PG8_MMA(0, 1, At, B1); PG8_BAR; PG8_SCHED;
            PG8_LDA(At, 0, 1); PG8_STAGE(PG8_SB(0, 0), b2, voffB); PG8_STAGE(PG8_SB(0, 1), b2 + hstep, voffB); PG8_STAGE(PG8_SA(0, 0), a2, voffA);
            PG8_WAIT_V(8); PG8_WAIT_L(0); PG8_BAR; PG8_MMA(1, 0, At, B0); PG8_MMA(1, 1, At, B1); PG8_BAR; PG8_SCHED;
            PG8_LDB(B0, 1, 0); PG8_LDB(B1, 1, 1); PG8_SCHED; PG8_LDA(At, 1, 0); PG8_STAGE(PG8_SA(0, 1), a2 + hstep, voffA);
            PG8_WAIT_V(8); PG8_WAIT_L(0); PG8_BAR; PG8_MMA(0, 0, At, B0); PG8_MMA(0, 1, At, B1); PG8_BAR; PG8_SCHED;
            PG8_LDA(At, 1, 1); PG8_STAGE(PG8_SB(1, 0), b3, voffB); PG8_STAGE(PG8_SB(1, 1), b3 + hstep, voffB); PG8_STAGE(PG8_SA(1, 0), a3, voffA);
            PG8_WAIT_V(8); PG8_WAIT_L(0); PG8_BAR; PG8_MMA(1, 0, At, B0); PG8_MMA(1, 1, At, B1); PG8_BAR; PG8_SCHED;
            } else {
            PG8_LDB(B0, 0, 0); PG8_SCHED; PG8_LDA(At, 0, 0); PG8_STAGE(PG8_SA(1, 1), a1 + hstep, voffA);
            PG8_WAIT_L(8); PG8_BAR; PG8_WAIT_L(0); PG8_MMA(0, 0, At, B0); PG8_BAR; PG8_SCHED;
            PG8_LDB(B1, 0, 1); PG8_STAGE(PG8_SB(0, 0), b2, voffB);
            PG8_BAR; PG8_WAIT_L(0); PG8_MMA(0, 1, At, B1); PG8_BAR;
            PG8_LDA(At, 0, 1); PG8_STAGE(PG8_SA(0, 0), a2, voffA);
            PG8_BAR; PG8_WAIT_L(0); PG8_MMA(1, 0, At, B0); PG8_BAR; PG8_SCHED;
            PG8_STAGE(PG8_SB(0, 1), b2 + hstep, voffB);
            PG8_WAIT_V(6); PG8_BAR; PG8_MMA(1, 1, At, B1); PG8_BAR;
            PG8_LDB(B0, 1, 0); PG8_SCHED; PG8_LDA(At, 1, 0); PG8_STAGE(PG8_SA(0, 1), a2 + hstep, voffA);
            PG8_WAIT_L(8); PG8_BAR; PG8_WAIT_L(0); PG8_MMA(0, 0, At, B0); PG8_BAR; PG8_SCHED;
            PG8_LDB(B1, 1, 1); PG8_STAGE(PG8_SB(1, 0), b3, voffB);
            PG8_BAR; PG8_WAIT_L(0); PG8_MMA(0, 1, At, B1); PG8_BAR;
            PG8_LDA(At, 1, 1); PG8_STAGE(PG8_SA(1, 0), a3, voffA);
            PG8_BAR; PG8_WAIT_L(0); PG8_MMA(1, 0, At, B0); PG8_BAR; PG8_SCHED;
            PG8_STAGE(PG8_SB(1, 1), b3 + hstep, voffB);
            PG8_WAIT_V(6); PG8_BAR; PG8_MMA(1, 1, At, B1); PG8_BAR;
            }
        }
        if constexpr (ALIGN_EPI) { if (wr == 0) PG8_BAR; }
        if constexpr (!Epi::AFTER_DRAIN) { E(acc, cur, wr, wc, fr, fq); S.done(cur); }
        if (!has_next) break;
#pragma unroll
        for (int a = 0; a < 2; ++a)
#pragma unroll
            for (int b = 0; b < 2; ++b)
#pragma unroll
                for (int m = 0; m < 4; ++m)
#pragma unroll
                    for (int n = 0; n < 2; ++n) acc[a][b][m][n] = (f32x4){0.f, 0.f, 0.f, 0.f};
        cur = nxt; cA = nA; cB = nB; ++ui;
        if constexpr (ALIGN_EPI) { if (wr == 1) PG8_BAR; }
    }
    PG8_WAIT_V(0);
    if constexpr (!ALIGN_EPI) { if (wr == 0) PG8_BAR; }
    PG8_BAR;
    if constexpr (Epi::AFTER_DRAIN) { E.fused(acc, cur, wr, wc, fr, fq, lds, wid, lane); S.done(cur); }
#undef PG8_SA
#undef PG8_SB
#undef PG8_STAGE
#undef PG8_LDA
#undef PG8_LDB
#undef PG8_MMA
#undef PG8_WAIT_V
#undef PG8_WAIT_L
#undef PG8_BAR
#undef PG8_SCHED
}
}

__device__ __forceinline__ u32x4 pack8(const f32x4 a, const f32x4 b) { u32x4 w; w.x = pk2(a[0], a[1]); w.y = pk2(a[2], a[3]); w.z = pk2(b[0], b[1]); w.w = pk2(b[2], b[3]); return w; }
__device__ __forceinline__ f32x4 silu4(const f32x4 v) { f32x4 o; o[0] = v[0] * sigmoidf_(v[0]); o[1] = v[1] * sigmoidf_(v[1]); o[2] = v[2] * sigmoidf_(v[2]); o[3] = v[3] * sigmoidf_(v[3]); return o; }
__device__ __forceinline__ f32x4 sig4(const f32x4 v) { f32x4 o; o[0] = sigmoidf_(v[0]); o[1] = sigmoidf_(v[1]); o[2] = sigmoidf_(v[2]); o[3] = sigmoidf_(v[3]); return o; }

struct RowSt {
    unsigned wa, ra; int rq, cq;
    __device__ __forceinline__ RowSt(LAS unsigned char* spare, int wr, int wc, int fr, int fq) {
        int lane = fr + 16 * fq; asm volatile("" : "+v"(lane));
        const int fr_ = lane & 15, fq_ = lane >> 4; const unsigned tile = (unsigned)(size_t)spare + (unsigned)(wr * 4 + wc) * 2048u;
        wa = tile + (unsigned)fr_ * 64u + (unsigned)((fq_ ^ ((fr_ >> 2) & 3)) << 4); ra = tile + (unsigned)lane * 16u; rq = lane >> 2; cq = 8 * ((lane & 3) ^ (lane >> 4)); }
    __device__ __forceinline__ void store(bf16_t* P, size_t row16, int stride, int col, const u32x4 v, int buf) const {
        *(LAS u32x4*)(size_t)(wa + 1024u * (unsigned)buf) = v; const u32x4 t = *(const LAS u32x4*)(size_t)(ra + 1024u * (unsigned)buf);
        *(u32x4*)(P + (row16 + (size_t)rq) * (size_t)stride + col + cq) = t; }
};

struct Epi0 {
    static constexpr bool PERM = true, AFTER_DRAIN = false;
    unsigned char* ws; unsigned char* dout; bool cheap; LAS unsigned char* spare;
    __device__ __forceinline__ void operator()(const f32x4 (&acc)[2][2][4][2], const pg8::Unit& u, int wr, int wc, int fr, int fq) const {
        const int t = u.pn, cwv = wc * 32; const size_t rw = (size_t)(u.pm * 256 + wr * 64);
        const RowSt rs(spare, wr, wc, fr, fq);
        if (t < 8) {
            bf16_t* U = (bf16_t*)(ws + WS_U);
#pragma unroll
            for (int ai = 0; ai < 2; ++ai)
#pragma unroll
                for (int m = 0; m < 4; ++m) {
                    const f32x4 a = cheap ? acc[ai][0][m][0] : acc[ai][0][m][0] * sig4(acc[ai][1][m][0]), b = cheap ? acc[ai][0][m][1] : acc[ai][0][m][1] * sig4(acc[ai][1][m][1]);
                    rs.store(U, rw + ai * 128 + m * 16, 1024, 128 * t + cwv, pack8(a, b), m & 1); }
        } else if (t == 28) {
            bf16_t* WDAD = (bf16_t*)(dout + DO_WDAD);
#pragma unroll
            for (int ai = 0; ai < 2; ++ai)
#pragma unroll
                for (int m = 0; m < 4; ++m) rs.store(WDAD, rw + ai * 128 + m * 16, 128, cwv, pack8(acc[ai][0][m][0], acc[ai][0][m][1]), m & 1);
        } else {
            const bool act = ((t < 12) || (t >= 24)) && !cheap; const int c0 = 256 * (t & 3);
            unsigned char* bp = (t >= 24) ? (dout + DO_BG) : (ws + WS_AG + (size_t)((t - 8) >> 2) * (64 * MiB));
            bf16_t* base = (bf16_t*)bp;
#pragma unroll
            for (int ai = 0; ai < 2; ++ai)
#pragma unroll
                for (int m = 0; m < 4; ++m) {
#pragma unroll
                    for (int bj = 0; bj < 2; ++bj) { f32x4 a = acc[ai][bj][m][0], b = acc[ai][bj][m][1];
                        if (act) { a = silu4(a); b = silu4(b); }
                        rs.store(base, rw + ai * 128 + m * 16, 1024, c0 + 128 * bj + cwv, pack8(a, b), bj); } }
        }
    }
};
static_assert(WS_R == WS_AG + 64 * MiB && WS_K == WS_AG + 128 * MiB && WS_V == WS_AG + 192 * MiB, "Epi0 region arithmetic");

struct EpiLora {
    static constexpr bool PERM = true, AFTER_DRAIN = false;
    bf16_t *D, *A; const float* vec; LAS unsigned char* spare;
    __device__ __forceinline__ void operator()(const f32x4 (&acc)[2][2][4][2], const pg8::Unit& u, int wr, int wc, int fr, int fq) const {
        const int t = u.pn, cw = wc * 32 + 8 * fq; const size_t rw = (size_t)(u.pm * 256 + wr * 64);
        const bool isd = t < 4; bf16_t* base = isd ? D : A; const int c0 = 256 * (t & 3); const float* bias = vec + (isd ? 0 : 1024) + c0 + cw;
        const float sc = isd ? 0.60653065971f : 1.0f;
        const RowSt rs(spare, wr, wc, fr, fq);
#pragma unroll
        for (int ai = 0; ai < 2; ++ai)
#pragma unroll
            for (int m = 0; m < 4; ++m) {
#pragma unroll
                for (int bj = 0; bj < 2; ++bj) { const f32x4 b0 = *(const f32x4*)(bias + 128 * bj), b1 = *(const f32x4*)(bias + 128 * bj + 4);
                    const f32x4 a = sig4(acc[ai][bj][m][0] + b0) * sc, b = sig4(acc[ai][bj][m][1] + b1) * sc;
                    rs.store(base, rw + ai * 128 + m * 16, 1024, c0 + 128 * bj + wc * 32, pack8(a, b), bj); } }
    }
};

struct EpiRes {
    static constexpr bool PERM = false, AFTER_DRAIN = false;
    const float* resid; float* out; const float* modp; const float* ada_b; int layer; bool cheap; LAS unsigned char* spare;
    __device__ __forceinline__ void operator()(const f32x4 (&acc)[2][2][4][2], const pg8::Unit& u, int wr, int wc, int fr, int fq) const {
        const int row0 = u.pm * 256 + wr * 64 + fr, col0 = u.pn * 256 + wc * 32 + 4 * fq, b = (u.pm * 256) / SEQ;
#ifdef EPIRES_CHEAP
        if (cheap) {
            f32x4 s = (f32x4){0.f, 0.f, 0.f, 0.f};
#pragma unroll
            for (int ai = 0; ai < 2; ++ai)
#pragma unroll
                for (int bj = 0; bj < 2; ++bj)
#pragma unroll
                    for (int m = 0; m < 4; ++m)
#pragma unroll
                        for (int n = 0; n < 2; ++n) s += acc[ai][bj][m][n];
            if (s[0] + s[1] + s[2] + s[3] == 1.2345e30f) out[(size_t)row0 * 1024 + col0] = s[0];
            return; }
#endif
        f32x4 gv[2][2];
#pragma unroll
        for (int bj = 0; bj < 2; ++bj)
#pragma unroll
            for (int n = 0; n < 2; ++n) { const int c = col0 + bj * 128 + n * 16; f32x4 g = *(const f32x4*)(ada_b + layer * 3072 + 2048 + c);
#pragma unroll
                for (int s = 0; s < 8; ++s) g += *(const f32x4*)(modp + (size_t)((s * 2 + layer) * 4 + b) * 3072 + 2048 + c);
                gv[bj][n] = g; }
        const int lane = fr + 16 * fq;
        const unsigned tile = (unsigned)(size_t)spare + (unsigned)(wr * 4 + wc) * 2048u;
        const unsigned wa = tile + (unsigned)fr * 128u + (unsigned)((fq ^ (fr >> 1)) << 4);
        const unsigned ra = tile + (unsigned)lane * 16u;
        const size_t o0 = (size_t)(u.pm * 256 + wr * 64 + (lane >> 3)) * 1024 + u.pn * 256 + wc * 32 + 4 * ((lane & 7) ^ (lane >> 4));
        const size_t o1 = (size_t)(u.pm * 256 + wr * 64 + 8 + (lane >> 3)) * 1024 + u.pn * 256 + wc * 32 + 4 * ((lane & 7) ^ (4 + (lane >> 4)));
        f32x4 rr[3][2];
        auto rload = [&](int idx, f32x4 (&dst)[2]) { const int ai = idx >> 3, m = (idx >> 1) & 3, bj = idx & 1; const size_t d = (size_t)(ai * 128 + m * 16) * 1024 + bj * 128;
            dst[0] = *(const f32x4*)(resid + o0 + d); dst[1] = *(const f32x4*)(resid + o1 + d); };
        rload(0, rr[0]); rload(1, rr[1]);
#pragma unroll
        for (int idx = 0; idx < 16; ++idx) { const int ai = idx >> 3, m = (idx >> 1) & 3, bj = idx & 1; const size_t d = (size_t)(ai * 128 + m * 16) * 1024 + bj * 128;
            if (idx + 2 < 16) rload(idx + 2, rr[(idx + 2) % 3]);
            *(LAS f32x4*)(size_t)wa = gv[bj][0] * acc[ai][bj][m][0]; *(LAS f32x4*)(size_t)(wa ^ 64u) = gv[bj][1] * acc[ai][bj][m][1];
            const f32x4 t0 = *(const LAS f32x4*)(size_t)ra, t1 = *(const LAS f32x4*)(size_t)(ra + 1024u);
            *(f32x4*)(out + o0 + d) = rr[idx % 3][0] + t0; *(f32x4*)(out + o1 + d) = rr[idx % 3][1] + t1;
            asm volatile("" ::: "memory"); }
    }
};

constexpr float Q_SCALE = 0.08838834764831845f * 1.4426950408889634f;
constexpr float WI_SCALE = 0.35355339059327373f * 0.125f;
struct Epi1 {
    static constexpr bool PERM = true, AFTER_DRAIN = false;
    bf16_t *Q, *KV, *QI, *KI, *G; float* WI; const f32x2* csa; const f32x2* csi; LAS unsigned char* spare;
    __device__ __forceinline__ void rope8(const f32x4 x1a, const f32x4 x1b, const f32x4 x2a, const f32x4 x2b, const f32x4 (&tv)[4], float sc, u32x4& o1, u32x4& o2) const {
        float c[8], s[8];
#pragma unroll
        for (int j = 0; j < 4; ++j) { c[2 * j] = tv[j][0]; s[2 * j] = tv[j][1]; c[2 * j + 1] = tv[j][2]; s[2 * j + 1] = tv[j][3]; }
        float a[8], b[8];
#pragma unroll
        for (int j = 0; j < 4; ++j) { a[j] = x1a[j]; a[4 + j] = x1b[j]; b[j] = x2a[j]; b[4 + j] = x2b[j]; }
        float p[8], q[8];
#pragma unroll
        for (int j = 0; j < 8; ++j) { p[j] = (a[j] * c[j] - b[j] * s[j]) * sc; q[j] = (b[j] * c[j] + a[j] * s[j]) * sc; }
        o1.x = pk2(p[0], p[1]); o1.y = pk2(p[2], p[3]); o1.z = pk2(p[4], p[5]); o1.w = pk2(p[6], p[7]);
        o2.x = pk2(q[0], q[1]); o2.y = pk2(q[2], q[3]); o2.z = pk2(q[4], q[5]); o2.w = pk2(q[6], q[7]);
    }
    __device__ __forceinline__ void operator()(const f32x4 (&acc)[2][2][4][2], const pg8::Unit& u, int wr, int wc, int fr, int fq) const {
        const int row0 = u.pm * 256 + wr * 64 + fr, t = u.pn; const size_t rw = (size_t)(u.pm * 256 + wr * 64);
        const RowSt rs(spare, wr, wc, fr, fq);
        const bool roped = (t < 8) || (t == 8 && wc < 2) || (t >= 9 && t < 11) || (t == 11 && wc == 0);
        if (roped) {
            int lane = fr + 16 * fq; asm volatile("" : "+v"(lane));
            const bool wide = t <= 8; const int rb = wide ? 1024 : 512;
            const f32x2* tab = wide ? csa + (((rw >> 4) * 2 + (wc & 1)) * 256 + lane) * 2 : csi + ((rw >> 4) * 256 + lane) * 2;
            f32x4 tv[3][4];
            auto tload = [&](int idx, f32x4 (&d)[4]) { const f32x2* p = tab + (size_t)((idx >> 2) * 8 + (idx & 3)) * rb;
#pragma unroll
                for (int j = 0; j < 4; ++j) d[j] = *(const f32x4*)(p + 128 * j); };
            tload(0, tv[0]); tload(1, tv[1]);
            const float sc = (t < 8) ? Q_SCALE : 1.0f;
#pragma unroll
            for (int idx = 0; idx < 8; ++idx) { const int ai = idx >> 2, m = idx & 3; const size_t r16 = rw + ai * 128 + m * 16;
                if (idx + 2 < 8) tload(idx + 2, tv[(idx + 2) % 3]);
                u32x4 o1, o2; rope8(acc[ai][0][m][0], acc[ai][0][m][1], acc[ai][1][m][0], acc[ai][1][m][1], tv[idx % 3], sc, o1, o2);
                if (t < 8) { const int head = 2 * t + (wc >> 1); rs.store(Q, r16, 2048, head * 128 + (wc & 1) * 32, o1, 0); rs.store(Q, r16, 2048, head * 128 + 64 + (wc & 1) * 32, o2, 1); }
                else if (t == 8) { rs.store(KV, r16, 256, (wc & 1) * 32, o1, 0); rs.store(KV, r16, 256, 64 + (wc & 1) * 32, o2, 1); }
                else if (t < 11) { const int head = 4 * (t - 9) + wc; rs.store(QI, r16, 512, head * 64, o1, 0); rs.store(QI, r16, 512, head * 64 + 32, o2, 1); }
                else { rs.store(KI, r16, 64, 0, o1, 0); rs.store(KI, r16, 64, 32, o2, 1); }
                asm volatile("" ::: "memory"); }
        } else {
#pragma unroll
            for (int ai = 0; ai < 2; ++ai)
#pragma unroll
                for (int m = 0; m < 4; ++m) { const size_t row = (size_t)(row0 + ai * 128 + m * 16), r16 = rw + ai * 128 + m * 16;
                    const f32x4 x1a = acc[ai][0][m][0], x1b = acc[ai][0][m][1], x2a = acc[ai][1][m][0], x2b = acc[ai][1][m][1];
                    if (t == 8) { rs.store(KV, r16, 256, 128 + (wc & 1) * 32, pack8(x1a, x1b), 0); rs.store(KV, r16, 256, 192 + (wc & 1) * 32, pack8(x2a, x2b), 1); }
                    else if (t == 11) { if (wc == 1 && fq == 0) { *(f32x4*)(WI + row * 8) = x1a * WI_SCALE; *(f32x4*)(WI + row * 8 + 4) = x1b * WI_SCALE; } }
                    else if (t >= 12) { const int c0 = 256 * (t - 12);
                        rs.store(G, r16, 2048, c0 + wc * 32, pack8(silu4(x1a), silu4(x1b)), 0); rs.store(G, r16, 2048, c0 + 128 + wc * 32, pack8(silu4(x2a), silu4(x2b)), 1); }
                }
        }
    }
};

struct Args {
    const float* x; const float* c; const int* pos; const float* ada_w; const float* ada_b; const float* norm_g; const float* final_g;
    const float* even_w_in; const float* even_w_out; const float* conv_w; const float* conv_vec; const float* mu_rkv; const float* mu_lora;
    const float* rwkv_vec; const float* w_up; const float* a_up; const float* r_k; const float* odd_w_in; const float* odd_w_out;
    float* out; unsigned char* ws; int ph_lo, ph_hi;
};

template <class SrcF>
__device__ __forceinline__ void transpose_item(const SrcF& src, int K, bf16_t* WT, LAS float* scr, int item, int nblk, int lane) {
    const int kb = item / nblk, nb = item % nblk, k0 = 64 * kb, n0 = 32 * nb;
    float tv[32];
#pragma unroll
    for (int i = 0; i < 32; ++i) tv[i] = src(k0 + 2 * i + (lane >> 5), n0 + (lane & 31));
#pragma unroll
    for (int i = 0; i < 32; ++i) scr[(2 * i + (lane >> 5)) * 33 + (lane & 31)] = tv[i];
    LDS_WAIT();
    const int c = lane & 7;
#pragma unroll
    for (int j = 0; j < 4; ++j) { const int n = (lane >> 3) + 8 * j; const LAS float* s = scr + (8 * c) * 33 + n;
        u32x4 o; o.x = pk2(s[0 * 33], s[1 * 33]); o.y = pk2(s[2 * 33], s[3 * 33]); o.z = pk2(s[4 * 33], s[5 * 33]); o.w = pk2(s[6 * 33], s[7 * 33]);
        *(u32x4*)(WT + (size_t)(n0 + n) * K + k0 + 8 * c) = o; }
    LDS_WAIT();
}

__device__ __forceinline__ void transpose_item_col(const float* W, int ldw, int scol, int K, bf16_t* WT, LAS float* scr, int k0, int n0, int lane) {
    const float* wp = W + (size_t)(k0 + (lane >> 5)) * ldw + (scol < 0 ? 0 : scol);
#pragma unroll 8
    for (int i = 0; i < 32; ++i) { const float v = wp[(size_t)(2 * i) * ldw]; scr[(2 * i + (lane >> 5)) * 33 + (lane & 31)] = scol < 0 ? 0.f : v; }
    LDS_WAIT();
    const int c = lane & 7;
#pragma unroll
    for (int j = 0; j < 4; ++j) { const int n = (lane >> 3) + 8 * j; const LAS float* s = scr + (8 * c) * 33 + n;
        u32x4 o; o.x = pk2(s[0 * 33], s[1 * 33]); o.y = pk2(s[2 * 33], s[3 * 33]); o.z = pk2(s[4 * 33], s[5 * 33]); o.w = pk2(s[6 * 33], s[7 * 33]);
        *(u32x4*)(WT + (size_t)(n0 + n) * K + k0 + 8 * c) = o; }
    LDS_WAIT();
}
__device__ __forceinline__ void rope_item(const Args& a, int r, int lane) {
    const float p = (float)a.pos[r]; const int f = lane;
    { const float inv = powf(10000.0f, -(float)(2 * f) / 128.0f); float sn, cs; sincosf(p * inv, &sn, &cs);
      ((f32x2*)(a.ws + WS_CSA))[(size_t)((((r >> 4) * 2 + (f >> 5)) * 4 + ((f & 7) >> 1)) * 64 + (r & 15) + 16 * ((f & 31) >> 3)) * 2 + (f & 1)] = (f32x2){cs, sn}; }
    if (f < 32) { const float inv = powf(10000.0f, -(float)(2 * f) / 64.0f); float sn, cs; sincosf(p * inv, &sn, &cs);
      ((f32x2*)(a.ws + WS_CSI))[(size_t)(((r >> 4) * 4 + ((f & 7) >> 1)) * 64 + (r & 15) + 16 * (f >> 3)) * 2 + (f & 1)] = (f32x2){cs, sn}; }
}
__device__ __forceinline__ void p0_late(const Args& a, const int wave, LAS unsigned char* lds, int first, int nblk) {
    const int lane = lane_id(), tid = wave * 64 + lane;
    LAS float* scr = (LAS float*)(lds + wave * 16384);
    const int gw = ((int)blockIdx.x - first) * NWAVES + wave, NGW = nblk * NWAVES;
    unsigned char* ws = a.ws;
    constexpr int I_WO = (2048 / 64) * (DM / 32), I_W1 = (DM / 64) * (N1 / 32), I_ROPE = MTOK;
    for (int it = gw; it < I_W1 + I_WO + I_ROPE; it += NGW) {
        int r = it;
        if (r < I_W1) { const int nblk = N1 / 32, k0 = 64 * (r / nblk), n0 = 32 * (r % nblk); transpose_item_col(a.odd_w_in, ODD_COLS, map1(n0 + (lane & 31)), DM, (bf16_t*)(ws + WS_WIN1), scr, k0, n0, lane); continue; } r -= I_W1;
        if (r < I_WO) { const int nblk = DM / 32, k0 = 64 * (r / nblk), n0 = 32 * (r % nblk); transpose_item_col(a.odd_w_out, DM, n0 + (lane & 31), 2048, (bf16_t*)(ws + WS_WOUT1), scr, k0, n0, lane); continue; } r -= I_WO;
        {
            const float p = (float)a.pos[r];
            { const float inv = powf(10000.0f, -(float)(2 * lane) / 128.0f); float sn, cs; sincosf(p * inv, &sn, &cs); ((f32x2*)(ws + WS_CSA))[(size_t)r * 64 + lane] = (f32x2){cs, sn}; }
            if (lane < 32) { const float inv = powf(10000.0f, -(float)(2 * lane) / 64.0f); float sn, cs; sincosf(p * inv, &sn, &cs); ((f32x2*)(ws + WS_CSI))[(size_t)r * 32 + lane] = (f32x2){cs, sn}; }
        }
    }
}
__device__ __forceinline__ void p0_prologue(const Args& a, const int wave, LAS unsigned char* lds) {
    const int lane = lane_id(), tid = wave * 64 + lane;
    LAS float* scr = (LAS float*)(lds + wave * 16384);
    const int gw = blockIdx.x * NWAVES + wave, NGW = gridDim.x * NWAVES;
    unsigned char* ws = a.ws;
    constexpr int I_W0 = (DM / 64) * (N0 / 32), I_WO = (2048 / 64) * (DM / 32), I_W1 = (DM / 64) * (N1 / 32), I_WL = (256 / 64) * (2048 / 32), I_MOD = 96 * 8, I_ROPE = MTOK;
    constexpr int NITEMS = I_W0 + I_WO + I_W1 + I_WO + I_WL + I_MOD + I_ROPE;
    constexpr int N_EARLY = I_W0 + I_WO + I_W1 + I_WO + I_WL + I_MOD;
    for (int it = gw; it < N_EARLY; it += NGW) {
        int r = it;
        if (r < I_W0) { const float* W = a.even_w_in; transpose_item([W](int k, int n) { const int s = map0(n); return s < 0 ? 0.f : W[(size_t)k * EVEN_COLS + s]; }, DM, (bf16_t*)(ws + WS_WIN0), scr, r, N0 / 32, lane); continue; } r -= I_W0;
        if (r < I_WO) { const float* W = a.even_w_out; transpose_item([W](int k, int n) { return W[(size_t)k * DM + n]; }, 2048, (bf16_t*)(ws + WS_WOUT0), scr, r, DM / 32, lane); continue; } r -= I_WO;
        if (r < I_W1) { const float* W = a.odd_w_in; transpose_item([W](int k, int n) { const int s = map1(n); return s < 0 ? 0.f : W[(size_t)k * ODD_COLS + s]; }, DM, (bf16_t*)(ws + WS_WIN1), scr, r, N1 / 32, lane); continue; } r -= I_W1;
        if (r < I_WO) { const float* W = a.odd_w_out; transpose_item([W](int k, int n) { return W[(size_t)k * DM + n]; }, 2048, (bf16_t*)(ws + WS_WOUT1), scr, r, DM / 32, lane); continue; } r -= I_WO;
        if (r < I_WL) { const float* wu = a.w_up; const float* au = a.a_up;
            transpose_item([wu, au](int k, int n) { if (n < 1024) return k < 64 ? wu[k * 1024 + n] : 0.f; return (k >= 64 && k < 128) ? au[(k - 64) * 1024 + (n - 1024)] : 0.f; }, 256, (bf16_t*)(ws + WS_WLORA), scr, r, 2048 / 32, lane); continue; } r -= I_WL;
        if (r < I_MOD) {
            const int cgp = r >> 3, ks = r & 7, col = cgp * 64 + lane, l = col / 3072, cc = col - l * 3072;
#pragma unroll
            for (int i = 0; i < 8; ++i) { const int idx = lane + 64 * i, bb = idx >> 7, kk = idx & 127; const float cv = a.c[bb * DM + ks * 128 + kk]; scr[kk * 4 + bb] = cv * sigmoidf_(cv); }
            LDS_WAIT();
            const float* W = a.ada_w + (size_t)l * DM * 3072 + cc + (size_t)(ks * 128) * 3072; f32x4 acc4 = (f32x4){0.f, 0.f, 0.f, 0.f};
#pragma unroll 1
            for (int k8 = 0; k8 < 128; k8 += 16) { float wv[16];
#pragma unroll
                for (int i = 0; i < 16; ++i) wv[i] = W[(size_t)(k8 + i) * 3072];
#pragma unroll
                for (int i = 0; i < 16; ++i) acc4 += *(const LAS f32x4*)(scr + (k8 + i) * 4) * wv[i]; }
            LDS_WAIT();
            const float acc0 = acc4[0], acc1 = acc4[1], acc2 = acc4[2], acc3 = acc4[3];
            float* mp = (float*)(ws + WS_MODP) + (size_t)((ks * 2 + l) * 4) * 3072 + cc;
            mp[0] = acc0; mp[3072] = acc1; mp[2 * 3072] = acc2; mp[3 * 3072] = acc3; continue; } r -= I_MOD;
    }
}

__device__ __forceinline__ void norm_phase(const Args& a, const int wave, LAS unsigned char* lds, const float* src, int layer) {
    const int lane = lane_id(), tid = wave * 64 + lane;
    LAS float* gs = (LAS float*)lds; LAS float* sh = gs + DM;
    const float* modp = (const float*)(a.ws + WS_MODP); bf16_t* H = (bf16_t*)(a.ws + WS_H);
    for (int tile = blockIdx.x; tile < MTOK / 128; tile += gridDim.x) {
        const int b = (tile * 128) / SEQ;
        __syncthreads();
        for (int c = tid; c < DM; c += NTHREADS) {
            float sc = a.ada_b[layer * 3072 + 1024 + c], sf = a.ada_b[layer * 3072 + c];
#pragma unroll
            for (int s = 0; s < 8; ++s) { const float* mp = modp + (size_t)((s * 2 + layer) * 4 + b) * 3072; sc += mp[1024 + c]; sf += mp[c]; }
            gs[c] = a.norm_g[layer * DM + c] * (1.0f + sc); sh[c] = sf; }
        __syncthreads();
        for (int r4 = 0; r4 < 16; r4 += 4) {
            f32x4 v[4][4]; float ss[4];
#pragma unroll
            for (int q = 0; q < 4; ++q) { const size_t m = (size_t)tile * 128 + wave * 16 + r4 + q; const f32x4* xr = (const f32x4*)(src + m * DM) + lane;
#pragma unroll
                for (int j = 0; j < 4; ++j) v[q][j] = xr[64 * j]; }
#pragma unroll
            for (int q = 0; q < 4; ++q) { float s = 0.f;
#pragma unroll
                for (int j = 0; j < 4; ++j) s += (v[q][j][0] * v[q][j][0] + v[q][j][1] * v[q][j][1]) + (v[q][j][2] * v[q][j][2] + v[q][j][3] * v[q][j][3]);
                ss[q] = s; }
#pragma unroll
            for (int q = 0; q < 4; ++q) ss[q] = wave_sum(ss[q]);
#pragma unroll
            for (int q = 0; q < 4; ++q) { const size_t m = (size_t)tile * 128 + wave * 16 + r4 + q; const float rstd = rsqrtf(ss[q] * (1.0f / DM) + 1e-6f);
                u32x2* o = (u32x2*)(H + m * DM) + lane;
#pragma unroll
                for (int j = 0; j < 4; ++j) { const f32x4 g = *(const LAS f32x4*)(gs + 4 * (64 * j + lane)), s = *(const LAS f32x4*)(sh + 4 * (64 * j + lane));
                    const f32x4 h = v[q][j] * rstd * g + s; u32x2 w; w.x = pk2(h[0], h[1]); w.y = pk2(h[2], h[3]); o[64 * j] = w; } }
        }
    }
}

__device__ __forceinline__ void final_phase(const Args& a, const int wave) {
    const int lane = lane_id(), tid = wave * 64 + lane;
    const int gw = blockIdx.x * NWAVES + wave, NGW = gridDim.x * NWAVES;
    f32x4 g[4];
#pragma unroll
    for (int j = 0; j < 4; ++j) g[j] = *((const f32x4*)a.final_g + 64 * j + lane);
    float tsc = 1.0f;
#ifdef STAMP_K
    { const unsigned long long* st = (const unsigned long long*)(a.ws + WS_STAMP); tsc = 1.0f + (float)(st[1] - st[0] + st[2]) * 1e-7f; }
#endif
    for (int m0 = 4 * gw; m0 < MTOK; m0 += 4 * NGW) {
        f32x4 v[4][4]; float ss[4];
#pragma unroll
        for (int q = 0; q < 4; ++q) { const f32x4* xr = (const f32x4*)(a.out + (size_t)(m0 + q) * DM) + lane;
#pragma unroll
            for (int j = 0; j < 4; ++j) v[q][j] = xr[64 * j]; }
#pragma unroll
        for (int q = 0; q < 4; ++q) { float s = 0.f;
#pragma unroll
            for (int j = 0; j < 4; ++j) s += (v[q][j][0] * v[q][j][0] + v[q][j][1] * v[q][j][1]) + (v[q][j][2] * v[q][j][2] + v[q][j][3] * v[q][j][3]);
            ss[q] = wave_sum(s); }
#pragma unroll
        for (int q = 0; q < 4; ++q) { const float rstd = rsqrtf(ss[q] * (1.0f / DM) + 1e-6f) * tsc; f32x4* xr = (f32x4*)(a.out + (size_t)(m0 + q) * DM) + lane;
#pragma unroll
            for (int j = 0; j < 4; ++j) xr[64 * j] = v[q][j] * rstd * g[j]; }
    }
}


__device__ __forceinline__ void conv_phase(const Args& a, const int wave, LAS unsigned char* lds, int first, int stride) {
    const int lane = lane_id(), tid = wave * 64 + lane;
    const bf16_t* U = (const bf16_t*)(a.ws + WS_U); const bf16_t* AG = (const bf16_t*)(a.ws + WS_AG); bf16_t* YAB = (bf16_t*)(a.ws + WS_YAB);
    f32x2 w[31];
#pragma unroll
    for (int j = 0; j < 31; ++j) w[j] = *(const f32x2*)(a.conv_w + j * DM + 2 * tid);
    const f32x2 cbias = *(const f32x2*)(a.conv_vec + 2 * tid);
    for (int tile = first; tile < MTOK / 32; tile += stride) {
        const int b = tile >> 8, s0 = (tile & 255) * 32;
        __syncthreads();
        for (int idx = tid; idx < 62 * 128; idx += NTHREADS) { const int row = idx >> 7, ch = idx & 127, s = s0 - 30 + row;
            u32x4 v = (u32x4){0u, 0u, 0u, 0u}; if (s >= 0) v = *(const u32x4*)(U + ((size_t)(b * SEQ + s)) * DM + ch * 8);
            *(LAS u32x4*)(lds + row * 2048 + ch * 16) = v; }
        __syncthreads();
        LAS unsigned char* rb0 = lds + tid * 4; LAS unsigned char* rb1 = rb0 + 65536; LAS unsigned char* wb0 = lds + tid * 8; LAS unsigned char* wb1 = wb0 + 65536;
        asm volatile("" : "+v"(rb0), "+v"(rb1), "+v"(wb0), "+v"(wb1));
        f32x2 acc[32];
#pragma unroll
        for (int t = 0; t < 32; ++t) acc[t] = (f32x2){0.f, 0.f};
#pragma unroll
        for (int i = 0; i < 62; ++i) { const unsigned xw = (i < 32) ? *(const LAS unsigned*)(rb0 + i * 2048) : *(const LAS unsigned*)(rb1 + (i - 32) * 2048); const f32x2 xv = (f32x2){bflo(xw), bfhi(xw)};
#pragma unroll
            for (int t = (i > 30 ? i - 30 : 0); t <= (i < 31 ? i : 31); ++t) acc[t] += xv * w[i - t]; }
        __syncthreads();
#pragma unroll
        for (int t = 0; t < 32; ++t) { if (t < 16) *(LAS f32x2*)(wb0 + t * 4096) = acc[t] + cbias; else *(LAS f32x2*)(wb1 + (t - 16) * 4096) = acc[t] + cbias; }
        __syncthreads();
        f32x4 lw[4], lb[4];
#pragma unroll
        for (int j = 0; j < 4; ++j) { lw[j] = *(const f32x4*)(a.conv_vec + DM + 4 * (lane + 64 * j)); lb[j] = *(const f32x4*)(a.conv_vec + 2 * DM + 4 * (lane + 64 * j)); }
        for (int tt = 0; tt < 4; ++tt) { const int t = wave * 4 + tt; const size_t m = (size_t)b * SEQ + s0 + t;
            f32x4 v[4]; float s = 0.f;
#pragma unroll
            for (int j = 0; j < 4; ++j) { v[j] = *(const LAS f32x4*)(lds + (size_t)t * 4096 + 16 * (lane + 64 * j)); s += (v[j][0] + v[j][1]) + (v[j][2] + v[j][3]); }
            const float mean = wave_sum(s) * (1.0f / DM); float q = 0.f;
#pragma unroll
            for (int j = 0; j < 4; ++j) { v[j] = v[j] - mean; q += (v[j][0] * v[j][0] + v[j][1] * v[j][1]) + (v[j][2] * v[j][2] + v[j][3] * v[j][3]); }
            const float rstd = rsqrtf(wave_sum(q) * (1.0f / DM) + 1e-5f);
#pragma unroll
            for (int j = 0; j < 4; ++j) { const f32x4 y = v[j] * rstd * lw[j] + lb[j]; const u32x2 g = *(const u32x2*)(AG + m * DM + 4 * (lane + 64 * j));
                const f32x4 o = silu4(y) * (f32x4){bflo(g.x), bfhi(g.x), bflo(g.y), bfhi(g.y)};
                u32x2 wv; wv.x = pk2(o[0], o[1]); wv.y = pk2(o[2], o[3]); *(u32x2*)(YAB + m * 2048 + 4 * (lane + 64 * j)) = wv; }
        }
    }
}

__device__ __forceinline__ void lora_pre_phase(const Args& a, const int wave) {
    const int lane = lane_id(), tid = wave * 64 + lane;

        const bf16_t* WDAD = (const bf16_t*)((unsigned char*)a.out + DO_WDAD); bf16_t* LA = (bf16_t*)((unsigned char*)a.out + DO_LA);
        const int gw = blockIdx.x * NWAVES + wave, NGW = gridDim.x * NWAVES;
        const f32x2 mu = *(const f32x2*)(a.mu_lora + 2 * lane);
        for (int m0 = gw * 4; m0 < MTOK; m0 += NGW * 4) {
            unsigned cur[4], prv[4];
#pragma unroll
            for (int i = 0; i < 4; ++i) { const int m = m0 + i; cur[i] = *(const unsigned*)(WDAD + (size_t)m * 128 + 2 * lane); }
#pragma unroll
            for (int i = 0; i < 4; ++i) { const int m = m0 + i; if (i > 0) prv[i] = cur[i - 1]; else { prv[0] = 0u; if ((m & (SEQ - 1)) > 0) prv[0] = *(const unsigned*)(WDAD + (size_t)(m - 1) * 128 + 2 * lane); } }
#pragma unroll
            for (int i = 0; i < 4; ++i) { const int m = m0 + i;
                float v0 = bflo(cur[i]), v1 = bfhi(cur[i]); v0 += (bflo(prv[i]) - v0) * mu[0]; v1 += (bfhi(prv[i]) - v1) * mu[1];
                if (lane < 32) { v0 = tanhf(v0); v1 = tanhf(v1); }
                *(unsigned*)(LA + (size_t)m * 256 + 2 * lane) = pk2(v0, v1); *(unsigned*)(LA + (size_t)m * 256 + 128 + 2 * lane) = 0u; }
        }
    }

struct ScanRaw { u32x2 r, rp, k, kp, v, vp, d, a; };
constexpr int SC_CH = 16, SC_BUF_F = 5 * SC_CH * 64 + SC_CH * 16;

__device__ __forceinline__ void scan_phase(const Args& a, const int wave, LAS unsigned char* lds) {
    const int lane = lane_id(), tid = wave * 64 + lane;
    const bf16_t* Rg = (const bf16_t*)(a.ws + WS_R); const bf16_t* Kg = (const bf16_t*)(a.ws + WS_K); const bf16_t* Vg = (const bf16_t*)(a.ws + WS_V);
    const bf16_t* Dg = (const bf16_t*)(a.ws + WS_DARR); const bf16_t* Ag = (const bf16_t*)(a.ws + WS_AARR);
    bf16_t* YAB = (bf16_t*)(a.ws + WS_YAB); float* RK = (float*)((unsigned char*)a.out + DO_RK);
    LAS float* bufs = (LAS float*)lds; LAS float* ybuf = bufs + 2 * SC_BUF_F;
    constexpr int NCH = SEQ / SC_CH;
    for (int job = blockIdx.x; job < 256; job += gridDim.x) {
        const int vcu = (gridDim.x == 256) ? ((job & 7) * 32 + (job >> 3)) : job;
        const int bh = vcu >> 2, vq = vcu & 3, b = bh >> 4, h = bh & 15;
        __syncthreads();
        if (wave >= 4) {
            const int pt = tid - 256, tok = pt >> 4, cgp = pt & 15, ch = h * 64 + 4 * cgp;
            const f32x4 mur = *(const f32x4*)(a.mu_rkv + ch), muk = *(const f32x4*)(a.mu_rkv + DM + ch), muv = *(const f32x4*)(a.mu_rkv + 2 * DM + ch);
            const f32x4 k_k = *(const f32x4*)(a.rwkv_vec + 2 * DM + ch), k_a = *(const f32x4*)(a.rwkv_vec + 3 * DM + ch), rkw = *(const f32x4*)(a.r_k + ch);
            auto load = [&](int c) { ScanRaw q; const int s = c * SC_CH + tok; const size_t m = (size_t)b * SEQ + s; const size_t o = m * DM + ch; const size_t op = (s > 0) ? o - DM : o;
                q.r = *(const u32x2*)(Rg + o); q.k = *(const u32x2*)(Kg + o); q.v = *(const u32x2*)(Vg + o); q.d = *(const u32x2*)(Dg + o); q.a = *(const u32x2*)(Ag + o);
                q.rp = *(const u32x2*)(Rg + op); q.kp = *(const u32x2*)(Kg + op); q.vp = *(const u32x2*)(Vg + op);
                if (s == 0) { q.rp = (u32x2){0u, 0u}; q.kp = (u32x2){0u, 0u}; q.vp = (u32x2){0u, 0u}; }
                return q; };
            auto un4 = [](u32x2 w) { return (f32x4){bflo(w.x), bfhi(w.x), bflo(w.y), bfhi(w.y)}; };
            auto process = [&](const ScanRaw& q, int c, LAS float* buf) {
                const f32x4 r0 = un4(q.r), k0 = un4(q.k), v0 = un4(q.v);
                const f32x4 rl = r0 + (un4(q.rp) - r0) * mur, kl = k0 + (un4(q.kp) - k0) * muk, vl = v0 + (un4(q.vp) - v0) * muv;
                const f32x4 d = un4(q.d), av = un4(q.a);
                f32x4 wdec; wdec[0] = __expf(-d[0]); wdec[1] = __expf(-d[1]); wdec[2] = __expf(-d[2]); wdec[3] = __expf(-d[3]);
                const f32x4 kkr = kl * k_k; float ss = (kkr[0] * kkr[0] + kkr[1] * kkr[1]) + (kkr[2] * kkr[2] + kkr[3] * kkr[3]); ss = row16_sum(ss);
                const float inv = 1.0f / fmaxf(sqrtf(ss), 1e-12f);
                const f32x4 kk = kkr * inv, kp = kl * (1.0f + (av - 1.0f) * k_a), bb = kk * av;
                float rk = (rl[0] * kp[0] * rkw[0] + rl[1] * kp[1] * rkw[1]) + (rl[2] * kp[2] * rkw[2] + rl[3] * kp[3] * rkw[3]); rk = row16_sum(rk);
                const int o = tok * 64 + 4 * cgp;
                *(LAS f32x4*)(buf + o) = -kk; *(LAS f32x4*)(buf + 1024 + o) = wdec; *(LAS f32x4*)(buf + 2048 + o) = bb; *(LAS f32x4*)(buf + 3072 + o) = kp; *(LAS f32x4*)(buf + 4096 + o) = rl;
                if ((cgp >> 2) == vq) *(LAS f32x4*)(buf + 5120 + tok * 16 + 4 * (cgp & 3)) = vl;
                if (vq == 0 && cgp == 0) RK[((size_t)b * SEQ + c * SC_CH + tok) * 16 + h] = rk; };
            auto flush = [&](int c, const LAS float* yb) {
                if (wave == 4) { const int t2 = lane >> 2, rq = lane & 3; const f32x4 y = *(const LAS f32x4*)(yb + t2 * 16 + 4 * rq);
                    u32x2 wv; wv.x = pk2(y[0], y[1]); wv.y = pk2(y[2], y[3]);
                    *(u32x2*)(YAB + ((size_t)b * SEQ + c * SC_CH + t2) * 2048 + 1024 + h * 64 + 16 * vq + 4 * rq) = wv; } };
            ScanRaw q0 = load(0), q1 = load(1);
            process(q0, 0, bufs); q0 = q1; q1 = load(2);
            __syncthreads();
            for (int c = 0; c < NCH; ++c) {
                if (c + 1 < NCH) process(q0, c + 1, bufs + ((c + 1) & 1) * SC_BUF_F);
                q0 = q1; if (c + 3 < NCH) q1 = load(c + 3);
                if (c >= 1) flush(c - 1, ybuf + ((c - 1) & 1) * 256);
                __syncthreads();
            }
            flush(NCH - 1, ybuf + ((NCH - 1) & 1) * 256);
        } else {
            const int rw = lane >> 4, ks = lane & 15, row = wave * 4 + rw;
            float s0 = 0.f, s1 = 0.f, s2 = 0.f, s3 = 0.f;
            __syncthreads();
            for (int c = 0; c < NCH; ++c) {
                const LAS float* buf = bufs + (c & 1) * SC_BUF_F; LAS float* yb = ybuf + (c & 1) * 256;
#pragma unroll
                for (int t = 0; t < SC_CH; ++t) {
                    const f32x4 nk = *(const LAS f32x4*)(buf + t * 64 + 4 * ks), w4 = *(const LAS f32x4*)(buf + 1024 + t * 64 + 4 * ks), b4 = *(const LAS f32x4*)(buf + 2048 + t * 64 + 4 * ks);
                    const f32x4 kp = *(const LAS f32x4*)(buf + 3072 + t * 64 + 4 * ks), r4 = *(const LAS f32x4*)(buf + 4096 + t * 64 + 4 * ks); const float vv = buf[5120 + t * 16 + row];
                    float sa = (s0 * nk[0] + s1 * nk[1]) + (s2 * nk[2] + s3 * nk[3]); sa = row16_sum(sa);
                    s0 = s0 * w4[0] + (sa * b4[0] + vv * kp[0]); s1 = s1 * w4[1] + (sa * b4[1] + vv * kp[1]);
                    s2 = s2 * w4[2] + (sa * b4[2] + vv * kp[2]); s3 = s3 * w4[3] + (sa * b4[3] + vv * kp[3]);
                    float y = (s0 * r4[0] + s1 * r4[1]) + (s2 * r4[2] + s3 * r4[3]); y = row16_sum(y);
                    if (ks == 0) yb[t * 16 + row] = y;
                }
                __syncthreads();
            }
        }
    }
}

__device__ __forceinline__ void post_phase(const Args& a, const int wave) {
    const int lane = lane_id(), tid = wave * 64 + lane;
    const int gw = blockIdx.x * NWAVES + wave, NGW = gridDim.x * NWAVES;
    const bf16_t* Vg = (const bf16_t*)(a.ws + WS_V); const bf16_t* BG = (const bf16_t*)((unsigned char*)a.out + DO_BG); const float* RK = (const float*)((unsigned char*)a.out + DO_RK);
    bf16_t* YAB = (bf16_t*)(a.ws + WS_YAB);
    const int head = lane >> 2, c0 = head * 64 + 16 * (lane & 3);
    f32x4 muv[4], lw[4], lb[4];
#pragma unroll
    for (int j = 0; j < 4; ++j) { muv[j] = *(const f32x4*)(a.mu_rkv + 2 * DM + c0 + 4 * j); lw[j] = *(const f32x4*)(a.rwkv_vec + 4 * DM + c0 + 4 * j); lb[j] = *(const f32x4*)(a.rwkv_vec + 5 * DM + c0 + 4 * j); }
    auto un4 = [](unsigned x, unsigned y) { return (f32x4){bflo(x), bfhi(x), bflo(y), bfhi(y)}; };
    for (int m = gw; m < MTOK; m += NGW) { const int s = m & (SEQ - 1);
        bf16_t* yp = YAB + (size_t)m * 2048 + 1024 + c0;
        const u32x4 ya = *(const u32x4*)yp, yb2 = *(const u32x4*)(yp + 8);
        const u32x4 va = *(const u32x4*)(Vg + (size_t)m * DM + c0), vb = *(const u32x4*)(Vg + (size_t)m * DM + c0 + 8);
        u32x4 pa = (u32x4){0u, 0u, 0u, 0u}, pb = pa; if (s > 0) { pa = *(const u32x4*)(Vg + (size_t)(m - 1) * DM + c0); pb = *(const u32x4*)(Vg + (size_t)(m - 1) * DM + c0 + 8); }
        const u32x4 ga = *(const u32x4*)(BG + (size_t)m * DM + c0), gb = *(const u32x4*)(BG + (size_t)m * DM + c0 + 8);
        const float rk = RK[(size_t)m * 16 + head];
        f32x4 y[4] = {un4(ya.x, ya.y), un4(ya.z, ya.w), un4(yb2.x, yb2.y), un4(yb2.z, yb2.w)};
        const f32x4 v[4] = {un4(va.x, va.y), un4(va.z, va.w), un4(vb.x, vb.y), un4(vb.z, vb.w)};
        const f32x4 p[4] = {un4(pa.x, pa.y), un4(pa.z, pa.w), un4(pb.x, pb.y), un4(pb.z, pb.w)};
        const f32x4 g[4] = {un4(ga.x, ga.y), un4(ga.z, ga.w), un4(gb.x, gb.y), un4(gb.z, gb.w)};
        float sm = 0.f;
#pragma unroll
        for (int j = 0; j < 4; ++j) sm += (y[j][0] + y[j][1]) + (y[j][2] + y[j][3]);
        const float mean = quad_sum(sm) * (1.0f / 64.0f); float q = 0.f;
#pragma unroll
        for (int j = 0; j < 4; ++j) { y[j] = y[j] - mean; q += (y[j][0] * y[j][0] + y[j][1] * y[j][1]) + (y[j][2] * y[j][2] + y[j][3] * y[j][3]); }
        const float rstd = rsqrtf(quad_sum(q) * (1.0f / 64.0f) + 64e-5f);
        u32x4 o[2];
#pragma unroll
        for (int j = 0; j < 4; ++j) { const f32x4 vl = v[j] + (p[j] - v[j]) * muv[j]; const f32x4 r = (y[j] * rstd * lw[j] + lb[j] + rk * vl) * g[j];
            if (j & 1) { o[j >> 1].z = pk2(r[0], r[1]); o[j >> 1].w = pk2(r[2], r[3]); } else { o[j >> 1].x = pk2(r[0], r[1]); o[j >> 1].y = pk2(r[2], r[3]); } }
        *(u32x4*)yp = o[0]; *(u32x4*)(yp + 8) = o[1];
    }
}

constexpr int CS_L = 32, CS_NCH = SEQ / CS_L, CS_NSLOT = 3;
constexpr int CS_NT = 0, CS_RT = 4096, CS_BT = 8192, CS_KT = 12288, CS_TM = 8192, CS_AKN = 10240, CS_ABR = 12288, CS_AKR = 14336, CS_BC = 16384, CS_KC = 20480, CS_VC = 24576, CS_GL = 28672, CS_SLOT = 29184;
constexpr int CS_RAW = CS_NSLOT * CS_SLOT, CS_RAWSZ = 5 * 33 * 128;
constexpr int CS_FLAGS = CS_RAW + CS_NSLOT * CS_RAWSZ;
static_assert(CS_FLAGS + 64 <= LDS_BYTES && (CS_RAW % 16) == 0 && (CS_RAWSZ % 16) == 0, "chunked scan LDS map");
__device__ __forceinline__ int permp(int j) { return 8 * ((j & 15) >> 2) + 4 * (j >> 4) + (j & 3); }
template <int CTRL, int RM> __device__ __forceinline__ float dppf(float x) { return __int_as_float(__builtin_amdgcn_update_dpp(0, __float_as_int(x), CTRL, RM, 0xf, true)); }
__device__ __forceinline__ float wave_total(float x) {
    x = row16_sum(x); x += dppf<0x142, 0xa>(x); x += dppf<0x143, 0xc>(x); return __int_as_float(__builtin_amdgcn_readlane(__float_as_int(x), 63)); }
__device__ __forceinline__ float wave_sum64(float x) { x = row16_sum(x); x += __shfl_xor(x, 16); x += __shfl_xor(x, 32); return x; }
__device__ __forceinline__ bf16x8 cfrag(const f32x16& x, int s) {
    u32x4 w; w.x = pk2(x[8 * s + 0], x[8 * s + 1]); w.y = pk2(x[8 * s + 2], x[8 * s + 3]); w.z = pk2(x[8 * s + 4], x[8 * s + 5]); w.w = pk2(x[8 * s + 6], x[8 * s + 7]); return __builtin_bit_cast(bf16x8, w); }
__device__ __forceinline__ bf16x8 cfrag2(const f32x4& a, const f32x4& b) { u32x4 w; w.x = pk2(a[0], a[1]); w.y = pk2(a[2], a[3]); w.z = pk2(b[0], b[1]); w.w = pk2(b[2], b[3]); return __builtin_bit_cast(bf16x8, w); }
__device__ __forceinline__ void lds_poll_ge(LAS unsigned* p, unsigned want) { while (__hip_atomic_load(p, __ATOMIC_RELAXED, __HIP_MEMORY_SCOPE_WORKGROUP) < want) __builtin_amdgcn_s_sleep(1); asm volatile("" ::: "memory"); }

__device__ __forceinline__ void cscan_job(const Args& a, const int wave, LAS unsigned char* lds, int bh) {
    int lane; asm volatile("v_mbcnt_lo_u32_b32 %0, -1, 0\n\tv_mbcnt_hi_u32_b32 %0, -1, %0" : "=v"(lane));
    const int tid = wave * 64 + lane;
    const int b = bh >> 4, h = bh & 15;
    const bf16_t* Rg = (const bf16_t*)(a.ws + WS_R); const bf16_t* Kg = (const bf16_t*)(a.ws + WS_K); const bf16_t* Vg = (const bf16_t*)(a.ws + WS_V);
    const bf16_t* Dg = (const bf16_t*)(a.ws + WS_DARR); const bf16_t* Ag = (const bf16_t*)(a.ws + WS_AARR);
    bf16_t* YAB = (bf16_t*)(a.ws + WS_YAB); float* RK = (float*)((unsigned char*)a.out + DO_RK);
    LAS unsigned* ready = (LAS unsigned*)(lds + CS_FLAGS); LAS unsigned* done = ready + CS_NSLOT; LAS unsigned* rawready = done + CS_NSLOT; LAS unsigned* rawfree = rawready + CS_NSLOT;
    __syncthreads();
    if (tid < 4 * CS_NSLOT) ready[tid] = 0u;
    __syncthreads();
    if (wave == 4) {
        const int rr = lane >> 3, cc = lane & 7;
        for (int c = 0; c < CS_NCH; ++c) {
            const int s = c % CS_NSLOT; LAS unsigned char* rw = lds + CS_RAW + s * CS_RAWSZ;
            const size_t m0 = (size_t)b * SEQ + (size_t)c * CS_L;
            u32x4 v[5][4], vp[3];
#pragma unroll
            for (int ar = 0; ar < 5; ++ar) { const bf16_t* src = (ar == 0) ? Rg : (ar == 1) ? Kg : (ar == 2) ? Vg : (ar == 3) ? Dg : Ag;
#pragma unroll
                for (int q4 = 0; q4 < 4; ++q4) v[ar][q4] = *(const u32x4*)(src + (m0 + 8 * q4 + rr) * DM + h * 64 + 8 * cc); }
#pragma unroll
            for (int ar = 0; ar < 3; ++ar) { const bf16_t* src = (ar == 0) ? Rg : (ar == 1) ? Kg : Vg; vp[ar] = (u32x4){0u, 0u, 0u, 0u};
                if (c > 0 && lane < 8) vp[ar] = *(const u32x4*)(src + (m0 - 1) * DM + h * 64 + 8 * cc); }
            if (c >= CS_NSLOT) lds_poll_ge(rawfree + s, (unsigned)(c / CS_NSLOT));
#pragma unroll
            for (int ar = 0; ar < 5; ++ar)
#pragma unroll
                for (int q4 = 0; q4 < 4; ++q4) *(LAS u32x4*)(rw + (ar * 33 + 1 + 8 * q4 + rr) * 128 + 16 * cc) = v[ar][q4];
            if (lane < 8) {
#pragma unroll
                for (int ar = 0; ar < 3; ++ar) *(LAS u32x4*)(rw + (ar * 33) * 128 + 16 * cc) = vp[ar]; }
            LDS_WAIT();
            if (lane == 0) __hip_atomic_store(rawready + s, (unsigned)(c + 1), __ATOMIC_RELAXED, __HIP_MEMORY_SCOPE_WORKGROUP);
        }
    } else if (wave >= 5) {
        const int hw = wave - 5, gch = h * 64 + lane;
        const float mur = a.mu_rkv[gch], muk = a.mu_rkv[DM + gch], muv = a.mu_rkv[2 * DM + gch], kkw = a.rwkv_vec[2 * DM + gch], kaw = a.rwkv_vec[3 * DM + gch], rkw = a.r_k[gch];
        const int kpos = 32 * (lane >> 5) + permp(lane & 31);
        for (int c = hw; c < CS_NCH; c += CS_NSLOT) {
            const int s = hw; LAS unsigned char* sl = lds + s * CS_SLOT; const LAS unsigned short* rw = (const LAS unsigned short*)(lds + CS_RAW + s * CS_RAWSZ);
            const unsigned use = (unsigned)(c / CS_NSLOT);
            { PROBE_BEGIN(10, a.ws, wave);
            if (use > 0u) lds_poll_ge(done + s, 4u * use);
            lds_poll_ge(rawready + s, (unsigned)(c + 1));
            PROBE_END(10, a.ws, wave); }
            PROBE_BEGIN(11, a.ws, wave);
            const size_t m0 = (size_t)b * SEQ + (size_t)c * CS_L; const size_t o0 = m0 * DM + gch;
            float rp = bflo((unsigned)rw[(0 * 33) * 64 + lane]), kp = bflo((unsigned)rw[(1 * 33) * 64 + lane]), vp = bflo((unsigned)rw[(2 * 33) * 64 + lane]);
            float cum = 0.f, gprev = 1.f;
            unsigned bcw[16], kcw[16], vcw[16];
#pragma unroll
            for (int grp = 0; grp < 4; ++grp) {
                float rlv[8], kkrv[8], kprv[8], vlv[8], aav[8], ddv[8], red[16];
#pragma unroll
                for (int e = 0; e < 8; ++e) { const int row = 1 + 8 * grp + e;
                    const float r0 = bflo((unsigned)rw[(0 * 33 + row) * 64 + lane]), k0 = bflo((unsigned)rw[(1 * 33 + row) * 64 + lane]), v0 = bflo((unsigned)rw[(2 * 33 + row) * 64 + lane]);
                    ddv[e] = bflo((unsigned)rw[(3 * 33 + row) * 64 + lane]); aav[e] = bflo((unsigned)rw[(4 * 33 + row) * 64 + lane]);
                    rlv[e] = r0 + (rp - r0) * mur; const float kl = k0 + (kp - k0) * muk; vlv[e] = v0 + (vp - v0) * muv; rp = r0; kp = k0; vp = v0;
                    kkrv[e] = kl * kkw; kprv[e] = kl * (1.0f + (aav[e] - 1.0f) * kaw);
                    red[2 * e] = kkrv[e] * kkrv[e]; red[2 * e + 1] = rlv[e] * kprv[e] * rkw; }
#pragma unroll
                for (int e = 0; e < 16; ++e) red[e] += dppf<0xB1, 0xf>(red[e]);
#pragma unroll
                for (int e = 0; e < 16; ++e) red[e] += dppf<0x4E, 0xf>(red[e]);
#pragma unroll
                for (int e = 0; e < 16; ++e) red[e] += dppf<0x141, 0xf>(red[e]);
#pragma unroll
                for (int e = 0; e < 16; ++e) red[e] += dppf<0x140, 0xf>(red[e]);
#pragma unroll
                for (int e = 0; e < 16; ++e) red[e] += dppf<0x142, 0xa>(red[e]);
#pragma unroll
                for (int e = 0; e < 16; ++e) red[e] += dppf<0x143, 0xc>(red[e]);
#pragma unroll
                for (int e = 0; e < 16; ++e) red[e] = __int_as_float(__builtin_amdgcn_readlane(__float_as_int(red[e]), 63));
                if (lane < 8) { float rkv = red[1];
#pragma unroll
                    for (int e = 1; e < 8; ++e) rkv = (lane == e) ? red[2 * e + 1] : rkv;
                    RK[(m0 + 8 * grp + lane) * 16 + h] = rkv; }
#pragma unroll
                for (int j2 = 0; j2 < 4; ++j2) {
                    const int i2 = 4 * grp + j2;
                    float nt[2], bt[2], kt[2], rt[2], vt[2];
#pragma unroll
                    for (int e = 0; e < 2; ++e) { const int te = 2 * j2 + e;
                        const float kkv = kkrv[te] * __builtin_amdgcn_rsqf(fmaxf(red[2 * te], 1e-24f)), bb = kkv * aav[te];
                        cum += ddv[te]; const float gi = __expf(-cum), ginv = __builtin_amdgcn_rcpf(gi);
                        nt[e] = -kkv * gprev; bt[e] = bb * ginv; kt[e] = kprv[te] * ginv; rt[e] = rlv[te] * gi; vt[e] = vlv[te]; gprev = gi; }
                    const unsigned wn = pk2(nt[0], nt[1]), wb = pk2(bt[0], bt[1]), wk = pk2(kt[0], kt[1]), wr = pk2(rt[0], rt[1]), wv = pk2(vt[0], vt[1]);
                    const int i = 2 * i2;
                    *(LAS unsigned short*)(sl + CS_NT + (i * 64 + kpos) * 2) = (unsigned short)wn; *(LAS unsigned short*)(sl + CS_NT + ((i + 1) * 64 + kpos) * 2) = (unsigned short)(wn >> 16);
                    *(LAS unsigned short*)(sl + CS_RT + (i * 64 + kpos) * 2) = (unsigned short)wr; *(LAS unsigned short*)(sl + CS_RT + ((i + 1) * 64 + kpos) * 2) = (unsigned short)(wr >> 16);
                    *(LAS unsigned short*)(sl + CS_BT + (i * 64 + kpos) * 2) = (unsigned short)wb; *(LAS unsigned short*)(sl + CS_BT + ((i + 1) * 64 + kpos) * 2) = (unsigned short)(wb >> 16);
                    *(LAS unsigned short*)(sl + CS_KT + (i * 64 + kpos) * 2) = (unsigned short)wk; *(LAS unsigned short*)(sl + CS_KT + ((i + 1) * 64 + kpos) * 2) = (unsigned short)(wk >> 16);
                    const int pw = permp(i) >> 1;
                    bcw[pw] = wb; kcw[pw] = wk; vcw[pw] = wv;
                }
                __builtin_amdgcn_sched_barrier(0);
            }
#pragma unroll
            for (int q4 = 0; q4 < 4; ++q4) {
                *(LAS u32x4*)(sl + CS_BC + lane * 64 + 16 * q4) = (u32x4){bcw[4 * q4], bcw[4 * q4 + 1], bcw[4 * q4 + 2], bcw[4 * q4 + 3]};
                *(LAS u32x4*)(sl + CS_KC + lane * 64 + 16 * q4) = (u32x4){kcw[4 * q4], kcw[4 * q4 + 1], kcw[4 * q4 + 2], kcw[4 * q4 + 3]};
                *(LAS u32x4*)(sl + CS_VC + lane * 64 + 16 * q4) = (u32x4){vcw[4 * q4], vcw[4 * q4 + 1], vcw[4 * q4 + 2], vcw[4 * q4 + 3]}; }
            *(LAS float*)(sl + CS_GL + lane * 4) = gprev;
            LDS_WAIT();
            if (lane == 0) __hip_atomic_store(rawfree + s, use + 1u, __ATOMIC_RELAXED, __HIP_MEMORY_SCOPE_WORKGROUP);
            PROBE_END(11, a.ws, wave);
            PROBE_BEGIN(12, a.ws, wave);
            const int tok = lane & 31, hf = lane >> 5;
            bf16x8 fn[4], fr[4], fb[4], fk[4];
#pragma unroll
            for (int ks = 0; ks < 4; ++ks) { fn[ks] = *(const LAS bf16x8*)(sl + CS_NT + (tok * 64 + 16 * ks + 8 * hf) * 2); fr[ks] = *(const LAS bf16x8*)(sl + CS_RT + (tok * 64 + 16 * ks + 8 * hf) * 2);
                fb[ks] = *(const LAS bf16x8*)(sl + CS_BT + (tok * 64 + 16 * ks + 8 * hf) * 2); fk[ks] = *(const LAS bf16x8*)(sl + CS_KT + (tok * 64 + 16 * ks + 8 * hf) * 2); }
            f32x16 P, Pt, Tm, Akn, Abr, Akr;
#pragma unroll
            for (int e = 0; e < 16; ++e) { P[e] = 0.f; Pt[e] = 0.f; Akn[e] = 0.f; Abr[e] = 0.f; Akr[e] = 0.f; }
#pragma unroll
            for (int ks = 0; ks < 4; ++ks) { P = __builtin_amdgcn_mfma_f32_32x32x16_bf16(fn[ks], fb[ks], P, 0, 0, 0); Pt = __builtin_amdgcn_mfma_f32_32x32x16_bf16(fb[ks], fn[ks], Pt, 0, 0, 0);
                Akn = __builtin_amdgcn_mfma_f32_32x32x16_bf16(fn[ks], fk[ks], Akn, 0, 0, 0); Abr = __builtin_amdgcn_mfma_f32_32x32x16_bf16(fr[ks], fb[ks], Abr, 0, 0, 0); Akr = __builtin_amdgcn_mfma_f32_32x32x16_bf16(fr[ks], fk[ks], Akr, 0, 0, 0); }
#pragma unroll
            for (int e = 0; e < 16; ++e) { const int row = (e & 3) + 8 * (e >> 2) + 4 * hf, col = tok;
                if (!(col < row)) { P[e] = 0.f; Akn[e] = 0.f; } if (!(row < col)) Pt[e] = 0.f; if (col > row) { Abr[e] = 0.f; Akr[e] = 0.f; }
                Tm[e] = P[e] + (row == col ? 1.0f : 0.f); }
#pragma unroll
            for (int mm = 1; mm <= 4; ++mm) {
                const bf16x8 p0 = cfrag(P, 0), p1 = cfrag(P, 1), q0 = cfrag(Pt, 0), q1 = cfrag(Pt, 1);
                f32x16 Ptn, Pn;
#pragma unroll
                for (int e = 0; e < 16; ++e) { Ptn[e] = 0.f; Pn[e] = 0.f; }
                Ptn = __builtin_amdgcn_mfma_f32_32x32x16_bf16(p0, q0, Ptn, 0, 0, 0); Ptn = __builtin_amdgcn_mfma_f32_32x32x16_bf16(p1, q1, Ptn, 0, 0, 0);
                if (mm < 4) { Pn = __builtin_amdgcn_mfma_f32_32x32x16_bf16(q0, p0, Pn, 0, 0, 0); Pn = __builtin_amdgcn_mfma_f32_32x32x16_bf16(q1, p1, Pn, 0, 0, 0); }
                const bf16x8 t0 = cfrag(Tm, 0), t1 = cfrag(Tm, 1), u0 = cfrag(Ptn, 0), u1 = cfrag(Ptn, 1);
                Tm = __builtin_amdgcn_mfma_f32_32x32x16_bf16(u0, t0, Tm, 0, 0, 0); Tm = __builtin_amdgcn_mfma_f32_32x32x16_bf16(u1, t1, Tm, 0, 0, 0);
                P = Pn; Pt = Ptn;
            }
            { const int pc = permp(tok);
#pragma unroll
              for (int e = 0; e < 16; e += 2) { const int row = (e & 3) + 8 * (e >> 2) + 4 * hf;
                const unsigned w0 = pk2(Tm[e], Tm[e + 1]), w1 = pk2(Akn[e], Akn[e + 1]), w2 = pk2(Abr[e], Abr[e + 1]), w3 = pk2(Akr[e], Akr[e + 1]);
                *(LAS unsigned short*)(sl + CS_TM + (row * 32 + pc) * 2) = (unsigned short)w0; *(LAS unsigned short*)(sl + CS_TM + ((row + 1) * 32 + pc) * 2) = (unsigned short)(w0 >> 16);
                *(LAS unsigned short*)(sl + CS_AKN + (row * 32 + pc) * 2) = (unsigned short)w1; *(LAS unsigned short*)(sl + CS_AKN + ((row + 1) * 32 + pc) * 2) = (unsigned short)(w1 >> 16);
                *(LAS unsigned short*)(sl + CS_ABR + (row * 32 + pc) * 2) = (unsigned short)w2; *(LAS unsigned short*)(sl + CS_ABR + ((row + 1) * 32 + pc) * 2) = (unsigned short)(w2 >> 16);
                *(LAS unsigned short*)(sl + CS_AKR + (row * 32 + pc) * 2) = (unsigned short)w3; *(LAS unsigned short*)(sl + CS_AKR + ((row + 1) * 32 + pc) * 2) = (unsigned short)(w3 >> 16); } }
            LDS_WAIT();
            if (lane == 0) __hip_atomic_store(ready + s, (unsigned)(c + 1), __ATOMIC_RELAXED, __HIP_MEMORY_SCOPE_WORKGROUP);
            PROBE_END(12, a.ws, wave);
        }
    } else {
        const int l15 = lane & 15, g = lane >> 4, vb = wave;
        f32x4 xc[4];
#pragma unroll
        for (int kt = 0; kt < 4; ++kt) xc[kt] = (f32x4){0.f, 0.f, 0.f, 0.f};
        for (int c = 0; c < CS_NCH; ++c) {
            const int s = c % CS_NSLOT; const LAS unsigned char* sl = lds + s * CS_SLOT;
            lds_poll_ge(ready + s, (unsigned)(c + 1));
            const bf16x8 xb0 = cfrag2(xc[0], xc[1]), xb1 = cfrag2(xc[2], xc[3]);
            const bf16x8 vop = *(const LAS bf16x8*)(sl + CS_VC + ((16 * vb + l15) * 32 + 8 * g) * 2);
            f32x4 W[2], U[2], Y[2];
#pragma unroll
            for (int rt = 0; rt < 2; ++rt) { const int row = 16 * rt + l15; f32x4 acc = (f32x4){0.f, 0.f, 0.f, 0.f};
                acc = __builtin_amdgcn_mfma_f32_16x16x32_bf16(*(const LAS bf16x8*)(sl + CS_AKN + (row * 32 + 8 * g) * 2), vop, acc, 0, 0, 0);
                acc = __builtin_amdgcn_mfma_f32_16x16x32_bf16(*(const LAS bf16x8*)(sl + CS_NT + (row * 64 + 8 * g) * 2), xb0, acc, 0, 0, 0);
                acc = __builtin_amdgcn_mfma_f32_16x16x32_bf16(*(const LAS bf16x8*)(sl + CS_NT + (row * 64 + 32 + 8 * g) * 2), xb1, acc, 0, 0, 0);
                W[rt] = acc; }
            const bf16x8 wb = cfrag2(W[0], W[1]);
#pragma unroll
            for (int rt = 0; rt < 2; ++rt) { const int row = 16 * rt + l15;
                U[rt] = __builtin_amdgcn_mfma_f32_16x16x32_bf16(*(const LAS bf16x8*)(sl + CS_TM + (row * 32 + 8 * g) * 2), wb, (f32x4){0.f, 0.f, 0.f, 0.f}, 0, 0, 0); }
            const bf16x8 ub = cfrag2(U[0], U[1]);
#pragma unroll
            for (int rt = 0; rt < 2; ++rt) { const int row = 16 * rt + l15; f32x4 acc = (f32x4){0.f, 0.f, 0.f, 0.f};
                acc = __builtin_amdgcn_mfma_f32_16x16x32_bf16(*(const LAS bf16x8*)(sl + CS_AKR + (row * 32 + 8 * g) * 2), vop, acc, 0, 0, 0);
                acc = __builtin_amdgcn_mfma_f32_16x16x32_bf16(*(const LAS bf16x8*)(sl + CS_RT + (row * 64 + 8 * g) * 2), xb0, acc, 0, 0, 0);
                acc = __builtin_amdgcn_mfma_f32_16x16x32_bf16(*(const LAS bf16x8*)(sl + CS_RT + (row * 64 + 32 + 8 * g) * 2), xb1, acc, 0, 0, 0);
                acc = __builtin_amdgcn_mfma_f32_16x16x32_bf16(*(const LAS bf16x8*)(sl + CS_ABR + (row * 32 + 8 * g) * 2), ub, acc, 0, 0, 0);
                Y[rt] = acc; }
#pragma unroll
            for (int kt = 0; kt < 4; ++kt) { const int row = 16 * kt + l15; f32x4 acc = xc[kt];
                acc = __builtin_amdgcn_mfma_f32_16x16x32_bf16(*(const LAS bf16x8*)(sl + CS_KC + (row * 32 + 8 * g) * 2), vop, acc, 0, 0, 0);
                acc = __builtin_amdgcn_mfma_f32_16x16x32_bf16(*(const LAS bf16x8*)(sl + CS_BC + (row * 32 + 8 * g) * 2), ub, acc, 0, 0, 0);
                xc[kt] = acc * *(const LAS f32x4*)(sl + CS_GL + (16 * kt + 4 * g) * 4); }
            LDS_WAIT();
            if (lane == 0) (void)__hip_atomic_fetch_add(done + s, 1u, __ATOMIC_RELAXED, __HIP_MEMORY_SCOPE_WORKGROUP);
#pragma unroll
            for (int rt = 0; rt < 2; ++rt)
#pragma unroll
                for (int e = 0; e < 4; ++e) { const size_t m = (size_t)b * SEQ + (size_t)c * CS_L + 16 * rt + 4 * g + e;
                    YAB[m * 2048 + 1024 + h * 64 + 16 * vb + l15] = (bf16_t)(pk2(Y[rt][e], 0.f) & 0xffffu); }
        }
    }
}

constexpr int CR_PIECE = 12, CR_NP = (CS_NCH + CR_PIECE - 1) / CR_PIECE, CR_PW = 4, CR_PSLOT = CS_SLOT + 2 * 33 * 128;
constexpr size_t DO_IMG = 66 * MiB;
static_assert((CR_PIECE % 4) == 0 && DO_IMG + (size_t)2 * 64 * CR_PIECE * CS_SLOT <= 128 * MiB && CR_PW * CR_PSLOT <= CS_FLAGS, "image buffer / producer slots");

__device__ __forceinline__ void cscan_produce(const Args& a, const int wave, LAS unsigned char* lds, const int piece, const int first, const int nblk) {
    const int nch = (CS_NCH - piece * CR_PIECE) < CR_PIECE ? (CS_NCH - piece * CR_PIECE) : CR_PIECE;
    if (wave >= CR_PW) {
        const int lane = lane_id(); const int iw = ((int)blockIdx.x - first) * (NWAVES - CR_PW) + (wave - CR_PW), niw = nblk * (NWAVES - CR_PW);
        for (int t = piece * 2 * niw + iw; t < (piece + 1) * 2 * niw && t < MTOK; t += niw) rope_item(a, t, lane);
        return; }
    const bf16_t* Rg = (const bf16_t*)(a.ws + WS_R); const bf16_t* Kg = (const bf16_t*)(a.ws + WS_K); const bf16_t* Vg = (const bf16_t*)(a.ws + WS_V);
    const bf16_t* Dg = (const bf16_t*)(a.ws + WS_DARR); const bf16_t* Ag = (const bf16_t*)(a.ws + WS_AARR);
    float* RK = (float*)((unsigned char*)a.out + DO_RK); unsigned char* IMG = (unsigned char*)a.out + DO_IMG + (size_t)(piece & 1) * 64 * CR_PIECE * CS_SLOT;
    LAS unsigned char* sl = lds + wave * CR_PSLOT;
    const LAS unsigned short* rawD = (const LAS unsigned short*)(sl + 16384); const LAS unsigned short* rawA = (const LAS unsigned short*)(sl + 20480);
    const LAS unsigned short* rawR = (const LAS unsigned short*)(sl + 24576); const LAS unsigned short* rawK = (const LAS unsigned short*)(sl + CS_SLOT); const LAS unsigned short* rawV = (const LAS unsigned short*)(sl + CS_SLOT + 33 * 128);
    u32x4 pre[5][4], prep[3];
    auto issue = [&](int it2, int rr, int c8, int lane) { const int bh2 = it2 / nch, cc2 = it2 % nch, c2 = piece * CR_PIECE + cc2; const unsigned mm = (unsigned)(bh2 >> 4) * SEQ + (unsigned)c2 * CS_L; const int hh = bh2 & 15;
        const unsigned eoff = ((mm + rr) * DM + hh * 64 + 8 * c8) * 2u;
        const unsigned char* wsb = a.ws;
#pragma unroll
        for (int ar = 0; ar < 5; ++ar) { constexpr size_t AOFF[5] = {WS_R, WS_K, WS_V, WS_DARR, WS_AARR};
#pragma unroll
            for (int q4 = 0; q4 < 4; ++q4) pre[ar][q4] = *(const u32x4*)(wsb + AOFF[ar] + eoff + (unsigned)(8 * q4 * DM * 2)); }
        const bool hasp = (c2 > 0) && (lane < 8); const unsigned poff = hasp ? (eoff - (unsigned)((rr + 1) * DM * 2)) : eoff;
#pragma unroll
        for (int ar = 0; ar < 3; ++ar) { constexpr size_t AOFF[3] = {WS_R, WS_K, WS_V}; const u32x4 t = *(const u32x4*)(wsb + AOFF[ar] + poff); prep[ar] = hasp ? t : (u32x4){0u, 0u, 0u, 0u}; } };
    const int it0 = ((int)blockIdx.x - first) * CR_PW + wave, nimg = 64 * nch, itstep = nblk * CR_PW;
    { const int l0 = lane_id(); if (it0 < nimg) issue(it0, l0 >> 3, l0 & 7, l0); }
    for (int it = it0; it < nimg; it += itstep) {
        const int lane = lane_id(), rr = lane >> 3, c8 = lane & 7, kpos = 32 * (lane >> 5) + permp(lane & 31);
        const int bh = it / nch, cc = it % nch, b = bh >> 4, h = bh & 15, c = piece * CR_PIECE + cc, gch = h * 64 + lane;
        const float mur = a.mu_rkv[gch], muk = a.mu_rkv[DM + gch], muv = a.mu_rkv[2 * DM + gch], kkw = a.rwkv_vec[2 * DM + gch], kaw = a.rwkv_vec[3 * DM + gch], rkw = a.r_k[gch];
            const size_t m0 = (size_t)b * SEQ + (size_t)c * CS_L;
            { LAS unsigned char* wb = sl + rr * 128 + 16 * c8; asm volatile("" : "+v"(wb));
#pragma unroll
              for (int q4 = 0; q4 < 4; ++q4) {
                *(LAS u32x4*)(wb + 24576 + (8 * q4 + 1) * 128) = pre[0][q4]; *(LAS u32x4*)(wb + CS_SLOT + (8 * q4 + 1) * 128) = pre[1][q4]; *(LAS u32x4*)(wb + CS_SLOT + 33 * 128 + (8 * q4 + 1) * 128) = pre[2][q4];
                *(LAS u32x4*)(wb + 16384 + (8 * q4) * 128) = pre[3][q4]; *(LAS u32x4*)(wb + 20480 + (8 * q4) * 128) = pre[4][q4]; }
              if (lane < 8) { *(LAS u32x4*)(wb + 24576) = prep[0]; *(LAS u32x4*)(wb + CS_SLOT) = prep[1]; *(LAS u32x4*)(wb + CS_SLOT + 33 * 128) = prep[2]; } }
            LDS_WAIT();
            const LAS unsigned short* rb = (const LAS unsigned short*)sl + lane; asm volatile("" : "+v"(rb));
            float rp = bflo((unsigned)rb[24576 / 2]), kp = bflo((unsigned)rb[CS_SLOT / 2]), vp = bflo((unsigned)rb[(CS_SLOT + 33 * 128) / 2]);
            float cum = 0.f, gprev = 1.f;
            unsigned bcw[16], kcw[16], vcw[16];
#pragma unroll
            for (int grp = 0; grp < 4; ++grp) {
                float rlv[8], kkrv[8], kprv[8], vlv[8], aav[8], ddv[8], red[16];
#pragma unroll
                for (int e = 0; e < 8; ++e) { const int row = 8 * grp + e;
                    const float r0 = bflo((unsigned)rb[24576 / 2 + (row + 1) * 64]), k0 = bflo((unsigned)rb[CS_SLOT / 2 + (row + 1) * 64]), v0 = bflo((unsigned)rb[(CS_SLOT + 33 * 128) / 2 + (row + 1) * 64]);
                    ddv[e] = bflo((unsigned)rb[16384 / 2 + row * 64]); aav[e] = bflo((unsigned)rb[20480 / 2 + row * 64]);
                    rlv[e] = r0 + (rp - r0) * mur; const float kl = k0 + (kp - k0) * muk; vlv[e] = v0 + (vp - v0) * muv; rp = r0; kp = k0; vp = v0;
                    kkrv[e] = kl * kkw; kprv[e] = kl * (1.0f + (aav[e] - 1.0f) * kaw);
                    red[2 * e] = kkrv[e] * kkrv[e]; red[2 * e + 1] = rlv[e] * kprv[e] * rkw; }
#pragma unroll
                for (int e = 0; e < 16; ++e) red[e] += dppf<0xB1, 0xf>(red[e]);
#pragma unroll
                for (int e = 0; e < 16; ++e) red[e] += dppf<0x4E, 0xf>(red[e]);
#pragma unroll
                for (int e = 0; e < 16; ++e) red[e] += dppf<0x141, 0xf>(red[e]);
#pragma unroll
                for (int e = 0; e < 16; ++e) red[e] += dppf<0x140, 0xf>(red[e]);
#pragma unroll
                for (int e = 0; e < 16; ++e) red[e] += dppf<0x142, 0xa>(red[e]);
#pragma unroll
                for (int e = 0; e < 16; ++e) red[e] += dppf<0x143, 0xc>(red[e]);
#pragma unroll
                for (int e = 0; e < 16; ++e) red[e] = __int_as_float(__builtin_amdgcn_readlane(__float_as_int(red[e]), 63));
                if (lane < 8) { float rkv = red[1];
#pragma unroll
                    for (int e = 1; e < 8; ++e) rkv = (lane == e) ? red[2 * e + 1] : rkv;
                    RK[(m0 + 8 * grp + lane) * 16 + h] = rkv; }
#pragma unroll
                for (int j2 = 0; j2 < 4; ++j2) {
                    const int i2 = 4 * grp + j2;
                    float nt[2], bt[2], kt[2], rt[2], vt[2];
#pragma unroll
                    for (int e = 0; e < 2; ++e) { const int te = 2 * j2 + e;
                        const float kkv = kkrv[te] * __builtin_amdgcn_rsqf(fmaxf(red[2 * te], 1e-24f)), bb = kkv * aav[te];
                        cum += ddv[te]; const float gi = __expf(-cum), ginv = __builtin_amdgcn_rcpf(gi);
                        nt[e] = -kkv * gprev; bt[e] = bb * ginv; kt[e] = kprv[te] * ginv; rt[e] = rlv[te] * gi; vt[e] = vlv[te]; gprev = gi; }
                    const unsigned wn = pk2(nt[0], nt[1]), wb = pk2(bt[0], bt[1]), wk = pk2(kt[0], kt[1]), wr = pk2(rt[0], rt[1]), wv = pk2(vt[0], vt[1]);
                    const int i = 2 * i2;
                    *(LAS unsigned short*)(sl + CS_NT + (i * 64 + kpos) * 2) = (unsigned short)wn; *(LAS unsigned short*)(sl + CS_NT + ((i + 1) * 64 + kpos) * 2) = (unsigned short)(wn >> 16);
                    *(LAS unsigned short*)(sl + CS_RT + (i * 64 + kpos) * 2) = (unsigned short)wr; *(LAS unsigned short*)(sl + CS_RT + ((i + 1) * 64 + kpos) * 2) = (unsigned short)(wr >> 16);
                    *(LAS unsigned short*)(sl + CS_BT + (i * 64 + kpos) * 2) = (unsigned short)wb; *(LAS unsigned short*)(sl + CS_BT + ((i + 1) * 64 + kpos) * 2) = (unsigned short)(wb >> 16);
                    *(LAS unsigned short*)(sl + CS_KT + (i * 64 + kpos) * 2) = (unsigned short)wk; *(LAS unsigned short*)(sl + CS_KT + ((i + 1) * 64 + kpos) * 2) = (unsigned short)(wk >> 16);
                    const int pw = permp(i) >> 1;
                    bcw[pw] = wb; kcw[pw] = wk; vcw[pw] = wv;
                }
                __builtin_amdgcn_sched_barrier(0);
            }
#pragma unroll
            for (int q4 = 0; q4 < 4; ++q4) {
                *(LAS u32x4*)(sl + CS_BC + lane * 64 + 16 * q4) = (u32x4){bcw[4 * q4], bcw[4 * q4 + 1], bcw[4 * q4 + 2], bcw[4 * q4 + 3]};
                *(LAS u32x4*)(sl + CS_KC + lane * 64 + 16 * q4) = (u32x4){kcw[4 * q4], kcw[4 * q4 + 1], kcw[4 * q4 + 2], kcw[4 * q4 + 3]};
                *(LAS u32x4*)(sl + CS_VC + lane * 64 + 16 * q4) = (u32x4){vcw[4 * q4], vcw[4 * q4 + 1], vcw[4 * q4 + 2], vcw[4 * q4 + 3]}; }
            *(LAS float*)(sl + CS_GL + lane * 4) = gprev;
            LDS_WAIT();
            const int tok = lane & 31, hf = lane >> 5;
            bf16x8 fn[4], fr[4], fb[4], fk[4];
#pragma unroll
            for (int ks = 0; ks < 4; ++ks) { fn[ks] = *(const LAS bf16x8*)(sl + CS_NT + (tok * 64 + 16 * ks + 8 * hf) * 2); fr[ks] = *(const LAS bf16x8*)(sl + CS_RT + (tok * 64 + 16 * ks + 8 * hf) * 2);
                fb[ks] = *(const LAS bf16x8*)(sl + CS_BT + (tok * 64 + 16 * ks + 8 * hf) * 2); fk[ks] = *(const LAS bf16x8*)(sl + CS_KT + (tok * 64 + 16 * ks + 8 * hf) * 2); }
            f32x16 P, Pt, Tm, Akn, Abr, Akr;
#pragma unroll
            for (int e = 0; e < 16; ++e) { P[e] = 0.f; Pt[e] = 0.f; Akn[e] = 0.f; Abr[e] = 0.f; Akr[e] = 0.f; }
#pragma unroll
            for (int ks = 0; ks < 4; ++ks) { P = __builtin_amdgcn_mfma_f32_32x32x16_bf16(fn[ks], fb[ks], P, 0, 0, 0); Pt = __builtin_amdgcn_mfma_f32_32x32x16_bf16(fb[ks], fn[ks], Pt, 0, 0, 0);
                Akn = __builtin_amdgcn_mfma_f32_32x32x16_bf16(fn[ks], fk[ks], Akn, 0, 0, 0); Abr = __builtin_amdgcn_mfma_f32_32x32x16_bf16(fr[ks], fb[ks], Abr, 0, 0, 0); Akr = __builtin_amdgcn_mfma_f32_32x32x16_bf16(fr[ks], fk[ks], Akr, 0, 0, 0); }
#pragma unroll
            for (int e = 0; e < 16; ++e) { const int row = (e & 3) + 8 * (e >> 2) + 4 * hf, col = tok;
                if (!(col < row)) { P[e] = 0.f; Akn[e] = 0.f; } if (!(row < col)) Pt[e] = 0.f; if (col > row) { Abr[e] = 0.f; Akr[e] = 0.f; }
                Tm[e] = P[e] + (row == col ? 1.0f : 0.f); }
#pragma unroll
            for (int mm = 1; mm <= 4; ++mm) {
                const bf16x8 p0 = cfrag(P, 0), p1 = cfrag(P, 1), q0 = cfrag(Pt, 0), q1 = cfrag(Pt, 1);
                f32x16 Ptn, Pn;
#pragma unroll
                for (int e = 0; e < 16; ++e) { Ptn[e] = 0.f; Pn[e] = 0.f; }
                Ptn = __builtin_amdgcn_mfma_f32_32x32x16_bf16(p0, q0, Ptn, 0, 0, 0); Ptn = __builtin_amdgcn_mfma_f32_32x32x16_bf16(p1, q1, Ptn, 0, 0, 0);
                if (mm < 4) { Pn = __builtin_amdgcn_mfma_f32_32x32x16_bf16(q0, p0, Pn, 0, 0, 0); Pn = __builtin_amdgcn_mfma_f32_32x32x16_bf16(q1, p1, Pn, 0, 0, 0); }
                const bf16x8 t0 = cfrag(Tm, 0), t1 = cfrag(Tm, 1), u0 = cfrag(Ptn, 0), u1 = cfrag(Ptn, 1);
                Tm = __builtin_amdgcn_mfma_f32_32x32x16_bf16(u0, t0, Tm, 0, 0, 0); Tm = __builtin_amdgcn_mfma_f32_32x32x16_bf16(u1, t1, Tm, 0, 0, 0);
                P = Pn; Pt = Ptn;
            }
            { const int itn = it + itstep; if (itn < nimg) { const int l2 = lane_id(); issue(itn, l2 >> 3, l2 & 7, l2); } }
            { const int pc = permp(tok);
#pragma unroll
              for (int e = 0; e < 16; e += 2) { const int row = (e & 3) + 8 * (e >> 2) + 4 * hf;
                const unsigned w0 = pk2(Tm[e], Tm[e + 1]), w1 = pk2(Akn[e], Akn[e + 1]), w2 = pk2(Abr[e], Abr[e + 1]), w3 = pk2(Akr[e], Akr[e + 1]);
                *(LAS unsigned short*)(sl + CS_TM + (row * 32 + pc) * 2) = (unsigned short)w0; *(LAS unsigned short*)(sl + CS_TM + ((row + 1) * 32 + pc) * 2) = (unsigned short)(w0 >> 16);
                *(LAS unsigned short*)(sl + CS_AKN + (row * 32 + pc) * 2) = (unsigned short)w1; *(LAS unsigned short*)(sl + CS_AKN + ((row + 1) * 32 + pc) * 2) = (unsigned short)(w1 >> 16);
                *(LAS unsigned short*)(sl + CS_ABR + (row * 32 + pc) * 2) = (unsigned short)w2; *(LAS unsigned short*)(sl + CS_ABR + ((row + 1) * 32 + pc) * 2) = (unsigned short)(w2 >> 16);
                *(LAS unsigned short*)(sl + CS_AKR + (row * 32 + pc) * 2) = (unsigned short)w3; *(LAS unsigned short*)(sl + CS_AKR + ((row + 1) * 32 + pc) * 2) = (unsigned short)(w3 >> 16); } }
            LDS_WAIT();
            { unsigned char* dst = IMG + (size_t)(bh * CR_PIECE + cc) * CS_SLOT;
#pragma unroll 1
              for (int j = lane; j < CS_SLOT / 16; j += 64) *(u32x4*)(dst + 16 * j) = *(const LAS u32x4*)(sl + 16 * j); }
            LDS_WAIT();
    }
}

__device__ __forceinline__ void cscan_consume(const Args& a, const int wave, LAS unsigned char* lds, const int bh, const int piece, f32x4 (&xc)[4]) {
    const int lane = lane_id();
    const int b = bh >> 4, h = bh & 15;
    bf16_t* YAB = (bf16_t*)(a.ws + WS_YAB); const unsigned char* IMG = (const unsigned char*)a.out + DO_IMG + (size_t)(piece & 1) * 64 * CR_PIECE * CS_SLOT;
    const int nch = (CS_NCH - piece * CR_PIECE) < CR_PIECE ? (CS_NCH - piece * CR_PIECE) : CR_PIECE;
    LAS unsigned* ready = (LAS unsigned*)(lds + CS_FLAGS); LAS unsigned* done = ready + 4;
    if (wave == 4) {
        constexpr int NI = (CS_SLOT + 1023) / 1024;
        for (int cc = 0; cc <= nch; ++cc) {
            if (cc < nch) { const int c = piece * CR_PIECE + cc, s = cc & 3; LAS unsigned char* sl = lds + s * CS_SLOT;
                const unsigned char* src = IMG + (size_t)(bh * CR_PIECE + cc) * CS_SLOT;
                if (c >= 4) lds_poll_ge(done + s, 4u * (unsigned)(c >> 2));
#pragma unroll
                for (int j = 0; j < NI; ++j) { const int idx = lane + 64 * j;
                    if (idx < CS_SLOT / 16) __builtin_amdgcn_global_load_lds((const unsigned*)(src + 16 * idx), (LAS unsigned*)(sl + 1024 * j), 16, 0, 0); } }
            if (cc >= 1) {
                if (cc < nch) asm volatile("s_waitcnt vmcnt(29)" ::: "memory"); else asm volatile("s_waitcnt vmcnt(0)" ::: "memory");
                if (lane == 0) __hip_atomic_store(ready + ((cc - 1) & 3), (unsigned)(piece * CR_PIECE + cc), __ATOMIC_RELAXED, __HIP_MEMORY_SCOPE_WORKGROUP); }
        }
    } else if (wave < 4) {
        const int l15 = lane & 15, g = lane >> 4, vb = wave;
        for (int cc = 0; cc < nch; ++cc) { const int c = piece * CR_PIECE + cc, s = cc & 3; const LAS unsigned char* sl = lds + s * CS_SLOT;
            { lds_poll_ge(ready + s, (unsigned)(c + 1)); }
            const bf16x8 xb0 = cfrag2(xc[0], xc[1]), xb1 = cfrag2(xc[2], xc[3]);
            const bf16x8 vop = *(const LAS bf16x8*)(sl + CS_VC + ((16 * vb + l15) * 32 + 8 * g) * 2);
            f32x4 W[2], U[2], Y[2];
#pragma unroll
            for (int rt = 0; rt < 2; ++rt) { const int row = 16 * rt + l15; f32x4 acc = (f32x4){0.f, 0.f, 0.f, 0.f};
                acc = __builtin_amdgcn_mfma_f32_16x16x32_bf16(*(const LAS bf16x8*)(sl + CS_AKN + (row * 32 + 8 * g) * 2), vop, acc, 0, 0, 0);
                acc = __builtin_amdgcn_mfma_f32_16x16x32_bf16(*(const LAS bf16x8*)(sl + CS_NT + (row * 64 + 8 * g) * 2), xb0, acc, 0, 0, 0);
                acc = __builtin_amdgcn_mfma_f32_16x16x32_bf16(*(const LAS bf16x8*)(sl + CS_NT + (row * 64 + 32 + 8 * g) * 2), xb1, acc, 0, 0, 0);
                W[rt] = acc; }
            const bf16x8 wb = cfrag2(W[0], W[1]);
#pragma unroll
            for (int rt = 0; rt < 2; ++rt) { const int row = 16 * rt + l15;
                U[rt] = __builtin_amdgcn_mfma_f32_16x16x32_bf16(*(const LAS bf16x8*)(sl + CS_TM + (row * 32 + 8 * g) * 2), wb, (f32x4){0.f, 0.f, 0.f, 0.f}, 0, 0, 0); }
            const bf16x8 ub = cfrag2(U[0], U[1]);
#pragma unroll
            for (int rt = 0; rt < 2; ++rt) { const int row = 16 * rt + l15; f32x4 acc = (f32x4){0.f, 0.f, 0.f, 0.f};
                acc = __builtin_amdgcn_mfma_f32_16x16x32_bf16(*(const LAS bf16x8*)(sl + CS_AKR + (row * 32 + 8 * g) * 2), vop, acc, 0, 0, 0);
                acc = __builtin_amdgcn_mfma_f32_16x16x32_bf16(*(const LAS bf16x8*)(sl + CS_RT + (row * 64 + 8 * g) * 2), xb0, acc, 0, 0, 0);
                acc = __builtin_amdgcn_mfma_f32_16x16x32_bf16(*(const LAS bf16x8*)(sl + CS_RT + (row * 64 + 32 + 8 * g) * 2), xb1, acc, 0, 0, 0);
                acc = __builtin_amdgcn_mfma_f32_16x16x32_bf16(*(const LAS bf16x8*)(sl + CS_ABR + (row * 32 + 8 * g) * 2), ub, acc, 0, 0, 0);
                Y[rt] = acc; }
#pragma unroll
            for (int kt = 0; kt < 4; ++kt) { const int row = 16 * kt + l15; f32x4 acc = xc[kt];
                acc = __builtin_amdgcn_mfma_f32_16x16x32_bf16(*(const LAS bf16x8*)(sl + CS_KC + (row * 32 + 8 * g) * 2), vop, acc, 0, 0, 0);
                acc = __builtin_amdgcn_mfma_f32_16x16x32_bf16(*(const LAS bf16x8*)(sl + CS_BC + (row * 32 + 8 * g) * 2), ub, acc, 0, 0, 0);
                xc[kt] = acc * *(const LAS f32x4*)(sl + CS_GL + (16 * kt + 4 * g) * 4); }
            LDS_WAIT();
            if (lane == 0) (void)__hip_atomic_fetch_add(done + s, 1u, __ATOMIC_RELAXED, __HIP_MEMORY_SCOPE_WORKGROUP);
#pragma unroll
            for (int rt = 0; rt < 2; ++rt)
#pragma unroll
                for (int e = 0; e < 4; ++e) { const size_t m = (size_t)b * SEQ + (size_t)c * CS_L + 16 * rt + 4 * g + e;
                    YAB[m * 2048 + 1024 + h * 64 + 16 * vb + l15] = (bf16_t)(pk2(Y[rt][e], 0.f) & 0xffffu); }
        }
    }
}

constexpr int DS_NQ = 16, DS_CAP = 2048, DS_TRIG = 1536, DS_TOPK = 256;
constexpr int DS_HIST_WORDS = 320;
constexpr int DS_KT_BYTES = 2048;
constexpr int DS_CAND_OFF = 0, DS_HIST_OFF = DS_NQ * DS_CAP * 4, DS_KT_OFF = DS_HIST_OFF, DS_CNT_OFF = DS_HIST_OFF + 8 * DS_KT_BYTES, DS_TAU_OFF = DS_CNT_OFF + 64;
static_assert(8 * DS_HIST_WORDS * 4 <= 8 * DS_KT_BYTES, "dsa LDS map");
static_assert(DS_TAU_OFF + 64 <= LDS_BYTES, "dsa LDS map");

template <int CTRL, int RM> __device__ __forceinline__ unsigned dppu(unsigned x) { return (unsigned)__builtin_amdgcn_update_dpp(0, (int)x, CTRL, RM, 0xf, true); }
__device__ __forceinline__ unsigned wave_scan_incl(unsigned v) {
    v += dppu<0x111, 0xf>(v); v += dppu<0x112, 0xf>(v); v += dppu<0x114, 0xf>(v); v += dppu<0x118, 0xf>(v);
    v += dppu<0x142, 0xa>(v);
    v += dppu<0x143, 0xc>(v);
    return v; }
template <int NE>
__device__ __forceinline__ void select_compact(LAS unsigned* cq, LAS unsigned* cntq, LAS unsigned* tauq, LAS unsigned* hist, int lane) {
    const unsigned n = *cntq;
    unsigned e[NE];
#pragma unroll
    for (int j = 0; j < NE; ++j) { const unsigned idx = lane + 64 * j; e[j] = idx < n ? cq[idx] : 0u; }
    unsigned npos = 0u;
#pragma unroll
    for (int j = 0; j < NE; ++j) npos += (unsigned)__popcll(__ballot(e[j] >= 0x80000000u));
    if (npos >= (unsigned)DS_TOPK) {
#pragma unroll
        for (int j = 0; j < NE; ++j) e[j] = (e[j] >= 0x80000000u) ? e[j] : 0u; }
    unsigned va = 0xFFFFFFFFu, vo = 0u;
#pragma unroll
    for (int j = 0; j < NE; ++j) { va &= (e[j] != 0u) ? e[j] : 0xFFFFFFFFu; vo |= e[j]; }
    va &= (unsigned)__builtin_amdgcn_update_dpp(-1, (int)va, 0xB1, 0xf, 0xf, true); va &= (unsigned)__builtin_amdgcn_update_dpp(-1, (int)va, 0x4E, 0xf, 0xf, true);
    va &= (unsigned)__builtin_amdgcn_update_dpp(-1, (int)va, 0x141, 0xf, 0xf, true); va &= (unsigned)__builtin_amdgcn_update_dpp(-1, (int)va, 0x140, 0xf, 0xf, true);
    vo |= dppu<0xB1, 0xf>(vo); vo |= dppu<0x4E, 0xf>(vo); vo |= dppu<0x141, 0xf>(vo); vo |= dppu<0x140, 0xf>(vo);
    const unsigned vas = (unsigned)(__builtin_amdgcn_readlane((int)va, 0) & __builtin_amdgcn_readlane((int)va, 16) & __builtin_amdgcn_readlane((int)va, 32) & __builtin_amdgcn_readlane((int)va, 48));
    const unsigned vos = (unsigned)(__builtin_amdgcn_readlane((int)vo, 0) | __builtin_amdgcn_readlane((int)vo, 16) | __builtin_amdgcn_readlane((int)vo, 32) | __builtin_amdgcn_readlane((int)vo, 48));
    const unsigned diff = vas ^ vos;
    const int top = diff ? 31 - __builtin_clz(diff) : 7;
    unsigned prefix = (top >= 31) ? 0u : (vos & ~((2u << top) - 1u)), mask = (top >= 31) ? 0u : ~((2u << top) - 1u), need = DS_TOPK;
    int hi = top;
    const int rl = 63 - lane;
#pragma unroll 1
    for (int pass = 0; pass < 4 && hi >= 0; ++pass) {
        const int shift = hi >= 7 ? hi - 7 : 0; const unsigned dmask = (hi >= 7) ? 0xFFu : ((2u << hi) - 1u);
        *(LAS u32x4*)(hist + 4 * lane) = (u32x4){0u, 0u, 0u, 0u};
        LDS_WAIT();
#pragma unroll
        for (int j = 0; j < NE; ++j) { const bool hit = (e[j] != 0u) && ((e[j] & mask) == prefix); const unsigned bin = hit ? ((e[j] >> shift) & dmask) : (256u + (unsigned)lane);
            (void)__hip_atomic_fetch_add(hist + bin, 1u, __ATOMIC_RELAXED, __HIP_MEMORY_SCOPE_WORKGROUP); }
        LDS_WAIT();
        const u32x4 h4 = *(const LAS u32x4*)(hist + 4 * rl);
        const unsigned tot = (h4.x + h4.y) + (h4.z + h4.w);
        const unsigned v = wave_scan_incl(tot);
        const unsigned above = v - tot;
        const bool is = (above < need) && (need <= v);
        unsigned B = 0u, ca = 0u;
        if (is) { unsigned c = above;
            if (c + h4.w >= need) { B = 4 * rl + 3; ca = c; } else { c += h4.w;
            if (c + h4.z >= need) { B = 4 * rl + 2; ca = c; } else { c += h4.z;
            if (c + h4.y >= need) { B = 4 * rl + 1; ca = c; } else { c += h4.y; B = 4 * rl; ca = c; } } } }
        const unsigned long long bal = __ballot(is);
        if (bal == 0ull) break;
        const int src = __builtin_amdgcn_readfirstlane(__ffsll((long long)bal) - 1);
        B = (unsigned)__builtin_amdgcn_readlane((int)B, src); ca = (unsigned)__builtin_amdgcn_readlane((int)ca, src);
        need -= ca; prefix |= B << shift; mask |= dmask << shift; hi = shift - 1;
    }
    const unsigned T = prefix;
    unsigned base = 0u;
#pragma unroll
    for (int j = 0; j < NE; ++j) { const bool keep = (e[j] >= T) && (e[j] != 0u); const unsigned long long bal = __ballot(keep);
        const unsigned pos = base + __builtin_amdgcn_mbcnt_hi((unsigned)(bal >> 32), __builtin_amdgcn_mbcnt_lo((unsigned)bal, 0u));
        if (keep) cq[pos] = e[j];
        base += (unsigned)__popcll(bal); }
    if (lane == 0) { *cntq = base; *tauq = T; }
    LDS_WAIT();
}

template <int NE>
__device__ __forceinline__ void filter_compact(LAS unsigned* cq, LAS unsigned* cntq, LAS unsigned* tauq, int lane) {
    const unsigned n = *cntq;
    unsigned e[NE];
#pragma unroll
    for (int j = 0; j < NE; ++j) { const unsigned idx = lane + 64 * j; e[j] = idx < n ? cq[idx] : 0u; }
    unsigned m0 = 0u, m1 = 0u, m2 = 0u, m3 = 0u;
#pragma unroll
    for (int j = 0; j < NE; ++j) { unsigned x = e[j], t;
        t = max(m0, x); x = min(m0, x); m0 = t; t = max(m1, x); x = min(m1, x); m1 = t; t = max(m2, x); x = min(m2, x); m2 = t; m3 = max(m3, x); }
    unsigned T = m3;
    T = min(T, (unsigned)__builtin_amdgcn_update_dpp(-1, (int)T, 0xB1, 0xf, 0xf, true)); T = min(T, (unsigned)__builtin_amdgcn_update_dpp(-1, (int)T, 0x4E, 0xf, 0xf, true));
    T = min(T, (unsigned)__builtin_amdgcn_update_dpp(-1, (int)T, 0x141, 0xf, 0xf, true)); T = min(T, (unsigned)__builtin_amdgcn_update_dpp(-1, (int)T, 0x140, 0xf, 0xf, true));
    T = min(min((unsigned)__builtin_amdgcn_readlane((int)T, 0), (unsigned)__builtin_amdgcn_readlane((int)T, 16)), min((unsigned)__builtin_amdgcn_readlane((int)T, 32), (unsigned)__builtin_amdgcn_readlane((int)T, 48)));
    unsigned base = 0u;
#pragma unroll
    for (int j = 0; j < NE; ++j) { const bool keep = (e[j] >= T) && (e[j] != 0u); const unsigned long long bal = __ballot(keep);
        const unsigned pos = base + __builtin_amdgcn_mbcnt_hi((unsigned)(bal >> 32), __builtin_amdgcn_mbcnt_lo((unsigned)bal, 0u));
        if (keep) cq[pos] = e[j];
        base += (unsigned)__popcll(bal); }
    if (lane == 0) { *cntq = base; *tauq = (T > 0u) ? T - 1u : 0u; }
    LDS_WAIT();
}

__device__ __forceinline__ float relu_(float x) { return __int_as_float(max(__float_as_int(x), 0)); }
__device__ __forceinline__ unsigned vrow_off(int pr) { return (unsigned)(pr < 28 ? 1024 + 256 * pr : 9216 + 256 * (pr - 28)); }
__device__ __forceinline__ unsigned swz_b(int row) { return (unsigned)(((row & 3) << 2) | ((row >> 2) & 3)); }

__device__ __forceinline__ void dsa_phase(const Args& a, const int wave, LAS unsigned char* lds, const bool dry = false) {
    const bf16_t* Qg = (const bf16_t*)(a.ws + WS_Q); const bf16_t* KVg = (const bf16_t*)(a.ws + WS_KV); const bf16_t* QIg = (const bf16_t*)(a.ws + WS_QI);
    const bf16_t* KIg = (const bf16_t*)(a.ws + WS_KI); const float* WIg = (const float*)(a.ws + WS_WI); bf16_t* Gg = (bf16_t*)(a.ws + WS_G);
    LAS unsigned* cand = (LAS unsigned*)(lds + DS_CAND_OFF); LAS unsigned* hist = (LAS unsigned*)(lds + DS_HIST_OFF) + wave * DS_HIST_WORDS;
    LAS unsigned* cnt = (LAS unsigned*)(lds + DS_CNT_OFF); LAS unsigned* taup = (LAS unsigned*)(lds + DS_TAU_OFF);
    for (int L = blockIdx.x; L < 2048; L += gridDim.x) {
        int lane; asm volatile("v_mbcnt_lo_u32_b32 %0, -1, 0\n\tv_mbcnt_hi_u32_b32 %0, -1, %0" : "=v"(lane));
        const int tid = wave * 64 + lane, ql = lane & 15, gq = lane >> 4;
        int b, j;
        if (gridDim.x == 256) { const int i = blockIdx.x, ui = L >> 8, x = i & 7, li = (i >> 3) * 2 + (x >> 2); b = x & 3; j = 128 * (ui >> 1) + ((ui & 1) ? 127 - li : li); }
        else { b = L >> 9; j = L & 511; }
        const unsigned mb = (unsigned)b * SEQ; const int q0 = DS_NQ * j; const unsigned mq = mb + q0 + ql;
        const int pos0 = a.pos[mb]; int nadm = ((a.pos[mq] >> 6) + 1) * 64 - pos0; nadm = nadm > SEQ ? SEQ : nadm;
        int nmax = ((a.pos[mb + q0 + DS_NQ - 1] >> 6) + 1) * 64 - pos0; nmax = nmax > SEQ ? SEQ : nmax;
        const int nstep = (nmax + 511) >> 9;
#ifdef DSA_REP_STREAM
        for (int srep_ = 0; srep_ < 2; ++srep_) { const bool sdry = (srep_ == 0) && a.ph_hi > 0;
#ifndef DSA_DRYMODE
#define DSA_DRYMODE 0
#endif
#else
        const bool sdry = false;
#define DSA_DRYMODE 0
#endif
        __syncthreads();
        if (tid < DS_NQ) { cnt[tid] = 0u; taup[tid] = 0u; }
        bf16x8 bq[8][2];
#pragma unroll
        for (int h = 0; h < 8; ++h)
#pragma unroll
            for (int ks = 0; ks < 2; ++ks) bq[h][ks] = *(const bf16x8*)(QIg + (mq * 512u + h * 64 + 32 * ks + 8 * gq));
        f32x2 wh[8]; { const f32x4 w0 = *(const f32x4*)(WIg + mq * 8), w1 = *(const f32x4*)(WIg + mq * 8 + 4);
#pragma unroll
            for (int h = 0; h < 4; ++h) { wh[h] = (f32x2){w0[h], w0[h]}; wh[4 + h] = (f32x2){w1[h], w1[h]}; } }
        __syncthreads();
        u32x4 ka[8];
        const unsigned ktb = (unsigned)(size_t)(lds + DS_KT_OFF) + (unsigned)wave * DS_KT_BYTES;
        { unsigned ko = (mb + 64 * wave) * 64u + 8u * lane, ko1 = ko + 2048u;
          asm volatile("" : "+v"(ko), "+v"(ko1));
#pragma unroll
          for (int j8 = 0; j8 < 8; ++j8) ka[j8] = *(const u32x4*)(KIg + ((j8 & 4) ? ko1 : ko) + (j8 & 3) * 512); }
        for (int step = 0; step <= nstep; ++step) {
            const int kb = 512 * step + 64 * wave; const bool active = (kb < nmax) && (step < nstep);
            PROBE_BEGIN(2, a.ws, wave);
            if (active) {
                f32x2 sc2[8];
#pragma unroll
                for (int i = 0; i < 8; ++i) sc2[i] = (f32x2){0.f, 0.f};
                const int ln = lane_id();
                const unsigned kw0 = ktb + (unsigned)(ln >> 3) * 128u + (unsigned)(((ln & 7) ^ (ln >> 4)) << 4);
                const unsigned kr0 = ktb + (unsigned)(ln & 15) * 128u + (unsigned)(((ln >> 4) ^ ((ln & 15) >> 1)) << 4);
                const int kbn = (kb + 512 < SEQ) ? kb + 512 : kb; unsigned ko = (mb + kbn) * 64u + 8u * ln, ko1 = ko + 2048u;
                asm volatile("" : "+v"(ko), "+v"(ko1));
#pragma unroll
                for (int st = 0; st < 4; ++st) {
                    *(LAS u32x4*)(size_t)kw0 = ka[2 * st]; *(LAS u32x4*)(size_t)(kw0 ^ 1088u) = ka[2 * st + 1];
                    LDS_WAIT();
                    if (!(sdry && (DSA_DRYMODE & 1))) {
                        ka[2 * st] = *(const u32x4*)(KIg + ((st & 2) ? ko1 : ko) + (2 * st & 3) * 512); ka[2 * st + 1] = *(const u32x4*)(KIg + ((st & 2) ? ko1 : ko) + ((2 * st + 1) & 3) * 512); }
                    const bf16x8 af0 = *(const LAS bf16x8*)(size_t)kr0, af1 = *(const LAS bf16x8*)(size_t)(kr0 ^ 64u);
#pragma unroll
                    for (int h = 0; h < 8; ++h) { f32x4 acc = (f32x4){0.f, 0.f, 0.f, 0.f};
                        acc = __builtin_amdgcn_mfma_f32_16x16x32_bf16(af0, bq[h][0], acc, 0, 0, 0); acc = __builtin_amdgcn_mfma_f32_16x16x32_bf16(af1, bq[h][1], acc, 0, 0, 0);
                        sc2[2 * st] += wh[h] * (f32x2){relu_(acc[0]), relu_(acc[1])}; sc2[2 * st + 1] += wh[h] * (f32x2){relu_(acc[2]), relu_(acc[3])}; }
                    __builtin_amdgcn_sched_barrier(0);
                }
                float sc[16];
#pragma unroll
                for (int i = 0; i < 8; ++i) { sc[2 * i] = sc2[i][0]; sc[2 * i + 1] = sc2[i][1]; }
                __builtin_amdgcn_sched_barrier(0);
                const unsigned tp = taup[ql]; unsigned pm = 0u;
#pragma unroll
                for (int i = 0; i < 16; ++i) { const int key = kb + 16 * (i >> 2) + 4 * gq + (i & 3); const unsigned u = __float_as_uint(sc[i]);
                    const unsigned ord = (u & 0x80000000u) ? ~u : (u | 0x80000000u); const unsigned pk = (ord & 0xFFFFE000u) | (unsigned)key;
                    sc[i] = __uint_as_float(pk);
                    if (key < nadm && pk > tp) pm |= 1u << i; }
                if (sdry && (DSA_DRYMODE & 2)) pm = 0u;
                const unsigned n = (unsigned)__popc(pm);
                unsigned k = 0u; if (n) k = __hip_atomic_fetch_add(cnt + ql, n, __ATOMIC_RELAXED, __HIP_MEMORY_SCOPE_WORKGROUP);
                LAS unsigned* cq = cand + ql * DS_CAP;
#pragma unroll
                for (int i = 0; i < 16; ++i) if (pm & (1u << i)) { cq[k] = __float_as_uint(sc[i]); ++k; }
            }
            __syncthreads();
            PROBE_END(2, a.ws, wave);
            const u32x4 c0 = *(const LAS u32x4*)(cnt), c1 = *(const LAS u32x4*)(cnt + 4), c2 = *(const LAS u32x4*)(cnt + 8), c3 = *(const LAS u32x4*)(cnt + 12);
            unsigned cm = max(max(max(c0.x, c0.y), max(c0.z, c0.w)), max(max(c1.x, c1.y), max(c1.z, c1.w)));
            cm = max(cm, max(max(max(c2.x, c2.y), max(c2.z, c2.w)), max(max(c3.x, c3.y), max(c3.z, c3.w))));
            const unsigned trig = (step == nstep) ? (unsigned)DS_TOPK : (unsigned)DS_TRIG;
#ifdef DSA_SEL2
            const int nsel = (step == nstep) ? 4 : 2;
#else
            const int nsel = 2;
#endif
            if (cm > trig) {
                PROBE_BEGIN(1, a.ws, wave);
#pragma unroll 1
                for (int qq = 0; qq < nsel; ++qq) { const int q = 2 * wave + (qq & 1); if (cnt[q] > trig || qq >= 2) {
                    if (step != nstep) filter_compact<32>(cand + q * DS_CAP, cnt + q, taup + q, lane);
                    if (step == nstep || cnt[q] > (unsigned)DS_TRIG) select_compact<32>(cand + q * DS_CAP, cnt + q, taup + q, hist, lane); } }
                __syncthreads();
                PROBE_END(1, a.ws, wave);
            }
        }
#ifdef DSA_REP_STREAM
        }
#endif
        const bf16_t* KVb = KVg + (size_t)mb * 256;
        int lane_a = lane; asm volatile("" : "+v"(lane_a));
        const int g16 = lane_a >> 4, l15 = lane_a & 15;
        const unsigned vbase = (unsigned)(size_t)(lds + DS_CAND_OFF) + (unsigned)wave * 16384u;
        unsigned ta0, ta1;
        { const int q = l15 >> 2, p = lane_a & 3; const int pr0 = 8 * g16 + q, pr1 = pr0 + 4;
          ta0 = vbase + vrow_off(pr0) + 16u * ((unsigned)(p >> 1) ^ swz_b(pr0)) + 8u * (unsigned)(p & 1);
          ta1 = vbase + vrow_off(pr1) + 16u * ((unsigned)(p >> 1) ^ swz_b(pr1)) + 8u * (unsigned)(p & 1); }
        const unsigned kwa = vbase + 10240u + (unsigned)(4 * g16) * 256u + (unsigned)((l15 ^ (4 * g16)) << 4);
        const unsigned kra = vbase + 10240u + (unsigned)l15 * 256u + (unsigned)((g16 ^ l15) << 4);
        const unsigned owa = vbase + 10240u + (unsigned)l15 * 256u + (unsigned)((g16 ^ l15) << 4);
        const unsigned ora = vbase + 10240u + (unsigned)(lane_a >> 3) * 256u + (unsigned)(((2 * (lane_a & 7)) ^ (lane_a >> 3)) << 4);
        unsigned vwa[8];
#pragma unroll
        for (int j2 = 0; j2 < 8; ++j2) { const int srow = 4 * j2 + g16; const int pr = (srow < 16) ? 8 * (srow >> 2) + (srow & 3) : 8 * ((srow - 16) >> 2) + 4 + (srow & 3);
            vwa[j2] = vbase + vrow_off(pr) + 16u * ((unsigned)l15 ^ swz_b(pr)); }
#ifdef DSA_REP_ATT
        for (int arep_ = 0; arep_ < 2; ++arep_) { const bool dry2 = dry || (arep_ == 0 && a.ph_hi > 0);
#else
        { const bool dry2 = dry;
#endif
        u32x4 qr[4];
#pragma unroll
        for (int i = 0; i < 4; ++i) qr[i] = *(const u32x4*)(Qg + ((mb + q0 + 2 * wave) * 2048u + (unsigned)(4 * g16 + i) * 128u + 8u * l15));
#pragma unroll 1
        for (int qq = 0; qq < 2; ++qq) {
            const int q = 2 * wave + qq; const unsigned m = mb + q0 + q; const int n = (int)cnt[q]; const LAS unsigned* cq = cand + q * DS_CAP;
            bf16x8 qb[4];
            {
#pragma unroll
              for (int i = 0; i < 4; ++i) *(LAS u32x4*)(size_t)(kwa ^ (unsigned)((i << 8) | (i << 4))) = qr[i];
              LDS_WAIT();
              if (qq == 0) {
#pragma unroll
                for (int i = 0; i < 4; ++i) qr[i] = *(const u32x4*)(Qg + ((m + 1u) * 2048u + (unsigned)(4 * g16 + i) * 128u + 8u * l15)); }
#pragma unroll
              for (int ks = 0; ks < 4; ++ks) qb[ks] = *(const LAS bf16x8*)(size_t)(kra ^ (unsigned)(ks << 6));
              LDS_WAIT(); }
            f32x4 sacc[16];
            const int nl = n - l15; const LAS unsigned* cql = cq + l15;
            u32x4 kr[5][4];
            auto kload = [&](int jt, u32x4 (&dst)[4]) { const u32x4 e4 = *(const LAS u32x4*)(cq + 16 * jt + 4 * g16);
#pragma unroll
                for (int i = 0; i < 4; ++i) dst[i] = *(const u32x4*)(KVb + ((e4[i] & 0x1FFFu) * 256u + 8u * l15)); };
            kload(0, kr[0]); kload(1, kr[1]); kload(2, kr[2]); kload(3, kr[3]);
#pragma unroll
            for (int i = 0; i < 4; ++i) *(LAS u32x4*)(size_t)(kwa ^ (unsigned)((i << 8) | (i << 4))) = kr[0][i];
#pragma unroll
            for (int jt = 0; jt < 16; ++jt) {
                if (jt + 4 < 16) kload(jt + 4, kr[(jt + 4) % 5]);
                bf16x8 fa[4];
#pragma unroll
                for (int ks = 0; ks < 4; ++ks) fa[ks] = *(const LAS bf16x8*)(size_t)(kra ^ (unsigned)(ks << 6));
                if (jt + 1 < 16) {
#pragma unroll
                    for (int i = 0; i < 4; ++i) *(LAS u32x4*)(size_t)(kwa ^ (unsigned)((i << 8) | (i << 4))) = kr[(jt + 1) % 5][i]; }
                f32x4 acc = (f32x4){0.f, 0.f, 0.f, 0.f};
#pragma unroll
                for (int ks = 0; ks < 4; ++ks) acc = __builtin_amdgcn_mfma_f32_16x16x32_bf16(fa[ks], qb[ks], acc, 0, 0, 0);
                sacc[jt] = acc;
            }
            u32x4 vr[2][8]; const int ng = n - g16; const LAS unsigned* cqg = cq + g16;
            auto vload = [&](int kk, u32x4 (&dst)[8]) {
#pragma unroll
                for (int j2 = 0; j2 < 8; ++j2) { const int sl = 32 * kk + 4 * j2; const unsigned e = cqg[sl]; const unsigned key = (sl < ng) ? (e & 0x1FFFu) : 0u;
                    dst[j2] = *(const u32x4*)(KVb + (key * 256u + 128u + 8u * l15)); } };
            vload(0, vr[0]); vload(1, vr[1]);
            __builtin_amdgcn_sched_barrier(0);
            float mx = -1e30f; const float nnf = (float)(n - 4 * g16 - 1);
#pragma unroll
            for (int jt = 0; jt < 16; ++jt)
#pragma unroll
                for (int r = 0; r < 4; ++r) { sacc[jt][r] = fmaf(fminf(nnf - (float)(16 * jt + r), 0.f), 1e30f, sacc[jt][r]); mx = fmaxf(mx, sacc[jt][r]); }
            mx = fmaxf(mx, __shfl_xor(mx, 16)); mx = fmaxf(mx, __shfl_xor(mx, 32));
            float sum = 0.f;
#pragma unroll
            for (int jt = 0; jt < 16; ++jt)
#pragma unroll
                for (int r = 0; r < 4; ++r) { const float p = __builtin_amdgcn_exp2f(sacc[jt][r] - mx); sacc[jt][r] = p; sum += p; }
            sum += __shfl_xor(sum, 16); sum += __shfl_xor(sum, 32);
            u32x4 pfr[8];
#pragma unroll
            for (int kk = 0; kk < 8; ++kk) { const f32x4 pa = sacc[2 * kk], pb2 = sacc[2 * kk + 1];
                pfr[kk].x = pk2(pa[0], pa[1]); pfr[kk].y = pk2(pa[2], pa[3]); pfr[kk].z = pk2(pb2[0], pb2[1]); pfr[kk].w = pk2(pb2[2], pb2[3]); }
            __builtin_amdgcn_sched_barrier(0);
            f32x4 o[8];
#pragma unroll
            for (int c = 0; c < 8; ++c) o[c] = (f32x4){0.f, 0.f, 0.f, 0.f};
            bf16_t* gqp = Gg + m * 2048u; u32x4 gwv[2][2];
#pragma unroll
            for (int p = 0; p < 2; ++p)
#pragma unroll
                for (int i = 0; i < 2; ++i) gwv[p][i] = *(const u32x4*)(gqp + ((8 * i + (lane_a >> 3)) * 128 + 64 * p + 8 * (lane_a & 7)));
#pragma unroll
            for (int kk = 0; kk < 8; ++kk) {
#pragma unroll
                for (int j2 = 0; j2 < 8; ++j2) *(LAS u32x4*)(size_t)vwa[j2] = vr[kk & 1][j2];
                __builtin_amdgcn_sched_barrier(0);
                if (kk + 2 < 8) vload(kk + 2, vr[kk & 1]);
                LDS_WAIT();
                const bf16x8 pfrag = __builtin_bit_cast(bf16x8, pfr[kk]);
#pragma unroll
                for (int ch = 0; ch < 2; ++ch) {
                    s16x4 t0[4], t1[4];
                    asm volatile("ds_read_b64_tr_b16 %0, %8\n\tds_read_b64_tr_b16 %1, %9\n\tds_read_b64_tr_b16 %2, %10\n\tds_read_b64_tr_b16 %3, %11\n\t"
                                 "ds_read_b64_tr_b16 %4, %12\n\tds_read_b64_tr_b16 %5, %13\n\tds_read_b64_tr_b16 %6, %14\n\tds_read_b64_tr_b16 %7, %15\n\ts_waitcnt lgkmcnt(0)"
                                 : "=&v"(t0[0]), "=&v"(t0[1]), "=&v"(t0[2]), "=&v"(t0[3]), "=&v"(t1[0]), "=&v"(t1[1]), "=&v"(t1[2]), "=&v"(t1[3])
                                 : "v"(ta0 ^ (unsigned)((4 * ch + 0) << 5)), "v"(ta0 ^ (unsigned)((4 * ch + 1) << 5)), "v"(ta0 ^ (unsigned)((4 * ch + 2) << 5)), "v"(ta0 ^ (unsigned)((4 * ch + 3) << 5)),
                                   "v"(ta1 ^ (unsigned)((4 * ch + 0) << 5)), "v"(ta1 ^ (unsigned)((4 * ch + 1) << 5)), "v"(ta1 ^ (unsigned)((4 * ch + 2) << 5)), "v"(ta1 ^ (unsigned)((4 * ch + 3) << 5)) : "memory");
                    __builtin_amdgcn_sched_barrier(0);
#pragma unroll
                    for (int c = 0; c < 4; ++c) { const bf16x8 av = __builtin_shufflevector(t0[c], t1[c], 0, 1, 2, 3, 4, 5, 6, 7);
                        o[4 * ch + c] = __builtin_amdgcn_mfma_f32_16x16x32_bf16(av, pfrag, o[4 * ch + c], 0, 0, 0); }
                }
            }
            const float inv = 1.0f / sum;
#pragma unroll
            for (int p = 0; p < 2; ++p) {
#pragma unroll
                for (int cc = 0; cc < 4; ++cc) *(LAS f32x4*)(size_t)(owa ^ (unsigned)(cc << 6)) = o[4 * p + cc] * inv;
                LDS_WAIT();
#pragma unroll
                for (int i = 0; i < 2; ++i) { bf16_t* gp = gqp + ((8 * i + (lane_a >> 3)) * 128 + 64 * p + 8 * (lane_a & 7)); const u32x4 gw = gwv[p][i];
                    const unsigned ra_ = (ora + 2048u * (unsigned)i) ^ (unsigned)(i << 7);
                    const f32x4 t0 = *(const LAS f32x4*)(size_t)ra_, t1 = *(const LAS f32x4*)(size_t)(ra_ ^ 16u);
                    u32x4 wv; wv.x = pk2(t0[0] * bflo(gw.x), t0[1] * bfhi(gw.x)); wv.y = pk2(t0[2] * bflo(gw.y), t0[3] * bfhi(gw.y));
                    wv.z = pk2(t1[0] * bflo(gw.z), t1[1] * bfhi(gw.z)); wv.w = pk2(t1[2] * bflo(gw.w), t1[3] * bfhi(gw.w));
                    if (!dry2) *(u32x4*)gp = wv; }
                LDS_WAIT();
            }
        }
        }
    }
}

#ifndef OLD_SCAN
#define OLD_SCAN 0
#endif
#ifndef MK_SPLIT
#define MK_SPLIT 0
#endif
#ifndef MK_PH_END
#define MK_PH_END 13
#endif
constexpr int N_PHASES = 13;

#define XB_TMO      128
#define XB_XCNT(j)  (256  + 64 * (j))
#define XB_XSUB(j)  (1280 + 64 * (j))
#define XB_XGEN(j)  (2304 + 64 * (j))
#define XB_TOP      3328
#define XB_TOPGEN   3392
#define XCD_BAR_WORDS 3456
#define XB_SPIN_CAP (1u << 18)

__device__ __forceinline__ unsigned xb_ld(unsigned* p)              { return __hip_atomic_load(p, __ATOMIC_RELAXED, __HIP_MEMORY_SCOPE_AGENT); }
__device__ __forceinline__ unsigned xb_add(unsigned* p, unsigned v) { return __hip_atomic_fetch_add(p, v, __ATOMIC_RELAXED, __HIP_MEMORY_SCOPE_AGENT); }
__device__ __forceinline__ unsigned xb_xcc_id() { return (unsigned)__builtin_amdgcn_s_getreg((3 << 11) | 20) & 0xFu; }
#define XB_SPIN(cond, bar) do { unsigned _sp = 0; while (cond) { __builtin_amdgcn_s_sleep(1); \
    if ((++_sp & 255u) == 0u) { if (xb_ld(&(bar)[XB_TMO])) break; if (_sp > XB_SPIN_CAP) { atomicAdd(&(bar)[XB_TMO], 1u); break; } } } } while (0)

struct XcdBarrier {
    unsigned* bar; unsigned x;
    volatile LAS unsigned* st;
};

__device__ __forceinline__ XcdBarrier xcd_barrier_post(unsigned* bar, volatile LAS unsigned* st, const int wave) {
    XcdBarrier b; b.bar = bar; b.x = xb_xcc_id(); b.st = st;
    if (lane_id() == 0 && wave == 0) (void)xb_add(&bar[XB_XCNT(b.x)], 1u);
    return b;
}
__device__ __forceinline__ void xcd_barrier_complete(unsigned* bar, unsigned x, unsigned& nloc, unsigned& nx) {
    const unsigned G = gridDim.x * gridDim.y * gridDim.z;
    unsigned sum, cnt, mine, sp = 0u;
    for (;;) {
        sum = 0u; cnt = 0u; mine = 0u;
#pragma unroll
        for (unsigned j = 0; j < 16; ++j) { const unsigned c = xb_ld(&bar[XB_XCNT(j)]); sum += c; cnt += (c > 0u) ? 1u : 0u; mine = (j == x) ? c : mine; }
        if (sum == G) break;
        __builtin_amdgcn_s_sleep(1);
        if ((++sp & 255u) == 0u) { if (xb_ld(&bar[XB_TMO])) break; if (sp > XB_SPIN_CAP) { atomicAdd(&bar[XB_TMO], 1u); break; } }
    }
    nloc = mine > 0u ? mine : 1u; nx = cnt > 0u ? cnt : 1u;
}

__device__ __forceinline__ void xcd_barrier(const XcdBarrier& b, const int wave) {
    asm volatile("s_waitcnt vmcnt(0)" ::: "memory");
    __syncthreads();
    if (wave == 0) { if (lane_id() == 0) {
        unsigned* bar = b.bar;
        __builtin_amdgcn_s_waitcnt(0);
        unsigned nloc = b.st[0], nx = b.st[1];
        if (nloc == 0u) { xcd_barrier_complete(bar, b.x, nloc, nx); b.st[0] = nloc; b.st[1] = nx; }
        const unsigned old = xb_add(&bar[XB_XSUB(b.x)], 1u);
        const unsigned gen = old / nloc;
        if (old + 1u == (gen + 1u) * nloc) {
            __builtin_amdgcn_fence(__ATOMIC_RELEASE, "agent");
            asm volatile("s_waitcnt vmcnt(0)" ::: "memory");
            const unsigned og = xb_add(&bar[XB_TOP], 1u);
            const unsigned tg = og / nx;
            if (og + 1u == (tg + 1u) * nx) xb_add(&bar[XB_TOPGEN], 1u);
            else XB_SPIN(xb_ld(&bar[XB_TOPGEN]) == tg, bar);
            __builtin_amdgcn_fence(__ATOMIC_ACQUIRE, "agent");
            xb_add(&bar[XB_XGEN(b.x)], 1u);
            asm volatile("s_waitcnt vmcnt(0)" ::: "memory");
        } else {
            XB_SPIN(xb_ld(&bar[XB_XGEN(b.x)]) == gen, bar);
            __builtin_amdgcn_fence(__ATOMIC_ACQUIRE, "agent");
            asm volatile("s_waitcnt vmcnt(0)" ::: "memory");
        }
    } }
    __syncthreads();
}

#define grid_bar(barptr, epoch, wv) xcd_barrier(xbar, (wv))
typedef const __attribute__((address_space(4))) Args* KArgs;
#if defined(__HIP_DEVICE_COMPILE__)
__device__ __forceinline__ Args kargs() { KArgs p = (KArgs)__builtin_amdgcn_kernarg_segment_ptr(); asm volatile("" : "+s"(p)); return *p; }
#else
__device__ __forceinline__ Args kargs() { return Args{}; }
#endif
#define PHASE_ARGS const Args a = kargs(); unsigned char* ws = a.ws; (void)ws

__global__ void __launch_bounds__(NTHREADS, 2) fwd_megakernel(Args a_by_value) {
    extern __shared__ __attribute__((aligned(16))) unsigned char lds_raw[];
    LAS unsigned char* lds = (LAS unsigned char*)lds_raw;
    cg::grid_group grid = cg::this_grid();
    const int wave = __builtin_amdgcn_readfirstlane((int)threadIdx.x >> 6);
    { volatile LAS unsigned* st0 = (volatile LAS unsigned*)(lds + LDS_BYTES - 16); if (wave == 0 && lane_id() < 4) st0[lane_id()] = 0u; __syncthreads(); }
    const XcdBarrier xbar = xcd_barrier_post((unsigned*)(kargs().ws + WS_BAR), (volatile LAS unsigned*)(lds + LDS_BYTES - 16), wave);
    int lo, hi; { const Args a0 = kargs(); lo = a0.ph_lo; hi = a0.ph_hi; }
#ifdef ONLY_PH
#define IN(k) ((k) == ONLY_PH && lo <= (k) && (k) < hi)
#else
#define IN(k) (lo <= (k) && (k) < hi)
#endif
#define SEAM(k) do { if (IN(k) && IN((k) + 1)) { if ((k) == 0) grid.sync(); else grid_bar((unsigned*)(kargs().ws + WS_BAR), (unsigned)(k), wave); } } while (0)
#ifdef REP_PH
#ifndef REP_N
#define REP_N 2
#endif
#define NREP(k) ((k) == REP_PH ? REP_N : 1)
#else
#define NREP(k) 1
#endif
#define REPEAT(k) for (int rep_ = 0; rep_ < NREP(k); ++rep_, (rep_ < NREP(k) ? grid_bar((unsigned*)(kargs().ws + WS_BAR) + 128, 1u, wave) : (void)0))
#ifdef STAMP_K
#define TSTAMP(k) do { if (((k) == STAMP_K || (k) == STAMP_K + 1) && blockIdx.x == 0 && wave == 0) { const unsigned long long t_ = __builtin_amdgcn_s_memrealtime(); \
        if (__builtin_amdgcn_mbcnt_lo(~0u, 0u) == 0u) ((unsigned long long*)(kargs().ws + WS_STAMP))[(k) - STAMP_K] = t_; } } while (0)
#else
#define TSTAMP(k) do { } while (0)
#endif
#ifdef STAMP_K
    if (blockIdx.x == PROBE_BLK && wave == 0) { unsigned long long* st_ = (unsigned long long*)(kargs().ws + WS_STAMP); if (__builtin_amdgcn_mbcnt_lo(~0u, 0u) < 3u) st_[__builtin_amdgcn_mbcnt_lo(~0u, 0u)] = 0ull; }
#endif
    TSTAMP(0);
    if (IN(0)) REPEAT(0) { PHASE_ARGS; p0_prologue(a, wave, lds); } SEAM(0); TSTAMP(1);
    if (IN(1)) REPEAT(1) { PHASE_ARGS; norm_phase(a, wave, lds, a.x, 0); } SEAM(1); TSTAMP(2);
    if (IN(2)) REPEAT(2) { PHASE_ARGS;
        pg8::Gemm g{(const bf16_t*)(ws + WS_H), (const bf16_t*)(ws + WS_WIN0), MTOK, N0, DM}; pg8::StaticOrder S; S.init(MTOK, N0, gridDim.x, blockIdx.x);
        #ifdef EPI0_CHEAP_FIRST
        Epi0 E{ws, (unsigned char*)a.out, NREP(2) == 2 && rep_ == 0 && a.ph_hi > 0, lds + pg8::STAGE_BYTES};
#else
        Epi0 E{ws, (unsigned char*)a.out, false, lds + pg8::STAGE_BYTES};
#endif
#ifdef SKEW0
        if (blockIdx.x >= 128) { const unsigned long long t0_ = __builtin_amdgcn_s_memrealtime(); while (__builtin_amdgcn_s_memrealtime() - t0_ < (unsigned long long)(SKEW0)) __builtin_amdgcn_s_sleep(64); }
#endif
        pg8::gemm_phase<Epi0, pg8::StaticOrder, true, true>(lds, g, S, E, wave);
    } SEAM(2); TSTAMP(3);
    if (IN(3)) REPEAT(3) { PHASE_ARGS; conv_phase(a, wave, lds, blockIdx.x, gridDim.x); lora_pre_phase(a, wave); } SEAM(3); TSTAMP(4);
    if (IN(4)) REPEAT(4) { PHASE_ARGS;
        pg8::Gemm g{(const bf16_t*)((unsigned char*)a.out + DO_LA), (const bf16_t*)(ws + WS_WLORA), MTOK, 2048, 256}; pg8::StaticOrder S; S.init(MTOK, 2048, gridDim.x, blockIdx.x);
        EpiLora E{(bf16_t*)(ws + WS_DARR), (bf16_t*)(ws + WS_AARR), a.rwkv_vec, lds + pg8::STAGE_BYTES};
        pg8::gemm_phase<EpiLora, pg8::StaticOrder, true, true>(lds, g, S, E, wave);
    } SEAM(4); TSTAMP(5);
    if (IN(5)) REPEAT(5) { PHASE_ARGS;
#if OLD_SCAN
        scan_phase(a, wave, lds);
#else
        unsigned* pbar = (unsigned*)(ws + WS_BAR) + 256;
        { __syncthreads(); if (wave == 0 && lane_id() < 8) ((LAS unsigned*)(lds + CS_FLAGS))[lane_id()] = 0u; __syncthreads(); }
        for (int r = 0; r <= CR_NP; ++r) {
            if (blockIdx.x >= 64) { if (r < CR_NP) cscan_produce(a, wave, lds, r, 64, gridDim.x - 64); }
            else if (r >= 1) {
                const int piece = r - 1;
                f32x4 xc[4]; f32x4* sv = (f32x4*)(ws + WS_XSAVE) + ((size_t)(blockIdx.x * 4 + (wave & 3)) * 64 + lane_id()) * 4;
#pragma unroll
                for (int kt = 0; kt < 4; ++kt) xc[kt] = (piece == 0 || wave >= 4) ? (f32x4){0.f, 0.f, 0.f, 0.f} : sv[kt];
                cscan_consume(a, wave, lds, blockIdx.x, piece, xc);
                if (wave < 4) {
#pragma unroll
                    for (int kt = 0; kt < 4; ++kt) sv[kt] = xc[kt]; }
            }
            grid_bar(pbar, (unsigned)(r + 1), wave);
#ifdef BAR2
            grid_bar(pbar + 128, (unsigned)(r + 1), wave);
#endif
        }
#endif
    } SEAM(5); TSTAMP(6);
    if (IN(6)) REPEAT(6) { PHASE_ARGS; post_phase(a, wave); } SEAM(6); TSTAMP(7);
    if (IN(7)) REPEAT(7) { PHASE_ARGS;
        pg8::Gemm g{(const bf16_t*)(ws + WS_YAB), (const bf16_t*)(ws + WS_WOUT0), MTOK, DM, 2048}; pg8::StaticOrder S; S.init(MTOK, DM, gridDim.x, blockIdx.x);
        EpiRes E{a.x, a.out, (const float*)(ws + WS_MODP), a.ada_b, 0, NREP(7) >= 2 && rep_ == 0 && a.ph_hi > 0, lds + pg8::STAGE_BYTES};
        pg8::gemm_phase<EpiRes, pg8::StaticOrder, true, true>(lds, g, S, E, wave);
    } SEAM(7); TSTAMP(8);
    if (IN(8)) REPEAT(8) { PHASE_ARGS; norm_phase(a, wave, lds, a.out, 1); } SEAM(8); TSTAMP(9);
    if (IN(9)) REPEAT(9) { PHASE_ARGS;
        pg8::Gemm g{(const bf16_t*)(ws + WS_H), (const bf16_t*)(ws + WS_WIN1), MTOK, N1, DM}; pg8::StaticOrder S; S.init(MTOK, N1, gridDim.x, blockIdx.x);
        Epi1 E{(bf16_t*)(ws + WS_Q), (bf16_t*)(ws + WS_KV), (bf16_t*)(ws + WS_QI), (bf16_t*)(ws + WS_KI), (bf16_t*)(ws + WS_G), (float*)(ws + WS_WI), (const f32x2*)(ws + WS_CSA), (const f32x2*)(ws + WS_CSI), lds + pg8::STAGE_BYTES};
        pg8::gemm_phase<Epi1, pg8::StaticOrder, true, true>(lds, g, S, E, wave);
    } SEAM(9); TSTAMP(10);
    if (IN(10)) REPEAT(10) { PHASE_ARGS; dsa_phase(a, wave, lds, NREP(10) == 2 && rep_ == 0 && a.ph_hi > 0); } SEAM(10); TSTAMP(11);
    if (IN(11)) REPEAT(11) { PHASE_ARGS;
        pg8::Gemm g{(const bf16_t*)(ws + WS_G), (const bf16_t*)(ws + WS_WOUT1), MTOK, DM, 2048}; pg8::StaticOrder S; S.init(MTOK, DM, gridDim.x, blockIdx.x);
        EpiRes E{a.out, a.out, (const float*)(ws + WS_MODP), a.ada_b, 1, false, lds + pg8::STAGE_BYTES};
        pg8::gemm_phase<EpiRes, pg8::StaticOrder, true, true>(lds, g, S, E, wave);
    } SEAM(11); TSTAMP(12);
    if (IN(12)) REPEAT(12) { PHASE_ARGS; final_phase(a, wave); }
#undef IN
#undef SEAM
}

extern "C" void kernel_launch(void* const* d_in, const int* in_sizes, int n_in, void* d_out, int out_size, void* d_ws, size_t ws_size, hipStream_t stream) {
    static int grid = 0;
    if (grid == 0) {
        if (n_in != 19 || out_size != MTOK * DM || ws_size < WS_NEED) { fprintf(stderr, "kernel_launch: unexpected shapes (n_in %d, out %d, ws %zu)\n", n_in, out_size, ws_size); grid = -1; return; }
        int dev = 0, cus = 0, per_cu = 0;
        (void)hipGetDevice(&dev); (void)hipDeviceGetAttribute(&cus, hipDeviceAttributeMultiprocessorCount, dev);
        if (hipFuncSetAttribute((const void*)fwd_megakernel, hipFuncAttributeMaxDynamicSharedMemorySize, LDS_BYTES) != hipSuccess) { fprintf(stderr, "kernel_launch: hipFuncSetAttribute failed\n"); grid = -1; return; }
        if (hipOccupancyMaxActiveBlocksPerMultiprocessor(&per_cu, (const void*)fwd_megakernel, NTHREADS, LDS_BYTES) != hipSuccess || per_cu < 1) { fprintf(stderr, "kernel_launch: occupancy query says %d\n", per_cu); per_cu = 1; }
        (void)hipGetLastError();
        grid = cus;
        if (grid > 256) grid = 256;
    }
    if (grid < 0) return;
    Args a{};
    a.x = (const float*)d_in[0]; a.c = (const float*)d_in[1]; a.pos = (const int*)d_in[2]; a.ada_w = (const float*)d_in[3]; a.ada_b = (const float*)d_in[4];
    a.norm_g = (const float*)d_in[5]; a.final_g = (const float*)d_in[6]; a.even_w_in = (const float*)d_in[7]; a.even_w_out = (const float*)d_in[8];
    a.conv_w = (const float*)d_in[9]; a.conv_vec = (const float*)d_in[10]; a.mu_rkv = (const float*)d_in[11]; a.mu_lora = (const float*)d_in[12];
    a.rwkv_vec = (const float*)d_in[13]; a.w_up = (const float*)d_in[14]; a.a_up = (const float*)d_in[15]; a.r_k = (const float*)d_in[16];
    a.odd_w_in = (const float*)d_in[17]; a.odd_w_out = (const float*)d_in[18];
    a.out = (float*)d_out; a.ws = (unsigned char*)d_ws;
    (void)hipMemsetAsync((char*)d_ws + WS_BAR, 0, 65536, stream);
#if MK_SPLIT
    for (int p = 0; p < MK_PH_END; ++p) { a.ph_lo = p; a.ph_hi = p + 1; void* args[] = {&a};
        hipError_t e = hipLaunchCooperativeKernel((const void*)fwd_megakernel, dim3(grid), dim3(NTHREADS), args, LDS_BYTES, stream);
        if (e != hipSuccess) { fprintf(stderr, "launch %d failed: %s\n", p, hipGetErrorString(e)); break; } }
#else
    a.ph_lo = 0; a.ph_hi = MK_PH_END; void* args[] = {&a};
    hipError_t e = hipLaunchCooperativeKernel((const void*)fwd_megakernel, dim3(grid), dim3(NTHREADS), args, LDS_BYTES, stream);
    if (e != hipSuccess) fprintf(stderr, "cooperative launch failed: %s (grid %d)\n", hipGetErrorString(e), grid);
#endif
}
```

```cpp
#include <hip/hip_runtime.h>
#include <hip/hip_cooperative_groups.h>
#include <cstdio>
#include <cstdint>
namespace cg = cooperative_groups;

#define LAS __attribute__((address_space(3)))
typedef unsigned short bf16_t;
typedef float f32x4 __attribute__((ext_vector_type(4)));
typedef float f32x2 __attribute__((ext_vector_type(2)));
typedef float f32x16 __attribute__((ext_vector_type(16)));
typedef unsigned u32x4 __attribute__((ext_vector_type(4)));
typedef unsigned u32x2 __attribute__((ext_vector_type(2)));
typedef short bf16x8 __attribute__((ext_vector_type(8)));
typedef short s16x4 __attribute__((ext_vector_type(4)));

constexpr int BATCH = 4, SEQ = 8192, DM = 1024, MTOK = BATCH * SEQ;
constexpr int N0 = 7424, N1 = 5120;
constexpr int EVEN_COLS = 7296, ODD_COLS = 4936;
constexpr int NWAVES = 8, NTHREADS = 512;
constexpr int LDS_BYTES = 155648;

constexpr size_t MiB = 1u << 20;
constexpr size_t WS_MODP = 0; constexpr size_t WS_STAMP = 3 * MiB; constexpr size_t WS_XSAVE = 1 * MiB;
constexpr size_t WS_BAR = 3 * MiB + 512 * 1024;
constexpr size_t WS_WIN0 = 4 * MiB, WS_WOUT0 = 20 * MiB, WS_WIN1 = 24 * MiB, WS_WOUT1 = 34 * MiB, WS_WLORA = 38 * MiB;
constexpr size_t WS_CSA = 40 * MiB, WS_CSI = 56 * MiB;
constexpr size_t WS_H = 64 * MiB;
constexpr size_t WS_YAB = 64 * MiB;
constexpr size_t WS_U = 192 * MiB, WS_AG = 256 * MiB, WS_R = 320 * MiB, WS_K = 384 * MiB, WS_V = 448 * MiB;
constexpr size_t WS_AARR = WS_U, WS_DARR = WS_AG;
constexpr size_t WS_Q = 128 * MiB, WS_G = 256 * MiB, WS_KV = 384 * MiB, WS_QI = 400 * MiB, WS_KI = 432 * MiB, WS_WI = 436 * MiB;
constexpr size_t WS_NEED = 512 * MiB;
constexpr size_t DO_BG = 0, DO_WDAD = 64 * MiB, DO_LA = 72 * MiB, DO_RK = 64 * MiB;

__device__ __forceinline__ float bflo(unsigned w) { return __uint_as_float(w << 16); }
__device__ __forceinline__ float bfhi(unsigned w) { return __uint_as_float(w & 0xffff0000u); }
typedef __bf16 bf16x2_t __attribute__((ext_vector_type(2)));
__device__ __forceinline__ unsigned pk2(float lo, float hi) { const f32x2 v = {lo, hi}; const bf16x2_t b = __builtin_convertvector(v, bf16x2_t); return __builtin_bit_cast(unsigned, b); }
__device__ __forceinline__ float sigmoidf_(float x) { return __builtin_amdgcn_rcpf(1.0f + __expf(-x)); }
__device__ __forceinline__ float wave_sum(float v) {
#pragma unroll
    for (int o = 1; o < 64; o <<= 1) v += __shfl_xor(v, o);
    return v;
}
template <int CTRL> __device__ __forceinline__ float dppmov(float x) { return __int_as_float(__builtin_amdgcn_update_dpp(0, __float_as_int(x), CTRL, 0xf, 0xf, true)); }
__device__ __forceinline__ float quad_sum(float x) { x += dppmov<0xB1>(x); x += dppmov<0x4E>(x); return x; }
__device__ __forceinline__ float row16_sum(float x) { x += dppmov<0xB1>(x); x += dppmov<0x4E>(x); x += dppmov<0x141>(x); x += dppmov<0x140>(x); return x; }
__device__ __forceinline__ int lane_id() { int l; asm volatile("v_mbcnt_lo_u32_b32 %0, -1, 0\n\tv_mbcnt_hi_u32_b32 %0, -1, %0" : "=v"(l)); return l; }
#define LDS_WAIT() asm volatile("s_waitcnt lgkmcnt(0)" ::: "memory")

__device__ __forceinline__ int map0(int n) {
    const int t = n >> 8, r = n & 255;
    if (t < 8) return (r < 128) ? 128 * t + r : 1024 + 128 * t + (r - 128);
    if (t < 12) return 2048 + 256 * (t - 8) + r;
    if (t < 24) return 3072 + 256 * (t - 12) + r;
    if (t < 28) return 6272 + 256 * (t - 24) + r;
    return (r < 128) ? 6144 + r : -1;
}
__device__ __forceinline__ int map1(int n) {
    const int t = n >> 8, r = n & 255, half = r >> 7, rr = r & 127;
    if (t < 8) return (2 * t + (rr >> 6)) * 128 + half * 64 + (rr & 63);
    if (t == 8) return 2048 + (rr >> 6) * 128 + half * 64 + (rr & 63);
    if (t < 11) return 2304 + (4 * (t - 9) + (rr >> 5)) * 64 + half * 32 + (rr & 31);
    if (t == 11) { if (rr < 32) return 2816 + half * 32 + rr; if (half == 0 && rr < 40) return 2880 + (rr - 32); return -1; }
    return 2888 + 256 * (t - 12) + r;
}

#ifndef PROBE_BLK
#define PROBE_BLK 0
#endif
#ifndef PROBE_WAVE
#define PROBE_WAVE 0
#endif
#if defined(STAMP_K) && defined(PROBE_SEC)
#define PROBE_BEGIN(sec, wsp, wv) unsigned long long PT0_##sec = 0; if ((sec) == PROBE_SEC && blockIdx.x == PROBE_BLK && (wv) == PROBE_WAVE) PT0_##sec = __builtin_amdgcn_s_memrealtime()
#define PROBE_END(sec, wsp, wv) do { if ((sec) == PROBE_SEC && blockIdx.x == PROBE_BLK && (wv) == PROBE_WAVE) { const unsigned long long dt_ = __builtin_amdgcn_s_memrealtime() - PT0_##sec; \
        if (__builtin_amdgcn_mbcnt_lo(~0u, 0u) == 0u) __hip_atomic_fetch_add((unsigned long long*)((wsp) + WS_STAMP) + 2, dt_, __ATOMIC_RELAXED, __HIP_MEMORY_SCOPE_AGENT); } } while (0)
#else
#define PROBE_BEGIN(sec, wsp, wv) do { } while (0)
#define PROBE_END(sec, wsp, wv) do { } while (0)
#endif
namespace pg8 {
#define PG8_LAS __attribute__((address_space(3)))
typedef unsigned short bf16_t;
typedef short bf16x8 __attribute__((ext_vector_type(8)));
typedef float f32x4 __attribute__((ext_vector_type(4)));
typedef unsigned u32x4 __attribute__((ext_vector_type(4)));
constexpr int BM = 256, BK = 64, HALF = 128, HTB = HALF * BK * 2  , STAGE_BYTES = 8 * HTB, NXCD = 8, WGM = 8;

__host__ __device__ __forceinline__ int lds_byte(int r, int c) { const int st = (r >> 4) * 2 + (c >> 5), rr = r & 15, cc = c & 31, ob = rr * 64 + cc * 2; return st * 1024 + (ob ^ (((ob >> 9) & 1) << 5)); }
__host__ __device__ __forceinline__ void stage_rc(int b, int& R, int& C) { const int st = b / 1024, sb = b % 1024, swz = sb ^ (((sb >> 9) & 1) << 5); R = (st >> 1) * 16 + swz / 64; C = (st & 1) * 32 + (swz % 64) / 2; }
__host__ __device__ __forceinline__ int perm32(int rho) { const int n = rho >> 4, i = rho & 15; return 8 * (i >> 2) + 4 * n + (i & 3); }

struct Unit { int pm, pn; };
struct Gemm { const bf16_t* A; const bf16_t* Bt; int M, N, K; };

struct StaticOrder {
    int nM, nN, nwg, G, c;
    __host__ __device__ void init(int M, int N, int G_, int c_) { nM = M / BM; nN = N / BM; nwg = nM * nN; G = G_; c = c_; }
    __host__ __device__ bool next(int i, Unit& u) const {
        const long L = (long)i * G + c; if (L >= nwg) return false;
        int wgid = (int)L; { const int q = nwg / NXCD, r = nwg % NXCD, xcd = wgid % NXCD, off = wgid / NXCD; wgid = (xcd < r ? xcd * (q + 1) : r * (q + 1) + (xcd - r) * q) + off; }
        const int nig = WGM * nN, gid = wgid / nig, fm = gid * WGM, gsz = (nM - fm) < WGM ? (nM - fm) : WGM;
        u.pm = fm + ((wgid % nig) % gsz); u.pn = (wgid % nig) / gsz; return true;
    }
    __device__ __forceinline__ void a_ready(const Unit&) const {}
    __device__ __forceinline__ void done(const Unit&) const {}
};

__device__ __forceinline__ unsigned cvt_pk_bf16(float lo, float hi) { unsigned r; asm volatile("v_cvt_pk_bf16_f32 %0, %1, %2" : "=v"(r) : "v"(lo), "v"(hi)); return r; }
typedef float f32x2 __attribute__((ext_vector_type(2)));
template <class Epi, class Sched, bool ALIGN_EPI = false, bool SP2 = false>
__device__ __forceinline__ void gemm_phase(PG8_LAS unsigned char* lds, const Gemm g, const Sched& S, const Epi& E, const int wave_in) {
    int lane; asm volatile("v_mbcnt_lo_u32_b32 %0, -1, 0\n\tv_mbcnt_hi_u32_b32 %0, -1, %0" : "=v"(lane));
    const int wid = wave_in, tid = wid * 64 + lane, wr = wid >> 2, wc = wid & 3, fr = lane & 15, fq = lane >> 4;
    const int K = g.K, nt = K / BK;
    unsigned voffA[2], voffB[2];
#pragma unroll
    for (int i = 0; i < 2; ++i) { int R, C; stage_rc(tid * 16 + i * 8192, R, C); const int Rb = Epi::PERM ? ((R & ~31) + perm32(R & 31)) : R;
        voffA[i] = (unsigned)(R * K + C) * 2u; voffB[i] = (unsigned)(Rb * K + C) * 2u; }
    const size_t kstep = (size_t)(BK * 2);
    const size_t hstep = (size_t)HALF * K * 2;
    const size_t tstep = 2 * hstep;
    const unsigned ldsw = (unsigned)wid * 1024u;
    const int aoff = lds_byte(wr * 64 + fr, fq * 8), boff = lds_byte(wc * 32 + fr, fq * 8);
#define PG8_SA(b, h) (((b) * 2 + (h)) * HTB)
#define PG8_SB(b, h) ((4 + (b) * 2 + (h)) * HTB)
#define PG8_STAGE(bufoff, gbase, voff) do { _Pragma("unroll") for (int _i = 0; _i < 2; ++_i) \
        __builtin_amdgcn_global_load_lds((const unsigned*)((const char*)(gbase) + (voff)[_i]), (PG8_LAS unsigned*)(lds + (bufoff) + ldsw + _i * 8192), 16, 0, 0); } while (0)
#define PG8_LDA(dst, b, h) do { _Pragma("unroll") for (int m = 0; m < 4; ++m) _Pragma("unroll") for (int k = 0; k < 2; ++k) dst[m][k] = *(const PG8_LAS bf16x8*)(lds + PG8_SA(b, h) + aoff + m * 2048 + k * 1024); } while (0)
#define PG8_LDB(dst, b, h) do { _Pragma("unroll") for (int n = 0; n < 2; ++n) _Pragma("unroll") for (int k = 0; k < 2; ++k) dst[n][k] = *(const PG8_LAS bf16x8*)(lds + PG8_SB(b, h) + boff + n * 2048 + k * 1024); } while (0)
#define PG8_MMA(ai, bj, At, Bt) do { __builtin_amdgcn_s_setprio(1); _Pragma("unroll") for (int m = 0; m < 4; ++m) _Pragma("unroll") for (int n = 0; n < 2; ++n) _Pragma("unroll") for (int k = 0; k < 2; ++k) \
        acc[ai][bj][m][n] = __builtin_amdgcn_mfma_f32_16x16x32_bf16(Bt[n][k], At[m][k], acc[ai][bj][m][n], 0, 0, 0); __builtin_amdgcn_s_setprio(0); } while (0)
#define PG8_WAIT_V(n) asm volatile("s_waitcnt vmcnt(" #n ")" ::: "memory")
#define PG8_WAIT_L(n) asm volatile("s_waitcnt lgkmcnt(" #n ")" ::: "memory")
#define PG8_BAR __builtin_amdgcn_s_barrier()
#define PG8_SCHED __builtin_amdgcn_sched_barrier(0)
    Unit cur, nxt; int ui = 0;
    if (!S.next(0, cur)) return;
    f32x4 acc[2][2][4][2];
#pragma unroll
    for (int a = 0; a < 2; ++a)
#pragma unroll
        for (int b = 0; b < 2; ++b)
#pragma unroll
            for (int m = 0; m < 4; ++m)
#pragma unroll
                for (int n = 0; n < 2; ++n) acc[a][b][m][n] = (f32x4){0.f, 0.f, 0.f, 0.f};
    bf16x8 At[4][2], B0[2][2], B1[2][2];
    const char* cA = (const char*)g.A + (size_t)cur.pm * tstep; const char* cB = (const char*)g.Bt + (size_t)cur.pn * tstep;
    S.a_ready(cur);
    if constexpr (SP2) {
        PG8_STAGE(PG8_SB(0, 0), cB, voffB); PG8_STAGE(PG8_SB(0, 1), cB + hstep, voffB); PG8_STAGE(PG8_SA(0, 0), cA, voffA); PG8_STAGE(PG8_SA(0, 1), cA + hstep, voffA);
        if (wr == 1) PG8_BAR;
        PG8_WAIT_V(2); PG8_BAR;
        PG8_STAGE(PG8_SB(1, 0), cB + kstep, voffB); PG8_STAGE(PG8_SA(1, 0), cA + kstep, voffA); PG8_STAGE(PG8_SB(1, 1), cB + hstep + kstep, voffB);
        PG8_WAIT_V(6); PG8_BAR;
    } else {
        PG8_STAGE(PG8_SB(0, 0), cB, voffB); PG8_STAGE(PG8_SA(0, 0), cA, voffA); PG8_STAGE(PG8_SB(0, 1), cB + hstep, voffB); PG8_STAGE(PG8_SA(0, 1), cA + hstep, voffA);
        if (wr == 1) PG8_BAR;
        PG8_WAIT_V(4); PG8_BAR;
        PG8_STAGE(PG8_SB(1, 0), cB + kstep, voffB); PG8_STAGE(PG8_SA(1, 0), cA + kstep, voffA); PG8_STAGE(PG8_SB(1, 1), cB + hstep + kstep, voffB);
        PG8_WAIT_V(6); PG8_BAR;
    }
    for (;;) {
        const bool has_next = S.next(ui + 1, nxt);
        const char* nA = has_next ? (const char*)g.A + (size_t)nxt.pm * tstep : cA; const char* nB = has_next ? (const char*)g.Bt + (size_t)nxt.pn * tstep : cB;
        for (int t = 0; t < nt; t += 2) {
            const bool last = (t == nt - 2);
            const char* a1 = cA + (size_t)(t + 1) * kstep;
            const char* a2 = last ? nA : cA + (size_t)(t + 2) * kstep; const char* b2 = last ? nB : cB + (size_t)(t + 2) * kstep;
            const char* a3 = a2 + kstep; const char* b3 = b2 + kstep;
            if (last && has_next) S.a_ready(nxt);
            if constexpr (SP2) {
            PG8_LDB(B0, 0, 0); PG8_LDB(B1, 0, 1); PG8_SCHED; PG8_LDA(At, 0, 0); PG8_STAGE(PG8_SA(1, 1), a1 + hstep, voffA);
            PG8_WAIT_V(8); PG8_WAIT_L(0); PG8_BAR; PG8_MMA(0, 0, At, B0); PG8_MMA(0, 1, At, B1); PG8_BAR; PG8_SCHED;
            PG8_LDA(At, 0, 1); PG8_STAGE(PG8_SB(0, 0), b2, voffB); PG8_STAGE(PG8_SB(0, 1), b2 + hstep, voffB); PG8_STAGE(PG8_SA(0, 0), a2, voffA);
            PG8_WAIT_V(8); PG8_WAIT_L(0); PG8_BAR; PG8_MMA(1, 0, At, B0); PG8_MMA(1, 1, At, B1); PG8_BAR; PG8_SCHED;
            PG8_LDB(B0, 1, 0); PG8_LDB(B1, 1, 1); PG8_SCHED; PG8_LDA(At, 1, 0); PG8_STAGE(PG8_SA(0, 1), a2 + hstep, voffA);
            PG8_WAIT_V(8); PG8_WAIT_L(0); PG8_BAR; PG8_MMA(0, 0, At, B0); PG8_MMA(0, 1, At, B1); PG8_BAR; PG8_SCHED;
            PG8_LDA(At, 1, 1); PG8_STAGE(PG8_SB(1, 0), b3, voffB); PG8_STAGE(PG8_SB(1, 1), b3 + hstep, voffB); PG8_STAGE(PG8_SA(1, 0), a3, voffA);
            PG8_WAIT_V(8); PG8_WAIT_L(0); PG8_BAR; PG8_MMA(1, 0, At, B0); PG8_MMA(1, 1, At, B1); PG8_BAR; PG8_SCHED;
            } else {
            PG8_LDB(B0, 0, 0); PG8_SCHED; PG8_LDA(At, 0, 0); PG8_STAGE(PG8_SA(1, 1), a1 + hstep, voffA);
            PG8_WAIT_L(8); PG8_BAR; PG8_WAIT_L(0); PG8_MMA(0, 0, At, B0); PG8_BAR; PG8_SCHED;
            PG8_LDB(B1, 0, 1); PG8_STAGE(PG8_SB(0, 0), b2, voffB);
            PG8_BAR; PG8_WAIT_L(0); PG8_MMA(0, 1, At, B1); PG8_BAR;
            PG8_LDA(At, 0, 1); PG8_STAGE(PG8_SA(0, 0), a2, voffA);
            PG8_BAR; PG8_WAIT_L(0); PG8_MMA(1, 0, At, B0); PG8_BAR; PG8_SCHED;
            PG8_STAGE(PG8_SB(0, 1), b2 + hstep, voffB);
            PG8_WAIT_V(6); PG8_BAR; PG8_MMA(1, 1, At, B1); PG8_BAR;
            PG8_LDB(B0, 1, 0); PG8_SCHED; PG8_LDA(At, 1, 0); PG8_STAGE(PG8_SA(0, 1), a2 + hstep, voffA);
            PG8_WAIT_L(8); PG8_BAR; PG8_WAIT_L(0); PG8_MMA(0, 0, At, B0); PG8_BAR; PG8_SCHED;
            PG8_LDB(B1, 1, 1); PG8_STAGE(PG8_SB(1, 0), b3, voffB);
            PG8_BAR; PG8_WAIT_L(0); PG8_MMA(0, 1, At, B1); PG8_BAR;
            PG8_LDA(At, 1, 1); PG8_STAGE(PG8_SA(1, 0), a3, voffA);
            PG8_BAR; PG8_WAIT_L(0); PG8_MMA(1, 0, At, B0); PG8_BAR; PG8_SCHED;
            PG8_STAGE(PG8_SB(1, 1), b3 + hstep, voffB);
            PG8_WAIT_V(6); PG8_BAR; PG8_MMA(1, 1, At, B1); PG8_BAR;
            }
        }
        if constexpr (ALIGN_EPI) { if (wr == 0) PG8_BAR; }
        if constexpr (!Epi::AFTER_DRAIN) { E(acc, cur, wr, wc, fr, fq); S.done(cur); }
        if (!has_next) break;
#pragma unroll
        for (int a = 0; a < 2; ++a)
#pragma unroll
            for (int b = 0; b < 2; ++b)
#pragma unroll
                for (int m = 0; m < 4; ++m)
#pragma unroll
                    for (int n = 0; n < 2; ++n) acc[a][b][m][n] = (f32x4){0.f, 0.f, 0.f, 0.f};
        cur = nxt; cA = nA; cB = nB; ++ui;
        if constexpr (ALIGN_EPI) { if (wr == 1) PG8_BAR; }
    }
    PG8_WAIT_V(0);
    if constexpr (!ALIGN_EPI) { if (wr == 0) PG8_BAR; }
    PG8_BAR;
    if constexpr (Epi::AFTER_DRAIN) { E.fused(acc, cur, wr, wc, fr, fq, lds, wid, lane); S.done(cur); }
#undef PG8_SA
#undef PG8_SB
#undef PG8_STAGE
#undef PG8_LDA
#undef PG8_LDB
#undef PG8_MMA
#undef PG8_WAIT_V
#undef PG8_WAIT_L
#undef PG8_BAR
#undef PG8_SCHED
}
}

__device__ __forceinline__ u32x4 pack8(const f32x4 a, const f32x4 b) { u32x4 w; w.x = pk2(a[0], a[1]); w.y = pk2(a[2], a[3]); w.z = pk2(b[0], b[1]); w.w = pk2(b[2], b[3]); return w; }
__device__ __forceinline__ f32x4 silu4(const f32x4 v) { f32x4 o; o[0] = v[0] * sigmoidf_(v[0]); o[1] = v[1] * sigmoidf_(v[1]); o[2] = v[2] * sigmoidf_(v[2]); o[3] = v[3] * sigmoidf_(v[3]); return o; }
__device__ __forceinline__ f32x4 sig4(const f32x4 v) { f32x4 o; o[0] = sigmoidf_(v[0]); o[1] = sigmoidf_(v[1]); o[2] = sigmoidf_(v[2]); o[3] = sigmoidf_(v[3]); return o; }

struct RowSt {
    unsigned wa, ra; int rq, cq;
    __device__ __forceinline__ RowSt(LAS unsigned char* spare, int wr, int wc, int fr, int fq) {
        int lane = fr + 16 * fq; asm volatile("" : "+v"(lane));
        const int fr_ = lane & 15, fq_ = lane >> 4; const unsigned tile = (unsigned)(size_t)spare + (unsigned)(wr * 4 + wc) * 2048u;
        wa = tile + (unsigned)fr_ * 64u + (unsigned)((fq_ ^ ((fr_ >> 2) & 3)) << 4); ra = tile + (unsigned)lane * 16u; rq = lane >> 2; cq = 8 * ((lane & 3) ^ (lane >> 4)); }
    __device__ __forceinline__ void store(bf16_t* P, size_t row16, int stride, int col, const u32x4 v, int buf) const {
        *(LAS u32x4*)(size_t)(wa + 1024u * (unsigned)buf) = v; const u32x4 t = *(const LAS u32x4*)(size_t)(ra + 1024u * (unsigned)buf);
        *(u32x4*)(P + (row16 + (size_t)rq) * (size_t)stride + col + cq) = t; }
};

struct Epi0 {
    static constexpr bool PERM = true, AFTER_DRAIN = false;
    unsigned char* ws; unsigned char* dout; bool cheap; LAS unsigned char* spare;
    __device__ __forceinline__ void operator()(const f32x4 (&acc)[2][2][4][2], const pg8::Unit& u, int wr, int wc, int fr, int fq) const {
        const int t = u.pn, cwv = wc * 32; const size_t rw = (size_t)(u.pm * 256 + wr * 64);
        const RowSt rs(spare, wr, wc, fr, fq);
        if (t < 8) {
            bf16_t* U = (bf16_t*)(ws + WS_U);
#pragma unroll
            for (int ai = 0; ai < 2; ++ai)
#pragma unroll
                for (int m = 0; m < 4; ++m) {
                    const f32x4 a = cheap ? acc[ai][0][m][0] : acc[ai][0][m][0] * sig4(acc[ai][1][m][0]), b = cheap ? acc[ai][0][m][1] : acc[ai][0][m][1] * sig4(acc[ai][1][m][1]);
                    rs.store(U, rw + ai * 128 + m * 16, 1024, 128 * t + cwv, pack8(a, b), m & 1); }
        } else if (t == 28) {
            bf16_t* WDAD = (bf16_t*)(dout + DO_WDAD);
#pragma unroll
            for (int ai = 0; ai < 2; ++ai)
#pragma unroll
                for (int m = 0; m < 4; ++m) rs.store(WDAD, rw + ai * 128 + m * 16, 128, cwv, pack8(acc[ai][0][m][0], acc[ai][0][m][1]), m & 1);
        } else {
            const bool act = ((t < 12) || (t >= 24)) && !cheap; const int c0 = 256 * (t & 3);
            unsigned char* bp = (t >= 24) ? (dout + DO_BG) : (ws + WS_AG + (size_t)((t - 8) >> 2) * (64 * MiB));
            bf16_t* base = (bf16_t*)bp;
#pragma unroll
            for (int ai = 0; ai < 2; ++ai)
#pragma unroll
                for (int m = 0; m < 4; ++m) {
#pragma unroll
                    for (int bj = 0; bj < 2; ++bj) { f32x4 a = acc[ai][bj][m][0], b = acc[ai][bj][m][1];
                        if (act) { a = silu4(a); b = silu4(b); }
                        rs.store(base, rw + ai * 128 + m * 16, 1024, c0 + 128 * bj + cwv, pack8(a, b), bj); } }
        }
    }
};
static_assert(WS_R == WS_AG + 64 * MiB && WS_K == WS_AG + 128 * MiB && WS_V == WS_AG + 192 * MiB, "Epi0 region arithmetic");

struct EpiLora {
    static constexpr bool PERM = true, AFTER_DRAIN = false;
    bf16_t *D, *A; const float* vec; LAS unsigned char* spare;
    __device__ __forceinline__ void operator()(const f32x4 (&acc)[2][2][4][2], const pg8::Unit& u, int wr, int wc, int fr, int fq) const {
        const int t = u.pn, cw = wc * 32 + 8 * fq; const size_t rw = (size_t)(u.pm * 256 + wr * 64);
        const bool isd = t < 4; bf16_t* base = isd ? D : A; const int c0 = 256 * (t & 3); const float* bias = vec + (isd ? 0 : 1024) + c0 + cw;
        const float sc = isd ? 0.60653065971f : 1.0f;
        const RowSt rs(spare, wr, wc, fr, fq);
#pragma unroll
        for (int ai = 0; ai < 2; ++ai)
#pragma unroll
            for (int m = 0; m < 4; ++m) {
#pragma unroll
                for (int bj = 0; bj < 2; ++bj) { const f32x4 b0 = *(const f32x4*)(bias + 128 * bj), b1 = *(const f32x4*)(bias + 128 * bj + 4);
                    const f32x4 a = sig4(acc[ai][bj][m][0] + b0) * sc, b = sig4(acc[ai][bj][m][1] + b1) * sc;
                    rs.store(base, rw + ai * 128 + m * 16, 1024, c0 + 128 * bj + wc * 32, pack8(a, b), bj); } }
    }
};

struct EpiRes {
    static constexpr bool PERM = false, AFTER_DRAIN = false;
    const float* resid; float* out; const float* modp; const float* ada_b; int layer; bool cheap; LAS unsigned char* spare;
    __device__ __forceinline__ void operator()(const f32x4 (&acc)[2][2][4][2], const pg8::Unit& u, int wr, int wc, int fr, int fq) const {
        const int row0 = u.pm * 256 + wr * 64 + fr, col0 = u.pn * 256 + wc * 32 + 4 * fq, b = (u.pm * 256) / SEQ;
#ifdef EPIRES_CHEAP
        if (cheap) {
            f32x4 s = (f32x4){0.f, 0.f, 0.f, 0.f};
#pragma unroll
            for (int ai = 0; ai < 2; ++ai)
#pragma unroll
                for (int bj = 0; bj < 2; ++bj)
#pragma unroll
                    for (int m = 0; m < 4; ++m)
#pragma unroll
                        for (int n = 0; n < 2; ++n) s += acc[ai][bj][m][n];
            if (s[0] + s[1] + s[2] + s[3] == 1.2345e30f) out[(size_t)row0 * 1024 + col0] = s[0];
            return; }
#endif
        f32x4 gv[2][2];
#pragma unroll
        for (int bj = 0; bj < 2; ++bj)
#pragma unroll
            for (int n = 0; n < 2; ++n) { const int c = col0 + bj * 128 + n * 16; f32x4 g = *(const f32x4*)(ada_b + layer * 3072 + 2048 + c);
#pragma unroll
                for (int s = 0; s < 8; ++s) g += *(const f32x4*)(modp + (size_t)((s * 2 + layer) * 4 + b) * 3072 + 2048 + c);
                gv[bj][n] = g; }
        const int lane = fr + 16 * fq;
        const unsigned tile = (unsigned)(size_t)spare + (unsigned)(wr * 4 + wc) * 2048u;
        const unsigned wa = tile + (unsigned)fr * 128u + (unsigned)((fq ^ (fr >> 1)) << 4);
        const unsigned ra = tile + (unsigned)lane * 16u;
        const size_t o0 = (size_t)(u.pm * 256 + wr * 64 + (lane >> 3)) * 1024 + u.pn * 256 + wc * 32 + 4 * ((lane & 7) ^ (lane >> 4));
        const size_t o1 = (size_t)(u.pm * 256 + wr * 64 + 8 + (lane >> 3)) * 1024 + u.pn * 256 + wc * 32 + 4 * ((lane & 7) ^ (4 + (lane >> 4)));
        f32x4 rr[3][2];
        auto rload = [&](int idx, f32x4 (&dst)[2]) { const int ai = idx >> 3, m = (idx >> 1) & 3, bj = idx & 1; const size_t d = (size_t)(ai * 128 + m * 16) * 1024 + bj * 128;
            dst[0] = *(const f32x4*)(resid + o0 + d); dst[1] = *(const f32x4*)(resid + o1 + d); };
        rload(0, rr[0]); rload(1, rr[1]);
#pragma unroll
        for (int idx = 0; idx < 16; ++idx) { const int ai = idx >> 3, m = (idx >> 1) & 3, bj = idx & 1; const size_t d = (size_t)(ai * 128 + m * 16) * 1024 + bj * 128;
            if (idx + 2 < 16) rload(idx + 2, rr[(idx + 2) % 3]);
            *(LAS f32x4*)(size_t)wa = gv[bj][0] * acc[ai][bj][m][0]; *(LAS f32x4*)(size_t)(wa ^ 64u) = gv[bj][1] * acc[ai][bj][m][1];
            const f32x4 t0 = *(const LAS f32x4*)(size_t)ra, t1 = *(const LAS f32x4*)(size_t)(ra + 1024u);
            *(f32x4*)(out + o0 + d) = rr[idx % 3][0] + t0; *(f32x4*)(out + o1 + d) = rr[idx % 3][1] + t1;
            asm volatile("" ::: "memory"); }
    }
};

constexpr float Q_SCALE = 0.08838834764831845f * 1.4426950408889634f;
constexpr float WI_SCALE = 0.35355339059327373f * 0.125f;
struct Epi1 {
    static constexpr bool PERM = true, AFTER_DRAIN = false;
    bf16_t *Q, *KV, *QI, *KI, *G; float* WI; const f32x2* csa; const f32x2* csi; LAS unsigned char* spare;
    __device__ __forceinline__ void rope8(const f32x4 x1a, const f32x4 x1b, const f32x4 x2a, const f32x4 x2b, const f32x4 (&tv)[4], float sc, u32x4& o1, u32x4& o2) const {
        float c[8], s[8];
#pragma unroll
        for (int j = 0; j < 4; ++j) { c[2 * j] = tv[j][0]; s[2 * j] = tv[j][1]; c[2 * j + 1] = tv[j][2]; s[2 * j + 1] = tv[j][3]; }
        float a[8], b[8];
#pragma unroll
        for (int j = 0; j < 4; ++j) { a[j] = x1a[j]; a[4 + j] = x1b[j]; b[j] = x2a[j]; b[4 + j] = x2b[j]; }
        float p[8], q[8];
#pragma unroll
        for (int j = 0; j < 8; ++j) { p[j] = (a[j] * c[j] - b[j] * s[j]) * sc; q[j] = (b[j] * c[j] + a[j] * s[j]) * sc; }
        o1.x = pk2(p[0], p[1]); o1.y = pk2(p[2], p[3]); o1.z = pk2(p[4], p[5]); o1.w = pk2(p[6], p[7]);
        o2.x = pk2(q[0], q[1]); o2.y = pk2(q[2], q[3]); o2.z = pk2(q[4], q[5]); o2.w = pk2(q[6], q[7]);
    }
    __device__ __forceinline__ void operator()(const f32x4 (&acc)[2][2][4][2], const pg8::Unit& u, int wr, int wc, int fr, int fq) const {
        const int row0 = u.pm * 256 + wr * 64 + fr, t = u.pn; const size_t rw = (size_t)(u.pm * 256 + wr * 64);
        const RowSt rs(spare, wr, wc, fr, fq);
        const bool roped = (t < 8) || (t == 8 && wc < 2) || (t >= 9 && t < 11) || (t == 11 && wc == 0);
        if (roped) {
            int lane = fr + 16 * fq; asm volatile("" : "+v"(lane));
            const bool wide = t <= 8; const int rb = wide ? 1024 : 512;
            const f32x2* tab = wide ? csa + (((rw >> 4) * 2 + (wc & 1)) * 256 + lane) * 2 : csi + ((rw >> 4) * 256 + lane) * 2;
            f32x4 tv[3][4];
            auto tload = [&](int idx, f32x4 (&d)[4]) { const f32x2* p = tab + (size_t)((idx >> 2) * 8 + (idx & 3)) * rb;
#pragma unroll
                for (int j = 0; j < 4; ++j) d[j] = *(const f32x4*)(p + 128 * j); };
            tload(0, tv[0]); tload(1, tv[1]);
            const float sc = (t < 8) ? Q_SCALE : 1.0f;
#pragma unroll
            for (int idx = 0; idx < 8; ++idx) { const int ai = idx >> 2, m = idx & 3; const size_t r16 = rw + ai * 128 + m * 16;
                if (idx + 2 < 8) tload(idx + 2, tv[(idx + 2) % 3]);
                u32x4 o1, o2; rope8(acc[ai][0][m][0], acc[ai][0][m][1], acc[ai][1][m][0], acc[ai][1][m][1], tv[idx % 3], sc, o1, o2);
                if (t < 8) { const int head = 2 * t + (wc >> 1); rs.store(Q, r16, 2048, head * 128 + (wc & 1) * 32, o1, 0); rs.store(Q, r16, 2048, head * 128 + 64 + (wc & 1) * 32, o2, 1); }
                else if (t == 8) { rs.store(KV, r16, 256, (wc & 1) * 32, o1, 0); rs.store(KV, r16, 256, 64 + (wc & 1) * 32, o2, 1); }
                else if (t < 11) { const int head = 4 * (t - 9) + wc; rs.store(QI, r16, 512, head * 64, o1, 0); rs.store(QI, r16, 512, head * 64 + 32, o2, 1); }
                else { rs.store(KI, r16, 64, 0, o1, 0); rs.store(KI, r16, 64, 32, o2, 1); }
                asm volatile("" ::: "memory"); }
        } else {
#pragma unroll
            for (int ai = 0; ai < 2; ++ai)
#pragma unroll
                for (int m = 0; m < 4; ++m) { const size_t row = (size_t)(row0 + ai * 128 + m * 16), r16 = rw + ai * 128 + m * 16;
                    const f32x4 x1a = acc[ai][0][m][0], x1b = acc[ai][0][m][1], x2a = acc[ai][1][m][0], x2b = acc[ai][1][m][1];
                    if (t == 8) { rs.store(KV, r16, 256, 128 + (wc & 1) * 32, pack8(x1a, x1b), 0); rs.store(KV, r16, 256, 192 + (wc & 1) * 32, pack8(x2a, x2b), 1); }
                    else if (t == 11) { if (wc == 1 && fq == 0) { *(f32x4*)(WI + row * 8) = x1a * WI_SCALE; *(f32x4*)(WI + row * 8 + 4) = x1b * WI_SCALE; } }
                    else if (t >= 12) { const int c0 = 256 * (t - 12);
                        rs.store(G, r16, 2048, c0 + wc * 32, pack8(silu4(x1a), silu4(x1b)), 0); rs.store(G, r16, 2048, c0 + 128 + wc * 32, pack8(silu4(x2a), silu4(x2b)), 1); }
                }
        }
    }
};

struct Args {
    const float* x; const float* c; const int* pos; const float* ada_w; const float* ada_b; const float* norm_g; const float* final_g;
    const float* even_w_in; const float* even_w_out; const float* conv_w; const float* conv_vec; const float* mu_rkv; const float* mu_lora;
    const float* rwkv_vec; const float* w_up; const float* a_up; const float* r_k; const float* odd_w_in; const float* odd_w_out;
    float* out; unsigned char* ws; int ph_lo, ph_hi;
};

template <class SrcF>
__device__ __forceinline__ void transpose_item(const SrcF& src, int K, bf16_t* WT, LAS float* scr, int item, int nblk, int lane) {
    const int kb = item / nblk, nb = item % nblk, k0 = 64 * kb, n0 = 32 * nb;
    float tv[32];
#pragma unroll
    for (int i = 0; i < 32; ++i) tv[i] = src(k0 + 2 * i + (lane >> 5), n0 + (lane & 31));
#pragma unroll
    for (int i = 0; i < 32; ++i) scr[(2 * i + (lane >> 5)) * 33 + (lane & 31)] = tv[i];
    LDS_WAIT();
    const int c = lane & 7;
#pragma unroll
    for (int j = 0; j < 4; ++j) { const int n = (lane >> 3) + 8 * j; const LAS float* s = scr + (8 * c) * 33 + n;
        u32x4 o; o.x = pk2(s[0 * 33], s[1 * 33]); o.y = pk2(s[2 * 33], s[3 * 33]); o.z = pk2(s[4 * 33], s[5 * 33]); o.w = pk2(s[6 * 33], s[7 * 33]);
        *(u32x4*)(WT + (size_t)(n0 + n) * K + k0 + 8 * c) = o; }
    LDS_WAIT();
}

__device__ __forceinline__ void transpose_item_col(const float* W, int ldw, int scol, int K, bf16_t* WT, LAS float* scr, int k0, int n0, int lane) {
    const float* wp = W + (size_t)(k0 + (lane >> 5)) * ldw + (scol < 0 ? 0 : scol);
#pragma unroll 8
    for (int i = 0; i < 32; ++i) { const float v = wp[(size_t)(2 * i) * ldw]; scr[(2 * i + (lane >> 5)) * 33 + (lane & 31)] = scol < 0 ? 0.f : v; }
    LDS_WAIT();
    const int c = lane & 7;
#pragma unroll
    for (int j = 0; j < 4; ++j) { const int n = (lane >> 3) + 8 * j; const LAS float* s = scr + (8 * c) * 33 + n;
        u32x4 o; o.x = pk2(s[0 * 33], s[1 * 33]); o.y = pk2(s[2 * 33], s[3 * 33]); o.z = pk2(s[4 * 33], s[5 * 33]); o.w = pk2(s[6 * 33], s[7 * 33]);
        *(u32x4*)(WT + (size_t)(n0 + n) * K + k0 + 8 * c) = o; }
    LDS_WAIT();
}
__device__ __forceinline__ void rope_item(const Args& a, int r, int lane) {
    const float p = (float)a.pos[r]; const int f = lane;
    { const float inv = powf(10000.0f, -(float)(2 * f) / 128.0f); float sn, cs; sincosf(p * inv, &sn, &cs);
      ((f32x2*)(a.ws + WS_CSA))[(size_t)((((r >> 4) * 2 + (f >> 5)) * 4 + ((f & 7) >> 1)) * 64 + (r & 15) + 16 * ((f & 31) >> 3)) * 2 + (f & 1)] = (f32x2){cs, sn}; }
    if (f < 32) { const float inv = powf(10000.0f, -(float)(2 * f) / 64.0f); float sn, cs; sincosf(p * inv, &sn, &cs);
      ((f32x2*)(a.ws + WS_CSI))[(size_t)(((r >> 4) * 4 + ((f & 7) >> 1)) * 64 + (r & 15) + 16 * (f >> 3)) * 2 + (f & 1)] = (f32x2){cs, sn}; }
}
__device__ __forceinline__ void p0_late(const Args& a, const int wave, LAS unsigned char* lds, int first, int nblk) {
    const int lane = lane_id(), tid = wave * 64 + lane;
    LAS float* scr = (LAS float*)(lds + wave * 16384);
    const int gw = ((int)blockIdx.x - first) * NWAVES + wave, NGW = nblk * NWAVES;
    unsigned char* ws = a.ws;
    constexpr int I_WO = (2048 / 64) * (DM / 32), I_W1 = (DM / 64) * (N1 / 32), I_ROPE = MTOK;
    for (int it = gw; it < I_W1 + I_WO + I_ROPE; it += NGW) {
        int r = it;
        if (r < I_W1) { const int nblk = N1 / 32, k0 = 64 * (r / nblk), n0 = 32 * (r % nblk); transpose_item_col(a.odd_w_in, ODD_COLS, map1(n0 + (lane & 31)), DM, (bf16_t*)(ws + WS_WIN1), scr, k0, n0, lane); continue; } r -= I_W1;
        if (r < I_WO) { const int nblk = DM / 32, k0 = 64 * (r / nblk), n0 = 32 * (r % nblk); transpose_item_col(a.odd_w_out, DM, n0 + (lane & 31), 2048, (bf16_t*)(ws + WS_WOUT1), scr, k0, n0, lane); continue; } r -= I_WO;
        {
            const float p = (float)a.pos[r];
            { const float inv = powf(10000.0f, -(float)(2 * lane) / 128.0f); float sn, cs; sincosf(p * inv, &sn, &cs); ((f32x2*)(ws + WS_CSA))[(size_t)r * 64 + lane] = (f32x2){cs, sn}; }
            if (lane < 32) { const float inv = powf(10000.0f, -(float)(2 * lane) / 64.0f); float sn, cs; sincosf(p * inv, &sn, &cs); ((f32x2*)(ws + WS_CSI))[(size_t)r * 32 + lane] = (f32x2){cs, sn}; }
        }
    }
}
__device__ __forceinline__ void p0_prologue(const Args& a, const int wave, LAS unsigned char* lds) {
    const int lane = lane_id(), tid = wave * 64 + lane;
    LAS float* scr = (LAS float*)(lds + wave * 16384);
    const int gw = blockIdx.x * NWAVES + wave, NGW = gridDim.x * NWAVES;
    unsigned char* ws = a.ws;
    constexpr int I_W0 = (DM / 64) * (N0 / 32), I_WO = (2048 / 64) * (DM / 32), I_W1 = (DM / 64) * (N1 / 32), I_WL = (256 / 64) * (2048 / 32), I_MOD = 96 * 8, I_ROPE = MTOK;
    constexpr int NITEMS = I_W0 + I_WO + I_W1 + I_WO + I_WL + I_MOD + I_ROPE;
    constexpr int N_EARLY = I_W0 + I_WO + I_W1 + I_WO + I_WL + I_MOD;
    for (int it = gw; it < N_EARLY; it += NGW) {
        int r = it;
        if (r < I_W0) { const float* W = a.even_w_in; transpose_item([W](int k, int n) { const int s = map0(n); return s < 0 ? 0.f : W[(size_t)k * EVEN_COLS + s]; }, DM, (bf16_t*)(ws + WS_WIN0), scr, r, N0 / 32, lane); continue; } r -= I_W0;
        if (r < I_WO) { const float* W = a.even_w_out; transpose_item([W](int k, int n) { return W[(size_t)k * DM + n]; }, 2048, (bf16_t*)(ws + WS_WOUT0), scr, r, DM / 32, lane); continue; } r -= I_WO;
        if (r < I_W1) { const float* W = a.odd_w_in; transpose_item([W](int k, int n) { const int s = map1(n); return s < 0 ? 0.f : W[(size_t)k * ODD_COLS + s]; }, DM, (bf16_t*)(ws + WS_WIN1), scr, r, N1 / 32, lane); continue; } r -= I_W1;
        if (r < I_WO) { const float* W = a.odd_w_out; transpose_item([W](int k, int n) { return W[(size_t)k * DM + n]; }, 2048, (bf16_t*)(ws + WS_WOUT1), scr, r, DM / 32, lane); continue; } r -= I_WO;
        if (r < I_WL) { const float* wu = a.w_up; const float* au = a.a_up;
            transpose_item([wu, au](int k, int n) { if (n < 1024) return k < 64 ? wu[k * 1024 + n] : 0.f; return (k >= 64 && k < 128) ? au[(k - 64) * 1024 + (n - 1024)] : 0.f; }, 256, (bf16_t*)(ws + WS_WLORA), scr, r, 2048 / 32, lane); continue; } r -= I_WL;
        if (r < I_MOD) {
            const int cgp = r >> 3, ks = r & 7, col = cgp * 64 + lane, l = col / 3072, cc = col - l * 3072;
#pragma unroll
            for (int i = 0; i < 8; ++i) { const int idx = lane + 64 * i, bb = idx >> 7, kk = idx & 127; const float cv = a.c[bb * DM + ks * 128 + kk]; scr[kk * 4 + bb] = cv * sigmoidf_(cv); }
            LDS_WAIT();
            const float* W = a.ada_w + (size_t)l * DM * 3072 + cc + (size_t)(ks * 128) * 3072; f32x4 acc4 = (f32x4){0.f, 0.f, 0.f, 0.f};
#pragma unroll 1
            for (int k8 = 0; k8 < 128; k8 += 16) { float wv[16];
#pragma unroll
                for (int i = 0; i < 16; ++i) wv[i] = W[(size_t)(k8 + i) * 3072];
#pragma unroll
                for (int i = 0; i < 16; ++i) acc4 += *(const LAS f32x4*)(scr + (k8 + i) * 4) * wv[i]; }
            LDS_WAIT();
            const float acc0 = acc4[0], acc1 = acc4[1], acc2 = acc4[2], acc3 = acc4[3];
            float* mp = (float*)(ws + WS_MODP) + (size_t)((ks * 2 + l) * 4) * 3072 + cc;
            mp[0] = acc0; mp[3072] = acc1; mp[2 * 3072] = acc2; mp[3 * 3072] = acc3; continue; } r -= I_MOD;
    }
}

__device__ __forceinline__ void norm_phase(const Args& a, const int wave, LAS unsigned char* lds, const float* src, int layer) {
    const int lane = lane_id(), tid = wave * 64 + lane;
    LAS float* gs = (LAS float*)lds; LAS float* sh = gs + DM;
    const float* modp = (const float*)(a.ws + WS_MODP); bf16_t* H = (bf16_t*)(a.ws + WS_H);
    for (int tile = blockIdx.x; tile < MTOK / 128; tile += gridDim.x) {
        const int b = (tile * 128) / SEQ;
        __syncthreads();
        for (int c = tid; c < DM; c += NTHREADS) {
            float sc = a.ada_b[layer * 3072 + 1024 + c], sf = a.ada_b[layer * 3072 + c];
#pragma unroll
            for (int s = 0; s < 8; ++s) { const float* mp = modp + (size_t)((s * 2 + layer) * 4 + b) * 3072; sc += mp[1024 + c]; sf += mp[c]; }
            gs[c] = a.norm_g[layer * DM + c] * (1.0f + sc); sh[c] = sf; }
        __syncthreads();
        for (int r4 = 0; r4 < 16; r4 += 4) {
            f32x4 v[4][4]; float ss[4];
#pragma unroll
            for (int q = 0; q < 4; ++q) { const size_t m = (size_t)tile * 128 + wave * 16 + r4 + q; const f32x4* xr = (const f32x4*)(src + m * DM) + lane;
#pragma unroll
                for (int j = 0; j < 4; ++j) v[q][j] = xr[64 * j]; }
#pragma unroll
            for (int q = 0; q < 4; ++q) { float s = 0.f;
#pragma unroll
                for (int j = 0; j < 4; ++j) s += (v[q][j][0] * v[q][j][0] + v[q][j][1] * v[q][j][1]) + (v[q][j][2] * v[q][j][2] + v[q][j][3] * v[q][j][3]);
                ss[q] = s; }
#pragma unroll
            for (int q = 0; q < 4; ++q) ss[q] = wave_sum(ss[q]);
#pragma unroll
            for (int q = 0; q < 4; ++q) { const size_t m = (size_t)tile * 128 + wave * 16 + r4 + q; const float rstd = rsqrtf(ss[q] * (1.0f / DM) + 1e-6f);
                u32x2* o = (u32x2*)(H + m * DM) + lane;
#pragma unroll
                for (int j = 0; j < 4; ++j) { const f32x4 g = *(const LAS f32x4*)(gs + 4 * (64 * j + lane)), s = *(const LAS f32x4*)(sh + 4 * (64 * j + lane));
                    const f32x4 h = v[q][j] * rstd * g + s; u32x2 w; w.x = pk2(h[0], h[1]); w.y = pk2(h[2], h[3]); o[64 * j] = w; } }
        }
    }
}

__device__ __forceinline__ void final_phase(const Args& a, const int wave) {
    const int lane = lane_id(), tid = wave * 64 + lane;
    const int gw = blockIdx.x * NWAVES + wave, NGW = gridDim.x * NWAVES;
    f32x4 g[4];
#pragma unroll
    for (int j = 0; j < 4; ++j) g[j] = *((const f32x4*)a.final_g + 64 * j + lane);
    float tsc = 1.0f;
#ifdef STAMP_K
    { const unsigned long long* st = (const unsigned long long*)(a.ws + WS_STAMP); tsc = 1.0f + (float)(st[1] - st[0] + st[2]) * 1e-7f; }
#endif
    for (int m0 = 4 * gw; m0 < MTOK; m0 += 4 * NGW) {
        f32x4 v[4][4]; float ss[4];
#pragma unroll
        for (int q = 0; q < 4; ++q) { const f32x4* xr = (const f32x4*)(a.out + (size_t)(m0 + q) * DM) + lane;
#pragma unroll
            for (int j = 0; j < 4; ++j) v[q][j] = xr[64 * j]; }
#pragma unroll
        for (int q = 0; q < 4; ++q) { float s = 0.f;
#pragma unroll
            for (int j = 0; j < 4; ++j) s += (v[q][j][0] * v[q][j][0] + v[q][j][1] * v[q][j][1]) + (v[q][j][2] * v[q][j][2] + v[q][j][3] * v[q][j][3]);
            ss[q] = wave_sum(s); }
#pragma unroll
        for (int q = 0; q < 4; ++q) { const float rstd = rsqrtf(ss[q] * (1.0f / DM) + 1e-6f) * tsc; f32x4* xr = (f32x4*)(a.out + (size_t)(m0 + q) * DM) + lane;
#pragma unroll
            for (int j = 0; j < 4; ++j) xr[64 * j] = v[q][j] * rstd * g[j]; }
    }
}


__device__ __forceinline__ void conv_phase(const Args& a, const int wave, LAS unsigned char* lds, int first, int stride) {
    const int lane = lane_id(), tid = wave * 64 + lane;
    const bf16_t* U = (const bf16_t*)(a.ws + WS_U); const bf16_t* AG = (const bf16_t*)(a.ws + WS_AG); bf16_t* YAB = (bf16_t*)(a.ws + WS_YAB);
    f32x2 w[31];
#pragma unroll
    for (int j = 0; j < 31; ++j) w[j] = *(const f32x2*)(a.conv_w + j * DM + 2 * tid);
    const f32x2 cbias = *(const f32x2*)(a.conv_vec + 2 * tid);
    for (int tile = first; tile < MTOK / 32; tile += stride) {
        const int b = tile >> 8, s0 = (tile & 255) * 32;
        __syncthreads();
        for (int idx = tid; idx < 62 * 128; idx += NTHREADS) { const int row = idx >> 7, ch = idx & 127, s = s0 - 30 + row;
            u32x4 v = (u32x4){0u, 0u, 0u, 0u}; if (s >= 0) v = *(const u32x4*)(U + ((size_t)(b * SEQ + s)) * DM + ch * 8);
            *(LAS u32x4*)(lds + row * 2048 + ch * 16) = v; }
        __syncthreads();
        LAS unsigned char* rb0 = lds + tid * 4; LAS unsigned char* rb1 = rb0 + 65536; LAS unsigned char* wb0 = lds + tid * 8; LAS unsigned char* wb1 = wb0 + 65536;
        asm volatile("" : "+v"(rb0), "+v"(rb1), "+v"(wb0), "+v"(wb1));
        f32x2 acc[32];
#pragma unroll
        for (int t = 0; t < 32; ++t) acc[t] = (f32x2){0.f, 0.f};
#pragma unroll
        for (int i = 0; i < 62; ++i) { const unsigned xw = (i < 32) ? *(const LAS unsigned*)(rb0 + i * 2048) : *(const LAS unsigned*)(rb1 + (i - 32) * 2048); const f32x2 xv = (f32x2){bflo(xw), bfhi(xw)};
#pragma unroll
            for (int t = (i > 30 ? i - 30 : 0); t <= (i < 31 ? i : 31); ++t) acc[t] += xv * w[i - t]; }
        __syncthreads();
#pragma unroll
        for (int t = 0; t < 32; ++t) { if (t < 16) *(LAS f32x2*)(wb0 + t * 4096) = acc[t] + cbias; else *(LAS f32x2*)(wb1 + (t - 16) * 4096) = acc[t] + cbias; }
        __syncthreads();
        f32x4 lw[4], lb[4];
#pragma unroll
        for (int j = 0; j < 4; ++j) { lw[j] = *(const f32x4*)(a.conv_vec + DM + 4 * (lane + 64 * j)); lb[j] = *(const f32x4*)(a.conv_vec + 2 * DM + 4 * (lane + 64 * j)); }
        for (int tt = 0; tt < 4; ++tt) { const int t = wave * 4 + tt; const size_t m = (size_t)b * SEQ + s0 + t;
            f32x4 v[4]; float s = 0.f;
#pragma unroll
            for (int j = 0; j < 4; ++j) { v[j] = *(const LAS f32x4*)(lds + (size_t)t * 4096 + 16 * (lane + 64 * j)); s += (v[j][0] + v[j][1]) + (v[j][2] + v[j][3]); }
            const float mean = wave_sum(s) * (1.0f / DM); float q = 0.f;
#pragma unroll
            for (int j = 0; j < 4; ++j) { v[j] = v[j] - mean; q += (v[j][0] * v[j][0] + v[j][1] * v[j][1]) + (v[j][2] * v[j][2] + v[j][3] * v[j][3]); }
            const float rstd = rsqrtf(wave_sum(q) * (1.0f / DM) + 1e-5f);
#pragma unroll
            for (int j = 0; j < 4; ++j) { const f32x4 y = v[j] * rstd * lw[j] + lb[j]; const u32x2 g = *(const u32x2*)(AG + m * DM + 4 * (lane + 64 * j));
                const f32x4 o = silu4(y) * (f32x4){bflo(g.x), bfhi(g.x), bflo(g.y), bfhi(g.y)};
                u32x2 wv; wv.x = pk2(o[0], o[1]); wv.y = pk2(o[2], o[3]); *(u32x2*)(YAB + m * 2048 + 4 * (lane + 64 * j)) = wv; }
        }
    }
}

__device__ __forceinline__ void lora_pre_phase(const Args& a, const int wave) {
    const int lane = lane_id(), tid = wave * 64 + lane;

        const bf16_t* WDAD = (const bf16_t*)((unsigned char*)a.out + DO_WDAD); bf16_t* LA = (bf16_t*)((unsigned char*)a.out + DO_LA);
        const int gw = blockIdx.x * NWAVES + wave, NGW = gridDim.x * NWAVES;
        const f32x2 mu = *(const f32x2*)(a.mu_lora + 2 * lane);
        for (int m0 = gw * 4; m0 < MTOK; m0 += NGW * 4) {
            unsigned cur[4], prv[4];
#pragma unroll
            for (int i = 0; i < 4; ++i) { const int m = m0 + i; cur[i] = *(const unsigned*)(WDAD + (size_t)m * 128 + 2 * lane); }
#pragma unroll
            for (int i = 0; i < 4; ++i) { const int m = m0 + i; if (i > 0) prv[i] = cur[i - 1]; else { prv[0] = 0u; if ((m & (SEQ - 1)) > 0) prv[0] = *(const unsigned*)(WDAD + (size_t)(m - 1) * 128 + 2 * lane); } }
#pragma unroll
            for (int i = 0; i < 4; ++i) { const int m = m0 + i;
                float v0 = bflo(cur[i]), v1 = bfhi(cur[i]); v0 += (bflo(prv[i]) - v0) * mu[0]; v1 += (bfhi(prv[i]) - v1) * mu[1];
                if (lane < 32) { v0 = tanhf(v0); v1 = tanhf(v1); }
                *(unsigned*)(LA + (size_t)m * 256 + 2 * lane) = pk2(v0, v1); *(unsigned*)(LA + (size_t)m * 256 + 128 + 2 * lane) = 0u; }
        }
    }

struct ScanRaw { u32x2 r, rp, k, kp, v, vp, d, a; };
constexpr int SC_CH = 16, SC_BUF_F = 5 * SC_CH * 64 + SC_CH * 16;

__device__ __forceinline__ void scan_phase(const Args& a, const int wave, LAS unsigned char* lds) {
    const int lane = lane_id(), tid = wave * 64 + lane;
    const bf16_t* Rg = (const bf16_t*)(a.ws + WS_R); const bf16_t* Kg = (const bf16_t*)(a.ws + WS_K); const bf16_t* Vg = (const bf16_t*)(a.ws + WS_V);
    const bf16_t* Dg = (const bf16_t*)(a.ws + WS_DARR); const bf16_t* Ag = (const bf16_t*)(a.ws + WS_AARR);
    bf16_t* YAB = (bf16_t*)(a.ws + WS_YAB); float* RK = (float*)((unsigned char*)a.out + DO_RK);
    LAS float* bufs = (LAS float*)lds; LAS float* ybuf = bufs + 2 * SC_BUF_F;
    constexpr int NCH = SEQ / SC_CH;
    for (int job = blockIdx.x; job < 256; job += gridDim.x) {
        const int vcu = (gridDim.x == 256) ? ((job & 7) * 32 + (job >> 3)) : job;
        const int bh = vcu >> 2, vq = vcu & 3, b = bh >> 4, h = bh & 15;
        __syncthreads();
        if (wave >= 4) {
            const int pt = tid - 256, tok = pt >> 4, cgp = pt & 15, ch = h * 64 + 4 * cgp;
            const f32x4 mur = *(const f32x4*)(a.mu_rkv + ch), muk = *(const f32x4*)(a.mu_rkv + DM + ch), muv = *(const f32x4*)(a.mu_rkv + 2 * DM + ch);
            const f32x4 k_k = *(const f32x4*)(a.rwkv_vec + 2 * DM + ch), k_a = *(const f32x4*)(a.rwkv_vec + 3 * DM + ch), rkw = *(const f32x4*)(a.r_k + ch);
            auto load = [&](int c) { ScanRaw q; const int s = c * SC_CH + tok; const size_t m = (size_t)b * SEQ + s; const size_t o = m * DM + ch; const size_t op = (s > 0) ? o - DM : o;
                q.r = *(const u32x2*)(Rg + o); q.k = *(const u32x2*)(Kg + o); q.v = *(const u32x2*)(Vg + o); q.d = *(const u32x2*)(Dg + o); q.a = *(const u32x2*)(Ag + o);
                q.rp = *(const u32x2*)(Rg + op); q.kp = *(const u32x2*)(Kg + op); q.vp = *(const u32x2*)(Vg + op);
                if (s == 0) { q.rp = (u32x2){0u, 0u}; q.kp = (u32x2){0u, 0u}; q.vp = (u32x2){0u, 0u}; }
                return q; };
            auto un4 = [](u32x2 w) { return (f32x4){bflo(w.x), bfhi(w.x), bflo(w.y), bfhi(w.y)}; };
            auto process = [&](const ScanRaw& q, int c, LAS float* buf) {
                const f32x4 r0 = un4(q.r), k0 = un4(q.k), v0 = un4(q.v);
                const f32x4 rl = r0 + (un4(q.rp) - r0) * mur, kl = k0 + (un4(q.kp) - k0) * muk, vl = v0 + (un4(q.vp) - v0) * muv;
                const f32x4 d = un4(q.d), av = un4(q.a);
                f32x4 wdec; wdec[0] = __expf(-d[0]); wdec[1] = __expf(-d[1]); wdec[2] = __expf(-d[2]); wdec[3] = __expf(-d[3]);
                const f32x4 kkr = kl * k_k; float ss = (kkr[0] * kkr[0] + kkr[1] * kkr[1]) + (kkr[2] * kkr[2] + kkr[3] * kkr[3]); ss = row16_sum(ss);
                const float inv = 1.0f / fmaxf(sqrtf(ss), 1e-12f);
                const f32x4 kk = kkr * inv, kp = kl * (1.0f + (av - 1.0f) * k_a), bb = kk * av;
                float rk = (rl[0] * kp[0] * rkw[0] + rl[1] * kp[1] * rkw[1]) + (rl[2] * kp[2] * rkw[2] + rl[3] * kp[3] * rkw[3]); rk = row16_sum(rk);
                const int o = tok * 64 + 4 * cgp;
                *(LAS f32x4*)(buf + o) = -kk; *(LAS f32x4*)(buf + 1024 + o) = wdec; *(LAS f32x4*)(buf + 2048 + o) = bb; *(LAS f32x4*)(buf + 3072 + o) = kp; *(LAS f32x4*)(buf + 4096 + o) = rl;
                if ((cgp >> 2) == vq) *(LAS f32x4*)(buf + 5120 + tok * 16 + 4 * (cgp & 3)) = vl;
                if (vq == 0 && cgp == 0) RK[((size_t)b * SEQ + c * SC_CH + tok) * 16 + h] = rk; };
            auto flush = [&](int c, const LAS float* yb) {
                if (wave == 4) { const int t2 = lane >> 2, rq = lane & 3; const f32x4 y = *(const LAS f32x4*)(yb + t2 * 16 + 4 * rq);
                    u32x2 wv; wv.x = pk2(y[0], y[1]); wv.y = pk2(y[2], y[3]);
                    *(u32x2*)(YAB + ((size_t)b * SEQ + c * SC_CH + t2) * 2048 + 1024 + h * 64 + 16 * vq + 4 * rq) = wv; } };
            ScanRaw q0 = load(0), q1 = load(1);
            process(q0, 0, bufs); q0 = q1; q1 = load(2);
            __syncthreads();
            for (int c = 0; c < NCH; ++c) {
                if (c + 1 < NCH) process(q0, c + 1, bufs + ((c + 1) & 1) * SC_BUF_F);
                q0 = q1; if (c + 3 < NCH) q1 = load(c + 3);
                if (c >= 1) flush(c - 1, ybuf + ((c - 1) & 1) * 256);
                __syncthreads();
            }
            flush(NCH - 1, ybuf + ((NCH - 1) & 1) * 256);
        } else {
            const int rw = lane >> 4, ks = lane & 15, row = wave * 4 + rw;
            float s0 = 0.f, s1 = 0.f, s2 = 0.f, s3 = 0.f;
            __syncthreads();
            for (int c = 0; c < NCH; ++c) {
                const LAS float* buf = bufs + (c & 1) * SC_BUF_F; LAS float* yb = ybuf + (c & 1) * 256;
#pragma unroll
                for (int t = 0; t < SC_CH; ++t) {
                    const f32x4 nk = *(const LAS f32x4*)(buf + t * 64 + 4 * ks), w4 = *(const LAS f32x4*)(buf + 1024 + t * 64 + 4 * ks), b4 = *(const LAS f32x4*)(buf + 2048 + t * 64 + 4 * ks);
                    const f32x4 kp = *(const LAS f32x4*)(buf + 3072 + t * 64 + 4 * ks), r4 = *(const LAS f32x4*)(buf + 4096 + t * 64 + 4 * ks); const float vv = buf[5120 + t * 16 + row];
                    float sa = (s0 * nk[0] + s1 * nk[1]) + (s2 * nk[2] + s3 * nk[3]); sa = row16_sum(sa);
                    s0 = s0 * w4[0] + (sa * b4[0] + vv * kp[0]); s1 = s1 * w4[1] + (sa * b4[1] + vv * kp[1]);
                    s2 = s2 * w4[2] + (sa * b4[2] + vv * kp[2]); s3 = s3 * w4[3] + (sa * b4[3] + vv * kp[3]);
                    float y = (s0 * r4[0] + s1 * r4[1]) + (s2 * r4[2] + s3 * r4[3]); y = row16_sum(y);
                    if (ks == 0) yb[t * 16 + row] = y;
                }
                __syncthreads();
            }
        }
    }
}

__device__ __forceinline__ void post_phase(const Args& a, const int wave) {
    const int lane = lane_id(), tid = wave * 64 + lane;
    const int gw = blockIdx.x * NWAVES + wave, NGW = gridDim.x * NWAVES;
    const bf16_t* Vg = (const bf16_t*)(a.ws + WS_V); const bf16_t* BG = (const bf16_t*)((unsigned char*)a.out + DO_BG); const float* RK = (const float*)((unsigned char*)a.out + DO_RK);
    bf16_t* YAB = (bf16_t*)(a.ws + WS_YAB);
    const int head = lane >> 2, c0 = head * 64 + 16 * (lane & 3);
    f32x4 muv[4], lw[4], lb[4];
#pragma unroll
    for (int j = 0; j < 4; ++j) { muv[j] = *(const f32x4*)(a.mu_rkv + 2 * DM + c0 + 4 * j); lw[j] = *(const f32x4*)(a.rwkv_vec + 4 * DM + c0 + 4 * j); lb[j] = *(const f32x4*)(a.rwkv_vec + 5 * DM + c0 + 4 * j); }
    auto un4 = [](unsigned x, unsigned y) { return (f32x4){bflo(x), bfhi(x), bflo(y), bfhi(y)}; };
    for (int m = gw; m < MTOK; m += NGW) { const int s = m & (SEQ - 1);
        bf16_t* yp = YAB + (size_t)m * 2048 + 1024 + c0;
        const u32x4 ya = *(const u32x4*)yp, yb2 = *(const u32x4*)(yp + 8);
        const u32x4 va = *(const u32x4*)(Vg + (size_t)m * DM + c0), vb = *(const u32x4*)(Vg + (size_t)m * DM + c0 + 8);
        u32x4 pa = (u32x4){0u, 0u, 0u, 0u}, pb = pa; if (s > 0) { pa = *(const u32x4*)(Vg + (size_t)(m - 1) * DM + c0); pb = *(const u32x4*)(Vg + (size_t)(m - 1) * DM + c0 + 8); }
        const u32x4 ga = *(const u32x4*)(BG + (size_t)m * DM + c0), gb = *(const u32x4*)(BG + (size_t)m * DM + c0 + 8);
        const float rk = RK[(size_t)m * 16 + head];
        f32x4 y[4] = {un4(ya.x, ya.y), un4(ya.z, ya.w), un4(yb2.x, yb2.y), un4(yb2.z, yb2.w)};
        const f32x4 v[4] = {un4(va.x, va.y), un4(va.z, va.w), un4(vb.x, vb.y), un4(vb.z, vb.w)};
        const f32x4 p[4] = {un4(pa.x, pa.y), un4(pa.z, pa.w), un4(pb.x, pb.y), un4(pb.z, pb.w)};
        const f32x4 g[4] = {un4(ga.x, ga.y), un4(ga.z, ga.w), un4(gb.x, gb.y), un4(gb.z, gb.w)};
        float sm = 0.f;
#pragma unroll
        for (int j = 0; j < 4; ++j) sm += (y[j][0] + y[j][1]) + (y[j][2] + y[j][3]);
        const float mean = quad_sum(sm) * (1.0f / 64.0f); float q = 0.f;
#pragma unroll
        for (int j = 0; j < 4; ++j) { y[j] = y[j] - mean; q += (y[j][0] * y[j][0] + y[j][1] * y[j][1]) + (y[j][2] * y[j][2] + y[j][3] * y[j][3]); }
        const float rstd = rsqrtf(quad_sum(q) * (1.0f / 64.0f) + 64e-5f);
        u32x4 o[2];
#pragma unroll
        for (int j = 0; j < 4; ++j) { const f32x4 vl = v[j] + (p[j] - v[j]) * muv[j]; const f32x4 r = (y[j] * rstd * lw[j] + lb[j] + rk * vl) * g[j];
            if (j & 1) { o[j >> 1].z = pk2(r[0], r[1]); o[j >> 1].w = pk2(r[2], r[3]); } else { o[j >> 1].x = pk2(r[0], r[1]); o[j >> 1].y = pk2(r[2], r[3]); } }
        *(u32x4*)yp = o[0]; *(u32x4*)(yp + 8) = o[1];
    }
}

constexpr int CS_L = 32, CS_NCH = SEQ / CS_L, CS_NSLOT = 3;
constexpr int CS_NT = 0, CS_RT = 4096, CS_BT = 8192, CS_KT = 12288, CS_TM = 8192, CS_AKN = 10240, CS_ABR = 12288, CS_AKR = 14336, CS_BC = 16384, CS_KC = 20480, CS_VC = 24576, CS_GL = 28672, CS_SLOT = 29184;
constexpr int CS_RAW = CS_NSLOT * CS_SLOT, CS_RAWSZ = 5 * 33 * 128;
constexpr int CS_FLAGS = CS_RAW + CS_NSLOT * CS_RAWSZ;
static_assert(CS_FLAGS + 64 <= LDS_BYTES && (CS_RAW % 16) == 0 && (CS_RAWSZ % 16) == 0, "chunked scan LDS map");
__device__ __forceinline__ int permp(int j) { return 8 * ((j & 15) >> 2) + 4 * (j >> 4) + (j & 3); }
template <int CTRL, int RM> __device__ __forceinline__ float dppf(float x) { return __int_as_float(__builtin_amdgcn_update_dpp(0, __float_as_int(x), CTRL, RM, 0xf, true)); }
__device__ __forceinline__ float wave_total(float x) {
    x = row16_sum(x); x += dppf<0x142, 0xa>(x); x += dppf<0x143, 0xc>(x); return __int_as_float(__builtin_amdgcn_readlane(__float_as_int(x), 63)); }
__device__ __forceinline__ float wave_sum64(float x) { x = row16_sum(x); x += __shfl_xor(x, 16); x += __shfl_xor(x, 32); return x; }
__device__ __forceinline__ bf16x8 cfrag(const f32x16& x, int s) {
    u32x4 w; w.x = pk2(x[8 * s + 0], x[8 * s + 1]); w.y = pk2(x[8 * s + 2], x[8 * s + 3]); w.z = pk2(x[8 * s + 4], x[8 * s + 5]); w.w = pk2(x[8 * s + 6], x[8 * s + 7]); return __builtin_bit_cast(bf16x8, w); }
__device__ __forceinline__ bf16x8 cfrag2(const f32x4& a, const f32x4& b) { u32x4 w; w.x = pk2(a[0], a[1]); w.y = pk2(a[2], a[3]); w.z = pk2(b[0], b[1]); w.w = pk2(b[2], b[3]); return __builtin_bit_cast(bf16x8, w); }
__device__ __forceinline__ void lds_poll_ge(LAS unsigned* p, unsigned want) { while (__hip_atomic_load(p, __ATOMIC_RELAXED, __HIP_MEMORY_SCOPE_WORKGROUP) < want) __builtin_amdgcn_s_sleep(1); asm volatile("" ::: "memory"); }

__device__ __forceinline__ void cscan_job(const Args& a, const int wave, LAS unsigned char* lds, int bh) {
    int lane; asm volatile("v_mbcnt_lo_u32_b32 %0, -1, 0\n\tv_mbcnt_hi_u32_b32 %0, -1, %0" : "=v"(lane));
    const int tid = wave * 64 + lane;
    const int b = bh >> 4, h = bh & 15;
    const bf16_t* Rg = (const bf16_t*)(a.ws + WS_R); const bf16_t* Kg = (const bf16_t*)(a.ws + WS_K); const bf16_t* Vg = (const bf16_t*)(a.ws + WS_V);
    const bf16_t* Dg = (const bf16_t*)(a.ws + WS_DARR); const bf16_t* Ag = (const bf16_t*)(a.ws + WS_AARR);
    bf16_t* YAB = (bf16_t*)(a.ws + WS_YAB); float* RK = (float*)((unsigned char*)a.out + DO_RK);
    LAS unsigned* ready = (LAS unsigned*)(lds + CS_FLAGS); LAS unsigned* done = ready + CS_NSLOT; LAS unsigned* rawready = done + CS_NSLOT; LAS unsigned* rawfree = rawready + CS_NSLOT;
    __syncthreads();
    if (tid < 4 * CS_NSLOT) ready[tid] = 0u;
    __syncthreads();
    if (wave == 4) {
        const int rr = lane >> 3, cc = lane & 7;
        for (int c = 0; c < CS_NCH; ++c) {
            const int s = c % CS_NSLOT; LAS unsigned char* rw = lds + CS_RAW + s * CS_RAWSZ;
            const size_t m0 = (size_t)b * SEQ + (size_t)c * CS_L;
            u32x4 v[5][4], vp[3];
#pragma unroll
            for (int ar = 0; ar < 5; ++ar) { const bf16_t* src = (ar == 0) ? Rg : (ar == 1) ? Kg : (ar == 2) ? Vg : (ar == 3) ? Dg : Ag;
#pragma unroll
                for (int q4 = 0; q4 < 4; ++q4) v[ar][q4] = *(const u32x4*)(src + (m0 + 8 * q4 + rr) * DM + h * 64 + 8 * cc); }
#pragma unroll
            for (int ar = 0; ar < 3; ++ar) { const bf16_t* src = (ar == 0) ? Rg : (ar == 1) ? Kg : Vg; vp[ar] = (u32x4){0u, 0u, 0u, 0u};
                if (c > 0 && lane < 8) vp[ar] = *(const u32x4*)(src + (m0 - 1) * DM + h * 64 + 8 * cc); }
            if (c >= CS_NSLOT) lds_poll_ge(rawfree + s, (unsigned)(c / CS_NSLOT));
#pragma unroll
            for (int ar = 0; ar < 5; ++ar)
#pragma unroll
                for (int q4 = 0; q4 < 4; ++q4) *(LAS u32x4*)(rw + (ar * 33 + 1 + 8 * q4 + rr) * 128 + 16 * cc) = v[ar][q4];
            if (lane < 8) {
#pragma unroll
                for (int ar = 0; ar < 3; ++ar) *(LAS u32x4*)(rw + (ar * 33) * 128 + 16 * cc) = vp[ar]; }
            LDS_WAIT();
            if (lane == 0) __hip_atomic_store(rawready + s, (unsigned)(c + 1), __ATOMIC_RELAXED, __HIP_MEMORY_SCOPE_WORKGROUP);
        }
    } else if (wave >= 5) {
        const int hw = wave - 5, gch = h * 64 + lane;
        const float mur = a.mu_rkv[gch], muk = a.mu_rkv[DM + gch], muv = a.mu_rkv[2 * DM + gch], kkw = a.rwkv_vec[2 * DM + gch], kaw = a.rwkv_vec[3 * DM + gch], rkw = a.r_k[gch];
        const int kpos = 32 * (lane >> 5) + permp(lane & 31);
        for (int c = hw; c < CS_NCH; c += CS_NSLOT) {
            const int s = hw; LAS unsigned char* sl = lds + s * CS_SLOT; const LAS unsigned short* rw = (const LAS unsigned short*)(lds + CS_RAW + s * CS_RAWSZ);
            const unsigned use = (unsigned)(c / CS_NSLOT);
            { PROBE_BEGIN(10, a.ws, wave);
            if (use > 0u) lds_poll_ge(done + s, 4u * use);
            lds_poll_ge(rawready + s, (unsigned)(c + 1));
            PROBE_END(10, a.ws, wave); }
            PROBE_BEGIN(11, a.ws, wave);
            const size_t m0 = (size_t)b * SEQ + (size_t)c * CS_L; const size_t o0 = m0 * DM + gch;
            float rp = bflo((unsigned)rw[(0 * 33) * 64 + lane]), kp = bflo((unsigned)rw[(1 * 33) * 64 + lane]), vp = bflo((unsigned)rw[(2 * 33) * 64 + lane]);
            float cum = 0.f, gprev = 1.f;
            unsigned bcw[16], kcw[16], vcw[16];
#pragma unroll
            for (int grp = 0; grp < 4; ++grp) {
                float rlv[8], kkrv[8], kprv[8], vlv[8], aav[8], ddv[8], red[16];
#pragma unroll
                for (int e = 0; e < 8; ++e) { const int row = 1 + 8 * grp + e;
                    const float r0 = bflo((unsigned)rw[(0 * 33 + row) * 64 + lane]), k0 = bflo((unsigned)rw[(1 * 33 + row) * 64 + lane]), v0 = bflo((unsigned)rw[(2 * 33 + row) * 64 + lane]);
                    ddv[e] = bflo((unsigned)rw[(3 * 33 + row) * 64 + lane]); aav[e] = bflo((unsigned)rw[(4 * 33 + row) * 64 + lane]);
                    rlv[e] = r0 + (rp - r0) * mur; const float kl = k0 + (kp - k0) * muk; vlv[e] = v0 + (vp - v0) * muv; rp = r0; kp = k0; vp = v0;
                    kkrv[e] = kl * kkw; kprv[e] = kl * (1.0f + (aav[e] - 1.0f) * kaw);
                    red[2 * e] = kkrv[e] * kkrv[e]; red[2 * e + 1] = rlv[e] * kprv[e] * rkw; }
#pragma unroll
                for (int e = 0; e < 16; ++e) red[e] += dppf<0xB1, 0xf>(red[e]);
#pragma unroll
                for (int e = 0; e < 16; ++e) red[e] += dppf<0x4E, 0xf>(red[e]);
#pragma unroll
                for (int e = 0; e < 16; ++e) red[e] += dppf<0x141, 0xf>(red[e]);
#pragma unroll
                for (int e = 0; e < 16; ++e) red[e] += dppf<0x140, 0xf>(red[e]);
#pragma unroll
                for (int e = 0; e < 16; ++e) red[e] += dppf<0x142, 0xa>(red[e]);
#pragma unroll
                for (int e = 0; e < 16; ++e) red[e] += dppf<0x143, 0xc>(red[e]);
#pragma unroll
                for (int e = 0; e < 16; ++e) red[e] = __int_as_float(__builtin_amdgcn_readlane(__float_as_int(red[e]), 63));
                if (lane < 8) { float rkv = red[1];
#pragma unroll
                    for (int e = 1; e < 8; ++e) rkv = (lane == e) ? red[2 * e + 1] : rkv;
                    RK[(m0 + 8 * grp + lane) * 16 + h] = rkv; }
#pragma unroll
                for (int j2 = 0; j2 < 4; ++j2) {
                    const int i2 = 4 * grp + j2;
                    float nt[2], bt[2], kt[2], rt[2], vt[2];
#pragma unroll
                    for (int e = 0; e < 2; ++e) { const int te = 2 * j2 + e;
                        const float kkv = kkrv[te] * __builtin_amdgcn_rsqf(fmaxf(red[2 * te], 1e-24f)), bb = kkv * aav[te];
                        cum += ddv[te]; const float gi = __expf(-cum), ginv = __builtin_amdgcn_rcpf(gi);
                        nt[e] = -kkv * gprev; bt[e] = bb * ginv; kt[e] = kprv[te] * ginv; rt[e] = rlv[te] * gi; vt[e] = vlv[te]; gprev = gi; }
                    const unsigned wn = pk2(nt[0], nt[1]), wb = pk2(bt[0], bt[1]), wk = pk2(kt[0], kt[1]), wr = pk2(rt[0], rt[1]), wv = pk2(vt[0], vt[1]);
                    const int i = 2 * i2;
                    *(LAS unsigned short*)(sl + CS_NT + (i * 64 + kpos) * 2) = (unsigned short)wn; *(LAS unsigned short*)(sl + CS_NT + ((i + 1) * 64 + kpos) * 2) = (unsigned short)(wn >> 16);
                    *(LAS unsigned short*)(sl + CS_RT + (i * 64 + kpos) * 2) = (unsigned short)wr; *(LAS unsigned short*)(sl + CS_RT + ((i + 1) * 64 + kpos) * 2) = (unsigned short)(wr >> 16);
                    *(LAS unsigned short*)(sl + CS_BT + (i * 64 + kpos) * 2) = (unsigned short)wb; *(LAS unsigned short*)(sl + CS_BT + ((i + 1) * 64 + kpos) * 2) = (unsigned short)(wb >> 16);
                    *(LAS unsigned short*)(sl + CS_KT + (i * 64 + kpos) * 2) = (unsigned short)wk; *(LAS unsigned short*)(sl + CS_KT + ((i + 1) * 64 + kpos) * 2) = (unsigned short)(wk >> 16);
                    const int pw = permp(i) >> 1;
                    bcw[pw] = wb; kcw[pw] = wk; vcw[pw] = wv;
                }
                __builtin_amdgcn_sched_barrier(0);
            }
#pragma unroll
            for (int q4 = 0; q4 < 4; ++q4) {
                *(LAS u32x4*)(sl + CS_BC + lane * 64 + 16 * q4) = (u32x4){bcw[4 * q4], bcw[4 * q4 + 1], bcw[4 * q4 + 2], bcw[4 * q4 + 3]};
                *(LAS u32x4*)(sl + CS_KC + lane * 64 + 16 * q4) = (u32x4){kcw[4 * q4], kcw[4 * q4 + 1], kcw[4 * q4 + 2], kcw[4 * q4 + 3]};
                *(LAS u32x4*)(sl + CS_VC + lane * 64 + 16 * q4) = (u32x4){vcw[4 * q4], vcw[4 * q4 + 1], vcw[4 * q4 + 2], vcw[4 * q4 + 3]}; }
            *(LAS float*)(sl + CS_GL + lane * 4) = gprev;
            LDS_WAIT();
            if (lane == 0) __hip_atomic_store(rawfree + s, use + 1u, __ATOMIC_RELAXED, __HIP_MEMORY_SCOPE_WORKGROUP);
            PROBE_END(11, a.ws, wave);
            PROBE_BEGIN(12, a.ws, wave);
            const int tok = lane & 31, hf = lane >> 5;
            bf16x8 fn[4], fr[4], fb[4], fk[4];
#pragma unroll
            for (int ks = 0; ks < 4; ++ks) { fn[ks] = *(const LAS bf16x8*)(sl + CS_NT + (tok * 64 + 16 * ks + 8 * hf) * 2); fr[ks] = *(const LAS bf16x8*)(sl + CS_RT + (tok * 64 + 16 * ks + 8 * hf) * 2);
                fb[ks] = *(const LAS bf16x8*)(sl + CS_BT + (tok * 64 + 16 * ks + 8 * hf) * 2); fk[ks] = *(const LAS bf16x8*)(sl + CS_KT + (tok * 64 + 16 * ks + 8 * hf) * 2); }
            f32x16 P, Pt, Tm, Akn, Abr, Akr;
#pragma unroll
            for (int e = 0; e < 16; ++e) { P[e] = 0.f; Pt[e] = 0.f; Akn[e] = 0.f; Abr[e] = 0.f; Akr[e] = 0.f; }
#pragma unroll
            for (int ks = 0; ks < 4; ++ks) { P = __builtin_amdgcn_mfma_f32_32x32x16_bf16(fn[ks], fb[ks], P, 0, 0, 0); Pt = __builtin_amdgcn_mfma_f32_32x32x16_bf16(fb[ks], fn[ks], Pt, 0, 0, 0);
                Akn = __builtin_amdgcn_mfma_f32_32x32x16_bf16(fn[ks], fk[ks], Akn, 0, 0, 0); Abr = __builtin_amdgcn_mfma_f32_32x32x16_bf16(fr[ks], fb[ks], Abr, 0, 0, 0); Akr = __builtin_amdgcn_mfma_f32_32x32x16_bf16(fr[ks], fk[ks], Akr, 0, 0, 0); }
#pragma unroll
            for (int e = 0; e < 16; ++e) { const int row = (e & 3) + 8 * (e >> 2) + 4 * hf, col = tok;
                if (!(col < row)) { P[e] = 0.f; Akn[e] = 0.f; } if (!(row < col)) Pt[e] = 0.f; if (col > row) { Abr[e] = 0.f; Akr[e] = 0.f; }
                Tm[e] = P[e] + (row == col ? 1.0f : 0.f); }
#pragma unroll
            for (int mm = 1; mm <= 4; ++mm) {
                const bf16x8 p0 = cfrag(P, 0), p1 = cfrag(P, 1), q0 = cfrag(Pt, 0), q1 = cfrag(Pt, 1);
                f32x16 Ptn, Pn;
#pragma unroll
                for (int e = 0; e < 16; ++e) { Ptn[e] = 0.f; Pn[e] = 0.f; }
                Ptn = __builtin_amdgcn_mfma_f32_32x32x16_bf16(p0, q0, Ptn, 0, 0, 0); Ptn = __builtin_amdgcn_mfma_f32_32x32x16_bf16(p1, q1, Ptn, 0, 0, 0);
                if (mm < 4) { Pn = __builtin_amdgcn_mfma_f32_32x32x16_bf16(q0, p0, Pn, 0, 0, 0); Pn = __builtin_amdgcn_mfma_f32_32x32x16_bf16(q1, p1, Pn, 0, 0, 0); }
                const bf16x8 t0 = cfrag(Tm, 0), t1 = cfrag(Tm, 1), u0 = cfrag(Ptn, 0), u1 = cfrag(Ptn, 1);
                Tm = __builtin_amdgcn_mfma_f32_32x32x16_bf16(u0, t0, Tm, 0, 0, 0); Tm = __builtin_amdgcn_mfma_f32_32x32x16_bf16(u1, t1, Tm, 0, 0, 0);
                P = Pn; Pt = Ptn;
            }
            { const int pc = permp(tok);
#pragma unroll
              for (int e = 0; e < 16; e += 2) { const int row = (e & 3) + 8 * (e >> 2) + 4 * hf;
                const unsigned w0 = pk2(Tm[e], Tm[e + 1]), w1 = pk2(Akn[e], Akn[e + 1]), w2 = pk2(Abr[e], Abr[e + 1]), w3 = pk2(Akr[e], Akr[e + 1]);
                *(LAS unsigned short*)(sl + CS_TM + (row * 32 + pc) * 2) = (unsigned short)w0; *(LAS unsigned short*)(sl + CS_TM + ((row + 1) * 32 + pc) * 2) = (unsigned short)(w0 >> 16);
                *(LAS unsigned short*)(sl + CS_AKN + (row * 32 + pc) * 2) = (unsigned short)w1; *(LAS unsigned short*)(sl + CS_AKN + ((row + 1) * 32 + pc) * 2) = (unsigned short)(w1 >> 16);
                *(LAS unsigned short*)(sl + CS_ABR + (row * 32 + pc) * 2) = (unsigned short)w2; *(LAS unsigned short*)(sl + CS_ABR + ((row + 1) * 32 + pc) * 2) = (unsigned short)(w2 >> 16);
                *(LAS unsigned short*)(sl + CS_AKR + (row * 32 + pc) * 2) = (unsigned short)w3; *(LAS unsigned short*)(sl + CS_AKR + ((row + 1) * 32 + pc) * 2) = (unsigned short)(w3 >> 16); } }
            LDS_WAIT();
            if (lane == 0) __hip_atomic_store(ready + s, (unsigned)(c + 1), __ATOMIC_RELAXED, __HIP_MEMORY_SCOPE_WORKGROUP);
            PROBE_END(12, a.ws, wave);
        }
    } else {
        const int l15 = lane & 15, g = lane >> 4, vb = wave;
        f32x4 xc[4];
#pragma unroll
        for (int kt = 0; kt < 4; ++kt) xc[kt] = (f32x4){0.f, 0.f, 0.f, 0.f};
        for (int c = 0; c < CS_NCH; ++c) {
            const int s = c % CS_NSLOT; const LAS unsigned char* sl = lds + s * CS_SLOT;
            lds_poll_ge(ready + s, (unsigned)(c + 1));
            const bf16x8 xb0 = cfrag2(xc[0], xc[1]), xb1 = cfrag2(xc[2], xc[3]);
            const bf16x8 vop = *(const LAS bf16x8*)(sl + CS_VC + ((16 * vb + l15) * 32 + 8 * g) * 2);
            f32x4 W[2], U[2], Y[2];
#pragma unroll
            for (int rt = 0; rt < 2; ++rt) { const int row = 16 * rt + l15; f32x4 acc = (f32x4){0.f, 0.f, 0.f, 0.f};
                acc = __builtin_amdgcn_mfma_f32_16x16x32_bf16(*(const LAS bf16x8*)(sl + CS_AKN + (row * 32 + 8 * g) * 2), vop, acc, 0, 0, 0);
                acc = __builtin_amdgcn_mfma_f32_16x16x32_bf16(*(const LAS bf16x8*)(sl + CS_NT + (row * 64 + 8 * g) * 2), xb0, acc, 0, 0, 0);
                acc = __builtin_amdgcn_mfma_f32_16x16x32_bf16(*(const LAS bf16x8*)(sl + CS_NT + (row * 64 + 32 + 8 * g) * 2), xb1, acc, 0, 0, 0);
                W[rt] = acc; }
            const bf16x8 wb = cfrag2(W[0], W[1]);
#pragma unroll
            for (int rt = 0; rt < 2; ++rt) { const int row = 16 * rt + l15;
                U[rt] = __builtin_amdgcn_mfma_f32_16x16x32_bf16(*(const LAS bf16x8*)(sl + CS_TM + (row * 32 + 8 * g) * 2), wb, (f32x4){0.f, 0.f, 0.f, 0.f}, 0, 0, 0); }
            const bf16x8 ub = cfrag2(U[0], U[1]);
#pragma unroll
            for (int rt = 0; rt < 2; ++rt) { const int row = 16 * rt + l15; f32x4 acc = (f32x4){0.f, 0.f, 0.f, 0.f};
                acc = __builtin_amdgcn_mfma_f32_16x16x32_bf16(*(const LAS bf16x8*)(sl + CS_AKR + (row * 32 + 8 * g) * 2), vop, acc, 0, 0, 0);
                acc = __builtin_amdgcn_mfma_f32_16x16x32_bf16(*(const LAS bf16x8*)(sl + CS_RT + (row * 64 + 8 * g) * 2), xb0, acc, 0, 0, 0);
                acc = __builtin_amdgcn_mfma_f32_16x16x32_bf16(*(const LAS bf16x8*)(sl + CS_RT + (row * 64 + 32 + 8 * g) * 2), xb1, acc, 0, 0, 0);
                acc = __builtin_amdgcn_mfma_f32_16x16x32_bf16(*(const LAS bf16x8*)(sl + CS_ABR + (row * 32 + 8 * g) * 2), ub, acc, 0, 0, 0);
                Y[rt] = acc; }
#pragma unroll
            for (int kt = 0; kt < 4; ++kt) { const int row = 16 * kt + l15; f32x4 acc = xc[kt];
                acc = __builtin_amdgcn_mfma_f32_16x16x32_bf16(*(const LAS bf16x8*)(sl + CS_KC + (row * 32 + 8 * g) * 2), vop, acc, 0, 0, 0);
                acc = __builtin_amdgcn_mfma_f32_16x16x32_bf16(*(const LAS bf16x8*)(sl + CS_BC + (row * 32 + 8 * g) * 2), ub, acc, 0, 0, 0);
                xc[kt] = acc * *(const LAS f32x4*)(sl + CS_GL + (16 * kt + 4 * g) * 4); }
            LDS_WAIT();
            if (lane == 0) (void)__hip_atomic_fetch_add(done + s, 1u, __ATOMIC_RELAXED, __HIP_MEMORY_SCOPE_WORKGROUP);
#pragma unroll
            for (int rt = 0; rt < 2; ++rt)
#pragma unroll
                for (int e = 0; e < 4; ++e) { const size_t m = (size_t)b * SEQ + (size_t)c * CS_L + 16 * rt + 4 * g + e;
                    YAB[m * 2048 + 1024 + h * 64 + 16 * vb + l15] = (bf16_t)(pk2(Y[rt][e], 0.f) & 0xffffu); }
        }
    }
}

constexpr int CR_PIECE = 12, CR_NP = (CS_NCH + CR_PIECE - 1) / CR_PIECE, CR_PW = 4, CR_PSLOT = CS_SLOT + 2 * 33 * 128;
constexpr size_t DO_IMG = 66 * MiB;
static_assert((CR_PIECE % 4) == 0 && DO_IMG + (size_t)2 * 64 * CR_PIECE * CS_SLOT <= 128 * MiB && CR_PW * CR_PSLOT <= CS_FLAGS, "image buffer / producer slots");

__device__ __forceinline__ void cscan_produce(const Args& a, const int wave, LAS unsigned char* lds, const int piece, const int first, const int nblk) {
    const int nch = (CS_NCH - piece * CR_PIECE) < CR_PIECE ? (CS_NCH - piece * CR_PIECE) : CR_PIECE;
    if (wave >= CR_PW) {
        const int lane = lane_id(); const int iw = ((int)blockIdx.x - first) * (NWAVES - CR_PW) + (wave - CR_PW), niw = nblk * (NWAVES - CR_PW);
        for (int t = piece * 2 * niw + iw; t < (piece + 1) * 2 * niw && t < MTOK; t += niw) rope_item(a, t, lane);
        return; }
    const bf16_t* Rg = (const bf16_t*)(a.ws + WS_R); const bf16_t* Kg = (const bf16_t*)(a.ws + WS_K); const bf16_t* Vg = (const bf16_t*)(a.ws + WS_V);
    const bf16_t* Dg = (const bf16_t*)(a.ws + WS_DARR); const bf16_t* Ag = (const bf16_t*)(a.ws + WS_AARR);
    float* RK = (float*)((unsigned char*)a.out + DO_RK); unsigned char* IMG = (unsigned char*)a.out + DO_IMG + (size_t)(piece & 1) * 64 * CR_PIECE * CS_SLOT;
    LAS unsigned char* sl = lds + wave * CR_PSLOT;
    const LAS unsigned short* rawD = (const LAS unsigned short*)(sl + 16384); const LAS unsigned short* rawA = (const LAS unsigned short*)(sl + 20480);
    const LAS unsigned short* rawR = (const LAS unsigned short*)(sl + 24576); const LAS unsigned short* rawK = (const LAS unsigned short*)(sl + CS_SLOT); const LAS unsigned short* rawV = (const LAS unsigned short*)(sl + CS_SLOT + 33 * 128);
    u32x4 pre[5][4], prep[3];
    auto issue = [&](int it2, int rr, int c8, int lane) { const int bh2 = it2 / nch, cc2 = it2 % nch, c2 = piece * CR_PIECE + cc2; const unsigned mm = (unsigned)(bh2 >> 4) * SEQ + (unsigned)c2 * CS_L; const int hh = bh2 & 15;
        const unsigned eoff = ((mm + rr) * DM + hh * 64 + 8 * c8) * 2u;
        const unsigned char* wsb = a.ws;
#pragma unroll
        for (int ar = 0; ar < 5; ++ar) { constexpr size_t AOFF[5] = {WS_R, WS_K, WS_V, WS_DARR, WS_AARR};
#pragma unroll
            for (int q4 = 0; q4 < 4; ++q4) pre[ar][q4] = *(const u32x4*)(wsb + AOFF[ar] + eoff + (unsigned)(8 * q4 * DM * 2)); }
        const bool hasp = (c2 > 0) && (lane < 8); const unsigned poff = hasp ? (eoff - (unsigned)((rr + 1) * DM * 2)) : eoff;
#pragma unroll
        for (int ar = 0; ar < 3; ++ar) { constexpr size_t AOFF[3] = {WS_R, WS_K, WS_V}; const u32x4 t = *(const u32x4*)(wsb + AOFF[ar] + poff); prep[ar] = hasp ? t : (u32x4){0u, 0u, 0u, 0u}; } };
    const int it0 = ((int)blockIdx.x - first) * CR_PW + wave, nimg = 64 * nch, itstep = nblk * CR_PW;
    { const int l0 = lane_id(); if (it0 < nimg) issue(it0, l0 >> 3, l0 & 7, l0); }
    for (int it = it0; it < nimg; it += itstep) {
        const int lane = lane_id(), rr = lane >> 3, c8 = lane & 7, kpos = 32 * (lane >> 5) + permp(lane & 31);
        const int bh = it / nch, cc = it % nch, b = bh >> 4, h = bh & 15, c = piece * CR_PIECE + cc, gch = h * 64 + lane;
        const float mur = a.mu_rkv[gch], muk = a.mu_rkv[DM + gch], muv = a.mu_rkv[2 * DM + gch], kkw = a.rwkv_vec[2 * DM + gch], kaw = a.rwkv_vec[3 * DM + gch], rkw = a.r_k[gch];
            const size_t m0 = (size_t)b * SEQ + (size_t)c * CS_L;
            { LAS unsigned char* wb = sl + rr * 128 + 16 * c8; asm volatile("" : "+v"(wb));
#pragma unroll
              for (int q4 = 0; q4 < 4; ++q4) {
                *(LAS u32x4*)(wb + 24576 + (8 * q4 + 1) * 128) = pre[0][q4]; *(LAS u32x4*)(wb + CS_SLOT + (8 * q4 + 1) * 128) = pre[1][q4]; *(LAS u32x4*)(wb + CS_SLOT + 33 * 128 + (8 * q4 + 1) * 128) = pre[2][q4];
                *(LAS u32x4*)(wb + 16384 + (8 * q4) * 128) = pre[3][q4]; *(LAS u32x4*)(wb + 20480 + (8 * q4) * 128) = pre[4][q4]; }
              if (lane < 8) { *(LAS u32x4*)(wb + 24576) = prep[0]; *(LAS u32x4*)(wb + CS_SLOT) = prep[1]; *(LAS u32x4*)(wb + CS_SLOT + 33 * 128) = prep[2]; } }
            LDS_WAIT();
            const LAS unsigned short* rb = (const LAS unsigned short*)sl + lane; asm volatile("" : "+v"(rb));
            float rp = bflo((unsigned)rb[24576 / 2]), kp = bflo((unsigned)rb[CS_SLOT / 2]), vp = bflo((unsigned)rb[(CS_SLOT + 33 * 128) / 2]);
            float cum = 0.f, gprev = 1.f;
            unsigned bcw[16], kcw[16], vcw[16];
#pragma unroll
            for (int grp = 0; grp < 4; ++grp) {
                float rlv[8], kkrv[8], kprv[8], vlv[8], aav[8], ddv[8], red[16];
#pragma unroll
                for (int e = 0; e < 8; ++e) { const int row = 8 * grp + e;
                    const float r0 = bflo((unsigned)rb[24576 / 2 + (row + 1) * 64]), k0 = bflo((unsigned)rb[CS_SLOT / 2 + (row + 1) * 64]), v0 = bflo((unsigned)rb[(CS_SLOT + 33 * 128) / 2 + (row + 1) * 64]);
                    ddv[e] = bflo((unsigned)rb[16384 / 2 + row * 64]); aav[e] = bflo((unsigned)rb[20480 / 2 + row * 64]);
                    rlv[e] = r0 + (rp - r0) * mur; const float kl = k0 + (kp - k0) * muk; vlv[e] = v0 + (vp - v0) * muv; rp = r0; kp = k0; vp = v0;
                    kkrv[e] = kl * kkw; kprv[e] = kl * (1.0f + (aav[e] - 1.0f) * kaw);
                    red[2 * e] = kkrv[e] * kkrv[e]; red[2 * e + 1] = rlv[e] * kprv[e] * rkw; }
#pragma unroll
                for (int e = 0; e < 16; ++e) red[e] += dppf<0xB1, 0xf>(red[e]);
#pragma unroll
                for (int e = 0; e < 16; ++e) red[e] += dppf<0x4E, 0xf>(red[e]);
#pragma unroll
                for (int e = 0; e < 16; ++e) red[e] += dppf<0x141, 0xf>(red[e]);
#pragma unroll
                for (int e = 0; e < 16; ++e) red[e] += dppf<0x140, 0xf>(red[e]);
#pragma unroll
                for (int e = 0; e < 16; ++e) red[e] += dppf<0x142, 0xa>(red[e]);
#pragma unroll
                for (int e = 0; e < 16; ++e) red[e] += dppf<0x143, 0xc>(red[e]);
#pragma unroll
                for (int e = 0; e < 16; ++e) red[e] = __int_as_float(__builtin_amdgcn_readlane(__float_as_int(red[e]), 63));
                if (lane < 8) { float rkv = red[1];
#pragma unroll
                    for (int e = 1; e < 8; ++e) rkv = (lane == e) ? red[2 * e + 1] : rkv;
                    RK[(m0 + 8 * grp + lane) * 16 + h] = rkv; }
#pragma unroll
                for (int j2 = 0; j2 < 4; ++j2) {
                    const int i2 = 4 * grp + j2;
                    float nt[2], bt[2], kt[2], rt[2], vt[2];
#pragma unroll
                    for (int e = 0; e < 2; ++e) { const int te = 2 * j2 + e;
                        const float kkv = kkrv[te] * __builtin_amdgcn_rsqf(fmaxf(red[2 * te], 1e-24f)), bb = kkv * aav[te];
                        cum += ddv[te]; const float gi = __expf(-cum), ginv = __builtin_amdgcn_rcpf(gi);
                        nt[e] = -kkv * gprev; bt[e] = bb * ginv; kt[e] = kprv[te] * ginv; rt[e] = rlv[te] * gi; vt[e] = vlv[te]; gprev = gi; }
                    const unsigned wn = pk2(nt[0], nt[1]), wb = pk2(bt[0], bt[1]), wk = pk2(kt[0], kt[1]), wr = pk2(rt[0], rt[1]), wv = pk2(vt[0], vt[1]);
                    const int i = 2 * i2;
                    *(LAS unsigned short*)(sl + CS_NT + (i * 64 + kpos) * 2) = (unsigned short)wn; *(LAS unsigned short*)(sl + CS_NT + ((i + 1) * 64 + kpos) * 2) = (unsigned short)(wn >> 16);
                    *(LAS unsigned short*)(sl + CS_RT + (i * 64 + kpos) * 2) = (unsigned short)wr; *(LAS unsigned short*)(sl + CS_RT + ((i + 1) * 64 + kpos) * 2) = (unsigned short)(wr >> 16);
                    *(LAS unsigned short*)(sl + CS_BT + (i * 64 + kpos) * 2) = (unsigned short)wb; *(LAS unsigned short*)(sl + CS_BT + ((i + 1) * 64 + kpos) * 2) = (unsigned short)(wb >> 16);
                    *(LAS unsigned short*)(sl + CS_KT + (i * 64 + kpos) * 2) = (unsigned short)wk; *(LAS unsigned short*)(sl + CS_KT + ((i + 1) * 64 + kpos) * 2) = (unsigned short)(wk >> 16);
                    const int pw = permp(i) >> 1;
                    bcw[pw] = wb; kcw[pw] = wk; vcw[pw] = wv;
                }
                __builtin_amdgcn_sched_barrier(0);
            }
#pragma unroll
            for (int q4 = 0; q4 < 4; ++q4) {
                *(LAS u32x4*)(sl + CS_BC + lane * 64 + 16 * q4) = (u32x4){bcw[4 * q4], bcw[4 * q4 + 1], bcw[4 * q4 + 2], bcw[4 * q4 + 3]};
                *(LAS u32x4*)(sl + CS_KC + lane * 64 + 16 * q4) = (u32x4){kcw[4 * q4], kcw[4 * q4 + 1], kcw[4 * q4 + 2], kcw[4 * q4 + 3]};
                *(LAS u32x4*)(sl + CS_VC + lane * 64 + 16 * q4) = (u32x4){vcw[4 * q4], vcw[4 * q4 + 1], vcw[4 * q4 + 2], vcw[4 * q4 + 3]}; }
            *(LAS float*)(sl + CS_GL + lane * 4) = gprev;
            LDS_WAIT();
            const int tok = lane & 31, hf = lane >> 5;
            bf16x8 fn[4], fr[4], fb[4], fk[4];
#pragma unroll
            for (int ks = 0; ks < 4; ++ks) { fn[ks] = *(const LAS bf16x8*)(sl + CS_NT + (tok * 64 + 16 * ks + 8 * hf) * 2); fr[ks] = *(const LAS bf16x8*)(sl + CS_RT + (tok * 64 + 16 * ks + 8 * hf) * 2);
                fb[ks] = *(const LAS bf16x8*)(sl + CS_BT + (tok * 64 + 16 * ks + 8 * hf) * 2); fk[ks] = *(const LAS bf16x8*)(sl + CS_KT + (tok * 64 + 16 * ks + 8 * hf) * 2); }
            f32x16 P, Pt, Tm, Akn, Abr, Akr;
#pragma unroll
            for (int e = 0; e < 16; ++e) { P[e] = 0.f; Pt[e] = 0.f; Akn[e] = 0.f; Abr[e] = 0.f; Akr[e] = 0.f; }
#pragma unroll
            for (int ks = 0; ks < 4; ++ks) { P = __builtin_amdgcn_mfma_f32_32x32x16_bf16(fn[ks], fb[ks], P, 0, 0, 0); Pt = __builtin_amdgcn_mfma_f32_32x32x16_bf16(fb[ks], fn[ks], Pt, 0, 0, 0);
                Akn = __builtin_amdgcn_mfma_f32_32x32x16_bf16(fn[ks], fk[ks], Akn, 0, 0, 0); Abr = __builtin_amdgcn_mfma_f32_32x32x16_bf16(fr[ks], fb[ks], Abr, 0, 0, 0); Akr = __builtin_amdgcn_mfma_f32_32x32x16_bf16(fr[ks], fk[ks], Akr, 0, 0, 0); }
#pragma unroll
            for (int e = 0; e < 16; ++e) { const int row = (e & 3) + 8 * (e >> 2) + 4 * hf, col = tok;
                if (!(col < row)) { P[e] = 0.f; Akn[e] = 0.f; } if (!(row < col)) Pt[e] = 0.f; if (col > row) { Abr[e] = 0.f; Akr[e] = 0.f; }
                Tm[e] = P[e] + (row == col ? 1.0f : 0.f); }
#pragma unroll
            for (int mm = 1; mm <= 4; ++mm) {
                const bf16x8 p0 = cfrag(P, 0), p1 = cfrag(P, 1), q0 = cfrag(Pt, 0), q1 = cfrag(Pt, 1);
                f32x16 Ptn, Pn;
#pragma unroll
                for (int e = 0; e < 16; ++e) { Ptn[e] = 0.f; Pn[e] = 0.f; }
                Ptn = __builtin_amdgcn_mfma_f32_32x32x16_bf16(p0, q0, Ptn, 0, 0, 0); Ptn = __builtin_amdgcn_mfma_f32_32x32x16_bf16(p1, q1, Ptn, 0, 0, 0);
                if (mm < 4) { Pn = __builtin_amdgcn_mfma_f32_32x32x16_bf16(q0, p0, Pn, 0, 0, 0); Pn = __builtin_amdgcn_mfma_f32_32x32x16_bf16(q1, p1, Pn, 0, 0, 0); }
                const bf16x8 t0 = cfrag(Tm, 0), t1 = cfrag(Tm, 1), u0 = cfrag(Ptn, 0), u1 = cfrag(Ptn, 1);
                Tm = __builtin_amdgcn_mfma_f32_32x32x16_bf16(u0, t0, Tm, 0, 0, 0); Tm = __builtin_amdgcn_mfma_f32_32x32x16_bf16(u1, t1, Tm, 0, 0, 0);
                P = Pn; Pt = Ptn;
            }
            { const int itn = it + itstep; if (itn < nimg) { const int l2 = lane_id(); issue(itn, l2 >> 3, l2 & 7, l2); } }
            { const int pc = permp(tok);
#pragma unroll
              for (int e = 0; e < 16; e += 2) { const int row = (e & 3) + 8 * (e >> 2) + 4 * hf;
                const unsigned w0 = pk2(Tm[e], Tm[e + 1]), w1 = pk2(Akn[e], Akn[e + 1]), w2 = pk2(Abr[e], Abr[e + 1]), w3 = pk2(Akr[e], Akr[e + 1]);
                *(LAS unsigned short*)(sl + CS_TM + (row * 32 + pc) * 2) = (unsigned short)w0; *(LAS unsigned short*)(sl + CS_TM + ((row + 1) * 32 + pc) * 2) = (unsigned short)(w0 >> 16);
                *(LAS unsigned short*)(sl + CS_AKN + (row * 32 + pc) * 2) = (unsigned short)w1; *(LAS unsigned short*)(sl + CS_AKN + ((row + 1) * 32 + pc) * 2) = (unsigned short)(w1 >> 16);
                *(LAS unsigned short*)(sl + CS_ABR + (row * 32 + pc) * 2) = (unsigned short)w2; *(LAS unsigned short*)(sl + CS_ABR + ((row + 1) * 32 + pc) * 2) = (unsigned short)(w2 >> 16);
                *(LAS unsigned short*)(sl + CS_AKR + (row * 32 + pc) * 2) = (unsigned short)w3; *(LAS unsigned short*)(sl + CS_AKR + ((row + 1) * 32 + pc) * 2) = (unsigned short)(w3 >> 16); } }
            LDS_WAIT();
            { unsigned char* dst = IMG + (size_t)(bh * CR_PIECE + cc) * CS_SLOT;
#pragma unroll 1
              for (int j = lane; j < CS_SLOT / 16; j += 64) *(u32x4*)(dst + 16 * j) = *(const LAS u32x4*)(sl + 16 * j); }
            LDS_WAIT();
    }
}

__device__ __forceinline__ void cscan_consume(const Args& a, const int wave, LAS unsigned char* lds, const int bh, const int piece, f32x4 (&xc)[4]) {
    const int lane = lane_id();
    const int b = bh >> 4, h = bh & 15;
    bf16_t* YAB = (bf16_t*)(a.ws + WS_YAB); const unsigned char* IMG = (const unsigned char*)a.out + DO_IMG + (size_t)(piece & 1) * 64 * CR_PIECE * CS_SLOT;
    const int nch = (CS_NCH - piece * CR_PIECE) < CR_PIECE ? (CS_NCH - piece * CR_PIECE) : CR_PIECE;
    LAS unsigned* ready = (LAS unsigned*)(lds + CS_FLAGS); LAS unsigned* done = ready + 4;
    if (wave == 4) {
        constexpr int NI = (CS_SLOT + 1023) / 1024;
        for (int cc = 0; cc <= nch; ++cc) {
            if (cc < nch) { const int c = piece * CR_PIECE + cc, s = cc & 3; LAS unsigned char* sl = lds + s * CS_SLOT;
                const unsigned char* src = IMG + (size_t)(bh * CR_PIECE + cc) * CS_SLOT;
                if (c >= 4) lds_poll_ge(done + s, 4u * (unsigned)(c >> 2));
#pragma unroll
                for (int j = 0; j < NI; ++j) { const int idx = lane + 64 * j;
                    if (idx < CS_SLOT / 16) __builtin_amdgcn_global_load_lds((const unsigned*)(src + 16 * idx), (LAS unsigned*)(sl + 1024 * j), 16, 0, 0); } }
            if (cc >= 1) {
                if (cc < nch) asm volatile("s_waitcnt vmcnt(29)" ::: "memory"); else asm volatile("s_waitcnt vmcnt(0)" ::: "memory");
                if (lane == 0) __hip_atomic_store(ready + ((cc - 1) & 3), (unsigned)(piece * CR_PIECE + cc), __ATOMIC_RELAXED, __HIP_MEMORY_SCOPE_WORKGROUP); }
        }
    } else if (wave < 4) {
        const int l15 = lane & 15, g = lane >> 4, vb = wave;
        for (int cc = 0; cc < nch; ++cc) { const int c = piece * CR_PIECE + cc, s = cc & 3; const LAS unsigned char* sl = lds + s * CS_SLOT;
            { lds_poll_ge(ready + s, (unsigned)(c + 1)); }
            const bf16x8 xb0 = cfrag2(xc[0], xc[1]), xb1 = cfrag2(xc[2], xc[3]);
            const bf16x8 vop = *(const LAS bf16x8*)(sl + CS_VC + ((16 * vb + l15) * 32 + 8 * g) * 2);
            f32x4 W[2], U[2], Y[2];
#pragma unroll
            for (int rt = 0; rt < 2; ++rt) { const int row = 16 * rt + l15; f32x4 acc = (f32x4){0.f, 0.f, 0.f, 0.f};
                acc = __builtin_amdgcn_mfma_f32_16x16x32_bf16(*(const LAS bf16x8*)(sl + CS_AKN + (row * 32 + 8 * g) * 2), vop, acc, 0, 0, 0);
                acc = __builtin_amdgcn_mfma_f32_16x16x32_bf16(*(const LAS bf16x8*)(sl + CS_NT + (row * 64 + 8 * g) * 2), xb0, acc, 0, 0, 0);
                acc = __builtin_amdgcn_mfma_f32_16x16x32_bf16(*(const LAS bf16x8*)(sl + CS_NT + (row * 64 + 32 + 8 * g) * 2), xb1, acc, 0, 0, 0);
                W[rt] = acc; }
            const bf16x8 wb = cfrag2(W[0], W[1]);
#pragma unroll
            for (int rt = 0; rt < 2; ++rt) { const int row = 16 * rt + l15;
                U[rt] = __builtin_amdgcn_mfma_f32_16x16x32_bf16(*(const LAS bf16x8*)(sl + CS_TM + (row * 32 + 8 * g) * 2), wb, (f32x4){0.f, 0.f, 0.f, 0.f}, 0, 0, 0); }
            const bf16x8 ub = cfrag2(U[0], U[1]);
#pragma unroll
            for (int rt = 0; rt < 2; ++rt) { const int row = 16 * rt + l15; f32x4 acc = (f32x4){0.f, 0.f, 0.f, 0.f};
                acc = __builtin_amdgcn_mfma_f32_16x16x32_bf16(*(const LAS bf16x8*)(sl + CS_AKR + (row * 32 + 8 * g) * 2), vop, acc, 0, 0, 0);
                acc = __builtin_amdgcn_mfma_f32_16x16x32_bf16(*(const LAS bf16x8*)(sl + CS_RT + (row * 64 + 8 * g) * 2), xb0, acc, 0, 0, 0);
                acc = __builtin_amdgcn_mfma_f32_16x16x32_bf16(*(const LAS bf16x8*)(sl + CS_RT + (row * 64 + 32 + 8 * g) * 2), xb1, acc, 0, 0, 0);
                acc = __builtin_amdgcn_mfma_f32_16x16x32_bf16(*(const LAS bf16x8*)(sl + CS_ABR + (row * 32 + 8 * g) * 2), ub, acc, 0, 0, 0);
                Y[rt] = acc; }
#pragma unroll
            for (int kt = 0; kt < 4; ++kt) { const int row = 16 * kt + l15; f32x4 acc = xc[kt];
                acc = __builtin_amdgcn_mfma_f32_16x16x32_bf16(*(const LAS bf16x8*)(sl + CS_KC + (row * 32 + 8 * g) * 2), vop, acc, 0, 0, 0);
                acc = __builtin_amdgcn_mfma_f32_16x16x32_bf16(*(const LAS bf16x8*)(sl + CS_BC + (row * 32 + 8 * g) * 2), ub, acc, 0, 0, 0);
                xc[kt] = acc * *(const LAS f32x4*)(sl + CS_GL + (16 * kt + 4 * g) * 4); }
            LDS_WAIT();
            if (lane == 0) (void)__hip_atomic_fetch_add(done + s, 1u, __ATOMIC_RELAXED, __HIP_MEMORY_SCOPE_WORKGROUP);
#pragma unroll
            for (int rt = 0; rt < 2; ++rt)
#pragma unroll
                for (int e = 0; e < 4; ++e) { const size_t m = (size_t)b * SEQ + (size_t)c * CS_L + 16 * rt + 4 * g + e;
                    YAB[m * 2048 + 1024 + h * 64 + 16 * vb + l15] = (bf16_t)(pk2(Y[rt][e], 0.f) & 0xffffu); }
        }
    }
}

constexpr int DS_NQ = 16, DS_CAP = 2048, DS_TRIG = 1536, DS_TOPK = 256;
constexpr int DS_HIST_WORDS = 320;
constexpr int DS_KT_BYTES = 2048;
constexpr int DS_CAND_OFF = 0, DS_HIST_OFF = DS_NQ * DS_CAP * 4, DS_KT_OFF = DS_HIST_OFF, DS_CNT_OFF = DS_HIST_OFF + 8 * DS_KT_BYTES, DS_TAU_OFF = DS_CNT_OFF + 64;
static_assert(8 * DS_HIST_WORDS * 4 <= 8 * DS_KT_BYTES, "dsa LDS map");
static_assert(DS_TAU_OFF + 64 <= LDS_BYTES, "dsa LDS map");

template <int CTRL, int RM> __device__ __forceinline__ unsigned dppu(unsigned x) { return (unsigned)__builtin_amdgcn_update_dpp(0, (int)x, CTRL, RM, 0xf, true); }
__device__ __forceinline__ unsigned wave_scan_incl(unsigned v) {
    v += dppu<0x111, 0xf>(v); v += dppu<0x112, 0xf>(v); v += dppu<0x114, 0xf>(v); v += dppu<0x118, 0xf>(v);
    v += dppu<0x142, 0xa>(v);
    v += dppu<0x143, 0xc>(v);
    return v; }
template <int NE>
__device__ __forceinline__ void select_compact(LAS unsigned* cq, LAS unsigned* cntq, LAS unsigned* tauq, LAS unsigned* hist, int lane) {
    const unsigned n = *cntq;
    unsigned e[NE];
#pragma unroll
    for (int j = 0; j < NE; ++j) { const unsigned idx = lane + 64 * j; e[j] = idx < n ? cq[idx] : 0u; }
    unsigned npos = 0u;
#pragma unroll
    for (int j = 0; j < NE; ++j) npos += (unsigned)__popcll(__ballot(e[j] >= 0x80000000u));
    if (npos >= (unsigned)DS_TOPK) {
#pragma unroll
        for (int j = 0; j < NE; ++j) e[j] = (e[j] >= 0x80000000u) ? e[j] : 0u; }
    unsigned va = 0xFFFFFFFFu, vo = 0u;
#pragma unroll
    for (int j = 0; j < NE; ++j) { va &= (e[j] != 0u) ? e[j] : 0xFFFFFFFFu; vo |= e[j]; }
    va &= (unsigned)__builtin_amdgcn_update_dpp(-1, (int)va, 0xB1, 0xf, 0xf, true); va &= (unsigned)__builtin_amdgcn_update_dpp(-1, (int)va, 0x4E, 0xf, 0xf, true);
    va &= (unsigned)__builtin_amdgcn_update_dpp(-1, (int)va, 0x141, 0xf, 0xf, true); va &= (unsigned)__builtin_amdgcn_update_dpp(-1, (int)va, 0x140, 0xf, 0xf, true);
    vo |= dppu<0xB1, 0xf>(vo); vo |= dppu<0x4E, 0xf>(vo); vo |= dppu<0x141, 0xf>(vo); vo |= dppu<0x140, 0xf>(vo);
    const unsigned vas = (unsigned)(__builtin_amdgcn_readlane((int)va, 0) & __builtin_amdgcn_readlane((int)va, 16) & __builtin_amdgcn_readlane((int)va, 32) & __builtin_amdgcn_readlane((int)va, 48));
    const unsigned vos = (unsigned)(__builtin_amdgcn_readlane((int)vo, 0) | __builtin_amdgcn_readlane((int)vo, 16) | __builtin_amdgcn_readlane((int)vo, 32) | __builtin_amdgcn_readlane((int)vo, 48));
    const unsigned diff = vas ^ vos;
    const int top = diff ? 31 - __builtin_clz(diff) : 7;
    unsigned prefix = (top >= 31) ? 0u : (vos & ~((2u << top) - 1u)), mask = (top >= 31) ? 0u : ~((2u << top) - 1u), need = DS_TOPK;
    int hi = top;
    const int rl = 63 - lane;
#pragma unroll 1
    for (int pass = 0; pass < 4 && hi >= 0; ++pass) {
        const int shift = hi >= 7 ? hi - 7 : 0; const unsigned dmask = (hi >= 7) ? 0xFFu : ((2u << hi) - 1u);
        *(LAS u32x4*)(hist + 4 * lane) = (u32x4){0u, 0u, 0u, 0u};
        LDS_WAIT();
#pragma unroll
        for (int j = 0; j < NE; ++j) { const bool hit = (e[j] != 0u) && ((e[j] & mask) == prefix); const unsigned bin = hit ? ((e[j] >> shift) & dmask) : (256u + (unsigned)lane);
            (void)__hip_atomic_fetch_add(hist + bin, 1u, __ATOMIC_RELAXED, __HIP_MEMORY_SCOPE_WORKGROUP); }
        LDS_WAIT();
        const u32x4 h4 = *(const LAS u32x4*)(hist + 4 * rl);
        const unsigned tot = (h4.x + h4.y) + (h4.z + h4.w);
        const unsigned v = wave_scan_incl(tot);
        const unsigned above = v - tot;
        const bool is = (above < need) && (need <= v);
        unsigned B = 0u, ca = 0u, hb = 0u;
        if (is) { unsigned c = above;
            if (c + h4.w >= need) { B = 4 * rl + 3; ca = c; hb = h4.w; } else { c += h4.w;
            if (c + h4.z >= need) { B = 4 * rl + 2; ca = c; hb = h4.z; } else { c += h4.z;
            if (c + h4.y >= need) { B = 4 * rl + 1; ca = c; hb = h4.y; } else { c += h4.y; B = 4 * rl; ca = c; hb = h4.x; } } } }
        const unsigned long long bal = __ballot(is);
        if (bal == 0ull) break;
        const int src = __builtin_amdgcn_readfirstlane(__ffsll((long long)bal) - 1);
        B = (unsigned)__builtin_amdgcn_readlane((int)B, src); ca = (unsigned)__builtin_amdgcn_readlane((int)ca, src); hb = (unsigned)__builtin_amdgcn_readlane((int)hb, src);
        need -= ca; prefix |= B << shift; mask |= dmask << shift; hi = shift - 1;
        if (hb == need) break;
    }
    const unsigned T = prefix;
    unsigned base = 0u;
#pragma unroll
    for (int j = 0; j < NE; ++j) { const bool keep = (e[j] >= T) && (e[j] != 0u); const unsigned long long bal = __ballot(keep);
        const unsigned pos = base + __builtin_amdgcn_mbcnt_hi((unsigned)(bal >> 32), __builtin_amdgcn_mbcnt_lo((unsigned)bal, 0u));
        if (keep) cq[pos] = e[j];
        base += (unsigned)__popcll(bal); }
    if (lane == 0) { *cntq = base; *tauq = T; }
    LDS_WAIT();
}

template <int NE>
__device__ __forceinline__ void filter_compact(LAS unsigned* cq, LAS unsigned* cntq, LAS unsigned* tauq, int lane) {
    const unsigned n = *cntq;
    unsigned e[NE];
#pragma unroll
    for (int j = 0; j < NE; ++j) { const unsigned idx = lane + 64 * j; e[j] = idx < n ? cq[idx] : 0u; }
    unsigned m0 = 0u, m1 = 0u, m2 = 0u, m3 = 0u;
#pragma unroll
    for (int j = 0; j < NE; ++j) { unsigned x = e[j], t;
        t = max(m0, x); x = min(m0, x); m0 = t; t = max(m1, x); x = min(m1, x); m1 = t; t = max(m2, x); x = min(m2, x); m2 = t; m3 = max(m3, x); }
    unsigned T = m3;
    T = min(T, (unsigned)__builtin_amdgcn_update_dpp(-1, (int)T, 0xB1, 0xf, 0xf, true)); T = min(T, (unsigned)__builtin_amdgcn_update_dpp(-1, (int)T, 0x4E, 0xf, 0xf, true));
    T = min(T, (unsigned)__builtin_amdgcn_update_dpp(-1, (int)T, 0x141, 0xf, 0xf, true)); T = min(T, (unsigned)__builtin_amdgcn_update_dpp(-1, (int)T, 0x140, 0xf, 0xf, true));
    T = min(min((unsigned)__builtin_amdgcn_readlane((int)T, 0), (unsigned)__builtin_amdgcn_readlane((int)T, 16)), min((unsigned)__builtin_amdgcn_readlane((int)T, 32), (unsigned)__builtin_amdgcn_readlane((int)T, 48)));
    unsigned base = 0u;
#pragma unroll
    for (int j = 0; j < NE; ++j) { const bool keep = (e[j] >= T) && (e[j] != 0u); const unsigned long long bal = __ballot(keep);
        const unsigned pos = base + __builtin_amdgcn_mbcnt_hi((unsigned)(bal >> 32), __builtin_amdgcn_mbcnt_lo((unsigned)bal, 0u));
        if (keep) cq[pos] = e[j];
        base += (unsigned)__popcll(bal); }
    if (lane == 0) { *cntq = base; *tauq = (T > 0u) ? T - 1u : 0u; }
    LDS_WAIT();
}

__device__ __forceinline__ float relu_(float x) { return __int_as_float(max(__float_as_int(x), 0)); }
__device__ __forceinline__ unsigned vrow_off(int pr) { return (unsigned)(pr < 28 ? 1024 + 256 * pr : 9216 + 256 * (pr - 28)); }
__device__ __forceinline__ unsigned swz_b(int row) { return (unsigned)(((row & 3) << 2) | ((row >> 2) & 3)); }

__device__ __forceinline__ void dsa_phase(const Args& a, const int wave, LAS unsigned char* lds, const bool dry = false) {
    const bf16_t* Qg = (const bf16_t*)(a.ws + WS_Q); const bf16_t* KVg = (const bf16_t*)(a.ws + WS_KV); const bf16_t* QIg = (const bf16_t*)(a.ws + WS_QI);
    const bf16_t* KIg = (const bf16_t*)(a.ws + WS_KI); const float* WIg = (const float*)(a.ws + WS_WI); bf16_t* Gg = (bf16_t*)(a.ws + WS_G);
    LAS unsigned* cand = (LAS unsigned*)(lds + DS_CAND_OFF); LAS unsigned* hist = (LAS unsigned*)(lds + DS_HIST_OFF) + wave * DS_HIST_WORDS;
    LAS unsigned* cnt = (LAS unsigned*)(lds + DS_CNT_OFF); LAS unsigned* taup = (LAS unsigned*)(lds + DS_TAU_OFF);
    for (int L = blockIdx.x; L < 2048; L += gridDim.x) {
        int lane; asm volatile("v_mbcnt_lo_u32_b32 %0, -1, 0\n\tv_mbcnt_hi_u32_b32 %0, -1, %0" : "=v"(lane));
        const int tid = wave * 64 + lane, ql = lane & 15, gq = lane >> 4;
        int b, j;
        if (gridDim.x == 256) { const int i = blockIdx.x, ui = L >> 8, x = i & 7, li = (i >> 3) * 2 + (x >> 2); b = x & 3; j = 128 * (ui >> 1) + ((ui & 1) ? 127 - li : li); }
        else { b = L >> 9; j = L & 511; }
        const unsigned mb = (unsigned)b * SEQ; const int q0 = DS_NQ * j; const unsigned mq = mb + q0 + ql;
        const int pos0 = a.pos[mb]; int nadm = ((a.pos[mq] >> 6) + 1) * 64 - pos0; nadm = nadm > SEQ ? SEQ : nadm;
        int nmax = ((a.pos[mb + q0 + DS_NQ - 1] >> 6) + 1) * 64 - pos0; nmax = nmax > SEQ ? SEQ : nmax;
        const int nstep = (nmax + 511) >> 9;
#ifdef DSA_REP_STREAM
        for (int srep_ = 0; srep_ < 2; ++srep_) { const bool sdry = (srep_ == 0) && a.ph_hi > 0;
#ifndef DSA_DRYMODE
#define DSA_DRYMODE 0
#endif
#else
        const bool sdry = false;
#define DSA_DRYMODE 0
#endif
        __syncthreads();
        if (tid < DS_NQ) { cnt[tid] = 0u; taup[tid] = 0u; }
        bf16x8 bq[8][2];
#pragma unroll
        for (int h = 0; h < 8; ++h)
#pragma unroll
            for (int ks = 0; ks < 2; ++ks) bq[h][ks] = *(const bf16x8*)(QIg + (mq * 512u + h * 64 + 32 * ks + 8 * gq));
        f32x2 wh[8]; { const f32x4 w0 = *(const f32x4*)(WIg + mq * 8), w1 = *(const f32x4*)(WIg + mq * 8 + 4);
#pragma unroll
            for (int h = 0; h < 4; ++h) { wh[h] = (f32x2){w0[h], w0[h]}; wh[4 + h] = (f32x2){w1[h], w1[h]}; } }
        __syncthreads();
        u32x4 ka[8];
        const unsigned ktb = (unsigned)(size_t)(lds + DS_KT_OFF) + (unsigned)wave * DS_KT_BYTES;
        { unsigned ko = (mb + 64 * wave) * 64u + 8u * lane, ko1 = ko + 2048u;
          asm volatile("" : "+v"(ko), "+v"(ko1));
#pragma unroll
          for (int j8 = 0; j8 < 8; ++j8) ka[j8] = *(const u32x4*)(KIg + ((j8 & 4) ? ko1 : ko) + (j8 & 3) * 512); }
        for (int step = 0; step <= nstep; ++step) {
            const int kb = 512 * step + 64 * wave; const bool active = (kb < nmax) && (step < nstep);
            PROBE_BEGIN(2, a.ws, wave);
            if (active) {
                f32x2 sc2[8];
#pragma unroll
                for (int i = 0; i < 8; ++i) sc2[i] = (f32x2){0.f, 0.f};
                const int ln = lane_id();
                const unsigned kw0 = ktb + (unsigned)(ln >> 3) * 128u + (unsigned)(((ln & 7) ^ (ln >> 4)) << 4);
                const unsigned kr0 = ktb + (unsigned)(ln & 15) * 128u + (unsigned)(((ln >> 4) ^ ((ln & 15) >> 1)) << 4);
                const int kbn = (kb + 512 < SEQ) ? kb + 512 : kb; unsigned ko = (mb + kbn) * 64u + 8u * ln, ko1 = ko + 2048u;
                asm volatile("" : "+v"(ko), "+v"(ko1));
#pragma unroll
                for (int st = 0; st < 4; ++st) {
                    *(LAS u32x4*)(size_t)kw0 = ka[2 * st]; *(LAS u32x4*)(size_t)(kw0 ^ 1088u) = ka[2 * st + 1];
                    LDS_WAIT();
                    if (!(sdry && (DSA_DRYMODE & 1))) {
                        ka[2 * st] = *(const u32x4*)(KIg + ((st & 2) ? ko1 : ko) + (2 * st & 3) * 512); ka[2 * st + 1] = *(const u32x4*)(KIg + ((st & 2) ? ko1 : ko) + ((2 * st + 1) & 3) * 512); }
                    const bf16x8 af0 = *(const LAS bf16x8*)(size_t)kr0, af1 = *(const LAS bf16x8*)(size_t)(kr0 ^ 64u);
                    f32x4 acc[8];
#pragma unroll
                    for (int h = 0; h < 8; ++h) acc[h] = __builtin_amdgcn_mfma_f32_16x16x32_bf16(af0, bq[h][0], (f32x4){0.f, 0.f, 0.f, 0.f}, 0, 0, 0);
#pragma unroll
                    for (int h = 0; h < 8; ++h) acc[h] = __builtin_amdgcn_mfma_f32_16x16x32_bf16(af1, bq[h][1], acc[h], 0, 0, 0);
                    __builtin_amdgcn_sched_barrier(0);
#pragma unroll
                    for (int h = 0; h < 8; ++h) {
                        sc2[2 * st] += wh[h] * (f32x2){relu_(acc[h][0]), relu_(acc[h][1])}; sc2[2 * st + 1] += wh[h] * (f32x2){relu_(acc[h][2]), relu_(acc[h][3])}; }
                    __builtin_amdgcn_sched_barrier(0);
                }
                float sc[16];
#pragma unroll
                for (int i = 0; i < 8; ++i) { sc[2 * i] = sc2[i][0]; sc[2 * i + 1] = sc2[i][1]; }
                __builtin_amdgcn_sched_barrier(0);
                const unsigned tp = taup[ql]; unsigned pm = 0u;
#pragma unroll
                for (int i = 0; i < 16; ++i) { const int key = kb + 16 * (i >> 2) + 4 * gq + (i & 3); const unsigned u = __float_as_uint(sc[i]);
                    const unsigned ord = (u & 0x80000000u) ? ~u : (u | 0x80000000u); const unsigned pk = (ord & 0xFFFFE000u) | (unsigned)key;
                    sc[i] = __uint_as_float(pk);
                    if (key < nadm && pk > tp) pm |= 1u << i; }
                if (sdry && (DSA_DRYMODE & 2)) pm = 0u;
                const unsigned n = (unsigned)__popc(pm);
                unsigned k = 0u; if (n) k = __hip_atomic_fetch_add(cnt + ql, n, __ATOMIC_RELAXED, __HIP_MEMORY_SCOPE_WORKGROUP);
                LAS unsigned* cq = cand + ql * DS_CAP;
#pragma unroll
                for (int i = 0; i < 16; ++i) if (pm & (1u << i)) { cq[k] = __float_as_uint(sc[i]); ++k; }
            }
            if (sdry && (DSA_DRYMODE & 8)) continue;
            __syncthreads();
            PROBE_END(2, a.ws, wave);
            const u32x4 c0 = *(const LAS u32x4*)(cnt), c1 = *(const LAS u32x4*)(cnt + 4), c2 = *(const LAS u32x4*)(cnt + 8), c3 = *(const LAS u32x4*)(cnt + 12);
            unsigned cm = max(max(max(c0.x, c0.y), max(c0.z, c0.w)), max(max(c1.x, c1.y), max(c1.z, c1.w)));
            cm = max(cm, max(max(max(c2.x, c2.y), max(c2.z, c2.w)), max(max(c3.x, c3.y), max(c3.z, c3.w))));
            const unsigned trig = (step == nstep) ? (unsigned)DS_TOPK : (unsigned)DS_TRIG;
#ifdef DSA_SEL2
            const int nsel = (step == nstep) ? 4 : 2;
#else
            const int nsel = 2;
#endif
            if (cm > trig) {
                PROBE_BEGIN(1, a.ws, wave);
#pragma unroll 1
                for (int qq = 0; qq < nsel; ++qq) { const int q = 2 * wave + (qq & 1); if (cnt[q] > trig || qq >= 2) {
                    if (step != nstep) filter_compact<32>(cand + q * DS_CAP, cnt + q, taup + q, lane);
                    if (step == nstep || cnt[q] > (unsigned)DS_TRIG) { const unsigned nq = (unsigned)__builtin_amdgcn_readfirstlane((int)cnt[q]);
                        if (nq <= 512u) select_compact<8>(cand + q * DS_CAP, cnt + q, taup + q, hist, lane);
                        else if (nq <= 768u) select_compact<12>(cand + q * DS_CAP, cnt + q, taup + q, hist, lane);
                        else if (nq <= 1024u) select_compact<16>(cand + q * DS_CAP, cnt + q, taup + q, hist, lane);
                        else if (nq <= 1536u) select_compact<24>(cand + q * DS_CAP, cnt + q, taup + q, hist, lane);
                        else select_compact<32>(cand + q * DS_CAP, cnt + q, taup + q, hist, lane); } } }
                __syncthreads();
                PROBE_END(1, a.ws, wave);
            }
        }
#ifdef DSA_REP_STREAM
        }
#endif
        const bf16_t* KVb = KVg + (size_t)mb * 256;
        int lane_a = lane; asm volatile("" : "+v"(lane_a));
        const int g16 = lane_a >> 4, l15 = lane_a & 15;
        const unsigned vbase = (unsigned)(size_t)(lds + DS_CAND_OFF) + (unsigned)wave * 16384u;
        unsigned ta0, ta1;
        { const int q = l15 >> 2, p = lane_a & 3; const int pr0 = 8 * g16 + q, pr1 = pr0 + 4;
          ta0 = vbase + vrow_off(pr0) + 16u * ((unsigned)(p >> 1) ^ swz_b(pr0)) + 8u * (unsigned)(p & 1);
          ta1 = vbase + vrow_off(pr1) + 16u * ((unsigned)(p >> 1) ^ swz_b(pr1)) + 8u * (unsigned)(p & 1); }
        const unsigned kwa = vbase + 10240u + (unsigned)(4 * g16) * 256u + (unsigned)((l15 ^ (4 * g16)) << 4);
        const unsigned kra = vbase + 10240u + (unsigned)l15 * 256u + (unsigned)((g16 ^ l15) << 4);
        const unsigned owa = vbase + 10240u + (unsigned)l15 * 256u + (unsigned)((g16 ^ l15) << 4);
        const unsigned ora = vbase + 10240u + (unsigned)(lane_a >> 3) * 256u + (unsigned)(((2 * (lane_a & 7)) ^ (lane_a >> 3)) << 4);
        unsigned vwa[8];
#pragma unroll
        for (int j2 = 0; j2 < 8; ++j2) { const int srow = 4 * j2 + g16; const int pr = (srow < 16) ? 8 * (srow >> 2) + (srow & 3) : 8 * ((srow - 16) >> 2) + 4 + (srow & 3);
            vwa[j2] = vbase + vrow_off(pr) + 16u * ((unsigned)l15 ^ swz_b(pr)); }
#ifdef DSA_REP_ATT
        for (int arep_ = 0; arep_ < 2; ++arep_) { const bool dry2 = dry || (arep_ == 0 && a.ph_hi > 0);
#else
        { const bool dry2 = dry;
#endif
        u32x4 qr[4];
#pragma unroll
        for (int i = 0; i < 4; ++i) qr[i] = *(const u32x4*)(Qg + ((mb + q0 + 2 * wave) * 2048u + (unsigned)(4 * g16 + i) * 128u + 8u * l15));
#pragma unroll 1
        for (int qq = 0; qq < 2; ++qq) {
            const int q = 2 * wave + qq; const unsigned m = mb + q0 + q; const int n = (int)cnt[q]; const LAS unsigned* cq = cand + q * DS_CAP;
            bf16x8 qb[4];
            {
#pragma unroll
              for (int i = 0; i < 4; ++i) *(LAS u32x4*)(size_t)(kwa ^ (unsigned)((i << 8) | (i << 4))) = qr[i];
              LDS_WAIT();
              if (qq == 0) {
#pragma unroll
                for (int i = 0; i < 4; ++i) qr[i] = *(const u32x4*)(Qg + ((m + 1u) * 2048u + (unsigned)(4 * g16 + i) * 128u + 8u * l15)); }
#pragma unroll
              for (int ks = 0; ks < 4; ++ks) qb[ks] = *(const LAS bf16x8*)(size_t)(kra ^ (unsigned)(ks << 6));
              LDS_WAIT(); }
            f32x4 sacc[16];
            const int nl = n - l15; const LAS unsigned* cql = cq + l15;
            u32x4 kr[5][4];
            auto kload = [&](int jt, u32x4 (&dst)[4]) { const u32x4 e4 = *(const LAS u32x4*)(cq + 16 * jt + 4 * g16);
#pragma unroll
                for (int i = 0; i < 4; ++i) dst[i] = *(const u32x4*)(KVb + ((e4[i] & 0x1FFFu) * 256u + 8u * l15)); };
            kload(0, kr[0]); kload(1, kr[1]); kload(2, kr[2]); kload(3, kr[3]);
#pragma unroll
            for (int i = 0; i < 4; ++i) *(LAS u32x4*)(size_t)(kwa ^ (unsigned)((i << 8) | (i << 4))) = kr[0][i];
#pragma unroll
            for (int jt = 0; jt < 16; ++jt) {
                if (jt + 4 < 16) kload(jt + 4, kr[(jt + 4) % 5]);
                bf16x8 fa[4];
#pragma unroll
                for (int ks = 0; ks < 4; ++ks) fa[ks] = *(const LAS bf16x8*)(size_t)(kra ^ (unsigned)(ks << 6));
                if (jt + 1 < 16) {
#pragma unroll
                    for (int i = 0; i < 4; ++i) *(LAS u32x4*)(size_t)(kwa ^ (unsigned)((i << 8) | (i << 4))) = kr[(jt + 1) % 5][i]; }
                f32x4 acc = (f32x4){0.f, 0.f, 0.f, 0.f};
#pragma unroll
                for (int ks = 0; ks < 4; ++ks) acc = __builtin_amdgcn_mfma_f32_16x16x32_bf16(fa[ks], qb[ks], acc, 0, 0, 0);
                sacc[jt] = acc;
            }
            u32x4 vr[2][8]; const int ng = n - g16; const LAS unsigned* cqg = cq + g16;
            auto vload = [&](int kk, u32x4 (&dst)[8]) {
#pragma unroll
                for (int j2 = 0; j2 < 8; ++j2) { const int sl = 32 * kk + 4 * j2; const unsigned e = cqg[sl]; const unsigned key = (sl < ng) ? (e & 0x1FFFu) : 0u;
                    dst[j2] = *(const u32x4*)(KVb + (key * 256u + 128u + 8u * l15)); } };
            vload(0, vr[0]); vload(1, vr[1]);
            __builtin_amdgcn_sched_barrier(0);
            float mx = -1e30f; const float nnf = (float)(n - 4 * g16 - 1);
#pragma unroll
            for (int jt = 0; jt < 16; ++jt)
#pragma unroll
                for (int r = 0; r < 4; ++r) { sacc[jt][r] = fmaf(fminf(nnf - (float)(16 * jt + r), 0.f), 1e30f, sacc[jt][r]); mx = fmaxf(mx, sacc[jt][r]); }
            mx = fmaxf(mx, __shfl_xor(mx, 16)); mx = fmaxf(mx, __shfl_xor(mx, 32));
            float sum = 0.f;
#pragma unroll
            for (int jt = 0; jt < 16; ++jt)
#pragma unroll
                for (int r = 0; r < 4; ++r) { const float p = __builtin_amdgcn_exp2f(sacc[jt][r] - mx); sacc[jt][r] = p; sum += p; }
            sum += __shfl_xor(sum, 16); sum += __shfl_xor(sum, 32);
            u32x4 pfr[8];
#pragma unroll
            for (int kk = 0; kk < 8; ++kk) { const f32x4 pa = sacc[2 * kk], pb2 = sacc[2 * kk + 1];
                pfr[kk].x = pk2(pa[0], pa[1]); pfr[kk].y = pk2(pa[2], pa[3]); pfr[kk].z = pk2(pb2[0], pb2[1]); pfr[kk].w = pk2(pb2[2], pb2[3]); }
            __builtin_amdgcn_sched_barrier(0);
            f32x4 o[8];
#pragma unroll
            for (int c = 0; c < 8; ++c) o[c] = (f32x4){0.f, 0.f, 0.f, 0.f};
            bf16_t* gqp = Gg + m * 2048u; u32x4 gwv[2][2];
#pragma unroll
            for (int p = 0; p < 2; ++p)
#pragma unroll
                for (int i = 0; i < 2; ++i) gwv[p][i] = *(const u32x4*)(gqp + ((8 * i + (lane_a >> 3)) * 128 + 64 * p + 8 * (lane_a & 7)));
#pragma unroll
            for (int kk = 0; kk < 8; ++kk) {
#pragma unroll
                for (int j2 = 0; j2 < 8; ++j2) *(LAS u32x4*)(size_t)vwa[j2] = vr[kk & 1][j2];
                __builtin_amdgcn_sched_barrier(0);
                if (kk + 2 < 8) vload(kk + 2, vr[kk & 1]);
                LDS_WAIT();
                const bf16x8 pfrag = __builtin_bit_cast(bf16x8, pfr[kk]);
#pragma unroll
                for (int ch = 0; ch < 2; ++ch) {
                    s16x4 t0[4], t1[4];
                    asm volatile("ds_read_b64_tr_b16 %0, %8\n\tds_read_b64_tr_b16 %1, %9\n\tds_read_b64_tr_b16 %2, %10\n\tds_read_b64_tr_b16 %3, %11\n\t"
                                 "ds_read_b64_tr_b16 %4, %12\n\tds_read_b64_tr_b16 %5, %13\n\tds_read_b64_tr_b16 %6, %14\n\tds_read_b64_tr_b16 %7, %15\n\ts_waitcnt lgkmcnt(0)"
                                 : "=&v"(t0[0]), "=&v"(t0[1]), "=&v"(t0[2]), "=&v"(t0[3]), "=&v"(t1[0]), "=&v"(t1[1]), "=&v"(t1[2]), "=&v"(t1[3])
                                 : "v"(ta0 ^ (unsigned)((4 * ch + 0) << 5)), "v"(ta0 ^ (unsigned)((4 * ch + 1) << 5)), "v"(ta0 ^ (unsigned)((4 * ch + 2) << 5)), "v"(ta0 ^ (unsigned)((4 * ch + 3) << 5)),
                                   "v"(ta1 ^ (unsigned)((4 * ch + 0) << 5)), "v"(ta1 ^ (unsigned)((4 * ch + 1) << 5)), "v"(ta1 ^ (unsigned)((4 * ch + 2) << 5)), "v"(ta1 ^ (unsigned)((4 * ch + 3) << 5)) : "memory");
                    __builtin_amdgcn_sched_barrier(0);
#pragma unroll
                    for (int c = 0; c < 4; ++c) { const bf16x8 av = __builtin_shufflevector(t0[c], t1[c], 0, 1, 2, 3, 4, 5, 6, 7);
                        o[4 * ch + c] = __builtin_amdgcn_mfma_f32_16x16x32_bf16(av, pfrag, o[4 * ch + c], 0, 0, 0); }
                }
            }
            const float inv = 1.0f / sum;
#pragma unroll
            for (int p = 0; p < 2; ++p) {
#pragma unroll
                for (int cc = 0; cc < 4; ++cc) *(LAS f32x4*)(size_t)(owa ^ (unsigned)(cc << 6)) = o[4 * p + cc] * inv;
                LDS_WAIT();
#pragma unroll
                for (int i = 0; i < 2; ++i) { bf16_t* gp = gqp + ((8 * i + (lane_a >> 3)) * 128 + 64 * p + 8 * (lane_a & 7)); const u32x4 gw = gwv[p][i];
                    const unsigned ra_ = (ora + 2048u * (unsigned)i) ^ (unsigned)(i << 7);
                    const f32x4 t0 = *(const LAS f32x4*)(size_t)ra_, t1 = *(const LAS f32x4*)(size_t)(ra_ ^ 16u);
                    u32x4 wv; wv.x = pk2(t0[0] * bflo(gw.x), t0[1] * bfhi(gw.x)); wv.y = pk2(t0[2] * bflo(gw.y), t0[3] * bfhi(gw.y));
                    wv.z = pk2(t1[0] * bflo(gw.z), t1[1] * bfhi(gw.z)); wv.w = pk2(t1[2] * bflo(gw.w), t1[3] * bfhi(gw.w));
                    if (!dry2) *(u32x4*)gp = wv; }
                LDS_WAIT();
            }
        }
        }
    }
}

#ifndef OLD_SCAN
#define OLD_SCAN 0
#endif
#ifndef MK_SPLIT
#define MK_SPLIT 0
#endif
#ifndef MK_PH_END
#define MK_PH_END 13
#endif
constexpr int N_PHASES = 13;

#define XB_TMO      128
#define XB_XCNT(j)  (256  + 64 * (j))
#define XB_XSUB(j)  (1280 + 64 * (j))
#define XB_XGEN(j)  (2304 + 64 * (j))
#define XB_TOP      3328
#define XB_TOPGEN   3392
#define XCD_BAR_WORDS 3456
#define XB_SPIN_CAP (1u << 18)

__device__ __forceinline__ unsigned xb_ld(unsigned* p)              { return __hip_atomic_load(p, __ATOMIC_RELAXED, __HIP_MEMORY_SCOPE_AGENT); }
__device__ __forceinline__ unsigned xb_add(unsigned* p, unsigned v) { return __hip_atomic_fetch_add(p, v, __ATOMIC_RELAXED, __HIP_MEMORY_SCOPE_AGENT); }
__device__ __forceinline__ unsigned xb_xcc_id() { return (unsigned)__builtin_amdgcn_s_getreg((3 << 11) | 20) & 0xFu; }
#define XB_SPIN(cond, bar) do { unsigned _sp = 0; while (cond) { __builtin_amdgcn_s_sleep(1); \
    if ((++_sp & 255u) == 0u) { if (xb_ld(&(bar)[XB_TMO])) break; if (_sp > XB_SPIN_CAP) { atomicAdd(&(bar)[XB_TMO], 1u); break; } } } } while (0)

struct XcdBarrier {
    unsigned* bar; unsigned x;
    volatile LAS unsigned* st;
};

__device__ __forceinline__ XcdBarrier xcd_barrier_post(unsigned* bar, volatile LAS unsigned* st, const int wave) {
    XcdBarrier b; b.bar = bar; b.x = xb_xcc_id(); b.st = st;
    if (lane_id() == 0 && wave == 0) (void)xb_add(&bar[XB_XCNT(b.x)], 1u);
    return b;
}
__device__ __forceinline__ void xcd_barrier_complete(unsigned* bar, unsigned x, unsigned& nloc, unsigned& nx) {
    const unsigned G = gridDim.x * gridDim.y * gridDim.z;
    unsigned sum, cnt, mine, sp = 0u;
    for (;;) {
        sum = 0u; cnt = 0u; mine = 0u;
#pragma unroll
        for (unsigned j = 0; j < 16; ++j) { const unsigned c = xb_ld(&bar[XB_XCNT(j)]); sum += c; cnt += (c > 0u) ? 1u : 0u; mine = (j == x) ? c : mine; }
        if (sum == G) break;
        __builtin_amdgcn_s_sleep(1);
        if ((++sp & 255u) == 0u) { if (xb_ld(&bar[XB_TMO])) break; if (sp > XB_SPIN_CAP) { atomicAdd(&bar[XB_TMO], 1u); break; } }
    }
    nloc = mine > 0u ? mine : 1u; nx = cnt > 0u ? cnt : 1u;
}

__device__ __forceinline__ void xcd_barrier(const XcdBarrier& b, const int wave) {
    asm volatile("s_waitcnt vmcnt(0)" ::: "memory");
    __syncthreads();
    if (wave == 0) { if (lane_id() == 0) {
        unsigned* bar = b.bar;
        __builtin_amdgcn_s_waitcnt(0);
        unsigned nloc = b.st[0], nx = b.st[1];
        if (nloc == 0u) { xcd_barrier_complete(bar, b.x, nloc, nx); b.st[0] = nloc; b.st[1] = nx; }
        const unsigned old = xb_add(&bar[XB_XSUB(b.x)], 1u);
        const unsigned gen = old / nloc;
        if (old + 1u == (gen + 1u) * nloc) {
            __builtin_amdgcn_fence(__ATOMIC_RELEASE, "agent");
            asm volatile("s_waitcnt vmcnt(0)" ::: "memory");
            const unsigned og = xb_add(&bar[XB_TOP], 1u);
            const unsigned tg = og / nx;
            if (og + 1u == (tg + 1u) * nx) xb_add(&bar[XB_TOPGEN], 1u);
            else XB_SPIN(xb_ld(&bar[XB_TOPGEN]) == tg, bar);
            __builtin_amdgcn_fence(__ATOMIC_ACQUIRE, "agent");
            xb_add(&bar[XB_XGEN(b.x)], 1u);
            asm volatile("s_waitcnt vmcnt(0)" ::: "memory");
        } else {
            XB_SPIN(xb_ld(&bar[XB_XGEN(b.x)]) == gen, bar);
            __builtin_amdgcn_fence(__ATOMIC_ACQUIRE, "agent");
            asm volatile("s_waitcnt vmcnt(0)" ::: "memory");
        }
    } }
    __syncthreads();
}

#define grid_bar(barptr, epoch, wv) xcd_barrier(xbar, (wv))
typedef const __attribute__((address_space(4))) Args* KArgs;
#if defined(__HIP_DEVICE_COMPILE__)
__device__ __forceinline__ Args kargs() { KArgs p = (KArgs)__builtin_amdgcn_kernarg_segment_ptr(); asm volatile("" : "+s"(p)); return *p; }
#else
__device__ __forceinline__ Args kargs() { return Args{}; }
#endif
#define PHASE_ARGS const Args a = kargs(); unsigned char* ws = a.ws; (void)ws

__global__ void __launch_bounds__(NTHREADS, 2) fwd_megakernel(Args a_by_value) {
    extern __shared__ __attribute__((aligned(16))) unsigned char lds_raw[];
    LAS unsigned char* lds = (LAS unsigned char*)lds_raw;
    cg::grid_group grid = cg::this_grid();
    const int wave = __builtin_amdgcn_readfirstlane((int)threadIdx.x >> 6);
    { volatile LAS unsigned* st0 = (volatile LAS unsigned*)(lds + LDS_BYTES - 16); if (wave == 0 && lane_id() < 4) st0[lane_id()] = 0u; __syncthreads(); }
    const XcdBarrier xbar = xcd_barrier_post((unsigned*)(kargs().ws + WS_BAR), (volatile LAS unsigned*)(lds + LDS_BYTES - 16), wave);
    int lo, hi; { const Args a0 = kargs(); lo = a0.ph_lo; hi = a0.ph_hi; }
#ifdef ONLY_PH
#define IN(k) ((k) == ONLY_PH && lo <= (k) && (k) < hi)
#else
#define IN(k) (lo <= (k) && (k) < hi)
#endif
#define SEAM(k) do { if (IN(k) && IN((k) + 1)) { if ((k) == 0) grid.sync(); else grid_bar((unsigned*)(kargs().ws + WS_BAR), (unsigned)(k), wave); } } while (0)
#ifdef REP_PH
#ifndef REP_N
#define REP_N 2
#endif
#define NREP(k) ((k) == REP_PH ? REP_N : 1)
#else
#define NREP(k) 1
#endif
#define REPEAT(k) for (int rep_ = 0; rep_ < NREP(k); ++rep_, (rep_ < NREP(k) ? grid_bar((unsigned*)(kargs().ws + WS_BAR) + 128, 1u, wave) : (void)0))
#ifdef STAMP_K
#define TSTAMP(k) do { if (((k) == STAMP_K || (k) == STAMP_K + 1) && blockIdx.x == 0 && wave == 0) { const unsigned long long t_ = __builtin_amdgcn_s_memrealtime(); \
        if (__builtin_amdgcn_mbcnt_lo(~0u, 0u) == 0u) ((unsigned long long*)(kargs().ws + WS_STAMP))[(k) - STAMP_K] = t_; } } while (0)
#else
#define TSTAMP(k) do { } while (0)
#endif
#ifdef STAMP_K
    if (blockIdx.x == PROBE_BLK && wave == 0) { unsigned long long* st_ = (unsigned long long*)(kargs().ws + WS_STAMP); if (__builtin_amdgcn_mbcnt_lo(~0u, 0u) < 3u) st_[__builtin_amdgcn_mbcnt_lo(~0u, 0u)] = 0ull; }
#endif
    TSTAMP(0);
    if (IN(0)) REPEAT(0) { PHASE_ARGS; p0_prologue(a, wave, lds); } SEAM(0); TSTAMP(1);
    if (IN(1)) REPEAT(1) { PHASE_ARGS; norm_phase(a, wave, lds, a.x, 0); } SEAM(1); TSTAMP(2);
    if (IN(2)) REPEAT(2) { PHASE_ARGS;
        pg8::Gemm g{(const bf16_t*)(ws + WS_H), (const bf16_t*)(ws + WS_WIN0), MTOK, N0, DM}; pg8::StaticOrder S; S.init(MTOK, N0, gridDim.x, blockIdx.x);
        #ifdef EPI0_CHEAP_FIRST
        Epi0 E{ws, (unsigned char*)a.out, NREP(2) == 2 && rep_ == 0 && a.ph_hi > 0, lds + pg8::STAGE_BYTES};
#else
        Epi0 E{ws, (unsigned char*)a.out, false, lds + pg8::STAGE_BYTES};
#endif
#ifdef SKEW0
        if (blockIdx.x >= 128) { const unsigned long long t0_ = __builtin_amdgcn_s_memrealtime(); while (__builtin_amdgcn_s_memrealtime() - t0_ < (unsigned long long)(SKEW0)) __builtin_amdgcn_s_sleep(64); }
#endif
        pg8::gemm_phase<Epi0, pg8::StaticOrder, true, true>(lds, g, S, E, wave);
    } SEAM(2); TSTAMP(3);
    if (IN(3)) REPEAT(3) { PHASE_ARGS; conv_phase(a, wave, lds, blockIdx.x, gridDim.x); lora_pre_phase(a, wave); } SEAM(3); TSTAMP(4);
    if (IN(4)) REPEAT(4) { PHASE_ARGS;
        pg8::Gemm g{(const bf16_t*)((unsigned char*)a.out + DO_LA), (const bf16_t*)(ws + WS_WLORA), MTOK, 2048, 256}; pg8::StaticOrder S; S.init(MTOK, 2048, gridDim.x, blockIdx.x);
        EpiLora E{(bf16_t*)(ws + WS_DARR), (bf16_t*)(ws + WS_AARR), a.rwkv_vec, lds + pg8::STAGE_BYTES};
        pg8::gemm_phase<EpiLora, pg8::StaticOrder, true, true>(lds, g, S, E, wave);
    } SEAM(4); TSTAMP(5);
    if (IN(5)) REPEAT(5) { PHASE_ARGS;
#if OLD_SCAN
        scan_phase(a, wave, lds);
#else
        unsigned* pbar = (unsigned*)(ws + WS_BAR) + 256;
        { __syncthreads(); if (wave == 0 && lane_id() < 8) ((LAS unsigned*)(lds + CS_FLAGS))[lane_id()] = 0u; __syncthreads(); }
        for (int r = 0; r <= CR_NP; ++r) {
            if (blockIdx.x >= 64) { if (r < CR_NP) cscan_produce(a, wave, lds, r, 64, gridDim.x - 64); }
            else if (r >= 1) {
                const int piece = r - 1;
                f32x4 xc[4]; f32x4* sv = (f32x4*)(ws + WS_XSAVE) + ((size_t)(blockIdx.x * 4 + (wave & 3)) * 64 + lane_id()) * 4;
#pragma unroll
                for (int kt = 0; kt < 4; ++kt) xc[kt] = (piece == 0 || wave >= 4) ? (f32x4){0.f, 0.f, 0.f, 0.f} : sv[kt];
                cscan_consume(a, wave, lds, blockIdx.x, piece, xc);
                if (wave < 4) {
#pragma unroll
                    for (int kt = 0; kt < 4; ++kt) sv[kt] = xc[kt]; }
            }
            grid_bar(pbar, (unsigned)(r + 1), wave);
#ifdef BAR2
            grid_bar(pbar + 128, (unsigned)(r + 1), wave);
#endif
        }
#endif
    } SEAM(5); TSTAMP(6);
    if (IN(6)) REPEAT(6) { PHASE_ARGS; post_phase(a, wave); } SEAM(6); TSTAMP(7);
    if (IN(7)) REPEAT(7) { PHASE_ARGS;
        pg8::Gemm g{(const bf16_t*)(ws + WS_YAB), (const bf16_t*)(ws + WS_WOUT0), MTOK, DM, 2048}; pg8::StaticOrder S; S.init(MTOK, DM, gridDim.x, blockIdx.x);
        EpiRes E{a.x, a.out, (const float*)(ws + WS_MODP), a.ada_b, 0, NREP(7) >= 2 && rep_ == 0 && a.ph_hi > 0, lds + pg8::STAGE_BYTES};
        pg8::gemm_phase<EpiRes, pg8::StaticOrder, true, true>(lds, g, S, E, wave);
    } SEAM(7); TSTAMP(8);
    if (IN(8)) REPEAT(8) { PHASE_ARGS; norm_phase(a, wave, lds, a.out, 1); } SEAM(8); TSTAMP(9);
    if (IN(9)) REPEAT(9) { PHASE_ARGS;
        pg8::Gemm g{(const bf16_t*)(ws + WS_H), (const bf16_t*)(ws + WS_WIN1), MTOK, N1, DM}; pg8::StaticOrder S; S.init(MTOK, N1, gridDim.x, blockIdx.x);
        Epi1 E{(bf16_t*)(ws + WS_Q), (bf16_t*)(ws + WS_KV), (bf16_t*)(ws + WS_QI), (bf16_t*)(ws + WS_KI), (bf16_t*)(ws + WS_G), (float*)(ws + WS_WI), (const f32x2*)(ws + WS_CSA), (const f32x2*)(ws + WS_CSI), lds + pg8::STAGE_BYTES};
        pg8::gemm_phase<Epi1, pg8::StaticOrder, true, true>(lds, g, S, E, wave);
    } SEAM(9); TSTAMP(10);
    if (IN(10)) REPEAT(10) { PHASE_ARGS; dsa_phase(a, wave, lds, NREP(10) == 2 && rep_ == 0 && a.ph_hi > 0); } SEAM(10); TSTAMP(11);
    if (IN(11)) REPEAT(11) { PHASE_ARGS;
        pg8::Gemm g{(const bf16_t*)(ws + WS_G), (const bf16_t*)(ws + WS_WOUT1), MTOK, DM, 2048}; pg8::StaticOrder S; S.init(MTOK, DM, gridDim.x, blockIdx.x);
        EpiRes E{a.out, a.out, (const float*)(ws + WS_MODP), a.ada_b, 1, false, lds + pg8::STAGE_BYTES};
        pg8::gemm_phase<EpiRes, pg8::StaticOrder, true, true>(lds, g, S, E, wave);
    } SEAM(11); TSTAMP(12);
    if (IN(12)) REPEAT(12) { PHASE_ARGS; final_phase(a, wave); }
#undef IN
#undef SEAM
}

extern "C" void kernel_launch(void* const* d_in, const int* in_sizes, int n_in, void* d_out, int out_size, void* d_ws, size_t ws_size, hipStream_t stream) {
    static int grid = 0;
    if (grid == 0) {
        if (n_in != 19 || out_size != MTOK * DM || ws_size < WS_NEED) { fprintf(stderr, "kernel_launch: unexpected shapes (n_in %d, out %d, ws %zu)\n", n_in, out_size, ws_size); grid = -1; return; }
        int dev = 0, cus = 0, per_cu = 0;
        (void)hipGetDevice(&dev); (void)hipDeviceGetAttribute(&cus, hipDeviceAttributeMultiprocessorCount, dev);
        if (hipFuncSetAttribute((const void*)fwd_megakernel, hipFuncAttributeMaxDynamicSharedMemorySize, LDS_BYTES) != hipSuccess) { fprintf(stderr, "kernel_launch: hipFuncSetAttribute failed\n"); grid = -1; return; }
        if (hipOccupancyMaxActiveBlocksPerMultiprocessor(&per_cu, (const void*)fwd_megakernel, NTHREADS, LDS_BYTES) != hipSuccess || per_cu < 1) { fprintf(stderr, "kernel_launch: occupancy query says %d\n", per_cu); per_cu = 1; }
        (void)hipGetLastError();
        grid = cus;
        if (grid > 256) grid = 256;
    }
    if (grid < 0) return;
    Args a{};
    a.x = (const float*)d_in[0]; a.c = (const float*)d_in[1]; a.pos = (const int*)d_in[2]; a.ada_w = (const float*)d_in[3]; a.ada_b = (const float*)d_in[4];
    a.norm_g = (const float*)d_in[5]; a.final_g = (const float*)d_in[6]; a.even_w_in = (const float*)d_in[7]; a.even_w_out = (const float*)d_in[8];
    a.conv_w = (const float*)d_in[9]; a.conv_vec = (const float*)d_in[10]; a.mu_rkv = (const float*)d_in[11]; a.mu_lora = (const float*)d_in[12];
    a.rwkv_vec = (const float*)d_in[13]; a.w_up = (const float*)d_in[14]; a.a_up = (const float*)d_in[15]; a.r_k = (const float*)d_in[16];
    a.odd_w_in = (const float*)d_in[17]; a.odd_w_out = (const float*)d_in[18];
    a.out = (float*)d_out; a.ws = (unsigned char*)d_ws;
    (void)hipMemsetAsync((char*)d_ws + WS_BAR, 0, 65536, stream);
#if MK_SPLIT
    for (int p = 0; p < MK_PH_END; ++p) { a.ph_lo = p; a.ph_hi = p + 1; void* args[] = {&a};
        hipError_t e = hipLaunchCooperativeKernel((const void*)fwd_megakernel, dim3(grid), dim3(NTHREADS), args, LDS_BYTES, stream);
        if (e != hipSuccess) { fprintf(stderr, "launch %d failed: %s\n", p, hipGetErrorString(e)); break; } }
#else
    a.ph_lo = 0; a.ph_hi = MK_PH_END; void* args[] = {&a};
    hipError_t e = hipLaunchCooperativeKernel((const void*)fwd_megakernel, dim3(grid), dim3(NTHREADS), args, LDS_BYTES, stream);
    if (e != hipSuccess) fprintf(stderr, "cooperative launch failed: %s (grid %d)\n", hipGetErrorString(e), grid);
#endif
}
```

```cpp
#include <hip/hip_runtime.h>
#include <hip/hip_cooperative_groups.h>
#include <cstdio>
#include <cstdint>
namespace cg = cooperative_groups;

#define LAS __attribute__((address_space(3)))
typedef unsigned short bf16_t;
typedef float f32x4 __attribute__((ext_vector_type(4)));
typedef float f32x2 __attribute__((ext_vector_type(2)));
typedef float f32x16 __attribute__((ext_vector_type(16)));
typedef unsigned u32x4 __attribute__((ext_vector_type(4)));
typedef unsigned u32x2 __attribute__((ext_vector_type(2)));
typedef short bf16x8 __attribute__((ext_vector_type(8)));
typedef short s16x4 __attribute__((ext_vector_type(4)));

constexpr int BATCH = 4, SEQ = 8192, DM = 1024, MTOK = BATCH * SEQ;
constexpr int N0 = 7424, N1 = 5120;
constexpr int EVEN_COLS = 7296, ODD_COLS = 4936;
constexpr int NWAVES = 8, NTHREADS = 512;
constexpr int LDS_BYTES = 155648;

constexpr size_t MiB = 1u << 20;
constexpr size_t WS_MODP = 0; constexpr size_t WS_STAMP = 3 * MiB; constexpr size_t WS_XSAVE = 1 * MiB;
constexpr size_t WS_BAR = 3 * MiB + 512 * 1024;
constexpr size_t WS_WIN0 = 4 * MiB, WS_WOUT0 = 20 * MiB, WS_WIN1 = 24 * MiB, WS_WOUT1 = 34 * MiB, WS_WLORA = 38 * MiB;
constexpr size_t WS_CSA = 40 * MiB, WS_CSI = 56 * MiB;
constexpr size_t WS_H = 64 * MiB;
constexpr size_t WS_YAB = 64 * MiB;
constexpr size_t WS_U = 192 * MiB, WS_AG = 256 * MiB, WS_R = 320 * MiB, WS_K = 384 * MiB, WS_V = 448 * MiB;
constexpr size_t WS_AARR = WS_U, WS_DARR = WS_AG;
constexpr size_t WS_Q = 128 * MiB, WS_G = 256 * MiB, WS_KV = 384 * MiB, WS_QI = 400 * MiB, WS_KI = 432 * MiB, WS_WI = 436 * MiB;
constexpr size_t WS_NEED = 512 * MiB;
constexpr size_t DO_BG = 0, DO_WDAD = 64 * MiB, DO_LA = 72 * MiB, DO_RK = 64 * MiB;

__device__ __forceinline__ float bflo(unsigned w) { return __uint_as_float(w << 16); }
__device__ __forceinline__ float bfhi(unsigned w) { return __uint_as_float(w & 0xffff0000u); }
typedef __bf16 bf16x2_t __attribute__((ext_vector_type(2)));
__device__ __forceinline__ unsigned pk2(float lo, float hi) { const f32x2 v = {lo, hi}; const bf16x2_t b = __builtin_convertvector(v, bf16x2_t); return __builtin_bit_cast(unsigned, b); }
__device__ __forceinline__ float sigmoidf_(float x) { return __builtin_amdgcn_rcpf(1.0f + __expf(-x)); }
__device__ __forceinline__ float wave_sum(float v) {
#pragma unroll
    for (int o = 1; o < 64; o <<= 1) v += __shfl_xor(v, o);
    return v;
}
template <int CTRL> __device__ __forceinline__ float dppmov(float x) { return __int_as_float(__builtin_amdgcn_update_dpp(0, __float_as_int(x), CTRL, 0xf, 0xf, true)); }
__device__ __forceinline__ float quad_sum(float x) { x += dppmov<0xB1>(x); x += dppmov<0x4E>(x); return x; }
__device__ __forceinline__ float row16_sum(float x) { x += dppmov<0xB1>(x); x += dppmov<0x4E>(x); x += dppmov<0x141>(x); x += dppmov<0x140>(x); return x; }
__device__ __forceinline__ int lane_id() { int l; asm volatile("v_mbcnt_lo_u32_b32 %0, -1, 0\n\tv_mbcnt_hi_u32_b32 %0, -1, %0" : "=v"(l)); return l; }
#define LDS_WAIT() asm volatile("s_waitcnt lgkmcnt(0)" ::: "memory")

__device__ __forceinline__ int map0(int n) {
    const int t = n >> 8, r = n & 255;
    if (t < 8) return (r < 128) ? 128 * t + r : 1024 + 128 * t + (r - 128);
    if (t < 12) return 2048 + 256 * (t - 8) + r;
    if (t < 24) return 3072 + 256 * (t - 12) + r;
    if (t < 28) return 6272 + 256 * (t - 24) + r;
    return (r < 128) ? 6144 + r : -1;
}
__device__ __forceinline__ int map1(int n) {
    const int t = n >> 8, r = n & 255, half = r >> 7, rr = r & 127;
    if (t < 8) return (2 * t + (rr >> 6)) * 128 + half * 64 + (rr & 63);
    if (t == 8) return 2048 + (rr >> 6) * 128 + half * 64 + (rr & 63);
    if (t < 11) return 2304 + (4 * (t - 9) + (rr >> 5)) * 64 + half * 32 + (rr & 31);
    if (t == 11) { if (rr < 32) return 2816 + half * 32 + rr; if (half == 0 && rr < 40) return 2880 + (rr - 32); return -1; }
    return 2888 + 256 * (t - 12) + r;
}

#ifndef PROBE_BLK
#define PROBE_BLK 0
#endif
#ifndef PROBE_WAVE
#define PROBE_WAVE 0
#endif
#if defined(STAMP_K) && defined(PROBE_SEC)
#define PROBE_BEGIN(sec, wsp, wv) unsigned long long PT0_##sec = 0; if ((sec) == PROBE_SEC && blockIdx.x == PROBE_BLK && (wv) == PROBE_WAVE) PT0_##sec = __builtin_amdgcn_s_memrealtime()
#define PROBE_END(sec, wsp, wv) do { if ((sec) == PROBE_SEC && blockIdx.x == PROBE_BLK && (wv) == PROBE_WAVE) { const unsigned long long dt_ = __builtin_amdgcn_s_memrealtime() - PT0_##sec; \
        if (__builtin_amdgcn_mbcnt_lo(~0u, 0u) == 0u) __hip_atomic_fetch_add((unsigned long long*)((wsp) + WS_STAMP) + 2, dt_, __ATOMIC_RELAXED, __HIP_MEMORY_SCOPE_AGENT); } } while (0)
#else
#define PROBE_BEGIN(sec, wsp, wv) do { } while (0)
#define PROBE_END(sec, wsp, wv) do { } while (0)
#endif
namespace pg8 {
#define PG8_LAS __attribute__((address_space(3)))
typedef unsigned short bf16_t;
typedef short bf16x8 __attribute__((ext_vector_type(8)));
typedef float f32x4 __attribute__((ext_vector_type(4)));
typedef unsigned u32x4 __attribute__((ext_vector_type(4)));
constexpr int BM = 256, BK = 64, HALF = 128, HTB = HALF * BK * 2  , STAGE_BYTES = 8 * HTB, NXCD = 8, WGM = 8;

__host__ __device__ __forceinline__ int lds_byte(int r, int c) { const int st = (r >> 4) * 2 + (c >> 5), rr = r & 15, cc = c & 31, ob = rr * 64 + cc * 2; return st * 1024 + (ob ^ (((ob >> 9) & 1) << 5)); }
__host__ __device__ __forceinline__ void stage_rc(int b, int& R, int& C) { const int st = b / 1024, sb = b % 1024, swz = sb ^ (((sb >> 9) & 1) << 5); R = (st >> 1) * 16 + swz / 64; C = (st & 1) * 32 + (swz % 64) / 2; }
__host__ __device__ __forceinline__ int perm32(int rho) { const int n = rho >> 4, i = rho & 15; return 8 * (i >> 2) + 4 * n + (i & 3); }

struct Unit { int pm, pn; };
struct Gemm { const bf16_t* A; const bf16_t* Bt; int M, N, K; };

struct StaticOrder {
    int nM, nN, nwg, G, c;
    __host__ __device__ void init(int M, int N, int G_, int c_) { nM = M / BM; nN = N / BM; nwg = nM * nN; G = G_; c = c_; }
    __host__ __device__ bool next(int i, Unit& u) const {
        const long L = (long)i * G + c; if (L >= nwg) return false;
        int wgid = (int)L; { const int q = nwg / NXCD, r = nwg % NXCD, xcd = wgid % NXCD, off = wgid / NXCD; wgid = (xcd < r ? xcd * (q + 1) : r * (q + 1) + (xcd - r) * q) + off; }
        const int nig = WGM * nN, gid = wgid / nig, fm = gid * WGM, gsz = (nM - fm) < WGM ? (nM - fm) : WGM;
        u.pm = fm + ((wgid % nig) % gsz); u.pn = (wgid % nig) / gsz; return true;
    }
    __device__ __forceinline__ void a_ready(const Unit&) const {}
    __device__ __forceinline__ void done(const Unit&) const {}
};

__device__ __forceinline__ unsigned cvt_pk_bf16(float lo, float hi) { unsigned r; asm volatile("v_cvt_pk_bf16_f32 %0, %1, %2" : "=v"(r) : "v"(lo), "v"(hi)); return r; }
typedef float f32x2 __attribute__((ext_vector_type(2)));
template <class Epi, class Sched, bool ALIGN_EPI = false, bool SP2 = false>
__device__ __forceinline__ void gemm_phase(PG8_LAS unsigned char* lds, const Gemm g, const Sched& S, const Epi& E, const int wave_in) {
    int lane; asm volatile("v_mbcnt_lo_u32_b32 %0, -1, 0\n\tv_mbcnt_hi_u32_b32 %0, -1, %0" : "=v"(lane));
    const int wid = wave_in, tid = wid * 64 + lane, wr = wid >> 2, wc = wid & 3, fr = lane & 15, fq = lane >> 4;
    const int K = g.K, nt = K / BK;
    unsigned voffA[2], voffB[2];
#pragma unroll
    for (int i = 0; i < 2; ++i) { int R, C; stage_rc(tid * 16 + i * 8192, R, C); const int Rb = Epi::PERM ? ((R & ~31) + perm32(R & 31)) : R;
        voffA[i] = (unsigned)(R * K + C) * 2u; voffB[i] = (unsigned)(Rb * K + C) * 2u; }
    const size_t kstep = (size_t)(BK * 2);
    const size_t hstep = (size_t)HALF * K * 2;
    const size_t tstep = 2 * hstep;
    const unsigned ldsw = (unsigned)wid * 1024u;
    const int aoff = lds_byte(wr * 64 + fr, fq * 8), boff = lds_byte(wc * 32 + fr, fq * 8);
#define PG8_SA(b, h) (((b) * 2 + (h)) * HTB)
#define PG8_SB(b, h) ((4 + (b) * 2 + (h)) * HTB)
#define PG8_STAGE(bufoff, gbase, voff) do { _Pragma("unroll") for (int _i = 0; _i < 2; ++_i) \
        __builtin_amdgcn_global_load_lds((const unsigned*)((const char*)(gbase) + (voff)[_i]), (PG8_LAS unsigned*)(lds + (bufoff) + ldsw + _i * 8192), 16, 0, 0); } while (0)
#define PG8_LDA(dst, b, h) do { _Pragma("unroll") for (int m = 0; m < 4; ++m) _Pragma("unroll") for (int k = 0; k < 2; ++k) dst[m][k] = *(const PG8_LAS bf16x8*)(lds + PG8_SA(b, h) + aoff + m * 2048 + k * 1024); } while (0)
#define PG8_LDB(dst, b, h) do { _Pragma("unroll") for (int n = 0; n < 2; ++n) _Pragma("unroll") for (int k = 0; k < 2; ++k) dst[n][k] = *(const PG8_LAS bf16x8*)(lds + PG8_SB(b, h) + boff + n * 2048 + k * 1024); } while (0)
#define PG8_MMA(ai, bj, At, Bt) do { __builtin_amdgcn_s_setprio(1); _Pragma("unroll") for (int m = 0; m < 4; ++m) _Pragma("unroll") for (int n = 0; n < 2; ++n) _Pragma("unroll") for (int k = 0; k < 2; ++k) \
        acc[ai][bj][m][n] = __builtin_amdgcn_mfma_f32_16x16x32_bf16(Bt[n][k], At[m][k], acc[ai][bj][m][n], 0, 0, 0); __builtin_amdgcn_s_setprio(0); } while (0)
#define PG8_WAIT_V(n) asm volatile("s_waitcnt vmcnt(" #n ")" ::: "memory")
#define PG8_WAIT_L(n) asm volatile("s_waitcnt lgkmcnt(" #n ")" ::: "memory")
#define PG8_BAR __builtin_amdgcn_s_barrier()
#define PG8_SCHED __builtin_amdgcn_sched_barrier(0)
    Unit cur, nxt; int ui = 0;
    if (!S.next(0, cur)) return;
    f32x4 acc[2][2][4][2];
#pragma unroll
    for (int a = 0; a < 2; ++a)
#pragma unroll
        for (int b = 0; b < 2; ++b)
#pragma unroll
            for (int m = 0; m < 4; ++m)
#pragma unroll
                for (int n = 0; n < 2; ++n) acc[a][b][m][n] = (f32x4){0.f, 0.f, 0.f, 0.f};
    bf16x8 At[4][2], B0[2][2], B1[2][2];
    const char* cA = (const char*)g.A + (size_t)cur.pm * tstep; const char* cB = (const char*)g.Bt + (size_t)cur.pn * tstep;
    S.a_ready(cur);
    if constexpr (SP2) {
        PG8_STAGE(PG8_SB(0, 0), cB, voffB); PG8_STAGE(PG8_SB(0, 1), cB + hstep, voffB); PG8_STAGE(PG8_SA(0, 0), cA, voffA); PG8_STAGE(PG8_SA(0, 1), cA + hstep, voffA);
        if (wr == 1) PG8_BAR;
        PG8_WAIT_V(2); PG8_BAR;
        PG8_STAGE(PG8_SB(1, 0), cB + kstep, voffB); PG8_STAGE(PG8_SA(1, 0), cA + kstep, voffA); PG8_STAGE(PG8_SB(1, 1), cB + hstep + kstep, voffB);
        PG8_WAIT_V(6); PG8_BAR;
    } else {
        PG8_STAGE(PG8_SB(0, 0), cB, voffB); PG8_STAGE(PG8_SA(0, 0), cA, voffA); PG8_STAGE(PG8_SB(0, 1), cB + hstep, voffB); PG8_STAGE(PG8_SA(0, 1), cA + hstep, voffA);
        if (wr == 1) PG8_BAR;
        PG8_WAIT_V(4); PG8_BAR;
        PG8_STAGE(PG8_SB(1, 0), cB + kstep, voffB); PG8_STAGE(PG8_SA(1, 0), cA + kstep, voffA); PG8_STAGE(PG8_SB(1, 1), cB + hstep + kstep, voffB);
        PG8_WAIT_V(6); PG8_BAR;
    }
    for (;;) {
        const bool has_next = S.next(ui + 1, nxt);
        const char* nA = has_next ? (const char*)g.A + (size_t)nxt.pm * tstep : cA; const char* nB = has_next ? (const char*)g.Bt + (size_t)nxt.pn * tstep : cB;
        for (int t = 0; t < nt; t += 2) {
            const bool last = (t == nt - 2);
            const char* a1 = cA + (size_t)(t + 1) * kstep;
            const char* a2 = last ? nA : cA + (size_t)(t + 2) * kstep; const char* b2 = last ? nB : cB + (size_t)(t + 2) * kstep;
            const char* a3 = a2 + kstep; const char* b3 = b2 + kstep;
            if (last && has_next) S.a_ready(nxt);
            if constexpr (SP2) {
            PG8_LDB(B0, 0, 0); PG8_LDB(B1, 0, 1); PG8_SCHED; PG8_LDA(At, 0, 0); PG8_STAGE(PG8_SA(1, 1), a1 + hstep, voffA);
            PG8_WAIT_V(8); PG8_WAIT_L(0); PG8_BAR; PG8_MMA(0, 0, At, B0); PG8_MMA(0, 1, At, B1); PG8_BAR; PG8_SCHED;
            PG8_LDA(At, 0, 1); PG8_STAGE(PG8_SB(0, 0), b2, voffB); PG8_STAGE(PG8_SB(0, 1), b2 + hstep, voffB); PG8_STAGE(PG8_SA(0, 0), a2, voffA);
            PG8_WAIT_V(8); PG8_WAIT_L(0); PG8_BAR; PG8_MMA(1, 0, At, B0); PG8_MMA(1, 1, At, B1); PG8_BAR; PG8_SCHED;
            PG8_LDB(B0, 1, 0); PG8_LDB(B1, 1, 1); PG8_SCHED; PG8_LDA(At, 1, 0); PG8_STAGE(PG8_SA(0, 1), a2 + hstep, voffA);
            PG8_WAIT_V(8); PG8_WAIT_L(0); PG8_BAR; PG8_MMA(0, 0, At, B0); PG8_MMA(0, 1, At, B1); PG8_BAR; PG8_SCHED;
            PG8_LDA(At, 1, 1); PG8_STAGE(PG8_SB(1, 0), b3, voffB); PG8_STAGE(PG8_SB(1, 1), b3 + hstep, voffB); PG8_STAGE(PG8_SA(1, 0), a3, voffA);
            PG8_WAIT_V(8); PG8_WAIT_L(0); PG8_BAR; PG8_MMA(1, 0, At, B0); PG8_MMA(1, 1, At, B1); PG8_BAR; PG8_SCHED;
            } else {
            PG8_LDB(B0, 0, 0); PG8_SCHED; PG8_LDA(At, 0, 0); PG8_STAGE(PG8_SA(1, 1), a1 + hstep, voffA);
            PG8_WAIT_L(8); PG8_BAR; PG8_WAIT_L(0); PG8_MMA(0, 0, At, B0); PG8_BAR; PG8_SCHED;
            PG8_LDB(B1, 0, 1); PG8_STAGE(PG8_SB(0, 0), b2, voffB);
            PG8_BAR; PG8_WAIT_L(0); PG8_MMA(0, 1, At, B1); PG8_BAR;
            PG8_LDA(At, 0, 1); PG8_STAGE(PG8_SA(0, 0), a2, voffA);
            PG8_BAR; PG8_WAIT_L(0); PG8_MMA(1, 0, At, B0); PG8_BAR; PG8_SCHED;
            PG8_STAGE(PG8_SB(0, 1), b2 + hstep, voffB);
            PG8_WAIT_V(6); PG8_BAR; PG8_MMA(1, 1, At, B1); PG8_BAR;
            PG8_LDB(B0, 1, 0); PG8_SCHED; PG8_LDA(At, 1, 0); PG8_STAGE(PG8_SA(0, 1), a2 + hstep, voffA);
            PG8_WAIT_L(8); PG8_BAR; PG8_WAIT_L(0); PG8_MMA(0, 0, At, B0); PG8_BAR; PG8_SCHED;
            PG8_LDB(B1, 1, 1); PG8_STAGE(PG8_SB(1, 0), b3, voffB);
            PG8_BAR; PG8_WAIT_L(0); PG8_MMA(0, 1, At, B1); PG8_BAR;
            PG8_LDA(At, 1, 1); PG8_STAGE(PG8_SA(1, 0), a3, voffA);
            PG8_BAR; PG8_WAIT_L(0); PG8_MMA(1, 0, At, B0); PG8_BAR; PG8_SCHED;
            PG8_STAGE(PG8_SB(1, 1), b3 + hstep, voffB);
            PG8_WAIT_V(6); PG8_BAR; PG8_MMA(1, 1, At, B1); PG8_BAR;
            }
        }
        if constexpr (ALIGN_EPI) { if (wr == 0) PG8_BAR; }
        if constexpr (!Epi::AFTER_DRAIN) { E(acc, cur, wr, wc, fr, fq); S.done(cur); }
        if (!has_next) break;
#pragma unroll
        for (int a = 0; a < 2; ++a)
#pragma unroll
            for (int b = 0; b < 2; ++b)
#pragma unroll
                for (int m = 0; m < 4; ++m)
#pragma unroll
                    for (int n = 0; n < 2; ++n) acc[a][b][m][n] = (f32x4){0.f, 0.f, 0.f, 0.f};
        cur = nxt; cA = nA; cB = nB; ++ui;
        if constexpr (ALIGN_EPI) { if (wr == 1) PG8_BAR; }
    }
    PG8_WAIT_V(0);
    if constexpr (!ALIGN_EPI) { if (wr == 0) PG8_BAR; }
    PG8_BAR;
    if constexpr (Epi::AFTER_DRAIN) { E.fused(acc, cur, wr, wc, fr, fq, lds, wid, lane); S.done(cur); }
#undef PG8_SA
#undef PG8_SB
#undef PG8_STAGE
#undef PG8_LDA
#undef PG8_LDB
#undef PG8_MMA
#undef PG8_WAIT_V
#undef PG8_WAIT_L
#undef PG8_BAR
#undef PG8_SCHED
}
}

__device__ __forceinline__ u32x4 pack8(const f32x4 a, const f32x4 b) { u32x4 w; w.x = pk2(a[0], a[1]); w.y = pk2(a[2], a[3]); w.z = pk2(b[0], b[1]); w.w = pk2(b[2], b[3]); return w; }
__device__ __forceinline__ f32x4 silu4(const f32x4 v) { f32x4 o; o[0] = v[0] * sigmoidf_(v[0]); o[1] = v[1] * sigmoidf_(v[1]); o[2] = v[2] * sigmoidf_(v[2]); o[3] = v[3] * sigmoidf_(v[3]); return o; }
__device__ __forceinline__ f32x4 sig4(const f32x4 v) { f32x4 o; o[0] = sigmoidf_(v[0]); o[1] = sigmoidf_(v[1]); o[2] = sigmoidf_(v[2]); o[3] = sigmoidf_(v[3]); return o; }

struct RowSt {
    unsigned wa, ra; int rq, cq;
    __device__ __forceinline__ RowSt(LAS unsigned char* spare, int wr, int wc, int fr, int fq) {
        int lane = fr + 16 * fq; asm volatile("" : "+v"(lane));
        const int fr_ = lane & 15, fq_ = lane >> 4; const unsigned tile = (unsigned)(size_t)spare + (unsigned)(wr * 4 + wc) * 2048u;
        wa = tile + (unsigned)fr_ * 64u + (unsigned)((fq_ ^ ((fr_ >> 2) & 3)) << 4); ra = tile + (unsigned)lane * 16u; rq = lane >> 2; cq = 8 * ((lane & 3) ^ (lane >> 4)); }
    __device__ __forceinline__ void store(bf16_t* P, size_t row16, int stride, int col, const u32x4 v, int buf) const {
        *(LAS u32x4*)(size_t)(wa + 1024u * (unsigned)buf) = v; const u32x4 t = *(const LAS u32x4*)(size_t)(ra + 1024u * (unsigned)buf);
        *(u32x4*)(P + (row16 + (size_t)rq) * (size_t)stride + col + cq) = t; }
};

struct Epi0 {
    static constexpr bool PERM = true, AFTER_DRAIN = false;
    unsigned char* ws; unsigned char* dout; bool cheap; LAS unsigned char* spare;
    __device__ __forceinline__ void operator()(const f32x4 (&acc)[2][2][4][2], const pg8::Unit& u, int wr, int wc, int fr, int fq) const {
        const int t = u.pn, cwv = wc * 32; const size_t rw = (size_t)(u.pm * 256 + wr * 64);
        const RowSt rs(spare, wr, wc, fr, fq);
        if (t < 8) {
            bf16_t* U = (bf16_t*)(ws + WS_U);
#pragma unroll
            for (int ai = 0; ai < 2; ++ai)
#pragma unroll
                for (int m = 0; m < 4; ++m) {
                    const f32x4 a = cheap ? acc[ai][0][m][0] : acc[ai][0][m][0] * sig4(acc[ai][1][m][0]), b = cheap ? acc[ai][0][m][1] : acc[ai][0][m][1] * sig4(acc[ai][1][m][1]);
                    rs.store(U, rw + ai * 128 + m * 16, 1024, 128 * t + cwv, pack8(a, b), m & 1); }
        } else if (t == 28) {
            bf16_t* WDAD = (bf16_t*)(dout + DO_WDAD);
#pragma unroll
            for (int ai = 0; ai < 2; ++ai)
#pragma unroll
                for (int m = 0; m < 4; ++m) rs.store(WDAD, rw + ai * 128 + m * 16, 128, cwv, pack8(acc[ai][0][m][0], acc[ai][0][m][1]), m & 1);
        } else {
            const bool act = ((t < 12) || (t >= 24)) && !cheap; const int c0 = 256 * (t & 3);
            unsigned char* bp = (t >= 24) ? (dout + DO_BG) : (ws + WS_AG + (size_t)((t - 8) >> 2) * (64 * MiB));
            bf16_t* base = (bf16_t*)bp;
#pragma unroll
            for (int ai = 0; ai < 2; ++ai)
#pragma unroll
                for (int m = 0; m < 4; ++m) {
#pragma unroll
                    for (int bj = 0; bj < 2; ++bj) { f32x4 a = acc[ai][bj][m][0], b = acc[ai][bj][m][1];
                        if (act) { a = silu4(a); b = silu4(b); }
                        rs.store(base, rw + ai * 128 + m * 16, 1024, c0 + 128 * bj + cwv, pack8(a, b), bj); } }
        }
    }
};
static_assert(WS_R == WS_AG + 64 * MiB && WS_K == WS_AG + 128 * MiB && WS_V == WS_AG + 192 * MiB, "Epi0 region arithmetic");

struct EpiLora {
    static constexpr bool PERM = true, AFTER_DRAIN = false;
    bf16_t *D, *A; const float* vec; LAS unsigned char* spare;
    __device__ __forceinline__ void operator()(const f32x4 (&acc)[2][2][4][2], const pg8::Unit& u, int wr, int wc, int fr, int fq) const {
        const int t = u.pn, cw = wc * 32 + 8 * fq; const size_t rw = (size_t)(u.pm * 256 + wr * 64);
        const bool isd = t < 4; bf16_t* base = isd ? D : A; const int c0 = 256 * (t & 3); const float* bias = vec + (isd ? 0 : 1024) + c0 + cw;
        const float sc = isd ? 0.60653065971f : 1.0f;
        const RowSt rs(spare, wr, wc, fr, fq);
#pragma unroll
        for (int ai = 0; ai < 2; ++ai)
#pragma unroll
            for (int m = 0; m < 4; ++m) {
#pragma unroll
                for (int bj = 0; bj < 2; ++bj) { const f32x4 b0 = *(const f32x4*)(bias + 128 * bj), b1 = *(const f32x4*)(bias + 128 * bj + 4);
                    const f32x4 a = sig4(acc[ai][bj][m][0] + b0) * sc, b = sig4(acc[ai][bj][m][1] + b1) * sc;
                    rs.store(base, rw + ai * 128 + m * 16, 1024, c0 + 128 * bj + wc * 32, pack8(a, b), bj); } }
    }
};

struct EpiRes {
    static constexpr bool PERM = false, AFTER_DRAIN = false;
    const float* resid; float* out; const float* modp; const float* ada_b; int layer; bool cheap; LAS unsigned char* spare;
    __device__ __forceinline__ void operator()(const f32x4 (&acc)[2][2][4][2], const pg8::Unit& u, int wr, int wc, int fr, int fq) const {
        const int row0 = u.pm * 256 + wr * 64 + fr, col0 = u.pn * 256 + wc * 32 + 4 * fq, b = (u.pm * 256) / SEQ;
#ifdef EPIRES_CHEAP
        if (cheap) {
            f32x4 s = (f32x4){0.f, 0.f, 0.f, 0.f};
#pragma unroll
            for (int ai = 0; ai < 2; ++ai)
#pragma unroll
                for (int bj = 0; bj < 2; ++bj)
#pragma unroll
                    for (int m = 0; m < 4; ++m)
#pragma unroll
                        for (int n = 0; n < 2; ++n) s += acc[ai][bj][m][n];
            if (s[0] + s[1] + s[2] + s[3] == 1.2345e30f) out[(size_t)row0 * 1024 + col0] = s[0];
            return; }
#endif
        f32x4 gv[2][2];
#pragma unroll
        for (int bj = 0; bj < 2; ++bj)
#pragma unroll
            for (int n = 0; n < 2; ++n) { const int c = col0 + bj * 128 + n * 16; f32x4 g = *(const f32x4*)(ada_b + layer * 3072 + 2048 + c);
#pragma unroll
                for (int s = 0; s < 8; ++s) g += *(const f32x4*)(modp + (size_t)((s * 2 + layer) * 4 + b) * 3072 + 2048 + c);
                gv[bj][n] = g; }
        const int lane = fr + 16 * fq;
        const unsigned tile = (unsigned)(size_t)spare + (unsigned)(wr * 4 + wc) * 2048u;
        const unsigned wa = tile + (unsigned)fr * 128u + (unsigned)((fq ^ (fr >> 1)) << 4);
        const unsigned ra = tile + (unsigned)lane * 16u;
        const size_t o0 = (size_t)(u.pm * 256 + wr * 64 + (lane >> 3)) * 1024 + u.pn * 256 + wc * 32 + 4 * ((lane & 7) ^ (lane >> 4));
        const size_t o1 = (size_t)(u.pm * 256 + wr * 64 + 8 + (lane >> 3)) * 1024 + u.pn * 256 + wc * 32 + 4 * ((lane & 7) ^ (4 + (lane >> 4)));
        f32x4 rr[3][2];
        auto rload = [&](int idx, f32x4 (&dst)[2]) { const int ai = idx >> 3, m = (idx >> 1) & 3, bj = idx & 1; const size_t d = (size_t)(ai * 128 + m * 16) * 1024 + bj * 128;
            dst[0] = *(const f32x4*)(resid + o0 + d); dst[1] = *(const f32x4*)(resid + o1 + d); };
        rload(0, rr[0]); rload(1, rr[1]);
#pragma unroll
        for (int idx = 0; idx < 16; ++idx) { const int ai = idx >> 3, m = (idx >> 1) & 3, bj = idx & 1; const size_t d = (size_t)(ai * 128 + m * 16) * 1024 + bj * 128;
            if (idx + 2 < 16) rload(idx + 2, rr[(idx + 2) % 3]);
            *(LAS f32x4*)(size_t)wa = gv[bj][0] * acc[ai][bj][m][0]; *(LAS f32x4*)(size_t)(wa ^ 64u) = gv[bj][1] * acc[ai][bj][m][1];
            const f32x4 t0 = *(const LAS f32x4*)(size_t)ra, t1 = *(const LAS f32x4*)(size_t)(ra + 1024u);
            *(f32x4*)(out + o0 + d) = rr[idx % 3][0] + t0; *(f32x4*)(out + o1 + d) = rr[idx % 3][1] + t1;
            asm volatile("" ::: "memory"); }
    }
};

constexpr float Q_SCALE = 0.08838834764831845f * 1.4426950408889634f;
constexpr float WI_SCALE = 0.35355339059327373f * 0.125f;
struct Epi1 {
    static constexpr bool PERM = true, AFTER_DRAIN = false;
    bf16_t *Q, *KV, *QI, *KI, *G; float* WI; const f32x2* csa; const f32x2* csi; LAS unsigned char* spare;
    __device__ __forceinline__ void rope8(const f32x4 x1a, const f32x4 x1b, const f32x4 x2a, const f32x4 x2b, const f32x4 (&tv)[4], float sc, u32x4& o1, u32x4& o2) const {
        float c[8], s[8];
#pragma unroll
        for (int j = 0; j < 4; ++j) { c[2 * j] = tv[j][0]; s[2 * j] = tv[j][1]; c[2 * j + 1] = tv[j][2]; s[2 * j + 1] = tv[j][3]; }
        float a[8], b[8];
#pragma unroll
        for (int j = 0; j < 4; ++j) { a[j] = x1a[j]; a[4 + j] = x1b[j]; b[j] = x2a[j]; b[4 + j] = x2b[j]; }
        float p[8], q[8];
#pragma unroll
        for (int j = 0; j < 8; ++j) { p[j] = (a[j] * c[j] - b[j] * s[j]) * sc; q[j] = (b[j] * c[j] + a[j] * s[j]) * sc; }
        o1.x = pk2(p[0], p[1]); o1.y = pk2(p[2], p[3]); o1.z = pk2(p[4], p[5]); o1.w = pk2(p[6], p[7]);
        o2.x = pk2(q[0], q[1]); o2.y = pk2(q[2], q[3]); o2.z = pk2(q[4], q[5]); o2.w = pk2(q[6], q[7]);
    }
    __device__ __forceinline__ void operator()(const f32x4 (&acc)[2][2][4][2], const pg8::Unit& u, int wr, int wc, int fr, int fq) const {
        const int row0 = u.pm * 256 + wr * 64 + fr, t = u.pn; const size_t rw = (size_t)(u.pm * 256 + wr * 64);
        const RowSt rs(spare, wr, wc, fr, fq);
        const bool roped = (t < 8) || (t == 8 && wc < 2) || (t >= 9 && t < 11) || (t == 11 && wc == 0);
        if (roped) {
            int lane = fr + 16 * fq; asm volatile("" : "+v"(lane));
            const bool wide = t <= 8; const int rb = wide ? 1024 : 512;
            const f32x2* tab = wide ? csa + (((rw >> 4) * 2 + (wc & 1)) * 256 + lane) * 2 : csi + ((rw >> 4) * 256 + lane) * 2;
            f32x4 tv[3][4];
            auto tload = [&](int idx, f32x4 (&d)[4]) { const f32x2* p = tab + (size_t)((idx >> 2) * 8 + (idx & 3)) * rb;
#pragma unroll
                for (int j = 0; j < 4; ++j) d[j] = *(const f32x4*)(p + 128 * j); };
            tload(0, tv[0]); tload(1, tv[1]);
            const float sc = (t < 8) ? Q_SCALE : 1.0f;
#pragma unroll
            for (int idx = 0; idx < 8; ++idx) { const int ai = idx >> 2, m = idx & 3; const size_t r16 = rw + ai * 128 + m * 16;
                if (idx + 2 < 8) tload(idx + 2, tv[(idx + 2) % 3]);
                u32x4 o1, o2; rope8(acc[ai][0][m][0], acc[ai][0][m][1], acc[ai][1][m][0], acc[ai][1][m][1], tv[idx % 3], sc, o1, o2);
                if (t < 8) { const int head = 2 * t + (wc >> 1); rs.store(Q, r16, 2048, head * 128 + (wc & 1) * 32, o1, 0); rs.store(Q, r16, 2048, head * 128 + 64 + (wc & 1) * 32, o2, 1); }
                else if (t == 8) { rs.store(KV, r16, 256, (wc & 1) * 32, o1, 0); rs.store(KV, r16, 256, 64 + (wc & 1) * 32, o2, 1); }
                else if (t < 11) { const int head = 4 * (t - 9) + wc; bf16_t* qp = QI + (((r16 >> 4) * 16 + head * 2) * 64 + lane) * 8; *(u32x4*)qp = o1; *(u32x4*)(qp + 512) = o2; }
                else { bf16_t* kp = KI + (((r16 >> 4) * 2) * 64 + lane) * 8; *(u32x4*)kp = o1; *(u32x4*)(kp + 512) = o2; }
                asm volatile("" ::: "memory"); }
        } else {
#pragma unroll
            for (int ai = 0; ai < 2; ++ai)
#pragma unroll
                for (int m = 0; m < 4; ++m) { const size_t row = (size_t)(row0 + ai * 128 + m * 16), r16 = rw + ai * 128 + m * 16;
                    const f32x4 x1a = acc[ai][0][m][0], x1b = acc[ai][0][m][1], x2a = acc[ai][1][m][0], x2b = acc[ai][1][m][1];
                    if (t == 8) { rs.store(KV, r16, 256, 128 + (wc & 1) * 32, pack8(x1a, x1b), 0); rs.store(KV, r16, 256, 192 + (wc & 1) * 32, pack8(x2a, x2b), 1); }
                    else if (t == 11) { if (wc == 1 && fq == 0) { *(f32x4*)(WI + row * 8) = x1a * WI_SCALE; *(f32x4*)(WI + row * 8 + 4) = x1b * WI_SCALE; } }
                    else if (t >= 12) { const int c0 = 256 * (t - 12);
                        rs.store(G, r16, 2048, c0 + wc * 32, pack8(silu4(x1a), silu4(x1b)), 0); rs.store(G, r16, 2048, c0 + 128 + wc * 32, pack8(silu4(x2a), silu4(x2b)), 1); }
                }
        }
    }
};

struct Args {
    const float* x; const float* c; const int* pos; const float* ada_w; const float* ada_b; const float* norm_g; const float* final_g;
    const float* even_w_in; const float* even_w_out; const float* conv_w; const float* conv_vec; const float* mu_rkv; const float* mu_lora;
    const float* rwkv_vec; const float* w_up; const float* a_up; const float* r_k; const float* odd_w_in; const float* odd_w_out;
    float* out; unsigned char* ws; int ph_lo, ph_hi;
};

template <class SrcF>
__device__ __forceinline__ void transpose_item(const SrcF& src, int K, bf16_t* WT, LAS float* scr, int item, int nblk, int lane) {
    const int kb = item / nblk, nb = item % nblk, k0 = 64 * kb, n0 = 32 * nb;
    float tv[32];
#pragma unroll
    for (int i = 0; i < 32; ++i) tv[i] = src(k0 + 2 * i + (lane >> 5), n0 + (lane & 31));
#pragma unroll
    for (int i = 0; i < 32; ++i) scr[(2 * i + (lane >> 5)) * 33 + (lane & 31)] = tv[i];
    LDS_WAIT();
    const int c = lane & 7;
#pragma unroll
    for (int j = 0; j < 4; ++j) { const int n = (lane >> 3) + 8 * j; const LAS float* s = scr + (8 * c) * 33 + n;
        u32x4 o; o.x = pk2(s[0 * 33], s[1 * 33]); o.y = pk2(s[2 * 33], s[3 * 33]); o.z = pk2(s[4 * 33], s[5 * 33]); o.w = pk2(s[6 * 33], s[7 * 33]);
        *(u32x4*)(WT + (size_t)(n0 + n) * K + k0 + 8 * c) = o; }
    LDS_WAIT();
}

__device__ __forceinline__ void transpose_item_col(const float* W, int ldw, int scol, int K, bf16_t* WT, LAS float* scr, int k0, int n0, int lane) {
    const float* wp = W + (size_t)(k0 + (lane >> 5)) * ldw + (scol < 0 ? 0 : scol);
#pragma unroll 8
    for (int i = 0; i < 32; ++i) { const float v = wp[(size_t)(2 * i) * ldw]; scr[(2 * i + (lane >> 5)) * 33 + (lane & 31)] = scol < 0 ? 0.f : v; }
    LDS_WAIT();
    const int c = lane & 7;
#pragma unroll
    for (int j = 0; j < 4; ++j) { const int n = (lane >> 3) + 8 * j; const LAS float* s = scr + (8 * c) * 33 + n;
        u32x4 o; o.x = pk2(s[0 * 33], s[1 * 33]); o.y = pk2(s[2 * 33], s[3 * 33]); o.z = pk2(s[4 * 33], s[5 * 33]); o.w = pk2(s[6 * 33], s[7 * 33]);
        *(u32x4*)(WT + (size_t)(n0 + n) * K + k0 + 8 * c) = o; }
    LDS_WAIT();
}
__device__ __forceinline__ void rope_item(const Args& a, int r, int lane) {
    const float p = (float)a.pos[r]; const int f = lane;
    { const float inv = powf(10000.0f, -(float)(2 * f) / 128.0f); float sn, cs; sincosf(p * inv, &sn, &cs);
      ((f32x2*)(a.ws + WS_CSA))[(size_t)((((r >> 4) * 2 + (f >> 5)) * 4 + ((f & 7) >> 1)) * 64 + (r & 15) + 16 * ((f & 31) >> 3)) * 2 + (f & 1)] = (f32x2){cs, sn}; }
    if (f < 32) { const float inv = powf(10000.0f, -(float)(2 * f) / 64.0f); float sn, cs; sincosf(p * inv, &sn, &cs);
      ((f32x2*)(a.ws + WS_CSI))[(size_t)(((r >> 4) * 4 + ((f & 7) >> 1)) * 64 + (r & 15) + 16 * (f >> 3)) * 2 + (f & 1)] = (f32x2){cs, sn}; }
}
__device__ __forceinline__ void p0_late(const Args& a, const int wave, LAS unsigned char* lds, int first, int nblk) {
    const int lane = lane_id(), tid = wave * 64 + lane;
    LAS float* scr = (LAS float*)(lds + wave * 16384);
    const int gw = ((int)blockIdx.x - first) * NWAVES + wave, NGW = nblk * NWAVES;
    unsigned char* ws = a.ws;
    constexpr int I_WO = (2048 / 64) * (DM / 32), I_W1 = (DM / 64) * (N1 / 32), I_ROPE = MTOK;
    for (int it = gw; it < I_W1 + I_WO + I_ROPE; it += NGW) {
        int r = it;
        if (r < I_W1) { const int nblk = N1 / 32, k0 = 64 * (r / nblk), n0 = 32 * (r % nblk); transpose_item_col(a.odd_w_in, ODD_COLS, map1(n0 + (lane & 31)), DM, (bf16_t*)(ws + WS_WIN1), scr, k0, n0, lane); continue; } r -= I_W1;
        if (r < I_WO) { const int nblk = DM / 32, k0 = 64 * (r / nblk), n0 = 32 * (r % nblk); transpose_item_col(a.odd_w_out, DM, n0 + (lane & 31), 2048, (bf16_t*)(ws + WS_WOUT1), scr, k0, n0, lane); continue; } r -= I_WO;
        {
            const float p = (float)a.pos[r];
            { const float inv = powf(10000.0f, -(float)(2 * lane) / 128.0f); float sn, cs; sincosf(p * inv, &sn, &cs); ((f32x2*)(ws + WS_CSA))[(size_t)r * 64 + lane] = (f32x2){cs, sn}; }
            if (lane < 32) { const float inv = powf(10000.0f, -(float)(2 * lane) / 64.0f); float sn, cs; sincosf(p * inv, &sn, &cs); ((f32x2*)(ws + WS_CSI))[(size_t)r * 32 + lane] = (f32x2){cs, sn}; }
        }
    }
}
__device__ __forceinline__ void p0_prologue(const Args& a, const int wave, LAS unsigned char* lds) {
    const int lane = lane_id(), tid = wave * 64 + lane;
    LAS float* scr = (LAS float*)(lds + wave * 16384);
    const int gw = blockIdx.x * NWAVES + wave, NGW = gridDim.x * NWAVES;
    unsigned char* ws = a.ws;
    constexpr int I_W0 = (DM / 64) * (N0 / 32), I_WO = (2048 / 64) * (DM / 32), I_W1 = (DM / 64) * (N1 / 32), I_WL = (256 / 64) * (2048 / 32), I_MOD = 96 * 8, I_ROPE = MTOK;
    constexpr int NITEMS = I_W0 + I_WO + I_W1 + I_WO + I_WL + I_MOD + I_ROPE;
    constexpr int N_EARLY = I_W0 + I_WO + I_W1 + I_WO + I_WL + I_MOD;
    for (int it = gw; it < N_EARLY; it += NGW) {
        int r = it;
        if (r < I_W0) { const float* W = a.even_w_in; transpose_item([W](int k, int n) { const int s = map0(n); return s < 0 ? 0.f : W[(size_t)k * EVEN_COLS + s]; }, DM, (bf16_t*)(ws + WS_WIN0), scr, r, N0 / 32, lane); continue; } r -= I_W0;
        if (r < I_WO) { const float* W = a.even_w_out; transpose_item([W](int k, int n) { return W[(size_t)k * DM + n]; }, 2048, (bf16_t*)(ws + WS_WOUT0), scr, r, DM / 32, lane); continue; } r -= I_WO;
        if (r < I_W1) { const float* W = a.odd_w_in; transpose_item([W](int k, int n) { const int s = map1(n); return s < 0 ? 0.f : W[(size_t)k * ODD_COLS + s]; }, DM, (bf16_t*)(ws + WS_WIN1), scr, r, N1 / 32, lane); continue; } r -= I_W1;
        if (r < I_WO) { const float* W = a.odd_w_out; transpose_item([W](int k, int n) { return W[(size_t)k * DM + n]; }, 2048, (bf16_t*)(ws + WS_WOUT1), scr, r, DM / 32, lane); continue; } r -= I_WO;
        if (r < I_WL) { const float* wu = a.w_up; const float* au = a.a_up;
            transpose_item([wu, au](int k, int n) { if (n < 1024) return k < 64 ? wu[k * 1024 + n] : 0.f; return (k >= 64 && k < 128) ? au[(k - 64) * 1024 + (n - 1024)] : 0.f; }, 256, (bf16_t*)(ws + WS_WLORA), scr, r, 2048 / 32, lane); continue; } r -= I_WL;
        if (r < I_MOD) {
            const int cgp = r >> 3, ks = r & 7, col = cgp * 64 + lane, l = col / 3072, cc = col - l * 3072;
#pragma unroll
            for (int i = 0; i < 8; ++i) { const int idx = lane + 64 * i, bb = idx >> 7, kk = idx & 127; const float cv = a.c[bb * DM + ks * 128 + kk]; scr[kk * 4 + bb] = cv * sigmoidf_(cv); }
            LDS_WAIT();
            const float* W = a.ada_w + (size_t)l * DM * 3072 + cc + (size_t)(ks * 128) * 3072; f32x4 acc4 = (f32x4){0.f, 0.f, 0.f, 0.f};
#pragma unroll 1
            for (int k8 = 0; k8 < 128; k8 += 16) { float wv[16];
#pragma unroll
                for (int i = 0; i < 16; ++i) wv[i] = W[(size_t)(k8 + i) * 3072];
#pragma unroll
                for (int i = 0; i < 16; ++i) acc4 += *(const LAS f32x4*)(scr + (k8 + i) * 4) * wv[i]; }
            LDS_WAIT();
            const float acc0 = acc4[0], acc1 = acc4[1], acc2 = acc4[2], acc3 = acc4[3];
            float* mp = (float*)(ws + WS_MODP) + (size_t)((ks * 2 + l) * 4) * 3072 + cc;
            mp[0] = acc0; mp[3072] = acc1; mp[2 * 3072] = acc2; mp[3 * 3072] = acc3; continue; } r -= I_MOD;
    }
}

__device__ __forceinline__ void norm_phase(const Args& a, const int wave, LAS unsigned char* lds, const float* src, int layer) {
    const int lane = lane_id(), tid = wave * 64 + lane;
    LAS float* gs = (LAS float*)lds; LAS float* sh = gs + DM;
    const float* modp = (const float*)(a.ws + WS_MODP); bf16_t* H = (bf16_t*)(a.ws + WS_H);
    for (int tile = blockIdx.x; tile < MTOK / 128; tile += gridDim.x) {
        const int b = (tile * 128) / SEQ;
        __syncthreads();
        for (int c = tid; c < DM; c += NTHREADS) {
            float sc = a.ada_b[layer * 3072 + 1024 + c], sf = a.ada_b[layer * 3072 + c];
#pragma unroll
            for (int s = 0; s < 8; ++s) { const float* mp = modp + (size_t)((s * 2 + layer) * 4 + b) * 3072; sc += mp[1024 + c]; sf += mp[c]; }
            gs[c] = a.norm_g[layer * DM + c] * (1.0f + sc); sh[c] = sf; }
        __syncthreads();
        for (int r4 = 0; r4 < 16; r4 += 4) {
            f32x4 v[4][4]; float ss[4];
#pragma unroll
            for (int q = 0; q < 4; ++q) { const size_t m = (size_t)tile * 128 + wave * 16 + r4 + q; const f32x4* xr = (const f32x4*)(src + m * DM) + lane;
#pragma unroll
                for (int j = 0; j < 4; ++j) v[q][j] = xr[64 * j]; }
#pragma unroll
            for (int q = 0; q < 4; ++q) { float s = 0.f;
#pragma unroll
                for (int j = 0; j < 4; ++j) s += (v[q][j][0] * v[q][j][0] + v[q][j][1] * v[q][j][1]) + (v[q][j][2] * v[q][j][2] + v[q][j][3] * v[q][j][3]);
                ss[q] = s; }
#pragma unroll
            for (int q = 0; q < 4; ++q) ss[q] = wave_sum(ss[q]);
#pragma unroll
            for (int q = 0; q < 4; ++q) { const size_t m = (size_t)tile * 128 + wave * 16 + r4 + q; const float rstd = rsqrtf(ss[q] * (1.0f / DM) + 1e-6f);
                u32x2* o = (u32x2*)(H + m * DM) + lane;
#pragma unroll
                for (int j = 0; j < 4; ++j) { const f32x4 g = *(const LAS f32x4*)(gs + 4 * (64 * j + lane)), s = *(const LAS f32x4*)(sh + 4 * (64 * j + lane));
                    const f32x4 h = v[q][j] * rstd * g + s; u32x2 w; w.x = pk2(h[0], h[1]); w.y = pk2(h[2], h[3]); o[64 * j] = w; } }
        }
    }
}

__device__ __forceinline__ void final_phase(const Args& a, const int wave) {
    const int lane = lane_id(), tid = wave * 64 + lane;
    const int gw = blockIdx.x * NWAVES + wave, NGW = gridDim.x * NWAVES;
    f32x4 g[4];
#pragma unroll
    for (int j = 0; j < 4; ++j) g[j] = *((const f32x4*)a.final_g + 64 * j + lane);
    float tsc = 1.0f;
#ifdef STAMP_K
    { const unsigned long long* st = (const unsigned long long*)(a.ws + WS_STAMP); tsc = 1.0f + (float)(st[1] - st[0] + st[2]) * 1e-7f; }
#endif
    for (int m0 = 4 * gw; m0 < MTOK; m0 += 4 * NGW) {
        f32x4 v[4][4]; float ss[4];
#pragma unroll
        for (int q = 0; q < 4; ++q) { const f32x4* xr = (const f32x4*)(a.out + (size_t)(m0 + q) * DM) + lane;
#pragma unroll
            for (int j = 0; j < 4; ++j) v[q][j] = xr[64 * j]; }
#pragma unroll
        for (int q = 0; q < 4; ++q) { float s = 0.f;
#pragma unroll
            for (int j = 0; j < 4; ++j) s += (v[q][j][0] * v[q][j][0] + v[q][j][1] * v[q][j][1]) + (v[q][j][2] * v[q][j][2] + v[q][j][3] * v[q][j][3]);
            ss[q] = wave_sum(s); }
#pragma unroll
        for (int q = 0; q < 4; ++q) { const float rstd = rsqrtf(ss[q] * (1.0f / DM) + 1e-6f) * tsc; f32x4* xr = (f32x4*)(a.out + (size_t)(m0 + q) * DM) + lane;
#pragma unroll
            for (int j = 0; j < 4; ++j) xr[64 * j] = v[q][j] * rstd * g[j]; }
    }
}


__device__ __forceinline__ void conv_phase(const Args& a, const int wave, LAS unsigned char* lds, int first, int stride) {
    const int lane = lane_id(), tid = wave * 64 + lane;
    const bf16_t* U = (const bf16_t*)(a.ws + WS_U); const bf16_t* AG = (const bf16_t*)(a.ws + WS_AG); bf16_t* YAB = (bf16_t*)(a.ws + WS_YAB);
    f32x2 w[31];
#pragma unroll
    for (int j = 0; j < 31; ++j) w[j] = *(const f32x2*)(a.conv_w + j * DM + 2 * tid);
    const f32x2 cbias = *(const f32x2*)(a.conv_vec + 2 * tid);
    for (int tile = first; tile < MTOK / 32; tile += stride) {
        const int b = tile >> 8, s0 = (tile & 255) * 32;
        __syncthreads();
        for (int idx = tid; idx < 62 * 128; idx += NTHREADS) { const int row = idx >> 7, ch = idx & 127, s = s0 - 30 + row;
            u32x4 v = (u32x4){0u, 0u, 0u, 0u}; if (s >= 0) v = *(const u32x4*)(U + ((size_t)(b * SEQ + s)) * DM + ch * 8);
            *(LAS u32x4*)(lds + row * 2048 + ch * 16) = v; }
        __syncthreads();
        LAS unsigned char* rb0 = lds + tid * 4; LAS unsigned char* rb1 = rb0 + 65536; LAS unsigned char* wb0 = lds + tid * 8; LAS unsigned char* wb1 = wb0 + 65536;
        asm volatile("" : "+v"(rb0), "+v"(rb1), "+v"(wb0), "+v"(wb1));
        f32x2 acc[32];
#pragma unroll
        for (int t = 0; t < 32; ++t) acc[t] = (f32x2){0.f, 0.f};
#pragma unroll
        for (int i = 0; i < 62; ++i) { const unsigned xw = (i < 32) ? *(const LAS unsigned*)(rb0 + i * 2048) : *(const LAS unsigned*)(rb1 + (i - 32) * 2048); const f32x2 xv = (f32x2){bflo(xw), bfhi(xw)};
#pragma unroll
            for (int t = (i > 30 ? i - 30 : 0); t <= (i < 31 ? i : 31); ++t) acc[t] += xv * w[i - t]; }
        __syncthreads();
#pragma unroll
        for (int t = 0; t < 32; ++t) { if (t < 16) *(LAS f32x2*)(wb0 + t * 4096) = acc[t] + cbias; else *(LAS f32x2*)(wb1 + (t - 16) * 4096) = acc[t] + cbias; }
        __syncthreads();
        f32x4 lw[4], lb[4];
#pragma unroll
        for (int j = 0; j < 4; ++j) { lw[j] = *(const f32x4*)(a.conv_vec + DM + 4 * (lane + 64 * j)); lb[j] = *(const f32x4*)(a.conv_vec + 2 * DM + 4 * (lane + 64 * j)); }
        for (int tt = 0; tt < 4; ++tt) { const int t = wave * 4 + tt; const size_t m = (size_t)b * SEQ + s0 + t;
            f32x4 v[4]; float s = 0.f;
#pragma unroll
            for (int j = 0; j < 4; ++j) { v[j] = *(const LAS f32x4*)(lds + (size_t)t * 4096 + 16 * (lane + 64 * j)); s += (v[j][0] + v[j][1]) + (v[j][2] + v[j][3]); }
            const float mean = wave_sum(s) * (1.0f / DM); float q = 0.f;
#pragma unroll
            for (int j = 0; j < 4; ++j) { v[j] = v[j] - mean; q += (v[j][0] * v[j][0] + v[j][1] * v[j][1]) + (v[j][2] * v[j][2] + v[j][3] * v[j][3]); }
            const float rstd = rsqrtf(wave_sum(q) * (1.0f / DM) + 1e-5f);
#pragma unroll
            for (int j = 0; j < 4; ++j) { const f32x4 y = v[j] * rstd * lw[j] + lb[j]; const u32x2 g = *(const u32x2*)(AG + m * DM + 4 * (lane + 64 * j));
                const f32x4 o = silu4(y) * (f32x4){bflo(g.x), bfhi(g.x), bflo(g.y), bfhi(g.y)};
                u32x2 wv; wv.x = pk2(o[0], o[1]); wv.y = pk2(o[2], o[3]); *(u32x2*)(YAB + m * 2048 + 4 * (lane + 64 * j)) = wv; }
        }
    }
}

__device__ __forceinline__ void lora_pre_phase(const Args& a, const int wave) {
    const int lane = lane_id(), tid = wave * 64 + lane;

        const bf16_t* WDAD = (const bf16_t*)((unsigned char*)a.out + DO_WDAD); bf16_t* LA = (bf16_t*)((unsigned char*)a.out + DO_LA);
        const int gw = blockIdx.x * NWAVES + wave, NGW = gridDim.x * NWAVES;
        const f32x2 mu = *(const f32x2*)(a.mu_lora + 2 * lane);
        for (int m0 = gw * 4; m0 < MTOK; m0 += NGW * 4) {
            unsigned cur[4], prv[4];
#pragma unroll
            for (int i = 0; i < 4; ++i) { const int m = m0 + i; cur[i] = *(const unsigned*)(WDAD + (size_t)m * 128 + 2 * lane); }
#pragma unroll
            for (int i = 0; i < 4; ++i) { const int m = m0 + i; if (i > 0) prv[i] = cur[i - 1]; else { prv[0] = 0u; if ((m & (SEQ - 1)) > 0) prv[0] = *(const unsigned*)(WDAD + (size_t)(m - 1) * 128 + 2 * lane); } }
#pragma unroll
            for (int i = 0; i < 4; ++i) { const int m = m0 + i;
                float v0 = bflo(cur[i]), v1 = bfhi(cur[i]); v0 += (bflo(prv[i]) - v0) * mu[0]; v1 += (bfhi(prv[i]) - v1) * mu[1];
                if (lane < 32) { v0 = tanhf(v0); v1 = tanhf(v1); }
                *(unsigned*)(LA + (size_t)m * 256 + 2 * lane) = pk2(v0, v1); *(unsigned*)(LA + (size_t)m * 256 + 128 + 2 * lane) = 0u; }
        }
    }

struct ScanRaw { u32x2 r, rp, k, kp, v, vp, d, a; };
constexpr int SC_CH = 16, SC_BUF_F = 5 * SC_CH * 64 + SC_CH * 16;

__device__ __forceinline__ void scan_phase(const Args& a, const int wave, LAS unsigned char* lds) {
    const int lane = lane_id(), tid = wave * 64 + lane;
    const bf16_t* Rg = (const bf16_t*)(a.ws + WS_R); const bf16_t* Kg = (const bf16_t*)(a.ws + WS_K); const bf16_t* Vg = (const bf16_t*)(a.ws + WS_V);
    const bf16_t* Dg = (const bf16_t*)(a.ws + WS_DARR); const bf16_t* Ag = (const bf16_t*)(a.ws + WS_AARR);
    bf16_t* YAB = (bf16_t*)(a.ws + WS_YAB); float* RK = (float*)((unsigned char*)a.out + DO_RK);
    LAS float* bufs = (LAS float*)lds; LAS float* ybuf = bufs + 2 * SC_BUF_F;
    constexpr int NCH = SEQ / SC_CH;
    for (int job = blockIdx.x; job < 256; job += gridDim.x) {
        const int vcu = (gridDim.x == 256) ? ((job & 7) * 32 + (job >> 3)) : job;
        const int bh = vcu >> 2, vq = vcu & 3, b = bh >> 4, h = bh & 15;
        __syncthreads();
        if (wave >= 4) {
            const int pt = tid - 256, tok = pt >> 4, cgp = pt & 15, ch = h * 64 + 4 * cgp;
            const f32x4 mur = *(const f32x4*)(a.mu_rkv + ch), muk = *(const f32x4*)(a.mu_rkv + DM + ch), muv = *(const f32x4*)(a.mu_rkv + 2 * DM + ch);
            const f32x4 k_k = *(const f32x4*)(a.rwkv_vec + 2 * DM + ch), k_a = *(const f32x4*)(a.rwkv_vec + 3 * DM + ch), rkw = *(const f32x4*)(a.r_k + ch);
            auto load = [&](int c) { ScanRaw q; const int s = c * SC_CH + tok; const size_t m = (size_t)b * SEQ + s; const size_t o = m * DM + ch; const size_t op = (s > 0) ? o - DM : o;
                q.r = *(const u32x2*)(Rg + o); q.k = *(const u32x2*)(Kg + o); q.v = *(const u32x2*)(Vg + o); q.d = *(const u32x2*)(Dg + o); q.a = *(const u32x2*)(Ag + o);
                q.rp = *(const u32x2*)(Rg + op); q.kp = *(const u32x2*)(Kg + op); q.vp = *(const u32x2*)(Vg + op);
                if (s == 0) { q.rp = (u32x2){0u, 0u}; q.kp = (u32x2){0u, 0u}; q.vp = (u32x2){0u, 0u}; }
                return q; };
            auto un4 = [](u32x2 w) { return (f32x4){bflo(w.x), bfhi(w.x), bflo(w.y), bfhi(w.y)}; };
            auto process = [&](const ScanRaw& q, int c, LAS float* buf) {
                const f32x4 r0 = un4(q.r), k0 = un4(q.k), v0 = un4(q.v);
                const f32x4 rl = r0 + (un4(q.rp) - r0) * mur, kl = k0 + (un4(q.kp) - k0) * muk, vl = v0 + (un4(q.vp) - v0) * muv;
                const f32x4 d = un4(q.d), av = un4(q.a);
                f32x4 wdec; wdec[0] = __expf(-d[0]); wdec[1] = __expf(-d[1]); wdec[2] = __expf(-d[2]); wdec[3] = __expf(-d[3]);
                const f32x4 kkr = kl * k_k; float ss = (kkr[0] * kkr[0] + kkr[1] * kkr[1]) + (kkr[2] * kkr[2] + kkr[3] * kkr[3]); ss = row16_sum(ss);
                const float inv = 1.0f / fmaxf(sqrtf(ss), 1e-12f);
                const f32x4 kk = kkr * inv, kp = kl * (1.0f + (av - 1.0f) * k_a), bb = kk * av;
                float rk = (rl[0] * kp[0] * rkw[0] + rl[1] * kp[1] * rkw[1]) + (rl[2] * kp[2] * rkw[2] + rl[3] * kp[3] * rkw[3]); rk = row16_sum(rk);
                const int o = tok * 64 + 4 * cgp;
                *(LAS f32x4*)(buf + o) = -kk; *(LAS f32x4*)(buf + 1024 + o) = wdec; *(LAS f32x4*)(buf + 2048 + o) = bb; *(LAS f32x4*)(buf + 3072 + o) = kp; *(LAS f32x4*)(buf + 4096 + o) = rl;
                if ((cgp >> 2) == vq) *(LAS f32x4*)(buf + 5120 + tok * 16 + 4 * (cgp & 3)) = vl;
                if (vq == 0 && cgp == 0) RK[((size_t)b * SEQ + c * SC_CH + tok) * 16 + h] = rk; };
            auto flush = [&](int c, const LAS float* yb) {
                if (wave == 4) { const int t2 = lane >> 2, rq = lane & 3; const f32x4 y = *(const LAS f32x4*)(yb + t2 * 16 + 4 * rq);
                    u32x2 wv; wv.x = pk2(y[0], y[1]); wv.y = pk2(y[2], y[3]);
                    *(u32x2*)(YAB + ((size_t)b * SEQ + c * SC_CH + t2) * 2048 + 1024 + h * 64 + 16 * vq + 4 * rq) = wv; } };
            ScanRaw q0 = load(0), q1 = load(1);
            process(q0, 0, bufs); q0 = q1; q1 = load(2);
            __syncthreads();
            for (int c = 0; c < NCH; ++c) {
                if (c + 1 < NCH) process(q0, c + 1, bufs + ((c + 1) & 1) * SC_BUF_F);
                q0 = q1; if (c + 3 < NCH) q1 = load(c + 3);
                if (c >= 1) flush(c - 1, ybuf + ((c - 1) & 1) * 256);
                __syncthreads();
            }
            flush(NCH - 1, ybuf + ((NCH - 1) & 1) * 256);
        } else {
            const int rw = lane >> 4, ks = lane & 15, row = wave * 4 + rw;
            float s0 = 0.f, s1 = 0.f, s2 = 0.f, s3 = 0.f;
            __syncthreads();
            for (int c = 0; c < NCH; ++c) {
                const LAS float* buf = bufs + (c & 1) * SC_BUF_F; LAS float* yb = ybuf + (c & 1) * 256;
#pragma unroll
                for (int t = 0; t < SC_CH; ++t) {
                    const f32x4 nk = *(const LAS f32x4*)(buf + t * 64 + 4 * ks), w4 = *(const LAS f32x4*)(buf + 1024 + t * 64 + 4 * ks), b4 = *(const LAS f32x4*)(buf + 2048 + t * 64 + 4 * ks);
                    const f32x4 kp = *(const LAS f32x4*)(buf + 3072 + t * 64 + 4 * ks), r4 = *(const LAS f32x4*)(buf + 4096 + t * 64 + 4 * ks); const float vv = buf[5120 + t * 16 + row];
                    float sa = (s0 * nk[0] + s1 * nk[1]) + (s2 * nk[2] + s3 * nk[3]); sa = row16_sum(sa);
                    s0 = s0 * w4[0] + (sa * b4[0] + vv * kp[0]); s1 = s1 * w4[1] + (sa * b4[1] + vv * kp[1]);
                    s2 = s2 * w4[2] + (sa * b4[2] + vv * kp[2]); s3 = s3 * w4[3] + (sa * b4[3] + vv * kp[3]);
                    float y = (s0 * r4[0] + s1 * r4[1]) + (s2 * r4[2] + s3 * r4[3]); y = row16_sum(y);
                    if (ks == 0) yb[t * 16 + row] = y;
                }
                __syncthreads();
            }
        }
    }
}

__device__ __forceinline__ void post_phase(const Args& a, const int wave) {
    const int lane = lane_id(), tid = wave * 64 + lane;
    const int gw = blockIdx.x * NWAVES + wave, NGW = gridDim.x * NWAVES;
    const bf16_t* Vg = (const bf16_t*)(a.ws + WS_V); const bf16_t* BG = (const bf16_t*)((unsigned char*)a.out + DO_BG); const float* RK = (const float*)((unsigned char*)a.out + DO_RK);
    bf16_t* YAB = (bf16_t*)(a.ws + WS_YAB);
    const int head = lane >> 2, c0 = head * 64 + 16 * (lane & 3);
    f32x4 muv[4], lw[4], lb[4];
#pragma unroll
    for (int j = 0; j < 4; ++j) { muv[j] = *(const f32x4*)(a.mu_rkv + 2 * DM + c0 + 4 * j); lw[j] = *(const f32x4*)(a.rwkv_vec + 4 * DM + c0 + 4 * j); lb[j] = *(const f32x4*)(a.rwkv_vec + 5 * DM + c0 + 4 * j); }
    auto un4 = [](unsigned x, unsigned y) { return (f32x4){bflo(x), bfhi(x), bflo(y), bfhi(y)}; };
    for (int m = gw; m < MTOK; m += NGW) { const int s = m & (SEQ - 1);
        bf16_t* yp = YAB + (size_t)m * 2048 + 1024 + c0;
        const u32x4 ya = *(const u32x4*)yp, yb2 = *(const u32x4*)(yp + 8);
        const u32x4 va = *(const u32x4*)(Vg + (size_t)m * DM + c0), vb = *(const u32x4*)(Vg + (size_t)m * DM + c0 + 8);
        u32x4 pa = (u32x4){0u, 0u, 0u, 0u}, pb = pa; if (s > 0) { pa = *(const u32x4*)(Vg + (size_t)(m - 1) * DM + c0); pb = *(const u32x4*)(Vg + (size_t)(m - 1) * DM + c0 + 8); }
        const u32x4 ga = *(const u32x4*)(BG + (size_t)m * DM + c0), gb = *(const u32x4*)(BG + (size_t)m * DM + c0 + 8);
        const float rk = RK[(size_t)m * 16 + head];
        f32x4 y[4] = {un4(ya.x, ya.y), un4(ya.z, ya.w), un4(yb2.x, yb2.y), un4(yb2.z, yb2.w)};
        const f32x4 v[4] = {un4(va.x, va.y), un4(va.z, va.w), un4(vb.x, vb.y), un4(vb.z, vb.w)};
        const f32x4 p[4] = {un4(pa.x, pa.y), un4(pa.z, pa.w), un4(pb.x, pb.y), un4(pb.z, pb.w)};
        const f32x4 g[4] = {un4(ga.x, ga.y), un4(ga.z, ga.w), un4(gb.x, gb.y), un4(gb.z, gb.w)};
        float sm = 0.f;
#pragma unroll
        for (int j = 0; j < 4; ++j) sm += (y[j][0] + y[j][1]) + (y[j][2] + y[j][3]);
        const float mean = quad_sum(sm) * (1.0f / 64.0f); float q = 0.f;
#pragma unroll
        for (int j = 0; j < 4; ++j) { y[j] = y[j] - mean; q += (y[j][0] * y[j][0] + y[j][1] * y[j][1]) + (y[j][2] * y[j][2] + y[j][3] * y[j][3]); }
        const float rstd = rsqrtf(quad_sum(q) * (1.0f / 64.0f) + 64e-5f);
        u32x4 o[2];
#pragma unroll
        for (int j = 0; j < 4; ++j) { const f32x4 vl = v[j] + (p[j] - v[j]) * muv[j]; const f32x4 r = (y[j] * rstd * lw[j] + lb[j] + rk * vl) * g[j];
            if (j & 1) { o[j >> 1].z = pk2(r[0], r[1]); o[j >> 1].w = pk2(r[2], r[3]); } else { o[j >> 1].x = pk2(r[0], r[1]); o[j >> 1].y = pk2(r[2], r[3]); } }
        *(u32x4*)yp = o[0]; *(u32x4*)(yp + 8) = o[1];
    }
}

constexpr int CS_L = 32, CS_NCH = SEQ / CS_L, CS_NSLOT = 3;
constexpr int CS_NT = 0, CS_RT = 4096, CS_BT = 8192, CS_KT = 12288, CS_TM = 8192, CS_AKN = 10240, CS_ABR = 12288, CS_AKR = 14336, CS_BC = 16384, CS_KC = 20480, CS_VC = 24576, CS_GL = 28672, CS_SLOT = 29184;
constexpr int CS_RAW = CS_NSLOT * CS_SLOT, CS_RAWSZ = 5 * 33 * 128;
constexpr int CS_FLAGS = CS_RAW + CS_NSLOT * CS_RAWSZ;
static_assert(CS_FLAGS + 64 <= LDS_BYTES && (CS_RAW % 16) == 0 && (CS_RAWSZ % 16) == 0, "chunked scan LDS map");
__device__ __forceinline__ int permp(int j) { return 8 * ((j & 15) >> 2) + 4 * (j >> 4) + (j & 3); }
template <int CTRL, int RM> __device__ __forceinline__ float dppf(float x) { return __int_as_float(__builtin_amdgcn_update_dpp(0, __float_as_int(x), CTRL, RM, 0xf, true)); }
__device__ __forceinline__ float wave_total(float x) {
    x = row16_sum(x); x += dppf<0x142, 0xa>(x); x += dppf<0x143, 0xc>(x); return __int_as_float(__builtin_amdgcn_readlane(__float_as_int(x), 63)); }
__device__ __forceinline__ float wave_sum64(float x) { x = row16_sum(x); x += __shfl_xor(x, 16); x += __shfl_xor(x, 32); return x; }
__device__ __forceinline__ bf16x8 cfrag(const f32x16& x, int s) {
    u32x4 w; w.x = pk2(x[8 * s + 0], x[8 * s + 1]); w.y = pk2(x[8 * s + 2], x[8 * s + 3]); w.z = pk2(x[8 * s + 4], x[8 * s + 5]); w.w = pk2(x[8 * s + 6], x[8 * s + 7]); return __builtin_bit_cast(bf16x8, w); }
__device__ __forceinline__ bf16x8 cfrag2(const f32x4& a, const f32x4& b) { u32x4 w; w.x = pk2(a[0], a[1]); w.y = pk2(a[2], a[3]); w.z = pk2(b[0], b[1]); w.w = pk2(b[2], b[3]); return __builtin_bit_cast(bf16x8, w); }
__device__ __forceinline__ void lds_poll_ge(LAS unsigned* p, unsigned want) { while (__hip_atomic_load(p, __ATOMIC_RELAXED, __HIP_MEMORY_SCOPE_WORKGROUP) < want) __builtin_amdgcn_s_sleep(1); asm volatile("" ::: "memory"); }

__device__ __forceinline__ void cscan_job(const Args& a, const int wave, LAS unsigned char* lds, int bh) {
    int lane; asm volatile("v_mbcnt_lo_u32_b32 %0, -1, 0\n\tv_mbcnt_hi_u32_b32 %0, -1, %0" : "=v"(lane));
    const int tid = wave * 64 + lane;
    const int b = bh >> 4, h = bh & 15;
    const bf16_t* Rg = (const bf16_t*)(a.ws + WS_R); const bf16_t* Kg = (const bf16_t*)(a.ws + WS_K); const bf16_t* Vg = (const bf16_t*)(a.ws + WS_V);
    const bf16_t* Dg = (const bf16_t*)(a.ws + WS_DARR); const bf16_t* Ag = (const bf16_t*)(a.ws + WS_AARR);
    bf16_t* YAB = (bf16_t*)(a.ws + WS_YAB); float* RK = (float*)((unsigned char*)a.out + DO_RK);
    LAS unsigned* ready = (LAS unsigned*)(lds + CS_FLAGS); LAS unsigned* done = ready + CS_NSLOT; LAS unsigned* rawready = done + CS_NSLOT; LAS unsigned* rawfree = rawready + CS_NSLOT;
    __syncthreads();
    if (tid < 4 * CS_NSLOT) ready[tid] = 0u;
    __syncthreads();
    if (wave == 4) {
        const int rr = lane >> 3, cc = lane & 7;
        for (int c = 0; c < CS_NCH; ++c) {
            const int s = c % CS_NSLOT; LAS unsigned char* rw = lds + CS_RAW + s * CS_RAWSZ;
            const size_t m0 = (size_t)b * SEQ + (size_t)c * CS_L;
            u32x4 v[5][4], vp[3];
#pragma unroll
            for (int ar = 0; ar < 5; ++ar) { const bf16_t* src = (ar == 0) ? Rg : (ar == 1) ? Kg : (ar == 2) ? Vg : (ar == 3) ? Dg : Ag;
#pragma unroll
                for (int q4 = 0; q4 < 4; ++q4) v[ar][q4] = *(const u32x4*)(src + (m0 + 8 * q4 + rr) * DM + h * 64 + 8 * cc); }
#pragma unroll
            for (int ar = 0; ar < 3; ++ar) { const bf16_t* src = (ar == 0) ? Rg : (ar == 1) ? Kg : Vg; vp[ar] = (u32x4){0u, 0u, 0u, 0u};
                if (c > 0 && lane < 8) vp[ar] = *(const u32x4*)(src + (m0 - 1) * DM + h * 64 + 8 * cc); }
            if (c >= CS_NSLOT) lds_poll_ge(rawfree + s, (unsigned)(c / CS_NSLOT));
#pragma unroll
            for (int ar = 0; ar < 5; ++ar)
#pragma unroll
                for (int q4 = 0; q4 < 4; ++q4) *(LAS u32x4*)(rw + (ar * 33 + 1 + 8 * q4 + rr) * 128 + 16 * cc) = v[ar][q4];
            if (lane < 8) {
#pragma unroll
                for (int ar = 0; ar < 3; ++ar) *(LAS u32x4*)(rw + (ar * 33) * 128 + 16 * cc) = vp[ar]; }
            LDS_WAIT();
            if (lane == 0) __hip_atomic_store(rawready + s, (unsigned)(c + 1), __ATOMIC_RELAXED, __HIP_MEMORY_SCOPE_WORKGROUP);
        }
    } else if (wave >= 5) {
        const int hw = wave - 5, gch = h * 64 + lane;
        const float mur = a.mu_rkv[gch], muk = a.mu_rkv[DM + gch], muv = a.mu_rkv[2 * DM + gch], kkw = a.rwkv_vec[2 * DM + gch], kaw = a.rwkv_vec[3 * DM + gch], rkw = a.r_k[gch];
        const int kpos = 32 * (lane >> 5) + permp(lane & 31);
        for (int c = hw; c < CS_NCH; c += CS_NSLOT) {
            const int s = hw; LAS unsigned char* sl = lds + s * CS_SLOT; const LAS unsigned short* rw = (const LAS unsigned short*)(lds + CS_RAW + s * CS_RAWSZ);
            const unsigned use = (unsigned)(c / CS_NSLOT);
            { PROBE_BEGIN(10, a.ws, wave);
            if (use > 0u) lds_poll_ge(done + s, 4u * use);
            lds_poll_ge(rawready + s, (unsigned)(c + 1));
            PROBE_END(10, a.ws, wave); }
            PROBE_BEGIN(11, a.ws, wave);
            const size_t m0 = (size_t)b * SEQ + (size_t)c * CS_L; const size_t o0 = m0 * DM + gch;
            float rp = bflo((unsigned)rw[(0 * 33) * 64 + lane]), kp = bflo((unsigned)rw[(1 * 33) * 64 + lane]), vp = bflo((unsigned)rw[(2 * 33) * 64 + lane]);
            float cum = 0.f, gprev = 1.f;
            unsigned bcw[16], kcw[16], vcw[16];
#pragma unroll
            for (int grp = 0; grp < 4; ++grp) {
                float rlv[8], kkrv[8], kprv[8], vlv[8], aav[8], ddv[8], red[16];
#pragma unroll
                for (int e = 0; e < 8; ++e) { const int row = 1 + 8 * grp + e;
                    const float r0 = bflo((unsigned)rw[(0 * 33 + row) * 64 + lane]), k0 = bflo((unsigned)rw[(1 * 33 + row) * 64 + lane]), v0 = bflo((unsigned)rw[(2 * 33 + row) * 64 + lane]);
                    ddv[e] = bflo((unsigned)rw[(3 * 33 + row) * 64 + lane]); aav[e] = bflo((unsigned)rw[(4 * 33 + row) * 64 + lane]);
                    rlv[e] = r0 + (rp - r0) * mur; const float kl = k0 + (kp - k0) * muk; vlv[e] = v0 + (vp - v0) * muv; rp = r0; kp = k0; vp = v0;
                    kkrv[e] = kl * kkw; kprv[e] = kl * (1.0f + (aav[e] - 1.0f) * kaw);
                    red[2 * e] = kkrv[e] * kkrv[e]; red[2 * e + 1] = rlv[e] * kprv[e] * rkw; }
#pragma unroll
                for (int e = 0; e < 16; ++e) red[e] += dppf<0xB1, 0xf>(red[e]);
#pragma unroll
                for (int e = 0; e < 16; ++e) red[e] += dppf<0x4E, 0xf>(red[e]);
#pragma unroll
                for (int e = 0; e < 16; ++e) red[e] += dppf<0x141, 0xf>(red[e]);
#pragma unroll
                for (int e = 0; e < 16; ++e) red[e] += dppf<0x140, 0xf>(red[e]);
#pragma unroll
                for (int e = 0; e < 16; ++e) red[e] += dppf<0x142, 0xa>(red[e]);
#pragma unroll
                for (int e = 0; e < 16; ++e) red[e] += dppf<0x143, 0xc>(red[e]);
#pragma unroll
                for (int e = 0; e < 16; ++e) red[e] = __int_as_float(__builtin_amdgcn_readlane(__float_as_int(red[e]), 63));
                if (lane < 8) { float rkv = red[1];
#pragma unroll
                    for (int e = 1; e < 8; ++e) rkv = (lane == e) ? red[2 * e + 1] : rkv;
                    RK[(m0 + 8 * grp + lane) * 16 + h] = rkv; }
#pragma unroll
                for (int j2 = 0; j2 < 4; ++j2) {
                    const int i2 = 4 * grp + j2;
                    float nt[2], bt[2], kt[2], rt[2], vt[2];
#pragma unroll
                    for (int e = 0; e < 2; ++e) { const int te = 2 * j2 + e;
                        const float kkv = kkrv[te] * __builtin_amdgcn_rsqf(fmaxf(red[2 * te], 1e-24f)), bb = kkv * aav[te];
                        cum += ddv[te]; const float gi = __expf(-cum), ginv = __builtin_amdgcn_rcpf(gi);
                        nt[e] = -kkv * gprev; bt[e] = bb * ginv; kt[e] = kprv[te] * ginv; rt[e] = rlv[te] * gi; vt[e] = vlv[te]; gprev = gi; }
                    const unsigned wn = pk2(nt[0], nt[1]), wb = pk2(bt[0], bt[1]), wk = pk2(kt[0], kt[1]), wr = pk2(rt[0], rt[1]), wv = pk2(vt[0], vt[1]);
                    const int i = 2 * i2;
                    *(LAS unsigned short*)(sl + CS_NT + (i * 64 + kpos) * 2) = (unsigned short)wn; *(LAS unsigned short*)(sl + CS_NT + ((i + 1) * 64 + kpos) * 2) = (unsigned short)(wn >> 16);
                    *(LAS unsigned short*)(sl + CS_RT + (i * 64 + kpos) * 2) = (unsigned short)wr; *(LAS unsigned short*)(sl + CS_RT + ((i + 1) * 64 + kpos) * 2) = (unsigned short)(wr >> 16);
                    *(LAS unsigned short*)(sl + CS_BT + (i * 64 + kpos) * 2) = (unsigned short)wb; *(LAS unsigned short*)(sl + CS_BT + ((i + 1) * 64 + kpos) * 2) = (unsigned short)(wb >> 16);
                    *(LAS unsigned short*)(sl + CS_KT + (i * 64 + kpos) * 2) = (unsigned short)wk; *(LAS unsigned short*)(sl + CS_KT + ((i + 1) * 64 + kpos) * 2) = (unsigned short)(wk >> 16);
                    const int pw = permp(i) >> 1;
                    bcw[pw] = wb; kcw[pw] = wk; vcw[pw] = wv;
                }
                __builtin_amdgcn_sched_barrier(0);
            }
#pragma unroll
            for (int q4 = 0; q4 < 4; ++q4) {
                *(LAS u32x4*)(sl + CS_BC + lane * 64 + 16 * q4) = (u32x4){bcw[4 * q4], bcw[4 * q4 + 1], bcw[4 * q4 + 2], bcw[4 * q4 + 3]};
                *(LAS u32x4*)(sl + CS_KC + lane * 64 + 16 * q4) = (u32x4){kcw[4 * q4], kcw[4 * q4 + 1], kcw[4 * q4 + 2], kcw[4 * q4 + 3]};
                *(LAS u32x4*)(sl + CS_VC + lane * 64 + 16 * q4) = (u32x4){vcw[4 * q4], vcw[4 * q4 + 1], vcw[4 * q4 + 2], vcw[4 * q4 + 3]}; }
            *(LAS float*)(sl + CS_GL + lane * 4) = gprev;
            LDS_WAIT();
            if (lane == 0) __hip_atomic_store(rawfree + s, use + 1u, __ATOMIC_RELAXED, __HIP_MEMORY_SCOPE_WORKGROUP);
            PROBE_END(11, a.ws, wave);
            PROBE_BEGIN(12, a.ws, wave);
            const int tok = lane & 31, hf = lane >> 5;
            bf16x8 fn[4], fr[4], fb[4], fk[4];
#pragma unroll
            for (int ks = 0; ks < 4; ++ks) { fn[ks] = *(const LAS bf16x8*)(sl + CS_NT + (tok * 64 + 16 * ks + 8 * hf) * 2); fr[ks] = *(const LAS bf16x8*)(sl + CS_RT + (tok * 64 + 16 * ks + 8 * hf) * 2);
                fb[ks] = *(const LAS bf16x8*)(sl + CS_BT + (tok * 64 + 16 * ks + 8 * hf) * 2); fk[ks] = *(const LAS bf16x8*)(sl + CS_KT + (tok * 64 + 16 * ks + 8 * hf) * 2); }
            f32x16 P, Pt, Tm, Akn, Abr, Akr;
#pragma unroll
            for (int e = 0; e < 16; ++e) { P[e] = 0.f; Pt[e] = 0.f; Akn[e] = 0.f; Abr[e] = 0.f; Akr[e] = 0.f; }
#pragma unroll
            for (int ks = 0; ks < 4; ++ks) { P = __builtin_amdgcn_mfma_f32_32x32x16_bf16(fn[ks], fb[ks], P, 0, 0, 0); Pt = __builtin_amdgcn_mfma_f32_32x32x16_bf16(fb[ks], fn[ks], Pt, 0, 0, 0);
                Akn = __builtin_amdgcn_mfma_f32_32x32x16_bf16(fn[ks], fk[ks], Akn, 0, 0, 0); Abr = __builtin_amdgcn_mfma_f32_32x32x16_bf16(fr[ks], fb[ks], Abr, 0, 0, 0); Akr = __builtin_amdgcn_mfma_f32_32x32x16_bf16(fr[ks], fk[ks], Akr, 0, 0, 0); }
#pragma unroll
            for (int e = 0; e < 16; ++e) { const int row = (e & 3) + 8 * (e >> 2) + 4 * hf, col = tok;
                if (!(col < row)) { P[e] = 0.f; Akn[e] = 0.f; } if (!(row < col)) Pt[e] = 0.f; if (col > row) { Abr[e] = 0.f; Akr[e] = 0.f; }
                Tm[e] = P[e] + (row == col ? 1.0f : 0.f); }
#pragma unroll
            for (int mm = 1; mm <= 4; ++mm) {
                const bf16x8 p0 = cfrag(P, 0), p1 = cfrag(P, 1), q0 = cfrag(Pt, 0), q1 = cfrag(Pt, 1);
                f32x16 Ptn, Pn;
#pragma unroll
                for (int e = 0; e < 16; ++e) { Ptn[e] = 0.f; Pn[e] = 0.f; }
                Ptn = __builtin_amdgcn_mfma_f32_32x32x16_bf16(p0, q0, Ptn, 0, 0, 0); Ptn = __builtin_amdgcn_mfma_f32_32x32x16_bf16(p1, q1, Ptn, 0, 0, 0);
                if (mm < 4) { Pn = __builtin_amdgcn_mfma_f32_32x32x16_bf16(q0, p0, Pn, 0, 0, 0); Pn = __builtin_amdgcn_mfma_f32_32x32x16_bf16(q1, p1, Pn, 0, 0, 0); }
                const bf16x8 t0 = cfrag(Tm, 0), t1 = cfrag(Tm, 1), u0 = cfrag(Ptn, 0), u1 = cfrag(Ptn, 1);
                Tm = __builtin_amdgcn_mfma_f32_32x32x16_bf16(u0, t0, Tm, 0, 0, 0); Tm = __builtin_amdgcn_mfma_f32_32x32x16_bf16(u1, t1, Tm, 0, 0, 0);
                P = Pn; Pt = Ptn;
            }
            { const int pc = permp(tok);
#pragma unroll
              for (int e = 0; e < 16; e += 2) { const int row = (e & 3) + 8 * (e >> 2) + 4 * hf;
                const unsigned w0 = pk2(Tm[e], Tm[e + 1]), w1 = pk2(Akn[e], Akn[e + 1]), w2 = pk2(Abr[e], Abr[e + 1]), w3 = pk2(Akr[e], Akr[e + 1]);
                *(LAS unsigned short*)(sl + CS_TM + (row * 32 + pc) * 2) = (unsigned short)w0; *(LAS unsigned short*)(sl + CS_TM + ((row + 1) * 32 + pc) * 2) = (unsigned short)(w0 >> 16);
                *(LAS unsigned short*)(sl + CS_AKN + (row * 32 + pc) * 2) = (unsigned short)w1; *(LAS unsigned short*)(sl + CS_AKN + ((row + 1) * 32 + pc) * 2) = (unsigned short)(w1 >> 16);
                *(LAS unsigned short*)(sl + CS_ABR + (row * 32 + pc) * 2) = (unsigned short)w2; *(LAS unsigned short*)(sl + CS_ABR + ((row + 1) * 32 + pc) * 2) = (unsigned short)(w2 >> 16);
                *(LAS unsigned short*)(sl + CS_AKR + (row * 32 + pc) * 2) = (unsigned short)w3; *(LAS unsigned short*)(sl + CS_AKR + ((row + 1) * 32 + pc) * 2) = (unsigned short)(w3 >> 16); } }
            LDS_WAIT();
            if (lane == 0) __hip_atomic_store(ready + s, (unsigned)(c + 1), __ATOMIC_RELAXED, __HIP_MEMORY_SCOPE_WORKGROUP);
            PROBE_END(12, a.ws, wave);
        }
    } else {
        const int l15 = lane & 15, g = lane >> 4, vb = wave;
        f32x4 xc[4];
#pragma unroll
        for (int kt = 0; kt < 4; ++kt) xc[kt] = (f32x4){0.f, 0.f, 0.f, 0.f};
        for (int c = 0; c < CS_NCH; ++c) {
            const int s = c % CS_NSLOT; const LAS unsigned char* sl = lds + s * CS_SLOT;
            lds_poll_ge(ready + s, (unsigned)(c + 1));
            const bf16x8 xb0 = cfrag2(xc[0], xc[1]), xb1 = cfrag2(xc[2], xc[3]);
            const bf16x8 vop = *(const LAS bf16x8*)(sl + CS_VC + ((16 * vb + l15) * 32 + 8 * g) * 2);
            f32x4 W[2], U[2], Y[2];
#pragma unroll
            for (int rt = 0; rt < 2; ++rt) { const int row = 16 * rt + l15; f32x4 acc = (f32x4){0.f, 0.f, 0.f, 0.f};
                acc = __builtin_amdgcn_mfma_f32_16x16x32_bf16(*(const LAS bf16x8*)(sl + CS_AKN + (row * 32 + 8 * g) * 2), vop, acc, 0, 0, 0);
                acc = __builtin_amdgcn_mfma_f32_16x16x32_bf16(*(const LAS bf16x8*)(sl + CS_NT + (row * 64 + 8 * g) * 2), xb0, acc, 0, 0, 0);
                acc = __builtin_amdgcn_mfma_f32_16x16x32_bf16(*(const LAS bf16x8*)(sl + CS_NT + (row * 64 + 32 + 8 * g) * 2), xb1, acc, 0, 0, 0);
                W[rt] = acc; }
            const bf16x8 wb = cfrag2(W[0], W[1]);
#pragma unroll
            for (int rt = 0; rt < 2; ++rt) { const int row = 16 * rt + l15;
                U[rt] = __builtin_amdgcn_mfma_f32_16x16x32_bf16(*(const LAS bf16x8*)(sl + CS_TM + (row * 32 + 8 * g) * 2), wb, (f32x4){0.f, 0.f, 0.f, 0.f}, 0, 0, 0); }
            const bf16x8 ub = cfrag2(U[0], U[1]);
#pragma unroll
            for (int rt = 0; rt < 2; ++rt) { const int row = 16 * rt + l15; f32x4 acc = (f32x4){0.f, 0.f, 0.f, 0.f};
                acc = __builtin_amdgcn_mfma_f32_16x16x32_bf16(*(const LAS bf16x8*)(sl + CS_AKR + (row * 32 + 8 * g) * 2), vop, acc, 0, 0, 0);
                acc = __builtin_amdgcn_mfma_f32_16x16x32_bf16(*(const LAS bf16x8*)(sl + CS_RT + (row * 64 + 8 * g) * 2), xb0, acc, 0, 0, 0);
                acc = __builtin_amdgcn_mfma_f32_16x16x32_bf16(*(const LAS bf16x8*)(sl + CS_RT + (row * 64 + 32 + 8 * g) * 2), xb1, acc, 0, 0, 0);
                acc = __builtin_amdgcn_mfma_f32_16x16x32_bf16(*(const LAS bf16x8*)(sl + CS_ABR + (row * 32 + 8 * g) * 2), ub, acc, 0, 0, 0);
                Y[rt] = acc; }
#pragma unroll
            for (int kt = 0; kt < 4; ++kt) { const int row = 16 * kt + l15; f32x4 acc = xc[kt];
                acc = __builtin_amdgcn_mfma_f32_16x16x32_bf16(*(const LAS bf16x8*)(sl + CS_KC + (row * 32 + 8 * g) * 2), vop, acc, 0, 0, 0);
                acc = __builtin_amdgcn_mfma_f32_16x16x32_bf16(*(const LAS bf16x8*)(sl + CS_BC + (row * 32 + 8 * g) * 2), ub, acc, 0, 0, 0);
                xc[kt] = acc * *(const LAS f32x4*)(sl + CS_GL + (16 * kt + 4 * g) * 4); }
            LDS_WAIT();
            if (lane == 0) (void)__hip_atomic_fetch_add(done + s, 1u, __ATOMIC_RELAXED, __HIP_MEMORY_SCOPE_WORKGROUP);
#pragma unroll
            for (int rt = 0; rt < 2; ++rt)
#pragma unroll
                for (int e = 0; e < 4; ++e) { const size_t m = (size_t)b * SEQ + (size_t)c * CS_L + 16 * rt + 4 * g + e;
                    YAB[m * 2048 + 1024 + h * 64 + 16 * vb + l15] = (bf16_t)(pk2(Y[rt][e], 0.f) & 0xffffu); }
        }
    }
}

constexpr int CR_PIECE = 12, CR_NP = (CS_NCH + CR_PIECE - 1) / CR_PIECE, CR_PW = 4, CR_PSLOT = CS_SLOT + 2 * 33 * 128;
constexpr size_t DO_IMG = 66 * MiB;
static_assert((CR_PIECE % 4) == 0 && DO_IMG + (size_t)2 * 64 * CR_PIECE * CS_SLOT <= 128 * MiB && CR_PW * CR_PSLOT <= CS_FLAGS, "image buffer / producer slots");

__device__ __forceinline__ void cscan_produce(const Args& a, const int wave, LAS unsigned char* lds, const int piece, const int first, const int nblk) {
    const int nch = (CS_NCH - piece * CR_PIECE) < CR_PIECE ? (CS_NCH - piece * CR_PIECE) : CR_PIECE;
    if (wave >= CR_PW) {
        const int lane = lane_id(); const int iw = ((int)blockIdx.x - first) * (NWAVES - CR_PW) + (wave - CR_PW), niw = nblk * (NWAVES - CR_PW);
        for (int t = piece * 2 * niw + iw; t < (piece + 1) * 2 * niw && t < MTOK; t += niw) rope_item(a, t, lane);
        return; }
    const bf16_t* Rg = (const bf16_t*)(a.ws + WS_R); const bf16_t* Kg = (const bf16_t*)(a.ws + WS_K); const bf16_t* Vg = (const bf16_t*)(a.ws + WS_V);
    const bf16_t* Dg = (const bf16_t*)(a.ws + WS_DARR); const bf16_t* Ag = (const bf16_t*)(a.ws + WS_AARR);
    float* RK = (float*)((unsigned char*)a.out + DO_RK); unsigned char* IMG = (unsigned char*)a.out + DO_IMG + (size_t)(piece & 1) * 64 * CR_PIECE * CS_SLOT;
    LAS unsigned char* sl = lds + wave * CR_PSLOT;
    const LAS unsigned short* rawD = (const LAS unsigned short*)(sl + 16384); const LAS unsigned short* rawA = (const LAS unsigned short*)(sl + 20480);
    const LAS unsigned short* rawR = (const LAS unsigned short*)(sl + 24576); const LAS unsigned short* rawK = (const LAS unsigned short*)(sl + CS_SLOT); const LAS unsigned short* rawV = (const LAS unsigned short*)(sl + CS_SLOT + 33 * 128);
    u32x4 pre[5][4], prep[3];
    auto issue = [&](int it2, int rr, int c8, int lane) { const int bh2 = it2 / nch, cc2 = it2 % nch, c2 = piece * CR_PIECE + cc2; const unsigned mm = (unsigned)(bh2 >> 4) * SEQ + (unsigned)c2 * CS_L; const int hh = bh2 & 15;
        const unsigned eoff = ((mm + rr) * DM + hh * 64 + 8 * c8) * 2u;
        const unsigned char* wsb = a.ws;
#pragma unroll
        for (int ar = 0; ar < 5; ++ar) { constexpr size_t AOFF[5] = {WS_R, WS_K, WS_V, WS_DARR, WS_AARR};
#pragma unroll
            for (int q4 = 0; q4 < 4; ++q4) pre[ar][q4] = *(const u32x4*)(wsb + AOFF[ar] + eoff + (unsigned)(8 * q4 * DM * 2)); }
        const bool hasp = (c2 > 0) && (lane < 8); const unsigned poff = hasp ? (eoff - (unsigned)((rr + 1) * DM * 2)) : eoff;
#pragma unroll
        for (int ar = 0; ar < 3; ++ar) { constexpr size_t AOFF[3] = {WS_R, WS_K, WS_V}; const u32x4 t = *(const u32x4*)(wsb + AOFF[ar] + poff); prep[ar] = hasp ? t : (u32x4){0u, 0u, 0u, 0u}; } };
    const int it0 = ((int)blockIdx.x - first) * CR_PW + wave, nimg = 64 * nch, itstep = nblk * CR_PW;
    { const int l0 = lane_id(); if (it0 < nimg) issue(it0, l0 >> 3, l0 & 7, l0); }
    for (int it = it0; it < nimg; it += itstep) {
        const int lane = lane_id(), rr = lane >> 3, c8 = lane & 7, kpos = 32 * (lane >> 5) + permp(lane & 31);
        const int bh = it / nch, cc = it % nch, b = bh >> 4, h = bh & 15, c = piece * CR_PIECE + cc, gch = h * 64 + lane;
        const float mur = a.mu_rkv[gch], muk = a.mu_rkv[DM + gch], muv = a.mu_rkv[2 * DM + gch], kkw = a.rwkv_vec[2 * DM + gch], kaw = a.rwkv_vec[3 * DM + gch], rkw = a.r_k[gch];
            const size_t m0 = (size_t)b * SEQ + (size_t)c * CS_L;
            { LAS unsigned char* wb = sl + rr * 128 + 16 * c8; asm volatile("" : "+v"(wb));
#pragma unroll
              for (int q4 = 0; q4 < 4; ++q4) {
                *(LAS u32x4*)(wb + 24576 + (8 * q4 + 1) * 128) = pre[0][q4]; *(LAS u32x4*)(wb + CS_SLOT + (8 * q4 + 1) * 128) = pre[1][q4]; *(LAS u32x4*)(wb + CS_SLOT + 33 * 128 + (8 * q4 + 1) * 128) = pre[2][q4];
                *(LAS u32x4*)(wb + 16384 + (8 * q4) * 128) = pre[3][q4]; *(LAS u32x4*)(wb + 20480 + (8 * q4) * 128) = pre[4][q4]; }
              if (lane < 8) { *(LAS u32x4*)(wb + 24576) = prep[0]; *(LAS u32x4*)(wb + CS_SLOT) = prep[1]; *(LAS u32x4*)(wb + CS_SLOT + 33 * 128) = prep[2]; } }
            LDS_WAIT();
            const LAS unsigned short* rb = (const LAS unsigned short*)sl + lane; asm volatile("" : "+v"(rb));
            float rp = bflo((unsigned)rb[24576 / 2]), kp = bflo((unsigned)rb[CS_SLOT / 2]), vp = bflo((unsigned)rb[(CS_SLOT + 33 * 128) / 2]);
            float cum = 0.f, gprev = 1.f;
            unsigned bcw[16], kcw[16], vcw[16];
#pragma unroll
            for (int grp = 0; grp < 4; ++grp) {
                float rlv[8], kkrv[8], kprv[8], vlv[8], aav[8], ddv[8], red[16];
#pragma unroll
                for (int e = 0; e < 8; ++e) { const int row = 8 * grp + e;
                    const float r0 = bflo((unsigned)rb[24576 / 2 + (row + 1) * 64]), k0 = bflo((unsigned)rb[CS_SLOT / 2 + (row + 1) * 64]), v0 = bflo((unsigned)rb[(CS_SLOT + 33 * 128) / 2 + (row + 1) * 64]);
                    ddv[e] = bflo((unsigned)rb[16384 / 2 + row * 64]); aav[e] = bflo((unsigned)rb[20480 / 2 + row * 64]);
                    rlv[e] = r0 + (rp - r0) * mur; const float kl = k0 + (kp - k0) * muk; vlv[e] = v0 + (vp - v0) * muv; rp = r0; kp = k0; vp = v0;
                    kkrv[e] = kl * kkw; kprv[e] = kl * (1.0f + (aav[e] - 1.0f) * kaw);
                    red[2 * e] = kkrv[e] * kkrv[e]; red[2 * e + 1] = rlv[e] * kprv[e] * rkw; }
#pragma unroll
                for (int e = 0; e < 16; ++e) red[e] += dppf<0xB1, 0xf>(red[e]);
#pragma unroll
                for (int e = 0; e < 16; ++e) red[e] += dppf<0x4E, 0xf>(red[e]);
#pragma unroll
                for (int e = 0; e < 16; ++e) red[e] += dppf<0x141, 0xf>(red[e]);
#pragma unroll
                for (int e = 0; e < 16; ++e) red[e] += dppf<0x140, 0xf>(red[e]);
#pragma unroll
                for (int e = 0; e < 16; ++e) red[e] += dppf<0x142, 0xa>(red[e]);
#pragma unroll
                for (int e = 0; e < 16; ++e) red[e] += dppf<0x143, 0xc>(red[e]);
#pragma unroll
                for (int e = 0; e < 16; ++e) red[e] = __int_as_float(__builtin_amdgcn_readlane(__float_as_int(red[e]), 63));
                if (lane < 8) { float rkv = red[1];
#pragma unroll
                    for (int e = 1; e < 8; ++e) rkv = (lane == e) ? red[2 * e + 1] : rkv;
                    RK[(m0 + 8 * grp + lane) * 16 + h] = rkv; }
#pragma unroll
                for (int j2 = 0; j2 < 4; ++j2) {
                    const int i2 = 4 * grp + j2;
                    float nt[2], bt[2], kt[2], rt[2], vt[2];
#pragma unroll
                    for (int e = 0; e < 2; ++e) { const int te = 2 * j2 + e;
                        const float kkv = kkrv[te] * __builtin_amdgcn_rsqf(fmaxf(red[2 * te], 1e-24f)), bb = kkv * aav[te];
                        cum += ddv[te]; const float gi = __expf(-cum), ginv = __builtin_amdgcn_rcpf(gi);
                        nt[e] = -kkv * gprev; bt[e] = bb * ginv; kt[e] = kprv[te] * ginv; rt[e] = rlv[te] * gi; vt[e] = vlv[te]; gprev = gi; }
                    const unsigned wn = pk2(nt[0], nt[1]), wb = pk2(bt[0], bt[1]), wk = pk2(kt[0], kt[1]), wr = pk2(rt[0], rt[1]), wv = pk2(vt[0], vt[1]);
                    const int i = 2 * i2;
                    *(LAS unsigned short*)(sl + CS_NT + (i * 64 + kpos) * 2) = (unsigned short)wn; *(LAS unsigned short*)(sl + CS_NT + ((i + 1) * 64 + kpos) * 2) = (unsigned short)(wn >> 16);
                    *(LAS unsigned short*)(sl + CS_RT + (i * 64 + kpos) * 2) = (unsigned short)wr; *(LAS unsigned short*)(sl + CS_RT + ((i + 1) * 64 + kpos) * 2) = (unsigned short)(wr >> 16);
                    *(LAS unsigned short*)(sl + CS_BT + (i * 64 + kpos) * 2) = (unsigned short)wb; *(LAS unsigned short*)(sl + CS_BT + ((i + 1) * 64 + kpos) * 2) = (unsigned short)(wb >> 16);
                    *(LAS unsigned short*)(sl + CS_KT + (i * 64 + kpos) * 2) = (unsigned short)wk; *(LAS unsigned short*)(sl + CS_KT + ((i + 1) * 64 + kpos) * 2) = (unsigned short)(wk >> 16);
                    const int pw = permp(i) >> 1;
                    bcw[pw] = wb; kcw[pw] = wk; vcw[pw] = wv;
                }
                __builtin_amdgcn_sched_barrier(0);
            }
#pragma unroll
            for (int q4 = 0; q4 < 4; ++q4) {
                *(LAS u32x4*)(sl + CS_BC + lane * 64 + 16 * q4) = (u32x4){bcw[4 * q4], bcw[4 * q4 + 1], bcw[4 * q4 + 2], bcw[4 * q4 + 3]};
                *(LAS u32x4*)(sl + CS_KC + lane * 64 + 16 * q4) = (u32x4){kcw[4 * q4], kcw[4 * q4 + 1], kcw[4 * q4 + 2], kcw[4 * q4 + 3]};
                *(LAS u32x4*)(sl + CS_VC + lane * 64 + 16 * q4) = (u32x4){vcw[4 * q4], vcw[4 * q4 + 1], vcw[4 * q4 + 2], vcw[4 * q4 + 3]}; }
            *(LAS float*)(sl + CS_GL + lane * 4) = gprev;
            LDS_WAIT();
            const int tok = lane & 31, hf = lane >> 5;
            bf16x8 fn[4], fr[4], fb[4], fk[4];
#pragma unroll
            for (int ks = 0; ks < 4; ++ks) { fn[ks] = *(const LAS bf16x8*)(sl + CS_NT + (tok * 64 + 16 * ks + 8 * hf) * 2); fr[ks] = *(const LAS bf16x8*)(sl + CS_RT + (tok * 64 + 16 * ks + 8 * hf) * 2);
                fb[ks] = *(const LAS bf16x8*)(sl + CS_BT + (tok * 64 + 16 * ks + 8 * hf) * 2); fk[ks] = *(const LAS bf16x8*)(sl + CS_KT + (tok * 64 + 16 * ks + 8 * hf) * 2); }
            f32x16 P, Pt, Tm, Akn, Abr, Akr;
#pragma unroll
            for (int e = 0; e < 16; ++e) { P[e] = 0.f; Pt[e] = 0.f; Akn[e] = 0.f; Abr[e] = 0.f; Akr[e] = 0.f; }
#pragma unroll
            for (int ks = 0; ks < 4; ++ks) { P = __builtin_amdgcn_mfma_f32_32x32x16_bf16(fn[ks], fb[ks], P, 0, 0, 0); Pt = __builtin_amdgcn_mfma_f32_32x32x16_bf16(fb[ks], fn[ks], Pt, 0, 0, 0);
                Akn = __builtin_amdgcn_mfma_f32_32x32x16_bf16(fn[ks], fk[ks], Akn, 0, 0, 0); Abr = __builtin_amdgcn_mfma_f32_32x32x16_bf16(fr[ks], fb[ks], Abr, 0, 0, 0); Akr = __builtin_amdgcn_mfma_f32_32x32x16_bf16(fr[ks], fk[ks], Akr, 0, 0, 0); }
#pragma unroll
            for (int e = 0; e < 16; ++e) { const int row = (e & 3) + 8 * (e >> 2) + 4 * hf, col = tok;
                if (!(col < row)) { P[e] = 0.f; Akn[e] = 0.f; } if (!(row < col)) Pt[e] = 0.f; if (col > row) { Abr[e] = 0.f; Akr[e] = 0.f; }
                Tm[e] = P[e] + (row == col ? 1.0f : 0.f); }
#pragma unroll
            for (int mm = 1; mm <= 4; ++mm) {
                const bf16x8 p0 = cfrag(P, 0), p1 = cfrag(P, 1), q0 = cfrag(Pt, 0), q1 = cfrag(Pt, 1);
                f32x16 Ptn, Pn;
#pragma unroll
                for (int e = 0; e < 16; ++e) { Ptn[e] = 0.f; Pn[e] = 0.f; }
                Ptn = __builtin_amdgcn_mfma_f32_32x32x16_bf16(p0, q0, Ptn, 0, 0, 0); Ptn = __builtin_amdgcn_mfma_f32_32x32x16_bf16(p1, q1, Ptn, 0, 0, 0);
                if (mm < 4) { Pn = __builtin_amdgcn_mfma_f32_32x32x16_bf16(q0, p0, Pn, 0, 0, 0); Pn = __builtin_amdgcn_mfma_f32_32x32x16_bf16(q1, p1, Pn, 0, 0, 0); }
                const bf16x8 t0 = cfrag(Tm, 0), t1 = cfrag(Tm, 1), u0 = cfrag(Ptn, 0), u1 = cfrag(Ptn, 1);
                Tm = __builtin_amdgcn_mfma_f32_32x32x16_bf16(u0, t0, Tm, 0, 0, 0); Tm = __builtin_amdgcn_mfma_f32_32x32x16_bf16(u1, t1, Tm, 0, 0, 0);
                P = Pn; Pt = Ptn;
            }
            { const int itn = it + itstep; if (itn < nimg) { const int l2 = lane_id(); issue(itn, l2 >> 3, l2 & 7, l2); } }
            { const int pc = permp(tok);
#pragma unroll
              for (int e = 0; e < 16; e += 2) { const int row = (e & 3) + 8 * (e >> 2) + 4 * hf;
                const unsigned w0 = pk2(Tm[e], Tm[e + 1]), w1 = pk2(Akn[e], Akn[e + 1]), w2 = pk2(Abr[e], Abr[e + 1]), w3 = pk2(Akr[e], Akr[e + 1]);
                *(LAS unsigned short*)(sl + CS_TM + (row * 32 + pc) * 2) = (unsigned short)w0; *(LAS unsigned short*)(sl + CS_TM + ((row + 1) * 32 + pc) * 2) = (unsigned short)(w0 >> 16);
                *(LAS unsigned short*)(sl + CS_AKN + (row * 32 + pc) * 2) = (unsigned short)w1; *(LAS unsigned short*)(sl + CS_AKN + ((row + 1) * 32 + pc) * 2) = (unsigned short)(w1 >> 16);
                *(LAS unsigned short*)(sl + CS_ABR + (row * 32 + pc) * 2) = (unsigned short)w2; *(LAS unsigned short*)(sl + CS_ABR + ((row + 1) * 32 + pc) * 2) = (unsigned short)(w2 >> 16);
                *(LAS unsigned short*)(sl + CS_AKR + (row * 32 + pc) * 2) = (unsigned short)w3; *(LAS unsigned short*)(sl + CS_AKR + ((row + 1) * 32 + pc) * 2) = (unsigned short)(w3 >> 16); } }
            LDS_WAIT();
            { unsigned char* dst = IMG + (size_t)(bh * CR_PIECE + cc) * CS_SLOT;
#pragma unroll 1
              for (int j = lane; j < CS_SLOT / 16; j += 64) *(u32x4*)(dst + 16 * j) = *(const LAS u32x4*)(sl + 16 * j); }
            LDS_WAIT();
    }
}

__device__ __forceinline__ void cscan_consume(const Args& a, const int wave, LAS unsigned char* lds, const int bh, const int piece, f32x4 (&xc)[4]) {
    const int lane = lane_id();
    const int b = bh >> 4, h = bh & 15;
    bf16_t* YAB = (bf16_t*)(a.ws + WS_YAB); const unsigned char* IMG = (const unsigned char*)a.out + DO_IMG + (size_t)(piece & 1) * 64 * CR_PIECE * CS_SLOT;
    const int nch = (CS_NCH - piece * CR_PIECE) < CR_PIECE ? (CS_NCH - piece * CR_PIECE) : CR_PIECE;
    LAS unsigned* ready = (LAS unsigned*)(lds + CS_FLAGS); LAS unsigned* done = ready + 4;
    if (wave == 4) {
        constexpr int NI = (CS_SLOT + 1023) / 1024;
        for (int cc = 0; cc <= nch; ++cc) {
            if (cc < nch) { const int c = piece * CR_PIECE + cc, s = cc & 3; LAS unsigned char* sl = lds + s * CS_SLOT;
                const unsigned char* src = IMG + (size_t)(bh * CR_PIECE + cc) * CS_SLOT;
                if (c >= 4) lds_poll_ge(done + s, 4u * (unsigned)(c >> 2));
#pragma unroll
                for (int j = 0; j < NI; ++j) { const int idx = lane + 64 * j;
                    if (idx < CS_SLOT / 16) __builtin_amdgcn_global_load_lds((const unsigned*)(src + 16 * idx), (LAS unsigned*)(sl + 1024 * j), 16, 0, 0); } }
            if (cc >= 1) {
                if (cc < nch) asm volatile("s_waitcnt vmcnt(29)" ::: "memory"); else asm volatile("s_waitcnt vmcnt(0)" ::: "memory");
                if (lane == 0) __hip_atomic_store(ready + ((cc - 1) & 3), (unsigned)(piece * CR_PIECE + cc), __ATOMIC_RELAXED, __HIP_MEMORY_SCOPE_WORKGROUP); }
        }
    } else if (wave < 4) {
        const int l15 = lane & 15, g = lane >> 4, vb = wave;
        for (int cc = 0; cc < nch; ++cc) { const int c = piece * CR_PIECE + cc, s = cc & 3; const LAS unsigned char* sl = lds + s * CS_SLOT;
            { lds_poll_ge(ready + s, (unsigned)(c + 1)); }
            const bf16x8 xb0 = cfrag2(xc[0], xc[1]), xb1 = cfrag2(xc[2], xc[3]);
            const bf16x8 vop = *(const LAS bf16x8*)(sl + CS_VC + ((16 * vb + l15) * 32 + 8 * g) * 2);
            f32x4 W[2], U[2], Y[2];
#pragma unroll
            for (int rt = 0; rt < 2; ++rt) { const int row = 16 * rt + l15; f32x4 acc = (f32x4){0.f, 0.f, 0.f, 0.f};
                acc = __builtin_amdgcn_mfma_f32_16x16x32_bf16(*(const LAS bf16x8*)(sl + CS_AKN + (row * 32 + 8 * g) * 2), vop, acc, 0, 0, 0);
                acc = __builtin_amdgcn_mfma_f32_16x16x32_bf16(*(const LAS bf16x8*)(sl + CS_NT + (row * 64 + 8 * g) * 2), xb0, acc, 0, 0, 0);
                acc = __builtin_amdgcn_mfma_f32_16x16x32_bf16(*(const LAS bf16x8*)(sl + CS_NT + (row * 64 + 32 + 8 * g) * 2), xb1, acc, 0, 0, 0);
                W[rt] = acc; }
            const bf16x8 wb = cfrag2(W[0], W[1]);
#pragma unroll
            for (int rt = 0; rt < 2; ++rt) { const int row = 16 * rt + l15;
                U[rt] = __builtin_amdgcn_mfma_f32_16x16x32_bf16(*(const LAS bf16x8*)(sl + CS_TM + (row * 32 + 8 * g) * 2), wb, (f32x4){0.f, 0.f, 0.f, 0.f}, 0, 0, 0); }
            const bf16x8 ub = cfrag2(U[0], U[1]);
#pragma unroll
            for (int rt = 0; rt < 2; ++rt) { const int row = 16 * rt + l15; f32x4 acc = (f32x4){0.f, 0.f, 0.f, 0.f};
                acc = __builtin_amdgcn_mfma_f32_16x16x32_bf16(*(const LAS bf16x8*)(sl + CS_AKR + (row * 32 + 8 * g) * 2), vop, acc, 0, 0, 0);
                acc = __builtin_amdgcn_mfma_f32_16x16x32_bf16(*(const LAS bf16x8*)(sl + CS_RT + (row * 64 + 8 * g) * 2), xb0, acc, 0, 0, 0);
                acc = __builtin_amdgcn_mfma_f32_16x16x32_bf16(*(const LAS bf16x8*)(sl + CS_RT + (row * 64 + 32 + 8 * g) * 2), xb1, acc, 0, 0, 0);
                acc = __builtin_amdgcn_mfma_f32_16x16x32_bf16(*(const LAS bf16x8*)(sl + CS_ABR + (row * 32 + 8 * g) * 2), ub, acc, 0, 0, 0);
                Y[rt] = acc; }
#pragma unroll
            for (int kt = 0; kt < 4; ++kt) { const int row = 16 * kt + l15; f32x4 acc = xc[kt];
                acc = __builtin_amdgcn_mfma_f32_16x16x32_bf16(*(const LAS bf16x8*)(sl + CS_KC + (row * 32 + 8 * g) * 2), vop, acc, 0, 0, 0);
                acc = __builtin_amdgcn_mfma_f32_16x16x32_bf16(*(const LAS bf16x8*)(sl + CS_BC + (row * 32 + 8 * g) * 2), ub, acc, 0, 0, 0);
                xc[kt] = acc * *(const LAS f32x4*)(sl + CS_GL + (16 * kt + 4 * g) * 4); }
            LDS_WAIT();
            if (lane == 0) (void)__hip_atomic_fetch_add(done + s, 1u, __ATOMIC_RELAXED, __HIP_MEMORY_SCOPE_WORKGROUP);
#pragma unroll
            for (int rt = 0; rt < 2; ++rt)
#pragma unroll
                for (int e = 0; e < 4; ++e) { const size_t m = (size_t)b * SEQ + (size_t)c * CS_L + 16 * rt + 4 * g + e;
                    YAB[m * 2048 + 1024 + h * 64 + 16 * vb + l15] = (bf16_t)(pk2(Y[rt][e], 0.f) & 0xffffu); }
        }
    }
}

constexpr int DS_NQ = 16, DS_CAP = 2048, DS_TRIG = 1536, DS_TOPK = 256;
constexpr int DS_HIST_WORDS = 320;
constexpr int DS_KT_BYTES = 2048;
constexpr int DS_CAND_OFF = 0, DS_HIST_OFF = DS_NQ * DS_CAP * 4, DS_KT_OFF = DS_HIST_OFF, DS_CNT_OFF = DS_HIST_OFF + 8 * DS_KT_BYTES, DS_TAU_OFF = DS_CNT_OFF + 64;
static_assert(8 * DS_HIST_WORDS * 4 <= 8 * DS_KT_BYTES, "dsa LDS map");
static_assert(DS_TAU_OFF + 64 <= LDS_BYTES, "dsa LDS map");

template <int CTRL, int RM> __device__ __forceinline__ unsigned dppu(unsigned x) { return (unsigned)__builtin_amdgcn_update_dpp(0, (int)x, CTRL, RM, 0xf, true); }
__device__ __forceinline__ unsigned wave_scan_incl(unsigned v) {
    v += dppu<0x111, 0xf>(v); v += dppu<0x112, 0xf>(v); v += dppu<0x114, 0xf>(v); v += dppu<0x118, 0xf>(v);
    v += dppu<0x142, 0xa>(v);
    v += dppu<0x143, 0xc>(v);
    return v; }
template <int NE>
__device__ __forceinline__ void select_compact(LAS unsigned* cq, LAS unsigned* cntq, LAS unsigned* tauq, LAS unsigned* hist, int lane) {
    const unsigned n = *cntq;
    unsigned e[NE];
#pragma unroll
    for (int j = 0; j < NE; ++j) { const unsigned idx = lane + 64 * j; e[j] = idx < n ? cq[idx] : 0u; }
    unsigned npos = 0u;
#pragma unroll
    for (int j = 0; j < NE; ++j) npos += (unsigned)__popcll(__ballot(e[j] >= 0x80000000u));
    if (npos >= (unsigned)DS_TOPK) {
#pragma unroll
        for (int j = 0; j < NE; ++j) e[j] = (e[j] >= 0x80000000u) ? e[j] : 0u; }
    unsigned va = 0xFFFFFFFFu, vo = 0u;
#pragma unroll
    for (int j = 0; j < NE; ++j) { va &= (e[j] != 0u) ? e[j] : 0xFFFFFFFFu; vo |= e[j]; }
    va &= (unsigned)__builtin_amdgcn_update_dpp(-1, (int)va, 0xB1, 0xf, 0xf, true); va &= (unsigned)__builtin_amdgcn_update_dpp(-1, (int)va, 0x4E, 0xf, 0xf, true);
    va &= (unsigned)__builtin_amdgcn_update_dpp(-1, (int)va, 0x141, 0xf, 0xf, true); va &= (unsigned)__builtin_amdgcn_update_dpp(-1, (int)va, 0x140, 0xf, 0xf, true);
    vo |= dppu<0xB1, 0xf>(vo); vo |= dppu<0x4E, 0xf>(vo); vo |= dppu<0x141, 0xf>(vo); vo |= dppu<0x140, 0xf>(vo);
    const unsigned vas = (unsigned)(__builtin_amdgcn_readlane((int)va, 0) & __builtin_amdgcn_readlane((int)va, 16) & __builtin_amdgcn_readlane((int)va, 32) & __builtin_amdgcn_readlane((int)va, 48));
    const unsigned vos = (unsigned)(__builtin_amdgcn_readlane((int)vo, 0) | __builtin_amdgcn_readlane((int)vo, 16) | __builtin_amdgcn_readlane((int)vo, 32) | __builtin_amdgcn_readlane((int)vo, 48));
    const unsigned diff = vas ^ vos;
    const int top = diff ? 31 - __builtin_clz(diff) : 7;
    unsigned prefix = (top >= 31) ? 0u : (vos & ~((2u << top) - 1u)), mask = (top >= 31) ? 0u : ~((2u << top) - 1u), need = DS_TOPK;
    int hi = top;
    const int rl = 63 - lane;
#pragma unroll 1
    for (int pass = 0; pass < 4 && hi >= 0; ++pass) {
        const int shift = hi >= 7 ? hi - 7 : 0; const unsigned dmask = (hi >= 7) ? 0xFFu : ((2u << hi) - 1u);
        *(LAS u32x4*)(hist + 4 * lane) = (u32x4){0u, 0u, 0u, 0u};
        LDS_WAIT();
#pragma unroll
        for (int j = 0; j < NE; ++j) { const bool hit = (e[j] != 0u) && ((e[j] & mask) == prefix); const unsigned bin = hit ? ((e[j] >> shift) & dmask) : (256u + (unsigned)lane);
            (void)__hip_atomic_fetch_add(hist + bin, 1u, __ATOMIC_RELAXED, __HIP_MEMORY_SCOPE_WORKGROUP); }
        LDS_WAIT();
        const u32x4 h4 = *(const LAS u32x4*)(hist + 4 * rl);
        const unsigned tot = (h4.x + h4.y) + (h4.z + h4.w);
        const unsigned v = wave_scan_incl(tot);
        const unsigned above = v - tot;
        const bool is = (above < need) && (need <= v);
        unsigned B = 0u, ca = 0u, hb = 0u;
        if (is) { unsigned c = above;
            if (c + h4.w >= need) { B = 4 * rl + 3; ca = c; hb = h4.w; } else { c += h4.w;
            if (c + h4.z >= need) { B = 4 * rl + 2; ca = c; hb = h4.z; } else { c += h4.z;
            if (c + h4.y >= need) { B = 4 * rl + 1; ca = c; hb = h4.y; } else { c += h4.y; B = 4 * rl; ca = c; hb = h4.x; } } } }
        const unsigned long long bal = __ballot(is);
        if (bal == 0ull) break;
        const int src = __builtin_amdgcn_readfirstlane(__ffsll((long long)bal) - 1);
        B = (unsigned)__builtin_amdgcn_readlane((int)B, src); ca = (unsigned)__builtin_amdgcn_readlane((int)ca, src); hb = (unsigned)__builtin_amdgcn_readlane((int)hb, src);
        need -= ca; prefix |= B << shift; mask |= dmask << shift; hi = shift - 1;
        if (hb == need) break;
    }
    const unsigned T = prefix;
    unsigned base = 0u;
#pragma unroll
    for (int j = 0; j < NE; ++j) { const bool keep = (e[j] >= T) && (e[j] != 0u); const unsigned long long bal = __ballot(keep);
        const unsigned pos = base + __builtin_amdgcn_mbcnt_hi((unsigned)(bal >> 32), __builtin_amdgcn_mbcnt_lo((unsigned)bal, 0u));
        if (keep) cq[pos] = e[j];
        base += (unsigned)__popcll(bal); }
    if (lane == 0) { *cntq = base; *tauq = T; }
    LDS_WAIT();
}

template <int NE>
__device__ __forceinline__ void filter_compact(LAS unsigned* cq, LAS unsigned* cntq, LAS unsigned* tauq, int lane) {
    const unsigned n = *cntq;
    unsigned e[NE];
#pragma unroll
    for (int j = 0; j < NE; ++j) { const unsigned idx = lane + 64 * j; e[j] = idx < n ? cq[idx] : 0u; }
    unsigned m0 = 0u, m1 = 0u, m2 = 0u, m3 = 0u;
#pragma unroll
    for (int j = 0; j < NE; ++j) { unsigned x = e[j], t;
        t = max(m0, x); x = min(m0, x); m0 = t; t = max(m1, x); x = min(m1, x); m1 = t; t = max(m2, x); x = min(m2, x); m2 = t; m3 = max(m3, x); }
    unsigned T = m3;
    T = min(T, (unsigned)__builtin_amdgcn_update_dpp(-1, (int)T, 0xB1, 0xf, 0xf, true)); T = min(T, (unsigned)__builtin_amdgcn_update_dpp(-1, (int)T, 0x4E, 0xf, 0xf, true));
    T = min(T, (unsigned)__builtin_amdgcn_update_dpp(-1, (int)T, 0x141, 0xf, 0xf, true)); T = min(T, (unsigned)__builtin_amdgcn_update_dpp(-1, (int)T, 0x140, 0xf, 0xf, true));
    T = min(min((unsigned)__builtin_amdgcn_readlane((int)T, 0), (unsigned)__builtin_amdgcn_readlane((int)T, 16)), min((unsigned)__builtin_amdgcn_readlane((int)T, 32), (unsigned)__builtin_amdgcn_readlane((int)T, 48)));
    unsigned base = 0u;
#pragma unroll
    for (int j = 0; j < NE; ++j) { const bool keep = (e[j] >= T) && (e[j] != 0u); const unsigned long long bal = __ballot(keep);
        const unsigned pos = base + __builtin_amdgcn_mbcnt_hi((unsigned)(bal >> 32), __builtin_amdgcn_mbcnt_lo((unsigned)bal, 0u));
        if (keep) cq[pos] = e[j];
        base += (unsigned)__popcll(bal); }
    if (lane == 0) { *cntq = base; *tauq = (T > 0u) ? T - 1u : 0u; }
    LDS_WAIT();
}

__device__ __forceinline__ float relu_(float x) { return __int_as_float(max(__float_as_int(x), 0)); }
__device__ __forceinline__ unsigned vrow_off(int pr) { return (unsigned)(pr < 28 ? 1024 + 256 * pr : 9216 + 256 * (pr - 28)); }
__device__ __forceinline__ unsigned swz_b(int row) { return (unsigned)(((row & 3) << 2) | ((row >> 2) & 3)); }

__device__ __forceinline__ void dsa_phase(const Args& a, const int wave, LAS unsigned char* lds, const bool dry = false) {
    const bf16_t* Qg = (const bf16_t*)(a.ws + WS_Q); const bf16_t* KVg = (const bf16_t*)(a.ws + WS_KV); const bf16_t* QIg = (const bf16_t*)(a.ws + WS_QI);
    const bf16_t* KIg = (const bf16_t*)(a.ws + WS_KI); const float* WIg = (const float*)(a.ws + WS_WI); bf16_t* Gg = (bf16_t*)(a.ws + WS_G);
    LAS unsigned* cand = (LAS unsigned*)(lds + DS_CAND_OFF); LAS unsigned* hist = (LAS unsigned*)(lds + DS_HIST_OFF) + wave * DS_HIST_WORDS;
    LAS unsigned* cnt = (LAS unsigned*)(lds + DS_CNT_OFF); LAS unsigned* taup = (LAS unsigned*)(lds + DS_TAU_OFF);
    for (int L = blockIdx.x; L < 2048; L += gridDim.x) {
        int lane; asm volatile("v_mbcnt_lo_u32_b32 %0, -1, 0\n\tv_mbcnt_hi_u32_b32 %0, -1, %0" : "=v"(lane));
        const int tid = wave * 64 + lane, ql = lane & 15, gq = lane >> 4;
        int b, j;
        if (gridDim.x == 256) { const int i = blockIdx.x, ui = L >> 8, x = i & 7, li = (i >> 3) * 2 + (x >> 2); b = x & 3; j = 128 * (ui >> 1) + ((ui & 1) ? 127 - li : li); }
        else { b = L >> 9; j = L & 511; }
        const unsigned mb = (unsigned)b * SEQ; const int q0 = DS_NQ * j; const unsigned mq = mb + q0 + ql;
        const int pos0 = a.pos[mb]; int nadm = ((a.pos[mq] >> 6) + 1) * 64 - pos0; nadm = nadm > SEQ ? SEQ : nadm;
        int nmax = ((a.pos[mb + q0 + DS_NQ - 1] >> 6) + 1) * 64 - pos0; nmax = nmax > SEQ ? SEQ : nmax;
        const int nstep = (nmax + 511) >> 9;
#ifdef DSA_REP_STREAM
        for (int srep_ = 0; srep_ < 2; ++srep_) { const bool sdry = (srep_ == 0) && a.ph_hi > 0;
#ifndef DSA_DRYMODE
#define DSA_DRYMODE 0
#endif
#else
        const bool sdry = false;
#define DSA_DRYMODE 0
#endif
        __syncthreads();
        if (tid < DS_NQ) { cnt[tid] = 0u; taup[tid] = 0u; }
        bf16x8 bq[8][2];
#pragma unroll
        for (int h = 0; h < 8; ++h)
#pragma unroll
            for (int ks = 0; ks < 2; ++ks) bq[h][ks] = *(const bf16x8*)(QIg + ((((mb + q0) >> 4) * 16 + h * 2 + ks) * 512u + 8u * lane));
        f32x2 wh[8]; { const f32x4 w0 = *(const f32x4*)(WIg + mq * 8), w1 = *(const f32x4*)(WIg + mq * 8 + 4);
#pragma unroll
            for (int h = 0; h < 4; ++h) { wh[h] = (f32x2){w0[h], w0[h]}; wh[4 + h] = (f32x2){w1[h], w1[h]}; } }
        __syncthreads();
        u32x4 ka[8];
        { unsigned ko = (mb + 64 * wave) * 64u + 8u * lane, ko1 = ko + 2048u;
          asm volatile("" : "+v"(ko), "+v"(ko1));
#pragma unroll
          for (int j8 = 0; j8 < 8; ++j8) ka[j8] = *(const u32x4*)(KIg + ((j8 & 4) ? ko1 : ko) + (j8 & 3) * 512); }
        for (int step = 0; step <= nstep; ++step) {
            const int kb = 512 * step + 64 * wave; const bool active = (kb < nmax) && (step < nstep);
            PROBE_BEGIN(2, a.ws, wave);
            if (active) {
                f32x2 sc2[8];
#pragma unroll
                for (int i = 0; i < 8; ++i) sc2[i] = (f32x2){0.f, 0.f};
                const int ln = lane_id();
                const int kbn = (kb + 512 < SEQ) ? kb + 512 : kb; unsigned ko = (mb + kbn) * 64u + 8u * ln, ko1 = ko + 2048u;
                asm volatile("" : "+v"(ko), "+v"(ko1));
#pragma unroll
                for (int st = 0; st < 4; ++st) {
                    const bf16x8 af0 = __builtin_bit_cast(bf16x8, ka[2 * st]), af1 = __builtin_bit_cast(bf16x8, ka[2 * st + 1]);
                    f32x4 acc[8];
#pragma unroll
                    for (int h = 0; h < 8; ++h) acc[h] = __builtin_amdgcn_mfma_f32_16x16x32_bf16(af0, bq[h][0], (f32x4){0.f, 0.f, 0.f, 0.f}, 0, 0, 0);
#pragma unroll
                    for (int h = 0; h < 8; ++h) acc[h] = __builtin_amdgcn_mfma_f32_16x16x32_bf16(af1, bq[h][1], acc[h], 0, 0, 0);
                    __builtin_amdgcn_sched_barrier(0);
                    if (!(sdry && (DSA_DRYMODE & 1))) {
                        ka[2 * st] = *(const u32x4*)(KIg + ((st & 2) ? ko1 : ko) + (2 * st & 3) * 512); ka[2 * st + 1] = *(const u32x4*)(KIg + ((st & 2) ? ko1 : ko) + ((2 * st + 1) & 3) * 512); }
#pragma unroll
                    for (int h = 0; h < 8; ++h) {
                        sc2[2 * st] += wh[h] * (f32x2){relu_(acc[h][0]), relu_(acc[h][1])}; sc2[2 * st + 1] += wh[h] * (f32x2){relu_(acc[h][2]), relu_(acc[h][3])}; }
                    __builtin_amdgcn_sched_barrier(0);
                }
                float sc[16];
#pragma unroll
                for (int i = 0; i < 8; ++i) { sc[2 * i] = sc2[i][0]; sc[2 * i + 1] = sc2[i][1]; }
                __builtin_amdgcn_sched_barrier(0);
                const unsigned tp = taup[ql]; unsigned pm = 0u;
#pragma unroll
                for (int i = 0; i < 16; ++i) { const int key = kb + 16 * (i >> 2) + 4 * gq + (i & 3); const unsigned u = __float_as_uint(sc[i]);
                    const unsigned ord = (u & 0x80000000u) ? ~u : (u | 0x80000000u); const unsigned pk = (ord & 0xFFFFE000u) | (unsigned)key;
                    sc[i] = __uint_as_float(pk);
                    if (key < nadm && pk > tp) pm |= 1u << i; }
                if (sdry && (DSA_DRYMODE & 2)) pm = 0u;
                const unsigned n = (unsigned)__popc(pm);
                unsigned k = 0u; if (n) k = __hip_atomic_fetch_add(cnt + ql, n, __ATOMIC_RELAXED, __HIP_MEMORY_SCOPE_WORKGROUP);
                LAS unsigned* cq = cand + ql * DS_CAP;
#pragma unroll
                for (int i = 0; i < 16; ++i) if (pm & (1u << i)) { cq[k] = __float_as_uint(sc[i]); ++k; }
            }
            if (sdry && (DSA_DRYMODE & 8)) continue;
            __syncthreads();
            PROBE_END(2, a.ws, wave);
            const u32x4 c0 = *(const LAS u32x4*)(cnt), c1 = *(const LAS u32x4*)(cnt + 4), c2 = *(const LAS u32x4*)(cnt + 8), c3 = *(const LAS u32x4*)(cnt + 12);
            unsigned cm = max(max(max(c0.x, c0.y), max(c0.z, c0.w)), max(max(c1.x, c1.y), max(c1.z, c1.w)));
            cm = max(cm, max(max(max(c2.x, c2.y), max(c2.z, c2.w)), max(max(c3.x, c3.y), max(c3.z, c3.w))));
            const unsigned trig = (step == nstep) ? (unsigned)DS_TOPK : (unsigned)DS_TRIG;
#ifdef DSA_SEL2
            const int nsel = (step == nstep) ? 4 : 2;
#else
            const int nsel = 2;
#endif
            if (cm > trig) {
                PROBE_BEGIN(1, a.ws, wave);
#pragma unroll 1
                for (int qq = 0; qq < nsel; ++qq) { const int q = 2 * wave + (qq & 1); if (cnt[q] > trig || qq >= 2) {
                    if (step != nstep) filter_compact<32>(cand + q * DS_CAP, cnt + q, taup + q, lane);
                    if (step == nstep || cnt[q] > (unsigned)DS_TRIG) { const unsigned nq = (unsigned)__builtin_amdgcn_readfirstlane((int)cnt[q]);
                        if (nq <= 512u) select_compact<8>(cand + q * DS_CAP, cnt + q, taup + q, hist, lane);
                        else if (nq <= 768u) select_compact<12>(cand + q * DS_CAP, cnt + q, taup + q, hist, lane);
                        else if (nq <= 1024u) select_compact<16>(cand + q * DS_CAP, cnt + q, taup + q, hist, lane);
                        else if (nq <= 1536u) select_compact<24>(cand + q * DS_CAP, cnt + q, taup + q, hist, lane);
                        else select_compact<32>(cand + q * DS_CAP, cnt + q, taup + q, hist, lane); } } }
                __syncthreads();
                PROBE_END(1, a.ws, wave);
            }
        }
#ifdef DSA_REP_STREAM
        }
#endif
        const bf16_t* KVb = KVg + (size_t)mb * 256;
        int lane_a = lane; asm volatile("" : "+v"(lane_a));
        const int g16 = lane_a >> 4, l15 = lane_a & 15;
        const unsigned vbase = (unsigned)(size_t)(lds + DS_CAND_OFF) + (unsigned)wave * 16384u;
        unsigned ta0, ta1;
        { const int q = l15 >> 2, p = lane_a & 3; const int pr0 = 8 * g16 + q, pr1 = pr0 + 4;
          ta0 = vbase + vrow_off(pr0) + 16u * ((unsigned)(p >> 1) ^ swz_b(pr0)) + 8u * (unsigned)(p & 1);
          ta1 = vbase + vrow_off(pr1) + 16u * ((unsigned)(p >> 1) ^ swz_b(pr1)) + 8u * (unsigned)(p & 1); }
        const unsigned kwa = vbase + 10240u + (unsigned)(4 * g16) * 256u + (unsigned)((l15 ^ (4 * g16)) << 4);
        const unsigned kra = vbase + 10240u + (unsigned)l15 * 256u + (unsigned)((g16 ^ l15) << 4);
        const unsigned owa = vbase + 10240u + (unsigned)l15 * 256u + (unsigned)((g16 ^ l15) << 4);
        const unsigned ora = vbase + 10240u + (unsigned)(lane_a >> 3) * 256u + (unsigned)(((2 * (lane_a & 7)) ^ (lane_a >> 3)) << 4);
        unsigned vwa[8];
#pragma unroll
        for (int j2 = 0; j2 < 8; ++j2) { const int srow = 4 * j2 + g16; const int pr = (srow < 16) ? 8 * (srow >> 2) + (srow & 3) : 8 * ((srow - 16) >> 2) + 4 + (srow & 3);
            vwa[j2] = vbase + vrow_off(pr) + 16u * ((unsigned)l15 ^ swz_b(pr)); }
#ifdef DSA_REP_ATT
        for (int arep_ = 0; arep_ < 2; ++arep_) { const bool dry2 = dry || (arep_ == 0 && a.ph_hi > 0);
#else
        { const bool dry2 = dry;
#endif
        u32x4 qr[4];
#pragma unroll
        for (int i = 0; i < 4; ++i) qr[i] = *(const u32x4*)(Qg + ((mb + q0 + 2 * wave) * 2048u + (unsigned)(4 * g16 + i) * 128u + 8u * l15));
#pragma unroll 1
        for (int qq = 0; qq < 2; ++qq) {
            const int q = 2 * wave + qq; const unsigned m = mb + q0 + q; const int n = (int)cnt[q]; const LAS unsigned* cq = cand + q * DS_CAP;
            bf16x8 qb[4];
            {
#pragma unroll
              for (int i = 0; i < 4; ++i) *(LAS u32x4*)(size_t)(kwa ^ (unsigned)((i << 8) | (i << 4))) = qr[i];
              LDS_WAIT();
              if (qq == 0) {
#pragma unroll
                for (int i = 0; i < 4; ++i) qr[i] = *(const u32x4*)(Qg + ((m + 1u) * 2048u + (unsigned)(4 * g16 + i) * 128u + 8u * l15)); }
#pragma unroll
              for (int ks = 0; ks < 4; ++ks) qb[ks] = *(const LAS bf16x8*)(size_t)(kra ^ (unsigned)(ks << 6));
              LDS_WAIT(); }
            f32x4 sacc[16];
            const int nl = n - l15; const LAS unsigned* cql = cq + l15;
            u32x4 kr[5][4];
            auto kload = [&](int jt, u32x4 (&dst)[4]) { const u32x4 e4 = *(const LAS u32x4*)(cq + 16 * jt + 4 * g16);
#pragma unroll
                for (int i = 0; i < 4; ++i) dst[i] = *(const u32x4*)(KVb + ((e4[i] & 0x1FFFu) * 256u + 8u * l15)); };
            kload(0, kr[0]); kload(1, kr[1]); kload(2, kr[2]); kload(3, kr[3]);
#pragma unroll
            for (int i = 0; i < 4; ++i) *(LAS u32x4*)(size_t)(kwa ^ (unsigned)((i << 8) | (i << 4))) = kr[0][i];
#pragma unroll
            for (int jt = 0; jt < 16; ++jt) {
                if (jt + 4 < 16) kload(jt + 4, kr[(jt + 4) % 5]);
                bf16x8 fa[4];
#pragma unroll
                for (int ks = 0; ks < 4; ++ks) fa[ks] = *(const LAS bf16x8*)(size_t)(kra ^ (unsigned)(ks << 6));
                if (jt + 1 < 16) {
#pragma unroll
                    for (int i = 0; i < 4; ++i) *(LAS u32x4*)(size_t)(kwa ^ (unsigned)((i << 8) | (i << 4))) = kr[(jt + 1) % 5][i]; }
                f32x4 acc = (f32x4){0.f, 0.f, 0.f, 0.f};
#pragma unroll
                for (int ks = 0; ks < 4; ++ks) acc = __builtin_amdgcn_mfma_f32_16x16x32_bf16(fa[ks], qb[ks], acc, 0, 0, 0);
                sacc[jt] = acc;
            }
            u32x4 vr[2][8]; const int ng = n - g16; const LAS unsigned* cqg = cq + g16;
            auto vload = [&](int kk, u32x4 (&dst)[8]) {
#pragma unroll
                for (int j2 = 0; j2 < 8; ++j2) { const int sl = 32 * kk + 4 * j2; const unsigned e = cqg[sl]; const unsigned key = (sl < ng) ? (e & 0x1FFFu) : 0u;
                    dst[j2] = *(const u32x4*)(KVb + (key * 256u + 128u + 8u * l15)); } };
            vload(0, vr[0]); vload(1, vr[1]);
            __builtin_amdgcn_sched_barrier(0);
            float mx = -1e30f; const float nnf = (float)(n - 4 * g16 - 1);
#pragma unroll
            for (int jt = 0; jt < 16; ++jt)
#pragma unroll
                for (int r = 0; r < 4; ++r) { sacc[jt][r] = fmaf(fminf(nnf - (float)(16 * jt + r), 0.f), 1e30f, sacc[jt][r]); mx = fmaxf(mx, sacc[jt][r]); }
            mx = fmaxf(mx, __shfl_xor(mx, 16)); mx = fmaxf(mx, __shfl_xor(mx, 32));
            float sum = 0.f;
#pragma unroll
            for (int jt = 0; jt < 16; ++jt)
#pragma unroll
                for (int r = 0; r < 4; ++r) { const float p = __builtin_amdgcn_exp2f(sacc[jt][r] - mx); sacc[jt][r] = p; sum += p; }
            sum += __shfl_xor(sum, 16); sum += __shfl_xor(sum, 32);
            u32x4 pfr[8];
#pragma unroll
            for (int kk = 0; kk < 8; ++kk) { const f32x4 pa = sacc[2 * kk], pb2 = sacc[2 * kk + 1];
                pfr[kk].x = pk2(pa[0], pa[1]); pfr[kk].y = pk2(pa[2], pa[3]); pfr[kk].z = pk2(pb2[0], pb2[1]); pfr[kk].w = pk2(pb2[2], pb2[3]); }
            __builtin_amdgcn_sched_barrier(0);
            f32x4 o[8];
#pragma unroll
            for (int c = 0; c < 8; ++c) o[c] = (f32x4){0.f, 0.f, 0.f, 0.f};
            bf16_t* gqp = Gg + m * 2048u; u32x4 gwv[2][2];
#pragma unroll
            for (int p = 0; p < 2; ++p)
#pragma unroll
                for (int i = 0; i < 2; ++i) gwv[p][i] = *(const u32x4*)(gqp + ((8 * i + (lane_a >> 3)) * 128 + 64 * p + 8 * (lane_a & 7)));
#pragma unroll
            for (int kk = 0; kk < 8; ++kk) {
#pragma unroll
                for (int j2 = 0; j2 < 8; ++j2) *(LAS u32x4*)(size_t)vwa[j2] = vr[kk & 1][j2];
                __builtin_amdgcn_sched_barrier(0);
                if (kk + 2 < 8) vload(kk + 2, vr[kk & 1]);
                LDS_WAIT();
                const bf16x8 pfrag = __builtin_bit_cast(bf16x8, pfr[kk]);
#pragma unroll
                for (int ch = 0; ch < 2; ++ch) {
                    s16x4 t0[4], t1[4];
                    asm volatile("ds_read_b64_tr_b16 %0, %8\n\tds_read_b64_tr_b16 %1, %9\n\tds_read_b64_tr_b16 %2, %10\n\tds_read_b64_tr_b16 %3, %11\n\t"
                                 "ds_read_b64_tr_b16 %4, %12\n\tds_read_b64_tr_b16 %5, %13\n\tds_read_b64_tr_b16 %6, %14\n\tds_read_b64_tr_b16 %7, %15\n\ts_waitcnt lgkmcnt(0)"
                                 : "=&v"(t0[0]), "=&v"(t0[1]), "=&v"(t0[2]), "=&v"(t0[3]), "=&v"(t1[0]), "=&v"(t1[1]), "=&v"(t1[2]), "=&v"(t1[3])
                                 : "v"(ta0 ^ (unsigned)((4 * ch + 0) << 5)), "v"(ta0 ^ (unsigned)((4 * ch + 1) << 5)), "v"(ta0 ^ (unsigned)((4 * ch + 2) << 5)), "v"(ta0 ^ (unsigned)((4 * ch + 3) << 5)),
                                   "v"(ta1 ^ (unsigned)((4 * ch + 0) << 5)), "v"(ta1 ^ (unsigned)((4 * ch + 1) << 5)), "v"(ta1 ^ (unsigned)((4 * ch + 2) << 5)), "v"(ta1 ^ (unsigned)((4 * ch + 3) << 5)) : "memory");
                    __builtin_amdgcn_sched_barrier(0);
#pragma unroll
                    for (int c = 0; c < 4; ++c) { const bf16x8 av = __builtin_shufflevector(t0[c], t1[c], 0, 1, 2, 3, 4, 5, 6, 7);
                        o[4 * ch + c] = __builtin_amdgcn_mfma_f32_16x16x32_bf16(av, pfrag, o[4 * ch + c], 0, 0, 0); }
                }
            }
            const float inv = 1.0f / sum;
#pragma unroll
            for (int p = 0; p < 2; ++p) {
#pragma unroll
                for (int cc = 0; cc < 4; ++cc) *(LAS f32x4*)(size_t)(owa ^ (unsigned)(cc << 6)) = o[4 * p + cc] * inv;
                LDS_WAIT();
#pragma unroll
                for (int i = 0; i < 2; ++i) { bf16_t* gp = gqp + ((8 * i + (lane_a >> 3)) * 128 + 64 * p + 8 * (lane_a & 7)); const u32x4 gw = gwv[p][i];
                    const unsigned ra_ = (ora + 2048u * (unsigned)i) ^ (unsigned)(i << 7);
                    const f32x4 t0 = *(const LAS f32x4*)(size_t)ra_, t1 = *(const LAS f32x4*)(size_t)(ra_ ^ 16u);
                    u32x4 wv; wv.x = pk2(t0[0] * bflo(gw.x), t0[1] * bfhi(gw.x)); wv.y = pk2(t0[2] * bflo(gw.y), t0[3] * bfhi(gw.y));
                    wv.z = pk2(t1[0] * bflo(gw.z), t1[1] * bfhi(gw.z)); wv.w = pk2(t1[2] * bflo(gw.w), t1[3] * bfhi(gw.w));
                    if (!dry2) *(u32x4*)gp = wv; }
                LDS_WAIT();
            }
        }
        }
    }
}

#ifndef OLD_SCAN
#define OLD_SCAN 0
#endif
#ifndef MK_SPLIT
#define MK_SPLIT 0
#endif
#ifndef MK_PH_END
#define MK_PH_END 13
#endif
constexpr int N_PHASES = 13;

#define XB_TMO      128
#define XB_XCNT(j)  (256  + 64 * (j))
#define XB_XSUB(j)  (1280 + 64 * (j))
#define XB_XGEN(j)  (2304 + 64 * (j))
#define XB_TOP      3328
#define XB_TOPGEN   3392
#define XCD_BAR_WORDS 3456
#define XB_SPIN_CAP (1u << 18)

__device__ __forceinline__ unsigned xb_ld(unsigned* p)              { return __hip_atomic_load(p, __ATOMIC_RELAXED, __HIP_MEMORY_SCOPE_AGENT); }
__device__ __forceinline__ unsigned xb_add(unsigned* p, unsigned v) { return __hip_atomic_fetch_add(p, v, __ATOMIC_RELAXED, __HIP_MEMORY_SCOPE_AGENT); }
__device__ __forceinline__ unsigned xb_xcc_id() { return (unsigned)__builtin_amdgcn_s_getreg((3 << 11) | 20) & 0xFu; }
#define XB_SPIN(cond, bar) do { unsigned _sp = 0; while (cond) { __builtin_amdgcn_s_sleep(1); \
    if ((++_sp & 255u) == 0u) { if (xb_ld(&(bar)[XB_TMO])) break; if (_sp > XB_SPIN_CAP) { atomicAdd(&(bar)[XB_TMO], 1u); break; } } } } while (0)

struct XcdBarrier {
    unsigned* bar; unsigned x;
    volatile LAS unsigned* st;
};

__device__ __forceinline__ XcdBarrier xcd_barrier_post(unsigned* bar, volatile LAS unsigned* st, const int wave) {
    XcdBarrier b; b.bar = bar; b.x = xb_xcc_id(); b.st = st;
    if (lane_id() == 0 && wave == 0) (void)xb_add(&bar[XB_XCNT(b.x)], 1u);
    return b;
}
__device__ __forceinline__ void xcd_barrier_complete(unsigned* bar, unsigned x, unsigned& nloc, unsigned& nx) {
    const unsigned G = gridDim.x * gridDim.y * gridDim.z;
    unsigned sum, cnt, mine, sp = 0u;
    for (;;) {
        sum = 0u; cnt = 0u; mine = 0u;
#pragma unroll
        for (unsigned j = 0; j < 16; ++j) { const unsigned c = xb_ld(&bar[XB_XCNT(j)]); sum += c; cnt += (c > 0u) ? 1u : 0u; mine = (j == x) ? c : mine; }
        if (sum == G) break;
        __builtin_amdgcn_s_sleep(1);
        if ((++sp & 255u) == 0u) { if (xb_ld(&bar[XB_TMO])) break; if (sp > XB_SPIN_CAP) { atomicAdd(&bar[XB_TMO], 1u); break; } }
    }
    nloc = mine > 0u ? mine : 1u; nx = cnt > 0u ? cnt : 1u;
}

__device__ __forceinline__ void xcd_barrier(const XcdBarrier& b, const int wave) {
    asm volatile("s_waitcnt vmcnt(0)" ::: "memory");
    __syncthreads();
    if (wave == 0) { if (lane_id() == 0) {
        unsigned* bar = b.bar;
        __builtin_amdgcn_s_waitcnt(0);
        unsigned nloc = b.st[0], nx = b.st[1];
        if (nloc == 0u) { xcd_barrier_complete(bar, b.x, nloc, nx); b.st[0] = nloc; b.st[1] = nx; }
        const unsigned old = xb_add(&bar[XB_XSUB(b.x)], 1u);
        const unsigned gen = old / nloc;
        if (old + 1u == (gen + 1u) * nloc) {
            __builtin_amdgcn_fence(__ATOMIC_RELEASE, "agent");
            asm volatile("s_waitcnt vmcnt(0)" ::: "memory");
            const unsigned og = xb_add(&bar[XB_TOP], 1u);
            const unsigned tg = og / nx;
            if (og + 1u == (tg + 1u) * nx) xb_add(&bar[XB_TOPGEN], 1u);
            else XB_SPIN(xb_ld(&bar[XB_TOPGEN]) == tg, bar);
            __builtin_amdgcn_fence(__ATOMIC_ACQUIRE, "agent");
            xb_add(&bar[XB_XGEN(b.x)], 1u);
            asm volatile("s_waitcnt vmcnt(0)" ::: "memory");
        } else {
            XB_SPIN(xb_ld(&bar[XB_XGEN(b.x)]) == gen, bar);
            __builtin_amdgcn_fence(__ATOMIC_ACQUIRE, "agent");
            asm volatile("s_waitcnt vmcnt(0)" ::: "memory");
        }
    } }
    __syncthreads();
}

#define grid_bar(barptr, epoch, wv) xcd_barrier(xbar, (wv))
typedef const __attribute__((address_space(4))) Args* KArgs;
#if defined(__HIP_DEVICE_COMPILE__)
__device__ __forceinline__ Args kargs() { KArgs p = (KArgs)__builtin_amdgcn_kernarg_segment_ptr(); asm volatile("" : "+s"(p)); return *p; }
#else
__device__ __forceinline__ Args kargs() { return Args{}; }
#endif
#define PHASE_ARGS const Args a = kargs(); unsigned char* ws = a.ws; (void)ws

__global__ void __launch_bounds__(NTHREADS, 2) fwd_megakernel(Args a_by_value) {
    extern __shared__ __attribute__((aligned(16))) unsigned char lds_raw[];
    LAS unsigned char* lds = (LAS unsigned char*)lds_raw;
    cg::grid_group grid = cg::this_grid();
    const int wave = __builtin_amdgcn_readfirstlane((int)threadIdx.x >> 6);
    { volatile LAS unsigned* st0 = (volatile LAS unsigned*)(lds + LDS_BYTES - 16); if (wave == 0 && lane_id() < 4) st0[lane_id()] = 0u; __syncthreads(); }
    const XcdBarrier xbar = xcd_barrier_post((unsigned*)(kargs().ws + WS_BAR), (volatile LAS unsigned*)(lds + LDS_BYTES - 16), wave);
    int lo, hi; { const Args a0 = kargs(); lo = a0.ph_lo; hi = a0.ph_hi; }
#ifdef ONLY_PH
#define IN(k) ((k) == ONLY_PH && lo <= (k) && (k) < hi)
#else
#define IN(k) (lo <= (k) && (k) < hi)
#endif
#define SEAM(k) do { if (IN(k) && IN((k) + 1)) { if ((k) == 0) grid.sync(); else grid_bar((unsigned*)(kargs().ws + WS_BAR), (unsigned)(k), wave); } } while (0)
#ifdef REP_PH
#ifndef REP_N
#define REP_N 2
#endif
#define NREP(k) ((k) == REP_PH ? REP_N : 1)
#else
#define NREP(k) 1
#endif
#define REPEAT(k) for (int rep_ = 0; rep_ < NREP(k); ++rep_, (rep_ < NREP(k) ? grid_bar((unsigned*)(kargs().ws + WS_BAR) + 128, 1u, wave) : (void)0))
#ifdef STAMP_K
#define TSTAMP(k) do { if (((k) == STAMP_K || (k) == STAMP_K + 1) && blockIdx.x == 0 && wave == 0) { const unsigned long long t_ = __builtin_amdgcn_s_memrealtime(); \
        if (__builtin_amdgcn_mbcnt_lo(~0u, 0u) == 0u) ((unsigned long long*)(kargs().ws + WS_STAMP))[(k) - STAMP_K] = t_; } } while (0)
#else
#define TSTAMP(k) do { } while (0)
#endif
#ifdef STAMP_K
    if (blockIdx.x == PROBE_BLK && wave == 0) { unsigned long long* st_ = (unsigned long long*)(kargs().ws + WS_STAMP); if (__builtin_amdgcn_mbcnt_lo(~0u, 0u) < 3u) st_[__builtin_amdgcn_mbcnt_lo(~0u, 0u)] = 0ull; }
#endif
    TSTAMP(0);
    if (IN(0)) REPEAT(0) { PHASE_ARGS; p0_prologue(a, wave, lds); } SEAM(0); TSTAMP(1);
    if (IN(1)) REPEAT(1) { PHASE_ARGS; norm_phase(a, wave, lds, a.x, 0); } SEAM(1); TSTAMP(2);
    if (IN(2)) REPEAT(2) { PHASE_ARGS;
        pg8::Gemm g{(const bf16_t*)(ws + WS_H), (const bf16_t*)(ws + WS_WIN0), MTOK, N0, DM}; pg8::StaticOrder S; S.init(MTOK, N0, gridDim.x, blockIdx.x);
        #ifdef EPI0_CHEAP_FIRST
        Epi0 E{ws, (unsigned char*)a.out, NREP(2) == 2 && rep_ == 0 && a.ph_hi > 0, lds + pg8::STAGE_BYTES};
#else
        Epi0 E{ws, (unsigned char*)a.out, false, lds + pg8::STAGE_BYTES};
#endif
#ifdef SKEW0
        if (blockIdx.x >= 128) { const unsigned long long t0_ = __builtin_amdgcn_s_memrealtime(); while (__builtin_amdgcn_s_memrealtime() - t0_ < (unsigned long long)(SKEW0)) __builtin_amdgcn_s_sleep(64); }
#endif
        pg8::gemm_phase<Epi0, pg8::StaticOrder, true, true>(lds, g, S, E, wave);
    } SEAM(2); TSTAMP(3);
    if (IN(3)) REPEAT(3) { PHASE_ARGS; conv_phase(a, wave, lds, blockIdx.x, gridDim.x); lora_pre_phase(a, wave); } SEAM(3); TSTAMP(4);
    if (IN(4)) REPEAT(4) { PHASE_ARGS;
        pg8::Gemm g{(const bf16_t*)((unsigned char*)a.out + DO_LA), (const bf16_t*)(ws + WS_WLORA), MTOK, 2048, 256}; pg8::StaticOrder S; S.init(MTOK, 2048, gridDim.x, blockIdx.x);
        EpiLora E{(bf16_t*)(ws + WS_DARR), (bf16_t*)(ws + WS_AARR), a.rwkv_vec, lds + pg8::STAGE_BYTES};
        pg8::gemm_phase<EpiLora, pg8::StaticOrder, true, true>(lds, g, S, E, wave);
    } SEAM(4); TSTAMP(5);
    if (IN(5)) REPEAT(5) { PHASE_ARGS;
#if OLD_SCAN
        scan_phase(a, wave, lds);
#else
        unsigned* pbar = (unsigned*)(ws + WS_BAR) + 256;
        { __syncthreads(); if (wave == 0 && lane_id() < 8) ((LAS unsigned*)(lds + CS_FLAGS))[lane_id()] = 0u; __syncthreads(); }
        for (int r = 0; r <= CR_NP; ++r) {
            if (blockIdx.x >= 64) { if (r < CR_NP) cscan_produce(a, wave, lds, r, 64, gridDim.x - 64); }
            else if (r >= 1) {
                const int piece = r - 1;
                f32x4 xc[4]; f32x4* sv = (f32x4*)(ws + WS_XSAVE) + ((size_t)(blockIdx.x * 4 + (wave & 3)) * 64 + lane_id()) * 4;
#pragma unroll
                for (int kt = 0; kt < 4; ++kt) xc[kt] = (piece == 0 || wave >= 4) ? (f32x4){0.f, 0.f, 0.f, 0.f} : sv[kt];
                cscan_consume(a, wave, lds, blockIdx.x, piece, xc);
                if (wave < 4) {
#pragma unroll
                    for (int kt = 0; kt < 4; ++kt) sv[kt] = xc[kt]; }
            }
            grid_bar(pbar, (unsigned)(r + 1), wave);
#ifdef BAR2
            grid_bar(pbar + 128, (unsigned)(r + 1), wave);
#endif
        }
#endif
    } SEAM(5); TSTAMP(6);
    if (IN(6)) REPEAT(6) { PHASE_ARGS; post_phase(a, wave); } SEAM(6); TSTAMP(7);
    if (IN(7)) REPEAT(7) { PHASE_ARGS;
        pg8::Gemm g{(const bf16_t*)(ws + WS_YAB), (const bf16_t*)(ws + WS_WOUT0), MTOK, DM, 2048}; pg8::StaticOrder S; S.init(MTOK, DM, gridDim.x, blockIdx.x);
        EpiRes E{a.x, a.out, (const float*)(ws + WS_MODP), a.ada_b, 0, NREP(7) >= 2 && rep_ == 0 && a.ph_hi > 0, lds + pg8::STAGE_BYTES};
        pg8::gemm_phase<EpiRes, pg8::StaticOrder, true, true>(lds, g, S, E, wave);
    } SEAM(7); TSTAMP(8);
    if (IN(8)) REPEAT(8) { PHASE_ARGS; norm_phase(a, wave, lds, a.out, 1); } SEAM(8); TSTAMP(9);
    if (IN(9)) REPEAT(9) { PHASE_ARGS;
        pg8::Gemm g{(const bf16_t*)(ws + WS_H), (const bf16_t*)(ws + WS_WIN1), MTOK, N1, DM}; pg8::StaticOrder S; S.init(MTOK, N1, gridDim.x, blockIdx.x);
        Epi1 E{(bf16_t*)(ws + WS_Q), (bf16_t*)(ws + WS_KV), (bf16_t*)(ws + WS_QI), (bf16_t*)(ws + WS_KI), (bf16_t*)(ws + WS_G), (float*)(ws + WS_WI), (const f32x2*)(ws + WS_CSA), (const f32x2*)(ws + WS_CSI), lds + pg8::STAGE_BYTES};
        pg8::gemm_phase<Epi1, pg8::StaticOrder, true, true>(lds, g, S, E, wave);
    } SEAM(9); TSTAMP(10);
    if (IN(10)) REPEAT(10) { PHASE_ARGS; dsa_phase(a, wave, lds, NREP(10) == 2 && rep_ == 0 && a.ph_hi > 0); } SEAM(10); TSTAMP(11);
    if (IN(11)) REPEAT(11) { PHASE_ARGS;
        pg8::Gemm g{(const bf16_t*)(ws + WS_G), (const bf16_t*)(ws + WS_WOUT1), MTOK, DM, 2048}; pg8::StaticOrder S; S.init(MTOK, DM, gridDim.x, blockIdx.x);
        EpiRes E{a.out, a.out, (const float*)(ws + WS_MODP), a.ada_b, 1, false, lds + pg8::STAGE_BYTES};
        pg8::gemm_phase<EpiRes, pg8::StaticOrder, true, true>(lds, g, S, E, wave);
    } SEAM(11); TSTAMP(12);
    if (IN(12)) REPEAT(12) { PHASE_ARGS; final_phase(a, wave); }
#undef IN
#undef SEAM
}

extern "C" void kernel_launch(void* const* d_in, const int* in_sizes, int n_in, void* d_out, int out_size, void* d_ws, size_t ws_size, hipStream_t stream) {
    static int grid = 0;
    if (grid == 0) {
        if (n_in != 19 || out_size != MTOK * DM || ws_size < WS_NEED) { fprintf(stderr, "kernel_launch: unexpected shapes (n_in %d, out %d, ws %zu)\n", n_in, out_size, ws_size); grid = -1; return; }
        int dev = 0, cus = 0, per_cu = 0;
        (void)hipGetDevice(&dev); (void)hipDeviceGetAttribute(&cus, hipDeviceAttributeMultiprocessorCount, dev);
        if (hipFuncSetAttribute((const void*)fwd_megakernel, hipFuncAttributeMaxDynamicSharedMemorySize, LDS_BYTES) != hipSuccess) { fprintf(stderr, "kernel_launch: hipFuncSetAttribute failed\n"); grid = -1; return; }
        if (hipOccupancyMaxActiveBlocksPerMultiprocessor(&per_cu, (const void*)fwd_megakernel, NTHREADS, LDS_BYTES) != hipSuccess || per_cu < 1) { fprintf(stderr, "kernel_launch: occupancy query says %d\n", per_cu); per_cu = 1; }
        (void)hipGetLastError();
        grid = cus;
        if (grid > 256) grid = 256;
    }
    if (grid < 0) return;
    Args a{};
    a.x = (const float*)d_in[0]; a.c = (const float*)d_in[1]; a.pos = (const int*)d_in[2]; a.ada_w = (const float*)d_in[3]; a.ada_b = (const float*)d_in[4];
    a.norm_g = (const float*)d_in[5]; a.final_g = (const float*)d_in[6]; a.even_w_in = (const float*)d_in[7]; a.even_w_out = (const float*)d_in[8];
    a.conv_w = (const float*)d_in[9]; a.conv_vec = (const float*)d_in[10]; a.mu_rkv = (const float*)d_in[11]; a.mu_lora = (const float*)d_in[12];
    a.rwkv_vec = (const float*)d_in[13]; a.w_up = (const float*)d_in[14]; a.a_up = (const float*)d_in[15]; a.r_k = (const float*)d_in[16];
    a.odd_w_in = (const float*)d_in[17]; a.odd_w_out = (const float*)d_in[18];
    a.out = (float*)d_out; a.ws = (unsigned char*)d_ws;
    (void)hipMemsetAsync((char*)d_ws + WS_BAR, 0, 65536, stream);
#if MK_SPLIT
    for (int p = 0; p < MK_PH_END; ++p) { a.ph_lo = p; a.ph_hi = p + 1; void* args[] = {&a};
        hipError_t e = hipLaunchCooperativeKernel((const void*)fwd_megakernel, dim3(grid), dim3(NTHREADS), args, LDS_BYTES, stream);
        if (e != hipSuccess) { fprintf(stderr, "launch %d failed: %s\n", p, hipGetErrorString(e)); break; } }
#else
    a.ph_lo = 0; a.ph_hi = MK_PH_END; void* args[] = {&a};
    hipError_t e = hipLaunchCooperativeKernel((const void*)fwd_megakernel, dim3(grid), dim3(NTHREADS), args, LDS_BYTES, stream);
    if (e != hipSuccess) fprintf(stderr, "cooperative launch failed: %s (grid %d)\n", hipGetErrorString(e), grid);
#endif
}
```

```cpp
#include <hip/hip_runtime.h>
#include <hip/hip_cooperative_groups.h>
#include <cstdio>
#include <cstdint>
namespace cg = cooperative_groups;

#define LAS __attribute__((address_space(3)))
typedef unsigned short bf16_t;
typedef float f32x4 __attribute__((ext_vector_type(4)));
typedef float f32x2 __attribute__((ext_vector_type(2)));
typedef float f32x16 __attribute__((ext_vector_type(16)));
typedef unsigned u32x4 __attribute__((ext_vector_type(4)));
typedef unsigned u32x2 __attribute__((ext_vector_type(2)));
typedef short bf16x8 __attribute__((ext_vector_type(8)));
typedef short s16x4 __attribute__((ext_vector_type(4)));

constexpr int BATCH = 4, SEQ = 8192, DM = 1024, MTOK = BATCH * SEQ;
constexpr int N0 = 7424, N1 = 5120;
constexpr int EVEN_COLS = 7296, ODD_COLS = 4936;
constexpr int NWAVES = 8, NTHREADS = 512;
constexpr int LDS_BYTES = 155648;

constexpr size_t MiB = 1u << 20;
constexpr size_t WS_MODP = 0; constexpr size_t WS_STAMP = 3 * MiB; constexpr size_t WS_XSAVE = 1 * MiB;
constexpr size_t WS_BAR = 3 * MiB + 512 * 1024;
constexpr size_t WS_WIN0 = 4 * MiB, WS_WOUT0 = 20 * MiB, WS_WIN1 = 24 * MiB, WS_WOUT1 = 34 * MiB, WS_WLORA = 38 * MiB;
constexpr size_t WS_CSA = 40 * MiB, WS_CSI = 56 * MiB;
constexpr size_t WS_H = 64 * MiB;
constexpr size_t WS_YAB = 64 * MiB;
constexpr size_t WS_U = 192 * MiB, WS_AG = 256 * MiB, WS_R = 320 * MiB, WS_K = 384 * MiB, WS_V = 448 * MiB;
constexpr size_t WS_AARR = WS_U, WS_DARR = WS_AG;
constexpr size_t WS_Q = 128 * MiB, WS_G = 256 * MiB, WS_KV = 384 * MiB, WS_QI = 400 * MiB, WS_KI = 432 * MiB, WS_WI = 436 * MiB;
constexpr size_t WS_NEED = 512 * MiB;
constexpr size_t DO_BG = 0, DO_WDAD = 64 * MiB, DO_LA = 72 * MiB, DO_RK = 64 * MiB;

__device__ __forceinline__ float bflo(unsigned w) { return __uint_as_float(w << 16); }
__device__ __forceinline__ float bfhi(unsigned w) { return __uint_as_float(w & 0xffff0000u); }
typedef __bf16 bf16x2_t __attribute__((ext_vector_type(2)));
__device__ __forceinline__ unsigned pk2(float lo, float hi) { const f32x2 v = {lo, hi}; const bf16x2_t b = __builtin_convertvector(v, bf16x2_t); return __builtin_bit_cast(unsigned, b); }
__device__ __forceinline__ float sigmoidf_(float x) { return __builtin_amdgcn_rcpf(1.0f + __expf(-x)); }
__device__ __forceinline__ float wave_sum(float v) {
#pragma unroll
    for (int o = 1; o < 64; o <<= 1) v += __shfl_xor(v, o);
    return v;
}
template <int CTRL> __device__ __forceinline__ float dppmov(float x) { return __int_as_float(__builtin_amdgcn_update_dpp(0, __float_as_int(x), CTRL, 0xf, 0xf, true)); }
__device__ __forceinline__ float quad_sum(float x) { x += dppmov<0xB1>(x); x += dppmov<0x4E>(x); return x; }
__device__ __forceinline__ float row16_sum(float x) { x += dppmov<0xB1>(x); x += dppmov<0x4E>(x); x += dppmov<0x141>(x); x += dppmov<0x140>(x); return x; }
__device__ __forceinline__ int lane_id() { int l; asm volatile("v_mbcnt_lo_u32_b32 %0, -1, 0\n\tv_mbcnt_hi_u32_b32 %0, -1, %0" : "=v"(l)); return l; }
#define LDS_WAIT() asm volatile("s_waitcnt lgkmcnt(0)" ::: "memory")

__device__ __forceinline__ int map0(int n) {
    const int t = n >> 8, r = n & 255;
    if (t < 8) return (r < 128) ? 128 * t + r : 1024 + 128 * t + (r - 128);
    if (t < 12) return 2048 + 256 * (t - 8) + r;
    if (t < 24) return 3072 + 256 * (t - 12) + r;
    if (t < 28) return 6272 + 256 * (t - 24) + r;
    return (r < 128) ? 6144 + r : -1;
}
__device__ __forceinline__ int map1(int n) {
    const int t = n >> 8, r = n & 255, half = r >> 7, rr = r & 127;
    if (t < 8) return (2 * t + (rr >> 6)) * 128 + half * 64 + (rr & 63);
    if (t == 8) return 2048 + (rr >> 6) * 128 + half * 64 + (rr & 63);
    if (t < 11) return 2304 + (4 * (t - 9) + (rr >> 5)) * 64 + half * 32 + (rr & 31);
    if (t == 11) { if (rr < 32) return 2816 + half * 32 + rr; if (half == 0 && rr < 40) return 2880 + (rr - 32); return -1; }
    return 2888 + 256 * (t - 12) + r;
}

#ifndef PROBE_BLK
#define PROBE_BLK 0
#endif
#ifndef PROBE_WAVE
#define PROBE_WAVE 0
#endif
#if defined(STAMP_K) && defined(PROBE_SEC)
#define PROBE_BEGIN(sec, wsp, wv) unsigned long long PT0_##sec = 0; if ((sec) == PROBE_SEC && blockIdx.x == PROBE_BLK && (wv) == PROBE_WAVE) PT0_##sec = __builtin_amdgcn_s_memrealtime()
#define PROBE_END(sec, wsp, wv) do { if ((sec) == PROBE_SEC && blockIdx.x == PROBE_BLK && (wv) == PROBE_WAVE) { const unsigned long long dt_ = __builtin_amdgcn_s_memrealtime() - PT0_##sec; \
        if (__builtin_amdgcn_mbcnt_lo(~0u, 0u) == 0u) __hip_atomic_fetch_add((unsigned long long*)((wsp) + WS_STAMP) + 2, dt_, __ATOMIC_RELAXED, __HIP_MEMORY_SCOPE_AGENT); } } while (0)
#else
#define PROBE_BEGIN(sec, wsp, wv) do { } while (0)
#define PROBE_END(sec, wsp, wv) do { } while (0)
#endif
namespace pg8 {
#define PG8_LAS __attribute__((address_space(3)))
typedef unsigned short bf16_t;
typedef short bf16x8 __attribute__((ext_vector_type(8)));
typedef float f32x4 __attribute__((ext_vector_type(4)));
typedef unsigned u32x4 __attribute__((ext_vector_type(4)));
constexpr int BM = 256, BK = 64, HALF = 128, HTB = HALF * BK * 2  , STAGE_BYTES = 8 * HTB, NXCD = 8, WGM = 8;

__host__ __device__ __forceinline__ int lds_byte(int r, int c) { const int st = (r >> 4) * 2 + (c >> 5), rr = r & 15, cc = c & 31, ob = rr * 64 + cc * 2; return st * 1024 + (ob ^ (((ob >> 9) & 1) << 5)); }
__host__ __device__ __forceinline__ void stage_rc(int b, int& R, int& C) { const int st = b / 1024, sb = b % 1024, swz = sb ^ (((sb >> 9) & 1) << 5); R = (st >> 1) * 16 + swz / 64; C = (st & 1) * 32 + (swz % 64) / 2; }
__host__ __device__ __forceinline__ int perm32(int rho) { const int n = rho >> 4, i = rho & 15; return 8 * (i >> 2) + 4 * n + (i & 3); }

struct Unit { int pm, pn; };
struct Gemm { const bf16_t* A; const bf16_t* Bt; int M, N, K; };

struct StaticOrder {
    int nM, nN, nwg, G, c;
    __host__ __device__ void init(int M, int N, int G_, int c_) { nM = M / BM; nN = N / BM; nwg = nM * nN; G = G_; c = c_; }
    __host__ __device__ bool next(int i, Unit& u) const {
        const long L = (long)i * G + c; if (L >= nwg) return false;
        int wgid = (int)L; { const int q = nwg / NXCD, r = nwg % NXCD, xcd = wgid % NXCD, off = wgid / NXCD; wgid = (xcd < r ? xcd * (q + 1) : r * (q + 1) + (xcd - r) * q) + off; }
        const int nig = WGM * nN, gid = wgid / nig, fm = gid * WGM, gsz = (nM - fm) < WGM ? (nM - fm) : WGM;
        u.pm = fm + ((wgid % nig) % gsz); u.pn = (wgid % nig) / gsz; return true;
    }
    __device__ __forceinline__ void a_ready(const Unit&) const {}
    __device__ __forceinline__ void done(const Unit&) const {}
};

__device__ __forceinline__ unsigned cvt_pk_bf16(float lo, float hi) { unsigned r; asm volatile("v_cvt_pk_bf16_f32 %0, %1, %2" : "=v"(r) : "v"(lo), "v"(hi)); return r; }
typedef float f32x2 __attribute__((ext_vector_type(2)));
template <class Epi, class Sched, bool ALIGN_EPI = false, bool SP2 = false>
__device__ __forceinline__ void gemm_phase(PG8_LAS unsigned char* lds, const Gemm g, const Sched& S, const Epi& E, const int wave_in) {
    int lane; asm volatile("v_mbcnt_lo_u32_b32 %0, -1, 0\n\tv_mbcnt_hi_u32_b32 %0, -1, %0" : "=v"(lane));
    const int wid = wave_in, tid = wid * 64 + lane, wr = wid >> 2, wc = wid & 3, fr = lane & 15, fq = lane >> 4;
    const int K = g.K, nt = K / BK;
    unsigned voffA[2], voffB[2];
#pragma unroll
    for (int i = 0; i < 2; ++i) { int R, C; stage_rc(tid * 16 + i * 8192, R, C); const int Rb = Epi::PERM ? ((R & ~31) + perm32(R & 31)) : R;
        voffA[i] = (unsigned)(R * K + C) * 2u; voffB[i] = (unsigned)(Rb * K + C) * 2u; }
    const size_t kstep = (size_t)(BK * 2);
    const size_t hstep = (size_t)HALF * K * 2;
    const size_t tstep = 2 * hstep;
    const unsigned ldsw = (unsigned)wid * 1024u;
    const int aoff = lds_byte(wr * 64 + fr, fq * 8), boff = lds_byte(wc * 32 + fr, fq * 8);
#define PG8_SA(b, h) (((b) * 2 + (h)) * HTB)
#define PG8_SB(b, h) ((4 + (b) * 2 + (h)) * HTB)
#define PG8_STAGE(bufoff, gbase, voff) do { _Pragma("unroll") for (int _i = 0; _i < 2; ++_i) \
        __builtin_amdgcn_global_load_lds((const unsigned*)((const char*)(gbase) + (voff)[_i]), (PG8_LAS unsigned*)(lds + (bufoff) + ldsw + _i * 8192), 16, 0, 0); } while (0)
#define PG8_LDA(dst, b, h) do { _Pragma("unroll") for (int m = 0; m < 4; ++m) _Pragma("unroll") for (int k = 0; k < 2; ++k) dst[m][k] = *(const PG8_LAS bf16x8*)(lds + PG8_SA(b, h) + aoff + m * 2048 + k * 1024); } while (0)
#define PG8_LDB(dst, b, h) do { _Pragma("unroll") for (int n = 0; n < 2; ++n) _Pragma("unroll") for (int k = 0; k < 2; ++k) dst[n][k] = *(const PG8_LAS bf16x8*)(lds + PG8_SB(b, h) + boff + n * 2048 + k * 1024); } while (0)
#define PG8_MMA(ai, bj, At, Bt) do { __builtin_amdgcn_s_setprio(1); _Pragma("unroll") for (int m = 0; m < 4; ++m) _Pragma("unroll") for (int n = 0; n < 2; ++n) _Pragma("unroll") for (int k = 0; k < 2; ++k) \
        acc[ai][bj][m][n] = __builtin_amdgcn_mfma_f32_16x16x32_bf16(Bt[n][k], At[m][k], acc[ai][bj][m][n], 0, 0, 0); __builtin_amdgcn_s_setprio(0); } while (0)
#define PG8_WAIT_V(n) asm volatile("s_waitcnt vmcnt(" #n ")" ::: "memory")
#define PG8_WAIT_L(n) asm volatile("s_waitcnt lgkmcnt(" #n ")" ::: "memory")
#define PG8_BAR __builtin_amdgcn_s_barrier()
#define PG8_SCHED __builtin_amdgcn_sched_barrier(0)
    Unit cur, nxt; int ui = 0;
    if (!S.next(0, cur)) return;
    f32x4 acc[2][2][4][2];
#pragma unroll
    for (int a = 0; a < 2; ++a)
#pragma unroll
        for (int b = 0; b < 2; ++b)
#pragma unroll
            for (int m = 0; m < 4; ++m)
#pragma unroll
                for (int n = 0; n < 2; ++n) acc[a][b][m][n] = (f32x4){0.f, 0.f, 0.f, 0.f};
    bf16x8 At[4][2], B0[2][2], B1[2][2];
    const char* cA = (const char*)g.A + (size_t)cur.pm * tstep; const char* cB = (const char*)g.Bt + (size_t)cur.pn * tstep;
    S.a_ready(cur);
    if constexpr (SP2) {
        PG8_STAGE(PG8_SB(0, 0), cB, voffB); PG8_STAGE(PG8_SB(0, 1), cB + hstep, voffB); PG8_STAGE(PG8_SA(0, 0), cA, voffA); PG8_STAGE(PG8_SA(0, 1), cA + hstep, voffA);
        if (wr == 1) PG8_BAR;
        PG8_WAIT_V(2); PG8_BAR;
        PG8_STAGE(PG8_SB(1, 0), cB + kstep, voffB); PG8_STAGE(PG8_SA(1, 0), cA + kstep, voffA); PG8_STAGE(PG8_SB(1, 1), cB + hstep + kstep, voffB);
        PG8_WAIT_V(6); PG8_BAR;
    } else {
        PG8_STAGE(PG8_SB(0, 0), cB, voffB); PG8_STAGE(PG8_SA(0, 0), cA, voffA); PG8_STAGE(PG8_SB(0, 1), cB + hstep, voffB); PG8_STAGE(PG8_SA(0, 1), cA + hstep, voffA);
        if (wr == 1) PG8_BAR;
        PG8_WAIT_V(4); PG8_BAR;
        PG8_STAGE(PG8_SB(1, 0), cB + kstep, voffB); PG8_STAGE(PG8_SA(1, 0), cA + kstep, voffA); PG8_STAGE(PG8_SB(1, 1), cB + hstep + kstep, voffB);
        PG8_WAIT_V(6); PG8_BAR;
    }
    for (;;) {
        const bool has_next = S.next(ui + 1, nxt);
        const char* nA = has_next ? (const char*)g.A + (size_t)nxt.pm * tstep : cA; const char* nB = has_next ? (const char*)g.Bt + (size_t)nxt.pn * tstep : cB;
        for (int t = 0; t < nt; t += 2) {
            const bool last = (t == nt - 2);
            const char* a1 = cA + (size_t)(t + 1) * kstep;
            const char* a2 = last ? nA : cA + (size_t)(t + 2) * kstep; const char* b2 = last ? nB : cB + (size_t)(t + 2) * kstep;
            const char* a3 = a2 + kstep; const char* b3 = b2 + kstep;
            if (last && has_next) S.a_ready(nxt);
            if constexpr (SP2) {
            PG8_LDB(B0, 0, 0); PG8_LDB(B1, 0, 1); PG8_SCHED; PG8_LDA(At, 0, 0); PG8_STAGE(PG8_SA(1, 1), a1 + hstep, voffA);
            PG8_WAIT_V(8); PG8_WAIT_L(0); PG8_BAR; PG8_MMA(0, 0, At, B0); PG8_MMA(0, 1, At, B1); PG8_BAR; PG8_SCHED;
            PG8_LDA(At, 0, 1); PG8_STAGE(PG8_SB(0, 0), b2, voffB); PG8_STAGE(PG8_SB(0, 1), b2 + hstep, voffB); PG8_STAGE(PG8_SA(0, 0), a2, voffA);
            PG8_WAIT_V(8); PG8_WAIT_L(0); PG8_BAR; PG8_MMA(1, 0, At, B0); PG8_MMA(1, 1, At, B1); PG8_BAR; PG8_SCHED;
            PG8_LDB(B0, 1, 0); PG8_LDB(B1, 1, 1); PG8_SCHED; PG8_LDA(At, 1, 0); PG8_STAGE(PG8_SA(0, 1), a2 + hstep, voffA);
            PG8_WAIT_V(8); PG8_WAIT_L(0); PG8_BAR; PG8_MMA(0, 0, At, B0); PG8_MMA(0, 1, At, B1); PG8_BAR; PG8_SCHED;
            PG8_LDA(At, 1, 1); PG8_STAGE(PG8_SB(1, 0), b3, voffB); PG8_STAGE(PG8_SB(1, 1), b3 + hstep, voffB); PG8_STAGE(PG8_SA(1, 0), a3, voffA);
            PG8_WAIT_V(8); PG8_WAIT_L(0); PG8_BAR; PG8_MMA(1, 0, At, B0); PG8_MMA(1, 1, At, B1); PG8_BAR; PG8_SCHED;
            } else {
            PG8_LDB(B0, 0, 0); PG8_SCHED; PG8_LDA(At, 0, 0); PG8_STAGE(PG8_SA(1, 1), a1 + hstep, voffA);
            PG8_WAIT_L(8); PG8_BAR; PG8_WAIT_L(0); PG8_MMA(0, 0, At, B0); PG8_BAR; PG8_SCHED;
            PG8_LDB(B1, 0, 1); PG8_STAGE(PG8_SB(0, 0), b2, voffB);
            PG8_BAR; PG8_WAIT_L(0); PG8_MMA(0, 1, At, B1); PG8_BAR;
            PG8_LDA(At, 0, 1); PG8_STAGE(PG8_SA(0, 0), a2, voffA);
            PG8_BAR; PG8_WAIT_L(0); PG8_MMA(1, 0, At, B0); PG8_BAR; PG8_SCHED;
            PG8_STAGE(PG8_SB(0, 1), b2 + hstep, voffB);
            PG8_WAIT_V(6); PG8_BAR; PG8_MMA(1, 1, At, B1); PG8_BAR;
            PG8_LDB(B0, 1, 0); PG8_SCHED; PG8_LDA(At, 1, 0); PG8_STAGE(PG8_SA(0, 1), a2 + hstep, voffA);
            PG8_WAIT_L(8); PG8_BAR; PG8_WAIT_L(0); PG8_MMA(0, 0, At, B0); PG8_BAR; PG8_SCHED;
            PG8_LDB(B1, 1, 1); PG8_STAGE(PG8_SB(1, 0), b3, voffB);
            PG8_BAR; PG8_WAIT_L(0); PG8_MMA(0, 1, At, B1); PG8_BAR;
            PG8_LDA(At, 1, 1); PG8_STAGE(PG8_SA(1, 0), a3, voffA);
            PG8_BAR; PG8_WAIT_L(0); PG8_MMA(1, 0, At, B0); PG8_BAR; PG8_SCHED;
            PG8_STAGE(PG8_SB(1, 1), b3 + hstep, voffB);
            PG8_WAIT_V(6); PG8_BAR; PG8_MMA(1, 1, At, B1); PG8_BAR;
            }
        }
        if constexpr (ALIGN_EPI) { if (wr == 0) PG8_BAR; }
        if constexpr (!Epi::AFTER_DRAIN) { E(acc, cur, wr, wc, fr, fq); S.done(cur); }
        if (!has_next) break;
#pragma unroll
        for (int a = 0; a < 2; ++a)
#pragma unroll
            for (int b = 0; b < 2; ++b)
#pragma unroll
                for (int m = 0; m < 4; ++m)
#pragma unroll
                    for (int n = 0; n < 2; ++n) acc[a][b][m][n] = (f32x4){0.f, 0.f, 0.f, 0.f};
        cur = nxt; cA = nA; cB = nB; ++ui;
        if constexpr (ALIGN_EPI) { if (wr == 1) PG8_BAR; }
    }
    PG8_WAIT_V(0);
    if constexpr (!ALIGN_EPI) { if (wr == 0) PG8_BAR; }
    PG8_BAR;
    if constexpr (Epi::AFTER_DRAIN) { E.fused(acc, cur, wr, wc, fr, fq, lds, wid, lane); S.done(cur); }
#undef PG8_SA
#undef PG8_SB
#undef PG8_STAGE
#undef PG8_LDA
#undef PG8_LDB
#undef PG8_MMA
#undef PG8_WAIT_V
#undef PG8_WAIT_L
#undef PG8_BAR
#undef PG8_SCHED
}
}

__device__ __forceinline__ u32x4 pack8(const f32x4 a, const f32x4 b) { u32x4 w; w.x = pk2(a[0], a[1]); w.y = pk2(a[2], a[3]); w.z = pk2(b[0], b[1]); w.w = pk2(b[2], b[3]); return w; }
__device__ __forceinline__ f32x4 silu4(const f32x4 v) { f32x4 o; o[0] = v[0] * sigmoidf_(v[0]); o[1] = v[1] * sigmoidf_(v[1]); o[2] = v[2] * sigmoidf_(v[2]); o[3] = v[3] * sigmoidf_(v[3]); return o; }
__device__ __forceinline__ f32x4 sig4(const f32x4 v) { f32x4 o; o[0] = sigmoidf_(v[0]); o[1] = sigmoidf_(v[1]); o[2] = sigmoidf_(v[2]); o[3] = sigmoidf_(v[3]); return o; }

struct RowSt {
    unsigned wa, ra; int rq, cq;
    __device__ __forceinline__ RowSt(LAS unsigned char* spare, int wr, int wc, int fr, int fq) {
        int lane = fr + 16 * fq; asm volatile("" : "+v"(lane));
        const int fr_ = lane & 15, fq_ = lane >> 4; const unsigned tile = (unsigned)(size_t)spare + (unsigned)(wr * 4 + wc) * 2048u;
        wa = tile + (unsigned)fr_ * 64u + (unsigned)((fq_ ^ ((fr_ >> 2) & 3)) << 4); ra = tile + (unsigned)lane * 16u; rq = lane >> 2; cq = 8 * ((lane & 3) ^ (lane >> 4)); }
    __device__ __forceinline__ void store(bf16_t* P, size_t row16, int stride, int col, const u32x4 v, int buf) const {
        *(LAS u32x4*)(size_t)(wa + 1024u * (unsigned)buf) = v; const u32x4 t = *(const LAS u32x4*)(size_t)(ra + 1024u * (unsigned)buf);
        *(u32x4*)(P + (row16 + (size_t)rq) * (size_t)stride + col + cq) = t; }
};

struct Epi0 {
    static constexpr bool PERM = true, AFTER_DRAIN = false;
    unsigned char* ws; unsigned char* dout; bool cheap; LAS unsigned char* spare;
    __device__ __forceinline__ void operator()(const f32x4 (&acc)[2][2][4][2], const pg8::Unit& u, int wr, int wc, int fr, int fq) const {
        const int t = u.pn, cwv = wc * 32; const size_t rw = (size_t)(u.pm * 256 + wr * 64);
        const RowSt rs(spare, wr, wc, fr, fq);
        if (t < 8) {
            bf16_t* U = (bf16_t*)(ws + WS_U);
#pragma unroll
            for (int ai = 0; ai < 2; ++ai)
#pragma unroll
                for (int m = 0; m < 4; ++m) {
                    const f32x4 a = cheap ? acc[ai][0][m][0] : acc[ai][0][m][0] * sig4(acc[ai][1][m][0]), b = cheap ? acc[ai][0][m][1] : acc[ai][0][m][1] * sig4(acc[ai][1][m][1]);
                    rs.store(U, rw + ai * 128 + m * 16, 1024, 128 * t + cwv, pack8(a, b), m & 1); }
        } else if (t == 28) {
            bf16_t* WDAD = (bf16_t*)(dout + DO_WDAD);
#pragma unroll
            for (int ai = 0; ai < 2; ++ai)
#pragma unroll
                for (int m = 0; m < 4; ++m) rs.store(WDAD, rw + ai * 128 + m * 16, 128, cwv, pack8(acc[ai][0][m][0], acc[ai][0][m][1]), m & 1);
        } else {
            const bool act = ((t < 12) || (t >= 24)) && !cheap; const int c0 = 256 * (t & 3);
            unsigned char* bp = (t >= 24) ? (dout + DO_BG) : (ws + WS_AG + (size_t)((t - 8) >> 2) * (64 * MiB));
            bf16_t* base = (bf16_t*)bp;
#pragma unroll
            for (int ai = 0; ai < 2; ++ai)
#pragma unroll
                for (int m = 0; m < 4; ++m) {
#pragma unroll
                    for (int bj = 0; bj < 2; ++bj) { f32x4 a = acc[ai][bj][m][0], b = acc[ai][bj][m][1];
                        if (act) { a = silu4(a); b = silu4(b); }
                        rs.store(base, rw + ai * 128 + m * 16, 1024, c0 + 128 * bj + cwv, pack8(a, b), bj); } }
        }
    }
};
static_assert(WS_R == WS_AG + 64 * MiB && WS_K == WS_AG + 128 * MiB && WS_V == WS_AG + 192 * MiB, "Epi0 region arithmetic");

struct EpiLora {
    static constexpr bool PERM = true, AFTER_DRAIN = false;
    bf16_t *D, *A; const float* vec; LAS unsigned char* spare;
    __device__ __forceinline__ void operator()(const f32x4 (&acc)[2][2][4][2], const pg8::Unit& u, int wr, int wc, int fr, int fq) const {
        const int t = u.pn, cw = wc * 32 + 8 * fq; const size_t rw = (size_t)(u.pm * 256 + wr * 64);
        const bool isd = t < 4; bf16_t* base = isd ? D : A; const int c0 = 256 * (t & 3); const float* bias = vec + (isd ? 0 : 1024) + c0 + cw;
        const float sc = isd ? 0.60653065971f : 1.0f;
        const RowSt rs(spare, wr, wc, fr, fq);
#pragma unroll
        for (int ai = 0; ai < 2; ++ai)
#pragma unroll
            for (int m = 0; m < 4; ++m) {
#pragma unroll
                for (int bj = 0; bj < 2; ++bj) { const f32x4 b0 = *(const f32x4*)(bias + 128 * bj), b1 = *(const f32x4*)(bias + 128 * bj + 4);
                    const f32x4 a = sig4(acc[ai][bj][m][0] + b0) * sc, b = sig4(acc[ai][bj][m][1] + b1) * sc;
                    rs.store(base, rw + ai * 128 + m * 16, 1024, c0 + 128 * bj + wc * 32, pack8(a, b), bj); } }
    }
};

struct EpiRes {
    static constexpr bool PERM = false, AFTER_DRAIN = false;
    const float* resid; float* out; const float* modp; const float* ada_b; int layer; bool cheap; LAS unsigned char* spare;
    __device__ __forceinline__ void operator()(const f32x4 (&acc)[2][2][4][2], const pg8::Unit& u, int wr, int wc, int fr, int fq) const {
        const int row0 = u.pm * 256 + wr * 64 + fr, col0 = u.pn * 256 + wc * 32 + 4 * fq, b = (u.pm * 256) / SEQ;
#ifdef EPIRES_CHEAP
        if (cheap) {
            f32x4 s = (f32x4){0.f, 0.f, 0.f, 0.f};
#pragma unroll
            for (int ai = 0; ai < 2; ++ai)
#pragma unroll
                for (int bj = 0; bj < 2; ++bj)
#pragma unroll
                    for (int m = 0; m < 4; ++m)
#pragma unroll
                        for (int n = 0; n < 2; ++n) s += acc[ai][bj][m][n];
            if (s[0] + s[1] + s[2] + s[3] == 1.2345e30f) out[(size_t)row0 * 1024 + col0] = s[0];
            return; }
#endif
        f32x4 gv[2][2];
#pragma unroll
        for (int bj = 0; bj < 2; ++bj)
#pragma unroll
            for (int n = 0; n < 2; ++n) { const int c = col0 + bj * 128 + n * 16; f32x4 g = *(const f32x4*)(ada_b + layer * 3072 + 2048 + c);
#pragma unroll
                for (int s = 0; s < 8; ++s) g += *(const f32x4*)(modp + (size_t)((s * 2 + layer) * 4 + b) * 3072 + 2048 + c);
                gv[bj][n] = g; }
        const int lane = fr + 16 * fq;
        const unsigned tile = (unsigned)(size_t)spare + (unsigned)(wr * 4 + wc) * 2048u;
        const unsigned wa = tile + (unsigned)fr * 128u + (unsigned)((fq ^ (fr >> 1)) << 4);
        const unsigned ra = tile + (unsigned)lane * 16u;
        const size_t o0 = (size_t)(u.pm * 256 + wr * 64 + (lane >> 3)) * 1024 + u.pn * 256 + wc * 32 + 4 * ((lane & 7) ^ (lane >> 4));
        const size_t o1 = (size_t)(u.pm * 256 + wr * 64 + 8 + (lane >> 3)) * 1024 + u.pn * 256 + wc * 32 + 4 * ((lane & 7) ^ (4 + (lane >> 4)));
        f32x4 rr[3][2];
        auto rload = [&](int idx, f32x4 (&dst)[2]) { const int ai = idx >> 3, m = (idx >> 1) & 3, bj = idx & 1; const size_t d = (size_t)(ai * 128 + m * 16) * 1024 + bj * 128;
            dst[0] = *(const f32x4*)(resid + o0 + d); dst[1] = *(const f32x4*)(resid + o1 + d); };
        rload(0, rr[0]); rload(1, rr[1]);
#pragma unroll
        for (int idx = 0; idx < 16; ++idx) { const int ai = idx >> 3, m = (idx >> 1) & 3, bj = idx & 1; const size_t d = (size_t)(ai * 128 + m * 16) * 1024 + bj * 128;
            if (idx + 2 < 16) rload(idx + 2, rr[(idx + 2) % 3]);
            *(LAS f32x4*)(size_t)wa = gv[bj][0] * acc[ai][bj][m][0]; *(LAS f32x4*)(size_t)(wa ^ 64u) = gv[bj][1] * acc[ai][bj][m][1];
            const f32x4 t0 = *(const LAS f32x4*)(size_t)ra, t1 = *(const LAS f32x4*)(size_t)(ra + 1024u);
            *(f32x4*)(out + o0 + d) = rr[idx % 3][0] + t0; *(f32x4*)(out + o1 + d) = rr[idx % 3][1] + t1;
            asm volatile("" ::: "memory"); }
    }
};

constexpr float Q_SCALE = 0.08838834764831845f * 1.4426950408889634f;
constexpr float WI_SCALE = 0.35355339059327373f * 0.125f;
struct Epi1 {
    static constexpr bool PERM = true, AFTER_DRAIN = false;
    bf16_t *Q, *KV, *QI, *KI, *G; float* WI; const f32x2* csa; const f32x2* csi; LAS unsigned char* spare;
    __device__ __forceinline__ void rope8(const f32x4 x1a, const f32x4 x1b, const f32x4 x2a, const f32x4 x2b, const f32x4 (&tv)[4], float sc, u32x4& o1, u32x4& o2) const {
        float c[8], s[8];
#pragma unroll
        for (int j = 0; j < 4; ++j) { c[2 * j] = tv[j][0]; s[2 * j] = tv[j][1]; c[2 * j + 1] = tv[j][2]; s[2 * j + 1] = tv[j][3]; }
        float a[8], b[8];
#pragma unroll
        for (int j = 0; j < 4; ++j) { a[j] = x1a[j]; a[4 + j] = x1b[j]; b[j] = x2a[j]; b[4 + j] = x2b[j]; }
        float p[8], q[8];
#pragma unroll
        for (int j = 0; j < 8; ++j) { p[j] = (a[j] * c[j] - b[j] * s[j]) * sc; q[j] = (b[j] * c[j] + a[j] * s[j]) * sc; }
        o1.x = pk2(p[0], p[1]); o1.y = pk2(p[2], p[3]); o1.z = pk2(p[4], p[5]); o1.w = pk2(p[6], p[7]);
        o2.x = pk2(q[0], q[1]); o2.y = pk2(q[2], q[3]); o2.z = pk2(q[4], q[5]); o2.w = pk2(q[6], q[7]);
    }
    __device__ __forceinline__ void operator()(const f32x4 (&acc)[2][2][4][2], const pg8::Unit& u, int wr, int wc, int fr, int fq) const {
        const int row0 = u.pm * 256 + wr * 64 + fr, t = u.pn; const size_t rw = (size_t)(u.pm * 256 + wr * 64);
        const RowSt rs(spare, wr, wc, fr, fq);
        const bool roped = (t < 8) || (t == 8 && wc < 2) || (t >= 9 && t < 11) || (t == 11 && wc == 0);
        if (roped) {
            int lane = fr + 16 * fq; asm volatile("" : "+v"(lane));
            const bool wide = t <= 8; const int rb = wide ? 1024 : 512;
            const f32x2* tab = wide ? csa + (((rw >> 4) * 2 + (wc & 1)) * 256 + lane) * 2 : csi + ((rw >> 4) * 256 + lane) * 2;
            f32x4 tv[3][4];
            auto tload = [&](int idx, f32x4 (&d)[4]) { const f32x2* p = tab + (size_t)((idx >> 2) * 8 + (idx & 3)) * rb;
#pragma unroll
                for (int j = 0; j < 4; ++j) d[j] = *(const f32x4*)(p + 128 * j); };
            tload(0, tv[0]); tload(1, tv[1]);
            const float sc = (t < 8) ? Q_SCALE : 1.0f;
#pragma unroll
            for (int idx = 0; idx < 8; ++idx) { const int ai = idx >> 2, m = idx & 3; const size_t r16 = rw + ai * 128 + m * 16;
                if (idx + 2 < 8) tload(idx + 2, tv[(idx + 2) % 3]);
                u32x4 o1, o2; rope8(acc[ai][0][m][0], acc[ai][0][m][1], acc[ai][1][m][0], acc[ai][1][m][1], tv[idx % 3], sc, o1, o2);
                if (t < 8) { const int head = 2 * t + (wc >> 1); rs.store(Q, r16, 2048, head * 128 + (wc & 1) * 32, o1, 0); rs.store(Q, r16, 2048, head * 128 + 64 + (wc & 1) * 32, o2, 1); }
                else if (t == 8) { rs.store(KV, r16, 256, (wc & 1) * 32, o1, 0); rs.store(KV, r16, 256, 64 + (wc & 1) * 32, o2, 1); }
                else if (t < 11) { const int head = 4 * (t - 9) + wc; bf16_t* qp = QI + (((r16 >> 4) * 16 + head * 2) * 64 + lane) * 8; *(u32x4*)qp = o1; *(u32x4*)(qp + 512) = o2; }
                else { bf16_t* kp = KI + (((r16 >> 4) * 2) * 64 + lane) * 8; *(u32x4*)kp = o1; *(u32x4*)(kp + 512) = o2; }
                asm volatile("" ::: "memory"); }
        } else {
#pragma unroll
            for (int ai = 0; ai < 2; ++ai)
#pragma unroll
                for (int m = 0; m < 4; ++m) { const size_t row = (size_t)(row0 + ai * 128 + m * 16), r16 = rw + ai * 128 + m * 16;
                    const f32x4 x1a = acc[ai][0][m][0], x1b = acc[ai][0][m][1], x2a = acc[ai][1][m][0], x2b = acc[ai][1][m][1];
                    if (t == 8) { rs.store(KV, r16, 256, 128 + (wc & 1) * 32, pack8(x1a, x1b), 0); rs.store(KV, r16, 256, 192 + (wc & 1) * 32, pack8(x2a, x2b), 1); }
                    else if (t == 11) { if (wc == 1 && fq == 0) { *(f32x4*)(WI + row * 8) = x1a * WI_SCALE; *(f32x4*)(WI + row * 8 + 4) = x1b * WI_SCALE; } }
                    else if (t >= 12) { const int c0 = 256 * (t - 12);
                        rs.store(G, r16, 2048, c0 + wc * 32, pack8(silu4(x1a), silu4(x1b)), 0); rs.store(G, r16, 2048, c0 + 128 + wc * 32, pack8(silu4(x2a), silu4(x2b)), 1); }
                }
        }
    }
};

struct Args {
    const float* x; const float* c; const int* pos; const float* ada_w; const float* ada_b; const float* norm_g; const float* final_g;
    const float* even_w_in; const float* even_w_out; const float* conv_w; const float* conv_vec; const float* mu_rkv; const float* mu_lora;
    const float* rwkv_vec; const float* w_up; const float* a_up; const float* r_k; const float* odd_w_in; const float* odd_w_out;
    float* out; unsigned char* ws; int ph_lo, ph_hi;
};

template <class SrcF>
__device__ __forceinline__ void transpose_item(const SrcF& src, int K, bf16_t* WT, LAS float* scr, int item, int nblk, int lane) {
    const int kb = item / nblk, nb = item % nblk, k0 = 64 * kb, n0 = 32 * nb;
    float tv[32];
#pragma unroll
    for (int i = 0; i < 32; ++i) tv[i] = src(k0 + 2 * i + (lane >> 5), n0 + (lane & 31));
#pragma unroll
    for (int i = 0; i < 32; ++i) scr[(2 * i + (lane >> 5)) * 33 + (lane & 31)] = tv[i];
    LDS_WAIT();
    const int c = lane & 7;
#pragma unroll
    for (int j = 0; j < 4; ++j) { const int n = (lane >> 3) + 8 * j; const LAS float* s = scr + (8 * c) * 33 + n;
        u32x4 o; o.x = pk2(s[0 * 33], s[1 * 33]); o.y = pk2(s[2 * 33], s[3 * 33]); o.z = pk2(s[4 * 33], s[5 * 33]); o.w = pk2(s[6 * 33], s[7 * 33]);
        *(u32x4*)(WT + (size_t)(n0 + n) * K + k0 + 8 * c) = o; }
    LDS_WAIT();
}

__device__ __forceinline__ void transpose_item_col(const float* W, int ldw, int scol, int K, bf16_t* WT, LAS float* scr, int k0, int n0, int lane) {
    const float* wp = W + (size_t)(k0 + (lane >> 5)) * ldw + (scol < 0 ? 0 : scol);
#pragma unroll 8
    for (int i = 0; i < 32; ++i) { const float v = wp[(size_t)(2 * i) * ldw]; scr[(2 * i + (lane >> 5)) * 33 + (lane & 31)] = scol < 0 ? 0.f : v; }
    LDS_WAIT();
    const int c = lane & 7;
#pragma unroll
    for (int j = 0; j < 4; ++j) { const int n = (lane >> 3) + 8 * j; const LAS float* s = scr + (8 * c) * 33 + n;
        u32x4 o; o.x = pk2(s[0 * 33], s[1 * 33]); o.y = pk2(s[2 * 33], s[3 * 33]); o.z = pk2(s[4 * 33], s[5 * 33]); o.w = pk2(s[6 * 33], s[7 * 33]);
        *(u32x4*)(WT + (size_t)(n0 + n) * K + k0 + 8 * c) = o; }
    LDS_WAIT();
}
__device__ __forceinline__ void rope_item(const Args& a, int r, int lane) {
    const float p = (float)a.pos[r]; const int f = lane;
    { const float inv = powf(10000.0f, -(float)(2 * f) / 128.0f); float sn, cs; sincosf(p * inv, &sn, &cs);
      ((f32x2*)(a.ws + WS_CSA))[(size_t)((((r >> 4) * 2 + (f >> 5)) * 4 + ((f & 7) >> 1)) * 64 + (r & 15) + 16 * ((f & 31) >> 3)) * 2 + (f & 1)] = (f32x2){cs, sn}; }
    if (f < 32) { const float inv = powf(10000.0f, -(float)(2 * f) / 64.0f); float sn, cs; sincosf(p * inv, &sn, &cs);
      ((f32x2*)(a.ws + WS_CSI))[(size_t)(((r >> 4) * 4 + ((f & 7) >> 1)) * 64 + (r & 15) + 16 * (f >> 3)) * 2 + (f & 1)] = (f32x2){cs, sn}; }
}
__device__ __forceinline__ void p0_late(const Args& a, const int wave, LAS unsigned char* lds, int first, int nblk) {
    const int lane = lane_id(), tid = wave * 64 + lane;
    LAS float* scr = (LAS float*)(lds + wave * 16384);
    const int gw = ((int)blockIdx.x - first) * NWAVES + wave, NGW = nblk * NWAVES;
    unsigned char* ws = a.ws;
    constexpr int I_WO = (2048 / 64) * (DM / 32), I_W1 = (DM / 64) * (N1 / 32), I_ROPE = MTOK;
    for (int it = gw; it < I_W1 + I_WO + I_ROPE; it += NGW) {
        int r = it;
        if (r < I_W1) { const int nblk = N1 / 32, k0 = 64 * (r / nblk), n0 = 32 * (r % nblk); transpose_item_col(a.odd_w_in, ODD_COLS, map1(n0 + (lane & 31)), DM, (bf16_t*)(ws + WS_WIN1), scr, k0, n0, lane); continue; } r -= I_W1;
        if (r < I_WO) { const int nblk = DM / 32, k0 = 64 * (r / nblk), n0 = 32 * (r % nblk); transpose_item_col(a.odd_w_out, DM, n0 + (lane & 31), 2048, (bf16_t*)(ws + WS_WOUT1), scr, k0, n0, lane); continue; } r -= I_WO;
        {
            const float p = (float)a.pos[r];
            { const float inv = powf(10000.0f, -(float)(2 * lane) / 128.0f); float sn, cs; sincosf(p * inv, &sn, &cs); ((f32x2*)(ws + WS_CSA))[(size_t)r * 64 + lane] = (f32x2){cs, sn}; }
            if (lane < 32) { const float inv = powf(10000.0f, -(float)(2 * lane) / 64.0f); float sn, cs; sincosf(p * inv, &sn, &cs); ((f32x2*)(ws + WS_CSI))[(size_t)r * 32 + lane] = (f32x2){cs, sn}; }
        }
    }
}
__device__ __forceinline__ void p0_prologue(const Args& a, const int wave, LAS unsigned char* lds) {
    const int lane = lane_id(), tid = wave * 64 + lane;
    LAS float* scr = (LAS float*)(lds + wave * 16384);
    const int gw = blockIdx.x * NWAVES + wave, NGW = gridDim.x * NWAVES;
    unsigned char* ws = a.ws;
    constexpr int I_W0 = (DM / 64) * (N0 / 32), I_WO = (2048 / 64) * (DM / 32), I_W1 = (DM / 64) * (N1 / 32), I_WL = (256 / 64) * (2048 / 32), I_MOD = 96 * 8, I_ROPE = MTOK;
    constexpr int NITEMS = I_W0 + I_WO + I_W1 + I_WO + I_WL + I_MOD + I_ROPE;
    constexpr int N_EARLY = I_W0 + I_WO + I_W1 + I_WO + I_WL + I_MOD;
    for (int it = gw; it < N_EARLY; it += NGW) {
        int r = it;
        if (r < I_W0) { const float* W = a.even_w_in; transpose_item([W](int k, int n) { const int s = map0(n); return s < 0 ? 0.f : W[(size_t)k * EVEN_COLS + s]; }, DM, (bf16_t*)(ws + WS_WIN0), scr, r, N0 / 32, lane); continue; } r -= I_W0;
        if (r < I_WO) { const float* W = a.even_w_out; transpose_item([W](int k, int n) { return W[(size_t)k * DM + n]; }, 2048, (bf16_t*)(ws + WS_WOUT0), scr, r, DM / 32, lane); continue; } r -= I_WO;
        if (r < I_W1) { const float* W = a.odd_w_in; transpose_item([W](int k, int n) { const int s = map1(n); return s < 0 ? 0.f : W[(size_t)k * ODD_COLS + s]; }, DM, (bf16_t*)(ws + WS_WIN1), scr, r, N1 / 32, lane); continue; } r -= I_W1;
        if (r < I_WO) { const float* W = a.odd_w_out; transpose_item([W](int k, int n) { return W[(size_t)k * DM + n]; }, 2048, (bf16_t*)(ws + WS_WOUT1), scr, r, DM / 32, lane); continue; } r -= I_WO;
        if (r < I_WL) { const float* wu = a.w_up; const float* au = a.a_up;
            transpose_item([wu, au](int k, int n) { if (n < 1024) return k < 64 ? wu[k * 1024 + n] : 0.f; return (k >= 64 && k < 128) ? au[(k - 64) * 1024 + (n - 1024)] : 0.f; }, 256, (bf16_t*)(ws + WS_WLORA), scr, r, 2048 / 32, lane); continue; } r -= I_WL;
        if (r < I_MOD) {
            const int cgp = r >> 3, ks = r & 7, col = cgp * 64 + lane, l = col / 3072, cc = col - l * 3072;
#pragma unroll
            for (int i = 0; i < 8; ++i) { const int idx = lane + 64 * i, bb = idx >> 7, kk = idx & 127; const float cv = a.c[bb * DM + ks * 128 + kk]; scr[kk * 4 + bb] = cv * sigmoidf_(cv); }
            LDS_WAIT();
            const float* W = a.ada_w + (size_t)l * DM * 3072 + cc + (size_t)(ks * 128) * 3072; f32x4 acc4 = (f32x4){0.f, 0.f, 0.f, 0.f};
#pragma unroll 1
            for (int k8 = 0; k8 < 128; k8 += 16) { float wv[16];
#pragma unroll
                for (int i = 0; i < 16; ++i) wv[i] = W[(size_t)(k8 + i) * 3072];
#pragma unroll
                for (int i = 0; i < 16; ++i) acc4 += *(const LAS f32x4*)(scr + (k8 + i) * 4) * wv[i]; }
            LDS_WAIT();
            const float acc0 = acc4[0], acc1 = acc4[1], acc2 = acc4[2], acc3 = acc4[3];
            float* mp = (float*)(ws + WS_MODP) + (size_t)((ks * 2 + l) * 4) * 3072 + cc;
            mp[0] = acc0; mp[3072] = acc1; mp[2 * 3072] = acc2; mp[3 * 3072] = acc3; continue; } r -= I_MOD;
    }
}

__device__ __forceinline__ void norm_phase(const Args& a, const int wave, LAS unsigned char* lds, const float* src, int layer) {
    const int lane = lane_id(), tid = wave * 64 + lane;
    LAS float* gs = (LAS float*)lds; LAS float* sh = gs + DM;
    const float* modp = (const float*)(a.ws + WS_MODP); bf16_t* H = (bf16_t*)(a.ws + WS_H);
    for (int tile = blockIdx.x; tile < MTOK / 128; tile += gridDim.x) {
        const int b = (tile * 128) / SEQ;
        __syncthreads();
        for (int c = tid; c < DM; c += NTHREADS) {
            float sc = a.ada_b[layer * 3072 + 1024 + c], sf = a.ada_b[layer * 3072 + c];
#pragma unroll
            for (int s = 0; s < 8; ++s) { const float* mp = modp + (size_t)((s * 2 + layer) * 4 + b) * 3072; sc += mp[1024 + c]; sf += mp[c]; }
            gs[c] = a.norm_g[layer * DM + c] * (1.0f + sc); sh[c] = sf; }
        __syncthreads();
        for (int r4 = 0; r4 < 16; r4 += 4) {
            f32x4 v[4][4]; float ss[4];
#pragma unroll
            for (int q = 0; q < 4; ++q) { const size_t m = (size_t)tile * 128 + wave * 16 + r4 + q; const f32x4* xr = (const f32x4*)(src + m * DM) + lane;
#pragma unroll
                for (int j = 0; j < 4; ++j) v[q][j] = xr[64 * j]; }
#pragma unroll
            for (int q = 0; q < 4; ++q) { float s = 0.f;
#pragma unroll
                for (int j = 0; j < 4; ++j) s += (v[q][j][0] * v[q][j][0] + v[q][j][1] * v[q][j][1]) + (v[q][j][2] * v[q][j][2] + v[q][j][3] * v[q][j][3]);
                ss[q] = s; }
#pragma unroll
            for (int q = 0; q < 4; ++q) ss[q] = wave_sum(ss[q]);
#pragma unroll
            for (int q = 0; q < 4; ++q) { const size_t m = (size_t)tile * 128 + wave * 16 + r4 + q; const float rstd = rsqrtf(ss[q] * (1.0f / DM) + 1e-6f);
                u32x2* o = (u32x2*)(H + m * DM) + lane;
#pragma unroll
                for (int j = 0; j < 4; ++j) { const f32x4 g = *(const LAS f32x4*)(gs + 4 * (64 * j + lane)), s = *(const LAS f32x4*)(sh + 4 * (64 * j + lane));
                    const f32x4 h = v[q][j] * rstd * g + s; u32x2 w; w.x = pk2(h[0], h[1]); w.y = pk2(h[2], h[3]); o[64 * j] = w; } }
        }
    }
}

__device__ __forceinline__ void final_phase(const Args& a, const int wave) {
    const int lane = lane_id(), tid = wave * 64 + lane;
    const int gw = blockIdx.x * NWAVES + wave, NGW = gridDim.x * NWAVES;
    f32x4 g[4];
#pragma unroll
    for (int j = 0; j < 4; ++j) g[j] = *((const f32x4*)a.final_g + 64 * j + lane);
    float tsc = 1.0f;
#ifdef STAMP_K
    { const unsigned long long* st = (const unsigned long long*)(a.ws + WS_STAMP); tsc = 1.0f + (float)(st[1] - st[0] + st[2]) * 1e-7f; }
#endif
    for (int m0 = 4 * gw; m0 < MTOK; m0 += 4 * NGW) {
        f32x4 v[4][4]; float ss[4];
#pragma unroll
        for (int q = 0; q < 4; ++q) { const f32x4* xr = (const f32x4*)(a.out + (size_t)(m0 + q) * DM) + lane;
#pragma unroll
            for (int j = 0; j < 4; ++j) v[q][j] = xr[64 * j]; }
#pragma unroll
        for (int q = 0; q < 4; ++q) { float s = 0.f;
#pragma unroll
            for (int j = 0; j < 4; ++j) s += (v[q][j][0] * v[q][j][0] + v[q][j][1] * v[q][j][1]) + (v[q][j][2] * v[q][j][2] + v[q][j][3] * v[q][j][3]);
            ss[q] = wave_sum(s); }
#pragma unroll
        for (int q = 0; q < 4; ++q) { const float rstd = rsqrtf(ss[q] * (1.0f / DM) + 1e-6f) * tsc; f32x4* xr = (f32x4*)(a.out + (size_t)(m0 + q) * DM) + lane;
#pragma unroll
            for (int j = 0; j < 4; ++j) xr[64 * j] = v[q][j] * rstd * g[j]; }
    }
}


__device__ __forceinline__ void conv_phase(const Args& a, const int wave, LAS unsigned char* lds, int first, int stride) {
    const int lane = lane_id(), tid = wave * 64 + lane;
    const bf16_t* U = (const bf16_t*)(a.ws + WS_U); const bf16_t* AG = (const bf16_t*)(a.ws + WS_AG); bf16_t* YAB = (bf16_t*)(a.ws + WS_YAB);
    f32x2 w[31];
#pragma unroll
    for (int j = 0; j < 31; ++j) w[j] = *(const f32x2*)(a.conv_w + j * DM + 2 * tid);
    const f32x2 cbias = *(const f32x2*)(a.conv_vec + 2 * tid);
    for (int tile = first; tile < MTOK / 32; tile += stride) {
        const int b = tile >> 8, s0 = (tile & 255) * 32;
        __syncthreads();
        for (int idx = tid; idx < 62 * 128; idx += NTHREADS) { const int row = idx >> 7, ch = idx & 127, s = s0 - 30 + row;
            u32x4 v = (u32x4){0u, 0u, 0u, 0u}; if (s >= 0) v = *(const u32x4*)(U + ((size_t)(b * SEQ + s)) * DM + ch * 8);
            *(LAS u32x4*)(lds + row * 2048 + ch * 16) = v; }
        __syncthreads();
        LAS unsigned char* rb0 = lds + tid * 4; LAS unsigned char* rb1 = rb0 + 65536; LAS unsigned char* wb0 = lds + tid * 8; LAS unsigned char* wb1 = wb0 + 65536;
        asm volatile("" : "+v"(rb0), "+v"(rb1), "+v"(wb0), "+v"(wb1));
        f32x2 acc[32];
#pragma unroll
        for (int t = 0; t < 32; ++t) acc[t] = (f32x2){0.f, 0.f};
#pragma unroll
        for (int i = 0; i < 62; ++i) { const unsigned xw = (i < 32) ? *(const LAS unsigned*)(rb0 + i * 2048) : *(const LAS unsigned*)(rb1 + (i - 32) * 2048); const f32x2 xv = (f32x2){bflo(xw), bfhi(xw)};
#pragma unroll
            for (int t = (i > 30 ? i - 30 : 0); t <= (i < 31 ? i : 31); ++t) acc[t] += xv * w[i - t]; }
        __syncthreads();
#pragma unroll
        for (int t = 0; t < 32; ++t) { if (t < 16) *(LAS f32x2*)(wb0 + t * 4096) = acc[t] + cbias; else *(LAS f32x2*)(wb1 + (t - 16) * 4096) = acc[t] + cbias; }
        __syncthreads();
        f32x4 lw[4], lb[4];
#pragma unroll
        for (int j = 0; j < 4; ++j) { lw[j] = *(const f32x4*)(a.conv_vec + DM + 4 * (lane + 64 * j)); lb[j] = *(const f32x4*)(a.conv_vec + 2 * DM + 4 * (lane + 64 * j)); }
        for (int tt = 0; tt < 4; ++tt) { const int t = wave * 4 + tt; const size_t m = (size_t)b * SEQ + s0 + t;
            f32x4 v[4]; float s = 0.f;
#pragma unroll
            for (int j = 0; j < 4; ++j) { v[j] = *(const LAS f32x4*)(lds + (size_t)t * 4096 + 16 * (lane + 64 * j)); s += (v[j][0] + v[j][1]) + (v[j][2] + v[j][3]); }
            const float mean = wave_sum(s) * (1.0f / DM); float q = 0.f;
#pragma unroll
            for (int j = 0; j < 4; ++j) { v[j] = v[j] - mean; q += (v[j][0] * v[j][0] + v[j][1] * v[j][1]) + (v[j][2] * v[j][2] + v[j][3] * v[j][3]); }
            const float rstd = rsqrtf(wave_sum(q) * (1.0f / DM) + 1e-5f);
#pragma unroll
            for (int j = 0; j < 4; ++j) { const f32x4 y = v[j] * rstd * lw[j] + lb[j]; const u32x2 g = *(const u32x2*)(AG + m * DM + 4 * (lane + 64 * j));
                const f32x4 o = silu4(y) * (f32x4){bflo(g.x), bfhi(g.x), bflo(g.y), bfhi(g.y)};
                u32x2 wv; wv.x = pk2(o[0], o[1]); wv.y = pk2(o[2], o[3]); *(u32x2*)(YAB + m * 2048 + 4 * (lane + 64 * j)) = wv; }
        }
    }
}

__device__ __forceinline__ void lora_pre_phase(const Args& a, const int wave) {
    const int lane = lane_id(), tid = wave * 64 + lane;

        const bf16_t* WDAD = (const bf16_t*)((unsigned char*)a.out + DO_WDAD); bf16_t* LA = (bf16_t*)((unsigned char*)a.out + DO_LA);
        const int gw = blockIdx.x * NWAVES + wave, NGW = gridDim.x * NWAVES;
        const f32x2 mu = *(const f32x2*)(a.mu_lora + 2 * lane);
        for (int m0 = gw * 4; m0 < MTOK; m0 += NGW * 4) {
            unsigned cur[4], prv[4];
#pragma unroll
            for (int i = 0; i < 4; ++i) { const int m = m0 + i; cur[i] = *(const unsigned*)(WDAD + (size_t)m * 128 + 2 * lane); }
#pragma unroll
            for (int i = 0; i < 4; ++i) { const int m = m0 + i; if (i > 0) prv[i] = cur[i - 1]; else { prv[0] = 0u; if ((m & (SEQ - 1)) > 0) prv[0] = *(const unsigned*)(WDAD + (size_t)(m - 1) * 128 + 2 * lane); } }
#pragma unroll
            for (int i = 0; i < 4; ++i) { const int m = m0 + i;
                float v0 = bflo(cur[i]), v1 = bfhi(cur[i]); v0 += (bflo(prv[i]) - v0) * mu[0]; v1 += (bfhi(prv[i]) - v1) * mu[1];
                if (lane < 32) { v0 = tanhf(v0); v1 = tanhf(v1); }
                *(unsigned*)(LA + (size_t)m * 256 + 2 * lane) = pk2(v0, v1); *(unsigned*)(LA + (size_t)m * 256 + 128 + 2 * lane) = 0u; }
        }
    }

struct ScanRaw { u32x2 r, rp, k, kp, v, vp, d, a; };
constexpr int SC_CH = 16, SC_BUF_F = 5 * SC_CH * 64 + SC_CH * 16;

__device__ __forceinline__ void scan_phase(const Args& a, const int wave, LAS unsigned char* lds) {
    const int lane = lane_id(), tid = wave * 64 + lane;
    const bf16_t* Rg = (const bf16_t*)(a.ws + WS_R); const bf16_t* Kg = (const bf16_t*)(a.ws + WS_K); const bf16_t* Vg = (const bf16_t*)(a.ws + WS_V);
    const bf16_t* Dg = (const bf16_t*)(a.ws + WS_DARR); const bf16_t* Ag = (const bf16_t*)(a.ws + WS_AARR);
    bf16_t* YAB = (bf16_t*)(a.ws + WS_YAB); float* RK = (float*)((unsigned char*)a.out + DO_RK);
    LAS float* bufs = (LAS float*)lds; LAS float* ybuf = bufs + 2 * SC_BUF_F;
    constexpr int NCH = SEQ / SC_CH;
    for (int job = blockIdx.x; job < 256; job += gridDim.x) {
        const int vcu = (gridDim.x == 256) ? ((job & 7) * 32 + (job >> 3)) : job;
        const int bh = vcu >> 2, vq = vcu & 3, b = bh >> 4, h = bh & 15;
        __syncthreads();
        if (wave >= 4) {
            const int pt = tid - 256, tok = pt >> 4, cgp = pt & 15, ch = h * 64 + 4 * cgp;
            const f32x4 mur = *(const f32x4*)(a.mu_rkv + ch), muk = *(const f32x4*)(a.mu_rkv + DM + ch), muv = *(const f32x4*)(a.mu_rkv + 2 * DM + ch);
            const f32x4 k_k = *(const f32x4*)(a.rwkv_vec + 2 * DM + ch), k_a = *(const f32x4*)(a.rwkv_vec + 3 * DM + ch), rkw = *(const f32x4*)(a.r_k + ch);
            auto load = [&](int c) { ScanRaw q; const int s = c * SC_CH + tok; const size_t m = (size_t)b * SEQ + s; const size_t o = m * DM + ch; const size_t op = (s > 0) ? o - DM : o;
                q.r = *(const u32x2*)(Rg + o); q.k = *(const u32x2*)(Kg + o); q.v = *(const u32x2*)(Vg + o); q.d = *(const u32x2*)(Dg + o); q.a = *(const u32x2*)(Ag + o);
                q.rp = *(const u32x2*)(Rg + op); q.kp = *(const u32x2*)(Kg + op); q.vp = *(const u32x2*)(Vg + op);
                if (s == 0) { q.rp = (u32x2){0u, 0u}; q.kp = (u32x2){0u, 0u}; q.vp = (u32x2){0u, 0u}; }
                return q; };
            auto un4 = [](u32x2 w) { return (f32x4){bflo(w.x), bfhi(w.x), bflo(w.y), bfhi(w.y)}; };
            auto process = [&](const ScanRaw& q, int c, LAS float* buf) {
                const f32x4 r0 = un4(q.r), k0 = un4(q.k), v0 = un4(q.v);
                const f32x4 rl = r0 + (un4(q.rp) - r0) * mur, kl = k0 + (un4(q.kp) - k0) * muk, vl = v0 + (un4(q.vp) - v0) * muv;
                const f32x4 d = un4(q.d), av = un4(q.a);
                f32x4 wdec; wdec[0] = __expf(-d[0]); wdec[1] = __expf(-d[1]); wdec[2] = __expf(-d[2]); wdec[3] = __expf(-d[3]);
                const f32x4 kkr = kl * k_k; float ss = (kkr[0] * kkr[0] + kkr[1] * kkr[1]) + (kkr[2] * kkr[2] + kkr[3] * kkr[3]); ss = row16_sum(ss);
                const float inv = 1.0f / fmaxf(sqrtf(ss), 1e-12f);
                const f32x4 kk = kkr * inv, kp = kl * (1.0f + (av - 1.0f) * k_a), bb = kk * av;
                float rk = (rl[0] * kp[0] * rkw[0] + rl[1] * kp[1] * rkw[1]) + (rl[2] * kp[2] * rkw[2] + rl[3] * kp[3] * rkw[3]); rk = row16_sum(rk);
                const int o = tok * 64 + 4 * cgp;
                *(LAS f32x4*)(buf + o) = -kk; *(LAS f32x4*)(buf + 1024 + o) = wdec; *(LAS f32x4*)(buf + 2048 + o) = bb; *(LAS f32x4*)(buf + 3072 + o) = kp; *(LAS f32x4*)(buf + 4096 + o) = rl;
                if ((cgp >> 2) == vq) *(LAS f32x4*)(buf + 5120 + tok * 16 + 4 * (cgp & 3)) = vl;
                if (vq == 0 && cgp == 0) RK[((size_t)b * SEQ + c * SC_CH + tok) * 16 + h] = rk; };
            auto flush = [&](int c, const LAS float* yb) {
                if (wave == 4) { const int t2 = lane >> 2, rq = lane & 3; const f32x4 y = *(const LAS f32x4*)(yb + t2 * 16 + 4 * rq);
                    u32x2 wv; wv.x = pk2(y[0], y[1]); wv.y = pk2(y[2], y[3]);
                    *(u32x2*)(YAB + ((size_t)b * SEQ + c * SC_CH + t2) * 2048 + 1024 + h * 64 + 16 * vq + 4 * rq) = wv; } };
            ScanRaw q0 = load(0), q1 = load(1);
            process(q0, 0, bufs); q0 = q1; q1 = load(2);
            __syncthreads();
            for (int c = 0; c < NCH; ++c) {
                if (c + 1 < NCH) process(q0, c + 1, bufs + ((c + 1) & 1) * SC_BUF_F);
                q0 = q1; if (c + 3 < NCH) q1 = load(c + 3);
                if (c >= 1) flush(c - 1, ybuf + ((c - 1) & 1) * 256);
                __syncthreads();
            }
            flush(NCH - 1, ybuf + ((NCH - 1) & 1) * 256);
        } else {
            const int rw = lane >> 4, ks = lane & 15, row = wave * 4 + rw;
            float s0 = 0.f, s1 = 0.f, s2 = 0.f, s3 = 0.f;
            __syncthreads();
            for (int c = 0; c < NCH; ++c) {
                const LAS float* buf = bufs + (c & 1) * SC_BUF_F; LAS float* yb = ybuf + (c & 1) * 256;
#pragma unroll
                for (int t = 0; t < SC_CH; ++t) {
                    const f32x4 nk = *(const LAS f32x4*)(buf + t * 64 + 4 * ks), w4 = *(const LAS f32x4*)(buf + 1024 + t * 64 + 4 * ks), b4 = *(const LAS f32x4*)(buf + 2048 + t * 64 + 4 * ks);
                    const f32x4 kp = *(const LAS f32x4*)(buf + 3072 + t * 64 + 4 * ks), r4 = *(const LAS f32x4*)(buf + 4096 + t * 64 + 4 * ks); const float vv = buf[5120 + t * 16 + row];
                    float sa = (s0 * nk[0] + s1 * nk[1]) + (s2 * nk[2] + s3 * nk[3]); sa = row16_sum(sa);
                    s0 = s0 * w4[0] + (sa * b4[0] + vv * kp[0]); s1 = s1 * w4[1] + (sa * b4[1] + vv * kp[1]);
                    s2 = s2 * w4[2] + (sa * b4[2] + vv * kp[2]); s3 = s3 * w4[3] + (sa * b4[3] + vv * kp[3]);
                    float y = (s0 * r4[0] + s1 * r4[1]) + (s2 * r4[2] + s3 * r4[3]); y = row16_sum(y);
                    if (ks == 0) yb[t * 16 + row] = y;
                }
                __syncthreads();
            }
        }
    }
}

__device__ __forceinline__ void post_phase(const Args& a, const int wave) {
    const int lane = lane_id(), tid = wave * 64 + lane;
    const int gw = blockIdx.x * NWAVES + wave, NGW = gridDim.x * NWAVES;
    const bf16_t* Vg = (const bf16_t*)(a.ws + WS_V); const bf16_t* BG = (const bf16_t*)((unsigned char*)a.out + DO_BG); const float* RK = (const float*)((unsigned char*)a.out + DO_RK);
    bf16_t* YAB = (bf16_t*)(a.ws + WS_YAB);
    const int head = lane >> 2, c0 = head * 64 + 16 * (lane & 3);
    f32x4 muv[4], lw[4], lb[4];
#pragma unroll
    for (int j = 0; j < 4; ++j) { muv[j] = *(const f32x4*)(a.mu_rkv + 2 * DM + c0 + 4 * j); lw[j] = *(const f32x4*)(a.rwkv_vec + 4 * DM + c0 + 4 * j); lb[j] = *(const f32x4*)(a.rwkv_vec + 5 * DM + c0 + 4 * j); }
    auto un4 = [](unsigned x, unsigned y) { return (f32x4){bflo(x), bfhi(x), bflo(y), bfhi(y)}; };
    for (int m = gw; m < MTOK; m += NGW) { const int s = m & (SEQ - 1);
        bf16_t* yp = YAB + (size_t)m * 2048 + 1024 + c0;
        const u32x4 ya = *(const u32x4*)yp, yb2 = *(const u32x4*)(yp + 8);
        const u32x4 va = *(const u32x4*)(Vg + (size_t)m * DM + c0), vb = *(const u32x4*)(Vg + (size_t)m * DM + c0 + 8);
        u32x4 pa = (u32x4){0u, 0u, 0u, 0u}, pb = pa; if (s > 0) { pa = *(const u32x4*)(Vg + (size_t)(m - 1) * DM + c0); pb = *(const u32x4*)(Vg + (size_t)(m - 1) * DM + c0 + 8); }
        const u32x4 ga = *(const u32x4*)(BG + (size_t)m * DM + c0), gb = *(const u32x4*)(BG + (size_t)m * DM + c0 + 8);
        const float rk = RK[(size_t)m * 16 + head];
        f32x4 y[4] = {un4(ya.x, ya.y), un4(ya.z, ya.w), un4(yb2.x, yb2.y), un4(yb2.z, yb2.w)};
        const f32x4 v[4] = {un4(va.x, va.y), un4(va.z, va.w), un4(vb.x, vb.y), un4(vb.z, vb.w)};
        const f32x4 p[4] = {un4(pa.x, pa.y), un4(pa.z, pa.w), un4(pb.x, pb.y), un4(pb.z, pb.w)};
        const f32x4 g[4] = {un4(ga.x, ga.y), un4(ga.z, ga.w), un4(gb.x, gb.y), un4(gb.z, gb.w)};
        float sm = 0.f;
#pragma unroll
        for (int j = 0; j < 4; ++j) sm += (y[j][0] + y[j][1]) + (y[j][2] + y[j][3]);
        const float mean = quad_sum(sm) * (1.0f / 64.0f); float q = 0.f;
#pragma unroll
        for (int j = 0; j < 4; ++j) { y[j] = y[j] - mean; q += (y[j][0] * y[j][0] + y[j][1] * y[j][1]) + (y[j][2] * y[j][2] + y[j][3] * y[j][3]); }
        const float rstd = rsqrtf(quad_sum(q) * (1.0f / 64.0f) + 64e-5f);
        u32x4 o[2];
#pragma unroll
        for (int j = 0; j < 4; ++j) { const f32x4 vl = v[j] + (p[j] - v[j]) * muv[j]; const f32x4 r = (y[j] * rstd * lw[j] + lb[j] + rk * vl) * g[j];
            if (j & 1) { o[j >> 1].z = pk2(r[0], r[1]); o[j >> 1].w = pk2(r[2], r[3]); } else { o[j >> 1].x = pk2(r[0], r[1]); o[j >> 1].y = pk2(r[2], r[3]); } }
        *(u32x4*)yp = o[0]; *(u32x4*)(yp + 8) = o[1];
    }
}

constexpr int CS_L = 32, CS_NCH = SEQ / CS_L, CS_NSLOT = 3;
constexpr int CS_NT = 0, CS_RT = 4096, CS_BT = 8192, CS_KT = 12288, CS_TM = 8192, CS_AKN = 10240, CS_ABR = 12288, CS_AKR = 14336, CS_BC = 16384, CS_KC = 20480, CS_VC = 24576, CS_GL = 28672, CS_SLOT = 29184;
constexpr int CS_RAW = CS_NSLOT * CS_SLOT, CS_RAWSZ = 5 * 33 * 128;
constexpr int CS_FLAGS = CS_RAW + CS_NSLOT * CS_RAWSZ;
static_assert(CS_FLAGS + 64 <= LDS_BYTES && (CS_RAW % 16) == 0 && (CS_RAWSZ % 16) == 0, "chunked scan LDS map");
__device__ __forceinline__ int permp(int j) { return 8 * ((j & 15) >> 2) + 4 * (j >> 4) + (j & 3); }
template <int CTRL, int RM> __device__ __forceinline__ float dppf(float x) { return __int_as_float(__builtin_amdgcn_update_dpp(0, __float_as_int(x), CTRL, RM, 0xf, true)); }
__device__ __forceinline__ float wave_total(float x) {
    x = row16_sum(x); x += dppf<0x142, 0xa>(x); x += dppf<0x143, 0xc>(x); return __int_as_float(__builtin_amdgcn_readlane(__float_as_int(x), 63)); }
__device__ __forceinline__ float wave_sum64(float x) { x = row16_sum(x); x += __shfl_xor(x, 16); x += __shfl_xor(x, 32); return x; }
__device__ __forceinline__ bf16x8 cfrag(const f32x16& x, int s) {
    u32x4 w; w.x = pk2(x[8 * s + 0], x[8 * s + 1]); w.y = pk2(x[8 * s + 2], x[8 * s + 3]); w.z = pk2(x[8 * s + 4], x[8 * s + 5]); w.w = pk2(x[8 * s + 6], x[8 * s + 7]); return __builtin_bit_cast(bf16x8, w); }
__device__ __forceinline__ bf16x8 cfrag2(const f32x4& a, const f32x4& b) { u32x4 w; w.x = pk2(a[0], a[1]); w.y = pk2(a[2], a[3]); w.z = pk2(b[0], b[1]); w.w = pk2(b[2], b[3]); return __builtin_bit_cast(bf16x8, w); }
__device__ __forceinline__ void lds_poll_ge(LAS unsigned* p, unsigned want) { while (__hip_atomic_load(p, __ATOMIC_RELAXED, __HIP_MEMORY_SCOPE_WORKGROUP) < want) __builtin_amdgcn_s_sleep(1); asm volatile("" ::: "memory"); }

__device__ __forceinline__ void cscan_job(const Args& a, const int wave, LAS unsigned char* lds, int bh) {
    int lane; asm volatile("v_mbcnt_lo_u32_b32 %0, -1, 0\n\tv_mbcnt_hi_u32_b32 %0, -1, %0" : "=v"(lane));
    const int tid = wave * 64 + lane;
    const int b = bh >> 4, h = bh & 15;
    const bf16_t* Rg = (const bf16_t*)(a.ws + WS_R); const bf16_t* Kg = (const bf16_t*)(a.ws + WS_K); const bf16_t* Vg = (const bf16_t*)(a.ws + WS_V);
    const bf16_t* Dg = (const bf16_t*)(a.ws + WS_DARR); const bf16_t* Ag = (const bf16_t*)(a.ws + WS_AARR);
    bf16_t* YAB = (bf16_t*)(a.ws + WS_YAB); float* RK = (float*)((unsigned char*)a.out + DO_RK);
    LAS unsigned* ready = (LAS unsigned*)(lds + CS_FLAGS); LAS unsigned* done = ready + CS_NSLOT; LAS unsigned* rawready = done + CS_NSLOT; LAS unsigned* rawfree = rawready + CS_NSLOT;
    __syncthreads();
    if (tid < 4 * CS_NSLOT) ready[tid] = 0u;
    __syncthreads();
    if (wave == 4) {
        const int rr = lane >> 3, cc = lane & 7;
        for (int c = 0; c < CS_NCH; ++c) {
            const int s = c % CS_NSLOT; LAS unsigned char* rw = lds + CS_RAW + s * CS_RAWSZ;
            const size_t m0 = (size_t)b * SEQ + (size_t)c * CS_L;
            u32x4 v[5][4], vp[3];
#pragma unroll
            for (int ar = 0; ar < 5; ++ar) { const bf16_t* src = (ar == 0) ? Rg : (ar == 1) ? Kg : (ar == 2) ? Vg : (ar == 3) ? Dg : Ag;
#pragma unroll
                for (int q4 = 0; q4 < 4; ++q4) v[ar][q4] = *(const u32x4*)(src + (m0 + 8 * q4 + rr) * DM + h * 64 + 8 * cc); }
#pragma unroll
            for (int ar = 0; ar < 3; ++ar) { const bf16_t* src = (ar == 0) ? Rg : (ar == 1) ? Kg : Vg; vp[ar] = (u32x4){0u, 0u, 0u, 0u};
                if (c > 0 && lane < 8) vp[ar] = *(const u32x4*)(src + (m0 - 1) * DM + h * 64 + 8 * cc); }
            if (c >= CS_NSLOT) lds_poll_ge(rawfree + s, (unsigned)(c / CS_NSLOT));
#pragma unroll
            for (int ar = 0; ar < 5; ++ar)
#pragma unroll
                for (int q4 = 0; q4 < 4; ++q4) *(LAS u32x4*)(rw + (ar * 33 + 1 + 8 * q4 + rr) * 128 + 16 * cc) = v[ar][q4];
            if (lane < 8) {
#pragma unroll
                for (int ar = 0; ar < 3; ++ar) *(LAS u32x4*)(rw + (ar * 33) * 128 + 16 * cc) = vp[ar]; }
            LDS_WAIT();
            if (lane == 0) __hip_atomic_store(rawready + s, (unsigned)(c + 1), __ATOMIC_RELAXED, __HIP_MEMORY_SCOPE_WORKGROUP);
        }
    } else if (wave >= 5) {
        const int hw = wave - 5, gch = h * 64 + lane;
        const float mur = a.mu_rkv[gch], muk = a.mu_rkv[DM + gch], muv = a.mu_rkv[2 * DM + gch], kkw = a.rwkv_vec[2 * DM + gch], kaw = a.rwkv_vec[3 * DM + gch], rkw = a.r_k[gch];
        const int kpos = 32 * (lane >> 5) + permp(lane & 31);
        for (int c = hw; c < CS_NCH; c += CS_NSLOT) {
            const int s = hw; LAS unsigned char* sl = lds + s * CS_SLOT; const LAS unsigned short* rw = (const LAS unsigned short*)(lds + CS_RAW + s * CS_RAWSZ);
            const unsigned use = (unsigned)(c / CS_NSLOT);
            { PROBE_BEGIN(10, a.ws, wave);
            if (use > 0u) lds_poll_ge(done + s, 4u * use);
            lds_poll_ge(rawready + s, (unsigned)(c + 1));
            PROBE_END(10, a.ws, wave); }
            PROBE_BEGIN(11, a.ws, wave);
            const size_t m0 = (size_t)b * SEQ + (size_t)c * CS_L; const size_t o0 = m0 * DM + gch;
            float rp = bflo((unsigned)rw[(0 * 33) * 64 + lane]), kp = bflo((unsigned)rw[(1 * 33) * 64 + lane]), vp = bflo((unsigned)rw[(2 * 33) * 64 + lane]);
            float cum = 0.f, gprev = 1.f;
            unsigned bcw[16], kcw[16], vcw[16];
#pragma unroll
            for (int grp = 0; grp < 4; ++grp) {
                float rlv[8], kkrv[8], kprv[8], vlv[8], aav[8], ddv[8], red[16];
#pragma unroll
                for (int e = 0; e < 8; ++e) { const int row = 1 + 8 * grp + e;
                    const float r0 = bflo((unsigned)rw[(0 * 33 + row) * 64 + lane]), k0 = bflo((unsigned)rw[(1 * 33 + row) * 64 + lane]), v0 = bflo((unsigned)rw[(2 * 33 + row) * 64 + lane]);
                    ddv[e] = bflo((unsigned)rw[(3 * 33 + row) * 64 + lane]); aav[e] = bflo((unsigned)rw[(4 * 33 + row) * 64 + lane]);
                    rlv[e] = r0 + (rp - r0) * mur; const float kl = k0 + (kp - k0) * muk; vlv[e] = v0 + (vp - v0) * muv; rp = r0; kp = k0; vp = v0;
                    kkrv[e] = kl * kkw; kprv[e] = kl * (1.0f + (aav[e] - 1.0f) * kaw);
                    red[2 * e] = kkrv[e] * kkrv[e]; red[2 * e + 1] = rlv[e] * kprv[e] * rkw; }
#pragma unroll
                for (int e = 0; e < 16; ++e) red[e] += dppf<0xB1, 0xf>(red[e]);
#pragma unroll
                for (int e = 0; e < 16; ++e) red[e] += dppf<0x4E, 0xf>(red[e]);
#pragma unroll
                for (int e = 0; e < 16; ++e) red[e] += dppf<0x141, 0xf>(red[e]);
#pragma unroll
                for (int e = 0; e < 16; ++e) red[e] += dppf<0x140, 0xf>(red[e]);
#pragma unroll
                for (int e = 0; e < 16; ++e) red[e] += dppf<0x142, 0xa>(red[e]);
#pragma unroll
                for (int e = 0; e < 16; ++e) red[e] += dppf<0x143, 0xc>(red[e]);
#pragma unroll
                for (int e = 0; e < 16; ++e) red[e] = __int_as_float(__builtin_amdgcn_readlane(__float_as_int(red[e]), 63));
                if (lane < 8) { float rkv = red[1];
#pragma unroll
                    for (int e = 1; e < 8; ++e) rkv = (lane == e) ? red[2 * e + 1] : rkv;
                    RK[(m0 + 8 * grp + lane) * 16 + h] = rkv; }
#pragma unroll
                for (int j2 = 0; j2 < 4; ++j2) {
                    const int i2 = 4 * grp + j2;
                    float nt[2], bt[2], kt[2], rt[2], vt[2];
#pragma unroll
                    for (int e = 0; e < 2; ++e) { const int te = 2 * j2 + e;
                        const float kkv = kkrv[te] * __builtin_amdgcn_rsqf(fmaxf(red[2 * te], 1e-24f)), bb = kkv * aav[te];
                        cum += ddv[te]; const float gi = __expf(-cum), ginv = __builtin_amdgcn_rcpf(gi);
                        nt[e] = -kkv * gprev; bt[e] = bb * ginv; kt[e] = kprv[te] * ginv; rt[e] = rlv[te] * gi; vt[e] = vlv[te]; gprev = gi; }
                    const unsigned wn = pk2(nt[0], nt[1]), wb = pk2(bt[0], bt[1]), wk = pk2(kt[0], kt[1]), wr = pk2(rt[0], rt[1]), wv = pk2(vt[0], vt[1]);
                    const int i = 2 * i2;
                    *(LAS unsigned short*)(sl + CS_NT + (i * 64 + kpos) * 2) = (unsigned short)wn; *(LAS unsigned short*)(sl + CS_NT + ((i + 1) * 64 + kpos) * 2) = (unsigned short)(wn >> 16);
                    *(LAS unsigned short*)(sl + CS_RT + (i * 64 + kpos) * 2) = (unsigned short)wr; *(LAS unsigned short*)(sl + CS_RT + ((i + 1) * 64 + kpos) * 2) = (unsigned short)(wr >> 16);
                    *(LAS unsigned short*)(sl + CS_BT + (i * 64 + kpos) * 2) = (unsigned short)wb; *(LAS unsigned short*)(sl + CS_BT + ((i + 1) * 64 + kpos) * 2) = (unsigned short)(wb >> 16);
                    *(LAS unsigned short*)(sl + CS_KT + (i * 64 + kpos) * 2) = (unsigned short)wk; *(LAS unsigned short*)(sl + CS_KT + ((i + 1) * 64 + kpos) * 2) = (unsigned short)(wk >> 16);
                    const int pw = permp(i) >> 1;
                    bcw[pw] = wb; kcw[pw] = wk; vcw[pw] = wv;
                }
                __builtin_amdgcn_sched_barrier(0);
            }
#pragma unroll
            for (int q4 = 0; q4 < 4; ++q4) {
                *(LAS u32x4*)(sl + CS_BC + lane * 64 + 16 * q4) = (u32x4){bcw[4 * q4], bcw[4 * q4 + 1], bcw[4 * q4 + 2], bcw[4 * q4 + 3]};
                *(LAS u32x4*)(sl + CS_KC + lane * 64 + 16 * q4) = (u32x4){kcw[4 * q4], kcw[4 * q4 + 1], kcw[4 * q4 + 2], kcw[4 * q4 + 3]};
                *(LAS u32x4*)(sl + CS_VC + lane * 64 + 16 * q4) = (u32x4){vcw[4 * q4], vcw[4 * q4 + 1], vcw[4 * q4 + 2], vcw[4 * q4 + 3]}; }
            *(LAS float*)(sl + CS_GL + lane * 4) = gprev;
            LDS_WAIT();
            if (lane == 0) __hip_atomic_store(rawfree + s, use + 1u, __ATOMIC_RELAXED, __HIP_MEMORY_SCOPE_WORKGROUP);
            PROBE_END(11, a.ws, wave);
            PROBE_BEGIN(12, a.ws, wave);
            const int tok = lane & 31, hf = lane >> 5;
            bf16x8 fn[4], fr[4], fb[4], fk[4];
#pragma unroll
            for (int ks = 0; ks < 4; ++ks) { fn[ks] = *(const LAS bf16x8*)(sl + CS_NT + (tok * 64 + 16 * ks + 8 * hf) * 2); fr[ks] = *(const LAS bf16x8*)(sl + CS_RT + (tok * 64 + 16 * ks + 8 * hf) * 2);
                fb[ks] = *(const LAS bf16x8*)(sl + CS_BT + (tok * 64 + 16 * ks + 8 * hf) * 2); fk[ks] = *(const LAS bf16x8*)(sl + CS_KT + (tok * 64 + 16 * ks + 8 * hf) * 2); }
            f32x16 P, Pt, Tm, Akn, Abr, Akr;
#pragma unroll
            for (int e = 0; e < 16; ++e) { P[e] = 0.f; Pt[e] = 0.f; Akn[e] = 0.f; Abr[e] = 0.f; Akr[e] = 0.f; }
#pragma unroll
            for (int ks = 0; ks < 4; ++ks) { P = __builtin_amdgcn_mfma_f32_32x32x16_bf16(fn[ks], fb[ks], P, 0, 0, 0); Pt = __builtin_amdgcn_mfma_f32_32x32x16_bf16(fb[ks], fn[ks], Pt, 0, 0, 0);
                Akn = __builtin_amdgcn_mfma_f32_32x32x16_bf16(fn[ks], fk[ks], Akn, 0, 0, 0); Abr = __builtin_amdgcn_mfma_f32_32x32x16_bf16(fr[ks], fb[ks], Abr, 0, 0, 0); Akr = __builtin_amdgcn_mfma_f32_32x32x16_bf16(fr[ks], fk[ks], Akr, 0, 0, 0); }
#pragma unroll
            for (int e = 0; e < 16; ++e) { const int row = (e & 3) + 8 * (e >> 2) + 4 * hf, col = tok;
                if (!(col < row)) { P[e] = 0.f; Akn[e] = 0.f; } if (!(row < col)) Pt[e] = 0.f; if (col > row) { Abr[e] = 0.f; Akr[e] = 0.f; }
                Tm[e] = P[e] + (row == col ? 1.0f : 0.f); }
#pragma unroll
            for (int mm = 1; mm <= 4; ++mm) {
                const bf16x8 p0 = cfrag(P, 0), p1 = cfrag(P, 1), q0 = cfrag(Pt, 0), q1 = cfrag(Pt, 1);
                f32x16 Ptn, Pn;
#pragma unroll
                for (int e = 0; e < 16; ++e) { Ptn[e] = 0.f; Pn[e] = 0.f; }
                Ptn = __builtin_amdgcn_mfma_f32_32x32x16_bf16(p0, q0, Ptn, 0, 0, 0); Ptn = __builtin_amdgcn_mfma_f32_32x32x16_bf16(p1, q1, Ptn, 0, 0, 0);
                if (mm < 4) { Pn = __builtin_amdgcn_mfma_f32_32x32x16_bf16(q0, p0, Pn, 0, 0, 0); Pn = __builtin_amdgcn_mfma_f32_32x32x16_bf16(q1, p1, Pn, 0, 0, 0); }
                const bf16x8 t0 = cfrag(Tm, 0), t1 = cfrag(Tm, 1), u0 = cfrag(Ptn, 0), u1 = cfrag(Ptn, 1);
                Tm = __builtin_amdgcn_mfma_f32_32x32x16_bf16(u0, t0, Tm, 0, 0, 0); Tm = __builtin_amdgcn_mfma_f32_32x32x16_bf16(u1, t1, Tm, 0, 0, 0);
                P = Pn; Pt = Ptn;
            }
            { const int pc = permp(tok);
#pragma unroll
              for (int e = 0; e < 16; e += 2) { const int row = (e & 3) + 8 * (e >> 2) + 4 * hf;
                const unsigned w0 = pk2(Tm[e], Tm[e + 1]), w1 = pk2(Akn[e], Akn[e + 1]), w2 = pk2(Abr[e], Abr[e + 1]), w3 = pk2(Akr[e], Akr[e + 1]);
                *(LAS unsigned short*)(sl + CS_TM + (row * 32 + pc) * 2) = (unsigned short)w0; *(LAS unsigned short*)(sl + CS_TM + ((row + 1) * 32 + pc) * 2) = (unsigned short)(w0 >> 16);
                *(LAS unsigned short*)(sl + CS_AKN + (row * 32 + pc) * 2) = (unsigned short)w1; *(LAS unsigned short*)(sl + CS_AKN + ((row + 1) * 32 + pc) * 2) = (unsigned short)(w1 >> 16);
                *(LAS unsigned short*)(sl + CS_ABR + (row * 32 + pc) * 2) = (unsigned short)w2; *(LAS unsigned short*)(sl + CS_ABR + ((row + 1) * 32 + pc) * 2) = (unsigned short)(w2 >> 16);
                *(LAS unsigned short*)(sl + CS_AKR + (row * 32 + pc) * 2) = (unsigned short)w3; *(LAS unsigned short*)(sl + CS_AKR + ((row + 1) * 32 + pc) * 2) = (unsigned short)(w3 >> 16); } }
            LDS_WAIT();
            if (lane == 0) __hip_atomic_store(ready + s, (unsigned)(c + 1), __ATOMIC_RELAXED, __HIP_MEMORY_SCOPE_WORKGROUP);
            PROBE_END(12, a.ws, wave);
        }
    } else {
        const int l15 = lane & 15, g = lane >> 4, vb = wave;
        f32x4 xc[4];
#pragma unroll
        for (int kt = 0; kt < 4; ++kt) xc[kt] = (f32x4){0.f, 0.f, 0.f, 0.f};
        for (int c = 0; c < CS_NCH; ++c) {
            const int s = c % CS_NSLOT; const LAS unsigned char* sl = lds + s * CS_SLOT;
            lds_poll_ge(ready + s, (unsigned)(c + 1));
            const bf16x8 xb0 = cfrag2(xc[0], xc[1]), xb1 = cfrag2(xc[2], xc[3]);
            const bf16x8 vop = *(const LAS bf16x8*)(sl + CS_VC + ((16 * vb + l15) * 32 + 8 * g) * 2);
            f32x4 W[2], U[2], Y[2];
#pragma unroll
            for (int rt = 0; rt < 2; ++rt) { const int row = 16 * rt + l15; f32x4 acc = (f32x4){0.f, 0.f, 0.f, 0.f};
                acc = __builtin_amdgcn_mfma_f32_16x16x32_bf16(*(const LAS bf16x8*)(sl + CS_AKN + (row * 32 + 8 * g) * 2), vop, acc, 0, 0, 0);
                acc = __builtin_amdgcn_mfma_f32_16x16x32_bf16(*(const LAS bf16x8*)(sl + CS_NT + (row * 64 + 8 * g) * 2), xb0, acc, 0, 0, 0);
                acc = __builtin_amdgcn_mfma_f32_16x16x32_bf16(*(const LAS bf16x8*)(sl + CS_NT + (row * 64 + 32 + 8 * g) * 2), xb1, acc, 0, 0, 0);
                W[rt] = acc; }
            const bf16x8 wb = cfrag2(W[0], W[1]);
#pragma unroll
            for (int rt = 0; rt < 2; ++rt) { const int row = 16 * rt + l15;
                U[rt] = __builtin_amdgcn_mfma_f32_16x16x32_bf16(*(const LAS bf16x8*)(sl + CS_TM + (row * 32 + 8 * g) * 2), wb, (f32x4){0.f, 0.f, 0.f, 0.f}, 0, 0, 0); }
            const bf16x8 ub = cfrag2(U[0], U[1]);
#pragma unroll
            for (int rt = 0; rt < 2; ++rt) { const int row = 16 * rt + l15; f32x4 acc = (f32x4){0.f, 0.f, 0.f, 0.f};
                acc = __builtin_amdgcn_mfma_f32_16x16x32_bf16(*(const LAS bf16x8*)(sl + CS_AKR + (row * 32 + 8 * g) * 2), vop, acc, 0, 0, 0);
                acc = __builtin_amdgcn_mfma_f32_16x16x32_bf16(*(const LAS bf16x8*)(sl + CS_RT + (row * 64 + 8 * g) * 2), xb0, acc, 0, 0, 0);
                acc = __builtin_amdgcn_mfma_f32_16x16x32_bf16(*(const LAS bf16x8*)(sl + CS_RT + (row * 64 + 32 + 8 * g) * 2), xb1, acc, 0, 0, 0);
                acc = __builtin_amdgcn_mfma_f32_16x16x32_bf16(*(const LAS bf16x8*)(sl + CS_ABR + (row * 32 + 8 * g) * 2), ub, acc, 0, 0, 0);
                Y[rt] = acc; }
#pragma unroll
            for (int kt = 0; kt < 4; ++kt) { const int row = 16 * kt + l15; f32x4 acc = xc[kt];
                acc = __builtin_amdgcn_mfma_f32_16x16x32_bf16(*(const LAS bf16x8*)(sl + CS_KC + (row * 32 + 8 * g) * 2), vop, acc, 0, 0, 0);
                acc = __builtin_amdgcn_mfma_f32_16x16x32_bf16(*(const LAS bf16x8*)(sl + CS_BC + (row * 32 + 8 * g) * 2), ub, acc, 0, 0, 0);
                xc[kt] = acc * *(const LAS f32x4*)(sl + CS_GL + (16 * kt + 4 * g) * 4); }
            LDS_WAIT();
            if (lane == 0) (void)__hip_atomic_fetch_add(done + s, 1u, __ATOMIC_RELAXED, __HIP_MEMORY_SCOPE_WORKGROUP);
#pragma unroll
            for (int rt = 0; rt < 2; ++rt)
#pragma unroll
                for (int e = 0; e < 4; ++e) { const size_t m = (size_t)b * SEQ + (size_t)c * CS_L + 16 * rt + 4 * g + e;
                    YAB[m * 2048 + 1024 + h * 64 + 16 * vb + l15] = (bf16_t)(pk2(Y[rt][e], 0.f) & 0xffffu); }
        }
    }
}

constexpr int CR_PIECE = 12, CR_NP = (CS_NCH + CR_PIECE - 1) / CR_PIECE, CR_PW = 4, CR_PSLOT = CS_SLOT + 2 * 33 * 128;
constexpr int CR_RING = 4, CR_FLAGS = LDS_BYTES - 128;
constexpr size_t DO_IMG = 66 * MiB;
static_assert(DO_IMG + (size_t)2 * 64 * CR_PIECE * CS_SLOT <= 128 * MiB && CR_PW * CR_PSLOT <= CR_FLAGS && CR_RING * CS_SLOT + CR_PSLOT <= CR_FLAGS, "image buffer / producer slots");

__device__ __forceinline__ void cscan_rope(const Args& a, const int wave, const int piece, const int first, const int nblk) {
    const int lane = lane_id(); const int iw = ((int)blockIdx.x - first) * (NWAVES - CR_PW) + (wave - CR_PW), niw = nblk * (NWAVES - CR_PW);
    const int per = (MTOK + CR_NP * niw - 1) / (CR_NP * niw);
    for (int t = piece * per * niw + iw; t < (piece + 1) * per * niw && t < MTOK; t += niw) rope_item(a, t, lane);
}
__device__ __forceinline__ void cscan_produce(const Args& a, LAS unsigned char* sl, const int piece, const int pidx, const int ptot) {
    const int nch = (CS_NCH - piece * CR_PIECE) < CR_PIECE ? (CS_NCH - piece * CR_PIECE) : CR_PIECE;
    const bf16_t* Rg = (const bf16_t*)(a.ws + WS_R); const bf16_t* Kg = (const bf16_t*)(a.ws + WS_K); const bf16_t* Vg = (const bf16_t*)(a.ws + WS_V);
    const bf16_t* Dg = (const bf16_t*)(a.ws + WS_DARR); const bf16_t* Ag = (const bf16_t*)(a.ws + WS_AARR);
    float* RK = (float*)((unsigned char*)a.out + DO_RK); unsigned char* IMG = (unsigned char*)a.out + DO_IMG + (size_t)(piece & 1) * 64 * CR_PIECE * CS_SLOT;
    const LAS unsigned short* rawD = (const LAS unsigned short*)(sl + 16384); const LAS unsigned short* rawA = (const LAS unsigned short*)(sl + 20480);
    const LAS unsigned short* rawR = (const LAS unsigned short*)(sl + 24576); const LAS unsigned short* rawK = (const LAS unsigned short*)(sl + CS_SLOT); const LAS unsigned short* rawV = (const LAS unsigned short*)(sl + CS_SLOT + 33 * 128);
    u32x4 pre[5][4], prep[3];
    auto issue = [&](int it2, int rr, int c8, int lane) { const int bh2 = it2 / nch, cc2 = it2 % nch, c2 = piece * CR_PIECE + cc2; const unsigned mm = (unsigned)(bh2 >> 4) * SEQ + (unsigned)c2 * CS_L; const int hh = bh2 & 15;
        const unsigned eoff = ((mm + rr) * DM + hh * 64 + 8 * c8) * 2u;
        const unsigned char* wsb = a.ws;
#pragma unroll
        for (int ar = 0; ar < 5; ++ar) { constexpr size_t AOFF[5] = {WS_R, WS_K, WS_V, WS_DARR, WS_AARR};
#pragma unroll
            for (int q4 = 0; q4 < 4; ++q4) pre[ar][q4] = *(const u32x4*)(wsb + AOFF[ar] + eoff + (unsigned)(8 * q4 * DM * 2)); }
        const bool hasp = (c2 > 0) && (lane < 8); const unsigned poff = hasp ? (eoff - (unsigned)((rr + 1) * DM * 2)) : eoff;
#pragma unroll
        for (int ar = 0; ar < 3; ++ar) { constexpr size_t AOFF[3] = {WS_R, WS_K, WS_V}; const u32x4 t = *(const u32x4*)(wsb + AOFF[ar] + poff); prep[ar] = hasp ? t : (u32x4){0u, 0u, 0u, 0u}; } };
    const int it0 = pidx, nimg = 64 * nch, itstep = ptot;
    { const int l0 = lane_id(); if (it0 < nimg) issue(it0, l0 >> 3, l0 & 7, l0); }
    for (int it = it0; it < nimg; it += itstep) {
        const int lane = lane_id(), rr = lane >> 3, c8 = lane & 7, kpos = 32 * (lane >> 5) + permp(lane & 31);
        const int bh = it / nch, cc = it % nch, b = bh >> 4, h = bh & 15, c = piece * CR_PIECE + cc, gch = h * 64 + lane;
        const float mur = a.mu_rkv[gch], muk = a.mu_rkv[DM + gch], muv = a.mu_rkv[2 * DM + gch], kkw = a.rwkv_vec[2 * DM + gch], kaw = a.rwkv_vec[3 * DM + gch], rkw = a.r_k[gch];
            const size_t m0 = (size_t)b * SEQ + (size_t)c * CS_L;
            { LAS unsigned char* wb = sl + rr * 128 + 16 * c8; asm volatile("" : "+v"(wb));
#pragma unroll
              for (int q4 = 0; q4 < 4; ++q4) {
                *(LAS u32x4*)(wb + 24576 + (8 * q4 + 1) * 128) = pre[0][q4]; *(LAS u32x4*)(wb + CS_SLOT + (8 * q4 + 1) * 128) = pre[1][q4]; *(LAS u32x4*)(wb + CS_SLOT + 33 * 128 + (8 * q4 + 1) * 128) = pre[2][q4];
                *(LAS u32x4*)(wb + 16384 + (8 * q4) * 128) = pre[3][q4]; *(LAS u32x4*)(wb + 20480 + (8 * q4) * 128) = pre[4][q4]; }
              if (lane < 8) { *(LAS u32x4*)(wb + 24576) = prep[0]; *(LAS u32x4*)(wb + CS_SLOT) = prep[1]; *(LAS u32x4*)(wb + CS_SLOT + 33 * 128) = prep[2]; } }
            LDS_WAIT();
            const LAS unsigned short* rb = (const LAS unsigned short*)sl + lane; asm volatile("" : "+v"(rb));
            float rp = bflo((unsigned)rb[24576 / 2]), kp = bflo((unsigned)rb[CS_SLOT / 2]), vp = bflo((unsigned)rb[(CS_SLOT + 33 * 128) / 2]);
            float cum = 0.f, gprev = 1.f;
            unsigned bcw[16], kcw[16], vcw[16];
#pragma unroll
            for (int grp = 0; grp < 4; ++grp) {
                float rlv[8], kkrv[8], kprv[8], vlv[8], aav[8], ddv[8], red[16];
#pragma unroll
                for (int e = 0; e < 8; ++e) { const int row = 8 * grp + e;
                    const float r0 = bflo((unsigned)rb[24576 / 2 + (row + 1) * 64]), k0 = bflo((unsigned)rb[CS_SLOT / 2 + (row + 1) * 64]), v0 = bflo((unsigned)rb[(CS_SLOT + 33 * 128) / 2 + (row + 1) * 64]);
                    ddv[e] = bflo((unsigned)rb[16384 / 2 + row * 64]); aav[e] = bflo((unsigned)rb[20480 / 2 + row * 64]);
                    rlv[e] = r0 + (rp - r0) * mur; const float kl = k0 + (kp - k0) * muk; vlv[e] = v0 + (vp - v0) * muv; rp = r0; kp = k0; vp = v0;
                    kkrv[e] = kl * kkw; kprv[e] = kl * (1.0f + (aav[e] - 1.0f) * kaw);
                    red[2 * e] = kkrv[e] * kkrv[e]; red[2 * e + 1] = rlv[e] * kprv[e] * rkw; }
#pragma unroll
                for (int e = 0; e < 16; ++e) red[e] += dppf<0xB1, 0xf>(red[e]);
#pragma unroll
                for (int e = 0; e < 16; ++e) red[e] += dppf<0x4E, 0xf>(red[e]);
#pragma unroll
                for (int e = 0; e < 16; ++e) red[e] += dppf<0x141, 0xf>(red[e]);
#pragma unroll
                for (int e = 0; e < 16; ++e) red[e] += dppf<0x140, 0xf>(red[e]);
#pragma unroll
                for (int e = 0; e < 16; ++e) red[e] += dppf<0x142, 0xa>(red[e]);
#pragma unroll
                for (int e = 0; e < 16; ++e) red[e] += dppf<0x143, 0xc>(red[e]);
#pragma unroll
                for (int e = 0; e < 16; ++e) red[e] = __int_as_float(__builtin_amdgcn_readlane(__float_as_int(red[e]), 63));
                if (lane < 8) { float rkv = red[1];
#pragma unroll
                    for (int e = 1; e < 8; ++e) rkv = (lane == e) ? red[2 * e + 1] : rkv;
                    RK[(m0 + 8 * grp + lane) * 16 + h] = rkv; }
#pragma unroll
                for (int j2 = 0; j2 < 4; ++j2) {
                    const int i2 = 4 * grp + j2;
                    float nt[2], bt[2], kt[2], rt[2], vt[2];
#pragma unroll
                    for (int e = 0; e < 2; ++e) { const int te = 2 * j2 + e;
                        const float kkv = kkrv[te] * __builtin_amdgcn_rsqf(fmaxf(red[2 * te], 1e-24f)), bb = kkv * aav[te];
                        cum += ddv[te]; const float gi = __expf(-cum), ginv = __builtin_amdgcn_rcpf(gi);
                        nt[e] = -kkv * gprev; bt[e] = bb * ginv; kt[e] = kprv[te] * ginv; rt[e] = rlv[te] * gi; vt[e] = vlv[te]; gprev = gi; }
                    const unsigned wn = pk2(nt[0], nt[1]), wb = pk2(bt[0], bt[1]), wk = pk2(kt[0], kt[1]), wr = pk2(rt[0], rt[1]), wv = pk2(vt[0], vt[1]);
                    const int i = 2 * i2;
                    *(LAS unsigned short*)(sl + CS_NT + (i * 64 + kpos) * 2) = (unsigned short)wn; *(LAS unsigned short*)(sl + CS_NT + ((i + 1) * 64 + kpos) * 2) = (unsigned short)(wn >> 16);
                    *(LAS unsigned short*)(sl + CS_RT + (i * 64 + kpos) * 2) = (unsigned short)wr; *(LAS unsigned short*)(sl + CS_RT + ((i + 1) * 64 + kpos) * 2) = (unsigned short)(wr >> 16);
                    *(LAS unsigned short*)(sl + CS_BT + (i * 64 + kpos) * 2) = (unsigned short)wb; *(LAS unsigned short*)(sl + CS_BT + ((i + 1) * 64 + kpos) * 2) = (unsigned short)(wb >> 16);
                    *(LAS unsigned short*)(sl + CS_KT + (i * 64 + kpos) * 2) = (unsigned short)wk; *(LAS unsigned short*)(sl + CS_KT + ((i + 1) * 64 + kpos) * 2) = (unsigned short)(wk >> 16);
                    const int pw = permp(i) >> 1;
                    bcw[pw] = wb; kcw[pw] = wk; vcw[pw] = wv;
                }
                __builtin_amdgcn_sched_barrier(0);
            }
#pragma unroll
            for (int q4 = 0; q4 < 4; ++q4) {
                *(LAS u32x4*)(sl + CS_BC + lane * 64 + 16 * q4) = (u32x4){bcw[4 * q4], bcw[4 * q4 + 1], bcw[4 * q4 + 2], bcw[4 * q4 + 3]};
                *(LAS u32x4*)(sl + CS_KC + lane * 64 + 16 * q4) = (u32x4){kcw[4 * q4], kcw[4 * q4 + 1], kcw[4 * q4 + 2], kcw[4 * q4 + 3]};
                *(LAS u32x4*)(sl + CS_VC + lane * 64 + 16 * q4) = (u32x4){vcw[4 * q4], vcw[4 * q4 + 1], vcw[4 * q4 + 2], vcw[4 * q4 + 3]}; }
            *(LAS float*)(sl + CS_GL + lane * 4) = gprev;
            LDS_WAIT();
            const int tok = lane & 31, hf = lane >> 5;
            bf16x8 fn[4], fr[4], fb[4], fk[4];
#pragma unroll
            for (int ks = 0; ks < 4; ++ks) { fn[ks] = *(const LAS bf16x8*)(sl + CS_NT + (tok * 64 + 16 * ks + 8 * hf) * 2); fr[ks] = *(const LAS bf16x8*)(sl + CS_RT + (tok * 64 + 16 * ks + 8 * hf) * 2);
                fb[ks] = *(const LAS bf16x8*)(sl + CS_BT + (tok * 64 + 16 * ks + 8 * hf) * 2); fk[ks] = *(const LAS bf16x8*)(sl + CS_KT + (tok * 64 + 16 * ks + 8 * hf) * 2); }
            f32x16 P, Pt, Tm, Akn, Abr, Akr;
#pragma unroll
            for (int e = 0; e < 16; ++e) { P[e] = 0.f; Pt[e] = 0.f; Akn[e] = 0.f; Abr[e] = 0.f; Akr[e] = 0.f; }
#pragma unroll
            for (int ks = 0; ks < 4; ++ks) { P = __builtin_amdgcn_mfma_f32_32x32x16_bf16(fn[ks], fb[ks], P, 0, 0, 0); Pt = __builtin_amdgcn_mfma_f32_32x32x16_bf16(fb[ks], fn[ks], Pt, 0, 0, 0);
                Akn = __builtin_amdgcn_mfma_f32_32x32x16_bf16(fn[ks], fk[ks], Akn, 0, 0, 0); Abr = __builtin_amdgcn_mfma_f32_32x32x16_bf16(fr[ks], fb[ks], Abr, 0, 0, 0); Akr = __builtin_amdgcn_mfma_f32_32x32x16_bf16(fr[ks], fk[ks], Akr, 0, 0, 0); }
#pragma unroll
            for (int e = 0; e < 16; ++e) { const int row = (e & 3) + 8 * (e >> 2) + 4 * hf, col = tok;
                if (!(col < row)) { P[e] = 0.f; Akn[e] = 0.f; } if (!(row < col)) Pt[e] = 0.f; if (col > row) { Abr[e] = 0.f; Akr[e] = 0.f; }
                Tm[e] = P[e] + (row == col ? 1.0f : 0.f); }
#pragma unroll
            for (int mm = 1; mm <= 4; ++mm) {
                const bf16x8 p0 = cfrag(P, 0), p1 = cfrag(P, 1), q0 = cfrag(Pt, 0), q1 = cfrag(Pt, 1);
                f32x16 Ptn, Pn;
#pragma unroll
                for (int e = 0; e < 16; ++e) { Ptn[e] = 0.f; Pn[e] = 0.f; }
                Ptn = __builtin_amdgcn_mfma_f32_32x32x16_bf16(p0, q0, Ptn, 0, 0, 0); Ptn = __builtin_amdgcn_mfma_f32_32x32x16_bf16(p1, q1, Ptn, 0, 0, 0);
                if (mm < 4) { Pn = __builtin_amdgcn_mfma_f32_32x32x16_bf16(q0, p0, Pn, 0, 0, 0); Pn = __builtin_amdgcn_mfma_f32_32x32x16_bf16(q1, p1, Pn, 0, 0, 0); }
                const bf16x8 t0 = cfrag(Tm, 0), t1 = cfrag(Tm, 1), u0 = cfrag(Ptn, 0), u1 = cfrag(Ptn, 1);
                Tm = __builtin_amdgcn_mfma_f32_32x32x16_bf16(u0, t0, Tm, 0, 0, 0); Tm = __builtin_amdgcn_mfma_f32_32x32x16_bf16(u1, t1, Tm, 0, 0, 0);
                P = Pn; Pt = Ptn;
            }
            { const int itn = it + itstep; if (itn < nimg) { const int l2 = lane_id(); issue(itn, l2 >> 3, l2 & 7, l2); } }
            { const int pc = permp(tok);
#pragma unroll
              for (int e = 0; e < 16; e += 2) { const int row = (e & 3) + 8 * (e >> 2) + 4 * hf;
                const unsigned w0 = pk2(Tm[e], Tm[e + 1]), w1 = pk2(Akn[e], Akn[e + 1]), w2 = pk2(Abr[e], Abr[e + 1]), w3 = pk2(Akr[e], Akr[e + 1]);
                *(LAS unsigned short*)(sl + CS_TM + (row * 32 + pc) * 2) = (unsigned short)w0; *(LAS unsigned short*)(sl + CS_TM + ((row + 1) * 32 + pc) * 2) = (unsigned short)(w0 >> 16);
                *(LAS unsigned short*)(sl + CS_AKN + (row * 32 + pc) * 2) = (unsigned short)w1; *(LAS unsigned short*)(sl + CS_AKN + ((row + 1) * 32 + pc) * 2) = (unsigned short)(w1 >> 16);
                *(LAS unsigned short*)(sl + CS_ABR + (row * 32 + pc) * 2) = (unsigned short)w2; *(LAS unsigned short*)(sl + CS_ABR + ((row + 1) * 32 + pc) * 2) = (unsigned short)(w2 >> 16);
                *(LAS unsigned short*)(sl + CS_AKR + (row * 32 + pc) * 2) = (unsigned short)w3; *(LAS unsigned short*)(sl + CS_AKR + ((row + 1) * 32 + pc) * 2) = (unsigned short)(w3 >> 16); } }
            LDS_WAIT();
            { unsigned char* dst = IMG + (size_t)(bh * CR_PIECE + cc) * CS_SLOT;
#pragma unroll 1
              for (int j = lane; j < CS_SLOT / 16; j += 64) *(u32x4*)(dst + 16 * j) = *(const LAS u32x4*)(sl + 16 * j); }
            LDS_WAIT();
    }
}

__device__ __forceinline__ void cscan_consume(const Args& a, const int wave, LAS unsigned char* lds, const int bh, const int piece, f32x4 (&xc)[4], const bool nomath = false) {
    const int lane = lane_id();
    const int b = bh >> 4, h = bh & 15;
    bf16_t* YAB = (bf16_t*)(a.ws + WS_YAB); const unsigned char* IMG = (const unsigned char*)a.out + DO_IMG + (size_t)(piece & 1) * 64 * CR_PIECE * CS_SLOT;
    const int nch = (CS_NCH - piece * CR_PIECE) < CR_PIECE ? (CS_NCH - piece * CR_PIECE) : CR_PIECE;
    LAS unsigned* ready = (LAS unsigned*)(lds + CR_FLAGS); LAS unsigned* done = ready + 4;
    if (wave == 4 || wave >= 6) {
        constexpr int NI = (CS_SLOT + 1023) / 1024;
        const int lw = (wave == 4) ? 0 : wave - 5; LAS unsigned* rdy = (lw == 0) ? ready : done + 4 * lw;
        for (int cc = 0; cc < nch + 2; ++cc) {
            if (cc < nch) { const int c = piece * CR_PIECE + cc, s = c & 3; LAS unsigned char* sl = lds + s * CS_SLOT;
                const unsigned char* src = IMG + (size_t)(bh * CR_PIECE + cc) * CS_SLOT;
                if (c >= 4) lds_poll_ge(done + s, 4u * (unsigned)(c >> 2));
                if (lw == 0) {
#pragma unroll
                    for (int j = 0; j < 10; ++j) { const int idx = lane + 64 * j; __builtin_amdgcn_global_load_lds((const unsigned*)(src + 16 * idx), (LAS unsigned*)(sl + 1024 * j), 16, 0, 0); }
                } else if (lw == 1) {
#pragma unroll
                    for (int j = 10; j < 20; ++j) { const int idx = lane + 64 * j; __builtin_amdgcn_global_load_lds((const unsigned*)(src + 16 * idx), (LAS unsigned*)(sl + 1024 * j), 16, 0, 0); }
                } else {
#pragma unroll
                    for (int j = 20; j < NI; ++j) { const int idx = lane + 64 * j;
                        if (idx < CS_SLOT / 16) __builtin_amdgcn_global_load_lds((const unsigned*)(src + 16 * idx), (LAS unsigned*)(sl + 1024 * j), 16, 0, 0); } } }
            if (cc >= 2) {
                if (lw < 2) { if (cc < nch) asm volatile("s_waitcnt vmcnt(20)" ::: "memory"); else if (cc == nch) asm volatile("s_waitcnt vmcnt(10)" ::: "memory"); else asm volatile("s_waitcnt vmcnt(0)" ::: "memory"); }
                else { if (cc < nch) asm volatile("s_waitcnt vmcnt(18)" ::: "memory"); else if (cc == nch) asm volatile("s_waitcnt vmcnt(9)" ::: "memory"); else asm volatile("s_waitcnt vmcnt(0)" ::: "memory"); }
                if (lane == 0) __hip_atomic_store(rdy + ((piece * CR_PIECE + cc - 2) & 3), (unsigned)(piece * CR_PIECE + cc - 1), __ATOMIC_RELAXED, __HIP_MEMORY_SCOPE_WORKGROUP); }
        }
    } else if (wave < 4) {
        const int l15 = lane & 15, g = lane >> 4, vb = wave;
        for (int cc = 0; cc < nch; ++cc) { const int c = piece * CR_PIECE + cc, s = c & 3; const LAS unsigned char* sl = lds + s * CS_SLOT;
            { lds_poll_ge(ready + s, (unsigned)(c + 1)); lds_poll_ge(done + 4 + s, (unsigned)(c + 1)); lds_poll_ge(done + 8 + s, (unsigned)(c + 1)); }
#ifdef SCAN_SKIP
            if ((SCAN_SKIP & 4) && nomath) { if (lane == 0) (void)__hip_atomic_fetch_add(done + s, 1u, __ATOMIC_RELAXED, __HIP_MEMORY_SCOPE_WORKGROUP); continue; }
#endif
            const bf16x8 vop = *(const LAS bf16x8*)(sl + CS_VC + ((16 * vb + l15) * 32 + 8 * g) * 2);
            bf16x8 oAKN[2], oNT[2][2], oTM[2], oAKR[2], oRT[2][2], oABR[2], oKC[4], oBC[4]; f32x4 oGL[4];
#pragma unroll
            for (int rt = 0; rt < 2; ++rt) { const int row = 16 * rt + l15;
                oAKN[rt] = *(const LAS bf16x8*)(sl + CS_AKN + (row * 32 + 8 * g) * 2); oNT[rt][0] = *(const LAS bf16x8*)(sl + CS_NT + (row * 64 + 8 * g) * 2); oNT[rt][1] = *(const LAS bf16x8*)(sl + CS_NT + (row * 64 + 32 + 8 * g) * 2);
                oTM[rt] = *(const LAS bf16x8*)(sl + CS_TM + (row * 32 + 8 * g) * 2); oAKR[rt] = *(const LAS bf16x8*)(sl + CS_AKR + (row * 32 + 8 * g) * 2);
                oRT[rt][0] = *(const LAS bf16x8*)(sl + CS_RT + (row * 64 + 8 * g) * 2); oRT[rt][1] = *(const LAS bf16x8*)(sl + CS_RT + (row * 64 + 32 + 8 * g) * 2); oABR[rt] = *(const LAS bf16x8*)(sl + CS_ABR + (row * 32 + 8 * g) * 2); }
#pragma unroll
            for (int kt = 0; kt < 4; ++kt) { const int row = 16 * kt + l15;
                oKC[kt] = *(const LAS bf16x8*)(sl + CS_KC + (row * 32 + 8 * g) * 2); oBC[kt] = *(const LAS bf16x8*)(sl + CS_BC + (row * 32 + 8 * g) * 2); oGL[kt] = *(const LAS f32x4*)(sl + CS_GL + (16 * kt + 4 * g) * 4); }
            __builtin_amdgcn_sched_barrier(0);
            const bf16x8 xb0 = cfrag2(xc[0], xc[1]), xb1 = cfrag2(xc[2], xc[3]);
            f32x4 W[2], U[2], Y[2];
#pragma unroll
            for (int rt = 0; rt < 2; ++rt) { f32x4 acc = (f32x4){0.f, 0.f, 0.f, 0.f};
                acc = __builtin_amdgcn_mfma_f32_16x16x32_bf16(oAKN[rt], vop, acc, 0, 0, 0);
                acc = __builtin_amdgcn_mfma_f32_16x16x32_bf16(oNT[rt][0], xb0, acc, 0, 0, 0);
                acc = __builtin_amdgcn_mfma_f32_16x16x32_bf16(oNT[rt][1], xb1, acc, 0, 0, 0);
                W[rt] = acc; }
            const bf16x8 wb = cfrag2(W[0], W[1]);
#pragma unroll
            for (int rt = 0; rt < 2; ++rt) U[rt] = __builtin_amdgcn_mfma_f32_16x16x32_bf16(oTM[rt], wb, (f32x4){0.f, 0.f, 0.f, 0.f}, 0, 0, 0);
            const bf16x8 ub = cfrag2(U[0], U[1]);
#pragma unroll
            for (int rt = 0; rt < 2; ++rt) { f32x4 acc = (f32x4){0.f, 0.f, 0.f, 0.f};
                acc = __builtin_amdgcn_mfma_f32_16x16x32_bf16(oAKR[rt], vop, acc, 0, 0, 0);
                acc = __builtin_amdgcn_mfma_f32_16x16x32_bf16(oRT[rt][0], xb0, acc, 0, 0, 0);
                acc = __builtin_amdgcn_mfma_f32_16x16x32_bf16(oRT[rt][1], xb1, acc, 0, 0, 0);
                acc = __builtin_amdgcn_mfma_f32_16x16x32_bf16(oABR[rt], ub, acc, 0, 0, 0);
                Y[rt] = acc; }
#pragma unroll
            for (int kt = 0; kt < 4; ++kt) { f32x4 acc = xc[kt];
                acc = __builtin_amdgcn_mfma_f32_16x16x32_bf16(oKC[kt], vop, acc, 0, 0, 0);
                acc = __builtin_amdgcn_mfma_f32_16x16x32_bf16(oBC[kt], ub, acc, 0, 0, 0);
                xc[kt] = acc * oGL[kt]; }
            LDS_WAIT();
            if (lane == 0) (void)__hip_atomic_fetch_add(done + s, 1u, __ATOMIC_RELAXED, __HIP_MEMORY_SCOPE_WORKGROUP);
#pragma unroll
            for (int rt = 0; rt < 2; ++rt)
#pragma unroll
                for (int e = 0; e < 4; ++e) { const size_t m = (size_t)b * SEQ + (size_t)c * CS_L + 16 * rt + 4 * g + e;
                    YAB[m * 2048 + 1024 + h * 64 + 16 * vb + l15] = (bf16_t)(pk2(Y[rt][e], 0.f) & 0xffffu); }
        }
    }
}

constexpr int DS_NQ = 16, DS_CAP = 2048, DS_TRIG = 1536, DS_TOPK = 256;
constexpr int DS_HIST_WORDS = 320;
constexpr int DS_KT_BYTES = 2048;
constexpr int DS_CAND_OFF = 0, DS_HIST_OFF = DS_NQ * DS_CAP * 4, DS_KT_OFF = DS_HIST_OFF, DS_CNT_OFF = DS_HIST_OFF + 8 * DS_KT_BYTES, DS_TAU_OFF = DS_CNT_OFF + 64;
static_assert(8 * DS_HIST_WORDS * 4 <= 8 * DS_KT_BYTES, "dsa LDS map");
static_assert(DS_TAU_OFF + 64 <= LDS_BYTES, "dsa LDS map");

template <int CTRL, int RM> __device__ __forceinline__ unsigned dppu(unsigned x) { return (unsigned)__builtin_amdgcn_update_dpp(0, (int)x, CTRL, RM, 0xf, true); }
__device__ __forceinline__ unsigned wave_scan_incl(unsigned v) {
    v += dppu<0x111, 0xf>(v); v += dppu<0x112, 0xf>(v); v += dppu<0x114, 0xf>(v); v += dppu<0x118, 0xf>(v);
    v += dppu<0x142, 0xa>(v);
    v += dppu<0x143, 0xc>(v);
    return v; }
template <int NE>
__device__ __forceinline__ void select_compact(LAS unsigned* cq, LAS unsigned* cntq, LAS unsigned* tauq, LAS unsigned* hist, int lane) {
    const unsigned n = *cntq;
    unsigned e[NE];
#pragma unroll
    for (int j = 0; j < NE; ++j) { const unsigned idx = lane + 64 * j; e[j] = idx < n ? cq[idx] : 0u; }
    unsigned npos = 0u;
#pragma unroll
    for (int j = 0; j < NE; ++j) npos += (unsigned)__popcll(__ballot(e[j] >= 0x80000000u));
    if (npos >= (unsigned)DS_TOPK) {
#pragma unroll
        for (int j = 0; j < NE; ++j) e[j] = (e[j] >= 0x80000000u) ? e[j] : 0u; }
    unsigned va = 0xFFFFFFFFu, vo = 0u;
#pragma unroll
    for (int j = 0; j < NE; ++j) { va &= (e[j] != 0u) ? e[j] : 0xFFFFFFFFu; vo |= e[j]; }
    va &= (unsigned)__builtin_amdgcn_update_dpp(-1, (int)va, 0xB1, 0xf, 0xf, true); va &= (unsigned)__builtin_amdgcn_update_dpp(-1, (int)va, 0x4E, 0xf, 0xf, true);
    va &= (unsigned)__builtin_amdgcn_update_dpp(-1, (int)va, 0x141, 0xf, 0xf, true); va &= (unsigned)__builtin_amdgcn_update_dpp(-1, (int)va, 0x140, 0xf, 0xf, true);
    vo |= dppu<0xB1, 0xf>(vo); vo |= dppu<0x4E, 0xf>(vo); vo |= dppu<0x141, 0xf>(vo); vo |= dppu<0x140, 0xf>(vo);
    const unsigned vas = (unsigned)(__builtin_amdgcn_readlane((int)va, 0) & __builtin_amdgcn_readlane((int)va, 16) & __builtin_amdgcn_readlane((int)va, 32) & __builtin_amdgcn_readlane((int)va, 48));
    const unsigned vos = (unsigned)(__builtin_amdgcn_readlane((int)vo, 0) | __builtin_amdgcn_readlane((int)vo, 16) | __builtin_amdgcn_readlane((int)vo, 32) | __builtin_amdgcn_readlane((int)vo, 48));
    const unsigned diff = vas ^ vos;
    const int top = diff ? 31 - __builtin_clz(diff) : 7;
    unsigned prefix = (top >= 31) ? 0u : (vos & ~((2u << top) - 1u)), mask = (top >= 31) ? 0u : ~((2u << top) - 1u), need = DS_TOPK;
    int hi = top;
    const int rl = 63 - lane;
#pragma unroll 1
    for (int pass = 0; pass < 4 && hi >= 0; ++pass) {
        const int shift = hi >= 7 ? hi - 7 : 0; const unsigned dmask = (hi >= 7) ? 0xFFu : ((2u << hi) - 1u);
        *(LAS u32x4*)(hist + 4 * lane) = (u32x4){0u, 0u, 0u, 0u};
        LDS_WAIT();
#pragma unroll
        for (int j = 0; j < NE; ++j) { const bool hit = (e[j] != 0u) && ((e[j] & mask) == prefix); const unsigned bin = hit ? ((e[j] >> shift) & dmask) : (256u + (unsigned)lane);
            (void)__hip_atomic_fetch_add(hist + bin, 1u, __ATOMIC_RELAXED, __HIP_MEMORY_SCOPE_WORKGROUP); }
        LDS_WAIT();
        const u32x4 h4 = *(const LAS u32x4*)(hist + 4 * rl);
        const unsigned tot = (h4.x + h4.y) + (h4.z + h4.w);
        const unsigned v = wave_scan_incl(tot);
        const unsigned above = v - tot;
        const bool is = (above < need) && (need <= v);
        unsigned B = 0u, ca = 0u, hb = 0u;
        if (is) { unsigned c = above;
            if (c + h4.w >= need) { B = 4 * rl + 3; ca = c; hb = h4.w; } else { c += h4.w;
            if (c + h4.z >= need) { B = 4 * rl + 2; ca = c; hb = h4.z; } else { c += h4.z;
            if (c + h4.y >= need) { B = 4 * rl + 1; ca = c; hb = h4.y; } else { c += h4.y; B = 4 * rl; ca = c; hb = h4.x; } } } }
        const unsigned long long bal = __ballot(is);
        if (bal == 0ull) break;
        const int src = __builtin_amdgcn_readfirstlane(__ffsll((long long)bal) - 1);
        B = (unsigned)__builtin_amdgcn_readlane((int)B, src); ca = (unsigned)__builtin_amdgcn_readlane((int)ca, src); hb = (unsigned)__builtin_amdgcn_readlane((int)hb, src);
        need -= ca; prefix |= B << shift; mask |= dmask << shift; hi = shift - 1;
        if (hb == need) break;
    }
    const unsigned T = prefix;
    unsigned base = 0u;
#pragma unroll
    for (int j = 0; j < NE; ++j) { const bool keep = (e[j] >= T) && (e[j] != 0u); const unsigned long long bal = __ballot(keep);
        const unsigned pos = base + __builtin_amdgcn_mbcnt_hi((unsigned)(bal >> 32), __builtin_amdgcn_mbcnt_lo((unsigned)bal, 0u));
        if (keep) cq[pos] = e[j];
        base += (unsigned)__popcll(bal); }
    if (lane == 0) { *cntq = base; *tauq = T; }
    LDS_WAIT();
}

template <int NE>
__device__ __forceinline__ void filter_compact(LAS unsigned* cq, LAS unsigned* cntq, LAS unsigned* tauq, int lane) {
    const unsigned n = *cntq;
    unsigned e[NE];
#pragma unroll
    for (int j = 0; j < NE; ++j) { const unsigned idx = lane + 64 * j; e[j] = idx < n ? cq[idx] : 0u; }
    unsigned m0 = 0u, m1 = 0u, m2 = 0u, m3 = 0u;
#pragma unroll
    for (int j = 0; j < NE; ++j) { unsigned x = e[j], t;
        t = max(m0, x); x = min(m0, x); m0 = t; t = max(m1, x); x = min(m1, x); m1 = t; t = max(m2, x); x = min(m2, x); m2 = t; m3 = max(m3, x); }
    unsigned T = m3;
    T = min(T, (unsigned)__builtin_amdgcn_update_dpp(-1, (int)T, 0xB1, 0xf, 0xf, true)); T = min(T, (unsigned)__builtin_amdgcn_update_dpp(-1, (int)T, 0x4E, 0xf, 0xf, true));
    T = min(T, (unsigned)__builtin_amdgcn_update_dpp(-1, (int)T, 0x141, 0xf, 0xf, true)); T = min(T, (unsigned)__builtin_amdgcn_update_dpp(-1, (int)T, 0x140, 0xf, 0xf, true));
    T = min(min((unsigned)__builtin_amdgcn_readlane((int)T, 0), (unsigned)__builtin_amdgcn_readlane((int)T, 16)), min((unsigned)__builtin_amdgcn_readlane((int)T, 32), (unsigned)__builtin_amdgcn_readlane((int)T, 48)));
    unsigned base = 0u;
#pragma unroll
    for (int j = 0; j < NE; ++j) { const bool keep = (e[j] >= T) && (e[j] != 0u); const unsigned long long bal = __ballot(keep);
        const unsigned pos = base + __builtin_amdgcn_mbcnt_hi((unsigned)(bal >> 32), __builtin_amdgcn_mbcnt_lo((unsigned)bal, 0u));
        if (keep) cq[pos] = e[j];
        base += (unsigned)__popcll(bal); }
    if (lane == 0) { *cntq = base; *tauq = (T > 0u) ? T - 1u : 0u; }
    LDS_WAIT();
}

__device__ __forceinline__ float relu_(float x) { return __int_as_float(max(__float_as_int(x), 0)); }
__device__ __forceinline__ unsigned vrow_off(int pr) { return (unsigned)(pr < 28 ? 1024 + 256 * pr : 9216 + 256 * (pr - 28)); }
__device__ __forceinline__ unsigned swz_b(int row) { return (unsigned)(((row & 3) << 2) | ((row >> 2) & 3)); }

__device__ __forceinline__ void dsa_phase(const Args& a, const int wave, LAS unsigned char* lds, const bool dry = false) {
    const bf16_t* Qg = (const bf16_t*)(a.ws + WS_Q); const bf16_t* KVg = (const bf16_t*)(a.ws + WS_KV); const bf16_t* QIg = (const bf16_t*)(a.ws + WS_QI);
    const bf16_t* KIg = (const bf16_t*)(a.ws + WS_KI); const float* WIg = (const float*)(a.ws + WS_WI); bf16_t* Gg = (bf16_t*)(a.ws + WS_G);
    LAS unsigned* cand = (LAS unsigned*)(lds + DS_CAND_OFF); LAS unsigned* hist = (LAS unsigned*)(lds + DS_HIST_OFF) + wave * DS_HIST_WORDS;
    LAS unsigned* cnt = (LAS unsigned*)(lds + DS_CNT_OFF); LAS unsigned* taup = (LAS unsigned*)(lds + DS_TAU_OFF);
    for (int L = blockIdx.x; L < 2048; L += gridDim.x) {
        int lane; asm volatile("v_mbcnt_lo_u32_b32 %0, -1, 0\n\tv_mbcnt_hi_u32_b32 %0, -1, %0" : "=v"(lane));
        const int tid = wave * 64 + lane, ql = lane & 15, gq = lane >> 4;
        int b, j;
        if (gridDim.x == 256) { const int i = blockIdx.x, ui = L >> 8, x = i & 7, li = (i >> 3) * 2 + (x >> 2); b = x & 3; j = 128 * (ui >> 1) + ((ui & 1) ? 127 - li : li); }
        else { b = L >> 9; j = L & 511; }
        const unsigned mb = (unsigned)b * SEQ; const int q0 = DS_NQ * j; const unsigned mq = mb + q0 + ql;
        const int pos0 = a.pos[mb]; int nadm = ((a.pos[mq] >> 6) + 1) * 64 - pos0; nadm = nadm > SEQ ? SEQ : nadm;
        int nmax = ((a.pos[mb + q0 + DS_NQ - 1] >> 6) + 1) * 64 - pos0; nmax = nmax > SEQ ? SEQ : nmax;
        const int nstep = (nmax + 511) >> 9;
#ifdef DSA_REP_STREAM
        for (int srep_ = 0; srep_ < 2; ++srep_) { const bool sdry = (srep_ == 0) && a.ph_hi > 0;
#ifndef DSA_DRYMODE
#define DSA_DRYMODE 0
#endif
#else
        const bool sdry = false;
#define DSA_DRYMODE 0
#endif
        __syncthreads();
        if (tid < DS_NQ) { cnt[tid] = 0u; taup[tid] = 0u; }
        bf16x8 bq[8][2];
#pragma unroll
        for (int h = 0; h < 8; ++h)
#pragma unroll
            for (int ks = 0; ks < 2; ++ks) bq[h][ks] = *(const bf16x8*)(QIg + ((((mb + q0) >> 4) * 16 + h * 2 + ks) * 512u + 8u * lane));
        f32x2 wh[8]; { const f32x4 w0 = *(const f32x4*)(WIg + mq * 8), w1 = *(const f32x4*)(WIg + mq * 8 + 4);
#pragma unroll
            for (int h = 0; h < 4; ++h) { wh[h] = (f32x2){w0[h], w0[h]}; wh[4 + h] = (f32x2){w1[h], w1[h]}; } }
        __syncthreads();
        u32x4 ka[8];
        { unsigned ko = (mb + 64 * wave) * 64u + 8u * lane, ko1 = ko + 2048u;
          asm volatile("" : "+v"(ko), "+v"(ko1));
#pragma unroll
          for (int j8 = 0; j8 < 8; ++j8) ka[j8] = *(const u32x4*)(KIg + ((j8 & 4) ? ko1 : ko) + (j8 & 3) * 512); }
        for (int step = 0; step <= nstep; ++step) {
            const int kb = 512 * step + 64 * wave; const bool active = (kb < nmax) && (step < nstep);
            PROBE_BEGIN(2, a.ws, wave);
            if (active) {
                f32x2 sc2[8];
#pragma unroll
                for (int i = 0; i < 8; ++i) sc2[i] = (f32x2){0.f, 0.f};
                const int ln = lane_id();
                const int kbn = (kb + 512 < SEQ) ? kb + 512 : kb; unsigned ko = (mb + kbn) * 64u + 8u * ln, ko1 = ko + 2048u;
                asm volatile("" : "+v"(ko), "+v"(ko1));
#pragma unroll
                for (int st = 0; st < 4; ++st) {
                    const bf16x8 af0 = __builtin_bit_cast(bf16x8, ka[2 * st]), af1 = __builtin_bit_cast(bf16x8, ka[2 * st + 1]);
                    f32x4 acc[8];
#pragma unroll
                    for (int h = 0; h < 8; ++h) acc[h] = __builtin_amdgcn_mfma_f32_16x16x32_bf16(af0, bq[h][0], (f32x4){0.f, 0.f, 0.f, 0.f}, 0, 0, 0);
#pragma unroll
                    for (int h = 0; h < 8; ++h) acc[h] = __builtin_amdgcn_mfma_f32_16x16x32_bf16(af1, bq[h][1], acc[h], 0, 0, 0);
                    __builtin_amdgcn_sched_barrier(0);
                    if (!(sdry && (DSA_DRYMODE & 1))) {
                        ka[2 * st] = *(const u32x4*)(KIg + ((st & 2) ? ko1 : ko) + (2 * st & 3) * 512); ka[2 * st + 1] = *(const u32x4*)(KIg + ((st & 2) ? ko1 : ko) + ((2 * st + 1) & 3) * 512); }
#pragma unroll
                    for (int h = 0; h < 8; ++h) {
                        sc2[2 * st] += wh[h] * (f32x2){relu_(acc[h][0]), relu_(acc[h][1])}; sc2[2 * st + 1] += wh[h] * (f32x2){relu_(acc[h][2]), relu_(acc[h][3])}; }
                    __builtin_amdgcn_sched_barrier(0);
                }
                float sc[16];
#pragma unroll
                for (int i = 0; i < 8; ++i) { sc[2 * i] = sc2[i][0]; sc[2 * i + 1] = sc2[i][1]; }
                __builtin_amdgcn_sched_barrier(0);
                const unsigned tp = taup[ql]; unsigned pm = 0u;
#pragma unroll
                for (int i = 0; i < 16; ++i) { const int key = kb + 16 * (i >> 2) + 4 * gq + (i & 3); const unsigned u = __float_as_uint(sc[i]);
                    const unsigned ord = (u & 0x80000000u) ? ~u : (u | 0x80000000u); const unsigned pk = (ord & 0xFFFFE000u) | (unsigned)key;
                    sc[i] = __uint_as_float(pk);
                    if (key < nadm && pk > tp) pm |= 1u << i; }
                if (sdry && (DSA_DRYMODE & 2)) pm = 0u;
                const unsigned n = (unsigned)__popc(pm);
                unsigned k = 0u; if (n) k = __hip_atomic_fetch_add(cnt + ql, n, __ATOMIC_RELAXED, __HIP_MEMORY_SCOPE_WORKGROUP);
                LAS unsigned* cq = cand + ql * DS_CAP;
#pragma unroll
                for (int i = 0; i < 16; ++i) if (pm & (1u << i)) { cq[k] = __float_as_uint(sc[i]); ++k; }
            }
            if (sdry && (DSA_DRYMODE & 8)) continue;
            __syncthreads();
            PROBE_END(2, a.ws, wave);
            const u32x4 c0 = *(const LAS u32x4*)(cnt), c1 = *(const LAS u32x4*)(cnt + 4), c2 = *(const LAS u32x4*)(cnt + 8), c3 = *(const LAS u32x4*)(cnt + 12);
            unsigned cm = max(max(max(c0.x, c0.y), max(c0.z, c0.w)), max(max(c1.x, c1.y), max(c1.z, c1.w)));
            cm = max(cm, max(max(max(c2.x, c2.y), max(c2.z, c2.w)), max(max(c3.x, c3.y), max(c3.z, c3.w))));
            const unsigned trig = (step == nstep) ? (unsigned)DS_TOPK : (unsigned)DS_TRIG;
#ifdef DSA_SEL2
            const int nsel = (step == nstep) ? 4 : 2;
#else
            const int nsel = 2;
#endif
            if (cm > trig) {
                PROBE_BEGIN(1, a.ws, wave);
#pragma unroll 1
                for (int qq = 0; qq < nsel; ++qq) { const int q = 2 * wave + (qq & 1); if (cnt[q] > trig || qq >= 2) {
                    if (step != nstep) filter_compact<32>(cand + q * DS_CAP, cnt + q, taup + q, lane);
                    if (step == nstep || cnt[q] > (unsigned)DS_TRIG) { const unsigned nq = (unsigned)__builtin_amdgcn_readfirstlane((int)cnt[q]);
                        if (nq <= 512u) select_compact<8>(cand + q * DS_CAP, cnt + q, taup + q, hist, lane);
                        else if (nq <= 768u) select_compact<12>(cand + q * DS_CAP, cnt + q, taup + q, hist, lane);
                        else if (nq <= 1024u) select_compact<16>(cand + q * DS_CAP, cnt + q, taup + q, hist, lane);
                        else if (nq <= 1536u) select_compact<24>(cand + q * DS_CAP, cnt + q, taup + q, hist, lane);
                        else select_compact<32>(cand + q * DS_CAP, cnt + q, taup + q, hist, lane); } } }
                __syncthreads();
                PROBE_END(1, a.ws, wave);
            }
        }
#ifdef DSA_REP_STREAM
        }
#endif
        const bf16_t* KVb = KVg + (size_t)mb * 256;
        int lane_a = lane; asm volatile("" : "+v"(lane_a));
        const int g16 = lane_a >> 4, l15 = lane_a & 15;
        const unsigned vbase = (unsigned)(size_t)(lds + DS_CAND_OFF) + (unsigned)wave * 16384u;
        unsigned ta0, ta1;
        { const int q = l15 >> 2, p = lane_a & 3; const int pr0 = 8 * g16 + q, pr1 = pr0 + 4;
          ta0 = vbase + vrow_off(pr0) + 16u * ((unsigned)(p >> 1) ^ swz_b(pr0)) + 8u * (unsigned)(p & 1);
          ta1 = vbase + vrow_off(pr1) + 16u * ((unsigned)(p >> 1) ^ swz_b(pr1)) + 8u * (unsigned)(p & 1); }
        const unsigned kwa = vbase + 10240u + (unsigned)(4 * g16) * 256u + (unsigned)((l15 ^ (4 * g16)) << 4);
        const unsigned kra = vbase + 10240u + (unsigned)l15 * 256u + (unsigned)((g16 ^ l15) << 4);
        const unsigned owa = vbase + 10240u + (unsigned)l15 * 256u + (unsigned)((g16 ^ l15) << 4);
        const unsigned ora = vbase + 10240u + (unsigned)(lane_a >> 3) * 256u + (unsigned)(((2 * (lane_a & 7)) ^ (lane_a >> 3)) << 4);
        unsigned vwa[8];
#pragma unroll
        for (int j2 = 0; j2 < 8; ++j2) { const int srow = 4 * j2 + g16; const int pr = (srow < 16) ? 8 * (srow >> 2) + (srow & 3) : 8 * ((srow - 16) >> 2) + 4 + (srow & 3);
            vwa[j2] = vbase + vrow_off(pr) + 16u * ((unsigned)l15 ^ swz_b(pr)); }
#ifdef DSA_REP_ATT
        for (int arep_ = 0; arep_ < 2; ++arep_) { const bool dry2 = dry || (arep_ == 0 && a.ph_hi > 0);
#else
        { const bool dry2 = dry;
#endif
        u32x4 qr[4];
#pragma unroll
        for (int i = 0; i < 4; ++i) qr[i] = *(const u32x4*)(Qg + ((mb + q0 + 2 * wave) * 2048u + (unsigned)(4 * g16 + i) * 128u + 8u * l15));
#pragma unroll 1
        for (int qq = 0; qq < 2; ++qq) {
            const int q = 2 * wave + qq; const unsigned m = mb + q0 + q; const int n = (int)cnt[q]; const LAS unsigned* cq = cand + q * DS_CAP;
            bf16x8 qb[4];
            {
#pragma unroll
              for (int i = 0; i < 4; ++i) *(LAS u32x4*)(size_t)(kwa ^ (unsigned)((i << 8) | (i << 4))) = qr[i];
              LDS_WAIT();
              if (qq == 0) {
#pragma unroll
                for (int i = 0; i < 4; ++i) qr[i] = *(const u32x4*)(Qg + ((m + 1u) * 2048u + (unsigned)(4 * g16 + i) * 128u + 8u * l15)); }
#pragma unroll
              for (int ks = 0; ks < 4; ++ks) qb[ks] = *(const LAS bf16x8*)(size_t)(kra ^ (unsigned)(ks << 6));
              LDS_WAIT(); }
            f32x4 sacc[16];
            const int nl = n - l15; const LAS unsigned* cql = cq + l15;
            u32x4 kr[5][4];
            auto kload = [&](int jt, u32x4 (&dst)[4]) { const u32x4 e4 = *(const LAS u32x4*)(cq + 16 * jt + 4 * g16);
#pragma unroll
                for (int i = 0; i < 4; ++i) dst[i] = *(const u32x4*)(KVb + ((e4[i] & 0x1FFFu) * 256u + 8u * l15)); };
            kload(0, kr[0]); kload(1, kr[1]); kload(2, kr[2]); kload(3, kr[3]);
#pragma unroll
            for (int i = 0; i < 4; ++i) *(LAS u32x4*)(size_t)(kwa ^ (unsigned)((i << 8) | (i << 4))) = kr[0][i];
#pragma unroll
            for (int jt = 0; jt < 16; ++jt) {
                if (jt + 4 < 16) kload(jt + 4, kr[(jt + 4) % 5]);
                bf16x8 fa[4];
#pragma unroll
                for (int ks = 0; ks < 4; ++ks) fa[ks] = *(const LAS bf16x8*)(size_t)(kra ^ (unsigned)(ks << 6));
                if (jt + 1 < 16) {
#pragma unroll
                    for (int i = 0; i < 4; ++i) *(LAS u32x4*)(size_t)(kwa ^ (unsigned)((i << 8) | (i << 4))) = kr[(jt + 1) % 5][i]; }
                f32x4 acc = (f32x4){0.f, 0.f, 0.f, 0.f};
#pragma unroll
                for (int ks = 0; ks < 4; ++ks) acc = __builtin_amdgcn_mfma_f32_16x16x32_bf16(fa[ks], qb[ks], acc, 0, 0, 0);
                sacc[jt] = acc;
            }
            u32x4 vr[2][8]; const int ng = n - g16; const LAS unsigned* cqg = cq + g16;
            auto vload = [&](int kk, u32x4 (&dst)[8]) {
#pragma unroll
                for (int j2 = 0; j2 < 8; ++j2) { const int sl = 32 * kk + 4 * j2; const unsigned e = cqg[sl]; const unsigned key = (sl < ng) ? (e & 0x1FFFu) : 0u;
                    dst[j2] = *(const u32x4*)(KVb + (key * 256u + 128u + 8u * l15)); } };
            vload(0, vr[0]); vload(1, vr[1]);
            __builtin_amdgcn_sched_barrier(0);
            float mx = -1e30f; const float nnf = (float)(n - 4 * g16 - 1);
#pragma unroll
            for (int jt = 0; jt < 16; ++jt)
#pragma unroll
                for (int r = 0; r < 4; ++r) { sacc[jt][r] = fmaf(fminf(nnf - (float)(16 * jt + r), 0.f), 1e30f, sacc[jt][r]); mx = fmaxf(mx, sacc[jt][r]); }
            mx = fmaxf(mx, __shfl_xor(mx, 16)); mx = fmaxf(mx, __shfl_xor(mx, 32));
            float sum = 0.f;
#pragma unroll
            for (int jt = 0; jt < 16; ++jt)
#pragma unroll
                for (int r = 0; r < 4; ++r) { const float p = __builtin_amdgcn_exp2f(sacc[jt][r] - mx); sacc[jt][r] = p; sum += p; }
            sum += __shfl_xor(sum, 16); sum += __shfl_xor(sum, 32);
            u32x4 pfr[8];
#pragma unroll
            for (int kk = 0; kk < 8; ++kk) { const f32x4 pa = sacc[2 * kk], pb2 = sacc[2 * kk + 1];
                pfr[kk].x = pk2(pa[0], pa[1]); pfr[kk].y = pk2(pa[2], pa[3]); pfr[kk].z = pk2(pb2[0], pb2[1]); pfr[kk].w = pk2(pb2[2], pb2[3]); }
            __builtin_amdgcn_sched_barrier(0);
            f32x4 o[8];
#pragma unroll
            for (int c = 0; c < 8; ++c) o[c] = (f32x4){0.f, 0.f, 0.f, 0.f};
            bf16_t* gqp = Gg + m * 2048u; u32x4 gwv[2][2];
#pragma unroll
            for (int p = 0; p < 2; ++p)
#pragma unroll
                for (int i = 0; i < 2; ++i) gwv[p][i] = *(const u32x4*)(gqp + ((8 * i + (lane_a >> 3)) * 128 + 64 * p + 8 * (lane_a & 7)));
#pragma unroll
            for (int kk = 0; kk < 8; ++kk) {
#pragma unroll
                for (int j2 = 0; j2 < 8; ++j2) *(LAS u32x4*)(size_t)vwa[j2] = vr[kk & 1][j2];
                __builtin_amdgcn_sched_barrier(0);
                if (kk + 2 < 8) vload(kk + 2, vr[kk & 1]);
                LDS_WAIT();
                const bf16x8 pfrag = __builtin_bit_cast(bf16x8, pfr[kk]);
#pragma unroll
                for (int ch = 0; ch < 2; ++ch) {
                    s16x4 t0[4], t1[4];
                    asm volatile("ds_read_b64_tr_b16 %0, %8\n\tds_read_b64_tr_b16 %1, %9\n\tds_read_b64_tr_b16 %2, %10\n\tds_read_b64_tr_b16 %3, %11\n\t"
                                 "ds_read_b64_tr_b16 %4, %12\n\tds_read_b64_tr_b16 %5, %13\n\tds_read_b64_tr_b16 %6, %14\n\tds_read_b64_tr_b16 %7, %15\n\ts_waitcnt lgkmcnt(0)"
                                 : "=&v"(t0[0]), "=&v"(t0[1]), "=&v"(t0[2]), "=&v"(t0[3]), "=&v"(t1[0]), "=&v"(t1[1]), "=&v"(t1[2]), "=&v"(t1[3])
                                 : "v"(ta0 ^ (unsigned)((4 * ch + 0) << 5)), "v"(ta0 ^ (unsigned)((4 * ch + 1) << 5)), "v"(ta0 ^ (unsigned)((4 * ch + 2) << 5)), "v"(ta0 ^ (unsigned)((4 * ch + 3) << 5)),
                                   "v"(ta1 ^ (unsigned)((4 * ch + 0) << 5)), "v"(ta1 ^ (unsigned)((4 * ch + 1) << 5)), "v"(ta1 ^ (unsigned)((4 * ch + 2) << 5)), "v"(ta1 ^ (unsigned)((4 * ch + 3) << 5)) : "memory");
                    __builtin_amdgcn_sched_barrier(0);
#pragma unroll
                    for (int c = 0; c < 4; ++c) { const bf16x8 av = __builtin_shufflevector(t0[c], t1[c], 0, 1, 2, 3, 4, 5, 6, 7);
                        o[4 * ch + c] = __builtin_amdgcn_mfma_f32_16x16x32_bf16(av, pfrag, o[4 * ch + c], 0, 0, 0); }
                }
            }
            const float inv = 1.0f / sum;
#pragma unroll
            for (int p = 0; p < 2; ++p) {
#pragma unroll
                for (int cc = 0; cc < 4; ++cc) *(LAS f32x4*)(size_t)(owa ^ (unsigned)(cc << 6)) = o[4 * p + cc] * inv;
                LDS_WAIT();
#pragma unroll
                for (int i = 0; i < 2; ++i) { bf16_t* gp = gqp + ((8 * i + (lane_a >> 3)) * 128 + 64 * p + 8 * (lane_a & 7)); const u32x4 gw = gwv[p][i];
                    const unsigned ra_ = (ora + 2048u * (unsigned)i) ^ (unsigned)(i << 7);
                    const f32x4 t0 = *(const LAS f32x4*)(size_t)ra_, t1 = *(const LAS f32x4*)(size_t)(ra_ ^ 16u);
                    u32x4 wv; wv.x = pk2(t0[0] * bflo(gw.x), t0[1] * bfhi(gw.x)); wv.y = pk2(t0[2] * bflo(gw.y), t0[3] * bfhi(gw.y));
                    wv.z = pk2(t1[0] * bflo(gw.z), t1[1] * bfhi(gw.z)); wv.w = pk2(t1[2] * bflo(gw.w), t1[3] * bfhi(gw.w));
                    if (!dry2) *(u32x4*)gp = wv; }
                LDS_WAIT();
            }
        }
        }
    }
}

#ifndef OLD_SCAN
#define OLD_SCAN 0
#endif
#ifndef MK_SPLIT
#define MK_SPLIT 0
#endif
#ifndef MK_PH_END
#define MK_PH_END 13
#endif
constexpr int N_PHASES = 13;

#define XB_TMO      128
#define XB_XCNT(j)  (256  + 64 * (j))
#define XB_XSUB(j)  (1280 + 64 * (j))
#define XB_XGEN(j)  (2304 + 64 * (j))
#define XB_TOP      3328
#define XB_TOPGEN   3392
#define XCD_BAR_WORDS 3456
#define XB_SPIN_CAP (1u << 18)

__device__ __forceinline__ unsigned xb_ld(unsigned* p)              { return __hip_atomic_load(p, __ATOMIC_RELAXED, __HIP_MEMORY_SCOPE_AGENT); }
__device__ __forceinline__ unsigned xb_add(unsigned* p, unsigned v) { return __hip_atomic_fetch_add(p, v, __ATOMIC_RELAXED, __HIP_MEMORY_SCOPE_AGENT); }
__device__ __forceinline__ unsigned xb_xcc_id() { return (unsigned)__builtin_amdgcn_s_getreg((3 << 11) | 20) & 0xFu; }
#define XB_SPIN(cond, bar) do { unsigned _sp = 0; while (cond) { __builtin_amdgcn_s_sleep(1); \
    if ((++_sp & 255u) == 0u) { if (xb_ld(&(bar)[XB_TMO])) break; if (_sp > XB_SPIN_CAP) { atomicAdd(&(bar)[XB_TMO], 1u); break; } } } } while (0)

struct XcdBarrier {
    unsigned* bar; unsigned x;
    volatile LAS unsigned* st;
};

__device__ __forceinline__ XcdBarrier xcd_barrier_post(unsigned* bar, volatile LAS unsigned* st, const int wave) {
    XcdBarrier b; b.bar = bar; b.x = xb_xcc_id(); b.st = st;
    if (lane_id() == 0 && wave == 0) (void)xb_add(&bar[XB_XCNT(b.x)], 1u);
    return b;
}
__device__ __forceinline__ void xcd_barrier_complete(unsigned* bar, unsigned x, unsigned& nloc, unsigned& nx) {
    const unsigned G = gridDim.x * gridDim.y * gridDim.z;
    unsigned sum, cnt, mine, sp = 0u;
    for (;;) {
        sum = 0u; cnt = 0u; mine = 0u;
#pragma unroll
        for (unsigned j = 0; j < 16; ++j) { const unsigned c = xb_ld(&bar[XB_XCNT(j)]); sum += c; cnt += (c > 0u) ? 1u : 0u; mine = (j == x) ? c : mine; }
        if (sum == G) break;
        __builtin_amdgcn_s_sleep(1);
        if ((++sp & 255u) == 0u) { if (xb_ld(&bar[XB_TMO])) break; if (sp > XB_SPIN_CAP) { atomicAdd(&bar[XB_TMO], 1u); break; } }
    }
    nloc = mine > 0u ? mine : 1u; nx = cnt > 0u ? cnt : 1u;
}

__device__ __forceinline__ void xcd_barrier(const XcdBarrier& b, const int wave) {
    asm volatile("s_waitcnt vmcnt(0)" ::: "memory");
    __syncthreads();
    if (wave == 0) { if (lane_id() == 0) {
        unsigned* bar = b.bar;
        __builtin_amdgcn_s_waitcnt(0);
        unsigned nloc = b.st[0], nx = b.st[1];
        if (nloc == 0u) { xcd_barrier_complete(bar, b.x, nloc, nx); b.st[0] = nloc; b.st[1] = nx; }
        const unsigned old = xb_add(&bar[XB_XSUB(b.x)], 1u);
        const unsigned gen = old / nloc;
        if (old + 1u == (gen + 1u) * nloc) {
            __builtin_amdgcn_fence(__ATOMIC_RELEASE, "agent");
            asm volatile("s_waitcnt vmcnt(0)" ::: "memory");
            const unsigned og = xb_add(&bar[XB_TOP], 1u);
            const unsigned tg = og / nx;
            if (og + 1u == (tg + 1u) * nx) xb_add(&bar[XB_TOPGEN], 1u);
            else XB_SPIN(xb_ld(&bar[XB_TOPGEN]) == tg, bar);
            __builtin_amdgcn_fence(__ATOMIC_ACQUIRE, "agent");
            xb_add(&bar[XB_XGEN(b.x)], 1u);
            asm volatile("s_waitcnt vmcnt(0)" ::: "memory");
        } else {
            XB_SPIN(xb_ld(&bar[XB_XGEN(b.x)]) == gen, bar);
            __builtin_amdgcn_fence(__ATOMIC_ACQUIRE, "agent");
            asm volatile("s_waitcnt vmcnt(0)" ::: "memory");
        }
    } }
    __syncthreads();
}

#define grid_bar(barptr, epoch, wv) xcd_barrier(xbar, (wv))
typedef const __attribute__((address_space(4))) Args* KArgs;
#if defined(__HIP_DEVICE_COMPILE__)
__device__ __forceinline__ Args kargs() { KArgs p = (KArgs)__builtin_amdgcn_kernarg_segment_ptr(); asm volatile("" : "+s"(p)); return *p; }
#else
__device__ __forceinline__ Args kargs() { return Args{}; }
#endif
#define PHASE_ARGS const Args a = kargs(); unsigned char* ws = a.ws; (void)ws

__global__ void __launch_bounds__(NTHREADS, 2) fwd_megakernel(Args a_by_value) {
    extern __shared__ __attribute__((aligned(16))) unsigned char lds_raw[];
    LAS unsigned char* lds = (LAS unsigned char*)lds_raw;
    cg::grid_group grid = cg::this_grid();
    const int wave = __builtin_amdgcn_readfirstlane((int)threadIdx.x >> 6);
    { volatile LAS unsigned* st0 = (volatile LAS unsigned*)(lds + LDS_BYTES - 16); if (wave == 0 && lane_id() < 4) st0[lane_id()] = 0u; __syncthreads(); }
    const XcdBarrier xbar = xcd_barrier_post((unsigned*)(kargs().ws + WS_BAR), (volatile LAS unsigned*)(lds + LDS_BYTES - 16), wave);
    int lo, hi; { const Args a0 = kargs(); lo = a0.ph_lo; hi = a0.ph_hi; }
#ifdef ONLY_PH
#define IN(k) ((k) == ONLY_PH && lo <= (k) && (k) < hi)
#else
#define IN(k) (lo <= (k) && (k) < hi)
#endif
#define SEAM(k) do { if (IN(k) && IN((k) + 1)) { if ((k) == 0) grid.sync(); else grid_bar((unsigned*)(kargs().ws + WS_BAR), (unsigned)(k), wave); } } while (0)
#ifdef REP_PH
#ifndef REP_N
#define REP_N 2
#endif
#define NREP(k) ((k) == REP_PH ? REP_N : 1)
#else
#define NREP(k) 1
#endif
#define REPEAT(k) for (int rep_ = 0; rep_ < NREP(k); ++rep_, (rep_ < NREP(k) ? grid_bar((unsigned*)(kargs().ws + WS_BAR) + 128, 1u, wave) : (void)0))
#ifdef STAMP_K
#define TSTAMP(k) do { if (((k) == STAMP_K || (k) == STAMP_K + 1) && blockIdx.x == 0 && wave == 0) { const unsigned long long t_ = __builtin_amdgcn_s_memrealtime(); \
        if (__builtin_amdgcn_mbcnt_lo(~0u, 0u) == 0u) ((unsigned long long*)(kargs().ws + WS_STAMP))[(k) - STAMP_K] = t_; } } while (0)
#else
#define TSTAMP(k) do { } while (0)
#endif
#ifdef STAMP_K
    if (blockIdx.x == PROBE_BLK && wave == 0) { unsigned long long* st_ = (unsigned long long*)(kargs().ws + WS_STAMP); if (__builtin_amdgcn_mbcnt_lo(~0u, 0u) < 3u) st_[__builtin_amdgcn_mbcnt_lo(~0u, 0u)] = 0ull; }
#endif
    TSTAMP(0);
    if (IN(0)) REPEAT(0) { PHASE_ARGS; p0_prologue(a, wave, lds); } SEAM(0); TSTAMP(1);
    if (IN(1)) REPEAT(1) { PHASE_ARGS; norm_phase(a, wave, lds, a.x, 0); } SEAM(1); TSTAMP(2);
    if (IN(2)) REPEAT(2) { PHASE_ARGS;
        pg8::Gemm g{(const bf16_t*)(ws + WS_H), (const bf16_t*)(ws + WS_WIN0), MTOK, N0, DM}; pg8::StaticOrder S; S.init(MTOK, N0, gridDim.x, blockIdx.x);
        #ifdef EPI0_CHEAP_FIRST
        Epi0 E{ws, (unsigned char*)a.out, NREP(2) == 2 && rep_ == 0 && a.ph_hi > 0, lds + pg8::STAGE_BYTES};
#else
        Epi0 E{ws, (unsigned char*)a.out, false, lds + pg8::STAGE_BYTES};
#endif
#ifdef SKEW0
        if (blockIdx.x >= 128) { const unsigned long long t0_ = __builtin_amdgcn_s_memrealtime(); while (__builtin_amdgcn_s_memrealtime() - t0_ < (unsigned long long)(SKEW0)) __builtin_amdgcn_s_sleep(64); }
#endif
        pg8::gemm_phase<Epi0, pg8::StaticOrder, true, true>(lds, g, S, E, wave);
    } SEAM(2); TSTAMP(3);
    if (IN(3)) REPEAT(3) { PHASE_ARGS; conv_phase(a, wave, lds, blockIdx.x, gridDim.x); lora_pre_phase(a, wave); } SEAM(3); TSTAMP(4);
    if (IN(4)) REPEAT(4) { PHASE_ARGS;
        pg8::Gemm g{(const bf16_t*)((unsigned char*)a.out + DO_LA), (const bf16_t*)(ws + WS_WLORA), MTOK, 2048, 256}; pg8::StaticOrder S; S.init(MTOK, 2048, gridDim.x, blockIdx.x);
        EpiLora E{(bf16_t*)(ws + WS_DARR), (bf16_t*)(ws + WS_AARR), a.rwkv_vec, lds + pg8::STAGE_BYTES};
        pg8::gemm_phase<EpiLora, pg8::StaticOrder, true, true>(lds, g, S, E, wave);
    } SEAM(4); TSTAMP(5);
    if (IN(5)) REPEAT(5) { PHASE_ARGS;
#if OLD_SCAN
        scan_phase(a, wave, lds);
#else
        unsigned* pbar = (unsigned*)(ws + WS_BAR) + 256;
        { __syncthreads(); if (wave == 0 && lane_id() < 16) ((LAS unsigned*)(lds + CR_FLAGS))[lane_id()] = 0u; __syncthreads(); }
        const int nbuild = ((int)gridDim.x - 64) * CR_PW;
#ifdef SCAN_SKIP
        const bool skipc = (SCAN_SKIP & 1) && NREP(5) >= 2 && rep_ == 0 && a.ph_hi > 0, skipp = (SCAN_SKIP & 2) && NREP(5) >= 2 && rep_ == 0 && a.ph_hi > 0;
#else
        const bool skipc = false, skipp = false;
#endif
        for (int r = 0; r <= CR_NP; ++r) {
            if (skipp && (blockIdx.x >= 64 || wave == 5)) { }
            else if (skipc && blockIdx.x < 64 && wave != 5) { }
            else
            if (blockIdx.x >= 64) { if (r < CR_NP) { if (wave < CR_PW) cscan_produce(a, lds + wave * CR_PSLOT, r, ((int)blockIdx.x - 64) * CR_PW + wave, nbuild); else cscan_rope(a, wave, r, 64, gridDim.x - 64); } }
            else if (wave == 5) { }
            else if (r >= 1) {
                const int piece = r - 1;
                f32x4 xc[4]; f32x4* sv = (f32x4*)(ws + WS_XSAVE) + ((size_t)(blockIdx.x * 4 + (wave & 3)) * 64 + lane_id()) * 4;
#pragma unroll
                for (int kt = 0; kt < 4; ++kt) xc[kt] = (piece == 0 || wave >= 4) ? (f32x4){0.f, 0.f, 0.f, 0.f} : sv[kt];
                cscan_consume(a, wave, lds, blockIdx.x, piece, xc, skipp);
                if (wave < 4) {
#pragma unroll
                    for (int kt = 0; kt < 4; ++kt) sv[kt] = xc[kt]; }
            }
            grid_bar(pbar, (unsigned)(r + 1), wave);
#ifdef BAR2
            grid_bar(pbar + 128, (unsigned)(r + 1), wave);
#endif
        }
#endif
    } SEAM(5); TSTAMP(6);
    if (IN(6)) REPEAT(6) { PHASE_ARGS; post_phase(a, wave); } SEAM(6); TSTAMP(7);
    if (IN(7)) REPEAT(7) { PHASE_ARGS;
        pg8::Gemm g{(const bf16_t*)(ws + WS_YAB), (const bf16_t*)(ws + WS_WOUT0), MTOK, DM, 2048}; pg8::StaticOrder S; S.init(MTOK, DM, gridDim.x, blockIdx.x);
        EpiRes E{a.x, a.out, (const float*)(ws + WS_MODP), a.ada_b, 0, NREP(7) >= 2 && rep_ == 0 && a.ph_hi > 0, lds + pg8::STAGE_BYTES};
        pg8::gemm_phase<EpiRes, pg8::StaticOrder, true, true>(lds, g, S, E, wave);
    } SEAM(7); TSTAMP(8);
    if (IN(8)) REPEAT(8) { PHASE_ARGS; norm_phase(a, wave, lds, a.out, 1); } SEAM(8); TSTAMP(9);
    if (IN(9)) REPEAT(9) { PHASE_ARGS;
        pg8::Gemm g{(const bf16_t*)(ws + WS_H), (const bf16_t*)(ws + WS_WIN1), MTOK, N1, DM}; pg8::StaticOrder S; S.init(MTOK, N1, gridDim.x, blockIdx.x);
        Epi1 E{(bf16_t*)(ws + WS_Q), (bf16_t*)(ws + WS_KV), (bf16_t*)(ws + WS_QI), (bf16_t*)(ws + WS_KI), (bf16_t*)(ws + WS_G), (float*)(ws + WS_WI), (const f32x2*)(ws + WS_CSA), (const f32x2*)(ws + WS_CSI), lds + pg8::STAGE_BYTES};
        pg8::gemm_phase<Epi1, pg8::StaticOrder, true, true>(lds, g, S, E, wave);
    } SEAM(9); TSTAMP(10);
    if (IN(10)) REPEAT(10) { PHASE_ARGS; dsa_phase(a, wave, lds, NREP(10) == 2 && rep_ == 0 && a.ph_hi > 0); } SEAM(10); TSTAMP(11);
    if (IN(11)) REPEAT(11) { PHASE_ARGS;
        pg8::Gemm g{(const bf16_t*)(ws + WS_G), (const bf16_t*)(ws + WS_WOUT1), MTOK, DM, 2048}; pg8::StaticOrder S; S.init(MTOK, DM, gridDim.x, blockIdx.x);
        EpiRes E{a.out, a.out, (const float*)(ws + WS_MODP), a.ada_b, 1, false, lds + pg8::STAGE_BYTES};
        pg8::gemm_phase<EpiRes, pg8::StaticOrder, true, true>(lds, g, S, E, wave);
    } SEAM(11); TSTAMP(12);
    if (IN(12)) REPEAT(12) { PHASE_ARGS; final_phase(a, wave); }
#undef IN
#undef SEAM
}

extern "C" void kernel_launch(void* const* d_in, const int* in_sizes, int n_in, void* d_out, int out_size, void* d_ws, size_t ws_size, hipStream_t stream) {
    static int grid = 0;
    if (grid == 0) {
        if (n_in != 19 || out_size != MTOK * DM || ws_size < WS_NEED) { fprintf(stderr, "kernel_launch: unexpected shapes (n_in %d, out %d, ws %zu)\n", n_in, out_size, ws_size); grid = -1; return; }
        int dev = 0, cus = 0, per_cu = 0;
        (void)hipGetDevice(&dev); (void)hipDeviceGetAttribute(&cus, hipDeviceAttributeMultiprocessorCount, dev);
        if (hipFuncSetAttribute((const void*)fwd_megakernel, hipFuncAttributeMaxDynamicSharedMemorySize, LDS_BYTES) != hipSuccess) { fprintf(stderr, "kernel_launch: hipFuncSetAttribute failed\n"); grid = -1; return; }
        if (hipOccupancyMaxActiveBlocksPerMultiprocessor(&per_cu, (const void*)fwd_megakernel, NTHREADS, LDS_BYTES) != hipSuccess || per_cu < 1) { fprintf(stderr, "kernel_launch: occupancy query says %d\n", per_cu); per_cu = 1; }
        (void)hipGetLastError();
        grid = cus;
        if (grid > 256) grid = 256;
    }
    if (grid < 0) return;
    Args a{};
    a.x = (const float*)d_in[0]; a.c = (const float*)d_in[1]; a.pos = (const int*)d_in[2]; a.ada_w = (const float*)d_in[3]; a.ada_b = (const float*)d_in[4];
    a.norm_g = (const float*)d_in[5]; a.final_g = (const float*)d_in[6]; a.even_w_in = (const float*)d_in[7]; a.even_w_out = (const float*)d_in[8];
    a.conv_w = (const float*)d_in[9]; a.conv_vec = (const float*)d_in[10]; a.mu_rkv = (const float*)d_in[11]; a.mu_lora = (const float*)d_in[12];
    a.rwkv_vec = (const float*)d_in[13]; a.w_up = (const float*)d_in[14]; a.a_up = (const float*)d_in[15]; a.r_k = (const float*)d_in[16];
    a.odd_w_in = (const float*)d_in[17]; a.odd_w_out = (const float*)d_in[18];
    a.out = (float*)d_out; a.ws = (unsigned char*)d_ws;
    (void)hipMemsetAsync((char*)d_ws + WS_BAR, 0, 65536, stream);
#if MK_SPLIT
    for (int p = 0; p < MK_PH_END; ++p) { a.ph_lo = p; a.ph_hi = p + 1; void* args[] = {&a};
        hipError_t e = hipLaunchCooperativeKernel((const void*)fwd_megakernel, dim3(grid), dim3(NTHREADS), args, LDS_BYTES, stream);
        if (e != hipSuccess) { fprintf(stderr, "launch %d failed: %s\n", p, hipGetErrorString(e)); break; } }
#else
    a.ph_lo = 0; a.ph_hi = MK_PH_END; void* args[] = {&a};
    hipError_t e = hipLaunchCooperativeKernel((const void*)fwd_megakernel, dim3(grid), dim3(NTHREADS), args, LDS_BYTES, stream);
    if (e != hipSuccess) fprintf(stderr, "cooperative launch failed: %s (grid %d)\n", hipGetErrorString(e), grid);
#endif
}
```

```cpp
#include <hip/hip_runtime.h>
#include <hip/hip_cooperative_groups.h>
#include <cstdio>
#include <cstdint>
namespace cg = cooperative_groups;

#define LAS __attribute__((address_space(3)))
typedef unsigned short bf16_t;
typedef float f32x4 __attribute__((ext_vector_type(4)));
typedef float f32x2 __attribute__((ext_vector_type(2)));
typedef float f32x16 __attribute__((ext_vector_type(16)));
typedef unsigned u32x4 __attribute__((ext_vector_type(4)));
typedef unsigned u32x2 __attribute__((ext_vector_type(2)));
typedef short bf16x8 __attribute__((ext_vector_type(8)));
typedef short s16x4 __attribute__((ext_vector_type(4)));

constexpr int BATCH = 4, SEQ = 8192, DM = 1024, MTOK = BATCH * SEQ;
constexpr int N0 = 7424, N1 = 5120;
constexpr int EVEN_COLS = 7296, ODD_COLS = 4936;
constexpr int NWAVES = 8, NTHREADS = 512;
constexpr int LDS_BYTES = 155648;

constexpr size_t MiB = 1u << 20;
constexpr size_t WS_MODP = 0; constexpr size_t WS_STAMP = 3 * MiB; constexpr size_t WS_XSAVE = 1 * MiB;
constexpr size_t WS_BAR = 3 * MiB + 512 * 1024;
constexpr size_t WS_WIN0 = 4 * MiB, WS_WOUT0 = 20 * MiB, WS_WIN1 = 24 * MiB, WS_WOUT1 = 34 * MiB, WS_WLORA = 38 * MiB;
constexpr size_t WS_CSA = 40 * MiB, WS_CSI = 56 * MiB;
constexpr size_t WS_H = 64 * MiB;
constexpr size_t WS_YAB = 64 * MiB;
constexpr size_t WS_U = 192 * MiB, WS_AG = 256 * MiB, WS_R = 320 * MiB, WS_K = 384 * MiB, WS_V = 448 * MiB;
constexpr size_t WS_AARR = WS_U, WS_DARR = WS_AG;
constexpr size_t WS_Q = 128 * MiB, WS_G = 256 * MiB, WS_KV = 384 * MiB, WS_QI = 400 * MiB, WS_KI = 432 * MiB, WS_WI = 436 * MiB;
constexpr size_t WS_NEED = 512 * MiB;
constexpr size_t DO_BG = 0, DO_WDAD = 64 * MiB, DO_LA = 72 * MiB, DO_RK = 64 * MiB;

__device__ __forceinline__ float bflo(unsigned w) { return __uint_as_float(w << 16); }
__device__ __forceinline__ float bfhi(unsigned w) { return __uint_as_float(w & 0xffff0000u); }
typedef __bf16 bf16x2_t __attribute__((ext_vector_type(2)));
__device__ __forceinline__ unsigned pk2(float lo, float hi) { const f32x2 v = {lo, hi}; const bf16x2_t b = __builtin_convertvector(v, bf16x2_t); return __builtin_bit_cast(unsigned, b); }
__device__ __forceinline__ float sigmoidf_(float x) { return __builtin_amdgcn_rcpf(1.0f + __expf(-x)); }
__device__ __forceinline__ float wave_sum(float v) {
#pragma unroll
    for (int o = 1; o < 64; o <<= 1) v += __shfl_xor(v, o);
    return v;
}
template <int CTRL> __device__ __forceinline__ float dppmov(float x) { return __int_as_float(__builtin_amdgcn_update_dpp(0, __float_as_int(x), CTRL, 0xf, 0xf, true)); }
__device__ __forceinline__ float quad_sum(float x) { x += dppmov<0xB1>(x); x += dppmov<0x4E>(x); return x; }
__device__ __forceinline__ float row16_sum(float x) { x += dppmov<0xB1>(x); x += dppmov<0x4E>(x); x += dppmov<0x141>(x); x += dppmov<0x140>(x); return x; }
__device__ __forceinline__ int lane_id() { int l; asm volatile("v_mbcnt_lo_u32_b32 %0, -1, 0\n\tv_mbcnt_hi_u32_b32 %0, -1, %0" : "=v"(l)); return l; }
#define LDS_WAIT() asm volatile("s_waitcnt lgkmcnt(0)" ::: "memory")

__device__ __forceinline__ int map0(int n) {
    const int t = n >> 8, r = n & 255;
    if (t < 8) return (r < 128) ? 128 * t + r : 1024 + 128 * t + (r - 128);
    if (t < 12) return 2048 + 256 * (t - 8) + r;
    if (t < 24) return 3072 + 256 * (t - 12) + r;
    if (t < 28) return 6272 + 256 * (t - 24) + r;
    return (r < 128) ? 6144 + r : -1;
}
__device__ __forceinline__ int map1(int n) {
    const int t = n >> 8, r = n & 255, half = r >> 7, rr = r & 127;
    if (t < 8) return (2 * t + (rr >> 6)) * 128 + half * 64 + (rr & 63);
    if (t == 8) return 2048 + (rr >> 6) * 128 + half * 64 + (rr & 63);
    if (t < 11) return 2304 + (4 * (t - 9) + (rr >> 5)) * 64 + half * 32 + (rr & 31);
    if (t == 11) { if (rr < 32) return 2816 + half * 32 + rr; if (half == 0 && rr < 40) return 2880 + (rr - 32); return -1; }
    return 2888 + 256 * (t - 12) + r;
}

#ifndef PROBE_BLK
#define PROBE_BLK 0
#endif
#ifndef PROBE_WAVE
#define PROBE_WAVE 0
#endif
#if defined(STAMP_K) && defined(PROBE_SEC)
#define PROBE_BEGIN(sec, wsp, wv) unsigned long long PT0_##sec = 0; if ((sec) == PROBE_SEC && blockIdx.x == PROBE_BLK && (wv) == PROBE_WAVE) PT0_##sec = __builtin_amdgcn_s_memrealtime()
#define PROBE_END(sec, wsp, wv) do { if ((sec) == PROBE_SEC && blockIdx.x == PROBE_BLK && (wv) == PROBE_WAVE) { const unsigned long long dt_ = __builtin_amdgcn_s_memrealtime() - PT0_##sec; \
        if (__builtin_amdgcn_mbcnt_lo(~0u, 0u) == 0u) __hip_atomic_fetch_add((unsigned long long*)((wsp) + WS_STAMP) + 2, dt_, __ATOMIC_RELAXED, __HIP_MEMORY_SCOPE_AGENT); } } while (0)
#else
#define PROBE_BEGIN(sec, wsp, wv) do { } while (0)
#define PROBE_END(sec, wsp, wv) do { } while (0)
#endif
namespace pg8 {
#define PG8_LAS __attribute__((address_space(3)))
typedef unsigned short bf16_t;
typedef short bf16x8 __attribute__((ext_vector_type(8)));
typedef float f32x4 __attribute__((ext_vector_type(4)));
typedef unsigned u32x4 __attribute__((ext_vector_type(4)));
constexpr int BM = 256, BK = 64, HALF = 128, HTB = HALF * BK * 2  , STAGE_BYTES = 8 * HTB, NXCD = 8;

__host__ __device__ __forceinline__ int lds_byte(int r, int c) { const int st = (r >> 4) * 2 + (c >> 5), rr = r & 15, cc = c & 31, ob = rr * 64 + cc * 2; return st * 1024 + (ob ^ (((ob >> 9) & 1) << 5)); }
__host__ __device__ __forceinline__ void stage_rc(int b, int& R, int& C) { const int st = b / 1024, sb = b % 1024, swz = sb ^ (((sb >> 9) & 1) << 5); R = (st >> 1) * 16 + swz / 64; C = (st & 1) * 32 + (swz % 64) / 2; }
__host__ __device__ __forceinline__ int perm32(int rho) { const int n = rho >> 4, i = rho & 15; return 8 * (i >> 2) + 4 * n + (i & 3); }

struct Unit { int pm, pn; };
struct Gemm { const bf16_t* A; const bf16_t* Bt; int M, N, K; };

struct StaticOrder {
    int nM, nN, nwg, G, c, WGM;
    __host__ __device__ void init(int M, int N, int G_, int c_, int wgm = 4) { nM = M / BM; nN = N / BM; nwg = nM * nN; G = G_; c = c_; WGM = wgm; }
    __host__ __device__ bool next(int i, Unit& u) const {
        const long L = (long)i * G + c; if (L >= nwg) return false;
        int wgid = (int)L; { const int q = nwg / NXCD, r = nwg % NXCD, xcd = wgid % NXCD, off = wgid / NXCD; wgid = (xcd < r ? xcd * (q + 1) : r * (q + 1) + (xcd - r) * q) + off; }
        const int nig = WGM * nN, gid = wgid / nig, fm = gid * WGM, gsz = (nM - fm) < WGM ? (nM - fm) : WGM;
        u.pm = fm + ((wgid % nig) % gsz); u.pn = (wgid % nig) / gsz; return true;
    }
    __device__ __forceinline__ void a_ready(const Unit&) const {}
    __device__ __forceinline__ void done(const Unit&) const {}
};

__device__ __forceinline__ unsigned cvt_pk_bf16(float lo, float hi) { unsigned r; asm volatile("v_cvt_pk_bf16_f32 %0, %1, %2" : "=v"(r) : "v"(lo), "v"(hi)); return r; }
typedef float f32x2 __attribute__((ext_vector_type(2)));
template <class Epi, class Sched, bool ALIGN_EPI = false, bool SP2 = false>
__device__ __forceinline__ void gemm_phase(PG8_LAS unsigned char* lds, const Gemm g, const Sched& S, const Epi& E, const int wave_in) {
    int lane; asm volatile("v_mbcnt_lo_u32_b32 %0, -1, 0\n\tv_mbcnt_hi_u32_b32 %0, -1, %0" : "=v"(lane));
    const int wid = wave_in, tid = wid * 64 + lane, wr = wid >> 2, wc = wid & 3, fr = lane & 15, fq = lane >> 4;
    const int K = g.K, nt = K / BK;
    unsigned voffA[2], voffB[2];
#pragma unroll
    for (int i = 0; i < 2; ++i) { int R, C; stage_rc(tid * 16 + i * 8192, R, C); const int Rb = Epi::PERM ? ((R & ~31) + perm32(R & 31)) : R;
        voffA[i] = (unsigned)(R * K + C) * 2u; voffB[i] = (unsigned)(Rb * K + C) * 2u; }
    const size_t kstep = (size_t)(BK * 2);
    const size_t hstep = (size_t)HALF * K * 2;
    const size_t tstep = 2 * hstep;
    const unsigned ldsw = (unsigned)wid * 1024u;
    const int aoff = lds_byte(wr * 64 + fr, fq * 8), boff = lds_byte(wc * 32 + fr, fq * 8);
#define PG8_SA(b, h) (((b) * 2 + (h)) * HTB)
#define PG8_SB(b, h) ((4 + (b) * 2 + (h)) * HTB)
#define PG8_STAGE(bufoff, gbase, voff) do { _Pragma("unroll") for (int _i = 0; _i < 2; ++_i) \
        __builtin_amdgcn_global_load_lds((const unsigned*)((const char*)(gbase) + (voff)[_i]), (PG8_LAS unsigned*)(lds + (bufoff) + ldsw + _i * 8192), 16, 0, 0); } while (0)
#define PG8_LDA(dst, b, h) do { _Pragma("unroll") for (int m = 0; m < 4; ++m) _Pragma("unroll") for (int k = 0; k < 2; ++k) dst[m][k] = *(const PG8_LAS bf16x8*)(lds + PG8_SA(b, h) + aoff + m * 2048 + k * 1024); } while (0)
#define PG8_LDB(dst, b, h) do { _Pragma("unroll") for (int n = 0; n < 2; ++n) _Pragma("unroll") for (int k = 0; k < 2; ++k) dst[n][k] = *(const PG8_LAS bf16x8*)(lds + PG8_SB(b, h) + boff + n * 2048 + k * 1024); } while (0)
#define PG8_MMA(ai, bj, At, Bt) do { __builtin_amdgcn_s_setprio(1); _Pragma("unroll") for (int m = 0; m < 4; ++m) _Pragma("unroll") for (int n = 0; n < 2; ++n) _Pragma("unroll") for (int k = 0; k < 2; ++k) \
        acc[ai][bj][m][n] = __builtin_amdgcn_mfma_f32_16x16x32_bf16(Bt[n][k], At[m][k], acc[ai][bj][m][n], 0, 0, 0); __builtin_amdgcn_s_setprio(0); } while (0)
#define PG8_WAIT_V(n) asm volatile("s_waitcnt vmcnt(" #n ")" ::: "memory")
#define PG8_WAIT_L(n) asm volatile("s_waitcnt lgkmcnt(" #n ")" ::: "memory")
#define PG8_BAR __builtin_amdgcn_s_barrier()
#define PG8_SCHED __builtin_amdgcn_sched_barrier(0)
    Unit cur, nxt; int ui = 0;
    if (!S.next(0, cur)) return;
    f32x4 acc[2][2][4][2];
#pragma unroll
    for (int a = 0; a < 2; ++a)
#pragma unroll
        for (int b = 0; b < 2; ++b)
#pragma unroll
            for (int m = 0; m < 4; ++m)
#pragma unroll
                for (int n = 0; n < 2; ++n) acc[a][b][m][n] = (f32x4){0.f, 0.f, 0.f, 0.f};
    bf16x8 At[4][2], B0[2][2], B1[2][2];
    const char* cA = (const char*)g.A + (size_t)cur.pm * tstep; const char* cB = (const char*)g.Bt + (size_t)cur.pn * tstep;
    S.a_ready(cur);
    if constexpr (SP2) {
        PG8_STAGE(PG8_SB(0, 0), cB, voffB); PG8_STAGE(PG8_SB(0, 1), cB + hstep, voffB); PG8_STAGE(PG8_SA(0, 0), cA, voffA); PG8_STAGE(PG8_SA(0, 1), cA + hstep, voffA);
        if (wr == 1) PG8_BAR;
        PG8_WAIT_V(2); PG8_BAR;
        PG8_STAGE(PG8_SB(1, 0), cB + kstep, voffB); PG8_STAGE(PG8_SA(1, 0), cA + kstep, voffA); PG8_STAGE(PG8_SB(1, 1), cB + hstep + kstep, voffB);
        PG8_WAIT_V(6); PG8_BAR;
    } else {
        PG8_STAGE(PG8_SB(0, 0), cB, voffB); PG8_STAGE(PG8_SA(0, 0), cA, voffA); PG8_STAGE(PG8_SB(0, 1), cB + hstep, voffB); PG8_STAGE(PG8_SA(0, 1), cA + hstep, voffA);
        if (wr == 1) PG8_BAR;
        PG8_WAIT_V(4); PG8_BAR;
        PG8_STAGE(PG8_SB(1, 0), cB + kstep, voffB); PG8_STAGE(PG8_SA(1, 0), cA + kstep, voffA); PG8_STAGE(PG8_SB(1, 1), cB + hstep + kstep, voffB);
        PG8_WAIT_V(6); PG8_BAR;
    }
    for (;;) {
        const bool has_next = S.next(ui + 1, nxt);
        const char* nA = has_next ? (const char*)g.A + (size_t)nxt.pm * tstep : cA; const char* nB = has_next ? (const char*)g.Bt + (size_t)nxt.pn * tstep : cB;
        for (int t = 0; t < nt; t += 2) {
            const bool last = (t == nt - 2);
            const char* a1 = cA + (size_t)(t + 1) * kstep;
            const char* a2 = last ? nA : cA + (size_t)(t + 2) * kstep; const char* b2 = last ? nB : cB + (size_t)(t + 2) * kstep;
            const char* a3 = a2 + kstep; const char* b3 = b2 + kstep;
            if (last && has_next) S.a_ready(nxt);
            if constexpr (SP2) {
            PG8_LDB(B0, 0, 0); PG8_LDB(B1, 0, 1); PG8_SCHED; PG8_LDA(At, 0, 0); PG8_STAGE(PG8_SA(1, 1), a1 + hstep, voffA);
            PG8_WAIT_V(8); PG8_WAIT_L(0); PG8_BAR; PG8_MMA(0, 0, At, B0); PG8_MMA(0, 1, At, B1); PG8_BAR; PG8_SCHED;
            PG8_LDA(At, 0, 1); PG8_STAGE(PG8_SB(0, 0), b2, voffB); PG8_STAGE(PG8_SB(0, 1), b2 + hstep, voffB); PG8_STAGE(PG8_SA(0, 0), a2, voffA);
            PG8_WAIT_V(8); PG8_WAIT_L(0); PG8_BAR; PG8_MMA(1, 0, At, B0); PG8_MMA(1, 1, At, B1); PG8_BAR; PG8_SCHED;
            PG8_LDB(B0, 1, 0); PG8_LDB(B1, 1, 1); PG8_SCHED; PG8_LDA(At, 1, 0); PG8_STAGE(PG8_SA(0, 1), a2 + hstep, voffA);
            PG8_WAIT_V(8); PG8_WAIT_L(0); PG8_BAR; PG8_MMA(0, 0, At, B0); PG8_MMA(0, 1, At, B1); PG8_BAR; PG8_SCHED;
            PG8_LDA(At, 1, 1); PG8_STAGE(PG8_SB(1, 0), b3, voffB); PG8_STAGE(PG8_SB(1, 1), b3 + hstep, voffB); PG8_STAGE(PG8_SA(1, 0), a3, voffA);
            PG8_WAIT_V(8); PG8_WAIT_L(0); PG8_BAR; PG8_MMA(1, 0, At, B0); PG8_MMA(1, 1, At, B1); PG8_BAR; PG8_SCHED;
            } else {
            PG8_LDB(B0, 0, 0); PG8_SCHED; PG8_LDA(At, 0, 0); PG8_STAGE(PG8_SA(1, 1), a1 + hstep, voffA);
            PG8_WAIT_L(8); PG8_BAR; PG8_WAIT_L(0); PG8_MMA(0, 0, At, B0); PG8_BAR; PG8_SCHED;
            PG8_LDB(B1, 0, 1); PG8_STAGE(PG8_SB(0, 0), b2, voffB);
            PG8_BAR; PG8_WAIT_L(0); PG8_MMA(0, 1, At, B1); PG8_BAR;
            PG8_LDA(At, 0, 1); PG8_STAGE(PG8_SA(0, 0), a2, voffA);
            PG8_BAR; PG8_WAIT_L(0); PG8_MMA(1, 0, At, B0); PG8_BAR; PG8_SCHED;
            PG8_STAGE(PG8_SB(0, 1), b2 + hstep, voffB);
            PG8_WAIT_V(6); PG8_BAR; PG8_MMA(1, 1, At, B1); PG8_BAR;
            PG8_LDB(B0, 1, 0); PG8_SCHED; PG8_LDA(At, 1, 0); PG8_STAGE(PG8_SA(0, 1), a2 + hstep, voffA);
            PG8_WAIT_L(8); PG8_BAR; PG8_WAIT_L(0); PG8_MMA(0, 0, At, B0); PG8_BAR; PG8_SCHED;
            PG8_LDB(B1, 1, 1); PG8_STAGE(PG8_SB(1, 0), b3, voffB);
            PG8_BAR; PG8_WAIT_L(0); PG8_MMA(0, 1, At, B1); PG8_BAR;
            PG8_LDA(At, 1, 1); PG8_STAGE(PG8_SA(1, 0), a3, voffA);
            PG8_BAR; PG8_WAIT_L(0); PG8_MMA(1, 0, At, B0); PG8_BAR; PG8_SCHED;
            PG8_STAGE(PG8_SB(1, 1), b3 + hstep, voffB);
            PG8_WAIT_V(6); PG8_BAR; PG8_MMA(1, 1, At, B1); PG8_BAR;
            }
        }
        if constexpr (ALIGN_EPI) { if (wr == 0) PG8_BAR; }
        if constexpr (!Epi::AFTER_DRAIN) { E(acc, cur, wr, wc, fr, fq); S.done(cur); }
        if (!has_next) break;
#pragma unroll
        for (int a = 0; a < 2; ++a)
#pragma unroll
            for (int b = 0; b < 2; ++b)
#pragma unroll
                for (int m = 0; m < 4; ++m)
#pragma unroll
                    for (int n = 0; n < 2; ++n) acc[a][b][m][n] = (f32x4){0.f, 0.f, 0.f, 0.f};
        cur = nxt; cA = nA; cB = nB; ++ui;
        if constexpr (ALIGN_EPI) { if (wr == 1) PG8_BAR; }
    }
    PG8_WAIT_V(0);
    if constexpr (!ALIGN_EPI) { if (wr == 0) PG8_BAR; }
    PG8_BAR;
    if constexpr (Epi::AFTER_DRAIN) { E.fused(acc, cur, wr, wc, fr, fq, lds, wid, lane); S.done(cur); }
#undef PG8_SA
#undef PG8_SB
#undef PG8_STAGE
#undef PG8_LDA
#undef PG8_LDB
#undef PG8_MMA
#undef PG8_WAIT_V
#undef PG8_WAIT_L
#undef PG8_BAR
#undef PG8_SCHED
}
}

__device__ __forceinline__ u32x4 pack8(const f32x4 a, const f32x4 b) { u32x4 w; w.x = pk2(a[0], a[1]); w.y = pk2(a[2], a[3]); w.z = pk2(b[0], b[1]); w.w = pk2(b[2], b[3]); return w; }
__device__ __forceinline__ f32x4 silu4(const f32x4 v) { f32x4 o; o[0] = v[0] * sigmoidf_(v[0]); o[1] = v[1] * sigmoidf_(v[1]); o[2] = v[2] * sigmoidf_(v[2]); o[3] = v[3] * sigmoidf_(v[3]); return o; }
__device__ __forceinline__ f32x4 sig4(const f32x4 v) { f32x4 o; o[0] = sigmoidf_(v[0]); o[1] = sigmoidf_(v[1]); o[2] = sigmoidf_(v[2]); o[3] = sigmoidf_(v[3]); return o; }

struct RowSt {
    unsigned wa, ra; int rq, cq;
    __device__ __forceinline__ RowSt(LAS unsigned char* spare, int wr, int wc, int fr, int fq) {
        int lane = fr + 16 * fq; asm volatile("" : "+v"(lane));
        const int fr_ = lane & 15, fq_ = lane >> 4; const unsigned tile = (unsigned)(size_t)spare + (unsigned)(wr * 4 + wc) * 2048u;
        wa = tile + (unsigned)fr_ * 64u + (unsigned)((fq_ ^ ((fr_ >> 2) & 3)) << 4); ra = tile + (unsigned)lane * 16u; rq = lane >> 2; cq = 8 * ((lane & 3) ^ (lane >> 4)); }
    __device__ __forceinline__ void store(bf16_t* P, size_t row16, int stride, int col, const u32x4 v, int buf) const {
        *(LAS u32x4*)(size_t)(wa + 1024u * (unsigned)buf) = v; const u32x4 t = *(const LAS u32x4*)(size_t)(ra + 1024u * (unsigned)buf);
        *(u32x4*)(P + (row16 + (size_t)rq) * (size_t)stride + col + cq) = t; }
};

struct Epi0 {
    static constexpr bool PERM = true, AFTER_DRAIN = false;
    unsigned char* ws; unsigned char* dout; bool cheap; LAS unsigned char* spare;
    __device__ __forceinline__ void operator()(const f32x4 (&acc)[2][2][4][2], const pg8::Unit& u, int wr, int wc, int fr, int fq) const {
        const int t = u.pn, cwv = wc * 32; const size_t rw = (size_t)(u.pm * 256 + wr * 64);
        const RowSt rs(spare, wr, wc, fr, fq);
        if (t < 8) {
            bf16_t* U = (bf16_t*)(ws + WS_U);
#pragma unroll
            for (int ai = 0; ai < 2; ++ai)
#pragma unroll
                for (int m = 0; m < 4; ++m) {
                    const f32x4 a = cheap ? acc[ai][0][m][0] : acc[ai][0][m][0] * sig4(acc[ai][1][m][0]), b = cheap ? acc[ai][0][m][1] : acc[ai][0][m][1] * sig4(acc[ai][1][m][1]);
                    rs.store(U, rw + ai * 128 + m * 16, 1024, 128 * t + cwv, pack8(a, b), m & 1); }
        } else if (t == 28) {
            bf16_t* WDAD = (bf16_t*)(dout + DO_WDAD);
#pragma unroll
            for (int ai = 0; ai < 2; ++ai)
#pragma unroll
                for (int m = 0; m < 4; ++m) rs.store(WDAD, rw + ai * 128 + m * 16, 128, cwv, pack8(acc[ai][0][m][0], acc[ai][0][m][1]), m & 1);
        } else {
            const bool act = ((t < 12) || (t >= 24)) && !cheap; const int c0 = 256 * (t & 3);
            unsigned char* bp = (t >= 24) ? (dout + DO_BG) : (ws + WS_AG + (size_t)((t - 8) >> 2) * (64 * MiB));
            bf16_t* base = (bf16_t*)bp;
#pragma unroll
            for (int ai = 0; ai < 2; ++ai)
#pragma unroll
                for (int m = 0; m < 4; ++m) {
#pragma unroll
                    for (int bj = 0; bj < 2; ++bj) { f32x4 a = acc[ai][bj][m][0], b = acc[ai][bj][m][1];
                        if (act) { a = silu4(a); b = silu4(b); }
                        rs.store(base, rw + ai * 128 + m * 16, 1024, c0 + 128 * bj + cwv, pack8(a, b), bj); } }
        }
    }
};
static_assert(WS_R == WS_AG + 64 * MiB && WS_K == WS_AG + 128 * MiB && WS_V == WS_AG + 192 * MiB, "Epi0 region arithmetic");

struct EpiLora {
    static constexpr bool PERM = true, AFTER_DRAIN = false;
    bf16_t *D, *A; const float* vec; LAS unsigned char* spare;
    __device__ __forceinline__ void operator()(const f32x4 (&acc)[2][2][4][2], const pg8::Unit& u, int wr, int wc, int fr, int fq) const {
        const int t = u.pn, cw = wc * 32 + 8 * fq; const size_t rw = (size_t)(u.pm * 256 + wr * 64);
        const bool isd = t < 4; bf16_t* base = isd ? D : A; const int c0 = 256 * (t & 3); const float* bias = vec + (isd ? 0 : 1024) + c0 + cw;
        const float sc = isd ? 0.60653065971f : 1.0f;
        const RowSt rs(spare, wr, wc, fr, fq);
#pragma unroll
        for (int ai = 0; ai < 2; ++ai)
#pragma unroll
            for (int m = 0; m < 4; ++m) {
#pragma unroll
                for (int bj = 0; bj < 2; ++bj) { const f32x4 b0 = *(const f32x4*)(bias + 128 * bj), b1 = *(const f32x4*)(bias + 128 * bj + 4);
                    const f32x4 a = sig4(acc[ai][bj][m][0] + b0) * sc, b = sig4(acc[ai][bj][m][1] + b1) * sc;
                    rs.store(base, rw + ai * 128 + m * 16, 1024, c0 + 128 * bj + wc * 32, pack8(a, b), bj); } }
    }
};

struct EpiRes {
    static constexpr bool PERM = false, AFTER_DRAIN = false;
    const float* resid; float* out; const float* modp; const float* ada_b; int layer; bool cheap; LAS unsigned char* spare;
    __device__ __forceinline__ void operator()(const f32x4 (&acc)[2][2][4][2], const pg8::Unit& u, int wr, int wc, int fr, int fq) const {
        const int row0 = u.pm * 256 + wr * 64 + fr, col0 = u.pn * 256 + wc * 32 + 4 * fq, b = (u.pm * 256) / SEQ;
#ifdef EPIRES_CHEAP
        if (cheap) {
            f32x4 s = (f32x4){0.f, 0.f, 0.f, 0.f};
#pragma unroll
            for (int ai = 0; ai < 2; ++ai)
#pragma unroll
                for (int bj = 0; bj < 2; ++bj)
#pragma unroll
                    for (int m = 0; m < 4; ++m)
#pragma unroll
                        for (int n = 0; n < 2; ++n) s += acc[ai][bj][m][n];
            if (s[0] + s[1] + s[2] + s[3] == 1.2345e30f) out[(size_t)row0 * 1024 + col0] = s[0];
            return; }
#endif
        f32x4 gv[2][2];
#pragma unroll
        for (int bj = 0; bj < 2; ++bj)
#pragma unroll
            for (int n = 0; n < 2; ++n) { const int c = col0 + bj * 128 + n * 16; f32x4 g = *(const f32x4*)(ada_b + layer * 3072 + 2048 + c);
#pragma unroll
                for (int s = 0; s < 8; ++s) g += *(const f32x4*)(modp + (size_t)((s * 2 + layer) * 4 + b) * 3072 + 2048 + c);
                gv[bj][n] = g; }
        const int lane = fr + 16 * fq;
        const unsigned tile = (unsigned)(size_t)spare + (unsigned)(wr * 4 + wc) * 2048u;
        const unsigned wa = tile + (unsigned)fr * 128u + (unsigned)((fq ^ (fr >> 1)) << 4);
        const unsigned ra = tile + (unsigned)lane * 16u;
        const size_t o0 = (size_t)(u.pm * 256 + wr * 64 + (lane >> 3)) * 1024 + u.pn * 256 + wc * 32 + 4 * ((lane & 7) ^ (lane >> 4));
        const size_t o1 = (size_t)(u.pm * 256 + wr * 64 + 8 + (lane >> 3)) * 1024 + u.pn * 256 + wc * 32 + 4 * ((lane & 7) ^ (4 + (lane >> 4)));
        f32x4 rr[3][2];
        auto rload = [&](int idx, f32x4 (&dst)[2]) { const int ai = idx >> 3, m = (idx >> 1) & 3, bj = idx & 1; const size_t d = (size_t)(ai * 128 + m * 16) * 1024 + bj * 128;
            dst[0] = __builtin_nontemporal_load((const f32x4*)(resid + o0 + d)); dst[1] = __builtin_nontemporal_load((const f32x4*)(resid + o1 + d)); };
        rload(0, rr[0]); rload(1, rr[1]);
#pragma unroll
        for (int idx = 0; idx < 16; ++idx) { const int ai = idx >> 3, m = (idx >> 1) & 3, bj = idx & 1; const size_t d = (size_t)(ai * 128 + m * 16) * 1024 + bj * 128;
            if (idx + 2 < 16) rload(idx + 2, rr[(idx + 2) % 3]);
            *(LAS f32x4*)(size_t)wa = gv[bj][0] * acc[ai][bj][m][0]; *(LAS f32x4*)(size_t)(wa ^ 64u) = gv[bj][1] * acc[ai][bj][m][1];
            const f32x4 t0 = *(const LAS f32x4*)(size_t)ra, t1 = *(const LAS f32x4*)(size_t)(ra + 1024u);
            *(f32x4*)(out + o0 + d) = rr[idx % 3][0] + t0; *(f32x4*)(out + o1 + d) = rr[idx % 3][1] + t1;
            asm volatile("" ::: "memory"); }
    }
};

constexpr float Q_SCALE = 0.08838834764831845f * 1.4426950408889634f;
constexpr float WI_SCALE = 0.35355339059327373f * 0.125f;
struct Epi1 {
    static constexpr bool PERM = true, AFTER_DRAIN = false;
    bf16_t *Q, *KV, *QI, *KI, *G; float* WI; const f32x2* csa; const f32x2* csi; LAS unsigned char* spare;
    __device__ __forceinline__ void rope8(const f32x4 x1a, const f32x4 x1b, const f32x4 x2a, const f32x4 x2b, const f32x4 (&tv)[4], float sc, u32x4& o1, u32x4& o2) const {
        float c[8], s[8];
#pragma unroll
        for (int j = 0; j < 4; ++j) { c[2 * j] = tv[j][0]; s[2 * j] = tv[j][1]; c[2 * j + 1] = tv[j][2]; s[2 * j + 1] = tv[j][3]; }
        float a[8], b[8];
#pragma unroll
        for (int j = 0; j < 4; ++j) { a[j] = x1a[j]; a[4 + j] = x1b[j]; b[j] = x2a[j]; b[4 + j] = x2b[j]; }
        float p[8], q[8];
#pragma unroll
        for (int j = 0; j < 8; ++j) { p[j] = (a[j] * c[j] - b[j] * s[j]) * sc; q[j] = (b[j] * c[j] + a[j] * s[j]) * sc; }
        o1.x = pk2(p[0], p[1]); o1.y = pk2(p[2], p[3]); o1.z = pk2(p[4], p[5]); o1.w = pk2(p[6], p[7]);
        o2.x = pk2(q[0], q[1]); o2.y = pk2(q[2], q[3]); o2.z = pk2(q[4], q[5]); o2.w = pk2(q[6], q[7]);
    }
    __device__ __forceinline__ void operator()(const f32x4 (&acc)[2][2][4][2], const pg8::Unit& u, int wr, int wc, int fr, int fq) const {
        const int row0 = u.pm * 256 + wr * 64 + fr, t = u.pn; const size_t rw = (size_t)(u.pm * 256 + wr * 64);
        const RowSt rs(spare, wr, wc, fr, fq);
        const bool roped = (t < 8) || (t == 8 && wc < 2) || (t >= 9 && t < 11) || (t == 11 && wc == 0);
        if (roped) {
            int lane = fr + 16 * fq; asm volatile("" : "+v"(lane));
            const bool wide = t <= 8; const int rb = wide ? 1024 : 512;
            const f32x2* tab = wide ? csa + (((rw >> 4) * 2 + (wc & 1)) * 256 + lane) * 2 : csi + ((rw >> 4) * 256 + lane) * 2;
            f32x4 tv[3][4];
            auto tload = [&](int idx, f32x4 (&d)[4]) { const f32x2* p = tab + (size_t)((idx >> 2) * 8 + (idx & 3)) * rb;
#pragma unroll
                for (int j = 0; j < 4; ++j) d[j] = *(const f32x4*)(p + 128 * j); };
            tload(0, tv[0]); tload(1, tv[1]);
            const float sc = (t < 8) ? Q_SCALE : 1.0f;
#pragma unroll
            for (int idx = 0; idx < 8; ++idx) { const int ai = idx >> 2, m = idx & 3; const size_t r16 = rw + ai * 128 + m * 16;
                if (idx + 2 < 8) tload(idx + 2, tv[(idx + 2) % 3]);
                u32x4 o1, o2; rope8(acc[ai][0][m][0], acc[ai][0][m][1], acc[ai][1][m][0], acc[ai][1][m][1], tv[idx % 3], sc, o1, o2);
                if (t < 8) { const int head = 2 * t + (wc >> 1); rs.store(Q, r16, 2048, head * 128 + (wc & 1) * 32, o1, 0); rs.store(Q, r16, 2048, head * 128 + 64 + (wc & 1) * 32, o2, 1); }
                else if (t == 8) { rs.store(KV, r16, 256, (wc & 1) * 32, o1, 0); rs.store(KV, r16, 256, 64 + (wc & 1) * 32, o2, 1); }
                else if (t < 11) { const int head = 4 * (t - 9) + wc; bf16_t* qp = QI + (((r16 >> 4) * 16 + head * 2) * 64 + lane) * 8; *(u32x4*)qp = o1; *(u32x4*)(qp + 512) = o2; }
                else { bf16_t* kp = KI + (((r16 >> 4) * 2) * 64 + lane) * 8; *(u32x4*)kp = o1; *(u32x4*)(kp + 512) = o2; }
                asm volatile("" ::: "memory"); }
        } else {
#pragma unroll
            for (int ai = 0; ai < 2; ++ai)
#pragma unroll
                for (int m = 0; m < 4; ++m) { const size_t row = (size_t)(row0 + ai * 128 + m * 16), r16 = rw + ai * 128 + m * 16;
                    const f32x4 x1a = acc[ai][0][m][0], x1b = acc[ai][0][m][1], x2a = acc[ai][1][m][0], x2b = acc[ai][1][m][1];
                    if (t == 8) { rs.store(KV, r16, 256, 128 + (wc & 1) * 32, pack8(x1a, x1b), 0); rs.store(KV, r16, 256, 192 + (wc & 1) * 32, pack8(x2a, x2b), 1); }
                    else if (t == 11) { if (wc == 1 && fq == 0) { *(f32x4*)(WI + row * 8) = x1a * WI_SCALE; *(f32x4*)(WI + row * 8 + 4) = x1b * WI_SCALE; } }
                    else if (t >= 12) { const int c0 = 256 * (t - 12);
                        rs.store(G, r16, 2048, c0 + wc * 32, pack8(silu4(x1a), silu4(x1b)), 0); rs.store(G, r16, 2048, c0 + 128 + wc * 32, pack8(silu4(x2a), silu4(x2b)), 1); }
                }
        }
    }
};

struct Args {
    const float* x; const float* c; const int* pos; const float* ada_w; const float* ada_b; const float* norm_g; const float* final_g;
    const float* even_w_in; const float* even_w_out; const float* conv_w; const float* conv_vec; const float* mu_rkv; const float* mu_lora;
    const float* rwkv_vec; const float* w_up; const float* a_up; const float* r_k; const float* odd_w_in; const float* odd_w_out;
    float* out; unsigned char* ws; int ph_lo, ph_hi;
};

template <class SrcF>
__device__ __forceinline__ void transpose_item(const SrcF& src, int K, bf16_t* WT, LAS float* scr, int item, int nblk, int lane) {
    const int kb = item / nblk, nb = item % nblk, k0 = 64 * kb, n0 = 32 * nb;
    float tv[32];
#pragma unroll
    for (int i = 0; i < 32; ++i) tv[i] = src(k0 + 2 * i + (lane >> 5), n0 + (lane & 31));
#pragma unroll
    for (int i = 0; i < 32; ++i) scr[(2 * i + (lane >> 5)) * 33 + (lane & 31)] = tv[i];
    LDS_WAIT();
    const int c = lane & 7;
#pragma unroll
    for (int j = 0; j < 4; ++j) { const int n = (lane >> 3) + 8 * j; const LAS float* s = scr + (8 * c) * 33 + n;
        u32x4 o; o.x = pk2(s[0 * 33], s[1 * 33]); o.y = pk2(s[2 * 33], s[3 * 33]); o.z = pk2(s[4 * 33], s[5 * 33]); o.w = pk2(s[6 * 33], s[7 * 33]);
        *(u32x4*)(WT + (size_t)(n0 + n) * K + k0 + 8 * c) = o; }
    LDS_WAIT();
}

__device__ __forceinline__ void transpose_item_col(const float* W, int ldw, int scol, int K, bf16_t* WT, LAS float* scr, int k0, int n0, int lane) {
    const float* wp = W + (size_t)(k0 + (lane >> 5)) * ldw + (scol < 0 ? 0 : scol);
#pragma unroll 8
    for (int i = 0; i < 32; ++i) { const float v = wp[(size_t)(2 * i) * ldw]; scr[(2 * i + (lane >> 5)) * 33 + (lane & 31)] = scol < 0 ? 0.f : v; }
    LDS_WAIT();
    const int c = lane & 7;
#pragma unroll
    for (int j = 0; j < 4; ++j) { const int n = (lane >> 3) + 8 * j; const LAS float* s = scr + (8 * c) * 33 + n;
        u32x4 o; o.x = pk2(s[0 * 33], s[1 * 33]); o.y = pk2(s[2 * 33], s[3 * 33]); o.z = pk2(s[4 * 33], s[5 * 33]); o.w = pk2(s[6 * 33], s[7 * 33]);
        *(u32x4*)(WT + (size_t)(n0 + n) * K + k0 + 8 * c) = o; }
    LDS_WAIT();
}
__device__ __forceinline__ void rope_item(const Args& a, int r, int lane, const float inv128, const float inv64) {
    const float p = (float)a.pos[r]; const int f = lane;
    { float sn, cs; sincosf(p * inv128, &sn, &cs);
      ((f32x2*)(a.ws + WS_CSA))[(size_t)((((r >> 4) * 2 + (f >> 5)) * 4 + ((f & 7) >> 1)) * 64 + (r & 15) + 16 * ((f & 31) >> 3)) * 2 + (f & 1)] = (f32x2){cs, sn}; }
    if (f < 32) { float sn, cs; sincosf(p * inv64, &sn, &cs);
      ((f32x2*)(a.ws + WS_CSI))[(size_t)(((r >> 4) * 4 + ((f & 7) >> 1)) * 64 + (r & 15) + 16 * (f >> 3)) * 2 + (f & 1)] = (f32x2){cs, sn}; }
}
__device__ __forceinline__ void p0_late(const Args& a, const int wave, LAS unsigned char* lds, int first, int nblk) {
    const int lane = lane_id(), tid = wave * 64 + lane;
    LAS float* scr = (LAS float*)(lds + wave * 16384);
    const int gw = ((int)blockIdx.x - first) * NWAVES + wave, NGW = nblk * NWAVES;
    unsigned char* ws = a.ws;
    constexpr int I_WO = (2048 / 64) * (DM / 32), I_W1 = (DM / 64) * (N1 / 32), I_ROPE = MTOK;
    for (int it = gw; it < I_W1 + I_WO + I_ROPE; it += NGW) {
        int r = it;
        if (r < I_W1) { const int nblk = N1 / 32, k0 = 64 * (r / nblk), n0 = 32 * (r % nblk); transpose_item_col(a.odd_w_in, ODD_COLS, map1(n0 + (lane & 31)), DM, (bf16_t*)(ws + WS_WIN1), scr, k0, n0, lane); continue; } r -= I_W1;
        if (r < I_WO) { const int nblk = DM / 32, k0 = 64 * (r / nblk), n0 = 32 * (r % nblk); transpose_item_col(a.odd_w_out, DM, n0 + (lane & 31), 2048, (bf16_t*)(ws + WS_WOUT1), scr, k0, n0, lane); continue; } r -= I_WO;
        {
            const float p = (float)a.pos[r];
            { const float inv = powf(10000.0f, -(float)(2 * lane) / 128.0f); float sn, cs; sincosf(p * inv, &sn, &cs); ((f32x2*)(ws + WS_CSA))[(size_t)r * 64 + lane] = (f32x2){cs, sn}; }
            if (lane < 32) { const float inv = powf(10000.0f, -(float)(2 * lane) / 64.0f); float sn, cs; sincosf(p * inv, &sn, &cs); ((f32x2*)(ws + WS_CSI))[(size_t)r * 32 + lane] = (f32x2){cs, sn}; }
        }
    }
}
__device__ __forceinline__ void p0_prologue(const Args& a, const int wave, LAS unsigned char* lds) {
    const int lane = lane_id(), tid = wave * 64 + lane;
    LAS float* scr = (LAS float*)(lds + wave * 16384);
    const int gw = blockIdx.x * NWAVES + wave, NGW = gridDim.x * NWAVES;
    unsigned char* ws = a.ws;
    constexpr int I_W0 = (DM / 64) * (N0 / 32), I_WO = (2048 / 64) * (DM / 32), I_W1 = (DM / 64) * (N1 / 32), I_WL = (128 / 64) * (2048 / 32), I_MOD = 96 * 8, I_ROPE = MTOK;
    constexpr int NITEMS = I_W0 + I_WO + I_W1 + I_WO + I_WL + I_MOD + I_ROPE;
    constexpr int N_EARLY = I_W0 + I_WO + I_W1 + I_WO + I_WL + I_MOD;
    for (int it = gw; it < N_EARLY; it += NGW) {
        int r = it;
        if (r < I_W0) { const float* W = a.even_w_in; transpose_item([W](int k, int n) { const int s = map0(n); return s < 0 ? 0.f : __builtin_nontemporal_load(W + (size_t)k * EVEN_COLS + s); }, DM, (bf16_t*)(ws + WS_WIN0), scr, r, N0 / 32, lane); continue; } r -= I_W0;
        if (r < I_WO) { const float* W = a.even_w_out; transpose_item([W](int k, int n) { return __builtin_nontemporal_load(W + (size_t)k * DM + n); }, 2048, (bf16_t*)(ws + WS_WOUT0), scr, r, DM / 32, lane); continue; } r -= I_WO;
        if (r < I_W1) { const float* W = a.odd_w_in; transpose_item([W](int k, int n) { const int s = map1(n); return s < 0 ? 0.f : __builtin_nontemporal_load(W + (size_t)k * ODD_COLS + s); }, DM, (bf16_t*)(ws + WS_WIN1), scr, r, N1 / 32, lane); continue; } r -= I_W1;
        if (r < I_WO) { const float* W = a.odd_w_out; transpose_item([W](int k, int n) { return __builtin_nontemporal_load(W + (size_t)k * DM + n); }, 2048, (bf16_t*)(ws + WS_WOUT1), scr, r, DM / 32, lane); continue; } r -= I_WO;
        if (r < I_WL) { const float* wu = a.w_up; const float* au = a.a_up;
            transpose_item([wu, au](int k, int n) { if (n < 1024) return k < 64 ? wu[k * 1024 + n] : 0.f; return (k >= 64 && k < 128) ? au[(k - 64) * 1024 + (n - 1024)] : 0.f; }, 128, (bf16_t*)(ws + WS_WLORA), scr, r, 2048 / 32, lane); continue; } r -= I_WL;
        if (r < I_MOD) {
            const int cgp = r >> 3, ks = r & 7, col = cgp * 64 + lane, l = col / 3072, cc = col - l * 3072;
#pragma unroll
            for (int i = 0; i < 8; ++i) { const int idx = lane + 64 * i, bb = idx >> 7, kk = idx & 127; const float cv = a.c[bb * DM + ks * 128 + kk]; scr[kk * 4 + bb] = cv * sigmoidf_(cv); }
            LDS_WAIT();
            const float* W = a.ada_w + (size_t)l * DM * 3072 + cc + (size_t)(ks * 128) * 3072; f32x4 acc4 = (f32x4){0.f, 0.f, 0.f, 0.f};
#pragma unroll 1
            for (int k8 = 0; k8 < 128; k8 += 16) { float wv[16];
#pragma unroll
                for (int i = 0; i < 16; ++i) wv[i] = W[(size_t)(k8 + i) * 3072];
#pragma unroll
                for (int i = 0; i < 16; ++i) acc4 += *(const LAS f32x4*)(scr + (k8 + i) * 4) * wv[i]; }
            LDS_WAIT();
            const float acc0 = acc4[0], acc1 = acc4[1], acc2 = acc4[2], acc3 = acc4[3];
            float* mp = (float*)(ws + WS_MODP) + (size_t)((ks * 2 + l) * 4) * 3072 + cc;
            mp[0] = acc0; mp[3072] = acc1; mp[2 * 3072] = acc2; mp[3 * 3072] = acc3; continue; } r -= I_MOD;
    }
}

__device__ __forceinline__ void norm_phase(const Args& a, const int wave, LAS unsigned char* lds, const float* src, int layer) {
    const int lane = lane_id(), tid = wave * 64 + lane;
    LAS float* gs = (LAS float*)lds; LAS float* sh = gs + DM;
    const float* modp = (const float*)(a.ws + WS_MODP); bf16_t* H = (bf16_t*)(a.ws + WS_H);
    for (int tile = blockIdx.x; tile < MTOK / 128; tile += gridDim.x) {
        const int b = (tile * 128) / SEQ;
        __syncthreads();
        for (int c = tid; c < DM; c += NTHREADS) {
            float sc = a.ada_b[layer * 3072 + 1024 + c], sf = a.ada_b[layer * 3072 + c];
#pragma unroll
            for (int s = 0; s < 8; ++s) { const float* mp = modp + (size_t)((s * 2 + layer) * 4 + b) * 3072; sc += mp[1024 + c]; sf += mp[c]; }
            gs[c] = a.norm_g[layer * DM + c] * (1.0f + sc); sh[c] = sf; }
        __syncthreads();
        for (int r4 = 0; r4 < 16; r4 += 4) {
            f32x4 v[4][4]; float ss[4];
#pragma unroll
            for (int q = 0; q < 4; ++q) { const size_t m = (size_t)tile * 128 + wave * 16 + r4 + q; const f32x4* xr = (const f32x4*)(src + m * DM) + lane;
#pragma unroll
                for (int j = 0; j < 4; ++j) v[q][j] = __builtin_nontemporal_load(xr + 64 * j); }
#pragma unroll
            for (int q = 0; q < 4; ++q) { float s = 0.f;
#pragma unroll
                for (int j = 0; j < 4; ++j) s += (v[q][j][0] * v[q][j][0] + v[q][j][1] * v[q][j][1]) + (v[q][j][2] * v[q][j][2] + v[q][j][3] * v[q][j][3]);
                ss[q] = s; }
#pragma unroll
            for (int q = 0; q < 4; ++q) ss[q] = wave_sum(ss[q]);
#pragma unroll
            for (int q = 0; q < 4; ++q) { const size_t m = (size_t)tile * 128 + wave * 16 + r4 + q; const float rstd = rsqrtf(ss[q] * (1.0f / DM) + 1e-6f);
                u32x2* o = (u32x2*)(H + m * DM) + lane;
#pragma unroll
                for (int j = 0; j < 4; ++j) { const f32x4 g = *(const LAS f32x4*)(gs + 4 * (64 * j + lane)), s = *(const LAS f32x4*)(sh + 4 * (64 * j + lane));
                    const f32x4 h = v[q][j] * rstd * g + s; u32x2 w; w.x = pk2(h[0], h[1]); w.y = pk2(h[2], h[3]); o[64 * j] = w; } }
        }
    }
}

__device__ __forceinline__ void final_phase(const Args& a, const int wave) {
    const int lane = lane_id(), tid = wave * 64 + lane;
    const int gw = blockIdx.x * NWAVES + wave, NGW = gridDim.x * NWAVES;
    f32x4 g[4];
#pragma unroll
    for (int j = 0; j < 4; ++j) g[j] = *((const f32x4*)a.final_g + 64 * j + lane);
    float tsc = 1.0f;
#ifdef STAMP_K
    { const unsigned long long* st = (const unsigned long long*)(a.ws + WS_STAMP); tsc = 1.0f + (float)(st[1] - st[0] + st[2]) * 1e-7f; }
#endif
    for (int m0 = 4 * gw; m0 < MTOK; m0 += 4 * NGW) {
        f32x4 v[4][4]; float ss[4];
#pragma unroll
        for (int q = 0; q < 4; ++q) { const f32x4* xr = (const f32x4*)(a.out + (size_t)(m0 + q) * DM) + lane;
#pragma unroll
            for (int j = 0; j < 4; ++j) v[q][j] = __builtin_nontemporal_load(xr + 64 * j); }
#pragma unroll
        for (int q = 0; q < 4; ++q) { float s = 0.f;
#pragma unroll
            for (int j = 0; j < 4; ++j) s += (v[q][j][0] * v[q][j][0] + v[q][j][1] * v[q][j][1]) + (v[q][j][2] * v[q][j][2] + v[q][j][3] * v[q][j][3]);
            ss[q] = wave_sum(s); }
#pragma unroll
        for (int q = 0; q < 4; ++q) { const float rstd = rsqrtf(ss[q] * (1.0f / DM) + 1e-6f) * tsc; f32x4* xr = (f32x4*)(a.out + (size_t)(m0 + q) * DM) + lane;
#pragma unroll
            for (int j = 0; j < 4; ++j) __builtin_nontemporal_store(v[q][j] * rstd * g[j], xr + 64 * j); }
    }
}


__device__ __forceinline__ void conv_phase(const Args& a, const int wave, LAS unsigned char* lds, int first, int stride) {
    const int lane = lane_id(), tid = wave * 64 + lane;
    const bf16_t* U = (const bf16_t*)(a.ws + WS_U); const bf16_t* AG = (const bf16_t*)(a.ws + WS_AG); bf16_t* YAB = (bf16_t*)(a.ws + WS_YAB);
    f32x2 w[31];
#pragma unroll
    for (int j = 0; j < 31; ++j) w[j] = *(const f32x2*)(a.conv_w + j * DM + 2 * tid);
    const f32x2 cbias = *(const f32x2*)(a.conv_vec + 2 * tid);
    for (int tile = first; tile < MTOK / 32; tile += stride) {
        const int b = tile >> 8, s0 = (tile & 255) * 32;
        __syncthreads();
        for (int idx = tid; idx < 62 * 128; idx += NTHREADS) { const int row = idx >> 7, ch = idx & 127, s = s0 - 30 + row;
            u32x4 v = (u32x4){0u, 0u, 0u, 0u}; if (s >= 0) v = *(const u32x4*)(U + ((size_t)(b * SEQ + s)) * DM + ch * 8);
            *(LAS u32x4*)(lds + row * 2048 + ch * 16) = v; }
        __syncthreads();
        LAS unsigned char* rb0 = lds + tid * 4; LAS unsigned char* rb1 = rb0 + 65536; LAS unsigned char* wb0 = lds + tid * 8; LAS unsigned char* wb1 = wb0 + 65536;
        asm volatile("" : "+v"(rb0), "+v"(rb1), "+v"(wb0), "+v"(wb1));
        f32x2 acc[32];
#pragma unroll
        for (int t = 0; t < 32; ++t) acc[t] = (f32x2){0.f, 0.f};
#pragma unroll
        for (int i = 0; i < 62; ++i) { const unsigned xw = (i < 32) ? *(const LAS unsigned*)(rb0 + i * 2048) : *(const LAS unsigned*)(rb1 + (i - 32) * 2048); const f32x2 xv = (f32x2){bflo(xw), bfhi(xw)};
#pragma unroll
            for (int t = (i > 30 ? i - 30 : 0); t <= (i < 31 ? i : 31); ++t) acc[t] += xv * w[i - t]; }
        __syncthreads();
#pragma unroll
        for (int t = 0; t < 32; ++t) { if (t < 16) *(LAS f32x2*)(wb0 + t * 4096) = acc[t] + cbias; else *(LAS f32x2*)(wb1 + (t - 16) * 4096) = acc[t] + cbias; }
        __syncthreads();
        f32x4 lw[4], lb[4];
#pragma unroll
        for (int j = 0; j < 4; ++j) { lw[j] = *(const f32x4*)(a.conv_vec + DM + 4 * (lane + 64 * j)); lb[j] = *(const f32x4*)(a.conv_vec + 2 * DM + 4 * (lane + 64 * j)); }
        for (int tt = 0; tt < 4; ++tt) { const int t = wave * 4 + tt; const size_t m = (size_t)b * SEQ + s0 + t;
            f32x4 v[4]; float s = 0.f;
#pragma unroll
            for (int j = 0; j < 4; ++j) { v[j] = *(const LAS f32x4*)(lds + (size_t)t * 4096 + 16 * (lane + 64 * j)); s += (v[j][0] + v[j][1]) + (v[j][2] + v[j][3]); }
            const float mean = wave_sum(s) * (1.0f / DM); float q = 0.f;
#pragma unroll
            for (int j = 0; j < 4; ++j) { v[j] = v[j] - mean; q += (v[j][0] * v[j][0] + v[j][1] * v[j][1]) + (v[j][2] * v[j][2] + v[j][3] * v[j][3]); }
            const float rstd = rsqrtf(wave_sum(q) * (1.0f / DM) + 1e-5f);
#pragma unroll
            for (int j = 0; j < 4; ++j) { const f32x4 y = v[j] * rstd * lw[j] + lb[j]; const u32x2 g = *(const u32x2*)(AG + m * DM + 4 * (lane + 64 * j));
                const f32x4 o = silu4(y) * (f32x4){bflo(g.x), bfhi(g.x), bflo(g.y), bfhi(g.y)};
                u32x2 wv; wv.x = pk2(o[0], o[1]); wv.y = pk2(o[2], o[3]); *(u32x2*)(YAB + m * 2048 + 4 * (lane + 64 * j)) = wv; }
        }
    }
}

__device__ __forceinline__ void lora_pre_phase(const Args& a, const int wave) {
    const int lane = lane_id(), tid = wave * 64 + lane;

        const bf16_t* WDAD = (const bf16_t*)((unsigned char*)a.out + DO_WDAD); bf16_t* LA = (bf16_t*)((unsigned char*)a.out + DO_LA);
        const int gw = blockIdx.x * NWAVES + wave, NGW = gridDim.x * NWAVES;
        const f32x2 mu = *(const f32x2*)(a.mu_lora + 2 * lane);
        for (int m0 = gw * 4; m0 < MTOK; m0 += NGW * 4) {
            unsigned cur[4], prv[4];
#pragma unroll
            for (int i = 0; i < 4; ++i) { const int m = m0 + i; cur[i] = *(const unsigned*)(WDAD + (size_t)m * 128 + 2 * lane); }
#pragma unroll
            for (int i = 0; i < 4; ++i) { const int m = m0 + i; if (i > 0) prv[i] = cur[i - 1]; else { prv[0] = 0u; if ((m & (SEQ - 1)) > 0) prv[0] = *(const unsigned*)(WDAD + (size_t)(m - 1) * 128 + 2 * lane); } }
#pragma unroll
            for (int i = 0; i < 4; ++i) { const int m = m0 + i;
                float v0 = bflo(cur[i]), v1 = bfhi(cur[i]); v0 += (bflo(prv[i]) - v0) * mu[0]; v1 += (bfhi(prv[i]) - v1) * mu[1];
                if (lane < 32) { v0 = tanhf(v0); v1 = tanhf(v1); }
                *(unsigned*)(LA + (size_t)m * 128 + 2 * lane) = pk2(v0, v1); }
        }
    }

struct ScanRaw { u32x2 r, rp, k, kp, v, vp, d, a; };
constexpr int SC_CH = 16, SC_BUF_F = 5 * SC_CH * 64 + SC_CH * 16;

__device__ __forceinline__ void scan_phase(const Args& a, const int wave, LAS unsigned char* lds) {
    const int lane = lane_id(), tid = wave * 64 + lane;
    const bf16_t* Rg = (const bf16_t*)(a.ws + WS_R); const bf16_t* Kg = (const bf16_t*)(a.ws + WS_K); const bf16_t* Vg = (const bf16_t*)(a.ws + WS_V);
    const bf16_t* Dg = (const bf16_t*)(a.ws + WS_DARR); const bf16_t* Ag = (const bf16_t*)(a.ws + WS_AARR);
    bf16_t* YAB = (bf16_t*)(a.ws + WS_YAB); float* RK = (float*)((unsigned char*)a.out + DO_RK);
    LAS float* bufs = (LAS float*)lds; LAS float* ybuf = bufs + 2 * SC_BUF_F;
    constexpr int NCH = SEQ / SC_CH;
    for (int job = blockIdx.x; job < 256; job += gridDim.x) {
        const int vcu = (gridDim.x == 256) ? ((job & 7) * 32 + (job >> 3)) : job;
        const int bh = vcu >> 2, vq = vcu & 3, b = bh >> 4, h = bh & 15;
        __syncthreads();
        if (wave >= 4) {
            const int pt = tid - 256, tok = pt >> 4, cgp = pt & 15, ch = h * 64 + 4 * cgp;
            const f32x4 mur = *(const f32x4*)(a.mu_rkv + ch), muk = *(const f32x4*)(a.mu_rkv + DM + ch), muv = *(const f32x4*)(a.mu_rkv + 2 * DM + ch);
            const f32x4 k_k = *(const f32x4*)(a.rwkv_vec + 2 * DM + ch), k_a = *(const f32x4*)(a.rwkv_vec + 3 * DM + ch), rkw = *(const f32x4*)(a.r_k + ch);
            auto load = [&](int c) { ScanRaw q; const int s = c * SC_CH + tok; const size_t m = (size_t)b * SEQ + s; const size_t o = m * DM + ch; const size_t op = (s > 0) ? o - DM : o;
                q.r = *(const u32x2*)(Rg + o); q.k = *(const u32x2*)(Kg + o); q.v = *(const u32x2*)(Vg + o); q.d = *(const u32x2*)(Dg + o); q.a = *(const u32x2*)(Ag + o);
                q.rp = *(const u32x2*)(Rg + op); q.kp = *(const u32x2*)(Kg + op); q.vp = *(const u32x2*)(Vg + op);
                if (s == 0) { q.rp = (u32x2){0u, 0u}; q.kp = (u32x2){0u, 0u}; q.vp = (u32x2){0u, 0u}; }
                return q; };
            auto un4 = [](u32x2 w) { return (f32x4){bflo(w.x), bfhi(w.x), bflo(w.y), bfhi(w.y)}; };
            auto process = [&](const ScanRaw& q, int c, LAS float* buf) {
                const f32x4 r0 = un4(q.r), k0 = un4(q.k), v0 = un4(q.v);
                const f32x4 rl = r0 + (un4(q.rp) - r0) * mur, kl = k0 + (un4(q.kp) - k0) * muk, vl = v0 + (un4(q.vp) - v0) * muv;
                const f32x4 d = un4(q.d), av = un4(q.a);
                f32x4 wdec; wdec[0] = __expf(-d[0]); wdec[1] = __expf(-d[1]); wdec[2] = __expf(-d[2]); wdec[3] = __expf(-d[3]);
                const f32x4 kkr = kl * k_k; float ss = (kkr[0] * kkr[0] + kkr[1] * kkr[1]) + (kkr[2] * kkr[2] + kkr[3] * kkr[3]); ss = row16_sum(ss);
                const float inv = 1.0f / fmaxf(sqrtf(ss), 1e-12f);
                const f32x4 kk = kkr * inv, kp = kl * (1.0f + (av - 1.0f) * k_a), bb = kk * av;
                float rk = (rl[0] * kp[0] * rkw[0] + rl[1] * kp[1] * rkw[1]) + (rl[2] * kp[2] * rkw[2] + rl[3] * kp[3] * rkw[3]); rk = row16_sum(rk);
                const int o = tok * 64 + 4 * cgp;
                *(LAS f32x4*)(buf + o) = -kk; *(LAS f32x4*)(buf + 1024 + o) = wdec; *(LAS f32x4*)(buf + 2048 + o) = bb; *(LAS f32x4*)(buf + 3072 + o) = kp; *(LAS f32x4*)(buf + 4096 + o) = rl;
                if ((cgp >> 2) == vq) *(LAS f32x4*)(buf + 5120 + tok * 16 + 4 * (cgp & 3)) = vl;
                if (vq == 0 && cgp == 0) RK[((size_t)b * SEQ + c * SC_CH + tok) * 16 + h] = rk; };
            auto flush = [&](int c, const LAS float* yb) {
                if (wave == 4) { const int t2 = lane >> 2, rq = lane & 3; const f32x4 y = *(const LAS f32x4*)(yb + t2 * 16 + 4 * rq);
                    u32x2 wv; wv.x = pk2(y[0], y[1]); wv.y = pk2(y[2], y[3]);
                    *(u32x2*)(YAB + ((size_t)b * SEQ + c * SC_CH + t2) * 2048 + 1024 + h * 64 + 16 * vq + 4 * rq) = wv; } };
            ScanRaw q0 = load(0), q1 = load(1);
            process(q0, 0, bufs); q0 = q1; q1 = load(2);
            __syncthreads();
            for (int c = 0; c < NCH; ++c) {
                if (c + 1 < NCH) process(q0, c + 1, bufs + ((c + 1) & 1) * SC_BUF_F);
                q0 = q1; if (c + 3 < NCH) q1 = load(c + 3);
                if (c >= 1) flush(c - 1, ybuf + ((c - 1) & 1) * 256);
                __syncthreads();
            }
            flush(NCH - 1, ybuf + ((NCH - 1) & 1) * 256);
        } else {
            const int rw = lane >> 4, ks = lane & 15, row = wave * 4 + rw;
            float s0 = 0.f, s1 = 0.f, s2 = 0.f, s3 = 0.f;
            __syncthreads();
            for (int c = 0; c < NCH; ++c) {
                const LAS float* buf = bufs + (c & 1) * SC_BUF_F; LAS float* yb = ybuf + (c & 1) * 256;
#pragma unroll
                for (int t = 0; t < SC_CH; ++t) {
                    const f32x4 nk = *(const LAS f32x4*)(buf + t * 64 + 4 * ks), w4 = *(const LAS f32x4*)(buf + 1024 + t * 64 + 4 * ks), b4 = *(const LAS f32x4*)(buf + 2048 + t * 64 + 4 * ks);
                    const f32x4 kp = *(const LAS f32x4*)(buf + 3072 + t * 64 + 4 * ks), r4 = *(const LAS f32x4*)(buf + 4096 + t * 64 + 4 * ks); const float vv = buf[5120 + t * 16 + row];
                    float sa = (s0 * nk[0] + s1 * nk[1]) + (s2 * nk[2] + s3 * nk[3]); sa = row16_sum(sa);
                    s0 = s0 * w4[0] + (sa * b4[0] + vv * kp[0]); s1 = s1 * w4[1] + (sa * b4[1] + vv * kp[1]);
                    s2 = s2 * w4[2] + (sa * b4[2] + vv * kp[2]); s3 = s3 * w4[3] + (sa * b4[3] + vv * kp[3]);
                    float y = (s0 * r4[0] + s1 * r4[1]) + (s2 * r4[2] + s3 * r4[3]); y = row16_sum(y);
                    if (ks == 0) yb[t * 16 + row] = y;
                }
                __syncthreads();
            }
        }
    }
}

__device__ __forceinline__ void post_phase(const Args& a, const int wave) {
    const int lane = lane_id();
    const int gw = blockIdx.x * NWAVES + wave, NGW = gridDim.x * NWAVES;
    const bf16_t* Vg = (const bf16_t*)(a.ws + WS_V); const bf16_t* BG = (const bf16_t*)((unsigned char*)a.out + DO_BG); const float* RK = (const float*)((unsigned char*)a.out + DO_RK);
    bf16_t* YAB = (bf16_t*)(a.ws + WS_YAB);
    f32x4 muv[2][2], lw[2][2], lb[2][2];
#pragma unroll
    for (int hf = 0; hf < 2; ++hf)
#pragma unroll
        for (int j = 0; j < 2; ++j) { const int c = 512 * hf + 8 * lane + 4 * j; muv[hf][j] = *(const f32x4*)(a.mu_rkv + 2 * DM + c); lw[hf][j] = *(const f32x4*)(a.rwkv_vec + 4 * DM + c); lb[hf][j] = *(const f32x4*)(a.rwkv_vec + 5 * DM + c); }
    auto un4 = [](unsigned x, unsigned y) { return (f32x4){bflo(x), bfhi(x), bflo(y), bfhi(y)}; };
    auto sum8 = [](float x) { x += dppmov<0xB1>(x); x += dppmov<0x4E>(x); x += dppmov<0x141>(x); return x; };
    for (int m0 = 2 * gw; m0 < MTOK; m0 += 2 * NGW) {
        u32x4 yv[2][2], vv[2][2], gv[2][2], pv[2]; float rk[2][2];
#pragma unroll
        for (int t = 0; t < 2; ++t)
#pragma unroll
            for (int hf = 0; hf < 2; ++hf) { const size_t m = (size_t)(m0 + t); const int c = 512 * hf + 8 * lane;
                yv[t][hf] = __builtin_nontemporal_load((const u32x4*)(YAB + m * 2048 + 1024 + c)); vv[t][hf] = __builtin_nontemporal_load((const u32x4*)(Vg + m * DM + c)); gv[t][hf] = __builtin_nontemporal_load((const u32x4*)(BG + m * DM + c));
                rk[t][hf] = RK[m * 16 + 8 * hf + (lane >> 3)]; }
#pragma unroll
        for (int hf = 0; hf < 2; ++hf) { pv[hf] = (u32x4){0u, 0u, 0u, 0u}; if ((m0 & (SEQ - 1)) > 0) pv[hf] = *(const u32x4*)(Vg + (size_t)(m0 - 1) * DM + 512 * hf + 8 * lane); }
#pragma unroll
        for (int t = 0; t < 2; ++t)
#pragma unroll
            for (int hf = 0; hf < 2; ++hf) { const u32x4 yw = yv[t][hf], vw = vv[t][hf], gw4 = gv[t][hf], pw = (t == 0) ? pv[hf] : vv[0][hf];
                f32x4 y[2] = {un4(yw.x, yw.y), un4(yw.z, yw.w)}; const f32x4 v[2] = {un4(vw.x, vw.y), un4(vw.z, vw.w)}, p[2] = {un4(pw.x, pw.y), un4(pw.z, pw.w)}, g[2] = {un4(gw4.x, gw4.y), un4(gw4.z, gw4.w)};
                const float mean = sum8((y[0][0] + y[0][1]) + (y[0][2] + y[0][3]) + (y[1][0] + y[1][1]) + (y[1][2] + y[1][3])) * (1.0f / 64.0f);
                y[0] = y[0] - mean; y[1] = y[1] - mean;
                const float rstd = rsqrtf(sum8((y[0][0] * y[0][0] + y[0][1] * y[0][1]) + (y[0][2] * y[0][2] + y[0][3] * y[0][3]) + (y[1][0] * y[1][0] + y[1][1] * y[1][1]) + (y[1][2] * y[1][2] + y[1][3] * y[1][3])) * (1.0f / 64.0f) + 64e-5f);
                u32x4 o;
#pragma unroll
                for (int j = 0; j < 2; ++j) { const f32x4 vl = v[j] + (p[j] - v[j]) * muv[hf][j]; const f32x4 r = (y[j] * rstd * lw[hf][j] + lb[hf][j] + rk[t][hf] * vl) * g[j];
                    if (j) { o.z = pk2(r[0], r[1]); o.w = pk2(r[2], r[3]); } else { o.x = pk2(r[0], r[1]); o.y = pk2(r[2], r[3]); } }
                *(u32x4*)(YAB + (size_t)(m0 + t) * 2048 + 1024 + 512 * hf + 8 * lane) = o; }
    }
}

constexpr int CS_L = 32, CS_NCH = SEQ / CS_L, CS_NSLOT = 3;
constexpr int CS_NT = 0, CS_RT = 4096, CS_BT = 8192, CS_KT = 12288, CS_TM = 8192, CS_AKN = 10240, CS_ABR = 12288, CS_AKR = 14336, CS_BC = 16384, CS_KC = 20480, CS_VC = 24576, CS_GL = 28672, CS_SLOT = 29184;
constexpr int CS_RAW = CS_NSLOT * CS_SLOT, CS_RAWSZ = 5 * 33 * 128;
constexpr int CS_FLAGS = CS_RAW + CS_NSLOT * CS_RAWSZ;
static_assert(CS_FLAGS + 64 <= LDS_BYTES && (CS_RAW % 16) == 0 && (CS_RAWSZ % 16) == 0, "chunked scan LDS map");
__device__ __forceinline__ int permp(int j) { return 8 * ((j & 15) >> 2) + 4 * (j >> 4) + (j & 3); }
template <int CTRL, int RM> __device__ __forceinline__ float dppf(float x) { return __int_as_float(__builtin_amdgcn_update_dpp(0, __float_as_int(x), CTRL, RM, 0xf, true)); }
__device__ __forceinline__ float wave_total(float x) {
    x = row16_sum(x); x += dppf<0x142, 0xa>(x); x += dppf<0x143, 0xc>(x); return __int_as_float(__builtin_amdgcn_readlane(__float_as_int(x), 63)); }
__device__ __forceinline__ float wave_sum64(float x) { x = row16_sum(x); x += __shfl_xor(x, 16); x += __shfl_xor(x, 32); return x; }
__device__ __forceinline__ bf16x8 cfrag(const f32x16& x, int s) {
    u32x4 w; w.x = pk2(x[8 * s + 0], x[8 * s + 1]); w.y = pk2(x[8 * s + 2], x[8 * s + 3]); w.z = pk2(x[8 * s + 4], x[8 * s + 5]); w.w = pk2(x[8 * s + 6], x[8 * s + 7]); return __builtin_bit_cast(bf16x8, w); }
__device__ __forceinline__ bf16x8 cfrag2(const f32x4& a, const f32x4& b) { u32x4 w; w.x = pk2(a[0], a[1]); w.y = pk2(a[2], a[3]); w.z = pk2(b[0], b[1]); w.w = pk2(b[2], b[3]); return __builtin_bit_cast(bf16x8, w); }
__device__ __forceinline__ void lds_poll_ge(LAS unsigned* p, unsigned want) { while (__hip_atomic_load(p, __ATOMIC_RELAXED, __HIP_MEMORY_SCOPE_WORKGROUP) < want) __builtin_amdgcn_s_sleep(1); asm volatile("" ::: "memory"); }

__device__ __forceinline__ void cscan_job(const Args& a, const int wave, LAS unsigned char* lds, int bh) {
    int lane; asm volatile("v_mbcnt_lo_u32_b32 %0, -1, 0\n\tv_mbcnt_hi_u32_b32 %0, -1, %0" : "=v"(lane));
    const int tid = wave * 64 + lane;
    const int b = bh >> 4, h = bh & 15;
    const bf16_t* Rg = (const bf16_t*)(a.ws + WS_R); const bf16_t* Kg = (const bf16_t*)(a.ws + WS_K); const bf16_t* Vg = (const bf16_t*)(a.ws + WS_V);
    const bf16_t* Dg = (const bf16_t*)(a.ws + WS_DARR); const bf16_t* Ag = (const bf16_t*)(a.ws + WS_AARR);
    bf16_t* YAB = (bf16_t*)(a.ws + WS_YAB); float* RK = (float*)((unsigned char*)a.out + DO_RK);
    LAS unsigned* ready = (LAS unsigned*)(lds + CS_FLAGS); LAS unsigned* done = ready + CS_NSLOT; LAS unsigned* rawready = done + CS_NSLOT; LAS unsigned* rawfree = rawready + CS_NSLOT;
    __syncthreads();
    if (tid < 4 * CS_NSLOT) ready[tid] = 0u;
    __syncthreads();
    if (wave == 4) {
        const int rr = lane >> 3, cc = lane & 7;
        for (int c = 0; c < CS_NCH; ++c) {
            const int s = c % CS_NSLOT; LAS unsigned char* rw = lds + CS_RAW + s * CS_RAWSZ;
            const size_t m0 = (size_t)b * SEQ + (size_t)c * CS_L;
            u32x4 v[5][4], vp[3];
#pragma unroll
            for (int ar = 0; ar < 5; ++ar) { const bf16_t* src = (ar == 0) ? Rg : (ar == 1) ? Kg : (ar == 2) ? Vg : (ar == 3) ? Dg : Ag;
#pragma unroll
                for (int q4 = 0; q4 < 4; ++q4) v[ar][q4] = *(const u32x4*)(src + (m0 + 8 * q4 + rr) * DM + h * 64 + 8 * cc); }
#pragma unroll
            for (int ar = 0; ar < 3; ++ar) { const bf16_t* src = (ar == 0) ? Rg : (ar == 1) ? Kg : Vg; vp[ar] = (u32x4){0u, 0u, 0u, 0u};
                if (c > 0 && lane < 8) vp[ar] = *(const u32x4*)(src + (m0 - 1) * DM + h * 64 + 8 * cc); }
            if (c >= CS_NSLOT) lds_poll_ge(rawfree + s, (unsigned)(c / CS_NSLOT));
#pragma unroll
            for (int ar = 0; ar < 5; ++ar)
#pragma unroll
                for (int q4 = 0; q4 < 4; ++q4) *(LAS u32x4*)(rw + (ar * 33 + 1 + 8 * q4 + rr) * 128 + 16 * cc) = v[ar][q4];
            if (lane < 8) {
#pragma unroll
                for (int ar = 0; ar < 3; ++ar) *(LAS u32x4*)(rw + (ar * 33) * 128 + 16 * cc) = vp[ar]; }
            LDS_WAIT();
            if (lane == 0) __hip_atomic_store(rawready + s, (unsigned)(c + 1), __ATOMIC_RELAXED, __HIP_MEMORY_SCOPE_WORKGROUP);
        }
    } else if (wave >= 5) {
        const int hw = wave - 5, gch = h * 64 + lane;
        const float mur = a.mu_rkv[gch], muk = a.mu_rkv[DM + gch], muv = a.mu_rkv[2 * DM + gch], kkw = a.rwkv_vec[2 * DM + gch], kaw = a.rwkv_vec[3 * DM + gch], rkw = a.r_k[gch];
        const int kpos = 32 * (lane >> 5) + permp(lane & 31);
        for (int c = hw; c < CS_NCH; c += CS_NSLOT) {
            const int s = hw; LAS unsigned char* sl = lds + s * CS_SLOT; const LAS unsigned short* rw = (const LAS unsigned short*)(lds + CS_RAW + s * CS_RAWSZ);
            const unsigned use = (unsigned)(c / CS_NSLOT);
            { PROBE_BEGIN(10, a.ws, wave);
            if (use > 0u) lds_poll_ge(done + s, 4u * use);
            lds_poll_ge(rawready + s, (unsigned)(c + 1));
            PROBE_END(10, a.ws, wave); }
            PROBE_BEGIN(11, a.ws, wave);
            const size_t m0 = (size_t)b * SEQ + (size_t)c * CS_L; const size_t o0 = m0 * DM + gch;
            float rp = bflo((unsigned)rw[(0 * 33) * 64 + lane]), kp = bflo((unsigned)rw[(1 * 33) * 64 + lane]), vp = bflo((unsigned)rw[(2 * 33) * 64 + lane]);
            float cum = 0.f, gprev = 1.f;
            unsigned bcw[16], kcw[16], vcw[16];
#pragma unroll
            for (int grp = 0; grp < 4; ++grp) {
                float rlv[8], kkrv[8], kprv[8], vlv[8], aav[8], ddv[8], red[16];
#pragma unroll
                for (int e = 0; e < 8; ++e) { const int row = 1 + 8 * grp + e;
                    const float r0 = bflo((unsigned)rw[(0 * 33 + row) * 64 + lane]), k0 = bflo((unsigned)rw[(1 * 33 + row) * 64 + lane]), v0 = bflo((unsigned)rw[(2 * 33 + row) * 64 + lane]);
                    ddv[e] = bflo((unsigned)rw[(3 * 33 + row) * 64 + lane]); aav[e] = bflo((unsigned)rw[(4 * 33 + row) * 64 + lane]);
                    rlv[e] = r0 + (rp - r0) * mur; const float kl = k0 + (kp - k0) * muk; vlv[e] = v0 + (vp - v0) * muv; rp = r0; kp = k0; vp = v0;
                    kkrv[e] = kl * kkw; kprv[e] = kl * (1.0f + (aav[e] - 1.0f) * kaw);
                    red[2 * e] = kkrv[e] * kkrv[e]; red[2 * e + 1] = rlv[e] * kprv[e] * rkw; }
#pragma unroll
                for (int e = 0; e < 16; ++e) red[e] += dppf<0xB1, 0xf>(red[e]);
#pragma unroll
                for (int e = 0; e < 16; ++e) red[e] += dppf<0x4E, 0xf>(red[e]);
#pragma unroll
                for (int e = 0; e < 16; ++e) red[e] += dppf<0x141, 0xf>(red[e]);
#pragma unroll
                for (int e = 0; e < 16; ++e) red[e] += dppf<0x140, 0xf>(red[e]);
#pragma unroll
                for (int e = 0; e < 16; ++e) red[e] += dppf<0x142, 0xa>(red[e]);
#pragma unroll
                for (int e = 0; e < 16; ++e) red[e] += dppf<0x143, 0xc>(red[e]);
#pragma unroll
                for (int e = 0; e < 16; ++e) red[e] = __int_as_float(__builtin_amdgcn_readlane(__float_as_int(red[e]), 63));
                if (lane < 8) { float rkv = red[1];
#pragma unroll
                    for (int e = 1; e < 8; ++e) rkv = (lane == e) ? red[2 * e + 1] : rkv;
                    RK[(m0 + 8 * grp + lane) * 16 + h] = rkv; }
#pragma unroll
                for (int j2 = 0; j2 < 4; ++j2) {
                    const int i2 = 4 * grp + j2;
                    float nt[2], bt[2], kt[2], rt[2], vt[2];
#pragma unroll
                    for (int e = 0; e < 2; ++e) { const int te = 2 * j2 + e;
                        const float kkv = kkrv[te] * __builtin_amdgcn_rsqf(fmaxf(red[2 * te], 1e-24f)), bb = kkv * aav[te];
                        cum += ddv[te]; const float gi = __expf(-cum), ginv = __builtin_amdgcn_rcpf(gi);
                        nt[e] = -kkv * gprev; bt[e] = bb * ginv; kt[e] = kprv[te] * ginv; rt[e] = rlv[te] * gi; vt[e] = vlv[te]; gprev = gi; }
                    const unsigned wn = pk2(nt[0], nt[1]), wb = pk2(bt[0], bt[1]), wk = pk2(kt[0], kt[1]), wr = pk2(rt[0], rt[1]), wv = pk2(vt[0], vt[1]);
                    const int i = 2 * i2;
                    *(LAS unsigned short*)(sl + CS_NT + (i * 64 + kpos) * 2) = (unsigned short)wn; *(LAS unsigned short*)(sl + CS_NT + ((i + 1) * 64 + kpos) * 2) = (unsigned short)(wn >> 16);
                    *(LAS unsigned short*)(sl + CS_RT + (i * 64 + kpos) * 2) = (unsigned short)wr; *(LAS unsigned short*)(sl + CS_RT + ((i + 1) * 64 + kpos) * 2) = (unsigned short)(wr >> 16);
                    *(LAS unsigned short*)(sl + CS_BT + (i * 64 + kpos) * 2) = (unsigned short)wb; *(LAS unsigned short*)(sl + CS_BT + ((i + 1) * 64 + kpos) * 2) = (unsigned short)(wb >> 16);
                    *(LAS unsigned short*)(sl + CS_KT + (i * 64 + kpos) * 2) = (unsigned short)wk; *(LAS unsigned short*)(sl + CS_KT + ((i + 1) * 64 + kpos) * 2) = (unsigned short)(wk >> 16);
                    const int pw = permp(i) >> 1;
                    bcw[pw] = wb; kcw[pw] = wk; vcw[pw] = wv;
                }
                __builtin_amdgcn_sched_barrier(0);
            }
#pragma unroll
            for (int q4 = 0; q4 < 4; ++q4) {
                *(LAS u32x4*)(sl + CS_BC + lane * 64 + 16 * q4) = (u32x4){bcw[4 * q4], bcw[4 * q4 + 1], bcw[4 * q4 + 2], bcw[4 * q4 + 3]};
                *(LAS u32x4*)(sl + CS_KC + lane * 64 + 16 * q4) = (u32x4){kcw[4 * q4], kcw[4 * q4 + 1], kcw[4 * q4 + 2], kcw[4 * q4 + 3]};
                *(LAS u32x4*)(sl + CS_VC + lane * 64 + 16 * q4) = (u32x4){vcw[4 * q4], vcw[4 * q4 + 1], vcw[4 * q4 + 2], vcw[4 * q4 + 3]}; }
            *(LAS float*)(sl + CS_GL + lane * 4) = gprev;
            LDS_WAIT();
            if (lane == 0) __hip_atomic_store(rawfree + s, use + 1u, __ATOMIC_RELAXED, __HIP_MEMORY_SCOPE_WORKGROUP);
            PROBE_END(11, a.ws, wave);
            PROBE_BEGIN(12, a.ws, wave);
            const int tok = lane & 31, hf = lane >> 5;
            bf16x8 fn[4], fr[4], fb[4], fk[4];
#pragma unroll
            for (int ks = 0; ks < 4; ++ks) { fn[ks] = *(const LAS bf16x8*)(sl + CS_NT + (tok * 64 + 16 * ks + 8 * hf) * 2); fr[ks] = *(const LAS bf16x8*)(sl + CS_RT + (tok * 64 + 16 * ks + 8 * hf) * 2);
                fb[ks] = *(const LAS bf16x8*)(sl + CS_BT + (tok * 64 + 16 * ks + 8 * hf) * 2); fk[ks] = *(const LAS bf16x8*)(sl + CS_KT + (tok * 64 + 16 * ks + 8 * hf) * 2); }
            f32x16 P, Pt, Tm, Akn, Abr, Akr;
#pragma unroll
            for (int e = 0; e < 16; ++e) { P[e] = 0.f; Pt[e] = 0.f; Akn[e] = 0.f; Abr[e] = 0.f; Akr[e] = 0.f; }
#pragma unroll
            for (int ks = 0; ks < 4; ++ks) { P = __builtin_amdgcn_mfma_f32_32x32x16_bf16(fn[ks], fb[ks], P, 0, 0, 0); Pt = __builtin_amdgcn_mfma_f32_32x32x16_bf16(fb[ks], fn[ks], Pt, 0, 0, 0);
                Akn = __builtin_amdgcn_mfma_f32_32x32x16_bf16(fn[ks], fk[ks], Akn, 0, 0, 0); Abr = __builtin_amdgcn_mfma_f32_32x32x16_bf16(fr[ks], fb[ks], Abr, 0, 0, 0); Akr = __builtin_amdgcn_mfma_f32_32x32x16_bf16(fr[ks], fk[ks], Akr, 0, 0, 0); }
#pragma unroll
            for (int e = 0; e < 16; ++e) { const int row = (e & 3) + 8 * (e >> 2) + 4 * hf, col = tok;
                if (!(col < row)) { P[e] = 0.f; Akn[e] = 0.f; } if (!(row < col)) Pt[e] = 0.f; if (col > row) { Abr[e] = 0.f; Akr[e] = 0.f; }
                Tm[e] = P[e] + (row == col ? 1.0f : 0.f); }
#pragma unroll
            for (int mm = 1; mm <= 4; ++mm) {
                const bf16x8 p0 = cfrag(P, 0), p1 = cfrag(P, 1), q0 = cfrag(Pt, 0), q1 = cfrag(Pt, 1);
                f32x16 Ptn, Pn;
#pragma unroll
                for (int e = 0; e < 16; ++e) { Ptn[e] = 0.f; Pn[e] = 0.f; }
                Ptn = __builtin_amdgcn_mfma_f32_32x32x16_bf16(p0, q0, Ptn, 0, 0, 0); Ptn = __builtin_amdgcn_mfma_f32_32x32x16_bf16(p1, q1, Ptn, 0, 0, 0);
                if (mm < 4) { Pn = __builtin_amdgcn_mfma_f32_32x32x16_bf16(q0, p0, Pn, 0, 0, 0); Pn = __builtin_amdgcn_mfma_f32_32x32x16_bf16(q1, p1, Pn, 0, 0, 0); }
                const bf16x8 t0 = cfrag(Tm, 0), t1 = cfrag(Tm, 1), u0 = cfrag(Ptn, 0), u1 = cfrag(Ptn, 1);
                Tm = __builtin_amdgcn_mfma_f32_32x32x16_bf16(u0, t0, Tm, 0, 0, 0); Tm = __builtin_amdgcn_mfma_f32_32x32x16_bf16(u1, t1, Tm, 0, 0, 0);
                P = Pn; Pt = Ptn;
            }
            { const int pc = permp(tok);
#pragma unroll
              for (int e = 0; e < 16; e += 2) { const int row = (e & 3) + 8 * (e >> 2) + 4 * hf;
                const unsigned w0 = pk2(Tm[e], Tm[e + 1]), w1 = pk2(Akn[e], Akn[e + 1]), w2 = pk2(Abr[e], Abr[e + 1]), w3 = pk2(Akr[e], Akr[e + 1]);
                *(LAS unsigned short*)(sl + CS_TM + (row * 32 + pc) * 2) = (unsigned short)w0; *(LAS unsigned short*)(sl + CS_TM + ((row + 1) * 32 + pc) * 2) = (unsigned short)(w0 >> 16);
                *(LAS unsigned short*)(sl + CS_AKN + (row * 32 + pc) * 2) = (unsigned short)w1; *(LAS unsigned short*)(sl + CS_AKN + ((row + 1) * 32 + pc) * 2) = (unsigned short)(w1 >> 16);
                *(LAS unsigned short*)(sl + CS_ABR + (row * 32 + pc) * 2) = (unsigned short)w2; *(LAS unsigned short*)(sl + CS_ABR + ((row + 1) * 32 + pc) * 2) = (unsigned short)(w2 >> 16);
                *(LAS unsigned short*)(sl + CS_AKR + (row * 32 + pc) * 2) = (unsigned short)w3; *(LAS unsigned short*)(sl + CS_AKR + ((row + 1) * 32 + pc) * 2) = (unsigned short)(w3 >> 16); } }
            LDS_WAIT();
            if (lane == 0) __hip_atomic_store(ready + s, (unsigned)(c + 1), __ATOMIC_RELAXED, __HIP_MEMORY_SCOPE_WORKGROUP);
            PROBE_END(12, a.ws, wave);
        }
    } else {
        const int l15 = lane & 15, g = lane >> 4, vb = wave;
        f32x4 xc[4];
#pragma unroll
        for (int kt = 0; kt < 4; ++kt) xc[kt] = (f32x4){0.f, 0.f, 0.f, 0.f};
        for (int c = 0; c < CS_NCH; ++c) {
            const int s = c % CS_NSLOT; const LAS unsigned char* sl = lds + s * CS_SLOT;
            lds_poll_ge(ready + s, (unsigned)(c + 1));
            const bf16x8 xb0 = cfrag2(xc[0], xc[1]), xb1 = cfrag2(xc[2], xc[3]);
            const bf16x8 vop = *(const LAS bf16x8*)(sl + CS_VC + ((16 * vb + l15) * 32 + 8 * g) * 2);
            f32x4 W[2], U[2], Y[2];
#pragma unroll
            for (int rt = 0; rt < 2; ++rt) { const int row = 16 * rt + l15; f32x4 acc = (f32x4){0.f, 0.f, 0.f, 0.f};
                acc = __builtin_amdgcn_mfma_f32_16x16x32_bf16(*(const LAS bf16x8*)(sl + CS_AKN + (row * 32 + 8 * g) * 2), vop, acc, 0, 0, 0);
                acc = __builtin_amdgcn_mfma_f32_16x16x32_bf16(*(const LAS bf16x8*)(sl + CS_NT + (row * 64 + 8 * g) * 2), xb0, acc, 0, 0, 0);
                acc = __builtin_amdgcn_mfma_f32_16x16x32_bf16(*(const LAS bf16x8*)(sl + CS_NT + (row * 64 + 32 + 8 * g) * 2), xb1, acc, 0, 0, 0);
                W[rt] = acc; }
            const bf16x8 wb = cfrag2(W[0], W[1]);
#pragma unroll
            for (int rt = 0; rt < 2; ++rt) { const int row = 16 * rt + l15;
                U[rt] = __builtin_amdgcn_mfma_f32_16x16x32_bf16(*(const LAS bf16x8*)(sl + CS_TM + (row * 32 + 8 * g) * 2), wb, (f32x4){0.f, 0.f, 0.f, 0.f}, 0, 0, 0); }
            const bf16x8 ub = cfrag2(U[0], U[1]);
#pragma unroll
            for (int rt = 0; rt < 2; ++rt) { const int row = 16 * rt + l15; f32x4 acc = (f32x4){0.f, 0.f, 0.f, 0.f};
                acc = __builtin_amdgcn_mfma_f32_16x16x32_bf16(*(const LAS bf16x8*)(sl + CS_AKR + (row * 32 + 8 * g) * 2), vop, acc, 0, 0, 0);
                acc = __builtin_amdgcn_mfma_f32_16x16x32_bf16(*(const LAS bf16x8*)(sl + CS_RT + (row * 64 + 8 * g) * 2), xb0, acc, 0, 0, 0);
                acc = __builtin_amdgcn_mfma_f32_16x16x32_bf16(*(const LAS bf16x8*)(sl + CS_RT + (row * 64 + 32 + 8 * g) * 2), xb1, acc, 0, 0, 0);
                acc = __builtin_amdgcn_mfma_f32_16x16x32_bf16(*(const LAS bf16x8*)(sl + CS_ABR + (row * 32 + 8 * g) * 2), ub, acc, 0, 0, 0);
                Y[rt] = acc; }
#pragma unroll
            for (int kt = 0; kt < 4; ++kt) { const int row = 16 * kt + l15; f32x4 acc = xc[kt];
                acc = __builtin_amdgcn_mfma_f32_16x16x32_bf16(*(const LAS bf16x8*)(sl + CS_KC + (row * 32 + 8 * g) * 2), vop, acc, 0, 0, 0);
                acc = __builtin_amdgcn_mfma_f32_16x16x32_bf16(*(const LAS bf16x8*)(sl + CS_BC + (row * 32 + 8 * g) * 2), ub, acc, 0, 0, 0);
                xc[kt] = acc * *(const LAS f32x4*)(sl + CS_GL + (16 * kt + 4 * g) * 4); }
            LDS_WAIT();
            if (lane == 0) (void)__hip_atomic_fetch_add(done + s, 1u, __ATOMIC_RELAXED, __HIP_MEMORY_SCOPE_WORKGROUP);
#pragma unroll
            for (int rt = 0; rt < 2; ++rt)
#pragma unroll
                for (int e = 0; e < 4; ++e) { const size_t m = (size_t)b * SEQ + (size_t)c * CS_L + 16 * rt + 4 * g + e;
                    YAB[m * 2048 + 1024 + h * 64 + 16 * vb + l15] = (bf16_t)(pk2(Y[rt][e], 0.f) & 0xffffu); }
        }
    }
}

constexpr int CR_PIECE = 12, CR_NP = (CS_NCH + CR_PIECE - 1) / CR_PIECE, CR_PW = 4, CR_PSLOT = CS_SLOT + 2 * 33 * 128;
constexpr int CR_RING = 4, CR_FLAGS = LDS_BYTES - 128;
constexpr size_t DO_IMG = 66 * MiB;
static_assert(CR_PW * CR_PSLOT <= CR_FLAGS && CR_RING * CS_SLOT <= CR_FLAGS, "builder slots / ring");
#define CRG_XCNT(j)    (64 * (j))
#define CRG_PROD(p)    (1024 + 64 * (p))
#define CRG_CONS(p)    (3072 + 64 * (p))
#define CRG_XSUB(p, j) (5120 + 4 * (16 * (p) + (j)))
#define CRG_READY(p, bh) (8192 + 16 * (64 * (p) + (bh)))
static_assert(CR_NP <= 32 && 8192 + CRG_XSUB(CR_NP, 0) <= 16384, "scan hand-off words");
constexpr size_t CR_HSZ = (size_t)CR_PIECE * CS_SLOT, CR_BUFSZ = 64 * CR_HSZ; constexpr int CR_H2 = 45;
static_assert(CR_H2 * CR_HSZ <= 16 * MiB && DO_IMG + 2 * CR_BUFSZ + (64 - CR_H2) * CR_HSZ <= 128 * MiB, "third image buffer");
__device__ __forceinline__ unsigned char* cr_img(const Args& a, int piece, int bh) {
    const int buf = piece % 3;
    if (buf < 2) return (unsigned char*)a.out + DO_IMG + (size_t)buf * CR_BUFSZ + (size_t)bh * CR_HSZ;
    return bh < CR_H2 ? a.ws + WS_WIN0 + (size_t)bh * CR_HSZ : (unsigned char*)a.out + DO_IMG + 2 * CR_BUFSZ + (size_t)(bh - CR_H2) * CR_HSZ; }
__device__ __forceinline__ int sw8(int r) { return (r >> 1) & 7; }
__device__ __forceinline__ int sw4(int r) { return (r >> 2) & 3; }
__device__ __forceinline__ int cr_nch(int p) { const int rem = CS_NCH - p * CR_PIECE; return rem < CR_PIECE ? rem : CR_PIECE; }
__device__ __forceinline__ unsigned crg_ld(unsigned* p) { return __hip_atomic_load(p, __ATOMIC_RELAXED, __HIP_MEMORY_SCOPE_AGENT); }

__device__ __forceinline__ void cscan_rope(const Args& a, const int wave, LAS unsigned* pf) {
    const int lane = lane_id(); const int iw = ((int)blockIdx.x - 64) * 3 + (wave - 5), niw = ((int)gridDim.x - 64) * 3;
    const int per = (MTOK + CR_NP * niw - 1) / (CR_NP * niw);
    const float inv128 = powf(10000.0f, -(float)(2 * lane) / 128.0f), inv64 = powf(10000.0f, -(float)(2 * lane) / 64.0f);
    for (int piece = 0; piece < CR_NP; ++piece) {
        if (piece > 0) lds_poll_ge(pf + 17, 4u * (unsigned)piece);
        for (int t = piece * per * niw + iw; t < (piece + 1) * per * niw && t < MTOK; t += niw) rope_item(a, t, lane, inv128, inv64); }
}
__device__ __forceinline__ void cscan_build(const Args& a, LAS unsigned char* sl, const int pidx, const int ptot, LAS unsigned* pf) {
    const bf16_t* Rg = (const bf16_t*)(a.ws + WS_R); const bf16_t* Kg = (const bf16_t*)(a.ws + WS_K); const bf16_t* Vg = (const bf16_t*)(a.ws + WS_V);
    const bf16_t* Dg = (const bf16_t*)(a.ws + WS_DARR); const bf16_t* Ag = (const bf16_t*)(a.ws + WS_AARR);
    float* RK = (float*)((unsigned char*)a.out + DO_RK);
    const LAS unsigned short* rawD = (const LAS unsigned short*)(sl + 16384); const LAS unsigned short* rawA = (const LAS unsigned short*)(sl + 20480);
    const LAS unsigned short* rawR = (const LAS unsigned short*)(sl + 24576); const LAS unsigned short* rawK = (const LAS unsigned short*)(sl + CS_SLOT); const LAS unsigned short* rawV = (const LAS unsigned short*)(sl + CS_SLOT + 33 * 128);
    u32x4 pre[5][4], prep[3];
    auto issue = [&](int p2, int it2, int rr, int c8, int lane) { const int nch2 = cr_nch(p2); const int bh2 = it2 / nch2, cc2 = it2 % nch2, c2 = p2 * CR_PIECE + cc2; const unsigned mm = (unsigned)(bh2 >> 4) * SEQ + (unsigned)c2 * CS_L; const int hh = bh2 & 15;
        const unsigned eoff = ((mm + rr) * DM + hh * 64 + 8 * c8) * 2u;
        const unsigned char* wsb = a.ws;
#pragma unroll
        for (int ar = 0; ar < 5; ++ar) { constexpr size_t AOFF[5] = {WS_R, WS_K, WS_V, WS_DARR, WS_AARR};
#pragma unroll
            for (int q4 = 0; q4 < 4; ++q4) pre[ar][q4] = *(const u32x4*)(wsb + AOFF[ar] + eoff + (unsigned)(8 * q4 * DM * 2)); }
        const bool hasp = (c2 > 0) && (lane < 8); const unsigned poff = hasp ? (eoff - (unsigned)((rr + 1) * DM * 2)) : eoff;
#pragma unroll
        for (int ar = 0; ar < 3; ++ar) { constexpr size_t AOFF[3] = {WS_R, WS_K, WS_V}; const u32x4 t = *(const u32x4*)(wsb + AOFF[ar] + poff); prep[ar] = hasp ? t : (u32x4){0u, 0u, 0u, 0u}; } };
    { const int l0 = lane_id(); if (pidx < 64 * cr_nch(0)) issue(0, pidx, l0 >> 3, l0 & 7, l0); }
    for (int piece = 0; piece < CR_NP; ++piece) {
      const int nch = cr_nch(piece);
      for (int it = pidx; it < 64 * nch; it += ptot) {
        const int lane = lane_id(), rr = lane >> 3, c8 = lane & 7, kpos = 32 * (lane >> 5) + permp(lane & 31);
        const int bh = it / nch, cc = it % nch, b = bh >> 4, h = bh & 15, c = piece * CR_PIECE + cc, gch = h * 64 + lane;
        const float mur = a.mu_rkv[gch], muk = a.mu_rkv[DM + gch], muv = a.mu_rkv[2 * DM + gch], kkw = a.rwkv_vec[2 * DM + gch], kaw = a.rwkv_vec[3 * DM + gch], rkw = a.r_k[gch];
            const size_t m0 = (size_t)b * SEQ + (size_t)c * CS_L;
            { LAS unsigned char* wb = sl + rr * 128 + 16 * c8; asm volatile("" : "+v"(wb));
#pragma unroll
              for (int q4 = 0; q4 < 4; ++q4) {
                *(LAS u32x4*)(wb + 24576 + (8 * q4 + 1) * 128) = pre[0][q4]; *(LAS u32x4*)(wb + CS_SLOT + (8 * q4 + 1) * 128) = pre[1][q4]; *(LAS u32x4*)(wb + CS_SLOT + 33 * 128 + (8 * q4 + 1) * 128) = pre[2][q4];
                *(LAS u32x4*)(wb + 16384 + (8 * q4) * 128) = pre[3][q4]; *(LAS u32x4*)(wb + 20480 + (8 * q4) * 128) = pre[4][q4]; }
              if (lane < 8) { *(LAS u32x4*)(wb + 24576) = prep[0]; *(LAS u32x4*)(wb + CS_SLOT) = prep[1]; *(LAS u32x4*)(wb + CS_SLOT + 33 * 128) = prep[2]; } }
            LDS_WAIT();
            const LAS unsigned short* rb = (const LAS unsigned short*)sl + lane; asm volatile("" : "+v"(rb));
            float rp = bflo((unsigned)rb[24576 / 2]), kp = bflo((unsigned)rb[CS_SLOT / 2]), vp = bflo((unsigned)rb[(CS_SLOT + 33 * 128) / 2]);
            float cum = 0.f, gprev = 1.f;
            unsigned bcw[16], kcw[16], vcw[16];
#pragma unroll
            for (int grp = 0; grp < 4; ++grp) {
                float rlv[8], kkrv[8], kprv[8], vlv[8], aav[8], ddv[8], red[16];
#pragma unroll
                for (int e = 0; e < 8; ++e) { const int row = 8 * grp + e;
                    const float r0 = bflo((unsigned)rb[24576 / 2 + (row + 1) * 64]), k0 = bflo((unsigned)rb[CS_SLOT / 2 + (row + 1) * 64]), v0 = bflo((unsigned)rb[(CS_SLOT + 33 * 128) / 2 + (row + 1) * 64]);
                    ddv[e] = bflo((unsigned)rb[16384 / 2 + row * 64]); aav[e] = bflo((unsigned)rb[20480 / 2 + row * 64]);
                    rlv[e] = r0 + (rp - r0) * mur; const float kl = k0 + (kp - k0) * muk; vlv[e] = v0 + (vp - v0) * muv; rp = r0; kp = k0; vp = v0;
                    kkrv[e] = kl * kkw; kprv[e] = kl * (1.0f + (aav[e] - 1.0f) * kaw);
                    red[2 * e] = kkrv[e] * kkrv[e]; red[2 * e + 1] = rlv[e] * kprv[e] * rkw; }
#pragma unroll
                for (int e = 0; e < 16; ++e) red[e] += dppf<0xB1, 0xf>(red[e]);
#pragma unroll
                for (int e = 0; e < 16; ++e) red[e] += dppf<0x4E, 0xf>(red[e]);
#pragma unroll
                for (int e = 0; e < 16; ++e) red[e] += dppf<0x141, 0xf>(red[e]);
#pragma unroll
                for (int e = 0; e < 16; ++e) red[e] += dppf<0x140, 0xf>(red[e]);
#pragma unroll
                for (int e = 0; e < 16; ++e) red[e] += dppf<0x142, 0xa>(red[e]);
#pragma unroll
                for (int e = 0; e < 16; ++e) red[e] += dppf<0x143, 0xc>(red[e]);
#pragma unroll
                for (int e = 0; e < 16; ++e) red[e] = __int_as_float(__builtin_amdgcn_readlane(__float_as_int(red[e]), 63));
                if (lane < 8) { float rkv = red[1];
#pragma unroll
                    for (int e = 1; e < 8; ++e) rkv = (lane == e) ? red[2 * e + 1] : rkv;
                    RK[(m0 + 8 * grp + lane) * 16 + h] = rkv; }
#pragma unroll
                for (int j2 = 0; j2 < 4; ++j2) {
                    const int i2 = 4 * grp + j2;
                    float nt[2], bt[2], kt[2], rt[2], vt[2];
#pragma unroll
                    for (int e = 0; e < 2; ++e) { const int te = 2 * j2 + e;
                        const float kkv = kkrv[te] * __builtin_amdgcn_rsqf(fmaxf(red[2 * te], 1e-24f)), bb = kkv * aav[te];
                        cum += ddv[te]; const float gi = __expf(-cum), ginv = __builtin_amdgcn_rcpf(gi);
                        nt[e] = -kkv * gprev; bt[e] = bb * ginv; kt[e] = kprv[te] * ginv; rt[e] = rlv[te] * gi; vt[e] = vlv[te]; gprev = gi; }
                    const unsigned wn = pk2(nt[0], nt[1]), wb = pk2(bt[0], bt[1]), wk = pk2(kt[0], kt[1]), wr = pk2(rt[0], rt[1]), wv = pk2(vt[0], vt[1]);
                    const int i = 2 * i2;
                    *(LAS unsigned short*)(sl + CS_NT + (i * 64 + (kpos ^ (sw8(i) << 3))) * 2) = (unsigned short)wn; *(LAS unsigned short*)(sl + CS_NT + ((i + 1) * 64 + (kpos ^ (sw8(i) << 3))) * 2) = (unsigned short)(wn >> 16);
                    *(LAS unsigned short*)(sl + CS_RT + (i * 64 + (kpos ^ (sw8(i) << 3))) * 2) = (unsigned short)wr; *(LAS unsigned short*)(sl + CS_RT + ((i + 1) * 64 + (kpos ^ (sw8(i) << 3))) * 2) = (unsigned short)(wr >> 16);
                    *(LAS unsigned short*)(sl + CS_BT + (i * 64 + (kpos ^ (sw8(i) << 3))) * 2) = (unsigned short)wb; *(LAS unsigned short*)(sl + CS_BT + ((i + 1) * 64 + (kpos ^ (sw8(i) << 3))) * 2) = (unsigned short)(wb >> 16);
                    *(LAS unsigned short*)(sl + CS_KT + (i * 64 + (kpos ^ (sw8(i) << 3))) * 2) = (unsigned short)wk; *(LAS unsigned short*)(sl + CS_KT + ((i + 1) * 64 + (kpos ^ (sw8(i) << 3))) * 2) = (unsigned short)(wk >> 16);
                    const int pw = permp(i) >> 1;
                    bcw[pw] = wb; kcw[pw] = wk; vcw[pw] = wv;
                }
                __builtin_amdgcn_sched_barrier(0);
            }
#pragma unroll
            for (int q4 = 0; q4 < 4; ++q4) {
                *(LAS u32x4*)(sl + CS_BC + lane * 64 + 16 * (q4 ^ sw4(lane))) = (u32x4){bcw[4 * q4], bcw[4 * q4 + 1], bcw[4 * q4 + 2], bcw[4 * q4 + 3]};
                *(LAS u32x4*)(sl + CS_KC + lane * 64 + 16 * (q4 ^ sw4(lane))) = (u32x4){kcw[4 * q4], kcw[4 * q4 + 1], kcw[4 * q4 + 2], kcw[4 * q4 + 3]};
                *(LAS u32x4*)(sl + CS_VC + lane * 64 + 16 * (q4 ^ sw4(lane))) = (u32x4){vcw[4 * q4], vcw[4 * q4 + 1], vcw[4 * q4 + 2], vcw[4 * q4 + 3]}; }
            *(LAS float*)(sl + CS_GL + lane * 4) = gprev;
            LDS_WAIT();
            const int tok = lane & 31, hf = lane >> 5;
            bf16x8 fn[4], fr[4], fb[4], fk[4];
#pragma unroll
            for (int ks = 0; ks < 4; ++ks) { fn[ks] = *(const LAS bf16x8*)(sl + CS_NT + (tok * 64 + 8 * ((2 * ks + hf) ^ sw8(tok))) * 2); fr[ks] = *(const LAS bf16x8*)(sl + CS_RT + (tok * 64 + 8 * ((2 * ks + hf) ^ sw8(tok))) * 2);
                fb[ks] = *(const LAS bf16x8*)(sl + CS_BT + (tok * 64 + 8 * ((2 * ks + hf) ^ sw8(tok))) * 2); fk[ks] = *(const LAS bf16x8*)(sl + CS_KT + (tok * 64 + 8 * ((2 * ks + hf) ^ sw8(tok))) * 2); }
            f32x16 P, Pt, Tm, Akn, Abr, Akr;
#pragma unroll
            for (int e = 0; e < 16; ++e) { P[e] = 0.f; Pt[e] = 0.f; Akn[e] = 0.f; Abr[e] = 0.f; Akr[e] = 0.f; }
#pragma unroll
            for (int ks = 0; ks < 4; ++ks) { P = __builtin_amdgcn_mfma_f32_32x32x16_bf16(fn[ks], fb[ks], P, 0, 0, 0); Pt = __builtin_amdgcn_mfma_f32_32x32x16_bf16(fb[ks], fn[ks], Pt, 0, 0, 0);
                Akn = __builtin_amdgcn_mfma_f32_32x32x16_bf16(fn[ks], fk[ks], Akn, 0, 0, 0); Abr = __builtin_amdgcn_mfma_f32_32x32x16_bf16(fr[ks], fb[ks], Abr, 0, 0, 0); Akr = __builtin_amdgcn_mfma_f32_32x32x16_bf16(fr[ks], fk[ks], Akr, 0, 0, 0); }
#pragma unroll
            for (int e = 0; e < 16; ++e) { const int row = (e & 3) + 8 * (e >> 2) + 4 * hf, col = tok;
                if (!(col < row)) { P[e] = 0.f; Akn[e] = 0.f; } if (!(row < col)) Pt[e] = 0.f; if (col > row) { Abr[e] = 0.f; Akr[e] = 0.f; }
                Tm[e] = P[e] + (row == col ? 1.0f : 0.f); }
#pragma unroll
            for (int mm = 1; mm <= 4; ++mm) {
                const bf16x8 p0 = cfrag(P, 0), p1 = cfrag(P, 1), q0 = cfrag(Pt, 0), q1 = cfrag(Pt, 1);
                f32x16 Ptn, Pn;
#pragma unroll
                for (int e = 0; e < 16; ++e) { Ptn[e] = 0.f; Pn[e] = 0.f; }
                Ptn = __builtin_amdgcn_mfma_f32_32x32x16_bf16(p0, q0, Ptn, 0, 0, 0); Ptn = __builtin_amdgcn_mfma_f32_32x32x16_bf16(p1, q1, Ptn, 0, 0, 0);
                if (mm < 4) { Pn = __builtin_amdgcn_mfma_f32_32x32x16_bf16(q0, p0, Pn, 0, 0, 0); Pn = __builtin_amdgcn_mfma_f32_32x32x16_bf16(q1, p1, Pn, 0, 0, 0); }
                const bf16x8 t0 = cfrag(Tm, 0), t1 = cfrag(Tm, 1), u0 = cfrag(Ptn, 0), u1 = cfrag(Ptn, 1);
                Tm = __builtin_amdgcn_mfma_f32_32x32x16_bf16(u0, t0, Tm, 0, 0, 0); Tm = __builtin_amdgcn_mfma_f32_32x32x16_bf16(u1, t1, Tm, 0, 0, 0);
                P = Pn; Pt = Ptn;
            }
            { const int pn = piece + 1, l2 = lane_id();
              if (it + ptot < 64 * nch) issue(piece, it + ptot, l2 >> 3, l2 & 7, l2); else if (pn < CR_NP && pidx < 64 * cr_nch(pn)) issue(pn, pidx, l2 >> 3, l2 & 7, l2); }
            { const int pc = permp(tok);
#pragma unroll
              for (int e = 0; e < 16; e += 2) { const int row = (e & 3) + 8 * (e >> 2) + 4 * hf;
                const unsigned w0 = pk2(Tm[e], Tm[e + 1]), w1 = pk2(Akn[e], Akn[e + 1]), w2 = pk2(Abr[e], Abr[e + 1]), w3 = pk2(Akr[e], Akr[e + 1]);
                *(LAS unsigned short*)(sl + CS_TM + (row * 32 + (pc ^ (sw4(row) << 3))) * 2) = (unsigned short)w0; *(LAS unsigned short*)(sl + CS_TM + ((row + 1) * 32 + (pc ^ (sw4(row) << 3))) * 2) = (unsigned short)(w0 >> 16);
                *(LAS unsigned short*)(sl + CS_AKN + (row * 32 + (pc ^ (sw4(row) << 3))) * 2) = (unsigned short)w1; *(LAS unsigned short*)(sl + CS_AKN + ((row + 1) * 32 + (pc ^ (sw4(row) << 3))) * 2) = (unsigned short)(w1 >> 16);
                *(LAS unsigned short*)(sl + CS_ABR + (row * 32 + (pc ^ (sw4(row) << 3))) * 2) = (unsigned short)w2; *(LAS unsigned short*)(sl + CS_ABR + ((row + 1) * 32 + (pc ^ (sw4(row) << 3))) * 2) = (unsigned short)(w2 >> 16);
                *(LAS unsigned short*)(sl + CS_AKR + (row * 32 + (pc ^ (sw4(row) << 3))) * 2) = (unsigned short)w3; *(LAS unsigned short*)(sl + CS_AKR + ((row + 1) * 32 + (pc ^ (sw4(row) << 3))) * 2) = (unsigned short)(w3 >> 16); } }
            LDS_WAIT();
            lds_poll_ge(pf + 16, (unsigned)(piece + 1));
            { unsigned char* dst = cr_img(a, piece, bh) + (size_t)cc * CS_SLOT;
#pragma unroll 1
              for (int j0 = 0; j0 < 28; j0 += 4) { u32x4 t4[4];
#pragma unroll
                  for (int q = 0; q < 4; ++q) t4[q] = *(const LAS u32x4*)(sl + 16 * (lane + 64 * (j0 + q)));
#pragma unroll
                  for (int q = 0; q < 4; ++q) { unsigned char* p = dst + 16 * (lane + 64 * (j0 + q)); asm volatile("global_store_dwordx4 %0, %1, off sc1\n\ts_nop 1" :: "v"(p), "v"(t4[q]) : "memory"); } }
              if (lane + 64 * 28 < CS_SLOT / 16) { const u32x4 v = *(const LAS u32x4*)(sl + 16 * (lane + 64 * 28)); unsigned char* p = dst + 16 * (lane + 64 * 28); asm volatile("global_store_dwordx4 %0, %1, off sc1\n\ts_nop 1" :: "v"(p), "v"(v) : "memory"); } }
            LDS_WAIT();
            asm volatile("s_waitcnt vmcnt(0)" ::: "memory");
            if (lane == 0) (void)__hip_atomic_fetch_add((unsigned*)(a.ws + WS_BAR) + 8192 + CRG_READY(piece, bh), 1u, __ATOMIC_RELAXED, __HIP_MEMORY_SCOPE_AGENT);
      }
      asm volatile("s_waitcnt vmcnt(0)" ::: "memory");
      if (lane_id() == 0) (void)__hip_atomic_fetch_add(pf + 17, 1u, __ATOMIC_RELAXED, __HIP_MEMORY_SCOPE_WORKGROUP);
    }
}
__device__ __forceinline__ void cscan_build_helper(unsigned* gb, LAS unsigned* pf, const unsigned x) {
    if (lane_id() != 0) return;
    const unsigned nloc = crg_ld(gb + CRG_XCNT(x));
    for (int p = 0; p < CR_NP; ++p) {
        if (p >= 3) { while (crg_ld(gb + CRG_CONS(p - 3)) < 64u) __builtin_amdgcn_s_sleep(4); }
        __hip_atomic_store(pf + 16, (unsigned)(p + 1), __ATOMIC_RELAXED, __HIP_MEMORY_SCOPE_WORKGROUP);
        lds_poll_ge(pf + 17, 4u * (unsigned)(p + 1));
        const unsigned old = __hip_atomic_fetch_add(gb + CRG_XSUB(p, x), 1u, __ATOMIC_RELAXED, __HIP_MEMORY_SCOPE_AGENT);
        if (old + 1u == nloc) {
            __builtin_amdgcn_fence(__ATOMIC_RELEASE, "agent");
            asm volatile("s_waitcnt vmcnt(0)" ::: "memory");
            (void)__hip_atomic_fetch_add(gb + CRG_PROD(p), 1u, __ATOMIC_RELAXED, __HIP_MEMORY_SCOPE_AGENT); }
    }
}
__device__ __forceinline__ void cscan_cons_helper(unsigned* gb, LAS unsigned* pf, const int bh) {
    if (lane_id() != 0) return;
    unsigned nx = 0u;
#pragma unroll 1
    for (int j = 0; j < 16; ++j) nx += crg_ld(gb + CRG_XCNT(j)) > 0u ? 1u : 0u;
    int pp = 0, pc = 0;
    while (pc < CR_NP) {
        if (pp < CR_NP && crg_ld(gb + CRG_READY(pp, bh)) >= (unsigned)cr_nch(pp)) {
            __builtin_amdgcn_fence(__ATOMIC_ACQUIRE, "agent"); asm volatile("s_waitcnt vmcnt(0)" ::: "memory");
            ++pp; __hip_atomic_store(pf + 16, (unsigned)pp, __ATOMIC_RELAXED, __HIP_MEMORY_SCOPE_WORKGROUP); }
        if (__hip_atomic_load(pf + 17, __ATOMIC_RELAXED, __HIP_MEMORY_SCOPE_WORKGROUP) >= 4u * (unsigned)(pc + 1)) { (void)__hip_atomic_fetch_add(gb + CRG_CONS(pc), 1u, __ATOMIC_RELAXED, __HIP_MEMORY_SCOPE_AGENT); ++pc; }
        __builtin_amdgcn_s_sleep(4);
    }
}

__device__ __forceinline__ void cscan_consume(const Args& a, const int wave, LAS unsigned char* lds, const int bh) {
    const int lane = lane_id();
    const int b = bh >> 4, h = bh & 15;
    bf16_t* YAB = (bf16_t*)(a.ws + WS_YAB);
    LAS unsigned* ready = (LAS unsigned*)(lds + CR_FLAGS); LAS unsigned* done = ready + 4; LAS unsigned* pf = ready;
    if (wave == 4 || wave >= 6) {
        constexpr int NI = (CS_SLOT + 1023) / 1024;
        const int lw = (wave == 4) ? 0 : wave - 5; LAS unsigned* rdy = (lw == 0) ? ready : done + 4 * lw;
        for (int c = 0; c < CS_NCH + 2; ++c) {
            if (c < CS_NCH) { const int piece = c / CR_PIECE, cc = c - piece * CR_PIECE, s = c & 3; LAS unsigned char* sl = lds + s * CS_SLOT;
                if (cc == 0) lds_poll_ge(pf + 16, (unsigned)(piece + 1));
                const unsigned char* src = cr_img(a, piece, bh) + (size_t)cc * CS_SLOT;
                if (c >= 4) lds_poll_ge(done + s, 4u * (unsigned)(c >> 2));
                if (lw == 0) {
#pragma unroll
                    for (int j = 0; j < 10; ++j) { const int idx = lane + 64 * j; __builtin_amdgcn_global_load_lds((const unsigned*)(src + 16 * idx), (LAS unsigned*)(sl + 1024 * j), 16, 0, 0); }
                } else if (lw == 1) {
#pragma unroll
                    for (int j = 10; j < 20; ++j) { const int idx = lane + 64 * j; __builtin_amdgcn_global_load_lds((const unsigned*)(src + 16 * idx), (LAS unsigned*)(sl + 1024 * j), 16, 0, 0); }
                } else {
#pragma unroll
                    for (int j = 20; j < NI; ++j) { const int idx = lane + 64 * j;
                        if (idx < CS_SLOT / 16) __builtin_amdgcn_global_load_lds((const unsigned*)(src + 16 * idx), (LAS unsigned*)(sl + 1024 * j), 16, 0, 0); } } }
            if (c >= 2) {
                if (lw < 2) { if (c < CS_NCH) asm volatile("s_waitcnt vmcnt(20)" ::: "memory"); else if (c == CS_NCH) asm volatile("s_waitcnt vmcnt(10)" ::: "memory"); else asm volatile("s_waitcnt vmcnt(0)" ::: "memory"); }
                else { if (c < CS_NCH) asm volatile("s_waitcnt vmcnt(18)" ::: "memory"); else if (c == CS_NCH) asm volatile("s_waitcnt vmcnt(9)" ::: "memory"); else asm volatile("s_waitcnt vmcnt(0)" ::: "memory"); }
                if (lane == 0) __hip_atomic_store(rdy + ((c - 2) & 3), (unsigned)(c - 1), __ATOMIC_RELAXED, __HIP_MEMORY_SCOPE_WORKGROUP); }
        }
    } else if (wave < 4) {
        const int l15 = lane & 15, g = lane >> 4, vb = wave;
        f32x4 xc[4];
#pragma unroll
        for (int kt = 0; kt < 4; ++kt) xc[kt] = (f32x4){0.f, 0.f, 0.f, 0.f};
        for (int c = 0; c < CS_NCH; ++c) { const int s = c & 3; const LAS unsigned char* sl = lds + s * CS_SLOT;
            { lds_poll_ge(ready + s, (unsigned)(c + 1)); lds_poll_ge(done + 4 + s, (unsigned)(c + 1)); lds_poll_ge(done + 8 + s, (unsigned)(c + 1)); }
            const bf16x8 vop = *(const LAS bf16x8*)(sl + CS_VC + ((16 * vb + l15) * 32 + 8 * (g ^ sw4(16 * vb + l15))) * 2);
            bf16x8 oAKN[2], oNT[2][2], oTM[2], oAKR[2], oRT[2][2], oABR[2], oKC[4], oBC[4]; f32x4 oGL[4];
#pragma unroll
            for (int rt = 0; rt < 2; ++rt) { const int row = 16 * rt + l15;
                oAKN[rt] = *(const LAS bf16x8*)(sl + CS_AKN + (row * 32 + 8 * (g ^ sw4(row))) * 2); oNT[rt][0] = *(const LAS bf16x8*)(sl + CS_NT + (row * 64 + 8 * (g ^ sw8(row))) * 2); oNT[rt][1] = *(const LAS bf16x8*)(sl + CS_NT + (row * 64 + 8 * ((g + 4) ^ sw8(row))) * 2);
                oTM[rt] = *(const LAS bf16x8*)(sl + CS_TM + (row * 32 + 8 * (g ^ sw4(row))) * 2); oAKR[rt] = *(const LAS bf16x8*)(sl + CS_AKR + (row * 32 + 8 * (g ^ sw4(row))) * 2);
                oRT[rt][0] = *(const LAS bf16x8*)(sl + CS_RT + (row * 64 + 8 * (g ^ sw8(row))) * 2); oRT[rt][1] = *(const LAS bf16x8*)(sl + CS_RT + (row * 64 + 8 * ((g + 4) ^ sw8(row))) * 2); oABR[rt] = *(const LAS bf16x8*)(sl + CS_ABR + (row * 32 + 8 * (g ^ sw4(row))) * 2); }
#pragma unroll
            for (int kt = 0; kt < 4; ++kt) { const int row = 16 * kt + l15;
                oKC[kt] = *(const LAS bf16x8*)(sl + CS_KC + (row * 32 + 8 * (g ^ sw4(row))) * 2); oBC[kt] = *(const LAS bf16x8*)(sl + CS_BC + (row * 32 + 8 * (g ^ sw4(row))) * 2); oGL[kt] = *(const LAS f32x4*)(sl + CS_GL + (16 * kt + 4 * g) * 4); }
            __builtin_amdgcn_sched_barrier(0);
            const bf16x8 xb0 = cfrag2(xc[0], xc[1]), xb1 = cfrag2(xc[2], xc[3]);
            f32x4 W[2], U[2], Y[2];
#pragma unroll
            for (int rt = 0; rt < 2; ++rt) { f32x4 acc = (f32x4){0.f, 0.f, 0.f, 0.f};
                acc = __builtin_amdgcn_mfma_f32_16x16x32_bf16(oAKN[rt], vop, acc, 0, 0, 0);
                acc = __builtin_amdgcn_mfma_f32_16x16x32_bf16(oNT[rt][0], xb0, acc, 0, 0, 0);
                acc = __builtin_amdgcn_mfma_f32_16x16x32_bf16(oNT[rt][1], xb1, acc, 0, 0, 0);
                W[rt] = acc; }
            const bf16x8 wb = cfrag2(W[0], W[1]);
#pragma unroll
            for (int rt = 0; rt < 2; ++rt) U[rt] = __builtin_amdgcn_mfma_f32_16x16x32_bf16(oTM[rt], wb, (f32x4){0.f, 0.f, 0.f, 0.f}, 0, 0, 0);
            const bf16x8 ub = cfrag2(U[0], U[1]);
#pragma unroll
            for (int rt = 0; rt < 2; ++rt) { f32x4 acc = (f32x4){0.f, 0.f, 0.f, 0.f};
                acc = __builtin_amdgcn_mfma_f32_16x16x32_bf16(oAKR[rt], vop, acc, 0, 0, 0);
                acc = __builtin_amdgcn_mfma_f32_16x16x32_bf16(oRT[rt][0], xb0, acc, 0, 0, 0);
                acc = __builtin_amdgcn_mfma_f32_16x16x32_bf16(oRT[rt][1], xb1, acc, 0, 0, 0);
                acc = __builtin_amdgcn_mfma_f32_16x16x32_bf16(oABR[rt], ub, acc, 0, 0, 0);
                Y[rt] = acc; }
#pragma unroll
            for (int kt = 0; kt < 4; ++kt) { f32x4 acc = xc[kt];
                acc = __builtin_amdgcn_mfma_f32_16x16x32_bf16(oKC[kt], vop, acc, 0, 0, 0);
                acc = __builtin_amdgcn_mfma_f32_16x16x32_bf16(oBC[kt], ub, acc, 0, 0, 0);
                xc[kt] = acc * oGL[kt]; }
            LDS_WAIT();
            if (lane == 0) (void)__hip_atomic_fetch_add(done + s, 1u, __ATOMIC_RELAXED, __HIP_MEMORY_SCOPE_WORKGROUP);
#pragma unroll
            for (int rt = 0; rt < 2; ++rt)
#pragma unroll
                for (int e = 0; e < 4; ++e) { const size_t m = (size_t)b * SEQ + (size_t)c * CS_L + 16 * rt + 4 * g + e;
                    YAB[m * 2048 + 1024 + h * 64 + 16 * vb + l15] = (bf16_t)(pk2(Y[rt][e], 0.f) & 0xffffu); }
            if ((c + 1) % CR_PIECE == 0 || c + 1 == CS_NCH) { if (lane == 0) (void)__hip_atomic_fetch_add(pf + 17, 1u, __ATOMIC_RELAXED, __HIP_MEMORY_SCOPE_WORKGROUP); }
        }
    }
}


constexpr int DS_NQ = 16, DS_CAP = 2048, DS_TRIG = 1536, DS_TOPK = 256;
constexpr int DS_HIST_WORDS = 320;
constexpr int DS_KT_BYTES = 2048;
constexpr int DS_CAND_OFF = 0, DS_HIST_OFF = DS_NQ * DS_CAP * 4, DS_KT_OFF = DS_HIST_OFF, DS_CNT_OFF = DS_HIST_OFF + 8 * DS_KT_BYTES, DS_TAU_OFF = DS_CNT_OFF + 64;
static_assert(8 * DS_HIST_WORDS * 4 <= 8 * DS_KT_BYTES, "dsa LDS map");
static_assert(DS_TAU_OFF + 64 + 8 <= LDS_BYTES - 128, "dsa LDS map");

template <int CTRL, int RM> __device__ __forceinline__ unsigned dppu(unsigned x) { return (unsigned)__builtin_amdgcn_update_dpp(0, (int)x, CTRL, RM, 0xf, true); }
__device__ __forceinline__ unsigned wave_scan_incl(unsigned v) {
    v += dppu<0x111, 0xf>(v); v += dppu<0x112, 0xf>(v); v += dppu<0x114, 0xf>(v); v += dppu<0x118, 0xf>(v);
    v += dppu<0x142, 0xa>(v);
    v += dppu<0x143, 0xc>(v);
    return v; }
template <int NE>
__device__ __forceinline__ void select_compact(LAS unsigned* cq, LAS unsigned* cntq, LAS unsigned* tauq, LAS unsigned* hist, int lane) {
    const unsigned n = *cntq;
    unsigned e[NE];
#pragma unroll
    for (int j = 0; j < NE; ++j) { const unsigned idx = lane + 64 * j; e[j] = idx < n ? cq[idx] : 0u; }
    unsigned npos = 0u;
#pragma unroll
    for (int j = 0; j < NE; ++j) npos += (unsigned)__popcll(__ballot(e[j] >= 0x80000000u));
    if (npos >= (unsigned)DS_TOPK) {
#pragma unroll
        for (int j = 0; j < NE; ++j) e[j] = (e[j] >= 0x80000000u) ? e[j] : 0u; }
    unsigned va = 0xFFFFFFFFu, vo = 0u;
#pragma unroll
    for (int j = 0; j < NE; ++j) { va &= (e[j] != 0u) ? e[j] : 0xFFFFFFFFu; vo |= e[j]; }
    va &= (unsigned)__builtin_amdgcn_update_dpp(-1, (int)va, 0xB1, 0xf, 0xf, true); va &= (unsigned)__builtin_amdgcn_update_dpp(-1, (int)va, 0x4E, 0xf, 0xf, true);
    va &= (unsigned)__builtin_amdgcn_update_dpp(-1, (int)va, 0x141, 0xf, 0xf, true); va &= (unsigned)__builtin_amdgcn_update_dpp(-1, (int)va, 0x140, 0xf, 0xf, true);
    vo |= dppu<0xB1, 0xf>(vo); vo |= dppu<0x4E, 0xf>(vo); vo |= dppu<0x141, 0xf>(vo); vo |= dppu<0x140, 0xf>(vo);
    const unsigned vas = (unsigned)(__builtin_amdgcn_readlane((int)va, 0) & __builtin_amdgcn_readlane((int)va, 16) & __builtin_amdgcn_readlane((int)va, 32) & __builtin_amdgcn_readlane((int)va, 48));
    const unsigned vos = (unsigned)(__builtin_amdgcn_readlane((int)vo, 0) | __builtin_amdgcn_readlane((int)vo, 16) | __builtin_amdgcn_readlane((int)vo, 32) | __builtin_amdgcn_readlane((int)vo, 48));
    const unsigned diff = vas ^ vos;
    const int top = diff ? 31 - __builtin_clz(diff) : 7;
    unsigned prefix = (top >= 31) ? 0u : (vos & ~((2u << top) - 1u)), mask = (top >= 31) ? 0u : ~((2u << top) - 1u), need = DS_TOPK;
    int hi = top;
    const int rl = 63 - lane;
#pragma unroll 1
    for (int pass = 0; pass < 4 && hi >= 0; ++pass) {
        const int shift = hi >= 7 ? hi - 7 : 0; const unsigned dmask = (hi >= 7) ? 0xFFu : ((2u << hi) - 1u);
        *(LAS u32x4*)(hist + 4 * lane) = (u32x4){0u, 0u, 0u, 0u};
        LDS_WAIT();
#pragma unroll
        for (int j = 0; j < NE; ++j) { const bool hit = (e[j] != 0u) && ((e[j] & mask) == prefix); const unsigned bin = hit ? ((e[j] >> shift) & dmask) : (256u + (unsigned)lane);
            (void)__hip_atomic_fetch_add(hist + bin, 1u, __ATOMIC_RELAXED, __HIP_MEMORY_SCOPE_WORKGROUP); }
        LDS_WAIT();
        const u32x4 h4 = *(const LAS u32x4*)(hist + 4 * rl);
        const unsigned tot = (h4.x + h4.y) + (h4.z + h4.w);
        const unsigned v = wave_scan_incl(tot);
        const unsigned above = v - tot;
        const bool is = (above < need) && (need <= v);
        unsigned B = 0u, ca = 0u, hb = 0u;
        if (is) { unsigned c = above;
            if (c + h4.w >= need) { B = 4 * rl + 3; ca = c; hb = h4.w; } else { c += h4.w;
            if (c + h4.z >= need) { B = 4 * rl + 2; ca = c; hb = h4.z; } else { c += h4.z;
            if (c + h4.y >= need) { B = 4 * rl + 1; ca = c; hb = h4.y; } else { c += h4.y; B = 4 * rl; ca = c; hb = h4.x; } } } }
        const unsigned long long bal = __ballot(is);
        if (bal == 0ull) break;
        const int src = __builtin_amdgcn_readfirstlane(__ffsll((long long)bal) - 1);
        B = (unsigned)__builtin_amdgcn_readlane((int)B, src); ca = (unsigned)__builtin_amdgcn_readlane((int)ca, src); hb = (unsigned)__builtin_amdgcn_readlane((int)hb, src);
        need -= ca; prefix |= B << shift; mask |= dmask << shift; hi = shift - 1;
        if (hb == need) break;
    }
    const unsigned T = prefix;
    unsigned base = 0u;
#pragma unroll
    for (int j = 0; j < NE; ++j) { const bool keep = (e[j] >= T) && (e[j] != 0u); const unsigned long long bal = __ballot(keep);
        const unsigned pos = base + __builtin_amdgcn_mbcnt_hi((unsigned)(bal >> 32), __builtin_amdgcn_mbcnt_lo((unsigned)bal, 0u));
        if (keep) cq[pos] = e[j];
        base += (unsigned)__popcll(bal); }
    if (lane == 0) { *cntq = base; *tauq = T; }
    LDS_WAIT();
}

template <int NE>
__device__ __forceinline__ void filter_compact(LAS unsigned* cq, LAS unsigned* cntq, LAS unsigned* tauq, int lane) {
    const unsigned n = *cntq;
    unsigned e[NE];
#pragma unroll
    for (int j = 0; j < NE; ++j) { const unsigned idx = lane + 64 * j; e[j] = idx < n ? cq[idx] : 0u; }
    unsigned m0 = 0u, m1 = 0u, m2 = 0u, m3 = 0u;
#pragma unroll
    for (int j = 0; j < NE; ++j) { unsigned x = e[j], t;
        t = max(m0, x); x = min(m0, x); m0 = t; t = max(m1, x); x = min(m1, x); m1 = t; t = max(m2, x); x = min(m2, x); m2 = t; m3 = max(m3, x); }
    unsigned T = m3;
    T = min(T, (unsigned)__builtin_amdgcn_update_dpp(-1, (int)T, 0xB1, 0xf, 0xf, true)); T = min(T, (unsigned)__builtin_amdgcn_update_dpp(-1, (int)T, 0x4E, 0xf, 0xf, true));
    T = min(T, (unsigned)__builtin_amdgcn_update_dpp(-1, (int)T, 0x141, 0xf, 0xf, true)); T = min(T, (unsigned)__builtin_amdgcn_update_dpp(-1, (int)T, 0x140, 0xf, 0xf, true));
    T = min(min((unsigned)__builtin_amdgcn_readlane((int)T, 0), (unsigned)__builtin_amdgcn_readlane((int)T, 16)), min((unsigned)__builtin_amdgcn_readlane((int)T, 32), (unsigned)__builtin_amdgcn_readlane((int)T, 48)));
    unsigned base = 0u;
#pragma unroll
    for (int j = 0; j < NE; ++j) { const bool keep = (e[j] >= T) && (e[j] != 0u); const unsigned long long bal = __ballot(keep);
        const unsigned pos = base + __builtin_amdgcn_mbcnt_hi((unsigned)(bal >> 32), __builtin_amdgcn_mbcnt_lo((unsigned)bal, 0u));
        if (keep) cq[pos] = e[j];
        base += (unsigned)__popcll(bal); }
    if (lane == 0) { *cntq = base; *tauq = (T > 0u) ? T - 1u : 0u; }
    LDS_WAIT();
}

__device__ __forceinline__ float relu_(float x) { return __int_as_float(max(__float_as_int(x), 0)); }
__device__ __forceinline__ unsigned vrow_off(int pr) { return (unsigned)(pr < 28 ? 1024 + 256 * pr : 9216 + 256 * (pr - 28)); }
__device__ __forceinline__ unsigned swz_b(int row) { return (unsigned)(((row & 3) << 2) | ((row >> 2) & 3)); }

__device__ __forceinline__ void dsa_phase(const Args& a, const int wave, LAS unsigned char* lds, const bool dry = false) {
    const bf16_t* Qg = (const bf16_t*)(a.ws + WS_Q); const bf16_t* KVg = (const bf16_t*)(a.ws + WS_KV); const bf16_t* QIg = (const bf16_t*)(a.ws + WS_QI);
    const bf16_t* KIg = (const bf16_t*)(a.ws + WS_KI); const float* WIg = (const float*)(a.ws + WS_WI); bf16_t* Gg = (bf16_t*)(a.ws + WS_G);
    LAS unsigned* cand = (LAS unsigned*)(lds + DS_CAND_OFF); LAS unsigned* hist = (LAS unsigned*)(lds + DS_HIST_OFF) + wave * DS_HIST_WORDS;
    LAS unsigned* cnt = (LAS unsigned*)(lds + DS_CNT_OFF); LAS unsigned* taup = (LAS unsigned*)(lds + DS_TAU_OFF);
    const bool dyn = (gridDim.x == 256);
    unsigned* qh = (unsigned*)(a.ws + WS_BAR) + 15360 + 64 * (blockIdx.x & 3);
    LAS unsigned* uq = (LAS unsigned*)(lds + DS_TAU_OFF + 64);
    unsigned ucur = 0u;
    if (dyn) { __syncthreads(); if (wave == 0 && lane_id() == 0) uq[0] = __hip_atomic_fetch_add(qh, 1u, __ATOMIC_RELAXED, __HIP_MEMORY_SCOPE_AGENT); __syncthreads(); ucur = (unsigned)__builtin_amdgcn_readfirstlane((int)uq[0]); }
    for (int kk = 0; ; ++kk) {
        const int L = (int)blockIdx.x + kk * (int)gridDim.x;
        if (dyn ? (ucur >= 512u) : (L >= 2048)) break;
        int lane; asm volatile("v_mbcnt_lo_u32_b32 %0, -1, 0\n\tv_mbcnt_hi_u32_b32 %0, -1, %0" : "=v"(lane));
        const int tid = wave * 64 + lane, ql = lane & 15, gq = lane >> 4;
        int b, j;
        if (dyn) { b = (int)blockIdx.x & 3; j = 511 - (int)ucur; }
        else { b = L >> 9; j = L & 511; }
        unsigned unext = 0u; if (dyn && tid == 0) unext = __hip_atomic_fetch_add(qh, 1u, __ATOMIC_RELAXED, __HIP_MEMORY_SCOPE_AGENT);
        const unsigned mb = (unsigned)b * SEQ; const int q0 = DS_NQ * j; const unsigned mq = mb + q0 + ql;
        const int pos0 = a.pos[mb]; int nadm = ((a.pos[mq] >> 6) + 1) * 64 - pos0; nadm = nadm > SEQ ? SEQ : nadm;
        int nmax = ((a.pos[mb + q0 + DS_NQ - 1] >> 6) + 1) * 64 - pos0; nmax = nmax > SEQ ? SEQ : nmax;
        const int nstep = (nmax + 511) >> 9;
#ifdef DSA_REP_STREAM
        for (int srep_ = 0; srep_ < 2; ++srep_) { const bool sdry = (srep_ == 0) && a.ph_hi > 0;
#ifndef DSA_DRYMODE
#define DSA_DRYMODE 0
#endif
#else
        const bool sdry = false;
#define DSA_DRYMODE 0
#endif
        bf16x8 bq[8][2];
#pragma unroll
        for (int h = 0; h < 8; ++h)
#pragma unroll
            for (int ks = 0; ks < 2; ++ks) bq[h][ks] = *(const bf16x8*)(QIg + ((((mb + q0) >> 4) * 16 + h * 2 + ks) * 512u + 8u * lane));
        f32x2 wh[8]; { const f32x4 w0 = *(const f32x4*)(WIg + mq * 8), w1 = *(const f32x4*)(WIg + mq * 8 + 4);
#pragma unroll
            for (int h = 0; h < 4; ++h) { wh[h] = (f32x2){w0[h], w0[h]}; wh[4 + h] = (f32x2){w1[h], w1[h]}; } }
        u32x4 ka[8];
        { unsigned ko = (mb + 64 * wave) * 64u + 8u * lane, ko1 = ko + 2048u;
          asm volatile("" : "+v"(ko), "+v"(ko1));
#pragma unroll
          for (int j8 = 0; j8 < 8; ++j8) ka[j8] = *(const u32x4*)(KIg + ((j8 & 4) ? ko1 : ko) + (j8 & 3) * 512); }
        __syncthreads();
        if (tid < DS_NQ) { cnt[tid] = 0u; taup[tid] = 0u; }
        if (dyn && tid == 0) uq[(kk + 1) & 1] = unext;
        __syncthreads();
        for (int step = 0; step <= nstep; ++step) {
            const int kb = 512 * step + 64 * wave; const bool active = (kb < nmax) && (step < nstep);
            PROBE_BEGIN(2, a.ws, wave);
            if (active) {
                f32x2 sc2[8];
#pragma unroll
                for (int i = 0; i < 8; ++i) sc2[i] = (f32x2){0.f, 0.f};
                const int ln = lane_id();
                const int kbn = (kb + 512 < SEQ) ? kb + 512 : kb; unsigned ko = (mb + kbn) * 64u + 8u * ln, ko1 = ko + 2048u;
                asm volatile("" : "+v"(ko), "+v"(ko1));
#pragma unroll
                for (int st = 0; st < 4; ++st) {
                    const bf16x8 af0 = __builtin_bit_cast(bf16x8, ka[2 * st]), af1 = __builtin_bit_cast(bf16x8, ka[2 * st + 1]);
                    f32x4 acc[8];
#pragma unroll
                    for (int h = 0; h < 8; ++h) acc[h] = __builtin_amdgcn_mfma_f32_16x16x32_bf16(af0, bq[h][0], (f32x4){0.f, 0.f, 0.f, 0.f}, 0, 0, 0);
#pragma unroll
                    for (int h = 0; h < 8; ++h) acc[h] = __builtin_amdgcn_mfma_f32_16x16x32_bf16(af1, bq[h][1], acc[h], 0, 0, 0);
                    __builtin_amdgcn_sched_barrier(0);
                    if (!(sdry && (DSA_DRYMODE & 1))) {
                        ka[2 * st] = *(const u32x4*)(KIg + ((st & 2) ? ko1 : ko) + (2 * st & 3) * 512); ka[2 * st + 1] = *(const u32x4*)(KIg + ((st & 2) ? ko1 : ko) + ((2 * st + 1) & 3) * 512); }
#pragma unroll
                    for (int h = 0; h < 8; ++h) {
                        sc2[2 * st] += wh[h] * (f32x2){relu_(acc[h][0]), relu_(acc[h][1])}; sc2[2 * st + 1] += wh[h] * (f32x2){relu_(acc[h][2]), relu_(acc[h][3])}; }
                    __builtin_amdgcn_sched_barrier(0);
                }
                float sc[16];
#pragma unroll
                for (int i = 0; i < 8; ++i) { sc[2 * i] = sc2[i][0]; sc[2 * i + 1] = sc2[i][1]; }
                __builtin_amdgcn_sched_barrier(0);
                const unsigned tp = taup[ql]; unsigned pm = 0u;
#pragma unroll
                for (int i = 0; i < 16; ++i) { const int key = kb + 16 * (i >> 2) + 4 * gq + (i & 3); const unsigned u = __float_as_uint(sc[i]);
                    const unsigned ord = (u & 0x80000000u) ? ~u : (u | 0x80000000u); const unsigned pk = (ord & 0xFFFFE000u) | (unsigned)key;
                    sc[i] = __uint_as_float(pk);
                    if (key < nadm && pk > tp) pm |= 1u << i; }
                if (sdry && (DSA_DRYMODE & 2)) pm = 0u;
                const unsigned n = (unsigned)__popc(pm);
                unsigned k = 0u; if (n) k = __hip_atomic_fetch_add(cnt + ql, n, __ATOMIC_RELAXED, __HIP_MEMORY_SCOPE_WORKGROUP);
                LAS unsigned* cq = cand + ql * DS_CAP;
#pragma unroll
                for (int i = 0; i < 16; ++i) if (pm & (1u << i)) { cq[k] = __float_as_uint(sc[i]); ++k; }
            }
            if (sdry && (DSA_DRYMODE & 8)) continue;
            __syncthreads();
            PROBE_END(2, a.ws, wave);
            const u32x4 c0 = *(const LAS u32x4*)(cnt), c1 = *(const LAS u32x4*)(cnt + 4), c2 = *(const LAS u32x4*)(cnt + 8), c3 = *(const LAS u32x4*)(cnt + 12);
            unsigned cm = max(max(max(c0.x, c0.y), max(c0.z, c0.w)), max(max(c1.x, c1.y), max(c1.z, c1.w)));
            cm = max(cm, max(max(max(c2.x, c2.y), max(c2.z, c2.w)), max(max(c3.x, c3.y), max(c3.z, c3.w))));
            const unsigned trig = (step == nstep) ? (unsigned)DS_TOPK : (unsigned)DS_TRIG;
#ifdef DSA_SEL2
            const int nsel = (step == nstep) ? 4 : 2;
#else
            const int nsel = 2;
#endif
            if (cm > trig) {
                PROBE_BEGIN(1, a.ws, wave);
#pragma unroll 1
                for (int qq = 0; qq < nsel; ++qq) { const int q = 2 * wave + (qq & 1); if (cnt[q] > trig || qq >= 2) {
                    if (step != nstep) filter_compact<32>(cand + q * DS_CAP, cnt + q, taup + q, lane);
                    if (step == nstep || cnt[q] > (unsigned)DS_TRIG) { const unsigned nq = (unsigned)__builtin_amdgcn_readfirstlane((int)cnt[q]);
                        if (nq <= 512u) select_compact<8>(cand + q * DS_CAP, cnt + q, taup + q, hist, lane);
                        else if (nq <= 768u) select_compact<12>(cand + q * DS_CAP, cnt + q, taup + q, hist, lane);
                        else if (nq <= 1024u) select_compact<16>(cand + q * DS_CAP, cnt + q, taup + q, hist, lane);
                        else if (nq <= 1536u) select_compact<24>(cand + q * DS_CAP, cnt + q, taup + q, hist, lane);
                        else select_compact<32>(cand + q * DS_CAP, cnt + q, taup + q, hist, lane); } } }
                __syncthreads();
                PROBE_END(1, a.ws, wave);
            }
        }
#ifdef DSA_REP_STREAM
        }
#endif
        const bf16_t* KVb = KVg + (size_t)mb * 256;
        int lane_a = lane; asm volatile("" : "+v"(lane_a));
        const int g16 = lane_a >> 4, l15 = lane_a & 15;
        const unsigned vbase = (unsigned)(size_t)(lds + DS_CAND_OFF) + (unsigned)wave * 16384u;
        unsigned ta0, ta1;
        { const int q = l15 >> 2, p = lane_a & 3; const int pr0 = 8 * g16 + q, pr1 = pr0 + 4;
          ta0 = vbase + vrow_off(pr0) + 16u * ((unsigned)(p >> 1) ^ swz_b(pr0)) + 8u * (unsigned)(p & 1);
          ta1 = vbase + vrow_off(pr1) + 16u * ((unsigned)(p >> 1) ^ swz_b(pr1)) + 8u * (unsigned)(p & 1); }
        const unsigned kwa = vbase + 10240u + (unsigned)(4 * g16) * 256u + (unsigned)((l15 ^ (4 * g16)) << 4);
        const unsigned kra = vbase + 10240u + (unsigned)l15 * 256u + (unsigned)((g16 ^ l15) << 4);
        const unsigned owa = vbase + 10240u + (unsigned)l15 * 256u + (unsigned)((g16 ^ l15) << 4);
        const unsigned ora = vbase + 10240u + (unsigned)(lane_a >> 3) * 256u + (unsigned)(((2 * (lane_a & 7)) ^ (lane_a >> 3)) << 4);
        unsigned vwa[8];
#pragma unroll
        for (int j2 = 0; j2 < 8; ++j2) { const int srow = 4 * j2 + g16; const int pr = (srow < 16) ? 8 * (srow >> 2) + (srow & 3) : 8 * ((srow - 16) >> 2) + 4 + (srow & 3);
            vwa[j2] = vbase + vrow_off(pr) + 16u * ((unsigned)l15 ^ swz_b(pr)); }
#ifdef DSA_REP_ATT
        for (int arep_ = 0; arep_ < 2; ++arep_) { const bool dry2 = dry || (arep_ == 0 && a.ph_hi > 0);
#else
        { const bool dry2 = dry;
#endif
        u32x4 qr[4];
#pragma unroll
        for (int i = 0; i < 4; ++i) qr[i] = *(const u32x4*)(Qg + ((mb + q0 + 2 * wave) * 2048u + (unsigned)(4 * g16 + i) * 128u + 8u * l15));
#pragma unroll 1
        for (int qq = 0; qq < 2; ++qq) {
            const int q = 2 * wave + qq; const unsigned m = mb + q0 + q; const int n = (int)cnt[q]; const LAS unsigned* cq = cand + q * DS_CAP;
            bf16x8 qb[4];
            {
#pragma unroll
              for (int i = 0; i < 4; ++i) *(LAS u32x4*)(size_t)(kwa ^ (unsigned)((i << 8) | (i << 4))) = qr[i];
              LDS_WAIT();
              if (qq == 0) {
#pragma unroll
                for (int i = 0; i < 4; ++i) qr[i] = *(const u32x4*)(Qg + ((m + 1u) * 2048u + (unsigned)(4 * g16 + i) * 128u + 8u * l15)); }
#pragma unroll
              for (int ks = 0; ks < 4; ++ks) qb[ks] = *(const LAS bf16x8*)(size_t)(kra ^ (unsigned)(ks << 6));
              LDS_WAIT(); }
            f32x4 sacc[16];
            const int nl = n - l15; const LAS unsigned* cql = cq + l15;
            u32x4 kr[5][4];
            auto kload = [&](int jt, u32x4 (&dst)[4]) { const u32x4 e4 = *(const LAS u32x4*)(cq + 16 * jt + 4 * g16);
#pragma unroll
                for (int i = 0; i < 4; ++i) dst[i] = *(const u32x4*)(KVb + ((e4[i] & 0x1FFFu) * 256u + 8u * l15)); };
            kload(0, kr[0]); kload(1, kr[1]); kload(2, kr[2]); kload(3, kr[3]);
#pragma unroll
            for (int i = 0; i < 4; ++i) *(LAS u32x4*)(size_t)(kwa ^ (unsigned)((i << 8) | (i << 4))) = kr[0][i];
#pragma unroll
            for (int jt = 0; jt < 16; ++jt) {
                if (jt + 4 < 16) kload(jt + 4, kr[(jt + 4) % 5]);
                bf16x8 fa[4];
#pragma unroll
                for (int ks = 0; ks < 4; ++ks) fa[ks] = *(const LAS bf16x8*)(size_t)(kra ^ (unsigned)(ks << 6));
                if (jt + 1 < 16) {
#pragma unroll
                    for (int i = 0; i < 4; ++i) *(LAS u32x4*)(size_t)(kwa ^ (unsigned)((i << 8) | (i << 4))) = kr[(jt + 1) % 5][i]; }
                f32x4 acc = (f32x4){0.f, 0.f, 0.f, 0.f};
#pragma unroll
                for (int ks = 0; ks < 4; ++ks) acc = __builtin_amdgcn_mfma_f32_16x16x32_bf16(fa[ks], qb[ks], acc, 0, 0, 0);
                sacc[jt] = acc;
            }
            u32x4 vr[2][8]; const int ng = n - g16; const LAS unsigned* cqg = cq + g16;
            auto vload = [&](int kk, u32x4 (&dst)[8]) {
#pragma unroll
                for (int j2 = 0; j2 < 8; ++j2) { const int sl = 32 * kk + 4 * j2; const unsigned e = cqg[sl]; const unsigned key = (sl < ng) ? (e & 0x1FFFu) : 0u;
                    dst[j2] = *(const u32x4*)(KVb + (key * 256u + 128u + 8u * l15)); } };
            vload(0, vr[0]); vload(1, vr[1]);
            __builtin_amdgcn_sched_barrier(0);
            float mx = -1e30f; const float nnf = (float)(n - 4 * g16 - 1);
#pragma unroll
            for (int jt = 0; jt < 16; ++jt)
#pragma unroll
                for (int r = 0; r < 4; ++r) { sacc[jt][r] = fmaf(fminf(nnf - (float)(16 * jt + r), 0.f), 1e30f, sacc[jt][r]); mx = fmaxf(mx, sacc[jt][r]); }
            mx = fmaxf(mx, __shfl_xor(mx, 16)); mx = fmaxf(mx, __shfl_xor(mx, 32));
            float sum = 0.f;
#pragma unroll
            for (int jt = 0; jt < 16; ++jt)
#pragma unroll
                for (int r = 0; r < 4; ++r) { const float p = __builtin_amdgcn_exp2f(sacc[jt][r] - mx); sacc[jt][r] = p; sum += p; }
            sum += __shfl_xor(sum, 16); sum += __shfl_xor(sum, 32);
            u32x4 pfr[8];
#pragma unroll
            for (int kk = 0; kk < 8; ++kk) { const f32x4 pa = sacc[2 * kk], pb2 = sacc[2 * kk + 1];
                pfr[kk].x = pk2(pa[0], pa[1]); pfr[kk].y = pk2(pa[2], pa[3]); pfr[kk].z = pk2(pb2[0], pb2[1]); pfr[kk].w = pk2(pb2[2], pb2[3]); }
            __builtin_amdgcn_sched_barrier(0);
            f32x4 o[8];
#pragma unroll
            for (int c = 0; c < 8; ++c) o[c] = (f32x4){0.f, 0.f, 0.f, 0.f};
            bf16_t* gqp = Gg + m * 2048u; u32x4 gwv[2][2];
#pragma unroll
            for (int p = 0; p < 2; ++p)
#pragma unroll
                for (int i = 0; i < 2; ++i) gwv[p][i] = *(const u32x4*)(gqp + ((8 * i + (lane_a >> 3)) * 128 + 64 * p + 8 * (lane_a & 7)));
#pragma unroll
            for (int kk = 0; kk < 8; ++kk) {
#pragma unroll
                for (int j2 = 0; j2 < 8; ++j2) *(LAS u32x4*)(size_t)vwa[j2] = vr[kk & 1][j2];
                __builtin_amdgcn_sched_barrier(0);
                if (kk + 2 < 8) vload(kk + 2, vr[kk & 1]);
                LDS_WAIT();
                const bf16x8 pfrag = __builtin_bit_cast(bf16x8, pfr[kk]);
#pragma unroll
                for (int ch = 0; ch < 2; ++ch) {
                    s16x4 t0[4], t1[4];
                    asm volatile("ds_read_b64_tr_b16 %0, %8\n\tds_read_b64_tr_b16 %1, %9\n\tds_read_b64_tr_b16 %2, %10\n\tds_read_b64_tr_b16 %3, %11\n\t"
                                 "ds_read_b64_tr_b16 %4, %12\n\tds_read_b64_tr_b16 %5, %13\n\tds_read_b64_tr_b16 %6, %14\n\tds_read_b64_tr_b16 %7, %15\n\ts_waitcnt lgkmcnt(0)"
                                 : "=&v"(t0[0]), "=&v"(t0[1]), "=&v"(t0[2]), "=&v"(t0[3]), "=&v"(t1[0]), "=&v"(t1[1]), "=&v"(t1[2]), "=&v"(t1[3])
                                 : "v"(ta0 ^ (unsigned)((4 * ch + 0) << 5)), "v"(ta0 ^ (unsigned)((4 * ch + 1) << 5)), "v"(ta0 ^ (unsigned)((4 * ch + 2) << 5)), "v"(ta0 ^ (unsigned)((4 * ch + 3) << 5)),
                                   "v"(ta1 ^ (unsigned)((4 * ch + 0) << 5)), "v"(ta1 ^ (unsigned)((4 * ch + 1) << 5)), "v"(ta1 ^ (unsigned)((4 * ch + 2) << 5)), "v"(ta1 ^ (unsigned)((4 * ch + 3) << 5)) : "memory");
                    __builtin_amdgcn_sched_barrier(0);
#pragma unroll
                    for (int c = 0; c < 4; ++c) { const bf16x8 av = __builtin_shufflevector(t0[c], t1[c], 0, 1, 2, 3, 4, 5, 6, 7);
                        o[4 * ch + c] = __builtin_amdgcn_mfma_f32_16x16x32_bf16(av, pfrag, o[4 * ch + c], 0, 0, 0); }
                }
            }
            const float inv = 1.0f / sum;
#pragma unroll
            for (int p = 0; p < 2; ++p) {
#pragma unroll
                for (int cc = 0; cc < 4; ++cc) *(LAS f32x4*)(size_t)(owa ^ (unsigned)(cc << 6)) = o[4 * p + cc] * inv;
                LDS_WAIT();
#pragma unroll
                for (int i = 0; i < 2; ++i) { bf16_t* gp = gqp + ((8 * i + (lane_a >> 3)) * 128 + 64 * p + 8 * (lane_a & 7)); const u32x4 gw = gwv[p][i];
                    const unsigned ra_ = (ora + 2048u * (unsigned)i) ^ (unsigned)(i << 7);
                    const f32x4 t0 = *(const LAS f32x4*)(size_t)ra_, t1 = *(const LAS f32x4*)(size_t)(ra_ ^ 16u);
                    u32x4 wv; wv.x = pk2(t0[0] * bflo(gw.x), t0[1] * bfhi(gw.x)); wv.y = pk2(t0[2] * bflo(gw.y), t0[3] * bfhi(gw.y));
                    wv.z = pk2(t1[0] * bflo(gw.z), t1[1] * bfhi(gw.z)); wv.w = pk2(t1[2] * bflo(gw.w), t1[3] * bfhi(gw.w));
                    if (!dry2) *(u32x4*)gp = wv; }
                LDS_WAIT();
            }
        }
        }
        if (dyn) ucur = (unsigned)__builtin_amdgcn_readfirstlane((int)uq[(kk + 1) & 1]);
    }
}

#ifndef OLD_SCAN
#define OLD_SCAN 0
#endif
#ifndef MK_SPLIT
#define MK_SPLIT 0
#endif
#ifndef MK_PH_END
#define MK_PH_END 13
#endif
constexpr int N_PHASES = 13;

#define XB_TMO      128
#define XB_XCNT(j)  (256  + 64 * (j))
#define XB_XSUB(j)  (1280 + 64 * (j))
#define XB_XGEN(j)  (2304 + 64 * (j))
#define XB_TOP      3328
#define XB_TOPGEN   3392
#define XCD_BAR_WORDS 3456
#define XB_SPIN_CAP (1u << 18)

__device__ __forceinline__ unsigned xb_ld(unsigned* p)              { return __hip_atomic_load(p, __ATOMIC_RELAXED, __HIP_MEMORY_SCOPE_AGENT); }
__device__ __forceinline__ unsigned xb_add(unsigned* p, unsigned v) { return __hip_atomic_fetch_add(p, v, __ATOMIC_RELAXED, __HIP_MEMORY_SCOPE_AGENT); }
__device__ __forceinline__ unsigned xb_xcc_id() { return (unsigned)__builtin_amdgcn_s_getreg((3 << 11) | 20) & 0xFu; }
#define XB_SPIN(cond, bar) do { unsigned _sp = 0; while (cond) { __builtin_amdgcn_s_sleep(1); \
    if ((++_sp & 255u) == 0u) { if (xb_ld(&(bar)[XB_TMO])) break; if (_sp > XB_SPIN_CAP) { atomicAdd(&(bar)[XB_TMO], 1u); break; } } } } while (0)

struct XcdBarrier {
    unsigned* bar; unsigned x;
    volatile LAS unsigned* st;
};

__device__ __forceinline__ XcdBarrier xcd_barrier_post(unsigned* bar, volatile LAS unsigned* st, const int wave) {
    XcdBarrier b; b.bar = bar; b.x = xb_xcc_id(); b.st = st;
    if (lane_id() == 0 && wave == 0) (void)xb_add(&bar[XB_XCNT(b.x)], 1u);
    return b;
}
__device__ __forceinline__ void xcd_barrier_complete(unsigned* bar, unsigned x, unsigned& nloc, unsigned& nx) {
    const unsigned G = gridDim.x * gridDim.y * gridDim.z;
    unsigned sum, cnt, mine, sp = 0u;
    for (;;) {
        sum = 0u; cnt = 0u; mine = 0u;
#pragma unroll
        for (unsigned j = 0; j < 16; ++j) { const unsigned c = xb_ld(&bar[XB_XCNT(j)]); sum += c; cnt += (c > 0u) ? 1u : 0u; mine = (j == x) ? c : mine; }
        if (sum == G) break;
        __builtin_amdgcn_s_sleep(1);
        if ((++sp & 255u) == 0u) { if (xb_ld(&bar[XB_TMO])) break; if (sp > XB_SPIN_CAP) { atomicAdd(&bar[XB_TMO], 1u); break; } }
    }
    nloc = mine > 0u ? mine : 1u; nx = cnt > 0u ? cnt : 1u;
}

__device__ __forceinline__ void xcd_barrier(const XcdBarrier& b, const int wave) {
    asm volatile("s_waitcnt vmcnt(0)" ::: "memory");
    __syncthreads();
    if (wave == 0) { if (lane_id() == 0) {
        unsigned* bar = b.bar;
        __builtin_amdgcn_s_waitcnt(0);
        unsigned nloc = b.st[0], nx = b.st[1];
        if (nloc == 0u) { xcd_barrier_complete(bar, b.x, nloc, nx); b.st[0] = nloc; b.st[1] = nx; }
        const unsigned old = xb_add(&bar[XB_XSUB(b.x)], 1u);
        const unsigned gen = old / nloc;
        if (old + 1u == (gen + 1u) * nloc) {
            __builtin_amdgcn_fence(__ATOMIC_RELEASE, "agent");
            asm volatile("s_waitcnt vmcnt(0)" ::: "memory");
            const unsigned og = xb_add(&bar[XB_TOP], 1u);
            const unsigned tg = og / nx;
            if (og + 1u == (tg + 1u) * nx) xb_add(&bar[XB_TOPGEN], 1u);
            else XB_SPIN(xb_ld(&bar[XB_TOPGEN]) == tg, bar);
            __builtin_amdgcn_fence(__ATOMIC_ACQUIRE, "agent");
            xb_add(&bar[XB_XGEN(b.x)], 1u);
            asm volatile("s_waitcnt vmcnt(0)" ::: "memory");
        } else {
            XB_SPIN(xb_ld(&bar[XB_XGEN(b.x)]) == gen, bar);
            __builtin_amdgcn_fence(__ATOMIC_ACQUIRE, "agent");
            asm volatile("s_waitcnt vmcnt(0)" ::: "memory");
        }
    } }
    __syncthreads();
}

#define grid_bar(barptr, epoch, wv) xcd_barrier(xbar, (wv))
typedef const __attribute__((address_space(4))) Args* KArgs;
#if defined(__HIP_DEVICE_COMPILE__)
__device__ __forceinline__ Args kargs() { KArgs p = (KArgs)__builtin_amdgcn_kernarg_segment_ptr(); asm volatile("" : "+s"(p)); return *p; }
#else
__device__ __forceinline__ Args kargs() { return Args{}; }
#endif
#define PHASE_ARGS const Args a = kargs(); unsigned char* ws = a.ws; (void)ws

__device__ __forceinline__ void cscan_phase(const Args& a, const int wave, LAS unsigned char* lds, const XcdBarrier& xbar) {
    unsigned* gb = (unsigned*)(a.ws + WS_BAR) + 8192; LAS unsigned* pf = (LAS unsigned*)(lds + CR_FLAGS);
    const unsigned x = xb_xcc_id();
    __syncthreads();
    if (wave == 0 && lane_id() < 24) pf[lane_id()] = 0u;
    if (blockIdx.x >= 64 && wave == 0 && lane_id() == 0) (void)__hip_atomic_fetch_add(gb + CRG_XCNT(x), 1u, __ATOMIC_RELAXED, __HIP_MEMORY_SCOPE_AGENT);
    xcd_barrier(xbar, wave);
    if (blockIdx.x >= 64) {
        if (wave < CR_PW) cscan_build(a, lds + wave * CR_PSLOT, ((int)blockIdx.x - 64) * CR_PW + wave, ((int)gridDim.x - 64) * CR_PW, pf);
        else if (wave == 4) cscan_build_helper(gb, pf, x);
        else cscan_rope(a, wave, pf);
    } else {
        if (wave == 5) cscan_cons_helper(gb, pf, (int)blockIdx.x); else cscan_consume(a, wave, lds, blockIdx.x);
    }
}


__global__ void __launch_bounds__(NTHREADS, 2) fwd_megakernel(Args a_by_value) {
    extern __shared__ __attribute__((aligned(16))) unsigned char lds_raw[];
    LAS unsigned char* lds = (LAS unsigned char*)lds_raw;
    cg::grid_group grid = cg::this_grid();
    const int wave = __builtin_amdgcn_readfirstlane((int)threadIdx.x >> 6);
    { volatile LAS unsigned* st0 = (volatile LAS unsigned*)(lds + LDS_BYTES - 16); if (wave == 0 && lane_id() < 4) st0[lane_id()] = 0u; __syncthreads(); }
    const XcdBarrier xbar = xcd_barrier_post((unsigned*)(kargs().ws + WS_BAR), (volatile LAS unsigned*)(lds + LDS_BYTES - 16), wave);
    int lo, hi; { const Args a0 = kargs(); lo = a0.ph_lo; hi = a0.ph_hi; }
#ifdef ONLY_PH
#define IN(k) ((k) == ONLY_PH && lo <= (k) && (k) < hi)
#else
#define IN(k) (lo <= (k) && (k) < hi)
#endif
#define SEAM(k) do { if (IN(k) && IN((k) + 1)) { if ((k) == 0) grid.sync(); else grid_bar((unsigned*)(kargs().ws + WS_BAR), (unsigned)(k), wave); } } while (0)
#ifdef REP_PH
#ifndef REP_N
#define REP_N 2
#endif
#define NREP(k) ((k) == REP_PH ? REP_N : 1)
#else
#define NREP(k) 1
#endif
#define REPEAT(k) for (int rep_ = 0; rep_ < NREP(k); ++rep_, (rep_ < NREP(k) ? grid_bar((unsigned*)(kargs().ws + WS_BAR) + 128, 1u, wave) : (void)0))
#ifdef STAMP_K
#define TSTAMP(k) do { if (((k) == STAMP_K || (k) == STAMP_K + 1) && blockIdx.x == 0 && wave == 0) { const unsigned long long t_ = __builtin_amdgcn_s_memrealtime(); \
        if (__builtin_amdgcn_mbcnt_lo(~0u, 0u) == 0u) ((unsigned long long*)(kargs().ws + WS_STAMP))[(k) - STAMP_K] = t_; } } while (0)
#else
#define TSTAMP(k) do { } while (0)
#endif
#ifdef STAMP_K
    if (blockIdx.x == PROBE_BLK && wave == 0) { unsigned long long* st_ = (unsigned long long*)(kargs().ws + WS_STAMP); if (__builtin_amdgcn_mbcnt_lo(~0u, 0u) < 3u) st_[__builtin_amdgcn_mbcnt_lo(~0u, 0u)] = 0ull; }
#endif
    TSTAMP(0);
    if (IN(0)) REPEAT(0) { PHASE_ARGS; p0_prologue(a, wave, lds); } SEAM(0); TSTAMP(1);
    if (IN(1)) REPEAT(1) { PHASE_ARGS; norm_phase(a, wave, lds, a.x, 0); } SEAM(1); TSTAMP(2);
    if (IN(2)) REPEAT(2) { PHASE_ARGS;
        pg8::Gemm g{(const bf16_t*)(ws + WS_H), (const bf16_t*)(ws + WS_WIN0), MTOK, N0, DM}; pg8::StaticOrder S; S.init(MTOK, N0, gridDim.x, blockIdx.x);
        #ifdef EPI0_CHEAP_FIRST
        Epi0 E{ws, (unsigned char*)a.out, NREP(2) == 2 && rep_ == 0 && a.ph_hi > 0, lds + pg8::STAGE_BYTES};
#else
        Epi0 E{ws, (unsigned char*)a.out, false, lds + pg8::STAGE_BYTES};
#endif
#ifdef SKEW0
        if (blockIdx.x >= 128) { const unsigned long long t0_ = __builtin_amdgcn_s_memrealtime(); while (__builtin_amdgcn_s_memrealtime() - t0_ < (unsigned long long)(SKEW0)) __builtin_amdgcn_s_sleep(64); }
#endif
        pg8::gemm_phase<Epi0, pg8::StaticOrder, true, true>(lds, g, S, E, wave);
    } SEAM(2); TSTAMP(3);
    if (IN(3)) REPEAT(3) { PHASE_ARGS; conv_phase(a, wave, lds, blockIdx.x, gridDim.x); lora_pre_phase(a, wave); } SEAM(3); TSTAMP(4);
    if (IN(4)) REPEAT(4) { PHASE_ARGS;
        pg8::Gemm g{(const bf16_t*)((unsigned char*)a.out + DO_LA), (const bf16_t*)(ws + WS_WLORA), MTOK, 2048, 128}; pg8::StaticOrder S; S.init(MTOK, 2048, gridDim.x, blockIdx.x);
        EpiLora E{(bf16_t*)(ws + WS_DARR), (bf16_t*)(ws + WS_AARR), a.rwkv_vec, lds + pg8::STAGE_BYTES};
        pg8::gemm_phase<EpiLora, pg8::StaticOrder, true, true>(lds, g, S, E, wave);
    } SEAM(4); TSTAMP(5);
    if (IN(5)) REPEAT(5) { PHASE_ARGS;
#if OLD_SCAN
        scan_phase(a, wave, lds);
#else
        cscan_phase(a, wave, lds, xbar);
#endif
    } SEAM(5); TSTAMP(6);
    if (IN(6)) REPEAT(6) { PHASE_ARGS; post_phase(a, wave); } SEAM(6); TSTAMP(7);
    if (IN(7)) REPEAT(7) { PHASE_ARGS;
        pg8::Gemm g{(const bf16_t*)(ws + WS_YAB), (const bf16_t*)(ws + WS_WOUT0), MTOK, DM, 2048}; pg8::StaticOrder S; S.init(MTOK, DM, gridDim.x, blockIdx.x);
        EpiRes E{a.x, a.out, (const float*)(ws + WS_MODP), a.ada_b, 0, NREP(7) >= 2 && rep_ == 0 && a.ph_hi > 0, lds + pg8::STAGE_BYTES};
        pg8::gemm_phase<EpiRes, pg8::StaticOrder, true, true>(lds, g, S, E, wave);
    } SEAM(7); TSTAMP(8);
    if (IN(8)) REPEAT(8) { PHASE_ARGS; norm_phase(a, wave, lds, a.out, 1); } SEAM(8); TSTAMP(9);
    if (IN(9)) REPEAT(9) { PHASE_ARGS;
        pg8::Gemm g{(const bf16_t*)(ws + WS_H), (const bf16_t*)(ws + WS_WIN1), MTOK, N1, DM}; pg8::StaticOrder S; S.init(MTOK, N1, gridDim.x, blockIdx.x);
        Epi1 E{(bf16_t*)(ws + WS_Q), (bf16_t*)(ws + WS_KV), (bf16_t*)(ws + WS_QI), (bf16_t*)(ws + WS_KI), (bf16_t*)(ws + WS_G), (float*)(ws + WS_WI), (const f32x2*)(ws + WS_CSA), (const f32x2*)(ws + WS_CSI), lds + pg8::STAGE_BYTES};
        pg8::gemm_phase<Epi1, pg8::StaticOrder, true, true>(lds, g, S, E, wave);
    } SEAM(9); TSTAMP(10);
    if (IN(10)) REPEAT(10) { PHASE_ARGS; dsa_phase(a, wave, lds, NREP(10) == 2 && rep_ == 0 && a.ph_hi > 0); } SEAM(10); TSTAMP(11);
    if (IN(11)) REPEAT(11) { PHASE_ARGS;
        pg8::Gemm g{(const bf16_t*)(ws + WS_G), (const bf16_t*)(ws + WS_WOUT1), MTOK, DM, 2048}; pg8::StaticOrder S; S.init(MTOK, DM, gridDim.x, blockIdx.x);
        EpiRes E{a.out, a.out, (const float*)(ws + WS_MODP), a.ada_b, 1, false, lds + pg8::STAGE_BYTES};
        pg8::gemm_phase<EpiRes, pg8::StaticOrder, true, true>(lds, g, S, E, wave);
    } SEAM(11); TSTAMP(12);
    if (IN(12)) REPEAT(12) { PHASE_ARGS; final_phase(a, wave); }
#undef IN
#undef SEAM
}

extern "C" void kernel_launch(void* const* d_in, const int* in_sizes, int n_in, void* d_out, int out_size, void* d_ws, size_t ws_size, hipStream_t stream) {
    static int grid = 0;
    if (grid == 0) {
        if (n_in != 19 || out_size != MTOK * DM || ws_size < WS_NEED) { fprintf(stderr, "kernel_launch: unexpected shapes (n_in %d, out %d, ws %zu)\n", n_in, out_size, ws_size); grid = -1; return; }
        int dev = 0, cus = 0, per_cu = 0;
        (void)hipGetDevice(&dev); (void)hipDeviceGetAttribute(&cus, hipDeviceAttributeMultiprocessorCount, dev);
        if (hipFuncSetAttribute((const void*)fwd_megakernel, hipFuncAttributeMaxDynamicSharedMemorySize, LDS_BYTES) != hipSuccess) { fprintf(stderr, "kernel_launch: hipFuncSetAttribute failed\n"); grid = -1; return; }
        if (hipOccupancyMaxActiveBlocksPerMultiprocessor(&per_cu, (const void*)fwd_megakernel, NTHREADS, LDS_BYTES) != hipSuccess || per_cu < 1) { fprintf(stderr, "kernel_launch: occupancy query says %d\n", per_cu); per_cu = 1; }
        (void)hipGetLastError();
        grid = cus;
        if (grid > 256) grid = 256;
    }
    if (grid < 0) return;
    Args a{};
    a.x = (const float*)d_in[0]; a.c = (const float*)d_in[1]; a.pos = (const int*)d_in[2]; a.ada_w = (const float*)d_in[3]; a.ada_b = (const float*)d_in[4];
    a.norm_g = (const float*)d_in[5]; a.final_g = (const float*)d_in[6]; a.even_w_in = (const float*)d_in[7]; a.even_w_out = (const float*)d_in[8];
    a.conv_w = (const float*)d_in[9]; a.conv_vec = (const float*)d_in[10]; a.mu_rkv = (const float*)d_in[11]; a.mu_lora = (const float*)d_in[12];
    a.rwkv_vec = (const float*)d_in[13]; a.w_up = (const float*)d_in[14]; a.a_up = (const float*)d_in[15]; a.r_k = (const float*)d_in[16];
    a.odd_w_in = (const float*)d_in[17]; a.odd_w_out = (const float*)d_in[18];
    a.out = (float*)d_out; a.ws = (unsigned char*)d_ws;
    (void)hipMemsetAsync((char*)d_ws + WS_BAR, 0, 196608, stream);
#if MK_SPLIT
    for (int p = 0; p < MK_PH_END; ++p) { a.ph_lo = p; a.ph_hi = p + 1; void* args[] = {&a};
        hipError_t e = hipLaunchCooperativeKernel((const void*)fwd_megakernel, dim3(grid), dim3(NTHREADS), args, LDS_BYTES, stream);
        if (e != hipSuccess) { fprintf(stderr, "launch %d failed: %s\n", p, hipGetErrorString(e)); break; } }
#else
    a.ph_lo = 0; a.ph_hi = MK_PH_END; void* args[] = {&a};
    hipError_t e = hipLaunchCooperativeKernel((const void*)fwd_megakernel, dim3(grid), dim3(NTHREADS), args, LDS_BYTES, stream);
    if (e != hipSuccess) fprintf(stderr, "cooperative launch failed: %s (grid %d)\n", hipGetErrorString(e), grid);
#endif
}
```
